# Optimizing an MI355X kernel written in HIP

```python
import math
import jax, jax.numpy as jnp
from jax import lax
import numpy as np

D_MODEL = 1024
BATCH = 8
SEQ = 4096
DEPTH = 1

N_MEM = 256
MOBA_HEADS = 8
MOBA_HD = 64
MOBA_W = MOBA_HEADS * MOBA_HD
MOBA_BLOCK = 256
MOBA_TOPK = 3
MOBA_QCHUNK = 32
HG_HEADS = 8
HG_DK = 64
HG_DV = 64
HG_W = HG_HEADS * HG_DK
HG_CHUNK = 64
MIX_W = MOBA_W + HG_HEADS * HG_DV
IN_COLS = 3 * MOBA_W + 4 * HG_W
X_HEADS = 4
X_HD = D_MODEL // X_HEADS
N_EXPERTS = 32
TOP_K = 4
D_FF = D_MODEL
SWIGLU_LIMIT = 7.0
SWIGLU_ALPHA = 1.702
MOE_BLOCK = 256
EPS = 1e-6
NEG = -1e30

kernel_name = 'hymba_moba_hgrn2_moe_layer'


def rmsnorm(x, g):
    xf = x.astype(jnp.float32)
    y = xf * lax.rsqrt(jnp.mean(xf * xf, axis=-1, keepdims=True) + EPS)
    return (y * g.astype(jnp.float32)).astype(x.dtype)


def split_heads(t, n_heads):
    b, s, w = t.shape
    return t.reshape(b, s, n_heads, w // n_heads).transpose(0, 2, 1, 3)


def moba_attention(q, k, v):
    B, H, S, hd = q.shape
    nb = -(-S // MOBA_BLOCK)
    pad = nb * MOBA_BLOCK - S
    kp = jnp.pad(k, ((0, 0), (0, 0), (0, pad), (0, 0)))
    vp = jnp.pad(v, ((0, 0), (0, 0), (0, pad), (0, 0)))
    kb = kp.reshape(B, H, nb, MOBA_BLOCK, hd)
    vb = vp.reshape(B, H, nb, MOBA_BLOCK, hd)
    kbar = jnp.mean(kb.astype(jnp.float32), axis=3)
    gate = jnp.einsum('bhsd,bhnd->bhsn', q.astype(jnp.float32), kbar)
    q_blk = jnp.arange(S, dtype=jnp.int32) // MOBA_BLOCK
    past = jnp.arange(nb, dtype=jnp.int32)[None, :] < q_blk[:, None]
    gate = jnp.where(past, gate, NEG)
    n_sel = min(MOBA_TOPK, nb)
    _, idx = lax.top_k(gate, n_sel)
    valid = idx < q_blk[:, None]

    nqc = S // MOBA_QCHUNK
    def to_chunks(t):
        return jnp.moveaxis(t.reshape(B, H, nqc, MOBA_QCHUNK, *t.shape[3:]), 2, 0)
    q_ch, idx_ch, val_ch = to_chunks(q), to_chunks(idx), to_chunks(valid)
    bi = jnp.arange(B)[:, None, None, None]
    hi = jnp.arange(H)[None, :, None, None]
    scale = hd ** -0.5

    def one_chunk(args):
        c, qc, ic, vc = args
        q0 = c * MOBA_QCHUNK
        j = q0 // MOBA_BLOCK
        k_sel = kb[bi, hi, ic]
        v_sel = vb[bi, hi, ic]
        k_own = lax.dynamic_index_in_dim(kb, j, axis=2, keepdims=False)
        v_own = lax.dynamic_index_in_dim(vb, j, axis=2, keepdims=False)
        s_sel = jnp.einsum('bhqd,bhqnkd->bhqnk', qc, k_sel).astype(jnp.float32) * scale
        s_sel = jnp.where(vc[..., None], s_sel, NEG).reshape(B, H, MOBA_QCHUNK, n_sel * MOBA_BLOCK)
        s_own = jnp.einsum('bhqd,bhkd->bhqk', qc, k_own).astype(jnp.float32) * scale
        qpos = q0 + jnp.arange(MOBA_QCHUNK, dtype=jnp.int32)
        kpos = j * MOBA_BLOCK + jnp.arange(MOBA_BLOCK, dtype=jnp.int32)
        s_own = jnp.where(kpos[None, :] <= qpos[:, None], s_own, NEG)
        p = jax.nn.softmax(jnp.concatenate([s_sel, s_own], axis=-1), axis=-1).astype(v.dtype)
        p_sel = p[..., :n_sel * MOBA_BLOCK].reshape(B, H, MOBA_QCHUNK, n_sel, MOBA_BLOCK)
        p_own = p[..., n_sel * MOBA_BLOCK:]
        return (jnp.einsum('bhqnk,bhqnkd->bhqd', p_sel, v_sel)
                + jnp.einsum('bhqk,bhkd->bhqd', p_own, v_own))

    out = lax.map(one_chunk, (jnp.arange(nqc, dtype=jnp.int32), q_ch, idx_ch, val_ch))
    return jnp.moveaxis(out, 0, 2).reshape(B, H, S, hd)


def hgrn2(q_raw, f_raw, i_raw, lb):
    B, S, _ = q_raw.shape
    f = lb + (1.0 - lb) * jax.nn.sigmoid(f_raw.astype(jnp.float32))
    logf = jnp.log(f)
    k = 1.0 - f
    q = jax.nn.silu(q_raw.astype(jnp.float32))
    v = i_raw.astype(jnp.float32)
    nch = S // HG_CHUNK
    def to_chunks(t):
        t = split_heads(t, HG_HEADS)
        return jnp.moveaxis(t.reshape(B, HG_HEADS, nch, HG_CHUNK, t.shape[-1]), 2, 0)
    qc, kc, vc, lc = to_chunks(q), to_chunks(k), to_chunks(v), to_chunks(logf)
    bc = jnp.cumsum(lc, axis=-2)
    tri = jnp.arange(HG_CHUNK)[:, None] >= jnp.arange(HG_CHUNK)[None, :]

    def step(state, inp):
        qt, kt, vt, bt = inp
        o_inter = jnp.einsum('bhtk,bhkv->bhtv', qt * jnp.exp(bt), state)
        diff = bt[:, :, :, None, :] - bt[:, :, None, :, :]
        decay = jnp.exp(jnp.where(tri[:, :, None], diff, -jnp.inf))
        a = jnp.einsum('bhtk,bhsk,bhtsk->bhts', qt, kt, decay)
        o_intra = jnp.einsum('bhts,bhsv->bhtv', a, vt)
        b_end = bt[:, :, -1]
        new_state = (jnp.exp(b_end)[..., None] * state
                     + jnp.einsum('bhsk,bhsv->bhkv', kt * jnp.exp(b_end[:, :, None] - bt), vt))
        return new_state, o_inter + o_intra

    s0 = jnp.zeros((B, HG_HEADS, HG_DK, HG_DV), jnp.float32)
    _, o = lax.scan(step, s0, (qc, kc, vc, bc))
    return jnp.moveaxis(o, 0, 2).reshape(B, HG_HEADS, S, HG_DV)


def cross_attention(hn, mem, g_mem, wq, wkv, wo):
    mn = rmsnorm(mem, g_mem)
    q = split_heads(hn @ wq, X_HEADS)
    k, v = jnp.split(mn @ wkv, 2, axis=-1)
    k, v = split_heads(k, X_HEADS), split_heads(v, X_HEADS)
    s = jnp.einsum('bhqd,bhkd->bhqk', q, k).astype(jnp.float32) * (X_HD ** -0.5)
    p = jax.nn.softmax(s, axis=-1).astype(v.dtype)
    o = jnp.einsum('bhqk,bhkd->bhqd', p, v)
    B, _, S, _ = o.shape
    return o.transpose(0, 2, 1, 3).reshape(B, S, D_MODEL) @ wo


def moe_ffn(xn, w_router, b_router, w1, b1, w2, b2):
    B, S, D = xn.shape
    T = B * S
    xt = xn.reshape(T, D)
    logits = (xt @ w_router).astype(jnp.float32) + b_router.astype(jnp.float32)
    top_v, top_i = lax.top_k(logits, TOP_K)
    gates = jax.nn.softmax(top_v, axis=-1)
    M = T * TOP_K
    flat_e = top_i.reshape(M)
    flat_tok = jnp.repeat(jnp.arange(T, dtype=jnp.int32), TOP_K)
    flat_g = gates.reshape(M)
    order = jnp.argsort(flat_e)
    se = flat_e[order]
    counts = jnp.zeros((N_EXPERTS,), jnp.int32).at[flat_e].add(1)
    start = jnp.cumsum(counts) - counts
    padded = (counts + MOE_BLOCK - 1) // MOE_BLOCK * MOE_BLOCK
    pad_end = jnp.cumsum(padded)
    pad_start = pad_end - padded
    dest = pad_start[se] + (jnp.arange(M, dtype=jnp.int32) - start[se])
    m_pad = M + N_EXPERTS * MOE_BLOCK
    n_blk = m_pad // MOE_BLOCK
    row_tok = jnp.zeros((m_pad,), jnp.int32).at[dest].set(flat_tok[order])
    row_g = jnp.zeros((m_pad,), jnp.float32).at[dest].set(flat_g[order])
    block_e = jnp.minimum(
        jnp.searchsorted(pad_end, jnp.arange(n_blk, dtype=jnp.int32) * MOE_BLOCK, side='right'),
        N_EXPERTS - 1).astype(jnp.int32)
    xs = xt[row_tok].reshape(n_blk, MOE_BLOCK, D)

    def expert_block(args):
        xb, e = args
        hcat = xb @ w1[e] + b1[e]
        glu = jnp.minimum(hcat[:, 0::2], SWIGLU_LIMIT)
        lin = jnp.clip(hcat[:, 1::2], -SWIGLU_LIMIT, SWIGLU_LIMIT)
        act = glu * jax.nn.sigmoid(SWIGLU_ALPHA * glu) * (lin + 1.0)
        return act @ w2[e] + b2[e]

    ys = lax.map(expert_block, (xs, block_e)).reshape(m_pad, D)
    out = jnp.zeros((T, D), jnp.float32).at[row_tok].add(ys.astype(jnp.float32) * row_g[:, None])
    return out.astype(xn.dtype).reshape(B, S, D)


def setup_inputs(seed: int = 0) -> dict:
    key = jax.random.key(seed)
    ks = jax.random.split(key, 24)
    f32 = jnp.float32
    def nrm(k, shape, scale):
        return jax.random.normal(k, shape, f32) * scale
    def gain(k, shape):
        return 1.0 + 0.02 * jax.random.normal(k, shape, f32)
    L = DEPTH
    return {
        'x': nrm(ks[0], (BATCH, SEQ, D_MODEL), 1.0),
        'mem': nrm(ks[1], (BATCH, N_MEM, D_MODEL), 1.0),
        'ln_mix_g': gain(ks[2], (L, D_MODEL)),
        'w_in': nrm(ks[3], (L, D_MODEL, IN_COLS), D_MODEL ** -0.5),
        'hgrn_lb_logits': nrm(ks[4], (L + 1, HG_W), 0.1),
        'hgrn_norm_g': gain(ks[5], (L, HG_HEADS * HG_DV)),
        'w_out': nrm(ks[6], (L, MIX_W, D_MODEL), MIX_W ** -0.5),
        'ln_x_g': gain(ks[7], (L, D_MODEL)),
        'ln_mem_g': gain(ks[8], (L, D_MODEL)),
        'wq_x': nrm(ks[9], (L, D_MODEL, D_MODEL), D_MODEL ** -0.5),
        'wkv_x': nrm(ks[10], (L, D_MODEL, 2 * D_MODEL), D_MODEL ** -0.5),
        'wo_x': nrm(ks[11], (L, D_MODEL, D_MODEL), D_MODEL ** -0.5),
        'ln_moe_g': gain(ks[12], (L, D_MODEL)),
        'w_router': nrm(ks[13], (L, D_MODEL, N_EXPERTS), D_MODEL ** -0.5),
        'b_router': nrm(ks[14], (L, N_EXPERTS), 0.01),
        'w1': nrm(ks[15], (L, N_EXPERTS, D_MODEL, 2 * D_FF), D_MODEL ** -0.5),
        'b1': nrm(ks[16], (L, N_EXPERTS, 2 * D_FF), 0.02),
        'w2': nrm(ks[17], (L, N_EXPERTS, D_FF, D_MODEL), D_FF ** -0.5),
        'b2': nrm(ks[18], (L, N_EXPERTS, D_MODEL), 0.02),
        'ln_f_g': gain(ks[19], (D_MODEL,)),
    }


def reference(x, mem, ln_mix_g, w_in, hgrn_lb_logits, hgrn_norm_g, w_out,
              ln_x_g, ln_mem_g, wq_x, wkv_x, wo_x,
              ln_moe_g, w_router, b_router, w1, b1, w2, b2, ln_f_g):
    B, S, _ = x.shape
    lb_table = jnp.cumsum(jax.nn.softmax(hgrn_lb_logits.astype(jnp.float32), axis=0), axis=0)
    split_pts = [MOBA_W, 2 * MOBA_W, 3 * MOBA_W,
                 3 * MOBA_W + HG_W, 3 * MOBA_W + 2 * HG_W, 3 * MOBA_W + 3 * HG_W]
    h = x
    for l in range(DEPTH):
        hn = rmsnorm(h, ln_mix_g[l])
        proj = hn @ w_in[l]
        mq, mk, mv, gq, gf, gi, gg = jnp.split(proj, split_pts, axis=-1)
        moba_o = moba_attention(split_heads(mq, MOBA_HEADS), split_heads(mk, MOBA_HEADS),
                                split_heads(mv, MOBA_HEADS))
        moba_o = moba_o.transpose(0, 2, 1, 3).reshape(B, S, MOBA_W)
        hg_o = hgrn2(gq, gf, gi, lb_table[l])
        hg_o = hg_o.transpose(0, 2, 1, 3)
        hg_o = hg_o * lax.rsqrt(jnp.mean(hg_o * hg_o, axis=-1, keepdims=True) + EPS)
        hg_o = hg_o * hgrn_norm_g[l].astype(jnp.float32).reshape(HG_HEADS, HG_DV)
        hg_o = (hg_o.reshape(B, S, HG_HEADS * HG_DV)
                * jax.nn.silu(gg.astype(jnp.float32))).astype(x.dtype)
        h = h + jnp.concatenate([moba_o, hg_o], axis=-1) @ w_out[l]
        h = h + cross_attention(rmsnorm(h, ln_x_g[l]), mem, ln_mem_g[l], wq_x[l], wkv_x[l], wo_x[l])
        h = h + moe_ffn(rmsnorm(h, ln_moe_g[l]), w_router[l], b_router[l],
                        w1[l], b1[l], w2[l], b2[l])
    return rmsnorm(h, ln_f_g)
```

```cpp
#include <hip/hip_runtime.h>
#include <hip/hip_cooperative_groups.h>
#include <cstdio>
#include <cstdint>
namespace cg = cooperative_groups;

#ifndef MK_N_LAUNCHES
#define MK_N_LAUNCHES 1
#endif
#ifndef MK_LAST_PHASE
#define MK_LAST_PHASE 10
#endif

#define LAS __attribute__((address_space(3)))
#define GAS __attribute__((address_space(1)))
typedef unsigned short bf16_t;
typedef short bf16x8 __attribute__((ext_vector_type(8)));
typedef short s16x4 __attribute__((ext_vector_type(4)));
typedef float f32x4 __attribute__((ext_vector_type(4)));
typedef float f32x2 __attribute__((ext_vector_type(2)));
typedef float f32x16 __attribute__((ext_vector_type(16)));
typedef unsigned u32x4 __attribute__((ext_vector_type(4)));
typedef unsigned u32x2 __attribute__((ext_vector_type(2)));

constexpr int BATCH = 8, SEQ = 4096, T = BATCH * SEQ, D = 1024, INC = 3584, NMEM = 256, MROWS = BATCH * NMEM;
constexpr int NEXP = 32, TOPK = 4, MT_MAX = T * TOPK / 256 + NEXP, MPAD = MT_MAX * 256;
constexpr float EPS = 1e-6f;
constexpr float LOG2E = 1.4426950408889634f;
constexpr float C2Q = 0.125f * LOG2E;
constexpr float C2X = 0.0625f * LOG2E;
constexpr int C_MQ = 0, C_MK = 512, C_MV = 1024, C_GQ = 1536, C_GF = 2048, C_GI = 2560, C_GG = 3072;

constexpr size_t MiB = 1u << 20;
constexpr size_t WS_CTL = 0, CTL_ZERO_BYTES = 2 * MiB;
constexpr size_t WS_KBAR = 1 * MiB;
constexpr size_t WS_SS1 = 1 * MiB + 256 * 1024;
constexpr size_t WS_SS2 = 1 * MiB + 384 * 1024;
constexpr size_t WS_TOKE = 2 * MiB, WS_TOKR = 2 * MiB + 512 * 1024, WS_TOKG = 3 * MiB;
constexpr size_t WS_WRT = 3 * MiB + 512 * 1024;
constexpr size_t WS_LIST = 4 * MiB;
constexpr size_t WS_WIN = 16 * MiB, WS_WOUT = 23 * MiB, WS_WQ = 25 * MiB, WS_WKV = 27 * MiB, WS_WO = 31 * MiB;
constexpr size_t WS_MN = 33 * MiB, WS_MEMK = 37 * MiB, WS_MEMVT = 41 * MiB;
constexpr size_t WS_W1 = 48 * MiB, WS_W2 = 176 * MiB;
constexpr size_t WS_PROJ = 240 * MiB;
constexpr size_t WS_XN = 464 * MiB;
constexpr size_t WS_OX = 464 * MiB;
constexpr size_t WS_MIX = 528 * MiB;
constexpr size_t WS_H1B = 592 * MiB;
constexpr size_t WS_QX = 656 * MiB;
constexpr size_t WS_PWS = 720 * MiB;
constexpr size_t WS_HMID = 240 * MiB;
constexpr size_t WS_Y = 512 * MiB;
constexpr size_t WS_H2F = 784 * MiB;
constexpr size_t WS_H2B = 912 * MiB;
constexpr size_t WS_END = 976 * MiB;
static_assert(WS_HMID + (size_t)MPAD * D * 2 <= WS_Y && WS_Y + (size_t)MPAD * D * 2 <= WS_H2F, "ws map");
constexpr int CW_TMO = 0;
constexpr int CW_CNT = 64;
constexpr int CW_QUEUE = 128;
constexpr int CW_BAR = 4096;

__device__ __forceinline__ unsigned f2bf(float f) { unsigned u = __builtin_bit_cast(unsigned, f); return (u + 0x7fffu + ((u >> 16) & 1u)) >> 16; }
__device__ __forceinline__ unsigned pk2(float lo, float hi) { return f2bf(lo) | (f2bf(hi) << 16); }
__device__ __forceinline__ float bf2f(unsigned short h) { return __builtin_bit_cast(float, (unsigned)h << 16); }
__device__ __forceinline__ float bflo(unsigned w) { return __builtin_bit_cast(float, w << 16); }
__device__ __forceinline__ float bfhi(unsigned w) { return __builtin_bit_cast(float, w & 0xffff0000u); }
typedef float f32x2_t __attribute__((ext_vector_type(2))); typedef __bf16 bf16x2_t __attribute__((ext_vector_type(2)));
__device__ __forceinline__ unsigned cvtpk(float lo, float hi) { f32x2_t v = {lo, hi}; bf16x2_t b = __builtin_convertvector(v, bf16x2_t); return __builtin_bit_cast(unsigned, b); }
__device__ __forceinline__ float wave_sum(float v) {
#pragma unroll
    for (int o = 1; o < 64; o <<= 1) v += __shfl_xor(v, o);
    return v;
}
__device__ __forceinline__ float fast_exp2(float x) { return __builtin_amdgcn_exp2f(x); }
__device__ __forceinline__ float fast_rcp(float x) { return __builtin_amdgcn_rcpf(x); }
__device__ __forceinline__ float silu_f(float x) { return x * fast_rcp(1.0f + fast_exp2(-x * LOG2E)); }
#define LDS_WAIT() asm volatile("s_waitcnt lgkmcnt(0)" ::: "memory")
#define VM_WAIT() asm volatile("s_waitcnt vmcnt(0)" ::: "memory")
#define RLX_AGENT __ATOMIC_RELAXED, __HIP_MEMORY_SCOPE_AGENT

namespace pg8 {
constexpr int BM = 256, BK = 64, HALF = 128, HTB = HALF * BK * 2, STAGE_BYTES = 8 * HTB;
__host__ __device__ __forceinline__ int lds_byte(int r, int c) { const int st = (r >> 4) * 2 + (c >> 5), rr = r & 15, cc = c & 31, ob = rr * 64 + cc * 2; return st * 1024 + (ob ^ (((ob >> 9) & 1) << 5)); }
__host__ __device__ __forceinline__ void stage_rc(int b, int& R, int& C) { const int st = b / 1024, sb = b % 1024, swz = sb ^ (((sb >> 9) & 1) << 5); R = (st >> 1) * 16 + swz / 64; C = (st & 1) * 32 + (swz % 64) / 2; }
__host__ __device__ __forceinline__ int perm32(int rho) { const int n = rho >> 4, i = rho & 15; return 8 * (i >> 2) + 4 * n + (i & 3); }

struct Unit { const char* A; const char* B; const int* rows; int pm, pn, aux, nrows; };

template <class Epi, class Sched, bool GATHER, bool ALIGN_EPI>
__device__ __forceinline__ void gemm_phase(LAS unsigned char* lds, const int lda, const int ldb, const int nt_in, const Sched& S, const Epi& E) {
    int nt = nt_in; asm volatile("" : "+s"(nt));
    int tid_ = threadIdx.x; asm volatile("" : "+v"(tid_));
    const int tid = tid_, wid = __builtin_amdgcn_readfirstlane(tid >> 6), lane = tid & 63, wr = wid >> 2, wc = wid & 3, fr = lane & 15, fq = lane >> 4;
    unsigned offB[2];
#pragma unroll
    for (int i = 0; i < 2; ++i) { int R, C; stage_rc(tid * 16 + i * 8192, R, C); const int Rb = Epi::PERM ? ((R & ~31) + perm32(R & 31)) : R;
        offB[i] = (unsigned)(Rb * ldb + C) * 2u; }
    const size_t kstep = (size_t)(BK * 2);
    const size_t hstepB = (size_t)HALF * ldb * 2;
    const unsigned ldsw = (unsigned)wid * 1024u;
    const int aoff = lds_byte(wr * 64 + fr, fq * 8), boff = lds_byte(wc * 32 + fr, fq * 8);
#define PG8_SA(b, h) (((b) * 2 + (h)) * HTB)
#define PG8_SB(b, h) ((4 + (b) * 2 + (h)) * HTB)
#define PG8_STG(bufoff, gbase, o0, o1) do { \
        __builtin_amdgcn_global_load_lds((const unsigned*)((const char*)(gbase) + (o0)), (LAS unsigned*)(lds + (bufoff) + ldsw), 16, 0, 0); \
        __builtin_amdgcn_global_load_lds((const unsigned*)((const char*)(gbase) + (o1)), (LAS unsigned*)(lds + (bufoff) + ldsw + 8192), 16, 0, 0); } while (0)
#define PG8_STGB(bufoff, gbase) PG8_STG(bufoff, gbase, offB[0], offB[1])
#define PG8_LDA(dst, b, h) do { _Pragma("unroll") for (int m = 0; m < 4; ++m) _Pragma("unroll") for (int k = 0; k < 2; ++k) dst[m][k] = *(const LAS bf16x8*)(lds + PG8_SA(b, h) + aoff + m * 2048 + k * 1024); } while (0)
#define PG8_LDB(dst, b, h) do { _Pragma("unroll") for (int n = 0; n < 2; ++n) _Pragma("unroll") for (int k = 0; k < 2; ++k) dst[n][k] = *(const LAS bf16x8*)(lds + PG8_SB(b, h) + boff + n * 2048 + k * 1024); } while (0)
#define PG8_MMA(ai, bj, At, Bt) do { __builtin_amdgcn_s_setprio(1); _Pragma("unroll") for (int m = 0; m < 4; ++m) _Pragma("unroll") for (int n = 0; n < 2; ++n) _Pragma("unroll") for (int k = 0; k < 2; ++k) \
        acc[ai][bj][m][n] = __builtin_amdgcn_mfma_f32_16x16x32_bf16(Bt[n][k], At[m][k], acc[ai][bj][m][n], 0, 0, 0); __builtin_amdgcn_s_setprio(0); } while (0)
#define PG8_WAIT_V(n) asm volatile("s_waitcnt vmcnt(" #n ")" ::: "memory")
#define PG8_WAIT_L(n) asm volatile("s_waitcnt lgkmcnt(" #n ")" ::: "memory")
#define PG8_BAR __builtin_amdgcn_s_barrier()
#define PG8_SCHED __builtin_amdgcn_sched_barrier(0)
    unsigned voffA[2], c2[2], pkc[2], pkn[2];
#pragma unroll
    for (int i = 0; i < 2; ++i) { int R, C; stage_rc(tid * 16 + i * 8192, R, C); voffA[i] = (unsigned)(R * lda + C) * 2u; c2[i] = (unsigned)C * 2u; }
    const size_t hstepA = (size_t)HALF * lda * 2;
    const unsigned lda2 = (unsigned)lda * 2u;
#define PG8_PKROWS(dst, u) do { if (GATHER) { _Pragma("unroll") for (int i_ = 0; i_ < 2; ++i_) { int R_, C_; stage_rc(tid * 16 + i_ * 8192, R_, C_); \
        const int nr_ = (u).nrows - 1; const int r0_ = R_ < nr_ ? R_ : nr_, r1_ = (R_ + HALF) < nr_ ? (R_ + HALF) : nr_; \
        dst[i_] = (unsigned)(u).rows[r0_] | ((unsigned)(u).rows[r1_] << 16); } } } while (0)
#define PG8_STGA(bufoff, gbase, h, NX) do { \
        if (GATHER) { const unsigned p0_ = (NX) ? pkn[0] : pkc[0], p1_ = (NX) ? pkn[1] : pkc[1]; \
            const unsigned o0_ = ((h) ? (p0_ >> 16) : (p0_ & 0xffffu)) * lda2 + c2[0], o1_ = ((h) ? (p1_ >> 16) : (p1_ & 0xffffu)) * lda2 + c2[1]; \
            PG8_STG(bufoff, gbase, o0_, o1_); } \
        else { PG8_STG(bufoff, (gbase) + ((h) ? hstepA : (size_t)0), voffA[0], voffA[1]); } } while (0)
    Unit cur, nxt; int ui = 0;
    if (!S.next(0, cur)) return;
    f32x4 acc[2][2][4][2];
#pragma unroll
    for (int a = 0; a < 2; ++a)
#pragma unroll
        for (int b = 0; b < 2; ++b)
#pragma unroll
            for (int m = 0; m < 4; ++m)
#pragma unroll
                for (int n = 0; n < 2; ++n) acc[a][b][m][n] = (f32x4){0.f, 0.f, 0.f, 0.f};
    bf16x8 At[4][2], B0[2][2], B1[2][2];
    pkc[0] = pkc[1] = pkn[0] = pkn[1] = 0u;
    PG8_PKROWS(pkc, cur);
    const char* cA = cur.A; const char* cB = cur.B;
    PG8_STGB(PG8_SB(0, 0), cB); PG8_STGB(PG8_SB(0, 1), cB + hstepB); PG8_STGA(PG8_SA(0, 0), cA, 0, false); PG8_STGA(PG8_SA(0, 1), cA, 1, false);
    if (wr == 1) PG8_BAR;
    PG8_WAIT_V(2); PG8_BAR;
    PG8_STGB(PG8_SB(1, 0), cB + kstep); PG8_STGA(PG8_SA(1, 0), cA + kstep, 0, false); PG8_STGB(PG8_SB(1, 1), cB + hstepB + kstep);
    PG8_WAIT_V(6); PG8_BAR;
    for (;;) {
        const bool has_next = S.next(ui + 1, nxt);
        if (GATHER) { if (has_next) { PG8_PKROWS(pkn, nxt); } else { pkn[0] = pkc[0]; pkn[1] = pkc[1]; } }
        const char* nA = has_next ? nxt.A : cA; const char* nB = has_next ? nxt.B : cB;
        for (int t = 0; t < nt; t += 2) {
            const bool last = (t == nt - 2);
            const char* a1 = cA + (size_t)(t + 1) * kstep;
            const char* a2 = last ? nA : cA + (size_t)(t + 2) * kstep; const char* b2 = last ? nB : cB + (size_t)(t + 2) * kstep;
            const char* a3 = a2 + kstep; const char* b3 = b2 + kstep;
            PG8_LDB(B0, 0, 0); PG8_LDB(B1, 0, 1); PG8_SCHED; PG8_LDA(At, 0, 0); PG8_STGA(PG8_SA(1, 1), a1, 1, false);
            PG8_WAIT_V(8); PG8_WAIT_L(0); PG8_BAR; PG8_MMA(0, 0, At, B0); PG8_MMA(0, 1, At, B1); PG8_BAR; PG8_SCHED;
            PG8_LDA(At, 0, 1); PG8_STGB(PG8_SB(0, 0), b2); PG8_STGB(PG8_SB(0, 1), b2 + hstepB); PG8_STGA(PG8_SA(0, 0), a2, 0, last);
            PG8_WAIT_V(8); PG8_WAIT_L(0); PG8_BAR; PG8_MMA(1, 0, At, B0); PG8_MMA(1, 1, At, B1); PG8_BAR; PG8_SCHED;
            PG8_LDB(B0, 1, 0); PG8_LDB(B1, 1, 1); PG8_SCHED; PG8_LDA(At, 1, 0); PG8_STGA(PG8_SA(0, 1), a2, 1, last);
            PG8_WAIT_V(8); PG8_WAIT_L(0); PG8_BAR; PG8_MMA(0, 0, At, B0); PG8_MMA(0, 1, At, B1); PG8_BAR; PG8_SCHED;
            PG8_LDA(At, 1, 1); PG8_STGB(PG8_SB(1, 0), b3); PG8_STGB(PG8_SB(1, 1), b3 + hstepB); PG8_STGA(PG8_SA(1, 0), a3, 0, last);
            PG8_WAIT_V(8); PG8_WAIT_L(0); PG8_BAR; PG8_MMA(1, 0, At, B0); PG8_MMA(1, 1, At, B1); PG8_BAR; PG8_SCHED;
        }
        if constexpr (ALIGN_EPI) { if (wr == 0) PG8_BAR; }
        if constexpr (!Epi::AFTER_DRAIN) { int t_e = threadIdx.x; asm volatile("" : "+v"(t_e)); const int fr_e = t_e & 15, fq_e = (t_e >> 4) & 3; E(acc, cur, wr, wc, fr_e, fq_e); }
        if (!has_next) break;
#pragma unroll
        for (int a = 0; a < 2; ++a)
#pragma unroll
            for (int b = 0; b < 2; ++b)
#pragma unroll
                for (int m = 0; m < 4; ++m)
#pragma unroll
                    for (int n = 0; n < 2; ++n) acc[a][b][m][n] = (f32x4){0.f, 0.f, 0.f, 0.f};
        cur = nxt; cA = nA; cB = nB; ++ui;
        if (GATHER) { pkc[0] = pkn[0]; pkc[1] = pkn[1]; }
        if constexpr (ALIGN_EPI) { if (wr == 1) PG8_BAR; }
    }
    PG8_WAIT_V(0);
    if constexpr (!ALIGN_EPI) { if (wr == 0) PG8_BAR; }
    PG8_BAR;
    if constexpr (Epi::AFTER_DRAIN) { int t_e = threadIdx.x; asm volatile("" : "+v"(t_e)); const int fr_e = t_e & 15, fq_e = (t_e >> 4) & 3; E.fused(acc, cur, wr, wc, fr_e, fq_e, lds, wid, t_e & 63); }
#undef PG8_SA
#undef PG8_SB
#undef PG8_STG
#undef PG8_STGB
#undef PG8_LDA
#undef PG8_LDB
#undef PG8_MMA
#undef PG8_WAIT_V
#undef PG8_WAIT_L
#undef PG8_SCHED
#undef PG8_PKROWS
#undef PG8_STGA
}
}

namespace pg8 {
constexpr int NXCD = 8, WGM = 8;
__device__ __forceinline__ void tile_order(int L, int nM, int nN, int& pm, int& pn) {
    const int nwg = nM * nN; int wgid = L;
    { const int q = nwg / NXCD, r = nwg % NXCD, xcd = wgid % NXCD, off = wgid / NXCD; wgid = (xcd < r ? xcd * (q + 1) : r * (q + 1) + (xcd - r) * q) + off; }
    const int nig = WGM * nN, gid = wgid / nig, fm = gid * WGM, gsz = (nM - fm) < WGM ? (nM - fm) : WGM;
    pm = fm + ((wgid % nig) % gsz); pn = (wgid % nig) / gsz;
}
struct DenseOrder {
    const char* A; const char* B; int lda, ldb, nM, nN, G, c;
    __device__ __forceinline__ bool next(int i, Unit& u) const {
        const long L = (long)i * G + c; if (L >= (long)nM * nN) return false;
        int pm, pn; tile_order((int)L, nM, nN, pm, pn);
        u.pm = pm; u.pn = pn; u.aux = 0; u.rows = nullptr; u.nrows = 256;
        u.A = A + (size_t)pm * 256 * lda * 2; u.B = B + (size_t)pn * 256 * ldb * 2; return true;
    }
};
struct KvOrder {
    const char* MN; const char* W; int G, c;
    __device__ __forceinline__ bool next(int i, Unit& u) const {
        const int L = i * G + c; if (L >= 64) return false;
        u.rows = nullptr; u.nrows = 256;
        if (L < 32) { u.aux = 0; u.pm = L >> 2; u.pn = L & 3; u.A = MN + (size_t)u.pm * 256 * D * 2; u.B = W + (size_t)u.pn * 256 * D * 2; }
        else { const int l = L - 32; u.aux = 1; u.pm = l >> 3; u.pn = l & 7; u.A = W + (size_t)(1024 + u.pm * 256) * D * 2; u.B = MN + (size_t)u.pn * 256 * D * 2; }
        return true;
    }
};
struct XaScoreOrder {
    const char* QX; const char* MK; int xu;
    __device__ __forceinline__ bool next(int i, Unit& u) const {
        if (i > 0 || xu >= 512) return false;
        const int head = xu & 3, rt = xu >> 2, b = rt >> 4;
        u.pm = rt; u.pn = head; u.aux = 0; u.rows = nullptr; u.nrows = 256;
        u.A = QX + ((size_t)rt * 256 * D + head * 256) * 2; u.B = MK + ((size_t)b * 256 * D + head * 256) * 2; return true;
    }
};
struct XaPvOrder {
    const char* PW; const char* VT; int G, c;
    __device__ __forceinline__ bool next(int i, Unit& u) const {
        const int xu = c + i * G; if (i >= 2 || xu >= 512) return false;
        const int head = xu & 3, rt = xu >> 2, b = rt >> 4;
        u.pm = rt; u.pn = head; u.aux = 0; u.rows = nullptr; u.nrows = 256;
        u.A = PW + (size_t)i * 256 * 256 * 2; u.B = VT + ((size_t)head * 256 * MROWS + b * 256) * 2; return true;
    }
};
struct MoeOrder {
    const char* A; const char* W; const int* list; const unsigned* cnt; const LAS unsigned char* te; const LAS int* ts;
    int ntiles, nN, G, c; size_t wstride; int gather;
    __device__ __forceinline__ bool next(int i, Unit& u) const {
        const long L = (long)i * G + c; if (L >= (long)ntiles * nN) return false;
        int pm, pn; tile_order((int)L, ntiles, nN, pm, pn);
        const int e = __builtin_amdgcn_readfirstlane((int)te[pm]);
        const int lt = pm - __builtin_amdgcn_readfirstlane(ts[e]);
        const int n = (int)__builtin_amdgcn_readfirstlane((int)__hip_atomic_load(cnt + e, RLX_AGENT)) - lt * 256;
        u.pm = pm; u.pn = pn; u.aux = e; u.nrows = n < 256 ? n : 256;
        u.rows = list + (size_t)e * T + lt * 256;
        u.A = gather ? A : A + (size_t)pm * 256 * D * 2;
        u.B = W + (size_t)e * wstride + (size_t)pn * 256 * D * 2; return true;
    }
};

struct EpiProj {
    static constexpr bool PERM = true, AFTER_DRAIN = false;
    bf16_t* O; float* kbar;
    __device__ __forceinline__ void operator()(const f32x4 (&acc)[2][2][4][2], const Unit& u, int wr, int wc, int fr, int fq) const {
        const int pn = u.pn, row0 = u.pm * BM + wr * 64 + fr, col0 = pn * BM + wc * 32 + 8 * fq;
        const int mode = (pn < 2) ? 1 : ((pn == 6 || pn == 7 || pn >= 12) ? 2 : 0);
#pragma unroll
        for (int ai = 0; ai < 2; ++ai)
#pragma unroll
            for (int m = 0; m < 4; ++m) { bf16_t* rowp = O + (size_t)(row0 + ai * HALF + m * 16) * INC + col0;
#pragma unroll
                for (int bj = 0; bj < 2; ++bj) { f32x4 v0 = acc[ai][bj][m][0], v1 = acc[ai][bj][m][1];
                    if (mode == 1) { v0 = v0 * C2Q; v1 = v1 * C2Q; }
                    else if (mode == 2) {
#pragma unroll
                        for (int e = 0; e < 4; ++e) { v0[e] = silu_f(v0[e]); v1[e] = silu_f(v1[e]); } }
                    u32x4 w; w.x = cvtpk(v0[0], v0[1]); w.y = cvtpk(v0[2], v0[3]); w.z = cvtpk(v1[0], v1[1]); w.w = cvtpk(v1[2], v1[3]);
                    *(u32x4*)(rowp + bj * HALF) = w; } }
        if (pn == 2 || pn == 3) {
#pragma unroll
            for (int bj = 0; bj < 2; ++bj)
#pragma unroll
                for (int n = 0; n < 2; ++n)
#pragma unroll
                    for (int e = 0; e < 4; ++e) { float s = 0.f;
#pragma unroll
                        for (int ai = 0; ai < 2; ++ai)
#pragma unroll
                            for (int m = 0; m < 4; ++m) s += acc[ai][bj][m][n][e];
                        s += __shfl_xor(s, 1); s += __shfl_xor(s, 2); s += __shfl_xor(s, 4); s += __shfl_xor(s, 8);
                        if (fr == 0) { const int c = bj * HALF + wc * 32 + 8 * fq + 4 * n + e, head = (pn - 2) * 4 + (c >> 6), d = c & 63;
                            atomicAdd(kbar + ((size_t)u.pm * 8 + head) * 64 + d, s); } }
        }
    }
};
struct EpiBf16 {
    static constexpr bool PERM = true, AFTER_DRAIN = false;
    bf16_t* O0; int ldc0; bf16_t* O1; int ldc1;
    __device__ __forceinline__ void operator()(const f32x4 (&acc)[2][2][4][2], const Unit& u, int wr, int wc, int fr, int fq) const {
        bf16_t* O = u.aux ? O1 : O0; const int ldc = u.aux ? ldc1 : ldc0;
        const int row0 = u.pm * BM + wr * 64 + fr, col0 = u.pn * BM + wc * 32 + 8 * fq;
#pragma unroll
        for (int ai = 0; ai < 2; ++ai)
#pragma unroll
            for (int m = 0; m < 4; ++m) { bf16_t* rowp = O + (size_t)(row0 + ai * HALF + m * 16) * ldc + col0;
#pragma unroll
                for (int bj = 0; bj < 2; ++bj) { const f32x4 v0 = acc[ai][bj][m][0], v1 = acc[ai][bj][m][1];
                    u32x4 w; w.x = cvtpk(v0[0], v0[1]); w.y = cvtpk(v0[2], v0[3]); w.z = cvtpk(v1[0], v1[1]); w.w = cvtpk(v1[2], v1[3]);
                    *(u32x4*)(rowp + bj * HALF) = w; } }
    }
};
template <bool BASE_F32, bool WRITE_F32> struct EpiRes {
    static constexpr bool PERM = true, AFTER_DRAIN = false;
    const void* base; bf16_t* Ob; float* Of; float* ss;
    __device__ __forceinline__ void operator()(const f32x4 (&acc)[2][2][4][2], const Unit& u, int wr, int wc, int fr, int fq) const {
        const int row0 = u.pm * BM + wr * 64 + fr, col0 = u.pn * BM + wc * 32 + 8 * fq;
#pragma unroll
        for (int ai = 0; ai < 2; ++ai)
#pragma unroll
            for (int m = 0; m < 4; ++m) { const int row = row0 + ai * HALF + m * 16; const size_t off = (size_t)row * D + col0; float sq = 0.f;
#pragma unroll
                for (int bj = 0; bj < 2; ++bj) { f32x4 b0, b1;
                    if (BASE_F32) { b0 = *(const f32x4*)((const float*)base + off + bj * HALF); b1 = *(const f32x4*)((const float*)base + off + bj * HALF + 4); }
                    else { const u32x4 w = *(const u32x4*)((const bf16_t*)base + off + bj * HALF);
                        b0 = (f32x4){bflo(w.x), bfhi(w.x), bflo(w.y), bfhi(w.y)}; b1 = (f32x4){bflo(w.z), bfhi(w.z), bflo(w.w), bfhi(w.w)}; }
                    const f32x4 v0 = acc[ai][bj][m][0] + b0, v1 = acc[ai][bj][m][1] + b1;
                    sq += (v0[0] * v0[0] + v0[1] * v0[1]) + (v0[2] * v0[2] + v0[3] * v0[3]) + (v1[0] * v1[0] + v1[1] * v1[1]) + (v1[2] * v1[2] + v1[3] * v1[3]);
                    u32x4 w; w.x = cvtpk(v0[0], v0[1]); w.y = cvtpk(v0[2], v0[3]); w.z = cvtpk(v1[0], v1[1]); w.w = cvtpk(v1[2], v1[3]);
                    *(u32x4*)(Ob + off + bj * HALF) = w;
                    if (WRITE_F32) { *(f32x4*)(Of + off + bj * HALF) = v0; *(f32x4*)(Of + off + bj * HALF + 4) = v1; } }
                sq += __shfl_xor(sq, 16); sq += __shfl_xor(sq, 32);
                if (fq == 0) atomicAdd(ss + row, sq); }
    }
};
struct EpiQ {
    static constexpr bool PERM = true, AFTER_DRAIN = false;
    bf16_t* O; const float* ss;
    __device__ __forceinline__ void operator()(const f32x4 (&acc)[2][2][4][2], const Unit& u, int wr, int wc, int fr, int fq) const {
        const int row0 = u.pm * BM + wr * 64 + fr, col0 = u.pn * BM + wc * 32 + 8 * fq;
#pragma unroll
        for (int ai = 0; ai < 2; ++ai)
#pragma unroll
            for (int m = 0; m < 4; ++m) { const int row = row0 + ai * HALF + m * 16; const float sc = C2X * __builtin_amdgcn_rsqf(ss[row] * (1.0f / D) + EPS);
                bf16_t* rowp = O + (size_t)row * D + col0;
#pragma unroll
                for (int bj = 0; bj < 2; ++bj) { const f32x4 v0 = acc[ai][bj][m][0] * sc, v1 = acc[ai][bj][m][1] * sc;
                    u32x4 w; w.x = cvtpk(v0[0], v0[1]); w.y = cvtpk(v0[2], v0[3]); w.z = cvtpk(v1[0], v1[1]); w.w = cvtpk(v1[2], v1[3]);
                    *(u32x4*)(rowp + bj * HALF) = w; } }
    }
};
struct EpiSoftmax {
    static constexpr bool PERM = true, AFTER_DRAIN = true;
    bf16_t* P;
    __device__ __forceinline__ void fused(f32x4 (&acc)[2][2][4][2], const Unit& u, int wr, int wc, int fr, int fq, LAS unsigned char* lds, int wid, int lane) const {
        LAS float* MX = (LAS float*)lds;
        LAS float* SM = (LAS float*)(lds + 4096);
#pragma unroll
        for (int ai = 0; ai < 2; ++ai)
#pragma unroll
            for (int m = 0; m < 4; ++m) { float mx = -3.0e38f;
#pragma unroll
                for (int bj = 0; bj < 2; ++bj)
#pragma unroll
                    for (int n = 0; n < 2; ++n) { const f32x4 x = acc[ai][bj][m][n]; mx = fmaxf(mx, fmaxf(fmaxf(x[0], x[1]), fmaxf(x[2], x[3]))); }
                mx = fmaxf(mx, __shfl_xor(mx, 16)); mx = fmaxf(mx, __shfl_xor(mx, 32));
                if (fq == 0) MX[(ai * HALF + wr * 64 + m * 16 + fr) * 4 + wc] = mx; }
        LDS_WAIT(); __builtin_amdgcn_s_barrier(); asm volatile("" ::: "memory");
#pragma unroll
        for (int ai = 0; ai < 2; ++ai)
#pragma unroll
            for (int m = 0; m < 4; ++m) { const int r = ai * HALF + wr * 64 + m * 16 + fr; const f32x4 q = *(const LAS f32x4*)(MX + r * 4);
                const float mx = fmaxf(fmaxf(q[0], q[1]), fmaxf(q[2], q[3])); float s = 0.f;
#pragma unroll
                for (int bj = 0; bj < 2; ++bj)
#pragma unroll
                    for (int n = 0; n < 2; ++n) { f32x4 x = acc[ai][bj][m][n];
#pragma unroll
                        for (int e = 0; e < 4; ++e) { x[e] = fast_exp2(x[e] - mx); s += x[e]; }
                        acc[ai][bj][m][n] = x; }
                s += __shfl_xor(s, 16); s += __shfl_xor(s, 32);
                if (fq == 0) SM[r * 4 + wc] = s; }
        LDS_WAIT(); __builtin_amdgcn_s_barrier(); asm volatile("" ::: "memory");
        const int col0 = wc * 32 + 8 * fq;
#pragma unroll
        for (int ai = 0; ai < 2; ++ai)
#pragma unroll
            for (int m = 0; m < 4; ++m) { const int r = ai * HALF + wr * 64 + m * 16 + fr; const f32x4 q = *(const LAS f32x4*)(SM + r * 4);
                const float inv = fast_rcp((q[0] + q[1]) + (q[2] + q[3]));
#pragma unroll
                for (int bj = 0; bj < 2; ++bj) { const f32x4 v0 = acc[ai][bj][m][0] * inv, v1 = acc[ai][bj][m][1] * inv;
                    u32x4 w; w.x = cvtpk(v0[0], v0[1]); w.y = cvtpk(v0[2], v0[3]); w.z = cvtpk(v1[0], v1[1]); w.w = cvtpk(v1[2], v1[3]);
                    *(u32x4*)(P + (size_t)r * 256 + bj * HALF + col0) = w; } }
        LDS_WAIT(); __builtin_amdgcn_s_barrier(); asm volatile("" ::: "memory");
    }
};
struct EpiW1 {
    static constexpr bool PERM = true, AFTER_DRAIN = false;
    bf16_t* O; const float* ss; const float* b1;
    __device__ __forceinline__ void operator()(const f32x4 (&acc)[2][2][4][2], const Unit& u, int wr, int wc, int fr, int fq) const {
        const int c0 = wc * 32 + 8 * fq;
        const float* bp = b1 + (size_t)u.aux * 2048 + 2 * (u.pn * 128 + c0);
        const f32x4 bq0 = *(const f32x4*)(bp), bq1 = *(const f32x4*)(bp + 4), bq2 = *(const f32x4*)(bp + 8), bq3 = *(const f32x4*)(bp + 12);
        const float bg[8] = {bq0[0], bq0[2], bq1[0], bq1[2], bq2[0], bq2[2], bq3[0], bq3[2]};
        const float bl[8] = {bq0[1], bq0[3], bq1[1], bq1[3], bq2[1], bq2[3], bq3[1], bq3[3]};
#pragma unroll
        for (int ai = 0; ai < 2; ++ai)
#pragma unroll
            for (int m = 0; m < 4; ++m) { const int r = ai * HALF + wr * 64 + m * 16 + fr; const int rr = r < u.nrows ? r : u.nrows - 1; const int tok = u.rows[rr];
                const float sc = __builtin_amdgcn_rsqf(ss[tok] * (1.0f / D) + EPS); float a[8];
#pragma unroll
                for (int j = 0; j < 8; ++j) { const float g = acc[ai][0][m][j >> 2][j & 3] * sc + bg[j], l = acc[ai][1][m][j >> 2][j & 3] * sc + bl[j];
                    const float glu = fminf(g, 7.0f), lin = fminf(fmaxf(l, -7.0f), 7.0f);
                    a[j] = glu * fast_rcp(1.0f + fast_exp2(-1.702f * LOG2E * glu)) * (lin + 1.0f); }
                u32x4 w; w.x = cvtpk(a[0], a[1]); w.y = cvtpk(a[2], a[3]); w.z = cvtpk(a[4], a[5]); w.w = cvtpk(a[6], a[7]);
                *(u32x4*)(O + ((size_t)u.pm * BM + r) * D + u.pn * 128 + c0) = w; }
    }
};
struct EpiW2 {
    static constexpr bool PERM = true, AFTER_DRAIN = false;
    bf16_t* O; const float* b2;
    __device__ __forceinline__ void operator()(const f32x4 (&acc)[2][2][4][2], const Unit& u, int wr, int wc, int fr, int fq) const {
        const int row0 = u.pm * BM + wr * 64 + fr, col0 = u.pn * BM + wc * 32 + 8 * fq;
        f32x4 bv[2][2];
#pragma unroll
        for (int bj = 0; bj < 2; ++bj)
#pragma unroll
            for (int n = 0; n < 2; ++n) bv[bj][n] = *(const f32x4*)(b2 + (size_t)u.aux * D + col0 + bj * HALF + 4 * n);
#pragma unroll
        for (int ai = 0; ai < 2; ++ai)
#pragma unroll
            for (int m = 0; m < 4; ++m) { bf16_t* rowp = O + (size_t)(row0 + ai * HALF + m * 16) * D + col0;
#pragma unroll
                for (int bj = 0; bj < 2; ++bj) { const f32x4 v0 = acc[ai][bj][m][0] + bv[bj][0], v1 = acc[ai][bj][m][1] + bv[bj][1];
                    u32x4 w; w.x = cvtpk(v0[0], v0[1]); w.y = cvtpk(v0[2], v0[3]); w.z = cvtpk(v1[0], v1[1]); w.w = cvtpk(v1[2], v1[3]);
                    *(u32x4*)(rowp + bj * HALF) = w; } }
    }
};
}

namespace moba {
using bf16x8 = ::bf16x8; using s16x4 = ::s16x4; using f32x16 = ::f32x16; using u32x4 = ::u32x4;
constexpr int DMQ = INC, DMO = D, HD = 64;
constexpr int NW = 8, QBLK = 32, QB = 256, KVBLK = 64;
__device__ __forceinline__ int crow(int r, int hi) { return (r & 3) + 8 * (r >> 2) + 4 * hi; }
#define SBAR() __builtin_amdgcn_sched_barrier(0)
__device__ __forceinline__ void cmask(f32x16& p0, f32x16& p1, int jb, int qrel, int hi) {
    const float NEG = -INFINITY; int kb = 64 * jb + 4 * hi;
#pragma unroll
    for (int r = 0; r < 16; ++r) { int kv = kb + (r & 3) + 8 * (r >> 2); if (kv > qrel) p0[r] = NEG; if (kv + 32 > qrel) p1[r] = NEG; }
}
constexpr int NSLOT = 3, SLOTB = 8192;
constexpr int LDS_K = 0, LDS_V = NSLOT * SLOTB, LDS_WS = 2 * NSLOT * SLOTB, LDS_OST = LDS_WS + NW * 64 * 4, LDS_KB = LDS_OST + NW * 4096, LDS_BYTES = LDS_KB + 16 * 64 * 4;
__device__ __forceinline__ void glds16(const void* gsrc, unsigned lds_dst) { unsigned keep;
    asm volatile("s_mov_b32 %0, m0\n\ts_mov_b32 m0, %2\n\ts_nop 0\n\tglobal_load_lds_dwordx4 %1, off\n\ts_mov_b32 m0, %0" : "=&s"(keep) : "v"(gsrc), "s"(lds_dst) : "memory"); }
__device__ __forceinline__ float max3f(float a, float b, float c) { float r; asm("v_max3_f32 %0, %1, %2, %3" : "=v"(r) : "v"(a), "v"(b), "v"(c)); return r; }
__device__ __forceinline__ float max2f(float a, float b) { float r; asm("v_max_f32_e32 %0, %1, %2" : "=v"(r) : "v"(a), "v"(b)); return r; }
__device__ __forceinline__ float fadd_s(float a, float b) { float r; asm("v_add_f32_e32 %0, %1, %2" : "=v"(r) : "v"(a), "v"(b)); return r; }
__device__ __forceinline__ float fsub_s(float a, float b) { float r; asm("v_sub_f32_e32 %0, %1, %2" : "=v"(r) : "v"(a), "v"(b)); return r; }
__device__ __forceinline__ unsigned cvtpk_s(float lo, float hi) { return ::cvtpk(lo, hi); }
#define WAIT_BAR(N) asm volatile("s_waitcnt vmcnt(" #N ") lgkmcnt(0)\n\ts_barrier" ::: "memory")
__device__ __forceinline__ void qkt(f32x16& p0, f32x16& p1, const char* Kslot, const bf16x8* qr, const f32x16& negm, int r32, int hi) {
    const char* kb = Kslot + hi * 1024 + r32 * 16;
#pragma unroll
    for (int d0 = 0; d0 < 4; ++d0) {
        const bf16x8 b0 = *reinterpret_cast<const bf16x8*>(kb + d0 * 2048);
        const bf16x8 b1 = *reinterpret_cast<const bf16x8*>(kb + d0 * 2048 + 512);
        if (d0 == 0) { p0 = __builtin_amdgcn_mfma_f32_32x32x16_bf16(b0, qr[0], negm, 0, 0, 0); p1 = __builtin_amdgcn_mfma_f32_32x32x16_bf16(b1, qr[0], negm, 0, 0, 0); }
        else { p0 = __builtin_amdgcn_mfma_f32_32x32x16_bf16(b0, qr[d0], p0, 0, 0, 0); p1 = __builtin_amdgcn_mfma_f32_32x32x16_bf16(b1, qr[d0], p1, 0, 0, 0); } }
}
typedef __attribute__((address_space(3))) const char* lds_cptr;
typedef short v4i16_t __attribute__((ext_vector_type(4)));
__device__ __forceinline__ void kload8(bf16x8* kf, lds_cptr kp) {
    kf[0] = *(const __attribute__((address_space(3))) bf16x8*)(kp);        kf[1] = *(const __attribute__((address_space(3))) bf16x8*)(kp + 512);
    kf[2] = *(const __attribute__((address_space(3))) bf16x8*)(kp + 2048); kf[3] = *(const __attribute__((address_space(3))) bf16x8*)(kp + 2560);
    kf[4] = *(const __attribute__((address_space(3))) bf16x8*)(kp + 4096); kf[5] = *(const __attribute__((address_space(3))) bf16x8*)(kp + 4608);
    kf[6] = *(const __attribute__((address_space(3))) bf16x8*)(kp + 6144); kf[7] = *(const __attribute__((address_space(3))) bf16x8*)(kp + 6656);
}
__device__ __forceinline__ void kload2(bf16x8* kf, lds_cptr kp, int j) { kf[2 * j] = *(const __attribute__((address_space(3))) bf16x8*)(kp + j * 2048); kf[2 * j + 1] = *(const __attribute__((address_space(3))) bf16x8*)(kp + j * 2048 + 512); }
__device__ __forceinline__ s16x4 vtr(lds_cptr p) { return __builtin_bit_cast(s16x4, __builtin_amdgcn_ds_read_tr16_b64_v4i16((__attribute__((address_space(3))) v4i16_t*)p)); }
__device__ __forceinline__ float rowmax(const f32x16& p0, const f32x16& p1) {
    float a = max3f(p0[0], p0[1], p1[0]), b = max3f(p0[2], p0[3], p1[1]); a = max3f(a, p1[2], p1[3]);
#pragma unroll
    for (int r = 4; r < 16; r += 4) { a = max3f(a, p0[r], p0[r + 1]); b = max3f(b, p0[r + 2], p0[r + 3]); a = max3f(a, p1[r], p1[r + 1]); b = max3f(b, p1[r + 2], p1[r + 3]); }
    const float m = max2f(a, b);
    auto rr = __builtin_amdgcn_permlane32_swap(__float_as_uint(m), __float_as_uint(m), false, false);
    return max2f(__uint_as_float(rr[0]), __uint_as_float(rr[1]));
}
__device__ __forceinline__ void pv(f32x16* o, int vb, bf16x8 pa0, bf16x8 pa1, bf16x8 pa2, bf16x8 pa3) {
#pragma unroll
    for (int d0 = 0; d0 < 2; ++d0) { s16x4 lo[4], hi[4];
#pragma unroll
        for (int ks = 0; ks < 4; ++ks) {
            asm volatile("ds_read_b64_tr_b16 %0,%1 offset:%c2" : "=&v"(lo[ks]) : "v"(vb), "i"(d0 * 4096 + ks * 1024) : "memory");
            asm volatile("ds_read_b64_tr_b16 %0,%1 offset:%c2" : "=&v"(hi[ks]) : "v"(vb), "i"(d0 * 4096 + ks * 1024 + 512) : "memory"); }
        asm volatile("s_waitcnt lgkmcnt(0)" ::: "memory"); SBAR();
#define PK(k) (bf16x8){lo[k][0], lo[k][1], lo[k][2], lo[k][3], hi[k][0], hi[k][1], hi[k][2], hi[k][3]}
        o[d0] = __builtin_amdgcn_mfma_f32_32x32x16_bf16(pa0, PK(0), o[d0], 0, 0, 0);
        o[d0] = __builtin_amdgcn_mfma_f32_32x32x16_bf16(pa1, PK(1), o[d0], 0, 0, 0);
        o[d0] = __builtin_amdgcn_mfma_f32_32x32x16_bf16(pa2, PK(2), o[d0], 0, 0, 0);
        o[d0] = __builtin_amdgcn_mfma_f32_32x32x16_bf16(pa3, PK(3), o[d0], 0, 0, 0);
#undef PK
    }
}
constexpr float NEGBIG = -1.0e30f;

template <int THRL> __device__ __forceinline__ void attn_unit(int b, int h, int qb, const bf16_t* Qg, const bf16_t* __restrict__ Kg, const bf16_t* __restrict__ Vg, bf16_t* Og, const float* __restrict__ kbar, char* shm) {
    int tid_ = threadIdx.x; asm volatile("" : "+v"(tid_));
    const int tid = tid_, lane = tid & 63, r32 = lane & 31, hi = lane >> 5; const int wid = __builtin_amdgcn_readfirstlane(tid >> 6);
    const long rowbase = (long)b * SEQ; const int q0 = qb * QB;
    const bf16_t* Qw = Qg + (rowbase + q0 + wid * QBLK) * DMQ + h * HD;
    const bf16_t* Kh = Kg + rowbase * DMQ + h * HD, *Vh = Vg + rowbase * DMQ + h * HD;
    const unsigned lds0 = (unsigned)(uintptr_t)shm;
    float* wsf = (float*)(shm + LDS_WS) + wid * 64;
    const bf16_t* ksrc = Kh + (long)lane * DMQ + wid * 8;
    const bf16_t* vsrc = Vh + (long)(16 * (wid & 3) + (lane >> 2)) * DMQ + (wid >> 2) * 32 + (lane & 3) * 8;
    const unsigned kdst = lds0 + LDS_K + wid * 1024, vdst = lds0 + LDS_V + wid * 1024;
    const int NT = 4 * qb + 4, NPAST = 4 * qb;
#define TMAP(t) (((t) < 4) ? (NPAST + (t)) : ((t) - 4))
#define DMA_K(t, slot) glds16(ksrc + (long)TMAP(t) * KVBLK * DMQ, (unsigned)__builtin_amdgcn_readfirstlane(kdst + (slot)))
#define DMA_V(t, slot) glds16(vsrc + (long)TMAP(t) * KVBLK * DMQ, (unsigned)__builtin_amdgcn_readfirstlane(vdst + (slot)))
    const char* Kbase = shm + LDS_K; bf16x8 kf[8];
    const lds_cptr shm3 = (lds_cptr)shm; const lds_cptr kp0 = shm3 + LDS_K + hi * 1024 + r32 * 16; const lds_cptr vp0 = shm3 + LDS_V + ((lane >> 4) & 1) * 32 + (lane & 3) * 8 + (4 * hi + ((lane & 15) >> 2)) * 64;
    DMA_K(0, 0); DMA_V(0, 0); DMA_K(1, SLOTB);
    bf16x8 qr[4];
#pragma unroll
    for (int d0 = 0; d0 < 4; ++d0) qr[d0] = *reinterpret_cast<const bf16x8*>(&Qw[(long)r32 * DMQ + d0 * 16 + hi * 8]);
    unsigned selm = 0u;
    if (qb > 0) {
        float* kbl = (float*)(shm + LDS_KB);
        for (int i = tid; i < qb * 64; i += NW * 64) kbl[i] = kbar[((size_t)(b * 16 + (i >> 6)) * 8 + h) * 64 + (i & 63)];
        asm volatile("s_waitcnt vmcnt(0) lgkmcnt(0)\n\ts_barrier" ::: "memory");
        if (qb <= 3) selm = (1u << qb) - 1u;
        else {
            float qf[32];
#pragma unroll
            for (int d0 = 0; d0 < 4; ++d0)
#pragma unroll
                for (int j = 0; j < 8; ++j) qf[d0 * 8 + j] = bf2f((unsigned short)qr[d0][j]);
            float g[15];
#pragma unroll
            for (int n = 0; n < 15; ++n) { float s = 0.f;
                if (n < qb) {
#pragma unroll
                    for (int d0 = 0; d0 < 4; ++d0) { const f32x4 k0 = *(const f32x4*)(kbl + n * 64 + d0 * 16 + hi * 8), k1 = *(const f32x4*)(kbl + n * 64 + d0 * 16 + hi * 8 + 4);
                        s += qf[d0 * 8 + 0] * k0[0] + qf[d0 * 8 + 1] * k0[1] + qf[d0 * 8 + 2] * k0[2] + qf[d0 * 8 + 3] * k0[3] + qf[d0 * 8 + 4] * k1[0] + qf[d0 * 8 + 5] * k1[1] + qf[d0 * 8 + 6] * k1[2] + qf[d0 * 8 + 7] * k1[3]; }
                    s += __shfl_xor(s, 32);
                } else s = -INFINITY;
                g[n] = s; }
#pragma unroll
            for (int pass = 0; pass < 3; ++pass) { float best = -INFINITY; int bi = 0;
#pragma unroll
                for (int n = 0; n < 15; ++n) if (g[n] > best) { best = g[n]; bi = n; }
                selm |= 1u << bi;
#pragma unroll
                for (int n = 0; n < 15; ++n) if (n == bi) g[n] = -INFINITY; }
        }
    }
    float mhat = 0.f, l_reg = 0.f; f32x16 o[2]; o[0] = f32x16{}; o[1] = f32x16{}; f32x16 cini = f32x16{}; asm volatile("" : "+v"(cini));
    const int qrel = wid * QBLK + r32;
#define SETC(t, JB) do { const float cm_ = ((JB >= 0) || ((selm >> (((t) - 4) >> 2)) & 1u)) ? -mhat : NEGBIG; \
      _Pragma("unroll") for (int r = 0; r < 16; ++r) cini[r] = cm_; asm volatile("" : "+v"(cini)); } while (0)
    bool resc = false;
#define START(P0, P1) do { const float rm = rowmax(P0, P1); resc = false; \
    { const float dl = rm; mhat = fadd_s(mhat, dl); \
      _Pragma("unroll") for (int r = 0; r < 16; ++r) { P0[r] = fsub_s(P0[r], dl); P1[r] = fsub_s(P1[r], dl); } } \
    _Pragma("unroll") for (int r = 0; r < 16; ++r) P0[r] = __builtin_amdgcn_exp2f(P0[r]); } while (0)
#define RESC() do { if (resc) { asm volatile("s_waitcnt lgkmcnt(0)" ::: "memory"); \
      _Pragma("unroll") for (int d_ = 0; d_ < 2; ++d_) _Pragma("unroll") for (int r = 0; r < 16; ++r) o[d_][r] *= wsf[crow(r, hi)]; } } while (0)
    f32x16 pA0, pA1, pB0, pB1;
    int sl_prev = 0, sl_cur = 0, sl_next = SLOTB;
#define ROT() do { sl_prev = sl_cur; sl_cur = sl_next; sl_next = (sl_next == (NSLOT - 1) * SLOTB) ? 0 : sl_next + SLOTB; } while (0)
    DMA_K(2, 2 * SLOTB);
    if (qb > 0) { WAIT_BAR(0); } else { WAIT_BAR(3); }
    qkt(pA0, pA1, Kbase, qr, cini, r32, hi); asm volatile("s_nop 15\n\ts_nop 7" : "+v"(pA0), "+v"(pA1)); cmask(pA0, pA1, 0, qrel, hi);
    START(pA0, pA1);
    _Pragma("unroll") for (int r = 0; r < 16; ++r) pA1[r] = __builtin_amdgcn_exp2f(pA1[r]);
    WAIT_BAR(0);
    DMA_K(3, 0); DMA_V(1, SLOTB);
    ROT();
    kload8(kf, kp0 + sl_cur);
    WAIT_BAR(2);
    s16x4 vlo[8], vhi[8]; u32x4 pw0, pw1, pw2, pw3;
#define PKW(P, B) cvtpk_s(P[B], P[B + 1])
#define PAF(k) __builtin_bit_cast(bf16x8, pw##k)
#define VFR(i) (bf16x8){vlo[i][0], vlo[i][1], vlo[i][2], vlo[i][3], vhi[i][0], vhi[i][1], vhi[i][2], vhi[i][3]}
#define PIN(x) asm volatile("" : "+v"(x))
#define MX3(a, b, c) __builtin_fmaxf(__builtin_fmaxf((a), (b)), (c))
#define GAPA(MF, A0, A1, A2, A3, W0, W1, PW) do { MF; sacc += A0; sacc += A1; sacc += A2; sacc += A3; PIN(sacc); W0; W1; PIN(PW); SBAR(); } while (0)
#define EX(v) __builtin_amdgcn_exp2f(v)
#define GAPB(MF, X, B) do { MF; X[B] = EX(X[B]); X[B + 1] = EX(X[B + 1]); X[B + 2] = EX(X[B + 2]); X[B + 3] = EX(X[B + 3]); PIN(X); SBAR(); } while (0)
#define VRD(i) do { vlo[i] = vtr(vp_ + (((i) >> 2) * 4096 + ((i) & 3) * 1024)); vhi[i] = vtr(vp_ + (((i) >> 2) * 4096 + ((i) & 3) * 1024 + 512)); } while (0)
#define KRD(G, j) do { if (G) { kload2(kf, kp0 + sl_next, j); SBAR(); } } while (0)
#define STEP(C0, C1, P0, P1, t, GK, GV, GL, JB) do { SETC(t, JB); SBAR(); \
    const lds_cptr vp_ = vp0 + sl_prev; \
    VRD(0); SBAR(); float sacc = (P0[0] + P0[1]); \
    GAPA(C0 = __builtin_amdgcn_mfma_f32_32x32x16_bf16(kf[0], qr[0], cini, 0, 0, 0), P0[2], P0[3], P0[4], P0[5],     pw0[0] = PKW(P0, 0), pw0[1] = PKW(P0, 2), pw0); \
    VRD(4); SBAR(); GAPA(C1 = __builtin_amdgcn_mfma_f32_32x32x16_bf16(kf[1], qr[0], cini, 0, 0, 0), P0[6], P0[7], P0[8], P0[9],     pw0[2] = PKW(P0, 4), pw0[3] = PKW(P0, 6), pw0); \
    VRD(1); SBAR(); GAPA(C0 = __builtin_amdgcn_mfma_f32_32x32x16_bf16(kf[2], qr[1], C0, 0, 0, 0),   P0[10], P0[11], P0[12], P0[13], pw1[0] = PKW(P0, 8), pw1[1] = PKW(P0, 10), pw1); \
    VRD(5); SBAR(); GAPA(C1 = __builtin_amdgcn_mfma_f32_32x32x16_bf16(kf[3], qr[1], C1, 0, 0, 0),   P0[14], P0[15], P1[0], P1[1],   pw1[2] = PKW(P0, 12), pw1[3] = PKW(P0, 14), pw1); \
    VRD(2); SBAR(); GAPA(C0 = __builtin_amdgcn_mfma_f32_32x32x16_bf16(kf[4], qr[2], C0, 0, 0, 0),   P1[2], P1[3], P1[4], P1[5],     pw2[0] = PKW(P1, 0), pw2[1] = PKW(P1, 2), pw2); \
    VRD(6); SBAR(); GAPA(C1 = __builtin_amdgcn_mfma_f32_32x32x16_bf16(kf[5], qr[2], C1, 0, 0, 0),   P1[6], P1[7], P1[8], P1[9],     pw2[2] = PKW(P1, 4), pw2[3] = PKW(P1, 6), pw2); \
    VRD(3); SBAR(); GAPA(C0 = __builtin_amdgcn_mfma_f32_32x32x16_bf16(kf[6], qr[3], C0, 0, 0, 0),   P1[10], P1[11], P1[12], P1[13], pw3[0] = PKW(P1, 8), pw3[1] = PKW(P1, 10), pw3); \
    VRD(7); SBAR(); GAPA(C1 = __builtin_amdgcn_mfma_f32_32x32x16_bf16(kf[7], qr[3], C1, 0, 0, 0),   P1[14], P1[15], 0.f, 0.f,       pw3[2] = PKW(P1, 12), pw3[3] = PKW(P1, 14), pw3); \
    l_reg += sacc; \
    if (GK) { DMA_K((t) + 3, sl_cur); } if (GV) { DMA_V((t) + 1, sl_next); } \
    if (JB >= 0) cmask(C0, C1, JB, qrel, hi); \
    { float a = MX3(C0[0], C0[1], C1[0]), b_ = MX3(C0[2], C0[3], C1[1]); a = MX3(a, C1[2], C1[3]); \
      _Pragma("unroll") for (int r = 4; r < 16; r += 4) { a = MX3(a, C0[r], C0[r + 1]); b_ = MX3(b_, C0[r + 2], C0[r + 3]); a = MX3(a, C1[r], C1[r + 1]); b_ = MX3(b_, C1[r + 2], C1[r + 3]); } \
      float rm = __builtin_fmaxf(a, b_); { auto rr = __builtin_amdgcn_permlane32_swap(__float_as_uint(rm), __float_as_uint(rm), false, false); rm = __builtin_fmaxf(__uint_as_float(rr[0]), __uint_as_float(rr[1])); } \
      resc = false; \
      if (__builtin_expect(__any(rm > (float)THRL), 0)) { const float dl = __builtin_fmaxf(rm, 0.f); mhat += dl; \
        _Pragma("unroll") for (int r = 0; r < 16; ++r) { C0[r] -= dl; C1[r] -= dl; } \
        const float f = __builtin_amdgcn_exp2f(-dl); l_reg *= f; if (hi == 0) wsf[r32] = f; resc = true; } } \
    SBAR(); \
    GAPB(o[0] = __builtin_amdgcn_mfma_f32_32x32x16_bf16(PAF(0), VFR(0), o[0], 0, 0, 0), C0, 0); \
    GAPB(o[1] = __builtin_amdgcn_mfma_f32_32x32x16_bf16(PAF(0), VFR(4), o[1], 0, 0, 0), C0, 4); \
    KRD(GL, 0); GAPB(o[0] = __builtin_amdgcn_mfma_f32_32x32x16_bf16(PAF(1), VFR(1), o[0], 0, 0, 0), C0, 8); \
    KRD(GL, 1); GAPB(o[1] = __builtin_amdgcn_mfma_f32_32x32x16_bf16(PAF(1), VFR(5), o[1], 0, 0, 0), C0, 12); \
    KRD(GL, 2); GAPB(o[0] = __builtin_amdgcn_mfma_f32_32x32x16_bf16(PAF(2), VFR(2), o[0], 0, 0, 0), C1, 0); \
    KRD(GL, 3); GAPB(o[1] = __builtin_amdgcn_mfma_f32_32x32x16_bf16(PAF(2), VFR(6), o[1], 0, 0, 0), C1, 4); \
    GAPB(o[0] = __builtin_amdgcn_mfma_f32_32x32x16_bf16(PAF(3), VFR(3), o[0], 0, 0, 0), C1, 8); \
    GAPB(o[1] = __builtin_amdgcn_mfma_f32_32x32x16_bf16(PAF(3), VFR(7), o[1], 0, 0, 0), C1, 12); \
    } while (0)
#define ENDW(tt) do { if ((tt) + 3 < NT) { WAIT_BAR(2); } else if ((tt) + 2 < NT) { WAIT_BAR(1); } else { WAIT_BAR(0); } } while (0)
    STEP(pB0, pB1, pA0, pA1, 1, (4 < NT), true, true, 1);   ENDW(1); RESC(); ROT();
    STEP(pA0, pA1, pB0, pB1, 2, (5 < NT), true, true, 2);   ENDW(2); RESC(); ROT();
    STEP(pB0, pB1, pA0, pA1, 3, (6 < NT), (4 < NT), (4 < NT), 3);   ENDW(3); RESC(); ROT();
    for (int t = 4; t < NT; t += 2) {
        STEP(pA0, pA1, pB0, pB1, t, (t + 3 < NT), true, true, -1);                       ENDW(t);     RESC(); ROT();
        STEP(pB0, pB1, pA0, pA1, t + 1, (t + 4 < NT), (t + 2 < NT), (t + 2 < NT), -1);   ENDW(t + 1); RESC(); ROT();
    }
    { float sacc = pB0[0] + pB0[1]; _Pragma("unroll") for (int r = 2; r < 16; ++r) sacc += pB0[r]; _Pragma("unroll") for (int r = 0; r < 16; ++r) sacc += pB1[r]; l_reg += sacc;
      pw0 = (u32x4){PKW(pB0, 0), PKW(pB0, 2), PKW(pB0, 4), PKW(pB0, 6)}; pw1 = (u32x4){PKW(pB0, 8), PKW(pB0, 10), PKW(pB0, 12), PKW(pB0, 14)}; pw2 = (u32x4){PKW(pB1, 0), PKW(pB1, 2), PKW(pB1, 4), PKW(pB1, 6)}; pw3 = (u32x4){PKW(pB1, 8), PKW(pB1, 10), PKW(pB1, 12), PKW(pB1, 14)};
      SBAR(); pv(o, (int)(unsigned long)vp0 + sl_prev, PAF(0), PAF(1), PAF(2), PAF(3)); }
#undef PKW
#undef PAF
#undef VFR
#undef PIN
#undef MX3
#undef GAPA
#undef GAPB
#undef EX
#undef VRD
#undef KRD
#undef STEP
#undef ENDW
    { auto rr = __builtin_amdgcn_permlane32_swap(__float_as_uint(l_reg), __float_as_uint(l_reg), false, false); l_reg = __uint_as_float(rr[0]) + __uint_as_float(rr[1]); }
    if (hi == 0) wsf[32 + r32] = l_reg; asm volatile("s_waitcnt lgkmcnt(0)" ::: "memory");
    float rli[16];
#pragma unroll
    for (int r = 0; r < 16; ++r) rli[r] = __builtin_amdgcn_rcpf(wsf[32 + crow(r, hi)]);
    bf16_t* Ow = Og + (rowbase + q0 + wid * QBLK) * DMO + h * HD;
    { bf16_t* stg = (bf16_t*)(shm + LDS_OST) + wid * 2048;
#pragma unroll
      for (int r = 0; r < 16; ++r) { const int orow = crow(r, hi);
#pragma unroll
        for (int d0 = 0; d0 < 2; ++d0) stg[orow * 64 + d0 * 32 + r32] = (bf16_t)f2bf(o[d0][r] * rli[r]); }
      asm volatile("s_waitcnt lgkmcnt(0)" ::: "memory");
#pragma unroll
      for (int i = 0; i < 4; ++i) { const int row = i * 8 + (lane >> 3), ch = lane & 7; const u32x4 v = *(const u32x4*)(stg + row * 64 + ch * 8); *(u32x4*)(Ow + (long)row * DMO + ch * 8) = v; } }
    asm volatile("s_waitcnt lgkmcnt(0)\n\ts_barrier" ::: "memory");
#undef DMA_K
#undef DMA_V
#undef TMAP
#undef SETC
#undef START
#undef RESC
#undef ROT
}
#undef SBAR
#undef WAIT_BAR
}

namespace hgrn {
constexpr int RS = 144;
constexpr int L_Q = 0, L_K = 9216, L_KT = 18432, L_VT = 27648, L_ST = 36864, L_SEG = 46080, L_DEND = 48128, L_SSQ = 48384, L_BYTES = 48896;
__device__ __forceinline__ int crow(int r, int hi) { return (r & 3) + 8 * (r >> 2) + 4 * hi; }
#define HG_BAR() do { asm volatile("s_waitcnt lgkmcnt(0)" ::: "memory"); __builtin_amdgcn_s_barrier(); asm volatile("" ::: "memory"); } while (0)
__device__ __forceinline__ void hgrn_unit(int b, int h, const bf16_t* __restrict__ proj, bf16_t* __restrict__ mix, const float* __restrict__ lb_logits, const float* __restrict__ norm_g, LAS unsigned char* lds) {
    int tid_ = threadIdx.x; asm volatile("" : "+v"(tid_));
    const int tid = tid_, lane = tid & 63, r32 = lane & 31, hi = lane >> 5; const int w = __builtin_amdgcn_readfirstlane(tid >> 6);
    const float lbk = fast_rcp(1.0f + fast_exp2((lb_logits[512 + h * 64 + lane] - lb_logits[h * 64 + lane]) * LOG2E));
    const int vr = (w >> 1) & 1, tc = w & 1;
    float ng[16];
#pragma unroll
    for (int r = 0; r < 16; ++r) ng[r] = norm_g[h * 64 + 32 * vr + crow(r, hi)];
    f32x16 S = f32x16{};
    for (int i = tid; i < 64 * RS / 4; i += 512) ((LAS unsigned*)(lds + L_ST))[i] = 0u;
    const size_t row00 = (size_t)b * SEQ;
    unsigned short fr[8], qv[8], vv[8];
    { const bf16_t* p = proj + (row00 + 8 * w) * INC + h * 64 + lane;
#pragma unroll
      for (int i = 0; i < 8; ++i) { fr[i] = p[(size_t)i * INC + C_GF]; qv[i] = p[(size_t)i * INC + C_GQ]; vv[i] = p[(size_t)i * INC + C_GI]; } }
    for (int c = 0; c < 64; ++c) {
        const size_t row0 = row00 + (size_t)c * 64;
        u32x2 gg[4];
        if (w < 4) { const bf16_t* gp = proj + (row0 + 32 * tc + r32) * INC + C_GG + h * 64 + 32 * vr + 4 * hi;
#pragma unroll
            for (int g = 0; g < 4; ++g) gg[g] = *(const u32x2*)(gp + 8 * g); }
        float p[8], kk[8];
        { float run = 0.f;
#pragma unroll
          for (int i = 0; i < 8; ++i) { const float x = bf2f(fr[i]); const float sg = fast_rcp(1.0f + fast_exp2(-x * LOG2E)); const float f = lbk + (1.0f - lbk) * sg;
              run += __builtin_amdgcn_logf(f); p[i] = run; kk[i] = 1.0f - f; } }
        ((LAS float*)(lds + L_SEG))[w * 64 + lane] = p[7];
        HG_BAR();
        { float off = 0.f;
#pragma unroll
          for (int j = 0; j < 7; ++j) { const float sv = ((LAS float*)(lds + L_SEG))[j * 64 + lane]; off += (j < w) ? sv : 0.f; }
          unsigned qk[4], kq[4];
#pragma unroll
          for (int i = 0; i < 8; i += 2) { const float b0 = off + p[i], b1 = off + p[i + 1];
              const float q0 = bf2f(qv[i]) * fast_exp2(b0), q1 = bf2f(qv[i + 1]) * fast_exp2(b1), k0 = kk[i] * fast_exp2(-b0), k1 = kk[i + 1] * fast_exp2(-b1);
              const unsigned qq = cvtpk(q0, q1), kw = cvtpk(k0, k1); qk[i >> 1] = qq; kq[i >> 1] = kw;
              *(LAS unsigned short*)(lds + L_Q + (8 * w + i) * RS + lane * 2) = (unsigned short)(qq & 0xffffu);
              *(LAS unsigned short*)(lds + L_Q + (8 * w + i + 1) * RS + lane * 2) = (unsigned short)(qq >> 16);
              *(LAS unsigned short*)(lds + L_K + (8 * w + i) * RS + lane * 2) = (unsigned short)(kw & 0xffffu);
              *(LAS unsigned short*)(lds + L_K + (8 * w + i + 1) * RS + lane * 2) = (unsigned short)(kw >> 16); }
          *(LAS u32x4*)(lds + L_KT + lane * RS + 16 * w) = (u32x4){kq[0], kq[1], kq[2], kq[3]};
          *(LAS u32x4*)(lds + L_VT + lane * RS + 16 * w) = (u32x4){(unsigned)vv[0] | ((unsigned)vv[1] << 16), (unsigned)vv[2] | ((unsigned)vv[3] << 16), (unsigned)vv[4] | ((unsigned)vv[5] << 16), (unsigned)vv[6] | ((unsigned)vv[7] << 16)};
          if (w == 7) ((LAS float*)(lds + L_DEND))[lane] = fast_exp2(off + p[7]); }
        if (c + 1 < 64) { const bf16_t* pp = proj + (row0 + 64 + 8 * w) * INC + h * 64 + lane;
#pragma unroll
            for (int i = 0; i < 8; ++i) { fr[i] = pp[(size_t)i * INC + C_GF]; qv[i] = pp[(size_t)i * INC + C_GQ]; vv[i] = pp[(size_t)i * INC + C_GI]; } }
        HG_BAR();
        f32x16 OT = f32x16{};
        if (w < 4) {
            bf16x8 bq[4];
#pragma unroll
            for (int ks = 0; ks < 4; ++ks) bq[ks] = *(const LAS bf16x8*)(lds + L_Q + (32 * tc + r32) * RS + (16 * ks + 8 * hi) * 2);
#pragma unroll
            for (int sr = 0; sr < 2; ++sr) if (sr <= tc) {
                f32x16 at = f32x16{};
#pragma unroll
                for (int ks = 0; ks < 4; ++ks) { const bf16x8 a = *(const LAS bf16x8*)(lds + L_K + (32 * sr + r32) * RS + (16 * ks + 8 * hi) * 2); at = __builtin_amdgcn_mfma_f32_32x32x16_bf16(a, bq[ks], at, 0, 0, 0); }
                if (sr == tc) {
#pragma unroll
                    for (int r = 0; r < 16; ++r) at[r] = (crow(r, hi) <= r32) ? at[r] : 0.f; }
#pragma unroll
                for (int st = 0; st < 2; ++st) {
                    u32x4 bw; bw.x = cvtpk(at[8 * st + 0], at[8 * st + 1]); bw.y = cvtpk(at[8 * st + 2], at[8 * st + 3]); bw.z = cvtpk(at[8 * st + 4], at[8 * st + 5]); bw.w = cvtpk(at[8 * st + 6], at[8 * st + 7]);
                    const u32x2 lo = *(const LAS u32x2*)(lds + L_VT + (32 * vr + r32) * RS + (32 * sr + 16 * st + 4 * hi) * 2);
                    const u32x2 hh = *(const LAS u32x2*)(lds + L_VT + (32 * vr + r32) * RS + (32 * sr + 16 * st + 8 + 4 * hi) * 2);
                    const u32x4 aw = (u32x4){lo.x, lo.y, hh.x, hh.y};
                    OT = __builtin_amdgcn_mfma_f32_32x32x16_bf16(__builtin_bit_cast(bf16x8, aw), __builtin_bit_cast(bf16x8, bw), OT, 0, 0, 0); }
            }
#pragma unroll
            for (int ks = 0; ks < 4; ++ks) { const bf16x8 a = *(const LAS bf16x8*)(lds + L_ST + (32 * vr + r32) * RS + (16 * ks + 8 * hi) * 2); OT = __builtin_amdgcn_mfma_f32_32x32x16_bf16(a, bq[ks], OT, 0, 0, 0); }
            float sq = 0.f;
#pragma unroll
            for (int r = 0; r < 16; ++r) sq += OT[r] * OT[r];
            sq += __shfl_xor(sq, 32);
            if (hi == 0) ((LAS float*)(lds + L_SSQ))[vr * 64 + 32 * tc + r32] = sq;
        } else {
#pragma unroll
            for (int st = 0; st < 4; ++st) { const bf16x8 a = *(const LAS bf16x8*)(lds + L_KT + (32 * vr + r32) * RS + (16 * st + 8 * hi) * 2);
                const bf16x8 bv = *(const LAS bf16x8*)(lds + L_VT + (32 * tc + r32) * RS + (16 * st + 8 * hi) * 2);
                S = __builtin_amdgcn_mfma_f32_32x32x16_bf16(a, bv, S, 0, 0, 0); }
#pragma unroll
            for (int r = 0; r < 16; ++r) S[r] *= ((LAS float*)(lds + L_DEND))[32 * vr + crow(r, hi)];
        }
        HG_BAR();
        if (w < 4) {
            const int t = 32 * tc + r32;
            const float tot = ((LAS float*)(lds + L_SSQ))[t] + ((LAS float*)(lds + L_SSQ))[64 + t];
            const float rstd = __builtin_amdgcn_rsqf(tot * (1.0f / 64.0f) + EPS);
            bf16_t* op = mix + (row0 + t) * D + 512 + h * 64 + 32 * vr + 4 * hi;
#pragma unroll
            for (int g = 0; g < 4; ++g) { const float y0 = OT[4 * g + 0] * rstd * ng[4 * g + 0] * bflo(gg[g].x), y1 = OT[4 * g + 1] * rstd * ng[4 * g + 1] * bfhi(gg[g].x),
                                                      y2 = OT[4 * g + 2] * rstd * ng[4 * g + 2] * bflo(gg[g].y), y3 = OT[4 * g + 3] * rstd * ng[4 * g + 3] * bfhi(gg[g].y);
                *(u32x2*)(op + 8 * g) = (u32x2){cvtpk(y0, y1), cvtpk(y2, y3)}; }
        } else {
#pragma unroll
            for (int g = 0; g < 4; ++g) *(LAS u32x2*)(lds + L_ST + (32 * tc + r32) * RS + (32 * vr + 8 * g + 4 * hi) * 2) = (u32x2){cvtpk(S[4 * g + 0], S[4 * g + 1]), cvtpk(S[4 * g + 2], S[4 * g + 3])};
        }
    }
    HG_BAR();
}
#undef HG_BAR
}

constexpr int NWAVES = 8;
constexpr int LDS_BYTES = 147456;
constexpr int TAIL = 131072;
constexpr int TL_TE = TAIL, TL_TS = TAIL + 576, TL_HIST = TAIL + 768, TL_BASE = TAIL + 896, TL_MISC = TAIL + 1024;
typedef GAS unsigned gu32;

struct Args { const float* in[20]; float* out; unsigned char* ws; int ph_lo, ph_hi; };

struct Frame {
    LAS unsigned char* lds; volatile LAS unsigned* MISC; unsigned* ctl;
    int tid, lane, wave, G, vcu;
};

template <int MODE> __device__ __forceinline__ void p0_transpose_item(const float* __restrict__ W, int K, int N, bf16_t* __restrict__ WT, const float* __restrict__ gain, LAS float* scr, int item, int lane) {
    const int nblk = N / 32, kb = item / nblk, nb = item % nblk, k0 = 64 * kb, n0 = 32 * nb;
#pragma unroll 8
    for (int i = 0; i < 32; ++i) { const int kk = 2 * i + (lane >> 5); float v = W[(size_t)(k0 + kk) * N + n0 + (lane & 31)]; if (gain) v *= gain[k0 + kk]; scr[kk * 33 + (lane & 31)] = v; }
    LDS_WAIT(); asm volatile("" ::: "memory");
    const int c = lane & 7;
#pragma unroll
    for (int j = 0; j < 4; ++j) { const int n = (lane >> 3) + 8 * j; const LAS float* s = scr + (8 * c) * 33 + n;
        u32x4 o; o.x = pk2(s[0 * 33], s[1 * 33]); o.y = pk2(s[2 * 33], s[3 * 33]); o.z = pk2(s[4 * 33], s[5 * 33]); o.w = pk2(s[6 * 33], s[7 * 33]);
        int row = n0 + n; if (MODE == 1) { const int jj = row >> 1, bj = row & 1; row = (jj >> 7) * 256 + bj * 128 + (jj & 127); }
        *(u32x4*)(WT + (size_t)row * K + k0 + 8 * c) = o; }
    LDS_WAIT(); asm volatile("" ::: "memory");
}
__device__ __forceinline__ void rms_row_to_bf16(const float* __restrict__ xrow, const float* __restrict__ g, bf16_t* __restrict__ orow, int lane) {
    const f32x4* xr = (const f32x4*)xrow + lane; const f32x4* gr = (const f32x4*)g + lane;
    f32x4 v[4]; float s = 0.f;
#pragma unroll
    for (int j = 0; j < 4; ++j) { v[j] = xr[64 * j]; s += (v[j].x * v[j].x + v[j].y * v[j].y) + (v[j].z * v[j].z + v[j].w * v[j].w); }
    const float rstd = 1.0f / sqrtf(wave_sum(s) * (1.0f / D) + EPS);
    unsigned long long* o8 = (unsigned long long*)orow + lane;
#pragma unroll
    for (int j = 0; j < 4; ++j) { const f32x4 gg = gr[64 * j];
        o8[64 * j] = (unsigned long long)pk2(v[j].x * rstd * gg.x, v[j].y * rstd * gg.y) | ((unsigned long long)pk2(v[j].z * rstd * gg.z, v[j].w * rstd * gg.w) << 32); }
}

__device__ __forceinline__ void p0_prologue(Frame& F, const Args& a) {
    unsigned char* ws = a.ws;
    LAS float* scr = (LAS float*)(F.lds + F.wave * 16384);
    const int gw = F.vcu * NWAVES + F.wave, NGW = F.G * NWAVES;
    constexpr int I_IN = 16 * 112, I_SQ = 16 * 32, I_KV = 16 * 64, I_W1 = 16 * 64, I_W2 = 16 * 32;
    constexpr int NITEMS = I_IN + 3 * I_SQ + I_KV + NEXP * (I_W1 + I_W2);
    for (int it = gw; it < NITEMS; it += NGW) {
        int r = it;
        if (r < I_IN) { p0_transpose_item<0>(a.in[3], D, INC, (bf16_t*)(ws + WS_WIN), nullptr, scr, r, F.lane); continue; } r -= I_IN;
        if (r < I_SQ) { p0_transpose_item<0>(a.in[6], D, D, (bf16_t*)(ws + WS_WOUT), nullptr, scr, r, F.lane); continue; } r -= I_SQ;
        if (r < I_SQ) { p0_transpose_item<0>(a.in[9], D, D, (bf16_t*)(ws + WS_WQ), a.in[7], scr, r, F.lane); continue; } r -= I_SQ;
        if (r < I_KV) { p0_transpose_item<0>(a.in[10], D, 2 * D, (bf16_t*)(ws + WS_WKV), nullptr, scr, r, F.lane); continue; } r -= I_KV;
        if (r < I_SQ) { p0_transpose_item<0>(a.in[11], D, D, (bf16_t*)(ws + WS_WO), nullptr, scr, r, F.lane); continue; } r -= I_SQ;
        if (r < NEXP * I_W1) { const int e = r / I_W1; p0_transpose_item<1>(a.in[15] + (size_t)e * D * 2048, D, 2048, (bf16_t*)(ws + WS_W1) + (size_t)e * 2048 * D, a.in[12], scr, r % I_W1, F.lane); continue; } r -= NEXP * I_W1;
        { const int e = r / I_W2; p0_transpose_item<0>(a.in[17] + (size_t)e * D * D, D, D, (bf16_t*)(ws + WS_W2) + (size_t)e * D * D, nullptr, scr, r % I_W2, F.lane); }
    }
    for (int i = (F.vcu * NWAVES + F.wave) * 64 + F.lane; i < NEXP * D; i += NGW * 64) { const int e = i >> 10, k = i & 1023; ((float*)(ws + WS_WRT))[i] = a.in[12][k] * a.in[13][k * NEXP + e]; }
    for (int m = gw; m < T; m += NGW) rms_row_to_bf16(a.in[0] + (size_t)m * D, a.in[2], (bf16_t*)(ws + WS_XN) + (size_t)m * D, F.lane);
    for (int m = gw; m < MROWS; m += NGW) rms_row_to_bf16(a.in[1] + (size_t)m * D, a.in[8], (bf16_t*)(ws + WS_MN) + (size_t)m * D, F.lane);
}

__device__ __forceinline__ unsigned xcc_id() { return (unsigned)__builtin_amdgcn_s_getreg((3 << 11) | 20) & 0xFu; }
constexpr int QITEMS = 8 + 128;
__device__ __forceinline__ void p2_mixer(Frame& F, const Args& a) {
    unsigned char* ws = a.ws;
    const bf16_t* proj = (const bf16_t*)(ws + WS_PROJ); bf16_t* mix = (bf16_t*)(ws + WS_MIX);
    const unsigned x0 = xcc_id() & 7u;
    int par = 0;
    for (;;) {
        if (F.tid == 0) { int code = -1;
            for (int j = 0; j < 8; ++j) { const unsigned xq = (x0 + j) & 7u; const unsigned i = __hip_atomic_fetch_add(F.ctl + CW_QUEUE + 64 * xq, 1u, RLX_AGENT);
                if (i < (unsigned)QITEMS) { code = (int)(xq * 256u + i); break; } }
            F.MISC[par] = (unsigned)code; }
        LDS_WAIT(); __builtin_amdgcn_s_barrier(); asm volatile("" ::: "memory");
        const int code = __builtin_amdgcn_readfirstlane((int)F.MISC[par]); par ^= 1;
        if (code < 0) break;
        const int xq = code >> 8, i = code & 255;
#ifndef NO_HGRN
        if (i < 8) { const int bh = xq + 8 * i; hgrn::hgrn_unit(bh >> 3, bh & 7, proj, mix, a.in[4], a.in[5], F.lds); }
        else
#endif
#ifndef NO_MOBA
        { const int j = i - 8, bh = xq + 8 * (j & 7), qb = 15 - (j >> 3);
            moba::attn_unit<8>(bh >> 3, bh & 7, qb, proj + C_MQ, proj + C_MK, proj + C_MV, mix, (const float*)(ws + WS_KBAR), (char*)(unsigned char*)F.lds); }
#else
        {}
#endif
    }
}

__device__ __forceinline__ void p7_router(Frame& F, const Args& a) {
    unsigned char* ws = a.ws;
    LAS float* WR = (LAS float*)F.lds;
    LAS int* hist = (LAS int*)(F.lds + TL_HIST); LAS int* basel = (LAS int*)(F.lds + TL_BASE);
    const float* wrt = (const float*)(ws + WS_WRT);
    for (int i = F.tid; i < NEXP * D / 4; i += 512) ((LAS f32x4*)WR)[i] = ((const f32x4*)wrt)[i];
    const float* h2f = (const float*)(ws + WS_H2F); const float* ss2 = (const float*)(ws + WS_SS2);
    int* toke = (int*)(ws + WS_TOKE); int* tokr = (int*)(ws + WS_TOKR); float* tokg = (float*)(ws + WS_TOKG); int* list = (int*)(ws + WS_LIST);
    const int lane = F.lane;
    const float brl = a.in[14][lane >> 1];
    for (int tb = blockIdx.x; tb < T / 128; tb += F.G) {
        if (F.tid < 32) hist[F.tid] = 0;
        LDS_WAIT(); __builtin_amdgcn_s_barrier(); asm volatile("" ::: "memory");
        int my_e = 0; float my_g = 0.f;
        for (int i = 0; i < 16; ++i) {
            const int t = tb * 128 + F.wave * 16 + i;
            f32x4 x[4];
#pragma unroll
            for (int j = 0; j < 4; ++j) x[j] = *(const f32x4*)(h2f + (size_t)t * D + 4 * lane + 256 * j);
            float v16[16], v8[8], v4[4], v2[2];
            { const bool up = (lane & 32) != 0;
#pragma unroll
              for (int e = 0; e < 16; ++e) { float s0 = 0.f, s1 = 0.f;
#pragma unroll
                  for (int j = 0; j < 4; ++j) { const f32x4 w0 = *(const LAS f32x4*)(WR + e * D + 4 * lane + 256 * j), w1 = *(const LAS f32x4*)(WR + (16 + e) * D + 4 * lane + 256 * j);
                      s0 += (x[j].x * w0.x + x[j].y * w0.y) + (x[j].z * w0.z + x[j].w * w0.w); s1 += (x[j].x * w1.x + x[j].y * w1.y) + (x[j].z * w1.z + x[j].w * w1.w); }
                  const float send = up ? s0 : s1, keep = up ? s1 : s0; v16[e] = keep + __shfl_xor(send, 32);
                  asm volatile("" ::: "memory"); } }
            { const bool up = (lane & 16) != 0;
#pragma unroll
              for (int e = 0; e < 8; ++e) { const float send = up ? v16[e] : v16[8 + e], keep = up ? v16[8 + e] : v16[e]; v8[e] = keep + __shfl_xor(send, 16); } }
            { const bool up = (lane & 8) != 0;
#pragma unroll
              for (int e = 0; e < 4; ++e) { const float send = up ? v8[e] : v8[4 + e], keep = up ? v8[4 + e] : v8[e]; v4[e] = keep + __shfl_xor(send, 8); } }
            { const bool up = (lane & 4) != 0;
#pragma unroll
              for (int e = 0; e < 2; ++e) { const float send = up ? v4[e] : v4[2 + e], keep = up ? v4[2 + e] : v4[e]; v2[e] = keep + __shfl_xor(send, 4); } }
            float v1; { const bool up = (lane & 2) != 0; const float send = up ? v2[0] : v2[1], keep = up ? v2[1] : v2[0]; v1 = keep + __shfl_xor(send, 2); }
            v1 += __shfl_xor(v1, 1);
            float cur = v1 * __builtin_amdgcn_rsqf(ss2[t] * (1.0f / D) + EPS) + brl;
            float tv[4]; int te_[4];
#pragma unroll
            for (int k = 0; k < 4; ++k) { float m = cur;
#pragma unroll
                for (int o = 1; o < 64; o <<= 1) m = fmaxf(m, __shfl_xor(m, o));
                const unsigned long long bal = __ballot(cur == m); const int li = __builtin_ctzll(bal); const int e = li >> 1;
                tv[k] = m; te_[k] = e; if ((lane >> 1) == e) cur = -INFINITY; }
            const float d1 = fast_exp2((tv[1] - tv[0]) * LOG2E), d2 = fast_exp2((tv[2] - tv[0]) * LOG2E), d3 = fast_exp2((tv[3] - tv[0]) * LOG2E);
            const float inv = 1.0f / (1.0f + d1 + d2 + d3);
            if ((lane >> 2) == i) { const int k = lane & 3; my_e = k == 0 ? te_[0] : (k == 1 ? te_[1] : (k == 2 ? te_[2] : te_[3])); my_g = (k == 0 ? 1.0f : (k == 1 ? d1 : (k == 2 ? d2 : d3))) * inv; }
        }
        const int rl = __hip_atomic_fetch_add(hist + my_e, 1, __ATOMIC_RELAXED, __HIP_MEMORY_SCOPE_WORKGROUP);
        LDS_WAIT(); __builtin_amdgcn_s_barrier(); asm volatile("" ::: "memory");
        if (F.tid < 32) basel[F.tid] = (int)__hip_atomic_fetch_add(F.ctl + CW_CNT + F.tid, (unsigned)hist[F.tid], RLX_AGENT);
        LDS_WAIT(); VM_WAIT(); __builtin_amdgcn_s_barrier(); asm volatile("" ::: "memory");
        { const int t = tb * 128 + F.wave * 16 + (lane >> 2), k = lane & 3; const int rank = basel[my_e] + rl;
          toke[t * 4 + k] = my_e; tokr[t * 4 + k] = rank; tokg[t * 4 + k] = my_g; list[(size_t)my_e * T + rank] = t; }
        LDS_WAIT(); __builtin_amdgcn_s_barrier(); asm volatile("" ::: "memory");
    }
}

__device__ __forceinline__ int build_tables(Frame& F) {
    LAS int* ts = (LAS int*)(F.lds + TL_TS); LAS unsigned char* te = (LAS unsigned char*)(F.lds + TL_TE);
    if (F.tid == 0) { int run = 0;
        for (int e = 0; e < NEXP; ++e) { ts[e] = run; const unsigned c = __hip_atomic_load(F.ctl + CW_CNT + e, RLX_AGENT); run += (int)((c + 255u) >> 8); }
        ts[NEXP] = run; }
    LDS_WAIT(); __builtin_amdgcn_s_barrier(); asm volatile("" ::: "memory");
    const int nt = ts[NEXP];
    for (int g = F.tid; g < nt; g += 512) { int e = 0;
        for (int j = 1; j < NEXP; ++j) e += (ts[j] <= g) ? 1 : 0;
        te[g] = (unsigned char)e; }
    LDS_WAIT(); __builtin_amdgcn_s_barrier(); asm volatile("" ::: "memory");
    return __builtin_amdgcn_readfirstlane(nt);
}

__device__ __forceinline__ void p10_combine(Frame& F, const Args& a) {
    unsigned char* ws = a.ws;
    LAS int* ts = (LAS int*)(F.lds + TL_TS);
    const float* h2f = (const float*)(ws + WS_H2F); const bf16_t* Y = (const bf16_t*)(ws + WS_Y);
    const int* toke = (const int*)(ws + WS_TOKE); const int* tokr = (const int*)(ws + WS_TOKR); const float* tokg = (const float*)(ws + WS_TOKG);
    const float* gf = a.in[19];
    const int gw = F.vcu * NWAVES + F.wave, NGW = F.G * NWAVES, lane = F.lane;
    for (int t = gw; t < T; t += NGW) {
        float o[16];
        { const f32x4 a0 = *(const f32x4*)(h2f + (size_t)t * D + 8 * lane), a1 = *(const f32x4*)(h2f + (size_t)t * D + 8 * lane + 4), a2 = *(const f32x4*)(h2f + (size_t)t * D + 512 + 8 * lane), a3 = *(const f32x4*)(h2f + (size_t)t * D + 512 + 8 * lane + 4);
          o[0] = a0.x; o[1] = a0.y; o[2] = a0.z; o[3] = a0.w; o[4] = a1.x; o[5] = a1.y; o[6] = a1.z; o[7] = a1.w; o[8] = a2.x; o[9] = a2.y; o[10] = a2.z; o[11] = a2.w; o[12] = a3.x; o[13] = a3.y; o[14] = a3.z; o[15] = a3.w; }
#pragma unroll
        for (int k = 0; k < 4; ++k) { const int e = toke[t * 4 + k], r = tokr[t * 4 + k]; const float g = tokg[t * 4 + k];
            const bf16_t* yr = Y + ((size_t)ts[e] * 256 + r) * D;
            const u32x4 y0 = *(const u32x4*)(yr + 8 * lane), y1 = *(const u32x4*)(yr + 512 + 8 * lane);
            o[0] += g * bflo(y0.x); o[1] += g * bfhi(y0.x); o[2] += g * bflo(y0.y); o[3] += g * bfhi(y0.y); o[4] += g * bflo(y0.z); o[5] += g * bfhi(y0.z); o[6] += g * bflo(y0.w); o[7] += g * bfhi(y0.w);
            o[8] += g * bflo(y1.x); o[9] += g * bfhi(y1.x); o[10] += g * bflo(y1.y); o[11] += g * bfhi(y1.y); o[12] += g * bflo(y1.z); o[13] += g * bfhi(y1.z); o[14] += g * bflo(y1.w); o[15] += g * bfhi(y1.w); }
        float s = 0.f;
#pragma unroll
        for (int j = 0; j < 16; ++j) s += o[j] * o[j];
        const float rstd = 1.0f / sqrtf(wave_sum(s) * (1.0f / D) + EPS);
        float* op = a.out + (size_t)t * D;
#pragma unroll
        for (int q = 0; q < 4; ++q) { const int col = (q >> 1) * 512 + 8 * lane + (q & 1) * 4; const f32x4 g4 = *(const f32x4*)(gf + col);
            *(f32x4*)(op + col) = (f32x4){o[4 * q] * rstd * g4.x, o[4 * q + 1] * rstd * g4.y, o[4 * q + 2] * rstd * g4.z, o[4 * q + 3] * rstd * g4.w}; }
    }
}

constexpr int N_PHASES = 11;
__global__ void __launch_bounds__(NWAVES * 64, 2) hymba_fwd(Args args) {
    extern __shared__ __attribute__((aligned(16))) unsigned char lds_raw[];
    Frame F;
    F.lds = (LAS unsigned char*)lds_raw;
    F.MISC = (volatile LAS unsigned*)(F.lds + TL_MISC);
    F.tid = threadIdx.x; F.lane = F.tid & 63; F.wave = __builtin_amdgcn_readfirstlane(F.tid >> 6);
    F.G = gridDim.x; { const int bx = blockIdx.x; F.vcu = (F.G % 8 == 0) ? (bx % 8) * (F.G / 8) + bx / 8 : bx; }
    unsigned char* ws = args.ws;
    F.ctl = (unsigned*)(ws + WS_CTL);
    const int lo = args.ph_lo, hi = args.ph_hi;
    const int cid = (int)blockIdx.x;
#ifndef MK_PHASE_MASK
#define MK_PHASE_MASK 0x7ff
#endif
#define IN(k) (((MK_PHASE_MASK >> (k)) & 1) && lo <= (k) && (k) < hi)
#define GRID_BAR(k) do { if (IN(k) && IN((k) + 1)) { cg::this_grid().sync(); } } while (0)

    if (IN(0)) { p0_prologue(F, args); }
    GRID_BAR(0);
    if (IN(1)) {
        { pg8::DenseOrder S{(const char*)(ws + WS_XN), (const char*)(ws + WS_WIN), D, D, T / 256, INC / 256, F.G, cid};
          pg8::EpiProj E{(bf16_t*)(ws + WS_PROJ), (float*)(ws + WS_KBAR)};
          pg8::gemm_phase<pg8::EpiProj, pg8::DenseOrder, false, true>(F.lds, D, D, D / 64, S, E); }
        { pg8::KvOrder S{(const char*)(ws + WS_MN), (const char*)(ws + WS_WKV), F.G, cid};
          pg8::EpiBf16 E{(bf16_t*)(ws + WS_MEMK), D, (bf16_t*)(ws + WS_MEMVT), MROWS};
          pg8::gemm_phase<pg8::EpiBf16, pg8::KvOrder, false, true>(F.lds, D, D, D / 64, S, E); }
    }
    GRID_BAR(1);
    if (IN(2)) { p2_mixer(F, args); }
    GRID_BAR(2);
    if (IN(3)) {
        pg8::DenseOrder S{(const char*)(ws + WS_MIX), (const char*)(ws + WS_WOUT), D, D, T / 256, D / 256, F.G, cid};
        pg8::EpiRes<true, false> E{(const void*)args.in[0], (bf16_t*)(ws + WS_H1B), nullptr, (float*)(ws + WS_SS1)};
        pg8::gemm_phase<pg8::EpiRes<true, false>, pg8::DenseOrder, false, true>(F.lds, D, D, D / 64, S, E);
    }
    GRID_BAR(3);
    if (IN(4)) {
        pg8::DenseOrder S{(const char*)(ws + WS_H1B), (const char*)(ws + WS_WQ), D, D, T / 256, D / 256, F.G, cid};
        pg8::EpiQ E{(bf16_t*)(ws + WS_QX), (const float*)(ws + WS_SS1)};
        pg8::gemm_phase<pg8::EpiQ, pg8::DenseOrder, false, true>(F.lds, D, D, D / 64, S, E);
    }
    GRID_BAR(4);
    if (IN(5)) {
        bf16_t* pw = (bf16_t*)(ws + WS_PWS) + (size_t)cid * 2 * 65536;
        for (int s = 0; s < 2; ++s) {
            pg8::XaScoreOrder S{(const char*)(ws + WS_QX), (const char*)(ws + WS_MEMK), cid + s * F.G};
            pg8::EpiSoftmax E{pw + (size_t)s * 65536};
            pg8::gemm_phase<pg8::EpiSoftmax, pg8::XaScoreOrder, false, false>(F.lds, D, D, 4, S, E);
        }
        VM_WAIT(); __syncthreads(); __builtin_amdgcn_fence(__ATOMIC_ACQUIRE, "agent"); __syncthreads();
        { pg8::XaPvOrder S{(const char*)pw, (const char*)(ws + WS_MEMVT), F.G, cid};
          pg8::EpiBf16 E{(bf16_t*)(ws + WS_OX), D, (bf16_t*)(ws + WS_OX), D};
          pg8::gemm_phase<pg8::EpiBf16, pg8::XaPvOrder, false, true>(F.lds, 256, MROWS, 4, S, E); }
    }
    GRID_BAR(5);
    if (IN(6)) {
        pg8::DenseOrder S{(const char*)(ws + WS_OX), (const char*)(ws + WS_WO), D, D, T / 256, D / 256, F.G, cid};
        pg8::EpiRes<false, true> E{(const void*)(ws + WS_H1B), (bf16_t*)(ws + WS_H2B), (float*)(ws + WS_H2F), (float*)(ws + WS_SS2)};
        pg8::gemm_phase<pg8::EpiRes<false, true>, pg8::DenseOrder, false, true>(F.lds, D, D, D / 64, S, E);
    }
    GRID_BAR(6);
    if (IN(7)) { p7_router(F, args); }
    GRID_BAR(7);
    if (IN(8)) {
        const int ntl = build_tables(F);
        pg8::MoeOrder S{(const char*)(ws + WS_H2B), (const char*)(ws + WS_W1), (const int*)(ws + WS_LIST), F.ctl + CW_CNT, (const LAS unsigned char*)(F.lds + TL_TE), (const LAS int*)(F.lds + TL_TS),
                        ntl, 8, F.G, cid, (size_t)2048 * D * 2, 1};
        pg8::EpiW1 E{(bf16_t*)(ws + WS_HMID), (const float*)(ws + WS_SS2), args.in[16]};
        pg8::gemm_phase<pg8::EpiW1, pg8::MoeOrder, true, true>(F.lds, D, D, D / 64, S, E);
    }
    GRID_BAR(8);
    if (IN(9)) {
        const int ntl = build_tables(F);
        pg8::MoeOrder S{(const char*)(ws + WS_HMID), (const char*)(ws + WS_W2), (const int*)(ws + WS_LIST), F.ctl + CW_CNT, (const LAS unsigned char*)(F.lds + TL_TE), (const LAS int*)(F.lds + TL_TS),
                        ntl, 4, F.G, cid, (size_t)D * D * 2, 0};
        pg8::EpiW2 E{(bf16_t*)(ws + WS_Y), args.in[18]};
        pg8::gemm_phase<pg8::EpiW2, pg8::MoeOrder, false, true>(F.lds, D, D, D / 64, S, E);
    }
    GRID_BAR(9);
    if (IN(10)) { (void)build_tables(F); p10_combine(F, args); }
#undef IN
#undef GRID_BAR
}

extern "C" void kernel_launch(void* const* d_in, const int* in_sizes, int n_in, void* d_out, int out_size, void* d_ws, size_t ws_size, hipStream_t stream) {
    static int grid = 0;
    if (grid == 0) {
        if (n_in != 20 || in_sizes[0] != T * D || out_size != T * D || ws_size < WS_END) {
            fprintf(stderr, "kernel_launch: shape/workspace mismatch (n_in %d, in0 %d, out %d, ws %zu, need %zu)\n", n_in, n_in > 0 ? in_sizes[0] : -1, out_size, ws_size, (size_t)WS_END); grid = -1; return; }
        int dev = 0, cus = 0, per_cu = 0;
        if (hipGetDevice(&dev) != hipSuccess || hipDeviceGetAttribute(&cus, hipDeviceAttributeMultiprocessorCount, dev) != hipSuccess) { grid = -1; return; }
        if (hipFuncSetAttribute((const void*)hymba_fwd, hipFuncAttributeMaxDynamicSharedMemorySize, LDS_BYTES) != hipSuccess) { fprintf(stderr, "kernel_launch: hipFuncSetAttribute failed\n"); grid = -1; return; }
        if (hipOccupancyMaxActiveBlocksPerMultiprocessor(&per_cu, (const void*)hymba_fwd, NWAVES * 64, LDS_BYTES) != hipSuccess || per_cu < 1) { fprintf(stderr, "kernel_launch: occupancy query says %d\n", per_cu); }
        (void)hipGetLastError();
        grid = cus;
        if (grid != 256) fprintf(stderr, "kernel_launch: %d CUs; this kernel is built for 256\n", grid);
    }
    if (grid < 0) return;
    (void)hipMemsetAsync((char*)d_ws + WS_CTL, 0, CTL_ZERO_BYTES, stream);
    Args a{};
    for (int i = 0; i < 20; ++i) a.in[i] = (const float*)d_in[i];
    a.out = (float*)d_out; a.ws = (unsigned char*)d_ws;
#if MK_N_LAUNCHES == 1
    a.ph_lo = 0; a.ph_hi = MK_LAST_PHASE + 1;
    void* kargs[] = {&a};
    hipError_t e = hipLaunchCooperativeKernel((const void*)hymba_fwd, dim3(grid), dim3(NWAVES * 64), kargs, LDS_BYTES, stream);
    if (e != hipSuccess) fprintf(stderr, "kernel_launch: cooperative launch failed: %s\n", hipGetErrorString(e));
#else
    for (int p = 0; p <= MK_LAST_PHASE; ++p) { a.ph_lo = p; a.ph_hi = p + 1; hipLaunchKernelGGL(hymba_fwd, dim3(grid), dim3(NWAVES * 64), LDS_BYTES, stream, a); }
#endif
}
```

```cpp
#include <hip/hip_runtime.h>
#include <hip/hip_cooperative_groups.h>
#include <cstdio>
#include <cstdint>
namespace cg = cooperative_groups;

#ifndef MK_N_LAUNCHES
#define MK_N_LAUNCHES 1
#endif
#ifndef MK_LAST_PHASE
#define MK_LAST_PHASE 10
#endif

#define LAS __attribute__((address_space(3)))
#define GAS __attribute__((address_space(1)))
typedef unsigned short bf16_t;
typedef short bf16x8 __attribute__((ext_vector_type(8)));
typedef short s16x4 __attribute__((ext_vector_type(4)));
typedef float f32x4 __attribute__((ext_vector_type(4)));
typedef float f32x2 __attribute__((ext_vector_type(2)));
typedef float f32x16 __attribute__((ext_vector_type(16)));
typedef unsigned u32x4 __attribute__((ext_vector_type(4)));
typedef unsigned u32x2 __attribute__((ext_vector_type(2)));

constexpr int BATCH = 8, SEQ = 4096, T = BATCH * SEQ, D = 1024, INC = 3584, NMEM = 256, MROWS = BATCH * NMEM;
constexpr int NEXP = 32, TOPK = 4, MT_MAX = T * TOPK / 256 + NEXP, MPAD = MT_MAX * 256;
constexpr float EPS = 1e-6f;
constexpr float LOG2E = 1.4426950408889634f;
constexpr float C2Q = 0.125f * LOG2E;
constexpr float C2X = 0.0625f * LOG2E;
constexpr int C_MQ = 0, C_MK = 512, C_MV = 1024, C_GQ = 1536, C_GF = 2048, C_GI = 2560, C_GG = 3072;

constexpr size_t MiB = 1u << 20;
constexpr size_t WS_CTL = 0, CTL_ZERO_BYTES = 2 * MiB;
constexpr size_t WS_KBAR = 1 * MiB;
constexpr size_t WS_SS1 = 1 * MiB + 256 * 1024;
constexpr size_t WS_SS2 = 1 * MiB + 384 * 1024;
constexpr size_t WS_TOKE = 2 * MiB, WS_TOKR = 2 * MiB + 512 * 1024, WS_TOKG = 3 * MiB;
constexpr size_t WS_WRT = 3 * MiB + 512 * 1024;
constexpr size_t WS_LIST = 4 * MiB;
constexpr size_t WS_WIN = 16 * MiB, WS_WOUT = 23 * MiB, WS_WQ = 25 * MiB, WS_WKV = 27 * MiB, WS_WO = 31 * MiB;
constexpr size_t WS_MN = 33 * MiB, WS_MEMK = 37 * MiB, WS_MEMVT = 41 * MiB;
constexpr size_t WS_W1 = 48 * MiB, WS_W2 = 176 * MiB;
constexpr size_t WS_PROJ = 240 * MiB;
constexpr size_t WS_XN = 464 * MiB;
constexpr size_t WS_OX = 464 * MiB;
constexpr size_t WS_MIX = 528 * MiB;
constexpr size_t WS_H1B = 592 * MiB;
constexpr size_t WS_QX = 656 * MiB;
constexpr size_t WS_PWS = 720 * MiB;
constexpr size_t WS_HMID = 240 * MiB;
constexpr size_t WS_Y = 512 * MiB;
constexpr size_t WS_H2F = 784 * MiB;
constexpr size_t WS_H2B = 912 * MiB;
constexpr size_t WS_DUMMY = 976 * MiB;
constexpr size_t WS_END = 984 * MiB;
static_assert(WS_HMID + (size_t)MPAD * D * 2 <= WS_Y && WS_Y + (size_t)MPAD * D * 2 <= WS_H2F, "ws map");
constexpr int CW_TMO = 0;
constexpr int CW_CNT = 64;
constexpr int CW_QUEUE = 128;
constexpr int CW_BAR = 4096;

__device__ __forceinline__ unsigned f2bf(float f) { unsigned u = __builtin_bit_cast(unsigned, f); return (u + 0x7fffu + ((u >> 16) & 1u)) >> 16; }
__device__ __forceinline__ unsigned pk2(float lo, float hi) { return f2bf(lo) | (f2bf(hi) << 16); }
__device__ __forceinline__ float bf2f(unsigned short h) { return __builtin_bit_cast(float, (unsigned)h << 16); }
__device__ __forceinline__ float bflo(unsigned w) { return __builtin_bit_cast(float, w << 16); }
__device__ __forceinline__ float bfhi(unsigned w) { return __builtin_bit_cast(float, w & 0xffff0000u); }
typedef float f32x2_t __attribute__((ext_vector_type(2))); typedef __bf16 bf16x2_t __attribute__((ext_vector_type(2)));
__device__ __forceinline__ unsigned cvtpk(float lo, float hi) { f32x2_t v = {lo, hi}; bf16x2_t b = __builtin_convertvector(v, bf16x2_t); return __builtin_bit_cast(unsigned, b); }
__device__ __forceinline__ float wave_sum(float v) {
#pragma unroll
    for (int o = 1; o < 64; o <<= 1) v += __shfl_xor(v, o);
    return v;
}
__device__ __forceinline__ float fast_exp2(float x) { return __builtin_amdgcn_exp2f(x); }
__device__ __forceinline__ float fast_rcp(float x) { return __builtin_amdgcn_rcpf(x); }
__device__ __forceinline__ float silu_f(float x) { return x * fast_rcp(1.0f + fast_exp2(-x * LOG2E)); }
#define LDS_WAIT() asm volatile("s_waitcnt lgkmcnt(0)" ::: "memory")
#define VM_WAIT() asm volatile("s_waitcnt vmcnt(0)" ::: "memory")
#define RLX_AGENT __ATOMIC_RELAXED, __HIP_MEMORY_SCOPE_AGENT

namespace pg8 {
constexpr int BM = 256, BK = 64, HALF = 128, HTB = HALF * BK * 2, STAGE_BYTES = 8 * HTB;
__host__ __device__ __forceinline__ int lds_byte(int r, int c) { const int st = (r >> 4) * 2 + (c >> 5), rr = r & 15, cc = c & 31, ob = rr * 64 + cc * 2; return st * 1024 + (ob ^ (((ob >> 9) & 1) << 5)); }
__host__ __device__ __forceinline__ void stage_rc(int b, int& R, int& C) { const int st = b / 1024, sb = b % 1024, swz = sb ^ (((sb >> 9) & 1) << 5); R = (st >> 1) * 16 + swz / 64; C = (st & 1) * 32 + (swz % 64) / 2; }
__host__ __device__ __forceinline__ int perm32(int rho) { const int n = rho >> 4, i = rho & 15; return 8 * (i >> 2) + 4 * n + (i & 3); }

struct Unit { const char* A; const char* B; const int* rows; int pm, pn, aux, nrows; };

template <class Epi, class Sched, bool GATHER, bool ALIGN_EPI>
__device__ __forceinline__ void gemm_phase(LAS unsigned char* lds, const int lda, const int ldb, const int nt_in, const Sched& S, const Epi& E) {
    int nt = nt_in; asm volatile("" : "+s"(nt));
    int tid_ = threadIdx.x; asm volatile("" : "+v"(tid_));
    const int tid = tid_, wid = __builtin_amdgcn_readfirstlane(tid >> 6), lane = tid & 63, wr = wid >> 2, wc = wid & 3, fr = lane & 15, fq = lane >> 4;
    unsigned offB[2];
#pragma unroll
    for (int i = 0; i < 2; ++i) { int R, C; stage_rc(tid * 16 + i * 8192, R, C); const int Rb = Epi::PERM ? ((R & ~31) + perm32(R & 31)) : R;
        offB[i] = (unsigned)(Rb * ldb + C) * 2u; }
    const size_t kstep = (size_t)(BK * 2);
    const size_t hstepB = (size_t)HALF * ldb * 2;
    const unsigned ldsw = (unsigned)wid * 1024u;
    const int aoff = lds_byte(wr * 64 + fr, fq * 8), boff = lds_byte(wc * 32 + fr, fq * 8);
#define PG8_SA(b, h) (((b) * 2 + (h)) * HTB)
#define PG8_SB(b, h) ((4 + (b) * 2 + (h)) * HTB)
#define PG8_STG(bufoff, gbase, o0, o1) do { \
        __builtin_amdgcn_global_load_lds((const unsigned*)((const char*)(gbase) + (o0)), (LAS unsigned*)(lds + (bufoff) + ldsw), 16, 0, 0); \
        __builtin_amdgcn_global_load_lds((const unsigned*)((const char*)(gbase) + (o1)), (LAS unsigned*)(lds + (bufoff) + ldsw + 8192), 16, 0, 0); } while (0)
#define PG8_STGB(bufoff, gbase) PG8_STG(bufoff, gbase, offB[0], offB[1])
#define PG8_LDA(dst, b, h) do { _Pragma("unroll") for (int m = 0; m < 4; ++m) _Pragma("unroll") for (int k = 0; k < 2; ++k) dst[m][k] = *(const LAS bf16x8*)(lds + PG8_SA(b, h) + aoff + m * 2048 + k * 1024); } while (0)
#define PG8_LDB(dst, b, h) do { _Pragma("unroll") for (int n = 0; n < 2; ++n) _Pragma("unroll") for (int k = 0; k < 2; ++k) dst[n][k] = *(const LAS bf16x8*)(lds + PG8_SB(b, h) + boff + n * 2048 + k * 1024); } while (0)
#define PG8_MMA(ai, bj, At, Bt) do { __builtin_amdgcn_s_setprio(1); _Pragma("unroll") for (int m = 0; m < 4; ++m) _Pragma("unroll") for (int n = 0; n < 2; ++n) _Pragma("unroll") for (int k = 0; k < 2; ++k) \
        acc[ai][bj][m][n] = __builtin_amdgcn_mfma_f32_16x16x32_bf16(Bt[n][k], At[m][k], acc[ai][bj][m][n], 0, 0, 0); __builtin_amdgcn_s_setprio(0); } while (0)
#define PG8_WAIT_V(n) asm volatile("s_waitcnt vmcnt(" #n ")" ::: "memory")
#define PG8_WAIT_L(n) asm volatile("s_waitcnt lgkmcnt(" #n ")" ::: "memory")
#define PG8_BAR __builtin_amdgcn_s_barrier()
#define PG8_SCHED __builtin_amdgcn_sched_barrier(0)
    unsigned voffA[2], c2[2], pkc[2], pkn[2];
#pragma unroll
    for (int i = 0; i < 2; ++i) { int R, C; stage_rc(tid * 16 + i * 8192, R, C); voffA[i] = (unsigned)(R * lda + C) * 2u; c2[i] = (unsigned)C * 2u; }
    const size_t hstepA = (size_t)HALF * lda * 2;
    const unsigned lda2 = (unsigned)lda * 2u;
#define PG8_PKROWS(dst, u) do { if (GATHER) { _Pragma("unroll") for (int i_ = 0; i_ < 2; ++i_) { int R_, C_; stage_rc(tid * 16 + i_ * 8192, R_, C_); \
        const int nr_ = (u).nrows - 1; const int r0_ = R_ < nr_ ? R_ : nr_, r1_ = (R_ + HALF) < nr_ ? (R_ + HALF) : nr_; \
        dst[i_] = (unsigned)(u).rows[r0_] | ((unsigned)(u).rows[r1_] << 16); } } } while (0)
#define PG8_STGA(bufoff, gbase, h, NX) do { \
        if (GATHER) { const unsigned p0_ = (NX) ? pkn[0] : pkc[0], p1_ = (NX) ? pkn[1] : pkc[1]; \
            const unsigned o0_ = ((h) ? (p0_ >> 16) : (p0_ & 0xffffu)) * lda2 + c2[0], o1_ = ((h) ? (p1_ >> 16) : (p1_ & 0xffffu)) * lda2 + c2[1]; \
            PG8_STG(bufoff, gbase, o0_, o1_); } \
        else { PG8_STG(bufoff, (gbase) + ((h) ? hstepA : (size_t)0), voffA[0], voffA[1]); } } while (0)
    Unit cur, nxt; int ui = 0;
    if (!S.next(0, cur)) return;
    f32x4 acc[2][2][4][2];
#pragma unroll
    for (int a = 0; a < 2; ++a)
#pragma unroll
        for (int b = 0; b < 2; ++b)
#pragma unroll
            for (int m = 0; m < 4; ++m)
#pragma unroll
                for (int n = 0; n < 2; ++n) acc[a][b][m][n] = (f32x4){0.f, 0.f, 0.f, 0.f};
    bf16x8 At[4][2], B0[2][2], B1[2][2];
    pkc[0] = pkc[1] = pkn[0] = pkn[1] = 0u;
    PG8_PKROWS(pkc, cur);
    const char* cA = cur.A; const char* cB = cur.B;
    PG8_STGB(PG8_SB(0, 0), cB); PG8_STGB(PG8_SB(0, 1), cB + hstepB); PG8_STGA(PG8_SA(0, 0), cA, 0, false); PG8_STGA(PG8_SA(0, 1), cA, 1, false);
    if (wr == 1) PG8_BAR;
    PG8_WAIT_V(2); PG8_BAR;
    PG8_STGB(PG8_SB(1, 0), cB + kstep); PG8_STGA(PG8_SA(1, 0), cA + kstep, 0, false); PG8_STGB(PG8_SB(1, 1), cB + hstepB + kstep);
    PG8_WAIT_V(6); PG8_BAR;
    for (;;) {
        const bool has_next = S.next(ui + 1, nxt);
        if (GATHER) { if (has_next) { PG8_PKROWS(pkn, nxt); } else { pkn[0] = pkc[0]; pkn[1] = pkc[1]; } }
        const char* nA = has_next ? nxt.A : cA; const char* nB = has_next ? nxt.B : cB;
        for (int t = 0; t < nt; t += 2) {
            const bool last = (t == nt - 2);
            const char* a1 = cA + (size_t)(t + 1) * kstep;
            const char* a2 = last ? nA : cA + (size_t)(t + 2) * kstep; const char* b2 = last ? nB : cB + (size_t)(t + 2) * kstep;
            const char* a3 = a2 + kstep; const char* b3 = b2 + kstep;
            PG8_LDB(B0, 0, 0); PG8_LDB(B1, 0, 1); PG8_SCHED; PG8_LDA(At, 0, 0); PG8_STGA(PG8_SA(1, 1), a1, 1, false);
            PG8_WAIT_V(8); PG8_WAIT_L(0); PG8_BAR; PG8_MMA(0, 0, At, B0); PG8_MMA(0, 1, At, B1); PG8_BAR; PG8_SCHED;
            PG8_LDA(At, 0, 1); PG8_STGB(PG8_SB(0, 0), b2); PG8_STGB(PG8_SB(0, 1), b2 + hstepB); PG8_STGA(PG8_SA(0, 0), a2, 0, last);
            PG8_WAIT_V(8); PG8_WAIT_L(0); PG8_BAR; PG8_MMA(1, 0, At, B0); PG8_MMA(1, 1, At, B1); PG8_BAR; PG8_SCHED;
            PG8_LDB(B0, 1, 0); PG8_LDB(B1, 1, 1); PG8_SCHED; PG8_LDA(At, 1, 0); PG8_STGA(PG8_SA(0, 1), a2, 1, last);
            PG8_WAIT_V(8); PG8_WAIT_L(0); PG8_BAR; PG8_MMA(0, 0, At, B0); PG8_MMA(0, 1, At, B1); PG8_BAR; PG8_SCHED;
            PG8_LDA(At, 1, 1); PG8_STGB(PG8_SB(1, 0), b3); PG8_STGB(PG8_SB(1, 1), b3 + hstepB); PG8_STGA(PG8_SA(1, 0), a3, 0, last);
            PG8_WAIT_V(8); PG8_WAIT_L(0); PG8_BAR; PG8_MMA(1, 0, At, B0); PG8_MMA(1, 1, At, B1); PG8_BAR; PG8_SCHED;
        }
        if constexpr (ALIGN_EPI) { if (wr == 0) PG8_BAR; }
        if constexpr (!Epi::AFTER_DRAIN) { int t_e = threadIdx.x; asm volatile("" : "+v"(t_e)); const int fr_e = t_e & 15, fq_e = (t_e >> 4) & 3; E(acc, cur, wr, wc, fr_e, fq_e); }
        if (!has_next) break;
#pragma unroll
        for (int a = 0; a < 2; ++a)
#pragma unroll
            for (int b = 0; b < 2; ++b)
#pragma unroll
                for (int m = 0; m < 4; ++m)
#pragma unroll
                    for (int n = 0; n < 2; ++n) acc[a][b][m][n] = (f32x4){0.f, 0.f, 0.f, 0.f};
        cur = nxt; cA = nA; cB = nB; ++ui;
        if (GATHER) { pkc[0] = pkn[0]; pkc[1] = pkn[1]; }
        if constexpr (ALIGN_EPI) { if (wr == 1) PG8_BAR; }
    }
    PG8_WAIT_V(0);
    if constexpr (!ALIGN_EPI) { if (wr == 0) PG8_BAR; }
    PG8_BAR;
    if constexpr (Epi::AFTER_DRAIN) { int t_e = threadIdx.x; asm volatile("" : "+v"(t_e)); const int fr_e = t_e & 15, fq_e = (t_e >> 4) & 3; E.fused(acc, cur, wr, wc, fr_e, fq_e, lds, wid, t_e & 63); }
#undef PG8_SA
#undef PG8_SB
#undef PG8_STG
#undef PG8_STGB
#undef PG8_LDA
#undef PG8_LDB
#undef PG8_MMA
#undef PG8_WAIT_V
#undef PG8_WAIT_L
#undef PG8_SCHED
#undef PG8_PKROWS
#undef PG8_STGA
}
}

namespace pg8 {
constexpr int NXCD = 8, WGM = 8;
__device__ __forceinline__ void tile_order(int L, int nM, int nN, int& pm, int& pn) {
    const int nwg = nM * nN; int wgid = L;
    { const int q = nwg / NXCD, r = nwg % NXCD, xcd = wgid % NXCD, off = wgid / NXCD; wgid = (xcd < r ? xcd * (q + 1) : r * (q + 1) + (xcd - r) * q) + off; }
    const int nig = WGM * nN, gid = wgid / nig, fm = gid * WGM, gsz = (nM - fm) < WGM ? (nM - fm) : WGM;
    pm = fm + ((wgid % nig) % gsz); pn = (wgid % nig) / gsz;
}
struct DenseOrder {
    const char* A; const char* B; int lda, ldb, nM, nN, G, c;
    __device__ __forceinline__ bool next(int i, Unit& u) const {
        const long L = (long)i * G + c; if (L >= (long)nM * nN) return false;
        int pm, pn; tile_order((int)L, nM, nN, pm, pn);
        u.pm = pm; u.pn = pn; u.aux = 0; u.rows = nullptr; u.nrows = 256;
        u.A = A + (size_t)pm * 256 * lda * 2; u.B = B + (size_t)pn * 256 * ldb * 2; return true;
    }
};
struct KvOrder {
    const char* MN; const char* W; int G, c;
    __device__ __forceinline__ bool next(int i, Unit& u) const {
        const int L = i * G + c; if (L >= 64) return false;
        u.rows = nullptr; u.nrows = 256;
        if (L < 32) { u.aux = 0; u.pm = L >> 2; u.pn = L & 3; u.A = MN + (size_t)u.pm * 256 * D * 2; u.B = W + (size_t)u.pn * 256 * D * 2; }
        else { const int l = L - 32; u.aux = 1; u.pm = l >> 3; u.pn = l & 7; u.A = W + (size_t)(1024 + u.pm * 256) * D * 2; u.B = MN + (size_t)u.pn * 256 * D * 2; }
        return true;
    }
};
struct XaScoreOrder {
    const char* QX; const char* MK; int xu;
    __device__ __forceinline__ bool next(int i, Unit& u) const {
        if (i > 0 || xu >= 512) return false;
        const int head = xu & 3, rt = xu >> 2, b = rt >> 4;
        u.pm = rt; u.pn = head; u.aux = 0; u.rows = nullptr; u.nrows = 256;
        u.A = QX + ((size_t)rt * 256 * D + head * 256) * 2; u.B = MK + ((size_t)b * 256 * D + head * 256) * 2; return true;
    }
};
struct XaPvOrder {
    const char* PW; const char* VT; int G, c;
    __device__ __forceinline__ bool next(int i, Unit& u) const {
        const int xu = c + i * G; if (i >= 2 || xu >= 512) return false;
        const int head = xu & 3, rt = xu >> 2, b = rt >> 4;
        u.pm = rt; u.pn = head; u.aux = 0; u.rows = nullptr; u.nrows = 256;
        u.A = PW + (size_t)i * 256 * 256 * 2; u.B = VT + ((size_t)head * 256 * MROWS + b * 256) * 2; return true;
    }
};
struct MoeOrder {
    const char* A; const char* W; const int* list; const unsigned* cnt; const LAS unsigned char* te; const LAS int* ts;
    int ntiles, nN, G, c; size_t wstride; int gather;
    __device__ __forceinline__ bool next(int i, Unit& u) const {
        const long L = (long)i * G + c; if (L >= (long)ntiles * nN) return false;
        int pm, pn; tile_order((int)L, ntiles, nN, pm, pn);
        const int e = __builtin_amdgcn_readfirstlane((int)te[pm]);
        const int lt = pm - __builtin_amdgcn_readfirstlane(ts[e]);
        const int n = (int)__builtin_amdgcn_readfirstlane((int)__hip_atomic_load(cnt + e, RLX_AGENT)) - lt * 256;
        u.pm = pm; u.pn = pn; u.aux = e; u.nrows = n < 256 ? n : 256;
        u.rows = list + (size_t)e * T + lt * 256;
        u.A = gather ? A : A + (size_t)pm * 256 * D * 2;
        u.B = W + (size_t)e * wstride + (size_t)pn * 256 * D * 2; return true;
    }
};

struct EpiProj {
    static constexpr bool PERM = true, AFTER_DRAIN = false;
    bf16_t* O; float* kbar;
    __device__ __forceinline__ void operator()(const f32x4 (&acc)[2][2][4][2], const Unit& u, int wr, int wc, int fr, int fq) const {
        const int pn = u.pn, row0 = u.pm * BM + wr * 64 + fr, col0 = pn * BM + wc * 32 + 8 * fq;
        const int mode = (pn < 2) ? 1 : ((pn == 6 || pn == 7 || pn >= 12) ? 2 : 0);
#pragma unroll
        for (int ai = 0; ai < 2; ++ai)
#pragma unroll
            for (int m = 0; m < 4; ++m) { bf16_t* rowp = O + (size_t)(row0 + ai * HALF + m * 16) * INC + col0;
#pragma unroll
                for (int bj = 0; bj < 2; ++bj) { f32x4 v0 = acc[ai][bj][m][0], v1 = acc[ai][bj][m][1];
                    if (mode == 1) { v0 = v0 * C2Q; v1 = v1 * C2Q; }
                    else if (mode == 2) {
#pragma unroll
                        for (int e = 0; e < 4; ++e) { v0[e] = silu_f(v0[e]); v1[e] = silu_f(v1[e]); } }
                    u32x4 w; w.x = cvtpk(v0[0], v0[1]); w.y = cvtpk(v0[2], v0[3]); w.z = cvtpk(v1[0], v1[1]); w.w = cvtpk(v1[2], v1[3]);
                    *(u32x4*)(rowp + bj * HALF) = w; } }
        if (pn == 2 || pn == 3) {
#pragma unroll
            for (int bj = 0; bj < 2; ++bj)
#pragma unroll
                for (int n = 0; n < 2; ++n)
#pragma unroll
                    for (int e = 0; e < 4; ++e) { float s = 0.f;
#pragma unroll
                        for (int ai = 0; ai < 2; ++ai)
#pragma unroll
                            for (int m = 0; m < 4; ++m) s += acc[ai][bj][m][n][e];
                        s += __shfl_xor(s, 1); s += __shfl_xor(s, 2); s += __shfl_xor(s, 4); s += __shfl_xor(s, 8);
                        if (fr == 0) { const int c = bj * HALF + wc * 32 + 8 * fq + 4 * n + e, head = (pn - 2) * 4 + (c >> 6), d = c & 63;
                            atomicAdd(kbar + ((size_t)u.pm * 8 + head) * 64 + d, s); } }
        }
    }
};
struct EpiBf16 {
    static constexpr bool PERM = true, AFTER_DRAIN = false;
    bf16_t* O0; int ldc0; bf16_t* O1; int ldc1;
    __device__ __forceinline__ void operator()(const f32x4 (&acc)[2][2][4][2], const Unit& u, int wr, int wc, int fr, int fq) const {
        bf16_t* O = u.aux ? O1 : O0; const int ldc = u.aux ? ldc1 : ldc0;
        const int row0 = u.pm * BM + wr * 64 + fr, col0 = u.pn * BM + wc * 32 + 8 * fq;
#pragma unroll
        for (int ai = 0; ai < 2; ++ai)
#pragma unroll
            for (int m = 0; m < 4; ++m) { bf16_t* rowp = O + (size_t)(row0 + ai * HALF + m * 16) * ldc + col0;
#pragma unroll
                for (int bj = 0; bj < 2; ++bj) { const f32x4 v0 = acc[ai][bj][m][0], v1 = acc[ai][bj][m][1];
                    u32x4 w; w.x = cvtpk(v0[0], v0[1]); w.y = cvtpk(v0[2], v0[3]); w.z = cvtpk(v1[0], v1[1]); w.w = cvtpk(v1[2], v1[3]);
                    *(u32x4*)(rowp + bj * HALF) = w; } }
    }
};
template <bool BASE_F32, bool WRITE_F32> struct EpiRes {
    static constexpr bool PERM = true, AFTER_DRAIN = false;
    const void* base; bf16_t* Ob; float* Of; float* ss;
    __device__ __forceinline__ void operator()(const f32x4 (&acc)[2][2][4][2], const Unit& u, int wr, int wc, int fr, int fq) const {
        const int row0 = u.pm * BM + wr * 64 + fr, col0 = u.pn * BM + wc * 32 + 8 * fq;
#pragma unroll
        for (int ai = 0; ai < 2; ++ai)
#pragma unroll
            for (int m = 0; m < 4; ++m) { const int row = row0 + ai * HALF + m * 16; const size_t off = (size_t)row * D + col0; float sq = 0.f;
#pragma unroll
                for (int bj = 0; bj < 2; ++bj) { f32x4 b0, b1;
                    if (BASE_F32) { b0 = *(const f32x4*)((const float*)base + off + bj * HALF); b1 = *(const f32x4*)((const float*)base + off + bj * HALF + 4); }
                    else { const u32x4 w = *(const u32x4*)((const bf16_t*)base + off + bj * HALF);
                        b0 = (f32x4){bflo(w.x), bfhi(w.x), bflo(w.y), bfhi(w.y)}; b1 = (f32x4){bflo(w.z), bfhi(w.z), bflo(w.w), bfhi(w.w)}; }
                    const f32x4 v0 = acc[ai][bj][m][0] + b0, v1 = acc[ai][bj][m][1] + b1;
                    sq += (v0[0] * v0[0] + v0[1] * v0[1]) + (v0[2] * v0[2] + v0[3] * v0[3]) + (v1[0] * v1[0] + v1[1] * v1[1]) + (v1[2] * v1[2] + v1[3] * v1[3]);
                    u32x4 w; w.x = cvtpk(v0[0], v0[1]); w.y = cvtpk(v0[2], v0[3]); w.z = cvtpk(v1[0], v1[1]); w.w = cvtpk(v1[2], v1[3]);
                    *(u32x4*)(Ob + off + bj * HALF) = w;
                    if (WRITE_F32) { *(f32x4*)(Of + off + bj * HALF) = v0; *(f32x4*)(Of + off + bj * HALF + 4) = v1; } }
                sq += __shfl_xor(sq, 16); sq += __shfl_xor(sq, 32);
                if (fq == 0) atomicAdd(ss + row, sq); }
    }
};
struct EpiQ {
    static constexpr bool PERM = true, AFTER_DRAIN = false;
    bf16_t* O; const float* ss;
    __device__ __forceinline__ void operator()(const f32x4 (&acc)[2][2][4][2], const Unit& u, int wr, int wc, int fr, int fq) const {
        const int row0 = u.pm * BM + wr * 64 + fr, col0 = u.pn * BM + wc * 32 + 8 * fq;
#pragma unroll
        for (int ai = 0; ai < 2; ++ai)
#pragma unroll
            for (int m = 0; m < 4; ++m) { const int row = row0 + ai * HALF + m * 16; const float sc = C2X * __builtin_amdgcn_rsqf(ss[row] * (1.0f / D) + EPS);
                bf16_t* rowp = O + (size_t)row * D + col0;
#pragma unroll
                for (int bj = 0; bj < 2; ++bj) { const f32x4 v0 = acc[ai][bj][m][0] * sc, v1 = acc[ai][bj][m][1] * sc;
                    u32x4 w; w.x = cvtpk(v0[0], v0[1]); w.y = cvtpk(v0[2], v0[3]); w.z = cvtpk(v1[0], v1[1]); w.w = cvtpk(v1[2], v1[3]);
                    *(u32x4*)(rowp + bj * HALF) = w; } }
    }
};
struct EpiSoftmax {
    static constexpr bool PERM = true, AFTER_DRAIN = true;
    bf16_t* P;
    __device__ __forceinline__ void fused(f32x4 (&acc)[2][2][4][2], const Unit& u, int wr, int wc, int fr, int fq, LAS unsigned char* lds, int wid, int lane) const {
        LAS float* MX = (LAS float*)lds;
        LAS float* SM = (LAS float*)(lds + 4096);
#pragma unroll
        for (int ai = 0; ai < 2; ++ai)
#pragma unroll
            for (int m = 0; m < 4; ++m) { float mx = -3.0e38f;
#pragma unroll
                for (int bj = 0; bj < 2; ++bj)
#pragma unroll
                    for (int n = 0; n < 2; ++n) { const f32x4 x = acc[ai][bj][m][n]; mx = fmaxf(mx, fmaxf(fmaxf(x[0], x[1]), fmaxf(x[2], x[3]))); }
                mx = fmaxf(mx, __shfl_xor(mx, 16)); mx = fmaxf(mx, __shfl_xor(mx, 32));
                if (fq == 0) MX[(ai * HALF + wr * 64 + m * 16 + fr) * 4 + wc] = mx; }
        LDS_WAIT(); __builtin_amdgcn_s_barrier(); asm volatile("" ::: "memory");
#pragma unroll
        for (int ai = 0; ai < 2; ++ai)
#pragma unroll
            for (int m = 0; m < 4; ++m) { const int r = ai * HALF + wr * 64 + m * 16 + fr; const f32x4 q = *(const LAS f32x4*)(MX + r * 4);
                const float mx = fmaxf(fmaxf(q[0], q[1]), fmaxf(q[2], q[3])); float s = 0.f;
#pragma unroll
                for (int bj = 0; bj < 2; ++bj)
#pragma unroll
                    for (int n = 0; n < 2; ++n) { f32x4 x = acc[ai][bj][m][n];
#pragma unroll
                        for (int e = 0; e < 4; ++e) { x[e] = fast_exp2(x[e] - mx); s += x[e]; }
                        acc[ai][bj][m][n] = x; }
                s += __shfl_xor(s, 16); s += __shfl_xor(s, 32);
                if (fq == 0) SM[r * 4 + wc] = s; }
        LDS_WAIT(); __builtin_amdgcn_s_barrier(); asm volatile("" ::: "memory");
        const int col0 = wc * 32 + 8 * fq;
#pragma unroll
        for (int ai = 0; ai < 2; ++ai)
#pragma unroll
            for (int m = 0; m < 4; ++m) { const int r = ai * HALF + wr * 64 + m * 16 + fr; const f32x4 q = *(const LAS f32x4*)(SM + r * 4);
                const float inv = fast_rcp((q[0] + q[1]) + (q[2] + q[3]));
#pragma unroll
                for (int bj = 0; bj < 2; ++bj) { const f32x4 v0 = acc[ai][bj][m][0] * inv, v1 = acc[ai][bj][m][1] * inv;
                    u32x4 w; w.x = cvtpk(v0[0], v0[1]); w.y = cvtpk(v0[2], v0[3]); w.z = cvtpk(v1[0], v1[1]); w.w = cvtpk(v1[2], v1[3]);
                    *(u32x4*)(P + (size_t)r * 256 + bj * HALF + col0) = w; } }
        LDS_WAIT(); __builtin_amdgcn_s_barrier(); asm volatile("" ::: "memory");
    }
};
struct EpiW1 {
    static constexpr bool PERM = true, AFTER_DRAIN = false;
    bf16_t* O; const float* ss; const float* b1;
    __device__ __forceinline__ void operator()(const f32x4 (&acc)[2][2][4][2], const Unit& u, int wr, int wc, int fr, int fq) const {
        const int c0 = wc * 32 + 8 * fq;
        const float* bp = b1 + (size_t)u.aux * 2048 + 2 * (u.pn * 128 + c0);
        const f32x4 bq0 = *(const f32x4*)(bp), bq1 = *(const f32x4*)(bp + 4), bq2 = *(const f32x4*)(bp + 8), bq3 = *(const f32x4*)(bp + 12);
        const float bg[8] = {bq0[0], bq0[2], bq1[0], bq1[2], bq2[0], bq2[2], bq3[0], bq3[2]};
        const float bl[8] = {bq0[1], bq0[3], bq1[1], bq1[3], bq2[1], bq2[3], bq3[1], bq3[3]};
#pragma unroll
        for (int ai = 0; ai < 2; ++ai)
#pragma unroll
            for (int m = 0; m < 4; ++m) { const int r = ai * HALF + wr * 64 + m * 16 + fr; const int rr = r < u.nrows ? r : u.nrows - 1; const int tok = u.rows[rr];
                const float sc = __builtin_amdgcn_rsqf(ss[tok] * (1.0f / D) + EPS); float a[8];
#pragma unroll
                for (int j = 0; j < 8; ++j) { const float g = acc[ai][0][m][j >> 2][j & 3] * sc + bg[j], l = acc[ai][1][m][j >> 2][j & 3] * sc + bl[j];
                    const float glu = fminf(g, 7.0f), lin = fminf(fmaxf(l, -7.0f), 7.0f);
                    a[j] = glu * fast_rcp(1.0f + fast_exp2(-1.702f * LOG2E * glu)) * (lin + 1.0f); }
                u32x4 w; w.x = cvtpk(a[0], a[1]); w.y = cvtpk(a[2], a[3]); w.z = cvtpk(a[4], a[5]); w.w = cvtpk(a[6], a[7]);
                *(u32x4*)(O + ((size_t)u.pm * BM + r) * D + u.pn * 128 + c0) = w; }
    }
};
struct EpiW2 {
    static constexpr bool PERM = true, AFTER_DRAIN = false;
    bf16_t* O; const float* b2;
    __device__ __forceinline__ void operator()(const f32x4 (&acc)[2][2][4][2], const Unit& u, int wr, int wc, int fr, int fq) const {
        const int row0 = u.pm * BM + wr * 64 + fr, col0 = u.pn * BM + wc * 32 + 8 * fq;
        f32x4 bv[2][2];
#pragma unroll
        for (int bj = 0; bj < 2; ++bj)
#pragma unroll
            for (int n = 0; n < 2; ++n) bv[bj][n] = *(const f32x4*)(b2 + (size_t)u.aux * D + col0 + bj * HALF + 4 * n);
#pragma unroll
        for (int ai = 0; ai < 2; ++ai)
#pragma unroll
            for (int m = 0; m < 4; ++m) { bf16_t* rowp = O + (size_t)(row0 + ai * HALF + m * 16) * D + col0;
#pragma unroll
                for (int bj = 0; bj < 2; ++bj) { const f32x4 v0 = acc[ai][bj][m][0] + bv[bj][0], v1 = acc[ai][bj][m][1] + bv[bj][1];
                    u32x4 w; w.x = cvtpk(v0[0], v0[1]); w.y = cvtpk(v0[2], v0[3]); w.z = cvtpk(v1[0], v1[1]); w.w = cvtpk(v1[2], v1[3]);
                    *(u32x4*)(rowp + bj * HALF) = w; } }
    }
};
}

namespace moba {
using bf16x8 = ::bf16x8; using s16x4 = ::s16x4; using f32x16 = ::f32x16; using u32x4 = ::u32x4;
constexpr int DMQ = INC, DMO = D, HD = 64;
constexpr int NW = 8, QBLK = 32, QB = 256, KVBLK = 64;
__device__ __forceinline__ int crow(int r, int hi) { return (r & 3) + 8 * (r >> 2) + 4 * hi; }
#define SBAR() __builtin_amdgcn_sched_barrier(0)
__device__ __forceinline__ void cmask(f32x16& p0, f32x16& p1, int jb, int qrel, int hi) {
    const float NEG = -INFINITY; int kb = 64 * jb + 4 * hi;
#pragma unroll
    for (int r = 0; r < 16; ++r) { int kv = kb + (r & 3) + 8 * (r >> 2); if (kv > qrel) p0[r] = NEG; if (kv + 32 > qrel) p1[r] = NEG; }
}
constexpr int NSLOT = 3, SLOTB = 8192;
constexpr int LDS_K = 0, LDS_V = NSLOT * SLOTB, LDS_WS = 2 * NSLOT * SLOTB, LDS_OST = LDS_WS + NW * 64 * 4, LDS_KB = LDS_OST + NW * 4096, LDS_BYTES = LDS_KB + 16 * 64 * 4;
__device__ __forceinline__ void glds16(const void* gsrc, unsigned lds_dst) { unsigned keep;
    asm volatile("s_mov_b32 %0, m0\n\ts_mov_b32 m0, %2\n\ts_nop 0\n\tglobal_load_lds_dwordx4 %1, off\n\ts_mov_b32 m0, %0" : "=&s"(keep) : "v"(gsrc), "s"(lds_dst) : "memory"); }
__device__ __forceinline__ float max3f(float a, float b, float c) { float r; asm("v_max3_f32 %0, %1, %2, %3" : "=v"(r) : "v"(a), "v"(b), "v"(c)); return r; }
__device__ __forceinline__ float max2f(float a, float b) { float r; asm("v_max_f32_e32 %0, %1, %2" : "=v"(r) : "v"(a), "v"(b)); return r; }
__device__ __forceinline__ float fadd_s(float a, float b) { float r; asm("v_add_f32_e32 %0, %1, %2" : "=v"(r) : "v"(a), "v"(b)); return r; }
__device__ __forceinline__ float fsub_s(float a, float b) { float r; asm("v_sub_f32_e32 %0, %1, %2" : "=v"(r) : "v"(a), "v"(b)); return r; }
__device__ __forceinline__ unsigned cvtpk_s(float lo, float hi) { return ::cvtpk(lo, hi); }
#define WAIT_BAR(N) asm volatile("s_waitcnt vmcnt(" #N ") lgkmcnt(0)\n\ts_barrier" ::: "memory")
__device__ __forceinline__ void qkt(f32x16& p0, f32x16& p1, const char* Kslot, const bf16x8* qr, const f32x16& negm, int r32, int hi) {
    const char* kb = Kslot + hi * 1024 + r32 * 16;
#pragma unroll
    for (int d0 = 0; d0 < 4; ++d0) {
        const bf16x8 b0 = *reinterpret_cast<const bf16x8*>(kb + d0 * 2048);
        const bf16x8 b1 = *reinterpret_cast<const bf16x8*>(kb + d0 * 2048 + 512);
        if (d0 == 0) { p0 = __builtin_amdgcn_mfma_f32_32x32x16_bf16(b0, qr[0], negm, 0, 0, 0); p1 = __builtin_amdgcn_mfma_f32_32x32x16_bf16(b1, qr[0], negm, 0, 0, 0); }
        else { p0 = __builtin_amdgcn_mfma_f32_32x32x16_bf16(b0, qr[d0], p0, 0, 0, 0); p1 = __builtin_amdgcn_mfma_f32_32x32x16_bf16(b1, qr[d0], p1, 0, 0, 0); } }
}
typedef __attribute__((address_space(3))) const char* lds_cptr;
typedef short v4i16_t __attribute__((ext_vector_type(4)));
__device__ __forceinline__ void kload8(bf16x8* kf, lds_cptr kp) {
    kf[0] = *(const __attribute__((address_space(3))) bf16x8*)(kp);        kf[1] = *(const __attribute__((address_space(3))) bf16x8*)(kp + 512);
    kf[2] = *(const __attribute__((address_space(3))) bf16x8*)(kp + 2048); kf[3] = *(const __attribute__((address_space(3))) bf16x8*)(kp + 2560);
    kf[4] = *(const __attribute__((address_space(3))) bf16x8*)(kp + 4096); kf[5] = *(const __attribute__((address_space(3))) bf16x8*)(kp + 4608);
    kf[6] = *(const __attribute__((address_space(3))) bf16x8*)(kp + 6144); kf[7] = *(const __attribute__((address_space(3))) bf16x8*)(kp + 6656);
}
__device__ __forceinline__ void kload2(bf16x8* kf, lds_cptr kp, int j) { kf[2 * j] = *(const __attribute__((address_space(3))) bf16x8*)(kp + j * 2048); kf[2 * j + 1] = *(const __attribute__((address_space(3))) bf16x8*)(kp + j * 2048 + 512); }
__device__ __forceinline__ s16x4 vtr(lds_cptr p) { return __builtin_bit_cast(s16x4, __builtin_amdgcn_ds_read_tr16_b64_v4i16((__attribute__((address_space(3))) v4i16_t*)p)); }
__device__ __forceinline__ float rowmax(const f32x16& p0, const f32x16& p1) {
    float a = max3f(p0[0], p0[1], p1[0]), b = max3f(p0[2], p0[3], p1[1]); a = max3f(a, p1[2], p1[3]);
#pragma unroll
    for (int r = 4; r < 16; r += 4) { a = max3f(a, p0[r], p0[r + 1]); b = max3f(b, p0[r + 2], p0[r + 3]); a = max3f(a, p1[r], p1[r + 1]); b = max3f(b, p1[r + 2], p1[r + 3]); }
    const float m = max2f(a, b);
    auto rr = __builtin_amdgcn_permlane32_swap(__float_as_uint(m), __float_as_uint(m), false, false);
    return max2f(__uint_as_float(rr[0]), __uint_as_float(rr[1]));
}
__device__ __forceinline__ void pv(f32x16* o, int vb, bf16x8 pa0, bf16x8 pa1, bf16x8 pa2, bf16x8 pa3) {
#pragma unroll
    for (int d0 = 0; d0 < 2; ++d0) { s16x4 lo[4], hi[4];
#pragma unroll
        for (int ks = 0; ks < 4; ++ks) {
            asm volatile("ds_read_b64_tr_b16 %0,%1 offset:%c2" : "=&v"(lo[ks]) : "v"(vb), "i"(d0 * 4096 + ks * 1024) : "memory");
            asm volatile("ds_read_b64_tr_b16 %0,%1 offset:%c2" : "=&v"(hi[ks]) : "v"(vb), "i"(d0 * 4096 + ks * 1024 + 512) : "memory"); }
        asm volatile("s_waitcnt lgkmcnt(0)" ::: "memory"); SBAR();
#define PK(k) (bf16x8){lo[k][0], lo[k][1], lo[k][2], lo[k][3], hi[k][0], hi[k][1], hi[k][2], hi[k][3]}
        o[d0] = __builtin_amdgcn_mfma_f32_32x32x16_bf16(pa0, PK(0), o[d0], 0, 0, 0);
        o[d0] = __builtin_amdgcn_mfma_f32_32x32x16_bf16(pa1, PK(1), o[d0], 0, 0, 0);
        o[d0] = __builtin_amdgcn_mfma_f32_32x32x16_bf16(pa2, PK(2), o[d0], 0, 0, 0);
        o[d0] = __builtin_amdgcn_mfma_f32_32x32x16_bf16(pa3, PK(3), o[d0], 0, 0, 0);
#undef PK
    }
}
constexpr float NEGBIG = -1.0e30f;

template <int THRL> __device__ __forceinline__ void attn_unit(int b, int h, int qb, const bf16_t* Qg, const bf16_t* __restrict__ Kg, const bf16_t* __restrict__ Vg, bf16_t* Og, const float* __restrict__ kbar, char* shm) {
    int tid_ = threadIdx.x; asm volatile("" : "+v"(tid_));
    const int tid = tid_, lane = tid & 63, r32 = lane & 31, hi = lane >> 5; const int wid = __builtin_amdgcn_readfirstlane(tid >> 6);
    const long rowbase = (long)b * SEQ; const int q0 = qb * QB;
    const bf16_t* Qw = Qg + (rowbase + q0 + wid * QBLK) * DMQ + h * HD;
    const bf16_t* Kh = Kg + rowbase * DMQ + h * HD, *Vh = Vg + rowbase * DMQ + h * HD;
    const unsigned lds0 = (unsigned)(uintptr_t)shm;
    float* wsf = (float*)(shm + LDS_WS) + wid * 64;
    const bf16_t* ksrc = Kh + (long)lane * DMQ + wid * 8;
    const bf16_t* vsrc = Vh + (long)(16 * (wid & 3) + (lane >> 2)) * DMQ + (wid >> 2) * 32 + (lane & 3) * 8;
    const unsigned kdst = lds0 + LDS_K + wid * 1024, vdst = lds0 + LDS_V + wid * 1024;
    const int NT = 4 * qb + 4, NPAST = 4 * qb;
#define TMAP(t) (((t) < 4) ? (NPAST + (t)) : ((t) - 4))
#define DMA_K(t, slot) glds16(ksrc + (long)TMAP(t) * KVBLK * DMQ, (unsigned)__builtin_amdgcn_readfirstlane(kdst + (slot)))
#define DMA_V(t, slot) glds16(vsrc + (long)TMAP(t) * KVBLK * DMQ, (unsigned)__builtin_amdgcn_readfirstlane(vdst + (slot)))
    const char* Kbase = shm + LDS_K; bf16x8 kf[8];
    const lds_cptr shm3 = (lds_cptr)shm; const lds_cptr kp0 = shm3 + LDS_K + hi * 1024 + r32 * 16; const lds_cptr vp0 = shm3 + LDS_V + ((lane >> 4) & 1) * 32 + (lane & 3) * 8 + (4 * hi + ((lane & 15) >> 2)) * 64;
    DMA_K(0, 0); DMA_V(0, 0); DMA_K(1, SLOTB);
    bf16x8 qr[4];
#pragma unroll
    for (int d0 = 0; d0 < 4; ++d0) qr[d0] = *reinterpret_cast<const bf16x8*>(&Qw[(long)r32 * DMQ + d0 * 16 + hi * 8]);
    unsigned selm = 0u;
    if (qb > 0) {
        float* kbl = (float*)(shm + LDS_KB);
        for (int i = tid; i < qb * 64; i += NW * 64) kbl[i] = kbar[((size_t)(b * 16 + (i >> 6)) * 8 + h) * 64 + (i & 63)];
        asm volatile("s_waitcnt vmcnt(0) lgkmcnt(0)\n\ts_barrier" ::: "memory");
        if (qb <= 3) selm = (1u << qb) - 1u;
        else {
            float qf[32];
#pragma unroll
            for (int d0 = 0; d0 < 4; ++d0)
#pragma unroll
                for (int j = 0; j < 8; ++j) qf[d0 * 8 + j] = bf2f((unsigned short)qr[d0][j]);
            float g[15];
#pragma unroll
            for (int n = 0; n < 15; ++n) { float s = 0.f;
                if (n < qb) {
#pragma unroll
                    for (int d0 = 0; d0 < 4; ++d0) { const f32x4 k0 = *(const f32x4*)(kbl + n * 64 + d0 * 16 + hi * 8), k1 = *(const f32x4*)(kbl + n * 64 + d0 * 16 + hi * 8 + 4);
                        s += qf[d0 * 8 + 0] * k0[0] + qf[d0 * 8 + 1] * k0[1] + qf[d0 * 8 + 2] * k0[2] + qf[d0 * 8 + 3] * k0[3] + qf[d0 * 8 + 4] * k1[0] + qf[d0 * 8 + 5] * k1[1] + qf[d0 * 8 + 6] * k1[2] + qf[d0 * 8 + 7] * k1[3]; }
                    s += __shfl_xor(s, 32);
                } else s = -INFINITY;
                g[n] = s; }
#pragma unroll
            for (int pass = 0; pass < 3; ++pass) { float best = -INFINITY; int bi = 0;
#pragma unroll
                for (int n = 0; n < 15; ++n) if (g[n] > best) { best = g[n]; bi = n; }
                selm |= 1u << bi;
#pragma unroll
                for (int n = 0; n < 15; ++n) if (n == bi) g[n] = -INFINITY; }
        }
    }
    float mhat = 0.f, l_reg = 0.f; f32x16 o[2]; o[0] = f32x16{}; o[1] = f32x16{}; f32x16 cini = f32x16{}; asm volatile("" : "+v"(cini));
    const int qrel = wid * QBLK + r32;
#define SETC(t, JB) do { const float cm_ = ((JB >= 0) || ((selm >> (((t) - 4) >> 2)) & 1u)) ? -mhat : NEGBIG; \
      _Pragma("unroll") for (int r = 0; r < 16; ++r) cini[r] = cm_; asm volatile("" : "+v"(cini)); } while (0)
    bool resc = false;
#define START(P0, P1) do { const float rm = rowmax(P0, P1); resc = false; \
    { const float dl = rm; mhat = fadd_s(mhat, dl); \
      _Pragma("unroll") for (int r = 0; r < 16; ++r) { P0[r] = fsub_s(P0[r], dl); P1[r] = fsub_s(P1[r], dl); } } \
    _Pragma("unroll") for (int r = 0; r < 16; ++r) P0[r] = __builtin_amdgcn_exp2f(P0[r]); } while (0)
#define RESC() do { if (resc) { asm volatile("s_waitcnt lgkmcnt(0)" ::: "memory"); \
      _Pragma("unroll") for (int d_ = 0; d_ < 2; ++d_) _Pragma("unroll") for (int r = 0; r < 16; ++r) o[d_][r] *= wsf[crow(r, hi)]; } } while (0)
    f32x16 pA0, pA1, pB0, pB1;
    int sl_prev = 0, sl_cur = 0, sl_next = SLOTB;
#define ROT() do { sl_prev = sl_cur; sl_cur = sl_next; sl_next = (sl_next == (NSLOT - 1) * SLOTB) ? 0 : sl_next + SLOTB; } while (0)
    DMA_K(2, 2 * SLOTB);
    if (qb > 0) { WAIT_BAR(0); } else { WAIT_BAR(3); }
    qkt(pA0, pA1, Kbase, qr, cini, r32, hi); asm volatile("s_nop 15\n\ts_nop 7" : "+v"(pA0), "+v"(pA1)); cmask(pA0, pA1, 0, qrel, hi);
    START(pA0, pA1);
    _Pragma("unroll") for (int r = 0; r < 16; ++r) pA1[r] = __builtin_amdgcn_exp2f(pA1[r]);
    WAIT_BAR(0);
    DMA_K(3, 0); DMA_V(1, SLOTB);
    ROT();
    kload8(kf, kp0 + sl_cur);
    WAIT_BAR(2);
    s16x4 vlo[8], vhi[8]; u32x4 pw0, pw1, pw2, pw3;
#define PKW(P, B) cvtpk_s(P[B], P[B + 1])
#define PAF(k) __builtin_bit_cast(bf16x8, pw##k)
#define VFR(i) (bf16x8){vlo[i][0], vlo[i][1], vlo[i][2], vlo[i][3], vhi[i][0], vhi[i][1], vhi[i][2], vhi[i][3]}
#define PIN(x) asm volatile("" : "+v"(x))
#define MX3(a, b, c) __builtin_fmaxf(__builtin_fmaxf((a), (b)), (c))
#define GAPA(MF, A0, A1, A2, A3, W0, W1, PW) do { MF; sacc += A0; sacc += A1; sacc += A2; sacc += A3; PIN(sacc); W0; W1; PIN(PW); SBAR(); } while (0)
#define EX(v) __builtin_amdgcn_exp2f(v)
#define GAPB(MF, X, B) do { MF; X[B] = EX(X[B]); X[B + 1] = EX(X[B + 1]); X[B + 2] = EX(X[B + 2]); X[B + 3] = EX(X[B + 3]); PIN(X); SBAR(); } while (0)
#define VRD(i) do { vlo[i] = vtr(vp_ + (((i) >> 2) * 4096 + ((i) & 3) * 1024)); vhi[i] = vtr(vp_ + (((i) >> 2) * 4096 + ((i) & 3) * 1024 + 512)); } while (0)
#define KRD(G, j) do { if (G) { kload2(kf, kp0 + sl_next, j); SBAR(); } } while (0)
#define STEP(C0, C1, P0, P1, t, GK, GV, GL, JB) do { SETC(t, JB); SBAR(); \
    const lds_cptr vp_ = vp0 + sl_prev; \
    VRD(0); SBAR(); float sacc = (P0[0] + P0[1]); \
    GAPA(C0 = __builtin_amdgcn_mfma_f32_32x32x16_bf16(kf[0], qr[0], cini, 0, 0, 0), P0[2], P0[3], P0[4], P0[5],     pw0[0] = PKW(P0, 0), pw0[1] = PKW(P0, 2), pw0); \
    VRD(4); SBAR(); GAPA(C1 = __builtin_amdgcn_mfma_f32_32x32x16_bf16(kf[1], qr[0], cini, 0, 0, 0), P0[6], P0[7], P0[8], P0[9],     pw0[2] = PKW(P0, 4), pw0[3] = PKW(P0, 6), pw0); \
    VRD(1); SBAR(); GAPA(C0 = __builtin_amdgcn_mfma_f32_32x32x16_bf16(kf[2], qr[1], C0, 0, 0, 0),   P0[10], P0[11], P0[12], P0[13], pw1[0] = PKW(P0, 8), pw1[1] = PKW(P0, 10), pw1); \
    VRD(5); SBAR(); GAPA(C1 = __builtin_amdgcn_mfma_f32_32x32x16_bf16(kf[3], qr[1], C1, 0, 0, 0),   P0[14], P0[15], P1[0], P1[1],   pw1[2] = PKW(P0, 12), pw1[3] = PKW(P0, 14), pw1); \
    VRD(2); SBAR(); GAPA(C0 = __builtin_amdgcn_mfma_f32_32x32x16_bf16(kf[4], qr[2], C0, 0, 0, 0),   P1[2], P1[3], P1[4], P1[5],     pw2[0] = PKW(P1, 0), pw2[1] = PKW(P1, 2), pw2); \
    VRD(6); SBAR(); GAPA(C1 = __builtin_amdgcn_mfma_f32_32x32x16_bf16(kf[5], qr[2], C1, 0, 0, 0),   P1[6], P1[7], P1[8], P1[9],     pw2[2] = PKW(P1, 4), pw2[3] = PKW(P1, 6), pw2); \
    VRD(3); SBAR(); GAPA(C0 = __builtin_amdgcn_mfma_f32_32x32x16_bf16(kf[6], qr[3], C0, 0, 0, 0),   P1[10], P1[11], P1[12], P1[13], pw3[0] = PKW(P1, 8), pw3[1] = PKW(P1, 10), pw3); \
    VRD(7); SBAR(); GAPA(C1 = __builtin_amdgcn_mfma_f32_32x32x16_bf16(kf[7], qr[3], C1, 0, 0, 0),   P1[14], P1[15], 0.f, 0.f,       pw3[2] = PKW(P1, 12), pw3[3] = PKW(P1, 14), pw3); \
    l_reg += sacc; \
    if (GK) { DMA_K((t) + 3, sl_cur); } if (GV) { DMA_V((t) + 1, sl_next); } \
    if (JB >= 0) cmask(C0, C1, JB, qrel, hi); \
    { float a = MX3(C0[0], C0[1], C1[0]), b_ = MX3(C0[2], C0[3], C1[1]); a = MX3(a, C1[2], C1[3]); \
      _Pragma("unroll") for (int r = 4; r < 16; r += 4) { a = MX3(a, C0[r], C0[r + 1]); b_ = MX3(b_, C0[r + 2], C0[r + 3]); a = MX3(a, C1[r], C1[r + 1]); b_ = MX3(b_, C1[r + 2], C1[r + 3]); } \
      float rm = __builtin_fmaxf(a, b_); { auto rr = __builtin_amdgcn_permlane32_swap(__float_as_uint(rm), __float_as_uint(rm), false, false); rm = __builtin_fmaxf(__uint_as_float(rr[0]), __uint_as_float(rr[1])); } \
      resc = false; \
      if (__builtin_expect(__any(rm > (float)THRL), 0)) { const float dl = __builtin_fmaxf(rm, 0.f); mhat += dl; \
        _Pragma("unroll") for (int r = 0; r < 16; ++r) { C0[r] -= dl; C1[r] -= dl; } \
        const float f = __builtin_amdgcn_exp2f(-dl); l_reg *= f; if (hi == 0) wsf[r32] = f; resc = true; } } \
    SBAR(); \
    GAPB(o[0] = __builtin_amdgcn_mfma_f32_32x32x16_bf16(PAF(0), VFR(0), o[0], 0, 0, 0), C0, 0); \
    GAPB(o[1] = __builtin_amdgcn_mfma_f32_32x32x16_bf16(PAF(0), VFR(4), o[1], 0, 0, 0), C0, 4); \
    KRD(GL, 0); GAPB(o[0] = __builtin_amdgcn_mfma_f32_32x32x16_bf16(PAF(1), VFR(1), o[0], 0, 0, 0), C0, 8); \
    KRD(GL, 1); GAPB(o[1] = __builtin_amdgcn_mfma_f32_32x32x16_bf16(PAF(1), VFR(5), o[1], 0, 0, 0), C0, 12); \
    KRD(GL, 2); GAPB(o[0] = __builtin_amdgcn_mfma_f32_32x32x16_bf16(PAF(2), VFR(2), o[0], 0, 0, 0), C1, 0); \
    KRD(GL, 3); GAPB(o[1] = __builtin_amdgcn_mfma_f32_32x32x16_bf16(PAF(2), VFR(6), o[1], 0, 0, 0), C1, 4); \
    GAPB(o[0] = __builtin_amdgcn_mfma_f32_32x32x16_bf16(PAF(3), VFR(3), o[0], 0, 0, 0), C1, 8); \
    GAPB(o[1] = __builtin_amdgcn_mfma_f32_32x32x16_bf16(PAF(3), VFR(7), o[1], 0, 0, 0), C1, 12); \
    } while (0)
#define ENDW(tt) do { if ((tt) + 3 < NT) { WAIT_BAR(2); } else if ((tt) + 2 < NT) { WAIT_BAR(1); } else { WAIT_BAR(0); } } while (0)
    STEP(pB0, pB1, pA0, pA1, 1, (4 < NT), true, true, 1);   ENDW(1); RESC(); ROT();
    STEP(pA0, pA1, pB0, pB1, 2, (5 < NT), true, true, 2);   ENDW(2); RESC(); ROT();
    STEP(pB0, pB1, pA0, pA1, 3, (6 < NT), (4 < NT), (4 < NT), 3);   ENDW(3); RESC(); ROT();
    for (int t = 4; t < NT; t += 2) {
        STEP(pA0, pA1, pB0, pB1, t, (t + 3 < NT), true, true, -1);                       ENDW(t);     RESC(); ROT();
        STEP(pB0, pB1, pA0, pA1, t + 1, (t + 4 < NT), (t + 2 < NT), (t + 2 < NT), -1);   ENDW(t + 1); RESC(); ROT();
    }
    { float sacc = pB0[0] + pB0[1]; _Pragma("unroll") for (int r = 2; r < 16; ++r) sacc += pB0[r]; _Pragma("unroll") for (int r = 0; r < 16; ++r) sacc += pB1[r]; l_reg += sacc;
      pw0 = (u32x4){PKW(pB0, 0), PKW(pB0, 2), PKW(pB0, 4), PKW(pB0, 6)}; pw1 = (u32x4){PKW(pB0, 8), PKW(pB0, 10), PKW(pB0, 12), PKW(pB0, 14)}; pw2 = (u32x4){PKW(pB1, 0), PKW(pB1, 2), PKW(pB1, 4), PKW(pB1, 6)}; pw3 = (u32x4){PKW(pB1, 8), PKW(pB1, 10), PKW(pB1, 12), PKW(pB1, 14)};
      SBAR(); pv(o, (int)(unsigned long)vp0 + sl_prev, PAF(0), PAF(1), PAF(2), PAF(3)); }
#undef PKW
#undef PAF
#undef VFR
#undef PIN
#undef MX3
#undef GAPA
#undef GAPB
#undef EX
#undef VRD
#undef KRD
#undef STEP
#undef ENDW
    { auto rr = __builtin_amdgcn_permlane32_swap(__float_as_uint(l_reg), __float_as_uint(l_reg), false, false); l_reg = __uint_as_float(rr[0]) + __uint_as_float(rr[1]); }
    if (hi == 0) wsf[32 + r32] = l_reg; asm volatile("s_waitcnt lgkmcnt(0)" ::: "memory");
    float rli[16];
#pragma unroll
    for (int r = 0; r < 16; ++r) rli[r] = __builtin_amdgcn_rcpf(wsf[32 + crow(r, hi)]);
    bf16_t* Ow = Og + (rowbase + q0 + wid * QBLK) * DMO + h * HD;
    { bf16_t* stg = (bf16_t*)(shm + LDS_OST) + wid * 2048;
#pragma unroll
      for (int r = 0; r < 16; ++r) { const int orow = crow(r, hi);
#pragma unroll
        for (int d0 = 0; d0 < 2; ++d0) stg[orow * 64 + d0 * 32 + r32] = (bf16_t)f2bf(o[d0][r] * rli[r]); }
      asm volatile("s_waitcnt lgkmcnt(0)" ::: "memory");
#pragma unroll
      for (int i = 0; i < 4; ++i) { const int row = i * 8 + (lane >> 3), ch = lane & 7; const u32x4 v = *(const u32x4*)(stg + row * 64 + ch * 8); *(u32x4*)(Ow + (long)row * DMO + ch * 8) = v; } }
    asm volatile("s_waitcnt lgkmcnt(0)\n\ts_barrier" ::: "memory");
#undef DMA_K
#undef DMA_V
#undef TMAP
#undef SETC
#undef START
#undef RESC
#undef ROT
}
#undef SBAR
#undef WAIT_BAR
}

namespace hgrn {
constexpr int RS = 144;
constexpr int L_Q = 0, L_K = 9216, L_KT = 18432, L_VT = 27648, L_ST = 36864, L_SEG = 46080, L_DEND = 48128, L_SSQ = 48384, L_BYTES = 48896;
__device__ __forceinline__ int crow(int r, int hi) { return (r & 3) + 8 * (r >> 2) + 4 * hi; }
#define HG_BAR() do { asm volatile("s_waitcnt lgkmcnt(0)" ::: "memory"); __builtin_amdgcn_s_barrier(); asm volatile("" ::: "memory"); } while (0)
__device__ __forceinline__ void hgrn_unit(int b, int h, const bf16_t* __restrict__ proj, bf16_t* __restrict__ mix, const float* __restrict__ lb_logits, const float* __restrict__ norm_g, LAS unsigned char* lds) {
    int tid_ = threadIdx.x; asm volatile("" : "+v"(tid_));
    const int tid = tid_, lane = tid & 63, r32 = lane & 31, hi = lane >> 5; const int w = __builtin_amdgcn_readfirstlane(tid >> 6);
    const float lbk = fast_rcp(1.0f + fast_exp2((lb_logits[512 + h * 64 + lane] - lb_logits[h * 64 + lane]) * LOG2E));
    const int vr = (w >> 1) & 1, tc = w & 1;
    float ng[16];
#pragma unroll
    for (int r = 0; r < 16; ++r) ng[r] = norm_g[h * 64 + 32 * vr + crow(r, hi)];
    f32x16 S = f32x16{};
    for (int i = tid; i < 64 * RS / 4; i += 512) ((LAS unsigned*)(lds + L_ST))[i] = 0u;
    const size_t row00 = (size_t)b * SEQ;
    unsigned short fr[8], qv[8], vv[8];
    { const bf16_t* p = proj + (row00 + 8 * w) * INC + h * 64 + lane;
#pragma unroll
      for (int i = 0; i < 8; ++i) { fr[i] = p[(size_t)i * INC + C_GF]; qv[i] = p[(size_t)i * INC + C_GQ]; vv[i] = p[(size_t)i * INC + C_GI]; } }
    for (int c = 0; c < 64; ++c) {
        const size_t row0 = row00 + (size_t)c * 64;
        u32x2 gg[4];
        if (w < 4) { const bf16_t* gp = proj + (row0 + 32 * tc + r32) * INC + C_GG + h * 64 + 32 * vr + 4 * hi;
#pragma unroll
            for (int g = 0; g < 4; ++g) gg[g] = *(const u32x2*)(gp + 8 * g); }
        float p[8], kk[8];
        { float run = 0.f;
#pragma unroll
          for (int i = 0; i < 8; ++i) { const float x = bf2f(fr[i]); const float sg = fast_rcp(1.0f + fast_exp2(-x * LOG2E)); const float f = lbk + (1.0f - lbk) * sg;
              run += __builtin_amdgcn_logf(f); p[i] = run; kk[i] = 1.0f - f; } }
        ((LAS float*)(lds + L_SEG))[w * 64 + lane] = p[7];
        HG_BAR();
        { float off = 0.f;
#pragma unroll
          for (int j = 0; j < 7; ++j) { const float sv = ((LAS float*)(lds + L_SEG))[j * 64 + lane]; off += (j < w) ? sv : 0.f; }
          unsigned qk[4], kq[4];
#pragma unroll
          for (int i = 0; i < 8; i += 2) { const float b0 = off + p[i], b1 = off + p[i + 1];
              const float q0 = bf2f(qv[i]) * fast_exp2(b0), q1 = bf2f(qv[i + 1]) * fast_exp2(b1), k0 = kk[i] * fast_exp2(-b0), k1 = kk[i + 1] * fast_exp2(-b1);
              const unsigned qq = cvtpk(q0, q1), kw = cvtpk(k0, k1); qk[i >> 1] = qq; kq[i >> 1] = kw;
              *(LAS unsigned short*)(lds + L_Q + (8 * w + i) * RS + lane * 2) = (unsigned short)(qq & 0xffffu);
              *(LAS unsigned short*)(lds + L_Q + (8 * w + i + 1) * RS + lane * 2) = (unsigned short)(qq >> 16);
              *(LAS unsigned short*)(lds + L_K + (8 * w + i) * RS + lane * 2) = (unsigned short)(kw & 0xffffu);
              *(LAS unsigned short*)(lds + L_K + (8 * w + i + 1) * RS + lane * 2) = (unsigned short)(kw >> 16); }
          *(LAS u32x4*)(lds + L_KT + lane * RS + 16 * w) = (u32x4){kq[0], kq[1], kq[2], kq[3]};
          *(LAS u32x4*)(lds + L_VT + lane * RS + 16 * w) = (u32x4){(unsigned)vv[0] | ((unsigned)vv[1] << 16), (unsigned)vv[2] | ((unsigned)vv[3] << 16), (unsigned)vv[4] | ((unsigned)vv[5] << 16), (unsigned)vv[6] | ((unsigned)vv[7] << 16)};
          if (w == 7) ((LAS float*)(lds + L_DEND))[lane] = fast_exp2(off + p[7]); }
        if (c + 1 < 64) { const bf16_t* pp = proj + (row0 + 64 + 8 * w) * INC + h * 64 + lane;
#pragma unroll
            for (int i = 0; i < 8; ++i) { fr[i] = pp[(size_t)i * INC + C_GF]; qv[i] = pp[(size_t)i * INC + C_GQ]; vv[i] = pp[(size_t)i * INC + C_GI]; } }
        HG_BAR();
        f32x16 OT = f32x16{};
        if (w < 4) {
            bf16x8 bq[4];
#pragma unroll
            for (int ks = 0; ks < 4; ++ks) bq[ks] = *(const LAS bf16x8*)(lds + L_Q + (32 * tc + r32) * RS + (16 * ks + 8 * hi) * 2);
#pragma unroll
            for (int sr = 0; sr < 2; ++sr) if (sr <= tc) {
                f32x16 at = f32x16{};
#pragma unroll
                for (int ks = 0; ks < 4; ++ks) { const bf16x8 a = *(const LAS bf16x8*)(lds + L_K + (32 * sr + r32) * RS + (16 * ks + 8 * hi) * 2); at = __builtin_amdgcn_mfma_f32_32x32x16_bf16(a, bq[ks], at, 0, 0, 0); }
                if (sr == tc) {
#pragma unroll
                    for (int r = 0; r < 16; ++r) at[r] = (crow(r, hi) <= r32) ? at[r] : 0.f; }
#pragma unroll
                for (int st = 0; st < 2; ++st) {
                    u32x4 bw; bw.x = cvtpk(at[8 * st + 0], at[8 * st + 1]); bw.y = cvtpk(at[8 * st + 2], at[8 * st + 3]); bw.z = cvtpk(at[8 * st + 4], at[8 * st + 5]); bw.w = cvtpk(at[8 * st + 6], at[8 * st + 7]);
                    const u32x2 lo = *(const LAS u32x2*)(lds + L_VT + (32 * vr + r32) * RS + (32 * sr + 16 * st + 4 * hi) * 2);
                    const u32x2 hh = *(const LAS u32x2*)(lds + L_VT + (32 * vr + r32) * RS + (32 * sr + 16 * st + 8 + 4 * hi) * 2);
                    const u32x4 aw = (u32x4){lo.x, lo.y, hh.x, hh.y};
                    OT = __builtin_amdgcn_mfma_f32_32x32x16_bf16(__builtin_bit_cast(bf16x8, aw), __builtin_bit_cast(bf16x8, bw), OT, 0, 0, 0); }
            }
#pragma unroll
            for (int ks = 0; ks < 4; ++ks) { const bf16x8 a = *(const LAS bf16x8*)(lds + L_ST + (32 * vr + r32) * RS + (16 * ks + 8 * hi) * 2); OT = __builtin_amdgcn_mfma_f32_32x32x16_bf16(a, bq[ks], OT, 0, 0, 0); }
            float sq = 0.f;
#pragma unroll
            for (int r = 0; r < 16; ++r) sq += OT[r] * OT[r];
            sq += __shfl_xor(sq, 32);
            if (hi == 0) ((LAS float*)(lds + L_SSQ))[vr * 64 + 32 * tc + r32] = sq;
        } else {
#pragma unroll
            for (int st = 0; st < 4; ++st) { const bf16x8 a = *(const LAS bf16x8*)(lds + L_KT + (32 * vr + r32) * RS + (16 * st + 8 * hi) * 2);
                const bf16x8 bv = *(const LAS bf16x8*)(lds + L_VT + (32 * tc + r32) * RS + (16 * st + 8 * hi) * 2);
                S = __builtin_amdgcn_mfma_f32_32x32x16_bf16(a, bv, S, 0, 0, 0); }
#pragma unroll
            for (int r = 0; r < 16; ++r) S[r] *= ((LAS float*)(lds + L_DEND))[32 * vr + crow(r, hi)];
        }
        HG_BAR();
        if (w < 4) {
            const int t = 32 * tc + r32;
            const float tot = ((LAS float*)(lds + L_SSQ))[t] + ((LAS float*)(lds + L_SSQ))[64 + t];
            const float rstd = __builtin_amdgcn_rsqf(tot * (1.0f / 64.0f) + EPS);
            bf16_t* op = mix + (row0 + t) * D + 512 + h * 64 + 32 * vr + 4 * hi;
#pragma unroll
            for (int g = 0; g < 4; ++g) { const float y0 = OT[4 * g + 0] * rstd * ng[4 * g + 0] * bflo(gg[g].x), y1 = OT[4 * g + 1] * rstd * ng[4 * g + 1] * bfhi(gg[g].x),
                                                      y2 = OT[4 * g + 2] * rstd * ng[4 * g + 2] * bflo(gg[g].y), y3 = OT[4 * g + 3] * rstd * ng[4 * g + 3] * bfhi(gg[g].y);
                *(u32x2*)(op + 8 * g) = (u32x2){cvtpk(y0, y1), cvtpk(y2, y3)}; }
        } else {
#pragma unroll
            for (int g = 0; g < 4; ++g) *(LAS u32x2*)(lds + L_ST + (32 * tc + r32) * RS + (32 * vr + 8 * g + 4 * hi) * 2) = (u32x2){cvtpk(S[4 * g + 0], S[4 * g + 1]), cvtpk(S[4 * g + 2], S[4 * g + 3])};
        }
    }
    HG_BAR();
}
#undef HG_BAR
}

constexpr int NWAVES = 8;
constexpr int LDS_BYTES = 147456;
constexpr int TAIL = 131072;
constexpr int TL_TE = TAIL, TL_TS = TAIL + 576, TL_HIST = TAIL + 768, TL_BASE = TAIL + 896, TL_MISC = TAIL + 1024;
typedef GAS unsigned gu32;

struct Args { const float* in[20]; float* out; unsigned char* ws; int ph_lo, ph_hi; };

struct Frame {
    LAS unsigned char* lds; volatile LAS unsigned* MISC; unsigned* ctl;
    int tid, lane, wave, G, vcu;
};

template <int MODE> __device__ __forceinline__ void p0_transpose_item(const float* __restrict__ W, int K, int N, bf16_t* __restrict__ WT, const float* __restrict__ gain, LAS float* scr, int item, int lane) {
    const int nblk = N / 32, kb = item / nblk, nb = item % nblk, k0 = 64 * kb, n0 = 32 * nb;
#pragma unroll 8
    for (int i = 0; i < 32; ++i) { const int kk = 2 * i + (lane >> 5); float v = W[(size_t)(k0 + kk) * N + n0 + (lane & 31)]; if (gain) v *= gain[k0 + kk]; scr[kk * 33 + (lane & 31)] = v; }
    LDS_WAIT(); asm volatile("" ::: "memory");
    const int c = lane & 7;
#pragma unroll
    for (int j = 0; j < 4; ++j) { const int n = (lane >> 3) + 8 * j; const LAS float* s = scr + (8 * c) * 33 + n;
        u32x4 o; o.x = pk2(s[0 * 33], s[1 * 33]); o.y = pk2(s[2 * 33], s[3 * 33]); o.z = pk2(s[4 * 33], s[5 * 33]); o.w = pk2(s[6 * 33], s[7 * 33]);
        int row = n0 + n; if (MODE == 1) { const int jj = row >> 1, bj = row & 1; row = (jj >> 7) * 256 + bj * 128 + (jj & 127); }
        *(u32x4*)(WT + (size_t)row * K + k0 + 8 * c) = o; }
    LDS_WAIT(); asm volatile("" ::: "memory");
}
__device__ __forceinline__ void rms_row_to_bf16(const float* __restrict__ xrow, const float* __restrict__ g, bf16_t* __restrict__ orow, int lane) {
    const f32x4* xr = (const f32x4*)xrow + lane; const f32x4* gr = (const f32x4*)g + lane;
    f32x4 v[4]; float s = 0.f;
#pragma unroll
    for (int j = 0; j < 4; ++j) { v[j] = xr[64 * j]; s += (v[j].x * v[j].x + v[j].y * v[j].y) + (v[j].z * v[j].z + v[j].w * v[j].w); }
    const float rstd = 1.0f / sqrtf(wave_sum(s) * (1.0f / D) + EPS);
    unsigned long long* o8 = (unsigned long long*)orow + lane;
#pragma unroll
    for (int j = 0; j < 4; ++j) { const f32x4 gg = gr[64 * j];
        o8[64 * j] = (unsigned long long)pk2(v[j].x * rstd * gg.x, v[j].y * rstd * gg.y) | ((unsigned long long)pk2(v[j].z * rstd * gg.z, v[j].w * rstd * gg.w) << 32); }
}

__device__ __forceinline__ void p0_prologue(Frame& F, const Args& a) {
    unsigned char* ws = a.ws;
    LAS float* scr = (LAS float*)(F.lds + F.wave * 16384);
    const int gw = F.vcu * NWAVES + F.wave, NGW = F.G * NWAVES;
    constexpr int I_IN = 16 * 112, I_SQ = 16 * 32, I_KV = 16 * 64, I_W1 = 16 * 64, I_W2 = 16 * 32;
    constexpr int NITEMS = I_IN + 3 * I_SQ + I_KV + NEXP * (I_W1 + I_W2);
    for (int it = gw; it < NITEMS; it += NGW) {
        int r = it;
        if (r < I_IN) { p0_transpose_item<0>(a.in[3], D, INC, (bf16_t*)(ws + WS_WIN), nullptr, scr, r, F.lane); continue; } r -= I_IN;
        if (r < I_SQ) { p0_transpose_item<0>(a.in[6], D, D, (bf16_t*)(ws + WS_WOUT), nullptr, scr, r, F.lane); continue; } r -= I_SQ;
        if (r < I_SQ) { p0_transpose_item<0>(a.in[9], D, D, (bf16_t*)(ws + WS_WQ), a.in[7], scr, r, F.lane); continue; } r -= I_SQ;
        if (r < I_KV) { p0_transpose_item<0>(a.in[10], D, 2 * D, (bf16_t*)(ws + WS_WKV), nullptr, scr, r, F.lane); continue; } r -= I_KV;
        if (r < I_SQ) { p0_transpose_item<0>(a.in[11], D, D, (bf16_t*)(ws + WS_WO), nullptr, scr, r, F.lane); continue; } r -= I_SQ;
        if (r < NEXP * I_W1) { const int e = r / I_W1; p0_transpose_item<1>(a.in[15] + (size_t)e * D * 2048, D, 2048, (bf16_t*)(ws + WS_W1) + (size_t)e * 2048 * D, a.in[12], scr, r % I_W1, F.lane); continue; } r -= NEXP * I_W1;
        { const int e = r / I_W2; p0_transpose_item<0>(a.in[17] + (size_t)e * D * D, D, D, (bf16_t*)(ws + WS_W2) + (size_t)e * D * D, nullptr, scr, r % I_W2, F.lane); }
    }
    for (int i = (F.vcu * NWAVES + F.wave) * 64 + F.lane; i < NEXP * D; i += NGW * 64) { const int e = i >> 10, k = i & 1023; ((float*)(ws + WS_WRT))[i] = a.in[12][k] * a.in[13][k * NEXP + e]; }
    for (int m = gw; m < T; m += NGW) rms_row_to_bf16(a.in[0] + (size_t)m * D, a.in[2], (bf16_t*)(ws + WS_XN) + (size_t)m * D, F.lane);
    for (int m = gw; m < MROWS; m += NGW) rms_row_to_bf16(a.in[1] + (size_t)m * D, a.in[8], (bf16_t*)(ws + WS_MN) + (size_t)m * D, F.lane);
}

__device__ __forceinline__ unsigned xcc_id() { return (unsigned)__builtin_amdgcn_s_getreg((3 << 11) | 20) & 0xFu; }
constexpr int QITEMS = 8 + 128;
__device__ __forceinline__ void p2_mixer(Frame& F, const Args& a, int rep) {
    unsigned char* ws = a.ws;
    const bf16_t* proj = (const bf16_t*)(ws + WS_PROJ); bf16_t* mix = (bf16_t*)(ws + WS_MIX);
    const unsigned x0 = xcc_id() & 7u;
    int par = 0;
    for (;;) {
        if (F.tid == 0) { int code = -1;
            for (int j = 0; j < 8; ++j) { const unsigned xq = (x0 + j) & 7u; const unsigned i = __hip_atomic_fetch_add(F.ctl + CW_QUEUE + 1024 * rep + 64 * xq, 1u, RLX_AGENT);
                if (i < (unsigned)QITEMS) { code = (int)(xq * 256u + i); break; } }
            F.MISC[par] = (unsigned)code; }
        LDS_WAIT(); __builtin_amdgcn_s_barrier(); asm volatile("" ::: "memory");
        const int code = __builtin_amdgcn_readfirstlane((int)F.MISC[par]); par ^= 1;
        if (code < 0) break;
        const int xq = code >> 8, i = code & 255;
#ifndef NO_HGRN
        if (i < 8) { const int bh = xq + 8 * i; hgrn::hgrn_unit(bh >> 3, bh & 7, proj, mix, a.in[4], a.in[5], F.lds); }
        else
#endif
#ifndef NO_MOBA
        { const int j = i - 8, bh = xq + 8 * (j & 7), qb = 15 - (j >> 3);
            moba::attn_unit<8>(bh >> 3, bh & 7, qb, proj + C_MQ, proj + C_MK, proj + C_MV, mix, (const float*)(ws + WS_KBAR), (char*)(unsigned char*)F.lds); }
#else
        {}
#endif
    }
}

__device__ __forceinline__ void p7_router(Frame& F, const Args& a, int rep) {
    unsigned char* ws = a.ws;
    LAS float* WR = (LAS float*)F.lds;
    LAS int* hist = (LAS int*)(F.lds + TL_HIST); LAS int* basel = (LAS int*)(F.lds + TL_BASE);
    const float* wrt = (const float*)(ws + WS_WRT);
    for (int i = F.tid; i < NEXP * D / 4; i += 512) ((LAS f32x4*)WR)[i] = ((const f32x4*)wrt)[i];
    const float* h2f = (const float*)(ws + WS_H2F); const float* ss2 = (const float*)(ws + WS_SS2);
    int* toke = (int*)(ws + (rep ? WS_DUMMY + 1 * MiB : WS_TOKE)); int* tokr = (int*)(ws + (rep ? WS_DUMMY + 1 * MiB + 512 * 1024 : WS_TOKR)); float* tokg = (float*)(ws + (rep ? WS_DUMMY + 2 * MiB : WS_TOKG)); int* list = (int*)(ws + (rep ? WS_DUMMY + 4 * MiB : WS_LIST));
    unsigned* cntw = F.ctl + (rep ? CW_CNT + 2048 * rep : CW_CNT);
    const int lane = F.lane;
    const float brl = a.in[14][lane >> 1];
    for (int tb = blockIdx.x; tb < T / 128; tb += F.G) {
        if (F.tid < 32) hist[F.tid] = 0;
        LDS_WAIT(); __builtin_amdgcn_s_barrier(); asm volatile("" ::: "memory");
        int my_e = 0; float my_g = 0.f;
        for (int i = 0; i < 16; ++i) {
            const int t = tb * 128 + F.wave * 16 + i;
            f32x4 x[4];
#pragma unroll
            for (int j = 0; j < 4; ++j) x[j] = *(const f32x4*)(h2f + (size_t)t * D + 4 * lane + 256 * j);
            float v16[16], v8[8], v4[4], v2[2];
            { const bool up = (lane & 32) != 0;
#pragma unroll
              for (int e = 0; e < 16; ++e) { float s0 = 0.f, s1 = 0.f;
#pragma unroll
                  for (int j = 0; j < 4; ++j) { const f32x4 w0 = *(const LAS f32x4*)(WR + e * D + 4 * lane + 256 * j), w1 = *(const LAS f32x4*)(WR + (16 + e) * D + 4 * lane + 256 * j);
                      s0 += (x[j].x * w0.x + x[j].y * w0.y) + (x[j].z * w0.z + x[j].w * w0.w); s1 += (x[j].x * w1.x + x[j].y * w1.y) + (x[j].z * w1.z + x[j].w * w1.w); }
                  const float send = up ? s0 : s1, keep = up ? s1 : s0; v16[e] = keep + __shfl_xor(send, 32);
                  asm volatile("" ::: "memory"); } }
            { const bool up = (lane & 16) != 0;
#pragma unroll
              for (int e = 0; e < 8; ++e) { const float send = up ? v16[e] : v16[8 + e], keep = up ? v16[8 + e] : v16[e]; v8[e] = keep + __shfl_xor(send, 16); } }
            { const bool up = (lane & 8) != 0;
#pragma unroll
              for (int e = 0; e < 4; ++e) { const float send = up ? v8[e] : v8[4 + e], keep = up ? v8[4 + e] : v8[e]; v4[e] = keep + __shfl_xor(send, 8); } }
            { const bool up = (lane & 4) != 0;
#pragma unroll
              for (int e = 0; e < 2; ++e) { const float send = up ? v4[e] : v4[2 + e], keep = up ? v4[2 + e] : v4[e]; v2[e] = keep + __shfl_xor(send, 4); } }
            float v1; { const bool up = (lane & 2) != 0; const float send = up ? v2[0] : v2[1], keep = up ? v2[1] : v2[0]; v1 = keep + __shfl_xor(send, 2); }
            v1 += __shfl_xor(v1, 1);
            float cur = v1 * __builtin_amdgcn_rsqf(ss2[t] * (1.0f / D) + EPS) + brl;
            float tv[4]; int te_[4];
#pragma unroll
            for (int k = 0; k < 4; ++k) { float m = cur;
#pragma unroll
                for (int o = 1; o < 64; o <<= 1) m = fmaxf(m, __shfl_xor(m, o));
                const unsigned long long bal = __ballot(cur == m); const int li = __builtin_ctzll(bal); const int e = li >> 1;
                tv[k] = m; te_[k] = e; if ((lane >> 1) == e) cur = -INFINITY; }
            const float d1 = fast_exp2((tv[1] - tv[0]) * LOG2E), d2 = fast_exp2((tv[2] - tv[0]) * LOG2E), d3 = fast_exp2((tv[3] - tv[0]) * LOG2E);
            const float inv = 1.0f / (1.0f + d1 + d2 + d3);
            if ((lane >> 2) == i) { const int k = lane & 3; my_e = k == 0 ? te_[0] : (k == 1 ? te_[1] : (k == 2 ? te_[2] : te_[3])); my_g = (k == 0 ? 1.0f : (k == 1 ? d1 : (k == 2 ? d2 : d3))) * inv; }
        }
        const int rl = __hip_atomic_fetch_add(hist + my_e, 1, __ATOMIC_RELAXED, __HIP_MEMORY_SCOPE_WORKGROUP);
        LDS_WAIT(); __builtin_amdgcn_s_barrier(); asm volatile("" ::: "memory");
        if (F.tid < 32) basel[F.tid] = (int)__hip_atomic_fetch_add(cntw + F.tid, (unsigned)hist[F.tid], RLX_AGENT);
        LDS_WAIT(); VM_WAIT(); __builtin_amdgcn_s_barrier(); asm volatile("" ::: "memory");
        { const int t = tb * 128 + F.wave * 16 + (lane >> 2), k = lane & 3; const int rank = basel[my_e] + rl;
          toke[t * 4 + k] = my_e; tokr[t * 4 + k] = rank; tokg[t * 4 + k] = my_g; list[(size_t)my_e * T + rank] = t; }
        LDS_WAIT(); __builtin_amdgcn_s_barrier(); asm volatile("" ::: "memory");
    }
}

__device__ __forceinline__ int build_tables(Frame& F) {
    LAS int* ts = (LAS int*)(F.lds + TL_TS); LAS unsigned char* te = (LAS unsigned char*)(F.lds + TL_TE);
    if (F.tid == 0) { int run = 0;
        for (int e = 0; e < NEXP; ++e) { ts[e] = run; const unsigned c = __hip_atomic_load(F.ctl + CW_CNT + e, RLX_AGENT); run += (int)((c + 255u) >> 8); }
        ts[NEXP] = run; }
    LDS_WAIT(); __builtin_amdgcn_s_barrier(); asm volatile("" ::: "memory");
    const int nt = ts[NEXP];
    for (int g = F.tid; g < nt; g += 512) { int e = 0;
        for (int j = 1; j < NEXP; ++j) e += (ts[j] <= g) ? 1 : 0;
        te[g] = (unsigned char)e; }
    LDS_WAIT(); __builtin_amdgcn_s_barrier(); asm volatile("" ::: "memory");
    return __builtin_amdgcn_readfirstlane(nt);
}

__device__ __forceinline__ void p10_combine(Frame& F, const Args& a) {
    unsigned char* ws = a.ws;
    LAS int* ts = (LAS int*)(F.lds + TL_TS);
    const float* h2f = (const float*)(ws + WS_H2F); const bf16_t* Y = (const bf16_t*)(ws + WS_Y);
    const int* toke = (const int*)(ws + WS_TOKE); const int* tokr = (const int*)(ws + WS_TOKR); const float* tokg = (const float*)(ws + WS_TOKG);
    const float* gf = a.in[19];
    const int gw = F.vcu * NWAVES + F.wave, NGW = F.G * NWAVES, lane = F.lane;
    for (int t = gw; t < T; t += NGW) {
        float o[16];
        { const f32x4 a0 = *(const f32x4*)(h2f + (size_t)t * D + 8 * lane), a1 = *(const f32x4*)(h2f + (size_t)t * D + 8 * lane + 4), a2 = *(const f32x4*)(h2f + (size_t)t * D + 512 + 8 * lane), a3 = *(const f32x4*)(h2f + (size_t)t * D + 512 + 8 * lane + 4);
          o[0] = a0.x; o[1] = a0.y; o[2] = a0.z; o[3] = a0.w; o[4] = a1.x; o[5] = a1.y; o[6] = a1.z; o[7] = a1.w; o[8] = a2.x; o[9] = a2.y; o[10] = a2.z; o[11] = a2.w; o[12] = a3.x; o[13] = a3.y; o[14] = a3.z; o[15] = a3.w; }
#pragma unroll
        for (int k = 0; k < 4; ++k) { const int e = toke[t * 4 + k], r = tokr[t * 4 + k]; const float g = tokg[t * 4 + k];
            const bf16_t* yr = Y + ((size_t)ts[e] * 256 + r) * D;
            const u32x4 y0 = *(const u32x4*)(yr + 8 * lane), y1 = *(const u32x4*)(yr + 512 + 8 * lane);
            o[0] += g * bflo(y0.x); o[1] += g * bfhi(y0.x); o[2] += g * bflo(y0.y); o[3] += g * bfhi(y0.y); o[4] += g * bflo(y0.z); o[5] += g * bfhi(y0.z); o[6] += g * bflo(y0.w); o[7] += g * bfhi(y0.w);
            o[8] += g * bflo(y1.x); o[9] += g * bfhi(y1.x); o[10] += g * bflo(y1.y); o[11] += g * bfhi(y1.y); o[12] += g * bflo(y1.z); o[13] += g * bfhi(y1.z); o[14] += g * bflo(y1.w); o[15] += g * bfhi(y1.w); }
        float s = 0.f;
#pragma unroll
        for (int j = 0; j < 16; ++j) s += o[j] * o[j];
        const float rstd = 1.0f / sqrtf(wave_sum(s) * (1.0f / D) + EPS);
        float* op = a.out + (size_t)t * D;
#pragma unroll
        for (int q = 0; q < 4; ++q) { const int col = (q >> 1) * 512 + 8 * lane + (q & 1) * 4; const f32x4 g4 = *(const f32x4*)(gf + col);
            *(f32x4*)(op + col) = (f32x4){o[4 * q] * rstd * g4.x, o[4 * q + 1] * rstd * g4.y, o[4 * q + 2] * rstd * g4.z, o[4 * q + 3] * rstd * g4.w}; }
    }
}

#define XB_TMO      128
#define XB_XCNT(j)  (256  + 64 * (j))
#define XB_XSUB(j)  (1280 + 64 * (j))
#define XB_XGEN(j)  (2304 + 64 * (j))
#define XB_TOP      3328
#define XB_TOPGEN   3392
#define XCD_BAR_WORDS 3456
#define XB_SPIN_CAP (1u << 22)
__device__ __forceinline__ unsigned xb_ld(unsigned* p)              { return __hip_atomic_load(p, __ATOMIC_RELAXED, __HIP_MEMORY_SCOPE_AGENT); }
__device__ __forceinline__ unsigned xb_add(unsigned* p, unsigned v) { return __hip_atomic_fetch_add(p, v, __ATOMIC_RELAXED, __HIP_MEMORY_SCOPE_AGENT); }
#define XB_SPIN(cond, bar) do { unsigned _sp = 0; while (cond) { __builtin_amdgcn_s_sleep(1); \
    if ((++_sp & 255u) == 0u) { if (xb_ld(&(bar)[XB_TMO])) break; if (_sp > XB_SPIN_CAP) { atomicAdd(&(bar)[XB_TMO], 1u); break; } } } } while (0)
struct XcdBarrier { unsigned* bar; unsigned x; volatile LAS unsigned* st; };
__device__ __forceinline__ XcdBarrier xcd_barrier_post(unsigned* bar, volatile LAS unsigned* st) {
    XcdBarrier b; b.bar = bar; b.x = (unsigned)__builtin_amdgcn_s_getreg((3 << 11) | 20) & 0xFu; b.st = st;
    if (threadIdx.x == 0) (void)xb_add(&bar[XB_XCNT(b.x)], 1u);
    return b;
}
__device__ __forceinline__ void xcd_barrier_complete(unsigned* bar, unsigned x, unsigned& nloc, unsigned& nx) {
    const unsigned G = gridDim.x * gridDim.y * gridDim.z;
    unsigned sum, cnt, mine, sp = 0u;
    for (;;) {
        sum = 0u; cnt = 0u; mine = 0u;
#pragma unroll
        for (unsigned j = 0; j < 16; ++j) { const unsigned c = xb_ld(&bar[XB_XCNT(j)]); sum += c; cnt += (c > 0u) ? 1u : 0u; mine = (j == x) ? c : mine; }
        if (sum == G) break;
        __builtin_amdgcn_s_sleep(1);
        if ((++sp & 255u) == 0u) { if (xb_ld(&bar[XB_TMO])) break; if (sp > XB_SPIN_CAP) { atomicAdd(&bar[XB_TMO], 1u); break; } }
    }
    nloc = mine > 0u ? mine : 1u; nx = cnt > 0u ? cnt : 1u;
}
__device__ __forceinline__ void xcd_barrier(const XcdBarrier& b) {
    asm volatile("s_waitcnt vmcnt(0)" ::: "memory");
    __syncthreads();
    if (threadIdx.x == 0) {
        unsigned* bar = b.bar;
        __builtin_amdgcn_s_waitcnt(0);
        unsigned nloc = b.st[0], nx = b.st[1];
        if (nloc == 0u) { xcd_barrier_complete(bar, b.x, nloc, nx); b.st[0] = nloc; b.st[1] = nx; }
        const unsigned old = xb_add(&bar[XB_XSUB(b.x)], 1u);
        const unsigned gen = old / nloc;
        if (old + 1u == (gen + 1u) * nloc) {
            __builtin_amdgcn_fence(__ATOMIC_RELEASE, "agent");
            asm volatile("s_waitcnt vmcnt(0)" ::: "memory");
            const unsigned og = xb_add(&bar[XB_TOP], 1u);
            const unsigned tg = og / nx;
            if (og + 1u == (tg + 1u) * nx) xb_add(&bar[XB_TOPGEN], 1u);
            else XB_SPIN(xb_ld(&bar[XB_TOPGEN]) == tg, bar);
            __builtin_amdgcn_fence(__ATOMIC_ACQUIRE, "agent");
            xb_add(&bar[XB_XGEN(b.x)], 1u);
            asm volatile("s_waitcnt vmcnt(0)" ::: "memory");
        } else {
            XB_SPIN(xb_ld(&bar[XB_XGEN(b.x)]) == gen, bar);
            __builtin_amdgcn_fence(__ATOMIC_ACQUIRE, "agent");
            asm volatile("s_waitcnt vmcnt(0)" ::: "memory");
        }
    }
    __syncthreads();
}
#ifndef MK_CG_ONLY
#define MK_CG_ONLY 0
#endif
__device__ __forceinline__ void grid_barrier(Frame& F, const XcdBarrier& xb_) { if (MK_CG_ONLY) cg::this_grid().sync(); else xcd_barrier(xb_); }
#ifndef MK_PHASE_MASK
#define MK_PHASE_MASK 0x7ff
#endif
#ifndef MK_REP_PHASE
#define MK_REP_PHASE -1
#endif
#ifndef MK_REP_N
#define MK_REP_N 0
#endif
__device__ __forceinline__ void ph0(Frame& F, const Args& args, int rep) { p0_prologue(F, args); }
__device__ __forceinline__ void ph1(Frame& F, const Args& args, int rep) {
    unsigned char* ws = args.ws; const int cid = (int)blockIdx.x;
    { pg8::DenseOrder S{(const char*)(ws + WS_XN), (const char*)(ws + WS_WIN), D, D, T / 256, INC / 256, F.G, cid};
      pg8::EpiProj E{(bf16_t*)(ws + WS_PROJ), rep ? (float*)(ws + WS_DUMMY) : (float*)(ws + WS_KBAR)};
      pg8::gemm_phase<pg8::EpiProj, pg8::DenseOrder, false, true>(F.lds, D, D, D / 64, S, E); }
    { pg8::KvOrder S{(const char*)(ws + WS_MN), (const char*)(ws + WS_WKV), F.G, cid};
      pg8::EpiBf16 E{(bf16_t*)(ws + WS_MEMK), D, (bf16_t*)(ws + WS_MEMVT), MROWS};
      pg8::gemm_phase<pg8::EpiBf16, pg8::KvOrder, false, true>(F.lds, D, D, D / 64, S, E); }
}
__device__ __forceinline__ void ph2(Frame& F, const Args& args, int rep) { p2_mixer(F, args, rep); }
__device__ __forceinline__ void ph3(Frame& F, const Args& args, int rep) {
    unsigned char* ws = args.ws; const int cid = (int)blockIdx.x;
    pg8::DenseOrder S{(const char*)(ws + WS_MIX), (const char*)(ws + WS_WOUT), D, D, T / 256, D / 256, F.G, cid};
    pg8::EpiRes<true, false> E{(const void*)args.in[0], (bf16_t*)(ws + WS_H1B), nullptr, rep ? (float*)(ws + WS_DUMMY + 512 * 1024) : (float*)(ws + WS_SS1)};
    pg8::gemm_phase<pg8::EpiRes<true, false>, pg8::DenseOrder, false, true>(F.lds, D, D, D / 64, S, E);
}
__device__ __forceinline__ void ph4(Frame& F, const Args& args, int rep) {
    unsigned char* ws = args.ws; const int cid = (int)blockIdx.x;
    pg8::DenseOrder S{(const char*)(ws + WS_H1B), (const char*)(ws + WS_WQ), D, D, T / 256, D / 256, F.G, cid};
    pg8::EpiQ E{(bf16_t*)(ws + WS_QX), (const float*)(ws + WS_SS1)};
    pg8::gemm_phase<pg8::EpiQ, pg8::DenseOrder, false, true>(F.lds, D, D, D / 64, S, E);
}
__device__ __forceinline__ void ph5(Frame& F, const Args& args, int rep) {
    unsigned char* ws = args.ws; const int cid = (int)blockIdx.x;
    bf16_t* pw = (bf16_t*)(ws + WS_PWS) + (size_t)cid * 2 * 65536;
    for (int s = 0; s < 2; ++s) {
        pg8::XaScoreOrder S{(const char*)(ws + WS_QX), (const char*)(ws + WS_MEMK), cid + s * F.G};
        pg8::EpiSoftmax E{pw + (size_t)s * 65536};
        pg8::gemm_phase<pg8::EpiSoftmax, pg8::XaScoreOrder, false, false>(F.lds, D, D, 4, S, E);
    }
    VM_WAIT(); __syncthreads(); __builtin_amdgcn_fence(__ATOMIC_ACQUIRE, "agent"); __syncthreads();
    { pg8::XaPvOrder S{(const char*)pw, (const char*)(ws + WS_MEMVT), F.G, cid};
      pg8::EpiBf16 E{(bf16_t*)(ws + WS_OX), D, (bf16_t*)(ws + WS_OX), D};
      pg8::gemm_phase<pg8::EpiBf16, pg8::XaPvOrder, false, true>(F.lds, 256, MROWS, 4, S, E); }
}
__device__ __forceinline__ void ph6(Frame& F, const Args& args, int rep) {
    unsigned char* ws = args.ws; const int cid = (int)blockIdx.x;
    pg8::DenseOrder S{(const char*)(ws + WS_OX), (const char*)(ws + WS_WO), D, D, T / 256, D / 256, F.G, cid};
    pg8::EpiRes<false, true> E{(const void*)(ws + WS_H1B), (bf16_t*)(ws + WS_H2B), (float*)(ws + WS_H2F), rep ? (float*)(ws + WS_DUMMY + 512 * 1024) : (float*)(ws + WS_SS2)};
    pg8::gemm_phase<pg8::EpiRes<false, true>, pg8::DenseOrder, false, true>(F.lds, D, D, D / 64, S, E);
}
__device__ __forceinline__ void ph7(Frame& F, const Args& args, int rep) { p7_router(F, args, rep); }
__device__ __forceinline__ void ph8(Frame& F, const Args& args, int rep) {
    unsigned char* ws = args.ws; const int cid = (int)blockIdx.x;
    const int ntl = build_tables(F);
    pg8::MoeOrder S{(const char*)(ws + WS_H2B), (const char*)(ws + WS_W1), (const int*)(ws + WS_LIST), F.ctl + CW_CNT, (const LAS unsigned char*)(F.lds + TL_TE), (const LAS int*)(F.lds + TL_TS),
                    ntl, 8, F.G, cid, (size_t)2048 * D * 2, 1};
    pg8::EpiW1 E{(bf16_t*)(ws + WS_HMID), (const float*)(ws + WS_SS2), args.in[16]};
    pg8::gemm_phase<pg8::EpiW1, pg8::MoeOrder, true, true>(F.lds, D, D, D / 64, S, E);
}
__device__ __forceinline__ void ph9(Frame& F, const Args& args, int rep) {
    unsigned char* ws = args.ws; const int cid = (int)blockIdx.x;
    const int ntl = build_tables(F);
    pg8::MoeOrder S{(const char*)(ws + WS_HMID), (const char*)(ws + WS_W2), (const int*)(ws + WS_LIST), F.ctl + CW_CNT, (const LAS unsigned char*)(F.lds + TL_TE), (const LAS int*)(F.lds + TL_TS),
                    ntl, 4, F.G, cid, (size_t)D * D * 2, 0};
    pg8::EpiW2 E{(bf16_t*)(ws + WS_Y), args.in[18]};
    pg8::gemm_phase<pg8::EpiW2, pg8::MoeOrder, false, true>(F.lds, D, D, D / 64, S, E);
}
__device__ __forceinline__ void ph10(Frame& F, const Args& args, int rep) { (void)build_tables(F); p10_combine(F, args); }

constexpr int N_PHASES = 11;
__global__ void __launch_bounds__(NWAVES * 64, 2) hymba_fwd(Args args) {
    extern __shared__ __attribute__((aligned(16))) unsigned char lds_raw[];
    Frame F;
    F.lds = (LAS unsigned char*)lds_raw;
    F.MISC = (volatile LAS unsigned*)(F.lds + TL_MISC);
    F.tid = threadIdx.x; F.lane = F.tid & 63; F.wave = __builtin_amdgcn_readfirstlane(F.tid >> 6);
    F.G = gridDim.x; { const int bx = blockIdx.x; F.vcu = (F.G % 8 == 0) ? (bx % 8) * (F.G / 8) + bx / 8 : bx; }
    F.ctl = (unsigned*)(args.ws + WS_CTL);
    const int lo = args.ph_lo, hi = args.ph_hi;
    for (int u = F.tid; u < 64; u += NWAVES * 64) ((LAS unsigned*)(F.lds + TL_MISC))[u] = 0u;
    __syncthreads();
    const XcdBarrier xbar = xcd_barrier_post(F.ctl + CW_BAR, F.MISC + 8);
#define RUN(k, fn) do { if (((MK_PHASE_MASK >> (k)) & 1) && lo <= (k) && (k) < hi) { fn(F, args, 0); \
        if (MK_REP_PHASE == (k) && MK_REP_N >= 1) { grid_barrier(F, xbar); fn(F, args, 1); } \
        if (MK_REP_PHASE == (k) && MK_REP_N >= 2) { grid_barrier(F, xbar); fn(F, args, 2); } \
        if ((k) + 1 < hi) { if ((k) == 0) cg::this_grid().sync(); else grid_barrier(F, xbar); } } } while (0)
    RUN(0, ph0); RUN(1, ph1); RUN(2, ph2); RUN(3, ph3); RUN(4, ph4); RUN(5, ph5); RUN(6, ph6); RUN(7, ph7); RUN(8, ph8); RUN(9, ph9); RUN(10, ph10);
#undef RUN
}

extern "C" void kernel_launch(void* const* d_in, const int* in_sizes, int n_in, void* d_out, int out_size, void* d_ws, size_t ws_size, hipStream_t stream) {
    static int grid = 0;
    if (grid == 0) {
        if (n_in != 20 || in_sizes[0] != T * D || out_size != T * D || ws_size < WS_END) {
            fprintf(stderr, "kernel_launch: shape/workspace mismatch (n_in %d, in0 %d, out %d, ws %zu, need %zu)\n", n_in, n_in > 0 ? in_sizes[0] : -1, out_size, ws_size, (size_t)WS_END); grid = -1; return; }
        int dev = 0, cus = 0, per_cu = 0;
        if (hipGetDevice(&dev) != hipSuccess || hipDeviceGetAttribute(&cus, hipDeviceAttributeMultiprocessorCount, dev) != hipSuccess) { grid = -1; return; }
        if (hipFuncSetAttribute((const void*)hymba_fwd, hipFuncAttributeMaxDynamicSharedMemorySize, LDS_BYTES) != hipSuccess) { fprintf(stderr, "kernel_launch: hipFuncSetAttribute failed\n"); grid = -1; return; }
        if (hipOccupancyMaxActiveBlocksPerMultiprocessor(&per_cu, (const void*)hymba_fwd, NWAVES * 64, LDS_BYTES) != hipSuccess || per_cu < 1) { fprintf(stderr, "kernel_launch: occupancy query says %d\n", per_cu); }
        (void)hipGetLastError();
        grid = cus;
        if (grid != 256) fprintf(stderr, "kernel_launch: %d CUs; this kernel is built for 256\n", grid);
    }
    if (grid < 0) return;
    (void)hipMemsetAsync((char*)d_ws + WS_CTL, 0, CTL_ZERO_BYTES, stream);
    Args a{};
    for (int i = 0; i < 20; ++i) a.in[i] = (const float*)d_in[i];
    a.out = (float*)d_out; a.ws = (unsigned char*)d_ws;
#if MK_N_LAUNCHES == 1
    a.ph_lo = 0; a.ph_hi = MK_LAST_PHASE + 1;
    void* kargs[] = {&a};
    hipError_t e = hipLaunchCooperativeKernel((const void*)hymba_fwd, dim3(grid), dim3(NWAVES * 64), kargs, LDS_BYTES, stream);
    if (e != hipSuccess) fprintf(stderr, "kernel_launch: cooperative launch failed: %s\n", hipGetErrorString(e));
#else
    for (int p = 0; p <= MK_LAST_PHASE; ++p) { a.ph_lo = p; a.ph_hi = p + 1; hipLaunchKernelGGL(hymba_fwd, dim3(grid), dim3(NWAVES * 64), LDS_BYTES, stream, a); }
#endif
}
```

```cpp
#include <hip/hip_runtime.h>
#include <hip/hip_cooperative_groups.h>
#include <cstdio>
#include <cstdint>
namespace cg = cooperative_groups;

#ifndef MK_N_LAUNCHES
#define MK_N_LAUNCHES 1
#endif
#ifndef MK_LAST_PHASE
#define MK_LAST_PHASE 10
#endif

#define LAS __attribute__((address_space(3)))
#define GAS __attribute__((address_space(1)))
typedef unsigned short bf16_t;
typedef short bf16x8 __attribute__((ext_vector_type(8)));
typedef short s16x4 __attribute__((ext_vector_type(4)));
typedef float f32x4 __attribute__((ext_vector_type(4)));
typedef float f32x2 __attribute__((ext_vector_type(2)));
typedef float f32x16 __attribute__((ext_vector_type(16)));
typedef unsigned u32x4 __attribute__((ext_vector_type(4)));
typedef unsigned u32x2 __attribute__((ext_vector_type(2)));

constexpr int BATCH = 8, SEQ = 4096, T = BATCH * SEQ, D = 1024, INC = 3584, NMEM = 256, MROWS = BATCH * NMEM;
constexpr int NEXP = 32, TOPK = 4, MT_MAX = T * TOPK / 256 + NEXP, MPAD = MT_MAX * 256;
constexpr float EPS = 1e-6f;
constexpr float LOG2E = 1.4426950408889634f;
constexpr float C2Q = 0.125f * LOG2E;
constexpr float C2X = 0.0625f * LOG2E;
constexpr int C_MQ = 0, C_MK = 512, C_MV = 1024, C_GQ = 1536, C_GF = 2048, C_GI = 2560, C_GG = 3072;

constexpr size_t MiB = 1u << 20;
constexpr size_t WS_CTL = 0, CTL_ZERO_BYTES = 2 * MiB;
constexpr size_t WS_KBAR = 1 * MiB;
constexpr size_t WS_SS1 = 1 * MiB + 256 * 1024;
constexpr size_t WS_SS2 = 1 * MiB + 384 * 1024;
constexpr size_t WS_TOKE = 2 * MiB, WS_TOKR = 2 * MiB + 512 * 1024, WS_TOKG = 3 * MiB;
constexpr size_t WS_WRT = 3 * MiB + 512 * 1024;
constexpr size_t WS_LIST = 4 * MiB;
constexpr size_t WS_WIN = 16 * MiB, WS_WOUT = 23 * MiB, WS_WQ = 25 * MiB, WS_WKV = 27 * MiB, WS_WO = 31 * MiB;
constexpr size_t WS_MN = 33 * MiB, WS_MEMK = 37 * MiB, WS_MEMVT = 41 * MiB;
constexpr size_t WS_W1 = 48 * MiB, WS_W2 = 176 * MiB;
constexpr size_t WS_PROJ = 240 * MiB;
constexpr size_t SEC_ELEMS = (size_t)16 * 1024 * 1024;
constexpr size_t WS_XN = 464 * MiB;
constexpr size_t WS_OX = 464 * MiB;
constexpr size_t WS_MIX = 528 * MiB;
constexpr size_t WS_H1B = 592 * MiB;
constexpr size_t WS_QX = 656 * MiB;
constexpr size_t WS_PWS = 720 * MiB;
constexpr size_t WS_HMID = 240 * MiB;
constexpr size_t WS_Y = 512 * MiB;
constexpr size_t WS_H2F = 784 * MiB;
constexpr size_t WS_H2B = 912 * MiB;
constexpr size_t WS_DUMMY = 976 * MiB;
constexpr size_t WS_END = 984 * MiB;
static_assert(WS_HMID + (size_t)MPAD * D * 2 <= WS_Y && WS_Y + (size_t)MPAD * D * 2 <= WS_H2F, "ws map");
constexpr int CW_TMO = 0;
constexpr int CW_CNT = 64;
constexpr int CW_QUEUE = 128;
constexpr int CW_BAR = 4096;

__device__ __forceinline__ unsigned f2bf(float f) { unsigned u = __builtin_bit_cast(unsigned, f); return (u + 0x7fffu + ((u >> 16) & 1u)) >> 16; }
__device__ __forceinline__ unsigned pk2(float lo, float hi) { return f2bf(lo) | (f2bf(hi) << 16); }
__device__ __forceinline__ float bf2f(unsigned short h) { return __builtin_bit_cast(float, (unsigned)h << 16); }
__device__ __forceinline__ float bflo(unsigned w) { return __builtin_bit_cast(float, w << 16); }
__device__ __forceinline__ float bfhi(unsigned w) { return __builtin_bit_cast(float, w & 0xffff0000u); }
typedef float f32x2_t __attribute__((ext_vector_type(2))); typedef __bf16 bf16x2_t __attribute__((ext_vector_type(2)));
__device__ __forceinline__ unsigned cvtpk(float lo, float hi) { f32x2_t v = {lo, hi}; bf16x2_t b = __builtin_convertvector(v, bf16x2_t); return __builtin_bit_cast(unsigned, b); }
__device__ __forceinline__ float wave_sum(float v) {
#pragma unroll
    for (int o = 1; o < 64; o <<= 1) v += __shfl_xor(v, o);
    return v;
}
__device__ __forceinline__ float fast_exp2(float x) { return __builtin_amdgcn_exp2f(x); }
__device__ __forceinline__ float fast_rcp(float x) { return __builtin_amdgcn_rcpf(x); }
__device__ __forceinline__ float silu_f(float x) { return x * fast_rcp(1.0f + fast_exp2(-x * LOG2E)); }
#define LDS_WAIT() asm volatile("s_waitcnt lgkmcnt(0)" ::: "memory")
#define VM_WAIT() asm volatile("s_waitcnt vmcnt(0)" ::: "memory")
#define RLX_AGENT __ATOMIC_RELAXED, __HIP_MEMORY_SCOPE_AGENT

namespace pg8 {
constexpr int BM = 256, BK = 64, HALF = 128, HTB = HALF * BK * 2, STAGE_BYTES = 8 * HTB;
__host__ __device__ __forceinline__ int lds_byte(int r, int c) { const int st = (r >> 4) * 2 + (c >> 5), rr = r & 15, cc = c & 31, ob = rr * 64 + cc * 2; return st * 1024 + (ob ^ (((ob >> 9) & 1) << 5)); }
__host__ __device__ __forceinline__ void stage_rc(int b, int& R, int& C) { const int st = b / 1024, sb = b % 1024, swz = sb ^ (((sb >> 9) & 1) << 5); R = (st >> 1) * 16 + swz / 64; C = (st & 1) * 32 + (swz % 64) / 2; }
__host__ __device__ __forceinline__ int perm32(int rho) { const int n = rho >> 4, i = rho & 15; return 8 * (i >> 2) + 4 * n + (i & 3); }

struct Unit { const char* A; const char* B; const int* rows; int pm, pn, aux, nrows; };

template <class Epi, class Sched, bool GATHER, bool ALIGN_EPI>
__device__ __forceinline__ void gemm_phase(LAS unsigned char* lds, const int lda, const int ldb, const int nt_in, const Sched& S, const Epi& E) {
    int nt = nt_in; asm volatile("" : "+s"(nt));
    int tid_ = threadIdx.x; asm volatile("" : "+v"(tid_));
    const int tid = tid_, wid = __builtin_amdgcn_readfirstlane(tid >> 6), lane = tid & 63, wr = wid >> 2, wc = wid & 3, fr = lane & 15, fq = lane >> 4;
    unsigned offB[2];
#pragma unroll
    for (int i = 0; i < 2; ++i) { int R, C; stage_rc(tid * 16 + i * 8192, R, C); const int Rb = Epi::PERM ? ((R & ~31) + perm32(R & 31)) : R;
        offB[i] = (unsigned)(Rb * ldb + C) * 2u; }
    const size_t kstep = (size_t)(BK * 2);
    const size_t hstepB = (size_t)HALF * ldb * 2;
    const unsigned ldsw = (unsigned)wid * 1024u;
    const int aoff = lds_byte(wr * 64 + fr, fq * 8), boff = lds_byte(wc * 32 + fr, fq * 8);
#define PG8_SA(b, h) (((b) * 2 + (h)) * HTB)
#define PG8_SB(b, h) ((4 + (b) * 2 + (h)) * HTB)
#define PG8_STG(bufoff, gbase, o0, o1) do { \
        __builtin_amdgcn_global_load_lds((const unsigned*)((const char*)(gbase) + (o0)), (LAS unsigned*)(lds + (bufoff) + ldsw), 16, 0, 0); \
        __builtin_amdgcn_global_load_lds((const unsigned*)((const char*)(gbase) + (o1)), (LAS unsigned*)(lds + (bufoff) + ldsw + 8192), 16, 0, 0); } while (0)
#define PG8_STGB(bufoff, gbase) PG8_STG(bufoff, gbase, offB[0], offB[1])
#define PG8_LDA(dst, b, h) do { _Pragma("unroll") for (int m = 0; m < 4; ++m) _Pragma("unroll") for (int k = 0; k < 2; ++k) dst[m][k] = *(const LAS bf16x8*)(lds + PG8_SA(b, h) + aoff + m * 2048 + k * 1024); } while (0)
#define PG8_LDB(dst, b, h) do { _Pragma("unroll") for (int n = 0; n < 2; ++n) _Pragma("unroll") for (int k = 0; k < 2; ++k) dst[n][k] = *(const LAS bf16x8*)(lds + PG8_SB(b, h) + boff + n * 2048 + k * 1024); } while (0)
#define PG8_MMA(ai, bj, At, Bt) do { __builtin_amdgcn_s_setprio(1); _Pragma("unroll") for (int m = 0; m < 4; ++m) _Pragma("unroll") for (int n = 0; n < 2; ++n) _Pragma("unroll") for (int k = 0; k < 2; ++k) \
        acc[ai][bj][m][n] = __builtin_amdgcn_mfma_f32_16x16x32_bf16(Bt[n][k], At[m][k], acc[ai][bj][m][n], 0, 0, 0); __builtin_amdgcn_s_setprio(0); } while (0)
#define PG8_WAIT_V(n) asm volatile("s_waitcnt vmcnt(" #n ")" ::: "memory")
#define PG8_WAIT_L(n) asm volatile("s_waitcnt lgkmcnt(" #n ")" ::: "memory")
#define PG8_BAR __builtin_amdgcn_s_barrier()
#define PG8_SCHED __builtin_amdgcn_sched_barrier(0)
    unsigned voffA[2], c2[2], pkc[2], pkn[2];
#pragma unroll
    for (int i = 0; i < 2; ++i) { int R, C; stage_rc(tid * 16 + i * 8192, R, C); voffA[i] = (unsigned)(R * lda + C) * 2u; c2[i] = (unsigned)C * 2u; }
    const size_t hstepA = (size_t)HALF * lda * 2;
    const unsigned lda2 = (unsigned)lda * 2u;
#define PG8_PKROWS(dst, u) do { if (GATHER) { _Pragma("unroll") for (int i_ = 0; i_ < 2; ++i_) { int R_, C_; stage_rc(tid * 16 + i_ * 8192, R_, C_); \
        const int nr_ = (u).nrows - 1; const int r0_ = R_ < nr_ ? R_ : nr_, r1_ = (R_ + HALF) < nr_ ? (R_ + HALF) : nr_; \
        dst[i_] = (unsigned)(u).rows[r0_] | ((unsigned)(u).rows[r1_] << 16); } } } while (0)
#define PG8_STGA(bufoff, gbase, h, NX) do { \
        if (GATHER) { const unsigned p0_ = (NX) ? pkn[0] : pkc[0], p1_ = (NX) ? pkn[1] : pkc[1]; \
            const unsigned o0_ = ((h) ? (p0_ >> 16) : (p0_ & 0xffffu)) * lda2 + c2[0], o1_ = ((h) ? (p1_ >> 16) : (p1_ & 0xffffu)) * lda2 + c2[1]; \
            PG8_STG(bufoff, gbase, o0_, o1_); } \
        else { PG8_STG(bufoff, (gbase) + ((h) ? hstepA : (size_t)0), voffA[0], voffA[1]); } } while (0)
    Unit cur, nxt; int ui = 0;
    if (!S.next(0, cur)) return;
    f32x4 acc[2][2][4][2];
#pragma unroll
    for (int a = 0; a < 2; ++a)
#pragma unroll
        for (int b = 0; b < 2; ++b)
#pragma unroll
            for (int m = 0; m < 4; ++m)
#pragma unroll
                for (int n = 0; n < 2; ++n) acc[a][b][m][n] = (f32x4){0.f, 0.f, 0.f, 0.f};
    bf16x8 At[4][2], B0[2][2], B1[2][2];
    pkc[0] = pkc[1] = pkn[0] = pkn[1] = 0u;
    PG8_PKROWS(pkc, cur);
    const char* cA = cur.A; const char* cB = cur.B;
    PG8_STGB(PG8_SB(0, 0), cB); PG8_STGB(PG8_SB(0, 1), cB + hstepB); PG8_STGA(PG8_SA(0, 0), cA, 0, false); PG8_STGA(PG8_SA(0, 1), cA, 1, false);
    if (wr == 1) PG8_BAR;
    PG8_WAIT_V(2); PG8_BAR;
    PG8_STGB(PG8_SB(1, 0), cB + kstep); PG8_STGA(PG8_SA(1, 0), cA + kstep, 0, false); PG8_STGB(PG8_SB(1, 1), cB + hstepB + kstep);
    PG8_WAIT_V(6); PG8_BAR;
    for (;;) {
        const bool has_next = S.next(ui + 1, nxt);
        if (GATHER) { if (has_next) { PG8_PKROWS(pkn, nxt); } else { pkn[0] = pkc[0]; pkn[1] = pkc[1]; } }
        const char* nA = has_next ? nxt.A : cA; const char* nB = has_next ? nxt.B : cB;
        for (int t = 0; t < nt; t += 2) {
            const bool last = (t == nt - 2);
            const char* a1 = cA + (size_t)(t + 1) * kstep;
            const char* a2 = last ? nA : cA + (size_t)(t + 2) * kstep; const char* b2 = last ? nB : cB + (size_t)(t + 2) * kstep;
            const char* a3 = a2 + kstep; const char* b3 = b2 + kstep;
            PG8_LDB(B0, 0, 0); PG8_LDB(B1, 0, 1); PG8_SCHED; PG8_LDA(At, 0, 0); PG8_STGA(PG8_SA(1, 1), a1, 1, false);
            PG8_WAIT_V(8); PG8_WAIT_L(0); PG8_BAR; PG8_MMA(0, 0, At, B0); PG8_MMA(0, 1, At, B1); PG8_BAR; PG8_SCHED;
            PG8_LDA(At, 0, 1); PG8_STGB(PG8_SB(0, 0), b2); PG8_STGB(PG8_SB(0, 1), b2 + hstepB); PG8_STGA(PG8_SA(0, 0), a2, 0, last);
            PG8_WAIT_V(8); PG8_WAIT_L(0); PG8_BAR; PG8_MMA(1, 0, At, B0); PG8_MMA(1, 1, At, B1); PG8_BAR; PG8_SCHED;
            PG8_LDB(B0, 1, 0); PG8_LDB(B1, 1, 1); PG8_SCHED; PG8_LDA(At, 1, 0); PG8_STGA(PG8_SA(0, 1), a2, 1, last);
            PG8_WAIT_V(8); PG8_WAIT_L(0); PG8_BAR; PG8_MMA(0, 0, At, B0); PG8_MMA(0, 1, At, B1); PG8_BAR; PG8_SCHED;
            PG8_LDA(At, 1, 1); PG8_STGB(PG8_SB(1, 0), b3); PG8_STGB(PG8_SB(1, 1), b3 + hstepB); PG8_STGA(PG8_SA(1, 0), a3, 0, last);
            PG8_WAIT_V(8); PG8_WAIT_L(0); PG8_BAR; PG8_MMA(1, 0, At, B0); PG8_MMA(1, 1, At, B1); PG8_BAR; PG8_SCHED;
        }
        if constexpr (ALIGN_EPI) { if (wr == 0) PG8_BAR; }
        if constexpr (!Epi::AFTER_DRAIN) { int t_e = threadIdx.x; asm volatile("" : "+v"(t_e)); const int fr_e = t_e & 15, fq_e = (t_e >> 4) & 3; E(acc, cur, wr, wc, fr_e, fq_e); }
        if (!has_next) break;
#pragma unroll
        for (int a = 0; a < 2; ++a)
#pragma unroll
            for (int b = 0; b < 2; ++b)
#pragma unroll
                for (int m = 0; m < 4; ++m)
#pragma unroll
                    for (int n = 0; n < 2; ++n) acc[a][b][m][n] = (f32x4){0.f, 0.f, 0.f, 0.f};
        cur = nxt; cA = nA; cB = nB; ++ui;
        if (GATHER) { pkc[0] = pkn[0]; pkc[1] = pkn[1]; }
        if constexpr (ALIGN_EPI) { if (wr == 1) PG8_BAR; }
    }
    PG8_WAIT_V(0);
    if constexpr (!ALIGN_EPI) { if (wr == 0) PG8_BAR; }
    PG8_BAR;
    if constexpr (Epi::AFTER_DRAIN) { int t_e = threadIdx.x; asm volatile("" : "+v"(t_e)); const int fr_e = t_e & 15, fq_e = (t_e >> 4) & 3; E.fused(acc, cur, wr, wc, fr_e, fq_e, lds, wid, t_e & 63); }
#undef PG8_SA
#undef PG8_SB
#undef PG8_STG
#undef PG8_STGB
#undef PG8_LDA
#undef PG8_LDB
#undef PG8_MMA
#undef PG8_WAIT_V
#undef PG8_WAIT_L
#undef PG8_SCHED
#undef PG8_PKROWS
#undef PG8_STGA
}
}

namespace pg8 {
constexpr int NXCD = 8, WGM = 8;
__device__ __forceinline__ void tile_order(int L, int nM, int nN, int& pm, int& pn) {
    const int nwg = nM * nN; int wgid = L;
    { const int q = nwg / NXCD, r = nwg % NXCD, xcd = wgid % NXCD, off = wgid / NXCD; wgid = (xcd < r ? xcd * (q + 1) : r * (q + 1) + (xcd - r) * q) + off; }
    const int nig = WGM * nN, gid = wgid / nig, fm = gid * WGM, gsz = (nM - fm) < WGM ? (nM - fm) : WGM;
    pm = fm + ((wgid % nig) % gsz); pn = (wgid % nig) / gsz;
}
struct DenseOrder {
    const char* A; const char* B; int lda, ldb, nM, nN, G, c;
    __device__ __forceinline__ bool next(int i, Unit& u) const {
        const long L = (long)i * G + c; if (L >= (long)nM * nN) return false;
        int pm, pn; tile_order((int)L, nM, nN, pm, pn);
        u.pm = pm; u.pn = pn; u.aux = 0; u.rows = nullptr; u.nrows = 256;
        u.A = A + (size_t)pm * 256 * lda * 2; u.B = B + (size_t)pn * 256 * ldb * 2; return true;
    }
};
struct KvOrder {
    const char* MN; const char* W; int G, c;
    __device__ __forceinline__ bool next(int i, Unit& u) const {
        const int L = i * G + c; if (L >= 64) return false;
        u.rows = nullptr; u.nrows = 256;
        if (L < 32) { u.aux = 0; u.pm = L >> 2; u.pn = L & 3; u.A = MN + (size_t)u.pm * 256 * D * 2; u.B = W + (size_t)u.pn * 256 * D * 2; }
        else { const int l = L - 32; u.aux = 1; u.pm = l >> 3; u.pn = l & 7; u.A = W + (size_t)(1024 + u.pm * 256) * D * 2; u.B = MN + (size_t)u.pn * 256 * D * 2; }
        return true;
    }
};
struct XaScoreOrder {
    const char* QX; const char* MK; int xu;
    __device__ __forceinline__ bool next(int i, Unit& u) const {
        if (i > 0 || xu >= 512) return false;
        const int head = xu & 3, rt = xu >> 2, b = rt >> 4;
        u.pm = rt; u.pn = head; u.aux = 0; u.rows = nullptr; u.nrows = 256;
        u.A = QX + ((size_t)rt * 256 * D + head * 256) * 2; u.B = MK + ((size_t)b * 256 * D + head * 256) * 2; return true;
    }
};
struct XaPvOrder {
    const char* PW; const char* VT; int G, c;
    __device__ __forceinline__ bool next(int i, Unit& u) const {
        const int xu = c + i * G; if (i >= 2 || xu >= 512) return false;
        const int head = xu & 3, rt = xu >> 2, b = rt >> 4;
        u.pm = rt; u.pn = head; u.aux = 0; u.rows = nullptr; u.nrows = 256;
        u.A = PW + (size_t)i * 256 * 256 * 2; u.B = VT + ((size_t)head * 256 * MROWS + b * 256) * 2; return true;
    }
};
struct MoeOrder {
    const char* A; const char* W; const int* list; const unsigned* cnt; const LAS unsigned char* te; const LAS int* ts;
    int ntiles, nN, G, c; size_t wstride; int gather;
    __device__ __forceinline__ bool next(int i, Unit& u) const {
        const long L = (long)i * G + c; if (L >= (long)ntiles * nN) return false;
        int pm, pn; tile_order((int)L, ntiles, nN, pm, pn);
        const int e = __builtin_amdgcn_readfirstlane((int)te[pm]);
        const int lt = pm - __builtin_amdgcn_readfirstlane(ts[e]);
        const int n = (int)__builtin_amdgcn_readfirstlane((int)__hip_atomic_load(cnt + e, RLX_AGENT)) - lt * 256;
        u.pm = pm; u.pn = pn; u.aux = e; u.nrows = n < 256 ? n : 256;
        u.rows = list + (size_t)e * T + lt * 256;
        u.A = gather ? A : A + (size_t)pm * 256 * D * 2;
        u.B = W + (size_t)e * wstride + (size_t)pn * 256 * D * 2; return true;
    }
};

struct EpiProj {
    static constexpr bool PERM = true, AFTER_DRAIN = false;
    bf16_t* O; float* kbar;
    __device__ __forceinline__ void operator()(const f32x4 (&acc)[2][2][4][2], const Unit& u, int wr, int wc, int fr, int fq) const {
        const int pn = u.pn, sec = pn >> 1, b = u.pm >> 4, t0 = (u.pm & 15) * 256 + wr * 64 + fr;
        const int mode = (pn < 2) ? 1 : ((pn == 6 || pn == 7 || pn >= 12) ? 2 : 0);
        bf16_t* sb = O + (size_t)sec * SEC_ELEMS;
#pragma unroll
        for (int bj = 0; bj < 2; ++bj) {
            const int c = bj * HALF + wc * 32 + 8 * fq, head = (pn & 1) * 4 + (c >> 6), d0 = c & 63;
            bf16_t* hb = sb + (size_t)(b * 8 + head) * (SEQ * 64);
#pragma unroll
            for (int ai = 0; ai < 2; ++ai)
#pragma unroll
                for (int m = 0; m < 4; ++m) { const int t = t0 + ai * HALF + m * 16;
                    f32x4 v0 = acc[ai][bj][m][0], v1 = acc[ai][bj][m][1];
                    if (mode == 1) { v0 = v0 * C2Q; v1 = v1 * C2Q; }
                    else if (mode == 2) {
#pragma unroll
                        for (int e = 0; e < 4; ++e) { v0[e] = silu_f(v0[e]); v1[e] = silu_f(v1[e]); } }
                    u32x4 w; w.x = cvtpk(v0[0], v0[1]); w.y = cvtpk(v0[2], v0[3]); w.z = cvtpk(v1[0], v1[1]); w.w = cvtpk(v1[2], v1[3]);
                    size_t off;
                    if (sec == 1) off = (size_t)(t >> 6) * 4096 + (d0 >> 3) * 512 + (t & 63) * 8;
                    else if (sec == 2) off = (size_t)(t >> 6) * 4096 + (d0 >> 5) * 2048 + (t & 63) * 32 + (d0 & 31);
                    else off = (size_t)t * 64 + d0;
                    *(u32x4*)(hb + off) = w; } }
        if (pn == 2 || pn == 3) {
#pragma unroll
            for (int bj = 0; bj < 2; ++bj)
#pragma unroll
                for (int n = 0; n < 2; ++n)
#pragma unroll
                    for (int e = 0; e < 4; ++e) { float s = 0.f;
#pragma unroll
                        for (int ai = 0; ai < 2; ++ai)
#pragma unroll
                            for (int m = 0; m < 4; ++m) s += acc[ai][bj][m][n][e];
                        s += __shfl_xor(s, 1); s += __shfl_xor(s, 2); s += __shfl_xor(s, 4); s += __shfl_xor(s, 8);
                        if (fr == 0) { const int c = bj * HALF + wc * 32 + 8 * fq + 4 * n + e, head = (pn - 2) * 4 + (c >> 6), d = c & 63;
                            atomicAdd(kbar + ((size_t)u.pm * 8 + head) * 64 + d, s); } }
        }
    }
};
struct EpiBf16 {
    static constexpr bool PERM = true, AFTER_DRAIN = false;
    bf16_t* O0; int ldc0; bf16_t* O1; int ldc1;
    __device__ __forceinline__ void operator()(const f32x4 (&acc)[2][2][4][2], const Unit& u, int wr, int wc, int fr, int fq) const {
        bf16_t* O = u.aux ? O1 : O0; const int ldc = u.aux ? ldc1 : ldc0;
        const int row0 = u.pm * BM + wr * 64 + fr, col0 = u.pn * BM + wc * 32 + 8 * fq;
#pragma unroll
        for (int ai = 0; ai < 2; ++ai)
#pragma unroll
            for (int m = 0; m < 4; ++m) { bf16_t* rowp = O + (size_t)(row0 + ai * HALF + m * 16) * ldc + col0;
#pragma unroll
                for (int bj = 0; bj < 2; ++bj) { const f32x4 v0 = acc[ai][bj][m][0], v1 = acc[ai][bj][m][1];
                    u32x4 w; w.x = cvtpk(v0[0], v0[1]); w.y = cvtpk(v0[2], v0[3]); w.z = cvtpk(v1[0], v1[1]); w.w = cvtpk(v1[2], v1[3]);
                    *(u32x4*)(rowp + bj * HALF) = w; } }
    }
};
template <bool BASE_F32, bool WRITE_F32> struct EpiRes {
    static constexpr bool PERM = true, AFTER_DRAIN = false;
    const void* base; bf16_t* Ob; float* Of; float* ss;
    __device__ __forceinline__ void operator()(const f32x4 (&acc)[2][2][4][2], const Unit& u, int wr, int wc, int fr, int fq) const {
        const int row0 = u.pm * BM + wr * 64 + fr, col0 = u.pn * BM + wc * 32 + 8 * fq;
#pragma unroll
        for (int ai = 0; ai < 2; ++ai)
#pragma unroll
            for (int m = 0; m < 4; ++m) { const int row = row0 + ai * HALF + m * 16; const size_t off = (size_t)row * D + col0; float sq = 0.f;
#pragma unroll
                for (int bj = 0; bj < 2; ++bj) { f32x4 b0, b1;
                    if (BASE_F32) { b0 = *(const f32x4*)((const float*)base + off + bj * HALF); b1 = *(const f32x4*)((const float*)base + off + bj * HALF + 4); }
                    else { const u32x4 w = *(const u32x4*)((const bf16_t*)base + off + bj * HALF);
                        b0 = (f32x4){bflo(w.x), bfhi(w.x), bflo(w.y), bfhi(w.y)}; b1 = (f32x4){bflo(w.z), bfhi(w.z), bflo(w.w), bfhi(w.w)}; }
                    const f32x4 v0 = acc[ai][bj][m][0] + b0, v1 = acc[ai][bj][m][1] + b1;
                    sq += (v0[0] * v0[0] + v0[1] * v0[1]) + (v0[2] * v0[2] + v0[3] * v0[3]) + (v1[0] * v1[0] + v1[1] * v1[1]) + (v1[2] * v1[2] + v1[3] * v1[3]);
                    u32x4 w; w.x = cvtpk(v0[0], v0[1]); w.y = cvtpk(v0[2], v0[3]); w.z = cvtpk(v1[0], v1[1]); w.w = cvtpk(v1[2], v1[3]);
                    *(u32x4*)(Ob + off + bj * HALF) = w;
                    if (WRITE_F32) { *(f32x4*)(Of + off + bj * HALF) = v0; *(f32x4*)(Of + off + bj * HALF + 4) = v1; } }
                sq += __shfl_xor(sq, 16); sq += __shfl_xor(sq, 32);
                if (fq == 0) atomicAdd(ss + row, sq); }
    }
};
struct EpiQ {
    static constexpr bool PERM = true, AFTER_DRAIN = false;
    bf16_t* O; const float* ss;
    __device__ __forceinline__ void operator()(const f32x4 (&acc)[2][2][4][2], const Unit& u, int wr, int wc, int fr, int fq) const {
        const int row0 = u.pm * BM + wr * 64 + fr, col0 = u.pn * BM + wc * 32 + 8 * fq;
#pragma unroll
        for (int ai = 0; ai < 2; ++ai)
#pragma unroll
            for (int m = 0; m < 4; ++m) { const int row = row0 + ai * HALF + m * 16; const float sc = C2X * __builtin_amdgcn_rsqf(ss[row] * (1.0f / D) + EPS);
                bf16_t* rowp = O + (size_t)row * D + col0;
#pragma unroll
                for (int bj = 0; bj < 2; ++bj) { const f32x4 v0 = acc[ai][bj][m][0] * sc, v1 = acc[ai][bj][m][1] * sc;
                    u32x4 w; w.x = cvtpk(v0[0], v0[1]); w.y = cvtpk(v0[2], v0[3]); w.z = cvtpk(v1[0], v1[1]); w.w = cvtpk(v1[2], v1[3]);
                    *(u32x4*)(rowp + bj * HALF) = w; } }
    }
};
struct EpiSoftmax {
    static constexpr bool PERM = true, AFTER_DRAIN = true;
    bf16_t* P;
    __device__ __forceinline__ void fused(f32x4 (&acc)[2][2][4][2], const Unit& u, int wr, int wc, int fr, int fq, LAS unsigned char* lds, int wid, int lane) const {
        LAS float* MX = (LAS float*)lds;
        LAS float* SM = (LAS float*)(lds + 4096);
#pragma unroll
        for (int ai = 0; ai < 2; ++ai)
#pragma unroll
            for (int m = 0; m < 4; ++m) { float mx = -3.0e38f;
#pragma unroll
                for (int bj = 0; bj < 2; ++bj)
#pragma unroll
                    for (int n = 0; n < 2; ++n) { const f32x4 x = acc[ai][bj][m][n]; mx = fmaxf(mx, fmaxf(fmaxf(x[0], x[1]), fmaxf(x[2], x[3]))); }
                mx = fmaxf(mx, __shfl_xor(mx, 16)); mx = fmaxf(mx, __shfl_xor(mx, 32));
                if (fq == 0) MX[(ai * HALF + wr * 64 + m * 16 + fr) * 4 + wc] = mx; }
        LDS_WAIT(); __builtin_amdgcn_s_barrier(); asm volatile("" ::: "memory");
#pragma unroll
        for (int ai = 0; ai < 2; ++ai)
#pragma unroll
            for (int m = 0; m < 4; ++m) { const int r = ai * HALF + wr * 64 + m * 16 + fr; const f32x4 q = *(const LAS f32x4*)(MX + r * 4);
                const float mx = fmaxf(fmaxf(q[0], q[1]), fmaxf(q[2], q[3])); float s = 0.f;
#pragma unroll
                for (int bj = 0; bj < 2; ++bj)
#pragma unroll
                    for (int n = 0; n < 2; ++n) { f32x4 x = acc[ai][bj][m][n];
#pragma unroll
                        for (int e = 0; e < 4; ++e) { x[e] = fast_exp2(x[e] - mx); s += x[e]; }
                        acc[ai][bj][m][n] = x; }
                s += __shfl_xor(s, 16); s += __shfl_xor(s, 32);
                if (fq == 0) SM[r * 4 + wc] = s; }
        LDS_WAIT(); __builtin_amdgcn_s_barrier(); asm volatile("" ::: "memory");
        const int col0 = wc * 32 + 8 * fq;
#pragma unroll
        for (int ai = 0; ai < 2; ++ai)
#pragma unroll
            for (int m = 0; m < 4; ++m) { const int r = ai * HALF + wr * 64 + m * 16 + fr; const f32x4 q = *(const LAS f32x4*)(SM + r * 4);
                const float inv = fast_rcp((q[0] + q[1]) + (q[2] + q[3]));
#pragma unroll
                for (int bj = 0; bj < 2; ++bj) { const f32x4 v0 = acc[ai][bj][m][0] * inv, v1 = acc[ai][bj][m][1] * inv;
                    u32x4 w; w.x = cvtpk(v0[0], v0[1]); w.y = cvtpk(v0[2], v0[3]); w.z = cvtpk(v1[0], v1[1]); w.w = cvtpk(v1[2], v1[3]);
                    *(u32x4*)(P + (size_t)r * 256 + bj * HALF + col0) = w; } }
        LDS_WAIT(); __builtin_amdgcn_s_barrier(); asm volatile("" ::: "memory");
    }
};
struct EpiW1 {
    static constexpr bool PERM = true, AFTER_DRAIN = false;
    bf16_t* O; const float* ss; const float* b1;
    __device__ __forceinline__ void operator()(const f32x4 (&acc)[2][2][4][2], const Unit& u, int wr, int wc, int fr, int fq) const {
        const int c0 = wc * 32 + 8 * fq;
        const float* bp = b1 + (size_t)u.aux * 2048 + 2 * (u.pn * 128 + c0);
        const f32x4 bq0 = *(const f32x4*)(bp), bq1 = *(const f32x4*)(bp + 4), bq2 = *(const f32x4*)(bp + 8), bq3 = *(const f32x4*)(bp + 12);
        const float bg[8] = {bq0[0], bq0[2], bq1[0], bq1[2], bq2[0], bq2[2], bq3[0], bq3[2]};
        const float bl[8] = {bq0[1], bq0[3], bq1[1], bq1[3], bq2[1], bq2[3], bq3[1], bq3[3]};
#pragma unroll
        for (int ai = 0; ai < 2; ++ai)
#pragma unroll
            for (int m = 0; m < 4; ++m) { const int r = ai * HALF + wr * 64 + m * 16 + fr; const int rr = r < u.nrows ? r : u.nrows - 1; const int tok = u.rows[rr];
                const float sc = __builtin_amdgcn_rsqf(ss[tok] * (1.0f / D) + EPS); float a[8];
#pragma unroll
                for (int j = 0; j < 8; ++j) { const float g = acc[ai][0][m][j >> 2][j & 3] * sc + bg[j], l = acc[ai][1][m][j >> 2][j & 3] * sc + bl[j];
                    const float glu = fminf(g, 7.0f), lin = fminf(fmaxf(l, -7.0f), 7.0f);
                    a[j] = glu * fast_rcp(1.0f + fast_exp2(-1.702f * LOG2E * glu)) * (lin + 1.0f); }
                u32x4 w; w.x = cvtpk(a[0], a[1]); w.y = cvtpk(a[2], a[3]); w.z = cvtpk(a[4], a[5]); w.w = cvtpk(a[6], a[7]);
                *(u32x4*)(O + ((size_t)u.pm * BM + r) * D + u.pn * 128 + c0) = w; }
    }
};
struct EpiW2 {
    static constexpr bool PERM = true, AFTER_DRAIN = false;
    bf16_t* O; const float* b2;
    __device__ __forceinline__ void operator()(const f32x4 (&acc)[2][2][4][2], const Unit& u, int wr, int wc, int fr, int fq) const {
        const int row0 = u.pm * BM + wr * 64 + fr, col0 = u.pn * BM + wc * 32 + 8 * fq;
        f32x4 bv[2][2];
#pragma unroll
        for (int bj = 0; bj < 2; ++bj)
#pragma unroll
            for (int n = 0; n < 2; ++n) bv[bj][n] = *(const f32x4*)(b2 + (size_t)u.aux * D + col0 + bj * HALF + 4 * n);
#pragma unroll
        for (int ai = 0; ai < 2; ++ai)
#pragma unroll
            for (int m = 0; m < 4; ++m) { bf16_t* rowp = O + (size_t)(row0 + ai * HALF + m * 16) * D + col0;
#pragma unroll
                for (int bj = 0; bj < 2; ++bj) { const f32x4 v0 = acc[ai][bj][m][0] + bv[bj][0], v1 = acc[ai][bj][m][1] + bv[bj][1];
                    u32x4 w; w.x = cvtpk(v0[0], v0[1]); w.y = cvtpk(v0[2], v0[3]); w.z = cvtpk(v1[0], v1[1]); w.w = cvtpk(v1[2], v1[3]);
                    *(u32x4*)(rowp + bj * HALF) = w; } }
    }
};
}

namespace moba {
using bf16x8 = ::bf16x8; using s16x4 = ::s16x4; using f32x16 = ::f32x16; using u32x4 = ::u32x4;
constexpr int DMQ = INC, DMO = D, HD = 64;
constexpr int NW = 8, QBLK = 32, QB = 256, KVBLK = 64;
__device__ __forceinline__ int crow(int r, int hi) { return (r & 3) + 8 * (r >> 2) + 4 * hi; }
#define SBAR() __builtin_amdgcn_sched_barrier(0)
__device__ __forceinline__ void cmask(f32x16& p0, f32x16& p1, int jb, int qrel, int hi) {
    const float NEG = -INFINITY; int kb = 64 * jb + 4 * hi;
#pragma unroll
    for (int r = 0; r < 16; ++r) { int kv = kb + (r & 3) + 8 * (r >> 2); if (kv > qrel) p0[r] = NEG; if (kv + 32 > qrel) p1[r] = NEG; }
}
constexpr int NSLOT = 3, SLOTB = 8192;
constexpr int LDS_K = 0, LDS_V = NSLOT * SLOTB, LDS_WS = 2 * NSLOT * SLOTB, LDS_OST = LDS_WS + NW * 64 * 4, LDS_KB = LDS_OST + NW * 4096, LDS_BYTES = LDS_KB + 16 * 64 * 4;
__device__ __forceinline__ void glds16(const void* gsrc, unsigned lds_dst) { unsigned keep;
    asm volatile("s_mov_b32 %0, m0\n\ts_mov_b32 m0, %2\n\ts_nop 0\n\tglobal_load_lds_dwordx4 %1, off\n\ts_mov_b32 m0, %0" : "=&s"(keep) : "v"(gsrc), "s"(lds_dst) : "memory"); }
__device__ __forceinline__ float max3f(float a, float b, float c) { float r; asm("v_max3_f32 %0, %1, %2, %3" : "=v"(r) : "v"(a), "v"(b), "v"(c)); return r; }
__device__ __forceinline__ float max2f(float a, float b) { float r; asm("v_max_f32_e32 %0, %1, %2" : "=v"(r) : "v"(a), "v"(b)); return r; }
__device__ __forceinline__ float fadd_s(float a, float b) { float r; asm("v_add_f32_e32 %0, %1, %2" : "=v"(r) : "v"(a), "v"(b)); return r; }
__device__ __forceinline__ float fsub_s(float a, float b) { float r; asm("v_sub_f32_e32 %0, %1, %2" : "=v"(r) : "v"(a), "v"(b)); return r; }
__device__ __forceinline__ unsigned cvtpk_s(float lo, float hi) { return ::cvtpk(lo, hi); }
#define WAIT_BAR(N) asm volatile("s_waitcnt vmcnt(" #N ") lgkmcnt(0)\n\ts_barrier" ::: "memory")
__device__ __forceinline__ void qkt(f32x16& p0, f32x16& p1, const char* Kslot, const bf16x8* qr, const f32x16& negm, int r32, int hi) {
    const char* kb = Kslot + hi * 1024 + r32 * 16;
#pragma unroll
    for (int d0 = 0; d0 < 4; ++d0) {
        const bf16x8 b0 = *reinterpret_cast<const bf16x8*>(kb + d0 * 2048);
        const bf16x8 b1 = *reinterpret_cast<const bf16x8*>(kb + d0 * 2048 + 512);
        if (d0 == 0) { p0 = __builtin_amdgcn_mfma_f32_32x32x16_bf16(b0, qr[0], negm, 0, 0, 0); p1 = __builtin_amdgcn_mfma_f32_32x32x16_bf16(b1, qr[0], negm, 0, 0, 0); }
        else { p0 = __builtin_amdgcn_mfma_f32_32x32x16_bf16(b0, qr[d0], p0, 0, 0, 0); p1 = __builtin_amdgcn_mfma_f32_32x32x16_bf16(b1, qr[d0], p1, 0, 0, 0); } }
}
typedef __attribute__((address_space(3))) const char* lds_cptr;
typedef short v4i16_t __attribute__((ext_vector_type(4)));
__device__ __forceinline__ void kload8(bf16x8* kf, lds_cptr kp) {
    kf[0] = *(const __attribute__((address_space(3))) bf16x8*)(kp);        kf[1] = *(const __attribute__((address_space(3))) bf16x8*)(kp + 512);
    kf[2] = *(const __attribute__((address_space(3))) bf16x8*)(kp + 2048); kf[3] = *(const __attribute__((address_space(3))) bf16x8*)(kp + 2560);
    kf[4] = *(const __attribute__((address_space(3))) bf16x8*)(kp + 4096); kf[5] = *(const __attribute__((address_space(3))) bf16x8*)(kp + 4608);
    kf[6] = *(const __attribute__((address_space(3))) bf16x8*)(kp + 6144); kf[7] = *(const __attribute__((address_space(3))) bf16x8*)(kp + 6656);
}
__device__ __forceinline__ void kload2(bf16x8* kf, lds_cptr kp, int j) { kf[2 * j] = *(const __attribute__((address_space(3))) bf16x8*)(kp + j * 2048); kf[2 * j + 1] = *(const __attribute__((address_space(3))) bf16x8*)(kp + j * 2048 + 512); }
__device__ __forceinline__ s16x4 vtr(lds_cptr p) { return __builtin_bit_cast(s16x4, __builtin_amdgcn_ds_read_tr16_b64_v4i16((__attribute__((address_space(3))) v4i16_t*)p)); }
__device__ __forceinline__ float rowmax(const f32x16& p0, const f32x16& p1) {
    float a = max3f(p0[0], p0[1], p1[0]), b = max3f(p0[2], p0[3], p1[1]); a = max3f(a, p1[2], p1[3]);
#pragma unroll
    for (int r = 4; r < 16; r += 4) { a = max3f(a, p0[r], p0[r + 1]); b = max3f(b, p0[r + 2], p0[r + 3]); a = max3f(a, p1[r], p1[r + 1]); b = max3f(b, p1[r + 2], p1[r + 3]); }
    const float m = max2f(a, b);
    auto rr = __builtin_amdgcn_permlane32_swap(__float_as_uint(m), __float_as_uint(m), false, false);
    return max2f(__uint_as_float(rr[0]), __uint_as_float(rr[1]));
}
__device__ __forceinline__ void pv(f32x16* o, int vb, bf16x8 pa0, bf16x8 pa1, bf16x8 pa2, bf16x8 pa3) {
#pragma unroll
    for (int d0 = 0; d0 < 2; ++d0) { s16x4 lo[4], hi[4];
#pragma unroll
        for (int ks = 0; ks < 4; ++ks) {
            asm volatile("ds_read_b64_tr_b16 %0,%1 offset:%c2" : "=&v"(lo[ks]) : "v"(vb), "i"(d0 * 4096 + ks * 1024) : "memory");
            asm volatile("ds_read_b64_tr_b16 %0,%1 offset:%c2" : "=&v"(hi[ks]) : "v"(vb), "i"(d0 * 4096 + ks * 1024 + 512) : "memory"); }
        asm volatile("s_waitcnt lgkmcnt(0)" ::: "memory"); SBAR();
#define PK(k) (bf16x8){lo[k][0], lo[k][1], lo[k][2], lo[k][3], hi[k][0], hi[k][1], hi[k][2], hi[k][3]}
        o[d0] = __builtin_amdgcn_mfma_f32_32x32x16_bf16(pa0, PK(0), o[d0], 0, 0, 0);
        o[d0] = __builtin_amdgcn_mfma_f32_32x32x16_bf16(pa1, PK(1), o[d0], 0, 0, 0);
        o[d0] = __builtin_amdgcn_mfma_f32_32x32x16_bf16(pa2, PK(2), o[d0], 0, 0, 0);
        o[d0] = __builtin_amdgcn_mfma_f32_32x32x16_bf16(pa3, PK(3), o[d0], 0, 0, 0);
#undef PK
    }
}
constexpr float NEGBIG = -1.0e30f;

template <int THRL> __device__ __forceinline__ void attn_unit(int b, int h, int qb, const bf16_t* Qg, const bf16_t* __restrict__ Kg, const bf16_t* __restrict__ Vg, bf16_t* Og, const float* __restrict__ kbar, char* shm) {
    int tid_ = threadIdx.x; asm volatile("" : "+v"(tid_));
    const int tid = tid_, lane = tid & 63, r32 = lane & 31, hi = lane >> 5; const int wid = __builtin_amdgcn_readfirstlane(tid >> 6);
    const long rowbase = (long)b * SEQ; const int q0 = qb * QB;
    const size_t hoff = (size_t)(b * 8 + h) * (SEQ * 64);
    const bf16_t* Qw = Qg + hoff + (size_t)(q0 + wid * QBLK) * 64;
    const bf16_t* Kh = Kg + hoff, *Vh = Vg + hoff;
    const unsigned lds0 = (unsigned)(uintptr_t)shm;
    float* wsf = (float*)(shm + LDS_WS) + wid * 64;
    const bf16_t* ksrc = Kh + wid * 512 + lane * 8;
    const bf16_t* vsrc = Vh + wid * 512 + lane * 8;
    const unsigned kdst = lds0 + LDS_K + wid * 1024, vdst = lds0 + LDS_V + wid * 1024;
    const int NT = 4 * qb + 4, NPAST = 4 * qb;
#define TMAP(t) (((t) < 4) ? (NPAST + (t)) : ((t) - 4))
#define DMA_K(t, slot) glds16(ksrc + (long)TMAP(t) * 4096, (unsigned)__builtin_amdgcn_readfirstlane(kdst + (slot)))
#define DMA_V(t, slot) glds16(vsrc + (long)TMAP(t) * 4096, (unsigned)__builtin_amdgcn_readfirstlane(vdst + (slot)))
    const char* Kbase = shm + LDS_K; bf16x8 kf[8];
    const lds_cptr shm3 = (lds_cptr)shm; const lds_cptr kp0 = shm3 + LDS_K + hi * 1024 + r32 * 16; const lds_cptr vp0 = shm3 + LDS_V + ((lane >> 4) & 1) * 32 + (lane & 3) * 8 + (4 * hi + ((lane & 15) >> 2)) * 64;
    DMA_K(0, 0); DMA_V(0, 0); DMA_K(1, SLOTB);
    bf16x8 qr[4];
#pragma unroll
    for (int d0 = 0; d0 < 4; ++d0) qr[d0] = *reinterpret_cast<const bf16x8*>(&Qw[(long)r32 * 64 + d0 * 16 + hi * 8]);
    unsigned selm = 0u;
    if (qb > 0) {
        float* kbl = (float*)(shm + LDS_KB);
        for (int i = tid; i < qb * 64; i += NW * 64) kbl[i] = kbar[((size_t)(b * 16 + (i >> 6)) * 8 + h) * 64 + (i & 63)];
        asm volatile("s_waitcnt vmcnt(0) lgkmcnt(0)\n\ts_barrier" ::: "memory");
        if (qb <= 3) selm = (1u << qb) - 1u;
        else {
            float qf[32];
#pragma unroll
            for (int d0 = 0; d0 < 4; ++d0)
#pragma unroll
                for (int j = 0; j < 8; ++j) qf[d0 * 8 + j] = bf2f((unsigned short)qr[d0][j]);
            float g[15];
#pragma unroll
            for (int n = 0; n < 15; ++n) { float s = 0.f;
                if (n < qb) {
#pragma unroll
                    for (int d0 = 0; d0 < 4; ++d0) { const f32x4 k0 = *(const f32x4*)(kbl + n * 64 + d0 * 16 + hi * 8), k1 = *(const f32x4*)(kbl + n * 64 + d0 * 16 + hi * 8 + 4);
                        s += qf[d0 * 8 + 0] * k0[0] + qf[d0 * 8 + 1] * k0[1] + qf[d0 * 8 + 2] * k0[2] + qf[d0 * 8 + 3] * k0[3] + qf[d0 * 8 + 4] * k1[0] + qf[d0 * 8 + 5] * k1[1] + qf[d0 * 8 + 6] * k1[2] + qf[d0 * 8 + 7] * k1[3]; }
                    s += __shfl_xor(s, 32);
                } else s = -INFINITY;
                g[n] = s; }
#pragma unroll
            for (int pass = 0; pass < 3; ++pass) { float best = -INFINITY; int bi = 0;
#pragma unroll
                for (int n = 0; n < 15; ++n) if (g[n] > best) { best = g[n]; bi = n; }
                selm |= 1u << bi;
#pragma unroll
                for (int n = 0; n < 15; ++n) if (n == bi) g[n] = -INFINITY; }
        }
    }
    float mhat = 0.f, l_reg = 0.f; f32x16 o[2]; o[0] = f32x16{}; o[1] = f32x16{}; f32x16 cini = f32x16{}; asm volatile("" : "+v"(cini));
    const int qrel = wid * QBLK + r32;
#define SETC(t, JB) do { const float cm_ = ((JB >= 0) || ((selm >> (((t) - 4) >> 2)) & 1u)) ? -mhat : NEGBIG; \
      _Pragma("unroll") for (int r = 0; r < 16; ++r) cini[r] = cm_; asm volatile("" : "+v"(cini)); } while (0)
    bool resc = false;
#define START(P0, P1) do { const float rm = rowmax(P0, P1); resc = false; \
    { const float dl = rm; mhat = fadd_s(mhat, dl); \
      _Pragma("unroll") for (int r = 0; r < 16; ++r) { P0[r] = fsub_s(P0[r], dl); P1[r] = fsub_s(P1[r], dl); } } \
    _Pragma("unroll") for (int r = 0; r < 16; ++r) P0[r] = __builtin_amdgcn_exp2f(P0[r]); } while (0)
#define RESC() do { if (resc) { asm volatile("s_waitcnt lgkmcnt(0)" ::: "memory"); \
      _Pragma("unroll") for (int d_ = 0; d_ < 2; ++d_) _Pragma("unroll") for (int r = 0; r < 16; ++r) o[d_][r] *= wsf[crow(r, hi)]; } } while (0)
    f32x16 pA0, pA1, pB0, pB1;
    int sl_prev = 0, sl_cur = 0, sl_next = SLOTB;
#define ROT() do { sl_prev = sl_cur; sl_cur = sl_next; sl_next = (sl_next == (NSLOT - 1) * SLOTB) ? 0 : sl_next + SLOTB; } while (0)
    DMA_K(2, 2 * SLOTB);
    if (qb > 0) { WAIT_BAR(0); } else { WAIT_BAR(3); }
    qkt(pA0, pA1, Kbase, qr, cini, r32, hi); asm volatile("s_nop 15\n\ts_nop 7" : "+v"(pA0), "+v"(pA1)); cmask(pA0, pA1, 0, qrel, hi);
    START(pA0, pA1);
    _Pragma("unroll") for (int r = 0; r < 16; ++r) pA1[r] = __builtin_amdgcn_exp2f(pA1[r]);
    WAIT_BAR(0);
    DMA_K(3, 0); DMA_V(1, SLOTB);
    ROT();
    kload8(kf, kp0 + sl_cur);
    WAIT_BAR(2);
    s16x4 vlo[8], vhi[8]; u32x4 pw0, pw1, pw2, pw3;
#define PKW(P, B) cvtpk_s(P[B], P[B + 1])
#define PAF(k) __builtin_bit_cast(bf16x8, pw##k)
#define VFR(i) (bf16x8){vlo[i][0], vlo[i][1], vlo[i][2], vlo[i][3], vhi[i][0], vhi[i][1], vhi[i][2], vhi[i][3]}
#define PIN(x) asm volatile("" : "+v"(x))
#define MX3(a, b, c) __builtin_fmaxf(__builtin_fmaxf((a), (b)), (c))
#define GAPA(MF, A0, A1, A2, A3, W0, W1, PW) do { MF; sacc += A0; sacc += A1; sacc += A2; sacc += A3; PIN(sacc); W0; W1; PIN(PW); SBAR(); } while (0)
#define EX(v) __builtin_amdgcn_exp2f(v)
#define GAPB(MF, X, B) do { MF; X[B] = EX(X[B]); X[B + 1] = EX(X[B + 1]); X[B + 2] = EX(X[B + 2]); X[B + 3] = EX(X[B + 3]); PIN(X); SBAR(); } while (0)
#define VRD(i) do { vlo[i] = vtr(vp_ + (((i) >> 2) * 4096 + ((i) & 3) * 1024)); vhi[i] = vtr(vp_ + (((i) >> 2) * 4096 + ((i) & 3) * 1024 + 512)); } while (0)
#define KRD(G, j) do { if (G) { kload2(kf, kp0 + sl_next, j); SBAR(); } } while (0)
#define STEP(C0, C1, P0, P1, t, GK, GV, GL, JB) do { SETC(t, JB); SBAR(); \
    const lds_cptr vp_ = vp0 + sl_prev; \
    VRD(0); SBAR(); float sacc = (P0[0] + P0[1]); \
    GAPA(C0 = __builtin_amdgcn_mfma_f32_32x32x16_bf16(kf[0], qr[0], cini, 0, 0, 0), P0[2], P0[3], P0[4], P0[5],     pw0[0] = PKW(P0, 0), pw0[1] = PKW(P0, 2), pw0); \
    VRD(4); SBAR(); GAPA(C1 = __builtin_amdgcn_mfma_f32_32x32x16_bf16(kf[1], qr[0], cini, 0, 0, 0), P0[6], P0[7], P0[8], P0[9],     pw0[2] = PKW(P0, 4), pw0[3] = PKW(P0, 6), pw0); \
    VRD(1); SBAR(); GAPA(C0 = __builtin_amdgcn_mfma_f32_32x32x16_bf16(kf[2], qr[1], C0, 0, 0, 0),   P0[10], P0[11], P0[12], P0[13], pw1[0] = PKW(P0, 8), pw1[1] = PKW(P0, 10), pw1); \
    VRD(5); SBAR(); GAPA(C1 = __builtin_amdgcn_mfma_f32_32x32x16_bf16(kf[3], qr[1], C1, 0, 0, 0),   P0[14], P0[15], P1[0], P1[1],   pw1[2] = PKW(P0, 12), pw1[3] = PKW(P0, 14), pw1); \
    VRD(2); SBAR(); GAPA(C0 = __builtin_amdgcn_mfma_f32_32x32x16_bf16(kf[4], qr[2], C0, 0, 0, 0),   P1[2], P1[3], P1[4], P1[5],     pw2[0] = PKW(P1, 0), pw2[1] = PKW(P1, 2), pw2); \
    VRD(6); SBAR(); GAPA(C1 = __builtin_amdgcn_mfma_f32_32x32x16_bf16(kf[5], qr[2], C1, 0, 0, 0),   P1[6], P1[7], P1[8], P1[9],     pw2[2] = PKW(P1, 4), pw2[3] = PKW(P1, 6), pw2); \
    VRD(3); SBAR(); GAPA(C0 = __builtin_amdgcn_mfma_f32_32x32x16_bf16(kf[6], qr[3], C0, 0, 0, 0),   P1[10], P1[11], P1[12], P1[13], pw3[0] = PKW(P1, 8), pw3[1] = PKW(P1, 10), pw3); \
    VRD(7); SBAR(); GAPA(C1 = __builtin_amdgcn_mfma_f32_32x32x16_bf16(kf[7], qr[3], C1, 0, 0, 0),   P1[14], P1[15], 0.f, 0.f,       pw3[2] = PKW(P1, 12), pw3[3] = PKW(P1, 14), pw3); \
    l_reg += sacc; \
    if (GK) { DMA_K((t) + 3, sl_cur); } if (GV) { DMA_V((t) + 1, sl_next); } \
    if (JB >= 0) cmask(C0, C1, JB, qrel, hi); \
    { float a = MX3(C0[0], C0[1], C1[0]), b_ = MX3(C0[2], C0[3], C1[1]); a = MX3(a, C1[2], C1[3]); \
      _Pragma("unroll") for (int r = 4; r < 16; r += 4) { a = MX3(a, C0[r], C0[r + 1]); b_ = MX3(b_, C0[r + 2], C0[r + 3]); a = MX3(a, C1[r], C1[r + 1]); b_ = MX3(b_, C1[r + 2], C1[r + 3]); } \
      float rm = __builtin_fmaxf(a, b_); { auto rr = __builtin_amdgcn_permlane32_swap(__float_as_uint(rm), __float_as_uint(rm), false, false); rm = __builtin_fmaxf(__uint_as_float(rr[0]), __uint_as_float(rr[1])); } \
      resc = false; \
      if (__builtin_expect(__any(rm > (float)THRL), 0)) { const float dl = __builtin_fmaxf(rm, 0.f); mhat += dl; \
        _Pragma("unroll") for (int r = 0; r < 16; ++r) { C0[r] -= dl; C1[r] -= dl; } \
        const float f = __builtin_amdgcn_exp2f(-dl); l_reg *= f; if (hi == 0) wsf[r32] = f; resc = true; } } \
    SBAR(); \
    GAPB(o[0] = __builtin_amdgcn_mfma_f32_32x32x16_bf16(PAF(0), VFR(0), o[0], 0, 0, 0), C0, 0); \
    GAPB(o[1] = __builtin_amdgcn_mfma_f32_32x32x16_bf16(PAF(0), VFR(4), o[1], 0, 0, 0), C0, 4); \
    KRD(GL, 0); GAPB(o[0] = __builtin_amdgcn_mfma_f32_32x32x16_bf16(PAF(1), VFR(1), o[0], 0, 0, 0), C0, 8); \
    KRD(GL, 1); GAPB(o[1] = __builtin_amdgcn_mfma_f32_32x32x16_bf16(PAF(1), VFR(5), o[1], 0, 0, 0), C0, 12); \
    KRD(GL, 2); GAPB(o[0] = __builtin_amdgcn_mfma_f32_32x32x16_bf16(PAF(2), VFR(2), o[0], 0, 0, 0), C1, 0); \
    KRD(GL, 3); GAPB(o[1] = __builtin_amdgcn_mfma_f32_32x32x16_bf16(PAF(2), VFR(6), o[1], 0, 0, 0), C1, 4); \
    GAPB(o[0] = __builtin_amdgcn_mfma_f32_32x32x16_bf16(PAF(3), VFR(3), o[0], 0, 0, 0), C1, 8); \
    GAPB(o[1] = __builtin_amdgcn_mfma_f32_32x32x16_bf16(PAF(3), VFR(7), o[1], 0, 0, 0), C1, 12); \
    } while (0)
#define ENDW(tt) do { if ((tt) + 3 < NT) { WAIT_BAR(2); } else if ((tt) + 2 < NT) { WAIT_BAR(1); } else { WAIT_BAR(0); } } while (0)
    STEP(pB0, pB1, pA0, pA1, 1, (4 < NT), true, true, 1);   ENDW(1); RESC(); ROT();
    STEP(pA0, pA1, pB0, pB1, 2, (5 < NT), true, true, 2);   ENDW(2); RESC(); ROT();
    STEP(pB0, pB1, pA0, pA1, 3, (6 < NT), (4 < NT), (4 < NT), 3);   ENDW(3); RESC(); ROT();
    for (int t = 4; t < NT; t += 2) {
        STEP(pA0, pA1, pB0, pB1, t, (t + 3 < NT), true, true, -1);                       ENDW(t);     RESC(); ROT();
        STEP(pB0, pB1, pA0, pA1, t + 1, (t + 4 < NT), (t + 2 < NT), (t + 2 < NT), -1);   ENDW(t + 1); RESC(); ROT();
    }
    { float sacc = pB0[0] + pB0[1]; _Pragma("unroll") for (int r = 2; r < 16; ++r) sacc += pB0[r]; _Pragma("unroll") for (int r = 0; r < 16; ++r) sacc += pB1[r]; l_reg += sacc;
      pw0 = (u32x4){PKW(pB0, 0), PKW(pB0, 2), PKW(pB0, 4), PKW(pB0, 6)}; pw1 = (u32x4){PKW(pB0, 8), PKW(pB0, 10), PKW(pB0, 12), PKW(pB0, 14)}; pw2 = (u32x4){PKW(pB1, 0), PKW(pB1, 2), PKW(pB1, 4), PKW(pB1, 6)}; pw3 = (u32x4){PKW(pB1, 8), PKW(pB1, 10), PKW(pB1, 12), PKW(pB1, 14)};
      SBAR(); pv(o, (int)(unsigned long)vp0 + sl_prev, PAF(0), PAF(1), PAF(2), PAF(3)); }
#undef PKW
#undef PAF
#undef VFR
#undef PIN
#undef MX3
#undef GAPA
#undef GAPB
#undef EX
#undef VRD
#undef KRD
#undef STEP
#undef ENDW
    { auto rr = __builtin_amdgcn_permlane32_swap(__float_as_uint(l_reg), __float_as_uint(l_reg), false, false); l_reg = __uint_as_float(rr[0]) + __uint_as_float(rr[1]); }
    if (hi == 0) wsf[32 + r32] = l_reg; asm volatile("s_waitcnt lgkmcnt(0)" ::: "memory");
    float rli[16];
#pragma unroll
    for (int r = 0; r < 16; ++r) rli[r] = __builtin_amdgcn_rcpf(wsf[32 + crow(r, hi)]);
    bf16_t* Ow = Og + (rowbase + q0 + wid * QBLK) * DMO + h * HD;
    { bf16_t* stg = (bf16_t*)(shm + LDS_OST) + wid * 2048;
#pragma unroll
      for (int r = 0; r < 16; ++r) { const int orow = crow(r, hi);
#pragma unroll
        for (int d0 = 0; d0 < 2; ++d0) stg[orow * 64 + d0 * 32 + r32] = (bf16_t)f2bf(o[d0][r] * rli[r]); }
      asm volatile("s_waitcnt lgkmcnt(0)" ::: "memory");
#pragma unroll
      for (int i = 0; i < 4; ++i) { const int row = i * 8 + (lane >> 3), ch = lane & 7; const u32x4 v = *(const u32x4*)(stg + row * 64 + ch * 8); *(u32x4*)(Ow + (long)row * DMO + ch * 8) = v; } }
    asm volatile("s_waitcnt lgkmcnt(0)\n\ts_barrier" ::: "memory");
#undef DMA_K
#undef DMA_V
#undef TMAP
#undef SETC
#undef START
#undef RESC
#undef ROT
}
#undef SBAR
#undef WAIT_BAR
}

namespace hgrn {
constexpr int RS = 144;
constexpr int R_FQV = 0, FQV_SLOT = 24576, R_G = 73728, G_SLOT = 8192;
constexpr int L_Q = 90112, L_K = L_Q + 9216, L_KT = L_K + 9216, L_VT = L_KT + 9216, L_ST = L_VT + 9216, L_SEG = L_ST + 9216, L_DEND = L_SEG + 2048, L_SSQ = L_DEND + 256, L_BYTES = L_SSQ + 512;
__device__ __forceinline__ int crow(int r, int hi) { return (r & 3) + 8 * (r >> 2) + 4 * hi; }
__device__ __forceinline__ void glds16(const void* gsrc, unsigned lds_dst) { unsigned keep;
    asm volatile("s_mov_b32 %0, m0\n\ts_mov_b32 m0, %2\n\ts_nop 0\n\tglobal_load_lds_dwordx4 %1, off\n\ts_mov_b32 m0, %0" : "=&s"(keep) : "v"(gsrc), "s"(lds_dst) : "memory"); }
#define HG_BAR() do { asm volatile("s_waitcnt lgkmcnt(0)" ::: "memory"); __builtin_amdgcn_s_barrier(); asm volatile("" ::: "memory"); } while (0)
__device__ __forceinline__ void hgrn_unit(int b, int h, const bf16_t* __restrict__ proj, bf16_t* __restrict__ mix, const float* __restrict__ lb_logits, const float* __restrict__ norm_g, LAS unsigned char* lds) {
    int tid_ = threadIdx.x; asm volatile("" : "+v"(tid_));
    const int tid = tid_, lane = tid & 63, r32 = lane & 31, hi = lane >> 5; const int w = __builtin_amdgcn_readfirstlane(tid >> 6);
    const float lbk = fast_rcp(1.0f + fast_exp2((lb_logits[512 + h * 64 + lane] - lb_logits[h * 64 + lane]) * LOG2E));
    const int vr = (w >> 1) & 1, tc = w & 1;
    float ng[16];
#pragma unroll
    for (int r = 0; r < 16; ++r) ng[r] = norm_g[h * 64 + 32 * vr + crow(r, hi)];
    f32x16 S = f32x16{};
    for (int i = tid; i < 64 * RS / 4; i += 512) ((LAS unsigned*)(lds + L_ST))[i] = 0u;
    const size_t hoff = (size_t)(b * 8 + h) * (SEQ * 64) + (size_t)w * 512 + lane * 8;
    const bf16_t* gQ = proj + 3 * SEC_ELEMS + hoff; const bf16_t* gF = proj + 4 * SEC_ELEMS + hoff; const bf16_t* gV = proj + 5 * SEC_ELEMS + hoff; const bf16_t* gG = proj + 6 * SEC_ELEMS + hoff;
    const unsigned lds0 = (unsigned)(uintptr_t)(unsigned char*)lds;
#define DMA_FQV(c_) do { const int cc_ = (c_) < 63 ? (c_) : 63; const unsigned d_ = (unsigned)__builtin_amdgcn_readfirstlane(lds0 + R_FQV + (unsigned)(((c_) % 3) * FQV_SLOT) + (unsigned)w * 1024u); \
        glds16(gF + (size_t)cc_ * 4096, d_); glds16(gQ + (size_t)cc_ * 4096, d_ + 8192u); glds16(gV + (size_t)cc_ * 4096, d_ + 16384u); } while (0)
#define DMA_G(c_) do { const int cc_ = (c_) < 63 ? (c_) : 63; glds16(gG + (size_t)cc_ * 4096, (unsigned)__builtin_amdgcn_readfirstlane(lds0 + R_G + (unsigned)(((c_) & 1) * G_SLOT) + (unsigned)w * 1024u)); } while (0)
    DMA_FQV(0); DMA_G(0); DMA_FQV(1); DMA_G(0);
    for (int c = 0; c < 64; ++c) {
        const size_t row0 = (size_t)b * SEQ + (size_t)c * 64;
        DMA_FQV(c + 2);
        asm volatile("s_waitcnt vmcnt(8)" ::: "memory");
        const LAS unsigned char* raw = lds + R_FQV + (c % 3) * FQV_SLOT + (8 * w) * 128 + lane * 2;
        float p[8], kk[8];
        { float run = 0.f;
#pragma unroll
          for (int i = 0; i < 8; ++i) { const float x = bf2f(*(const LAS unsigned short*)(raw + i * 128)); const float sg = fast_rcp(1.0f + fast_exp2(-x * LOG2E)); const float f = lbk + (1.0f - lbk) * sg;
              run += __builtin_amdgcn_logf(f); p[i] = run; kk[i] = 1.0f - f; } }
        ((LAS float*)(lds + L_SEG))[w * 64 + lane] = p[7];
        HG_BAR();
        DMA_G(c + 1);
        { float off = 0.f;
#pragma unroll
          for (int j = 0; j < 7; ++j) { const float sv = ((LAS float*)(lds + L_SEG))[j * 64 + lane]; off += (j < w) ? sv : 0.f; }
          unsigned kq[4], vq[4];
#pragma unroll
          for (int i = 0; i < 8; i += 2) { const float b0 = off + p[i], b1 = off + p[i + 1];
              const unsigned short q0r = *(const LAS unsigned short*)(raw + 8192 + i * 128), q1r = *(const LAS unsigned short*)(raw + 8192 + (i + 1) * 128);
              const unsigned short v0r = *(const LAS unsigned short*)(raw + 16384 + i * 128), v1r = *(const LAS unsigned short*)(raw + 16384 + (i + 1) * 128);
              const float q0 = bf2f(q0r) * fast_exp2(b0), q1 = bf2f(q1r) * fast_exp2(b1), k0 = kk[i] * fast_exp2(-b0), k1 = kk[i + 1] * fast_exp2(-b1);
              const unsigned qq = cvtpk(q0, q1), kw = cvtpk(k0, k1); kq[i >> 1] = kw; vq[i >> 1] = (unsigned)v0r | ((unsigned)v1r << 16);
              *(LAS unsigned short*)(lds + L_Q + (8 * w + i) * RS + lane * 2) = (unsigned short)(qq & 0xffffu);
              *(LAS unsigned short*)(lds + L_Q + (8 * w + i + 1) * RS + lane * 2) = (unsigned short)(qq >> 16);
              *(LAS unsigned short*)(lds + L_K + (8 * w + i) * RS + lane * 2) = (unsigned short)(kw & 0xffffu);
              *(LAS unsigned short*)(lds + L_K + (8 * w + i + 1) * RS + lane * 2) = (unsigned short)(kw >> 16); }
          *(LAS u32x4*)(lds + L_KT + lane * RS + 16 * w) = (u32x4){kq[0], kq[1], kq[2], kq[3]};
          *(LAS u32x4*)(lds + L_VT + lane * RS + 16 * w) = (u32x4){vq[0], vq[1], vq[2], vq[3]};
          if (w == 7) ((LAS float*)(lds + L_DEND))[lane] = fast_exp2(off + p[7]); }
        asm volatile("s_waitcnt vmcnt(4)" ::: "memory");
        HG_BAR();
        f32x16 OT = f32x16{};
        if (w < 4) {
            bf16x8 bq[4];
#pragma unroll
            for (int ks = 0; ks < 4; ++ks) bq[ks] = *(const LAS bf16x8*)(lds + L_Q + (32 * tc + r32) * RS + (16 * ks + 8 * hi) * 2);
#pragma unroll
            for (int sr = 0; sr < 2; ++sr) if (sr <= tc) {
                f32x16 at = f32x16{};
#pragma unroll
                for (int ks = 0; ks < 4; ++ks) { const bf16x8 a = *(const LAS bf16x8*)(lds + L_K + (32 * sr + r32) * RS + (16 * ks + 8 * hi) * 2); at = __builtin_amdgcn_mfma_f32_32x32x16_bf16(a, bq[ks], at, 0, 0, 0); }
                if (sr == tc) {
#pragma unroll
                    for (int r = 0; r < 16; ++r) at[r] = (crow(r, hi) <= r32) ? at[r] : 0.f; }
#pragma unroll
                for (int st = 0; st < 2; ++st) {
                    u32x4 bw; bw.x = cvtpk(at[8 * st + 0], at[8 * st + 1]); bw.y = cvtpk(at[8 * st + 2], at[8 * st + 3]); bw.z = cvtpk(at[8 * st + 4], at[8 * st + 5]); bw.w = cvtpk(at[8 * st + 6], at[8 * st + 7]);
                    const u32x2 lo = *(const LAS u32x2*)(lds + L_VT + (32 * vr + r32) * RS + (32 * sr + 16 * st + 4 * hi) * 2);
                    const u32x2 hh = *(const LAS u32x2*)(lds + L_VT + (32 * vr + r32) * RS + (32 * sr + 16 * st + 8 + 4 * hi) * 2);
                    const u32x4 aw = (u32x4){lo.x, lo.y, hh.x, hh.y};
                    OT = __builtin_amdgcn_mfma_f32_32x32x16_bf16(__builtin_bit_cast(bf16x8, aw), __builtin_bit_cast(bf16x8, bw), OT, 0, 0, 0); }
            }
#pragma unroll
            for (int ks = 0; ks < 4; ++ks) { const bf16x8 a = *(const LAS bf16x8*)(lds + L_ST + (32 * vr + r32) * RS + (16 * ks + 8 * hi) * 2); OT = __builtin_amdgcn_mfma_f32_32x32x16_bf16(a, bq[ks], OT, 0, 0, 0); }
            float sq = 0.f;
#pragma unroll
            for (int r = 0; r < 16; ++r) sq += OT[r] * OT[r];
            sq += __shfl_xor(sq, 32);
            if (hi == 0) ((LAS float*)(lds + L_SSQ))[vr * 64 + 32 * tc + r32] = sq;
        } else {
#pragma unroll
            for (int st = 0; st < 4; ++st) { const bf16x8 a = *(const LAS bf16x8*)(lds + L_KT + (32 * vr + r32) * RS + (16 * st + 8 * hi) * 2);
                const bf16x8 bv = *(const LAS bf16x8*)(lds + L_VT + (32 * tc + r32) * RS + (16 * st + 8 * hi) * 2);
                S = __builtin_amdgcn_mfma_f32_32x32x16_bf16(a, bv, S, 0, 0, 0); }
#pragma unroll
            for (int r = 0; r < 16; ++r) S[r] *= ((LAS float*)(lds + L_DEND))[32 * vr + crow(r, hi)];
        }
        HG_BAR();
        if (w < 4) {
            const int t = 32 * tc + r32;
            const float tot = ((LAS float*)(lds + L_SSQ))[t] + ((LAS float*)(lds + L_SSQ))[64 + t];
            const float rstd = __builtin_amdgcn_rsqf(tot * (1.0f / 64.0f) + EPS);
            const LAS unsigned char* gp = lds + R_G + (c & 1) * G_SLOT + t * 128 + (32 * vr + 4 * hi) * 2;
            bf16_t* op = mix + (row0 + t) * D + 512 + h * 64 + 32 * vr + 4 * hi;
#pragma unroll
            for (int g = 0; g < 4; ++g) { const u32x2 gg = *(const LAS u32x2*)(gp + 16 * g);
                const float y0 = OT[4 * g + 0] * rstd * ng[4 * g + 0] * bflo(gg.x), y1 = OT[4 * g + 1] * rstd * ng[4 * g + 1] * bfhi(gg.x),
                            y2 = OT[4 * g + 2] * rstd * ng[4 * g + 2] * bflo(gg.y), y3 = OT[4 * g + 3] * rstd * ng[4 * g + 3] * bfhi(gg.y);
                *(u32x2*)(op + 8 * g) = (u32x2){cvtpk(y0, y1), cvtpk(y2, y3)}; }
        } else {
#pragma unroll
            for (int g = 0; g < 4; ++g) *(LAS u32x2*)(lds + L_ST + (32 * tc + r32) * RS + (32 * vr + 8 * g + 4 * hi) * 2) = (u32x2){cvtpk(S[4 * g + 0], S[4 * g + 1]), cvtpk(S[4 * g + 2], S[4 * g + 3])};
        }
    }
    asm volatile("s_waitcnt vmcnt(0)" ::: "memory");
    HG_BAR();
#undef DMA_FQV
#undef DMA_G
}
#undef HG_BAR
}

constexpr int NWAVES = 8;
constexpr int LDS_BYTES = 147456;
constexpr int TAIL = 145408;
constexpr int TL_TE = TAIL, TL_TS = TAIL + 576, TL_HIST = TAIL + 768, TL_BASE = TAIL + 896, TL_MISC = TAIL + 1024;
typedef GAS unsigned gu32;

struct Args { const float* in[20]; float* out; unsigned char* ws; int ph_lo, ph_hi; };

struct Frame {
    LAS unsigned char* lds; volatile LAS unsigned* MISC; unsigned* ctl;
    int tid, lane, wave, G, vcu;
};

struct P0Item { const float* W; bf16_t* WT; const float* gain; int N, K, k0, n0, mode; };
__device__ __forceinline__ bool p0_decode(const Args& a, int it, P0Item& I) {
    unsigned char* ws = a.ws;
    constexpr int I_IN = 16 * 56, I_SQ = 16 * 16, I_KV = 16 * 32, I_W1 = 16 * 32, I_W2 = 16 * 16;
    constexpr int NITEMS = I_IN + 3 * I_SQ + I_KV + NEXP * (I_W1 + I_W2);
    if (it >= NITEMS) return false;
    int r = it; I.gain = nullptr; I.mode = 0; I.K = D;
    if (r < I_IN) { I.W = a.in[3]; I.WT = (bf16_t*)(ws + WS_WIN); I.N = INC; }
    else if ((r -= I_IN) < I_SQ) { I.W = a.in[6]; I.WT = (bf16_t*)(ws + WS_WOUT); I.N = D; }
    else if ((r -= I_SQ) < I_SQ) { I.W = a.in[9]; I.WT = (bf16_t*)(ws + WS_WQ); I.N = D; I.gain = a.in[7]; }
    else if ((r -= I_SQ) < I_KV) { I.W = a.in[10]; I.WT = (bf16_t*)(ws + WS_WKV); I.N = 2 * D; }
    else if ((r -= I_KV) < I_SQ) { I.W = a.in[11]; I.WT = (bf16_t*)(ws + WS_WO); I.N = D; }
    else if ((r -= I_SQ) < NEXP * I_W1) { const int e = r / I_W1; r -= e * I_W1; I.W = a.in[15] + (size_t)e * D * 2048; I.WT = (bf16_t*)(ws + WS_W1) + (size_t)e * 2048 * D; I.N = 2048; I.gain = a.in[12]; I.mode = 1; }
    else { r -= NEXP * I_W1; const int e = r / I_W2; r -= e * I_W2; I.W = a.in[17] + (size_t)e * D * D; I.WT = (bf16_t*)(ws + WS_W2) + (size_t)e * D * D; I.N = D; }
    const int nblk = I.N / 64; I.k0 = 64 * (r / nblk); I.n0 = 64 * (r % nblk); return true;
}
__device__ __forceinline__ void p0_load(const P0Item& I, f32x4 (&v)[16], int lane) {
    const float* p = I.W + (size_t)(I.k0 + (lane >> 4)) * I.N + I.n0 + 4 * (lane & 15);
#pragma unroll
    for (int j = 0; j < 16; ++j) v[j] = *(const f32x4*)(p + (size_t)(4 * j) * I.N);
}
__device__ __forceinline__ void p0_store(const P0Item& I, const f32x4 (&v)[16], LAS unsigned char* tl, int lane) {
    const int kr = lane >> 4, nq = lane & 15;
#pragma unroll
    for (int j = 0; j < 16; ++j) { const int k = 4 * j + kr; const float g = I.gain ? I.gain[I.k0 + k] : 1.0f;
        *(LAS u32x2*)(tl + k * 128 + (((nq >> 1) ^ ((k >> 3) & 7)) * 16) + (nq & 1) * 8) = (u32x2){pk2(v[j].x * g, v[j].y * g), pk2(v[j].z * g, v[j].w * g)}; }
    LDS_WAIT(); asm volatile("" ::: "memory");
    const int c = lane & 7;
#pragma unroll
    for (int i = 0; i < 8; ++i) { const int n = (lane >> 3) + 8 * i; const LAS unsigned char* sp = tl + (8 * c) * 128 + ((i ^ c) * 16) + (n & 7) * 2;
        unsigned short e[8];
#pragma unroll
        for (int q = 0; q < 8; ++q) e[q] = *(const LAS unsigned short*)(sp + q * 128);
        int row = I.n0 + n; if (I.mode == 1) { const int jj = row >> 1, bj = row & 1; row = (jj >> 7) * 256 + bj * 128 + (jj & 127); }
        *(u32x4*)(I.WT + (size_t)row * I.K + I.k0 + 8 * c) = (u32x4){(unsigned)e[0] | ((unsigned)e[1] << 16), (unsigned)e[2] | ((unsigned)e[3] << 16), (unsigned)e[4] | ((unsigned)e[5] << 16), (unsigned)e[6] | ((unsigned)e[7] << 16)}; }
    LDS_WAIT(); asm volatile("" ::: "memory");
}
__device__ __forceinline__ void rms_rows2_to_bf16(const float* __restrict__ x0, const float* __restrict__ x1, const float* __restrict__ g, bf16_t* __restrict__ o0, bf16_t* __restrict__ o1, int lane) {
    const f32x4* xa = (const f32x4*)x0 + lane; const f32x4* xb = (const f32x4*)x1 + lane; const f32x4* gr = (const f32x4*)g + lane;
    f32x4 va[4], vb[4]; float sa = 0.f, sb = 0.f;
#pragma unroll
    for (int j = 0; j < 4; ++j) { va[j] = xa[64 * j]; vb[j] = xb[64 * j]; }
#pragma unroll
    for (int j = 0; j < 4; ++j) { sa += (va[j].x * va[j].x + va[j].y * va[j].y) + (va[j].z * va[j].z + va[j].w * va[j].w); sb += (vb[j].x * vb[j].x + vb[j].y * vb[j].y) + (vb[j].z * vb[j].z + vb[j].w * vb[j].w); }
    const float ra = 1.0f / sqrtf(wave_sum(sa) * (1.0f / D) + EPS), rb = 1.0f / sqrtf(wave_sum(sb) * (1.0f / D) + EPS);
    unsigned long long* pa = (unsigned long long*)o0 + lane; unsigned long long* pb = (unsigned long long*)o1 + lane;
#pragma unroll
    for (int j = 0; j < 4; ++j) { const f32x4 gg = gr[64 * j];
        pa[64 * j] = (unsigned long long)pk2(va[j].x * ra * gg.x, va[j].y * ra * gg.y) | ((unsigned long long)pk2(va[j].z * ra * gg.z, va[j].w * ra * gg.w) << 32);
        pb[64 * j] = (unsigned long long)pk2(vb[j].x * rb * gg.x, vb[j].y * rb * gg.y) | ((unsigned long long)pk2(vb[j].z * rb * gg.z, vb[j].w * rb * gg.w) << 32); }
}

__device__ __forceinline__ void p0_prologue(Frame& F, const Args& a) {
    unsigned char* ws = a.ws;
    LAS unsigned char* tl = F.lds + F.wave * 8192;
    const int gw = F.vcu * NWAVES + F.wave, NGW = F.G * NWAVES;
    for (int m = 2 * gw; m < T; m += 2 * NGW) rms_rows2_to_bf16(a.in[0] + (size_t)m * D, a.in[0] + (size_t)(m + 1) * D, a.in[2], (bf16_t*)(ws + WS_XN) + (size_t)m * D, (bf16_t*)(ws + WS_XN) + (size_t)(m + 1) * D, F.lane);
    for (int m = 2 * gw; m < MROWS; m += 2 * NGW) rms_rows2_to_bf16(a.in[1] + (size_t)m * D, a.in[1] + (size_t)(m + 1) * D, a.in[8], (bf16_t*)(ws + WS_MN) + (size_t)m * D, (bf16_t*)(ws + WS_MN) + (size_t)(m + 1) * D, F.lane);
    for (int i = gw * 64 + F.lane; i < NEXP * D; i += NGW * 64) { const int e = i >> 10, k = i & 1023; ((float*)(ws + WS_WRT))[i] = a.in[12][k] * a.in[13][k * NEXP + e]; }
    P0Item IA, IB; f32x4 va[16], vb[16];
    int it = gw; bool ha = p0_decode(a, it, IA); if (ha) p0_load(IA, va, F.lane);
    while (ha) {
        const bool hb = p0_decode(a, it + NGW, IB); if (hb) p0_load(IB, vb, F.lane);
        p0_store(IA, va, tl, F.lane);
        if (!hb) break;
        it += 2 * NGW; ha = p0_decode(a, it, IA); if (ha) p0_load(IA, va, F.lane);
        p0_store(IB, vb, tl, F.lane);
    }
}

__device__ __forceinline__ unsigned xcc_id() { return (unsigned)__builtin_amdgcn_s_getreg((3 << 11) | 20) & 0xFu; }
constexpr int QITEMS = 8 + 128;
__device__ __forceinline__ void p2_mixer(Frame& F, const Args& a, int rep) {
    unsigned char* ws = a.ws;
    const bf16_t* proj = (const bf16_t*)(ws + WS_PROJ); bf16_t* mix = (bf16_t*)(ws + WS_MIX);
    const unsigned x0 = xcc_id() & 7u;
    int par = 0;
    for (;;) {
        if (F.tid == 0) { int code = -1;
            for (int j = 0; j < 8; ++j) { const unsigned xq = (x0 + j) & 7u; const unsigned i = __hip_atomic_fetch_add(F.ctl + CW_QUEUE + 1024 * rep + 64 * xq, 1u, RLX_AGENT);
                if (i < (unsigned)QITEMS) { code = (int)(xq * 256u + i); break; } }
            F.MISC[par] = (unsigned)code; }
        LDS_WAIT(); __builtin_amdgcn_s_barrier(); asm volatile("" ::: "memory");
        const int code = __builtin_amdgcn_readfirstlane((int)F.MISC[par]); par ^= 1;
        if (code < 0) break;
        const int xq = code >> 8, i = code & 255;
#ifdef MK_P2_REPMODE
        if (rep && ((MK_P2_REPMODE == 1 && i >= 8) || (MK_P2_REPMODE == 2 && i < 8))) continue;
#endif
#ifndef NO_HGRN
        if (i < 8) { hgrn::hgrn_unit(xq, i, proj, mix, a.in[4], a.in[5], F.lds); }
        else
#endif
#ifndef NO_MOBA
        { const int j = i - 8, g = j >> 6, jj = j & 63, hh = 4 * g + (jj & 3), qb = 15 - (jj >> 2);
            moba::attn_unit<8>(xq, hh, qb, proj, proj + SEC_ELEMS, proj + 2 * SEC_ELEMS, mix, (const float*)(ws + WS_KBAR), (char*)(unsigned char*)F.lds); }
#else
        {}
#endif
    }
}

__device__ __forceinline__ void p7_router(Frame& F, const Args& a, int rep) {
    unsigned char* ws = a.ws;
    LAS float* WR = (LAS float*)F.lds;
    LAS int* hist = (LAS int*)(F.lds + TL_HIST); LAS int* basel = (LAS int*)(F.lds + TL_BASE);
    const float* wrt = (const float*)(ws + WS_WRT);
    for (int i = F.tid; i < NEXP * D / 4; i += 512) ((LAS f32x4*)WR)[i] = ((const f32x4*)wrt)[i];
    const float* h2f = (const float*)(ws + WS_H2F); const float* ss2 = (const float*)(ws + WS_SS2);
    int* toke = (int*)(ws + (rep ? WS_DUMMY + 1 * MiB : WS_TOKE)); int* tokr = (int*)(ws + (rep ? WS_DUMMY + 1 * MiB + 512 * 1024 : WS_TOKR)); float* tokg = (float*)(ws + (rep ? WS_DUMMY + 2 * MiB : WS_TOKG)); int* list = (int*)(ws + (rep ? WS_DUMMY + 4 * MiB : WS_LIST));
    unsigned* cntw = F.ctl + (rep ? CW_CNT + 2048 * rep : CW_CNT);
    const int lane = F.lane;
    const float brl = a.in[14][lane >> 1];
    for (int tb = blockIdx.x; tb < T / 128; tb += F.G) {
        if (F.tid < 32) hist[F.tid] = 0;
        LDS_WAIT(); __builtin_amdgcn_s_barrier(); asm volatile("" ::: "memory");
        int my_e = 0; float my_g = 0.f;
        for (int ig = 0; ig < 8; ++ig) {
            const int tq = tb * 128 + F.wave * 16 + ig * 2;
            f32x4 x[2][4];
#pragma unroll
            for (int q = 0; q < 2; ++q)
#pragma unroll
                for (int j = 0; j < 4; ++j) x[q][j] = *(const f32x4*)(h2f + (size_t)(tq + q) * D + 4 * lane + 256 * j);
            float v16[2][16];
            { const bool up = (lane & 32) != 0;
#pragma unroll
              for (int e = 0; e < 16; ++e) { float s0[2] = {0.f, 0.f}, s1[2] = {0.f, 0.f};
#pragma unroll
                  for (int j = 0; j < 4; ++j) { const f32x4 w0 = *(const LAS f32x4*)(WR + e * D + 4 * lane + 256 * j), w1 = *(const LAS f32x4*)(WR + (16 + e) * D + 4 * lane + 256 * j);
#pragma unroll
                      for (int q = 0; q < 2; ++q) { s0[q] += (x[q][j].x * w0.x + x[q][j].y * w0.y) + (x[q][j].z * w0.z + x[q][j].w * w0.w); s1[q] += (x[q][j].x * w1.x + x[q][j].y * w1.y) + (x[q][j].z * w1.z + x[q][j].w * w1.w); } }
#pragma unroll
                  for (int q = 0; q < 2; ++q) { const float send = up ? s0[q] : s1[q], keep = up ? s1[q] : s0[q]; v16[q][e] = keep + __shfl_xor(send, 32); }
                  asm volatile("" ::: "memory"); } }
#pragma unroll
            for (int q = 0; q < 2; ++q) {
                float v8[8], v4[4], v2[2];
                { const bool up = (lane & 16) != 0;
#pragma unroll
                  for (int e = 0; e < 8; ++e) { const float send = up ? v16[q][e] : v16[q][8 + e], keep = up ? v16[q][8 + e] : v16[q][e]; v8[e] = keep + __shfl_xor(send, 16); } }
                { const bool up = (lane & 8) != 0;
#pragma unroll
                  for (int e = 0; e < 4; ++e) { const float send = up ? v8[e] : v8[4 + e], keep = up ? v8[4 + e] : v8[e]; v4[e] = keep + __shfl_xor(send, 8); } }
                { const bool up = (lane & 4) != 0;
#pragma unroll
                  for (int e = 0; e < 2; ++e) { const float send = up ? v4[e] : v4[2 + e], keep = up ? v4[2 + e] : v4[e]; v2[e] = keep + __shfl_xor(send, 4); } }
                float v1; { const bool up = (lane & 2) != 0; const float send = up ? v2[0] : v2[1], keep = up ? v2[1] : v2[0]; v1 = keep + __shfl_xor(send, 2); }
                v1 += __shfl_xor(v1, 1);
                float cur = v1 * __builtin_amdgcn_rsqf(ss2[tq + q] * (1.0f / D) + EPS) + brl;
                float tv[4]; int te_[4];
#pragma unroll
                for (int k = 0; k < 4; ++k) { float m = cur;
#pragma unroll
                    for (int o = 1; o < 64; o <<= 1) m = fmaxf(m, __shfl_xor(m, o));
                    const unsigned long long bal = __ballot(cur == m); const int li = __builtin_ctzll(bal); const int e = li >> 1;
                    tv[k] = m; te_[k] = e; if ((lane >> 1) == e) cur = -INFINITY; }
                const float d1 = fast_exp2((tv[1] - tv[0]) * LOG2E), d2 = fast_exp2((tv[2] - tv[0]) * LOG2E), d3 = fast_exp2((tv[3] - tv[0]) * LOG2E);
                const float inv = 1.0f / (1.0f + d1 + d2 + d3);
                if ((lane >> 2) == ig * 2 + q) { const int k = lane & 3; my_e = k == 0 ? te_[0] : (k == 1 ? te_[1] : (k == 2 ? te_[2] : te_[3])); my_g = (k == 0 ? 1.0f : (k == 1 ? d1 : (k == 2 ? d2 : d3))) * inv; }
            }
        }
        const int rl = __hip_atomic_fetch_add(hist + my_e, 1, __ATOMIC_RELAXED, __HIP_MEMORY_SCOPE_WORKGROUP);
        LDS_WAIT(); __builtin_amdgcn_s_barrier(); asm volatile("" ::: "memory");
        if (F.tid < 32) basel[F.tid] = (int)__hip_atomic_fetch_add(cntw + F.tid, (unsigned)hist[F.tid], RLX_AGENT);
        LDS_WAIT(); VM_WAIT(); __builtin_amdgcn_s_barrier(); asm volatile("" ::: "memory");
        { const int t = tb * 128 + F.wave * 16 + (lane >> 2), k = lane & 3; const int rank = basel[my_e] + rl;
          toke[t * 4 + k] = my_e; tokr[t * 4 + k] = rank; tokg[t * 4 + k] = my_g; list[(size_t)my_e * T + rank] = t; }
        LDS_WAIT(); __builtin_amdgcn_s_barrier(); asm volatile("" ::: "memory");
    }
}

__device__ __forceinline__ int build_tables(Frame& F) {
    LAS int* ts = (LAS int*)(F.lds + TL_TS); LAS unsigned char* te = (LAS unsigned char*)(F.lds + TL_TE);
    if (F.tid == 0) { int run = 0;
        for (int e = 0; e < NEXP; ++e) { ts[e] = run; const unsigned c = __hip_atomic_load(F.ctl + CW_CNT + e, RLX_AGENT); run += (int)((c + 255u) >> 8); }
        ts[NEXP] = run; }
    LDS_WAIT(); __builtin_amdgcn_s_barrier(); asm volatile("" ::: "memory");
    const int nt = ts[NEXP];
    for (int g = F.tid; g < nt; g += 512) { int e = 0;
        for (int j = 1; j < NEXP; ++j) e += (ts[j] <= g) ? 1 : 0;
        te[g] = (unsigned char)e; }
    LDS_WAIT(); __builtin_amdgcn_s_barrier(); asm volatile("" ::: "memory");
    return __builtin_amdgcn_readfirstlane(nt);
}

__device__ __forceinline__ void p10_combine(Frame& F, const Args& a) {
    unsigned char* ws = a.ws;
    LAS int* ts = (LAS int*)(F.lds + TL_TS);
    const float* h2f = (const float*)(ws + WS_H2F); const bf16_t* Y = (const bf16_t*)(ws + WS_Y);
    const int* toke = (const int*)(ws + WS_TOKE); const int* tokr = (const int*)(ws + WS_TOKR); const float* tokg = (const float*)(ws + WS_TOKG);
    const float* gf = a.in[19];
    const int gw = F.vcu * NWAVES + F.wave, NGW = F.G * NWAVES, lane = F.lane;
    for (int t = gw; t < T; t += NGW) {
        float o[16];
        { const f32x4 a0 = *(const f32x4*)(h2f + (size_t)t * D + 8 * lane), a1 = *(const f32x4*)(h2f + (size_t)t * D + 8 * lane + 4), a2 = *(const f32x4*)(h2f + (size_t)t * D + 512 + 8 * lane), a3 = *(const f32x4*)(h2f + (size_t)t * D + 512 + 8 * lane + 4);
          o[0] = a0.x; o[1] = a0.y; o[2] = a0.z; o[3] = a0.w; o[4] = a1.x; o[5] = a1.y; o[6] = a1.z; o[7] = a1.w; o[8] = a2.x; o[9] = a2.y; o[10] = a2.z; o[11] = a2.w; o[12] = a3.x; o[13] = a3.y; o[14] = a3.z; o[15] = a3.w; }
#pragma unroll
        for (int k = 0; k < 4; ++k) { const int e = toke[t * 4 + k], r = tokr[t * 4 + k]; const float g = tokg[t * 4 + k];
            const bf16_t* yr = Y + ((size_t)ts[e] * 256 + r) * D;
            const u32x4 y0 = *(const u32x4*)(yr + 8 * lane), y1 = *(const u32x4*)(yr + 512 + 8 * lane);
            o[0] += g * bflo(y0.x); o[1] += g * bfhi(y0.x); o[2] += g * bflo(y0.y); o[3] += g * bfhi(y0.y); o[4] += g * bflo(y0.z); o[5] += g * bfhi(y0.z); o[6] += g * bflo(y0.w); o[7] += g * bfhi(y0.w);
            o[8] += g * bflo(y1.x); o[9] += g * bfhi(y1.x); o[10] += g * bflo(y1.y); o[11] += g * bfhi(y1.y); o[12] += g * bflo(y1.z); o[13] += g * bfhi(y1.z); o[14] += g * bflo(y1.w); o[15] += g * bfhi(y1.w); }
        float s = 0.f;
#pragma unroll
        for (int j = 0; j < 16; ++j) s += o[j] * o[j];
        const float rstd = 1.0f / sqrtf(wave_sum(s) * (1.0f / D) + EPS);
        float* op = a.out + (size_t)t * D;
#pragma unroll
        for (int q = 0; q < 4; ++q) { const int col = (q >> 1) * 512 + 8 * lane + (q & 1) * 4; const f32x4 g4 = *(const f32x4*)(gf + col);
            *(f32x4*)(op + col) = (f32x4){o[4 * q] * rstd * g4.x, o[4 * q + 1] * rstd * g4.y, o[4 * q + 2] * rstd * g4.z, o[4 * q + 3] * rstd * g4.w}; }
    }
}

#define XB_TMO      128
#define XB_XCNT(j)  (256  + 64 * (j))
#define XB_XSUB(j)  (1280 + 64 * (j))
#define XB_XGEN(j)  (2304 + 64 * (j))
#define XB_TOP      3328
#define XB_TOPGEN   3392
#define XCD_BAR_WORDS 3456
#define XB_SPIN_CAP (1u << 22)
__device__ __forceinline__ unsigned xb_ld(unsigned* p)              { return __hip_atomic_load(p, __ATOMIC_RELAXED, __HIP_MEMORY_SCOPE_AGENT); }
__device__ __forceinline__ unsigned xb_add(unsigned* p, unsigned v) { return __hip_atomic_fetch_add(p, v, __ATOMIC_RELAXED, __HIP_MEMORY_SCOPE_AGENT); }
#define XB_SPIN(cond, bar) do { unsigned _sp = 0; while (cond) { __builtin_amdgcn_s_sleep(1); \
    if ((++_sp & 255u) == 0u) { if (xb_ld(&(bar)[XB_TMO])) break; if (_sp > XB_SPIN_CAP) { atomicAdd(&(bar)[XB_TMO], 1u); break; } } } } while (0)
struct XcdBarrier { unsigned* bar; unsigned x; volatile LAS unsigned* st; };
__device__ __forceinline__ XcdBarrier xcd_barrier_post(unsigned* bar, volatile LAS unsigned* st) {
    XcdBarrier b; b.bar = bar; b.x = (unsigned)__builtin_amdgcn_s_getreg((3 << 11) | 20) & 0xFu; b.st = st;
    if (threadIdx.x == 0) (void)xb_add(&bar[XB_XCNT(b.x)], 1u);
    return b;
}
__device__ __forceinline__ void xcd_barrier_complete(unsigned* bar, unsigned x, unsigned& nloc, unsigned& nx) {
    const unsigned G = gridDim.x * gridDim.y * gridDim.z;
    unsigned sum, cnt, mine, sp = 0u;
    for (;;) {
        sum = 0u; cnt = 0u; mine = 0u;
#pragma unroll
        for (unsigned j = 0; j < 16; ++j) { const unsigned c = xb_ld(&bar[XB_XCNT(j)]); sum += c; cnt += (c > 0u) ? 1u : 0u; mine = (j == x) ? c : mine; }
        if (sum == G) break;
        __builtin_amdgcn_s_sleep(1);
        if ((++sp & 255u) == 0u) { if (xb_ld(&bar[XB_TMO])) break; if (sp > XB_SPIN_CAP) { atomicAdd(&bar[XB_TMO], 1u); break; } }
    }
    nloc = mine > 0u ? mine : 1u; nx = cnt > 0u ? cnt : 1u;
}
__device__ __forceinline__ void xcd_barrier(const XcdBarrier& b) {
    asm volatile("s_waitcnt vmcnt(0)" ::: "memory");
    __syncthreads();
    if (threadIdx.x == 0) {
        unsigned* bar = b.bar;
        __builtin_amdgcn_s_waitcnt(0);
        unsigned nloc = b.st[0], nx = b.st[1];
        if (nloc == 0u) { xcd_barrier_complete(bar, b.x, nloc, nx); b.st[0] = nloc; b.st[1] = nx; }
        const unsigned old = xb_add(&bar[XB_XSUB(b.x)], 1u);
        const unsigned gen = old / nloc;
        if (old + 1u == (gen + 1u) * nloc) {
            __builtin_amdgcn_fence(__ATOMIC_RELEASE, "agent");
            asm volatile("s_waitcnt vmcnt(0)" ::: "memory");
            const unsigned og = xb_add(&bar[XB_TOP], 1u);
            const unsigned tg = og / nx;
            if (og + 1u == (tg + 1u) * nx) xb_add(&bar[XB_TOPGEN], 1u);
            else XB_SPIN(xb_ld(&bar[XB_TOPGEN]) == tg, bar);
            __builtin_amdgcn_fence(__ATOMIC_ACQUIRE, "agent");
            xb_add(&bar[XB_XGEN(b.x)], 1u);
            asm volatile("s_waitcnt vmcnt(0)" ::: "memory");
        } else {
            XB_SPIN(xb_ld(&bar[XB_XGEN(b.x)]) == gen, bar);
            __builtin_amdgcn_fence(__ATOMIC_ACQUIRE, "agent");
            asm volatile("s_waitcnt vmcnt(0)" ::: "memory");
        }
    }
    __syncthreads();
}
#ifndef MK_CG_ONLY
#define MK_CG_ONLY 0
#endif
__device__ __forceinline__ void grid_barrier(Frame& F, const XcdBarrier& xb_) { if (MK_CG_ONLY) cg::this_grid().sync(); else xcd_barrier(xb_); }
#ifndef MK_PHASE_MASK
#define MK_PHASE_MASK 0x7ff
#endif
#ifndef MK_REP_PHASE
#define MK_REP_PHASE -1
#endif
#ifndef MK_REP_N
#define MK_REP_N 0
#endif
__device__ __forceinline__ void ph0(Frame& F, const Args& args, int rep) { p0_prologue(F, args); }
__device__ __forceinline__ void ph1(Frame& F, const Args& args, int rep) {
    unsigned char* ws = args.ws; const int cid = (int)blockIdx.x;
    { pg8::DenseOrder S{(const char*)(ws + WS_XN), (const char*)(ws + WS_WIN), D, D, T / 256, INC / 256, F.G, cid};
      pg8::EpiProj E{(bf16_t*)(ws + WS_PROJ), rep ? (float*)(ws + WS_DUMMY) : (float*)(ws + WS_KBAR)};
      pg8::gemm_phase<pg8::EpiProj, pg8::DenseOrder, false, true>(F.lds, D, D, D / 64, S, E); }
    { pg8::KvOrder S{(const char*)(ws + WS_MN), (const char*)(ws + WS_WKV), F.G, cid};
      pg8::EpiBf16 E{(bf16_t*)(ws + WS_MEMK), D, (bf16_t*)(ws + WS_MEMVT), MROWS};
      pg8::gemm_phase<pg8::EpiBf16, pg8::KvOrder, false, true>(F.lds, D, D, D / 64, S, E); }
}
__device__ __forceinline__ void ph2(Frame& F, const Args& args, int rep) { p2_mixer(F, args, rep); }
__device__ __forceinline__ void ph3(Frame& F, const Args& args, int rep) {
    unsigned char* ws = args.ws; const int cid = (int)blockIdx.x;
    pg8::DenseOrder S{(const char*)(ws + WS_MIX), (const char*)(ws + WS_WOUT), D, D, T / 256, D / 256, F.G, cid};
    pg8::EpiRes<true, false> E{(const void*)args.in[0], (bf16_t*)(ws + WS_H1B), nullptr, rep ? (float*)(ws + WS_DUMMY + 512 * 1024) : (float*)(ws + WS_SS1)};
    pg8::gemm_phase<pg8::EpiRes<true, false>, pg8::DenseOrder, false, true>(F.lds, D, D, D / 64, S, E);
}
__device__ __forceinline__ void ph4(Frame& F, const Args& args, int rep) {
    unsigned char* ws = args.ws; const int cid = (int)blockIdx.x;
    pg8::DenseOrder S{(const char*)(ws + WS_H1B), (const char*)(ws + WS_WQ), D, D, T / 256, D / 256, F.G, cid};
    pg8::EpiQ E{(bf16_t*)(ws + WS_QX), (const float*)(ws + WS_SS1)};
    pg8::gemm_phase<pg8::EpiQ, pg8::DenseOrder, false, true>(F.lds, D, D, D / 64, S, E);
}
__device__ __forceinline__ void ph5(Frame& F, const Args& args, int rep) {
    unsigned char* ws = args.ws; const int cid = (int)blockIdx.x;
    bf16_t* pw = (bf16_t*)(ws + WS_PWS) + (size_t)cid * 2 * 65536;
    for (int s = 0; s < 2; ++s) {
        pg8::XaScoreOrder S{(const char*)(ws + WS_QX), (const char*)(ws + WS_MEMK), cid + s * F.G};
        pg8::EpiSoftmax E{pw + (size_t)s * 65536};
        pg8::gemm_phase<pg8::EpiSoftmax, pg8::XaScoreOrder, false, false>(F.lds, D, D, 4, S, E);
    }
    VM_WAIT(); __syncthreads(); __builtin_amdgcn_fence(__ATOMIC_ACQUIRE, "agent"); __syncthreads();
    { pg8::XaPvOrder S{(const char*)pw, (const char*)(ws + WS_MEMVT), F.G, cid};
      pg8::EpiBf16 E{(bf16_t*)(ws + WS_OX), D, (bf16_t*)(ws + WS_OX), D};
      pg8::gemm_phase<pg8::EpiBf16, pg8::XaPvOrder, false, true>(F.lds, 256, MROWS, 4, S, E); }
}
__device__ __forceinline__ void ph6(Frame& F, const Args& args, int rep) {
    unsigned char* ws = args.ws; const int cid = (int)blockIdx.x;
    pg8::DenseOrder S{(const char*)(ws + WS_OX), (const char*)(ws + WS_WO), D, D, T / 256, D / 256, F.G, cid};
    pg8::EpiRes<false, true> E{(const void*)(ws + WS_H1B), (bf16_t*)(ws + WS_H2B), (float*)(ws + WS_H2F), rep ? (float*)(ws + WS_DUMMY + 512 * 1024) : (float*)(ws + WS_SS2)};
    pg8::gemm_phase<pg8::EpiRes<false, true>, pg8::DenseOrder, false, true>(F.lds, D, D, D / 64, S, E);
}
__device__ __forceinline__ void ph7(Frame& F, const Args& args, int rep) { p7_router(F, args, rep); }
__device__ __forceinline__ void ph8(Frame& F, const Args& args, int rep) {
    unsigned char* ws = args.ws; const int cid = (int)blockIdx.x;
    const int ntl = build_tables(F);
    pg8::MoeOrder S{(const char*)(ws + WS_H2B), (const char*)(ws + WS_W1), (const int*)(ws + WS_LIST), F.ctl + CW_CNT, (const LAS unsigned char*)(F.lds + TL_TE), (const LAS int*)(F.lds + TL_TS),
                    ntl, 8, F.G, cid, (size_t)2048 * D * 2, 1};
    pg8::EpiW1 E{(bf16_t*)(ws + WS_HMID), (const float*)(ws + WS_SS2), args.in[16]};
    pg8::gemm_phase<pg8::EpiW1, pg8::MoeOrder, true, true>(F.lds, D, D, D / 64, S, E);
}
__device__ __forceinline__ void ph9(Frame& F, const Args& args, int rep) {
    unsigned char* ws = args.ws; const int cid = (int)blockIdx.x;
    const int ntl = build_tables(F);
    pg8::MoeOrder S{(const char*)(ws + WS_HMID), (const char*)(ws + WS_W2), (const int*)(ws + WS_LIST), F.ctl + CW_CNT, (const LAS unsigned char*)(F.lds + TL_TE), (const LAS int*)(F.lds + TL_TS),
                    ntl, 4, F.G, cid, (size_t)D * D * 2, 0};
    pg8::EpiW2 E{(bf16_t*)(ws + WS_Y), args.in[18]};
    pg8::gemm_phase<pg8::EpiW2, pg8::MoeOrder, false, true>(F.lds, D, D, D / 64, S, E);
}
__device__ __forceinline__ void ph10(Frame& F, const Args& args, int rep) { (void)build_tables(F); p10_combine(F, args); }

constexpr int N_PHASES = 11;
__global__ void __launch_bounds__(NWAVES * 64, 2) hymba_fwd(Args args) {
    extern __shared__ __attribute__((aligned(16))) unsigned char lds_raw[];
    Frame F;
    F.lds = (LAS unsigned char*)lds_raw;
    F.MISC = (volatile LAS unsigned*)(F.lds + TL_MISC);
    F.tid = threadIdx.x; F.lane = F.tid & 63; F.wave = __builtin_amdgcn_readfirstlane(F.tid >> 6);
    F.G = gridDim.x; { const int bx = blockIdx.x; F.vcu = (F.G % 8 == 0) ? (bx % 8) * (F.G / 8) + bx / 8 : bx; }
    F.ctl = (unsigned*)(args.ws + WS_CTL);
    const int lo = args.ph_lo, hi = args.ph_hi;
    for (int u = F.tid; u < 64; u += NWAVES * 64) ((LAS unsigned*)(F.lds + TL_MISC))[u] = 0u;
    __syncthreads();
    const XcdBarrier xbar = xcd_barrier_post(F.ctl + CW_BAR, F.MISC + 8);
#define RUN(k, fn) do { if (((MK_PHASE_MASK >> (k)) & 1) && lo <= (k) && (k) < hi) { fn(F, args, 0); \
        if (MK_REP_PHASE == (k) && MK_REP_N >= 1) { grid_barrier(F, xbar); fn(F, args, 1); } \
        if (MK_REP_PHASE == (k) && MK_REP_N >= 2) { grid_barrier(F, xbar); fn(F, args, 2); } \
        if ((k) + 1 < hi) { if ((k) == 0) cg::this_grid().sync(); else grid_barrier(F, xbar); } } } while (0)
    RUN(0, ph0); RUN(1, ph1); RUN(2, ph2); RUN(3, ph3); RUN(4, ph4); RUN(5, ph5); RUN(6, ph6); RUN(7, ph7); RUN(8, ph8); RUN(9, ph9); RUN(10, ph10);
#undef RUN
}

extern "C" void kernel_launch(void* const* d_in, const int* in_sizes, int n_in, void* d_out, int out_size, void* d_ws, size_t ws_size, hipStream_t stream) {
    static int grid = 0;
    if (grid == 0) {
        if (n_in != 20 || in_sizes[0] != T * D || out_size != T * D || ws_size < WS_END) {
            fprintf(stderr, "kernel_launch: shape/workspace mismatch (n_in %d, in0 %d, out %d, ws %zu, need %zu)\n", n_in, n_in > 0 ? in_sizes[0] : -1, out_size, ws_size, (size_t)WS_END); grid = -1; return; }
        int dev = 0, cus = 0, per_cu = 0;
        if (hipGetDevice(&dev) != hipSuccess || hipDeviceGetAttribute(&cus, hipDeviceAttributeMultiprocessorCount, dev) != hipSuccess) { grid = -1; return; }
        if (hipFuncSetAttribute((const void*)hymba_fwd, hipFuncAttributeMaxDynamicSharedMemorySize, LDS_BYTES) != hipSuccess) { fprintf(stderr, "kernel_launch: hipFuncSetAttribute failed\n"); grid = -1; return; }
        if (hipOccupancyMaxActiveBlocksPerMultiprocessor(&per_cu, (const void*)hymba_fwd, NWAVES * 64, LDS_BYTES) != hipSuccess || per_cu < 1) { fprintf(stderr, "kernel_launch: occupancy query says %d\n", per_cu); }
        (void)hipGetLastError();
        grid = cus;
        if (grid != 256) fprintf(stderr, "kernel_launch: %d CUs; this kernel is built for 256\n", grid);
    }
    if (grid < 0) return;
    (void)hipMemsetAsync((char*)d_ws + WS_CTL, 0, CTL_ZERO_BYTES, stream);
    Args a{};
    for (int i = 0; i < 20; ++i) a.in[i] = (const float*)d_in[i];
    a.out = (float*)d_out; a.ws = (unsigned char*)d_ws;
#if MK_N_LAUNCHES == 1
    a.ph_lo = 0; a.ph_hi = MK_LAST_PHASE + 1;
    void* kargs[] = {&a};
    hipError_t e = hipLaunchCooperativeKernel((const void*)hymba_fwd, dim3(grid), dim3(NWAVES * 64), kargs, LDS_BYTES, stream);
    if (e != hipSuccess) fprintf(stderr, "kernel_launch: cooperative launch failed: %s\n", hipGetErrorString(e));
#else
    for (int p = 0; p <= MK_LAST_PHASE; ++p) { a.ph_lo = p; a.ph_hi = p + 1; hipLaunchKernelGGL(hymba_fwd, dim3(grid), dim3(NWAVES * 64), LDS_BYTES, stream, a); }
#endif
}
```

```cpp
#include <hip/hip_runtime.h>
#include <hip/hip_cooperative_groups.h>
#include <cstdio>
#include <cstdint>
namespace cg = cooperative_groups;

#ifndef MK_N_LAUNCHES
#define MK_N_LAUNCHES 1
#endif
#ifndef MK_LAST_PHASE
#define MK_LAST_PHASE 10
#endif

#define LAS __attribute__((address_space(3)))
#define GAS __attribute__((address_space(1)))
typedef unsigned short bf16_t;
typedef short bf16x8 __attribute__((ext_vector_type(8)));
typedef short s16x4 __attribute__((ext_vector_type(4)));
typedef float f32x4 __attribute__((ext_vector_type(4)));
typedef float f32x2 __attribute__((ext_vector_type(2)));
typedef float f32x16 __attribute__((ext_vector_type(16)));
typedef unsigned u32x4 __attribute__((ext_vector_type(4)));
typedef unsigned u32x2 __attribute__((ext_vector_type(2)));
typedef int v8i32_t __attribute__((ext_vector_type(8)));

constexpr int BATCH = 8, SEQ = 4096, T = BATCH * SEQ, D = 1024, INC = 3584, NMEM = 256, MROWS = BATCH * NMEM;
constexpr int NEXP = 32, TOPK = 4, MT_MAX = T * TOPK / 256 + NEXP, MPAD = MT_MAX * 256;
constexpr float EPS = 1e-6f;
constexpr float LOG2E = 1.4426950408889634f;
constexpr float C2Q = 0.125f * LOG2E;
constexpr float C2X = 0.0625f * LOG2E;
constexpr int C_MQ = 0, C_MK = 512, C_MV = 1024, C_GQ = 1536, C_GF = 2048, C_GI = 2560, C_GG = 3072;

constexpr size_t MiB = 1u << 20;
constexpr size_t WS_CTL = 0, CTL_ZERO_BYTES = 2 * MiB;
constexpr size_t WS_KBAR = 1 * MiB;
constexpr size_t WS_SS1 = 1 * MiB + 256 * 1024;
constexpr size_t WS_SS2 = 1 * MiB + 384 * 1024;
constexpr size_t WS_TOKE = 2 * MiB, WS_TOKR = 2 * MiB + 512 * 1024, WS_TOKG = 3 * MiB;
constexpr size_t WS_WRT = 3 * MiB + 512 * 1024;
constexpr size_t WS_LIST = 4 * MiB;
constexpr size_t WS_WIN = 16 * MiB, WS_WOUT = 23 * MiB, WS_WQ = 25 * MiB, WS_WKV = 27 * MiB, WS_WO = 31 * MiB;
constexpr size_t WS_MN = 33 * MiB, WS_MEMK = 37 * MiB, WS_MEMVT = 41 * MiB;
constexpr size_t WS_W1 = 48 * MiB, WS_W2 = 176 * MiB;
constexpr size_t WS_PROJ = 240 * MiB;
constexpr size_t SEC_ELEMS = (size_t)16 * 1024 * 1024;
constexpr size_t WS_XN = 464 * MiB;
constexpr size_t WS_OX = 464 * MiB;
constexpr size_t WS_MIX = 528 * MiB;
constexpr size_t WS_H1B = 592 * MiB;
constexpr size_t WS_QX = 656 * MiB;
constexpr size_t WS_PWS = 720 * MiB;
constexpr size_t WS_HMID = 240 * MiB;
constexpr size_t WS_Y = 512 * MiB;
constexpr size_t WS_H2F = 784 * MiB;
constexpr size_t WS_H2B = 912 * MiB;
constexpr size_t WS_DUMMY = 976 * MiB;
constexpr size_t WS_END = 984 * MiB;
static_assert(WS_HMID + (size_t)MPAD * D * 2 <= WS_Y && WS_Y + (size_t)MPAD * D * 2 <= WS_H2F, "ws map");
constexpr int CW_TMO = 0;
constexpr int CW_CNT = 64;
constexpr int CW_QUEUE = 128;
constexpr int CW_BAR = 4096;

__device__ __forceinline__ unsigned f2bf(float f) { unsigned u = __builtin_bit_cast(unsigned, f); return (u + 0x7fffu + ((u >> 16) & 1u)) >> 16; }
__device__ __forceinline__ unsigned pk2(float lo, float hi) { return f2bf(lo) | (f2bf(hi) << 16); }
__device__ __forceinline__ float bf2f(unsigned short h) { return __builtin_bit_cast(float, (unsigned)h << 16); }
__device__ __forceinline__ float bflo(unsigned w) { return __builtin_bit_cast(float, w << 16); }
__device__ __forceinline__ float bfhi(unsigned w) { return __builtin_bit_cast(float, w & 0xffff0000u); }
typedef float f32x2_t __attribute__((ext_vector_type(2))); typedef __bf16 bf16x2_t __attribute__((ext_vector_type(2)));
__device__ __forceinline__ unsigned cvtpk(float lo, float hi) { f32x2_t v = {lo, hi}; bf16x2_t b = __builtin_convertvector(v, bf16x2_t); return __builtin_bit_cast(unsigned, b); }
__device__ __forceinline__ float wave_sum(float v) {
#pragma unroll
    for (int o = 1; o < 64; o <<= 1) v += __shfl_xor(v, o);
    return v;
}
__device__ __forceinline__ float fast_exp2(float x) { return __builtin_amdgcn_exp2f(x); }
__device__ __forceinline__ float fast_rcp(float x) { return __builtin_amdgcn_rcpf(x); }
__device__ __forceinline__ float silu_f(float x) { return x * fast_rcp(1.0f + fast_exp2(-x * LOG2E)); }
__device__ __forceinline__ unsigned pk4_fp8(float a, float b, float c, float d) { int w = 0; w = __builtin_amdgcn_cvt_pk_fp8_f32(a, b, w, false); w = __builtin_amdgcn_cvt_pk_fp8_f32(c, d, w, true); return (unsigned)w; }
constexpr float WSCALE8 = 32.0f, WSCALE8_INV = 1.0f / 32.0f;
#define LDS_WAIT() asm volatile("s_waitcnt lgkmcnt(0)" ::: "memory")
#define VM_WAIT() asm volatile("s_waitcnt vmcnt(0)" ::: "memory")
#define RLX_AGENT __ATOMIC_RELAXED, __HIP_MEMORY_SCOPE_AGENT

namespace pg8 {
constexpr int BM = 256, BK = 64, HALF = 128, HTB = HALF * BK * 2, STAGE_BYTES = 8 * HTB;
__device__ __forceinline__ void glds16s(const char* sbase, unsigned voff, unsigned lds_dst) { unsigned keep;
    asm volatile("s_mov_b32 %0, m0\n\ts_mov_b32 m0, %3\n\ts_nop 0\n\tglobal_load_lds_dwordx4 %1, %2\n\ts_mov_b32 m0, %0" : "=&s"(keep) : "v"(voff), "s"(sbase), "s"(lds_dst) : "memory"); }
__host__ __device__ __forceinline__ int lds_byte(int r, int c) { const int st = (r >> 4) * 2 + (c >> 5), rr = r & 15, cc = c & 31, ob = rr * 64 + cc * 2; return st * 1024 + (ob ^ (((ob >> 9) & 1) << 5)); }
__host__ __device__ __forceinline__ void stage_rc(int b, int& R, int& C) { const int st = b / 1024, sb = b % 1024, swz = sb ^ (((sb >> 9) & 1) << 5); R = (st >> 1) * 16 + swz / 64; C = (st & 1) * 32 + (swz % 64) / 2; }
__host__ __device__ __forceinline__ int perm32(int rho) { const int n = rho >> 4, i = rho & 15; return 8 * (i >> 2) + 4 * n + (i & 3); }

struct Unit { const char* A; const char* B; const int* rows; int pm, pn, aux, nrows; };

template <class Epi, class Sched, bool GATHER, bool ALIGN_EPI, bool FP8 = false>
__device__ __forceinline__ void gemm_phase(LAS unsigned char* lds, const int lda, const int ldb, const int nt_in, const Sched& S, const Epi& E) {
    int nt = nt_in; asm volatile("" : "+s"(nt));
    int tid_ = threadIdx.x; asm volatile("" : "+v"(tid_));
    const int tid = tid_, wid = __builtin_amdgcn_readfirstlane(tid >> 6), lane = tid & 63, wr = wid >> 2, wc = wid & 3, fr = lane & 15, fq = lane >> 4;
    unsigned offB0; { int R, C; stage_rc(tid * 16, R, C); const int Rb = Epi::PERM ? ((R & ~31) + perm32(R & 31)) : R; offB0 = (unsigned)(Rb * ldb + C) * 2u; }
    const size_t pstepB = (size_t)64 * ldb * 2;
    const size_t kstep = (size_t)(BK * 2);
    const size_t hstepB = (size_t)HALF * ldb * 2;
    const unsigned ldsb = (unsigned)__builtin_amdgcn_readfirstlane((int)((unsigned)(uintptr_t)(unsigned char*)lds + (unsigned)wid * 1024u));
    const int aoff = lds_byte(wr * 64 + fr, FP8 ? fq * 16 : fq * 8), boff = lds_byte(wc * 32 + fr, FP8 ? fq * 16 : fq * 8);
#define PG8_SA(b, h) (((b) * 2 + (h)) * HTB)
#define PG8_SB(b, h) ((4 + (b) * 2 + (h)) * HTB)
#define PG8_STGB(bufoff, gbase) do { glds16s((const char*)(gbase), offB0, ldsb + (unsigned)(bufoff)); glds16s((const char*)(gbase) + pstepB, offB0, ldsb + (unsigned)(bufoff) + 8192u); } while (0)
#define PG8_LD16(p_) (*(const LAS u32x4*)(p_))
#define PG8_CAT(x, y) __builtin_bit_cast(v8i32_t, __builtin_shufflevector(x, y, 0, 1, 2, 3, 4, 5, 6, 7))
    unsigned aA0 = (unsigned)(aoff + PG8_SA(0, 0)), aA1 = (unsigned)(aoff + PG8_SA(1, 0)), bB0 = (unsigned)(boff + PG8_SB(0, 0)), bB1 = (unsigned)(boff + PG8_SB(1, 0));
    asm volatile("" : "+v"(aA0), "+v"(aA1), "+v"(bB0), "+v"(bB1));
    int scl8 = 0x7f7f7f7f; asm volatile("" : "+v"(scl8));
#define PG8_LDA(dst, b, h) do { const LAS unsigned char* ap_ = lds + ((b) ? aA1 : aA0) + (h) * HTB; _Pragma("unroll") for (int m = 0; m < 4; ++m) { \
        if constexpr (FP8) { dst##8[m] = PG8_CAT(PG8_LD16(ap_ + m * 2048), PG8_LD16(ap_ + m * 2048 + 16)); } \
        else { _Pragma("unroll") for (int k = 0; k < 2; ++k) dst[m][k] = *(const LAS bf16x8*)(ap_ + m * 2048 + k * 1024); } } } while (0)
#define PG8_LDB(dst, b, h) do { const LAS unsigned char* bp_ = lds + ((b) ? bB1 : bB0) + (h) * HTB; _Pragma("unroll") for (int n = 0; n < 2; ++n) { \
        if constexpr (FP8) { dst##8[n] = PG8_CAT(PG8_LD16(bp_ + n * 2048), PG8_LD16(bp_ + n * 2048 + 16)); } \
        else { _Pragma("unroll") for (int k = 0; k < 2; ++k) dst[n][k] = *(const LAS bf16x8*)(bp_ + n * 2048 + k * 1024); } } } while (0)
#define PG8_MMA(ai, bj, At, Bt) do { __builtin_amdgcn_s_setprio(1); _Pragma("unroll") for (int m = 0; m < 4; ++m) _Pragma("unroll") for (int n = 0; n < 2; ++n) { \
        if constexpr (FP8) asm volatile("v_mfma_scale_f32_16x16x128_f8f6f4 %0, %1, %2, %0, %3, %3 op_sel_hi:[0,0,0]" : "+v"(acc[ai][bj][m][n]) : "v"(Bt##8[n]), "v"(At##8[m]), "v"(scl8));   \
        else { _Pragma("unroll") for (int k = 0; k < 2; ++k) acc[ai][bj][m][n] = __builtin_amdgcn_mfma_f32_16x16x32_bf16(Bt[n][k], At[m][k], acc[ai][bj][m][n], 0, 0, 0); } } \
        __builtin_amdgcn_s_setprio(0); } while (0)
#define PG8_WAIT_V(n) asm volatile("s_waitcnt vmcnt(" #n ")" ::: "memory")
#define PG8_WAIT_L(n) asm volatile("s_waitcnt lgkmcnt(" #n ")" ::: "memory")
#define PG8_BAR __builtin_amdgcn_s_barrier()
#define PG8_SCHED __builtin_amdgcn_sched_barrier(0)
    unsigned voffA0, c2, pkc[2], pkn[2];
    { int R, C; stage_rc(tid * 16, R, C); voffA0 = (unsigned)(R * lda + C) * 2u; c2 = (unsigned)C * 2u; }
    const size_t hstepA = (size_t)HALF * lda * 2, pstepA = (size_t)64 * lda * 2;
    const unsigned lda2 = (unsigned)lda * 2u;
#define PG8_PKROWS(dst, u) do { if (GATHER) { _Pragma("unroll") for (int i_ = 0; i_ < 2; ++i_) { int R_, C_; stage_rc(tid * 16 + i_ * 8192, R_, C_); \
        const int nr_ = (u).nrows - 1; const int r0_ = R_ < nr_ ? R_ : nr_, r1_ = (R_ + HALF) < nr_ ? (R_ + HALF) : nr_; \
        dst[i_] = (unsigned)(u).rows[r0_] | ((unsigned)(u).rows[r1_] << 16); } } } while (0)
#define PG8_STGA(bufoff, gbase, h, NX) do { \
        if (GATHER) { const unsigned p0_ = (NX) ? pkn[0] : pkc[0], p1_ = (NX) ? pkn[1] : pkc[1]; \
            const unsigned o0_ = ((h) ? (p0_ >> 16) : (p0_ & 0xffffu)) * lda2 + c2, o1_ = ((h) ? (p1_ >> 16) : (p1_ & 0xffffu)) * lda2 + c2; \
            glds16s((const char*)(gbase), o0_, ldsb + (unsigned)(bufoff)); glds16s((const char*)(gbase), o1_, ldsb + (unsigned)(bufoff) + 8192u); } \
        else { const char* gb_ = (const char*)(gbase) + ((h) ? hstepA : (size_t)0); glds16s(gb_, voffA0, ldsb + (unsigned)(bufoff)); glds16s(gb_ + pstepA, voffA0, ldsb + (unsigned)(bufoff) + 8192u); } } while (0)
    Unit cur, nxt; int ui = 0;
    if (!S.next(0, cur)) return;
    f32x4 acc[2][2][4][2];
#pragma unroll
    for (int a = 0; a < 2; ++a)
#pragma unroll
        for (int b = 0; b < 2; ++b)
#pragma unroll
            for (int m = 0; m < 4; ++m)
#pragma unroll
                for (int n = 0; n < 2; ++n) acc[a][b][m][n] = (f32x4){0.f, 0.f, 0.f, 0.f};
    bf16x8 At[4][2], B0[2][2], B1[2][2]; v8i32_t At8[4], B08[2], B18[2];
    pkc[0] = pkc[1] = pkn[0] = pkn[1] = 0u;
    PG8_PKROWS(pkc, cur);
    const char* cA = cur.A; const char* cB = cur.B;
    PG8_STGB(PG8_SB(0, 0), cB); PG8_STGB(PG8_SB(0, 1), cB + hstepB); PG8_STGA(PG8_SA(0, 0), cA, 0, false); PG8_STGA(PG8_SA(0, 1), cA, 1, false);
    if (wr == 1) PG8_BAR;
    PG8_WAIT_V(2); PG8_BAR;
    PG8_STGB(PG8_SB(1, 0), cB + kstep); PG8_STGA(PG8_SA(1, 0), cA + kstep, 0, false); PG8_STGB(PG8_SB(1, 1), cB + hstepB + kstep);
    PG8_WAIT_V(6); PG8_BAR;
    for (;;) {
        const bool has_next = S.next(ui + 1, nxt);
        if (GATHER) { if (has_next) { PG8_PKROWS(pkn, nxt); } else { pkn[0] = pkc[0]; pkn[1] = pkc[1]; } }
        const char* nA = has_next ? nxt.A : cA; const char* nB = has_next ? nxt.B : cB;
        for (int t = 0; t < nt; t += 2) {
            const bool last = (t == nt - 2);
            const char* a1 = cA + (size_t)(t + 1) * kstep;
            const char* a2 = last ? nA : cA + (size_t)(t + 2) * kstep; const char* b2 = last ? nB : cB + (size_t)(t + 2) * kstep;
            const char* a3 = a2 + kstep; const char* b3 = b2 + kstep;
            PG8_LDB(B0, 0, 0); PG8_LDB(B1, 0, 1); PG8_SCHED; PG8_LDA(At, 0, 0); PG8_STGA(PG8_SA(1, 1), a1, 1, false);
            PG8_WAIT_V(8); PG8_WAIT_L(0); PG8_BAR; PG8_MMA(0, 0, At, B0); PG8_MMA(0, 1, At, B1); PG8_BAR; PG8_SCHED;
            PG8_LDA(At, 0, 1); PG8_STGB(PG8_SB(0, 0), b2); PG8_STGB(PG8_SB(0, 1), b2 + hstepB); PG8_STGA(PG8_SA(0, 0), a2, 0, last);
            PG8_WAIT_V(8); PG8_WAIT_L(0); PG8_BAR; PG8_MMA(1, 0, At, B0); PG8_MMA(1, 1, At, B1); PG8_BAR; PG8_SCHED;
            PG8_LDB(B0, 1, 0); PG8_LDB(B1, 1, 1); PG8_SCHED; PG8_LDA(At, 1, 0); PG8_STGA(PG8_SA(0, 1), a2, 1, last);
            PG8_WAIT_V(8); PG8_WAIT_L(0); PG8_BAR; PG8_MMA(0, 0, At, B0); PG8_MMA(0, 1, At, B1); PG8_BAR; PG8_SCHED;
            PG8_LDA(At, 1, 1); PG8_STGB(PG8_SB(1, 0), b3); PG8_STGB(PG8_SB(1, 1), b3 + hstepB); PG8_STGA(PG8_SA(1, 0), a3, 0, last);
            PG8_WAIT_V(8); PG8_WAIT_L(0); PG8_BAR; PG8_MMA(1, 0, At, B0); PG8_MMA(1, 1, At, B1); PG8_BAR; PG8_SCHED;
        }
        if constexpr (ALIGN_EPI) { if (wr == 0) PG8_BAR; }
        if constexpr (FP8) asm volatile("s_nop 15\n\ts_nop 15" ::: "memory");
        if constexpr (!Epi::AFTER_DRAIN) { int t_e = threadIdx.x; asm volatile("" : "+v"(t_e)); const int fr_e = t_e & 15, fq_e = (t_e >> 4) & 3; E(acc, cur, wr, wc, fr_e, fq_e); }
        if (!has_next) break;
#pragma unroll
        for (int a = 0; a < 2; ++a)
#pragma unroll
            for (int b = 0; b < 2; ++b)
#pragma unroll
                for (int m = 0; m < 4; ++m)
#pragma unroll
                    for (int n = 0; n < 2; ++n) acc[a][b][m][n] = (f32x4){0.f, 0.f, 0.f, 0.f};
        cur = nxt; cA = nA; cB = nB; ++ui;
        if (GATHER) { pkc[0] = pkn[0]; pkc[1] = pkn[1]; }
        if constexpr (ALIGN_EPI) { if (wr == 1) PG8_BAR; }
    }
    PG8_WAIT_V(0);
    if constexpr (!ALIGN_EPI) { if (wr == 0) PG8_BAR; }
    PG8_BAR;
    if constexpr (Epi::AFTER_DRAIN) { int t_e = threadIdx.x; asm volatile("" : "+v"(t_e)); const int fr_e = t_e & 15, fq_e = (t_e >> 4) & 3; E.fused(acc, cur, wr, wc, fr_e, fq_e, lds, wid, t_e & 63); }
#undef PG8_SA
#undef PG8_SB
#undef PG8_STGB
#undef PG8_LDA
#undef PG8_LDB
#undef PG8_MMA
#undef PG8_CAT
#undef PG8_LD16
#undef PG8_WAIT_V
#undef PG8_WAIT_L
#undef PG8_SCHED
#undef PG8_PKROWS
#undef PG8_STGA
}
}

namespace pg8 {
constexpr int NXCD = 8, WGM = 8;
__device__ __forceinline__ void tile_order(int L, int nM, int nN, int& pm, int& pn) {
    const int nwg = nM * nN; int wgid = L;
    { const int q = nwg / NXCD, r = nwg % NXCD, xcd = wgid % NXCD, off = wgid / NXCD; wgid = (xcd < r ? xcd * (q + 1) : r * (q + 1) + (xcd - r) * q) + off; }
    const int nig = WGM * nN, gid = wgid / nig, fm = gid * WGM, gsz = (nM - fm) < WGM ? (nM - fm) : WGM;
    pm = fm + ((wgid % nig) % gsz); pn = (wgid % nig) / gsz;
}
struct DenseOrder {
    const char* A; const char* B; int lda, ldb, nM, nN, G, c;
    __device__ __forceinline__ bool next(int i, Unit& u) const {
        const long L = (long)i * G + c; if (L >= (long)nM * nN) return false;
        int pm, pn; tile_order((int)L, nM, nN, pm, pn);
        u.pm = pm; u.pn = pn; u.aux = 0; u.rows = nullptr; u.nrows = 256;
        u.A = A + (size_t)pm * 256 * lda * 2; u.B = B + (size_t)pn * 256 * ldb * 2; return true;
    }
};
struct KvOrder {
    const char* MN; const char* W; int G, c;
    __device__ __forceinline__ bool next(int i, Unit& u) const {
        const int L = i * G + c; if (L >= 64) return false;
        u.rows = nullptr; u.nrows = 256;
        if (L < 32) { u.aux = 0; u.pm = L >> 2; u.pn = L & 3; u.A = MN + (size_t)u.pm * 256 * D * 2; u.B = W + (size_t)u.pn * 256 * D * 2; }
        else { const int l = L - 32; u.aux = 1; u.pm = l >> 3; u.pn = l & 7; u.A = W + (size_t)(1024 + u.pm * 256) * D * 2; u.B = MN + (size_t)u.pn * 256 * D * 2; }
        return true;
    }
};
struct XaScoreOrder {
    const char* QX; const char* MK; int xu;
    __device__ __forceinline__ bool next(int i, Unit& u) const {
        if (i > 0 || xu >= 512) return false;
        const int head = xu & 3, rt = xu >> 2, b = rt >> 4;
        u.pm = rt; u.pn = head; u.aux = 0; u.rows = nullptr; u.nrows = 256;
        u.A = QX + ((size_t)rt * 256 * D + head * 256) * 2; u.B = MK + ((size_t)b * 256 * D + head * 256) * 2; return true;
    }
};
struct XaPvOrder {
    const char* PW; const char* VT; int G, c;
    __device__ __forceinline__ bool next(int i, Unit& u) const {
        const int xu = c + i * G; if (i >= 2 || xu >= 512) return false;
        const int head = xu & 3, rt = xu >> 2, b = rt >> 4;
        u.pm = rt; u.pn = head; u.aux = 0; u.rows = nullptr; u.nrows = 256;
        u.A = PW + (size_t)i * 256 * 256 * 2; u.B = VT + ((size_t)head * 256 * MROWS + b * 256) * 2; return true;
    }
};
struct MoeOrder {
    const char* A; const char* W; const int* list; const unsigned* cnt; const LAS unsigned char* te; const LAS int* ts;
    int ntiles, nN, G, c; size_t wstride; int gather; size_t atile, btile;
    __device__ __forceinline__ bool next(int i, Unit& u) const {
        const long L = (long)i * G + c; if (L >= (long)ntiles * nN) return false;
        int pm, pn; tile_order((int)L, ntiles, nN, pm, pn);
        const int e = __builtin_amdgcn_readfirstlane((int)te[pm]);
        const int lt = pm - __builtin_amdgcn_readfirstlane(ts[e]);
        const int n = (int)__builtin_amdgcn_readfirstlane((int)__hip_atomic_load(cnt + e, RLX_AGENT)) - lt * 256;
        u.pm = pm; u.pn = pn; u.aux = e; u.nrows = n < 256 ? n : 256;
        u.rows = list + (size_t)e * T + lt * 256;
        u.A = gather ? A : A + (size_t)pm * atile;
        u.B = W + (size_t)e * wstride + (size_t)pn * btile; return true;
    }
};

struct EpiProj {
    static constexpr bool PERM = true, AFTER_DRAIN = false;
    bf16_t* O; float* kbar;
    __device__ __forceinline__ void operator()(const f32x4 (&acc)[2][2][4][2], const Unit& u, int wr, int wc, int fr, int fq) const {
        const int pn = u.pn, sec = pn >> 1, b = u.pm >> 4, t0 = (u.pm & 15) * 256 + wr * 64 + fr;
        const int mode = (pn < 2) ? 1 : ((pn == 6 || pn == 7 || pn >= 12) ? 2 : 0);
        bf16_t* sb = O + (size_t)sec * SEC_ELEMS;
#pragma unroll
        for (int bj = 0; bj < 2; ++bj) {
            const int c = bj * HALF + wc * 32 + 8 * fq, head = (pn & 1) * 4 + (c >> 6), d0 = c & 63;
            bf16_t* hb = sb + (size_t)(b * 8 + head) * (SEQ * 64);
#pragma unroll
            for (int ai = 0; ai < 2; ++ai)
#pragma unroll
                for (int m = 0; m < 4; ++m) { const int t = t0 + ai * HALF + m * 16;
                    f32x4 v0 = acc[ai][bj][m][0], v1 = acc[ai][bj][m][1];
                    if (mode == 1) { v0 = v0 * C2Q; v1 = v1 * C2Q; }
                    else if (mode == 2) {
#pragma unroll
                        for (int e = 0; e < 4; ++e) { v0[e] = silu_f(v0[e]); v1[e] = silu_f(v1[e]); } }
                    u32x4 w; w.x = cvtpk(v0[0], v0[1]); w.y = cvtpk(v0[2], v0[3]); w.z = cvtpk(v1[0], v1[1]); w.w = cvtpk(v1[2], v1[3]);
                    size_t off;
                    if (sec == 1) off = (size_t)(t >> 6) * 4096 + (d0 >> 3) * 512 + (t & 63) * 8;
                    else if (sec == 2) off = (size_t)(t >> 6) * 4096 + (d0 >> 5) * 2048 + (t & 63) * 32 + (d0 & 31);
                    else off = (size_t)t * 64 + d0;
                    *(u32x4*)(hb + off) = w; } }
        if (pn == 2 || pn == 3) {
#pragma unroll
            for (int bj = 0; bj < 2; ++bj)
#pragma unroll
                for (int n = 0; n < 2; ++n)
#pragma unroll
                    for (int e = 0; e < 4; ++e) { float s = 0.f;
#pragma unroll
                        for (int ai = 0; ai < 2; ++ai)
#pragma unroll
                            for (int m = 0; m < 4; ++m) s += acc[ai][bj][m][n][e];
                        s += __shfl_xor(s, 1); s += __shfl_xor(s, 2); s += __shfl_xor(s, 4); s += __shfl_xor(s, 8);
                        if (fr == 0) { const int c = bj * HALF + wc * 32 + 8 * fq + 4 * n + e, head = (pn - 2) * 4 + (c >> 6), d = c & 63;
                            atomicAdd(kbar + ((size_t)u.pm * 8 + head) * 64 + d, s); } }
        }
    }
};
struct EpiBf16 {
    static constexpr bool PERM = true, AFTER_DRAIN = false;
    bf16_t* O0; int ldc0; bf16_t* O1; int ldc1;
    __device__ __forceinline__ void operator()(const f32x4 (&acc)[2][2][4][2], const Unit& u, int wr, int wc, int fr, int fq) const {
        bf16_t* O = u.aux ? O1 : O0; const int ldc = u.aux ? ldc1 : ldc0;
        const int row0 = u.pm * BM + wr * 64 + fr, col0 = u.pn * BM + wc * 32 + 8 * fq;
#pragma unroll
        for (int ai = 0; ai < 2; ++ai)
#pragma unroll
            for (int m = 0; m < 4; ++m) { bf16_t* rowp = O + (size_t)(row0 + ai * HALF + m * 16) * ldc + col0;
#pragma unroll
                for (int bj = 0; bj < 2; ++bj) { const f32x4 v0 = acc[ai][bj][m][0], v1 = acc[ai][bj][m][1];
                    u32x4 w; w.x = cvtpk(v0[0], v0[1]); w.y = cvtpk(v0[2], v0[3]); w.z = cvtpk(v1[0], v1[1]); w.w = cvtpk(v1[2], v1[3]);
                    *(u32x4*)(rowp + bj * HALF) = w; } }
    }
};
template <bool BASE_F32, bool WRITE_F32, bool OUT_FP8 = false> struct EpiRes {
    static constexpr bool PERM = true, AFTER_DRAIN = false;
    const void* base; bf16_t* Ob; float* Of; float* ss;
    __device__ __forceinline__ void operator()(const f32x4 (&acc)[2][2][4][2], const Unit& u, int wr, int wc, int fr, int fq) const {
        const int row0 = u.pm * BM + wr * 64 + fr, col0 = u.pn * BM + wc * 32 + 8 * fq;
#pragma unroll
        for (int ai = 0; ai < 2; ++ai)
#pragma unroll
            for (int m = 0; m < 4; ++m) { const int row = row0 + ai * HALF + m * 16; const size_t off = (size_t)row * D + col0; float sq = 0.f;
#pragma unroll
                for (int bj = 0; bj < 2; ++bj) { f32x4 b0, b1;
                    if (BASE_F32) { b0 = *(const f32x4*)((const float*)base + off + bj * HALF); b1 = *(const f32x4*)((const float*)base + off + bj * HALF + 4); }
                    else { const u32x4 w = *(const u32x4*)((const bf16_t*)base + off + bj * HALF);
                        b0 = (f32x4){bflo(w.x), bfhi(w.x), bflo(w.y), bfhi(w.y)}; b1 = (f32x4){bflo(w.z), bfhi(w.z), bflo(w.w), bfhi(w.w)}; }
                    const f32x4 v0 = acc[ai][bj][m][0] + b0, v1 = acc[ai][bj][m][1] + b1;
                    sq += (v0[0] * v0[0] + v0[1] * v0[1]) + (v0[2] * v0[2] + v0[3] * v0[3]) + (v1[0] * v1[0] + v1[1] * v1[1]) + (v1[2] * v1[2] + v1[3] * v1[3]);
                    if (OUT_FP8) { *(u32x2*)((unsigned char*)Ob + off + bj * HALF) = (u32x2){pk4_fp8(v0[0], v0[1], v0[2], v0[3]), pk4_fp8(v1[0], v1[1], v1[2], v1[3])}; }
                    else { u32x4 w; w.x = cvtpk(v0[0], v0[1]); w.y = cvtpk(v0[2], v0[3]); w.z = cvtpk(v1[0], v1[1]); w.w = cvtpk(v1[2], v1[3]);
                    *(u32x4*)(Ob + off + bj * HALF) = w; }
                    if (WRITE_F32) { *(f32x4*)(Of + off + bj * HALF) = v0; *(f32x4*)(Of + off + bj * HALF + 4) = v1; } }
                sq += __shfl_xor(sq, 16); sq += __shfl_xor(sq, 32);
                if (fq == 0) atomicAdd(ss + row, sq); }
    }
};
struct EpiQ {
    static constexpr bool PERM = true, AFTER_DRAIN = false;
    bf16_t* O; const float* ss;
    __device__ __forceinline__ void operator()(const f32x4 (&acc)[2][2][4][2], const Unit& u, int wr, int wc, int fr, int fq) const {
        const int row0 = u.pm * BM + wr * 64 + fr, col0 = u.pn * BM + wc * 32 + 8 * fq;
#pragma unroll
        for (int ai = 0; ai < 2; ++ai)
#pragma unroll
            for (int m = 0; m < 4; ++m) { const int row = row0 + ai * HALF + m * 16; const float sc = C2X * __builtin_amdgcn_rsqf(ss[row] * (1.0f / D) + EPS);
                bf16_t* rowp = O + (size_t)row * D + col0;
#pragma unroll
                for (int bj = 0; bj < 2; ++bj) { const f32x4 v0 = acc[ai][bj][m][0] * sc, v1 = acc[ai][bj][m][1] * sc;
                    u32x4 w; w.x = cvtpk(v0[0], v0[1]); w.y = cvtpk(v0[2], v0[3]); w.z = cvtpk(v1[0], v1[1]); w.w = cvtpk(v1[2], v1[3]);
                    *(u32x4*)(rowp + bj * HALF) = w; } }
    }
};
struct EpiSoftmax {
    static constexpr bool PERM = true, AFTER_DRAIN = true;
    bf16_t* P;
    __device__ __forceinline__ void fused(f32x4 (&acc)[2][2][4][2], const Unit& u, int wr, int wc, int fr, int fq, LAS unsigned char* lds, int wid, int lane) const {
        LAS float* MX = (LAS float*)lds;
        LAS float* SM = (LAS float*)(lds + 4096);
#pragma unroll
        for (int ai = 0; ai < 2; ++ai)
#pragma unroll
            for (int m = 0; m < 4; ++m) { float mx = -3.0e38f;
#pragma unroll
                for (int bj = 0; bj < 2; ++bj)
#pragma unroll
                    for (int n = 0; n < 2; ++n) { const f32x4 x = acc[ai][bj][m][n]; mx = fmaxf(mx, fmaxf(fmaxf(x[0], x[1]), fmaxf(x[2], x[3]))); }
                mx = fmaxf(mx, __shfl_xor(mx, 16)); mx = fmaxf(mx, __shfl_xor(mx, 32));
                if (fq == 0) MX[(ai * HALF + wr * 64 + m * 16 + fr) * 4 + wc] = mx; }
        LDS_WAIT(); __builtin_amdgcn_s_barrier(); asm volatile("" ::: "memory");
#pragma unroll
        for (int ai = 0; ai < 2; ++ai)
#pragma unroll
            for (int m = 0; m < 4; ++m) { const int r = ai * HALF + wr * 64 + m * 16 + fr; const f32x4 q = *(const LAS f32x4*)(MX + r * 4);
                const float mx = fmaxf(fmaxf(q[0], q[1]), fmaxf(q[2], q[3])); float s = 0.f;
#pragma unroll
                for (int bj = 0; bj < 2; ++bj)
#pragma unroll
                    for (int n = 0; n < 2; ++n) { f32x4 x = acc[ai][bj][m][n];
#pragma unroll
                        for (int e = 0; e < 4; ++e) { x[e] = fast_exp2(x[e] - mx); s += x[e]; }
                        acc[ai][bj][m][n] = x; }
                s += __shfl_xor(s, 16); s += __shfl_xor(s, 32);
                if (fq == 0) SM[r * 4 + wc] = s; }
        LDS_WAIT(); __builtin_amdgcn_s_barrier(); asm volatile("" ::: "memory");
        const int col0 = wc * 32 + 8 * fq;
#pragma unroll
        for (int ai = 0; ai < 2; ++ai)
#pragma unroll
            for (int m = 0; m < 4; ++m) { const int r = ai * HALF + wr * 64 + m * 16 + fr; const f32x4 q = *(const LAS f32x4*)(SM + r * 4);
                const float inv = fast_rcp((q[0] + q[1]) + (q[2] + q[3]));
#pragma unroll
                for (int bj = 0; bj < 2; ++bj) { const f32x4 v0 = acc[ai][bj][m][0] * inv, v1 = acc[ai][bj][m][1] * inv;
                    u32x4 w; w.x = cvtpk(v0[0], v0[1]); w.y = cvtpk(v0[2], v0[3]); w.z = cvtpk(v1[0], v1[1]); w.w = cvtpk(v1[2], v1[3]);
                    *(u32x4*)(P + (size_t)r * 256 + bj * HALF + col0) = w; } }
        LDS_WAIT(); __builtin_amdgcn_s_barrier(); asm volatile("" ::: "memory");
    }
};
struct EpiW1 {
    static constexpr bool PERM = true, AFTER_DRAIN = false;
    bf16_t* O; const float* ss; const float* b1;
    __device__ __forceinline__ void operator()(const f32x4 (&acc)[2][2][4][2], const Unit& u, int wr, int wc, int fr, int fq) const {
        const int c0 = wc * 32 + 8 * fq;
        const float* bp = b1 + (size_t)u.aux * 2048 + 2 * (u.pn * 128 + c0);
        const f32x4 bq0 = *(const f32x4*)(bp), bq1 = *(const f32x4*)(bp + 4), bq2 = *(const f32x4*)(bp + 8), bq3 = *(const f32x4*)(bp + 12);
        const float bg[8] = {bq0[0], bq0[2], bq1[0], bq1[2], bq2[0], bq2[2], bq3[0], bq3[2]};
        const float bl[8] = {bq0[1], bq0[3], bq1[1], bq1[3], bq2[1], bq2[3], bq3[1], bq3[3]};
#pragma unroll
        for (int ai = 0; ai < 2; ++ai)
#pragma unroll
            for (int m = 0; m < 4; ++m) { const int r = ai * HALF + wr * 64 + m * 16 + fr; const int rr = r < u.nrows ? r : u.nrows - 1; const int tok = u.rows[rr];
                const float sc = WSCALE8_INV * __builtin_amdgcn_rsqf(ss[tok] * (1.0f / D) + EPS); float a[8];
#pragma unroll
                for (int j = 0; j < 8; ++j) { const float g = acc[ai][0][m][j >> 2][j & 3] * sc + bg[j], l = acc[ai][1][m][j >> 2][j & 3] * sc + bl[j];
                    const float glu = fminf(g, 7.0f), lin = fminf(fmaxf(l, -7.0f), 7.0f);
                    a[j] = glu * fast_rcp(1.0f + fast_exp2(-1.702f * LOG2E * glu)) * (lin + 1.0f); }
                *(u32x2*)((unsigned char*)O + ((size_t)u.pm * BM + r) * D + u.pn * 128 + c0) = (u32x2){pk4_fp8(a[0], a[1], a[2], a[3]), pk4_fp8(a[4], a[5], a[6], a[7])}; }
    }
};
struct EpiW2 {
    static constexpr bool PERM = true, AFTER_DRAIN = false;
    bf16_t* O; const float* b2;
    __device__ __forceinline__ void operator()(const f32x4 (&acc)[2][2][4][2], const Unit& u, int wr, int wc, int fr, int fq) const {
        const int row0 = u.pm * BM + wr * 64 + fr, col0 = u.pn * BM + wc * 32 + 8 * fq;
        f32x4 bv[2][2];
#pragma unroll
        for (int bj = 0; bj < 2; ++bj)
#pragma unroll
            for (int n = 0; n < 2; ++n) bv[bj][n] = *(const f32x4*)(b2 + (size_t)u.aux * D + col0 + bj * HALF + 4 * n);
#pragma unroll
        for (int ai = 0; ai < 2; ++ai)
#pragma unroll
            for (int m = 0; m < 4; ++m) { bf16_t* rowp = O + (size_t)(row0 + ai * HALF + m * 16) * D + col0;
#pragma unroll
                for (int bj = 0; bj < 2; ++bj) { const f32x4 v0 = acc[ai][bj][m][0] * WSCALE8_INV + bv[bj][0], v1 = acc[ai][bj][m][1] * WSCALE8_INV + bv[bj][1];
                    u32x4 w; w.x = cvtpk(v0[0], v0[1]); w.y = cvtpk(v0[2], v0[3]); w.z = cvtpk(v1[0], v1[1]); w.w = cvtpk(v1[2], v1[3]);
                    *(u32x4*)(rowp + bj * HALF) = w; } }
    }
};
}

namespace moba {
using bf16x8 = ::bf16x8; using s16x4 = ::s16x4; using f32x16 = ::f32x16; using u32x4 = ::u32x4;
constexpr int DMQ = INC, DMO = D, HD = 64;
constexpr int NW = 8, QBLK = 32, QB = 256, KVBLK = 64;
__device__ __forceinline__ int crow(int r, int hi) { return (r & 3) + 8 * (r >> 2) + 4 * hi; }
#define SBAR() __builtin_amdgcn_sched_barrier(0)
__device__ __forceinline__ void cmask(f32x16& p0, f32x16& p1, int jb, int qrel, int hi) {
    const float NEG = -INFINITY; int kb = 64 * jb + 4 * hi;
#pragma unroll
    for (int r = 0; r < 16; ++r) { int kv = kb + (r & 3) + 8 * (r >> 2); if (kv > qrel) p0[r] = NEG; if (kv + 32 > qrel) p1[r] = NEG; }
}
constexpr int NSLOT = 3, SLOTB = 8192;
constexpr int LDS_K = 0, LDS_V = NSLOT * SLOTB, LDS_WS = 2 * NSLOT * SLOTB, LDS_OST = LDS_WS + NW * 64 * 4, LDS_KB = LDS_OST + NW * 4096, LDS_BYTES = LDS_KB + 16 * 64 * 4;
__device__ __forceinline__ void glds16(const void* gsrc, unsigned lds_dst) { unsigned keep;
    asm volatile("s_mov_b32 %0, m0\n\ts_mov_b32 m0, %2\n\ts_nop 0\n\tglobal_load_lds_dwordx4 %1, off\n\ts_mov_b32 m0, %0" : "=&s"(keep) : "v"(gsrc), "s"(lds_dst) : "memory"); }
__device__ __forceinline__ float max3f(float a, float b, float c) { float r; asm("v_max3_f32 %0, %1, %2, %3" : "=v"(r) : "v"(a), "v"(b), "v"(c)); return r; }
__device__ __forceinline__ float max2f(float a, float b) { float r; asm("v_max_f32_e32 %0, %1, %2" : "=v"(r) : "v"(a), "v"(b)); return r; }
__device__ __forceinline__ float fadd_s(float a, float b) { float r; asm("v_add_f32_e32 %0, %1, %2" : "=v"(r) : "v"(a), "v"(b)); return r; }
__device__ __forceinline__ float fsub_s(float a, float b) { float r; asm("v_sub_f32_e32 %0, %1, %2" : "=v"(r) : "v"(a), "v"(b)); return r; }
__device__ __forceinline__ unsigned cvtpk_s(float lo, float hi) { return ::cvtpk(lo, hi); }
#define WAIT_BAR(N) asm volatile("s_waitcnt vmcnt(" #N ") lgkmcnt(0)\n\ts_barrier" ::: "memory")
__device__ __forceinline__ void qkt(f32x16& p0, f32x16& p1, const char* Kslot, const bf16x8* qr, const f32x16& negm, int r32, int hi) {
    const char* kb = Kslot + hi * 1024 + r32 * 16;
#pragma unroll
    for (int d0 = 0; d0 < 4; ++d0) {
        const bf16x8 b0 = *reinterpret_cast<const bf16x8*>(kb + d0 * 2048);
        const bf16x8 b1 = *reinterpret_cast<const bf16x8*>(kb + d0 * 2048 + 512);
        if (d0 == 0) { p0 = __builtin_amdgcn_mfma_f32_32x32x16_bf16(b0, qr[0], negm, 0, 0, 0); p1 = __builtin_amdgcn_mfma_f32_32x32x16_bf16(b1, qr[0], negm, 0, 0, 0); }
        else { p0 = __builtin_amdgcn_mfma_f32_32x32x16_bf16(b0, qr[d0], p0, 0, 0, 0); p1 = __builtin_amdgcn_mfma_f32_32x32x16_bf16(b1, qr[d0], p1, 0, 0, 0); } }
}
typedef __attribute__((address_space(3))) const char* lds_cptr;
typedef short v4i16_t __attribute__((ext_vector_type(4)));
__device__ __forceinline__ void kload8(bf16x8* kf, lds_cptr kp) {
    kf[0] = *(const __attribute__((address_space(3))) bf16x8*)(kp);        kf[1] = *(const __attribute__((address_space(3))) bf16x8*)(kp + 512);
    kf[2] = *(const __attribute__((address_space(3))) bf16x8*)(kp + 2048); kf[3] = *(const __attribute__((address_space(3))) bf16x8*)(kp + 2560);
    kf[4] = *(const __attribute__((address_space(3))) bf16x8*)(kp + 4096); kf[5] = *(const __attribute__((address_space(3))) bf16x8*)(kp + 4608);
    kf[6] = *(const __attribute__((address_space(3))) bf16x8*)(kp + 6144); kf[7] = *(const __attribute__((address_space(3))) bf16x8*)(kp + 6656);
}
__device__ __forceinline__ void kload2(bf16x8* kf, lds_cptr kp, int j) { kf[2 * j] = *(const __attribute__((address_space(3))) bf16x8*)(kp + j * 2048); kf[2 * j + 1] = *(const __attribute__((address_space(3))) bf16x8*)(kp + j * 2048 + 512); }
__device__ __forceinline__ s16x4 vtr(lds_cptr p) { return __builtin_bit_cast(s16x4, __builtin_amdgcn_ds_read_tr16_b64_v4i16((__attribute__((address_space(3))) v4i16_t*)p)); }
__device__ __forceinline__ float rowmax(const f32x16& p0, const f32x16& p1) {
    float a = max3f(p0[0], p0[1], p1[0]), b = max3f(p0[2], p0[3], p1[1]); a = max3f(a, p1[2], p1[3]);
#pragma unroll
    for (int r = 4; r < 16; r += 4) { a = max3f(a, p0[r], p0[r + 1]); b = max3f(b, p0[r + 2], p0[r + 3]); a = max3f(a, p1[r], p1[r + 1]); b = max3f(b, p1[r + 2], p1[r + 3]); }
    const float m = max2f(a, b);
    auto rr = __builtin_amdgcn_permlane32_swap(__float_as_uint(m), __float_as_uint(m), false, false);
    return max2f(__uint_as_float(rr[0]), __uint_as_float(rr[1]));
}
__device__ __forceinline__ void pv(f32x16* o, int vb, bf16x8 pa0, bf16x8 pa1, bf16x8 pa2, bf16x8 pa3) {
#pragma unroll
    for (int d0 = 0; d0 < 2; ++d0) { s16x4 lo[4], hi[4];
#pragma unroll
        for (int ks = 0; ks < 4; ++ks) {
            asm volatile("ds_read_b64_tr_b16 %0,%1 offset:%c2" : "=&v"(lo[ks]) : "v"(vb), "i"(d0 * 4096 + ks * 1024) : "memory");
            asm volatile("ds_read_b64_tr_b16 %0,%1 offset:%c2" : "=&v"(hi[ks]) : "v"(vb), "i"(d0 * 4096 + ks * 1024 + 512) : "memory"); }
        asm volatile("s_waitcnt lgkmcnt(0)" ::: "memory"); SBAR();
#define PK(k) (bf16x8){lo[k][0], lo[k][1], lo[k][2], lo[k][3], hi[k][0], hi[k][1], hi[k][2], hi[k][3]}
        o[d0] = __builtin_amdgcn_mfma_f32_32x32x16_bf16(pa0, PK(0), o[d0], 0, 0, 0);
        o[d0] = __builtin_amdgcn_mfma_f32_32x32x16_bf16(pa1, PK(1), o[d0], 0, 0, 0);
        o[d0] = __builtin_amdgcn_mfma_f32_32x32x16_bf16(pa2, PK(2), o[d0], 0, 0, 0);
        o[d0] = __builtin_amdgcn_mfma_f32_32x32x16_bf16(pa3, PK(3), o[d0], 0, 0, 0);
#undef PK
    }
}
constexpr float NEGBIG = -1.0e30f;

template <int THRL> __device__ __forceinline__ void attn_unit(int b, int h, int qb, const bf16_t* Qg, const bf16_t* __restrict__ Kg, const bf16_t* __restrict__ Vg, bf16_t* Og, const float* __restrict__ kbar, char* shm) {
    int tid_ = threadIdx.x; asm volatile("" : "+v"(tid_));
    const int tid = tid_, lane = tid & 63, r32 = lane & 31, hi = lane >> 5; const int wid = __builtin_amdgcn_readfirstlane(tid >> 6);
    const long rowbase = (long)b * SEQ; const int q0 = qb * QB;
    const size_t hoff = (size_t)(b * 8 + h) * (SEQ * 64);
    const bf16_t* Qw = Qg + hoff + (size_t)(q0 + wid * QBLK) * 64;
    const bf16_t* Kh = Kg + hoff, *Vh = Vg + hoff;
    const unsigned lds0 = (unsigned)(uintptr_t)shm;
    float* wsf = (float*)(shm + LDS_WS) + wid * 64;
    const bf16_t* ksrc = Kh + wid * 512 + lane * 8;
    const bf16_t* vsrc = Vh + wid * 512 + lane * 8;
    const unsigned kdst = lds0 + LDS_K + wid * 1024, vdst = lds0 + LDS_V + wid * 1024;
    const int NT = 4 * qb + 4, NPAST = 4 * qb;
#define TMAP(t) (((t) < 4) ? (NPAST + (t)) : ((t) - 4))
#define DMA_K(t, slot) glds16(ksrc + (long)TMAP(t) * 4096, (unsigned)__builtin_amdgcn_readfirstlane(kdst + (slot)))
#define DMA_V(t, slot) glds16(vsrc + (long)TMAP(t) * 4096, (unsigned)__builtin_amdgcn_readfirstlane(vdst + (slot)))
    const char* Kbase = shm + LDS_K; bf16x8 kf[8];
    const lds_cptr shm3 = (lds_cptr)shm; const lds_cptr kp0 = shm3 + LDS_K + hi * 1024 + r32 * 16; const lds_cptr vp0 = shm3 + LDS_V + ((lane >> 4) & 1) * 32 + (lane & 3) * 8 + (4 * hi + ((lane & 15) >> 2)) * 64;
    DMA_K(0, 0); DMA_V(0, 0); DMA_K(1, SLOTB);
    bf16x8 qr[4];
#pragma unroll
    for (int d0 = 0; d0 < 4; ++d0) qr[d0] = *reinterpret_cast<const bf16x8*>(&Qw[(long)r32 * 64 + d0 * 16 + hi * 8]);
    unsigned selm = 0u;
    if (qb > 0) {
        float* kbl = (float*)(shm + LDS_KB);
        for (int i = tid; i < qb * 64; i += NW * 64) kbl[i] = kbar[((size_t)(b * 16 + (i >> 6)) * 8 + h) * 64 + (i & 63)];
        asm volatile("s_waitcnt vmcnt(0) lgkmcnt(0)\n\ts_barrier" ::: "memory");
        if (qb <= 3) selm = (1u << qb) - 1u;
        else {
            float qf[32];
#pragma unroll
            for (int d0 = 0; d0 < 4; ++d0)
#pragma unroll
                for (int j = 0; j < 8; ++j) qf[d0 * 8 + j] = bf2f((unsigned short)qr[d0][j]);
            float g[15];
#pragma unroll
            for (int n = 0; n < 15; ++n) { float s = 0.f;
                if (n < qb) {
#pragma unroll
                    for (int d0 = 0; d0 < 4; ++d0) { const f32x4 k0 = *(const f32x4*)(kbl + n * 64 + d0 * 16 + hi * 8), k1 = *(const f32x4*)(kbl + n * 64 + d0 * 16 + hi * 8 + 4);
                        s += qf[d0 * 8 + 0] * k0[0] + qf[d0 * 8 + 1] * k0[1] + qf[d0 * 8 + 2] * k0[2] + qf[d0 * 8 + 3] * k0[3] + qf[d0 * 8 + 4] * k1[0] + qf[d0 * 8 + 5] * k1[1] + qf[d0 * 8 + 6] * k1[2] + qf[d0 * 8 + 7] * k1[3]; }
                    s += __shfl_xor(s, 32);
                } else s = -INFINITY;
                g[n] = s; }
#pragma unroll
            for (int pass = 0; pass < 3; ++pass) { float best = -INFINITY; int bi = 0;
#pragma unroll
                for (int n = 0; n < 15; ++n) if (g[n] > best) { best = g[n]; bi = n; }
                selm |= 1u << bi;
#pragma unroll
                for (int n = 0; n < 15; ++n) if (n == bi) g[n] = -INFINITY; }
        }
    }
    float mhat = 0.f, l_reg = 0.f; f32x16 o[2]; o[0] = f32x16{}; o[1] = f32x16{}; f32x16 cini = f32x16{}; asm volatile("" : "+v"(cini));
    const int qrel = wid * QBLK + r32;
#define SETC(t, JB) do { const float cm_ = ((JB >= 0) || ((selm >> (((t) - 4) >> 2)) & 1u)) ? -mhat : NEGBIG; \
      _Pragma("unroll") for (int r = 0; r < 16; ++r) cini[r] = cm_; asm volatile("" : "+v"(cini)); } while (0)
    bool resc = false;
#define START(P0, P1) do { const float rm = rowmax(P0, P1); resc = false; \
    { const float dl = rm; mhat = fadd_s(mhat, dl); \
      _Pragma("unroll") for (int r = 0; r < 16; ++r) { P0[r] = fsub_s(P0[r], dl); P1[r] = fsub_s(P1[r], dl); } } \
    _Pragma("unroll") for (int r = 0; r < 16; ++r) P0[r] = __builtin_amdgcn_exp2f(P0[r]); } while (0)
#define RESC() do { if (resc) { asm volatile("s_waitcnt lgkmcnt(0)" ::: "memory"); \
      _Pragma("unroll") for (int d_ = 0; d_ < 2; ++d_) _Pragma("unroll") for (int r = 0; r < 16; ++r) o[d_][r] *= wsf[crow(r, hi)]; } } while (0)
    f32x16 pA0, pA1, pB0, pB1;
    int sl_prev = 0, sl_cur = 0, sl_next = SLOTB;
#define ROT() do { sl_prev = sl_cur; sl_cur = sl_next; sl_next = (sl_next == (NSLOT - 1) * SLOTB) ? 0 : sl_next + SLOTB; } while (0)
    DMA_K(2, 2 * SLOTB);
    if (qb > 0) { WAIT_BAR(0); } else { WAIT_BAR(3); }
    qkt(pA0, pA1, Kbase, qr, cini, r32, hi); asm volatile("s_nop 15\n\ts_nop 7" : "+v"(pA0), "+v"(pA1)); cmask(pA0, pA1, 0, qrel, hi);
    START(pA0, pA1);
    _Pragma("unroll") for (int r = 0; r < 16; ++r) pA1[r] = __builtin_amdgcn_exp2f(pA1[r]);
    WAIT_BAR(0);
    DMA_K(3, 0); DMA_V(1, SLOTB);
    ROT();
    kload8(kf, kp0 + sl_cur);
    WAIT_BAR(2);
    s16x4 vlo[8], vhi[8]; u32x4 pw0, pw1, pw2, pw3;
#define PKW(P, B) cvtpk_s(P[B], P[B + 1])
#define PAF(k) __builtin_bit_cast(bf16x8, pw##k)
#define VFR(i) (bf16x8){vlo[i][0], vlo[i][1], vlo[i][2], vlo[i][3], vhi[i][0], vhi[i][1], vhi[i][2], vhi[i][3]}
#define PIN(x) asm volatile("" : "+v"(x))
#define MX3(a, b, c) __builtin_fmaxf(__builtin_fmaxf((a), (b)), (c))
#define GAPA(MF, A0, A1, A2, A3, W0, W1, PW) do { MF; sacc += A0; sacc += A1; sacc += A2; sacc += A3; PIN(sacc); W0; W1; PIN(PW); SBAR(); } while (0)
#define EX(v) __builtin_amdgcn_exp2f(v)
#define GAPB(MF, X, B) do { MF; X[B] = EX(X[B]); X[B + 1] = EX(X[B + 1]); X[B + 2] = EX(X[B + 2]); X[B + 3] = EX(X[B + 3]); PIN(X); SBAR(); } while (0)
#define VRD(i) do { vlo[i] = vtr(vp_ + (((i) >> 2) * 4096 + ((i) & 3) * 1024)); vhi[i] = vtr(vp_ + (((i) >> 2) * 4096 + ((i) & 3) * 1024 + 512)); } while (0)
#define KRD(G, j) do { if (G) { kload2(kf, kp0 + sl_next, j); SBAR(); } } while (0)
#define STEP(C0, C1, P0, P1, t, GK, GV, GL, JB) do { SETC(t, JB); SBAR(); \
    const lds_cptr vp_ = vp0 + sl_prev; \
    VRD(0); SBAR(); float sacc = (P0[0] + P0[1]); \
    GAPA(C0 = __builtin_amdgcn_mfma_f32_32x32x16_bf16(kf[0], qr[0], cini, 0, 0, 0), P0[2], P0[3], P0[4], P0[5],     pw0[0] = PKW(P0, 0), pw0[1] = PKW(P0, 2), pw0); \
    VRD(4); SBAR(); GAPA(C1 = __builtin_amdgcn_mfma_f32_32x32x16_bf16(kf[1], qr[0], cini, 0, 0, 0), P0[6], P0[7], P0[8], P0[9],     pw0[2] = PKW(P0, 4), pw0[3] = PKW(P0, 6), pw0); \
    VRD(1); SBAR(); GAPA(C0 = __builtin_amdgcn_mfma_f32_32x32x16_bf16(kf[2], qr[1], C0, 0, 0, 0),   P0[10], P0[11], P0[12], P0[13], pw1[0] = PKW(P0, 8), pw1[1] = PKW(P0, 10), pw1); \
    VRD(5); SBAR(); GAPA(C1 = __builtin_amdgcn_mfma_f32_32x32x16_bf16(kf[3], qr[1], C1, 0, 0, 0),   P0[14], P0[15], P1[0], P1[1],   pw1[2] = PKW(P0, 12), pw1[3] = PKW(P0, 14), pw1); \
    VRD(2); SBAR(); GAPA(C0 = __builtin_amdgcn_mfma_f32_32x32x16_bf16(kf[4], qr[2], C0, 0, 0, 0),   P1[2], P1[3], P1[4], P1[5],     pw2[0] = PKW(P1, 0), pw2[1] = PKW(P1, 2), pw2); \
    VRD(6); SBAR(); GAPA(C1 = __builtin_amdgcn_mfma_f32_32x32x16_bf16(kf[5], qr[2], C1, 0, 0, 0),   P1[6], P1[7], P1[8], P1[9],     pw2[2] = PKW(P1, 4), pw2[3] = PKW(P1, 6), pw2); \
    VRD(3); SBAR(); GAPA(C0 = __builtin_amdgcn_mfma_f32_32x32x16_bf16(kf[6], qr[3], C0, 0, 0, 0),   P1[10], P1[11], P1[12], P1[13], pw3[0] = PKW(P1, 8), pw3[1] = PKW(P1, 10), pw3); \
    VRD(7); SBAR(); GAPA(C1 = __builtin_amdgcn_mfma_f32_32x32x16_bf16(kf[7], qr[3], C1, 0, 0, 0),   P1[14], P1[15], 0.f, 0.f,       pw3[2] = PKW(P1, 12), pw3[3] = PKW(P1, 14), pw3); \
    l_reg += sacc; \
    if (GK) { DMA_K((t) + 3, sl_cur); } if (GV) { DMA_V((t) + 1, sl_next); } \
    if (JB >= 0) cmask(C0, C1, JB, qrel, hi); \
    { float a = MX3(C0[0], C0[1], C1[0]), b_ = MX3(C0[2], C0[3], C1[1]); a = MX3(a, C1[2], C1[3]); \
      _Pragma("unroll") for (int r = 4; r < 16; r += 4) { a = MX3(a, C0[r], C0[r + 1]); b_ = MX3(b_, C0[r + 2], C0[r + 3]); a = MX3(a, C1[r], C1[r + 1]); b_ = MX3(b_, C1[r + 2], C1[r + 3]); } \
      float rm = __builtin_fmaxf(a, b_); { auto rr = __builtin_amdgcn_permlane32_swap(__float_as_uint(rm), __float_as_uint(rm), false, false); rm = __builtin_fmaxf(__uint_as_float(rr[0]), __uint_as_float(rr[1])); } \
      resc = false; \
      if (__builtin_expect(__any(rm > (float)THRL), 0)) { const float dl = __builtin_fmaxf(rm, 0.f); mhat += dl; \
        _Pragma("unroll") for (int r = 0; r < 16; ++r) { C0[r] -= dl; C1[r] -= dl; } \
        const float f = __builtin_amdgcn_exp2f(-dl); l_reg *= f; if (hi == 0) wsf[r32] = f; resc = true; } } \
    SBAR(); \
    GAPB(o[0] = __builtin_amdgcn_mfma_f32_32x32x16_bf16(PAF(0), VFR(0), o[0], 0, 0, 0), C0, 0); \
    GAPB(o[1] = __builtin_amdgcn_mfma_f32_32x32x16_bf16(PAF(0), VFR(4), o[1], 0, 0, 0), C0, 4); \
    KRD(GL, 0); GAPB(o[0] = __builtin_amdgcn_mfma_f32_32x32x16_bf16(PAF(1), VFR(1), o[0], 0, 0, 0), C0, 8); \
    KRD(GL, 1); GAPB(o[1] = __builtin_amdgcn_mfma_f32_32x32x16_bf16(PAF(1), VFR(5), o[1], 0, 0, 0), C0, 12); \
    KRD(GL, 2); GAPB(o[0] = __builtin_amdgcn_mfma_f32_32x32x16_bf16(PAF(2), VFR(2), o[0], 0, 0, 0), C1, 0); \
    KRD(GL, 3); GAPB(o[1] = __builtin_amdgcn_mfma_f32_32x32x16_bf16(PAF(2), VFR(6), o[1], 0, 0, 0), C1, 4); \
    GAPB(o[0] = __builtin_amdgcn_mfma_f32_32x32x16_bf16(PAF(3), VFR(3), o[0], 0, 0, 0), C1, 8); \
    GAPB(o[1] = __builtin_amdgcn_mfma_f32_32x32x16_bf16(PAF(3), VFR(7), o[1], 0, 0, 0), C1, 12); \
    } while (0)
#define ENDW(tt) do { if ((tt) + 3 < NT) { WAIT_BAR(2); } else if ((tt) + 2 < NT) { WAIT_BAR(1); } else { WAIT_BAR(0); } } while (0)
    STEP(pB0, pB1, pA0, pA1, 1, (4 < NT), true, true, 1);   ENDW(1); RESC(); ROT();
    STEP(pA0, pA1, pB0, pB1, 2, (5 < NT), true, true, 2);   ENDW(2); RESC(); ROT();
    STEP(pB0, pB1, pA0, pA1, 3, (6 < NT), (4 < NT), (4 < NT), 3);   ENDW(3); RESC(); ROT();
    for (int t = 4; t < NT; t += 2) {
        STEP(pA0, pA1, pB0, pB1, t, (t + 3 < NT), true, true, -1);                       ENDW(t);     RESC(); ROT();
        STEP(pB0, pB1, pA0, pA1, t + 1, (t + 4 < NT), (t + 2 < NT), (t + 2 < NT), -1);   ENDW(t + 1); RESC(); ROT();
    }
    { float sacc = pB0[0] + pB0[1]; _Pragma("unroll") for (int r = 2; r < 16; ++r) sacc += pB0[r]; _Pragma("unroll") for (int r = 0; r < 16; ++r) sacc += pB1[r]; l_reg += sacc;
      pw0 = (u32x4){PKW(pB0, 0), PKW(pB0, 2), PKW(pB0, 4), PKW(pB0, 6)}; pw1 = (u32x4){PKW(pB0, 8), PKW(pB0, 10), PKW(pB0, 12), PKW(pB0, 14)}; pw2 = (u32x4){PKW(pB1, 0), PKW(pB1, 2), PKW(pB1, 4), PKW(pB1, 6)}; pw3 = (u32x4){PKW(pB1, 8), PKW(pB1, 10), PKW(pB1, 12), PKW(pB1, 14)};
      SBAR(); pv(o, (int)(unsigned long)vp0 + sl_prev, PAF(0), PAF(1), PAF(2), PAF(3)); }
#undef PKW
#undef PAF
#undef VFR
#undef PIN
#undef MX3
#undef GAPA
#undef GAPB
#undef EX
#undef VRD
#undef KRD
#undef STEP
#undef ENDW
    { auto rr = __builtin_amdgcn_permlane32_swap(__float_as_uint(l_reg), __float_as_uint(l_reg), false, false); l_reg = __uint_as_float(rr[0]) + __uint_as_float(rr[1]); }
    if (hi == 0) wsf[32 + r32] = l_reg; asm volatile("s_waitcnt lgkmcnt(0)" ::: "memory");
    float rli[16];
#pragma unroll
    for (int r = 0; r < 16; ++r) rli[r] = __builtin_amdgcn_rcpf(wsf[32 + crow(r, hi)]);
    bf16_t* Ow = Og + (rowbase + q0 + wid * QBLK) * DMO + h * HD;
    { bf16_t* stg = (bf16_t*)(shm + LDS_OST) + wid * 2048;
#pragma unroll
      for (int r = 0; r < 16; ++r) { const int orow = crow(r, hi);
#pragma unroll
        for (int d0 = 0; d0 < 2; ++d0) stg[orow * 64 + d0 * 32 + r32] = (bf16_t)f2bf(o[d0][r] * rli[r]); }
      asm volatile("s_waitcnt lgkmcnt(0)" ::: "memory");
#pragma unroll
      for (int i = 0; i < 4; ++i) { const int row = i * 8 + (lane >> 3), ch = lane & 7; const u32x4 v = *(const u32x4*)(stg + row * 64 + ch * 8); *(u32x4*)(Ow + (long)row * DMO + ch * 8) = v; } }
    asm volatile("s_waitcnt lgkmcnt(0)\n\ts_barrier" ::: "memory");
#undef DMA_K
#undef DMA_V
#undef TMAP
#undef SETC
#undef START
#undef RESC
#undef ROT
}
#undef SBAR
#undef WAIT_BAR
}

namespace hgrn {
constexpr int RS = 144;
constexpr int R_FQV = 0, FQV_SLOT = 32768;
constexpr int L_Q = 98304, L_K = L_Q + 9216, L_KT = L_K + 9216, L_VT = L_KT + 9216, L_ST = L_VT + 9216, L_SEG = L_ST + 9216, L_DEND = L_SEG + 2048, L_SSQ = L_DEND + 256, L_BYTES = L_SSQ + 512;
__device__ __forceinline__ int crow(int r, int hi) { return (r & 3) + 8 * (r >> 2) + 4 * hi; }
__device__ __forceinline__ void glds16(const void* gsrc, unsigned lds_dst) { unsigned keep;
    asm volatile("s_mov_b32 %0, m0\n\ts_mov_b32 m0, %2\n\ts_nop 0\n\tglobal_load_lds_dwordx4 %1, off\n\ts_mov_b32 m0, %0" : "=&s"(keep) : "v"(gsrc), "s"(lds_dst) : "memory"); }
#define HG_BAR() do { asm volatile("s_waitcnt lgkmcnt(0)" ::: "memory"); __builtin_amdgcn_s_barrier(); asm volatile("" ::: "memory"); } while (0)
__device__ __forceinline__ void hgrn_unit(int b, int h, const bf16_t* __restrict__ proj, bf16_t* __restrict__ mix, const float* __restrict__ lb_logits, const float* __restrict__ norm_g, LAS unsigned char* lds) {
    int tid_ = threadIdx.x; asm volatile("" : "+v"(tid_));
    const int tid = tid_, lane = tid & 63, r32 = lane & 31, hi = lane >> 5; const int w = __builtin_amdgcn_readfirstlane(tid >> 6);
    const float lbk = fast_rcp(1.0f + fast_exp2((lb_logits[512 + h * 64 + lane] - lb_logits[h * 64 + lane]) * LOG2E));
    const int vr = (w >> 1) & 1, tc = w & 1;
    float ng[16];
#pragma unroll
    for (int r = 0; r < 16; ++r) ng[r] = norm_g[h * 64 + 32 * vr + crow(r, hi)];
    f32x16 S = f32x16{};
    for (int i = tid; i < 64 * RS / 4; i += 512) ((LAS unsigned*)(lds + L_ST))[i] = 0u;
    const size_t hoff = (size_t)(b * 8 + h) * (SEQ * 64) + (size_t)w * 512 + lane * 8;
    const bf16_t* gQ = proj + 3 * SEC_ELEMS + hoff; const bf16_t* gF = proj + 4 * SEC_ELEMS + hoff; const bf16_t* gV = proj + 5 * SEC_ELEMS + hoff; const bf16_t* gG = proj + 6 * SEC_ELEMS + hoff;
    const unsigned lds0 = (unsigned)(uintptr_t)(unsigned char*)lds;
#define DMA_FQV(c_) do { const int cc_ = (c_) < 63 ? (c_) : 63; const unsigned d_ = (unsigned)__builtin_amdgcn_readfirstlane(lds0 + R_FQV + (unsigned)(((c_) % 3) * FQV_SLOT) + (unsigned)w * 1024u); \
        glds16(gF + (size_t)cc_ * 4096, d_); glds16(gQ + (size_t)cc_ * 4096, d_ + 8192u); glds16(gV + (size_t)cc_ * 4096, d_ + 16384u); } while (0)
#define DMA_G(c_) do { const int cc_ = (c_) < 63 ? (c_) : 63; glds16(gG + (size_t)cc_ * 4096, (unsigned)__builtin_amdgcn_readfirstlane(lds0 + R_FQV + (unsigned)(((c_) % 3) * FQV_SLOT) + 24576u + (unsigned)w * 1024u)); } while (0)
    DMA_FQV(0); DMA_G(0); DMA_FQV(1); DMA_G(1);
    for (int c = 0; c < 64; ++c) {
        const size_t row0 = (size_t)b * SEQ + (size_t)c * 64;
        DMA_FQV(c + 2);
        asm volatile("s_waitcnt vmcnt(8)" ::: "memory");
        const LAS unsigned char* raw = lds + R_FQV + (c % 3) * FQV_SLOT + (8 * w) * 128 + lane * 2;
        float p[8], kk[8];
        { float run = 0.f;
#pragma unroll
          for (int i = 0; i < 8; ++i) { const float x = bf2f(*(const LAS unsigned short*)(raw + i * 128)); const float sg = fast_rcp(1.0f + fast_exp2(-x * LOG2E)); const float f = lbk + (1.0f - lbk) * sg;
              run += __builtin_amdgcn_logf(f); p[i] = run; kk[i] = 1.0f - f; } }
        ((LAS float*)(lds + L_SEG))[w * 64 + lane] = p[7];
        HG_BAR();
        DMA_G(c + 2);
        { float off = 0.f;
#pragma unroll
          for (int j = 0; j < 7; ++j) { const float sv = ((LAS float*)(lds + L_SEG))[j * 64 + lane]; off += (j < w) ? sv : 0.f; }
          unsigned kq[4], vq[4];
#pragma unroll
          for (int i = 0; i < 8; i += 2) { const float b0 = off + p[i], b1 = off + p[i + 1];
              const unsigned short q0r = *(const LAS unsigned short*)(raw + 8192 + i * 128), q1r = *(const LAS unsigned short*)(raw + 8192 + (i + 1) * 128);
              const unsigned short v0r = *(const LAS unsigned short*)(raw + 16384 + i * 128), v1r = *(const LAS unsigned short*)(raw + 16384 + (i + 1) * 128);
              const float q0 = bf2f(q0r) * fast_exp2(b0), q1 = bf2f(q1r) * fast_exp2(b1), k0 = kk[i] * fast_exp2(-b0), k1 = kk[i + 1] * fast_exp2(-b1);
              const unsigned qq = cvtpk(q0, q1), kw = cvtpk(k0, k1); kq[i >> 1] = kw; vq[i >> 1] = (unsigned)v0r | ((unsigned)v1r << 16);
              *(LAS unsigned short*)(lds + L_Q + (8 * w + i) * RS + lane * 2) = (unsigned short)(qq & 0xffffu);
              *(LAS unsigned short*)(lds + L_Q + (8 * w + i + 1) * RS + lane * 2) = (unsigned short)(qq >> 16);
              *(LAS unsigned short*)(lds + L_K + (8 * w + i) * RS + lane * 2) = (unsigned short)(kw & 0xffffu);
              *(LAS unsigned short*)(lds + L_K + (8 * w + i + 1) * RS + lane * 2) = (unsigned short)(kw >> 16); }
          *(LAS u32x4*)(lds + L_KT + lane * RS + 16 * w) = (u32x4){kq[0], kq[1], kq[2], kq[3]};
          *(LAS u32x4*)(lds + L_VT + lane * RS + 16 * w) = (u32x4){vq[0], vq[1], vq[2], vq[3]};
          if (w == 7) ((LAS float*)(lds + L_DEND))[lane] = fast_exp2(off + p[7]); }
        asm volatile("s_waitcnt vmcnt(8)" ::: "memory");
        HG_BAR();
        f32x16 OT = f32x16{};
        if (w < 4) {
            bf16x8 bq[4];
#pragma unroll
            for (int ks = 0; ks < 4; ++ks) bq[ks] = *(const LAS bf16x8*)(lds + L_Q + (32 * tc + r32) * RS + (16 * ks + 8 * hi) * 2);
#pragma unroll
            for (int sr = 0; sr < 2; ++sr) if (sr <= tc) {
                f32x16 at = f32x16{};
#pragma unroll
                for (int ks = 0; ks < 4; ++ks) { const bf16x8 a = *(const LAS bf16x8*)(lds + L_K + (32 * sr + r32) * RS + (16 * ks + 8 * hi) * 2); at = __builtin_amdgcn_mfma_f32_32x32x16_bf16(a, bq[ks], at, 0, 0, 0); }
                if (sr == tc) {
#pragma unroll
                    for (int r = 0; r < 16; ++r) at[r] = (crow(r, hi) <= r32) ? at[r] : 0.f; }
#pragma unroll
                for (int st = 0; st < 2; ++st) {
                    u32x4 bw; bw.x = cvtpk(at[8 * st + 0], at[8 * st + 1]); bw.y = cvtpk(at[8 * st + 2], at[8 * st + 3]); bw.z = cvtpk(at[8 * st + 4], at[8 * st + 5]); bw.w = cvtpk(at[8 * st + 6], at[8 * st + 7]);
                    const u32x2 lo = *(const LAS u32x2*)(lds + L_VT + (32 * vr + r32) * RS + (32 * sr + 16 * st + 4 * hi) * 2);
                    const u32x2 hh = *(const LAS u32x2*)(lds + L_VT + (32 * vr + r32) * RS + (32 * sr + 16 * st + 8 + 4 * hi) * 2);
                    const u32x4 aw = (u32x4){lo.x, lo.y, hh.x, hh.y};
                    OT = __builtin_amdgcn_mfma_f32_32x32x16_bf16(__builtin_bit_cast(bf16x8, aw), __builtin_bit_cast(bf16x8, bw), OT, 0, 0, 0); }
            }
#pragma unroll
            for (int ks = 0; ks < 4; ++ks) { const bf16x8 a = *(const LAS bf16x8*)(lds + L_ST + (32 * vr + r32) * RS + (16 * ks + 8 * hi) * 2); OT = __builtin_amdgcn_mfma_f32_32x32x16_bf16(a, bq[ks], OT, 0, 0, 0); }
            float sq = 0.f;
#pragma unroll
            for (int r = 0; r < 16; ++r) sq += OT[r] * OT[r];
            sq += __shfl_xor(sq, 32);
            if (hi == 0) ((LAS float*)(lds + L_SSQ))[vr * 64 + 32 * tc + r32] = sq;
        } else {
#pragma unroll
            for (int st = 0; st < 4; ++st) { const bf16x8 a = *(const LAS bf16x8*)(lds + L_KT + (32 * vr + r32) * RS + (16 * st + 8 * hi) * 2);
                const bf16x8 bv = *(const LAS bf16x8*)(lds + L_VT + (32 * tc + r32) * RS + (16 * st + 8 * hi) * 2);
                S = __builtin_amdgcn_mfma_f32_32x32x16_bf16(a, bv, S, 0, 0, 0); }
#pragma unroll
            for (int r = 0; r < 16; ++r) S[r] *= ((LAS float*)(lds + L_DEND))[32 * vr + crow(r, hi)];
        }
        HG_BAR();
        if (w < 4) {
            const int t = 32 * tc + r32;
            const float tot = ((LAS float*)(lds + L_SSQ))[t] + ((LAS float*)(lds + L_SSQ))[64 + t];
            const float rstd = __builtin_amdgcn_rsqf(tot * (1.0f / 64.0f) + EPS);
            const LAS unsigned char* gp = lds + R_FQV + (c % 3) * FQV_SLOT + 24576 + t * 128 + (32 * vr + 4 * hi) * 2;
            bf16_t* op = mix + (row0 + t) * D + 512 + h * 64 + 32 * vr + 4 * hi;
#pragma unroll
            for (int g = 0; g < 4; ++g) { const u32x2 gg = *(const LAS u32x2*)(gp + 16 * g);
                const float y0 = OT[4 * g + 0] * rstd * ng[4 * g + 0] * bflo(gg.x), y1 = OT[4 * g + 1] * rstd * ng[4 * g + 1] * bfhi(gg.x),
                            y2 = OT[4 * g + 2] * rstd * ng[4 * g + 2] * bflo(gg.y), y3 = OT[4 * g + 3] * rstd * ng[4 * g + 3] * bfhi(gg.y);
                *(u32x2*)(op + 8 * g) = (u32x2){cvtpk(y0, y1), cvtpk(y2, y3)}; }
        } else {
#pragma unroll
            for (int g = 0; g < 4; ++g) *(LAS u32x2*)(lds + L_ST + (32 * tc + r32) * RS + (32 * vr + 8 * g + 4 * hi) * 2) = (u32x2){cvtpk(S[4 * g + 0], S[4 * g + 1]), cvtpk(S[4 * g + 2], S[4 * g + 3])};
        }
    }
    asm volatile("s_waitcnt vmcnt(0)" ::: "memory");
    HG_BAR();
#undef DMA_FQV
#undef DMA_G
}
#undef HG_BAR
}

constexpr int NWAVES = 8;
constexpr int LDS_BYTES = 163840;
constexpr int TAIL = 161792;
constexpr int TL_TE = TAIL, TL_TS = TAIL + 576, TL_HIST = TAIL + 768, TL_BASE = TAIL + 896, TL_MISC = TAIL + 1024;
typedef GAS unsigned gu32;

struct Args { const float* in[20]; float* out; unsigned char* ws; int ph_lo, ph_hi; };

struct Frame {
    LAS unsigned char* lds; volatile LAS unsigned* MISC; unsigned* ctl;
    int tid, lane, wave, G, vcu;
};

struct P0Item { const float* W; bf16_t* WT; const float* gain; int N, K, k0, n0, mode; };
__device__ __forceinline__ bool p0_decode(const Args& a, int it, P0Item& I) {
    unsigned char* ws = a.ws;
    constexpr int I_IN = 16 * 56, I_SQ = 16 * 16, I_KV = 16 * 32, I_W1 = 16 * 32, I_W2 = 16 * 16;
    constexpr int NITEMS = I_IN + 3 * I_SQ + I_KV + NEXP * (I_W1 + I_W2);
    if (it >= NITEMS) return false;
    int r = it; I.gain = nullptr; I.mode = 0; I.K = D;
    if (r < I_IN) { I.W = a.in[3]; I.WT = (bf16_t*)(ws + WS_WIN); I.N = INC; }
    else if ((r -= I_IN) < I_SQ) { I.W = a.in[6]; I.WT = (bf16_t*)(ws + WS_WOUT); I.N = D; }
    else if ((r -= I_SQ) < I_SQ) { I.W = a.in[9]; I.WT = (bf16_t*)(ws + WS_WQ); I.N = D; I.gain = a.in[7]; }
    else if ((r -= I_SQ) < I_KV) { I.W = a.in[10]; I.WT = (bf16_t*)(ws + WS_WKV); I.N = 2 * D; }
    else if ((r -= I_KV) < I_SQ) { I.W = a.in[11]; I.WT = (bf16_t*)(ws + WS_WO); I.N = D; }
    else if ((r -= I_SQ) < NEXP * I_W1) { const int e = r / I_W1; r -= e * I_W1; I.W = a.in[15] + (size_t)e * D * 2048; I.WT = (bf16_t*)(ws + WS_W1 + (size_t)e * 2048 * D); I.N = 2048; I.gain = a.in[12]; I.mode = 3; }
    else { r -= NEXP * I_W1; const int e = r / I_W2; r -= e * I_W2; I.W = a.in[17] + (size_t)e * D * D; I.WT = (bf16_t*)(ws + WS_W2 + (size_t)e * D * D); I.N = D; I.mode = 2; }
    const int nblk = I.N / 64; I.k0 = 64 * (r / nblk); I.n0 = 64 * (r % nblk); return true;
}
__device__ __forceinline__ void p0_load(const P0Item& I, f32x4 (&v)[16], int lane) {
    const float* p = I.W + (size_t)(I.k0 + (lane >> 4)) * I.N + I.n0 + 4 * (lane & 15);
#pragma unroll
    for (int j = 0; j < 16; ++j) v[j] = *(const f32x4*)(p + (size_t)(4 * j) * I.N);
}
__device__ __forceinline__ void p0_store(const P0Item& I, const f32x4 (&v)[16], LAS unsigned char* tl, int lane) {
    const int kr = lane >> 4, nq = lane & 15;
#pragma unroll
    for (int j = 0; j < 16; ++j) { const int k = 4 * j + kr; const float g = I.gain ? I.gain[I.k0 + k] : 1.0f;
        *(LAS u32x2*)(tl + k * 128 + (((nq >> 1) ^ ((k >> 3) & 7)) * 16) + (nq & 1) * 8) = (u32x2){pk2(v[j].x * g, v[j].y * g), pk2(v[j].z * g, v[j].w * g)}; }
    LDS_WAIT(); asm volatile("" ::: "memory");
    const int c = lane & 7;
#pragma unroll
    for (int i = 0; i < 8; ++i) { const int n = (lane >> 3) + 8 * i; const LAS unsigned char* sp = tl + (8 * c) * 128 + ((i ^ c) * 16) + (n & 7) * 2;
        unsigned short e[8];
#pragma unroll
        for (int q = 0; q < 8; ++q) e[q] = *(const LAS unsigned short*)(sp + q * 128);
        int row = I.n0 + n; if (I.mode & 1) { const int jj = row >> 1, bj = row & 1; row = (jj >> 7) * 256 + bj * 128 + (jj & 127); }
        if (I.mode & 2) *(u32x2*)((unsigned char*)I.WT + (size_t)row * I.K + I.k0 + 8 * c) = (u32x2){pk4_fp8(bf2f(e[0]) * WSCALE8, bf2f(e[1]) * WSCALE8, bf2f(e[2]) * WSCALE8, bf2f(e[3]) * WSCALE8), pk4_fp8(bf2f(e[4]) * WSCALE8, bf2f(e[5]) * WSCALE8, bf2f(e[6]) * WSCALE8, bf2f(e[7]) * WSCALE8)};
        else *(u32x4*)(I.WT + (size_t)row * I.K + I.k0 + 8 * c) = (u32x4){(unsigned)e[0] | ((unsigned)e[1] << 16), (unsigned)e[2] | ((unsigned)e[3] << 16), (unsigned)e[4] | ((unsigned)e[5] << 16), (unsigned)e[6] | ((unsigned)e[7] << 16)}; }
    LDS_WAIT(); asm volatile("" ::: "memory");
}
__device__ __forceinline__ void rms_rows2_to_bf16(const float* __restrict__ x0, const float* __restrict__ x1, const float* __restrict__ g, bf16_t* __restrict__ o0, bf16_t* __restrict__ o1, int lane) {
    const f32x4* xa = (const f32x4*)x0 + lane; const f32x4* xb = (const f32x4*)x1 + lane; const f32x4* gr = (const f32x4*)g + lane;
    f32x4 va[4], vb[4]; float sa = 0.f, sb = 0.f;
#pragma unroll
    for (int j = 0; j < 4; ++j) { va[j] = xa[64 * j]; vb[j] = xb[64 * j]; }
#pragma unroll
    for (int j = 0; j < 4; ++j) { sa += (va[j].x * va[j].x + va[j].y * va[j].y) + (va[j].z * va[j].z + va[j].w * va[j].w); sb += (vb[j].x * vb[j].x + vb[j].y * vb[j].y) + (vb[j].z * vb[j].z + vb[j].w * vb[j].w); }
    const float ra = 1.0f / sqrtf(wave_sum(sa) * (1.0f / D) + EPS), rb = 1.0f / sqrtf(wave_sum(sb) * (1.0f / D) + EPS);
    unsigned long long* pa = (unsigned long long*)o0 + lane; unsigned long long* pb = (unsigned long long*)o1 + lane;
#pragma unroll
    for (int j = 0; j < 4; ++j) { const f32x4 gg = gr[64 * j];
        pa[64 * j] = (unsigned long long)pk2(va[j].x * ra * gg.x, va[j].y * ra * gg.y) | ((unsigned long long)pk2(va[j].z * ra * gg.z, va[j].w * ra * gg.w) << 32);
        pb[64 * j] = (unsigned long long)pk2(vb[j].x * rb * gg.x, vb[j].y * rb * gg.y) | ((unsigned long long)pk2(vb[j].z * rb * gg.z, vb[j].w * rb * gg.w) << 32); }
}

__device__ __forceinline__ void p0_prologue(Frame& F, const Args& a) {
    unsigned char* ws = a.ws;
    LAS unsigned char* tl = F.lds + F.wave * 8192;
    const int gw = F.vcu * NWAVES + F.wave, NGW = F.G * NWAVES;
    for (int m = 2 * gw; m < T; m += 2 * NGW) rms_rows2_to_bf16(a.in[0] + (size_t)m * D, a.in[0] + (size_t)(m + 1) * D, a.in[2], (bf16_t*)(ws + WS_XN) + (size_t)m * D, (bf16_t*)(ws + WS_XN) + (size_t)(m + 1) * D, F.lane);
    for (int m = 2 * gw; m < MROWS; m += 2 * NGW) rms_rows2_to_bf16(a.in[1] + (size_t)m * D, a.in[1] + (size_t)(m + 1) * D, a.in[8], (bf16_t*)(ws + WS_MN) + (size_t)m * D, (bf16_t*)(ws + WS_MN) + (size_t)(m + 1) * D, F.lane);
    for (int i = gw * 64 + F.lane; i < NEXP * D; i += NGW * 64) { const int e = i >> 10, k = i & 1023; ((float*)(ws + WS_WRT))[i] = a.in[12][k] * a.in[13][k * NEXP + e]; }
    P0Item IA, IB; f32x4 va[16], vb[16];
    int it = gw; bool ha = p0_decode(a, it, IA); if (ha) p0_load(IA, va, F.lane);
    while (ha) {
        const bool hb = p0_decode(a, it + NGW, IB); if (hb) p0_load(IB, vb, F.lane);
        p0_store(IA, va, tl, F.lane);
        if (!hb) break;
        it += 2 * NGW; ha = p0_decode(a, it, IA); if (ha) p0_load(IA, va, F.lane);
        p0_store(IB, vb, tl, F.lane);
    }
}

__device__ __forceinline__ unsigned xcc_id() { return (unsigned)__builtin_amdgcn_s_getreg((3 << 11) | 20) & 0xFu; }
constexpr int QITEMS = 8 + 128;
__device__ __forceinline__ void p2_mixer(Frame& F, const Args& a, int rep) {
    unsigned char* ws = a.ws;
    const bf16_t* proj = (const bf16_t*)(ws + WS_PROJ); bf16_t* mix = (bf16_t*)(ws + WS_MIX);
    const unsigned x0 = xcc_id() & 7u;
    int par = 0;
#ifdef MK_P2_REPMODE
    if (rep && MK_P2_REPMODE == 4) return;
#endif
#ifdef MK_P2_HALF
    if (rep && (blockIdx.x & 8)) return;
#endif
    for (;;) {
        if (F.tid == 0) { int code = -1;
            for (int j = 0; j < 8; ++j) { const unsigned xq = (x0 + j) & 7u; const unsigned i = __hip_atomic_fetch_add(F.ctl + CW_QUEUE + 1024 * rep + 64 * xq, 1u, RLX_AGENT);
                if (i < (unsigned)QITEMS) { code = (int)(xq * 256u + i); break; } }
            F.MISC[par] = (unsigned)code; }
        LDS_WAIT(); __builtin_amdgcn_s_barrier(); asm volatile("" ::: "memory");
        const int code = __builtin_amdgcn_readfirstlane((int)F.MISC[par]); par ^= 1;
        if (code < 0) break;
        const int xq = code >> 8, i = code & 255;
#ifdef MK_P2_REPMODE
        if (rep && ((MK_P2_REPMODE == 1 && i >= 8) || (MK_P2_REPMODE == 2 && i < 8) || MK_P2_REPMODE == 3)) continue;
#endif
#ifndef NO_HGRN
        if (i < 8) { hgrn::hgrn_unit(xq, i, proj, mix, a.in[4], a.in[5], F.lds); }
        else
#endif
#ifndef NO_MOBA
        { const int j = i - 8, g = j >> 5, jj = j & 31, hh = 2 * g + (jj & 1), qb = 15 - (jj >> 1);
            moba::attn_unit<8>(xq, hh, qb, proj, proj + SEC_ELEMS, proj + 2 * SEC_ELEMS, mix, (const float*)(ws + WS_KBAR), (char*)(unsigned char*)F.lds); }
#else
        {}
#endif
    }
}

__device__ __forceinline__ void p7_router(Frame& F, const Args& a, int rep) {
    unsigned char* ws = a.ws;
    LAS float* WR = (LAS float*)F.lds;
    LAS int* hist = (LAS int*)(F.lds + TL_HIST); LAS int* basel = (LAS int*)(F.lds + TL_BASE);
    const float* wrt = (const float*)(ws + WS_WRT);
    for (int i = F.tid; i < NEXP * D / 4; i += 512) ((LAS f32x4*)WR)[i] = ((const f32x4*)wrt)[i];
    const float* h2f = (const float*)(ws + WS_H2F); const float* ss2 = (const float*)(ws + WS_SS2);
    int* toke = (int*)(ws + (rep ? WS_DUMMY + 1 * MiB : WS_TOKE)); int* tokr = (int*)(ws + (rep ? WS_DUMMY + 1 * MiB + 512 * 1024 : WS_TOKR)); float* tokg = (float*)(ws + (rep ? WS_DUMMY + 2 * MiB : WS_TOKG)); int* list = (int*)(ws + (rep ? WS_DUMMY + 4 * MiB : WS_LIST));
    unsigned* cntw = F.ctl + (rep ? CW_CNT + 2048 * rep : CW_CNT);
    const int lane = F.lane;
    const float brl = a.in[14][lane >> 1];
    for (int tb = blockIdx.x; tb < T / 128; tb += F.G) {
        if (F.tid < 32) hist[F.tid] = 0;
        LDS_WAIT(); __builtin_amdgcn_s_barrier(); asm volatile("" ::: "memory");
        int my_e = 0; float my_g = 0.f;
        for (int ig = 0; ig < 8; ++ig) {
            const int tq = tb * 128 + F.wave * 16 + ig * 2;
            f32x4 x[2][4];
#pragma unroll
            for (int q = 0; q < 2; ++q)
#pragma unroll
                for (int j = 0; j < 4; ++j) x[q][j] = *(const f32x4*)(h2f + (size_t)(tq + q) * D + 4 * lane + 256 * j);
            float v16[2][16];
            { const bool up = (lane & 32) != 0;
#pragma unroll
              for (int e = 0; e < 16; ++e) { float s0[2] = {0.f, 0.f}, s1[2] = {0.f, 0.f};
#pragma unroll
                  for (int j = 0; j < 4; ++j) { const f32x4 w0 = *(const LAS f32x4*)(WR + e * D + 4 * lane + 256 * j), w1 = *(const LAS f32x4*)(WR + (16 + e) * D + 4 * lane + 256 * j);
#pragma unroll
                      for (int q = 0; q < 2; ++q) { s0[q] += (x[q][j].x * w0.x + x[q][j].y * w0.y) + (x[q][j].z * w0.z + x[q][j].w * w0.w); s1[q] += (x[q][j].x * w1.x + x[q][j].y * w1.y) + (x[q][j].z * w1.z + x[q][j].w * w1.w); } }
#pragma unroll
                  for (int q = 0; q < 2; ++q) { const float send = up ? s0[q] : s1[q], keep = up ? s1[q] : s0[q]; v16[q][e] = keep + __shfl_xor(send, 32); }
                  asm volatile("" ::: "memory"); } }
#pragma unroll
            for (int q = 0; q < 2; ++q) {
                float v8[8], v4[4], v2[2];
                { const bool up = (lane & 16) != 0;
#pragma unroll
                  for (int e = 0; e < 8; ++e) { const float send = up ? v16[q][e] : v16[q][8 + e], keep = up ? v16[q][8 + e] : v16[q][e]; v8[e] = keep + __shfl_xor(send, 16); } }
                { const bool up = (lane & 8) != 0;
#pragma unroll
                  for (int e = 0; e < 4; ++e) { const float send = up ? v8[e] : v8[4 + e], keep = up ? v8[4 + e] : v8[e]; v4[e] = keep + __shfl_xor(send, 8); } }
                { const bool up = (lane & 4) != 0;
#pragma unroll
                  for (int e = 0; e < 2; ++e) { const float send = up ? v4[e] : v4[2 + e], keep = up ? v4[2 + e] : v4[e]; v2[e] = keep + __shfl_xor(send, 4); } }
                float v1; { const bool up = (lane & 2) != 0; const float send = up ? v2[0] : v2[1], keep = up ? v2[1] : v2[0]; v1 = keep + __shfl_xor(send, 2); }
                v1 += __shfl_xor(v1, 1);
                float cur = v1 * __builtin_amdgcn_rsqf(ss2[tq + q] * (1.0f / D) + EPS) + brl;
                float tv[4]; int te_[4];
#pragma unroll
                for (int k = 0; k < 4; ++k) { float m = cur;
#pragma unroll
                    for (int o = 1; o < 64; o <<= 1) m = fmaxf(m, __shfl_xor(m, o));
                    const unsigned long long bal = __ballot(cur == m); const int li = __builtin_ctzll(bal); const int e = li >> 1;
                    tv[k] = m; te_[k] = e; if ((lane >> 1) == e) cur = -INFINITY; }
                const float d1 = fast_exp2((tv[1] - tv[0]) * LOG2E), d2 = fast_exp2((tv[2] - tv[0]) * LOG2E), d3 = fast_exp2((tv[3] - tv[0]) * LOG2E);
                const float inv = 1.0f / (1.0f + d1 + d2 + d3);
                if ((lane >> 2) == ig * 2 + q) { const int k = lane & 3; my_e = k == 0 ? te_[0] : (k == 1 ? te_[1] : (k == 2 ? te_[2] : te_[3])); my_g = (k == 0 ? 1.0f : (k == 1 ? d1 : (k == 2 ? d2 : d3))) * inv; }
            }
        }
        const int rl = __hip_atomic_fetch_add(hist + my_e, 1, __ATOMIC_RELAXED, __HIP_MEMORY_SCOPE_WORKGROUP);
        LDS_WAIT(); __builtin_amdgcn_s_barrier(); asm volatile("" ::: "memory");
        if (F.tid < 32) basel[F.tid] = (int)__hip_atomic_fetch_add(cntw + F.tid, (unsigned)hist[F.tid], RLX_AGENT);
        LDS_WAIT(); VM_WAIT(); __builtin_amdgcn_s_barrier(); asm volatile("" ::: "memory");
        { const int t = tb * 128 + F.wave * 16 + (lane >> 2), k = lane & 3; const int rank = basel[my_e] + rl;
          toke[t * 4 + k] = my_e; tokr[t * 4 + k] = rank; tokg[t * 4 + k] = my_g; list[(size_t)my_e * T + rank] = t; }
        LDS_WAIT(); __builtin_amdgcn_s_barrier(); asm volatile("" ::: "memory");
    }
}

__device__ __forceinline__ int build_tables(Frame& F) {
    LAS int* ts = (LAS int*)(F.lds + TL_TS); LAS unsigned char* te = (LAS unsigned char*)(F.lds + TL_TE);
    if (F.tid == 0) { int run = 0;
        for (int e = 0; e < NEXP; ++e) { ts[e] = run; const unsigned c = __hip_atomic_load(F.ctl + CW_CNT + e, RLX_AGENT); run += (int)((c + 255u) >> 8); }
        ts[NEXP] = run; }
    LDS_WAIT(); __builtin_amdgcn_s_barrier(); asm volatile("" ::: "memory");
    const int nt = ts[NEXP];
    for (int g = F.tid; g < nt; g += 512) { int e = 0;
        for (int j = 1; j < NEXP; ++j) e += (ts[j] <= g) ? 1 : 0;
        te[g] = (unsigned char)e; }
    LDS_WAIT(); __builtin_amdgcn_s_barrier(); asm volatile("" ::: "memory");
    return __builtin_amdgcn_readfirstlane(nt);
}

__device__ __forceinline__ void p10_combine(Frame& F, const Args& a) {
    unsigned char* ws = a.ws;
    LAS int* ts = (LAS int*)(F.lds + TL_TS);
    const float* h2f = (const float*)(ws + WS_H2F); const bf16_t* Y = (const bf16_t*)(ws + WS_Y);
    const int* toke = (const int*)(ws + WS_TOKE); const int* tokr = (const int*)(ws + WS_TOKR); const float* tokg = (const float*)(ws + WS_TOKG);
    const float* gf = a.in[19];
    const int gw = F.vcu * NWAVES + F.wave, NGW = F.G * NWAVES, lane = F.lane;
    for (int t = gw; t < T; t += NGW) {
        float o[16];
        { const f32x4 a0 = *(const f32x4*)(h2f + (size_t)t * D + 8 * lane), a1 = *(const f32x4*)(h2f + (size_t)t * D + 8 * lane + 4), a2 = *(const f32x4*)(h2f + (size_t)t * D + 512 + 8 * lane), a3 = *(const f32x4*)(h2f + (size_t)t * D + 512 + 8 * lane + 4);
          o[0] = a0.x; o[1] = a0.y; o[2] = a0.z; o[3] = a0.w; o[4] = a1.x; o[5] = a1.y; o[6] = a1.z; o[7] = a1.w; o[8] = a2.x; o[9] = a2.y; o[10] = a2.z; o[11] = a2.w; o[12] = a3.x; o[13] = a3.y; o[14] = a3.z; o[15] = a3.w; }
#pragma unroll
        for (int k = 0; k < 4; ++k) { const int e = toke[t * 4 + k], r = tokr[t * 4 + k]; const float g = tokg[t * 4 + k];
            const bf16_t* yr = Y + ((size_t)ts[e] * 256 + r) * D;
            const u32x4 y0 = *(const u32x4*)(yr + 8 * lane), y1 = *(const u32x4*)(yr + 512 + 8 * lane);
            o[0] += g * bflo(y0.x); o[1] += g * bfhi(y0.x); o[2] += g * bflo(y0.y); o[3] += g * bfhi(y0.y); o[4] += g * bflo(y0.z); o[5] += g * bfhi(y0.z); o[6] += g * bflo(y0.w); o[7] += g * bfhi(y0.w);
            o[8] += g * bflo(y1.x); o[9] += g * bfhi(y1.x); o[10] += g * bflo(y1.y); o[11] += g * bfhi(y1.y); o[12] += g * bflo(y1.z); o[13] += g * bfhi(y1.z); o[14] += g * bflo(y1.w); o[15] += g * bfhi(y1.w); }
        float s = 0.f;
#pragma unroll
        for (int j = 0; j < 16; ++j) s += o[j] * o[j];
        const float rstd = 1.0f / sqrtf(wave_sum(s) * (1.0f / D) + EPS);
        float* op = a.out + (size_t)t * D;
#pragma unroll
        for (int q = 0; q < 4; ++q) { const int col = (q >> 1) * 512 + 8 * lane + (q & 1) * 4; const f32x4 g4 = *(const f32x4*)(gf + col);
            *(f32x4*)(op + col) = (f32x4){o[4 * q] * rstd * g4.x, o[4 * q + 1] * rstd * g4.y, o[4 * q + 2] * rstd * g4.z, o[4 * q + 3] * rstd * g4.w}; }
    }
}

#define XB_TMO      128
#define XB_XCNT(j)  (256  + 64 * (j))
#define XB_XSUB(j)  (1280 + 64 * (j))
#define XB_XGEN(j)  (2304 + 64 * (j))
#define XB_TOP      3328
#define XB_TOPGEN   3392
#define XCD_BAR_WORDS 3456
#define XB_SPIN_CAP (1u << 22)
__device__ __forceinline__ unsigned xb_ld(unsigned* p)              { return __hip_atomic_load(p, __ATOMIC_RELAXED, __HIP_MEMORY_SCOPE_AGENT); }
__device__ __forceinline__ unsigned xb_add(unsigned* p, unsigned v) { return __hip_atomic_fetch_add(p, v, __ATOMIC_RELAXED, __HIP_MEMORY_SCOPE_AGENT); }
#define XB_SPIN(cond, bar) do { unsigned _sp = 0; while (cond) { __builtin_amdgcn_s_sleep(1); \
    if ((++_sp & 255u) == 0u) { if (xb_ld(&(bar)[XB_TMO])) break; if (_sp > XB_SPIN_CAP) { atomicAdd(&(bar)[XB_TMO], 1u); break; } } } } while (0)
struct XcdBarrier { unsigned* bar; unsigned x; volatile LAS unsigned* st; };
__device__ __forceinline__ XcdBarrier xcd_barrier_post(unsigned* bar, volatile LAS unsigned* st) {
    XcdBarrier b; b.bar = bar; b.x = (unsigned)__builtin_amdgcn_s_getreg((3 << 11) | 20) & 0xFu; b.st = st;
    if (threadIdx.x == 0) (void)xb_add(&bar[XB_XCNT(b.x)], 1u);
    return b;
}
__device__ __forceinline__ void xcd_barrier_complete(unsigned* bar, unsigned x, unsigned& nloc, unsigned& nx) {
    const unsigned G = gridDim.x * gridDim.y * gridDim.z;
    unsigned sum, cnt, mine, sp = 0u;
    for (;;) {
        sum = 0u; cnt = 0u; mine = 0u;
#pragma unroll
        for (unsigned j = 0; j < 16; ++j) { const unsigned c = xb_ld(&bar[XB_XCNT(j)]); sum += c; cnt += (c > 0u) ? 1u : 0u; mine = (j == x) ? c : mine; }
        if (sum == G) break;
        __builtin_amdgcn_s_sleep(1);
        if ((++sp & 255u) == 0u) { if (xb_ld(&bar[XB_TMO])) break; if (sp > XB_SPIN_CAP) { atomicAdd(&bar[XB_TMO], 1u); break; } }
    }
    nloc = mine > 0u ? mine : 1u; nx = cnt > 0u ? cnt : 1u;
}
__device__ __forceinline__ void xcd_barrier(const XcdBarrier& b) {
    asm volatile("s_waitcnt vmcnt(0)" ::: "memory");
    __syncthreads();
    if (threadIdx.x == 0) {
        unsigned* bar = b.bar;
        __builtin_amdgcn_s_waitcnt(0);
        unsigned nloc = b.st[0], nx = b.st[1];
        if (nloc == 0u) { xcd_barrier_complete(bar, b.x, nloc, nx); b.st[0] = nloc; b.st[1] = nx; }
        const unsigned old = xb_add(&bar[XB_XSUB(b.x)], 1u);
        const unsigned gen = old / nloc;
        if (old + 1u == (gen + 1u) * nloc) {
            __builtin_amdgcn_fence(__ATOMIC_RELEASE, "agent");
            asm volatile("s_waitcnt vmcnt(0)" ::: "memory");
            const unsigned og = xb_add(&bar[XB_TOP], 1u);
            const unsigned tg = og / nx;
            if (og + 1u == (tg + 1u) * nx) xb_add(&bar[XB_TOPGEN], 1u);
            else XB_SPIN(xb_ld(&bar[XB_TOPGEN]) == tg, bar);
            __builtin_amdgcn_fence(__ATOMIC_ACQUIRE, "agent");
            xb_add(&bar[XB_XGEN(b.x)], 1u);
            asm volatile("s_waitcnt vmcnt(0)" ::: "memory");
        } else {
            XB_SPIN(xb_ld(&bar[XB_XGEN(b.x)]) == gen, bar);
            __builtin_amdgcn_fence(__ATOMIC_ACQUIRE, "agent");
            asm volatile("s_waitcnt vmcnt(0)" ::: "memory");
        }
    }
    __syncthreads();
}
#ifndef MK_CG_ONLY
#define MK_CG_ONLY 0
#endif
__device__ __forceinline__ void grid_barrier(Frame& F, const XcdBarrier& xb_) { if (MK_CG_ONLY) cg::this_grid().sync(); else xcd_barrier(xb_); }
#ifndef MK_PHASE_MASK
#define MK_PHASE_MASK 0x7ff
#endif
#ifndef MK_REP_PHASE
#define MK_REP_PHASE -1
#endif
#ifndef MK_REP_N
#define MK_REP_N 0
#endif
__device__ __forceinline__ void ph0(Frame& F, const Args& args, int rep) { p0_prologue(F, args); }
__device__ __forceinline__ void ph1(Frame& F, const Args& args, int rep) {
    unsigned char* ws = args.ws; const int cid = (int)blockIdx.x;
    { pg8::DenseOrder S{(const char*)(ws + WS_XN), (const char*)(ws + WS_WIN), D, D, T / 256, INC / 256, F.G, cid};
      pg8::EpiProj E{(bf16_t*)(ws + WS_PROJ), rep ? (float*)(ws + WS_DUMMY) : (float*)(ws + WS_KBAR)};
      pg8::gemm_phase<pg8::EpiProj, pg8::DenseOrder, false, true>(F.lds, D, D, D / 64, S, E); }
    { pg8::KvOrder S{(const char*)(ws + WS_MN), (const char*)(ws + WS_WKV), F.G, cid};
      pg8::EpiBf16 E{(bf16_t*)(ws + WS_MEMK), D, (bf16_t*)(ws + WS_MEMVT), MROWS};
      pg8::gemm_phase<pg8::EpiBf16, pg8::KvOrder, false, true>(F.lds, D, D, D / 64, S, E); }
}
__device__ __forceinline__ void ph2(Frame& F, const Args& args, int rep) { p2_mixer(F, args, rep); }
__device__ __forceinline__ void ph3(Frame& F, const Args& args, int rep) {
    unsigned char* ws = args.ws; const int cid = (int)blockIdx.x;
    pg8::DenseOrder S{(const char*)(ws + WS_MIX), (const char*)(ws + WS_WOUT), D, D, T / 256, D / 256, F.G, cid};
    pg8::EpiRes<true, false> E{(const void*)args.in[0], (bf16_t*)(ws + WS_H1B), nullptr, rep ? (float*)(ws + WS_DUMMY + 512 * 1024) : (float*)(ws + WS_SS1)};
    pg8::gemm_phase<pg8::EpiRes<true, false>, pg8::DenseOrder, false, true>(F.lds, D, D, D / 64, S, E);
}
__device__ __forceinline__ void ph4(Frame& F, const Args& args, int rep) {
    unsigned char* ws = args.ws; const int cid = (int)blockIdx.x;
    pg8::DenseOrder S{(const char*)(ws + WS_H1B), (const char*)(ws + WS_WQ), D, D, T / 256, D / 256, F.G, cid};
    pg8::EpiQ E{(bf16_t*)(ws + WS_QX), (const float*)(ws + WS_SS1)};
    pg8::gemm_phase<pg8::EpiQ, pg8::DenseOrder, false, true>(F.lds, D, D, D / 64, S, E);
}
__device__ __forceinline__ void ph5(Frame& F, const Args& args, int rep) {
    unsigned char* ws = args.ws; const int cid = (int)blockIdx.x;
    bf16_t* pw = (bf16_t*)(ws + WS_PWS) + (size_t)cid * 2 * 65536;
    for (int s = 0; s < 2; ++s) {
        pg8::XaScoreOrder S{(const char*)(ws + WS_QX), (const char*)(ws + WS_MEMK), cid + s * F.G};
        pg8::EpiSoftmax E{pw + (size_t)s * 65536};
        pg8::gemm_phase<pg8::EpiSoftmax, pg8::XaScoreOrder, false, false>(F.lds, D, D, 4, S, E);
    }
    VM_WAIT(); __syncthreads(); __builtin_amdgcn_fence(__ATOMIC_ACQUIRE, "agent"); __syncthreads();
    { pg8::XaPvOrder S{(const char*)pw, (const char*)(ws + WS_MEMVT), F.G, cid};
      pg8::EpiBf16 E{(bf16_t*)(ws + WS_OX), D, (bf16_t*)(ws + WS_OX), D};
      pg8::gemm_phase<pg8::EpiBf16, pg8::XaPvOrder, false, true>(F.lds, 256, MROWS, 4, S, E); }
}
__device__ __forceinline__ void ph6(Frame& F, const Args& args, int rep) {
    unsigned char* ws = args.ws; const int cid = (int)blockIdx.x;
    pg8::DenseOrder S{(const char*)(ws + WS_OX), (const char*)(ws + WS_WO), D, D, T / 256, D / 256, F.G, cid};
    pg8::EpiRes<false, true, true> E{(const void*)(ws + WS_H1B), (bf16_t*)(ws + WS_H2B), (float*)(ws + WS_H2F), rep ? (float*)(ws + WS_DUMMY + 512 * 1024) : (float*)(ws + WS_SS2)};
    pg8::gemm_phase<pg8::EpiRes<false, true, true>, pg8::DenseOrder, false, true>(F.lds, D, D, D / 64, S, E);
}
__device__ __forceinline__ void ph7(Frame& F, const Args& args, int rep) { p7_router(F, args, rep); }
__device__ __forceinline__ void ph8(Frame& F, const Args& args, int rep) {
    unsigned char* ws = args.ws; const int cid = (int)blockIdx.x;
    const int ntl = build_tables(F);
    pg8::MoeOrder S{(const char*)(ws + WS_H2B), (const char*)(ws + WS_W1), (const int*)(ws + WS_LIST), F.ctl + CW_CNT, (const LAS unsigned char*)(F.lds + TL_TE), (const LAS int*)(F.lds + TL_TS),
                    ntl, 8, F.G, cid, (size_t)2048 * D, 1, (size_t)256 * D, (size_t)256 * D};
    pg8::EpiW1 E{(bf16_t*)(ws + WS_HMID), (const float*)(ws + WS_SS2), args.in[16]};
    pg8::gemm_phase<pg8::EpiW1, pg8::MoeOrder, true, true, true>(F.lds, D / 2, D / 2, D / 128, S, E);
}
__device__ __forceinline__ void ph9(Frame& F, const Args& args, int rep) {
    unsigned char* ws = args.ws; const int cid = (int)blockIdx.x;
    const int ntl = build_tables(F);
    pg8::MoeOrder S{(const char*)(ws + WS_HMID), (const char*)(ws + WS_W2), (const int*)(ws + WS_LIST), F.ctl + CW_CNT, (const LAS unsigned char*)(F.lds + TL_TE), (const LAS int*)(F.lds + TL_TS),
                    ntl, 4, F.G, cid, (size_t)D * D, 0, (size_t)256 * D, (size_t)256 * D};
    pg8::EpiW2 E{(bf16_t*)(ws + WS_Y), args.in[18]};
    pg8::gemm_phase<pg8::EpiW2, pg8::MoeOrder, false, true, true>(F.lds, D / 2, D / 2, D / 128, S, E);
}
__device__ __forceinline__ void ph10(Frame& F, const Args& args, int rep) { (void)build_tables(F); p10_combine(F, args); }

constexpr int N_PHASES = 11;
__global__ void __launch_bounds__(NWAVES * 64, 2) hymba_fwd(Args args) {
    extern __shared__ __attribute__((aligned(16))) unsigned char lds_raw[];
    Frame F;
    F.lds = (LAS unsigned char*)lds_raw;
    F.MISC = (volatile LAS unsigned*)(F.lds + TL_MISC);
    F.tid = threadIdx.x; F.lane = F.tid & 63; F.wave = __builtin_amdgcn_readfirstlane(F.tid >> 6);
    F.G = gridDim.x; { const int bx = blockIdx.x; F.vcu = (F.G % 8 == 0) ? (bx % 8) * (F.G / 8) + bx / 8 : bx; }
    F.ctl = (unsigned*)(args.ws + WS_CTL);
    const int lo = args.ph_lo, hi = args.ph_hi;
    for (int u = F.tid; u < 64; u += NWAVES * 64) ((LAS unsigned*)(F.lds + TL_MISC))[u] = 0u;
    __syncthreads();
    const XcdBarrier xbar = xcd_barrier_post(F.ctl + CW_BAR, F.MISC + 8);
#define RUN(k, fn) do { if (((MK_PHASE_MASK >> (k)) & 1) && lo <= (k) && (k) < hi) { fn(F, args, 0); \
        if (MK_REP_PHASE == (k) && MK_REP_N >= 1) { grid_barrier(F, xbar); fn(F, args, 1); } \
        if (MK_REP_PHASE == (k) && MK_REP_N >= 2) { grid_barrier(F, xbar); fn(F, args, 2); } \
        if ((k) + 1 < hi) { if ((k) == 0) cg::this_grid().sync(); else grid_barrier(F, xbar); } } } while (0)
    RUN(0, ph0); RUN(1, ph1); RUN(2, ph2); RUN(3, ph3); RUN(4, ph4); RUN(5, ph5); RUN(6, ph6); RUN(7, ph7); RUN(8, ph8); RUN(9, ph9); RUN(10, ph10);
#undef RUN
}

extern "C" void kernel_launch(void* const* d_in, const int* in_sizes, int n_in, void* d_out, int out_size, void* d_ws, size_t ws_size, hipStream_t stream) {
    static int grid = 0;
    if (grid == 0) {
        if (n_in != 20 || in_sizes[0] != T * D || out_size != T * D || ws_size < WS_END) {
            fprintf(stderr, "kernel_launch: shape/workspace mismatch (n_in %d, in0 %d, out %d, ws %zu, need %zu)\n", n_in, n_in > 0 ? in_sizes[0] : -1, out_size, ws_size, (size_t)WS_END); grid = -1; return; }
        int dev = 0, cus = 0, per_cu = 0;
        if (hipGetDevice(&dev) != hipSuccess || hipDeviceGetAttribute(&cus, hipDeviceAttributeMultiprocessorCount, dev) != hipSuccess) { grid = -1; return; }
        if (hipFuncSetAttribute((const void*)hymba_fwd, hipFuncAttributeMaxDynamicSharedMemorySize, LDS_BYTES) != hipSuccess) { fprintf(stderr, "kernel_launch: hipFuncSetAttribute failed\n"); grid = -1; return; }
        if (hipOccupancyMaxActiveBlocksPerMultiprocessor(&per_cu, (const void*)hymba_fwd, NWAVES * 64, LDS_BYTES) != hipSuccess || per_cu < 1) { fprintf(stderr, "kernel_launch: occupancy query says %d\n", per_cu); }
        (void)hipGetLastError();
        grid = cus;
        if (grid != 256) fprintf(stderr, "kernel_launch: %d CUs; this kernel is built for 256\n", grid);
    }
    if (grid < 0) return;
    (void)hipMemsetAsync((char*)d_ws + WS_CTL, 0, CTL_ZERO_BYTES, stream);
    Args a{};
    for (int i = 0; i < 20; ++i) a.in[i] = (const float*)d_in[i];
    a.out = (float*)d_out; a.ws = (unsigned char*)d_ws;
#if MK_N_LAUNCHES == 1
    a.ph_lo = 0; a.ph_hi = MK_LAST_PHASE + 1;
    void* kargs[] = {&a};
    hipError_t e = hipLaunchCooperativeKernel((const void*)hymba_fwd, dim3(grid), dim3(NWAVES * 64), kargs, LDS_BYTES, stream);
    if (e != hipSuccess) fprintf(stderr, "kernel_launch: cooperative launch failed: %s\n", hipGetErrorString(e));
#else
    for (int p = 0; p <= MK_LAST_PHASE; ++p) { a.ph_lo = p; a.ph_hi = p + 1; hipLaunchKernelGGL(hymba_fwd, dim3(grid), dim3(NWAVES * 64), LDS_BYTES, stream, a); }
#endif
}
```

```cpp
#include <hip/hip_runtime.h>
#include <hip/hip_cooperative_groups.h>
#include <cstdio>
#include <cstdint>
namespace cg = cooperative_groups;

#ifndef MK_N_LAUNCHES
#define MK_N_LAUNCHES 1
#endif
#ifndef MK_LAST_PHASE
#define MK_LAST_PHASE 10
#endif

#define LAS __attribute__((address_space(3)))
#define GAS __attribute__((address_space(1)))
typedef unsigned short bf16_t;
typedef short bf16x8 __attribute__((ext_vector_type(8)));
typedef short s16x4 __attribute__((ext_vector_type(4)));
typedef float f32x4 __attribute__((ext_vector_type(4)));
typedef float f32x2 __attribute__((ext_vector_type(2)));
typedef float f32x16 __attribute__((ext_vector_type(16)));
typedef unsigned u32x4 __attribute__((ext_vector_type(4)));
typedef unsigned u32x2 __attribute__((ext_vector_type(2)));
typedef int v8i32_t __attribute__((ext_vector_type(8)));

constexpr int BATCH = 8, SEQ = 4096, T = BATCH * SEQ, D = 1024, INC = 3584, NMEM = 256, MROWS = BATCH * NMEM;
constexpr int NEXP = 32, TOPK = 4, MT_MAX = T * TOPK / 256 + NEXP, MPAD = MT_MAX * 256;
constexpr float EPS = 1e-6f;
constexpr float LOG2E = 1.4426950408889634f;
constexpr float C2Q = 0.125f * LOG2E;
constexpr float C2X = 0.0625f * LOG2E;
constexpr int C_MQ = 0, C_MK = 512, C_MV = 1024, C_GQ = 1536, C_GF = 2048, C_GI = 2560, C_GG = 3072;

constexpr size_t MiB = 1u << 20;
constexpr size_t WS_CTL = 0, CTL_ZERO_BYTES = 2 * MiB;
constexpr size_t WS_KBAR = 1 * MiB;
constexpr size_t WS_SS1 = 1 * MiB + 256 * 1024;
constexpr size_t WS_SS2 = 1 * MiB + 384 * 1024;
constexpr size_t WS_TOKE = 2 * MiB, WS_TOKR = 2 * MiB + 512 * 1024, WS_TOKG = 3 * MiB;
constexpr size_t WS_WRT = 3 * MiB + 512 * 1024;
constexpr size_t WS_LIST = 4 * MiB;
constexpr size_t WS_GLIST = 8 * MiB;
constexpr size_t WS_WIN = 16 * MiB, WS_WOUT = 23 * MiB, WS_WQ = 25 * MiB, WS_WKV = 27 * MiB, WS_WO = 31 * MiB;
constexpr size_t WS_MN = 33 * MiB, WS_MEMK = 37 * MiB, WS_MEMVT = 41 * MiB;
constexpr size_t WS_W1 = 48 * MiB, WS_W2 = 176 * MiB;
constexpr size_t WS_PROJ = 240 * MiB;
constexpr size_t SEC_ELEMS = (size_t)16 * 1024 * 1024;
constexpr size_t WS_XN = 464 * MiB;
constexpr size_t WS_OX = 464 * MiB;
constexpr size_t WS_MIX = 528 * MiB;
constexpr size_t WS_H1B = 592 * MiB;
constexpr size_t WS_QX = 656 * MiB;
constexpr size_t WS_PWS = 720 * MiB;
constexpr size_t WS_HMID = 240 * MiB;
constexpr size_t WS_Y = 512 * MiB;
constexpr size_t WS_H2F = 784 * MiB;
constexpr size_t WS_H2B = 912 * MiB;
constexpr size_t WS_DUMMY = 976 * MiB;
constexpr size_t WS_END = 988 * MiB;
static_assert(WS_HMID + (size_t)MPAD * D * 2 <= WS_Y && WS_Y + (size_t)MPAD * D * 2 <= WS_H2F, "ws map");
constexpr int CW_TMO = 0;
constexpr int CW_CNT = 64;
constexpr int CW_QUEUE = 128;
constexpr int CW_BAR = 4096;

__device__ __forceinline__ unsigned f2bf(float f) { unsigned u = __builtin_bit_cast(unsigned, f); return (u + 0x7fffu + ((u >> 16) & 1u)) >> 16; }
__device__ __forceinline__ unsigned pk2(float lo, float hi) { return f2bf(lo) | (f2bf(hi) << 16); }
__device__ __forceinline__ float bf2f(unsigned short h) { return __builtin_bit_cast(float, (unsigned)h << 16); }
__device__ __forceinline__ float bflo(unsigned w) { return __builtin_bit_cast(float, w << 16); }
__device__ __forceinline__ float bfhi(unsigned w) { return __builtin_bit_cast(float, w & 0xffff0000u); }
typedef float f32x2_t __attribute__((ext_vector_type(2))); typedef __bf16 bf16x2_t __attribute__((ext_vector_type(2)));
__device__ __forceinline__ unsigned cvtpk(float lo, float hi) { f32x2_t v = {lo, hi}; bf16x2_t b = __builtin_convertvector(v, bf16x2_t); return __builtin_bit_cast(unsigned, b); }
__device__ __forceinline__ float wave_sum(float v) {
#pragma unroll
    for (int o = 1; o < 64; o <<= 1) v += __shfl_xor(v, o);
    return v;
}
__device__ __forceinline__ float fast_exp2(float x) { return __builtin_amdgcn_exp2f(x); }
__device__ __forceinline__ float fast_rcp(float x) { return __builtin_amdgcn_rcpf(x); }
__device__ __forceinline__ float silu_f(float x) { return x * fast_rcp(1.0f + fast_exp2(-x * LOG2E)); }
__device__ __forceinline__ unsigned pk4_fp8(float a, float b, float c, float d) { int w = 0; w = __builtin_amdgcn_cvt_pk_fp8_f32(a, b, w, false); w = __builtin_amdgcn_cvt_pk_fp8_f32(c, d, w, true); return (unsigned)w; }
constexpr float WSCALE8 = 32.0f, WSCALE8_INV = 1.0f / 32.0f;
#define LDS_WAIT() asm volatile("s_waitcnt lgkmcnt(0)" ::: "memory")
#define VM_WAIT() asm volatile("s_waitcnt vmcnt(0)" ::: "memory")
#define RLX_AGENT __ATOMIC_RELAXED, __HIP_MEMORY_SCOPE_AGENT

namespace pg8 {
constexpr int BM = 256, BK = 64, HALF = 128, HTB = HALF * BK * 2, STAGE_BYTES = 8 * HTB;
__device__ __forceinline__ void glds16s(const char* sbase, unsigned voff, unsigned lds_dst) { unsigned keep;
    asm volatile("s_mov_b32 %0, m0\n\ts_mov_b32 m0, %3\n\ts_nop 0\n\tglobal_load_lds_dwordx4 %1, %2\n\ts_mov_b32 m0, %0" : "=&s"(keep) : "v"(voff), "s"(sbase), "s"(lds_dst) : "memory"); }
__host__ __device__ __forceinline__ int lds_byte(int r, int c) { const int st = (r >> 4) * 2 + (c >> 5), rr = r & 15, cc = c & 31, ob = rr * 64 + cc * 2; return st * 1024 + (ob ^ (((ob >> 9) & 1) << 5)); }
__host__ __device__ __forceinline__ void stage_rc(int b, int& R, int& C) { const int st = b / 1024, sb = b % 1024, swz = sb ^ (((sb >> 9) & 1) << 5); R = (st >> 1) * 16 + swz / 64; C = (st & 1) * 32 + (swz % 64) / 2; }
__host__ __device__ __forceinline__ int perm32(int rho) { const int n = rho >> 4, i = rho & 15; return 8 * (i >> 2) + 4 * n + (i & 3); }

struct Unit { const char* A; const char* B; const int* rows; int pm, pn, aux, nrows; };

template <class Epi, class Sched, bool GATHER, bool ALIGN_EPI, bool FP8 = false>
__device__ __forceinline__ void gemm_phase(LAS unsigned char* lds, const int lda, const int ldb, const int nt_in, const Sched& S, const Epi& E) {
    int nt = nt_in; asm volatile("" : "+s"(nt));
    int tid_ = threadIdx.x; asm volatile("" : "+v"(tid_));
    const int tid = tid_, wid = __builtin_amdgcn_readfirstlane(tid >> 6), lane = tid & 63, wr = wid >> 2, wc = wid & 3, fr = lane & 15, fq = lane >> 4;
    unsigned offB0; { int R, C; stage_rc(tid * 16, R, C); const int Rb = Epi::PERM ? ((R & ~31) + perm32(R & 31)) : R; offB0 = (unsigned)(Rb * ldb + C) * 2u; }
    const size_t pstepB = (size_t)64 * ldb * 2;
    const size_t kstep = (size_t)(BK * 2);
    const size_t hstepB = (size_t)HALF * ldb * 2;
    const unsigned ldsb = (unsigned)__builtin_amdgcn_readfirstlane((int)((unsigned)(uintptr_t)(unsigned char*)lds + (unsigned)wid * 1024u));
    const int aoff = lds_byte(wr * 64 + fr, FP8 ? fq * 16 : fq * 8), boff = lds_byte(wc * 32 + fr, FP8 ? fq * 16 : fq * 8);
#define PG8_SA(b, h) (((b) * 2 + (h)) * HTB)
#define PG8_SB(b, h) ((4 + (b) * 2 + (h)) * HTB)
#define PG8_STGB(bufoff, gbase) do { glds16s((const char*)(gbase), offB0, ldsb + (unsigned)(bufoff)); glds16s((const char*)(gbase) + pstepB, offB0, ldsb + (unsigned)(bufoff) + 8192u); } while (0)
#define PG8_LD16(p_) (*(const LAS u32x4*)(p_))
#define PG8_CAT(x, y) __builtin_bit_cast(v8i32_t, __builtin_shufflevector(x, y, 0, 1, 2, 3, 4, 5, 6, 7))
    unsigned aA0 = (unsigned)(aoff + PG8_SA(0, 0)), aA1 = (unsigned)(aoff + PG8_SA(1, 0)), bB0 = (unsigned)(boff + PG8_SB(0, 0)), bB1 = (unsigned)(boff + PG8_SB(1, 0));
    asm volatile("" : "+v"(aA0), "+v"(aA1), "+v"(bB0), "+v"(bB1));
    int scl8 = 0x7f7f7f7f; asm volatile("" : "+v"(scl8));
#define PG8_LDA(dst, b, h) do { const LAS unsigned char* ap_ = lds + ((b) ? aA1 : aA0) + (h) * HTB; _Pragma("unroll") for (int m = 0; m < 4; ++m) { \
        if constexpr (FP8) { dst##8[m] = PG8_CAT(PG8_LD16(ap_ + m * 2048), PG8_LD16(ap_ + m * 2048 + 16)); } \
        else { _Pragma("unroll") for (int k = 0; k < 2; ++k) dst[m][k] = *(const LAS bf16x8*)(ap_ + m * 2048 + k * 1024); } } } while (0)
#define PG8_LDB(dst, b, h) do { const LAS unsigned char* bp_ = lds + ((b) ? bB1 : bB0) + (h) * HTB; _Pragma("unroll") for (int n = 0; n < 2; ++n) { \
        if constexpr (FP8) { dst##8[n] = PG8_CAT(PG8_LD16(bp_ + n * 2048), PG8_LD16(bp_ + n * 2048 + 16)); } \
        else { _Pragma("unroll") for (int k = 0; k < 2; ++k) dst[n][k] = *(const LAS bf16x8*)(bp_ + n * 2048 + k * 1024); } } } while (0)
#define PG8_MMA(ai, bj, At, Bt) do { __builtin_amdgcn_s_setprio(1); _Pragma("unroll") for (int m = 0; m < 4; ++m) _Pragma("unroll") for (int n = 0; n < 2; ++n) { \
        if constexpr (FP8) asm volatile("v_mfma_scale_f32_16x16x128_f8f6f4 %0, %1, %2, %0, %3, %3 op_sel_hi:[0,0,0]" : "+v"(acc[ai][bj][m][n]) : "v"(Bt##8[n]), "v"(At##8[m]), "v"(scl8));   \
        else { _Pragma("unroll") for (int k = 0; k < 2; ++k) acc[ai][bj][m][n] = __builtin_amdgcn_mfma_f32_16x16x32_bf16(Bt[n][k], At[m][k], acc[ai][bj][m][n], 0, 0, 0); } } \
        __builtin_amdgcn_s_setprio(0); } while (0)
#define PG8_WAIT_V(n) asm volatile("s_waitcnt vmcnt(" #n ")" ::: "memory")
#define PG8_WAIT_L(n) asm volatile("s_waitcnt lgkmcnt(" #n ")" ::: "memory")
#define PG8_BAR __builtin_amdgcn_s_barrier()
#define PG8_SCHED __builtin_amdgcn_sched_barrier(0)
    unsigned voffA0, c2, pkc[2], pkn[2];
    { int R, C; stage_rc(tid * 16, R, C); voffA0 = (unsigned)(R * lda + C) * 2u; c2 = (unsigned)C * 2u; }
    const size_t hstepA = (size_t)HALF * lda * 2, pstepA = (size_t)64 * lda * 2;
    const unsigned lda2 = (unsigned)lda * 2u;
#define PG8_PKROWS(dst, u) do { if (GATHER) { _Pragma("unroll") for (int i_ = 0; i_ < 2; ++i_) { int R_, C_; stage_rc(tid * 16 + i_ * 8192, R_, C_); \
        const int nr_ = (u).nrows - 1; const int r0_ = R_ < nr_ ? R_ : nr_, r1_ = (R_ + HALF) < nr_ ? (R_ + HALF) : nr_; \
        dst[i_] = (unsigned)(u).rows[r0_] | ((unsigned)(u).rows[r1_] << 16); } } } while (0)
#define PG8_STGA(bufoff, gbase, h, NX) do { \
        if (GATHER) { const unsigned p0_ = (NX) ? pkn[0] : pkc[0], p1_ = (NX) ? pkn[1] : pkc[1]; \
            const unsigned o0_ = ((h) ? (p0_ >> 16) : (p0_ & 0xffffu)) * lda2 + c2, o1_ = ((h) ? (p1_ >> 16) : (p1_ & 0xffffu)) * lda2 + c2; \
            glds16s((const char*)(gbase), o0_, ldsb + (unsigned)(bufoff)); glds16s((const char*)(gbase), o1_, ldsb + (unsigned)(bufoff) + 8192u); } \
        else { const char* gb_ = (const char*)(gbase) + ((h) ? hstepA : (size_t)0); glds16s(gb_, voffA0, ldsb + (unsigned)(bufoff)); glds16s(gb_ + pstepA, voffA0, ldsb + (unsigned)(bufoff) + 8192u); } } while (0)
    Unit cur, nxt; int ui = 0;
    if (!S.next(0, cur)) return;
    f32x4 acc[2][2][4][2];
#pragma unroll
    for (int a = 0; a < 2; ++a)
#pragma unroll
        for (int b = 0; b < 2; ++b)
#pragma unroll
            for (int m = 0; m < 4; ++m)
#pragma unroll
                for (int n = 0; n < 2; ++n) acc[a][b][m][n] = (f32x4){0.f, 0.f, 0.f, 0.f};
    bf16x8 At[4][2], B0[2][2], B1[2][2]; v8i32_t At8[4], B08[2], B18[2];
    pkc[0] = pkc[1] = pkn[0] = pkn[1] = 0u;
    PG8_PKROWS(pkc, cur);
    const char* cA = cur.A; const char* cB = cur.B;
    PG8_STGB(PG8_SB(0, 0), cB); PG8_STGB(PG8_SB(0, 1), cB + hstepB); PG8_STGA(PG8_SA(0, 0), cA, 0, false); PG8_STGA(PG8_SA(0, 1), cA, 1, false);
    if (wr == 1) PG8_BAR;
    PG8_WAIT_V(2); PG8_BAR;
    PG8_STGB(PG8_SB(1, 0), cB + kstep); PG8_STGA(PG8_SA(1, 0), cA + kstep, 0, false); PG8_STGB(PG8_SB(1, 1), cB + hstepB + kstep);
    PG8_WAIT_V(6); PG8_BAR;
    for (;;) {
        const bool has_next = S.next(ui + 1, nxt);
        if (GATHER) { if (has_next) { PG8_PKROWS(pkn, nxt); } else { pkn[0] = pkc[0]; pkn[1] = pkc[1]; } }
        const char* nA = has_next ? nxt.A : cA; const char* nB = has_next ? nxt.B : cB;
        typename Epi::Pre pre; { int t_p = threadIdx.x; asm volatile("" : "+v"(t_p)); E.prefetch(cur, wr, t_p & 15, pre); }
        for (int t = 0; t < nt; t += 2) {
            const bool last = (t == nt - 2);
            const char* a1 = cA + (size_t)(t + 1) * kstep;
            const char* a2 = last ? nA : cA + (size_t)(t + 2) * kstep; const char* b2 = last ? nB : cB + (size_t)(t + 2) * kstep;
            const char* a3 = a2 + kstep; const char* b3 = b2 + kstep;
            PG8_LDB(B0, 0, 0); PG8_LDB(B1, 0, 1); PG8_SCHED; PG8_LDA(At, 0, 0); PG8_STGA(PG8_SA(1, 1), a1, 1, false);
            PG8_WAIT_V(8); PG8_WAIT_L(0); PG8_BAR; PG8_MMA(0, 0, At, B0); PG8_MMA(0, 1, At, B1); PG8_BAR; PG8_SCHED;
            PG8_LDA(At, 0, 1); PG8_STGB(PG8_SB(0, 0), b2); PG8_STGB(PG8_SB(0, 1), b2 + hstepB); PG8_STGA(PG8_SA(0, 0), a2, 0, last);
            PG8_WAIT_V(8); PG8_WAIT_L(0); PG8_BAR; PG8_MMA(1, 0, At, B0); PG8_MMA(1, 1, At, B1); PG8_BAR; PG8_SCHED;
            PG8_LDB(B0, 1, 0); PG8_LDB(B1, 1, 1); PG8_SCHED; PG8_LDA(At, 1, 0); PG8_STGA(PG8_SA(0, 1), a2, 1, last);
            PG8_WAIT_V(8); PG8_WAIT_L(0); PG8_BAR; PG8_MMA(0, 0, At, B0); PG8_MMA(0, 1, At, B1); PG8_BAR; PG8_SCHED;
            PG8_LDA(At, 1, 1); PG8_STGB(PG8_SB(1, 0), b3); PG8_STGB(PG8_SB(1, 1), b3 + hstepB); PG8_STGA(PG8_SA(1, 0), a3, 0, last);
            PG8_WAIT_V(8); PG8_WAIT_L(0); PG8_BAR; PG8_MMA(1, 0, At, B0); PG8_MMA(1, 1, At, B1); PG8_BAR; PG8_SCHED;
        }
        if constexpr (ALIGN_EPI) { if (wr == 0) PG8_BAR; }
        if constexpr (FP8) asm volatile("s_nop 15\n\ts_nop 15" ::: "memory");
        if constexpr (!Epi::AFTER_DRAIN) { int t_e = threadIdx.x; asm volatile("" : "+v"(t_e)); const int fr_e = t_e & 15, fq_e = (t_e >> 4) & 3; E(acc, cur, wr, wc, fr_e, fq_e, pre); }
        if (!has_next) break;
#pragma unroll
        for (int a = 0; a < 2; ++a)
#pragma unroll
            for (int b = 0; b < 2; ++b)
#pragma unroll
                for (int m = 0; m < 4; ++m)
#pragma unroll
                    for (int n = 0; n < 2; ++n) acc[a][b][m][n] = (f32x4){0.f, 0.f, 0.f, 0.f};
        cur = nxt; cA = nA; cB = nB; ++ui;
        if (GATHER) { pkc[0] = pkn[0]; pkc[1] = pkn[1]; }
        if constexpr (ALIGN_EPI) { if (wr == 1) PG8_BAR; }
    }
    PG8_WAIT_V(0);
    if constexpr (!ALIGN_EPI) { if (wr == 0) PG8_BAR; }
    PG8_BAR;
    if constexpr (Epi::AFTER_DRAIN) { int t_e = threadIdx.x; asm volatile("" : "+v"(t_e)); const int fr_e = t_e & 15, fq_e = (t_e >> 4) & 3; E.fused(acc, cur, wr, wc, fr_e, fq_e, lds, wid, t_e & 63); }
#undef PG8_SA
#undef PG8_SB
#undef PG8_STGB
#undef PG8_LDA
#undef PG8_LDB
#undef PG8_MMA
#undef PG8_CAT
#undef PG8_LD16
#undef PG8_WAIT_V
#undef PG8_WAIT_L
#undef PG8_SCHED
#undef PG8_PKROWS
#undef PG8_STGA
}
}

namespace pg8 {
constexpr int NXCD = 8, WGM = 8;
__device__ __forceinline__ void tile_order(int L, int nM, int nN, int& pm, int& pn) {
    const int nwg = nM * nN; int wgid = L;
    { const int q = nwg / NXCD, r = nwg % NXCD, xcd = wgid % NXCD, off = wgid / NXCD; wgid = (xcd < r ? xcd * (q + 1) : r * (q + 1) + (xcd - r) * q) + off; }
    const int nig = WGM * nN, gid = wgid / nig, fm = gid * WGM, gsz = (nM - fm) < WGM ? (nM - fm) : WGM;
    pm = fm + ((wgid % nig) % gsz); pn = (wgid % nig) / gsz;
}
struct DenseOrder {
    const char* A; const char* B; int lda, ldb, nM, nN, G, c;
    __device__ __forceinline__ bool next(int i, Unit& u) const {
        const long L = (long)i * G + c; if (L >= (long)nM * nN) return false;
        int pm, pn; tile_order((int)L, nM, nN, pm, pn);
        u.pm = pm; u.pn = pn; u.aux = 0; u.rows = nullptr; u.nrows = 256;
        u.A = A + (size_t)pm * 256 * lda * 2; u.B = B + (size_t)pn * 256 * ldb * 2; return true;
    }
};
struct KvOrder {
    const char* MN; const char* W; int L0;
    __device__ __forceinline__ bool next(int i, Unit& u) const {
        const int L = L0; if (i > 0 || L >= 64) return false;
        u.rows = nullptr; u.nrows = 256;
        if (L < 32) { u.aux = 0; u.pm = L >> 2; u.pn = L & 3; u.A = MN + (size_t)u.pm * 256 * D * 2; u.B = W + (size_t)u.pn * 256 * D * 2; }
        else { const int l = L - 32; u.aux = 1; u.pm = l >> 3; u.pn = l & 7; u.A = W + (size_t)(1024 + u.pm * 256) * D * 2; u.B = MN + (size_t)u.pn * 256 * D * 2; }
        return true;
    }
};
struct XaScoreOrder {
    const char* QX; const char* MK; int xu;
    __device__ __forceinline__ bool next(int i, Unit& u) const {
        if (i > 0 || xu >= 512) return false;
        const int head = xu & 3, rt = xu >> 2, b = rt >> 4;
        u.pm = rt; u.pn = head; u.aux = 0; u.rows = nullptr; u.nrows = 256;
        u.A = QX + ((size_t)rt * 256 * D + head * 256) * 2; u.B = MK + ((size_t)b * 256 * D + head * 256) * 2; return true;
    }
};
struct XaPvOrder {
    const char* PW; const char* VT; int G, c;
    __device__ __forceinline__ bool next(int i, Unit& u) const {
        const int xu = c + i * G; if (i >= 2 || xu >= 512) return false;
        const int head = xu & 3, rt = xu >> 2, b = rt >> 4;
        u.pm = rt; u.pn = head; u.aux = 0; u.rows = nullptr; u.nrows = 256;
        u.A = PW + (size_t)i * 256 * 256 * 2; u.B = VT + ((size_t)head * 256 * MROWS + b * 256) * 2; return true;
    }
};
struct MoeOrder {
    const char* A; const char* W; const int* list; const LAS int* cnt; const LAS unsigned char* te; const LAS int* ts;
    int ntiles, nN, G, c; size_t wstride; int gather; size_t atile, btile;
    __device__ __forceinline__ bool next(int i, Unit& u) const {
        const long L = (long)i * G + c; if (L >= (long)ntiles * nN) return false;
        int pm, pn; tile_order((int)L, ntiles, nN, pm, pn);
        const int e = __builtin_amdgcn_readfirstlane((int)te[pm]);
        const int lt = pm - __builtin_amdgcn_readfirstlane(ts[e]);
        const int n = __builtin_amdgcn_readfirstlane(cnt[e]) - lt * 256;
        u.pm = pm; u.pn = pn; u.aux = e; u.nrows = n < 256 ? n : 256;
        u.rows = list + (size_t)e * T + lt * 256;
        u.A = gather ? A : A + (size_t)pm * atile;
        u.B = W + (size_t)e * wstride + (size_t)pn * btile; return true;
    }
};

struct EpiProj {
    static constexpr bool PERM = true, AFTER_DRAIN = false; struct Pre {}; __device__ __forceinline__ void prefetch(const Unit&, int, int, Pre&) const {}
    bf16_t* O; float* kbar;
    __device__ __forceinline__ void operator()(const f32x4 (&acc)[2][2][4][2], const Unit& u, int wr, int wc, int fr, int fq, const Pre&) const {
        const int pn = u.pn, sec = pn >> 1, b = u.pm >> 4, t0 = (u.pm & 15) * 256 + wr * 64 + fr;
        const int mode = (pn < 2) ? 1 : ((pn == 6 || pn == 7 || pn >= 12) ? 2 : 0);
        bf16_t* sb = O + (size_t)sec * SEC_ELEMS;
#pragma unroll
        for (int bj = 0; bj < 2; ++bj) {
            const int c = bj * HALF + wc * 32 + 8 * fq, head = (pn & 1) * 4 + (c >> 6), d0 = c & 63;
            bf16_t* hb = sb + (size_t)(b * 8 + head) * (SEQ * 64);
#pragma unroll
            for (int ai = 0; ai < 2; ++ai)
#pragma unroll
                for (int m = 0; m < 4; ++m) { const int t = t0 + ai * HALF + m * 16;
                    f32x4 v0 = acc[ai][bj][m][0], v1 = acc[ai][bj][m][1];
                    if (mode == 1) { v0 = v0 * C2Q; v1 = v1 * C2Q; }
                    else if (mode == 2) {
#pragma unroll
                        for (int e = 0; e < 4; ++e) { v0[e] = silu_f(v0[e]); v1[e] = silu_f(v1[e]); } }
                    u32x4 w; w.x = cvtpk(v0[0], v0[1]); w.y = cvtpk(v0[2], v0[3]); w.z = cvtpk(v1[0], v1[1]); w.w = cvtpk(v1[2], v1[3]);
                    size_t off;
                    if (sec == 1) off = (size_t)(t >> 6) * 4096 + (d0 >> 3) * 512 + (t & 63) * 8;
                    else if (sec == 2) off = (size_t)(t >> 6) * 4096 + (d0 >> 5) * 2048 + (t & 63) * 32 + (d0 & 31);
                    else off = (size_t)t * 64 + d0;
                    *(u32x4*)(hb + off) = w; } }
        if (pn == 2 || pn == 3) {
#pragma unroll
            for (int bj = 0; bj < 2; ++bj)
#pragma unroll
                for (int n = 0; n < 2; ++n)
#pragma unroll
                    for (int e = 0; e < 4; ++e) { float s = 0.f;
#pragma unroll
                        for (int ai = 0; ai < 2; ++ai)
#pragma unroll
                            for (int m = 0; m < 4; ++m) s += acc[ai][bj][m][n][e];
                        s += __shfl_xor(s, 1); s += __shfl_xor(s, 2); s += __shfl_xor(s, 4); s += __shfl_xor(s, 8);
                        if (fr == 0) { const int c = bj * HALF + wc * 32 + 8 * fq + 4 * n + e, head = (pn - 2) * 4 + (c >> 6), d = c & 63;
                            atomicAdd(kbar + ((size_t)u.pm * 8 + head) * 64 + d, s); } }
        }
    }
};
struct EpiBf16 {
    static constexpr bool PERM = true, AFTER_DRAIN = false; struct Pre {}; __device__ __forceinline__ void prefetch(const Unit&, int, int, Pre&) const {}
    bf16_t* O0; int ldc0; bf16_t* O1; int ldc1;
    __device__ __forceinline__ void operator()(const f32x4 (&acc)[2][2][4][2], const Unit& u, int wr, int wc, int fr, int fq, const Pre&) const {
        bf16_t* O = u.aux ? O1 : O0; const int ldc = u.aux ? ldc1 : ldc0;
        const int row0 = u.pm * BM + wr * 64 + fr, col0 = u.pn * BM + wc * 32 + 8 * fq;
#pragma unroll
        for (int ai = 0; ai < 2; ++ai)
#pragma unroll
            for (int m = 0; m < 4; ++m) { bf16_t* rowp = O + (size_t)(row0 + ai * HALF + m * 16) * ldc + col0;
#pragma unroll
                for (int bj = 0; bj < 2; ++bj) { const f32x4 v0 = acc[ai][bj][m][0], v1 = acc[ai][bj][m][1];
                    u32x4 w; w.x = cvtpk(v0[0], v0[1]); w.y = cvtpk(v0[2], v0[3]); w.z = cvtpk(v1[0], v1[1]); w.w = cvtpk(v1[2], v1[3]);
                    *(u32x4*)(rowp + bj * HALF) = w; } }
    }
};
template <bool BASE_F32, bool WRITE_F32, bool OUT_FP8 = false> struct EpiRes {
    static constexpr bool PERM = true, AFTER_DRAIN = false; struct Pre {}; __device__ __forceinline__ void prefetch(const Unit&, int, int, Pre&) const {}
    const void* base; bf16_t* Ob; float* Of; float* ss;
    __device__ __forceinline__ void operator()(const f32x4 (&acc)[2][2][4][2], const Unit& u, int wr, int wc, int fr, int fq, const Pre&) const {
        const int row0 = u.pm * BM + wr * 64 + fr, col0 = u.pn * BM + wc * 32 + 8 * fq;
#pragma unroll
        for (int ai = 0; ai < 2; ++ai)
#pragma unroll
            for (int m = 0; m < 4; ++m) { const int row = row0 + ai * HALF + m * 16; const size_t off = (size_t)row * D + col0; float sq = 0.f;
#pragma unroll
                for (int bj = 0; bj < 2; ++bj) { f32x4 b0, b1;
                    if (BASE_F32) { b0 = *(const f32x4*)((const float*)base + off + bj * HALF); b1 = *(const f32x4*)((const float*)base + off + bj * HALF + 4); }
                    else { const u32x4 w = *(const u32x4*)((const bf16_t*)base + off + bj * HALF);
                        b0 = (f32x4){bflo(w.x), bfhi(w.x), bflo(w.y), bfhi(w.y)}; b1 = (f32x4){bflo(w.z), bfhi(w.z), bflo(w.w), bfhi(w.w)}; }
                    const f32x4 v0 = acc[ai][bj][m][0] + b0, v1 = acc[ai][bj][m][1] + b1;
                    sq += (v0[0] * v0[0] + v0[1] * v0[1]) + (v0[2] * v0[2] + v0[3] * v0[3]) + (v1[0] * v1[0] + v1[1] * v1[1]) + (v1[2] * v1[2] + v1[3] * v1[3]);
                    if (OUT_FP8) { *(u32x2*)((unsigned char*)Ob + off + bj * HALF) = (u32x2){pk4_fp8(v0[0], v0[1], v0[2], v0[3]), pk4_fp8(v1[0], v1[1], v1[2], v1[3])}; }
                    else { u32x4 w; w.x = cvtpk(v0[0], v0[1]); w.y = cvtpk(v0[2], v0[3]); w.z = cvtpk(v1[0], v1[1]); w.w = cvtpk(v1[2], v1[3]);
                    *(u32x4*)(Ob + off + bj * HALF) = w; }
                    if (WRITE_F32) { *(f32x4*)(Of + off + bj * HALF) = v0; *(f32x4*)(Of + off + bj * HALF + 4) = v1; } }
                sq += __shfl_xor(sq, 16); sq += __shfl_xor(sq, 32);
                if (fq == 0) atomicAdd(ss + row, sq); }
    }
};
struct EpiQ {
    static constexpr bool PERM = true, AFTER_DRAIN = false; struct Pre {}; __device__ __forceinline__ void prefetch(const Unit&, int, int, Pre&) const {}
    bf16_t* O; const float* ss;
    __device__ __forceinline__ void operator()(const f32x4 (&acc)[2][2][4][2], const Unit& u, int wr, int wc, int fr, int fq, const Pre&) const {
        const int row0 = u.pm * BM + wr * 64 + fr, col0 = u.pn * BM + wc * 32 + 8 * fq;
#pragma unroll
        for (int ai = 0; ai < 2; ++ai)
#pragma unroll
            for (int m = 0; m < 4; ++m) { const int row = row0 + ai * HALF + m * 16; const float sc = C2X * __builtin_amdgcn_rsqf(ss[row] * (1.0f / D) + EPS);
                bf16_t* rowp = O + (size_t)row * D + col0;
#pragma unroll
                for (int bj = 0; bj < 2; ++bj) { const f32x4 v0 = acc[ai][bj][m][0] * sc, v1 = acc[ai][bj][m][1] * sc;
                    u32x4 w; w.x = cvtpk(v0[0], v0[1]); w.y = cvtpk(v0[2], v0[3]); w.z = cvtpk(v1[0], v1[1]); w.w = cvtpk(v1[2], v1[3]);
                    *(u32x4*)(rowp + bj * HALF) = w; } }
    }
};
struct EpiSoftmax {
    static constexpr bool PERM = true, AFTER_DRAIN = true; struct Pre {}; __device__ __forceinline__ void prefetch(const Unit&, int, int, Pre&) const {}
    bf16_t* P;
    __device__ __forceinline__ void fused(f32x4 (&acc)[2][2][4][2], const Unit& u, int wr, int wc, int fr, int fq, LAS unsigned char* lds, int wid, int lane) const {
        LAS float* MX = (LAS float*)lds;
        LAS float* SM = (LAS float*)(lds + 4096);
#pragma unroll
        for (int ai = 0; ai < 2; ++ai)
#pragma unroll
            for (int m = 0; m < 4; ++m) { float mx = -3.0e38f;
#pragma unroll
                for (int bj = 0; bj < 2; ++bj)
#pragma unroll
                    for (int n = 0; n < 2; ++n) { const f32x4 x = acc[ai][bj][m][n]; mx = fmaxf(mx, fmaxf(fmaxf(x[0], x[1]), fmaxf(x[2], x[3]))); }
                mx = fmaxf(mx, __shfl_xor(mx, 16)); mx = fmaxf(mx, __shfl_xor(mx, 32));
                if (fq == 0) MX[(ai * HALF + wr * 64 + m * 16 + fr) * 4 + wc] = mx; }
        LDS_WAIT(); __builtin_amdgcn_s_barrier(); asm volatile("" ::: "memory");
#pragma unroll
        for (int ai = 0; ai < 2; ++ai)
#pragma unroll
            for (int m = 0; m < 4; ++m) { const int r = ai * HALF + wr * 64 + m * 16 + fr; const f32x4 q = *(const LAS f32x4*)(MX + r * 4);
                const float mx = fmaxf(fmaxf(q[0], q[1]), fmaxf(q[2], q[3])); float s = 0.f;
#pragma unroll
                for (int bj = 0; bj < 2; ++bj)
#pragma unroll
                    for (int n = 0; n < 2; ++n) { f32x4 x = acc[ai][bj][m][n];
#pragma unroll
                        for (int e = 0; e < 4; ++e) { x[e] = fast_exp2(x[e] - mx); s += x[e]; }
                        acc[ai][bj][m][n] = x; }
                s += __shfl_xor(s, 16); s += __shfl_xor(s, 32);
                if (fq == 0) SM[r * 4 + wc] = s; }
        LDS_WAIT(); __builtin_amdgcn_s_barrier(); asm volatile("" ::: "memory");
        const int col0 = wc * 32 + 8 * fq;
#pragma unroll
        for (int ai = 0; ai < 2; ++ai)
#pragma unroll
            for (int m = 0; m < 4; ++m) { const int r = ai * HALF + wr * 64 + m * 16 + fr; const f32x4 q = *(const LAS f32x4*)(SM + r * 4);
                const float inv = fast_rcp((q[0] + q[1]) + (q[2] + q[3]));
#pragma unroll
                for (int bj = 0; bj < 2; ++bj) { const f32x4 v0 = acc[ai][bj][m][0] * inv, v1 = acc[ai][bj][m][1] * inv;
                    u32x4 w; w.x = cvtpk(v0[0], v0[1]); w.y = cvtpk(v0[2], v0[3]); w.z = cvtpk(v1[0], v1[1]); w.w = cvtpk(v1[2], v1[3]);
                    *(u32x4*)(P + (size_t)r * 256 + bj * HALF + col0) = w; } }
        LDS_WAIT(); __builtin_amdgcn_s_barrier(); asm volatile("" ::: "memory");
    }
};
struct EpiW1 {
    static constexpr bool PERM = true, AFTER_DRAIN = false;
    struct Pre { float sc[8]; };
    bf16_t* O; const float* ss; const float* b1;
    __device__ __forceinline__ void prefetch(const Unit& u, int wr, int fr, Pre& p) const {
#pragma unroll
        for (int ai = 0; ai < 2; ++ai)
#pragma unroll
            for (int m = 0; m < 4; ++m) { const int r = ai * HALF + wr * 64 + m * 16 + fr; const int rr = r < u.nrows ? r : u.nrows - 1; p.sc[ai * 4 + m] = ss[u.rows[rr]]; }
    }
    __device__ __forceinline__ void operator()(const f32x4 (&acc)[2][2][4][2], const Unit& u, int wr, int wc, int fr, int fq, const Pre& pre) const {
        const int c0 = wc * 32 + 8 * fq;
        const float* bp = b1 + (size_t)u.aux * 2048 + 2 * (u.pn * 128 + c0);
        const f32x4 bq0 = *(const f32x4*)(bp), bq1 = *(const f32x4*)(bp + 4), bq2 = *(const f32x4*)(bp + 8), bq3 = *(const f32x4*)(bp + 12);
        const float bg[8] = {bq0[0], bq0[2], bq1[0], bq1[2], bq2[0], bq2[2], bq3[0], bq3[2]};
        const float bl[8] = {bq0[1], bq0[3], bq1[1], bq1[3], bq2[1], bq2[3], bq3[1], bq3[3]};
#pragma unroll
        for (int ai = 0; ai < 2; ++ai)
#pragma unroll
            for (int m = 0; m < 4; ++m) { const int r = ai * HALF + wr * 64 + m * 16 + fr;
                const float sc = WSCALE8_INV * __builtin_amdgcn_rsqf(pre.sc[ai * 4 + m] * (1.0f / D) + EPS); float a[8];
#pragma unroll
                for (int j = 0; j < 8; ++j) { const float g = acc[ai][0][m][j >> 2][j & 3] * sc + bg[j], l = acc[ai][1][m][j >> 2][j & 3] * sc + bl[j];
                    const float glu = fminf(g, 7.0f), lin = fminf(fmaxf(l, -7.0f), 7.0f);
                    a[j] = glu * fast_rcp(1.0f + fast_exp2(-1.702f * LOG2E * glu)) * (lin + 1.0f); }
                *(u32x2*)((unsigned char*)O + ((size_t)u.pm * BM + r) * D + u.pn * 128 + c0) = (u32x2){pk4_fp8(a[0], a[1], a[2], a[3]), pk4_fp8(a[4], a[5], a[6], a[7])}; }
    }
};
constexpr float YSCALE = 16.0f, YSCALE_INV = 1.0f / 16.0f;
struct EpiW2 {
    static constexpr bool PERM = true, AFTER_DRAIN = false;
    struct Pre { float g[8]; };
    unsigned char* O; const float* b2; const int* list0; const float* gl0;
    __device__ __forceinline__ void prefetch(const Unit& u, int wr, int fr, Pre& p) const {
        const float* gp = gl0 + (u.rows - list0);
#pragma unroll
        for (int ai = 0; ai < 2; ++ai)
#pragma unroll
            for (int m = 0; m < 4; ++m) { const int r = ai * HALF + wr * 64 + m * 16 + fr; p.g[ai * 4 + m] = r < u.nrows ? gp[r] : 0.f; }
    }
    __device__ __forceinline__ void operator()(const f32x4 (&acc)[2][2][4][2], const Unit& u, int wr, int wc, int fr, int fq, const Pre& pre) const {
        const int row0 = u.pm * BM + wr * 64 + fr, col0 = u.pn * BM + wc * 32 + 8 * fq;
        f32x4 bv[2][2];
#pragma unroll
        for (int bj = 0; bj < 2; ++bj)
#pragma unroll
            for (int n = 0; n < 2; ++n) bv[bj][n] = *(const f32x4*)(b2 + (size_t)u.aux * D + col0 + bj * HALF + 4 * n);
#pragma unroll
        for (int ai = 0; ai < 2; ++ai)
#pragma unroll
            for (int m = 0; m < 4; ++m) { unsigned char* rowp = O + (size_t)(row0 + ai * HALF + m * 16) * D + col0; const float g = YSCALE * pre.g[ai * 4 + m];
#pragma unroll
                for (int bj = 0; bj < 2; ++bj) { const f32x4 v0 = (acc[ai][bj][m][0] * WSCALE8_INV + bv[bj][0]) * g, v1 = (acc[ai][bj][m][1] * WSCALE8_INV + bv[bj][1]) * g;
                    *(u32x2*)(rowp + bj * HALF) = (u32x2){pk4_fp8(v0[0], v0[1], v0[2], v0[3]), pk4_fp8(v1[0], v1[1], v1[2], v1[3])}; } }
    }
};
}

namespace moba {
using bf16x8 = ::bf16x8; using s16x4 = ::s16x4; using f32x16 = ::f32x16; using u32x4 = ::u32x4;
constexpr int DMQ = INC, DMO = D, HD = 64;
constexpr int NW = 8, QBLK = 32, QB = 256, KVBLK = 64;
__device__ __forceinline__ int crow(int r, int hi) { return (r & 3) + 8 * (r >> 2) + 4 * hi; }
#define SBAR() __builtin_amdgcn_sched_barrier(0)
__device__ __forceinline__ void cmask(f32x16& p0, f32x16& p1, int jb, int qrel, int hi) {
    const float NEG = -INFINITY; int kb = 64 * jb + 4 * hi;
#pragma unroll
    for (int r = 0; r < 16; ++r) { int kv = kb + (r & 3) + 8 * (r >> 2); if (kv > qrel) p0[r] = NEG; if (kv + 32 > qrel) p1[r] = NEG; }
}
constexpr int NSLOT = 3, SLOTB = 8192;
constexpr int LDS_K = 0, LDS_V = NSLOT * SLOTB, LDS_WS = 2 * NSLOT * SLOTB, LDS_OST = LDS_WS + NW * 64 * 4, LDS_KB = LDS_OST + NW * 4096, LDS_BYTES = LDS_KB + 16 * 64 * 4;
__device__ __forceinline__ void glds16(const void* gsrc, unsigned lds_dst) { unsigned keep;
    asm volatile("s_mov_b32 %0, m0\n\ts_mov_b32 m0, %2\n\ts_nop 0\n\tglobal_load_lds_dwordx4 %1, off\n\ts_mov_b32 m0, %0" : "=&s"(keep) : "v"(gsrc), "s"(lds_dst) : "memory"); }
__device__ __forceinline__ float max3f(float a, float b, float c) { float r; asm("v_max3_f32 %0, %1, %2, %3" : "=v"(r) : "v"(a), "v"(b), "v"(c)); return r; }
__device__ __forceinline__ float max2f(float a, float b) { float r; asm("v_max_f32_e32 %0, %1, %2" : "=v"(r) : "v"(a), "v"(b)); return r; }
__device__ __forceinline__ float fadd_s(float a, float b) { float r; asm("v_add_f32_e32 %0, %1, %2" : "=v"(r) : "v"(a), "v"(b)); return r; }
__device__ __forceinline__ float fsub_s(float a, float b) { float r; asm("v_sub_f32_e32 %0, %1, %2" : "=v"(r) : "v"(a), "v"(b)); return r; }
__device__ __forceinline__ unsigned cvtpk_s(float lo, float hi) { return ::cvtpk(lo, hi); }
#define WAIT_BAR(N) asm volatile("s_waitcnt vmcnt(" #N ") lgkmcnt(0)\n\ts_barrier" ::: "memory")
__device__ __forceinline__ void qkt(f32x16& p0, f32x16& p1, const char* Kslot, const bf16x8* qr, const f32x16& negm, int r32, int hi) {
    const char* kb = Kslot + hi * 1024 + r32 * 16;
#pragma unroll
    for (int d0 = 0; d0 < 4; ++d0) {
        const bf16x8 b0 = *reinterpret_cast<const bf16x8*>(kb + d0 * 2048);
        const bf16x8 b1 = *reinterpret_cast<const bf16x8*>(kb + d0 * 2048 + 512);
        if (d0 == 0) { p0 = __builtin_amdgcn_mfma_f32_32x32x16_bf16(b0, qr[0], negm, 0, 0, 0); p1 = __builtin_amdgcn_mfma_f32_32x32x16_bf16(b1, qr[0], negm, 0, 0, 0); }
        else { p0 = __builtin_amdgcn_mfma_f32_32x32x16_bf16(b0, qr[d0], p0, 0, 0, 0); p1 = __builtin_amdgcn_mfma_f32_32x32x16_bf16(b1, qr[d0], p1, 0, 0, 0); } }
}
typedef __attribute__((address_space(3))) const char* lds_cptr;
typedef short v4i16_t __attribute__((ext_vector_type(4)));
__device__ __forceinline__ void kload8(bf16x8* kf, lds_cptr kp) {
    kf[0] = *(const __attribute__((address_space(3))) bf16x8*)(kp);        kf[1] = *(const __attribute__((address_space(3))) bf16x8*)(kp + 512);
    kf[2] = *(const __attribute__((address_space(3))) bf16x8*)(kp + 2048); kf[3] = *(const __attribute__((address_space(3))) bf16x8*)(kp + 2560);
    kf[4] = *(const __attribute__((address_space(3))) bf16x8*)(kp + 4096); kf[5] = *(const __attribute__((address_space(3))) bf16x8*)(kp + 4608);
    kf[6] = *(const __attribute__((address_space(3))) bf16x8*)(kp + 6144); kf[7] = *(const __attribute__((address_space(3))) bf16x8*)(kp + 6656);
}
__device__ __forceinline__ void kload2(bf16x8* kf, lds_cptr kp, int j) { kf[2 * j] = *(const __attribute__((address_space(3))) bf16x8*)(kp + j * 2048); kf[2 * j + 1] = *(const __attribute__((address_space(3))) bf16x8*)(kp + j * 2048 + 512); }
__device__ __forceinline__ s16x4 vtr(lds_cptr p) { return __builtin_bit_cast(s16x4, __builtin_amdgcn_ds_read_tr16_b64_v4i16((__attribute__((address_space(3))) v4i16_t*)p)); }
__device__ __forceinline__ float rowmax(const f32x16& p0, const f32x16& p1) {
    float a = max3f(p0[0], p0[1], p1[0]), b = max3f(p0[2], p0[3], p1[1]); a = max3f(a, p1[2], p1[3]);
#pragma unroll
    for (int r = 4; r < 16; r += 4) { a = max3f(a, p0[r], p0[r + 1]); b = max3f(b, p0[r + 2], p0[r + 3]); a = max3f(a, p1[r], p1[r + 1]); b = max3f(b, p1[r + 2], p1[r + 3]); }
    const float m = max2f(a, b);
    auto rr = __builtin_amdgcn_permlane32_swap(__float_as_uint(m), __float_as_uint(m), false, false);
    return max2f(__uint_as_float(rr[0]), __uint_as_float(rr[1]));
}
__device__ __forceinline__ void pv(f32x16* o, int vb, bf16x8 pa0, bf16x8 pa1, bf16x8 pa2, bf16x8 pa3) {
#pragma unroll
    for (int d0 = 0; d0 < 2; ++d0) { s16x4 lo[4], hi[4];
#pragma unroll
        for (int ks = 0; ks < 4; ++ks) {
            asm volatile("ds_read_b64_tr_b16 %0,%1 offset:%c2" : "=&v"(lo[ks]) : "v"(vb), "i"(d0 * 4096 + ks * 1024) : "memory");
            asm volatile("ds_read_b64_tr_b16 %0,%1 offset:%c2" : "=&v"(hi[ks]) : "v"(vb), "i"(d0 * 4096 + ks * 1024 + 512) : "memory"); }
        asm volatile("s_waitcnt lgkmcnt(0)" ::: "memory"); SBAR();
#define PK(k) (bf16x8){lo[k][0], lo[k][1], lo[k][2], lo[k][3], hi[k][0], hi[k][1], hi[k][2], hi[k][3]}
        o[d0] = __builtin_amdgcn_mfma_f32_32x32x16_bf16(pa0, PK(0), o[d0], 0, 0, 0);
        o[d0] = __builtin_amdgcn_mfma_f32_32x32x16_bf16(pa1, PK(1), o[d0], 0, 0, 0);
        o[d0] = __builtin_amdgcn_mfma_f32_32x32x16_bf16(pa2, PK(2), o[d0], 0, 0, 0);
        o[d0] = __builtin_amdgcn_mfma_f32_32x32x16_bf16(pa3, PK(3), o[d0], 0, 0, 0);
#undef PK
    }
}
constexpr float NEGBIG = -1.0e30f;

template <int THRL> __device__ __forceinline__ void attn_unit(int b, int h, int qb, const bf16_t* Qg, const bf16_t* __restrict__ Kg, const bf16_t* __restrict__ Vg, bf16_t* Og, const float* __restrict__ kbar, char* shm) {
    int tid_ = threadIdx.x; asm volatile("" : "+v"(tid_));
    const int tid = tid_, lane = tid & 63, r32 = lane & 31, hi = lane >> 5; const int wid = __builtin_amdgcn_readfirstlane(tid >> 6);
    const long rowbase = (long)b * SEQ; const int q0 = qb * QB;
    const size_t hoff = (size_t)(b * 8 + h) * (SEQ * 64);
    const bf16_t* Qw = Qg + hoff + (size_t)(q0 + wid * QBLK) * 64;
    const bf16_t* Kh = Kg + hoff, *Vh = Vg + hoff;
    const unsigned lds0 = (unsigned)(uintptr_t)shm;
    float* wsf = (float*)(shm + LDS_WS) + wid * 64;
    const bf16_t* ksrc = Kh + wid * 512 + lane * 8;
    const bf16_t* vsrc = Vh + wid * 512 + lane * 8;
    const unsigned kdst = lds0 + LDS_K + wid * 1024, vdst = lds0 + LDS_V + wid * 1024;
    const int NT = 4 * qb + 4, NPAST = 4 * qb;
#define TMAP(t) (((t) < 4) ? (NPAST + (t)) : ((t) - 4))
#define DMA_K(t, slot) glds16(ksrc + (long)TMAP(t) * 4096, (unsigned)__builtin_amdgcn_readfirstlane(kdst + (slot)))
#define DMA_V(t, slot) glds16(vsrc + (long)TMAP(t) * 4096, (unsigned)__builtin_amdgcn_readfirstlane(vdst + (slot)))
    const char* Kbase = shm + LDS_K; bf16x8 kf[8];
    const lds_cptr shm3 = (lds_cptr)shm; const lds_cptr kp0 = shm3 + LDS_K + hi * 1024 + r32 * 16; const lds_cptr vp0 = shm3 + LDS_V + ((lane >> 4) & 1) * 32 + (lane & 3) * 8 + (4 * hi + ((lane & 15) >> 2)) * 64;
    DMA_K(0, 0); DMA_V(0, 0); DMA_K(1, SLOTB);
    bf16x8 qr[4];
#pragma unroll
    for (int d0 = 0; d0 < 4; ++d0) qr[d0] = *reinterpret_cast<const bf16x8*>(&Qw[(long)r32 * 64 + d0 * 16 + hi * 8]);
    unsigned selm = 0u;
    if (qb > 0) {
        float* kbl = (float*)(shm + LDS_KB);
        for (int i = tid; i < qb * 64; i += NW * 64) kbl[i] = kbar[((size_t)(b * 16 + (i >> 6)) * 8 + h) * 64 + (i & 63)];
        asm volatile("s_waitcnt vmcnt(0) lgkmcnt(0)\n\ts_barrier" ::: "memory");
        if (qb <= 3) selm = (1u << qb) - 1u;
        else {
            float qf[32];
#pragma unroll
            for (int d0 = 0; d0 < 4; ++d0)
#pragma unroll
                for (int j = 0; j < 8; ++j) qf[d0 * 8 + j] = bf2f((unsigned short)qr[d0][j]);
            float g[15];
#pragma unroll
            for (int n = 0; n < 15; ++n) { float s = 0.f;
                if (n < qb) {
#pragma unroll
                    for (int d0 = 0; d0 < 4; ++d0) { const f32x4 k0 = *(const f32x4*)(kbl + n * 64 + d0 * 16 + hi * 8), k1 = *(const f32x4*)(kbl + n * 64 + d0 * 16 + hi * 8 + 4);
                        s += qf[d0 * 8 + 0] * k0[0] + qf[d0 * 8 + 1] * k0[1] + qf[d0 * 8 + 2] * k0[2] + qf[d0 * 8 + 3] * k0[3] + qf[d0 * 8 + 4] * k1[0] + qf[d0 * 8 + 5] * k1[1] + qf[d0 * 8 + 6] * k1[2] + qf[d0 * 8 + 7] * k1[3]; }
                    s += __shfl_xor(s, 32);
                } else s = -INFINITY;
                g[n] = s; }
#pragma unroll
            for (int pass = 0; pass < 3; ++pass) { float best = -INFINITY; int bi = 0;
#pragma unroll
                for (int n = 0; n < 15; ++n) if (g[n] > best) { best = g[n]; bi = n; }
                selm |= 1u << bi;
#pragma unroll
                for (int n = 0; n < 15; ++n) if (n == bi) g[n] = -INFINITY; }
        }
    }
    float mhat = 0.f, l_reg = 0.f; f32x16 o[2]; o[0] = f32x16{}; o[1] = f32x16{}; f32x16 cini = f32x16{}; asm volatile("" : "+v"(cini));
    const int qrel = wid * QBLK + r32;
#define SETC(t, JB) do { const float cm_ = ((JB >= 0) || ((selm >> (((t) - 4) >> 2)) & 1u)) ? -mhat : NEGBIG; \
      _Pragma("unroll") for (int r = 0; r < 16; ++r) cini[r] = cm_; asm volatile("" : "+v"(cini)); } while (0)
    bool resc = false;
#define START(P0, P1) do { const float rm = rowmax(P0, P1); resc = false; \
    { const float dl = rm; mhat = fadd_s(mhat, dl); \
      _Pragma("unroll") for (int r = 0; r < 16; ++r) { P0[r] = fsub_s(P0[r], dl); P1[r] = fsub_s(P1[r], dl); } } \
    _Pragma("unroll") for (int r = 0; r < 16; ++r) P0[r] = __builtin_amdgcn_exp2f(P0[r]); } while (0)
#define RESC() do { if (resc) { asm volatile("s_waitcnt lgkmcnt(0)" ::: "memory"); \
      _Pragma("unroll") for (int d_ = 0; d_ < 2; ++d_) _Pragma("unroll") for (int r = 0; r < 16; ++r) o[d_][r] *= wsf[crow(r, hi)]; } } while (0)
    f32x16 pA0, pA1, pB0, pB1;
    int sl_prev = 0, sl_cur = 0, sl_next = SLOTB;
#define ROT() do { sl_prev = sl_cur; sl_cur = sl_next; sl_next = (sl_next == (NSLOT - 1) * SLOTB) ? 0 : sl_next + SLOTB; } while (0)
    DMA_K(2, 2 * SLOTB);
    if (qb > 0) { WAIT_BAR(0); } else { WAIT_BAR(3); }
    qkt(pA0, pA1, Kbase, qr, cini, r32, hi); asm volatile("s_nop 15\n\ts_nop 7" : "+v"(pA0), "+v"(pA1)); cmask(pA0, pA1, 0, qrel, hi);
    START(pA0, pA1);
    _Pragma("unroll") for (int r = 0; r < 16; ++r) pA1[r] = __builtin_amdgcn_exp2f(pA1[r]);
    WAIT_BAR(0);
    DMA_K(3, 0); DMA_V(1, SLOTB);
    ROT();
    kload8(kf, kp0 + sl_cur);
    WAIT_BAR(2);
    s16x4 vlo[8], vhi[8]; u32x4 pw0, pw1, pw2, pw3;
#define PKW(P, B) cvtpk_s(P[B], P[B + 1])
#define PAF(k) __builtin_bit_cast(bf16x8, pw##k)
#define VFR(i) (bf16x8){vlo[i][0], vlo[i][1], vlo[i][2], vlo[i][3], vhi[i][0], vhi[i][1], vhi[i][2], vhi[i][3]}
#define PIN(x) asm volatile("" : "+v"(x))
#define MX3(a, b, c) __builtin_fmaxf(__builtin_fmaxf((a), (b)), (c))
#define GAPA(MF, A0, A1, A2, A3, W0, W1, PW) do { MF; sacc += A0; sacc += A1; sacc += A2; sacc += A3; PIN(sacc); W0; W1; PIN(PW); SBAR(); } while (0)
#define EX(v) __builtin_amdgcn_exp2f(v)
#define GAPB(MF, X, B) do { MF; X[B] = EX(X[B]); X[B + 1] = EX(X[B + 1]); X[B + 2] = EX(X[B + 2]); X[B + 3] = EX(X[B + 3]); PIN(X); SBAR(); } while (0)
#define VRD(i) do { vlo[i] = vtr(vp_ + (((i) >> 2) * 4096 + ((i) & 3) * 1024)); vhi[i] = vtr(vp_ + (((i) >> 2) * 4096 + ((i) & 3) * 1024 + 512)); } while (0)
#define KRD(G, j) do { if (G) { kload2(kf, kp0 + sl_next, j); SBAR(); } } while (0)
#define STEP(C0, C1, P0, P1, t, GK, GV, GL, JB) do { SETC(t, JB); SBAR(); \
    const lds_cptr vp_ = vp0 + sl_prev; \
    VRD(0); SBAR(); float sacc = (P0[0] + P0[1]); \
    GAPA(C0 = __builtin_amdgcn_mfma_f32_32x32x16_bf16(kf[0], qr[0], cini, 0, 0, 0), P0[2], P0[3], P0[4], P0[5],     pw0[0] = PKW(P0, 0), pw0[1] = PKW(P0, 2), pw0); \
    VRD(4); SBAR(); GAPA(C1 = __builtin_amdgcn_mfma_f32_32x32x16_bf16(kf[1], qr[0], cini, 0, 0, 0), P0[6], P0[7], P0[8], P0[9],     pw0[2] = PKW(P0, 4), pw0[3] = PKW(P0, 6), pw0); \
    VRD(1); SBAR(); GAPA(C0 = __builtin_amdgcn_mfma_f32_32x32x16_bf16(kf[2], qr[1], C0, 0, 0, 0),   P0[10], P0[11], P0[12], P0[13], pw1[0] = PKW(P0, 8), pw1[1] = PKW(P0, 10), pw1); \
    VRD(5); SBAR(); GAPA(C1 = __builtin_amdgcn_mfma_f32_32x32x16_bf16(kf[3], qr[1], C1, 0, 0, 0),   P0[14], P0[15], P1[0], P1[1],   pw1[2] = PKW(P0, 12), pw1[3] = PKW(P0, 14), pw1); \
    VRD(2); SBAR(); GAPA(C0 = __builtin_amdgcn_mfma_f32_32x32x16_bf16(kf[4], qr[2], C0, 0, 0, 0),   P1[2], P1[3], P1[4], P1[5],     pw2[0] = PKW(P1, 0), pw2[1] = PKW(P1, 2), pw2); \
    VRD(6); SBAR(); GAPA(C1 = __builtin_amdgcn_mfma_f32_32x32x16_bf16(kf[5], qr[2], C1, 0, 0, 0),   P1[6], P1[7], P1[8], P1[9],     pw2[2] = PKW(P1, 4), pw2[3] = PKW(P1, 6), pw2); \
    VRD(3); SBAR(); GAPA(C0 = __builtin_amdgcn_mfma_f32_32x32x16_bf16(kf[6], qr[3], C0, 0, 0, 0),   P1[10], P1[11], P1[12], P1[13], pw3[0] = PKW(P1, 8), pw3[1] = PKW(P1, 10), pw3); \
    VRD(7); SBAR(); GAPA(C1 = __builtin_amdgcn_mfma_f32_32x32x16_bf16(kf[7], qr[3], C1, 0, 0, 0),   P1[14], P1[15], 0.f, 0.f,       pw3[2] = PKW(P1, 12), pw3[3] = PKW(P1, 14), pw3); \
    l_reg += sacc; \
    if (GK) { DMA_K((t) + 3, sl_cur); } if (GV) { DMA_V((t) + 1, sl_next); } \
    if (JB >= 0) cmask(C0, C1, JB, qrel, hi); \
    { float a = MX3(C0[0], C0[1], C1[0]), b_ = MX3(C0[2], C0[3], C1[1]); a = MX3(a, C1[2], C1[3]); \
      _Pragma("unroll") for (int r = 4; r < 16; r += 4) { a = MX3(a, C0[r], C0[r + 1]); b_ = MX3(b_, C0[r + 2], C0[r + 3]); a = MX3(a, C1[r], C1[r + 1]); b_ = MX3(b_, C1[r + 2], C1[r + 3]); } \
      float rm = __builtin_fmaxf(a, b_); { auto rr = __builtin_amdgcn_permlane32_swap(__float_as_uint(rm), __float_as_uint(rm), false, false); rm = __builtin_fmaxf(__uint_as_float(rr[0]), __uint_as_float(rr[1])); } \
      resc = false; \
      if (__builtin_expect(__any(rm > (float)THRL), 0)) { const float dl = __builtin_fmaxf(rm, 0.f); mhat += dl; \
        _Pragma("unroll") for (int r = 0; r < 16; ++r) { C0[r] -= dl; C1[r] -= dl; } \
        const float f = __builtin_amdgcn_exp2f(-dl); l_reg *= f; if (hi == 0) wsf[r32] = f; resc = true; } } \
    SBAR(); \
    GAPB(o[0] = __builtin_amdgcn_mfma_f32_32x32x16_bf16(PAF(0), VFR(0), o[0], 0, 0, 0), C0, 0); \
    GAPB(o[1] = __builtin_amdgcn_mfma_f32_32x32x16_bf16(PAF(0), VFR(4), o[1], 0, 0, 0), C0, 4); \
    KRD(GL, 0); GAPB(o[0] = __builtin_amdgcn_mfma_f32_32x32x16_bf16(PAF(1), VFR(1), o[0], 0, 0, 0), C0, 8); \
    KRD(GL, 1); GAPB(o[1] = __builtin_amdgcn_mfma_f32_32x32x16_bf16(PAF(1), VFR(5), o[1], 0, 0, 0), C0, 12); \
    KRD(GL, 2); GAPB(o[0] = __builtin_amdgcn_mfma_f32_32x32x16_bf16(PAF(2), VFR(2), o[0], 0, 0, 0), C1, 0); \
    KRD(GL, 3); GAPB(o[1] = __builtin_amdgcn_mfma_f32_32x32x16_bf16(PAF(2), VFR(6), o[1], 0, 0, 0), C1, 4); \
    GAPB(o[0] = __builtin_amdgcn_mfma_f32_32x32x16_bf16(PAF(3), VFR(3), o[0], 0, 0, 0), C1, 8); \
    GAPB(o[1] = __builtin_amdgcn_mfma_f32_32x32x16_bf16(PAF(3), VFR(7), o[1], 0, 0, 0), C1, 12); \
    } while (0)
#define ENDW(tt) do { if ((tt) + 3 < NT) { WAIT_BAR(2); } else if ((tt) + 2 < NT) { WAIT_BAR(1); } else { WAIT_BAR(0); } } while (0)
    STEP(pB0, pB1, pA0, pA1, 1, (4 < NT), true, true, 1);   ENDW(1); RESC(); ROT();
    STEP(pA0, pA1, pB0, pB1, 2, (5 < NT), true, true, 2);   ENDW(2); RESC(); ROT();
    STEP(pB0, pB1, pA0, pA1, 3, (6 < NT), (4 < NT), (4 < NT), 3);   ENDW(3); RESC(); ROT();
    for (int t = 4; t < NT; t += 2) {
        STEP(pA0, pA1, pB0, pB1, t, (t + 3 < NT), true, true, -1);                       ENDW(t);     RESC(); ROT();
        STEP(pB0, pB1, pA0, pA1, t + 1, (t + 4 < NT), (t + 2 < NT), (t + 2 < NT), -1);   ENDW(t + 1); RESC(); ROT();
    }
    { float sacc = pB0[0] + pB0[1]; _Pragma("unroll") for (int r = 2; r < 16; ++r) sacc += pB0[r]; _Pragma("unroll") for (int r = 0; r < 16; ++r) sacc += pB1[r]; l_reg += sacc;
      pw0 = (u32x4){PKW(pB0, 0), PKW(pB0, 2), PKW(pB0, 4), PKW(pB0, 6)}; pw1 = (u32x4){PKW(pB0, 8), PKW(pB0, 10), PKW(pB0, 12), PKW(pB0, 14)}; pw2 = (u32x4){PKW(pB1, 0), PKW(pB1, 2), PKW(pB1, 4), PKW(pB1, 6)}; pw3 = (u32x4){PKW(pB1, 8), PKW(pB1, 10), PKW(pB1, 12), PKW(pB1, 14)};
      SBAR(); pv(o, (int)(unsigned long)vp0 + sl_prev, PAF(0), PAF(1), PAF(2), PAF(3)); }
#undef PKW
#undef PAF
#undef VFR
#undef PIN
#undef MX3
#undef GAPA
#undef GAPB
#undef EX
#undef VRD
#undef KRD
#undef STEP
#undef ENDW
    { auto rr = __builtin_amdgcn_permlane32_swap(__float_as_uint(l_reg), __float_as_uint(l_reg), false, false); l_reg = __uint_as_float(rr[0]) + __uint_as_float(rr[1]); }
    if (hi == 0) wsf[32 + r32] = l_reg; asm volatile("s_waitcnt lgkmcnt(0)" ::: "memory");
    float rli[16];
#pragma unroll
    for (int r = 0; r < 16; ++r) rli[r] = __builtin_amdgcn_rcpf(wsf[32 + crow(r, hi)]);
    bf16_t* Ow = Og + (rowbase + q0 + wid * QBLK) * DMO + h * HD;
    { bf16_t* stg = (bf16_t*)(shm + LDS_OST) + wid * 2048;
#pragma unroll
      for (int r = 0; r < 16; ++r) { const int orow = crow(r, hi);
#pragma unroll
        for (int d0 = 0; d0 < 2; ++d0) stg[orow * 64 + d0 * 32 + r32] = (bf16_t)f2bf(o[d0][r] * rli[r]); }
      asm volatile("s_waitcnt lgkmcnt(0)" ::: "memory");
#pragma unroll
      for (int i = 0; i < 4; ++i) { const int row = i * 8 + (lane >> 3), ch = lane & 7; const u32x4 v = *(const u32x4*)(stg + row * 64 + ch * 8); *(u32x4*)(Ow + (long)row * DMO + ch * 8) = v; } }
    asm volatile("s_waitcnt lgkmcnt(0)\n\ts_barrier" ::: "memory");
#undef DMA_K
#undef DMA_V
#undef TMAP
#undef SETC
#undef START
#undef RESC
#undef ROT
}
#undef SBAR
#undef WAIT_BAR
}

namespace hgrn {
constexpr int RS = 144;
constexpr int R_FQV = 0, FQV_SLOT = 32768;
constexpr int L_Q = 98304, L_K = L_Q + 9216, L_KT = L_K + 9216, L_VT = L_KT + 9216, L_ST = L_VT + 9216, L_SEG = L_ST + 9216, L_DEND = L_SEG + 2048, L_SSQ = L_DEND + 256, L_BYTES = L_SSQ + 512;
__device__ __forceinline__ int crow(int r, int hi) { return (r & 3) + 8 * (r >> 2) + 4 * hi; }
__device__ __forceinline__ void glds16(const void* gsrc, unsigned lds_dst) { unsigned keep;
    asm volatile("s_mov_b32 %0, m0\n\ts_mov_b32 m0, %2\n\ts_nop 0\n\tglobal_load_lds_dwordx4 %1, off\n\ts_mov_b32 m0, %0" : "=&s"(keep) : "v"(gsrc), "s"(lds_dst) : "memory"); }
#define HG_BAR() do { asm volatile("s_waitcnt lgkmcnt(0)" ::: "memory"); __builtin_amdgcn_s_barrier(); asm volatile("" ::: "memory"); } while (0)
__device__ __forceinline__ void hgrn_unit(int b, int h, const bf16_t* __restrict__ proj, bf16_t* __restrict__ mix, const float* __restrict__ lb_logits, const float* __restrict__ norm_g, LAS unsigned char* lds) {
    int tid_ = threadIdx.x; asm volatile("" : "+v"(tid_));
    const int tid = tid_, lane = tid & 63, r32 = lane & 31, hi = lane >> 5; const int w = __builtin_amdgcn_readfirstlane(tid >> 6);
    const float lbk = fast_rcp(1.0f + fast_exp2((lb_logits[512 + h * 64 + lane] - lb_logits[h * 64 + lane]) * LOG2E));
    const int vr = (w >> 1) & 1, tc = w & 1;
    float ng[16];
#pragma unroll
    for (int r = 0; r < 16; ++r) ng[r] = norm_g[h * 64 + 32 * vr + crow(r, hi)];
    f32x16 S = f32x16{};
    for (int i = tid; i < 64 * RS / 4; i += 512) ((LAS unsigned*)(lds + L_ST))[i] = 0u;
    const size_t hoff = (size_t)(b * 8 + h) * (SEQ * 64) + (size_t)w * 512 + lane * 8;
    const bf16_t* gQ = proj + 3 * SEC_ELEMS + hoff; const bf16_t* gF = proj + 4 * SEC_ELEMS + hoff; const bf16_t* gV = proj + 5 * SEC_ELEMS + hoff; const bf16_t* gG = proj + 6 * SEC_ELEMS + hoff;
    const unsigned lds0 = (unsigned)(uintptr_t)(unsigned char*)lds;
#define DMA_FQV(c_) do { const int cc_ = (c_) < 63 ? (c_) : 63; const unsigned d_ = (unsigned)__builtin_amdgcn_readfirstlane(lds0 + R_FQV + (unsigned)(((c_) % 3) * FQV_SLOT) + (unsigned)w * 1024u); \
        glds16(gF + (size_t)cc_ * 4096, d_); glds16(gQ + (size_t)cc_ * 4096, d_ + 8192u); glds16(gV + (size_t)cc_ * 4096, d_ + 16384u); } while (0)
#define DMA_G(c_) do { const int cc_ = (c_) < 63 ? (c_) : 63; glds16(gG + (size_t)cc_ * 4096, (unsigned)__builtin_amdgcn_readfirstlane(lds0 + R_FQV + (unsigned)(((c_) % 3) * FQV_SLOT) + 24576u + (unsigned)w * 1024u)); } while (0)
    DMA_FQV(0); DMA_G(0); DMA_FQV(1); DMA_G(1);
    for (int c = 0; c < 64; ++c) {
        const size_t row0 = (size_t)b * SEQ + (size_t)c * 64;
        DMA_FQV(c + 2);
        asm volatile("s_waitcnt vmcnt(8)" ::: "memory");
        const LAS unsigned char* raw = lds + R_FQV + (c % 3) * FQV_SLOT + (8 * w) * 128 + lane * 2;
        float p[8], kk[8];
        { float run = 0.f;
#pragma unroll
          for (int i = 0; i < 8; ++i) { const float x = bf2f(*(const LAS unsigned short*)(raw + i * 128)); const float sg = fast_rcp(1.0f + fast_exp2(-x * LOG2E)); const float f = lbk + (1.0f - lbk) * sg;
              run += __builtin_amdgcn_logf(f); p[i] = run; kk[i] = 1.0f - f; } }
        ((LAS float*)(lds + L_SEG))[w * 64 + lane] = p[7];
        HG_BAR();
        DMA_G(c + 2);
        { float off = 0.f;
#pragma unroll
          for (int j = 0; j < 7; ++j) { const float sv = ((LAS float*)(lds + L_SEG))[j * 64 + lane]; off += (j < w) ? sv : 0.f; }
          unsigned kq[4], vq[4];
#pragma unroll
          for (int i = 0; i < 8; i += 2) { const float b0 = off + p[i], b1 = off + p[i + 1];
              const unsigned short q0r = *(const LAS unsigned short*)(raw + 8192 + i * 128), q1r = *(const LAS unsigned short*)(raw + 8192 + (i + 1) * 128);
              const unsigned short v0r = *(const LAS unsigned short*)(raw + 16384 + i * 128), v1r = *(const LAS unsigned short*)(raw + 16384 + (i + 1) * 128);
              const float q0 = bf2f(q0r) * fast_exp2(b0), q1 = bf2f(q1r) * fast_exp2(b1), k0 = kk[i] * fast_exp2(-b0), k1 = kk[i + 1] * fast_exp2(-b1);
              const unsigned qq = cvtpk(q0, q1), kw = cvtpk(k0, k1); kq[i >> 1] = kw; vq[i >> 1] = (unsigned)v0r | ((unsigned)v1r << 16);
              *(LAS unsigned short*)(lds + L_Q + (8 * w + i) * RS + lane * 2) = (unsigned short)(qq & 0xffffu);
              *(LAS unsigned short*)(lds + L_Q + (8 * w + i + 1) * RS + lane * 2) = (unsigned short)(qq >> 16);
              *(LAS unsigned short*)(lds + L_K + (8 * w + i) * RS + lane * 2) = (unsigned short)(kw & 0xffffu);
              *(LAS unsigned short*)(lds + L_K + (8 * w + i + 1) * RS + lane * 2) = (unsigned short)(kw >> 16); }
          *(LAS u32x4*)(lds + L_KT + lane * RS + 16 * w) = (u32x4){kq[0], kq[1], kq[2], kq[3]};
          *(LAS u32x4*)(lds + L_VT + lane * RS + 16 * w) = (u32x4){vq[0], vq[1], vq[2], vq[3]};
          if (w == 7) ((LAS float*)(lds + L_DEND))[lane] = fast_exp2(off + p[7]); }
        asm volatile("s_waitcnt vmcnt(8)" ::: "memory");
        HG_BAR();
        f32x16 OT = f32x16{};
        if (w < 4) {
            bf16x8 bq[4];
#pragma unroll
            for (int ks = 0; ks < 4; ++ks) bq[ks] = *(const LAS bf16x8*)(lds + L_Q + (32 * tc + r32) * RS + (16 * ks + 8 * hi) * 2);
#pragma unroll
            for (int sr = 0; sr < 2; ++sr) if (sr <= tc) {
                f32x16 at = f32x16{};
#pragma unroll
                for (int ks = 0; ks < 4; ++ks) { const bf16x8 a = *(const LAS bf16x8*)(lds + L_K + (32 * sr + r32) * RS + (16 * ks + 8 * hi) * 2); at = __builtin_amdgcn_mfma_f32_32x32x16_bf16(a, bq[ks], at, 0, 0, 0); }
                if (sr == tc) {
#pragma unroll
                    for (int r = 0; r < 16; ++r) at[r] = (crow(r, hi) <= r32) ? at[r] : 0.f; }
#pragma unroll
                for (int st = 0; st < 2; ++st) {
                    u32x4 bw; bw.x = cvtpk(at[8 * st + 0], at[8 * st + 1]); bw.y = cvtpk(at[8 * st + 2], at[8 * st + 3]); bw.z = cvtpk(at[8 * st + 4], at[8 * st + 5]); bw.w = cvtpk(at[8 * st + 6], at[8 * st + 7]);
                    const u32x2 lo = *(const LAS u32x2*)(lds + L_VT + (32 * vr + r32) * RS + (32 * sr + 16 * st + 4 * hi) * 2);
                    const u32x2 hh = *(const LAS u32x2*)(lds + L_VT + (32 * vr + r32) * RS + (32 * sr + 16 * st + 8 + 4 * hi) * 2);
                    const u32x4 aw = (u32x4){lo.x, lo.y, hh.x, hh.y};
                    OT = __builtin_amdgcn_mfma_f32_32x32x16_bf16(__builtin_bit_cast(bf16x8, aw), __builtin_bit_cast(bf16x8, bw), OT, 0, 0, 0); }
            }
#pragma unroll
            for (int ks = 0; ks < 4; ++ks) { const bf16x8 a = *(const LAS bf16x8*)(lds + L_ST + (32 * vr + r32) * RS + (16 * ks + 8 * hi) * 2); OT = __builtin_amdgcn_mfma_f32_32x32x16_bf16(a, bq[ks], OT, 0, 0, 0); }
            float sq = 0.f;
#pragma unroll
            for (int r = 0; r < 16; ++r) sq += OT[r] * OT[r];
            sq += __shfl_xor(sq, 32);
            if (hi == 0) ((LAS float*)(lds + L_SSQ))[vr * 64 + 32 * tc + r32] = sq;
        } else {
#pragma unroll
            for (int st = 0; st < 4; ++st) { const bf16x8 a = *(const LAS bf16x8*)(lds + L_KT + (32 * vr + r32) * RS + (16 * st + 8 * hi) * 2);
                const bf16x8 bv = *(const LAS bf16x8*)(lds + L_VT + (32 * tc + r32) * RS + (16 * st + 8 * hi) * 2);
                S = __builtin_amdgcn_mfma_f32_32x32x16_bf16(a, bv, S, 0, 0, 0); }
#pragma unroll
            for (int r = 0; r < 16; ++r) S[r] *= ((LAS float*)(lds + L_DEND))[32 * vr + crow(r, hi)];
        }
        HG_BAR();
        if (w < 4) {
            const int t = 32 * tc + r32;
            const float tot = ((LAS float*)(lds + L_SSQ))[t] + ((LAS float*)(lds + L_SSQ))[64 + t];
            const float rstd = __builtin_amdgcn_rsqf(tot * (1.0f / 64.0f) + EPS);
            const LAS unsigned char* gp = lds + R_FQV + (c % 3) * FQV_SLOT + 24576 + t * 128 + (32 * vr + 4 * hi) * 2;
            bf16_t* op = mix + (row0 + t) * D + 512 + h * 64 + 32 * vr + 4 * hi;
#pragma unroll
            for (int g = 0; g < 4; ++g) { const u32x2 gg = *(const LAS u32x2*)(gp + 16 * g);
                const float y0 = OT[4 * g + 0] * rstd * ng[4 * g + 0] * bflo(gg.x), y1 = OT[4 * g + 1] * rstd * ng[4 * g + 1] * bfhi(gg.x),
                            y2 = OT[4 * g + 2] * rstd * ng[4 * g + 2] * bflo(gg.y), y3 = OT[4 * g + 3] * rstd * ng[4 * g + 3] * bfhi(gg.y);
                *(u32x2*)(op + 8 * g) = (u32x2){cvtpk(y0, y1), cvtpk(y2, y3)}; }
        } else {
#pragma unroll
            for (int g = 0; g < 4; ++g) *(LAS u32x2*)(lds + L_ST + (32 * tc + r32) * RS + (32 * vr + 8 * g + 4 * hi) * 2) = (u32x2){cvtpk(S[4 * g + 0], S[4 * g + 1]), cvtpk(S[4 * g + 2], S[4 * g + 3])};
        }
    }
    asm volatile("s_waitcnt vmcnt(0)" ::: "memory");
    HG_BAR();
#undef DMA_FQV
#undef DMA_G
}
#undef HG_BAR
}

constexpr int NWAVES = 8;
constexpr int LDS_BYTES = 163840;
constexpr int TAIL = 161792;
constexpr int TL_TE = TAIL, TL_TS = TAIL + 576, TL_HIST = TAIL + 768, TL_BASE = TAIL + 896, TL_MISC = TAIL + 1024, TL_CNT = TAIL + 1280;
typedef GAS unsigned gu32;

struct Args { const float* in[20]; float* out; unsigned char* ws; int ph_lo, ph_hi; };

struct Frame {
    LAS unsigned char* lds; volatile LAS unsigned* MISC; unsigned* ctl;
    int tid, lane, wave, G, vcu;
};

struct P0Item { const float* W; bf16_t* WT; const float* gain; int N, K, k0, n0, mode; };
__device__ __forceinline__ bool p0_decode(const Args& a, int it, P0Item& I) {
    unsigned char* ws = a.ws;
    constexpr int I_IN = 16 * 56, I_SQ = 16 * 16, I_KV = 16 * 32, I_W1 = 16 * 32, I_W2 = 16 * 16;
    constexpr int NITEMS = I_IN + 3 * I_SQ + I_KV + NEXP * (I_W1 + I_W2);
    if (it >= NITEMS) return false;
    int r = it; I.gain = nullptr; I.mode = 0; I.K = D;
    if (r < I_IN) { I.W = a.in[3]; I.WT = (bf16_t*)(ws + WS_WIN); I.N = INC; }
    else if ((r -= I_IN) < I_SQ) { I.W = a.in[6]; I.WT = (bf16_t*)(ws + WS_WOUT); I.N = D; }
    else if ((r -= I_SQ) < I_SQ) { I.W = a.in[9]; I.WT = (bf16_t*)(ws + WS_WQ); I.N = D; I.gain = a.in[7]; }
    else if ((r -= I_SQ) < I_KV) { I.W = a.in[10]; I.WT = (bf16_t*)(ws + WS_WKV); I.N = 2 * D; }
    else if ((r -= I_KV) < I_SQ) { I.W = a.in[11]; I.WT = (bf16_t*)(ws + WS_WO); I.N = D; }
    else if ((r -= I_SQ) < NEXP * I_W1) { const int e = r / I_W1; r -= e * I_W1; I.W = a.in[15] + (size_t)e * D * 2048; I.WT = (bf16_t*)(ws + WS_W1 + (size_t)e * 2048 * D); I.N = 2048; I.gain = a.in[12]; I.mode = 3; }
    else { r -= NEXP * I_W1; const int e = r / I_W2; r -= e * I_W2; I.W = a.in[17] + (size_t)e * D * D; I.WT = (bf16_t*)(ws + WS_W2 + (size_t)e * D * D); I.N = D; I.mode = 2; }
    const int nblk = I.N / 64; I.k0 = 64 * (r / nblk); I.n0 = 64 * (r % nblk); return true;
}
__device__ __forceinline__ void p0_load(const P0Item& I, f32x4 (&v)[16], int lane) {
    const float* p = I.W + (size_t)(I.k0 + (lane >> 4)) * I.N + I.n0 + 4 * (lane & 15);
#pragma unroll
    for (int j = 0; j < 16; ++j) v[j] = *(const f32x4*)(p + (size_t)(4 * j) * I.N);
}
__device__ __forceinline__ void p0_store(const P0Item& I, const f32x4 (&v)[16], LAS unsigned char* tl, int lane) {
    const int kr = lane >> 4, nq = lane & 15;
#pragma unroll
    for (int j = 0; j < 16; ++j) { const int k = 4 * j + kr; const float g = I.gain ? I.gain[I.k0 + k] : 1.0f;
        *(LAS u32x2*)(tl + k * 128 + (((nq >> 1) ^ ((k >> 3) & 7)) * 16) + (nq & 1) * 8) = (u32x2){pk2(v[j].x * g, v[j].y * g), pk2(v[j].z * g, v[j].w * g)}; }
    LDS_WAIT(); asm volatile("" ::: "memory");
    const int c = lane & 7;
#pragma unroll
    for (int i = 0; i < 8; ++i) { const int n = (lane >> 3) + 8 * i; const LAS unsigned char* sp = tl + (8 * c) * 128 + ((i ^ c) * 16) + (n & 7) * 2;
        unsigned short e[8];
#pragma unroll
        for (int q = 0; q < 8; ++q) e[q] = *(const LAS unsigned short*)(sp + q * 128);
        int row = I.n0 + n; if (I.mode & 1) { const int jj = row >> 1, bj = row & 1; row = (jj >> 7) * 256 + bj * 128 + (jj & 127); }
        if (I.mode & 2) *(u32x2*)((unsigned char*)I.WT + (size_t)row * I.K + I.k0 + 8 * c) = (u32x2){pk4_fp8(bf2f(e[0]) * WSCALE8, bf2f(e[1]) * WSCALE8, bf2f(e[2]) * WSCALE8, bf2f(e[3]) * WSCALE8), pk4_fp8(bf2f(e[4]) * WSCALE8, bf2f(e[5]) * WSCALE8, bf2f(e[6]) * WSCALE8, bf2f(e[7]) * WSCALE8)};
        else *(u32x4*)(I.WT + (size_t)row * I.K + I.k0 + 8 * c) = (u32x4){(unsigned)e[0] | ((unsigned)e[1] << 16), (unsigned)e[2] | ((unsigned)e[3] << 16), (unsigned)e[4] | ((unsigned)e[5] << 16), (unsigned)e[6] | ((unsigned)e[7] << 16)}; }
    LDS_WAIT(); asm volatile("" ::: "memory");
}
__device__ __forceinline__ void rms_rows2_to_bf16(const float* __restrict__ x0, const float* __restrict__ x1, const float* __restrict__ g, bf16_t* __restrict__ o0, bf16_t* __restrict__ o1, int lane) {
    const f32x4* xa = (const f32x4*)x0 + lane; const f32x4* xb = (const f32x4*)x1 + lane; const f32x4* gr = (const f32x4*)g + lane;
    f32x4 va[4], vb[4]; float sa = 0.f, sb = 0.f;
#pragma unroll
    for (int j = 0; j < 4; ++j) { va[j] = xa[64 * j]; vb[j] = xb[64 * j]; }
#pragma unroll
    for (int j = 0; j < 4; ++j) { sa += (va[j].x * va[j].x + va[j].y * va[j].y) + (va[j].z * va[j].z + va[j].w * va[j].w); sb += (vb[j].x * vb[j].x + vb[j].y * vb[j].y) + (vb[j].z * vb[j].z + vb[j].w * vb[j].w); }
    const float ra = 1.0f / sqrtf(wave_sum(sa) * (1.0f / D) + EPS), rb = 1.0f / sqrtf(wave_sum(sb) * (1.0f / D) + EPS);
    unsigned long long* pa = (unsigned long long*)o0 + lane; unsigned long long* pb = (unsigned long long*)o1 + lane;
#pragma unroll
    for (int j = 0; j < 4; ++j) { const f32x4 gg = gr[64 * j];
        pa[64 * j] = (unsigned long long)pk2(va[j].x * ra * gg.x, va[j].y * ra * gg.y) | ((unsigned long long)pk2(va[j].z * ra * gg.z, va[j].w * ra * gg.w) << 32);
        pb[64 * j] = (unsigned long long)pk2(vb[j].x * rb * gg.x, vb[j].y * rb * gg.y) | ((unsigned long long)pk2(vb[j].z * rb * gg.z, vb[j].w * rb * gg.w) << 32); }
}

__device__ __forceinline__ void p0_prologue(Frame& F, const Args& a) {
    unsigned char* ws = a.ws;
    LAS unsigned char* tl = F.lds + F.wave * 8192;
    const int gw = F.vcu * NWAVES + F.wave, NGW = F.G * NWAVES;
    for (int m = 2 * gw; m < T; m += 2 * NGW) rms_rows2_to_bf16(a.in[0] + (size_t)m * D, a.in[0] + (size_t)(m + 1) * D, a.in[2], (bf16_t*)(ws + WS_XN) + (size_t)m * D, (bf16_t*)(ws + WS_XN) + (size_t)(m + 1) * D, F.lane);
    for (int m = 2 * gw; m < MROWS; m += 2 * NGW) rms_rows2_to_bf16(a.in[1] + (size_t)m * D, a.in[1] + (size_t)(m + 1) * D, a.in[8], (bf16_t*)(ws + WS_MN) + (size_t)m * D, (bf16_t*)(ws + WS_MN) + (size_t)(m + 1) * D, F.lane);
    for (int i = gw * 64 + F.lane; i < NEXP * D; i += NGW * 64) { const int e = i >> 10, k = i & 1023; ((float*)(ws + WS_WRT))[i] = a.in[12][k] * a.in[13][k * NEXP + e]; }
    P0Item IA, IB; f32x4 va[16], vb[16];
    int it = gw; bool ha = p0_decode(a, it, IA); if (ha) p0_load(IA, va, F.lane);
    while (ha) {
        const bool hb = p0_decode(a, it + NGW, IB); if (hb) p0_load(IB, vb, F.lane);
        p0_store(IA, va, tl, F.lane);
        if (!hb) break;
        it += 2 * NGW; ha = p0_decode(a, it, IA); if (ha) p0_load(IA, va, F.lane);
        p0_store(IB, vb, tl, F.lane);
    }
}

__device__ __forceinline__ unsigned xcc_id() { return (unsigned)__builtin_amdgcn_s_getreg((3 << 11) | 20) & 0xFu; }
constexpr int QITEMS = 16 + 128;
__device__ __forceinline__ void p2_mixer(Frame& F, const Args& a, int rep) {
    unsigned char* ws = a.ws;
    const bf16_t* proj = (const bf16_t*)(ws + WS_PROJ); bf16_t* mix = (bf16_t*)(ws + WS_MIX);
    const unsigned x0 = xcc_id() & 7u;
    int par = 0;
#ifdef MK_P2_REPMODE
    if (rep && MK_P2_REPMODE == 4) return;
#endif
#ifdef MK_P2_HALF
    if (rep && (blockIdx.x & 8)) return;
#endif
    for (;;) {
        if (F.tid == 0) { int code = -1;
            for (int j = 0; j < 8; ++j) { const unsigned xq = (x0 + j) & 7u; const unsigned i = __hip_atomic_fetch_add(F.ctl + CW_QUEUE + 1024 * rep + 64 * xq, 1u, RLX_AGENT);
                if (i < (unsigned)QITEMS) { code = (int)(xq * 256u + i); break; } }
            F.MISC[par] = (unsigned)code; }
        LDS_WAIT(); __builtin_amdgcn_s_barrier(); asm volatile("" ::: "memory");
        const int code = __builtin_amdgcn_readfirstlane((int)F.MISC[par]); par ^= 1;
        if (code < 0) break;
        const int xq = code >> 8, i = code & 255;
#ifdef MK_P2_REPMODE
        if (rep && ((MK_P2_REPMODE == 1 && i >= 8) || (MK_P2_REPMODE == 2 && i < 16) || MK_P2_REPMODE == 3)) continue;
#endif
#ifndef NO_HGRN
        if (i < 8) { hgrn::hgrn_unit(xq, i, proj, mix, a.in[4], a.in[5], F.lds); }
        else
#endif
        if (i < 16) {
            pg8::KvOrder S{(const char*)(ws + WS_MN), (const char*)(ws + WS_WKV), xq * 8 + (i - 8)};
            pg8::EpiBf16 E{(bf16_t*)(ws + WS_MEMK), D, (bf16_t*)(ws + WS_MEMVT), MROWS};
            pg8::gemm_phase<pg8::EpiBf16, pg8::KvOrder, false, false>(F.lds, D, D, D / 64, S, E);
        } else
#ifndef NO_MOBA
        { const int j = i - 16, g = j >> 5, jj = j & 31, hh = 2 * g + (jj & 1), qb = 15 - (jj >> 1);
            moba::attn_unit<8>(xq, hh, qb, proj, proj + SEC_ELEMS, proj + 2 * SEC_ELEMS, mix, (const float*)(ws + WS_KBAR), (char*)(unsigned char*)F.lds); }
#else
        {}
#endif
    }
}

__device__ __forceinline__ void p7_router(Frame& F, const Args& a, int rep) {
    unsigned char* ws = a.ws;
    LAS float* WR = (LAS float*)F.lds;
    LAS int* hist = (LAS int*)(F.lds + TL_HIST); LAS int* basel = (LAS int*)(F.lds + TL_BASE);
    const float* wrt = (const float*)(ws + WS_WRT);
    for (int i = F.tid; i < NEXP * D / 4; i += 512) ((LAS f32x4*)WR)[i] = ((const f32x4*)wrt)[i];
    const float* h2f = (const float*)(ws + WS_H2F); const float* ss2 = (const float*)(ws + WS_SS2);
    int* toke = (int*)(ws + (rep ? WS_DUMMY + 1 * MiB : WS_TOKE)); int* tokr = (int*)(ws + (rep ? WS_DUMMY + 1 * MiB + 512 * 1024 : WS_TOKR)); float* tokg = (float*)(ws + (rep ? WS_DUMMY + 2 * MiB : WS_TOKG)); int* list = (int*)(ws + (rep ? WS_DUMMY + 4 * MiB : WS_LIST)); float* glist = (float*)(ws + (rep ? WS_DUMMY + 8 * MiB : WS_GLIST));
    unsigned* cntw = F.ctl + (rep ? CW_CNT + 2048 * rep : CW_CNT);
    const int lane = F.lane;
    const float brl = a.in[14][lane >> 1];
    for (int tb = blockIdx.x; tb < T / 128; tb += F.G) {
        if (F.tid < 32) hist[F.tid] = 0;
        LDS_WAIT(); __builtin_amdgcn_s_barrier(); asm volatile("" ::: "memory");
        int my_e = 0; float my_g = 0.f;
        for (int ig = 0; ig < 8; ++ig) {
            const int tq = tb * 128 + F.wave * 16 + ig * 2;
            f32x4 x[2][4];
#pragma unroll
            for (int q = 0; q < 2; ++q)
#pragma unroll
                for (int j = 0; j < 4; ++j) x[q][j] = *(const f32x4*)(h2f + (size_t)(tq + q) * D + 4 * lane + 256 * j);
            float v16[2][16];
            { const bool up = (lane & 32) != 0;
#pragma unroll
              for (int e = 0; e < 16; ++e) { float s0[2] = {0.f, 0.f}, s1[2] = {0.f, 0.f};
#pragma unroll
                  for (int j = 0; j < 4; ++j) { const f32x4 w0 = *(const LAS f32x4*)(WR + e * D + 4 * lane + 256 * j), w1 = *(const LAS f32x4*)(WR + (16 + e) * D + 4 * lane + 256 * j);
#pragma unroll
                      for (int q = 0; q < 2; ++q) { s0[q] += (x[q][j].x * w0.x + x[q][j].y * w0.y) + (x[q][j].z * w0.z + x[q][j].w * w0.w); s1[q] += (x[q][j].x * w1.x + x[q][j].y * w1.y) + (x[q][j].z * w1.z + x[q][j].w * w1.w); } }
#pragma unroll
                  for (int q = 0; q < 2; ++q) { const float send = up ? s0[q] : s1[q], keep = up ? s1[q] : s0[q]; v16[q][e] = keep + __shfl_xor(send, 32); }
                  asm volatile("" ::: "memory"); } }
#pragma unroll
            for (int q = 0; q < 2; ++q) {
                float v8[8], v4[4], v2[2];
                { const bool up = (lane & 16) != 0;
#pragma unroll
                  for (int e = 0; e < 8; ++e) { const float send = up ? v16[q][e] : v16[q][8 + e], keep = up ? v16[q][8 + e] : v16[q][e]; v8[e] = keep + __shfl_xor(send, 16); } }
                { const bool up = (lane & 8) != 0;
#pragma unroll
                  for (int e = 0; e < 4; ++e) { const float send = up ? v8[e] : v8[4 + e], keep = up ? v8[4 + e] : v8[e]; v4[e] = keep + __shfl_xor(send, 8); } }
                { const bool up = (lane & 4) != 0;
#pragma unroll
                  for (int e = 0; e < 2; ++e) { const float send = up ? v4[e] : v4[2 + e], keep = up ? v4[2 + e] : v4[e]; v2[e] = keep + __shfl_xor(send, 4); } }
                float v1; { const bool up = (lane & 2) != 0; const float send = up ? v2[0] : v2[1], keep = up ? v2[1] : v2[0]; v1 = keep + __shfl_xor(send, 2); }
                v1 += __shfl_xor(v1, 1);
                float cur = v1 * __builtin_amdgcn_rsqf(ss2[tq + q] * (1.0f / D) + EPS) + brl;
                float tv[4]; int te_[4];
#pragma unroll
                for (int k = 0; k < 4; ++k) { float m = cur;
#pragma unroll
                    for (int o = 1; o < 64; o <<= 1) m = fmaxf(m, __shfl_xor(m, o));
                    const unsigned long long bal = __ballot(cur == m); const int li = __builtin_ctzll(bal); const int e = li >> 1;
                    tv[k] = m; te_[k] = e; if ((lane >> 1) == e) cur = -INFINITY; }
                const float d1 = fast_exp2((tv[1] - tv[0]) * LOG2E), d2 = fast_exp2((tv[2] - tv[0]) * LOG2E), d3 = fast_exp2((tv[3] - tv[0]) * LOG2E);
                const float inv = 1.0f / (1.0f + d1 + d2 + d3);
                if ((lane >> 2) == ig * 2 + q) { const int k = lane & 3; my_e = k == 0 ? te_[0] : (k == 1 ? te_[1] : (k == 2 ? te_[2] : te_[3])); my_g = (k == 0 ? 1.0f : (k == 1 ? d1 : (k == 2 ? d2 : d3))) * inv; }
            }
        }
        const int rl = __hip_atomic_fetch_add(hist + my_e, 1, __ATOMIC_RELAXED, __HIP_MEMORY_SCOPE_WORKGROUP);
        LDS_WAIT(); __builtin_amdgcn_s_barrier(); asm volatile("" ::: "memory");
        if (F.tid < 32) basel[F.tid] = (int)__hip_atomic_fetch_add(cntw + F.tid, (unsigned)hist[F.tid], RLX_AGENT);
        LDS_WAIT(); VM_WAIT(); __builtin_amdgcn_s_barrier(); asm volatile("" ::: "memory");
        { const int t = tb * 128 + F.wave * 16 + (lane >> 2), k = lane & 3; const int rank = basel[my_e] + rl;
          toke[t * 4 + k] = my_e; tokr[t * 4 + k] = rank; tokg[t * 4 + k] = my_g; list[(size_t)my_e * T + rank] = t; glist[(size_t)my_e * T + rank] = my_g; }
        LDS_WAIT(); __builtin_amdgcn_s_barrier(); asm volatile("" ::: "memory");
    }
}

__device__ __forceinline__ int build_tables(Frame& F) {
    LAS int* ts = (LAS int*)(F.lds + TL_TS); LAS unsigned char* te = (LAS unsigned char*)(F.lds + TL_TE);
    if (F.tid == 0) { int run = 0;
        for (int e = 0; e < NEXP; ++e) { ts[e] = run; const unsigned c = __hip_atomic_load(F.ctl + CW_CNT + e, RLX_AGENT); ((LAS int*)(F.lds + TL_CNT))[e] = (int)c; run += (int)((c + 255u) >> 8); }
        ts[NEXP] = run; }
    LDS_WAIT(); __builtin_amdgcn_s_barrier(); asm volatile("" ::: "memory");
    const int nt = ts[NEXP];
    for (int g = F.tid; g < nt; g += 512) { int e = 0;
        for (int j = 1; j < NEXP; ++j) e += (ts[j] <= g) ? 1 : 0;
        te[g] = (unsigned char)e; }
    LDS_WAIT(); __builtin_amdgcn_s_barrier(); asm volatile("" ::: "memory");
    return __builtin_amdgcn_readfirstlane(nt);
}

__device__ __forceinline__ void p10_combine(Frame& F, const Args& a) {
    unsigned char* ws = a.ws;
    LAS int* ts = (LAS int*)(F.lds + TL_TS);
    const float* h2f = (const float*)(ws + WS_H2F); const unsigned char* Y = (const unsigned char*)(ws + WS_Y);
    const int* toke = (const int*)(ws + WS_TOKE); const int* tokr = (const int*)(ws + WS_TOKR);
    const float* gf = a.in[19];
    const int gw = F.vcu * NWAVES + F.wave, NGW = F.G * NWAVES, lane = F.lane;
    for (int t = gw; t < T; t += NGW) {
        float o[16];
        { const f32x4 a0 = *(const f32x4*)(h2f + (size_t)t * D + 8 * lane), a1 = *(const f32x4*)(h2f + (size_t)t * D + 8 * lane + 4), a2 = *(const f32x4*)(h2f + (size_t)t * D + 512 + 8 * lane), a3 = *(const f32x4*)(h2f + (size_t)t * D + 512 + 8 * lane + 4);
          o[0] = a0.x; o[1] = a0.y; o[2] = a0.z; o[3] = a0.w; o[4] = a1.x; o[5] = a1.y; o[6] = a1.z; o[7] = a1.w; o[8] = a2.x; o[9] = a2.y; o[10] = a2.z; o[11] = a2.w; o[12] = a3.x; o[13] = a3.y; o[14] = a3.z; o[15] = a3.w; }
#pragma unroll
        for (int k = 0; k < 4; ++k) { const int e = toke[t * 4 + k], r = tokr[t * 4 + k];
            const unsigned char* yr = Y + ((size_t)ts[e] * 256 + r) * D;
            const u32x2 y0 = *(const u32x2*)(yr + 8 * lane), y1 = *(const u32x2*)(yr + 512 + 8 * lane);
            const f32x2 a0 = __builtin_amdgcn_cvt_pk_f32_fp8((int)y0.x, false), a1 = __builtin_amdgcn_cvt_pk_f32_fp8((int)y0.x, true), a2 = __builtin_amdgcn_cvt_pk_f32_fp8((int)y0.y, false), a3 = __builtin_amdgcn_cvt_pk_f32_fp8((int)y0.y, true);
            const f32x2 c0 = __builtin_amdgcn_cvt_pk_f32_fp8((int)y1.x, false), c1 = __builtin_amdgcn_cvt_pk_f32_fp8((int)y1.x, true), c2 = __builtin_amdgcn_cvt_pk_f32_fp8((int)y1.y, false), c3 = __builtin_amdgcn_cvt_pk_f32_fp8((int)y1.y, true);
            o[0] += pg8::YSCALE_INV * a0.x; o[1] += pg8::YSCALE_INV * a0.y; o[2] += pg8::YSCALE_INV * a1.x; o[3] += pg8::YSCALE_INV * a1.y; o[4] += pg8::YSCALE_INV * a2.x; o[5] += pg8::YSCALE_INV * a2.y; o[6] += pg8::YSCALE_INV * a3.x; o[7] += pg8::YSCALE_INV * a3.y;
            o[8] += pg8::YSCALE_INV * c0.x; o[9] += pg8::YSCALE_INV * c0.y; o[10] += pg8::YSCALE_INV * c1.x; o[11] += pg8::YSCALE_INV * c1.y; o[12] += pg8::YSCALE_INV * c2.x; o[13] += pg8::YSCALE_INV * c2.y; o[14] += pg8::YSCALE_INV * c3.x; o[15] += pg8::YSCALE_INV * c3.y; }
        float s = 0.f;
#pragma unroll
        for (int j = 0; j < 16; ++j) s += o[j] * o[j];
        const float rstd = 1.0f / sqrtf(wave_sum(s) * (1.0f / D) + EPS);
        float* op = a.out + (size_t)t * D;
#pragma unroll
        for (int q = 0; q < 4; ++q) { const int col = (q >> 1) * 512 + 8 * lane + (q & 1) * 4; const f32x4 g4 = *(const f32x4*)(gf + col);
            *(f32x4*)(op + col) = (f32x4){o[4 * q] * rstd * g4.x, o[4 * q + 1] * rstd * g4.y, o[4 * q + 2] * rstd * g4.z, o[4 * q + 3] * rstd * g4.w}; }
    }
}

#define XB_TMO      128
#define XB_XCNT(j)  (256  + 64 * (j))
#define XB_XSUB(j)  (1280 + 64 * (j))
#define XB_XGEN(j)  (2304 + 64 * (j))
#define XB_TOP      3328
#define XB_TOPGEN   3392
#define XCD_BAR_WORDS 3456
#define XB_SPIN_CAP (1u << 22)
__device__ __forceinline__ unsigned xb_ld(unsigned* p)              { return __hip_atomic_load(p, __ATOMIC_RELAXED, __HIP_MEMORY_SCOPE_AGENT); }
__device__ __forceinline__ unsigned xb_add(unsigned* p, unsigned v) { return __hip_atomic_fetch_add(p, v, __ATOMIC_RELAXED, __HIP_MEMORY_SCOPE_AGENT); }
#define XB_SPIN(cond, bar) do { unsigned _sp = 0; while (cond) { __builtin_amdgcn_s_sleep(1); \
    if ((++_sp & 255u) == 0u) { if (xb_ld(&(bar)[XB_TMO])) break; if (_sp > XB_SPIN_CAP) { atomicAdd(&(bar)[XB_TMO], 1u); break; } } } } while (0)
struct XcdBarrier { unsigned* bar; unsigned x; volatile LAS unsigned* st; };
__device__ __forceinline__ XcdBarrier xcd_barrier_post(unsigned* bar, volatile LAS unsigned* st) {
    XcdBarrier b; b.bar = bar; b.x = (unsigned)__builtin_amdgcn_s_getreg((3 << 11) | 20) & 0xFu; b.st = st;
    if (threadIdx.x == 0) (void)xb_add(&bar[XB_XCNT(b.x)], 1u);
    return b;
}
__device__ __forceinline__ void xcd_barrier_complete(unsigned* bar, unsigned x, unsigned& nloc, unsigned& nx) {
    const unsigned G = gridDim.x * gridDim.y * gridDim.z;
    unsigned sum, cnt, mine, sp = 0u;
    for (;;) {
        sum = 0u; cnt = 0u; mine = 0u;
#pragma unroll
        for (unsigned j = 0; j < 16; ++j) { const unsigned c = xb_ld(&bar[XB_XCNT(j)]); sum += c; cnt += (c > 0u) ? 1u : 0u; mine = (j == x) ? c : mine; }
        if (sum == G) break;
        __builtin_amdgcn_s_sleep(1);
        if ((++sp & 255u) == 0u) { if (xb_ld(&bar[XB_TMO])) break; if (sp > XB_SPIN_CAP) { atomicAdd(&bar[XB_TMO], 1u); break; } }
    }
    nloc = mine > 0u ? mine : 1u; nx = cnt > 0u ? cnt : 1u;
}
__device__ __forceinline__ void xcd_barrier(const XcdBarrier& b) {
    asm volatile("s_waitcnt vmcnt(0)" ::: "memory");
    __syncthreads();
    if (threadIdx.x == 0) {
        unsigned* bar = b.bar;
        __builtin_amdgcn_s_waitcnt(0);
        unsigned nloc = b.st[0], nx = b.st[1];
        if (nloc == 0u) { xcd_barrier_complete(bar, b.x, nloc, nx); b.st[0] = nloc; b.st[1] = nx; }
        const unsigned old = xb_add(&bar[XB_XSUB(b.x)], 1u);
        const unsigned gen = old / nloc;
        if (old + 1u == (gen + 1u) * nloc) {
            __builtin_amdgcn_fence(__ATOMIC_RELEASE, "agent");
            asm volatile("s_waitcnt vmcnt(0)" ::: "memory");
            const unsigned og = xb_add(&bar[XB_TOP], 1u);
            const unsigned tg = og / nx;
            if (og + 1u == (tg + 1u) * nx) xb_add(&bar[XB_TOPGEN], 1u);
            else XB_SPIN(xb_ld(&bar[XB_TOPGEN]) == tg, bar);
            __builtin_amdgcn_fence(__ATOMIC_ACQUIRE, "agent");
            xb_add(&bar[XB_XGEN(b.x)], 1u);
            asm volatile("s_waitcnt vmcnt(0)" ::: "memory");
        } else {
            XB_SPIN(xb_ld(&bar[XB_XGEN(b.x)]) == gen, bar);
            __builtin_amdgcn_fence(__ATOMIC_ACQUIRE, "agent");
            asm volatile("s_waitcnt vmcnt(0)" ::: "memory");
        }
    }
    __syncthreads();
}
#ifndef MK_CG_ONLY
#define MK_CG_ONLY 0
#endif
__device__ __forceinline__ void grid_barrier(Frame& F, const XcdBarrier& xb_) { if (MK_CG_ONLY) cg::this_grid().sync(); else xcd_barrier(xb_); }
#ifndef MK_PHASE_MASK
#define MK_PHASE_MASK 0x7ff
#endif
#ifndef MK_REP_PHASE
#define MK_REP_PHASE -1
#endif
#ifndef MK_REP_N
#define MK_REP_N 0
#endif
__device__ __forceinline__ void ph0(Frame& F, const Args& args, int rep) { p0_prologue(F, args); }
__device__ __forceinline__ void ph1(Frame& F, const Args& args, int rep) {
    unsigned char* ws = args.ws; const int cid = (int)blockIdx.x;
    { pg8::DenseOrder S{(const char*)(ws + WS_XN), (const char*)(ws + WS_WIN), D, D, T / 256, INC / 256, F.G, cid};
      pg8::EpiProj E{(bf16_t*)(ws + WS_PROJ), rep ? (float*)(ws + WS_DUMMY) : (float*)(ws + WS_KBAR)};
      pg8::gemm_phase<pg8::EpiProj, pg8::DenseOrder, false, true>(F.lds, D, D, D / 64, S, E); }
}
__device__ __forceinline__ void ph2(Frame& F, const Args& args, int rep) { p2_mixer(F, args, rep); }
__device__ __forceinline__ void ph3(Frame& F, const Args& args, int rep) {
    unsigned char* ws = args.ws; const int cid = (int)blockIdx.x;
    pg8::DenseOrder S{(const char*)(ws + WS_MIX), (const char*)(ws + WS_WOUT), D, D, T / 256, D / 256, F.G, cid};
    pg8::EpiRes<true, false> E{(const void*)args.in[0], (bf16_t*)(ws + WS_H1B), nullptr, rep ? (float*)(ws + WS_DUMMY + 512 * 1024) : (float*)(ws + WS_SS1)};
    pg8::gemm_phase<pg8::EpiRes<true, false>, pg8::DenseOrder, false, true>(F.lds, D, D, D / 64, S, E);
}
__device__ __forceinline__ void ph4(Frame& F, const Args& args, int rep) {
    unsigned char* ws = args.ws; const int cid = (int)blockIdx.x;
    pg8::DenseOrder S{(const char*)(ws + WS_H1B), (const char*)(ws + WS_WQ), D, D, T / 256, D / 256, F.G, cid};
    pg8::EpiQ E{(bf16_t*)(ws + WS_QX), (const float*)(ws + WS_SS1)};
    pg8::gemm_phase<pg8::EpiQ, pg8::DenseOrder, false, true>(F.lds, D, D, D / 64, S, E);
}
__device__ __forceinline__ void ph5(Frame& F, const Args& args, int rep) {
    unsigned char* ws = args.ws; const int cid = (int)blockIdx.x;
    bf16_t* pw = (bf16_t*)(ws + WS_PWS) + (size_t)cid * 2 * 65536;
    for (int s = 0; s < 2; ++s) {
        pg8::XaScoreOrder S{(const char*)(ws + WS_QX), (const char*)(ws + WS_MEMK), cid + s * F.G};
        pg8::EpiSoftmax E{pw + (size_t)s * 65536};
        pg8::gemm_phase<pg8::EpiSoftmax, pg8::XaScoreOrder, false, false>(F.lds, D, D, 4, S, E);
    }
    VM_WAIT(); __syncthreads(); __builtin_amdgcn_fence(__ATOMIC_ACQUIRE, "agent"); __syncthreads();
    { pg8::XaPvOrder S{(const char*)pw, (const char*)(ws + WS_MEMVT), F.G, cid};
      pg8::EpiBf16 E{(bf16_t*)(ws + WS_OX), D, (bf16_t*)(ws + WS_OX), D};
      pg8::gemm_phase<pg8::EpiBf16, pg8::XaPvOrder, false, true>(F.lds, 256, MROWS, 4, S, E); }
}
__device__ __forceinline__ void ph6(Frame& F, const Args& args, int rep) {
    unsigned char* ws = args.ws; const int cid = (int)blockIdx.x;
    pg8::DenseOrder S{(const char*)(ws + WS_OX), (const char*)(ws + WS_WO), D, D, T / 256, D / 256, F.G, cid};
    pg8::EpiRes<false, true, true> E{(const void*)(ws + WS_H1B), (bf16_t*)(ws + WS_H2B), (float*)(ws + WS_H2F), rep ? (float*)(ws + WS_DUMMY + 512 * 1024) : (float*)(ws + WS_SS2)};
    pg8::gemm_phase<pg8::EpiRes<false, true, true>, pg8::DenseOrder, false, true>(F.lds, D, D, D / 64, S, E);
}
__device__ __forceinline__ void ph7(Frame& F, const Args& args, int rep) { p7_router(F, args, rep); }
__device__ __forceinline__ void ph8(Frame& F, const Args& args, int rep) {
    unsigned char* ws = args.ws; const int cid = (int)blockIdx.x;
    const int ntl = build_tables(F);
    pg8::MoeOrder S{(const char*)(ws + WS_H2B), (const char*)(ws + WS_W1), (const int*)(ws + WS_LIST), (const LAS int*)(F.lds + TL_CNT), (const LAS unsigned char*)(F.lds + TL_TE), (const LAS int*)(F.lds + TL_TS),
                    ntl, 8, F.G, cid, (size_t)2048 * D, 1, (size_t)256 * D, (size_t)256 * D};
    pg8::EpiW1 E{(bf16_t*)(ws + WS_HMID), (const float*)(ws + WS_SS2), args.in[16]};
    pg8::gemm_phase<pg8::EpiW1, pg8::MoeOrder, true, true, true>(F.lds, D / 2, D / 2, D / 128, S, E);
}
__device__ __forceinline__ void ph9(Frame& F, const Args& args, int rep) {
    unsigned char* ws = args.ws; const int cid = (int)blockIdx.x;
    const int ntl = build_tables(F);
    pg8::MoeOrder S{(const char*)(ws + WS_HMID), (const char*)(ws + WS_W2), (const int*)(ws + WS_LIST), (const LAS int*)(F.lds + TL_CNT), (const LAS unsigned char*)(F.lds + TL_TE), (const LAS int*)(F.lds + TL_TS),
                    ntl, 4, F.G, cid, (size_t)D * D, 0, (size_t)256 * D, (size_t)256 * D};
    pg8::EpiW2 E{(unsigned char*)(ws + WS_Y), args.in[18], (const int*)(ws + WS_LIST), (const float*)(ws + WS_GLIST)};
    pg8::gemm_phase<pg8::EpiW2, pg8::MoeOrder, false, true, true>(F.lds, D / 2, D / 2, D / 128, S, E);
}
__device__ __forceinline__ void ph10(Frame& F, const Args& args, int rep) { (void)build_tables(F); p10_combine(F, args); }

constexpr int N_PHASES = 11;
__global__ void __launch_bounds__(NWAVES * 64, 2) hymba_fwd(Args args) {
    extern __shared__ __attribute__((aligned(16))) unsigned char lds_raw[];
    Frame F;
    F.lds = (LAS unsigned char*)lds_raw;
    F.MISC = (volatile LAS unsigned*)(F.lds + TL_MISC);
    F.tid = threadIdx.x; F.lane = F.tid & 63; F.wave = __builtin_amdgcn_readfirstlane(F.tid >> 6);
    F.G = gridDim.x; { const int bx = blockIdx.x; F.vcu = (F.G % 8 == 0) ? (bx % 8) * (F.G / 8) + bx / 8 : bx; }
    F.ctl = (unsigned*)(args.ws + WS_CTL);
    const int lo = args.ph_lo, hi = args.ph_hi;
    for (int u = F.tid; u < 64; u += NWAVES * 64) ((LAS unsigned*)(F.lds + TL_MISC))[u] = 0u;
    __syncthreads();
    const XcdBarrier xbar = xcd_barrier_post(F.ctl + CW_BAR, F.MISC + 8);
#define RUN(k, fn) do { if (((MK_PHASE_MASK >> (k)) & 1) && lo <= (k) && (k) < hi) { fn(F, args, 0); \
        if (MK_REP_PHASE == (k) && MK_REP_N >= 1) { grid_barrier(F, xbar); fn(F, args, 1); } \
        if (MK_REP_PHASE == (k) && MK_REP_N >= 2) { grid_barrier(F, xbar); fn(F, args, 2); } \
        if ((k) + 1 < hi) { if ((k) == 0) cg::this_grid().sync(); else grid_barrier(F, xbar); } } } while (0)
    RUN(0, ph0); RUN(1, ph1); RUN(2, ph2); RUN(3, ph3); RUN(4, ph4); RUN(5, ph5); RUN(6, ph6); RUN(7, ph7); RUN(8, ph8); RUN(9, ph9); RUN(10, ph10);
#undef RUN
}

extern "C" void kernel_launch(void* const* d_in, const int* in_sizes, int n_in, void* d_out, int out_size, void* d_ws, size_t ws_size, hipStream_t stream) {
    static int grid = 0;
    if (grid == 0) {
        if (n_in != 20 || in_sizes[0] != T * D || out_size != T * D || ws_size < WS_END) {
            fprintf(stderr, "kernel_launch: shape/workspace mismatch (n_in %d, in0 %d, out %d, ws %zu, need %zu)\n", n_in, n_in > 0 ? in_sizes[0] : -1, out_size, ws_size, (size_t)WS_END); grid = -1; return; }
        int dev = 0, cus = 0, per_cu = 0;
        if (hipGetDevice(&dev) != hipSuccess || hipDeviceGetAttribute(&cus, hipDeviceAttributeMultiprocessorCount, dev) != hipSuccess) { grid = -1; return; }
        if (hipFuncSetAttribute((const void*)hymba_fwd, hipFuncAttributeMaxDynamicSharedMemorySize, LDS_BYTES) != hipSuccess) { fprintf(stderr, "kernel_launch: hipFuncSetAttribute failed\n"); grid = -1; return; }
        if (hipOccupancyMaxActiveBlocksPerMultiprocessor(&per_cu, (const void*)hymba_fwd, NWAVES * 64, LDS_BYTES) != hipSuccess || per_cu < 1) { fprintf(stderr, "kernel_launch: occupancy query says %d\n", per_cu); }
        (void)hipGetLastError();
        grid = cus;
        if (grid != 256) fprintf(stderr, "kernel_launch: %d CUs; this kernel is built for 256\n", grid);
    }
    if (grid < 0) return;
    (void)hipMemsetAsync((char*)d_ws + WS_CTL, 0, CTL_ZERO_BYTES, stream);
    Args a{};
    for (int i = 0; i < 20; ++i) a.in[i] = (const float*)d_in[i];
    a.out = (float*)d_out; a.ws = (unsigned char*)d_ws;
#if MK_N_LAUNCHES == 1
    a.ph_lo = 0; a.ph_hi = MK_LAST_PHASE + 1;
    void* kargs[] = {&a};
    hipError_t e = hipLaunchCooperativeKernel((const void*)hymba_fwd, dim3(grid), dim3(NWAVES * 64), kargs, LDS_BYTES, stream);
    if (e != hipSuccess) fprintf(stderr, "kernel_launch: cooperative launch failed: %s\n", hipGetErrorString(e));
#else
    for (int p = 0; p <= MK_LAST_PHASE; ++p) { a.ph_lo = p; a.ph_hi = p + 1; hipLaunchKernelGGL(hymba_fwd, dim3(grid), dim3(NWAVES * 64), LDS_BYTES, stream, a); }
#endif
}
```

```cpp
#include <hip/hip_runtime.h>
#include <hip/hip_cooperative_groups.h>
#include <cstdio>
#include <cstdint>
namespace cg = cooperative_groups;

#ifndef MK_N_LAUNCHES
#define MK_N_LAUNCHES 1
#endif
#ifndef MK_LAST_PHASE
#define MK_LAST_PHASE 10
#endif

#define LAS __attribute__((address_space(3)))
#define GAS __attribute__((address_space(1)))
typedef unsigned short bf16_t;
typedef short bf16x8 __attribute__((ext_vector_type(8)));
typedef short s16x4 __attribute__((ext_vector_type(4)));
typedef float f32x4 __attribute__((ext_vector_type(4)));
typedef float f32x2 __attribute__((ext_vector_type(2)));
typedef float f32x16 __attribute__((ext_vector_type(16)));
typedef unsigned u32x4 __attribute__((ext_vector_type(4)));
typedef unsigned u32x2 __attribute__((ext_vector_type(2)));
typedef int v8i32_t __attribute__((ext_vector_type(8)));

constexpr int BATCH = 8, SEQ = 4096, T = BATCH * SEQ, D = 1024, INC = 3584, NMEM = 256, MROWS = BATCH * NMEM;
constexpr int NEXP = 32, TOPK = 4, MT_MAX = T * TOPK / 256 + NEXP, MPAD = MT_MAX * 256;
constexpr float EPS = 1e-6f;
constexpr float LOG2E = 1.4426950408889634f;
constexpr float C2Q = 0.125f * LOG2E;
constexpr float C2X = 0.0625f * LOG2E;
constexpr int C_MQ = 0, C_MK = 512, C_MV = 1024, C_GQ = 1536, C_GF = 2048, C_GI = 2560, C_GG = 3072;

constexpr size_t MiB = 1u << 20;
constexpr size_t WS_CTL = 0, CTL_ZERO_BYTES = 2 * MiB;
constexpr size_t WS_KBAR = 1 * MiB;
constexpr size_t WS_SS1 = 1 * MiB + 256 * 1024;
constexpr size_t WS_SS2 = 1 * MiB + 384 * 1024;
constexpr size_t WS_TOKE = 2 * MiB, WS_TOKR = 2 * MiB + 512 * 1024, WS_TOKG = 3 * MiB;
constexpr size_t WS_WRT = 3 * MiB + 512 * 1024;
constexpr size_t WS_LIST = 4 * MiB;
constexpr size_t WS_GLIST = 8 * MiB;
constexpr size_t WS_WIN = 16 * MiB, WS_WOUT = 23 * MiB, WS_WQ = 25 * MiB, WS_WKV = 27 * MiB, WS_WO = 31 * MiB;
constexpr size_t WS_MN = 33 * MiB, WS_MEMK = 37 * MiB, WS_MEMVT = 41 * MiB;
constexpr size_t WS_W1 = 48 * MiB, WS_W2 = 176 * MiB;
constexpr size_t WS_PROJ = 240 * MiB;
constexpr size_t SEC_ELEMS = (size_t)16 * 1024 * 1024;
constexpr size_t WS_XN = 464 * MiB;
constexpr size_t WS_OX = 464 * MiB;
constexpr size_t WS_MIX = 528 * MiB;
constexpr size_t WS_H1B = 592 * MiB;
constexpr size_t WS_QX = 656 * MiB;
constexpr size_t WS_PWS = 720 * MiB;
constexpr size_t WS_HMID = 240 * MiB;
constexpr size_t WS_Y = 512 * MiB;
constexpr size_t WS_H2F = 784 * MiB;
constexpr size_t WS_H2B = 912 * MiB;
constexpr size_t WS_DUMMY = 976 * MiB;
constexpr size_t WS_END = 988 * MiB;
static_assert(WS_HMID + (size_t)MPAD * D * 2 <= WS_Y && WS_Y + (size_t)MPAD * D * 2 <= WS_H2F, "ws map");
constexpr int CW_TMO = 0;
constexpr int CW_CNT = 64;
constexpr int CW_QUEUE = 128;
constexpr int CW_BAR = 4096;

__device__ __forceinline__ unsigned f2bf(float f) { unsigned u = __builtin_bit_cast(unsigned, f); return (u + 0x7fffu + ((u >> 16) & 1u)) >> 16; }
__device__ __forceinline__ unsigned pk2(float lo, float hi) { return f2bf(lo) | (f2bf(hi) << 16); }
__device__ __forceinline__ float bf2f(unsigned short h) { return __builtin_bit_cast(float, (unsigned)h << 16); }
__device__ __forceinline__ float bflo(unsigned w) { return __builtin_bit_cast(float, w << 16); }
__device__ __forceinline__ float bfhi(unsigned w) { return __builtin_bit_cast(float, w & 0xffff0000u); }
typedef float f32x2_t __attribute__((ext_vector_type(2))); typedef __bf16 bf16x2_t __attribute__((ext_vector_type(2)));
__device__ __forceinline__ unsigned cvtpk(float lo, float hi) { f32x2_t v = {lo, hi}; bf16x2_t b = __builtin_convertvector(v, bf16x2_t); return __builtin_bit_cast(unsigned, b); }
__device__ __forceinline__ float wave_sum(float v) {
#pragma unroll
    for (int o = 1; o < 64; o <<= 1) v += __shfl_xor(v, o);
    return v;
}
__device__ __forceinline__ float fast_exp2(float x) { return __builtin_amdgcn_exp2f(x); }
__device__ __forceinline__ float fast_rcp(float x) { return __builtin_amdgcn_rcpf(x); }
__device__ __forceinline__ float silu_f(float x) { return x * fast_rcp(1.0f + fast_exp2(-x * LOG2E)); }
__device__ __forceinline__ unsigned pk4_fp8(float a, float b, float c, float d) { int w = 0; w = __builtin_amdgcn_cvt_pk_fp8_f32(a, b, w, false); w = __builtin_amdgcn_cvt_pk_fp8_f32(c, d, w, true); return (unsigned)w; }
constexpr float WSCALE8 = 32.0f, WSCALE8_INV = 1.0f / 32.0f;
#define LDS_WAIT() asm volatile("s_waitcnt lgkmcnt(0)" ::: "memory")
#define VM_WAIT() asm volatile("s_waitcnt vmcnt(0)" ::: "memory")
#define RLX_AGENT __ATOMIC_RELAXED, __HIP_MEMORY_SCOPE_AGENT

namespace pg8 {
constexpr int BM = 256, BK = 64, HALF = 128, HTB = HALF * BK * 2, STAGE_BYTES = 8 * HTB;
__device__ __forceinline__ void glds16s(const char* sbase, unsigned voff, unsigned lds_dst) { unsigned keep;
    asm volatile("s_mov_b32 %0, m0\n\ts_mov_b32 m0, %3\n\ts_nop 0\n\tglobal_load_lds_dwordx4 %1, %2\n\ts_mov_b32 m0, %0" : "=&s"(keep) : "v"(voff), "s"(sbase), "s"(lds_dst) : "memory"); }
__host__ __device__ __forceinline__ int lds_byte(int r, int c) { const int st = (r >> 4) * 2 + (c >> 5), rr = r & 15, cc = c & 31, ob = rr * 64 + cc * 2; return st * 1024 + (ob ^ (((ob >> 9) & 1) << 5)); }
__host__ __device__ __forceinline__ void stage_rc(int b, int& R, int& C) { const int st = b / 1024, sb = b % 1024, swz = sb ^ (((sb >> 9) & 1) << 5); R = (st >> 1) * 16 + swz / 64; C = (st & 1) * 32 + (swz % 64) / 2; }
__host__ __device__ __forceinline__ int perm32(int rho) { const int n = rho >> 4, i = rho & 15; return 8 * (i >> 2) + 4 * n + (i & 3); }

struct Unit { const char* A; const char* B; const int* rows; int pm, pn, aux, nrows; };

template <class Epi, class Sched, bool GATHER, bool ALIGN_EPI, bool FP8 = false>
__device__ __forceinline__ void gemm_phase(LAS unsigned char* lds, const int lda, const int ldb, const int nt_in, const Sched& S, const Epi& E) {
    int nt = nt_in; asm volatile("" : "+s"(nt));
    int tid_ = threadIdx.x; asm volatile("" : "+v"(tid_));
    const int tid = tid_, wid = __builtin_amdgcn_readfirstlane(tid >> 6), lane = tid & 63, wr = wid >> 2, wc = wid & 3, fr = lane & 15, fq = lane >> 4;
    unsigned offB0; { int R, C; stage_rc(tid * 16, R, C); const int Rb = Epi::PERM ? ((R & ~31) + perm32(R & 31)) : R; offB0 = (unsigned)(Rb * ldb + C) * 2u; }
    const size_t pstepB = (size_t)64 * ldb * 2;
    const size_t kstep = (size_t)(BK * 2);
    const size_t hstepB = (size_t)HALF * ldb * 2;
    const unsigned ldsb = (unsigned)__builtin_amdgcn_readfirstlane((int)((unsigned)(uintptr_t)(unsigned char*)lds + (unsigned)wid * 1024u));
    const int aoff = lds_byte(wr * 64 + fr, FP8 ? fq * 16 : fq * 8), boff = lds_byte(wc * 32 + fr, FP8 ? fq * 16 : fq * 8);
#define PG8_SA(b, h) (((b) * 2 + (h)) * HTB)
#define PG8_SB(b, h) ((4 + (b) * 2 + (h)) * HTB)
#define PG8_STGB(bufoff, gbase) do { glds16s((const char*)(gbase), offB0, ldsb + (unsigned)(bufoff)); glds16s((const char*)(gbase) + pstepB, offB0, ldsb + (unsigned)(bufoff) + 8192u); } while (0)
#define PG8_LD16(p_) (*(const LAS u32x4*)(p_))
#define PG8_CAT(x, y) __builtin_bit_cast(v8i32_t, __builtin_shufflevector(x, y, 0, 1, 2, 3, 4, 5, 6, 7))
    unsigned aA0 = (unsigned)(aoff + PG8_SA(0, 0)), aA1 = (unsigned)(aoff + PG8_SA(1, 0)), bB0 = (unsigned)(boff + PG8_SB(0, 0)), bB1 = (unsigned)(boff + PG8_SB(1, 0));
    asm volatile("" : "+v"(aA0), "+v"(aA1), "+v"(bB0), "+v"(bB1));
    int scl8 = 0x7f7f7f7f; asm volatile("" : "+v"(scl8));
#define PG8_LDA(dst, b, h) do { const LAS unsigned char* ap_ = lds + ((b) ? aA1 : aA0) + (h) * HTB; _Pragma("unroll") for (int m = 0; m < 4; ++m) { \
        if constexpr (FP8) { dst##8[m] = PG8_CAT(PG8_LD16(ap_ + m * 2048), PG8_LD16(ap_ + m * 2048 + 16)); } \
        else { _Pragma("unroll") for (int k = 0; k < 2; ++k) dst[m][k] = *(const LAS bf16x8*)(ap_ + m * 2048 + k * 1024); } } } while (0)
#define PG8_LDB(dst, b, h) do { const LAS unsigned char* bp_ = lds + ((b) ? bB1 : bB0) + (h) * HTB; _Pragma("unroll") for (int n = 0; n < 2; ++n) { \
        if constexpr (FP8) { dst##8[n] = PG8_CAT(PG8_LD16(bp_ + n * 2048), PG8_LD16(bp_ + n * 2048 + 16)); } \
        else { _Pragma("unroll") for (int k = 0; k < 2; ++k) dst[n][k] = *(const LAS bf16x8*)(bp_ + n * 2048 + k * 1024); } } } while (0)
#define PG8_MMA(ai, bj, At, Bt) do { __builtin_amdgcn_s_setprio(1); _Pragma("unroll") for (int m = 0; m < 4; ++m) _Pragma("unroll") for (int n = 0; n < 2; ++n) { \
        if constexpr (FP8) asm volatile("v_mfma_scale_f32_16x16x128_f8f6f4 %0, %1, %2, %0, %3, %3 op_sel_hi:[0,0,0]" : "+v"(acc[ai][bj][m][n]) : "v"(Bt##8[n]), "v"(At##8[m]), "v"(scl8));   \
        else { _Pragma("unroll") for (int k = 0; k < 2; ++k) acc[ai][bj][m][n] = __builtin_amdgcn_mfma_f32_16x16x32_bf16(Bt[n][k], At[m][k], acc[ai][bj][m][n], 0, 0, 0); } } \
        __builtin_amdgcn_s_setprio(0); } while (0)
#define PG8_WAIT_V(n) asm volatile("s_waitcnt vmcnt(" #n ")" ::: "memory")
#define PG8_WAIT_L(n) asm volatile("s_waitcnt lgkmcnt(" #n ")" ::: "memory")
#define PG8_BAR __builtin_amdgcn_s_barrier()
#define PG8_SCHED __builtin_amdgcn_sched_barrier(0)
    unsigned voffA0, c2, pkc[2], pkn[2];
    { int R, C; stage_rc(tid * 16, R, C); voffA0 = (unsigned)(R * lda + C) * 2u; c2 = (unsigned)C * 2u; }
    const size_t hstepA = (size_t)HALF * lda * 2, pstepA = (size_t)64 * lda * 2;
    const unsigned lda2 = (unsigned)lda * 2u;
#define PG8_PKROWS(dst, u) do { if (GATHER) { _Pragma("unroll") for (int i_ = 0; i_ < 2; ++i_) { int R_, C_; stage_rc(tid * 16 + i_ * 8192, R_, C_); \
        const int nr_ = (u).nrows - 1; const int r0_ = R_ < nr_ ? R_ : nr_, r1_ = (R_ + HALF) < nr_ ? (R_ + HALF) : nr_; \
        dst[i_] = (unsigned)(u).rows[r0_] | ((unsigned)(u).rows[r1_] << 16); } } } while (0)
#define PG8_STGA(bufoff, gbase, h, NX) do { \
        if (GATHER) { const unsigned p0_ = (NX) ? pkn[0] : pkc[0], p1_ = (NX) ? pkn[1] : pkc[1]; \
            const unsigned o0_ = ((h) ? (p0_ >> 16) : (p0_ & 0xffffu)) * lda2 + c2, o1_ = ((h) ? (p1_ >> 16) : (p1_ & 0xffffu)) * lda2 + c2; \
            glds16s((const char*)(gbase), o0_, ldsb + (unsigned)(bufoff)); glds16s((const char*)(gbase), o1_, ldsb + (unsigned)(bufoff) + 8192u); } \
        else { const char* gb_ = (const char*)(gbase) + ((h) ? hstepA : (size_t)0); glds16s(gb_, voffA0, ldsb + (unsigned)(bufoff)); glds16s(gb_ + pstepA, voffA0, ldsb + (unsigned)(bufoff) + 8192u); } } while (0)
    Unit cur, nxt; int ui = 0;
    if (!S.next(0, cur)) return;
    f32x4 acc[2][2][4][2];
#pragma unroll
    for (int a = 0; a < 2; ++a)
#pragma unroll
        for (int b = 0; b < 2; ++b)
#pragma unroll
            for (int m = 0; m < 4; ++m)
#pragma unroll
                for (int n = 0; n < 2; ++n) acc[a][b][m][n] = (f32x4){0.f, 0.f, 0.f, 0.f};
    bf16x8 At[4][2], B0[2][2], B1[2][2]; v8i32_t At8[4], B08[2], B18[2];
    pkc[0] = pkc[1] = pkn[0] = pkn[1] = 0u;
    PG8_PKROWS(pkc, cur);
    const char* cA = cur.A; const char* cB = cur.B;
    PG8_STGB(PG8_SB(0, 0), cB); PG8_STGB(PG8_SB(0, 1), cB + hstepB); PG8_STGA(PG8_SA(0, 0), cA, 0, false); PG8_STGA(PG8_SA(0, 1), cA, 1, false);
    if (wr == 1) PG8_BAR;
    PG8_WAIT_V(2); PG8_BAR;
    PG8_STGB(PG8_SB(1, 0), cB + kstep); PG8_STGA(PG8_SA(1, 0), cA + kstep, 0, false); PG8_STGB(PG8_SB(1, 1), cB + hstepB + kstep);
    PG8_WAIT_V(6); PG8_BAR;
    for (;;) {
        const bool has_next = S.next(ui + 1, nxt);
        if (GATHER) { if (has_next) { PG8_PKROWS(pkn, nxt); } else { pkn[0] = pkc[0]; pkn[1] = pkc[1]; } }
        const char* nA = has_next ? nxt.A : cA; const char* nB = has_next ? nxt.B : cB;
        typename Epi::Pre pre; { int t_p = threadIdx.x; asm volatile("" : "+v"(t_p)); E.prefetch(cur, wr, t_p & 15, pre); }
        for (int t = 0; t < nt; t += 2) {
            const bool last = (t == nt - 2);
            const char* a1 = cA + (size_t)(t + 1) * kstep;
            const char* a2 = last ? nA : cA + (size_t)(t + 2) * kstep; const char* b2 = last ? nB : cB + (size_t)(t + 2) * kstep;
            const char* a3 = a2 + kstep; const char* b3 = b2 + kstep;
            PG8_LDB(B0, 0, 0); PG8_LDB(B1, 0, 1); PG8_SCHED; PG8_LDA(At, 0, 0); PG8_STGA(PG8_SA(1, 1), a1, 1, false);
            PG8_WAIT_V(8); PG8_WAIT_L(0); PG8_BAR; PG8_MMA(0, 0, At, B0); PG8_MMA(0, 1, At, B1); PG8_BAR; PG8_SCHED;
            PG8_LDA(At, 0, 1); PG8_STGB(PG8_SB(0, 0), b2); PG8_STGB(PG8_SB(0, 1), b2 + hstepB); PG8_STGA(PG8_SA(0, 0), a2, 0, last);
            PG8_WAIT_V(8); PG8_WAIT_L(0); PG8_BAR; PG8_MMA(1, 0, At, B0); PG8_MMA(1, 1, At, B1); PG8_BAR; PG8_SCHED;
            PG8_LDB(B0, 1, 0); PG8_LDB(B1, 1, 1); PG8_SCHED; PG8_LDA(At, 1, 0); PG8_STGA(PG8_SA(0, 1), a2, 1, last);
            PG8_WAIT_V(8); PG8_WAIT_L(0); PG8_BAR; PG8_MMA(0, 0, At, B0); PG8_MMA(0, 1, At, B1); PG8_BAR; PG8_SCHED;
            PG8_LDA(At, 1, 1); PG8_STGB(PG8_SB(1, 0), b3); PG8_STGB(PG8_SB(1, 1), b3 + hstepB); PG8_STGA(PG8_SA(1, 0), a3, 0, last);
            PG8_WAIT_V(8); PG8_WAIT_L(0); PG8_BAR; PG8_MMA(1, 0, At, B0); PG8_MMA(1, 1, At, B1); PG8_BAR; PG8_SCHED;
        }
        if constexpr (ALIGN_EPI) { if (wr == 0) PG8_BAR; }
        if constexpr (FP8) asm volatile("s_nop 15\n\ts_nop 15" ::: "memory");
        if constexpr (!Epi::AFTER_DRAIN) { int t_e = threadIdx.x; asm volatile("" : "+v"(t_e)); const int fr_e = t_e & 15, fq_e = (t_e >> 4) & 3; E(acc, cur, wr, wc, fr_e, fq_e, pre); }
        if (!has_next) break;
#pragma unroll
        for (int a = 0; a < 2; ++a)
#pragma unroll
            for (int b = 0; b < 2; ++b)
#pragma unroll
                for (int m = 0; m < 4; ++m)
#pragma unroll
                    for (int n = 0; n < 2; ++n) acc[a][b][m][n] = (f32x4){0.f, 0.f, 0.f, 0.f};
        cur = nxt; cA = nA; cB = nB; ++ui;
        if (GATHER) { pkc[0] = pkn[0]; pkc[1] = pkn[1]; }
        if constexpr (ALIGN_EPI) { if (wr == 1) PG8_BAR; }
    }
    PG8_WAIT_V(0);
    if constexpr (!ALIGN_EPI) { if (wr == 0) PG8_BAR; }
    PG8_BAR;
    if constexpr (Epi::AFTER_DRAIN) { int t_e = threadIdx.x; asm volatile("" : "+v"(t_e)); const int fr_e = t_e & 15, fq_e = (t_e >> 4) & 3; E.fused(acc, cur, wr, wc, fr_e, fq_e, lds, wid, t_e & 63); }
#undef PG8_SA
#undef PG8_SB
#undef PG8_STGB
#undef PG8_LDA
#undef PG8_LDB
#undef PG8_MMA
#undef PG8_CAT
#undef PG8_LD16
#undef PG8_WAIT_V
#undef PG8_WAIT_L
#undef PG8_SCHED
#undef PG8_PKROWS
#undef PG8_STGA
}
}

namespace pg8 {
constexpr int NXCD = 8, WGM = 8;
__device__ __forceinline__ void tile_order(int L, int nM, int nN, int& pm, int& pn) {
    const int nwg = nM * nN; int wgid = L;
    { const int q = nwg / NXCD, r = nwg % NXCD, xcd = wgid % NXCD, off = wgid / NXCD; wgid = (xcd < r ? xcd * (q + 1) : r * (q + 1) + (xcd - r) * q) + off; }
    const int nig = WGM * nN, gid = wgid / nig, fm = gid * WGM, gsz = (nM - fm) < WGM ? (nM - fm) : WGM;
    pm = fm + ((wgid % nig) % gsz); pn = (wgid % nig) / gsz;
}
struct DenseOrder {
    const char* A; const char* B; int lda, ldb, nM, nN, G, c;
    __device__ __forceinline__ bool next(int i, Unit& u) const {
        const long L = (long)i * G + c; if (L >= (long)nM * nN) return false;
        int pm, pn; tile_order((int)L, nM, nN, pm, pn);
        u.pm = pm; u.pn = pn; u.aux = 0; u.rows = nullptr; u.nrows = 256;
        u.A = A + (size_t)pm * 256 * lda * 2; u.B = B + (size_t)pn * 256 * ldb * 2; return true;
    }
};
struct KvOrder {
    const char* MN; const char* W; int L0;
    __device__ __forceinline__ bool next(int i, Unit& u) const {
        const int L = L0; if (i > 0 || L >= 64) return false;
        u.rows = nullptr; u.nrows = 256; u.pm = L >> 3; const int ct = L & 7; u.aux = ct >> 2; u.pn = ct & 3;
        u.A = MN + (size_t)u.pm * 256 * D * 2; u.B = W + (size_t)ct * 256 * D * 2; return true;
    }
};
struct XmnOrder {
    const char* MK; const char* MV; const char* WQN; const char* WOT; int G, c;
    __device__ __forceinline__ bool next(int i, Unit& u) const {
        const int L = c + i * G; if (L >= 256) return false;
        u.rows = nullptr; u.nrows = 256;
        if (L < 128) { const int b = L >> 4, h = (L >> 2) & 3, kt = L & 3; u.aux = 0; u.pm = b * 4 + h; u.pn = kt;
            u.A = MK + ((size_t)(b * 256) * D + h * 256) * 2; u.B = WQN + ((size_t)(kt * 256) * D + h * 256) * 2; }
        else { const int l = L - 128, b = l >> 4, nt = (l >> 2) & 3, h = l & 3; u.aux = 1; u.pm = b * 4 + nt; u.pn = h;
            u.A = WOT + ((size_t)(nt * 256) * D + h * 256) * 2; u.B = MV + ((size_t)(b * 256) * D + h * 256) * 2; }
        return true;
    }
};
struct XbOrder {
    const char* A; const char* Bb; int G, c;
    __device__ __forceinline__ bool next(int i, Unit& u) const {
        const long L = (long)i * G + c; if (L >= 512) return false;
        int pm, pn; tile_order((int)L, T / 256, 4, pm, pn);
        u.pm = pm; u.pn = pn; u.aux = 0; u.rows = nullptr; u.nrows = 256;
        u.A = A + (size_t)pm * 256 * D * 2; u.B = Bb + (size_t)(pm >> 4) * D * D * 2 + (size_t)pn * 256 * D * 2; return true;
    }
};
struct MoeOrder {
    const char* A; const char* W; const int* list; const LAS int* cnt; const LAS unsigned char* te; const LAS int* ts;
    int ntiles, nN, G, c; size_t wstride; int gather; size_t atile, btile;
    __device__ __forceinline__ bool next(int i, Unit& u) const {
        const long L = (long)i * G + c; if (L >= (long)ntiles * nN) return false;
        int pm, pn; tile_order((int)L, ntiles, nN, pm, pn);
        const int e = __builtin_amdgcn_readfirstlane((int)te[pm]);
        const int lt = pm - __builtin_amdgcn_readfirstlane(ts[e]);
        const int n = __builtin_amdgcn_readfirstlane(cnt[e]) - lt * 256;
        u.pm = pm; u.pn = pn; u.aux = e; u.nrows = n < 256 ? n : 256;
        u.rows = list + (size_t)e * T + lt * 256;
        u.A = gather ? A : A + (size_t)pm * atile;
        u.B = W + (size_t)e * wstride + (size_t)pn * btile; return true;
    }
};

struct EpiProj {
    static constexpr bool PERM = true, AFTER_DRAIN = false; struct Pre {}; __device__ __forceinline__ void prefetch(const Unit&, int, int, Pre&) const {}
    bf16_t* O; float* kbar;
    __device__ __forceinline__ void operator()(const f32x4 (&acc)[2][2][4][2], const Unit& u, int wr, int wc, int fr, int fq, const Pre&) const {
        const int pn = u.pn, sec = pn >> 1, b = u.pm >> 4, t0 = (u.pm & 15) * 256 + wr * 64 + fr;
        const int mode = (pn < 2) ? 1 : ((pn == 6 || pn == 7 || pn >= 12) ? 2 : 0);
        bf16_t* sb = O + (size_t)sec * SEC_ELEMS;
#pragma unroll
        for (int bj = 0; bj < 2; ++bj) {
            const int c = bj * HALF + wc * 32 + 8 * fq, head = (pn & 1) * 4 + (c >> 6), d0 = c & 63;
            bf16_t* hb = sb + (size_t)(b * 8 + head) * (SEQ * 64);
#pragma unroll
            for (int ai = 0; ai < 2; ++ai)
#pragma unroll
                for (int m = 0; m < 4; ++m) { const int t = t0 + ai * HALF + m * 16;
                    f32x4 v0 = acc[ai][bj][m][0], v1 = acc[ai][bj][m][1];
                    if (mode == 1) { v0 = v0 * C2Q; v1 = v1 * C2Q; }
                    else if (mode == 2) {
#pragma unroll
                        for (int e = 0; e < 4; ++e) { v0[e] = silu_f(v0[e]); v1[e] = silu_f(v1[e]); } }
                    u32x4 w; w.x = cvtpk(v0[0], v0[1]); w.y = cvtpk(v0[2], v0[3]); w.z = cvtpk(v1[0], v1[1]); w.w = cvtpk(v1[2], v1[3]);
                    size_t off;
                    if (sec == 1) off = (size_t)(t >> 6) * 4096 + (d0 >> 3) * 512 + (t & 63) * 8;
                    else if (sec == 2) off = (size_t)(t >> 6) * 4096 + (d0 >> 5) * 2048 + (t & 63) * 32 + (d0 & 31);
                    else off = (size_t)t * 64 + d0;
                    *(u32x4*)(hb + off) = w; } }
        if (pn == 2 || pn == 3) {
#pragma unroll
            for (int bj = 0; bj < 2; ++bj)
#pragma unroll
                for (int n = 0; n < 2; ++n)
#pragma unroll
                    for (int e = 0; e < 4; ++e) { float s = 0.f;
#pragma unroll
                        for (int ai = 0; ai < 2; ++ai)
#pragma unroll
                            for (int m = 0; m < 4; ++m) s += acc[ai][bj][m][n][e];
                        s += __shfl_xor(s, 1); s += __shfl_xor(s, 2); s += __shfl_xor(s, 4); s += __shfl_xor(s, 8);
                        if (fr == 0) { const int c = bj * HALF + wc * 32 + 8 * fq + 4 * n + e, head = (pn - 2) * 4 + (c >> 6), d = c & 63;
                            atomicAdd(kbar + ((size_t)u.pm * 8 + head) * 64 + d, s); } }
        }
    }
};
struct EpiBf16 {
    static constexpr bool PERM = true, AFTER_DRAIN = false; struct Pre {}; __device__ __forceinline__ void prefetch(const Unit&, int, int, Pre&) const {}
    bf16_t* O0; int ldc0; bf16_t* O1; int ldc1;
    __device__ __forceinline__ void operator()(const f32x4 (&acc)[2][2][4][2], const Unit& u, int wr, int wc, int fr, int fq, const Pre&) const {
        bf16_t* O = u.aux ? O1 : O0; const int ldc = u.aux ? ldc1 : ldc0;
        const int row0 = u.pm * BM + wr * 64 + fr, col0 = u.pn * BM + wc * 32 + 8 * fq;
#pragma unroll
        for (int ai = 0; ai < 2; ++ai)
#pragma unroll
            for (int m = 0; m < 4; ++m) { bf16_t* rowp = O + (size_t)(row0 + ai * HALF + m * 16) * ldc + col0;
#pragma unroll
                for (int bj = 0; bj < 2; ++bj) { const f32x4 v0 = acc[ai][bj][m][0], v1 = acc[ai][bj][m][1];
                    u32x4 w; w.x = cvtpk(v0[0], v0[1]); w.y = cvtpk(v0[2], v0[3]); w.z = cvtpk(v1[0], v1[1]); w.w = cvtpk(v1[2], v1[3]);
                    *(u32x4*)(rowp + bj * HALF) = w; } }
    }
};
template <bool BASE_F32, bool WRITE_F32, bool OUT_FP8 = false> struct EpiRes {
    static constexpr bool PERM = true, AFTER_DRAIN = false; struct Pre {}; __device__ __forceinline__ void prefetch(const Unit&, int, int, Pre&) const {}
    const void* base; bf16_t* Ob; float* Of; float* ss;
    __device__ __forceinline__ void operator()(const f32x4 (&acc)[2][2][4][2], const Unit& u, int wr, int wc, int fr, int fq, const Pre&) const {
        const int row0 = u.pm * BM + wr * 64 + fr, col0 = u.pn * BM + wc * 32 + 8 * fq;
#pragma unroll
        for (int ai = 0; ai < 2; ++ai)
#pragma unroll
            for (int m = 0; m < 4; ++m) { const int row = row0 + ai * HALF + m * 16; const size_t off = (size_t)row * D + col0; float sq = 0.f;
#pragma unroll
                for (int bj = 0; bj < 2; ++bj) { f32x4 b0, b1;
                    if (BASE_F32) { b0 = *(const f32x4*)((const float*)base + off + bj * HALF); b1 = *(const f32x4*)((const float*)base + off + bj * HALF + 4); }
                    else { const u32x4 w = *(const u32x4*)((const bf16_t*)base + off + bj * HALF);
                        b0 = (f32x4){bflo(w.x), bfhi(w.x), bflo(w.y), bfhi(w.y)}; b1 = (f32x4){bflo(w.z), bfhi(w.z), bflo(w.w), bfhi(w.w)}; }
                    const f32x4 v0 = acc[ai][bj][m][0] + b0, v1 = acc[ai][bj][m][1] + b1;
                    sq += (v0[0] * v0[0] + v0[1] * v0[1]) + (v0[2] * v0[2] + v0[3] * v0[3]) + (v1[0] * v1[0] + v1[1] * v1[1]) + (v1[2] * v1[2] + v1[3] * v1[3]);
                    if (OUT_FP8) { *(u32x2*)((unsigned char*)Ob + off + bj * HALF) = (u32x2){pk4_fp8(v0[0], v0[1], v0[2], v0[3]), pk4_fp8(v1[0], v1[1], v1[2], v1[3])}; }
                    else { u32x4 w; w.x = cvtpk(v0[0], v0[1]); w.y = cvtpk(v0[2], v0[3]); w.z = cvtpk(v1[0], v1[1]); w.w = cvtpk(v1[2], v1[3]);
                    *(u32x4*)(Ob + off + bj * HALF) = w; }
                    if (WRITE_F32) { *(f32x4*)(Of + off + bj * HALF) = v0; *(f32x4*)(Of + off + bj * HALF + 4) = v1; } }
                sq += __shfl_xor(sq, 16); sq += __shfl_xor(sq, 32);
                if (fq == 0) atomicAdd(ss + row, sq); }
    }
};
struct EpiQ {
    static constexpr bool PERM = true, AFTER_DRAIN = false; struct Pre {}; __device__ __forceinline__ void prefetch(const Unit&, int, int, Pre&) const {}
    bf16_t* O; const float* ss;
    __device__ __forceinline__ void operator()(const f32x4 (&acc)[2][2][4][2], const Unit& u, int wr, int wc, int fr, int fq, const Pre&) const {
        const int row0 = u.pm * BM + wr * 64 + fr, col0 = u.pn * BM + wc * 32 + 8 * fq;
#pragma unroll
        for (int ai = 0; ai < 2; ++ai)
#pragma unroll
            for (int m = 0; m < 4; ++m) { const int row = row0 + ai * HALF + m * 16; const float sc = C2X * __builtin_amdgcn_rsqf(ss[row] * (1.0f / D) + EPS);
                bf16_t* rowp = O + (size_t)row * D + col0;
#pragma unroll
                for (int bj = 0; bj < 2; ++bj) { const f32x4 v0 = acc[ai][bj][m][0] * sc, v1 = acc[ai][bj][m][1] * sc;
                    u32x4 w; w.x = cvtpk(v0[0], v0[1]); w.y = cvtpk(v0[2], v0[3]); w.z = cvtpk(v1[0], v1[1]); w.w = cvtpk(v1[2], v1[3]);
                    *(u32x4*)(rowp + bj * HALF) = w; } }
    }
};
struct EpiSoftmaxS {
    static constexpr bool PERM = true, AFTER_DRAIN = false; struct Pre {}; __device__ __forceinline__ void prefetch(const Unit&, int, int, Pre&) const {}
    bf16_t* P; const float* ss; LAS unsigned char* tb;
    __device__ __forceinline__ void operator()(f32x4 (&acc)[2][2][4][2], const Unit& u, int wr, int wc, int fr, int fq, const Pre&) const {
        LAS float* MX = (LAS float*)tb;
        LAS float* SM = (LAS float*)(tb + 4096);
#pragma unroll
        for (int ai = 0; ai < 2; ++ai)
#pragma unroll
            for (int m = 0; m < 4; ++m) { const int r = ai * HALF + wr * 64 + m * 16 + fr; const float sc = C2X * __builtin_amdgcn_rsqf(ss[u.pm * BM + r] * (1.0f / D) + EPS); float mx = -3.0e38f;
#pragma unroll
                for (int bj = 0; bj < 2; ++bj)
#pragma unroll
                    for (int n = 0; n < 2; ++n) { f32x4 x = acc[ai][bj][m][n] * sc; acc[ai][bj][m][n] = x; mx = fmaxf(mx, fmaxf(fmaxf(x[0], x[1]), fmaxf(x[2], x[3]))); }
                mx = fmaxf(mx, __shfl_xor(mx, 16)); mx = fmaxf(mx, __shfl_xor(mx, 32));
                if (fq == 0) MX[r * 4 + wc] = mx; }
        LDS_WAIT(); __builtin_amdgcn_s_barrier(); asm volatile("" ::: "memory");
#pragma unroll
        for (int ai = 0; ai < 2; ++ai)
#pragma unroll
            for (int m = 0; m < 4; ++m) { const int r = ai * HALF + wr * 64 + m * 16 + fr; const f32x4 q = *(const LAS f32x4*)(MX + r * 4);
                const float mx = fmaxf(fmaxf(q[0], q[1]), fmaxf(q[2], q[3])); float sm = 0.f;
#pragma unroll
                for (int bj = 0; bj < 2; ++bj)
#pragma unroll
                    for (int n = 0; n < 2; ++n) { f32x4 x = acc[ai][bj][m][n];
#pragma unroll
                        for (int e = 0; e < 4; ++e) { x[e] = fast_exp2(x[e] - mx); sm += x[e]; }
                        acc[ai][bj][m][n] = x; }
                sm += __shfl_xor(sm, 16); sm += __shfl_xor(sm, 32);
                if (fq == 0) SM[r * 4 + wc] = sm; }
        LDS_WAIT(); __builtin_amdgcn_s_barrier(); asm volatile("" ::: "memory");
        const int col0 = u.pn * BM + wc * 32 + 8 * fq;
#pragma unroll
        for (int ai = 0; ai < 2; ++ai)
#pragma unroll
            for (int m = 0; m < 4; ++m) { const int r = ai * HALF + wr * 64 + m * 16 + fr; const f32x4 q = *(const LAS f32x4*)(SM + r * 4);
                const float inv = fast_rcp((q[0] + q[1]) + (q[2] + q[3]));
#pragma unroll
                for (int bj = 0; bj < 2; ++bj) { const f32x4 v0 = acc[ai][bj][m][0] * inv, v1 = acc[ai][bj][m][1] * inv;
                    u32x4 w; w.x = cvtpk(v0[0], v0[1]); w.y = cvtpk(v0[2], v0[3]); w.z = cvtpk(v1[0], v1[1]); w.w = cvtpk(v1[2], v1[3]);
                    *(u32x4*)(P + ((size_t)u.pm * BM + r) * D + bj * HALF + col0) = w; } }
        LDS_WAIT(); __builtin_amdgcn_s_barrier(); asm volatile("" ::: "memory");
    }
};
struct EpiW1 {
    static constexpr bool PERM = true, AFTER_DRAIN = false;
    struct Pre { float sc[8]; };
    bf16_t* O; const float* ss; const float* b1;
    __device__ __forceinline__ void prefetch(const Unit& u, int wr, int fr, Pre& p) const {
#pragma unroll
        for (int ai = 0; ai < 2; ++ai)
#pragma unroll
            for (int m = 0; m < 4; ++m) { const int r = ai * HALF + wr * 64 + m * 16 + fr; const int rr = r < u.nrows ? r : u.nrows - 1; p.sc[ai * 4 + m] = ss[u.rows[rr]]; }
    }
    __device__ __forceinline__ void operator()(const f32x4 (&acc)[2][2][4][2], const Unit& u, int wr, int wc, int fr, int fq, const Pre& pre) const {
        const int c0 = wc * 32 + 8 * fq;
        const float* bp = b1 + (size_t)u.aux * 2048 + 2 * (u.pn * 128 + c0);
        const f32x4 bq0 = *(const f32x4*)(bp), bq1 = *(const f32x4*)(bp + 4), bq2 = *(const f32x4*)(bp + 8), bq3 = *(const f32x4*)(bp + 12);
        const float bg[8] = {bq0[0], bq0[2], bq1[0], bq1[2], bq2[0], bq2[2], bq3[0], bq3[2]};
        const float bl[8] = {bq0[1], bq0[3], bq1[1], bq1[3], bq2[1], bq2[3], bq3[1], bq3[3]};
#pragma unroll
        for (int ai = 0; ai < 2; ++ai)
#pragma unroll
            for (int m = 0; m < 4; ++m) { const int r = ai * HALF + wr * 64 + m * 16 + fr;
                const float sc = WSCALE8_INV * __builtin_amdgcn_rsqf(pre.sc[ai * 4 + m] * (1.0f / D) + EPS); float a[8];
#pragma unroll
                for (int j = 0; j < 8; ++j) { const float g = acc[ai][0][m][j >> 2][j & 3] * sc + bg[j], l = acc[ai][1][m][j >> 2][j & 3] * sc + bl[j];
                    const float glu = fminf(g, 7.0f), lin = fminf(fmaxf(l, -7.0f), 7.0f);
                    a[j] = glu * fast_rcp(1.0f + fast_exp2(-1.702f * LOG2E * glu)) * (lin + 1.0f); }
                *(u32x2*)((unsigned char*)O + ((size_t)u.pm * BM + r) * D + u.pn * 128 + c0) = (u32x2){pk4_fp8(a[0], a[1], a[2], a[3]), pk4_fp8(a[4], a[5], a[6], a[7])}; }
    }
};
constexpr float YSCALE = 16.0f, YSCALE_INV = 1.0f / 16.0f;
struct EpiW2 {
    static constexpr bool PERM = true, AFTER_DRAIN = false;
    struct Pre { float g[8]; };
    unsigned char* O; const float* b2; const int* list0; const float* gl0;
    __device__ __forceinline__ void prefetch(const Unit& u, int wr, int fr, Pre& p) const {
        const float* gp = gl0 + (u.rows - list0);
#pragma unroll
        for (int ai = 0; ai < 2; ++ai)
#pragma unroll
            for (int m = 0; m < 4; ++m) { const int r = ai * HALF + wr * 64 + m * 16 + fr; p.g[ai * 4 + m] = r < u.nrows ? gp[r] : 0.f; }
    }
    __device__ __forceinline__ void operator()(const f32x4 (&acc)[2][2][4][2], const Unit& u, int wr, int wc, int fr, int fq, const Pre& pre) const {
        const int row0 = u.pm * BM + wr * 64 + fr, col0 = u.pn * BM + wc * 32 + 8 * fq;
        f32x4 bv[2][2];
#pragma unroll
        for (int bj = 0; bj < 2; ++bj)
#pragma unroll
            for (int n = 0; n < 2; ++n) bv[bj][n] = *(const f32x4*)(b2 + (size_t)u.aux * D + col0 + bj * HALF + 4 * n);
#pragma unroll
        for (int ai = 0; ai < 2; ++ai)
#pragma unroll
            for (int m = 0; m < 4; ++m) { unsigned char* rowp = O + (size_t)(row0 + ai * HALF + m * 16) * D + col0; const float g = YSCALE * pre.g[ai * 4 + m];
#pragma unroll
                for (int bj = 0; bj < 2; ++bj) { const f32x4 v0 = (acc[ai][bj][m][0] * WSCALE8_INV + bv[bj][0]) * g, v1 = (acc[ai][bj][m][1] * WSCALE8_INV + bv[bj][1]) * g;
                    *(u32x2*)(rowp + bj * HALF) = (u32x2){pk4_fp8(v0[0], v0[1], v0[2], v0[3]), pk4_fp8(v1[0], v1[1], v1[2], v1[3])}; } }
    }
};
}

namespace moba {
using bf16x8 = ::bf16x8; using s16x4 = ::s16x4; using f32x16 = ::f32x16; using u32x4 = ::u32x4;
constexpr int DMQ = INC, DMO = D, HD = 64;
constexpr int NW = 8, QBLK = 32, QB = 256, KVBLK = 64;
__device__ __forceinline__ int crow(int r, int hi) { return (r & 3) + 8 * (r >> 2) + 4 * hi; }
#define SBAR() __builtin_amdgcn_sched_barrier(0)
__device__ __forceinline__ void cmask(f32x16& p0, f32x16& p1, int jb, int qrel, int hi) {
    const float NEG = -INFINITY; int kb = 64 * jb + 4 * hi;
#pragma unroll
    for (int r = 0; r < 16; ++r) { int kv = kb + (r & 3) + 8 * (r >> 2); if (kv > qrel) p0[r] = NEG; if (kv + 32 > qrel) p1[r] = NEG; }
}
constexpr int NSLOT = 3, SLOTB = 8192;
constexpr int LDS_K = 0, LDS_V = NSLOT * SLOTB, LDS_WS = 2 * NSLOT * SLOTB, LDS_OST = LDS_WS + NW * 64 * 4, LDS_KB = LDS_OST + NW * 4096, LDS_BYTES = LDS_KB + 16 * 64 * 4;
__device__ __forceinline__ void glds16(const void* gsrc, unsigned lds_dst) { unsigned keep;
    asm volatile("s_mov_b32 %0, m0\n\ts_mov_b32 m0, %2\n\ts_nop 0\n\tglobal_load_lds_dwordx4 %1, off\n\ts_mov_b32 m0, %0" : "=&s"(keep) : "v"(gsrc), "s"(lds_dst) : "memory"); }
__device__ __forceinline__ float max3f(float a, float b, float c) { float r; asm("v_max3_f32 %0, %1, %2, %3" : "=v"(r) : "v"(a), "v"(b), "v"(c)); return r; }
__device__ __forceinline__ float max2f(float a, float b) { float r; asm("v_max_f32_e32 %0, %1, %2" : "=v"(r) : "v"(a), "v"(b)); return r; }
__device__ __forceinline__ float fadd_s(float a, float b) { float r; asm("v_add_f32_e32 %0, %1, %2" : "=v"(r) : "v"(a), "v"(b)); return r; }
__device__ __forceinline__ float fsub_s(float a, float b) { float r; asm("v_sub_f32_e32 %0, %1, %2" : "=v"(r) : "v"(a), "v"(b)); return r; }
__device__ __forceinline__ unsigned cvtpk_s(float lo, float hi) { return ::cvtpk(lo, hi); }
#define WAIT_BAR(N) asm volatile("s_waitcnt vmcnt(" #N ") lgkmcnt(0)\n\ts_barrier" ::: "memory")
__device__ __forceinline__ void qkt(f32x16& p0, f32x16& p1, const char* Kslot, const bf16x8* qr, const f32x16& negm, int r32, int hi) {
    const char* kb = Kslot + hi * 1024 + r32 * 16;
#pragma unroll
    for (int d0 = 0; d0 < 4; ++d0) {
        const bf16x8 b0 = *reinterpret_cast<const bf16x8*>(kb + d0 * 2048);
        const bf16x8 b1 = *reinterpret_cast<const bf16x8*>(kb + d0 * 2048 + 512);
        if (d0 == 0) { p0 = __builtin_amdgcn_mfma_f32_32x32x16_bf16(b0, qr[0], negm, 0, 0, 0); p1 = __builtin_amdgcn_mfma_f32_32x32x16_bf16(b1, qr[0], negm, 0, 0, 0); }
        else { p0 = __builtin_amdgcn_mfma_f32_32x32x16_bf16(b0, qr[d0], p0, 0, 0, 0); p1 = __builtin_amdgcn_mfma_f32_32x32x16_bf16(b1, qr[d0], p1, 0, 0, 0); } }
}
typedef __attribute__((address_space(3))) const char* lds_cptr;
typedef short v4i16_t __attribute__((ext_vector_type(4)));
__device__ __forceinline__ void kload8(bf16x8* kf, lds_cptr kp) {
    kf[0] = *(const __attribute__((address_space(3))) bf16x8*)(kp);        kf[1] = *(const __attribute__((address_space(3))) bf16x8*)(kp + 512);
    kf[2] = *(const __attribute__((address_space(3))) bf16x8*)(kp + 2048); kf[3] = *(const __attribute__((address_space(3))) bf16x8*)(kp + 2560);
    kf[4] = *(const __attribute__((address_space(3))) bf16x8*)(kp + 4096); kf[5] = *(const __attribute__((address_space(3))) bf16x8*)(kp + 4608);
    kf[6] = *(const __attribute__((address_space(3))) bf16x8*)(kp + 6144); kf[7] = *(const __attribute__((address_space(3))) bf16x8*)(kp + 6656);
}
__device__ __forceinline__ void kload2(bf16x8* kf, lds_cptr kp, int j) { kf[2 * j] = *(const __attribute__((address_space(3))) bf16x8*)(kp + j * 2048); kf[2 * j + 1] = *(const __attribute__((address_space(3))) bf16x8*)(kp + j * 2048 + 512); }
__device__ __forceinline__ s16x4 vtr(lds_cptr p) { return __builtin_bit_cast(s16x4, __builtin_amdgcn_ds_read_tr16_b64_v4i16((__attribute__((address_space(3))) v4i16_t*)p)); }
__device__ __forceinline__ float rowmax(const f32x16& p0, const f32x16& p1) {
    float a = max3f(p0[0], p0[1], p1[0]), b = max3f(p0[2], p0[3], p1[1]); a = max3f(a, p1[2], p1[3]);
#pragma unroll
    for (int r = 4; r < 16; r += 4) { a = max3f(a, p0[r], p0[r + 1]); b = max3f(b, p0[r + 2], p0[r + 3]); a = max3f(a, p1[r], p1[r + 1]); b = max3f(b, p1[r + 2], p1[r + 3]); }
    const float m = max2f(a, b);
    auto rr = __builtin_amdgcn_permlane32_swap(__float_as_uint(m), __float_as_uint(m), false, false);
    return max2f(__uint_as_float(rr[0]), __uint_as_float(rr[1]));
}
__device__ __forceinline__ void pv(f32x16* o, int vb, bf16x8 pa0, bf16x8 pa1, bf16x8 pa2, bf16x8 pa3) {
#pragma unroll
    for (int d0 = 0; d0 < 2; ++d0) { s16x4 lo[4], hi[4];
#pragma unroll
        for (int ks = 0; ks < 4; ++ks) {
            asm volatile("ds_read_b64_tr_b16 %0,%1 offset:%c2" : "=&v"(lo[ks]) : "v"(vb), "i"(d0 * 4096 + ks * 1024) : "memory");
            asm volatile("ds_read_b64_tr_b16 %0,%1 offset:%c2" : "=&v"(hi[ks]) : "v"(vb), "i"(d0 * 4096 + ks * 1024 + 512) : "memory"); }
        asm volatile("s_waitcnt lgkmcnt(0)" ::: "memory"); SBAR();
#define PK(k) (bf16x8){lo[k][0], lo[k][1], lo[k][2], lo[k][3], hi[k][0], hi[k][1], hi[k][2], hi[k][3]}
        o[d0] = __builtin_amdgcn_mfma_f32_32x32x16_bf16(pa0, PK(0), o[d0], 0, 0, 0);
        o[d0] = __builtin_amdgcn_mfma_f32_32x32x16_bf16(pa1, PK(1), o[d0], 0, 0, 0);
        o[d0] = __builtin_amdgcn_mfma_f32_32x32x16_bf16(pa2, PK(2), o[d0], 0, 0, 0);
        o[d0] = __builtin_amdgcn_mfma_f32_32x32x16_bf16(pa3, PK(3), o[d0], 0, 0, 0);
#undef PK
    }
}
constexpr float NEGBIG = -1.0e30f;

template <int THRL> __device__ __forceinline__ void attn_unit(int b, int h, int qb, const bf16_t* Qg, const bf16_t* __restrict__ Kg, const bf16_t* __restrict__ Vg, bf16_t* Og, const float* __restrict__ kbar, char* shm) {
    int tid_ = threadIdx.x; asm volatile("" : "+v"(tid_));
    const int tid = tid_, lane = tid & 63, r32 = lane & 31, hi = lane >> 5; const int wid = __builtin_amdgcn_readfirstlane(tid >> 6);
    const long rowbase = (long)b * SEQ; const int q0 = qb * QB;
    const size_t hoff = (size_t)(b * 8 + h) * (SEQ * 64);
    const bf16_t* Qw = Qg + hoff + (size_t)(q0 + wid * QBLK) * 64;
    const bf16_t* Kh = Kg + hoff, *Vh = Vg + hoff;
    const unsigned lds0 = (unsigned)(uintptr_t)shm;
    float* wsf = (float*)(shm + LDS_WS) + wid * 64;
    const bf16_t* ksrc = Kh + wid * 512 + lane * 8;
    const bf16_t* vsrc = Vh + wid * 512 + lane * 8;
    const unsigned kdst = lds0 + LDS_K + wid * 1024, vdst = lds0 + LDS_V + wid * 1024;
    const int NT = 4 * qb + 4, NPAST = 4 * qb;
#define TMAP(t) (((t) < 4) ? (NPAST + (t)) : ((t) - 4))
#define DMA_K(t, slot) glds16(ksrc + (long)TMAP(t) * 4096, (unsigned)__builtin_amdgcn_readfirstlane(kdst + (slot)))
#define DMA_V(t, slot) glds16(vsrc + (long)TMAP(t) * 4096, (unsigned)__builtin_amdgcn_readfirstlane(vdst + (slot)))
    const char* Kbase = shm + LDS_K; bf16x8 kf[8];
    const lds_cptr shm3 = (lds_cptr)shm; const lds_cptr kp0 = shm3 + LDS_K + hi * 1024 + r32 * 16; const lds_cptr vp0 = shm3 + LDS_V + ((lane >> 4) & 1) * 32 + (lane & 3) * 8 + (4 * hi + ((lane & 15) >> 2)) * 64;
    DMA_K(0, 0); DMA_V(0, 0); DMA_K(1, SLOTB);
    bf16x8 qr[4];
#pragma unroll
    for (int d0 = 0; d0 < 4; ++d0) qr[d0] = *reinterpret_cast<const bf16x8*>(&Qw[(long)r32 * 64 + d0 * 16 + hi * 8]);
    unsigned selm = 0u;
    if (qb > 0) {
        float* kbl = (float*)(shm + LDS_KB);
        for (int i = tid; i < qb * 64; i += NW * 64) kbl[i] = kbar[((size_t)(b * 16 + (i >> 6)) * 8 + h) * 64 + (i & 63)];
        asm volatile("s_waitcnt vmcnt(0) lgkmcnt(0)\n\ts_barrier" ::: "memory");
        if (qb <= 3) selm = (1u << qb) - 1u;
        else {
            float qf[32];
#pragma unroll
            for (int d0 = 0; d0 < 4; ++d0)
#pragma unroll
                for (int j = 0; j < 8; ++j) qf[d0 * 8 + j] = bf2f((unsigned short)qr[d0][j]);
            float g[15];
#pragma unroll
            for (int n = 0; n < 15; ++n) { float s = 0.f;
                if (n < qb) {
#pragma unroll
                    for (int d0 = 0; d0 < 4; ++d0) { const f32x4 k0 = *(const f32x4*)(kbl + n * 64 + d0 * 16 + hi * 8), k1 = *(const f32x4*)(kbl + n * 64 + d0 * 16 + hi * 8 + 4);
                        s += qf[d0 * 8 + 0] * k0[0] + qf[d0 * 8 + 1] * k0[1] + qf[d0 * 8 + 2] * k0[2] + qf[d0 * 8 + 3] * k0[3] + qf[d0 * 8 + 4] * k1[0] + qf[d0 * 8 + 5] * k1[1] + qf[d0 * 8 + 6] * k1[2] + qf[d0 * 8 + 7] * k1[3]; }
                    s += __shfl_xor(s, 32);
                } else s = -INFINITY;
                g[n] = s; }
#pragma unroll
            for (int pass = 0; pass < 3; ++pass) { float best = -INFINITY; int bi = 0;
#pragma unroll
                for (int n = 0; n < 15; ++n) if (g[n] > best) { best = g[n]; bi = n; }
                selm |= 1u << bi;
#pragma unroll
                for (int n = 0; n < 15; ++n) if (n == bi) g[n] = -INFINITY; }
        }
    }
    float mhat = 0.f, l_reg = 0.f; f32x16 o[2]; o[0] = f32x16{}; o[1] = f32x16{}; f32x16 cini = f32x16{}; asm volatile("" : "+v"(cini));
    const int qrel = wid * QBLK + r32;
#define SETC(t, JB) do { const float cm_ = ((JB >= 0) || ((selm >> (((t) - 4) >> 2)) & 1u)) ? -mhat : NEGBIG; \
      _Pragma("unroll") for (int r = 0; r < 16; ++r) cini[r] = cm_; asm volatile("" : "+v"(cini)); } while (0)
    bool resc = false;
#define START(P0, P1) do { const float rm = rowmax(P0, P1); resc = false; \
    { const float dl = rm; mhat = fadd_s(mhat, dl); \
      _Pragma("unroll") for (int r = 0; r < 16; ++r) { P0[r] = fsub_s(P0[r], dl); P1[r] = fsub_s(P1[r], dl); } } \
    _Pragma("unroll") for (int r = 0; r < 16; ++r) P0[r] = __builtin_amdgcn_exp2f(P0[r]); } while (0)
#define RESC() do { if (resc) { asm volatile("s_waitcnt lgkmcnt(0)" ::: "memory"); \
      _Pragma("unroll") for (int d_ = 0; d_ < 2; ++d_) _Pragma("unroll") for (int r = 0; r < 16; ++r) o[d_][r] *= wsf[crow(r, hi)]; } } while (0)
    f32x16 pA0, pA1, pB0, pB1;
    int sl_prev = 0, sl_cur = 0, sl_next = SLOTB;
#define ROT() do { sl_prev = sl_cur; sl_cur = sl_next; sl_next = (sl_next == (NSLOT - 1) * SLOTB) ? 0 : sl_next + SLOTB; } while (0)
    DMA_K(2, 2 * SLOTB);
    if (qb > 0) { WAIT_BAR(0); } else { WAIT_BAR(3); }
    qkt(pA0, pA1, Kbase, qr, cini, r32, hi); asm volatile("s_nop 15\n\ts_nop 7" : "+v"(pA0), "+v"(pA1)); cmask(pA0, pA1, 0, qrel, hi);
    START(pA0, pA1);
    _Pragma("unroll") for (int r = 0; r < 16; ++r) pA1[r] = __builtin_amdgcn_exp2f(pA1[r]);
    WAIT_BAR(0);
    DMA_K(3, 0); DMA_V(1, SLOTB);
    ROT();
    kload8(kf, kp0 + sl_cur);
    WAIT_BAR(2);
    s16x4 vlo[8], vhi[8]; u32x4 pw0, pw1, pw2, pw3;
#define PKW(P, B) cvtpk_s(P[B], P[B + 1])
#define PAF(k) __builtin_bit_cast(bf16x8, pw##k)
#define VFR(i) (bf16x8){vlo[i][0], vlo[i][1], vlo[i][2], vlo[i][3], vhi[i][0], vhi[i][1], vhi[i][2], vhi[i][3]}
#define PIN(x) asm volatile("" : "+v"(x))
#define MX3(a, b, c) __builtin_fmaxf(__builtin_fmaxf((a), (b)), (c))
#define GAPA(MF, A0, A1, A2, A3, W0, W1, PW) do { MF; sacc += A0; sacc += A1; sacc += A2; sacc += A3; PIN(sacc); W0; W1; PIN(PW); SBAR(); } while (0)
#define EX(v) __builtin_amdgcn_exp2f(v)
#define GAPB(MF, X, B) do { MF; X[B] = EX(X[B]); X[B + 1] = EX(X[B + 1]); X[B + 2] = EX(X[B + 2]); X[B + 3] = EX(X[B + 3]); PIN(X); SBAR(); } while (0)
#define VRD(i) do { vlo[i] = vtr(vp_ + (((i) >> 2) * 4096 + ((i) & 3) * 1024)); vhi[i] = vtr(vp_ + (((i) >> 2) * 4096 + ((i) & 3) * 1024 + 512)); } while (0)
#define KRD(G, j) do { if (G) { kload2(kf, kp0 + sl_next, j); SBAR(); } } while (0)
#define STEP(C0, C1, P0, P1, t, GK, GV, GL, JB) do { SETC(t, JB); SBAR(); \
    const lds_cptr vp_ = vp0 + sl_prev; \
    VRD(0); SBAR(); float sacc = (P0[0] + P0[1]); \
    GAPA(C0 = __builtin_amdgcn_mfma_f32_32x32x16_bf16(kf[0], qr[0], cini, 0, 0, 0), P0[2], P0[3], P0[4], P0[5],     pw0[0] = PKW(P0, 0), pw0[1] = PKW(P0, 2), pw0); \
    VRD(4); SBAR(); GAPA(C1 = __builtin_amdgcn_mfma_f32_32x32x16_bf16(kf[1], qr[0], cini, 0, 0, 0), P0[6], P0[7], P0[8], P0[9],     pw0[2] = PKW(P0, 4), pw0[3] = PKW(P0, 6), pw0); \
    VRD(1); SBAR(); GAPA(C0 = __builtin_amdgcn_mfma_f32_32x32x16_bf16(kf[2], qr[1], C0, 0, 0, 0),   P0[10], P0[11], P0[12], P0[13], pw1[0] = PKW(P0, 8), pw1[1] = PKW(P0, 10), pw1); \
    VRD(5); SBAR(); GAPA(C1 = __builtin_amdgcn_mfma_f32_32x32x16_bf16(kf[3], qr[1], C1, 0, 0, 0),   P0[14], P0[15], P1[0], P1[1],   pw1[2] = PKW(P0, 12), pw1[3] = PKW(P0, 14), pw1); \
    VRD(2); SBAR(); GAPA(C0 = __builtin_amdgcn_mfma_f32_32x32x16_bf16(kf[4], qr[2], C0, 0, 0, 0),   P1[2], P1[3], P1[4], P1[5],     pw2[0] = PKW(P1, 0), pw2[1] = PKW(P1, 2), pw2); \
    VRD(6); SBAR(); GAPA(C1 = __builtin_amdgcn_mfma_f32_32x32x16_bf16(kf[5], qr[2], C1, 0, 0, 0),   P1[6], P1[7], P1[8], P1[9],     pw2[2] = PKW(P1, 4), pw2[3] = PKW(P1, 6), pw2); \
    VRD(3); SBAR(); GAPA(C0 = __builtin_amdgcn_mfma_f32_32x32x16_bf16(kf[6], qr[3], C0, 0, 0, 0),   P1[10], P1[11], P1[12], P1[13], pw3[0] = PKW(P1, 8), pw3[1] = PKW(P1, 10), pw3); \
    VRD(7); SBAR(); GAPA(C1 = __builtin_amdgcn_mfma_f32_32x32x16_bf16(kf[7], qr[3], C1, 0, 0, 0),   P1[14], P1[15], 0.f, 0.f,       pw3[2] = PKW(P1, 12), pw3[3] = PKW(P1, 14), pw3); \
    l_reg += sacc; \
    if (GK) { DMA_K((t) + 3, sl_cur); } if (GV) { DMA_V((t) + 1, sl_next); } \
    if (JB >= 0) cmask(C0, C1, JB, qrel, hi); \
    { float a = MX3(C0[0], C0[1], C1[0]), b_ = MX3(C0[2], C0[3], C1[1]); a = MX3(a, C1[2], C1[3]); \
      _Pragma("unroll") for (int r = 4; r < 16; r += 4) { a = MX3(a, C0[r], C0[r + 1]); b_ = MX3(b_, C0[r + 2], C0[r + 3]); a = MX3(a, C1[r], C1[r + 1]); b_ = MX3(b_, C1[r + 2], C1[r + 3]); } \
      float rm = __builtin_fmaxf(a, b_); { auto rr = __builtin_amdgcn_permlane32_swap(__float_as_uint(rm), __float_as_uint(rm), false, false); rm = __builtin_fmaxf(__uint_as_float(rr[0]), __uint_as_float(rr[1])); } \
      resc = false; \
      if (__builtin_expect(__any(rm > (float)THRL), 0)) { const float dl = __builtin_fmaxf(rm, 0.f); mhat += dl; \
        _Pragma("unroll") for (int r = 0; r < 16; ++r) { C0[r] -= dl; C1[r] -= dl; } \
        const float f = __builtin_amdgcn_exp2f(-dl); l_reg *= f; if (hi == 0) wsf[r32] = f; resc = true; } } \
    SBAR(); \
    GAPB(o[0] = __builtin_amdgcn_mfma_f32_32x32x16_bf16(PAF(0), VFR(0), o[0], 0, 0, 0), C0, 0); \
    GAPB(o[1] = __builtin_amdgcn_mfma_f32_32x32x16_bf16(PAF(0), VFR(4), o[1], 0, 0, 0), C0, 4); \
    KRD(GL, 0); GAPB(o[0] = __builtin_amdgcn_mfma_f32_32x32x16_bf16(PAF(1), VFR(1), o[0], 0, 0, 0), C0, 8); \
    KRD(GL, 1); GAPB(o[1] = __builtin_amdgcn_mfma_f32_32x32x16_bf16(PAF(1), VFR(5), o[1], 0, 0, 0), C0, 12); \
    KRD(GL, 2); GAPB(o[0] = __builtin_amdgcn_mfma_f32_32x32x16_bf16(PAF(2), VFR(2), o[0], 0, 0, 0), C1, 0); \
    KRD(GL, 3); GAPB(o[1] = __builtin_amdgcn_mfma_f32_32x32x16_bf16(PAF(2), VFR(6), o[1], 0, 0, 0), C1, 4); \
    GAPB(o[0] = __builtin_amdgcn_mfma_f32_32x32x16_bf16(PAF(3), VFR(3), o[0], 0, 0, 0), C1, 8); \
    GAPB(o[1] = __builtin_amdgcn_mfma_f32_32x32x16_bf16(PAF(3), VFR(7), o[1], 0, 0, 0), C1, 12); \
    } while (0)
#define ENDW(tt) do { if ((tt) + 3 < NT) { WAIT_BAR(2); } else if ((tt) + 2 < NT) { WAIT_BAR(1); } else { WAIT_BAR(0); } } while (0)
    STEP(pB0, pB1, pA0, pA1, 1, (4 < NT), true, true, 1);   ENDW(1); RESC(); ROT();
    STEP(pA0, pA1, pB0, pB1, 2, (5 < NT), true, true, 2);   ENDW(2); RESC(); ROT();
    STEP(pB0, pB1, pA0, pA1, 3, (6 < NT), (4 < NT), (4 < NT), 3);   ENDW(3); RESC(); ROT();
    for (int t = 4; t < NT; t += 2) {
        STEP(pA0, pA1, pB0, pB1, t, (t + 3 < NT), true, true, -1);                       ENDW(t);     RESC(); ROT();
        STEP(pB0, pB1, pA0, pA1, t + 1, (t + 4 < NT), (t + 2 < NT), (t + 2 < NT), -1);   ENDW(t + 1); RESC(); ROT();
    }
    { float sacc = pB0[0] + pB0[1]; _Pragma("unroll") for (int r = 2; r < 16; ++r) sacc += pB0[r]; _Pragma("unroll") for (int r = 0; r < 16; ++r) sacc += pB1[r]; l_reg += sacc;
      pw0 = (u32x4){PKW(pB0, 0), PKW(pB0, 2), PKW(pB0, 4), PKW(pB0, 6)}; pw1 = (u32x4){PKW(pB0, 8), PKW(pB0, 10), PKW(pB0, 12), PKW(pB0, 14)}; pw2 = (u32x4){PKW(pB1, 0), PKW(pB1, 2), PKW(pB1, 4), PKW(pB1, 6)}; pw3 = (u32x4){PKW(pB1, 8), PKW(pB1, 10), PKW(pB1, 12), PKW(pB1, 14)};
      SBAR(); pv(o, (int)(unsigned long)vp0 + sl_prev, PAF(0), PAF(1), PAF(2), PAF(3)); }
#undef PKW
#undef PAF
#undef VFR
#undef PIN
#undef MX3
#undef GAPA
#undef GAPB
#undef EX
#undef VRD
#undef KRD
#undef STEP
#undef ENDW
    { auto rr = __builtin_amdgcn_permlane32_swap(__float_as_uint(l_reg), __float_as_uint(l_reg), false, false); l_reg = __uint_as_float(rr[0]) + __uint_as_float(rr[1]); }
    if (hi == 0) wsf[32 + r32] = l_reg; asm volatile("s_waitcnt lgkmcnt(0)" ::: "memory");
    float rli[16];
#pragma unroll
    for (int r = 0; r < 16; ++r) rli[r] = __builtin_amdgcn_rcpf(wsf[32 + crow(r, hi)]);
    bf16_t* Ow = Og + (rowbase + q0 + wid * QBLK) * DMO + h * HD;
    { bf16_t* stg = (bf16_t*)(shm + LDS_OST) + wid * 2048;
#pragma unroll
      for (int r = 0; r < 16; ++r) { const int orow = crow(r, hi);
#pragma unroll
        for (int d0 = 0; d0 < 2; ++d0) stg[orow * 64 + d0 * 32 + r32] = (bf16_t)f2bf(o[d0][r] * rli[r]); }
      asm volatile("s_waitcnt lgkmcnt(0)" ::: "memory");
#pragma unroll
      for (int i = 0; i < 4; ++i) { const int row = i * 8 + (lane >> 3), ch = lane & 7; const u32x4 v = *(const u32x4*)(stg + row * 64 + ch * 8); *(u32x4*)(Ow + (long)row * DMO + ch * 8) = v; } }
    asm volatile("s_waitcnt lgkmcnt(0)\n\ts_barrier" ::: "memory");
#undef DMA_K
#undef DMA_V
#undef TMAP
#undef SETC
#undef START
#undef RESC
#undef ROT
}
#undef SBAR
#undef WAIT_BAR
}

namespace hgrn {
constexpr int RS = 144;
constexpr int R_FQV = 0, FQV_SLOT = 32768;
constexpr int L_Q = 98304, L_K = L_Q + 9216, L_KT = L_K + 9216, L_VT = L_KT + 9216, L_ST = L_VT + 9216, L_SEG = L_ST + 9216, L_DEND = L_SEG + 2048, L_SSQ = L_DEND + 256, L_BYTES = L_SSQ + 512;
__device__ __forceinline__ int crow(int r, int hi) { return (r & 3) + 8 * (r >> 2) + 4 * hi; }
__device__ __forceinline__ void glds16(const void* gsrc, unsigned lds_dst) { unsigned keep;
    asm volatile("s_mov_b32 %0, m0\n\ts_mov_b32 m0, %2\n\ts_nop 0\n\tglobal_load_lds_dwordx4 %1, off\n\ts_mov_b32 m0, %0" : "=&s"(keep) : "v"(gsrc), "s"(lds_dst) : "memory"); }
#define HG_BAR() do { asm volatile("s_waitcnt lgkmcnt(0)" ::: "memory"); __builtin_amdgcn_s_barrier(); asm volatile("" ::: "memory"); } while (0)
__device__ __forceinline__ void hgrn_unit(int b, int h, const bf16_t* __restrict__ proj, bf16_t* __restrict__ mix, const float* __restrict__ lb_logits, const float* __restrict__ norm_g, LAS unsigned char* lds) {
    int tid_ = threadIdx.x; asm volatile("" : "+v"(tid_));
    const int tid = tid_, lane = tid & 63, r32 = lane & 31, hi = lane >> 5; const int w = __builtin_amdgcn_readfirstlane(tid >> 6);
    const float lbk = fast_rcp(1.0f + fast_exp2((lb_logits[512 + h * 64 + lane] - lb_logits[h * 64 + lane]) * LOG2E));
    const int vr = (w >> 1) & 1, tc = w & 1;
    float ng[16];
#pragma unroll
    for (int r = 0; r < 16; ++r) ng[r] = norm_g[h * 64 + 32 * vr + crow(r, hi)];
    f32x16 S = f32x16{};
    for (int i = tid; i < 64 * RS / 4; i += 512) ((LAS unsigned*)(lds + L_ST))[i] = 0u;
    const size_t hoff = (size_t)(b * 8 + h) * (SEQ * 64) + (size_t)w * 512 + lane * 8;
    const bf16_t* gQ = proj + 3 * SEC_ELEMS + hoff; const bf16_t* gF = proj + 4 * SEC_ELEMS + hoff; const bf16_t* gV = proj + 5 * SEC_ELEMS + hoff; const bf16_t* gG = proj + 6 * SEC_ELEMS + hoff;
    const unsigned lds0 = (unsigned)(uintptr_t)(unsigned char*)lds;
#define DMA_FQV(c_) do { const int cc_ = (c_) < 63 ? (c_) : 63; const unsigned d_ = (unsigned)__builtin_amdgcn_readfirstlane(lds0 + R_FQV + (unsigned)(((c_) % 3) * FQV_SLOT) + (unsigned)w * 1024u); \
        glds16(gF + (size_t)cc_ * 4096, d_); glds16(gQ + (size_t)cc_ * 4096, d_ + 8192u); glds16(gV + (size_t)cc_ * 4096, d_ + 16384u); } while (0)
#define DMA_G(c_) do { const int cc_ = (c_) < 63 ? (c_) : 63; glds16(gG + (size_t)cc_ * 4096, (unsigned)__builtin_amdgcn_readfirstlane(lds0 + R_FQV + (unsigned)(((c_) % 3) * FQV_SLOT) + 24576u + (unsigned)w * 1024u)); } while (0)
    DMA_FQV(0); DMA_G(0); DMA_FQV(1); DMA_G(1);
    for (int c = 0; c < 64; ++c) {
        const size_t row0 = (size_t)b * SEQ + (size_t)c * 64;
        DMA_FQV(c + 2);
        asm volatile("s_waitcnt vmcnt(8)" ::: "memory");
        const LAS unsigned char* raw = lds + R_FQV + (c % 3) * FQV_SLOT + (8 * w) * 128 + lane * 2;
        float p[8], kk[8];
        { float run = 0.f;
#pragma unroll
          for (int i = 0; i < 8; ++i) { const float x = bf2f(*(const LAS unsigned short*)(raw + i * 128)); const float sg = fast_rcp(1.0f + fast_exp2(-x * LOG2E)); const float f = lbk + (1.0f - lbk) * sg;
              run += __builtin_amdgcn_logf(f); p[i] = run; kk[i] = 1.0f - f; } }
        ((LAS float*)(lds + L_SEG))[w * 64 + lane] = p[7];
        HG_BAR();
        DMA_G(c + 2);
        { float off = 0.f;
#pragma unroll
          for (int j = 0; j < 7; ++j) { const float sv = ((LAS float*)(lds + L_SEG))[j * 64 + lane]; off += (j < w) ? sv : 0.f; }
          unsigned kq[4], vq[4];
#pragma unroll
          for (int i = 0; i < 8; i += 2) { const float b0 = off + p[i], b1 = off + p[i + 1];
              const unsigned short q0r = *(const LAS unsigned short*)(raw + 8192 + i * 128), q1r = *(const LAS unsigned short*)(raw + 8192 + (i + 1) * 128);
              const unsigned short v0r = *(const LAS unsigned short*)(raw + 16384 + i * 128), v1r = *(const LAS unsigned short*)(raw + 16384 + (i + 1) * 128);
              const float q0 = bf2f(q0r) * fast_exp2(b0), q1 = bf2f(q1r) * fast_exp2(b1), k0 = kk[i] * fast_exp2(-b0), k1 = kk[i + 1] * fast_exp2(-b1);
              const unsigned qq = cvtpk(q0, q1), kw = cvtpk(k0, k1); kq[i >> 1] = kw; vq[i >> 1] = (unsigned)v0r | ((unsigned)v1r << 16);
              *(LAS unsigned short*)(lds + L_Q + (8 * w + i) * RS + lane * 2) = (unsigned short)(qq & 0xffffu);
              *(LAS unsigned short*)(lds + L_Q + (8 * w + i + 1) * RS + lane * 2) = (unsigned short)(qq >> 16);
              *(LAS unsigned short*)(lds + L_K + (8 * w + i) * RS + lane * 2) = (unsigned short)(kw & 0xffffu);
              *(LAS unsigned short*)(lds + L_K + (8 * w + i + 1) * RS + lane * 2) = (unsigned short)(kw >> 16); }
          *(LAS u32x4*)(lds + L_KT + lane * RS + 16 * w) = (u32x4){kq[0], kq[1], kq[2], kq[3]};
          *(LAS u32x4*)(lds + L_VT + lane * RS + 16 * w) = (u32x4){vq[0], vq[1], vq[2], vq[3]};
          if (w == 7) ((LAS float*)(lds + L_DEND))[lane] = fast_exp2(off + p[7]); }
        asm volatile("s_waitcnt vmcnt(8)" ::: "memory");
        HG_BAR();
        f32x16 OT = f32x16{};
        if (w < 4) {
            bf16x8 bq[4];
#pragma unroll
            for (int ks = 0; ks < 4; ++ks) bq[ks] = *(const LAS bf16x8*)(lds + L_Q + (32 * tc + r32) * RS + (16 * ks + 8 * hi) * 2);
#pragma unroll
            for (int sr = 0; sr < 2; ++sr) if (sr <= tc) {
                f32x16 at = f32x16{};
#pragma unroll
                for (int ks = 0; ks < 4; ++ks) { const bf16x8 a = *(const LAS bf16x8*)(lds + L_K + (32 * sr + r32) * RS + (16 * ks + 8 * hi) * 2); at = __builtin_amdgcn_mfma_f32_32x32x16_bf16(a, bq[ks], at, 0, 0, 0); }
                if (sr == tc) {
#pragma unroll
                    for (int r = 0; r < 16; ++r) at[r] = (crow(r, hi) <= r32) ? at[r] : 0.f; }
#pragma unroll
                for (int st = 0; st < 2; ++st) {
                    u32x4 bw; bw.x = cvtpk(at[8 * st + 0], at[8 * st + 1]); bw.y = cvtpk(at[8 * st + 2], at[8 * st + 3]); bw.z = cvtpk(at[8 * st + 4], at[8 * st + 5]); bw.w = cvtpk(at[8 * st + 6], at[8 * st + 7]);
                    const u32x2 lo = *(const LAS u32x2*)(lds + L_VT + (32 * vr + r32) * RS + (32 * sr + 16 * st + 4 * hi) * 2);
                    const u32x2 hh = *(const LAS u32x2*)(lds + L_VT + (32 * vr + r32) * RS + (32 * sr + 16 * st + 8 + 4 * hi) * 2);
                    const u32x4 aw = (u32x4){lo.x, lo.y, hh.x, hh.y};
                    OT = __builtin_amdgcn_mfma_f32_32x32x16_bf16(__builtin_bit_cast(bf16x8, aw), __builtin_bit_cast(bf16x8, bw), OT, 0, 0, 0); }
            }
#pragma unroll
            for (int ks = 0; ks < 4; ++ks) { const bf16x8 a = *(const LAS bf16x8*)(lds + L_ST + (32 * vr + r32) * RS + (16 * ks + 8 * hi) * 2); OT = __builtin_amdgcn_mfma_f32_32x32x16_bf16(a, bq[ks], OT, 0, 0, 0); }
            float sq = 0.f;
#pragma unroll
            for (int r = 0; r < 16; ++r) sq += OT[r] * OT[r];
            sq += __shfl_xor(sq, 32);
            if (hi == 0) ((LAS float*)(lds + L_SSQ))[vr * 64 + 32 * tc + r32] = sq;
        } else {
#pragma unroll
            for (int st = 0; st < 4; ++st) { const bf16x8 a = *(const LAS bf16x8*)(lds + L_KT + (32 * vr + r32) * RS + (16 * st + 8 * hi) * 2);
                const bf16x8 bv = *(const LAS bf16x8*)(lds + L_VT + (32 * tc + r32) * RS + (16 * st + 8 * hi) * 2);
                S = __builtin_amdgcn_mfma_f32_32x32x16_bf16(a, bv, S, 0, 0, 0); }
#pragma unroll
            for (int r = 0; r < 16; ++r) S[r] *= ((LAS float*)(lds + L_DEND))[32 * vr + crow(r, hi)];
        }
        HG_BAR();
        if (w < 4) {
            const int t = 32 * tc + r32;
            const float tot = ((LAS float*)(lds + L_SSQ))[t] + ((LAS float*)(lds + L_SSQ))[64 + t];
            const float rstd = __builtin_amdgcn_rsqf(tot * (1.0f / 64.0f) + EPS);
            const LAS unsigned char* gp = lds + R_FQV + (c % 3) * FQV_SLOT + 24576 + t * 128 + (32 * vr + 4 * hi) * 2;
            bf16_t* op = mix + (row0 + t) * D + 512 + h * 64 + 32 * vr + 4 * hi;
#pragma unroll
            for (int g = 0; g < 4; ++g) { const u32x2 gg = *(const LAS u32x2*)(gp + 16 * g);
                const float y0 = OT[4 * g + 0] * rstd * ng[4 * g + 0] * bflo(gg.x), y1 = OT[4 * g + 1] * rstd * ng[4 * g + 1] * bfhi(gg.x),
                            y2 = OT[4 * g + 2] * rstd * ng[4 * g + 2] * bflo(gg.y), y3 = OT[4 * g + 3] * rstd * ng[4 * g + 3] * bfhi(gg.y);
                *(u32x2*)(op + 8 * g) = (u32x2){cvtpk(y0, y1), cvtpk(y2, y3)}; }
        } else {
#pragma unroll
            for (int g = 0; g < 4; ++g) *(LAS u32x2*)(lds + L_ST + (32 * tc + r32) * RS + (32 * vr + 8 * g + 4 * hi) * 2) = (u32x2){cvtpk(S[4 * g + 0], S[4 * g + 1]), cvtpk(S[4 * g + 2], S[4 * g + 3])};
        }
    }
    asm volatile("s_waitcnt vmcnt(0)" ::: "memory");
    HG_BAR();
#undef DMA_FQV
#undef DMA_G
}
#undef HG_BAR
}

constexpr int NWAVES = 8;
constexpr int LDS_BYTES = 163840;
constexpr int TAIL = 161792;
constexpr int TL_TE = TAIL, TL_TS = TAIL + 576, TL_HIST = TAIL + 768, TL_BASE = TAIL + 896, TL_MISC = TAIL + 1024, TL_CNT = TAIL + 1280;
typedef GAS unsigned gu32;

struct Args { const float* in[20]; float* out; unsigned char* ws; int ph_lo, ph_hi; };

struct Frame {
    LAS unsigned char* lds; volatile LAS unsigned* MISC; unsigned* ctl;
    int tid, lane, wave, G, vcu;
};

struct P0Item { const float* W; bf16_t* WT; const float* gain; int N, K, k0, n0, mode; };
__device__ __forceinline__ bool p0_decode(const Args& a, int it, P0Item& I) {
    unsigned char* ws = a.ws;
    constexpr int I_IN = 16 * 56, I_SQ = 16 * 16, I_KV = 16 * 32, I_W1 = 16 * 32, I_W2 = 16 * 16;
    constexpr int NITEMS = I_IN + 2 * I_SQ + I_KV + NEXP * (I_W1 + I_W2);
    if (it >= NITEMS) return false;
    int r = it; I.gain = nullptr; I.mode = 0; I.K = D;
    if (r < I_IN) { I.W = a.in[3]; I.WT = (bf16_t*)(ws + WS_WIN); I.N = INC; }
    else if ((r -= I_IN) < I_SQ) { I.W = a.in[6]; I.WT = (bf16_t*)(ws + WS_WOUT); I.N = D; }
    else if ((r -= I_SQ) < I_KV) { I.W = a.in[10]; I.WT = (bf16_t*)(ws + WS_WKV); I.N = 2 * D; }
    else if ((r -= I_KV) < I_SQ) { I.W = a.in[11]; I.WT = (bf16_t*)(ws + WS_WO); I.N = D; }
    else if ((r -= I_SQ) < NEXP * I_W1) { const int e = r / I_W1; r -= e * I_W1; I.W = a.in[15] + (size_t)e * D * 2048; I.WT = (bf16_t*)(ws + WS_W1 + (size_t)e * 2048 * D); I.N = 2048; I.gain = a.in[12]; I.mode = 3; }
    else { r -= NEXP * I_W1; const int e = r / I_W2; r -= e * I_W2; I.W = a.in[17] + (size_t)e * D * D; I.WT = (bf16_t*)(ws + WS_W2 + (size_t)e * D * D); I.N = D; I.mode = 2; }
    const int nblk = I.N / 64; I.k0 = 64 * (r / nblk); I.n0 = 64 * (r % nblk); return true;
}
__device__ __forceinline__ void p0_load(const P0Item& I, f32x4 (&v)[16], int lane) {
    const float* p = I.W + (size_t)(I.k0 + (lane >> 4)) * I.N + I.n0 + 4 * (lane & 15);
#pragma unroll
    for (int j = 0; j < 16; ++j) v[j] = *(const f32x4*)(p + (size_t)(4 * j) * I.N);
}
__device__ __forceinline__ void p0_store(const P0Item& I, const f32x4 (&v)[16], LAS unsigned char* tl, int lane) {
    const int kr = lane >> 4, nq = lane & 15;
#pragma unroll
    for (int j = 0; j < 16; ++j) { const int k = 4 * j + kr; const float g = I.gain ? I.gain[I.k0 + k] : 1.0f;
        *(LAS u32x2*)(tl + k * 128 + (((nq >> 1) ^ ((k >> 3) & 7)) * 16) + (nq & 1) * 8) = (u32x2){pk2(v[j].x * g, v[j].y * g), pk2(v[j].z * g, v[j].w * g)}; }
    LDS_WAIT(); asm volatile("" ::: "memory");
    const int c = lane & 7;
#pragma unroll
    for (int i = 0; i < 8; ++i) { const int n = (lane >> 3) + 8 * i; const LAS unsigned char* sp = tl + (8 * c) * 128 + ((i ^ c) * 16) + (n & 7) * 2;
        unsigned short e[8];
#pragma unroll
        for (int q = 0; q < 8; ++q) e[q] = *(const LAS unsigned short*)(sp + q * 128);
        int row = I.n0 + n; if (I.mode & 1) { const int jj = row >> 1, bj = row & 1; row = (jj >> 7) * 256 + bj * 128 + (jj & 127); }
        if (I.mode & 2) *(u32x2*)((unsigned char*)I.WT + (size_t)row * I.K + I.k0 + 8 * c) = (u32x2){pk4_fp8(bf2f(e[0]) * WSCALE8, bf2f(e[1]) * WSCALE8, bf2f(e[2]) * WSCALE8, bf2f(e[3]) * WSCALE8), pk4_fp8(bf2f(e[4]) * WSCALE8, bf2f(e[5]) * WSCALE8, bf2f(e[6]) * WSCALE8, bf2f(e[7]) * WSCALE8)};
        else *(u32x4*)(I.WT + (size_t)row * I.K + I.k0 + 8 * c) = (u32x4){(unsigned)e[0] | ((unsigned)e[1] << 16), (unsigned)e[2] | ((unsigned)e[3] << 16), (unsigned)e[4] | ((unsigned)e[5] << 16), (unsigned)e[6] | ((unsigned)e[7] << 16)}; }
    LDS_WAIT(); asm volatile("" ::: "memory");
}
__device__ __forceinline__ void rms_rows2_to_bf16(const float* __restrict__ x0, const float* __restrict__ x1, const float* __restrict__ g, bf16_t* __restrict__ o0, bf16_t* __restrict__ o1, int lane) {
    const f32x4* xa = (const f32x4*)x0 + lane; const f32x4* xb = (const f32x4*)x1 + lane; const f32x4* gr = (const f32x4*)g + lane;
    f32x4 va[4], vb[4]; float sa = 0.f, sb = 0.f;
#pragma unroll
    for (int j = 0; j < 4; ++j) { va[j] = xa[64 * j]; vb[j] = xb[64 * j]; }
#pragma unroll
    for (int j = 0; j < 4; ++j) { sa += (va[j].x * va[j].x + va[j].y * va[j].y) + (va[j].z * va[j].z + va[j].w * va[j].w); sb += (vb[j].x * vb[j].x + vb[j].y * vb[j].y) + (vb[j].z * vb[j].z + vb[j].w * vb[j].w); }
    const float ra = 1.0f / sqrtf(wave_sum(sa) * (1.0f / D) + EPS), rb = 1.0f / sqrtf(wave_sum(sb) * (1.0f / D) + EPS);
    unsigned long long* pa = (unsigned long long*)o0 + lane; unsigned long long* pb = (unsigned long long*)o1 + lane;
#pragma unroll
    for (int j = 0; j < 4; ++j) { const f32x4 gg = gr[64 * j];
        pa[64 * j] = (unsigned long long)pk2(va[j].x * ra * gg.x, va[j].y * ra * gg.y) | ((unsigned long long)pk2(va[j].z * ra * gg.z, va[j].w * ra * gg.w) << 32);
        pb[64 * j] = (unsigned long long)pk2(vb[j].x * rb * gg.x, vb[j].y * rb * gg.y) | ((unsigned long long)pk2(vb[j].z * rb * gg.z, vb[j].w * rb * gg.w) << 32); }
}

__device__ __forceinline__ void p0_prologue(Frame& F, const Args& a) {
    unsigned char* ws = a.ws;
    LAS unsigned char* tl = F.lds + F.wave * 8192;
    const int gw = F.vcu * NWAVES + F.wave, NGW = F.G * NWAVES;
    for (int m = 2 * gw; m < T; m += 2 * NGW) rms_rows2_to_bf16(a.in[0] + (size_t)m * D, a.in[0] + (size_t)(m + 1) * D, a.in[2], (bf16_t*)(ws + WS_XN) + (size_t)m * D, (bf16_t*)(ws + WS_XN) + (size_t)(m + 1) * D, F.lane);
    for (int m = 2 * gw; m < MROWS; m += 2 * NGW) rms_rows2_to_bf16(a.in[1] + (size_t)m * D, a.in[1] + (size_t)(m + 1) * D, a.in[8], (bf16_t*)(ws + WS_MN) + (size_t)m * D, (bf16_t*)(ws + WS_MN) + (size_t)(m + 1) * D, F.lane);
    for (int i = gw * 64 + F.lane; i < D * D / 4; i += NGW * 64) { const f32x4 w = ((const f32x4*)a.in[9])[i]; const float g = a.in[7][i >> 8];
        ((u32x2*)(ws + WS_WQ))[i] = (u32x2){pk2(w.x * g, w.y * g), pk2(w.z * g, w.w * g)}; }
    for (int i = gw * 64 + F.lane; i < NEXP * D; i += NGW * 64) { const int e = i >> 10, k = i & 1023; const float w = a.in[12][k] * a.in[13][k * NEXP + e];
        const unsigned hi = f2bf(w); ((bf16_t*)(ws + WS_WRT))[i] = (bf16_t)hi; ((bf16_t*)(ws + WS_WRT))[NEXP * D + i] = (bf16_t)f2bf(w - bf2f((unsigned short)hi)); }
    P0Item IA, IB; f32x4 va[16], vb[16];
    int it = gw; bool ha = p0_decode(a, it, IA); if (ha) p0_load(IA, va, F.lane);
    while (ha) {
        const bool hb = p0_decode(a, it + NGW, IB); if (hb) p0_load(IB, vb, F.lane);
        p0_store(IA, va, tl, F.lane);
        if (!hb) break;
        it += 2 * NGW; ha = p0_decode(a, it, IA); if (ha) p0_load(IA, va, F.lane);
        p0_store(IB, vb, tl, F.lane);
    }
}

__device__ __forceinline__ unsigned xcc_id() { return (unsigned)__builtin_amdgcn_s_getreg((3 << 11) | 20) & 0xFu; }
constexpr int QITEMS = 16 + 128;
__device__ __forceinline__ void p2_mixer(Frame& F, const Args& a, int rep) {
    unsigned char* ws = a.ws;
    const bf16_t* proj = (const bf16_t*)(ws + WS_PROJ); bf16_t* mix = (bf16_t*)(ws + WS_MIX);
    const unsigned x0 = xcc_id() & 7u;
    int par = 0;
#ifdef MK_P2_REPMODE
    if (rep && MK_P2_REPMODE == 4) return;
#endif
#ifdef MK_P2_HALF
    if (rep && (blockIdx.x & 8)) return;
#endif
    for (;;) {
        if (F.tid == 0) { int code = -1;
            for (int j = 0; j < 8; ++j) { const unsigned xq = (x0 + j) & 7u; const unsigned i = __hip_atomic_fetch_add(F.ctl + CW_QUEUE + 1024 * rep + 64 * xq, 1u, RLX_AGENT);
                if (i < (unsigned)QITEMS) { code = (int)(xq * 256u + i); break; } }
            F.MISC[par] = (unsigned)code; }
        LDS_WAIT(); __builtin_amdgcn_s_barrier(); asm volatile("" ::: "memory");
        const int code = __builtin_amdgcn_readfirstlane((int)F.MISC[par]); par ^= 1;
        if (code < 0) break;
        const int xq = code >> 8, i = code & 255;
#ifdef MK_P2_REPMODE
        if (rep && ((MK_P2_REPMODE == 1 && i >= 8) || (MK_P2_REPMODE == 2 && i < 16) || MK_P2_REPMODE == 3)) continue;
#endif
#ifndef NO_HGRN
        if (i < 8) { hgrn::hgrn_unit(xq, i, proj, mix, a.in[4], a.in[5], F.lds); }
        else
#endif
        if (i < 16) {
            pg8::KvOrder S{(const char*)(ws + WS_MN), (const char*)(ws + WS_WKV), xq * 8 + (i - 8)};
            pg8::EpiBf16 E{(bf16_t*)(ws + WS_MEMK), D, (bf16_t*)(ws + WS_MEMVT), D};
            pg8::gemm_phase<pg8::EpiBf16, pg8::KvOrder, false, false>(F.lds, D, D, D / 64, S, E);
        } else
#ifndef NO_MOBA
        { const int j = i - 16, g = j >> 5, jj = j & 31, hh = 2 * g + (jj & 1), qb = 15 - (jj >> 1);
            moba::attn_unit<8>(xq, hh, qb, proj, proj + SEC_ELEMS, proj + 2 * SEC_ELEMS, mix, (const float*)(ws + WS_KBAR), (char*)(unsigned char*)F.lds); }
#else
        {}
#endif
    }
}

__device__ __forceinline__ void p7_router(Frame& F, const Args& a, int rep) {
    unsigned char* ws = a.ws;
    constexpr int WRS = 2064;
    LAS unsigned char* WH = F.lds; LAS unsigned char* WL = F.lds + 32 * WRS;
    LAS int* hist = (LAS int*)(F.lds + TL_HIST); LAS int* basel = (LAS int*)(F.lds + TL_BASE);
    { const u32x4* src = (const u32x4*)(ws + WS_WRT);
      for (int i = F.tid; i < 2 * NEXP * D / 8; i += 512) { const int m = i >> 12, r = (i >> 7) & 31, c = i & 127; *(LAS u32x4*)(F.lds + m * 32 * WRS + r * WRS + c * 16) = src[i]; } }
    const float* h2f = (const float*)(ws + WS_H2F); const float* ss2 = (const float*)(ws + WS_SS2);
    int* toke = (int*)(ws + (rep ? WS_DUMMY + 1 * MiB : WS_TOKE)); int* tokr = (int*)(ws + (rep ? WS_DUMMY + 1 * MiB + 512 * 1024 : WS_TOKR)); float* tokg = (float*)(ws + (rep ? WS_DUMMY + 2 * MiB : WS_TOKG)); int* list = (int*)(ws + (rep ? WS_DUMMY + 4 * MiB : WS_LIST)); float* glist = (float*)(ws + (rep ? WS_DUMMY + 8 * MiB : WS_GLIST));
    unsigned* cntw = F.ctl + (rep ? CW_CNT + 2048 * rep : CW_CNT);
    const int lane = F.lane, r16 = lane & 15, g4 = lane >> 4;
    const float br0 = a.in[14][r16], br1 = a.in[14][16 + r16];
    for (int tb = blockIdx.x; tb < T / 128; tb += F.G) {
        if (F.tid < 32) hist[F.tid] = 0;
        LDS_WAIT(); __builtin_amdgcn_s_barrier(); asm volatile("" ::: "memory");
        const int t0 = tb * 128 + F.wave * 16;
        const float* xr = h2f + (size_t)(t0 + r16) * D + 8 * g4;
        f32x4 acc0 = (f32x4){0.f, 0.f, 0.f, 0.f}, acc1 = acc0;
        f32x4 xa = *(const f32x4*)(xr), xb = *(const f32x4*)(xr + 4);
#pragma unroll 4
        for (int ks = 0; ks < 32; ++ks) {
            const f32x4 ca = xa, cb = xb;
            if (ks + 1 < 32) { xa = *(const f32x4*)(xr + 32 * (ks + 1)); xb = *(const f32x4*)(xr + 32 * (ks + 1) + 4); }
            const unsigned h0 = cvtpk(ca.x, ca.y), h1 = cvtpk(ca.z, ca.w), h2 = cvtpk(cb.x, cb.y), h3 = cvtpk(cb.z, cb.w);
            const unsigned l0 = cvtpk(ca.x - bflo(h0), ca.y - bfhi(h0)), l1 = cvtpk(ca.z - bflo(h1), ca.w - bfhi(h1)), l2 = cvtpk(cb.x - bflo(h2), cb.y - bfhi(h2)), l3 = cvtpk(cb.z - bflo(h3), cb.w - bfhi(h3));
            const bf16x8 ah = __builtin_bit_cast(bf16x8, (u32x4){h0, h1, h2, h3}), al = __builtin_bit_cast(bf16x8, (u32x4){l0, l1, l2, l3});
            const int bo = r16 * WRS + (32 * ks + 8 * g4) * 2;
            const bf16x8 bh0 = *(const LAS bf16x8*)(WH + bo), bh1 = *(const LAS bf16x8*)(WH + 16 * WRS + bo), bl0 = *(const LAS bf16x8*)(WL + bo), bl1 = *(const LAS bf16x8*)(WL + 16 * WRS + bo);
            acc0 = __builtin_amdgcn_mfma_f32_16x16x32_bf16(ah, bh0, acc0, 0, 0, 0); acc1 = __builtin_amdgcn_mfma_f32_16x16x32_bf16(ah, bh1, acc1, 0, 0, 0);
            acc0 = __builtin_amdgcn_mfma_f32_16x16x32_bf16(ah, bl0, acc0, 0, 0, 0); acc1 = __builtin_amdgcn_mfma_f32_16x16x32_bf16(ah, bl1, acc1, 0, 0, 0);
            acc0 = __builtin_amdgcn_mfma_f32_16x16x32_bf16(al, bh0, acc0, 0, 0, 0); acc1 = __builtin_amdgcn_mfma_f32_16x16x32_bf16(al, bh1, acc1, 0, 0, 0);
        }
        int my_e = 0; float my_g = 0.f;
#pragma unroll
        for (int j = 0; j < 4; ++j) {
            const float rs = __builtin_amdgcn_rsqf(ss2[t0 + 4 * g4 + j] * (1.0f / D) + EPS);
            float a0 = acc0[j] * rs + br0, a1 = acc1[j] * rs + br1; float tv[4]; int te_[4];
#pragma unroll
            for (int k = 0; k < 4; ++k) { float m = fmaxf(a0, a1);
#pragma unroll
                for (int o = 1; o < 16; o <<= 1) m = fmaxf(m, __shfl_xor(m, o));
                int e = (a0 == m) ? r16 : ((a1 == m) ? 16 + r16 : 99);
#pragma unroll
                for (int o = 1; o < 16; o <<= 1) e = min(e, __shfl_xor(e, o));
                tv[k] = m; te_[k] = e; if (e == r16) a0 = -INFINITY; if (e == 16 + r16) a1 = -INFINITY; }
            const float d1 = fast_exp2((tv[1] - tv[0]) * LOG2E), d2 = fast_exp2((tv[2] - tv[0]) * LOG2E), d3 = fast_exp2((tv[3] - tv[0]) * LOG2E);
            const float inv = 1.0f / (1.0f + d1 + d2 + d3);
            if ((r16 >> 2) == j) { const int k = lane & 3; my_e = k == 0 ? te_[0] : (k == 1 ? te_[1] : (k == 2 ? te_[2] : te_[3])); my_g = (k == 0 ? 1.0f : (k == 1 ? d1 : (k == 2 ? d2 : d3))) * inv; }
        }
        const int rl = __hip_atomic_fetch_add(hist + my_e, 1, __ATOMIC_RELAXED, __HIP_MEMORY_SCOPE_WORKGROUP);
        LDS_WAIT(); __builtin_amdgcn_s_barrier(); asm volatile("" ::: "memory");
        if (F.tid < 32) basel[F.tid] = (int)__hip_atomic_fetch_add(cntw + F.tid, (unsigned)hist[F.tid], RLX_AGENT);
        LDS_WAIT(); VM_WAIT(); __builtin_amdgcn_s_barrier(); asm volatile("" ::: "memory");
        { const int t = t0 + 4 * g4 + (r16 >> 2), k = lane & 3; const int rank = basel[my_e] + rl;
          toke[t * 4 + k] = my_e; tokr[t * 4 + k] = rank; tokg[t * 4 + k] = my_g; list[(size_t)my_e * T + rank] = t; glist[(size_t)my_e * T + rank] = my_g; }
        LDS_WAIT(); __builtin_amdgcn_s_barrier(); asm volatile("" ::: "memory");
    }
}

__device__ __forceinline__ int build_tables(Frame& F) {
    LAS int* ts = (LAS int*)(F.lds + TL_TS); LAS unsigned char* te = (LAS unsigned char*)(F.lds + TL_TE);
    if (F.tid == 0) { int run = 0;
        for (int e = 0; e < NEXP; ++e) { ts[e] = run; const unsigned c = __hip_atomic_load(F.ctl + CW_CNT + e, RLX_AGENT); ((LAS int*)(F.lds + TL_CNT))[e] = (int)c; run += (int)((c + 255u) >> 8); }
        ts[NEXP] = run; }
    LDS_WAIT(); __builtin_amdgcn_s_barrier(); asm volatile("" ::: "memory");
    const int nt = ts[NEXP];
    for (int g = F.tid; g < nt; g += 512) { int e = 0;
        for (int j = 1; j < NEXP; ++j) e += (ts[j] <= g) ? 1 : 0;
        te[g] = (unsigned char)e; }
    LDS_WAIT(); __builtin_amdgcn_s_barrier(); asm volatile("" ::: "memory");
    return __builtin_amdgcn_readfirstlane(nt);
}

__device__ __forceinline__ void p10_combine(Frame& F, const Args& a) {
    unsigned char* ws = a.ws;
    LAS int* ts = (LAS int*)(F.lds + TL_TS);
    const float* h2f = (const float*)(ws + WS_H2F); const unsigned char* Y = (const unsigned char*)(ws + WS_Y);
    const int* toke = (const int*)(ws + WS_TOKE); const int* tokr = (const int*)(ws + WS_TOKR);
    const float* gf = a.in[19];
    const int gw = F.vcu * NWAVES + F.wave, NGW = F.G * NWAVES, lane = F.lane;
    for (int t0 = 2 * gw; t0 < T; t0 += 2 * NGW) {
        float o[2][16]; u32x2 y[2][4][2];
#pragma unroll
        for (int q = 0; q < 2; ++q) { const int t = t0 + q;
#pragma unroll
            for (int k = 0; k < 4; ++k) { const int e = toke[t * 4 + k], r = tokr[t * 4 + k]; const unsigned char* yr = Y + ((size_t)ts[e] * 256 + r) * D;
                y[q][k][0] = *(const u32x2*)(yr + 8 * lane); y[q][k][1] = *(const u32x2*)(yr + 512 + 8 * lane); }
            const f32x4 a0 = *(const f32x4*)(h2f + (size_t)t * D + 8 * lane), a1 = *(const f32x4*)(h2f + (size_t)t * D + 8 * lane + 4), a2 = *(const f32x4*)(h2f + (size_t)t * D + 512 + 8 * lane), a3 = *(const f32x4*)(h2f + (size_t)t * D + 512 + 8 * lane + 4);
            o[q][0] = a0.x; o[q][1] = a0.y; o[q][2] = a0.z; o[q][3] = a0.w; o[q][4] = a1.x; o[q][5] = a1.y; o[q][6] = a1.z; o[q][7] = a1.w; o[q][8] = a2.x; o[q][9] = a2.y; o[q][10] = a2.z; o[q][11] = a2.w; o[q][12] = a3.x; o[q][13] = a3.y; o[q][14] = a3.z; o[q][15] = a3.w; }
#pragma unroll
        for (int q = 0; q < 2; ++q) {
#pragma unroll
            for (int k = 0; k < 4; ++k)
#pragma unroll
                for (int hf = 0; hf < 2; ++hf) { const u32x2 w = y[q][k][hf];
                    const f32x2 c0 = __builtin_amdgcn_cvt_pk_f32_fp8((int)w.x, false), c1 = __builtin_amdgcn_cvt_pk_f32_fp8((int)w.x, true), c2 = __builtin_amdgcn_cvt_pk_f32_fp8((int)w.y, false), c3 = __builtin_amdgcn_cvt_pk_f32_fp8((int)w.y, true);
                    o[q][8 * hf + 0] += pg8::YSCALE_INV * c0.x; o[q][8 * hf + 1] += pg8::YSCALE_INV * c0.y; o[q][8 * hf + 2] += pg8::YSCALE_INV * c1.x; o[q][8 * hf + 3] += pg8::YSCALE_INV * c1.y;
                    o[q][8 * hf + 4] += pg8::YSCALE_INV * c2.x; o[q][8 * hf + 5] += pg8::YSCALE_INV * c2.y; o[q][8 * hf + 6] += pg8::YSCALE_INV * c3.x; o[q][8 * hf + 7] += pg8::YSCALE_INV * c3.y; }
            float s = 0.f;
#pragma unroll
            for (int j = 0; j < 16; ++j) s += o[q][j] * o[q][j];
            const float rstd = 1.0f / sqrtf(wave_sum(s) * (1.0f / D) + EPS);
            float* op = a.out + (size_t)(t0 + q) * D;
#pragma unroll
            for (int v = 0; v < 4; ++v) { const int col = (v >> 1) * 512 + 8 * lane + (v & 1) * 4; const f32x4 g4 = *(const f32x4*)(gf + col);
                *(f32x4*)(op + col) = (f32x4){o[q][4 * v] * rstd * g4.x, o[q][4 * v + 1] * rstd * g4.y, o[q][4 * v + 2] * rstd * g4.z, o[q][4 * v + 3] * rstd * g4.w}; }
        }
    }
}

#define XB_TMO      128
#define XB_XCNT(j)  (256  + 64 * (j))
#define XB_XSUB(j)  (1280 + 64 * (j))
#define XB_XGEN(j)  (2304 + 64 * (j))
#define XB_TOP      3328
#define XB_TOPGEN   3392
#define XCD_BAR_WORDS 3456
#define XB_SPIN_CAP (1u << 22)
__device__ __forceinline__ unsigned xb_ld(unsigned* p)              { return __hip_atomic_load(p, __ATOMIC_RELAXED, __HIP_MEMORY_SCOPE_AGENT); }
__device__ __forceinline__ unsigned xb_add(unsigned* p, unsigned v) { return __hip_atomic_fetch_add(p, v, __ATOMIC_RELAXED, __HIP_MEMORY_SCOPE_AGENT); }
#define XB_SPIN(cond, bar) do { unsigned _sp = 0; while (cond) { __builtin_amdgcn_s_sleep(1); \
    if ((++_sp & 255u) == 0u) { if (xb_ld(&(bar)[XB_TMO])) break; if (_sp > XB_SPIN_CAP) { atomicAdd(&(bar)[XB_TMO], 1u); break; } } } } while (0)
struct XcdBarrier { unsigned* bar; unsigned x; volatile LAS unsigned* st; };
__device__ __forceinline__ XcdBarrier xcd_barrier_post(unsigned* bar, volatile LAS unsigned* st) {
    XcdBarrier b; b.bar = bar; b.x = (unsigned)__builtin_amdgcn_s_getreg((3 << 11) | 20) & 0xFu; b.st = st;
    if (threadIdx.x == 0) (void)xb_add(&bar[XB_XCNT(b.x)], 1u);
    return b;
}
__device__ __forceinline__ void xcd_barrier_complete(unsigned* bar, unsigned x, unsigned& nloc, unsigned& nx) {
    const unsigned G = gridDim.x * gridDim.y * gridDim.z;
    unsigned sum, cnt, mine, sp = 0u;
    for (;;) {
        sum = 0u; cnt = 0u; mine = 0u;
#pragma unroll
        for (unsigned j = 0; j < 16; ++j) { const unsigned c = xb_ld(&bar[XB_XCNT(j)]); sum += c; cnt += (c > 0u) ? 1u : 0u; mine = (j == x) ? c : mine; }
        if (sum == G) break;
        __builtin_amdgcn_s_sleep(1);
        if ((++sp & 255u) == 0u) { if (xb_ld(&bar[XB_TMO])) break; if (sp > XB_SPIN_CAP) { atomicAdd(&bar[XB_TMO], 1u); break; } }
    }
    nloc = mine > 0u ? mine : 1u; nx = cnt > 0u ? cnt : 1u;
}
__device__ __forceinline__ void xcd_barrier(const XcdBarrier& b) {
    asm volatile("s_waitcnt vmcnt(0)" ::: "memory");
    __syncthreads();
    if (threadIdx.x == 0) {
        unsigned* bar = b.bar;
        __builtin_amdgcn_s_waitcnt(0);
        unsigned nloc = b.st[0], nx = b.st[1];
        if (nloc == 0u) { xcd_barrier_complete(bar, b.x, nloc, nx); b.st[0] = nloc; b.st[1] = nx; }
        const unsigned old = xb_add(&bar[XB_XSUB(b.x)], 1u);
        const unsigned gen = old / nloc;
        if (old + 1u == (gen + 1u) * nloc) {
            __builtin_amdgcn_fence(__ATOMIC_RELEASE, "agent");
            asm volatile("s_waitcnt vmcnt(0)" ::: "memory");
            const unsigned og = xb_add(&bar[XB_TOP], 1u);
            const unsigned tg = og / nx;
            if (og + 1u == (tg + 1u) * nx) xb_add(&bar[XB_TOPGEN], 1u);
            else XB_SPIN(xb_ld(&bar[XB_TOPGEN]) == tg, bar);
            __builtin_amdgcn_fence(__ATOMIC_ACQUIRE, "agent");
            xb_add(&bar[XB_XGEN(b.x)], 1u);
            asm volatile("s_waitcnt vmcnt(0)" ::: "memory");
        } else {
            XB_SPIN(xb_ld(&bar[XB_XGEN(b.x)]) == gen, bar);
            __builtin_amdgcn_fence(__ATOMIC_ACQUIRE, "agent");
            asm volatile("s_waitcnt vmcnt(0)" ::: "memory");
        }
    }
    __syncthreads();
}
#ifndef MK_CG_ONLY
#define MK_CG_ONLY 0
#endif
__device__ __forceinline__ void grid_barrier(Frame& F, const XcdBarrier& xb_) { if (MK_CG_ONLY) cg::this_grid().sync(); else xcd_barrier(xb_); }
#ifndef MK_PHASE_MASK
#define MK_PHASE_MASK 0x7ff
#endif
#ifndef MK_REP_PHASE
#define MK_REP_PHASE -1
#endif
#ifndef MK_REP_N
#define MK_REP_N 0
#endif
__device__ __forceinline__ void ph0(Frame& F, const Args& args, int rep) { p0_prologue(F, args); }
__device__ __forceinline__ void ph1(Frame& F, const Args& args, int rep) {
    unsigned char* ws = args.ws; const int cid = (int)blockIdx.x;
    { pg8::DenseOrder S{(const char*)(ws + WS_XN), (const char*)(ws + WS_WIN), D, D, T / 256, INC / 256, F.G, cid};
      pg8::EpiProj E{(bf16_t*)(ws + WS_PROJ), rep ? (float*)(ws + WS_DUMMY) : (float*)(ws + WS_KBAR)};
      pg8::gemm_phase<pg8::EpiProj, pg8::DenseOrder, false, true>(F.lds, D, D, D / 64, S, E); }
}
__device__ __forceinline__ void ph2(Frame& F, const Args& args, int rep) { p2_mixer(F, args, rep); }
constexpr size_t WS_MB = WS_PROJ, WS_NB = WS_PROJ + 16 * MiB, WS_PB = WS_QX;
constexpr int LDS_XTAB = 131072;
__device__ __forceinline__ void ph3(Frame& F, const Args& args, int rep) {
    unsigned char* ws = args.ws; const int cid = (int)blockIdx.x;
    { pg8::XmnOrder S{(const char*)(ws + WS_MEMK), (const char*)(ws + WS_MEMVT), (const char*)(ws + WS_WQ), (const char*)(ws + WS_WO), F.G, cid};
      pg8::EpiBf16 E{(bf16_t*)(ws + WS_MB), D, (bf16_t*)(ws + WS_NB), D};
      pg8::gemm_phase<pg8::EpiBf16, pg8::XmnOrder, false, true>(F.lds, D, D, 4, S, E); }
    pg8::DenseOrder S{(const char*)(ws + WS_MIX), (const char*)(ws + WS_WOUT), D, D, T / 256, D / 256, F.G, cid};
    pg8::EpiRes<true, false> E{(const void*)args.in[0], (bf16_t*)(ws + WS_H1B), nullptr, rep ? (float*)(ws + WS_DUMMY + 512 * 1024) : (float*)(ws + WS_SS1)};
    pg8::gemm_phase<pg8::EpiRes<true, false>, pg8::DenseOrder, false, true>(F.lds, D, D, D / 64, S, E);
}
__device__ __forceinline__ void ph4(Frame& F, const Args& args, int rep) {
    unsigned char* ws = args.ws; const int cid = (int)blockIdx.x;
    pg8::XbOrder S{(const char*)(ws + WS_H1B), (const char*)(ws + WS_MB), F.G, cid};
    pg8::EpiSoftmaxS E{(bf16_t*)(ws + WS_PB), (const float*)(ws + WS_SS1), F.lds + LDS_XTAB};
    pg8::gemm_phase<pg8::EpiSoftmaxS, pg8::XbOrder, false, true>(F.lds, D, D, D / 64, S, E);
}
__device__ __forceinline__ void ph5(Frame& F, const Args& args, int rep) {}
__device__ __forceinline__ void ph6(Frame& F, const Args& args, int rep) {
    unsigned char* ws = args.ws; const int cid = (int)blockIdx.x;
    pg8::XbOrder S{(const char*)(ws + WS_PB), (const char*)(ws + WS_NB), F.G, cid};
    pg8::EpiRes<false, true, true> E{(const void*)(ws + WS_H1B), (bf16_t*)(ws + WS_H2B), (float*)(ws + WS_H2F), rep ? (float*)(ws + WS_DUMMY + 512 * 1024) : (float*)(ws + WS_SS2)};
    pg8::gemm_phase<pg8::EpiRes<false, true, true>, pg8::XbOrder, false, true>(F.lds, D, D, D / 64, S, E);
}
__device__ __forceinline__ void ph7(Frame& F, const Args& args, int rep) { p7_router(F, args, rep); }
__device__ __forceinline__ void ph8(Frame& F, const Args& args, int rep) {
    unsigned char* ws = args.ws; const int cid = (int)blockIdx.x;
    const int ntl = build_tables(F);
    pg8::MoeOrder S{(const char*)(ws + WS_H2B), (const char*)(ws + WS_W1), (const int*)(ws + WS_LIST), (const LAS int*)(F.lds + TL_CNT), (const LAS unsigned char*)(F.lds + TL_TE), (const LAS int*)(F.lds + TL_TS),
                    ntl, 8, F.G, cid, (size_t)2048 * D, 1, (size_t)256 * D, (size_t)256 * D};
    pg8::EpiW1 E{(bf16_t*)(ws + WS_HMID), (const float*)(ws + WS_SS2), args.in[16]};
    pg8::gemm_phase<pg8::EpiW1, pg8::MoeOrder, true, true, true>(F.lds, D / 2, D / 2, D / 128, S, E);
}
__device__ __forceinline__ void ph9(Frame& F, const Args& args, int rep) {
    unsigned char* ws = args.ws; const int cid = (int)blockIdx.x;
    const int ntl = build_tables(F);
    pg8::MoeOrder S{(const char*)(ws + WS_HMID), (const char*)(ws + WS_W2), (const int*)(ws + WS_LIST), (const LAS int*)(F.lds + TL_CNT), (const LAS unsigned char*)(F.lds + TL_TE), (const LAS int*)(F.lds + TL_TS),
                    ntl, 4, F.G, cid, (size_t)D * D, 0, (size_t)256 * D, (size_t)256 * D};
    pg8::EpiW2 E{(unsigned char*)(ws + WS_Y), args.in[18], (const int*)(ws + WS_LIST), (const float*)(ws + WS_GLIST)};
    pg8::gemm_phase<pg8::EpiW2, pg8::MoeOrder, false, true, true>(F.lds, D / 2, D / 2, D / 128, S, E);
}
__device__ __forceinline__ void ph10(Frame& F, const Args& args, int rep) { (void)build_tables(F); p10_combine(F, args); }

constexpr int N_PHASES = 11;
__global__ void __launch_bounds__(NWAVES * 64, 2) hymba_fwd(Args args) {
    extern __shared__ __attribute__((aligned(16))) unsigned char lds_raw[];
    Frame F;
    F.lds = (LAS unsigned char*)lds_raw;
    F.MISC = (volatile LAS unsigned*)(F.lds + TL_MISC);
    F.tid = threadIdx.x; F.lane = F.tid & 63; F.wave = __builtin_amdgcn_readfirstlane(F.tid >> 6);
    F.G = gridDim.x; { const int bx = blockIdx.x; F.vcu = (F.G % 8 == 0) ? (bx % 8) * (F.G / 8) + bx / 8 : bx; }
    F.ctl = (unsigned*)(args.ws + WS_CTL);
    const int lo = args.ph_lo, hi = args.ph_hi;
    for (int u = F.tid; u < 64; u += NWAVES * 64) ((LAS unsigned*)(F.lds + TL_MISC))[u] = 0u;
    __syncthreads();
    const XcdBarrier xbar = xcd_barrier_post(F.ctl + CW_BAR, F.MISC + 8);
#define RUN(k, fn) do { if (((MK_PHASE_MASK >> (k)) & 1) && lo <= (k) && (k) < hi) { fn(F, args, 0); \
        if (MK_REP_PHASE == (k) && MK_REP_N >= 1) { grid_barrier(F, xbar); fn(F, args, 1); } \
        if (MK_REP_PHASE == (k) && MK_REP_N >= 2) { grid_barrier(F, xbar); fn(F, args, 2); } \
        if ((k) + 1 < hi) { if ((k) == 0) cg::this_grid().sync(); else grid_barrier(F, xbar); } } } while (0)
    RUN(0, ph0); RUN(1, ph1); RUN(2, ph2); RUN(3, ph3); RUN(4, ph4);   RUN(6, ph6); RUN(7, ph7); RUN(8, ph8); RUN(9, ph9); RUN(10, ph10);
#undef RUN
}

extern "C" void kernel_launch(void* const* d_in, const int* in_sizes, int n_in, void* d_out, int out_size, void* d_ws, size_t ws_size, hipStream_t stream) {
    static int grid = 0;
    if (grid == 0) {
        if (n_in != 20 || in_sizes[0] != T * D || out_size != T * D || ws_size < WS_END) {
            fprintf(stderr, "kernel_launch: shape/workspace mismatch (n_in %d, in0 %d, out %d, ws %zu, need %zu)\n", n_in, n_in > 0 ? in_sizes[0] : -1, out_size, ws_size, (size_t)WS_END); grid = -1; return; }
        int dev = 0, cus = 0, per_cu = 0;
        if (hipGetDevice(&dev) != hipSuccess || hipDeviceGetAttribute(&cus, hipDeviceAttributeMultiprocessorCount, dev) != hipSuccess) { grid = -1; return; }
        if (hipFuncSetAttribute((const void*)hymba_fwd, hipFuncAttributeMaxDynamicSharedMemorySize, LDS_BYTES) != hipSuccess) { fprintf(stderr, "kernel_launch: hipFuncSetAttribute failed\n"); grid = -1; return; }
        if (hipOccupancyMaxActiveBlocksPerMultiprocessor(&per_cu, (const void*)hymba_fwd, NWAVES * 64, LDS_BYTES) != hipSuccess || per_cu < 1) { fprintf(stderr, "kernel_launch: occupancy query says %d\n", per_cu); }
        (void)hipGetLastError();
        grid = cus;
        if (grid != 256) fprintf(stderr, "kernel_launch: %d CUs; this kernel is built for 256\n", grid);
    }
    if (grid < 0) return;
    (void)hipMemsetAsync((char*)d_ws + WS_CTL, 0, CTL_ZERO_BYTES, stream);
    Args a{};
    for (int i = 0; i < 20; ++i) a.in[i] = (const float*)d_in[i];
    a.out = (float*)d_out; a.ws = (unsigned char*)d_ws;
#if MK_N_LAUNCHES == 1
    a.ph_lo = 0; a.ph_hi = MK_LAST_PHASE + 1;
    void* kargs[] = {&a};
    hipError_t e = hipLaunchCooperativeKernel((const void*)hymba_fwd, dim3(grid), dim3(NWAVES * 64), kargs, LDS_BYTES, stream);
    if (e != hipSuccess) fprintf(stderr, "kernel_launch: cooperative launch failed: %s\n", hipGetErrorString(e));
#else
    for (int p = 0; p <= MK_LAST_PHASE; ++p) { a.ph_lo = p; a.ph_hi = p + 1; hipLaunchKernelGGL(hymba_fwd, dim3(grid), dim3(NWAVES * 64), LDS_BYTES, stream, a); }
#endif
}
```

```cpp
#include <hip/hip_runtime.h>
#include <hip/hip_cooperative_groups.h>
#include <cstdio>
#include <cstdint>
namespace cg = cooperative_groups;

#ifndef MK_N_LAUNCHES
#define MK_N_LAUNCHES 1
#endif
#ifndef MK_LAST_PHASE
#define MK_LAST_PHASE 10
#endif

#define LAS __attribute__((address_space(3)))
#define GAS __attribute__((address_space(1)))
typedef unsigned short bf16_t;
typedef short bf16x8 __attribute__((ext_vector_type(8)));
typedef short s16x4 __attribute__((ext_vector_type(4)));
typedef float f32x4 __attribute__((ext_vector_type(4)));
typedef float f32x2 __attribute__((ext_vector_type(2)));
typedef float f32x16 __attribute__((ext_vector_type(16)));
typedef unsigned u32x4 __attribute__((ext_vector_type(4)));
typedef unsigned u32x2 __attribute__((ext_vector_type(2)));
typedef int v8i32_t __attribute__((ext_vector_type(8)));

constexpr int BATCH = 8, SEQ = 4096, T = BATCH * SEQ, D = 1024, INC = 3584, NMEM = 256, MROWS = BATCH * NMEM;
constexpr int NEXP = 32, TOPK = 4, MT_MAX = T * TOPK / 256 + NEXP, MPAD = MT_MAX * 256;
constexpr float EPS = 1e-6f;
constexpr float LOG2E = 1.4426950408889634f;
constexpr float C2Q = 0.125f * LOG2E;
constexpr float C2X = 0.0625f * LOG2E;
constexpr int C_MQ = 0, C_MK = 512, C_MV = 1024, C_GQ = 1536, C_GF = 2048, C_GI = 2560, C_GG = 3072;

constexpr size_t MiB = 1u << 20;
constexpr size_t WS_CTL = 0, CTL_ZERO_BYTES = 2 * MiB;
constexpr size_t WS_KBAR = 1 * MiB;
constexpr size_t WS_SS1 = 1 * MiB + 256 * 1024;
constexpr size_t WS_SS2 = 1 * MiB + 384 * 1024;
constexpr size_t WS_TOKE = 2 * MiB, WS_TOKR = 2 * MiB + 512 * 1024, WS_TOKG = 3 * MiB;
constexpr size_t WS_WRT = 3 * MiB + 512 * 1024;
constexpr size_t WS_LIST = 4 * MiB;
constexpr size_t WS_GLIST = 8 * MiB;
constexpr size_t WS_WIN = 16 * MiB, WS_WOUT = 23 * MiB, WS_WQ = 25 * MiB, WS_WKV = 27 * MiB, WS_WO = 31 * MiB;
constexpr size_t WS_MN = 33 * MiB, WS_MEMK = 37 * MiB, WS_MEMVT = 41 * MiB;
constexpr size_t WS_W1 = 48 * MiB, WS_W2 = 176 * MiB;
constexpr size_t WS_PROJ = 240 * MiB;
constexpr size_t SEC_ELEMS = (size_t)16 * 1024 * 1024;
constexpr size_t WS_XN = 464 * MiB;
constexpr size_t WS_OX = 464 * MiB;
constexpr size_t WS_MIX = 528 * MiB;
constexpr size_t WS_H1B = 592 * MiB;
constexpr size_t WS_QX = 656 * MiB;
constexpr size_t WS_PWS = 720 * MiB;
constexpr size_t WS_HMID = 240 * MiB;
constexpr size_t WS_Y = 512 * MiB;
constexpr size_t WS_H2F = 784 * MiB;
constexpr size_t WS_H2B = 912 * MiB;
constexpr size_t WS_DUMMY = 976 * MiB;
constexpr size_t WS_END = 988 * MiB;
static_assert(WS_HMID + (size_t)MPAD * D * 2 <= WS_Y && WS_Y + (size_t)MPAD * D * 2 <= WS_H2F, "ws map");
constexpr int CW_TMO = 0;
constexpr int CW_CNT = 64;
constexpr int CW_QUEUE = 128;
constexpr int CW_BAR = 4096;

__device__ __forceinline__ unsigned f2bf(float f) { unsigned u = __builtin_bit_cast(unsigned, f); return (u + 0x7fffu + ((u >> 16) & 1u)) >> 16; }
__device__ __forceinline__ unsigned pk2(float lo, float hi) { return f2bf(lo) | (f2bf(hi) << 16); }
__device__ __forceinline__ float bf2f(unsigned short h) { return __builtin_bit_cast(float, (unsigned)h << 16); }
__device__ __forceinline__ float bflo(unsigned w) { return __builtin_bit_cast(float, w << 16); }
__device__ __forceinline__ float bfhi(unsigned w) { return __builtin_bit_cast(float, w & 0xffff0000u); }
typedef float f32x2_t __attribute__((ext_vector_type(2))); typedef __bf16 bf16x2_t __attribute__((ext_vector_type(2)));
__device__ __forceinline__ unsigned cvtpk(float lo, float hi) { f32x2_t v = {lo, hi}; bf16x2_t b = __builtin_convertvector(v, bf16x2_t); return __builtin_bit_cast(unsigned, b); }
__device__ __forceinline__ float wave_sum(float v) {
#pragma unroll
    for (int o = 1; o < 64; o <<= 1) v += __shfl_xor(v, o);
    return v;
}
__device__ __forceinline__ float fast_exp2(float x) { return __builtin_amdgcn_exp2f(x); }
__device__ __forceinline__ float fast_rcp(float x) { return __builtin_amdgcn_rcpf(x); }
__device__ __forceinline__ float silu_f(float x) { return x * fast_rcp(1.0f + fast_exp2(-x * LOG2E)); }
__device__ __forceinline__ unsigned pk4_fp8(float a, float b, float c, float d) { int w = 0; w = __builtin_amdgcn_cvt_pk_fp8_f32(a, b, w, false); w = __builtin_amdgcn_cvt_pk_fp8_f32(c, d, w, true); return (unsigned)w; }
constexpr float XSCALE8 = 4.0f, XSCALE8_INV = 0.25f, PSCALE8 = 256.0f, PSCALE8_INV = 1.0f / 256.0f;
constexpr float WSCALE8 = 32.0f, WSCALE8_INV = 1.0f / 32.0f;
#define LDS_WAIT() asm volatile("s_waitcnt lgkmcnt(0)" ::: "memory")
#define VM_WAIT() asm volatile("s_waitcnt vmcnt(0)" ::: "memory")
#define RLX_AGENT __ATOMIC_RELAXED, __HIP_MEMORY_SCOPE_AGENT

namespace pg8 {
constexpr int BM = 256, BK = 64, HALF = 128, HTB = HALF * BK * 2, STAGE_BYTES = 8 * HTB;
__device__ __forceinline__ void glds16s(const char* sbase, unsigned voff, unsigned lds_dst) { unsigned keep;
    asm volatile("s_mov_b32 %0, m0\n\ts_mov_b32 m0, %3\n\ts_nop 0\n\tglobal_load_lds_dwordx4 %1, %2\n\ts_mov_b32 m0, %0" : "=&s"(keep) : "v"(voff), "s"(sbase), "s"(lds_dst) : "memory"); }
__host__ __device__ __forceinline__ int lds_byte(int r, int c) { const int st = (r >> 4) * 2 + (c >> 5), rr = r & 15, cc = c & 31, ob = rr * 64 + cc * 2; return st * 1024 + (ob ^ (((ob >> 9) & 1) << 5)); }
__host__ __device__ __forceinline__ void stage_rc(int b, int& R, int& C) { const int st = b / 1024, sb = b % 1024, swz = sb ^ (((sb >> 9) & 1) << 5); R = (st >> 1) * 16 + swz / 64; C = (st & 1) * 32 + (swz % 64) / 2; }
__host__ __device__ __forceinline__ int perm32(int rho) { const int n = rho >> 4, i = rho & 15; return 8 * (i >> 2) + 4 * n + (i & 3); }

struct Unit { const char* A; const char* B; const int* rows; int pm, pn, aux, nrows; };

template <class Epi, class Sched, bool GATHER, bool ALIGN_EPI, bool FP8 = false>
__device__ __forceinline__ void gemm_phase(LAS unsigned char* lds, const int lda, const int ldb, const int nt_in, const Sched& S, const Epi& E) {
    int nt = nt_in; asm volatile("" : "+s"(nt));
    int tid_ = threadIdx.x; asm volatile("" : "+v"(tid_));
    const int tid = tid_, wid = __builtin_amdgcn_readfirstlane(tid >> 6), lane = tid & 63, wr = wid >> 2, wc = wid & 3, fr = lane & 15, fq = lane >> 4;
    unsigned offB0; { int R, C; stage_rc(tid * 16, R, C); const int Rb = Epi::PERM ? ((R & ~31) + perm32(R & 31)) : R; offB0 = (unsigned)(Rb * ldb + C) * 2u; }
    const size_t pstepB = (size_t)64 * ldb * 2;
    const size_t kstep = (size_t)(BK * 2);
    const size_t hstepB = (size_t)HALF * ldb * 2;
    const unsigned ldsb = (unsigned)__builtin_amdgcn_readfirstlane((int)((unsigned)(uintptr_t)(unsigned char*)lds + (unsigned)wid * 1024u));
    const int aoff = lds_byte(wr * 64 + fr, FP8 ? fq * 16 : fq * 8), boff = lds_byte(wc * 32 + fr, FP8 ? fq * 16 : fq * 8);
#define PG8_SA(b, h) (((b) * 2 + (h)) * HTB)
#define PG8_SB(b, h) ((4 + (b) * 2 + (h)) * HTB)
#define PG8_STGB(bufoff, gbase) do { glds16s((const char*)(gbase), offB0, ldsb + (unsigned)(bufoff)); glds16s((const char*)(gbase) + pstepB, offB0, ldsb + (unsigned)(bufoff) + 8192u); } while (0)
#define PG8_LD16(p_) (*(const LAS u32x4*)(p_))
#define PG8_CAT(x, y) __builtin_bit_cast(v8i32_t, __builtin_shufflevector(x, y, 0, 1, 2, 3, 4, 5, 6, 7))
    unsigned aA0 = (unsigned)(aoff + PG8_SA(0, 0)), aA1 = (unsigned)(aoff + PG8_SA(1, 0)), bB0 = (unsigned)(boff + PG8_SB(0, 0)), bB1 = (unsigned)(boff + PG8_SB(1, 0));
    asm volatile("" : "+v"(aA0), "+v"(aA1), "+v"(bB0), "+v"(bB1));
    int scl8 = 0x7f7f7f7f; asm volatile("" : "+v"(scl8));
#define PG8_LDA(dst, b, h) do { const LAS unsigned char* ap_ = lds + ((b) ? aA1 : aA0) + (h) * HTB; _Pragma("unroll") for (int m = 0; m < 4; ++m) { \
        if constexpr (FP8) { dst##8[m] = PG8_CAT(PG8_LD16(ap_ + m * 2048), PG8_LD16(ap_ + m * 2048 + 16)); } \
        else { _Pragma("unroll") for (int k = 0; k < 2; ++k) dst[m][k] = *(const LAS bf16x8*)(ap_ + m * 2048 + k * 1024); } } } while (0)
#define PG8_LDB(dst, b, h) do { const LAS unsigned char* bp_ = lds + ((b) ? bB1 : bB0) + (h) * HTB; _Pragma("unroll") for (int n = 0; n < 2; ++n) { \
        if constexpr (FP8) { dst##8[n] = PG8_CAT(PG8_LD16(bp_ + n * 2048), PG8_LD16(bp_ + n * 2048 + 16)); } \
        else { _Pragma("unroll") for (int k = 0; k < 2; ++k) dst[n][k] = *(const LAS bf16x8*)(bp_ + n * 2048 + k * 1024); } } } while (0)
#define PG8_MMA(ai, bj, At, Bt) do { __builtin_amdgcn_s_setprio(1); _Pragma("unroll") for (int m = 0; m < 4; ++m) _Pragma("unroll") for (int n = 0; n < 2; ++n) { \
        if constexpr (FP8) asm volatile("v_mfma_scale_f32_16x16x128_f8f6f4 %0, %1, %2, %0, %3, %3 op_sel_hi:[0,0,0]" : "+v"(acc[ai][bj][m][n]) : "v"(Bt##8[n]), "v"(At##8[m]), "v"(scl8));   \
        else { _Pragma("unroll") for (int k = 0; k < 2; ++k) acc[ai][bj][m][n] = __builtin_amdgcn_mfma_f32_16x16x32_bf16(Bt[n][k], At[m][k], acc[ai][bj][m][n], 0, 0, 0); } } \
        __builtin_amdgcn_s_setprio(0); } while (0)
#define PG8_WAIT_V(n) asm volatile("s_waitcnt vmcnt(" #n ")" ::: "memory")
#define PG8_WAIT_L(n) asm volatile("s_waitcnt lgkmcnt(" #n ")" ::: "memory")
#define PG8_BAR __builtin_amdgcn_s_barrier()
#define PG8_SCHED __builtin_amdgcn_sched_barrier(0)
    unsigned voffA0, c2, pkc[2], pkn[2];
    { int R, C; stage_rc(tid * 16, R, C); voffA0 = (unsigned)(R * lda + C) * 2u; c2 = (unsigned)C * 2u; }
    const size_t hstepA = (size_t)HALF * lda * 2, pstepA = (size_t)64 * lda * 2;
    const unsigned lda2 = (unsigned)lda * 2u;
#define PG8_PKROWS(dst, u) do { if (GATHER) { _Pragma("unroll") for (int i_ = 0; i_ < 2; ++i_) { int R_, C_; stage_rc(tid * 16 + i_ * 8192, R_, C_); \
        const int nr_ = (u).nrows - 1; const int r0_ = R_ < nr_ ? R_ : nr_, r1_ = (R_ + HALF) < nr_ ? (R_ + HALF) : nr_; \
        dst[i_] = (unsigned)(u).rows[r0_] | ((unsigned)(u).rows[r1_] << 16); } } } while (0)
#define PG8_STGA(bufoff, gbase, h, NX) do { \
        if (GATHER) { const unsigned p0_ = (NX) ? pkn[0] : pkc[0], p1_ = (NX) ? pkn[1] : pkc[1]; \
            const unsigned o0_ = ((h) ? (p0_ >> 16) : (p0_ & 0xffffu)) * lda2 + c2, o1_ = ((h) ? (p1_ >> 16) : (p1_ & 0xffffu)) * lda2 + c2; \
            glds16s((const char*)(gbase), o0_, ldsb + (unsigned)(bufoff)); glds16s((const char*)(gbase), o1_, ldsb + (unsigned)(bufoff) + 8192u); } \
        else { const char* gb_ = (const char*)(gbase) + ((h) ? hstepA : (size_t)0); glds16s(gb_, voffA0, ldsb + (unsigned)(bufoff)); glds16s(gb_ + pstepA, voffA0, ldsb + (unsigned)(bufoff) + 8192u); } } while (0)
    Unit cur, nxt; int ui = 0;
    if (!S.next(0, cur)) return;
    f32x4 acc[2][2][4][2];
#pragma unroll
    for (int a = 0; a < 2; ++a)
#pragma unroll
        for (int b = 0; b < 2; ++b)
#pragma unroll
            for (int m = 0; m < 4; ++m)
#pragma unroll
                for (int n = 0; n < 2; ++n) acc[a][b][m][n] = (f32x4){0.f, 0.f, 0.f, 0.f};
    bf16x8 At[4][2], B0[2][2], B1[2][2]; v8i32_t At8[4], B08[2], B18[2];
    pkc[0] = pkc[1] = pkn[0] = pkn[1] = 0u;
    PG8_PKROWS(pkc, cur);
    const char* cA = cur.A; const char* cB = cur.B;
    PG8_STGB(PG8_SB(0, 0), cB); PG8_STGB(PG8_SB(0, 1), cB + hstepB); PG8_STGA(PG8_SA(0, 0), cA, 0, false); PG8_STGA(PG8_SA(0, 1), cA, 1, false);
    if (wr == 1) PG8_BAR;
    PG8_WAIT_V(2); PG8_BAR;
    PG8_STGB(PG8_SB(1, 0), cB + kstep); PG8_STGA(PG8_SA(1, 0), cA + kstep, 0, false); PG8_STGB(PG8_SB(1, 1), cB + hstepB + kstep);
    PG8_WAIT_V(6); PG8_BAR;
    for (;;) {
        const bool has_next = S.next(ui + 1, nxt);
        if (GATHER) { if (has_next) { PG8_PKROWS(pkn, nxt); } else { pkn[0] = pkc[0]; pkn[1] = pkc[1]; } }
        const char* nA = has_next ? nxt.A : cA; const char* nB = has_next ? nxt.B : cB;
        typename Epi::Pre pre; { int t_p = threadIdx.x; asm volatile("" : "+v"(t_p)); E.prefetch(cur, wr, t_p & 15, pre); }
        for (int t = 0; t < nt; t += 2) {
            const bool last = (t == nt - 2);
            const char* a1 = cA + (size_t)(t + 1) * kstep;
            const char* a2 = last ? nA : cA + (size_t)(t + 2) * kstep; const char* b2 = last ? nB : cB + (size_t)(t + 2) * kstep;
            const char* a3 = a2 + kstep; const char* b3 = b2 + kstep;
            PG8_LDB(B0, 0, 0); PG8_LDB(B1, 0, 1); PG8_SCHED; PG8_LDA(At, 0, 0); PG8_STGA(PG8_SA(1, 1), a1, 1, false);
            PG8_WAIT_V(8); PG8_WAIT_L(0); PG8_BAR; PG8_MMA(0, 0, At, B0); PG8_MMA(0, 1, At, B1); PG8_BAR; PG8_SCHED;
            PG8_LDA(At, 0, 1); PG8_STGB(PG8_SB(0, 0), b2); PG8_STGB(PG8_SB(0, 1), b2 + hstepB); PG8_STGA(PG8_SA(0, 0), a2, 0, last);
            PG8_WAIT_V(8); PG8_WAIT_L(0); PG8_BAR; PG8_MMA(1, 0, At, B0); PG8_MMA(1, 1, At, B1); PG8_BAR; PG8_SCHED;
            PG8_LDB(B0, 1, 0); PG8_LDB(B1, 1, 1); PG8_SCHED; PG8_LDA(At, 1, 0); PG8_STGA(PG8_SA(0, 1), a2, 1, last);
            PG8_WAIT_V(8); PG8_WAIT_L(0); PG8_BAR; PG8_MMA(0, 0, At, B0); PG8_MMA(0, 1, At, B1); PG8_BAR; PG8_SCHED;
            PG8_LDA(At, 1, 1); PG8_STGB(PG8_SB(1, 0), b3); PG8_STGB(PG8_SB(1, 1), b3 + hstepB); PG8_STGA(PG8_SA(1, 0), a3, 0, last);
            PG8_WAIT_V(8); PG8_WAIT_L(0); PG8_BAR; PG8_MMA(1, 0, At, B0); PG8_MMA(1, 1, At, B1); PG8_BAR; PG8_SCHED;
        }
        if constexpr (ALIGN_EPI) { if (wr == 0) PG8_BAR; }
        if constexpr (FP8) asm volatile("s_nop 15\n\ts_nop 15" ::: "memory");
        if constexpr (!Epi::AFTER_DRAIN) { int t_e = threadIdx.x; asm volatile("" : "+v"(t_e)); const int fr_e = t_e & 15, fq_e = (t_e >> 4) & 3; E(acc, cur, wr, wc, fr_e, fq_e, pre); }
        if (!has_next) break;
#pragma unroll
        for (int a = 0; a < 2; ++a)
#pragma unroll
            for (int b = 0; b < 2; ++b)
#pragma unroll
                for (int m = 0; m < 4; ++m)
#pragma unroll
                    for (int n = 0; n < 2; ++n) acc[a][b][m][n] = (f32x4){0.f, 0.f, 0.f, 0.f};
        cur = nxt; cA = nA; cB = nB; ++ui;
        if (GATHER) { pkc[0] = pkn[0]; pkc[1] = pkn[1]; }
        if constexpr (ALIGN_EPI) { if (wr == 1) PG8_BAR; }
    }
    PG8_WAIT_V(0);
    if constexpr (!ALIGN_EPI) { if (wr == 0) PG8_BAR; }
    PG8_BAR;
    if constexpr (Epi::AFTER_DRAIN) { int t_e = threadIdx.x; asm volatile("" : "+v"(t_e)); const int fr_e = t_e & 15, fq_e = (t_e >> 4) & 3; E.fused(acc, cur, wr, wc, fr_e, fq_e, lds, wid, t_e & 63); }
#undef PG8_SA
#undef PG8_SB
#undef PG8_STGB
#undef PG8_LDA
#undef PG8_LDB
#undef PG8_MMA
#undef PG8_CAT
#undef PG8_LD16
#undef PG8_WAIT_V
#undef PG8_WAIT_L
#undef PG8_SCHED
#undef PG8_PKROWS
#undef PG8_STGA
}
}

namespace pg8 {
constexpr int NXCD = 8, WGM = 8;
__device__ __forceinline__ void tile_order(int L, int nM, int nN, int& pm, int& pn) {
    const int nwg = nM * nN; int wgid = L;
    { const int q = nwg / NXCD, r = nwg % NXCD, xcd = wgid % NXCD, off = wgid / NXCD; wgid = (xcd < r ? xcd * (q + 1) : r * (q + 1) + (xcd - r) * q) + off; }
    const int nig = WGM * nN, gid = wgid / nig, fm = gid * WGM, gsz = (nM - fm) < WGM ? (nM - fm) : WGM;
    pm = fm + ((wgid % nig) % gsz); pn = (wgid % nig) / gsz;
}
struct DenseOrder {
    const char* A; const char* B; int lda, ldb, nM, nN, G, c;
    __device__ __forceinline__ bool next(int i, Unit& u) const {
        const long L = (long)i * G + c; if (L >= (long)nM * nN) return false;
        int pm, pn; tile_order((int)L, nM, nN, pm, pn);
        u.pm = pm; u.pn = pn; u.aux = 0; u.rows = nullptr; u.nrows = 256;
        u.A = A + (size_t)pm * 256 * lda * 2; u.B = B + (size_t)pn * 256 * ldb * 2; return true;
    }
};
struct KvOrder {
    const char* MN; const char* W; int L0;
    __device__ __forceinline__ bool next(int i, Unit& u) const {
        const int L = L0; if (i > 0 || L >= 64) return false;
        u.rows = nullptr; u.nrows = 256; u.pm = L >> 3; const int ct = L & 7; u.aux = ct >> 2; u.pn = ct & 3;
        u.A = MN + (size_t)u.pm * 256 * D * 2; u.B = W + (size_t)ct * 256 * D * 2; return true;
    }
};
struct XmnOrder {
    const char* MK; const char* MV; const char* WQN; const char* WOT; int G, c;
    __device__ __forceinline__ bool next(int i, Unit& u) const {
        const int L = c + i * G; if (L >= 256) return false;
        u.rows = nullptr; u.nrows = 256;
        if (L < 128) { const int b = L >> 4, h = (L >> 2) & 3, kt = L & 3; u.aux = 0; u.pm = b * 4 + h; u.pn = kt;
            u.A = MK + ((size_t)(b * 256) * D + h * 256) * 2; u.B = WQN + ((size_t)(kt * 256) * D + h * 256) * 2; }
        else { const int l = L - 128, b = l >> 4, nt = (l >> 2) & 3, h = l & 3; u.aux = 1; u.pm = b * 4 + nt; u.pn = h;
            u.A = WOT + ((size_t)(nt * 256) * D + h * 256) * 2; u.B = MV + ((size_t)(b * 256) * D + h * 256) * 2; }
        return true;
    }
};
struct XbOrder {
    const char* A; const char* Bb; int G, c; size_t rb;
    __device__ __forceinline__ bool next(int i, Unit& u) const {
        const long L = (long)i * G + c; if (L >= 512) return false;
        int pm, pn; tile_order((int)L, T / 256, 4, pm, pn);
        u.pm = pm; u.pn = pn; u.aux = 0; u.rows = nullptr; u.nrows = 256;
        u.A = A + (size_t)pm * 256 * rb; u.B = Bb + (size_t)(pm >> 4) * D * rb + (size_t)pn * 256 * rb; return true;
    }
};
struct MoeOrder {
    const char* A; const char* W; const int* list; const LAS int* cnt; const LAS unsigned char* te; const LAS int* ts;
    int ntiles, nN, G, c; size_t wstride; int gather; size_t atile, btile;
    __device__ __forceinline__ bool next(int i, Unit& u) const {
        const long L = (long)i * G + c; if (L >= (long)ntiles * nN) return false;
        int pm, pn; tile_order((int)L, ntiles, nN, pm, pn);
        const int e = __builtin_amdgcn_readfirstlane((int)te[pm]);
        const int lt = pm - __builtin_amdgcn_readfirstlane(ts[e]);
        const int n = __builtin_amdgcn_readfirstlane(cnt[e]) - lt * 256;
        u.pm = pm; u.pn = pn; u.aux = e; u.nrows = n < 256 ? n : 256;
        u.rows = list + (size_t)e * T + lt * 256;
        u.A = gather ? A : A + (size_t)pm * atile;
        u.B = W + (size_t)e * wstride + (size_t)pn * btile; return true;
    }
};

struct EpiProj {
    static constexpr bool PERM = true, AFTER_DRAIN = false; struct Pre {}; __device__ __forceinline__ void prefetch(const Unit&, int, int, Pre&) const {}
    bf16_t* O; float* kbar;
    __device__ __forceinline__ void operator()(const f32x4 (&acc)[2][2][4][2], const Unit& u, int wr, int wc, int fr, int fq, const Pre&) const {
        const int pn = u.pn, sec = pn >> 1, b = u.pm >> 4, t0 = (u.pm & 15) * 256 + wr * 64 + fr;
        const int mode = (pn < 2) ? 1 : ((pn == 6 || pn == 7 || pn >= 12) ? 2 : 0);
        bf16_t* sb = O + (size_t)sec * SEC_ELEMS;
#pragma unroll
        for (int bj = 0; bj < 2; ++bj) {
            const int c = bj * HALF + wc * 32 + 8 * fq, head = (pn & 1) * 4 + (c >> 6), d0 = c & 63;
            bf16_t* hb = sb + (size_t)(b * 8 + head) * (SEQ * 64);
#pragma unroll
            for (int ai = 0; ai < 2; ++ai)
#pragma unroll
                for (int m = 0; m < 4; ++m) { const int t = t0 + ai * HALF + m * 16;
                    f32x4 v0 = acc[ai][bj][m][0], v1 = acc[ai][bj][m][1];
                    if (mode == 1) { v0 = v0 * C2Q; v1 = v1 * C2Q; }
                    else if (mode == 2) {
#pragma unroll
                        for (int e = 0; e < 4; ++e) { v0[e] = silu_f(v0[e]); v1[e] = silu_f(v1[e]); } }
                    u32x4 w; w.x = cvtpk(v0[0], v0[1]); w.y = cvtpk(v0[2], v0[3]); w.z = cvtpk(v1[0], v1[1]); w.w = cvtpk(v1[2], v1[3]);
                    size_t off;
                    if (sec == 1) off = (size_t)(t >> 6) * 4096 + (d0 >> 3) * 512 + (t & 63) * 8;
                    else if (sec == 2) off = (size_t)(t >> 6) * 4096 + (d0 >> 5) * 2048 + (t & 63) * 32 + (d0 & 31);
                    else off = (size_t)t * 64 + d0;
                    *(u32x4*)(hb + off) = w; } }
        if (pn == 2 || pn == 3) {
#pragma unroll
            for (int bj = 0; bj < 2; ++bj)
#pragma unroll
                for (int n = 0; n < 2; ++n)
#pragma unroll
                    for (int e = 0; e < 4; ++e) { float s = 0.f;
#pragma unroll
                        for (int ai = 0; ai < 2; ++ai)
#pragma unroll
                            for (int m = 0; m < 4; ++m) s += acc[ai][bj][m][n][e];
                        s += __shfl_xor(s, 1); s += __shfl_xor(s, 2); s += __shfl_xor(s, 4); s += __shfl_xor(s, 8);
                        if (fr == 0) { const int c = bj * HALF + wc * 32 + 8 * fq + 4 * n + e, head = (pn - 2) * 4 + (c >> 6), d = c & 63;
                            atomicAdd(kbar + ((size_t)u.pm * 8 + head) * 64 + d, s); } }
        }
    }
};
struct EpiBf16 {
    static constexpr bool PERM = true, AFTER_DRAIN = false; struct Pre {}; __device__ __forceinline__ void prefetch(const Unit&, int, int, Pre&) const {}
    bf16_t* O0; int ldc0; bf16_t* O1; int ldc1;
    __device__ __forceinline__ void operator()(const f32x4 (&acc)[2][2][4][2], const Unit& u, int wr, int wc, int fr, int fq, const Pre&) const {
        bf16_t* O = u.aux ? O1 : O0; const int ldc = u.aux ? ldc1 : ldc0;
        const int row0 = u.pm * BM + wr * 64 + fr, col0 = u.pn * BM + wc * 32 + 8 * fq;
#pragma unroll
        for (int ai = 0; ai < 2; ++ai)
#pragma unroll
            for (int m = 0; m < 4; ++m) { bf16_t* rowp = O + (size_t)(row0 + ai * HALF + m * 16) * ldc + col0;
#pragma unroll
                for (int bj = 0; bj < 2; ++bj) { const f32x4 v0 = acc[ai][bj][m][0], v1 = acc[ai][bj][m][1];
                    u32x4 w; w.x = cvtpk(v0[0], v0[1]); w.y = cvtpk(v0[2], v0[3]); w.z = cvtpk(v1[0], v1[1]); w.w = cvtpk(v1[2], v1[3]);
                    *(u32x4*)(rowp + bj * HALF) = w; } }
    }
};
struct EpiFp8 {
    static constexpr bool PERM = true, AFTER_DRAIN = false; struct Pre {}; __device__ __forceinline__ void prefetch(const Unit&, int, int, Pre&) const {}
    unsigned char* O0; int ldc0; unsigned char* O1; int ldc1; float scale;
    __device__ __forceinline__ void operator()(const f32x4 (&acc)[2][2][4][2], const Unit& u, int wr, int wc, int fr, int fq, const Pre&) const {
        unsigned char* O = u.aux ? O1 : O0; const int ldc = u.aux ? ldc1 : ldc0;
        const int row0 = u.pm * BM + wr * 64 + fr, col0 = u.pn * BM + wc * 32 + 8 * fq;
#pragma unroll
        for (int ai = 0; ai < 2; ++ai)
#pragma unroll
            for (int m = 0; m < 4; ++m) { unsigned char* rowp = O + (size_t)(row0 + ai * HALF + m * 16) * ldc + col0;
#pragma unroll
                for (int bj = 0; bj < 2; ++bj) { const f32x4 v0 = acc[ai][bj][m][0] * scale, v1 = acc[ai][bj][m][1] * scale;
                    *(u32x2*)(rowp + bj * HALF) = (u32x2){pk4_fp8(v0[0], v0[1], v0[2], v0[3]), pk4_fp8(v1[0], v1[1], v1[2], v1[3])}; } }
    }
};
template <bool BASE_F32, bool WRITE_F32, bool OUT_FP8 = false> struct EpiRes {
    static constexpr bool PERM = true, AFTER_DRAIN = false; struct Pre {}; __device__ __forceinline__ void prefetch(const Unit&, int, int, Pre&) const {}
    const void* base; bf16_t* Ob; float* Of; float* ss; float asc; unsigned char* Oq;
    __device__ __forceinline__ void operator()(const f32x4 (&acc)[2][2][4][2], const Unit& u, int wr, int wc, int fr, int fq, const Pre&) const {
        const int row0 = u.pm * BM + wr * 64 + fr, col0 = u.pn * BM + wc * 32 + 8 * fq;
#pragma unroll
        for (int ai = 0; ai < 2; ++ai)
#pragma unroll
            for (int m = 0; m < 4; ++m) { const int row = row0 + ai * HALF + m * 16; const size_t off = (size_t)row * D + col0; float sq = 0.f;
#pragma unroll
                for (int bj = 0; bj < 2; ++bj) { f32x4 b0, b1;
                    if (BASE_F32) { b0 = *(const f32x4*)((const float*)base + off + bj * HALF); b1 = *(const f32x4*)((const float*)base + off + bj * HALF + 4); }
                    else { const u32x4 w = *(const u32x4*)((const bf16_t*)base + off + bj * HALF);
                        b0 = (f32x4){bflo(w.x), bfhi(w.x), bflo(w.y), bfhi(w.y)}; b1 = (f32x4){bflo(w.z), bfhi(w.z), bflo(w.w), bfhi(w.w)}; }
                    const f32x4 v0 = acc[ai][bj][m][0] * asc + b0, v1 = acc[ai][bj][m][1] * asc + b1;
                    sq += (v0[0] * v0[0] + v0[1] * v0[1]) + (v0[2] * v0[2] + v0[3] * v0[3]) + (v1[0] * v1[0] + v1[1] * v1[1]) + (v1[2] * v1[2] + v1[3] * v1[3]);
                    if (OUT_FP8) { *(u32x2*)((unsigned char*)Ob + off + bj * HALF) = (u32x2){pk4_fp8(v0[0], v0[1], v0[2], v0[3]), pk4_fp8(v1[0], v1[1], v1[2], v1[3])}; }
                    else { u32x4 w; w.x = cvtpk(v0[0], v0[1]); w.y = cvtpk(v0[2], v0[3]); w.z = cvtpk(v1[0], v1[1]); w.w = cvtpk(v1[2], v1[3]);
                    *(u32x4*)(Ob + off + bj * HALF) = w; }
                    if (Oq) *(u32x2*)(Oq + off + bj * HALF) = (u32x2){pk4_fp8(v0[0], v0[1], v0[2], v0[3]), pk4_fp8(v1[0], v1[1], v1[2], v1[3])};
                    if (WRITE_F32) { *(f32x4*)(Of + off + bj * HALF) = v0; *(f32x4*)(Of + off + bj * HALF + 4) = v1; } }
                sq += __shfl_xor(sq, 16); sq += __shfl_xor(sq, 32);
                if (fq == 0) atomicAdd(ss + row, sq); }
    }
};
struct EpiQ {
    static constexpr bool PERM = true, AFTER_DRAIN = false; struct Pre {}; __device__ __forceinline__ void prefetch(const Unit&, int, int, Pre&) const {}
    bf16_t* O; const float* ss;
    __device__ __forceinline__ void operator()(const f32x4 (&acc)[2][2][4][2], const Unit& u, int wr, int wc, int fr, int fq, const Pre&) const {
        const int row0 = u.pm * BM + wr * 64 + fr, col0 = u.pn * BM + wc * 32 + 8 * fq;
#pragma unroll
        for (int ai = 0; ai < 2; ++ai)
#pragma unroll
            for (int m = 0; m < 4; ++m) { const int row = row0 + ai * HALF + m * 16; const float sc = C2X * __builtin_amdgcn_rsqf(ss[row] * (1.0f / D) + EPS);
                bf16_t* rowp = O + (size_t)row * D + col0;
#pragma unroll
                for (int bj = 0; bj < 2; ++bj) { const f32x4 v0 = acc[ai][bj][m][0] * sc, v1 = acc[ai][bj][m][1] * sc;
                    u32x4 w; w.x = cvtpk(v0[0], v0[1]); w.y = cvtpk(v0[2], v0[3]); w.z = cvtpk(v1[0], v1[1]); w.w = cvtpk(v1[2], v1[3]);
                    *(u32x4*)(rowp + bj * HALF) = w; } }
    }
};
struct EpiSoftmaxS {
    static constexpr bool PERM = true, AFTER_DRAIN = false; struct Pre {}; __device__ __forceinline__ void prefetch(const Unit&, int, int, Pre&) const {}
    unsigned char* P; const float* ss; LAS unsigned char* tb; float qs;
    __device__ __forceinline__ void operator()(f32x4 (&acc)[2][2][4][2], const Unit& u, int wr, int wc, int fr, int fq, const Pre&) const {
        LAS float* MX = (LAS float*)tb;
        LAS float* SM = (LAS float*)(tb + 4096);
#pragma unroll
        for (int ai = 0; ai < 2; ++ai)
#pragma unroll
            for (int m = 0; m < 4; ++m) { const int r = ai * HALF + wr * 64 + m * 16 + fr; const float sc = qs * C2X * __builtin_amdgcn_rsqf(ss[u.pm * BM + r] * (1.0f / D) + EPS); float mx = -3.0e38f;
#pragma unroll
                for (int bj = 0; bj < 2; ++bj)
#pragma unroll
                    for (int n = 0; n < 2; ++n) { f32x4 x = acc[ai][bj][m][n] * sc; acc[ai][bj][m][n] = x; mx = fmaxf(mx, fmaxf(fmaxf(x[0], x[1]), fmaxf(x[2], x[3]))); }
                mx = fmaxf(mx, __shfl_xor(mx, 16)); mx = fmaxf(mx, __shfl_xor(mx, 32));
                if (fq == 0) MX[r * 4 + wc] = mx; }
        LDS_WAIT(); __builtin_amdgcn_s_barrier(); asm volatile("" ::: "memory");
#pragma unroll
        for (int ai = 0; ai < 2; ++ai)
#pragma unroll
            for (int m = 0; m < 4; ++m) { const int r = ai * HALF + wr * 64 + m * 16 + fr; const f32x4 q = *(const LAS f32x4*)(MX + r * 4);
                const float mx = fmaxf(fmaxf(q[0], q[1]), fmaxf(q[2], q[3])); float sm = 0.f;
#pragma unroll
                for (int bj = 0; bj < 2; ++bj)
#pragma unroll
                    for (int n = 0; n < 2; ++n) { f32x4 x = acc[ai][bj][m][n];
#pragma unroll
                        for (int e = 0; e < 4; ++e) { x[e] = fast_exp2(x[e] - mx); sm += x[e]; }
                        acc[ai][bj][m][n] = x; }
                sm += __shfl_xor(sm, 16); sm += __shfl_xor(sm, 32);
                if (fq == 0) SM[r * 4 + wc] = sm; }
        LDS_WAIT(); __builtin_amdgcn_s_barrier(); asm volatile("" ::: "memory");
        const int col0 = u.pn * BM + wc * 32 + 8 * fq;
#pragma unroll
        for (int ai = 0; ai < 2; ++ai)
#pragma unroll
            for (int m = 0; m < 4; ++m) { const int r = ai * HALF + wr * 64 + m * 16 + fr; const f32x4 q = *(const LAS f32x4*)(SM + r * 4);
                const float inv = PSCALE8 * fast_rcp((q[0] + q[1]) + (q[2] + q[3]));
#pragma unroll
                for (int bj = 0; bj < 2; ++bj) { const f32x4 v0 = acc[ai][bj][m][0] * inv, v1 = acc[ai][bj][m][1] * inv;
                    *(u32x2*)(P + ((size_t)u.pm * BM + r) * D + bj * HALF + col0) = (u32x2){pk4_fp8(v0[0], v0[1], v0[2], v0[3]), pk4_fp8(v1[0], v1[1], v1[2], v1[3])}; } }
        LDS_WAIT(); __builtin_amdgcn_s_barrier(); asm volatile("" ::: "memory");
    }
};
struct EpiW1 {
    static constexpr bool PERM = true, AFTER_DRAIN = false;
    struct Pre { float sc[8]; };
    bf16_t* O; const float* ss; const float* b1;
    __device__ __forceinline__ void prefetch(const Unit& u, int wr, int fr, Pre& p) const {
#pragma unroll
        for (int ai = 0; ai < 2; ++ai)
#pragma unroll
            for (int m = 0; m < 4; ++m) { const int r = ai * HALF + wr * 64 + m * 16 + fr; const int rr = r < u.nrows ? r : u.nrows - 1; p.sc[ai * 4 + m] = ss[u.rows[rr]]; }
    }
    __device__ __forceinline__ void operator()(const f32x4 (&acc)[2][2][4][2], const Unit& u, int wr, int wc, int fr, int fq, const Pre& pre) const {
        const int c0 = wc * 32 + 8 * fq;
        const float* bp = b1 + (size_t)u.aux * 2048 + 2 * (u.pn * 128 + c0);
        const f32x4 bq0 = *(const f32x4*)(bp), bq1 = *(const f32x4*)(bp + 4), bq2 = *(const f32x4*)(bp + 8), bq3 = *(const f32x4*)(bp + 12);
        const float bg[8] = {bq0[0], bq0[2], bq1[0], bq1[2], bq2[0], bq2[2], bq3[0], bq3[2]};
        const float bl[8] = {bq0[1], bq0[3], bq1[1], bq1[3], bq2[1], bq2[3], bq3[1], bq3[3]};
#pragma unroll
        for (int ai = 0; ai < 2; ++ai)
#pragma unroll
            for (int m = 0; m < 4; ++m) { const int r = ai * HALF + wr * 64 + m * 16 + fr;
                const float sc = WSCALE8_INV * __builtin_amdgcn_rsqf(pre.sc[ai * 4 + m] * (1.0f / D) + EPS); float a[8];
#pragma unroll
                for (int j = 0; j < 8; ++j) { const float g = acc[ai][0][m][j >> 2][j & 3] * sc + bg[j], l = acc[ai][1][m][j >> 2][j & 3] * sc + bl[j];
                    const float glu = fminf(g, 7.0f), lin = fminf(fmaxf(l, -7.0f), 7.0f);
                    a[j] = glu * fast_rcp(1.0f + fast_exp2(-1.702f * LOG2E * glu)) * (lin + 1.0f); }
                *(u32x2*)((unsigned char*)O + ((size_t)u.pm * BM + r) * D + u.pn * 128 + c0) = (u32x2){pk4_fp8(a[0], a[1], a[2], a[3]), pk4_fp8(a[4], a[5], a[6], a[7])}; }
    }
};
constexpr float YSCALE = 16.0f, YSCALE_INV = 1.0f / 16.0f;
struct EpiW2 {
    static constexpr bool PERM = true, AFTER_DRAIN = false;
    struct Pre { float g[8]; };
    unsigned char* O; const float* b2; const int* list0; const float* gl0;
    __device__ __forceinline__ void prefetch(const Unit& u, int wr, int fr, Pre& p) const {
        const float* gp = gl0 + (u.rows - list0);
#pragma unroll
        for (int ai = 0; ai < 2; ++ai)
#pragma unroll
            for (int m = 0; m < 4; ++m) { const int r = ai * HALF + wr * 64 + m * 16 + fr; p.g[ai * 4 + m] = r < u.nrows ? gp[r] : 0.f; }
    }
    __device__ __forceinline__ void operator()(const f32x4 (&acc)[2][2][4][2], const Unit& u, int wr, int wc, int fr, int fq, const Pre& pre) const {
        const int row0 = u.pm * BM + wr * 64 + fr, col0 = u.pn * BM + wc * 32 + 8 * fq;
        f32x4 bv[2][2];
#pragma unroll
        for (int bj = 0; bj < 2; ++bj)
#pragma unroll
            for (int n = 0; n < 2; ++n) bv[bj][n] = *(const f32x4*)(b2 + (size_t)u.aux * D + col0 + bj * HALF + 4 * n);
#pragma unroll
        for (int ai = 0; ai < 2; ++ai)
#pragma unroll
            for (int m = 0; m < 4; ++m) { unsigned char* rowp = O + (size_t)(row0 + ai * HALF + m * 16) * D + col0; const float g = YSCALE * pre.g[ai * 4 + m];
#pragma unroll
                for (int bj = 0; bj < 2; ++bj) { const f32x4 v0 = (acc[ai][bj][m][0] * WSCALE8_INV + bv[bj][0]) * g, v1 = (acc[ai][bj][m][1] * WSCALE8_INV + bv[bj][1]) * g;
                    *(u32x2*)(rowp + bj * HALF) = (u32x2){pk4_fp8(v0[0], v0[1], v0[2], v0[3]), pk4_fp8(v1[0], v1[1], v1[2], v1[3])}; } }
    }
};
}

namespace moba {
using bf16x8 = ::bf16x8; using s16x4 = ::s16x4; using f32x16 = ::f32x16; using u32x4 = ::u32x4;
constexpr int DMQ = INC, DMO = D, HD = 64;
constexpr int NW = 8, QBLK = 32, QB = 256, KVBLK = 64;
__device__ __forceinline__ int crow(int r, int hi) { return (r & 3) + 8 * (r >> 2) + 4 * hi; }
#define SBAR() __builtin_amdgcn_sched_barrier(0)
__device__ __forceinline__ void cmask(f32x16& p0, f32x16& p1, int jb, int qrel, int hi) {
    const float NEG = -INFINITY; int kb = 64 * jb + 4 * hi;
#pragma unroll
    for (int r = 0; r < 16; ++r) { int kv = kb + (r & 3) + 8 * (r >> 2); if (kv > qrel) p0[r] = NEG; if (kv + 32 > qrel) p1[r] = NEG; }
}
constexpr int NSLOT = 3, SLOTB = 8192;
constexpr int LDS_K = 0, LDS_V = NSLOT * SLOTB, LDS_WS = 2 * NSLOT * SLOTB, LDS_OST = LDS_WS + NW * 64 * 4, LDS_KB = LDS_OST + NW * 4096, LDS_BYTES = LDS_KB + 16 * 64 * 4;
__device__ __forceinline__ void glds16(const void* gsrc, unsigned lds_dst) { unsigned keep;
    asm volatile("s_mov_b32 %0, m0\n\ts_mov_b32 m0, %2\n\ts_nop 0\n\tglobal_load_lds_dwordx4 %1, off\n\ts_mov_b32 m0, %0" : "=&s"(keep) : "v"(gsrc), "s"(lds_dst) : "memory"); }
__device__ __forceinline__ float max3f(float a, float b, float c) { float r; asm("v_max3_f32 %0, %1, %2, %3" : "=v"(r) : "v"(a), "v"(b), "v"(c)); return r; }
__device__ __forceinline__ float max2f(float a, float b) { float r; asm("v_max_f32_e32 %0, %1, %2" : "=v"(r) : "v"(a), "v"(b)); return r; }
__device__ __forceinline__ float fadd_s(float a, float b) { float r; asm("v_add_f32_e32 %0, %1, %2" : "=v"(r) : "v"(a), "v"(b)); return r; }
__device__ __forceinline__ float fsub_s(float a, float b) { float r; asm("v_sub_f32_e32 %0, %1, %2" : "=v"(r) : "v"(a), "v"(b)); return r; }
__device__ __forceinline__ unsigned cvtpk_s(float lo, float hi) { return ::cvtpk(lo, hi); }
#define WAIT_BAR(N) asm volatile("s_waitcnt vmcnt(" #N ") lgkmcnt(0)\n\ts_barrier" ::: "memory")
__device__ __forceinline__ void qkt(f32x16& p0, f32x16& p1, const char* Kslot, const bf16x8* qr, const f32x16& negm, int r32, int hi) {
    const char* kb = Kslot + hi * 1024 + r32 * 16;
#pragma unroll
    for (int d0 = 0; d0 < 4; ++d0) {
        const bf16x8 b0 = *reinterpret_cast<const bf16x8*>(kb + d0 * 2048);
        const bf16x8 b1 = *reinterpret_cast<const bf16x8*>(kb + d0 * 2048 + 512);
        if (d0 == 0) { p0 = __builtin_amdgcn_mfma_f32_32x32x16_bf16(b0, qr[0], negm, 0, 0, 0); p1 = __builtin_amdgcn_mfma_f32_32x32x16_bf16(b1, qr[0], negm, 0, 0, 0); }
        else { p0 = __builtin_amdgcn_mfma_f32_32x32x16_bf16(b0, qr[d0], p0, 0, 0, 0); p1 = __builtin_amdgcn_mfma_f32_32x32x16_bf16(b1, qr[d0], p1, 0, 0, 0); } }
}
typedef __attribute__((address_space(3))) const char* lds_cptr;
typedef short v4i16_t __attribute__((ext_vector_type(4)));
__device__ __forceinline__ void kload8(bf16x8* kf, lds_cptr kp) {
    kf[0] = *(const __attribute__((address_space(3))) bf16x8*)(kp);        kf[1] = *(const __attribute__((address_space(3))) bf16x8*)(kp + 512);
    kf[2] = *(const __attribute__((address_space(3))) bf16x8*)(kp + 2048); kf[3] = *(const __attribute__((address_space(3))) bf16x8*)(kp + 2560);
    kf[4] = *(const __attribute__((address_space(3))) bf16x8*)(kp + 4096); kf[5] = *(const __attribute__((address_space(3))) bf16x8*)(kp + 4608);
    kf[6] = *(const __attribute__((address_space(3))) bf16x8*)(kp + 6144); kf[7] = *(const __attribute__((address_space(3))) bf16x8*)(kp + 6656);
}
__device__ __forceinline__ void kload2(bf16x8* kf, lds_cptr kp, int j) { kf[2 * j] = *(const __attribute__((address_space(3))) bf16x8*)(kp + j * 2048); kf[2 * j + 1] = *(const __attribute__((address_space(3))) bf16x8*)(kp + j * 2048 + 512); }
__device__ __forceinline__ s16x4 vtr(lds_cptr p) { return __builtin_bit_cast(s16x4, __builtin_amdgcn_ds_read_tr16_b64_v4i16((__attribute__((address_space(3))) v4i16_t*)p)); }
__device__ __forceinline__ float rowmax(const f32x16& p0, const f32x16& p1) {
    float a = max3f(p0[0], p0[1], p1[0]), b = max3f(p0[2], p0[3], p1[1]); a = max3f(a, p1[2], p1[3]);
#pragma unroll
    for (int r = 4; r < 16; r += 4) { a = max3f(a, p0[r], p0[r + 1]); b = max3f(b, p0[r + 2], p0[r + 3]); a = max3f(a, p1[r], p1[r + 1]); b = max3f(b, p1[r + 2], p1[r + 3]); }
    const float m = max2f(a, b);
    auto rr = __builtin_amdgcn_permlane32_swap(__float_as_uint(m), __float_as_uint(m), false, false);
    return max2f(__uint_as_float(rr[0]), __uint_as_float(rr[1]));
}
__device__ __forceinline__ void pv(f32x16* o, int vb, bf16x8 pa0, bf16x8 pa1, bf16x8 pa2, bf16x8 pa3) {
#pragma unroll
    for (int d0 = 0; d0 < 2; ++d0) { s16x4 lo[4], hi[4];
#pragma unroll
        for (int ks = 0; ks < 4; ++ks) {
            asm volatile("ds_read_b64_tr_b16 %0,%1 offset:%c2" : "=&v"(lo[ks]) : "v"(vb), "i"(d0 * 4096 + ks * 1024) : "memory");
            asm volatile("ds_read_b64_tr_b16 %0,%1 offset:%c2" : "=&v"(hi[ks]) : "v"(vb), "i"(d0 * 4096 + ks * 1024 + 512) : "memory"); }
        asm volatile("s_waitcnt lgkmcnt(0)" ::: "memory"); SBAR();
#define PK(k) (bf16x8){lo[k][0], lo[k][1], lo[k][2], lo[k][3], hi[k][0], hi[k][1], hi[k][2], hi[k][3]}
        o[d0] = __builtin_amdgcn_mfma_f32_32x32x16_bf16(pa0, PK(0), o[d0], 0, 0, 0);
        o[d0] = __builtin_amdgcn_mfma_f32_32x32x16_bf16(pa1, PK(1), o[d0], 0, 0, 0);
        o[d0] = __builtin_amdgcn_mfma_f32_32x32x16_bf16(pa2, PK(2), o[d0], 0, 0, 0);
        o[d0] = __builtin_amdgcn_mfma_f32_32x32x16_bf16(pa3, PK(3), o[d0], 0, 0, 0);
#undef PK
    }
}
constexpr float NEGBIG = -1.0e30f;

template <int THRL> __device__ __forceinline__ void attn_unit(int b, int h, int qb, const bf16_t* Qg, const bf16_t* __restrict__ Kg, const bf16_t* __restrict__ Vg, bf16_t* Og, const float* __restrict__ kbar, char* shm) {
    int tid_ = threadIdx.x; asm volatile("" : "+v"(tid_));
    const int tid = tid_, lane = tid & 63, r32 = lane & 31, hi = lane >> 5; const int wid = __builtin_amdgcn_readfirstlane(tid >> 6);
    const long rowbase = (long)b * SEQ; const int q0 = qb * QB;
    const size_t hoff = (size_t)(b * 8 + h) * (SEQ * 64);
    const bf16_t* Qw = Qg + hoff + (size_t)(q0 + wid * QBLK) * 64;
    const bf16_t* Kh = Kg + hoff, *Vh = Vg + hoff;
    const unsigned lds0 = (unsigned)(uintptr_t)shm;
    float* wsf = (float*)(shm + LDS_WS) + wid * 64;
    const bf16_t* ksrc = Kh + wid * 512 + lane * 8;
    const bf16_t* vsrc = Vh + wid * 512 + lane * 8;
    const unsigned kdst = lds0 + LDS_K + wid * 1024, vdst = lds0 + LDS_V + wid * 1024;
    const int NT = 4 * qb + 4, NPAST = 4 * qb;
#define TMAP(t) (((t) < 4) ? (NPAST + (t)) : ((t) - 4))
#define DMA_K(t, slot) glds16(ksrc + (long)TMAP(t) * 4096, (unsigned)__builtin_amdgcn_readfirstlane(kdst + (slot)))
#define DMA_V(t, slot) glds16(vsrc + (long)TMAP(t) * 4096, (unsigned)__builtin_amdgcn_readfirstlane(vdst + (slot)))
    const char* Kbase = shm + LDS_K; bf16x8 kf[8];
    const lds_cptr shm3 = (lds_cptr)shm; const lds_cptr kp0 = shm3 + LDS_K + hi * 1024 + r32 * 16; const lds_cptr vp0 = shm3 + LDS_V + ((lane >> 4) & 1) * 32 + (lane & 3) * 8 + (4 * hi + ((lane & 15) >> 2)) * 64;
    DMA_K(0, 0); DMA_V(0, 0); DMA_K(1, SLOTB);
    bf16x8 qr[4];
#pragma unroll
    for (int d0 = 0; d0 < 4; ++d0) qr[d0] = *reinterpret_cast<const bf16x8*>(&Qw[(long)r32 * 64 + d0 * 16 + hi * 8]);
    unsigned selm = 0u;
    if (qb > 0) {
        float* kbl = (float*)(shm + LDS_KB);
        for (int i = tid; i < qb * 64; i += NW * 64) kbl[i] = kbar[((size_t)(b * 16 + (i >> 6)) * 8 + h) * 64 + (i & 63)];
        asm volatile("s_waitcnt vmcnt(0) lgkmcnt(0)\n\ts_barrier" ::: "memory");
        if (qb <= 3) selm = (1u << qb) - 1u;
        else {
            float qf[32];
#pragma unroll
            for (int d0 = 0; d0 < 4; ++d0)
#pragma unroll
                for (int j = 0; j < 8; ++j) qf[d0 * 8 + j] = bf2f((unsigned short)qr[d0][j]);
            float g[15];
#pragma unroll
            for (int n = 0; n < 15; ++n) { float s = 0.f;
                if (n < qb) {
#pragma unroll
                    for (int d0 = 0; d0 < 4; ++d0) { const f32x4 k0 = *(const f32x4*)(kbl + n * 64 + d0 * 16 + hi * 8), k1 = *(const f32x4*)(kbl + n * 64 + d0 * 16 + hi * 8 + 4);
                        s += qf[d0 * 8 + 0] * k0[0] + qf[d0 * 8 + 1] * k0[1] + qf[d0 * 8 + 2] * k0[2] + qf[d0 * 8 + 3] * k0[3] + qf[d0 * 8 + 4] * k1[0] + qf[d0 * 8 + 5] * k1[1] + qf[d0 * 8 + 6] * k1[2] + qf[d0 * 8 + 7] * k1[3]; }
                    s += __shfl_xor(s, 32);
                } else s = -INFINITY;
                g[n] = s; }
#pragma unroll
            for (int pass = 0; pass < 3; ++pass) { float best = -INFINITY; int bi = 0;
#pragma unroll
                for (int n = 0; n < 15; ++n) if (g[n] > best) { best = g[n]; bi = n; }
                selm |= 1u << bi;
#pragma unroll
                for (int n = 0; n < 15; ++n) if (n == bi) g[n] = -INFINITY; }
        }
    }
    float mhat = 0.f, l_reg = 0.f; f32x16 o[2]; o[0] = f32x16{}; o[1] = f32x16{}; f32x16 cini = f32x16{}; asm volatile("" : "+v"(cini));
    const int qrel = wid * QBLK + r32;
#define SETC(t, JB) do { const float cm_ = ((JB >= 0) || ((selm >> (((t) - 4) >> 2)) & 1u)) ? -mhat : NEGBIG; \
      _Pragma("unroll") for (int r = 0; r < 16; ++r) cini[r] = cm_; asm volatile("" : "+v"(cini)); } while (0)
    bool resc = false;
#define START(P0, P1) do { const float rm = rowmax(P0, P1); resc = false; \
    { const float dl = rm; mhat = fadd_s(mhat, dl); \
      _Pragma("unroll") for (int r = 0; r < 16; ++r) { P0[r] = fsub_s(P0[r], dl); P1[r] = fsub_s(P1[r], dl); } } \
    _Pragma("unroll") for (int r = 0; r < 16; ++r) P0[r] = __builtin_amdgcn_exp2f(P0[r]); } while (0)
#define RESC() do { if (resc) { asm volatile("s_waitcnt lgkmcnt(0)" ::: "memory"); \
      _Pragma("unroll") for (int d_ = 0; d_ < 2; ++d_) _Pragma("unroll") for (int r = 0; r < 16; ++r) o[d_][r] *= wsf[crow(r, hi)]; } } while (0)
    f32x16 pA0, pA1, pB0, pB1;
    int sl_prev = 0, sl_cur = 0, sl_next = SLOTB;
#define ROT() do { sl_prev = sl_cur; sl_cur = sl_next; sl_next = (sl_next == (NSLOT - 1) * SLOTB) ? 0 : sl_next + SLOTB; } while (0)
    DMA_K(2, 2 * SLOTB);
    if (qb > 0) { WAIT_BAR(0); } else { WAIT_BAR(3); }
    qkt(pA0, pA1, Kbase, qr, cini, r32, hi); asm volatile("s_nop 15\n\ts_nop 7" : "+v"(pA0), "+v"(pA1)); cmask(pA0, pA1, 0, qrel, hi);
    START(pA0, pA1);
    _Pragma("unroll") for (int r = 0; r < 16; ++r) pA1[r] = __builtin_amdgcn_exp2f(pA1[r]);
    WAIT_BAR(0);
    DMA_K(3, 0); DMA_V(1, SLOTB);
    ROT();
    kload8(kf, kp0 + sl_cur);
    WAIT_BAR(2);
    s16x4 vlo[8], vhi[8]; u32x4 pw0, pw1, pw2, pw3;
#define PKW(P, B) cvtpk_s(P[B], P[B + 1])
#define PAF(k) __builtin_bit_cast(bf16x8, pw##k)
#define VFR(i) (bf16x8){vlo[i][0], vlo[i][1], vlo[i][2], vlo[i][3], vhi[i][0], vhi[i][1], vhi[i][2], vhi[i][3]}
#define PIN(x) asm volatile("" : "+v"(x))
#define MX3(a, b, c) __builtin_fmaxf(__builtin_fmaxf((a), (b)), (c))
#define GAPA(MF, A0, A1, A2, A3, W0, W1, PW) do { MF; sacc += A0; sacc += A1; sacc += A2; sacc += A3; PIN(sacc); W0; W1; PIN(PW); SBAR(); } while (0)
#define EX(v) __builtin_amdgcn_exp2f(v)
#define GAPB(MF, X, B) do { MF; X[B] = EX(X[B]); X[B + 1] = EX(X[B + 1]); X[B + 2] = EX(X[B + 2]); X[B + 3] = EX(X[B + 3]); PIN(X); SBAR(); } while (0)
#define VRD(i) do { vlo[i] = vtr(vp_ + (((i) >> 2) * 4096 + ((i) & 3) * 1024)); vhi[i] = vtr(vp_ + (((i) >> 2) * 4096 + ((i) & 3) * 1024 + 512)); } while (0)
#define KRD(G, j) do { if (G) { kload2(kf, kp0 + sl_next, j); SBAR(); } } while (0)
#define STEP(C0, C1, P0, P1, t, GK, GV, GL, JB) do { SETC(t, JB); SBAR(); \
    const lds_cptr vp_ = vp0 + sl_prev; \
    VRD(0); SBAR(); float sacc = (P0[0] + P0[1]); \
    GAPA(C0 = __builtin_amdgcn_mfma_f32_32x32x16_bf16(kf[0], qr[0], cini, 0, 0, 0), P0[2], P0[3], P0[4], P0[5],     pw0[0] = PKW(P0, 0), pw0[1] = PKW(P0, 2), pw0); \
    VRD(4); SBAR(); GAPA(C1 = __builtin_amdgcn_mfma_f32_32x32x16_bf16(kf[1], qr[0], cini, 0, 0, 0), P0[6], P0[7], P0[8], P0[9],     pw0[2] = PKW(P0, 4), pw0[3] = PKW(P0, 6), pw0); \
    VRD(1); SBAR(); GAPA(C0 = __builtin_amdgcn_mfma_f32_32x32x16_bf16(kf[2], qr[1], C0, 0, 0, 0),   P0[10], P0[11], P0[12], P0[13], pw1[0] = PKW(P0, 8), pw1[1] = PKW(P0, 10), pw1); \
    VRD(5); SBAR(); GAPA(C1 = __builtin_amdgcn_mfma_f32_32x32x16_bf16(kf[3], qr[1], C1, 0, 0, 0),   P0[14], P0[15], P1[0], P1[1],   pw1[2] = PKW(P0, 12), pw1[3] = PKW(P0, 14), pw1); \
    VRD(2); SBAR(); GAPA(C0 = __builtin_amdgcn_mfma_f32_32x32x16_bf16(kf[4], qr[2], C0, 0, 0, 0),   P1[2], P1[3], P1[4], P1[5],     pw2[0] = PKW(P1, 0), pw2[1] = PKW(P1, 2), pw2); \
    VRD(6); SBAR(); GAPA(C1 = __builtin_amdgcn_mfma_f32_32x32x16_bf16(kf[5], qr[2], C1, 0, 0, 0),   P1[6], P1[7], P1[8], P1[9],     pw2[2] = PKW(P1, 4), pw2[3] = PKW(P1, 6), pw2); \
    VRD(3); SBAR(); GAPA(C0 = __builtin_amdgcn_mfma_f32_32x32x16_bf16(kf[6], qr[3], C0, 0, 0, 0),   P1[10], P1[11], P1[12], P1[13], pw3[0] = PKW(P1, 8), pw3[1] = PKW(P1, 10), pw3); \
    VRD(7); SBAR(); GAPA(C1 = __builtin_amdgcn_mfma_f32_32x32x16_bf16(kf[7], qr[3], C1, 0, 0, 0),   P1[14], P1[15], 0.f, 0.f,       pw3[2] = PKW(P1, 12), pw3[3] = PKW(P1, 14), pw3); \
    l_reg += sacc; \
    if (GK) { DMA_K((t) + 3, sl_cur); } if (GV) { DMA_V((t) + 1, sl_next); } \
    if (JB >= 0) cmask(C0, C1, JB, qrel, hi); \
    { float a = MX3(C0[0], C0[1], C1[0]), b_ = MX3(C0[2], C0[3], C1[1]); a = MX3(a, C1[2], C1[3]); \
      _Pragma("unroll") for (int r = 4; r < 16; r += 4) { a = MX3(a, C0[r], C0[r + 1]); b_ = MX3(b_, C0[r + 2], C0[r + 3]); a = MX3(a, C1[r], C1[r + 1]); b_ = MX3(b_, C1[r + 2], C1[r + 3]); } \
      float rm = __builtin_fmaxf(a, b_); { auto rr = __builtin_amdgcn_permlane32_swap(__float_as_uint(rm), __float_as_uint(rm), false, false); rm = __builtin_fmaxf(__uint_as_float(rr[0]), __uint_as_float(rr[1])); } \
      resc = false; \
      if (__builtin_expect(__any(rm > (float)THRL), 0)) { const float dl = __builtin_fmaxf(rm, 0.f); mhat += dl; \
        _Pragma("unroll") for (int r = 0; r < 16; ++r) { C0[r] -= dl; C1[r] -= dl; } \
        const float f = __builtin_amdgcn_exp2f(-dl); l_reg *= f; if (hi == 0) wsf[r32] = f; resc = true; } } \
    SBAR(); \
    GAPB(o[0] = __builtin_amdgcn_mfma_f32_32x32x16_bf16(PAF(0), VFR(0), o[0], 0, 0, 0), C0, 0); \
    GAPB(o[1] = __builtin_amdgcn_mfma_f32_32x32x16_bf16(PAF(0), VFR(4), o[1], 0, 0, 0), C0, 4); \
    KRD(GL, 0); GAPB(o[0] = __builtin_amdgcn_mfma_f32_32x32x16_bf16(PAF(1), VFR(1), o[0], 0, 0, 0), C0, 8); \
    KRD(GL, 1); GAPB(o[1] = __builtin_amdgcn_mfma_f32_32x32x16_bf16(PAF(1), VFR(5), o[1], 0, 0, 0), C0, 12); \
    KRD(GL, 2); GAPB(o[0] = __builtin_amdgcn_mfma_f32_32x32x16_bf16(PAF(2), VFR(2), o[0], 0, 0, 0), C1, 0); \
    KRD(GL, 3); GAPB(o[1] = __builtin_amdgcn_mfma_f32_32x32x16_bf16(PAF(2), VFR(6), o[1], 0, 0, 0), C1, 4); \
    GAPB(o[0] = __builtin_amdgcn_mfma_f32_32x32x16_bf16(PAF(3), VFR(3), o[0], 0, 0, 0), C1, 8); \
    GAPB(o[1] = __builtin_amdgcn_mfma_f32_32x32x16_bf16(PAF(3), VFR(7), o[1], 0, 0, 0), C1, 12); \
    } while (0)
#define ENDW(tt) do { if ((tt) + 3 < NT) { WAIT_BAR(2); } else if ((tt) + 2 < NT) { WAIT_BAR(1); } else { WAIT_BAR(0); } } while (0)
    STEP(pB0, pB1, pA0, pA1, 1, (4 < NT), true, true, 1);   ENDW(1); RESC(); ROT();
    STEP(pA0, pA1, pB0, pB1, 2, (5 < NT), true, true, 2);   ENDW(2); RESC(); ROT();
    STEP(pB0, pB1, pA0, pA1, 3, (6 < NT), (4 < NT), (4 < NT), 3);   ENDW(3); RESC(); ROT();
    for (int t = 4; t < NT; t += 2) {
        STEP(pA0, pA1, pB0, pB1, t, (t + 3 < NT), true, true, -1);                       ENDW(t);     RESC(); ROT();
        STEP(pB0, pB1, pA0, pA1, t + 1, (t + 4 < NT), (t + 2 < NT), (t + 2 < NT), -1);   ENDW(t + 1); RESC(); ROT();
    }
    { float sacc = pB0[0] + pB0[1]; _Pragma("unroll") for (int r = 2; r < 16; ++r) sacc += pB0[r]; _Pragma("unroll") for (int r = 0; r < 16; ++r) sacc += pB1[r]; l_reg += sacc;
      pw0 = (u32x4){PKW(pB0, 0), PKW(pB0, 2), PKW(pB0, 4), PKW(pB0, 6)}; pw1 = (u32x4){PKW(pB0, 8), PKW(pB0, 10), PKW(pB0, 12), PKW(pB0, 14)}; pw2 = (u32x4){PKW(pB1, 0), PKW(pB1, 2), PKW(pB1, 4), PKW(pB1, 6)}; pw3 = (u32x4){PKW(pB1, 8), PKW(pB1, 10), PKW(pB1, 12), PKW(pB1, 14)};
      SBAR(); pv(o, (int)(unsigned long)vp0 + sl_prev, PAF(0), PAF(1), PAF(2), PAF(3)); }
#undef PKW
#undef PAF
#undef VFR
#undef PIN
#undef MX3
#undef GAPA
#undef GAPB
#undef EX
#undef VRD
#undef KRD
#undef STEP
#undef ENDW
    { auto rr = __builtin_amdgcn_permlane32_swap(__float_as_uint(l_reg), __float_as_uint(l_reg), false, false); l_reg = __uint_as_float(rr[0]) + __uint_as_float(rr[1]); }
    if (hi == 0) wsf[32 + r32] = l_reg; asm volatile("s_waitcnt lgkmcnt(0)" ::: "memory");
    float rli[16];
#pragma unroll
    for (int r = 0; r < 16; ++r) rli[r] = __builtin_amdgcn_rcpf(wsf[32 + crow(r, hi)]);
    bf16_t* Ow = Og + (rowbase + q0 + wid * QBLK) * DMO + h * HD;
    { bf16_t* stg = (bf16_t*)(shm + LDS_OST) + wid * 2048;
#pragma unroll
      for (int r = 0; r < 16; ++r) { const int orow = crow(r, hi);
#pragma unroll
        for (int d0 = 0; d0 < 2; ++d0) stg[orow * 64 + d0 * 32 + r32] = (bf16_t)f2bf(o[d0][r] * rli[r]); }
      asm volatile("s_waitcnt lgkmcnt(0)" ::: "memory");
#pragma unroll
      for (int i = 0; i < 4; ++i) { const int row = i * 8 + (lane >> 3), ch = lane & 7; const u32x4 v = *(const u32x4*)(stg + row * 64 + ch * 8); *(u32x4*)(Ow + (long)row * DMO + ch * 8) = v; } }
    asm volatile("s_waitcnt lgkmcnt(0)\n\ts_barrier" ::: "memory");
#undef DMA_K
#undef DMA_V
#undef TMAP
#undef SETC
#undef START
#undef RESC
#undef ROT
}
#undef SBAR
#undef WAIT_BAR
}

namespace hgrn {
constexpr int RS = 144;
constexpr int R_FQV = 0, FQV_SLOT = 32768;
constexpr int L_Q = 98304, L_K = L_Q + 9216, L_KT = L_K + 9216, L_VT = L_KT + 9216, L_ST = L_VT + 9216, L_SEG = L_ST + 9216, L_DEND = L_SEG + 2048, L_SSQ = L_DEND + 256, L_BYTES = L_SSQ + 512;
__device__ __forceinline__ int crow(int r, int hi) { return (r & 3) + 8 * (r >> 2) + 4 * hi; }
__device__ __forceinline__ void glds16(const void* gsrc, unsigned lds_dst) { unsigned keep;
    asm volatile("s_mov_b32 %0, m0\n\ts_mov_b32 m0, %2\n\ts_nop 0\n\tglobal_load_lds_dwordx4 %1, off\n\ts_mov_b32 m0, %0" : "=&s"(keep) : "v"(gsrc), "s"(lds_dst) : "memory"); }
#define HG_BAR() do { asm volatile("s_waitcnt lgkmcnt(0)" ::: "memory"); __builtin_amdgcn_s_barrier(); asm volatile("" ::: "memory"); } while (0)
__device__ __forceinline__ void hgrn_unit(int b, int h, const bf16_t* __restrict__ proj, bf16_t* __restrict__ mix, const float* __restrict__ lb_logits, const float* __restrict__ norm_g, LAS unsigned char* lds) {
    int tid_ = threadIdx.x; asm volatile("" : "+v"(tid_));
    const int tid = tid_, lane = tid & 63, r32 = lane & 31, hi = lane >> 5; const int w = __builtin_amdgcn_readfirstlane(tid >> 6);
    const float lbk = fast_rcp(1.0f + fast_exp2((lb_logits[512 + h * 64 + lane] - lb_logits[h * 64 + lane]) * LOG2E));
    const int vr = (w >> 1) & 1, tc = w & 1;
    float ng[16];
#pragma unroll
    for (int r = 0; r < 16; ++r) ng[r] = norm_g[h * 64 + 32 * vr + crow(r, hi)];
    f32x16 S = f32x16{};
    for (int i = tid; i < 64 * RS / 4; i += 512) ((LAS unsigned*)(lds + L_ST))[i] = 0u;
    const size_t hoff = (size_t)(b * 8 + h) * (SEQ * 64) + (size_t)w * 512 + lane * 8;
    const bf16_t* gQ = proj + 3 * SEC_ELEMS + hoff; const bf16_t* gF = proj + 4 * SEC_ELEMS + hoff; const bf16_t* gV = proj + 5 * SEC_ELEMS + hoff; const bf16_t* gG = proj + 6 * SEC_ELEMS + hoff;
    const unsigned lds0 = (unsigned)(uintptr_t)(unsigned char*)lds;
#define DMA_FQV(c_) do { const int cc_ = (c_) < 63 ? (c_) : 63; const unsigned d_ = (unsigned)__builtin_amdgcn_readfirstlane(lds0 + R_FQV + (unsigned)(((c_) % 3) * FQV_SLOT) + (unsigned)w * 1024u); \
        glds16(gF + (size_t)cc_ * 4096, d_); glds16(gQ + (size_t)cc_ * 4096, d_ + 8192u); glds16(gV + (size_t)cc_ * 4096, d_ + 16384u); } while (0)
#define DMA_G(c_) do { const int cc_ = (c_) < 63 ? (c_) : 63; glds16(gG + (size_t)cc_ * 4096, (unsigned)__builtin_amdgcn_readfirstlane(lds0 + R_FQV + (unsigned)(((c_) % 3) * FQV_SLOT) + 24576u + (unsigned)w * 1024u)); } while (0)
    DMA_FQV(0); DMA_G(0); DMA_FQV(1); DMA_G(1);
    for (int c = 0; c < 64; ++c) {
        const size_t row0 = (size_t)b * SEQ + (size_t)c * 64;
        DMA_FQV(c + 2);
        asm volatile("s_waitcnt vmcnt(8)" ::: "memory");
        const LAS unsigned char* raw = lds + R_FQV + (c % 3) * FQV_SLOT + (8 * w) * 128 + lane * 2;
        float p[8], kk[8];
        { float run = 0.f;
#pragma unroll
          for (int i = 0; i < 8; ++i) { const float x = bf2f(*(const LAS unsigned short*)(raw + i * 128)); const float sg = fast_rcp(1.0f + fast_exp2(-x * LOG2E)); const float f = lbk + (1.0f - lbk) * sg;
              run += __builtin_amdgcn_logf(f); p[i] = run; kk[i] = 1.0f - f; } }
        ((LAS float*)(lds + L_SEG))[w * 64 + lane] = p[7];
        HG_BAR();
        DMA_G(c + 2);
        { float off = 0.f;
#pragma unroll
          for (int j = 0; j < 7; ++j) { const float sv = ((LAS float*)(lds + L_SEG))[j * 64 + lane]; off += (j < w) ? sv : 0.f; }
          unsigned kq[4], vq[4];
#pragma unroll
          for (int i = 0; i < 8; i += 2) { const float b0 = off + p[i], b1 = off + p[i + 1];
              const unsigned short q0r = *(const LAS unsigned short*)(raw + 8192 + i * 128), q1r = *(const LAS unsigned short*)(raw + 8192 + (i + 1) * 128);
              const unsigned short v0r = *(const LAS unsigned short*)(raw + 16384 + i * 128), v1r = *(const LAS unsigned short*)(raw + 16384 + (i + 1) * 128);
              const float q0 = bf2f(q0r) * fast_exp2(b0), q1 = bf2f(q1r) * fast_exp2(b1), k0 = kk[i] * fast_exp2(-b0), k1 = kk[i + 1] * fast_exp2(-b1);
              const unsigned qq = cvtpk(q0, q1), kw = cvtpk(k0, k1); kq[i >> 1] = kw; vq[i >> 1] = (unsigned)v0r | ((unsigned)v1r << 16);
              *(LAS unsigned short*)(lds + L_Q + (8 * w + i) * RS + lane * 2) = (unsigned short)(qq & 0xffffu);
              *(LAS unsigned short*)(lds + L_Q + (8 * w + i + 1) * RS + lane * 2) = (unsigned short)(qq >> 16);
              *(LAS unsigned short*)(lds + L_K + (8 * w + i) * RS + lane * 2) = (unsigned short)(kw & 0xffffu);
              *(LAS unsigned short*)(lds + L_K + (8 * w + i + 1) * RS + lane * 2) = (unsigned short)(kw >> 16); }
          *(LAS u32x4*)(lds + L_KT + lane * RS + 16 * w) = (u32x4){kq[0], kq[1], kq[2], kq[3]};
          *(LAS u32x4*)(lds + L_VT + lane * RS + 16 * w) = (u32x4){vq[0], vq[1], vq[2], vq[3]};
          if (w == 7) ((LAS float*)(lds + L_DEND))[lane] = fast_exp2(off + p[7]); }
        asm volatile("s_waitcnt vmcnt(8)" ::: "memory");
        HG_BAR();
        f32x16 OT = f32x16{};
        if (w < 4) {
            bf16x8 bq[4];
#pragma unroll
            for (int ks = 0; ks < 4; ++ks) bq[ks] = *(const LAS bf16x8*)(lds + L_Q + (32 * tc + r32) * RS + (16 * ks + 8 * hi) * 2);
#pragma unroll
            for (int sr = 0; sr < 2; ++sr) if (sr <= tc) {
                f32x16 at = f32x16{};
#pragma unroll
                for (int ks = 0; ks < 4; ++ks) { const bf16x8 a = *(const LAS bf16x8*)(lds + L_K + (32 * sr + r32) * RS + (16 * ks + 8 * hi) * 2); at = __builtin_amdgcn_mfma_f32_32x32x16_bf16(a, bq[ks], at, 0, 0, 0); }
                if (sr == tc) {
#pragma unroll
                    for (int r = 0; r < 16; ++r) at[r] = (crow(r, hi) <= r32) ? at[r] : 0.f; }
#pragma unroll
                for (int st = 0; st < 2; ++st) {
                    u32x4 bw; bw.x = cvtpk(at[8 * st + 0], at[8 * st + 1]); bw.y = cvtpk(at[8 * st + 2], at[8 * st + 3]); bw.z = cvtpk(at[8 * st + 4], at[8 * st + 5]); bw.w = cvtpk(at[8 * st + 6], at[8 * st + 7]);
                    const u32x2 lo = *(const LAS u32x2*)(lds + L_VT + (32 * vr + r32) * RS + (32 * sr + 16 * st + 4 * hi) * 2);
                    const u32x2 hh = *(const LAS u32x2*)(lds + L_VT + (32 * vr + r32) * RS + (32 * sr + 16 * st + 8 + 4 * hi) * 2);
                    const u32x4 aw = (u32x4){lo.x, lo.y, hh.x, hh.y};
                    OT = __builtin_amdgcn_mfma_f32_32x32x16_bf16(__builtin_bit_cast(bf16x8, aw), __builtin_bit_cast(bf16x8, bw), OT, 0, 0, 0); }
            }
#pragma unroll
            for (int ks = 0; ks < 4; ++ks) { const bf16x8 a = *(const LAS bf16x8*)(lds + L_ST + (32 * vr + r32) * RS + (16 * ks + 8 * hi) * 2); OT = __builtin_amdgcn_mfma_f32_32x32x16_bf16(a, bq[ks], OT, 0, 0, 0); }
            float sq = 0.f;
#pragma unroll
            for (int r = 0; r < 16; ++r) sq += OT[r] * OT[r];
            sq += __shfl_xor(sq, 32);
            if (hi == 0) ((LAS float*)(lds + L_SSQ))[vr * 64 + 32 * tc + r32] = sq;
        } else {
#pragma unroll
            for (int st = 0; st < 4; ++st) { const bf16x8 a = *(const LAS bf16x8*)(lds + L_KT + (32 * vr + r32) * RS + (16 * st + 8 * hi) * 2);
                const bf16x8 bv = *(const LAS bf16x8*)(lds + L_VT + (32 * tc + r32) * RS + (16 * st + 8 * hi) * 2);
                S = __builtin_amdgcn_mfma_f32_32x32x16_bf16(a, bv, S, 0, 0, 0); }
#pragma unroll
            for (int r = 0; r < 16; ++r) S[r] *= ((LAS float*)(lds + L_DEND))[32 * vr + crow(r, hi)];
        }
        HG_BAR();
        if (w < 4) {
            const int t = 32 * tc + r32;
            const float tot = ((LAS float*)(lds + L_SSQ))[t] + ((LAS float*)(lds + L_SSQ))[64 + t];
            const float rstd = __builtin_amdgcn_rsqf(tot * (1.0f / 64.0f) + EPS);
            const LAS unsigned char* gp = lds + R_FQV + (c % 3) * FQV_SLOT + 24576 + t * 128 + (32 * vr + 4 * hi) * 2;
            bf16_t* op = mix + (row0 + t) * D + 512 + h * 64 + 32 * vr + 4 * hi;
#pragma unroll
            for (int g = 0; g < 4; ++g) { const u32x2 gg = *(const LAS u32x2*)(gp + 16 * g);
                const float y0 = OT[4 * g + 0] * rstd * ng[4 * g + 0] * bflo(gg.x), y1 = OT[4 * g + 1] * rstd * ng[4 * g + 1] * bfhi(gg.x),
                            y2 = OT[4 * g + 2] * rstd * ng[4 * g + 2] * bflo(gg.y), y3 = OT[4 * g + 3] * rstd * ng[4 * g + 3] * bfhi(gg.y);
                *(u32x2*)(op + 8 * g) = (u32x2){cvtpk(y0, y1), cvtpk(y2, y3)}; }
        } else {
#pragma unroll
            for (int g = 0; g < 4; ++g) *(LAS u32x2*)(lds + L_ST + (32 * tc + r32) * RS + (32 * vr + 8 * g + 4 * hi) * 2) = (u32x2){cvtpk(S[4 * g + 0], S[4 * g + 1]), cvtpk(S[4 * g + 2], S[4 * g + 3])};
        }
    }
    asm volatile("s_waitcnt vmcnt(0)" ::: "memory");
    HG_BAR();
#undef DMA_FQV
#undef DMA_G
}
#undef HG_BAR
}

constexpr int NWAVES = 8;
constexpr int LDS_BYTES = 163840;
constexpr int TAIL = 161792;
constexpr int TL_TE = TAIL, TL_TS = TAIL + 576, TL_HIST = TAIL + 768, TL_BASE = TAIL + 896, TL_MISC = TAIL + 1024, TL_CNT = TAIL + 1280;
typedef GAS unsigned gu32;

struct Args { const float* in[20]; float* out; unsigned char* ws; int ph_lo, ph_hi; };

struct Frame {
    LAS unsigned char* lds; volatile LAS unsigned* MISC; unsigned* ctl;
    int tid, lane, wave, G, vcu;
};

struct P0Item { const float* W; bf16_t* WT; const float* gain; int N, K, k0, n0, mode; };
__device__ __forceinline__ bool p0_decode(const Args& a, int it, P0Item& I) {
    unsigned char* ws = a.ws;
    constexpr int I_IN = 16 * 56, I_SQ = 16 * 16, I_KV = 16 * 32, I_W1 = 16 * 32, I_W2 = 16 * 16;
    constexpr int NITEMS = I_IN + 2 * I_SQ + I_KV + NEXP * (I_W1 + I_W2);
    if (it >= NITEMS) return false;
    int r = it; I.gain = nullptr; I.mode = 0; I.K = D;
    if (r < I_IN) { I.W = a.in[3]; I.WT = (bf16_t*)(ws + WS_WIN); I.N = INC; }
    else if ((r -= I_IN) < I_SQ) { I.W = a.in[6]; I.WT = (bf16_t*)(ws + WS_WOUT); I.N = D; }
    else if ((r -= I_SQ) < I_KV) { I.W = a.in[10]; I.WT = (bf16_t*)(ws + WS_WKV); I.N = 2 * D; }
    else if ((r -= I_KV) < I_SQ) { I.W = a.in[11]; I.WT = (bf16_t*)(ws + WS_WO); I.N = D; }
    else if ((r -= I_SQ) < NEXP * I_W1) { const int e = r / I_W1; r -= e * I_W1; I.W = a.in[15] + (size_t)e * D * 2048; I.WT = (bf16_t*)(ws + WS_W1 + (size_t)e * 2048 * D); I.N = 2048; I.gain = a.in[12]; I.mode = 3; }
    else { r -= NEXP * I_W1; const int e = r / I_W2; r -= e * I_W2; I.W = a.in[17] + (size_t)e * D * D; I.WT = (bf16_t*)(ws + WS_W2 + (size_t)e * D * D); I.N = D; I.mode = 2; }
    const int nblk = I.N / 64; I.k0 = 64 * (r / nblk); I.n0 = 64 * (r % nblk); return true;
}
__device__ __forceinline__ void p0_load(const P0Item& I, f32x4 (&v)[16], int lane) {
    const float* p = I.W + (size_t)(I.k0 + (lane >> 4)) * I.N + I.n0 + 4 * (lane & 15);
#pragma unroll
    for (int j = 0; j < 16; ++j) v[j] = *(const f32x4*)(p + (size_t)(4 * j) * I.N);
}
__device__ __forceinline__ void p0_store(const P0Item& I, const f32x4 (&v)[16], LAS unsigned char* tl, int lane) {
    const int kr = lane >> 4, nq = lane & 15;
#pragma unroll
    for (int j = 0; j < 16; ++j) { const int k = 4 * j + kr; const float g = I.gain ? I.gain[I.k0 + k] : 1.0f;
        *(LAS u32x2*)(tl + k * 128 + (((nq >> 1) ^ ((k >> 3) & 7)) * 16) + (nq & 1) * 8) = (u32x2){pk2(v[j].x * g, v[j].y * g), pk2(v[j].z * g, v[j].w * g)}; }
    LDS_WAIT(); asm volatile("" ::: "memory");
    const int c = lane & 7;
#pragma unroll
    for (int i = 0; i < 8; ++i) { const int n = (lane >> 3) + 8 * i; const LAS unsigned char* sp = tl + (8 * c) * 128 + ((i ^ c) * 16) + (n & 7) * 2;
        unsigned short e[8];
#pragma unroll
        for (int q = 0; q < 8; ++q) e[q] = *(const LAS unsigned short*)(sp + q * 128);
        int row = I.n0 + n; if (I.mode & 1) { const int jj = row >> 1, bj = row & 1; row = (jj >> 7) * 256 + bj * 128 + (jj & 127); }
        if (I.mode & 2) *(u32x2*)((unsigned char*)I.WT + (size_t)row * I.K + I.k0 + 8 * c) = (u32x2){pk4_fp8(bf2f(e[0]) * WSCALE8, bf2f(e[1]) * WSCALE8, bf2f(e[2]) * WSCALE8, bf2f(e[3]) * WSCALE8), pk4_fp8(bf2f(e[4]) * WSCALE8, bf2f(e[5]) * WSCALE8, bf2f(e[6]) * WSCALE8, bf2f(e[7]) * WSCALE8)};
        else *(u32x4*)(I.WT + (size_t)row * I.K + I.k0 + 8 * c) = (u32x4){(unsigned)e[0] | ((unsigned)e[1] << 16), (unsigned)e[2] | ((unsigned)e[3] << 16), (unsigned)e[4] | ((unsigned)e[5] << 16), (unsigned)e[6] | ((unsigned)e[7] << 16)}; }
    LDS_WAIT(); asm volatile("" ::: "memory");
}
__device__ __forceinline__ void rms_rows2_to_bf16(const float* __restrict__ x0, const float* __restrict__ x1, const float* __restrict__ g, bf16_t* __restrict__ o0, bf16_t* __restrict__ o1, int lane) {
    const f32x4* xa = (const f32x4*)x0 + lane; const f32x4* xb = (const f32x4*)x1 + lane; const f32x4* gr = (const f32x4*)g + lane;
    f32x4 va[4], vb[4]; float sa = 0.f, sb = 0.f;
#pragma unroll
    for (int j = 0; j < 4; ++j) { va[j] = xa[64 * j]; vb[j] = xb[64 * j]; }
#pragma unroll
    for (int j = 0; j < 4; ++j) { sa += (va[j].x * va[j].x + va[j].y * va[j].y) + (va[j].z * va[j].z + va[j].w * va[j].w); sb += (vb[j].x * vb[j].x + vb[j].y * vb[j].y) + (vb[j].z * vb[j].z + vb[j].w * vb[j].w); }
    const float ra = 1.0f / sqrtf(wave_sum(sa) * (1.0f / D) + EPS), rb = 1.0f / sqrtf(wave_sum(sb) * (1.0f / D) + EPS);
    unsigned long long* pa = (unsigned long long*)o0 + lane; unsigned long long* pb = (unsigned long long*)o1 + lane;
#pragma unroll
    for (int j = 0; j < 4; ++j) { const f32x4 gg = gr[64 * j];
        pa[64 * j] = (unsigned long long)pk2(va[j].x * ra * gg.x, va[j].y * ra * gg.y) | ((unsigned long long)pk2(va[j].z * ra * gg.z, va[j].w * ra * gg.w) << 32);
        pb[64 * j] = (unsigned long long)pk2(vb[j].x * rb * gg.x, vb[j].y * rb * gg.y) | ((unsigned long long)pk2(vb[j].z * rb * gg.z, vb[j].w * rb * gg.w) << 32); }
}

__device__ __forceinline__ void p0_prologue(Frame& F, const Args& a) {
    unsigned char* ws = a.ws;
    LAS unsigned char* tl = F.lds + F.wave * 8192;
    const int gw = F.vcu * NWAVES + F.wave, NGW = F.G * NWAVES;
    for (int m = 2 * gw; m < T; m += 2 * NGW) rms_rows2_to_bf16(a.in[0] + (size_t)m * D, a.in[0] + (size_t)(m + 1) * D, a.in[2], (bf16_t*)(ws + WS_XN) + (size_t)m * D, (bf16_t*)(ws + WS_XN) + (size_t)(m + 1) * D, F.lane);
    for (int m = 2 * gw; m < MROWS; m += 2 * NGW) rms_rows2_to_bf16(a.in[1] + (size_t)m * D, a.in[1] + (size_t)(m + 1) * D, a.in[8], (bf16_t*)(ws + WS_MN) + (size_t)m * D, (bf16_t*)(ws + WS_MN) + (size_t)(m + 1) * D, F.lane);
    for (int i = gw * 64 + F.lane; i < D * D / 4; i += NGW * 64) { const f32x4 w = ((const f32x4*)a.in[9])[i]; const float g = a.in[7][i >> 8];
        ((u32x2*)(ws + WS_WQ))[i] = (u32x2){pk2(w.x * g, w.y * g), pk2(w.z * g, w.w * g)}; }
    for (int i = gw * 64 + F.lane; i < NEXP * D; i += NGW * 64) { const int e = i >> 10, k = i & 1023; const float w = a.in[12][k] * a.in[13][k * NEXP + e];
        const unsigned hi = f2bf(w); ((bf16_t*)(ws + WS_WRT))[i] = (bf16_t)hi; ((bf16_t*)(ws + WS_WRT))[NEXP * D + i] = (bf16_t)f2bf(w - bf2f((unsigned short)hi)); }
    P0Item IA, IB; f32x4 va[16], vb[16];
    int it = gw; bool ha = p0_decode(a, it, IA); if (ha) p0_load(IA, va, F.lane);
    while (ha) {
        const bool hb = p0_decode(a, it + NGW, IB); if (hb) p0_load(IB, vb, F.lane);
        p0_store(IA, va, tl, F.lane);
        if (!hb) break;
        it += 2 * NGW; ha = p0_decode(a, it, IA); if (ha) p0_load(IA, va, F.lane);
        p0_store(IB, vb, tl, F.lane);
    }
}

__device__ __forceinline__ unsigned xcc_id() { return (unsigned)__builtin_amdgcn_s_getreg((3 << 11) | 20) & 0xFu; }
constexpr int QITEMS = 16 + 128;
__device__ __forceinline__ void p2_mixer(Frame& F, const Args& a, int rep) {
    unsigned char* ws = a.ws;
    const bf16_t* proj = (const bf16_t*)(ws + WS_PROJ); bf16_t* mix = (bf16_t*)(ws + WS_MIX);
    const unsigned x0 = xcc_id() & 7u;
    int par = 0;
#ifdef MK_P2_REPMODE
    if (rep && MK_P2_REPMODE == 4) return;
#endif
#ifdef MK_P2_HALF
    if (rep && (blockIdx.x & 8)) return;
#endif
    for (;;) {
        if (F.tid == 0) { int code = -1;
            for (int j = 0; j < 8; ++j) { const unsigned xq = (x0 + j) & 7u; const unsigned i = __hip_atomic_fetch_add(F.ctl + CW_QUEUE + 1024 * rep + 64 * xq, 1u, RLX_AGENT);
                if (i < (unsigned)QITEMS) { code = (int)(xq * 256u + i); break; } }
            F.MISC[par] = (unsigned)code; }
        LDS_WAIT(); __builtin_amdgcn_s_barrier(); asm volatile("" ::: "memory");
        const int code = __builtin_amdgcn_readfirstlane((int)F.MISC[par]); par ^= 1;
        if (code < 0) break;
        const int xq = code >> 8, i = code & 255;
#ifdef MK_P2_REPMODE
        if (rep && ((MK_P2_REPMODE == 1 && i >= 8) || (MK_P2_REPMODE == 2 && i < 16) || MK_P2_REPMODE == 3)) continue;
#endif
#ifndef NO_HGRN
        if (i < 8) { hgrn::hgrn_unit(xq, i, proj, mix, a.in[4], a.in[5], F.lds); }
        else
#endif
        if (i < 16) {
            pg8::KvOrder S{(const char*)(ws + WS_MN), (const char*)(ws + WS_WKV), xq * 8 + (i - 8)};
            pg8::EpiBf16 E{(bf16_t*)(ws + WS_MEMK), D, (bf16_t*)(ws + WS_MEMVT), D};
            pg8::gemm_phase<pg8::EpiBf16, pg8::KvOrder, false, false>(F.lds, D, D, D / 64, S, E);
        } else
#ifndef NO_MOBA
        { const int j = i - 16, g = j >> 5, jj = j & 31, hh = 2 * g + (jj & 1), qb = 15 - (jj >> 1);
            moba::attn_unit<8>(xq, hh, qb, proj, proj + SEC_ELEMS, proj + 2 * SEC_ELEMS, mix, (const float*)(ws + WS_KBAR), (char*)(unsigned char*)F.lds); }
#else
        {}
#endif
    }
}

__device__ __forceinline__ void p7_router(Frame& F, const Args& a, int rep) {
    unsigned char* ws = a.ws;
    constexpr int WRS = 2064;
    LAS unsigned char* WH = F.lds; LAS unsigned char* WL = F.lds + 32 * WRS;
    LAS int* hist = (LAS int*)(F.lds + TL_HIST); LAS int* basel = (LAS int*)(F.lds + TL_BASE);
    { const u32x4* src = (const u32x4*)(ws + WS_WRT);
      for (int i = F.tid; i < 2 * NEXP * D / 8; i += 512) { const int m = i >> 12, r = (i >> 7) & 31, c = i & 127; *(LAS u32x4*)(F.lds + m * 32 * WRS + r * WRS + c * 16) = src[i]; } }
    const float* h2f = (const float*)(ws + WS_H2F); const float* ss2 = (const float*)(ws + WS_SS2);
    int* toke = (int*)(ws + (rep ? WS_DUMMY + 1 * MiB : WS_TOKE)); int* tokr = (int*)(ws + (rep ? WS_DUMMY + 1 * MiB + 512 * 1024 : WS_TOKR)); float* tokg = (float*)(ws + (rep ? WS_DUMMY + 2 * MiB : WS_TOKG)); int* list = (int*)(ws + (rep ? WS_DUMMY + 4 * MiB : WS_LIST)); float* glist = (float*)(ws + (rep ? WS_DUMMY + 8 * MiB : WS_GLIST));
    unsigned* cntw = F.ctl + (rep ? CW_CNT + 2048 * rep : CW_CNT);
    const int lane = F.lane, r16 = lane & 15, g4 = lane >> 4;
    const float br0 = a.in[14][r16], br1 = a.in[14][16 + r16];
    for (int tb = blockIdx.x; tb < T / 128; tb += F.G) {
        if (F.tid < 32) hist[F.tid] = 0;
        LDS_WAIT(); __builtin_amdgcn_s_barrier(); asm volatile("" ::: "memory");
        const int t0 = tb * 128 + F.wave * 16;
        const float* xr = h2f + (size_t)(t0 + r16) * D + 8 * g4;
        f32x4 acc0 = (f32x4){0.f, 0.f, 0.f, 0.f}, acc1 = acc0;
        f32x4 xa = *(const f32x4*)(xr), xb = *(const f32x4*)(xr + 4);
#pragma unroll 4
        for (int ks = 0; ks < 32; ++ks) {
            const f32x4 ca = xa, cb = xb;
            if (ks + 1 < 32) { xa = *(const f32x4*)(xr + 32 * (ks + 1)); xb = *(const f32x4*)(xr + 32 * (ks + 1) + 4); }
            const unsigned h0 = cvtpk(ca.x, ca.y), h1 = cvtpk(ca.z, ca.w), h2 = cvtpk(cb.x, cb.y), h3 = cvtpk(cb.z, cb.w);
            const unsigned l0 = cvtpk(ca.x - bflo(h0), ca.y - bfhi(h0)), l1 = cvtpk(ca.z - bflo(h1), ca.w - bfhi(h1)), l2 = cvtpk(cb.x - bflo(h2), cb.y - bfhi(h2)), l3 = cvtpk(cb.z - bflo(h3), cb.w - bfhi(h3));
            const bf16x8 ah = __builtin_bit_cast(bf16x8, (u32x4){h0, h1, h2, h3}), al = __builtin_bit_cast(bf16x8, (u32x4){l0, l1, l2, l3});
            const int bo = r16 * WRS + (32 * ks + 8 * g4) * 2;
            const bf16x8 bh0 = *(const LAS bf16x8*)(WH + bo), bh1 = *(const LAS bf16x8*)(WH + 16 * WRS + bo), bl0 = *(const LAS bf16x8*)(WL + bo), bl1 = *(const LAS bf16x8*)(WL + 16 * WRS + bo);
            acc0 = __builtin_amdgcn_mfma_f32_16x16x32_bf16(ah, bh0, acc0, 0, 0, 0); acc1 = __builtin_amdgcn_mfma_f32_16x16x32_bf16(ah, bh1, acc1, 0, 0, 0);
            acc0 = __builtin_amdgcn_mfma_f32_16x16x32_bf16(ah, bl0, acc0, 0, 0, 0); acc1 = __builtin_amdgcn_mfma_f32_16x16x32_bf16(ah, bl1, acc1, 0, 0, 0);
            acc0 = __builtin_amdgcn_mfma_f32_16x16x32_bf16(al, bh0, acc0, 0, 0, 0); acc1 = __builtin_amdgcn_mfma_f32_16x16x32_bf16(al, bh1, acc1, 0, 0, 0);
        }
        int my_e = 0; float my_g = 0.f;
#pragma unroll
        for (int j = 0; j < 4; ++j) {
            const float rs = __builtin_amdgcn_rsqf(ss2[t0 + 4 * g4 + j] * (1.0f / D) + EPS);
            float a0 = acc0[j] * rs + br0, a1 = acc1[j] * rs + br1; float tv[4]; int te_[4];
#pragma unroll
            for (int k = 0; k < 4; ++k) { float m = fmaxf(a0, a1);
#pragma unroll
                for (int o = 1; o < 16; o <<= 1) m = fmaxf(m, __shfl_xor(m, o));
                int e = (a0 == m) ? r16 : ((a1 == m) ? 16 + r16 : 99);
#pragma unroll
                for (int o = 1; o < 16; o <<= 1) e = min(e, __shfl_xor(e, o));
                tv[k] = m; te_[k] = e; if (e == r16) a0 = -INFINITY; if (e == 16 + r16) a1 = -INFINITY; }
            const float d1 = fast_exp2((tv[1] - tv[0]) * LOG2E), d2 = fast_exp2((tv[2] - tv[0]) * LOG2E), d3 = fast_exp2((tv[3] - tv[0]) * LOG2E);
            const float inv = 1.0f / (1.0f + d1 + d2 + d3);
            if ((r16 >> 2) == j) { const int k = lane & 3; my_e = k == 0 ? te_[0] : (k == 1 ? te_[1] : (k == 2 ? te_[2] : te_[3])); my_g = (k == 0 ? 1.0f : (k == 1 ? d1 : (k == 2 ? d2 : d3))) * inv; }
        }
        const int rl = __hip_atomic_fetch_add(hist + my_e, 1, __ATOMIC_RELAXED, __HIP_MEMORY_SCOPE_WORKGROUP);
        LDS_WAIT(); __builtin_amdgcn_s_barrier(); asm volatile("" ::: "memory");
        if (F.tid < 32) basel[F.tid] = (int)__hip_atomic_fetch_add(cntw + F.tid, (unsigned)hist[F.tid], RLX_AGENT);
        LDS_WAIT(); VM_WAIT(); __builtin_amdgcn_s_barrier(); asm volatile("" ::: "memory");
        { const int t = t0 + 4 * g4 + (r16 >> 2), k = lane & 3; const int rank = basel[my_e] + rl;
          toke[t * 4 + k] = my_e; tokr[t * 4 + k] = rank; tokg[t * 4 + k] = my_g; list[(size_t)my_e * T + rank] = t; glist[(size_t)my_e * T + rank] = my_g; }
        LDS_WAIT(); __builtin_amdgcn_s_barrier(); asm volatile("" ::: "memory");
    }
}

__device__ __forceinline__ int build_tables(Frame& F) {
    LAS int* ts = (LAS int*)(F.lds + TL_TS); LAS unsigned char* te = (LAS unsigned char*)(F.lds + TL_TE);
    if (F.tid == 0) { int run = 0;
        for (int e = 0; e < NEXP; ++e) { ts[e] = run; const unsigned c = __hip_atomic_load(F.ctl + CW_CNT + e, RLX_AGENT); ((LAS int*)(F.lds + TL_CNT))[e] = (int)c; run += (int)((c + 255u) >> 8); }
        ts[NEXP] = run; }
    LDS_WAIT(); __builtin_amdgcn_s_barrier(); asm volatile("" ::: "memory");
    const int nt = ts[NEXP];
    for (int g = F.tid; g < nt; g += 512) { int e = 0;
        for (int j = 1; j < NEXP; ++j) e += (ts[j] <= g) ? 1 : 0;
        te[g] = (unsigned char)e; }
    LDS_WAIT(); __builtin_amdgcn_s_barrier(); asm volatile("" ::: "memory");
    return __builtin_amdgcn_readfirstlane(nt);
}

__device__ __forceinline__ void p10_combine(Frame& F, const Args& a) {
    unsigned char* ws = a.ws;
    LAS int* ts = (LAS int*)(F.lds + TL_TS);
    const float* h2f = (const float*)(ws + WS_H2F); const unsigned char* Y = (const unsigned char*)(ws + WS_Y);
    const int* toke = (const int*)(ws + WS_TOKE); const int* tokr = (const int*)(ws + WS_TOKR);
    const float* gf = a.in[19];
    const int gw = F.vcu * NWAVES + F.wave, NGW = F.G * NWAVES, lane = F.lane;
    for (int t0 = 2 * gw; t0 < T; t0 += 2 * NGW) {
        float o[2][16]; u32x2 y[2][4][2];
#pragma unroll
        for (int q = 0; q < 2; ++q) { const int t = t0 + q;
#pragma unroll
            for (int k = 0; k < 4; ++k) { const int e = toke[t * 4 + k], r = tokr[t * 4 + k]; const unsigned char* yr = Y + ((size_t)ts[e] * 256 + r) * D;
                y[q][k][0] = *(const u32x2*)(yr + 8 * lane); y[q][k][1] = *(const u32x2*)(yr + 512 + 8 * lane); }
            const f32x4 a0 = *(const f32x4*)(h2f + (size_t)t * D + 8 * lane), a1 = *(const f32x4*)(h2f + (size_t)t * D + 8 * lane + 4), a2 = *(const f32x4*)(h2f + (size_t)t * D + 512 + 8 * lane), a3 = *(const f32x4*)(h2f + (size_t)t * D + 512 + 8 * lane + 4);
            o[q][0] = a0.x; o[q][1] = a0.y; o[q][2] = a0.z; o[q][3] = a0.w; o[q][4] = a1.x; o[q][5] = a1.y; o[q][6] = a1.z; o[q][7] = a1.w; o[q][8] = a2.x; o[q][9] = a2.y; o[q][10] = a2.z; o[q][11] = a2.w; o[q][12] = a3.x; o[q][13] = a3.y; o[q][14] = a3.z; o[q][15] = a3.w; }
#pragma unroll
        for (int q = 0; q < 2; ++q) {
#pragma unroll
            for (int k = 0; k < 4; ++k)
#pragma unroll
                for (int hf = 0; hf < 2; ++hf) { const u32x2 w = y[q][k][hf];
                    const f32x2 c0 = __builtin_amdgcn_cvt_pk_f32_fp8((int)w.x, false), c1 = __builtin_amdgcn_cvt_pk_f32_fp8((int)w.x, true), c2 = __builtin_amdgcn_cvt_pk_f32_fp8((int)w.y, false), c3 = __builtin_amdgcn_cvt_pk_f32_fp8((int)w.y, true);
                    o[q][8 * hf + 0] += pg8::YSCALE_INV * c0.x; o[q][8 * hf + 1] += pg8::YSCALE_INV * c0.y; o[q][8 * hf + 2] += pg8::YSCALE_INV * c1.x; o[q][8 * hf + 3] += pg8::YSCALE_INV * c1.y;
                    o[q][8 * hf + 4] += pg8::YSCALE_INV * c2.x; o[q][8 * hf + 5] += pg8::YSCALE_INV * c2.y; o[q][8 * hf + 6] += pg8::YSCALE_INV * c3.x; o[q][8 * hf + 7] += pg8::YSCALE_INV * c3.y; }
            float s = 0.f;
#pragma unroll
            for (int j = 0; j < 16; ++j) s += o[q][j] * o[q][j];
            const float rstd = 1.0f / sqrtf(wave_sum(s) * (1.0f / D) + EPS);
            float* op = a.out + (size_t)(t0 + q) * D;
#pragma unroll
            for (int v = 0; v < 4; ++v) { const int col = (v >> 1) * 512 + 8 * lane + (v & 1) * 4; const f32x4 g4 = *(const f32x4*)(gf + col);
                *(f32x4*)(op + col) = (f32x4){o[q][4 * v] * rstd * g4.x, o[q][4 * v + 1] * rstd * g4.y, o[q][4 * v + 2] * rstd * g4.z, o[q][4 * v + 3] * rstd * g4.w}; }
        }
    }
}

#define XB_TMO      128
#define XB_XCNT(j)  (256  + 64 * (j))
#define XB_XSUB(j)  (1280 + 64 * (j))
#define XB_XGEN(j)  (2304 + 64 * (j))
#define XB_TOP      3328
#define XB_TOPGEN   3392
#define XCD_BAR_WORDS 3456
#define XB_SPIN_CAP (1u << 22)
__device__ __forceinline__ unsigned xb_ld(unsigned* p)              { return __hip_atomic_load(p, __ATOMIC_RELAXED, __HIP_MEMORY_SCOPE_AGENT); }
__device__ __forceinline__ unsigned xb_add(unsigned* p, unsigned v) { return __hip_atomic_fetch_add(p, v, __ATOMIC_RELAXED, __HIP_MEMORY_SCOPE_AGENT); }
#define XB_SPIN(cond, bar) do { unsigned _sp = 0; while (cond) { __builtin_amdgcn_s_sleep(1); \
    if ((++_sp & 255u) == 0u) { if (xb_ld(&(bar)[XB_TMO])) break; if (_sp > XB_SPIN_CAP) { atomicAdd(&(bar)[XB_TMO], 1u); break; } } } } while (0)
struct XcdBarrier { unsigned* bar; unsigned x; volatile LAS unsigned* st; };
__device__ __forceinline__ XcdBarrier xcd_barrier_post(unsigned* bar, volatile LAS unsigned* st) {
    XcdBarrier b; b.bar = bar; b.x = (unsigned)__builtin_amdgcn_s_getreg((3 << 11) | 20) & 0xFu; b.st = st;
    if (threadIdx.x == 0) (void)xb_add(&bar[XB_XCNT(b.x)], 1u);
    return b;
}
__device__ __forceinline__ void xcd_barrier_complete(unsigned* bar, unsigned x, unsigned& nloc, unsigned& nx) {
    const unsigned G = gridDim.x * gridDim.y * gridDim.z;
    unsigned sum, cnt, mine, sp = 0u;
    for (;;) {
        sum = 0u; cnt = 0u; mine = 0u;
#pragma unroll
        for (unsigned j = 0; j < 16; ++j) { const unsigned c = xb_ld(&bar[XB_XCNT(j)]); sum += c; cnt += (c > 0u) ? 1u : 0u; mine = (j == x) ? c : mine; }
        if (sum == G) break;
        __builtin_amdgcn_s_sleep(1);
        if ((++sp & 255u) == 0u) { if (xb_ld(&bar[XB_TMO])) break; if (sp > XB_SPIN_CAP) { atomicAdd(&bar[XB_TMO], 1u); break; } }
    }
    nloc = mine > 0u ? mine : 1u; nx = cnt > 0u ? cnt : 1u;
}
__device__ __forceinline__ void xcd_barrier(const XcdBarrier& b) {
    asm volatile("s_waitcnt vmcnt(0)" ::: "memory");
    __syncthreads();
    if (threadIdx.x == 0) {
        unsigned* bar = b.bar;
        __builtin_amdgcn_s_waitcnt(0);
        unsigned nloc = b.st[0], nx = b.st[1];
        if (nloc == 0u) { xcd_barrier_complete(bar, b.x, nloc, nx); b.st[0] = nloc; b.st[1] = nx; }
        const unsigned old = xb_add(&bar[XB_XSUB(b.x)], 1u);
        const unsigned gen = old / nloc;
        if (old + 1u == (gen + 1u) * nloc) {
            __builtin_amdgcn_fence(__ATOMIC_RELEASE, "agent");
            asm volatile("s_waitcnt vmcnt(0)" ::: "memory");
            const unsigned og = xb_add(&bar[XB_TOP], 1u);
            const unsigned tg = og / nx;
            if (og + 1u == (tg + 1u) * nx) xb_add(&bar[XB_TOPGEN], 1u);
            else XB_SPIN(xb_ld(&bar[XB_TOPGEN]) == tg, bar);
            __builtin_amdgcn_fence(__ATOMIC_ACQUIRE, "agent");
            xb_add(&bar[XB_XGEN(b.x)], 1u);
            asm volatile("s_waitcnt vmcnt(0)" ::: "memory");
        } else {
            XB_SPIN(xb_ld(&bar[XB_XGEN(b.x)]) == gen, bar);
            __builtin_amdgcn_fence(__ATOMIC_ACQUIRE, "agent");
            asm volatile("s_waitcnt vmcnt(0)" ::: "memory");
        }
    }
    __syncthreads();
}
#ifndef MK_CG_ONLY
#define MK_CG_ONLY 0
#endif
__device__ __forceinline__ void grid_barrier(Frame& F, const XcdBarrier& xb_) { if (MK_CG_ONLY) cg::this_grid().sync(); else xcd_barrier(xb_); }
#ifndef MK_PHASE_MASK
#define MK_PHASE_MASK 0x7ff
#endif
#ifndef MK_REP_PHASE
#define MK_REP_PHASE -1
#endif
#ifndef MK_REP_N
#define MK_REP_N 0
#endif
__device__ __forceinline__ void ph0(Frame& F, const Args& args, int rep) { p0_prologue(F, args); }
__device__ __forceinline__ void ph1(Frame& F, const Args& args, int rep) {
    unsigned char* ws = args.ws; const int cid = (int)blockIdx.x;
    { pg8::DenseOrder S{(const char*)(ws + WS_XN), (const char*)(ws + WS_WIN), D, D, T / 256, INC / 256, F.G, cid};
      pg8::EpiProj E{(bf16_t*)(ws + WS_PROJ), rep ? (float*)(ws + WS_DUMMY) : (float*)(ws + WS_KBAR)};
      pg8::gemm_phase<pg8::EpiProj, pg8::DenseOrder, false, true>(F.lds, D, D, D / 64, S, E); }
}
__device__ __forceinline__ void ph2(Frame& F, const Args& args, int rep) { p2_mixer(F, args, rep); }
constexpr size_t WS_MB = WS_PROJ, WS_NB = WS_PROJ + 16 * MiB, WS_H1Q = WS_PROJ + 32 * MiB, WS_PB = WS_QX;
constexpr size_t WS_UNUSED_XA = 0;
constexpr int LDS_XTAB = 131072;
__device__ __forceinline__ void ph3(Frame& F, const Args& args, int rep) {
    unsigned char* ws = args.ws; const int cid = (int)blockIdx.x;
    { pg8::XmnOrder S{(const char*)(ws + WS_MEMK), (const char*)(ws + WS_MEMVT), (const char*)(ws + WS_WQ), (const char*)(ws + WS_WO), F.G, cid};
      pg8::EpiFp8 E{(unsigned char*)(ws + WS_MB), D, (unsigned char*)(ws + WS_NB), D, XSCALE8};
      pg8::gemm_phase<pg8::EpiFp8, pg8::XmnOrder, false, true>(F.lds, D, D, 4, S, E); }
    pg8::DenseOrder S{(const char*)(ws + WS_MIX), (const char*)(ws + WS_WOUT), D, D, T / 256, D / 256, F.G, cid};
    pg8::EpiRes<true, false> E{(const void*)args.in[0], (bf16_t*)(ws + WS_H1B), nullptr, rep ? (float*)(ws + WS_DUMMY + 512 * 1024) : (float*)(ws + WS_SS1), 1.0f, (unsigned char*)(ws + WS_H1Q)};
    pg8::gemm_phase<pg8::EpiRes<true, false>, pg8::DenseOrder, false, true>(F.lds, D, D, D / 64, S, E);
}
__device__ __forceinline__ void ph4(Frame& F, const Args& args, int rep) {
    unsigned char* ws = args.ws; const int cid = (int)blockIdx.x;
    pg8::XbOrder S{(const char*)(ws + WS_H1Q), (const char*)(ws + WS_MB), F.G, cid, (size_t)D};
    pg8::EpiSoftmaxS E{(unsigned char*)(ws + WS_PB), (const float*)(ws + WS_SS1), F.lds + LDS_XTAB, XSCALE8_INV};
    pg8::gemm_phase<pg8::EpiSoftmaxS, pg8::XbOrder, false, true, true>(F.lds, D / 2, D / 2, D / 128, S, E);
}
__device__ __forceinline__ void ph5(Frame& F, const Args& args, int rep) {}
__device__ __forceinline__ void ph6(Frame& F, const Args& args, int rep) {
    unsigned char* ws = args.ws; const int cid = (int)blockIdx.x;
    pg8::XbOrder S{(const char*)(ws + WS_PB), (const char*)(ws + WS_NB), F.G, cid, (size_t)D};
    pg8::EpiRes<false, true, true> E{(const void*)(ws + WS_H1B), (bf16_t*)(ws + WS_H2B), (float*)(ws + WS_H2F), rep ? (float*)(ws + WS_DUMMY + 512 * 1024) : (float*)(ws + WS_SS2), PSCALE8_INV * XSCALE8_INV, nullptr};
    pg8::gemm_phase<pg8::EpiRes<false, true, true>, pg8::XbOrder, false, true, true>(F.lds, D / 2, D / 2, D / 128, S, E);
}
__device__ __forceinline__ void ph7(Frame& F, const Args& args, int rep) { p7_router(F, args, rep); }
__device__ __forceinline__ void ph8(Frame& F, const Args& args, int rep) {
    unsigned char* ws = args.ws; const int cid = (int)blockIdx.x;
    const int ntl = build_tables(F);
    pg8::MoeOrder S{(const char*)(ws + WS_H2B), (const char*)(ws + WS_W1), (const int*)(ws + WS_LIST), (const LAS int*)(F.lds + TL_CNT), (const LAS unsigned char*)(F.lds + TL_TE), (const LAS int*)(F.lds + TL_TS),
                    ntl, 8, F.G, cid, (size_t)2048 * D, 1, (size_t)256 * D, (size_t)256 * D};
    pg8::EpiW1 E{(bf16_t*)(ws + WS_HMID), (const float*)(ws + WS_SS2), args.in[16]};
    pg8::gemm_phase<pg8::EpiW1, pg8::MoeOrder, true, true, true>(F.lds, D / 2, D / 2, D / 128, S, E);
}
__device__ __forceinline__ void ph9(Frame& F, const Args& args, int rep) {
    unsigned char* ws = args.ws; const int cid = (int)blockIdx.x;
    const int ntl = build_tables(F);
    pg8::MoeOrder S{(const char*)(ws + WS_HMID), (const char*)(ws + WS_W2), (const int*)(ws + WS_LIST), (const LAS int*)(F.lds + TL_CNT), (const LAS unsigned char*)(F.lds + TL_TE), (const LAS int*)(F.lds + TL_TS),
                    ntl, 4, F.G, cid, (size_t)D * D, 0, (size_t)256 * D, (size_t)256 * D};
    pg8::EpiW2 E{(unsigned char*)(ws + WS_Y), args.in[18], (const int*)(ws + WS_LIST), (const float*)(ws + WS_GLIST)};
    pg8::gemm_phase<pg8::EpiW2, pg8::MoeOrder, false, true, true>(F.lds, D / 2, D / 2, D / 128, S, E);
}
__device__ __forceinline__ void ph10(Frame& F, const Args& args, int rep) { (void)build_tables(F); p10_combine(F, args); }

constexpr int N_PHASES = 11;
__global__ void __launch_bounds__(NWAVES * 64, 2) hymba_fwd(Args args) {
    extern __shared__ __attribute__((aligned(16))) unsigned char lds_raw[];
    Frame F;
    F.lds = (LAS unsigned char*)lds_raw;
    F.MISC = (volatile LAS unsigned*)(F.lds + TL_MISC);
    F.tid = threadIdx.x; F.lane = F.tid & 63; F.wave = __builtin_amdgcn_readfirstlane(F.tid >> 6);
    F.G = gridDim.x; { const int bx = blockIdx.x; F.vcu = (F.G % 8 == 0) ? (bx % 8) * (F.G / 8) + bx / 8 : bx; }
    F.ctl = (unsigned*)(args.ws + WS_CTL);
    const int lo = args.ph_lo, hi = args.ph_hi;
    for (int u = F.tid; u < 64; u += NWAVES * 64) ((LAS unsigned*)(F.lds + TL_MISC))[u] = 0u;
    __syncthreads();
    const XcdBarrier xbar = xcd_barrier_post(F.ctl + CW_BAR, F.MISC + 8);
#define RUN(k, fn) do { if (((MK_PHASE_MASK >> (k)) & 1) && lo <= (k) && (k) < hi) { fn(F, args, 0); \
        if (MK_REP_PHASE == (k) && MK_REP_N >= 1) { grid_barrier(F, xbar); fn(F, args, 1); } \
        if (MK_REP_PHASE == (k) && MK_REP_N >= 2) { grid_barrier(F, xbar); fn(F, args, 2); } \
        if ((k) + 1 < hi) { if ((k) == 0) cg::this_grid().sync(); else grid_barrier(F, xbar); } } } while (0)
    RUN(0, ph0); RUN(1, ph1); RUN(2, ph2); RUN(3, ph3); RUN(4, ph4);   RUN(6, ph6); RUN(7, ph7); RUN(8, ph8); RUN(9, ph9); RUN(10, ph10);
#undef RUN
}

extern "C" void kernel_launch(void* const* d_in, const int* in_sizes, int n_in, void* d_out, int out_size, void* d_ws, size_t ws_size, hipStream_t stream) {
    static int grid = 0;
    if (grid == 0) {
        if (n_in != 20 || in_sizes[0] != T * D || out_size != T * D || ws_size < WS_END) {
            fprintf(stderr, "kernel_launch: shape/workspace mismatch (n_in %d, in0 %d, out %d, ws %zu, need %zu)\n", n_in, n_in > 0 ? in_sizes[0] : -1, out_size, ws_size, (size_t)WS_END); grid = -1; return; }
        int dev = 0, cus = 0, per_cu = 0;
        if (hipGetDevice(&dev) != hipSuccess || hipDeviceGetAttribute(&cus, hipDeviceAttributeMultiprocessorCount, dev) != hipSuccess) { grid = -1; return; }
        if (hipFuncSetAttribute((const void*)hymba_fwd, hipFuncAttributeMaxDynamicSharedMemorySize, LDS_BYTES) != hipSuccess) { fprintf(stderr, "kernel_launch: hipFuncSetAttribute failed\n"); grid = -1; return; }
        if (hipOccupancyMaxActiveBlocksPerMultiprocessor(&per_cu, (const void*)hymba_fwd, NWAVES * 64, LDS_BYTES) != hipSuccess || per_cu < 1) { fprintf(stderr, "kernel_launch: occupancy query says %d\n", per_cu); }
        (void)hipGetLastError();
        grid = cus;
        if (grid != 256) fprintf(stderr, "kernel_launch: %d CUs; this kernel is built for 256\n", grid);
    }
    if (grid < 0) return;
    (void)hipMemsetAsync((char*)d_ws + WS_CTL, 0, CTL_ZERO_BYTES, stream);
    Args a{};
    for (int i = 0; i < 20; ++i) a.in[i] = (const float*)d_in[i];
    a.out = (float*)d_out; a.ws = (unsigned char*)d_ws;
#if MK_N_LAUNCHES == 1
    a.ph_lo = 0; a.ph_hi = MK_LAST_PHASE + 1;
    void* kargs[] = {&a};
    hipError_t e = hipLaunchCooperativeKernel((const void*)hymba_fwd, dim3(grid), dim3(NWAVES * 64), kargs, LDS_BYTES, stream);
    if (e != hipSuccess) fprintf(stderr, "kernel_launch: cooperative launch failed: %s\n", hipGetErrorString(e));
#else
    for (int p = 0; p <= MK_LAST_PHASE; ++p) { a.ph_lo = p; a.ph_hi = p + 1; hipLaunchKernelGGL(hymba_fwd, dim3(grid), dim3(NWAVES * 64), LDS_BYTES, stream, a); }
#endif
}
```

```cpp
#include <hip/hip_runtime.h>
#include <hip/hip_cooperative_groups.h>
#include <cstdio>
#include <cstdint>
namespace cg = cooperative_groups;

#ifndef MK_N_LAUNCHES
#define MK_N_LAUNCHES 1
#endif
#ifndef MK_LAST_PHASE
#define MK_LAST_PHASE 10
#endif

#define LAS __attribute__((address_space(3)))
#define GAS __attribute__((address_space(1)))
typedef unsigned short bf16_t;
typedef short bf16x8 __attribute__((ext_vector_type(8)));
typedef short s16x4 __attribute__((ext_vector_type(4)));
typedef float f32x4 __attribute__((ext_vector_type(4)));
typedef float f32x2 __attribute__((ext_vector_type(2)));
typedef float f32x16 __attribute__((ext_vector_type(16)));
typedef unsigned u32x4 __attribute__((ext_vector_type(4)));
typedef unsigned u32x2 __attribute__((ext_vector_type(2)));
typedef int v8i32_t __attribute__((ext_vector_type(8)));

constexpr int BATCH = 8, SEQ = 4096, T = BATCH * SEQ, D = 1024, INC = 3584, NMEM = 256, MROWS = BATCH * NMEM;
constexpr int NEXP = 32, TOPK = 4, MT_MAX = T * TOPK / 256 + NEXP, MPAD = MT_MAX * 256;
constexpr float EPS = 1e-6f;
constexpr float LOG2E = 1.4426950408889634f;
constexpr float C2Q = 0.125f * LOG2E;
constexpr float C2X = 0.0625f * LOG2E;
constexpr int C_MQ = 0, C_MK = 512, C_MV = 1024, C_GQ = 1536, C_GF = 2048, C_GI = 2560, C_GG = 3072;

constexpr size_t MiB = 1u << 20;
constexpr size_t WS_CTL = 0, CTL_ZERO_BYTES = 2 * MiB;
constexpr size_t WS_KBAR = 1 * MiB;
constexpr size_t WS_SS1 = 1 * MiB + 256 * 1024;
constexpr size_t WS_SS2 = 1 * MiB + 384 * 1024;
constexpr size_t WS_TOKE = 2 * MiB, WS_TOKR = 2 * MiB + 512 * 1024, WS_TOKG = 3 * MiB;
constexpr size_t WS_WRT = 3 * MiB + 512 * 1024;
constexpr size_t WS_LIST = 4 * MiB;
constexpr size_t WS_GLIST = 8 * MiB;
constexpr size_t WS_SSLIST = 12 * MiB;
constexpr size_t WS_WIN = 16 * MiB, WS_WOUT = 23 * MiB, WS_WQ = 25 * MiB, WS_WKV = 27 * MiB, WS_WO = 31 * MiB;
constexpr size_t WS_MN = 33 * MiB, WS_MEMK = 37 * MiB, WS_MEMVT = 41 * MiB;
constexpr size_t WS_W1 = 48 * MiB, WS_W2 = 176 * MiB;
constexpr size_t WS_PROJ = 240 * MiB;
constexpr size_t SEC_ELEMS = (size_t)16 * 1024 * 1024;
constexpr size_t WS_XN = 464 * MiB;
constexpr size_t WS_OX = 464 * MiB;
constexpr size_t WS_MIX = 528 * MiB;
constexpr size_t WS_H1B = 592 * MiB;
constexpr size_t WS_QX = 656 * MiB;
constexpr size_t WS_PWS = 720 * MiB;
constexpr size_t WS_HMID = 240 * MiB;
constexpr size_t WS_Y = 512 * MiB;
constexpr size_t WS_H2F = 784 * MiB;
constexpr size_t WS_H2B = 912 * MiB;
constexpr size_t WS_DUMMY = 976 * MiB;
constexpr size_t WS_END = 992 * MiB;
static_assert(WS_HMID + (size_t)MPAD * D * 2 <= WS_Y && WS_Y + (size_t)MPAD * D * 2 <= WS_H2F, "ws map");
constexpr int CW_TMO = 0;
constexpr int CW_CNT = 64;
constexpr int CW_QUEUE = 128;
constexpr int CW_BAR = 4096;

__device__ __forceinline__ unsigned f2bf(float f) { unsigned u = __builtin_bit_cast(unsigned, f); return (u + 0x7fffu + ((u >> 16) & 1u)) >> 16; }
__device__ __forceinline__ unsigned pk2(float lo, float hi) { return f2bf(lo) | (f2bf(hi) << 16); }
__device__ __forceinline__ float bf2f(unsigned short h) { return __builtin_bit_cast(float, (unsigned)h << 16); }
__device__ __forceinline__ float bflo(unsigned w) { return __builtin_bit_cast(float, w << 16); }
__device__ __forceinline__ float bfhi(unsigned w) { return __builtin_bit_cast(float, w & 0xffff0000u); }
typedef float f32x2_t __attribute__((ext_vector_type(2))); typedef __bf16 bf16x2_t __attribute__((ext_vector_type(2)));
__device__ __forceinline__ unsigned cvtpk(float lo, float hi) { f32x2_t v = {lo, hi}; bf16x2_t b = __builtin_convertvector(v, bf16x2_t); return __builtin_bit_cast(unsigned, b); }
__device__ __forceinline__ float wave_sum(float v) {
#pragma unroll
    for (int o = 1; o < 64; o <<= 1) v += __shfl_xor(v, o);
    return v;
}
__device__ __forceinline__ float fast_exp2(float x) { return __builtin_amdgcn_exp2f(x); }
__device__ __forceinline__ float fast_rcp(float x) { return __builtin_amdgcn_rcpf(x); }
__device__ __forceinline__ float silu_f(float x) { return x * fast_rcp(1.0f + fast_exp2(-x * LOG2E)); }
__device__ __forceinline__ unsigned pk4_fp8(float a, float b, float c, float d) { int w = 0; w = __builtin_amdgcn_cvt_pk_fp8_f32(a, b, w, false); w = __builtin_amdgcn_cvt_pk_fp8_f32(c, d, w, true); return (unsigned)w; }
constexpr float XSCALE8 = 4.0f, XSCALE8_INV = 0.25f, PSCALE8 = 256.0f, PSCALE8_INV = 1.0f / 256.0f;
constexpr float WSCALE8 = 32.0f, WSCALE8_INV = 1.0f / 32.0f;
#define LDS_WAIT() asm volatile("s_waitcnt lgkmcnt(0)" ::: "memory")
#define VM_WAIT() asm volatile("s_waitcnt vmcnt(0)" ::: "memory")
#define RLX_AGENT __ATOMIC_RELAXED, __HIP_MEMORY_SCOPE_AGENT

namespace pg8 {
constexpr int BM = 256, BK = 64, HALF = 128, HTB = HALF * BK * 2, STAGE_BYTES = 8 * HTB;
__device__ __forceinline__ unsigned gload32_hidden(const void* sbase, unsigned voff) { unsigned v; asm volatile("global_load_dword %0, %1, %2" : "=v"(v) : "v"(voff), "s"(sbase) : "memory"); return v; }
__device__ __forceinline__ void glds16s(const char* sbase, unsigned voff, unsigned lds_dst) { unsigned keep;
    asm volatile("s_mov_b32 %0, m0\n\ts_mov_b32 m0, %3\n\ts_nop 0\n\tglobal_load_lds_dwordx4 %1, %2\n\ts_mov_b32 m0, %0" : "=&s"(keep) : "v"(voff), "s"(sbase), "s"(lds_dst) : "memory"); }
__host__ __device__ __forceinline__ int lds_byte(int r, int c) { const int st = (r >> 4) * 2 + (c >> 5), rr = r & 15, cc = c & 31, ob = rr * 64 + cc * 2; return st * 1024 + (ob ^ (((ob >> 9) & 1) << 5)); }
__host__ __device__ __forceinline__ void stage_rc(int b, int& R, int& C) { const int st = b / 1024, sb = b % 1024, swz = sb ^ (((sb >> 9) & 1) << 5); R = (st >> 1) * 16 + swz / 64; C = (st & 1) * 32 + (swz % 64) / 2; }
__host__ __device__ __forceinline__ int perm32(int rho) { const int n = rho >> 4, i = rho & 15; return 8 * (i >> 2) + 4 * n + (i & 3); }

struct Unit { const char* A; const char* B; const int* rows; int pm, pn, aux, nrows; };

template <class Epi, class Sched, bool GATHER, bool ALIGN_EPI, bool FP8 = false>
__device__ __forceinline__ void gemm_phase(LAS unsigned char* lds, const int lda, const int ldb, const int nt_in, const Sched& S, const Epi& E) {
    int nt = nt_in; asm volatile("" : "+s"(nt));
    int tid_ = threadIdx.x; asm volatile("" : "+v"(tid_));
    const int tid = tid_, wid = __builtin_amdgcn_readfirstlane(tid >> 6), lane = tid & 63, wr = wid >> 2, wc = wid & 3, fr = lane & 15, fq = lane >> 4;
    unsigned offB0; { int R, C; stage_rc(tid * 16, R, C); const int Rb = Epi::PERM ? ((R & ~31) + perm32(R & 31)) : R; offB0 = (unsigned)(Rb * ldb + C) * 2u; }
    const size_t pstepB = (size_t)64 * ldb * 2;
    const size_t kstep = (size_t)(BK * 2);
    const size_t hstepB = (size_t)HALF * ldb * 2;
    const unsigned ldsb = (unsigned)__builtin_amdgcn_readfirstlane((int)((unsigned)(uintptr_t)(unsigned char*)lds + (unsigned)wid * 1024u));
    const int aoff = lds_byte(wr * 64 + fr, FP8 ? fq * 16 : fq * 8), boff = lds_byte(wc * 32 + fr, FP8 ? fq * 16 : fq * 8);
#define PG8_SA(b, h) (((b) * 2 + (h)) * HTB)
#define PG8_SB(b, h) ((4 + (b) * 2 + (h)) * HTB)
#define PG8_STGB(bufoff, gbase) do { glds16s((const char*)(gbase), offB0, ldsb + (unsigned)(bufoff)); glds16s((const char*)(gbase) + pstepB, offB0, ldsb + (unsigned)(bufoff) + 8192u); } while (0)
#define PG8_LD16(p_) (*(const LAS u32x4*)(p_))
#define PG8_CAT(x, y) __builtin_bit_cast(v8i32_t, __builtin_shufflevector(x, y, 0, 1, 2, 3, 4, 5, 6, 7))
    unsigned aA0 = (unsigned)(aoff + PG8_SA(0, 0)), aA1 = (unsigned)(aoff + PG8_SA(1, 0)), bB0 = (unsigned)(boff + PG8_SB(0, 0)), bB1 = (unsigned)(boff + PG8_SB(1, 0));
    asm volatile("" : "+v"(aA0), "+v"(aA1), "+v"(bB0), "+v"(bB1));
    int scl8 = 0x7f7f7f7f; asm volatile("" : "+v"(scl8));
#define PG8_LDA(dst, b, h) do { const LAS unsigned char* ap_ = lds + ((b) ? aA1 : aA0) + (h) * HTB; _Pragma("unroll") for (int m = 0; m < 4; ++m) { \
        if constexpr (FP8) { dst##8[m] = PG8_CAT(PG8_LD16(ap_ + m * 2048), PG8_LD16(ap_ + m * 2048 + 16)); } \
        else { _Pragma("unroll") for (int k = 0; k < 2; ++k) dst[m][k] = *(const LAS bf16x8*)(ap_ + m * 2048 + k * 1024); } } } while (0)
#define PG8_LDB(dst, b, h) do { const LAS unsigned char* bp_ = lds + ((b) ? bB1 : bB0) + (h) * HTB; _Pragma("unroll") for (int n = 0; n < 2; ++n) { \
        if constexpr (FP8) { dst##8[n] = PG8_CAT(PG8_LD16(bp_ + n * 2048), PG8_LD16(bp_ + n * 2048 + 16)); } \
        else { _Pragma("unroll") for (int k = 0; k < 2; ++k) dst[n][k] = *(const LAS bf16x8*)(bp_ + n * 2048 + k * 1024); } } } while (0)
#define PG8_MMA(ai, bj, At, Bt) do { __builtin_amdgcn_s_setprio(1); _Pragma("unroll") for (int m = 0; m < 4; ++m) _Pragma("unroll") for (int n = 0; n < 2; ++n) { \
        if constexpr (FP8) asm volatile("v_mfma_scale_f32_16x16x128_f8f6f4 %0, %1, %2, %0, %3, %3 op_sel_hi:[0,0,0]" : "+v"(acc[ai][bj][m][n]) : "v"(Bt##8[n]), "v"(At##8[m]), "v"(scl8));   \
        else { _Pragma("unroll") for (int k = 0; k < 2; ++k) acc[ai][bj][m][n] = __builtin_amdgcn_mfma_f32_16x16x32_bf16(Bt[n][k], At[m][k], acc[ai][bj][m][n], 0, 0, 0); } } \
        __builtin_amdgcn_s_setprio(0); } while (0)
#define PG8_WAIT_V(n) asm volatile("s_waitcnt vmcnt(" #n ")" ::: "memory")
#define PG8_WAIT_L(n) asm volatile("s_waitcnt lgkmcnt(" #n ")" ::: "memory")
#define PG8_BAR __builtin_amdgcn_s_barrier()
#define PG8_SCHED __builtin_amdgcn_sched_barrier(0)
    unsigned voffA0, c2, pkc[2], pkn[2], praw[4];
    { int R, C; stage_rc(tid * 16, R, C); voffA0 = (unsigned)(R * lda + C) * 2u; c2 = (unsigned)C * 2u; }
    const size_t hstepA = (size_t)HALF * lda * 2, pstepA = (size_t)64 * lda * 2;
    const unsigned lda2 = (unsigned)lda * 2u;
#define PG8_PKROWS(dst, u) do { if (GATHER) { _Pragma("unroll") for (int i_ = 0; i_ < 2; ++i_) { int R_, C_; stage_rc(tid * 16 + i_ * 8192, R_, C_); \
        const int nr_ = (u).nrows - 1; const int r0_ = R_ < nr_ ? R_ : nr_, r1_ = (R_ + HALF) < nr_ ? (R_ + HALF) : nr_; \
        dst[i_] = (unsigned)(u).rows[r0_] | ((unsigned)(u).rows[r1_] << 16); } } } while (0)
#define PG8_RAWROWS(u) do { if (GATHER) { _Pragma("unroll") for (int i_ = 0; i_ < 2; ++i_) { int R_, C_; stage_rc(tid * 16 + i_ * 8192, R_, C_); \
        const int nr_ = (u).nrows - 1; const int r0_ = R_ < nr_ ? R_ : nr_, r1_ = (R_ + HALF) < nr_ ? (R_ + HALF) : nr_; \
        praw[2 * i_] = gload32_hidden((u).rows, (unsigned)r0_ * 4u); praw[2 * i_ + 1] = gload32_hidden((u).rows, (unsigned)r1_ * 4u); } } } while (0)
#define PG8_PACKRAW(dst) do { unsigned a0_ = praw[0], a1_ = praw[1], a2_ = praw[2], a3_ = praw[3]; asm volatile("" : "+v"(a0_), "+v"(a1_), "+v"(a2_), "+v"(a3_)); \
        dst[0] = a0_ | (a1_ << 16); dst[1] = a2_ | (a3_ << 16); } while (0)
#define PG8_STGA(bufoff, gbase, h, NX) do { \
        if (GATHER) { const unsigned p0_ = (NX) ? pkn[0] : pkc[0], p1_ = (NX) ? pkn[1] : pkc[1]; \
            const unsigned o0_ = ((h) ? (p0_ >> 16) : (p0_ & 0xffffu)) * lda2 + c2, o1_ = ((h) ? (p1_ >> 16) : (p1_ & 0xffffu)) * lda2 + c2; \
            glds16s((const char*)(gbase), o0_, ldsb + (unsigned)(bufoff)); glds16s((const char*)(gbase), o1_, ldsb + (unsigned)(bufoff) + 8192u); } \
        else { const char* gb_ = (const char*)(gbase) + ((h) ? hstepA : (size_t)0); glds16s(gb_, voffA0, ldsb + (unsigned)(bufoff)); glds16s(gb_ + pstepA, voffA0, ldsb + (unsigned)(bufoff) + 8192u); } } while (0)
    Unit cur, nxt; int ui = 0;
    if (!S.next(0, cur)) return;
    f32x4 acc[2][2][4][2];
#pragma unroll
    for (int a = 0; a < 2; ++a)
#pragma unroll
        for (int b = 0; b < 2; ++b)
#pragma unroll
            for (int m = 0; m < 4; ++m)
#pragma unroll
                for (int n = 0; n < 2; ++n) acc[a][b][m][n] = (f32x4){0.f, 0.f, 0.f, 0.f};
    bf16x8 At[4][2], B0[2][2], B1[2][2]; v8i32_t At8[4], B08[2], B18[2];
    pkc[0] = pkc[1] = pkn[0] = pkn[1] = 0u; praw[0] = praw[1] = praw[2] = praw[3] = 0u;
    PG8_PKROWS(pkc, cur);
    const char* cA = cur.A; const char* cB = cur.B;
    PG8_STGB(PG8_SB(0, 0), cB); PG8_STGB(PG8_SB(0, 1), cB + hstepB); PG8_STGA(PG8_SA(0, 0), cA, 0, false); PG8_STGA(PG8_SA(0, 1), cA, 1, false);
    if (wr == 1) PG8_BAR;
    PG8_WAIT_V(2); PG8_BAR;
    PG8_STGB(PG8_SB(1, 0), cB + kstep); PG8_STGA(PG8_SA(1, 0), cA + kstep, 0, false); PG8_STGB(PG8_SB(1, 1), cB + hstepB + kstep);
    PG8_WAIT_V(6); PG8_BAR;
    for (;;) {
        const bool has_next = S.next(ui + 1, nxt);
        if (GATHER) { if (has_next) { PG8_RAWROWS(nxt); } }
        const char* nA = has_next ? nxt.A : cA; const char* nB = has_next ? nxt.B : cB;
        typename Epi::Pre pre; { int t_p = threadIdx.x; asm volatile("" : "+v"(t_p)); E.prefetch(cur, wr, t_p & 15, pre); }
        for (int t = 0; t < nt; t += 2) {
            const bool last = (t == nt - 2);
            if (GATHER) { pkn[0] = pkc[0]; pkn[1] = pkc[1]; if (last && has_next) { PG8_PACKRAW(pkn); } }
            const char* a1 = cA + (size_t)(t + 1) * kstep;
            const char* a2 = last ? nA : cA + (size_t)(t + 2) * kstep; const char* b2 = last ? nB : cB + (size_t)(t + 2) * kstep;
            const char* a3 = a2 + kstep; const char* b3 = b2 + kstep;
            PG8_LDB(B0, 0, 0); PG8_LDB(B1, 0, 1); PG8_SCHED; PG8_LDA(At, 0, 0); PG8_STGA(PG8_SA(1, 1), a1, 1, false);
            PG8_WAIT_V(8); PG8_WAIT_L(0); PG8_BAR; PG8_MMA(0, 0, At, B0); PG8_MMA(0, 1, At, B1); PG8_BAR; PG8_SCHED;
            PG8_LDA(At, 0, 1); PG8_STGB(PG8_SB(0, 0), b2); PG8_STGB(PG8_SB(0, 1), b2 + hstepB); PG8_STGA(PG8_SA(0, 0), a2, 0, last);
            PG8_WAIT_V(8); PG8_WAIT_L(0); PG8_BAR; PG8_MMA(1, 0, At, B0); PG8_MMA(1, 1, At, B1); PG8_BAR; PG8_SCHED;
            PG8_LDB(B0, 1, 0); PG8_LDB(B1, 1, 1); PG8_SCHED; PG8_LDA(At, 1, 0); PG8_STGA(PG8_SA(0, 1), a2, 1, last);
            PG8_WAIT_V(8); PG8_WAIT_L(0); PG8_BAR; PG8_MMA(0, 0, At, B0); PG8_MMA(0, 1, At, B1); PG8_BAR; PG8_SCHED;
            PG8_LDA(At, 1, 1); PG8_STGB(PG8_SB(1, 0), b3); PG8_STGB(PG8_SB(1, 1), b3 + hstepB); PG8_STGA(PG8_SA(1, 0), a3, 0, last);
            PG8_WAIT_V(8); PG8_WAIT_L(0); PG8_BAR; PG8_MMA(1, 0, At, B0); PG8_MMA(1, 1, At, B1); PG8_BAR; PG8_SCHED;
        }
        if constexpr (ALIGN_EPI) { if (wr == 0) PG8_BAR; }
        if constexpr (FP8) asm volatile("s_nop 15\n\ts_nop 15" ::: "memory");
        if constexpr (!Epi::AFTER_DRAIN) { int t_e = threadIdx.x; asm volatile("" : "+v"(t_e)); const int fr_e = t_e & 15, fq_e = (t_e >> 4) & 3; E(acc, cur, wr, wc, fr_e, fq_e, pre); }
        if (!has_next) break;
#pragma unroll
        for (int a = 0; a < 2; ++a)
#pragma unroll
            for (int b = 0; b < 2; ++b)
#pragma unroll
                for (int m = 0; m < 4; ++m)
#pragma unroll
                    for (int n = 0; n < 2; ++n) acc[a][b][m][n] = (f32x4){0.f, 0.f, 0.f, 0.f};
        cur = nxt; cA = nA; cB = nB; ++ui;
        if (GATHER) { PG8_PACKRAW(pkc); }
        if constexpr (ALIGN_EPI) { if (wr == 1) PG8_BAR; }
    }
    PG8_WAIT_V(0);
    if constexpr (!ALIGN_EPI) { if (wr == 0) PG8_BAR; }
    PG8_BAR;
    if constexpr (Epi::AFTER_DRAIN) { int t_e = threadIdx.x; asm volatile("" : "+v"(t_e)); const int fr_e = t_e & 15, fq_e = (t_e >> 4) & 3; E.fused(acc, cur, wr, wc, fr_e, fq_e, lds, wid, t_e & 63); }
#undef PG8_SA
#undef PG8_SB
#undef PG8_STGB
#undef PG8_LDA
#undef PG8_LDB
#undef PG8_MMA
#undef PG8_CAT
#undef PG8_LD16
#undef PG8_WAIT_V
#undef PG8_WAIT_L
#undef PG8_SCHED
#undef PG8_PKROWS
#undef PG8_RAWROWS
#undef PG8_PACKRAW
#undef PG8_STGA
}
}

namespace pg8 {
constexpr int NXCD = 8, WGM = 8;
__device__ __forceinline__ void tile_order(int L, int nM, int nN, int& pm, int& pn) {
    const int nwg = nM * nN; int wgid = L;
    { const int q = nwg / NXCD, r = nwg % NXCD, xcd = wgid % NXCD, off = wgid / NXCD; wgid = (xcd < r ? xcd * (q + 1) : r * (q + 1) + (xcd - r) * q) + off; }
    const int nig = WGM * nN, gid = wgid / nig, fm = gid * WGM, gsz = (nM - fm) < WGM ? (nM - fm) : WGM;
    pm = fm + ((wgid % nig) % gsz); pn = (wgid % nig) / gsz;
}
struct DenseOrder {
    const char* A; const char* B; int lda, ldb, nM, nN, G, c;
    __device__ __forceinline__ bool next(int i, Unit& u) const {
        const long L = (long)i * G + c; if (L >= (long)nM * nN) return false;
        int pm, pn; tile_order((int)L, nM, nN, pm, pn);
        u.pm = pm; u.pn = pn; u.aux = 0; u.rows = nullptr; u.nrows = 256;
        u.A = A + (size_t)pm * 256 * lda * 2; u.B = B + (size_t)pn * 256 * ldb * 2; return true;
    }
};
struct KvOrder {
    const char* MN; const char* W; int L0;
    __device__ __forceinline__ bool next(int i, Unit& u) const {
        const int L = L0; if (i > 0 || L >= 64) return false;
        u.rows = nullptr; u.nrows = 256; u.pm = L >> 3; const int ct = L & 7; u.aux = ct >> 2; u.pn = ct & 3;
        u.A = MN + (size_t)u.pm * 256 * D * 2; u.B = W + (size_t)ct * 256 * D * 2; return true;
    }
};
struct XmnOrder {
    const char* MK; const char* MV; const char* WQN; const char* WOT; int G, c;
    __device__ __forceinline__ bool next(int i, Unit& u) const {
        const int L = c + i * G; if (L >= 256) return false;
        u.rows = nullptr; u.nrows = 256;
        if (L < 128) { const int b = L >> 4, h = (L >> 2) & 3, kt = L & 3; u.aux = 0; u.pm = b * 4 + h; u.pn = kt;
            u.A = MK + ((size_t)(b * 256) * D + h * 256) * 2; u.B = WQN + ((size_t)(kt * 256) * D + h * 256) * 2; }
        else { const int l = L - 128, b = l >> 4, nt = (l >> 2) & 3, h = l & 3; u.aux = 1; u.pm = b * 4 + nt; u.pn = h;
            u.A = WOT + ((size_t)(nt * 256) * D + h * 256) * 2; u.B = MV + ((size_t)(b * 256) * D + h * 256) * 2; }
        return true;
    }
};
struct XbOrder {
    const char* A; const char* Bb; int G, c; size_t rb;
    __device__ __forceinline__ bool next(int i, Unit& u) const {
        const long L = (long)i * G + c; if (L >= 512) return false;
        int pm, pn; tile_order((int)L, T / 256, 4, pm, pn);
        u.pm = pm; u.pn = pn; u.aux = 0; u.rows = nullptr; u.nrows = 256;
        u.A = A + (size_t)pm * 256 * rb; u.B = Bb + (size_t)(pm >> 4) * D * rb + (size_t)pn * 256 * rb; return true;
    }
};
struct MoeOrder {
    const char* A; const char* W; const int* list; const LAS int* cnt; const LAS unsigned char* te; const LAS int* ts;
    int ntiles, nN, G, c; size_t wstride; int gather; size_t atile, btile;
    __device__ __forceinline__ bool next(int i, Unit& u) const {
        const long L = (long)i * G + c; if (L >= (long)ntiles * nN) return false;
        int pm, pn; tile_order((int)L, ntiles, nN, pm, pn);
        const int e = __builtin_amdgcn_readfirstlane((int)te[pm]);
        const int lt = pm - __builtin_amdgcn_readfirstlane(ts[e]);
        const int n = __builtin_amdgcn_readfirstlane(cnt[e]) - lt * 256;
        u.pm = pm; u.pn = pn; u.aux = e; u.nrows = n < 256 ? n : 256;
        u.rows = list + (size_t)e * T + lt * 256;
        u.A = gather ? A : A + (size_t)pm * atile;
        u.B = W + (size_t)e * wstride + (size_t)pn * btile; return true;
    }
};

struct EpiProj {
    static constexpr bool PERM = true, AFTER_DRAIN = false; struct Pre {}; __device__ __forceinline__ void prefetch(const Unit&, int, int, Pre&) const {}
    bf16_t* O; float* kbar;
    __device__ __forceinline__ void operator()(const f32x4 (&acc)[2][2][4][2], const Unit& u, int wr, int wc, int fr, int fq, const Pre&) const {
        const int pn = u.pn, sec = pn >> 1, b = u.pm >> 4, t0 = (u.pm & 15) * 256 + wr * 64 + fr;
        const int mode = (pn < 2) ? 1 : ((pn == 6 || pn == 7 || pn >= 12) ? 2 : 0);
        bf16_t* sb = O + (size_t)sec * SEC_ELEMS;
#pragma unroll
        for (int bj = 0; bj < 2; ++bj) {
            const int c = bj * HALF + wc * 32 + 8 * fq, head = (pn & 1) * 4 + (c >> 6), d0 = c & 63;
            bf16_t* hb = sb + (size_t)(b * 8 + head) * (SEQ * 64);
#pragma unroll
            for (int ai = 0; ai < 2; ++ai)
#pragma unroll
                for (int m = 0; m < 4; ++m) { const int t = t0 + ai * HALF + m * 16;
                    f32x4 v0 = acc[ai][bj][m][0], v1 = acc[ai][bj][m][1];
                    if (mode == 1) { v0 = v0 * C2Q; v1 = v1 * C2Q; }
                    else if (mode == 2) {
#pragma unroll
                        for (int e = 0; e < 4; ++e) { v0[e] = silu_f(v0[e]); v1[e] = silu_f(v1[e]); } }
                    u32x4 w; w.x = cvtpk(v0[0], v0[1]); w.y = cvtpk(v0[2], v0[3]); w.z = cvtpk(v1[0], v1[1]); w.w = cvtpk(v1[2], v1[3]);
                    size_t off;
                    if (sec == 1) off = (size_t)(t >> 6) * 4096 + (d0 >> 3) * 512 + (t & 63) * 8;
                    else if (sec == 2) off = (size_t)(t >> 6) * 4096 + (d0 >> 5) * 2048 + (t & 63) * 32 + (d0 & 31);
                    else off = (size_t)t * 64 + d0;
                    *(u32x4*)(hb + off) = w; } }
        if (pn == 2 || pn == 3) {
#pragma unroll
            for (int bj = 0; bj < 2; ++bj)
#pragma unroll
                for (int n = 0; n < 2; ++n)
#pragma unroll
                    for (int e = 0; e < 4; ++e) { float s = 0.f;
#pragma unroll
                        for (int ai = 0; ai < 2; ++ai)
#pragma unroll
                            for (int m = 0; m < 4; ++m) s += acc[ai][bj][m][n][e];
                        s += __shfl_xor(s, 1); s += __shfl_xor(s, 2); s += __shfl_xor(s, 4); s += __shfl_xor(s, 8);
                        if (fr == 0) { const int c = bj * HALF + wc * 32 + 8 * fq + 4 * n + e, head = (pn - 2) * 4 + (c >> 6), d = c & 63;
                            atomicAdd(kbar + ((size_t)u.pm * 8 + head) * 64 + d, s); } }
        }
    }
};
struct EpiBf16 {
    static constexpr bool PERM = true, AFTER_DRAIN = false; struct Pre {}; __device__ __forceinline__ void prefetch(const Unit&, int, int, Pre&) const {}
    bf16_t* O0; int ldc0; bf16_t* O1; int ldc1;
    __device__ __forceinline__ void operator()(const f32x4 (&acc)[2][2][4][2], const Unit& u, int wr, int wc, int fr, int fq, const Pre&) const {
        bf16_t* O = u.aux ? O1 : O0; const int ldc = u.aux ? ldc1 : ldc0;
        const int row0 = u.pm * BM + wr * 64 + fr, col0 = u.pn * BM + wc * 32 + 8 * fq;
#pragma unroll
        for (int ai = 0; ai < 2; ++ai)
#pragma unroll
            for (int m = 0; m < 4; ++m) { bf16_t* rowp = O + (size_t)(row0 + ai * HALF + m * 16) * ldc + col0;
#pragma unroll
                for (int bj = 0; bj < 2; ++bj) { const f32x4 v0 = acc[ai][bj][m][0], v1 = acc[ai][bj][m][1];
                    u32x4 w; w.x = cvtpk(v0[0], v0[1]); w.y = cvtpk(v0[2], v0[3]); w.z = cvtpk(v1[0], v1[1]); w.w = cvtpk(v1[2], v1[3]);
                    *(u32x4*)(rowp + bj * HALF) = w; } }
    }
};
struct EpiFp8 {
    static constexpr bool PERM = true, AFTER_DRAIN = false; struct Pre {}; __device__ __forceinline__ void prefetch(const Unit&, int, int, Pre&) const {}
    unsigned char* O0; int ldc0; unsigned char* O1; int ldc1; float scale;
    __device__ __forceinline__ void operator()(const f32x4 (&acc)[2][2][4][2], const Unit& u, int wr, int wc, int fr, int fq, const Pre&) const {
        unsigned char* O = u.aux ? O1 : O0; const int ldc = u.aux ? ldc1 : ldc0;
        const int row0 = u.pm * BM + wr * 64 + fr, col0 = u.pn * BM + wc * 32 + 8 * fq;
#pragma unroll
        for (int ai = 0; ai < 2; ++ai)
#pragma unroll
            for (int m = 0; m < 4; ++m) { unsigned char* rowp = O + (size_t)(row0 + ai * HALF + m * 16) * ldc + col0;
#pragma unroll
                for (int bj = 0; bj < 2; ++bj) { const f32x4 v0 = acc[ai][bj][m][0] * scale, v1 = acc[ai][bj][m][1] * scale;
                    *(u32x2*)(rowp + bj * HALF) = (u32x2){pk4_fp8(v0[0], v0[1], v0[2], v0[3]), pk4_fp8(v1[0], v1[1], v1[2], v1[3])}; } }
    }
};
template <bool BASE_F32, bool WRITE_F32, bool OUT_FP8 = false> struct EpiRes {
    static constexpr bool PERM = true, AFTER_DRAIN = false; struct Pre {}; __device__ __forceinline__ void prefetch(const Unit&, int, int, Pre&) const {}
    const void* base; bf16_t* Ob; float* Of; float* ss; float asc; unsigned char* Oq;
    __device__ __forceinline__ void operator()(const f32x4 (&acc)[2][2][4][2], const Unit& u, int wr, int wc, int fr, int fq, const Pre&) const {
        const int row0 = u.pm * BM + wr * 64 + fr, col0 = u.pn * BM + wc * 32 + 8 * fq;
#pragma unroll
        for (int ai = 0; ai < 2; ++ai)
#pragma unroll
            for (int m = 0; m < 4; ++m) { const int row = row0 + ai * HALF + m * 16; const size_t off = (size_t)row * D + col0; float sq = 0.f;
#pragma unroll
                for (int bj = 0; bj < 2; ++bj) { f32x4 b0, b1;
                    if (BASE_F32) { b0 = *(const f32x4*)((const float*)base + off + bj * HALF); b1 = *(const f32x4*)((const float*)base + off + bj * HALF + 4); }
                    else { const u32x4 w = *(const u32x4*)((const bf16_t*)base + off + bj * HALF);
                        b0 = (f32x4){bflo(w.x), bfhi(w.x), bflo(w.y), bfhi(w.y)}; b1 = (f32x4){bflo(w.z), bfhi(w.z), bflo(w.w), bfhi(w.w)}; }
                    const f32x4 v0 = acc[ai][bj][m][0] * asc + b0, v1 = acc[ai][bj][m][1] * asc + b1;
                    sq += (v0[0] * v0[0] + v0[1] * v0[1]) + (v0[2] * v0[2] + v0[3] * v0[3]) + (v1[0] * v1[0] + v1[1] * v1[1]) + (v1[2] * v1[2] + v1[3] * v1[3]);
                    if (OUT_FP8) { *(u32x2*)((unsigned char*)Ob + off + bj * HALF) = (u32x2){pk4_fp8(v0[0], v0[1], v0[2], v0[3]), pk4_fp8(v1[0], v1[1], v1[2], v1[3])}; }
                    else { u32x4 w; w.x = cvtpk(v0[0], v0[1]); w.y = cvtpk(v0[2], v0[3]); w.z = cvtpk(v1[0], v1[1]); w.w = cvtpk(v1[2], v1[3]);
                    *(u32x4*)(Ob + off + bj * HALF) = w; }
                    if (Oq) *(u32x2*)(Oq + off + bj * HALF) = (u32x2){pk4_fp8(v0[0], v0[1], v0[2], v0[3]), pk4_fp8(v1[0], v1[1], v1[2], v1[3])};
                    if (WRITE_F32) { *(f32x4*)(Of + off + bj * HALF) = v0; *(f32x4*)(Of + off + bj * HALF + 4) = v1; } }
                sq += __shfl_xor(sq, 16); sq += __shfl_xor(sq, 32);
                if (fq == 0) atomicAdd(ss + row, sq); }
    }
};
struct EpiQ {
    static constexpr bool PERM = true, AFTER_DRAIN = false; struct Pre {}; __device__ __forceinline__ void prefetch(const Unit&, int, int, Pre&) const {}
    bf16_t* O; const float* ss;
    __device__ __forceinline__ void operator()(const f32x4 (&acc)[2][2][4][2], const Unit& u, int wr, int wc, int fr, int fq, const Pre&) const {
        const int row0 = u.pm * BM + wr * 64 + fr, col0 = u.pn * BM + wc * 32 + 8 * fq;
#pragma unroll
        for (int ai = 0; ai < 2; ++ai)
#pragma unroll
            for (int m = 0; m < 4; ++m) { const int row = row0 + ai * HALF + m * 16; const float sc = C2X * __builtin_amdgcn_rsqf(ss[row] * (1.0f / D) + EPS);
                bf16_t* rowp = O + (size_t)row * D + col0;
#pragma unroll
                for (int bj = 0; bj < 2; ++bj) { const f32x4 v0 = acc[ai][bj][m][0] * sc, v1 = acc[ai][bj][m][1] * sc;
                    u32x4 w; w.x = cvtpk(v0[0], v0[1]); w.y = cvtpk(v0[2], v0[3]); w.z = cvtpk(v1[0], v1[1]); w.w = cvtpk(v1[2], v1[3]);
                    *(u32x4*)(rowp + bj * HALF) = w; } }
    }
};
struct EpiSoftmaxS {
    static constexpr bool PERM = true, AFTER_DRAIN = false; struct Pre {}; __device__ __forceinline__ void prefetch(const Unit&, int, int, Pre&) const {}
    unsigned char* P; const float* ss; LAS unsigned char* tb; float qs;
    __device__ __forceinline__ void operator()(f32x4 (&acc)[2][2][4][2], const Unit& u, int wr, int wc, int fr, int fq, const Pre&) const {
        LAS float* MX = (LAS float*)tb;
        LAS float* SM = (LAS float*)(tb + 4096);
#pragma unroll
        for (int ai = 0; ai < 2; ++ai)
#pragma unroll
            for (int m = 0; m < 4; ++m) { const int r = ai * HALF + wr * 64 + m * 16 + fr; const float sc = qs * C2X * __builtin_amdgcn_rsqf(ss[u.pm * BM + r] * (1.0f / D) + EPS); float mx = -3.0e38f;
#pragma unroll
                for (int bj = 0; bj < 2; ++bj)
#pragma unroll
                    for (int n = 0; n < 2; ++n) { f32x4 x = acc[ai][bj][m][n] * sc; acc[ai][bj][m][n] = x; mx = fmaxf(mx, fmaxf(fmaxf(x[0], x[1]), fmaxf(x[2], x[3]))); }
                mx = fmaxf(mx, __shfl_xor(mx, 16)); mx = fmaxf(mx, __shfl_xor(mx, 32));
                if (fq == 0) MX[r * 4 + wc] = mx; }
        LDS_WAIT(); __builtin_amdgcn_s_barrier(); asm volatile("" ::: "memory");
#pragma unroll
        for (int ai = 0; ai < 2; ++ai)
#pragma unroll
            for (int m = 0; m < 4; ++m) { const int r = ai * HALF + wr * 64 + m * 16 + fr; const f32x4 q = *(const LAS f32x4*)(MX + r * 4);
                const float mx = fmaxf(fmaxf(q[0], q[1]), fmaxf(q[2], q[3])); float sm = 0.f;
#pragma unroll
                for (int bj = 0; bj < 2; ++bj)
#pragma unroll
                    for (int n = 0; n < 2; ++n) { f32x4 x = acc[ai][bj][m][n];
#pragma unroll
                        for (int e = 0; e < 4; ++e) { x[e] = fast_exp2(x[e] - mx); sm += x[e]; }
                        acc[ai][bj][m][n] = x; }
                sm += __shfl_xor(sm, 16); sm += __shfl_xor(sm, 32);
                if (fq == 0) SM[r * 4 + wc] = sm; }
        LDS_WAIT(); __builtin_amdgcn_s_barrier(); asm volatile("" ::: "memory");
        const int col0 = u.pn * BM + wc * 32 + 8 * fq;
#pragma unroll
        for (int ai = 0; ai < 2; ++ai)
#pragma unroll
            for (int m = 0; m < 4; ++m) { const int r = ai * HALF + wr * 64 + m * 16 + fr; const f32x4 q = *(const LAS f32x4*)(SM + r * 4);
                const float inv = PSCALE8 * fast_rcp((q[0] + q[1]) + (q[2] + q[3]));
#pragma unroll
                for (int bj = 0; bj < 2; ++bj) { const f32x4 v0 = acc[ai][bj][m][0] * inv, v1 = acc[ai][bj][m][1] * inv;
                    *(u32x2*)(P + ((size_t)u.pm * BM + r) * D + bj * HALF + col0) = (u32x2){pk4_fp8(v0[0], v0[1], v0[2], v0[3]), pk4_fp8(v1[0], v1[1], v1[2], v1[3])}; } }
        LDS_WAIT(); __builtin_amdgcn_s_barrier(); asm volatile("" ::: "memory");
    }
};
struct EpiW1 {
    static constexpr bool PERM = true, AFTER_DRAIN = false;
    struct Pre { float sc[8]; };
    bf16_t* O; const float* ssl; const float* b1; const int* list0;
    __device__ __forceinline__ void prefetch(const Unit& u, int wr, int fr, Pre& p) const {
        const float* sp = ssl + (u.rows - list0);
#pragma unroll
        for (int ai = 0; ai < 2; ++ai)
#pragma unroll
            for (int m = 0; m < 4; ++m) { const int r = ai * HALF + wr * 64 + m * 16 + fr; const int rr = r < u.nrows ? r : u.nrows - 1; p.sc[ai * 4 + m] = __uint_as_float(gload32_hidden(sp, (unsigned)rr * 4u)); }
    }
    __device__ __forceinline__ void operator()(const f32x4 (&acc)[2][2][4][2], const Unit& u, int wr, int wc, int fr, int fq, const Pre& pre) const {
        const int c0 = wc * 32 + 8 * fq;
        const float* bp = b1 + (size_t)u.aux * 2048 + 2 * (u.pn * 128 + c0);
        const f32x4 bq0 = *(const f32x4*)(bp), bq1 = *(const f32x4*)(bp + 4), bq2 = *(const f32x4*)(bp + 8), bq3 = *(const f32x4*)(bp + 12);
        const float bg[8] = {bq0[0], bq0[2], bq1[0], bq1[2], bq2[0], bq2[2], bq3[0], bq3[2]};
        const float bl[8] = {bq0[1], bq0[3], bq1[1], bq1[3], bq2[1], bq2[3], bq3[1], bq3[3]};
#pragma unroll
        for (int ai = 0; ai < 2; ++ai)
#pragma unroll
            for (int m = 0; m < 4; ++m) { const int r = ai * HALF + wr * 64 + m * 16 + fr;
                float ssv = pre.sc[ai * 4 + m]; asm volatile("" : "+v"(ssv));
                const float sc = WSCALE8_INV * __builtin_amdgcn_rsqf(ssv * (1.0f / D) + EPS); float a[8];
#pragma unroll
                for (int j = 0; j < 8; ++j) { const float g = acc[ai][0][m][j >> 2][j & 3] * sc + bg[j], l = acc[ai][1][m][j >> 2][j & 3] * sc + bl[j];
                    const float glu = fminf(g, 7.0f), lin = fminf(fmaxf(l, -7.0f), 7.0f);
                    a[j] = glu * fast_rcp(1.0f + fast_exp2(-1.702f * LOG2E * glu)) * (lin + 1.0f); }
                *(u32x2*)((unsigned char*)O + ((size_t)u.pm * BM + r) * D + u.pn * 128 + c0) = (u32x2){pk4_fp8(a[0], a[1], a[2], a[3]), pk4_fp8(a[4], a[5], a[6], a[7])}; }
    }
};
constexpr float YSCALE = 16.0f, YSCALE_INV = 1.0f / 16.0f;
struct EpiW2 {
    static constexpr bool PERM = true, AFTER_DRAIN = false;
    struct Pre { float g[8]; };
    unsigned char* O; const float* b2; const int* list0; const float* gl0;
    __device__ __forceinline__ void prefetch(const Unit& u, int wr, int fr, Pre& p) const {
        const float* gp = gl0 + (u.rows - list0);
#pragma unroll
        for (int ai = 0; ai < 2; ++ai)
#pragma unroll
            for (int m = 0; m < 4; ++m) { const int r = ai * HALF + wr * 64 + m * 16 + fr; const int rr = r < u.nrows ? r : u.nrows - 1; p.g[ai * 4 + m] = __uint_as_float(gload32_hidden(gp, (unsigned)rr * 4u)); }
    }
    __device__ __forceinline__ void operator()(const f32x4 (&acc)[2][2][4][2], const Unit& u, int wr, int wc, int fr, int fq, const Pre& pre) const {
        const int row0 = u.pm * BM + wr * 64 + fr, col0 = u.pn * BM + wc * 32 + 8 * fq;
        f32x4 bv[2][2];
#pragma unroll
        for (int bj = 0; bj < 2; ++bj)
#pragma unroll
            for (int n = 0; n < 2; ++n) bv[bj][n] = *(const f32x4*)(b2 + (size_t)u.aux * D + col0 + bj * HALF + 4 * n);
#pragma unroll
        for (int ai = 0; ai < 2; ++ai)
#pragma unroll
            for (int m = 0; m < 4; ++m) { unsigned char* rowp = O + (size_t)(row0 + ai * HALF + m * 16) * D + col0; float gv = pre.g[ai * 4 + m]; asm volatile("" : "+v"(gv)); const float g = YSCALE * gv;
#pragma unroll
                for (int bj = 0; bj < 2; ++bj) { const f32x4 v0 = (acc[ai][bj][m][0] * WSCALE8_INV + bv[bj][0]) * g, v1 = (acc[ai][bj][m][1] * WSCALE8_INV + bv[bj][1]) * g;
                    *(u32x2*)(rowp + bj * HALF) = (u32x2){pk4_fp8(v0[0], v0[1], v0[2], v0[3]), pk4_fp8(v1[0], v1[1], v1[2], v1[3])}; } }
    }
};
}

namespace moba {
using bf16x8 = ::bf16x8; using s16x4 = ::s16x4; using f32x16 = ::f32x16; using u32x4 = ::u32x4;
constexpr int DMQ = INC, DMO = D, HD = 64;
constexpr int NW = 8, QBLK = 32, QB = 256, KVBLK = 64;
__device__ __forceinline__ int crow(int r, int hi) { return (r & 3) + 8 * (r >> 2) + 4 * hi; }
#define SBAR() __builtin_amdgcn_sched_barrier(0)
__device__ __forceinline__ void cmask(f32x16& p0, f32x16& p1, int jb, int qrel, int hi) {
    const float NEG = -INFINITY; int kb = 64 * jb + 4 * hi;
#pragma unroll
    for (int r = 0; r < 16; ++r) { int kv = kb + (r & 3) + 8 * (r >> 2); if (kv > qrel) p0[r] = NEG; if (kv + 32 > qrel) p1[r] = NEG; }
}
constexpr int NSLOT = 3, SLOTB = 8192;
constexpr int LDS_K = 0, LDS_V = NSLOT * SLOTB, LDS_WS = 2 * NSLOT * SLOTB, LDS_OST = LDS_WS + NW * 64 * 4, LDS_KB = LDS_OST + NW * 4096, LDS_BYTES = LDS_KB + 16 * 64 * 4;
__device__ __forceinline__ void glds16(const void* gsrc, unsigned lds_dst) { unsigned keep;
    asm volatile("s_mov_b32 %0, m0\n\ts_mov_b32 m0, %2\n\ts_nop 0\n\tglobal_load_lds_dwordx4 %1, off\n\ts_mov_b32 m0, %0" : "=&s"(keep) : "v"(gsrc), "s"(lds_dst) : "memory"); }
__device__ __forceinline__ float max3f(float a, float b, float c) { float r; asm("v_max3_f32 %0, %1, %2, %3" : "=v"(r) : "v"(a), "v"(b), "v"(c)); return r; }
__device__ __forceinline__ float max2f(float a, float b) { float r; asm("v_max_f32_e32 %0, %1, %2" : "=v"(r) : "v"(a), "v"(b)); return r; }
__device__ __forceinline__ float fadd_s(float a, float b) { float r; asm("v_add_f32_e32 %0, %1, %2" : "=v"(r) : "v"(a), "v"(b)); return r; }
__device__ __forceinline__ float fsub_s(float a, float b) { float r; asm("v_sub_f32_e32 %0, %1, %2" : "=v"(r) : "v"(a), "v"(b)); return r; }
__device__ __forceinline__ unsigned cvtpk_s(float lo, float hi) { return ::cvtpk(lo, hi); }
#define WAIT_BAR(N) asm volatile("s_waitcnt vmcnt(" #N ") lgkmcnt(0)\n\ts_barrier" ::: "memory")
__device__ __forceinline__ void qkt(f32x16& p0, f32x16& p1, const char* Kslot, const bf16x8* qr, const f32x16& negm, int r32, int hi) {
    const char* kb = Kslot + hi * 1024 + r32 * 16;
#pragma unroll
    for (int d0 = 0; d0 < 4; ++d0) {
        const bf16x8 b0 = *reinterpret_cast<const bf16x8*>(kb + d0 * 2048);
        const bf16x8 b1 = *reinterpret_cast<const bf16x8*>(kb + d0 * 2048 + 512);
        if (d0 == 0) { p0 = __builtin_amdgcn_mfma_f32_32x32x16_bf16(b0, qr[0], negm, 0, 0, 0); p1 = __builtin_amdgcn_mfma_f32_32x32x16_bf16(b1, qr[0], negm, 0, 0, 0); }
        else { p0 = __builtin_amdgcn_mfma_f32_32x32x16_bf16(b0, qr[d0], p0, 0, 0, 0); p1 = __builtin_amdgcn_mfma_f32_32x32x16_bf16(b1, qr[d0], p1, 0, 0, 0); } }
}
typedef __attribute__((address_space(3))) const char* lds_cptr;
typedef short v4i16_t __attribute__((ext_vector_type(4)));
__device__ __forceinline__ void kload8(bf16x8* kf, lds_cptr kp) {
    kf[0] = *(const __attribute__((address_space(3))) bf16x8*)(kp);        kf[1] = *(const __attribute__((address_space(3))) bf16x8*)(kp + 512);
    kf[2] = *(const __attribute__((address_space(3))) bf16x8*)(kp + 2048); kf[3] = *(const __attribute__((address_space(3))) bf16x8*)(kp + 2560);
    kf[4] = *(const __attribute__((address_space(3))) bf16x8*)(kp + 4096); kf[5] = *(const __attribute__((address_space(3))) bf16x8*)(kp + 4608);
    kf[6] = *(const __attribute__((address_space(3))) bf16x8*)(kp + 6144); kf[7] = *(const __attribute__((address_space(3))) bf16x8*)(kp + 6656);
}
__device__ __forceinline__ void kload2(bf16x8* kf, lds_cptr kp, int j) { kf[2 * j] = *(const __attribute__((address_space(3))) bf16x8*)(kp + j * 2048); kf[2 * j + 1] = *(const __attribute__((address_space(3))) bf16x8*)(kp + j * 2048 + 512); }
__device__ __forceinline__ s16x4 vtr(lds_cptr p) { return __builtin_bit_cast(s16x4, __builtin_amdgcn_ds_read_tr16_b64_v4i16((__attribute__((address_space(3))) v4i16_t*)p)); }
__device__ __forceinline__ float rowmax(const f32x16& p0, const f32x16& p1) {
    float a = max3f(p0[0], p0[1], p1[0]), b = max3f(p0[2], p0[3], p1[1]); a = max3f(a, p1[2], p1[3]);
#pragma unroll
    for (int r = 4; r < 16; r += 4) { a = max3f(a, p0[r], p0[r + 1]); b = max3f(b, p0[r + 2], p0[r + 3]); a = max3f(a, p1[r], p1[r + 1]); b = max3f(b, p1[r + 2], p1[r + 3]); }
    const float m = max2f(a, b);
    auto rr = __builtin_amdgcn_permlane32_swap(__float_as_uint(m), __float_as_uint(m), false, false);
    return max2f(__uint_as_float(rr[0]), __uint_as_float(rr[1]));
}
__device__ __forceinline__ void pv(f32x16* o, int vb, bf16x8 pa0, bf16x8 pa1, bf16x8 pa2, bf16x8 pa3) {
#pragma unroll
    for (int d0 = 0; d0 < 2; ++d0) { s16x4 lo[4], hi[4];
#pragma unroll
        for (int ks = 0; ks < 4; ++ks) {
            asm volatile("ds_read_b64_tr_b16 %0,%1 offset:%c2" : "=&v"(lo[ks]) : "v"(vb), "i"(d0 * 4096 + ks * 1024) : "memory");
            asm volatile("ds_read_b64_tr_b16 %0,%1 offset:%c2" : "=&v"(hi[ks]) : "v"(vb), "i"(d0 * 4096 + ks * 1024 + 512) : "memory"); }
        asm volatile("s_waitcnt lgkmcnt(0)" ::: "memory"); SBAR();
#define PK(k) (bf16x8){lo[k][0], lo[k][1], lo[k][2], lo[k][3], hi[k][0], hi[k][1], hi[k][2], hi[k][3]}
        o[d0] = __builtin_amdgcn_mfma_f32_32x32x16_bf16(pa0, PK(0), o[d0], 0, 0, 0);
        o[d0] = __builtin_amdgcn_mfma_f32_32x32x16_bf16(pa1, PK(1), o[d0], 0, 0, 0);
        o[d0] = __builtin_amdgcn_mfma_f32_32x32x16_bf16(pa2, PK(2), o[d0], 0, 0, 0);
        o[d0] = __builtin_amdgcn_mfma_f32_32x32x16_bf16(pa3, PK(3), o[d0], 0, 0, 0);
#undef PK
    }
}
constexpr float NEGBIG = -1.0e30f;

template <int THRL> __device__ __forceinline__ void attn_unit(int b, int h, int qb, const bf16_t* Qg, const bf16_t* __restrict__ Kg, const bf16_t* __restrict__ Vg, bf16_t* Og, const float* __restrict__ kbar, char* shm) {
    int tid_ = threadIdx.x; asm volatile("" : "+v"(tid_));
    const int tid = tid_, lane = tid & 63, r32 = lane & 31, hi = lane >> 5; const int wid = __builtin_amdgcn_readfirstlane(tid >> 6);
    const long rowbase = (long)b * SEQ; const int q0 = qb * QB;
    const size_t hoff = (size_t)(b * 8 + h) * (SEQ * 64);
    const bf16_t* Qw = Qg + hoff + (size_t)(q0 + wid * QBLK) * 64;
    const bf16_t* Kh = Kg + hoff, *Vh = Vg + hoff;
    const unsigned lds0 = (unsigned)(uintptr_t)shm;
    float* wsf = (float*)(shm + LDS_WS) + wid * 64;
    const bf16_t* ksrc = Kh + wid * 512 + lane * 8;
    const bf16_t* vsrc = Vh + wid * 512 + lane * 8;
    const unsigned kdst = lds0 + LDS_K + wid * 1024, vdst = lds0 + LDS_V + wid * 1024;
    const int NT = 4 * qb + 4, NPAST = 4 * qb;
#define TMAP(t) (((t) < 4) ? (NPAST + (t)) : ((t) - 4))
#define DMA_K(t, slot) glds16(ksrc + (long)TMAP(t) * 4096, (unsigned)__builtin_amdgcn_readfirstlane(kdst + (slot)))
#define DMA_V(t, slot) glds16(vsrc + (long)TMAP(t) * 4096, (unsigned)__builtin_amdgcn_readfirstlane(vdst + (slot)))
    const char* Kbase = shm + LDS_K; bf16x8 kf[8];
    const lds_cptr shm3 = (lds_cptr)shm; const lds_cptr kp0 = shm3 + LDS_K + hi * 1024 + r32 * 16; const lds_cptr vp0 = shm3 + LDS_V + ((lane >> 4) & 1) * 32 + (lane & 3) * 8 + (4 * hi + ((lane & 15) >> 2)) * 64;
    DMA_K(0, 0); DMA_V(0, 0); DMA_K(1, SLOTB);
    bf16x8 qr[4];
#pragma unroll
    for (int d0 = 0; d0 < 4; ++d0) qr[d0] = *reinterpret_cast<const bf16x8*>(&Qw[(long)r32 * 64 + d0 * 16 + hi * 8]);
    unsigned selm = 0u;
    if (qb > 0) {
        float* kbl = (float*)(shm + LDS_KB);
        for (int i = tid; i < qb * 64; i += NW * 64) kbl[i] = kbar[((size_t)(b * 16 + (i >> 6)) * 8 + h) * 64 + (i & 63)];
        asm volatile("s_waitcnt vmcnt(0) lgkmcnt(0)\n\ts_barrier" ::: "memory");
        if (qb <= 3) selm = (1u << qb) - 1u;
        else {
            float qf[32];
#pragma unroll
            for (int d0 = 0; d0 < 4; ++d0)
#pragma unroll
                for (int j = 0; j < 8; ++j) qf[d0 * 8 + j] = bf2f((unsigned short)qr[d0][j]);
            float g[15];
#pragma unroll
            for (int n = 0; n < 15; ++n) { float s = 0.f;
                if (n < qb) {
#pragma unroll
                    for (int d0 = 0; d0 < 4; ++d0) { const f32x4 k0 = *(const f32x4*)(kbl + n * 64 + d0 * 16 + hi * 8), k1 = *(const f32x4*)(kbl + n * 64 + d0 * 16 + hi * 8 + 4);
                        s += qf[d0 * 8 + 0] * k0[0] + qf[d0 * 8 + 1] * k0[1] + qf[d0 * 8 + 2] * k0[2] + qf[d0 * 8 + 3] * k0[3] + qf[d0 * 8 + 4] * k1[0] + qf[d0 * 8 + 5] * k1[1] + qf[d0 * 8 + 6] * k1[2] + qf[d0 * 8 + 7] * k1[3]; }
                    s += __shfl_xor(s, 32);
                } else s = -INFINITY;
                g[n] = s; }
#pragma unroll
            for (int pass = 0; pass < 3; ++pass) { float best = -INFINITY; int bi = 0;
#pragma unroll
                for (int n = 0; n < 15; ++n) if (g[n] > best) { best = g[n]; bi = n; }
                selm |= 1u << bi;
#pragma unroll
                for (int n = 0; n < 15; ++n) if (n == bi) g[n] = -INFINITY; }
        }
    }
    float mhat = 0.f, l_reg = 0.f; f32x16 o[2]; o[0] = f32x16{}; o[1] = f32x16{}; f32x16 cini = f32x16{}; asm volatile("" : "+v"(cini));
    const int qrel = wid * QBLK + r32;
#define SETC(t, JB) do { const float cm_ = ((JB >= 0) || ((selm >> (((t) - 4) >> 2)) & 1u)) ? -mhat : NEGBIG; \
      _Pragma("unroll") for (int r = 0; r < 16; ++r) cini[r] = cm_; asm volatile("" : "+v"(cini)); } while (0)
    bool resc = false;
#define START(P0, P1) do { const float rm = rowmax(P0, P1); resc = false; \
    { const float dl = rm; mhat = fadd_s(mhat, dl); \
      _Pragma("unroll") for (int r = 0; r < 16; ++r) { P0[r] = fsub_s(P0[r], dl); P1[r] = fsub_s(P1[r], dl); } } \
    _Pragma("unroll") for (int r = 0; r < 16; ++r) P0[r] = __builtin_amdgcn_exp2f(P0[r]); } while (0)
#define RESC() do { if (resc) { asm volatile("s_waitcnt lgkmcnt(0)" ::: "memory"); \
      _Pragma("unroll") for (int d_ = 0; d_ < 2; ++d_) _Pragma("unroll") for (int r = 0; r < 16; ++r) o[d_][r] *= wsf[crow(r, hi)]; } } while (0)
    f32x16 pA0, pA1, pB0, pB1;
    int sl_prev = 0, sl_cur = 0, sl_next = SLOTB;
#define ROT() do { sl_prev = sl_cur; sl_cur = sl_next; sl_next = (sl_next == (NSLOT - 1) * SLOTB) ? 0 : sl_next + SLOTB; } while (0)
    DMA_K(2, 2 * SLOTB);
    if (qb > 0) { WAIT_BAR(0); } else { WAIT_BAR(3); }
    qkt(pA0, pA1, Kbase, qr, cini, r32, hi); asm volatile("s_nop 15\n\ts_nop 7" : "+v"(pA0), "+v"(pA1)); cmask(pA0, pA1, 0, qrel, hi);
    START(pA0, pA1);
    _Pragma("unroll") for (int r = 0; r < 16; ++r) pA1[r] = __builtin_amdgcn_exp2f(pA1[r]);
    WAIT_BAR(0);
    DMA_K(3, 0); DMA_V(1, SLOTB);
    ROT();
    kload8(kf, kp0 + sl_cur);
    WAIT_BAR(2);
    s16x4 vlo[8], vhi[8]; u32x4 pw0, pw1, pw2, pw3;
#define PKW(P, B) cvtpk_s(P[B], P[B + 1])
#define PAF(k) __builtin_bit_cast(bf16x8, pw##k)
#define VFR(i) (bf16x8){vlo[i][0], vlo[i][1], vlo[i][2], vlo[i][3], vhi[i][0], vhi[i][1], vhi[i][2], vhi[i][3]}
#define PIN(x) asm volatile("" : "+v"(x))
#define MX3(a, b, c) __builtin_fmaxf(__builtin_fmaxf((a), (b)), (c))
#define GAPA(MF, A0, A1, A2, A3, W0, W1, PW) do { MF; sacc += A0; sacc += A1; sacc += A2; sacc += A3; PIN(sacc); W0; W1; PIN(PW); SBAR(); } while (0)
#define EX(v) __builtin_amdgcn_exp2f(v)
#define GAPB(MF, X, B) do { MF; X[B] = EX(X[B]); X[B + 1] = EX(X[B + 1]); X[B + 2] = EX(X[B + 2]); X[B + 3] = EX(X[B + 3]); PIN(X); SBAR(); } while (0)
#define VRD(i) do { vlo[i] = vtr(vp_ + (((i) >> 2) * 4096 + ((i) & 3) * 1024)); vhi[i] = vtr(vp_ + (((i) >> 2) * 4096 + ((i) & 3) * 1024 + 512)); } while (0)
#define KRD(G, j) do { if (G) { kload2(kf, kp0 + sl_next, j); SBAR(); } } while (0)
#define STEP(C0, C1, P0, P1, t, GK, GV, GL, JB) do { SETC(t, JB); SBAR(); \
    const lds_cptr vp_ = vp0 + sl_prev; \
    VRD(0); SBAR(); float sacc = (P0[0] + P0[1]); \
    GAPA(C0 = __builtin_amdgcn_mfma_f32_32x32x16_bf16(kf[0], qr[0], cini, 0, 0, 0), P0[2], P0[3], P0[4], P0[5],     pw0[0] = PKW(P0, 0), pw0[1] = PKW(P0, 2), pw0); \
    VRD(4); SBAR(); GAPA(C1 = __builtin_amdgcn_mfma_f32_32x32x16_bf16(kf[1], qr[0], cini, 0, 0, 0), P0[6], P0[7], P0[8], P0[9],     pw0[2] = PKW(P0, 4), pw0[3] = PKW(P0, 6), pw0); \
    VRD(1); SBAR(); GAPA(C0 = __builtin_amdgcn_mfma_f32_32x32x16_bf16(kf[2], qr[1], C0, 0, 0, 0),   P0[10], P0[11], P0[12], P0[13], pw1[0] = PKW(P0, 8), pw1[1] = PKW(P0, 10), pw1); \
    VRD(5); SBAR(); GAPA(C1 = __builtin_amdgcn_mfma_f32_32x32x16_bf16(kf[3], qr[1], C1, 0, 0, 0),   P0[14], P0[15], P1[0], P1[1],   pw1[2] = PKW(P0, 12), pw1[3] = PKW(P0, 14), pw1); \
    VRD(2); SBAR(); GAPA(C0 = __builtin_amdgcn_mfma_f32_32x32x16_bf16(kf[4], qr[2], C0, 0, 0, 0),   P1[2], P1[3], P1[4], P1[5],     pw2[0] = PKW(P1, 0), pw2[1] = PKW(P1, 2), pw2); \
    VRD(6); SBAR(); GAPA(C1 = __builtin_amdgcn_mfma_f32_32x32x16_bf16(kf[5], qr[2], C1, 0, 0, 0),   P1[6], P1[7], P1[8], P1[9],     pw2[2] = PKW(P1, 4), pw2[3] = PKW(P1, 6), pw2); \
    VRD(3); SBAR(); GAPA(C0 = __builtin_amdgcn_mfma_f32_32x32x16_bf16(kf[6], qr[3], C0, 0, 0, 0),   P1[10], P1[11], P1[12], P1[13], pw3[0] = PKW(P1, 8), pw3[1] = PKW(P1, 10), pw3); \
    VRD(7); SBAR(); GAPA(C1 = __builtin_amdgcn_mfma_f32_32x32x16_bf16(kf[7], qr[3], C1, 0, 0, 0),   P1[14], P1[15], 0.f, 0.f,       pw3[2] = PKW(P1, 12), pw3[3] = PKW(P1, 14), pw3); \
    l_reg += sacc; \
    if (GK) { DMA_K((t) + 3, sl_cur); } if (GV) { DMA_V((t) + 1, sl_next); } \
    if (JB >= 0) cmask(C0, C1, JB, qrel, hi); \
    { float a = MX3(C0[0], C0[1], C1[0]), b_ = MX3(C0[2], C0[3], C1[1]); a = MX3(a, C1[2], C1[3]); \
      _Pragma("unroll") for (int r = 4; r < 16; r += 4) { a = MX3(a, C0[r], C0[r + 1]); b_ = MX3(b_, C0[r + 2], C0[r + 3]); a = MX3(a, C1[r], C1[r + 1]); b_ = MX3(b_, C1[r + 2], C1[r + 3]); } \
      float rm = __builtin_fmaxf(a, b_); { auto rr = __builtin_amdgcn_permlane32_swap(__float_as_uint(rm), __float_as_uint(rm), false, false); rm = __builtin_fmaxf(__uint_as_float(rr[0]), __uint_as_float(rr[1])); } \
      resc = false; \
      if (__builtin_expect(__any(rm > (float)THRL), 0)) { const float dl = __builtin_fmaxf(rm, 0.f); mhat += dl; \
        _Pragma("unroll") for (int r = 0; r < 16; ++r) { C0[r] -= dl; C1[r] -= dl; } \
        const float f = __builtin_amdgcn_exp2f(-dl); l_reg *= f; if (hi == 0) wsf[r32] = f; resc = true; } } \
    SBAR(); \
    GAPB(o[0] = __builtin_amdgcn_mfma_f32_32x32x16_bf16(PAF(0), VFR(0), o[0], 0, 0, 0), C0, 0); \
    GAPB(o[1] = __builtin_amdgcn_mfma_f32_32x32x16_bf16(PAF(0), VFR(4), o[1], 0, 0, 0), C0, 4); \
    KRD(GL, 0); GAPB(o[0] = __builtin_amdgcn_mfma_f32_32x32x16_bf16(PAF(1), VFR(1), o[0], 0, 0, 0), C0, 8); \
    KRD(GL, 1); GAPB(o[1] = __builtin_amdgcn_mfma_f32_32x32x16_bf16(PAF(1), VFR(5), o[1], 0, 0, 0), C0, 12); \
    KRD(GL, 2); GAPB(o[0] = __builtin_amdgcn_mfma_f32_32x32x16_bf16(PAF(2), VFR(2), o[0], 0, 0, 0), C1, 0); \
    KRD(GL, 3); GAPB(o[1] = __builtin_amdgcn_mfma_f32_32x32x16_bf16(PAF(2), VFR(6), o[1], 0, 0, 0), C1, 4); \
    GAPB(o[0] = __builtin_amdgcn_mfma_f32_32x32x16_bf16(PAF(3), VFR(3), o[0], 0, 0, 0), C1, 8); \
    GAPB(o[1] = __builtin_amdgcn_mfma_f32_32x32x16_bf16(PAF(3), VFR(7), o[1], 0, 0, 0), C1, 12); \
    } while (0)
#define ENDW(tt) do { if ((tt) + 3 < NT) { WAIT_BAR(2); } else if ((tt) + 2 < NT) { WAIT_BAR(1); } else { WAIT_BAR(0); } } while (0)
    STEP(pB0, pB1, pA0, pA1, 1, (4 < NT), true, true, 1);   ENDW(1); RESC(); ROT();
    STEP(pA0, pA1, pB0, pB1, 2, (5 < NT), true, true, 2);   ENDW(2); RESC(); ROT();
    STEP(pB0, pB1, pA0, pA1, 3, (6 < NT), (4 < NT), (4 < NT), 3);   ENDW(3); RESC(); ROT();
    for (int t = 4; t < NT; t += 2) {
        STEP(pA0, pA1, pB0, pB1, t, (t + 3 < NT), true, true, -1);                       ENDW(t);     RESC(); ROT();
        STEP(pB0, pB1, pA0, pA1, t + 1, (t + 4 < NT), (t + 2 < NT), (t + 2 < NT), -1);   ENDW(t + 1); RESC(); ROT();
    }
    { float sacc = pB0[0] + pB0[1]; _Pragma("unroll") for (int r = 2; r < 16; ++r) sacc += pB0[r]; _Pragma("unroll") for (int r = 0; r < 16; ++r) sacc += pB1[r]; l_reg += sacc;
      pw0 = (u32x4){PKW(pB0, 0), PKW(pB0, 2), PKW(pB0, 4), PKW(pB0, 6)}; pw1 = (u32x4){PKW(pB0, 8), PKW(pB0, 10), PKW(pB0, 12), PKW(pB0, 14)}; pw2 = (u32x4){PKW(pB1, 0), PKW(pB1, 2), PKW(pB1, 4), PKW(pB1, 6)}; pw3 = (u32x4){PKW(pB1, 8), PKW(pB1, 10), PKW(pB1, 12), PKW(pB1, 14)};
      SBAR(); pv(o, (int)(unsigned long)vp0 + sl_prev, PAF(0), PAF(1), PAF(2), PAF(3)); }
#undef PKW
#undef PAF
#undef VFR
#undef PIN
#undef MX3
#undef GAPA
#undef GAPB
#undef EX
#undef VRD
#undef KRD
#undef STEP
#undef ENDW
    { auto rr = __builtin_amdgcn_permlane32_swap(__float_as_uint(l_reg), __float_as_uint(l_reg), false, false); l_reg = __uint_as_float(rr[0]) + __uint_as_float(rr[1]); }
    if (hi == 0) wsf[32 + r32] = l_reg; asm volatile("s_waitcnt lgkmcnt(0)" ::: "memory");
    float rli[16];
#pragma unroll
    for (int r = 0; r < 16; ++r) rli[r] = __builtin_amdgcn_rcpf(wsf[32 + crow(r, hi)]);
    bf16_t* Ow = Og + (rowbase + q0 + wid * QBLK) * DMO + h * HD;
    { bf16_t* stg = (bf16_t*)(shm + LDS_OST) + wid * 2048;
#pragma unroll
      for (int r = 0; r < 16; ++r) { const int orow = crow(r, hi);
#pragma unroll
        for (int d0 = 0; d0 < 2; ++d0) stg[orow * 64 + d0 * 32 + r32] = (bf16_t)f2bf(o[d0][r] * rli[r]); }
      asm volatile("s_waitcnt lgkmcnt(0)" ::: "memory");
#pragma unroll
      for (int i = 0; i < 4; ++i) { const int row = i * 8 + (lane >> 3), ch = lane & 7; const u32x4 v = *(const u32x4*)(stg + row * 64 + ch * 8); *(u32x4*)(Ow + (long)row * DMO + ch * 8) = v; } }
    asm volatile("s_waitcnt lgkmcnt(0)\n\ts_barrier" ::: "memory");
#undef DMA_K
#undef DMA_V
#undef TMAP
#undef SETC
#undef START
#undef RESC
#undef ROT
}
#undef SBAR
#undef WAIT_BAR
}

namespace hgrn {
constexpr int RS = 144;
constexpr int R_FQV = 0, FQV_SLOT = 32768;
constexpr int L_Q = 98304, L_K = L_Q + 9216, L_KT = L_K + 9216, L_VT = L_KT + 9216, L_ST = L_VT + 9216, L_SEG = L_ST + 9216, L_DEND = L_SEG + 2048, L_SSQ = L_DEND + 256, L_BYTES = L_SSQ + 512;
__device__ __forceinline__ int crow(int r, int hi) { return (r & 3) + 8 * (r >> 2) + 4 * hi; }
__device__ __forceinline__ void glds16(const void* gsrc, unsigned lds_dst) { unsigned keep;
    asm volatile("s_mov_b32 %0, m0\n\ts_mov_b32 m0, %2\n\ts_nop 0\n\tglobal_load_lds_dwordx4 %1, off\n\ts_mov_b32 m0, %0" : "=&s"(keep) : "v"(gsrc), "s"(lds_dst) : "memory"); }
#define HG_BAR() do { asm volatile("s_waitcnt lgkmcnt(0)" ::: "memory"); __builtin_amdgcn_s_barrier(); asm volatile("" ::: "memory"); } while (0)
__device__ __forceinline__ void hgrn_unit(int b, int h, const bf16_t* __restrict__ proj, bf16_t* __restrict__ mix, const float* __restrict__ lb_logits, const float* __restrict__ norm_g, LAS unsigned char* lds) {
    int tid_ = threadIdx.x; asm volatile("" : "+v"(tid_));
    const int tid = tid_, lane = tid & 63, r32 = lane & 31, hi = lane >> 5; const int w = __builtin_amdgcn_readfirstlane(tid >> 6);
    const float lbk = fast_rcp(1.0f + fast_exp2((lb_logits[512 + h * 64 + lane] - lb_logits[h * 64 + lane]) * LOG2E));
    const int vr = (w >> 1) & 1, tc = w & 1;
    float ng[16];
#pragma unroll
    for (int r = 0; r < 16; ++r) ng[r] = norm_g[h * 64 + 32 * vr + crow(r, hi)];
    f32x16 S = f32x16{};
    for (int i = tid; i < 64 * RS / 4; i += 512) ((LAS unsigned*)(lds + L_ST))[i] = 0u;
    const size_t hoff = (size_t)(b * 8 + h) * (SEQ * 64) + (size_t)w * 512 + lane * 8;
    const bf16_t* gQ = proj + 3 * SEC_ELEMS + hoff; const bf16_t* gF = proj + 4 * SEC_ELEMS + hoff; const bf16_t* gV = proj + 5 * SEC_ELEMS + hoff; const bf16_t* gG = proj + 6 * SEC_ELEMS + hoff;
    const unsigned lds0 = (unsigned)(uintptr_t)(unsigned char*)lds;
#define DMA_FQV(c_) do { const int cc_ = (c_) < 63 ? (c_) : 63; const unsigned d_ = (unsigned)__builtin_amdgcn_readfirstlane(lds0 + R_FQV + (unsigned)(((c_) % 3) * FQV_SLOT) + (unsigned)w * 1024u); \
        glds16(gF + (size_t)cc_ * 4096, d_); glds16(gQ + (size_t)cc_ * 4096, d_ + 8192u); glds16(gV + (size_t)cc_ * 4096, d_ + 16384u); } while (0)
#define DMA_G(c_) do { const int cc_ = (c_) < 63 ? (c_) : 63; glds16(gG + (size_t)cc_ * 4096, (unsigned)__builtin_amdgcn_readfirstlane(lds0 + R_FQV + (unsigned)(((c_) % 3) * FQV_SLOT) + 24576u + (unsigned)w * 1024u)); } while (0)
    DMA_FQV(0); DMA_G(0); DMA_FQV(1); DMA_G(1);
    for (int c = 0; c < 64; ++c) {
        const size_t row0 = (size_t)b * SEQ + (size_t)c * 64;
        DMA_FQV(c + 2);
        asm volatile("s_waitcnt vmcnt(8)" ::: "memory");
        const LAS unsigned char* raw = lds + R_FQV + (c % 3) * FQV_SLOT + (8 * w) * 128 + lane * 2;
        float p[8], kk[8];
        { float run = 0.f;
#pragma unroll
          for (int i = 0; i < 8; ++i) { const float x = bf2f(*(const LAS unsigned short*)(raw + i * 128)); const float sg = fast_rcp(1.0f + fast_exp2(-x * LOG2E)); const float f = lbk + (1.0f - lbk) * sg;
              run += __builtin_amdgcn_logf(f); p[i] = run; kk[i] = 1.0f - f; } }
        ((LAS float*)(lds + L_SEG))[w * 64 + lane] = p[7];
        HG_BAR();
        DMA_G(c + 2);
        { float off = 0.f;
#pragma unroll
          for (int j = 0; j < 7; ++j) { const float sv = ((LAS float*)(lds + L_SEG))[j * 64 + lane]; off += (j < w) ? sv : 0.f; }
          unsigned kq[4], vq[4];
#pragma unroll
          for (int i = 0; i < 8; i += 2) { const float b0 = off + p[i], b1 = off + p[i + 1];
              const unsigned short q0r = *(const LAS unsigned short*)(raw + 8192 + i * 128), q1r = *(const LAS unsigned short*)(raw + 8192 + (i + 1) * 128);
              const unsigned short v0r = *(const LAS unsigned short*)(raw + 16384 + i * 128), v1r = *(const LAS unsigned short*)(raw + 16384 + (i + 1) * 128);
              const float q0 = bf2f(q0r) * fast_exp2(b0), q1 = bf2f(q1r) * fast_exp2(b1), k0 = kk[i] * fast_exp2(-b0), k1 = kk[i + 1] * fast_exp2(-b1);
              const unsigned qq = cvtpk(q0, q1), kw = cvtpk(k0, k1); kq[i >> 1] = kw; vq[i >> 1] = (unsigned)v0r | ((unsigned)v1r << 16);
              *(LAS unsigned short*)(lds + L_Q + (8 * w + i) * RS + lane * 2) = (unsigned short)(qq & 0xffffu);
              *(LAS unsigned short*)(lds + L_Q + (8 * w + i + 1) * RS + lane * 2) = (unsigned short)(qq >> 16);
              *(LAS unsigned short*)(lds + L_K + (8 * w + i) * RS + lane * 2) = (unsigned short)(kw & 0xffffu);
              *(LAS unsigned short*)(lds + L_K + (8 * w + i + 1) * RS + lane * 2) = (unsigned short)(kw >> 16); }
          *(LAS u32x4*)(lds + L_KT + lane * RS + 16 * w) = (u32x4){kq[0], kq[1], kq[2], kq[3]};
          *(LAS u32x4*)(lds + L_VT + lane * RS + 16 * w) = (u32x4){vq[0], vq[1], vq[2], vq[3]};
          if (w == 7) ((LAS float*)(lds + L_DEND))[lane] = fast_exp2(off + p[7]); }
        asm volatile("s_waitcnt vmcnt(8)" ::: "memory");
        HG_BAR();
        f32x16 OT = f32x16{};
        if (w < 4) {
            bf16x8 bq[4];
#pragma unroll
            for (int ks = 0; ks < 4; ++ks) bq[ks] = *(const LAS bf16x8*)(lds + L_Q + (32 * tc + r32) * RS + (16 * ks + 8 * hi) * 2);
#pragma unroll
            for (int sr = 0; sr < 2; ++sr) if (sr <= tc) {
                f32x16 at = f32x16{};
#pragma unroll
                for (int ks = 0; ks < 4; ++ks) { const bf16x8 a = *(const LAS bf16x8*)(lds + L_K + (32 * sr + r32) * RS + (16 * ks + 8 * hi) * 2); at = __builtin_amdgcn_mfma_f32_32x32x16_bf16(a, bq[ks], at, 0, 0, 0); }
                if (sr == tc) {
#pragma unroll
                    for (int r = 0; r < 16; ++r) at[r] = (crow(r, hi) <= r32) ? at[r] : 0.f; }
#pragma unroll
                for (int st = 0; st < 2; ++st) {
                    u32x4 bw; bw.x = cvtpk(at[8 * st + 0], at[8 * st + 1]); bw.y = cvtpk(at[8 * st + 2], at[8 * st + 3]); bw.z = cvtpk(at[8 * st + 4], at[8 * st + 5]); bw.w = cvtpk(at[8 * st + 6], at[8 * st + 7]);
                    const u32x2 lo = *(const LAS u32x2*)(lds + L_VT + (32 * vr + r32) * RS + (32 * sr + 16 * st + 4 * hi) * 2);
                    const u32x2 hh = *(const LAS u32x2*)(lds + L_VT + (32 * vr + r32) * RS + (32 * sr + 16 * st + 8 + 4 * hi) * 2);
                    const u32x4 aw = (u32x4){lo.x, lo.y, hh.x, hh.y};
                    OT = __builtin_amdgcn_mfma_f32_32x32x16_bf16(__builtin_bit_cast(bf16x8, aw), __builtin_bit_cast(bf16x8, bw), OT, 0, 0, 0); }
            }
#pragma unroll
            for (int ks = 0; ks < 4; ++ks) { const bf16x8 a = *(const LAS bf16x8*)(lds + L_ST + (32 * vr + r32) * RS + (16 * ks + 8 * hi) * 2); OT = __builtin_amdgcn_mfma_f32_32x32x16_bf16(a, bq[ks], OT, 0, 0, 0); }
            float sq = 0.f;
#pragma unroll
            for (int r = 0; r < 16; ++r) sq += OT[r] * OT[r];
            sq += __shfl_xor(sq, 32);
            if (hi == 0) ((LAS float*)(lds + L_SSQ))[vr * 64 + 32 * tc + r32] = sq;
        } else {
#pragma unroll
            for (int st = 0; st < 4; ++st) { const bf16x8 a = *(const LAS bf16x8*)(lds + L_KT + (32 * vr + r32) * RS + (16 * st + 8 * hi) * 2);
                const bf16x8 bv = *(const LAS bf16x8*)(lds + L_VT + (32 * tc + r32) * RS + (16 * st + 8 * hi) * 2);
                S = __builtin_amdgcn_mfma_f32_32x32x16_bf16(a, bv, S, 0, 0, 0); }
#pragma unroll
            for (int r = 0; r < 16; ++r) S[r] *= ((LAS float*)(lds + L_DEND))[32 * vr + crow(r, hi)];
        }
        HG_BAR();
        if (w < 4) {
            const int t = 32 * tc + r32;
            const float tot = ((LAS float*)(lds + L_SSQ))[t] + ((LAS float*)(lds + L_SSQ))[64 + t];
            const float rstd = __builtin_amdgcn_rsqf(tot * (1.0f / 64.0f) + EPS);
            const LAS unsigned char* gp = lds + R_FQV + (c % 3) * FQV_SLOT + 24576 + t * 128 + (32 * vr + 4 * hi) * 2;
            bf16_t* op = mix + (row0 + t) * D + 512 + h * 64 + 32 * vr + 4 * hi;
#pragma unroll
            for (int g = 0; g < 4; ++g) { const u32x2 gg = *(const LAS u32x2*)(gp + 16 * g);
                const float y0 = OT[4 * g + 0] * rstd * ng[4 * g + 0] * bflo(gg.x), y1 = OT[4 * g + 1] * rstd * ng[4 * g + 1] * bfhi(gg.x),
                            y2 = OT[4 * g + 2] * rstd * ng[4 * g + 2] * bflo(gg.y), y3 = OT[4 * g + 3] * rstd * ng[4 * g + 3] * bfhi(gg.y);
                *(u32x2*)(op + 8 * g) = (u32x2){cvtpk(y0, y1), cvtpk(y2, y3)}; }
        } else {
#pragma unroll
            for (int g = 0; g < 4; ++g) *(LAS u32x2*)(lds + L_ST + (32 * tc + r32) * RS + (32 * vr + 8 * g + 4 * hi) * 2) = (u32x2){cvtpk(S[4 * g + 0], S[4 * g + 1]), cvtpk(S[4 * g + 2], S[4 * g + 3])};
        }
    }
    asm volatile("s_waitcnt vmcnt(0)" ::: "memory");
    HG_BAR();
#undef DMA_FQV
#undef DMA_G
}
#undef HG_BAR
}

constexpr int NWAVES = 8;
constexpr int LDS_BYTES = 163840;
constexpr int TAIL = 161792;
constexpr int TL_TE = TAIL, TL_TS = TAIL + 576, TL_HIST = TAIL + 768, TL_BASE = TAIL + 896, TL_MISC = TAIL + 1024, TL_CNT = TAIL + 1280;
typedef GAS unsigned gu32;

struct Args { const float* in[20]; float* out; unsigned char* ws; int ph_lo, ph_hi; };

struct Frame {
    LAS unsigned char* lds; volatile LAS unsigned* MISC; unsigned* ctl;
    int tid, lane, wave, G, vcu;
};

struct P0Item { const float* W; bf16_t* WT; const float* gain; int N, K, k0, n0, mode; };
__device__ __forceinline__ bool p0_decode(const Args& a, int it, P0Item& I) {
    unsigned char* ws = a.ws;
    constexpr int I_IN = 16 * 56, I_SQ = 16 * 16, I_KV = 16 * 32, I_W1 = 16 * 32, I_W2 = 16 * 16;
    constexpr int NITEMS = I_IN + 2 * I_SQ + I_KV + NEXP * (I_W1 + I_W2);
    if (it >= NITEMS) return false;
    int r = it; I.gain = nullptr; I.mode = 0; I.K = D;
    if (r < I_IN) { I.W = a.in[3]; I.WT = (bf16_t*)(ws + WS_WIN); I.N = INC; }
    else if ((r -= I_IN) < I_SQ) { I.W = a.in[6]; I.WT = (bf16_t*)(ws + WS_WOUT); I.N = D; }
    else if ((r -= I_SQ) < I_KV) { I.W = a.in[10]; I.WT = (bf16_t*)(ws + WS_WKV); I.N = 2 * D; }
    else if ((r -= I_KV) < I_SQ) { I.W = a.in[11]; I.WT = (bf16_t*)(ws + WS_WO); I.N = D; }
    else if ((r -= I_SQ) < NEXP * I_W1) { const int e = r / I_W1; r -= e * I_W1; I.W = a.in[15] + (size_t)e * D * 2048; I.WT = (bf16_t*)(ws + WS_W1 + (size_t)e * 2048 * D); I.N = 2048; I.gain = a.in[12]; I.mode = 3; }
    else { r -= NEXP * I_W1; const int e = r / I_W2; r -= e * I_W2; I.W = a.in[17] + (size_t)e * D * D; I.WT = (bf16_t*)(ws + WS_W2 + (size_t)e * D * D); I.N = D; I.mode = 2; }
    const int nblk = I.N / 64; I.k0 = 64 * (r / nblk); I.n0 = 64 * (r % nblk); return true;
}
__device__ __forceinline__ void p0_load(const P0Item& I, f32x4 (&v)[16], int lane) {
    const float* p = I.W + (size_t)(I.k0 + (lane >> 4)) * I.N + I.n0 + 4 * (lane & 15);
#pragma unroll
    for (int j = 0; j < 16; ++j) v[j] = *(const f32x4*)(p + (size_t)(4 * j) * I.N);
}
__device__ __forceinline__ void p0_store(const P0Item& I, const f32x4 (&v)[16], LAS unsigned char* tl, int lane) {
    const int kr = lane >> 4, nq = lane & 15;
#pragma unroll
    for (int j = 0; j < 16; ++j) { const int k = 4 * j + kr; const float g = I.gain ? I.gain[I.k0 + k] : 1.0f;
        *(LAS u32x2*)(tl + k * 128 + (((nq >> 1) ^ ((k >> 3) & 7)) * 16) + (nq & 1) * 8) = (u32x2){pk2(v[j].x * g, v[j].y * g), pk2(v[j].z * g, v[j].w * g)}; }
    LDS_WAIT(); asm volatile("" ::: "memory");
    const int c = lane & 7;
#pragma unroll
    for (int i = 0; i < 8; ++i) { const int n = (lane >> 3) + 8 * i; const LAS unsigned char* sp = tl + (8 * c) * 128 + ((i ^ c) * 16) + (n & 7) * 2;
        unsigned short e[8];
#pragma unroll
        for (int q = 0; q < 8; ++q) e[q] = *(const LAS unsigned short*)(sp + q * 128);
        int row = I.n0 + n; if (I.mode & 1) { const int jj = row >> 1, bj = row & 1; row = (jj >> 7) * 256 + bj * 128 + (jj & 127); }
        if (I.mode & 2) *(u32x2*)((unsigned char*)I.WT + (size_t)row * I.K + I.k0 + 8 * c) = (u32x2){pk4_fp8(bf2f(e[0]) * WSCALE8, bf2f(e[1]) * WSCALE8, bf2f(e[2]) * WSCALE8, bf2f(e[3]) * WSCALE8), pk4_fp8(bf2f(e[4]) * WSCALE8, bf2f(e[5]) * WSCALE8, bf2f(e[6]) * WSCALE8, bf2f(e[7]) * WSCALE8)};
        else *(u32x4*)(I.WT + (size_t)row * I.K + I.k0 + 8 * c) = (u32x4){(unsigned)e[0] | ((unsigned)e[1] << 16), (unsigned)e[2] | ((unsigned)e[3] << 16), (unsigned)e[4] | ((unsigned)e[5] << 16), (unsigned)e[6] | ((unsigned)e[7] << 16)}; }
    LDS_WAIT(); asm volatile("" ::: "memory");
}
__device__ __forceinline__ void rms_rows2_to_bf16(const float* __restrict__ x0, const float* __restrict__ x1, const float* __restrict__ g, bf16_t* __restrict__ o0, bf16_t* __restrict__ o1, int lane) {
    const f32x4* xa = (const f32x4*)x0 + lane; const f32x4* xb = (const f32x4*)x1 + lane; const f32x4* gr = (const f32x4*)g + lane;
    f32x4 va[4], vb[4]; float sa = 0.f, sb = 0.f;
#pragma unroll
    for (int j = 0; j < 4; ++j) { va[j] = xa[64 * j]; vb[j] = xb[64 * j]; }
#pragma unroll
    for (int j = 0; j < 4; ++j) { sa += (va[j].x * va[j].x + va[j].y * va[j].y) + (va[j].z * va[j].z + va[j].w * va[j].w); sb += (vb[j].x * vb[j].x + vb[j].y * vb[j].y) + (vb[j].z * vb[j].z + vb[j].w * vb[j].w); }
    const float ra = 1.0f / sqrtf(wave_sum(sa) * (1.0f / D) + EPS), rb = 1.0f / sqrtf(wave_sum(sb) * (1.0f / D) + EPS);
    unsigned long long* pa = (unsigned long long*)o0 + lane; unsigned long long* pb = (unsigned long long*)o1 + lane;
#pragma unroll
    for (int j = 0; j < 4; ++j) { const f32x4 gg = gr[64 * j];
        pa[64 * j] = (unsigned long long)pk2(va[j].x * ra * gg.x, va[j].y * ra * gg.y) | ((unsigned long long)pk2(va[j].z * ra * gg.z, va[j].w * ra * gg.w) << 32);
        pb[64 * j] = (unsigned long long)pk2(vb[j].x * rb * gg.x, vb[j].y * rb * gg.y) | ((unsigned long long)pk2(vb[j].z * rb * gg.z, vb[j].w * rb * gg.w) << 32); }
}

__device__ __forceinline__ void p0_prologue(Frame& F, const Args& a) {
    unsigned char* ws = a.ws;
    LAS unsigned char* tl = F.lds + F.wave * 8192;
    const int gw = F.vcu * NWAVES + F.wave, NGW = F.G * NWAVES;
    for (int m = 2 * gw; m < T; m += 2 * NGW) rms_rows2_to_bf16(a.in[0] + (size_t)m * D, a.in[0] + (size_t)(m + 1) * D, a.in[2], (bf16_t*)(ws + WS_XN) + (size_t)m * D, (bf16_t*)(ws + WS_XN) + (size_t)(m + 1) * D, F.lane);
    for (int m = 2 * gw; m < MROWS; m += 2 * NGW) rms_rows2_to_bf16(a.in[1] + (size_t)m * D, a.in[1] + (size_t)(m + 1) * D, a.in[8], (bf16_t*)(ws + WS_MN) + (size_t)m * D, (bf16_t*)(ws + WS_MN) + (size_t)(m + 1) * D, F.lane);
    for (int i = gw * 64 + F.lane; i < D * D / 4; i += NGW * 64) { const f32x4 w = ((const f32x4*)a.in[9])[i]; const float g = a.in[7][i >> 8];
        ((u32x2*)(ws + WS_WQ))[i] = (u32x2){pk2(w.x * g, w.y * g), pk2(w.z * g, w.w * g)}; }
    for (int i = gw * 64 + F.lane; i < NEXP * D; i += NGW * 64) { const int e = i >> 10, k = i & 1023; const float w = a.in[12][k] * a.in[13][k * NEXP + e];
        const unsigned hi = f2bf(w); ((bf16_t*)(ws + WS_WRT))[i] = (bf16_t)hi; ((bf16_t*)(ws + WS_WRT))[NEXP * D + i] = (bf16_t)f2bf(w - bf2f((unsigned short)hi)); }
    P0Item IA, IB; f32x4 va[16], vb[16];
    int it = gw; bool ha = p0_decode(a, it, IA); if (ha) p0_load(IA, va, F.lane);
    while (ha) {
        const bool hb = p0_decode(a, it + NGW, IB); if (hb) p0_load(IB, vb, F.lane);
        p0_store(IA, va, tl, F.lane);
        if (!hb) break;
        it += 2 * NGW; ha = p0_decode(a, it, IA); if (ha) p0_load(IA, va, F.lane);
        p0_store(IB, vb, tl, F.lane);
    }
}

__device__ __forceinline__ unsigned xcc_id() { return (unsigned)__builtin_amdgcn_s_getreg((3 << 11) | 20) & 0xFu; }
constexpr int QITEMS = 16 + 128;
__device__ __forceinline__ void p2_mixer(Frame& F, const Args& a, int rep) {
    unsigned char* ws = a.ws;
    const bf16_t* proj = (const bf16_t*)(ws + WS_PROJ); bf16_t* mix = (bf16_t*)(ws + WS_MIX);
    const unsigned x0 = xcc_id() & 7u;
    int par = 0;
#ifdef MK_P2_REPMODE
    if (rep && MK_P2_REPMODE == 4) return;
#endif
#ifdef MK_P2_HALF
    if (rep && (blockIdx.x & 8)) return;
#endif
    for (;;) {
        if (F.tid == 0) { int code = -1;
            for (int j = 0; j < 8; ++j) { const unsigned xq = (x0 + j) & 7u; const unsigned i = __hip_atomic_fetch_add(F.ctl + CW_QUEUE + 1024 * rep + 64 * xq, 1u, RLX_AGENT);
                if (i < (unsigned)QITEMS) { code = (int)(xq * 256u + i); break; } }
            F.MISC[par] = (unsigned)code; }
        LDS_WAIT(); __builtin_amdgcn_s_barrier(); asm volatile("" ::: "memory");
        const int code = __builtin_amdgcn_readfirstlane((int)F.MISC[par]); par ^= 1;
        if (code < 0) break;
        const int xq = code >> 8, i = code & 255;
#ifdef MK_P2_REPMODE
        if (rep && ((MK_P2_REPMODE == 1 && i >= 8) || (MK_P2_REPMODE == 2 && i < 16) || MK_P2_REPMODE == 3)) continue;
#endif
#ifndef NO_HGRN
        if (i < 8) { hgrn::hgrn_unit(xq, i, proj, mix, a.in[4], a.in[5], F.lds); }
        else
#endif
        if (i < 16) {
            pg8::KvOrder S{(const char*)(ws + WS_MN), (const char*)(ws + WS_WKV), xq * 8 + (i - 8)};
            pg8::EpiBf16 E{(bf16_t*)(ws + WS_MEMK), D, (bf16_t*)(ws + WS_MEMVT), D};
            pg8::gemm_phase<pg8::EpiBf16, pg8::KvOrder, false, false>(F.lds, D, D, D / 64, S, E);
        } else
#ifndef NO_MOBA
        { const int j = i - 16, g = j >> 5, jj = j & 31, hh = 2 * g + (jj & 1), qb = 15 - (jj >> 1);
            moba::attn_unit<8>(xq, hh, qb, proj, proj + SEC_ELEMS, proj + 2 * SEC_ELEMS, mix, (const float*)(ws + WS_KBAR), (char*)(unsigned char*)F.lds); }
#else
        {}
#endif
    }
}

__device__ __forceinline__ void p7_router(Frame& F, const Args& a, int rep) {
    unsigned char* ws = a.ws;
    constexpr int WRS = 2064;
    LAS unsigned char* WH = F.lds; LAS unsigned char* WL = F.lds + 32 * WRS;
    LAS int* hist = (LAS int*)(F.lds + TL_HIST); LAS int* basel = (LAS int*)(F.lds + TL_BASE);
    { const u32x4* src = (const u32x4*)(ws + WS_WRT);
      for (int i = F.tid; i < 2 * NEXP * D / 8; i += 512) { const int m = i >> 12, r = (i >> 7) & 31, c = i & 127; *(LAS u32x4*)(F.lds + m * 32 * WRS + r * WRS + c * 16) = src[i]; } }
    const float* h2f = (const float*)(ws + WS_H2F); const float* ss2 = (const float*)(ws + WS_SS2);
    int* toke = (int*)(ws + (rep ? WS_DUMMY + 1 * MiB : WS_TOKE)); int* tokr = (int*)(ws + (rep ? WS_DUMMY + 1 * MiB + 512 * 1024 : WS_TOKR)); float* tokg = (float*)(ws + (rep ? WS_DUMMY + 2 * MiB : WS_TOKG)); int* list = (int*)(ws + (rep ? WS_DUMMY + 4 * MiB : WS_LIST)); float* glist = (float*)(ws + (rep ? WS_DUMMY + 8 * MiB : WS_GLIST)); float* sslist = (float*)(ws + (rep ? WS_DUMMY + 12 * MiB : WS_SSLIST));
    unsigned* cntw = F.ctl + (rep ? CW_CNT + 2048 * rep : CW_CNT);
    const int lane = F.lane, r16 = lane & 15, g4 = lane >> 4;
    const float br0 = a.in[14][r16], br1 = a.in[14][16 + r16];
    for (int tb = blockIdx.x; tb < T / 128; tb += F.G) {
        if (F.tid < 32) hist[F.tid] = 0;
        LDS_WAIT(); __builtin_amdgcn_s_barrier(); asm volatile("" ::: "memory");
        const int t0 = tb * 128 + F.wave * 16;
        const float* xr = h2f + (size_t)(t0 + r16) * D + 8 * g4;
        f32x4 acc0 = (f32x4){0.f, 0.f, 0.f, 0.f}, acc1 = acc0;
        f32x4 xa = *(const f32x4*)(xr), xb = *(const f32x4*)(xr + 4);
#pragma unroll 4
        for (int ks = 0; ks < 32; ++ks) {
            const f32x4 ca = xa, cb = xb;
            if (ks + 1 < 32) { xa = *(const f32x4*)(xr + 32 * (ks + 1)); xb = *(const f32x4*)(xr + 32 * (ks + 1) + 4); }
            const unsigned h0 = cvtpk(ca.x, ca.y), h1 = cvtpk(ca.z, ca.w), h2 = cvtpk(cb.x, cb.y), h3 = cvtpk(cb.z, cb.w);
            const unsigned l0 = cvtpk(ca.x - bflo(h0), ca.y - bfhi(h0)), l1 = cvtpk(ca.z - bflo(h1), ca.w - bfhi(h1)), l2 = cvtpk(cb.x - bflo(h2), cb.y - bfhi(h2)), l3 = cvtpk(cb.z - bflo(h3), cb.w - bfhi(h3));
            const bf16x8 ah = __builtin_bit_cast(bf16x8, (u32x4){h0, h1, h2, h3}), al = __builtin_bit_cast(bf16x8, (u32x4){l0, l1, l2, l3});
            const int bo = r16 * WRS + (32 * ks + 8 * g4) * 2;
            const bf16x8 bh0 = *(const LAS bf16x8*)(WH + bo), bh1 = *(const LAS bf16x8*)(WH + 16 * WRS + bo), bl0 = *(const LAS bf16x8*)(WL + bo), bl1 = *(const LAS bf16x8*)(WL + 16 * WRS + bo);
            acc0 = __builtin_amdgcn_mfma_f32_16x16x32_bf16(ah, bh0, acc0, 0, 0, 0); acc1 = __builtin_amdgcn_mfma_f32_16x16x32_bf16(ah, bh1, acc1, 0, 0, 0);
            acc0 = __builtin_amdgcn_mfma_f32_16x16x32_bf16(ah, bl0, acc0, 0, 0, 0); acc1 = __builtin_amdgcn_mfma_f32_16x16x32_bf16(ah, bl1, acc1, 0, 0, 0);
            acc0 = __builtin_amdgcn_mfma_f32_16x16x32_bf16(al, bh0, acc0, 0, 0, 0); acc1 = __builtin_amdgcn_mfma_f32_16x16x32_bf16(al, bh1, acc1, 0, 0, 0);
        }
        int my_e = 0; float my_g = 0.f;
#pragma unroll
        for (int j = 0; j < 4; ++j) {
            const float rs = __builtin_amdgcn_rsqf(ss2[t0 + 4 * g4 + j] * (1.0f / D) + EPS);
            float a0 = acc0[j] * rs + br0, a1 = acc1[j] * rs + br1; float tv[4]; int te_[4];
#pragma unroll
            for (int k = 0; k < 4; ++k) { float m = fmaxf(a0, a1);
#pragma unroll
                for (int o = 1; o < 16; o <<= 1) m = fmaxf(m, __shfl_xor(m, o));
                int e = (a0 == m) ? r16 : ((a1 == m) ? 16 + r16 : 99);
#pragma unroll
                for (int o = 1; o < 16; o <<= 1) e = min(e, __shfl_xor(e, o));
                tv[k] = m; te_[k] = e; if (e == r16) a0 = -INFINITY; if (e == 16 + r16) a1 = -INFINITY; }
            const float d1 = fast_exp2((tv[1] - tv[0]) * LOG2E), d2 = fast_exp2((tv[2] - tv[0]) * LOG2E), d3 = fast_exp2((tv[3] - tv[0]) * LOG2E);
            const float inv = 1.0f / (1.0f + d1 + d2 + d3);
            if ((r16 >> 2) == j) { const int k = lane & 3; my_e = k == 0 ? te_[0] : (k == 1 ? te_[1] : (k == 2 ? te_[2] : te_[3])); my_g = (k == 0 ? 1.0f : (k == 1 ? d1 : (k == 2 ? d2 : d3))) * inv; }
        }
        const int rl = __hip_atomic_fetch_add(hist + my_e, 1, __ATOMIC_RELAXED, __HIP_MEMORY_SCOPE_WORKGROUP);
        LDS_WAIT(); __builtin_amdgcn_s_barrier(); asm volatile("" ::: "memory");
        if (F.tid < 32) basel[F.tid] = (int)__hip_atomic_fetch_add(cntw + F.tid, (unsigned)hist[F.tid], RLX_AGENT);
        LDS_WAIT(); VM_WAIT(); __builtin_amdgcn_s_barrier(); asm volatile("" ::: "memory");
        { const int t = t0 + 4 * g4 + (r16 >> 2), k = lane & 3; const int rank = basel[my_e] + rl;
          toke[t * 4 + k] = my_e; tokr[t * 4 + k] = rank; tokg[t * 4 + k] = my_g; list[(size_t)my_e * T + rank] = t; glist[(size_t)my_e * T + rank] = my_g; sslist[(size_t)my_e * T + rank] = ss2[t]; }
        LDS_WAIT(); __builtin_amdgcn_s_barrier(); asm volatile("" ::: "memory");
    }
}

__device__ __forceinline__ int build_tables(Frame& F) {
    LAS int* ts = (LAS int*)(F.lds + TL_TS); LAS unsigned char* te = (LAS unsigned char*)(F.lds + TL_TE);
    if (F.tid < NEXP) ((LAS int*)(F.lds + TL_CNT))[F.tid] = (int)__hip_atomic_load(F.ctl + CW_CNT + F.tid, RLX_AGENT);
    LDS_WAIT(); __builtin_amdgcn_s_barrier(); asm volatile("" ::: "memory");
    if (F.tid == 0) { int run = 0;
        for (int e = 0; e < NEXP; ++e) { ts[e] = run; run += (((LAS int*)(F.lds + TL_CNT))[e] + 255) >> 8; }
        ts[NEXP] = run; }
    LDS_WAIT(); __builtin_amdgcn_s_barrier(); asm volatile("" ::: "memory");
    const int nt = ts[NEXP];
    for (int g = F.tid; g < nt; g += 512) { int e = 0;
        for (int j = 1; j < NEXP; ++j) e += (ts[j] <= g) ? 1 : 0;
        te[g] = (unsigned char)e; }
    LDS_WAIT(); __builtin_amdgcn_s_barrier(); asm volatile("" ::: "memory");
    return __builtin_amdgcn_readfirstlane(nt);
}

__device__ __forceinline__ void p10_combine(Frame& F, const Args& a) {
    unsigned char* ws = a.ws;
    LAS int* ts = (LAS int*)(F.lds + TL_TS);
    const float* h2f = (const float*)(ws + WS_H2F); const unsigned char* Y = (const unsigned char*)(ws + WS_Y);
    const int* toke = (const int*)(ws + WS_TOKE); const int* tokr = (const int*)(ws + WS_TOKR);
    const float* gf = a.in[19];
    const int gw = F.vcu * NWAVES + F.wave, NGW = F.G * NWAVES, lane = F.lane;
    for (int t0 = 2 * gw; t0 < T; t0 += 2 * NGW) {
        float o[2][16]; u32x2 y[2][4][2];
#pragma unroll
        for (int q = 0; q < 2; ++q) { const int t = t0 + q;
#pragma unroll
            for (int k = 0; k < 4; ++k) { const int e = toke[t * 4 + k], r = tokr[t * 4 + k]; const unsigned char* yr = Y + ((size_t)ts[e] * 256 + r) * D;
                y[q][k][0] = *(const u32x2*)(yr + 8 * lane); y[q][k][1] = *(const u32x2*)(yr + 512 + 8 * lane); }
            const f32x4 a0 = *(const f32x4*)(h2f + (size_t)t * D + 8 * lane), a1 = *(const f32x4*)(h2f + (size_t)t * D + 8 * lane + 4), a2 = *(const f32x4*)(h2f + (size_t)t * D + 512 + 8 * lane), a3 = *(const f32x4*)(h2f + (size_t)t * D + 512 + 8 * lane + 4);
            o[q][0] = a0.x; o[q][1] = a0.y; o[q][2] = a0.z; o[q][3] = a0.w; o[q][4] = a1.x; o[q][5] = a1.y; o[q][6] = a1.z; o[q][7] = a1.w; o[q][8] = a2.x; o[q][9] = a2.y; o[q][10] = a2.z; o[q][11] = a2.w; o[q][12] = a3.x; o[q][13] = a3.y; o[q][14] = a3.z; o[q][15] = a3.w; }
#pragma unroll
        for (int q = 0; q < 2; ++q) {
#pragma unroll
            for (int k = 0; k < 4; ++k)
#pragma unroll
                for (int hf = 0; hf < 2; ++hf) { const u32x2 w = y[q][k][hf];
                    const f32x2 c0 = __builtin_amdgcn_cvt_pk_f32_fp8((int)w.x, false), c1 = __builtin_amdgcn_cvt_pk_f32_fp8((int)w.x, true), c2 = __builtin_amdgcn_cvt_pk_f32_fp8((int)w.y, false), c3 = __builtin_amdgcn_cvt_pk_f32_fp8((int)w.y, true);
                    o[q][8 * hf + 0] += pg8::YSCALE_INV * c0.x; o[q][8 * hf + 1] += pg8::YSCALE_INV * c0.y; o[q][8 * hf + 2] += pg8::YSCALE_INV * c1.x; o[q][8 * hf + 3] += pg8::YSCALE_INV * c1.y;
                    o[q][8 * hf + 4] += pg8::YSCALE_INV * c2.x; o[q][8 * hf + 5] += pg8::YSCALE_INV * c2.y; o[q][8 * hf + 6] += pg8::YSCALE_INV * c3.x; o[q][8 * hf + 7] += pg8::YSCALE_INV * c3.y; }
            float s = 0.f;
#pragma unroll
            for (int j = 0; j < 16; ++j) s += o[q][j] * o[q][j];
            const float rstd = 1.0f / sqrtf(wave_sum(s) * (1.0f / D) + EPS);
            float* op = a.out + (size_t)(t0 + q) * D;
#pragma unroll
            for (int v = 0; v < 4; ++v) { const int col = (v >> 1) * 512 + 8 * lane + (v & 1) * 4; const f32x4 g4 = *(const f32x4*)(gf + col);
                *(f32x4*)(op + col) = (f32x4){o[q][4 * v] * rstd * g4.x, o[q][4 * v + 1] * rstd * g4.y, o[q][4 * v + 2] * rstd * g4.z, o[q][4 * v + 3] * rstd * g4.w}; }
        }
    }
}

#define XB_TMO      128
#define XB_XCNT(j)  (256  + 64 * (j))
#define XB_XSUB(j)  (1280 + 64 * (j))
#define XB_XGEN(j)  (2304 + 64 * (j))
#define XB_TOP      3328
#define XB_TOPGEN   3392
#define XCD_BAR_WORDS 3456
#define XB_SPIN_CAP (1u << 22)
__device__ __forceinline__ unsigned xb_ld(unsigned* p)              { return __hip_atomic_load(p, __ATOMIC_RELAXED, __HIP_MEMORY_SCOPE_AGENT); }
__device__ __forceinline__ unsigned xb_add(unsigned* p, unsigned v) { return __hip_atomic_fetch_add(p, v, __ATOMIC_RELAXED, __HIP_MEMORY_SCOPE_AGENT); }
#define XB_SPIN(cond, bar) do { unsigned _sp = 0; while (cond) { __builtin_amdgcn_s_sleep(1); \
    if ((++_sp & 255u) == 0u) { if (xb_ld(&(bar)[XB_TMO])) break; if (_sp > XB_SPIN_CAP) { atomicAdd(&(bar)[XB_TMO], 1u); break; } } } } while (0)
struct XcdBarrier { unsigned* bar; unsigned x; volatile LAS unsigned* st; };
__device__ __forceinline__ XcdBarrier xcd_barrier_post(unsigned* bar, volatile LAS unsigned* st) {
    XcdBarrier b; b.bar = bar; b.x = (unsigned)__builtin_amdgcn_s_getreg((3 << 11) | 20) & 0xFu; b.st = st;
    if (threadIdx.x == 0) (void)xb_add(&bar[XB_XCNT(b.x)], 1u);
    return b;
}
__device__ __forceinline__ void xcd_barrier_complete(unsigned* bar, unsigned x, unsigned& nloc, unsigned& nx) {
    const unsigned G = gridDim.x * gridDim.y * gridDim.z;
    unsigned sum, cnt, mine, sp = 0u;
    for (;;) {
        sum = 0u; cnt = 0u; mine = 0u;
#pragma unroll
        for (unsigned j = 0; j < 16; ++j) { const unsigned c = xb_ld(&bar[XB_XCNT(j)]); sum += c; cnt += (c > 0u) ? 1u : 0u; mine = (j == x) ? c : mine; }
        if (sum == G) break;
        __builtin_amdgcn_s_sleep(1);
        if ((++sp & 255u) == 0u) { if (xb_ld(&bar[XB_TMO])) break; if (sp > XB_SPIN_CAP) { atomicAdd(&bar[XB_TMO], 1u); break; } }
    }
    nloc = mine > 0u ? mine : 1u; nx = cnt > 0u ? cnt : 1u;
}
__device__ __forceinline__ void xcd_barrier(const XcdBarrier& b) {
    asm volatile("s_waitcnt vmcnt(0)" ::: "memory");
    __syncthreads();
    if (threadIdx.x == 0) {
        unsigned* bar = b.bar;
        __builtin_amdgcn_s_waitcnt(0);
        unsigned nloc = b.st[0], nx = b.st[1];
        if (nloc == 0u) { xcd_barrier_complete(bar, b.x, nloc, nx); b.st[0] = nloc; b.st[1] = nx; }
        const unsigned old = xb_add(&bar[XB_XSUB(b.x)], 1u);
        const unsigned gen = old / nloc;
        if (old + 1u == (gen + 1u) * nloc) {
            __builtin_amdgcn_fence(__ATOMIC_RELEASE, "agent");
            asm volatile("s_waitcnt vmcnt(0)" ::: "memory");
            const unsigned og = xb_add(&bar[XB_TOP], 1u);
            const unsigned tg = og / nx;
            if (og + 1u == (tg + 1u) * nx) xb_add(&bar[XB_TOPGEN], 1u);
            else XB_SPIN(xb_ld(&bar[XB_TOPGEN]) == tg, bar);
            __builtin_amdgcn_fence(__ATOMIC_ACQUIRE, "agent");
            xb_add(&bar[XB_XGEN(b.x)], 1u);
            asm volatile("s_waitcnt vmcnt(0)" ::: "memory");
        } else {
            XB_SPIN(xb_ld(&bar[XB_XGEN(b.x)]) == gen, bar);
            __builtin_amdgcn_fence(__ATOMIC_ACQUIRE, "agent");
            asm volatile("s_waitcnt vmcnt(0)" ::: "memory");
        }
    }
    __syncthreads();
}
#ifndef MK_CG_ONLY
#define MK_CG_ONLY 0
#endif
__device__ __forceinline__ void grid_barrier(Frame& F, const XcdBarrier& xb_) { if (MK_CG_ONLY) cg::this_grid().sync(); else xcd_barrier(xb_); }
#ifndef MK_PHASE_MASK
#define MK_PHASE_MASK 0x7ff
#endif
#ifndef MK_REP_PHASE
#define MK_REP_PHASE -1
#endif
#ifndef MK_REP_N
#define MK_REP_N 0
#endif
__device__ __forceinline__ void ph0(Frame& F, const Args& args, int rep) { p0_prologue(F, args); }
__device__ __forceinline__ void ph1(Frame& F, const Args& args, int rep) {
    unsigned char* ws = args.ws; const int cid = (int)blockIdx.x;
    { pg8::DenseOrder S{(const char*)(ws + WS_XN), (const char*)(ws + WS_WIN), D, D, T / 256, INC / 256, F.G, cid};
      pg8::EpiProj E{(bf16_t*)(ws + WS_PROJ), rep ? (float*)(ws + WS_DUMMY) : (float*)(ws + WS_KBAR)};
      pg8::gemm_phase<pg8::EpiProj, pg8::DenseOrder, false, true>(F.lds, D, D, D / 64, S, E); }
}
__device__ __forceinline__ void ph2(Frame& F, const Args& args, int rep) { p2_mixer(F, args, rep); }
constexpr size_t WS_MB = WS_PROJ, WS_NB = WS_PROJ + 16 * MiB, WS_H1Q = WS_PROJ + 32 * MiB, WS_PB = WS_QX;
constexpr size_t WS_UNUSED_XA = 0;
constexpr int LDS_XTAB = 131072;
__device__ __forceinline__ void ph3(Frame& F, const Args& args, int rep) {
    unsigned char* ws = args.ws; const int cid = (int)blockIdx.x;
    { pg8::XmnOrder S{(const char*)(ws + WS_MEMK), (const char*)(ws + WS_MEMVT), (const char*)(ws + WS_WQ), (const char*)(ws + WS_WO), F.G, cid};
      pg8::EpiFp8 E{(unsigned char*)(ws + WS_MB), D, (unsigned char*)(ws + WS_NB), D, XSCALE8};
      pg8::gemm_phase<pg8::EpiFp8, pg8::XmnOrder, false, true>(F.lds, D, D, 4, S, E); }
    pg8::DenseOrder S{(const char*)(ws + WS_MIX), (const char*)(ws + WS_WOUT), D, D, T / 256, D / 256, F.G, cid};
    pg8::EpiRes<true, false> E{(const void*)args.in[0], (bf16_t*)(ws + WS_H1B), nullptr, rep ? (float*)(ws + WS_DUMMY + 512 * 1024) : (float*)(ws + WS_SS1), 1.0f, (unsigned char*)(ws + WS_H1Q)};
    pg8::gemm_phase<pg8::EpiRes<true, false>, pg8::DenseOrder, false, true>(F.lds, D, D, D / 64, S, E);
}
__device__ __forceinline__ void ph4(Frame& F, const Args& args, int rep) {
    unsigned char* ws = args.ws; const int cid = (int)blockIdx.x;
    pg8::XbOrder S{(const char*)(ws + WS_H1Q), (const char*)(ws + WS_MB), F.G, cid, (size_t)D};
    pg8::EpiSoftmaxS E{(unsigned char*)(ws + WS_PB), (const float*)(ws + WS_SS1), F.lds + LDS_XTAB, XSCALE8_INV};
    pg8::gemm_phase<pg8::EpiSoftmaxS, pg8::XbOrder, false, true, true>(F.lds, D / 2, D / 2, D / 128, S, E);
}
__device__ __forceinline__ void ph5(Frame& F, const Args& args, int rep) {}
__device__ __forceinline__ void ph6(Frame& F, const Args& args, int rep) {
    unsigned char* ws = args.ws; const int cid = (int)blockIdx.x;
    pg8::XbOrder S{(const char*)(ws + WS_PB), (const char*)(ws + WS_NB), F.G, cid, (size_t)D};
    pg8::EpiRes<false, true, true> E{(const void*)(ws + WS_H1B), (bf16_t*)(ws + WS_H2B), (float*)(ws + WS_H2F), rep ? (float*)(ws + WS_DUMMY + 512 * 1024) : (float*)(ws + WS_SS2), PSCALE8_INV * XSCALE8_INV, nullptr};
    pg8::gemm_phase<pg8::EpiRes<false, true, true>, pg8::XbOrder, false, true, true>(F.lds, D / 2, D / 2, D / 128, S, E);
}
__device__ __forceinline__ void ph7(Frame& F, const Args& args, int rep) { p7_router(F, args, rep); }
__device__ __forceinline__ void ph8(Frame& F, const Args& args, int rep) {
    unsigned char* ws = args.ws; const int cid = (int)blockIdx.x;
    const int ntl = build_tables(F);
    pg8::MoeOrder S{(const char*)(ws + WS_H2B), (const char*)(ws + WS_W1), (const int*)(ws + WS_LIST), (const LAS int*)(F.lds + TL_CNT), (const LAS unsigned char*)(F.lds + TL_TE), (const LAS int*)(F.lds + TL_TS),
                    ntl, 8, F.G, cid, (size_t)2048 * D, 1, (size_t)256 * D, (size_t)256 * D};
    pg8::EpiW1 E{(bf16_t*)(ws + WS_HMID), (const float*)(ws + WS_SSLIST), args.in[16], (const int*)(ws + WS_LIST)};
    pg8::gemm_phase<pg8::EpiW1, pg8::MoeOrder, true, true, true>(F.lds, D / 2, D / 2, D / 128, S, E);
}
__device__ __forceinline__ void ph9(Frame& F, const Args& args, int rep) {
    unsigned char* ws = args.ws; const int cid = (int)blockIdx.x;
    const int ntl = build_tables(F);
    pg8::MoeOrder S{(const char*)(ws + WS_HMID), (const char*)(ws + WS_W2), (const int*)(ws + WS_LIST), (const LAS int*)(F.lds + TL_CNT), (const LAS unsigned char*)(F.lds + TL_TE), (const LAS int*)(F.lds + TL_TS),
                    ntl, 4, F.G, cid, (size_t)D * D, 0, (size_t)256 * D, (size_t)256 * D};
    pg8::EpiW2 E{(unsigned char*)(ws + WS_Y), args.in[18], (const int*)(ws + WS_LIST), (const float*)(ws + WS_GLIST)};
    pg8::gemm_phase<pg8::EpiW2, pg8::MoeOrder, false, true, true>(F.lds, D / 2, D / 2, D / 128, S, E);
}
__device__ __forceinline__ void ph10(Frame& F, const Args& args, int rep) { (void)build_tables(F); p10_combine(F, args); }

constexpr int N_PHASES = 11;
__global__ void __launch_bounds__(NWAVES * 64, 2) hymba_fwd(Args args) {
    extern __shared__ __attribute__((aligned(16))) unsigned char lds_raw[];
    Frame F;
    F.lds = (LAS unsigned char*)lds_raw;
    F.MISC = (volatile LAS unsigned*)(F.lds + TL_MISC);
    F.tid = threadIdx.x; F.lane = F.tid & 63; F.wave = __builtin_amdgcn_readfirstlane(F.tid >> 6);
    F.G = gridDim.x; { const int bx = blockIdx.x; F.vcu = (F.G % 8 == 0) ? (bx % 8) * (F.G / 8) + bx / 8 : bx; }
    F.ctl = (unsigned*)(args.ws + WS_CTL);
    const int lo = args.ph_lo, hi = args.ph_hi;
    for (int u = F.tid; u < 64; u += NWAVES * 64) ((LAS unsigned*)(F.lds + TL_MISC))[u] = 0u;
    __syncthreads();
    const XcdBarrier xbar = xcd_barrier_post(F.ctl + CW_BAR, F.MISC + 8);
#define RUN(k, fn) do { if (((MK_PHASE_MASK >> (k)) & 1) && lo <= (k) && (k) < hi) { fn(F, args, 0); \
        if (MK_REP_PHASE == (k) && MK_REP_N >= 1) { grid_barrier(F, xbar); fn(F, args, 1); } \
        if (MK_REP_PHASE == (k) && MK_REP_N >= 2) { grid_barrier(F, xbar); fn(F, args, 2); } \
        if ((k) + 1 < hi) { if ((k) == 0) cg::this_grid().sync(); else grid_barrier(F, xbar); } } } while (0)
    RUN(0, ph0); RUN(1, ph1); RUN(2, ph2); RUN(3, ph3); RUN(4, ph4);   RUN(6, ph6); RUN(7, ph7); RUN(8, ph8); RUN(9, ph9); RUN(10, ph10);
#undef RUN
}

extern "C" void kernel_launch(void* const* d_in, const int* in_sizes, int n_in, void* d_out, int out_size, void* d_ws, size_t ws_size, hipStream_t stream) {
    static int grid = 0;
    if (grid == 0) {
        if (n_in != 20 || in_sizes[0] != T * D || out_size != T * D || ws_size < WS_END) {
            fprintf(stderr, "kernel_launch: shape/workspace mismatch (n_in %d, in0 %d, out %d, ws %zu, need %zu)\n", n_in, n_in > 0 ? in_sizes[0] : -1, out_size, ws_size, (size_t)WS_END); grid = -1; return; }
        int dev = 0, cus = 0, per_cu = 0;
        if (hipGetDevice(&dev) != hipSuccess || hipDeviceGetAttribute(&cus, hipDeviceAttributeMultiprocessorCount, dev) != hipSuccess) { grid = -1; return; }
        if (hipFuncSetAttribute((const void*)hymba_fwd, hipFuncAttributeMaxDynamicSharedMemorySize, LDS_BYTES) != hipSuccess) { fprintf(stderr, "kernel_launch: hipFuncSetAttribute failed\n"); grid = -1; return; }
        if (hipOccupancyMaxActiveBlocksPerMultiprocessor(&per_cu, (const void*)hymba_fwd, NWAVES * 64, LDS_BYTES) != hipSuccess || per_cu < 1) { fprintf(stderr, "kernel_launch: occupancy query says %d\n", per_cu); }
        (void)hipGetLastError();
        grid = cus;
        if (grid != 256) fprintf(stderr, "kernel_launch: %d CUs; this kernel is built for 256\n", grid);
    }
    if (grid < 0) return;
    (void)hipMemsetAsync((char*)d_ws + WS_CTL, 0, CTL_ZERO_BYTES, stream);
    Args a{};
    for (int i = 0; i < 20; ++i) a.in[i] = (const float*)d_in[i];
    a.out = (float*)d_out; a.ws = (unsigned char*)d_ws;
#if MK_N_LAUNCHES == 1
    a.ph_lo = 0; a.ph_hi = MK_LAST_PHASE + 1;
    void* kargs[] = {&a};
    hipError_t e = hipLaunchCooperativeKernel((const void*)hymba_fwd, dim3(grid), dim3(NWAVES * 64), kargs, LDS_BYTES, stream);
    if (e != hipSuccess) fprintf(stderr, "kernel_launch: cooperative launch failed: %s\n", hipGetErrorString(e));
#else
    for (int p = 0; p <= MK_LAST_PHASE; ++p) { a.ph_lo = p; a.ph_hi = p + 1; hipLaunchKernelGGL(hymba_fwd, dim3(grid), dim3(NWAVES * 64), LDS_BYTES, stream, a); }
#endif
}
```

```cpp
#include <hip/hip_runtime.h>
#include <hip/hip_cooperative_groups.h>
#include <cstdio>
#include <cstdint>
namespace cg = cooperative_groups;

#ifndef MK_N_LAUNCHES
#define MK_N_LAUNCHES 1
#endif
#ifndef MK_LAST_PHASE
#define MK_LAST_PHASE 10
#endif

#define LAS __attribute__((address_space(3)))
#define GAS __attribute__((address_space(1)))
typedef unsigned short bf16_t;
typedef short bf16x8 __attribute__((ext_vector_type(8)));
typedef short s16x4 __attribute__((ext_vector_type(4)));
typedef float f32x4 __attribute__((ext_vector_type(4)));
typedef float f32x2 __attribute__((ext_vector_type(2)));
typedef float f32x16 __attribute__((ext_vector_type(16)));
typedef unsigned u32x4 __attribute__((ext_vector_type(4)));
typedef unsigned u32x2 __attribute__((ext_vector_type(2)));
typedef int v8i32_t __attribute__((ext_vector_type(8)));

constexpr int BATCH = 8, SEQ = 4096, T = BATCH * SEQ, D = 1024, INC = 3584, NMEM = 256, MROWS = BATCH * NMEM;
constexpr int NEXP = 32, TOPK = 4, MT_MAX = T * TOPK / 256 + NEXP, MPAD = MT_MAX * 256;
constexpr float EPS = 1e-6f;
constexpr float LOG2E = 1.4426950408889634f;
constexpr float C2Q = 0.125f * LOG2E;
constexpr float C2X = 0.0625f * LOG2E;
constexpr int C_MQ = 0, C_MK = 512, C_MV = 1024, C_GQ = 1536, C_GF = 2048, C_GI = 2560, C_GG = 3072;

constexpr size_t MiB = 1u << 20;
constexpr size_t WS_CTL = 0, CTL_ZERO_BYTES = 2 * MiB;
constexpr size_t WS_KBAR = 1 * MiB;
constexpr size_t WS_SS1 = 1 * MiB + 256 * 1024;
constexpr size_t WS_SS2 = 1 * MiB + 384 * 1024;
constexpr size_t WS_TOKE = 2 * MiB, WS_TOKR = 2 * MiB + 512 * 1024, WS_TOKG = 3 * MiB;
constexpr size_t WS_WRT = 3 * MiB + 512 * 1024;
constexpr size_t WS_LIST = 4 * MiB;
constexpr size_t WS_GLIST = 8 * MiB;
constexpr size_t WS_SSLIST = 12 * MiB;
constexpr size_t WS_WIN = 16 * MiB, WS_WOUT = 23 * MiB, WS_WQ = 25 * MiB, WS_WKV = 27 * MiB, WS_WO = 31 * MiB;
constexpr size_t WS_MN = 33 * MiB, WS_MEMK = 37 * MiB, WS_MEMVT = 41 * MiB;
constexpr size_t WS_W1 = 48 * MiB, WS_W2 = 176 * MiB;
constexpr size_t WS_PROJ = 240 * MiB;
constexpr size_t SEC_ELEMS = (size_t)16 * 1024 * 1024;
constexpr size_t WS_XN = 464 * MiB;
constexpr size_t WS_OX = 464 * MiB;
constexpr size_t WS_MIX = 528 * MiB;
constexpr size_t WS_H1B = 592 * MiB;
constexpr size_t WS_QX = 656 * MiB;
constexpr size_t WS_PWS = 720 * MiB;
constexpr size_t WS_HMID = 240 * MiB;
constexpr size_t WS_Y = 512 * MiB;
constexpr size_t WS_H2F = 784 * MiB;
constexpr size_t WS_H2B = 912 * MiB;
constexpr size_t WS_DUMMY = 976 * MiB;
constexpr size_t WS_END = 992 * MiB;
static_assert(WS_HMID + (size_t)MPAD * D * 2 <= WS_Y && WS_Y + (size_t)MPAD * D * 2 <= WS_H2F, "ws map");
constexpr int CW_TMO = 0;
constexpr int CW_CNT = 64;
constexpr int CW_QUEUE = 128;
constexpr int CW_BAR = 4096;

__device__ __forceinline__ unsigned f2bf(float f) { unsigned u = __builtin_bit_cast(unsigned, f); return (u + 0x7fffu + ((u >> 16) & 1u)) >> 16; }
__device__ __forceinline__ unsigned pk2(float lo, float hi) { return f2bf(lo) | (f2bf(hi) << 16); }
__device__ __forceinline__ float bf2f(unsigned short h) { return __builtin_bit_cast(float, (unsigned)h << 16); }
__device__ __forceinline__ float bflo(unsigned w) { return __builtin_bit_cast(float, w << 16); }
__device__ __forceinline__ float bfhi(unsigned w) { return __builtin_bit_cast(float, w & 0xffff0000u); }
typedef float f32x2_t __attribute__((ext_vector_type(2))); typedef __bf16 bf16x2_t __attribute__((ext_vector_type(2)));
__device__ __forceinline__ unsigned cvtpk(float lo, float hi) { f32x2_t v = {lo, hi}; bf16x2_t b = __builtin_convertvector(v, bf16x2_t); return __builtin_bit_cast(unsigned, b); }
__device__ __forceinline__ float wave_sum(float v) {
#pragma unroll
    for (int o = 1; o < 64; o <<= 1) v += __shfl_xor(v, o);
    return v;
}
__device__ __forceinline__ float fast_exp2(float x) { return __builtin_amdgcn_exp2f(x); }
__device__ __forceinline__ float fast_rcp(float x) { return __builtin_amdgcn_rcpf(x); }
__device__ __forceinline__ float silu_f(float x) { return x * fast_rcp(1.0f + fast_exp2(-x * LOG2E)); }
__device__ __forceinline__ unsigned pk4_fp8(float a, float b, float c, float d) { int w = 0; w = __builtin_amdgcn_cvt_pk_fp8_f32(a, b, w, false); w = __builtin_amdgcn_cvt_pk_fp8_f32(c, d, w, true); return (unsigned)w; }
constexpr float XSCALE8 = 4.0f, XSCALE8_INV = 0.25f, PSCALE8 = 256.0f, PSCALE8_INV = 1.0f / 256.0f;
constexpr float WSCALE8 = 32.0f, WSCALE8_INV = 1.0f / 32.0f;
#define LDS_WAIT() asm volatile("s_waitcnt lgkmcnt(0)" ::: "memory")
#define VM_WAIT() asm volatile("s_waitcnt vmcnt(0)" ::: "memory")
#define RLX_AGENT __ATOMIC_RELAXED, __HIP_MEMORY_SCOPE_AGENT

namespace pg8 {
constexpr int BM = 256, BK = 64, HALF = 128, HTB = HALF * BK * 2, STAGE_BYTES = 8 * HTB;
__device__ __forceinline__ unsigned gload32_hidden(const void* sbase, unsigned voff) { unsigned v; asm volatile("global_load_dword %0, %1, %2" : "=v"(v) : "v"(voff), "s"(sbase) : "memory"); return v; }
__device__ __forceinline__ f32x4 gload128_hidden(const void* sbase, unsigned voff) { f32x4 v; asm volatile("global_load_dwordx4 %0, %1, %2" : "=v"(v) : "v"(voff), "s"(sbase) : "memory"); return v; }
__device__ __forceinline__ void glds16s(const char* sbase, unsigned voff, unsigned lds_dst) { unsigned keep;
    asm volatile("s_mov_b32 %0, m0\n\ts_mov_b32 m0, %3\n\ts_nop 0\n\tglobal_load_lds_dwordx4 %1, %2\n\ts_mov_b32 m0, %0" : "=&s"(keep) : "v"(voff), "s"(sbase), "s"(lds_dst) : "memory"); }
__host__ __device__ __forceinline__ int lds_byte(int r, int c) { const int st = (r >> 4) * 2 + (c >> 5), rr = r & 15, cc = c & 31, ob = rr * 64 + cc * 2; return st * 1024 + (ob ^ (((ob >> 9) & 1) << 5)); }
__host__ __device__ __forceinline__ void stage_rc(int b, int& R, int& C) { const int st = b / 1024, sb = b % 1024, swz = sb ^ (((sb >> 9) & 1) << 5); R = (st >> 1) * 16 + swz / 64; C = (st & 1) * 32 + (swz % 64) / 2; }
__host__ __device__ __forceinline__ int perm32(int rho) { const int n = rho >> 4, i = rho & 15; return 8 * (i >> 2) + 4 * n + (i & 3); }

struct Unit { const char* A; const char* B; const int* rows; int pm, pn, aux, nrows, ntu; };

template <class Epi, class Sched, bool GATHER, bool ALIGN_EPI, bool FP8 = false>
__device__ __forceinline__ void gemm_phase(LAS unsigned char* lds, const int lda, const int ldb, const int nt_in, const Sched& S, const Epi& E) {
    int nt = nt_in; asm volatile("" : "+s"(nt));
    int tid_ = threadIdx.x; asm volatile("" : "+v"(tid_));
    const int tid = tid_, wid = __builtin_amdgcn_readfirstlane(tid >> 6), lane = tid & 63, wr = wid >> 2, wc = wid & 3, fr = lane & 15, fq = lane >> 4;
    unsigned offB0; { int R, C; stage_rc(tid * 16, R, C); const int Rb = Epi::PERM ? ((R & ~31) + perm32(R & 31)) : R; offB0 = (unsigned)(Rb * ldb + C) * 2u; }
    const size_t pstepB = (size_t)64 * ldb * 2;
    const size_t kstep = (size_t)(BK * 2);
    const size_t hstepB = (size_t)HALF * ldb * 2;
    const unsigned ldsb = (unsigned)__builtin_amdgcn_readfirstlane((int)((unsigned)(uintptr_t)(unsigned char*)lds + (unsigned)wid * 1024u));
    const int aoff = lds_byte(wr * 64 + fr, FP8 ? fq * 16 : fq * 8), boff = lds_byte(wc * 32 + fr, FP8 ? fq * 16 : fq * 8);
#define PG8_SA(b, h) (((b) * 2 + (h)) * HTB)
#define PG8_SB(b, h) ((4 + (b) * 2 + (h)) * HTB)
#define PG8_STGB(bufoff, gbase) do { glds16s((const char*)(gbase), offB0, ldsb + (unsigned)(bufoff)); glds16s((const char*)(gbase) + pstepB, offB0, ldsb + (unsigned)(bufoff) + 8192u); } while (0)
#define PG8_LD16(p_) (*(const LAS u32x4*)(p_))
#define PG8_CAT(x, y) __builtin_bit_cast(v8i32_t, __builtin_shufflevector(x, y, 0, 1, 2, 3, 4, 5, 6, 7))
    unsigned aA0 = (unsigned)(aoff + PG8_SA(0, 0)), aA1 = (unsigned)(aoff + PG8_SA(1, 0)), bB0 = (unsigned)(boff + PG8_SB(0, 0)), bB1 = (unsigned)(boff + PG8_SB(1, 0));
    asm volatile("" : "+v"(aA0), "+v"(aA1), "+v"(bB0), "+v"(bB1));
    int scl8 = 0x7f7f7f7f; asm volatile("" : "+v"(scl8));
#define PG8_LDA(dst, b, h) do { const LAS unsigned char* ap_ = lds + ((b) ? aA1 : aA0) + (h) * HTB; _Pragma("unroll") for (int m = 0; m < 4; ++m) { \
        if constexpr (FP8) { dst##8[m] = PG8_CAT(PG8_LD16(ap_ + m * 2048), PG8_LD16(ap_ + m * 2048 + 16)); } \
        else { _Pragma("unroll") for (int k = 0; k < 2; ++k) dst[m][k] = *(const LAS bf16x8*)(ap_ + m * 2048 + k * 1024); } } } while (0)
#define PG8_LDB(dst, b, h) do { const LAS unsigned char* bp_ = lds + ((b) ? bB1 : bB0) + (h) * HTB; _Pragma("unroll") for (int n = 0; n < 2; ++n) { \
        if constexpr (FP8) { dst##8[n] = PG8_CAT(PG8_LD16(bp_ + n * 2048), PG8_LD16(bp_ + n * 2048 + 16)); } \
        else { _Pragma("unroll") for (int k = 0; k < 2; ++k) dst[n][k] = *(const LAS bf16x8*)(bp_ + n * 2048 + k * 1024); } } } while (0)
#define PG8_MMA(ai, bj, At, Bt) do { __builtin_amdgcn_s_setprio(1); _Pragma("unroll") for (int m = 0; m < 4; ++m) _Pragma("unroll") for (int n = 0; n < 2; ++n) { \
        if constexpr (FP8) asm volatile("v_mfma_scale_f32_16x16x128_f8f6f4 %0, %1, %2, %0, %3, %3 op_sel_hi:[0,0,0]" : "+v"(acc[ai][bj][m][n]) : "v"(Bt##8[n]), "v"(At##8[m]), "v"(scl8));   \
        else { _Pragma("unroll") for (int k = 0; k < 2; ++k) acc[ai][bj][m][n] = __builtin_amdgcn_mfma_f32_16x16x32_bf16(Bt[n][k], At[m][k], acc[ai][bj][m][n], 0, 0, 0); } } \
        __builtin_amdgcn_s_setprio(0); } while (0)
#define PG8_WAIT_V(n) asm volatile("s_waitcnt vmcnt(" #n ")" ::: "memory")
#define PG8_WAIT_L(n) asm volatile("s_waitcnt lgkmcnt(" #n ")" ::: "memory")
#define PG8_BAR __builtin_amdgcn_s_barrier()
#define PG8_SCHED __builtin_amdgcn_sched_barrier(0)
    unsigned voffA0, c2, pkc[2], pkn[2], praw[4];
    { int R, C; stage_rc(tid * 16, R, C); voffA0 = (unsigned)(R * lda + C) * 2u; c2 = (unsigned)C * 2u; }
    const size_t hstepA = (size_t)HALF * lda * 2, pstepA = (size_t)64 * lda * 2;
    const unsigned lda2 = (unsigned)lda * 2u;
#define PG8_PKROWS(dst, u) do { if (GATHER) { _Pragma("unroll") for (int i_ = 0; i_ < 2; ++i_) { int R_, C_; stage_rc(tid * 16 + i_ * 8192, R_, C_); \
        const int nr_ = (u).nrows - 1; const int r0_ = R_ < nr_ ? R_ : nr_, r1_ = (R_ + HALF) < nr_ ? (R_ + HALF) : nr_; \
        dst[i_] = (unsigned)(u).rows[r0_] | ((unsigned)(u).rows[r1_] << 16); } } } while (0)
#define PG8_RAWROWS(u) do { if (GATHER) { _Pragma("unroll") for (int i_ = 0; i_ < 2; ++i_) { int R_, C_; stage_rc(tid * 16 + i_ * 8192, R_, C_); \
        const int nr_ = (u).nrows - 1; const int r0_ = R_ < nr_ ? R_ : nr_, r1_ = (R_ + HALF) < nr_ ? (R_ + HALF) : nr_; \
        praw[2 * i_] = gload32_hidden((u).rows, (unsigned)r0_ * 4u); praw[2 * i_ + 1] = gload32_hidden((u).rows, (unsigned)r1_ * 4u); } } } while (0)
#define PG8_PACKRAW(dst) do { unsigned a0_ = praw[0], a1_ = praw[1], a2_ = praw[2], a3_ = praw[3]; asm volatile("" : "+v"(a0_), "+v"(a1_), "+v"(a2_), "+v"(a3_)); \
        dst[0] = a0_ | (a1_ << 16); dst[1] = a2_ | (a3_ << 16); } while (0)
#define PG8_STGA(bufoff, gbase, h, NX) do { \
        if (GATHER) { const unsigned p0_ = (NX) ? pkn[0] : pkc[0], p1_ = (NX) ? pkn[1] : pkc[1]; \
            const unsigned o0_ = ((h) ? (p0_ >> 16) : (p0_ & 0xffffu)) * lda2 + c2, o1_ = ((h) ? (p1_ >> 16) : (p1_ & 0xffffu)) * lda2 + c2; \
            glds16s((const char*)(gbase), o0_, ldsb + (unsigned)(bufoff)); glds16s((const char*)(gbase), o1_, ldsb + (unsigned)(bufoff) + 8192u); } \
        else { const char* gb_ = (const char*)(gbase) + ((h) ? hstepA : (size_t)0); glds16s(gb_, voffA0, ldsb + (unsigned)(bufoff)); glds16s(gb_ + pstepA, voffA0, ldsb + (unsigned)(bufoff) + 8192u); } } while (0)
    Unit cur, nxt; int ui = 0;
    if (!S.next(0, cur)) return;
    f32x4 acc[2][2][4][2];
#pragma unroll
    for (int a = 0; a < 2; ++a)
#pragma unroll
        for (int b = 0; b < 2; ++b)
#pragma unroll
            for (int m = 0; m < 4; ++m)
#pragma unroll
                for (int n = 0; n < 2; ++n) acc[a][b][m][n] = (f32x4){0.f, 0.f, 0.f, 0.f};
    bf16x8 At[4][2], B0[2][2], B1[2][2]; v8i32_t At8[4], B08[2], B18[2];
    pkc[0] = pkc[1] = pkn[0] = pkn[1] = 0u; praw[0] = praw[1] = praw[2] = praw[3] = 0u;
    PG8_PKROWS(pkc, cur);
    const char* cA = cur.A; const char* cB = cur.B;
    PG8_STGB(PG8_SB(0, 0), cB); PG8_STGB(PG8_SB(0, 1), cB + hstepB); PG8_STGA(PG8_SA(0, 0), cA, 0, false); PG8_STGA(PG8_SA(0, 1), cA, 1, false);
    if (wr == 1) PG8_BAR;
    PG8_WAIT_V(2); PG8_BAR;
    PG8_STGB(PG8_SB(1, 0), cB + kstep); PG8_STGA(PG8_SA(1, 0), cA + kstep, 0, false); PG8_STGB(PG8_SB(1, 1), cB + hstepB + kstep);
    PG8_WAIT_V(6); PG8_BAR;
    for (;;) {
        const bool has_next = S.next(ui + 1, nxt);
        if (GATHER) { if (has_next) { PG8_RAWROWS(nxt); } }
        const char* nA = has_next ? nxt.A : cA; const char* nB = has_next ? nxt.B : cB;
        typename Epi::Pre pre; { int t_p = threadIdx.x; asm volatile("" : "+v"(t_p)); E.prefetch(cur, wr, wc, t_p & 15, (t_p >> 4) & 3, pre); }
        const int ntc = cur.ntu ? cur.ntu : nt;
        for (int t = 0; t < ntc; t += 2) {
            const bool last = (t == ntc - 2);
            if (GATHER) { pkn[0] = pkc[0]; pkn[1] = pkc[1]; if (last && has_next) { PG8_PACKRAW(pkn); } }
            const char* a1 = cA + (size_t)(t + 1) * kstep;
            const char* a2 = last ? nA : cA + (size_t)(t + 2) * kstep; const char* b2 = last ? nB : cB + (size_t)(t + 2) * kstep;
            const char* a3 = a2 + kstep; const char* b3 = b2 + kstep;
            PG8_LDB(B0, 0, 0); PG8_LDB(B1, 0, 1); PG8_SCHED; PG8_LDA(At, 0, 0); PG8_STGA(PG8_SA(1, 1), a1, 1, false);
            PG8_WAIT_V(8); PG8_WAIT_L(0); PG8_BAR; PG8_MMA(0, 0, At, B0); PG8_MMA(0, 1, At, B1); PG8_BAR; PG8_SCHED;
            PG8_LDA(At, 0, 1); PG8_STGB(PG8_SB(0, 0), b2); PG8_STGB(PG8_SB(0, 1), b2 + hstepB); PG8_STGA(PG8_SA(0, 0), a2, 0, last);
            PG8_WAIT_V(8); PG8_WAIT_L(0); PG8_BAR; PG8_MMA(1, 0, At, B0); PG8_MMA(1, 1, At, B1); PG8_BAR; PG8_SCHED;
            PG8_LDB(B0, 1, 0); PG8_LDB(B1, 1, 1); PG8_SCHED; PG8_LDA(At, 1, 0); PG8_STGA(PG8_SA(0, 1), a2, 1, last);
            PG8_WAIT_V(8); PG8_WAIT_L(0); PG8_BAR; PG8_MMA(0, 0, At, B0); PG8_MMA(0, 1, At, B1); PG8_BAR; PG8_SCHED;
            PG8_LDA(At, 1, 1); PG8_STGB(PG8_SB(1, 0), b3); PG8_STGB(PG8_SB(1, 1), b3 + hstepB); PG8_STGA(PG8_SA(1, 0), a3, 0, last);
            PG8_WAIT_V(8); PG8_WAIT_L(0); PG8_BAR; PG8_MMA(1, 0, At, B0); PG8_MMA(1, 1, At, B1); PG8_BAR; PG8_SCHED;
        }
        if constexpr (ALIGN_EPI) { if (wr == 0) PG8_BAR; }
        if constexpr (FP8) asm volatile("s_nop 15\n\ts_nop 15" ::: "memory");
        if constexpr (!Epi::AFTER_DRAIN) { int t_e = threadIdx.x; asm volatile("" : "+v"(t_e)); const int fr_e = t_e & 15, fq_e = (t_e >> 4) & 3; E(acc, cur, wr, wc, fr_e, fq_e, pre); }
        if (!has_next) break;
#pragma unroll
        for (int a = 0; a < 2; ++a)
#pragma unroll
            for (int b = 0; b < 2; ++b)
#pragma unroll
                for (int m = 0; m < 4; ++m)
#pragma unroll
                    for (int n = 0; n < 2; ++n) acc[a][b][m][n] = (f32x4){0.f, 0.f, 0.f, 0.f};
        cur = nxt; cA = nA; cB = nB; ++ui;
        if (GATHER) { PG8_PACKRAW(pkc); }
        if constexpr (ALIGN_EPI) { if (wr == 1) PG8_BAR; }
    }
    PG8_WAIT_V(0);
    if constexpr (!ALIGN_EPI) { if (wr == 0) PG8_BAR; }
    PG8_BAR;
    if constexpr (Epi::AFTER_DRAIN) { int t_e = threadIdx.x; asm volatile("" : "+v"(t_e)); const int fr_e = t_e & 15, fq_e = (t_e >> 4) & 3; E.fused(acc, cur, wr, wc, fr_e, fq_e, lds, wid, t_e & 63); }
#undef PG8_SA
#undef PG8_SB
#undef PG8_STGB
#undef PG8_LDA
#undef PG8_LDB
#undef PG8_MMA
#undef PG8_CAT
#undef PG8_LD16
#undef PG8_WAIT_V
#undef PG8_WAIT_L
#undef PG8_SCHED
#undef PG8_PKROWS
#undef PG8_RAWROWS
#undef PG8_PACKRAW
#undef PG8_STGA
}
}

namespace pg8 {
constexpr int NXCD = 8, WGM = 8;
__device__ __forceinline__ void tile_order(int L, int nM, int nN, int& pm, int& pn) {
    const int nwg = nM * nN; int wgid = L;
    { const int q = nwg / NXCD, r = nwg % NXCD, xcd = wgid % NXCD, off = wgid / NXCD; wgid = (xcd < r ? xcd * (q + 1) : r * (q + 1) + (xcd - r) * q) + off; }
    const int nig = WGM * nN, gid = wgid / nig, fm = gid * WGM, gsz = (nM - fm) < WGM ? (nM - fm) : WGM;
    pm = fm + ((wgid % nig) % gsz); pn = (wgid % nig) / gsz;
}
struct DenseOrder {
    const char* A; const char* B; int lda, ldb, nM, nN, G, c;
    __device__ __forceinline__ bool next(int i, Unit& u) const {
        const long L = (long)i * G + c; if (L >= (long)nM * nN) return false;
        int pm, pn; tile_order((int)L, nM, nN, pm, pn);
        u.pm = pm; u.pn = pn; u.aux = 0; u.rows = nullptr; u.nrows = 256; u.ntu = 0;
        u.A = A + (size_t)pm * 256 * lda * 2; u.B = B + (size_t)pn * 256 * ldb * 2; return true;
    }
};
struct KvOrder {
    const char* MN; const char* W; int L0;
    __device__ __forceinline__ bool next(int i, Unit& u) const {
        const int L = L0; if (i > 0 || L >= 64) return false;
        u.rows = nullptr; u.nrows = 256; u.ntu = 0; u.pm = L >> 3; const int ct = L & 7; u.aux = ct >> 2; u.pn = ct & 3;
        u.A = MN + (size_t)u.pm * 256 * D * 2; u.B = W + (size_t)ct * 256 * D * 2; return true;
    }
};
struct XmnOrder {
    const char* MK; const char* MV; const char* WQN; const char* WOT; int G, c;
    __device__ __forceinline__ bool next(int i, Unit& u) const {
        const int L = c + i * G; if (L >= 256) return false;
        u.rows = nullptr; u.nrows = 256; u.ntu = 0;
        if (L < 128) { const int b = L >> 4, h = (L >> 2) & 3, kt = L & 3; u.aux = 0; u.pm = b * 4 + h; u.pn = kt;
            u.A = MK + ((size_t)(b * 256) * D + h * 256) * 2; u.B = WQN + ((size_t)(kt * 256) * D + h * 256) * 2; }
        else { const int l = L - 128, b = l >> 4, nt = (l >> 2) & 3, h = l & 3; u.aux = 1; u.pm = b * 4 + nt; u.pn = h;
            u.A = WOT + ((size_t)(nt * 256) * D + h * 256) * 2; u.B = MV + ((size_t)(b * 256) * D + h * 256) * 2; }
        return true;
    }
};
struct P3Order {
    XmnOrder X; DenseOrder Dn;
    __device__ __forceinline__ bool next(int i, Unit& u) const {
        if (i == 0 && X.c < 256) { X.next(0, u); u.ntu = 4; return true; }
        const bool ok = Dn.next(X.c < 256 ? i - 1 : i, u); u.aux = 2; return ok;
    }
};
struct XbOrder {
    const char* A; const char* Bb; int G, c; size_t rb;
    __device__ __forceinline__ bool next(int i, Unit& u) const {
        const long L = (long)i * G + c; if (L >= 512) return false;
        int pm, pn; tile_order((int)L, T / 256, 4, pm, pn);
        u.pm = pm; u.pn = pn; u.aux = 0; u.rows = nullptr; u.nrows = 256; u.ntu = 0;
        u.A = A + (size_t)pm * 256 * rb; u.B = Bb + (size_t)(pm >> 4) * D * rb + (size_t)pn * 256 * rb; return true;
    }
};
struct MoeOrder {
    const char* A; const char* W; const int* list; const LAS int* cnt; const LAS unsigned char* te; const LAS int* ts;
    int ntiles, nN, G, c; size_t wstride; int gather; size_t atile, btile;
    __device__ __forceinline__ bool next(int i, Unit& u) const {
        const long L = (long)i * G + c; if (L >= (long)ntiles * nN) return false;
        int pm, pn; tile_order((int)L, ntiles, nN, pm, pn);
        const int e = __builtin_amdgcn_readfirstlane((int)te[pm]);
        const int lt = pm - __builtin_amdgcn_readfirstlane(ts[e]);
        const int n = __builtin_amdgcn_readfirstlane(cnt[e]) - lt * 256;
        u.pm = pm; u.pn = pn; u.aux = e; u.nrows = n < 256 ? n : 256; u.ntu = 0;
        u.rows = list + (size_t)e * T + lt * 256;
        u.A = gather ? A : A + (size_t)pm * atile;
        u.B = W + (size_t)e * wstride + (size_t)pn * btile; return true;
    }
};

struct EpiProj {
    static constexpr bool PERM = true, AFTER_DRAIN = false; struct Pre {}; __device__ __forceinline__ void prefetch(const Unit&, int, int, int, int, Pre&) const {}
    bf16_t* O; float* kbar;
    __device__ __forceinline__ void operator()(const f32x4 (&acc)[2][2][4][2], const Unit& u, int wr, int wc, int fr, int fq, const Pre&) const {
        const int pn = u.pn, sec = pn >> 1, b = u.pm >> 4, t0 = (u.pm & 15) * 256 + wr * 64 + fr;
        const int mode = (pn < 2) ? 1 : ((pn == 6 || pn == 7 || pn >= 12) ? 2 : 0);
        bf16_t* sb = O + (size_t)sec * SEC_ELEMS;
#pragma unroll
        for (int bj = 0; bj < 2; ++bj) {
            const int c = bj * HALF + wc * 32 + 8 * fq, head = (pn & 1) * 4 + (c >> 6), d0 = c & 63;
            bf16_t* hb = sb + (size_t)(b * 8 + head) * (SEQ * 64);
#pragma unroll
            for (int ai = 0; ai < 2; ++ai)
#pragma unroll
                for (int m = 0; m < 4; ++m) { const int t = t0 + ai * HALF + m * 16;
                    f32x4 v0 = acc[ai][bj][m][0], v1 = acc[ai][bj][m][1];
                    if (mode == 1) { v0 = v0 * C2Q; v1 = v1 * C2Q; }
                    else if (mode == 2) {
#pragma unroll
                        for (int e = 0; e < 4; ++e) { v0[e] = silu_f(v0[e]); v1[e] = silu_f(v1[e]); } }
                    u32x4 w; w.x = cvtpk(v0[0], v0[1]); w.y = cvtpk(v0[2], v0[3]); w.z = cvtpk(v1[0], v1[1]); w.w = cvtpk(v1[2], v1[3]);
                    size_t off;
                    if (sec == 1) off = (size_t)(t >> 6) * 4096 + (d0 >> 3) * 512 + (t & 63) * 8;
                    else if (sec == 2) off = (size_t)(t >> 6) * 4096 + (d0 >> 5) * 2048 + (t & 63) * 32 + (d0 & 31);
                    else off = (size_t)t * 64 + d0;
                    *(u32x4*)(hb + off) = w; } }
        if (pn == 2 || pn == 3) {
#pragma unroll
            for (int bj = 0; bj < 2; ++bj)
#pragma unroll
                for (int n = 0; n < 2; ++n)
#pragma unroll
                    for (int e = 0; e < 4; ++e) { float s = 0.f;
#pragma unroll
                        for (int ai = 0; ai < 2; ++ai)
#pragma unroll
                            for (int m = 0; m < 4; ++m) s += acc[ai][bj][m][n][e];
                        s += __shfl_xor(s, 1); s += __shfl_xor(s, 2); s += __shfl_xor(s, 4); s += __shfl_xor(s, 8);
                        if (fr == 0) { const int c = bj * HALF + wc * 32 + 8 * fq + 4 * n + e, head = (pn - 2) * 4 + (c >> 6), d = c & 63;
                            atomicAdd(kbar + ((size_t)u.pm * 8 + head) * 64 + d, s); } }
        }
    }
};
struct EpiBf16 {
    static constexpr bool PERM = true, AFTER_DRAIN = false; struct Pre {}; __device__ __forceinline__ void prefetch(const Unit&, int, int, int, int, Pre&) const {}
    bf16_t* O0; int ldc0; bf16_t* O1; int ldc1;
    __device__ __forceinline__ void operator()(const f32x4 (&acc)[2][2][4][2], const Unit& u, int wr, int wc, int fr, int fq, const Pre&) const {
        bf16_t* O = u.aux ? O1 : O0; const int ldc = u.aux ? ldc1 : ldc0;
        const int row0 = u.pm * BM + wr * 64 + fr, col0 = u.pn * BM + wc * 32 + 8 * fq;
#pragma unroll
        for (int ai = 0; ai < 2; ++ai)
#pragma unroll
            for (int m = 0; m < 4; ++m) { bf16_t* rowp = O + (size_t)(row0 + ai * HALF + m * 16) * ldc + col0;
#pragma unroll
                for (int bj = 0; bj < 2; ++bj) { const f32x4 v0 = acc[ai][bj][m][0], v1 = acc[ai][bj][m][1];
                    u32x4 w; w.x = cvtpk(v0[0], v0[1]); w.y = cvtpk(v0[2], v0[3]); w.z = cvtpk(v1[0], v1[1]); w.w = cvtpk(v1[2], v1[3]);
                    *(u32x4*)(rowp + bj * HALF) = w; } }
    }
};
struct EpiFp8 {
    static constexpr bool PERM = true, AFTER_DRAIN = false; struct Pre {}; __device__ __forceinline__ void prefetch(const Unit&, int, int, int, int, Pre&) const {}
    unsigned char* O0; int ldc0; unsigned char* O1; int ldc1; float scale;
    __device__ __forceinline__ void operator()(const f32x4 (&acc)[2][2][4][2], const Unit& u, int wr, int wc, int fr, int fq, const Pre&) const {
        unsigned char* O = u.aux ? O1 : O0; const int ldc = u.aux ? ldc1 : ldc0;
        const int row0 = u.pm * BM + wr * 64 + fr, col0 = u.pn * BM + wc * 32 + 8 * fq;
#pragma unroll
        for (int ai = 0; ai < 2; ++ai)
#pragma unroll
            for (int m = 0; m < 4; ++m) { unsigned char* rowp = O + (size_t)(row0 + ai * HALF + m * 16) * ldc + col0;
#pragma unroll
                for (int bj = 0; bj < 2; ++bj) { const f32x4 v0 = acc[ai][bj][m][0] * scale, v1 = acc[ai][bj][m][1] * scale;
                    *(u32x2*)(rowp + bj * HALF) = (u32x2){pk4_fp8(v0[0], v0[1], v0[2], v0[3]), pk4_fp8(v1[0], v1[1], v1[2], v1[3])}; } }
    }
};
template <bool BASE_F32, bool WRITE_F32, bool OUT_FP8 = false> struct EpiRes {
    static constexpr bool PERM = true, AFTER_DRAIN = false; struct Pre {}; __device__ __forceinline__ void prefetch(const Unit&, int, int, int, int, Pre&) const {}
    const void* base; bf16_t* Ob; float* Of; float* ss; float asc; unsigned char* Oq;
    __device__ __forceinline__ void operator()(const f32x4 (&acc)[2][2][4][2], const Unit& u, int wr, int wc, int fr, int fq, const Pre&) const {
        const int row0 = u.pm * BM + wr * 64 + fr, col0 = u.pn * BM + wc * 32 + 8 * fq;
#pragma unroll
        for (int ai = 0; ai < 2; ++ai)
#pragma unroll
            for (int m = 0; m < 4; ++m) { const int row = row0 + ai * HALF + m * 16; const size_t off = (size_t)row * D + col0; float sq = 0.f;
#pragma unroll
                for (int bj = 0; bj < 2; ++bj) { f32x4 b0, b1;
                    if (BASE_F32) { b0 = *(const f32x4*)((const float*)base + off + bj * HALF); b1 = *(const f32x4*)((const float*)base + off + bj * HALF + 4); }
                    else { const u32x4 w = *(const u32x4*)((const bf16_t*)base + off + bj * HALF);
                        b0 = (f32x4){bflo(w.x), bfhi(w.x), bflo(w.y), bfhi(w.y)}; b1 = (f32x4){bflo(w.z), bfhi(w.z), bflo(w.w), bfhi(w.w)}; }
                    const f32x4 v0 = acc[ai][bj][m][0] * asc + b0, v1 = acc[ai][bj][m][1] * asc + b1;
                    sq += (v0[0] * v0[0] + v0[1] * v0[1]) + (v0[2] * v0[2] + v0[3] * v0[3]) + (v1[0] * v1[0] + v1[1] * v1[1]) + (v1[2] * v1[2] + v1[3] * v1[3]);
                    if (OUT_FP8) { *(u32x2*)((unsigned char*)Ob + off + bj * HALF) = (u32x2){pk4_fp8(v0[0], v0[1], v0[2], v0[3]), pk4_fp8(v1[0], v1[1], v1[2], v1[3])}; }
                    else { u32x4 w; w.x = cvtpk(v0[0], v0[1]); w.y = cvtpk(v0[2], v0[3]); w.z = cvtpk(v1[0], v1[1]); w.w = cvtpk(v1[2], v1[3]);
                    *(u32x4*)(Ob + off + bj * HALF) = w; }
                    if (Oq) *(u32x2*)(Oq + off + bj * HALF) = (u32x2){pk4_fp8(v0[0], v0[1], v0[2], v0[3]), pk4_fp8(v1[0], v1[1], v1[2], v1[3])};
                    if (WRITE_F32) { *(f32x4*)(Of + off + bj * HALF) = v0; *(f32x4*)(Of + off + bj * HALF + 4) = v1; } }
                sq += __shfl_xor(sq, 16); sq += __shfl_xor(sq, 32);
                if (fq == 0) atomicAdd(ss + row, sq); }
    }
};
struct EpiP3 {
    static constexpr bool PERM = true, AFTER_DRAIN = false; struct Pre {}; __device__ __forceinline__ void prefetch(const Unit&, int, int, int, int, Pre&) const {}
    EpiFp8 a; EpiRes<true, false> b;
    __device__ __forceinline__ void operator()(const f32x4 (&acc)[2][2][4][2], const Unit& u, int wr, int wc, int fr, int fq, const Pre&) const {
        if (u.aux < 2) a(acc, u, wr, wc, fr, fq, EpiFp8::Pre{}); else b(acc, u, wr, wc, fr, fq, EpiRes<true, false>::Pre{});
    }
};
struct EpiQ {
    static constexpr bool PERM = true, AFTER_DRAIN = false; struct Pre {}; __device__ __forceinline__ void prefetch(const Unit&, int, int, int, int, Pre&) const {}
    bf16_t* O; const float* ss;
    __device__ __forceinline__ void operator()(const f32x4 (&acc)[2][2][4][2], const Unit& u, int wr, int wc, int fr, int fq, const Pre&) const {
        const int row0 = u.pm * BM + wr * 64 + fr, col0 = u.pn * BM + wc * 32 + 8 * fq;
#pragma unroll
        for (int ai = 0; ai < 2; ++ai)
#pragma unroll
            for (int m = 0; m < 4; ++m) { const int row = row0 + ai * HALF + m * 16; const float sc = C2X * __builtin_amdgcn_rsqf(ss[row] * (1.0f / D) + EPS);
                bf16_t* rowp = O + (size_t)row * D + col0;
#pragma unroll
                for (int bj = 0; bj < 2; ++bj) { const f32x4 v0 = acc[ai][bj][m][0] * sc, v1 = acc[ai][bj][m][1] * sc;
                    u32x4 w; w.x = cvtpk(v0[0], v0[1]); w.y = cvtpk(v0[2], v0[3]); w.z = cvtpk(v1[0], v1[1]); w.w = cvtpk(v1[2], v1[3]);
                    *(u32x4*)(rowp + bj * HALF) = w; } }
    }
};
struct EpiSoftmaxS {
    static constexpr bool PERM = true, AFTER_DRAIN = false; struct Pre {}; __device__ __forceinline__ void prefetch(const Unit&, int, int, int, int, Pre&) const {}
    unsigned char* P; const float* ss; LAS unsigned char* tb; float qs;
    __device__ __forceinline__ void operator()(f32x4 (&acc)[2][2][4][2], const Unit& u, int wr, int wc, int fr, int fq, const Pre&) const {
        LAS float* MX = (LAS float*)tb;
        LAS float* SM = (LAS float*)(tb + 4096);
#pragma unroll
        for (int ai = 0; ai < 2; ++ai)
#pragma unroll
            for (int m = 0; m < 4; ++m) { const int r = ai * HALF + wr * 64 + m * 16 + fr; const float sc = qs * C2X * __builtin_amdgcn_rsqf(ss[u.pm * BM + r] * (1.0f / D) + EPS); float mx = -3.0e38f;
#pragma unroll
                for (int bj = 0; bj < 2; ++bj)
#pragma unroll
                    for (int n = 0; n < 2; ++n) { f32x4 x = acc[ai][bj][m][n] * sc; acc[ai][bj][m][n] = x; mx = fmaxf(mx, fmaxf(fmaxf(x[0], x[1]), fmaxf(x[2], x[3]))); }
                mx = fmaxf(mx, __shfl_xor(mx, 16)); mx = fmaxf(mx, __shfl_xor(mx, 32));
                if (fq == 0) MX[r * 4 + wc] = mx; }
        LDS_WAIT(); __builtin_amdgcn_s_barrier(); asm volatile("" ::: "memory");
#pragma unroll
        for (int ai = 0; ai < 2; ++ai)
#pragma unroll
            for (int m = 0; m < 4; ++m) { const int r = ai * HALF + wr * 64 + m * 16 + fr; const f32x4 q = *(const LAS f32x4*)(MX + r * 4);
                const float mx = fmaxf(fmaxf(q[0], q[1]), fmaxf(q[2], q[3])); float sm = 0.f;
#pragma unroll
                for (int bj = 0; bj < 2; ++bj)
#pragma unroll
                    for (int n = 0; n < 2; ++n) { f32x4 x = acc[ai][bj][m][n];
#pragma unroll
                        for (int e = 0; e < 4; ++e) { x[e] = fast_exp2(x[e] - mx); sm += x[e]; }
                        acc[ai][bj][m][n] = x; }
                sm += __shfl_xor(sm, 16); sm += __shfl_xor(sm, 32);
                if (fq == 0) SM[r * 4 + wc] = sm; }
        LDS_WAIT(); __builtin_amdgcn_s_barrier(); asm volatile("" ::: "memory");
        const int col0 = u.pn * BM + wc * 32 + 8 * fq;
#pragma unroll
        for (int ai = 0; ai < 2; ++ai)
#pragma unroll
            for (int m = 0; m < 4; ++m) { const int r = ai * HALF + wr * 64 + m * 16 + fr; const f32x4 q = *(const LAS f32x4*)(SM + r * 4);
                const float inv = PSCALE8 * fast_rcp((q[0] + q[1]) + (q[2] + q[3]));
#pragma unroll
                for (int bj = 0; bj < 2; ++bj) { const f32x4 v0 = acc[ai][bj][m][0] * inv, v1 = acc[ai][bj][m][1] * inv;
                    *(u32x2*)(P + ((size_t)u.pm * BM + r) * D + bj * HALF + col0) = (u32x2){pk4_fp8(v0[0], v0[1], v0[2], v0[3]), pk4_fp8(v1[0], v1[1], v1[2], v1[3])}; } }
        LDS_WAIT(); __builtin_amdgcn_s_barrier(); asm volatile("" ::: "memory");
    }
};
struct EpiW1 {
    static constexpr bool PERM = true, AFTER_DRAIN = false;
    struct Pre { float sc[8]; f32x4 bq[4]; };
    bf16_t* O; const float* ssl; const float* b1; const int* list0;
    __device__ __forceinline__ void prefetch(const Unit& u, int wr, int wc, int fr, int fq, Pre& p) const {
        const float* sp = ssl + (u.rows - list0);
        { const float* bb = b1 + (size_t)u.aux * 2048 + 2 * (u.pn * 128); const unsigned bo = (unsigned)(2 * (wc * 32 + 8 * fq)) * 4u;
#pragma unroll
          for (int q = 0; q < 4; ++q) p.bq[q] = gload128_hidden(bb, bo + 16u * q); }
#pragma unroll
        for (int ai = 0; ai < 2; ++ai)
#pragma unroll
            for (int m = 0; m < 4; ++m) { const int r = ai * HALF + wr * 64 + m * 16 + fr; const int rr = r < u.nrows ? r : u.nrows - 1; p.sc[ai * 4 + m] = __uint_as_float(gload32_hidden(sp, (unsigned)rr * 4u)); }
    }
    __device__ __forceinline__ void operator()(const f32x4 (&acc)[2][2][4][2], const Unit& u, int wr, int wc, int fr, int fq, const Pre& pre) const {
        const int c0 = wc * 32 + 8 * fq;
        f32x4 bq0 = pre.bq[0], bq1 = pre.bq[1], bq2 = pre.bq[2], bq3 = pre.bq[3]; asm volatile("" : "+v"(bq0), "+v"(bq1), "+v"(bq2), "+v"(bq3));
        const float bg[8] = {bq0[0], bq0[2], bq1[0], bq1[2], bq2[0], bq2[2], bq3[0], bq3[2]};
        const float bl[8] = {bq0[1], bq0[3], bq1[1], bq1[3], bq2[1], bq2[3], bq3[1], bq3[3]};
#pragma unroll
        for (int ai = 0; ai < 2; ++ai)
#pragma unroll
            for (int m = 0; m < 4; ++m) { const int r = ai * HALF + wr * 64 + m * 16 + fr;
                float ssv = pre.sc[ai * 4 + m]; asm volatile("" : "+v"(ssv));
                const float sc = WSCALE8_INV * __builtin_amdgcn_rsqf(ssv * (1.0f / D) + EPS); float a[8];
#pragma unroll
                for (int j = 0; j < 8; ++j) { const float g = acc[ai][0][m][j >> 2][j & 3] * sc + bg[j], l = acc[ai][1][m][j >> 2][j & 3] * sc + bl[j];
                    const float glu = fminf(g, 7.0f), lin = fminf(fmaxf(l, -7.0f), 7.0f);
                    a[j] = glu * fast_rcp(1.0f + fast_exp2(-1.702f * LOG2E * glu)) * (lin + 1.0f); }
                *(u32x2*)((unsigned char*)O + ((size_t)u.pm * BM + r) * D + u.pn * 128 + c0) = (u32x2){pk4_fp8(a[0], a[1], a[2], a[3]), pk4_fp8(a[4], a[5], a[6], a[7])}; }
    }
};
constexpr float YSCALE = 16.0f, YSCALE_INV = 1.0f / 16.0f;
struct EpiW2 {
    static constexpr bool PERM = true, AFTER_DRAIN = false;
    struct Pre { float g[8]; f32x4 bv[4]; };
    unsigned char* O; const float* b2; const int* list0; const float* gl0;
    __device__ __forceinline__ void prefetch(const Unit& u, int wr, int wc, int fr, int fq, Pre& p) const {
        const float* gp = gl0 + (u.rows - list0);
        { const float* bb = b2 + (size_t)u.aux * D + u.pn * BM; const unsigned bo = (unsigned)(wc * 32 + 8 * fq) * 4u;
#pragma unroll
          for (int q = 0; q < 4; ++q) p.bv[q] = gload128_hidden(bb, bo + (unsigned)((q >> 1) * HALF * 4 + (q & 1) * 16)); }
#pragma unroll
        for (int ai = 0; ai < 2; ++ai)
#pragma unroll
            for (int m = 0; m < 4; ++m) { const int r = ai * HALF + wr * 64 + m * 16 + fr; const int rr = r < u.nrows ? r : u.nrows - 1; p.g[ai * 4 + m] = __uint_as_float(gload32_hidden(gp, (unsigned)rr * 4u)); }
    }
    __device__ __forceinline__ void operator()(const f32x4 (&acc)[2][2][4][2], const Unit& u, int wr, int wc, int fr, int fq, const Pre& pre) const {
        const int row0 = u.pm * BM + wr * 64 + fr, col0 = u.pn * BM + wc * 32 + 8 * fq;
        f32x4 bv[2][2]; bv[0][0] = pre.bv[0]; bv[0][1] = pre.bv[1]; bv[1][0] = pre.bv[2]; bv[1][1] = pre.bv[3]; asm volatile("" : "+v"(bv[0][0]), "+v"(bv[0][1]), "+v"(bv[1][0]), "+v"(bv[1][1]));
#pragma unroll
        for (int ai = 0; ai < 2; ++ai)
#pragma unroll
            for (int m = 0; m < 4; ++m) { unsigned char* rowp = O + (size_t)(row0 + ai * HALF + m * 16) * D + col0; float gv = pre.g[ai * 4 + m]; asm volatile("" : "+v"(gv)); const float g = YSCALE * gv;
#pragma unroll
                for (int bj = 0; bj < 2; ++bj) { const f32x4 v0 = (acc[ai][bj][m][0] * WSCALE8_INV + bv[bj][0]) * g, v1 = (acc[ai][bj][m][1] * WSCALE8_INV + bv[bj][1]) * g;
                    *(u32x2*)(rowp + bj * HALF) = (u32x2){pk4_fp8(v0[0], v0[1], v0[2], v0[3]), pk4_fp8(v1[0], v1[1], v1[2], v1[3])}; } }
    }
};
}

namespace moba {
using bf16x8 = ::bf16x8; using s16x4 = ::s16x4; using f32x16 = ::f32x16; using u32x4 = ::u32x4;
constexpr int DMQ = INC, DMO = D, HD = 64;
constexpr int NW = 8, QBLK = 32, QB = 256, KVBLK = 64;
__device__ __forceinline__ int crow(int r, int hi) { return (r & 3) + 8 * (r >> 2) + 4 * hi; }
#define SBAR() __builtin_amdgcn_sched_barrier(0)
__device__ __forceinline__ void cmask(f32x16& p0, f32x16& p1, int jb, int qrel, int hi) {
    const float NEG = -INFINITY; int kb = 64 * jb + 4 * hi;
#pragma unroll
    for (int r = 0; r < 16; ++r) { int kv = kb + (r & 3) + 8 * (r >> 2); if (kv > qrel) p0[r] = NEG; if (kv + 32 > qrel) p1[r] = NEG; }
}
constexpr int NSLOT = 3, SLOTB = 8192;
constexpr int LDS_K = 0, LDS_V = NSLOT * SLOTB, LDS_WS = 2 * NSLOT * SLOTB, LDS_OST = LDS_WS + NW * 64 * 4, LDS_KB = LDS_OST + NW * 4096, LDS_BYTES = LDS_KB + 16 * 64 * 4;
__device__ __forceinline__ void glds16(const void* gsrc, unsigned lds_dst) { unsigned keep;
    asm volatile("s_mov_b32 %0, m0\n\ts_mov_b32 m0, %2\n\ts_nop 0\n\tglobal_load_lds_dwordx4 %1, off\n\ts_mov_b32 m0, %0" : "=&s"(keep) : "v"(gsrc), "s"(lds_dst) : "memory"); }
__device__ __forceinline__ float max3f(float a, float b, float c) { float r; asm("v_max3_f32 %0, %1, %2, %3" : "=v"(r) : "v"(a), "v"(b), "v"(c)); return r; }
__device__ __forceinline__ float max2f(float a, float b) { float r; asm("v_max_f32_e32 %0, %1, %2" : "=v"(r) : "v"(a), "v"(b)); return r; }
__device__ __forceinline__ float fadd_s(float a, float b) { float r; asm("v_add_f32_e32 %0, %1, %2" : "=v"(r) : "v"(a), "v"(b)); return r; }
__device__ __forceinline__ float fsub_s(float a, float b) { float r; asm("v_sub_f32_e32 %0, %1, %2" : "=v"(r) : "v"(a), "v"(b)); return r; }
__device__ __forceinline__ unsigned cvtpk_s(float lo, float hi) { return ::cvtpk(lo, hi); }
#define WAIT_BAR(N) asm volatile("s_waitcnt vmcnt(" #N ") lgkmcnt(0)\n\ts_barrier" ::: "memory")
__device__ __forceinline__ void qkt(f32x16& p0, f32x16& p1, const char* Kslot, const bf16x8* qr, const f32x16& negm, int r32, int hi) {
    const char* kb = Kslot + hi * 1024 + r32 * 16;
#pragma unroll
    for (int d0 = 0; d0 < 4; ++d0) {
        const bf16x8 b0 = *reinterpret_cast<const bf16x8*>(kb + d0 * 2048);
        const bf16x8 b1 = *reinterpret_cast<const bf16x8*>(kb + d0 * 2048 + 512);
        if (d0 == 0) { p0 = __builtin_amdgcn_mfma_f32_32x32x16_bf16(b0, qr[0], negm, 0, 0, 0); p1 = __builtin_amdgcn_mfma_f32_32x32x16_bf16(b1, qr[0], negm, 0, 0, 0); }
        else { p0 = __builtin_amdgcn_mfma_f32_32x32x16_bf16(b0, qr[d0], p0, 0, 0, 0); p1 = __builtin_amdgcn_mfma_f32_32x32x16_bf16(b1, qr[d0], p1, 0, 0, 0); } }
}
typedef __attribute__((address_space(3))) const char* lds_cptr;
typedef short v4i16_t __attribute__((ext_vector_type(4)));
__device__ __forceinline__ void kload8(bf16x8* kf, lds_cptr kp) {
    kf[0] = *(const __attribute__((address_space(3))) bf16x8*)(kp);        kf[1] = *(const __attribute__((address_space(3))) bf16x8*)(kp + 512);
    kf[2] = *(const __attribute__((address_space(3))) bf16x8*)(kp + 2048); kf[3] = *(const __attribute__((address_space(3))) bf16x8*)(kp + 2560);
    kf[4] = *(const __attribute__((address_space(3))) bf16x8*)(kp + 4096); kf[5] = *(const __attribute__((address_space(3))) bf16x8*)(kp + 4608);
    kf[6] = *(const __attribute__((address_space(3))) bf16x8*)(kp + 6144); kf[7] = *(const __attribute__((address_space(3))) bf16x8*)(kp + 6656);
}
__device__ __forceinline__ void kload2(bf16x8* kf, lds_cptr kp, int j) { kf[2 * j] = *(const __attribute__((address_space(3))) bf16x8*)(kp + j * 2048); kf[2 * j + 1] = *(const __attribute__((address_space(3))) bf16x8*)(kp + j * 2048 + 512); }
__device__ __forceinline__ s16x4 vtr(lds_cptr p) { return __builtin_bit_cast(s16x4, __builtin_amdgcn_ds_read_tr16_b64_v4i16((__attribute__((address_space(3))) v4i16_t*)p)); }
__device__ __forceinline__ float rowmax(const f32x16& p0, const f32x16& p1) {
    float a = max3f(p0[0], p0[1], p1[0]), b = max3f(p0[2], p0[3], p1[1]); a = max3f(a, p1[2], p1[3]);
#pragma unroll
    for (int r = 4; r < 16; r += 4) { a = max3f(a, p0[r], p0[r + 1]); b = max3f(b, p0[r + 2], p0[r + 3]); a = max3f(a, p1[r], p1[r + 1]); b = max3f(b, p1[r + 2], p1[r + 3]); }
    const float m = max2f(a, b);
    auto rr = __builtin_amdgcn_permlane32_swap(__float_as_uint(m), __float_as_uint(m), false, false);
    return max2f(__uint_as_float(rr[0]), __uint_as_float(rr[1]));
}
__device__ __forceinline__ void pv(f32x16* o, int vb, bf16x8 pa0, bf16x8 pa1, bf16x8 pa2, bf16x8 pa3) {
#pragma unroll
    for (int d0 = 0; d0 < 2; ++d0) { s16x4 lo[4], hi[4];
#pragma unroll
        for (int ks = 0; ks < 4; ++ks) {
            asm volatile("ds_read_b64_tr_b16 %0,%1 offset:%c2" : "=&v"(lo[ks]) : "v"(vb), "i"(d0 * 4096 + ks * 1024) : "memory");
            asm volatile("ds_read_b64_tr_b16 %0,%1 offset:%c2" : "=&v"(hi[ks]) : "v"(vb), "i"(d0 * 4096 + ks * 1024 + 512) : "memory"); }
        asm volatile("s_waitcnt lgkmcnt(0)" ::: "memory"); SBAR();
#define PK(k) (bf16x8){lo[k][0], lo[k][1], lo[k][2], lo[k][3], hi[k][0], hi[k][1], hi[k][2], hi[k][3]}
        o[d0] = __builtin_amdgcn_mfma_f32_32x32x16_bf16(pa0, PK(0), o[d0], 0, 0, 0);
        o[d0] = __builtin_amdgcn_mfma_f32_32x32x16_bf16(pa1, PK(1), o[d0], 0, 0, 0);
        o[d0] = __builtin_amdgcn_mfma_f32_32x32x16_bf16(pa2, PK(2), o[d0], 0, 0, 0);
        o[d0] = __builtin_amdgcn_mfma_f32_32x32x16_bf16(pa3, PK(3), o[d0], 0, 0, 0);
#undef PK
    }
}
constexpr float NEGBIG = -1.0e30f;

template <int THRL> __device__ __forceinline__ void attn_unit(int b, int h, int qb, const bf16_t* Qg, const bf16_t* __restrict__ Kg, const bf16_t* __restrict__ Vg, bf16_t* Og, const float* __restrict__ kbar, char* shm) {
    int tid_ = threadIdx.x; asm volatile("" : "+v"(tid_));
    const int tid = tid_, lane = tid & 63, r32 = lane & 31, hi = lane >> 5; const int wid = __builtin_amdgcn_readfirstlane(tid >> 6);
    const long rowbase = (long)b * SEQ; const int q0 = qb * QB;
    const size_t hoff = (size_t)(b * 8 + h) * (SEQ * 64);
    const bf16_t* Qw = Qg + hoff + (size_t)(q0 + wid * QBLK) * 64;
    const bf16_t* Kh = Kg + hoff, *Vh = Vg + hoff;
    const unsigned lds0 = (unsigned)(uintptr_t)shm;
    float* wsf = (float*)(shm + LDS_WS) + wid * 64;
    const bf16_t* ksrc = Kh + wid * 512 + lane * 8;
    const bf16_t* vsrc = Vh + wid * 512 + lane * 8;
    const unsigned kdst = lds0 + LDS_K + wid * 1024, vdst = lds0 + LDS_V + wid * 1024;
    const int NT = 4 * qb + 4, NPAST = 4 * qb;
#define TMAP(t) (((t) < 4) ? (NPAST + (t)) : ((t) - 4))
#define DMA_K(t, slot) glds16(ksrc + (long)TMAP(t) * 4096, (unsigned)__builtin_amdgcn_readfirstlane(kdst + (slot)))
#define DMA_V(t, slot) glds16(vsrc + (long)TMAP(t) * 4096, (unsigned)__builtin_amdgcn_readfirstlane(vdst + (slot)))
    const char* Kbase = shm + LDS_K; bf16x8 kf[8];
    const lds_cptr shm3 = (lds_cptr)shm; const lds_cptr kp0 = shm3 + LDS_K + hi * 1024 + r32 * 16; const lds_cptr vp0 = shm3 + LDS_V + ((lane >> 4) & 1) * 32 + (lane & 3) * 8 + (4 * hi + ((lane & 15) >> 2)) * 64;
    DMA_K(0, 0); DMA_V(0, 0); DMA_K(1, SLOTB);
    bf16x8 qr[4];
#pragma unroll
    for (int d0 = 0; d0 < 4; ++d0) qr[d0] = *reinterpret_cast<const bf16x8*>(&Qw[(long)r32 * 64 + d0 * 16 + hi * 8]);
    unsigned selm = 0u;
    if (qb > 0) {
        float* kbl = (float*)(shm + LDS_KB);
        for (int i = tid; i < qb * 64; i += NW * 64) kbl[i] = kbar[((size_t)(b * 16 + (i >> 6)) * 8 + h) * 64 + (i & 63)];
        asm volatile("s_waitcnt vmcnt(0) lgkmcnt(0)\n\ts_barrier" ::: "memory");
        if (qb <= 3) selm = (1u << qb) - 1u;
        else {
            float qf[32];
#pragma unroll
            for (int d0 = 0; d0 < 4; ++d0)
#pragma unroll
                for (int j = 0; j < 8; ++j) qf[d0 * 8 + j] = bf2f((unsigned short)qr[d0][j]);
            float g[15];
#pragma unroll
            for (int n = 0; n < 15; ++n) { float s = 0.f;
                if (n < qb) {
#pragma unroll
                    for (int d0 = 0; d0 < 4; ++d0) { const f32x4 k0 = *(const f32x4*)(kbl + n * 64 + d0 * 16 + hi * 8), k1 = *(const f32x4*)(kbl + n * 64 + d0 * 16 + hi * 8 + 4);
                        s += qf[d0 * 8 + 0] * k0[0] + qf[d0 * 8 + 1] * k0[1] + qf[d0 * 8 + 2] * k0[2] + qf[d0 * 8 + 3] * k0[3] + qf[d0 * 8 + 4] * k1[0] + qf[d0 * 8 + 5] * k1[1] + qf[d0 * 8 + 6] * k1[2] + qf[d0 * 8 + 7] * k1[3]; }
                    s += __shfl_xor(s, 32);
                } else s = -INFINITY;
                g[n] = s; }
#pragma unroll
            for (int pass = 0; pass < 3; ++pass) { float best = -INFINITY; int bi = 0;
#pragma unroll
                for (int n = 0; n < 15; ++n) if (g[n] > best) { best = g[n]; bi = n; }
                selm |= 1u << bi;
#pragma unroll
                for (int n = 0; n < 15; ++n) if (n == bi) g[n] = -INFINITY; }
        }
    }
    float mhat = 0.f, l_reg = 0.f; f32x16 o[2]; o[0] = f32x16{}; o[1] = f32x16{}; f32x16 cini = f32x16{}; asm volatile("" : "+v"(cini));
    const int qrel = wid * QBLK + r32;
#define SETC(t, JB) do { const float cm_ = ((JB >= 0) || ((selm >> (((t) - 4) >> 2)) & 1u)) ? -mhat : NEGBIG; \
      _Pragma("unroll") for (int r = 0; r < 16; ++r) cini[r] = cm_; asm volatile("" : "+v"(cini)); } while (0)
    bool resc = false;
#define START(P0, P1) do { const float rm = rowmax(P0, P1); resc = false; \
    { const float dl = rm; mhat = fadd_s(mhat, dl); \
      _Pragma("unroll") for (int r = 0; r < 16; ++r) { P0[r] = fsub_s(P0[r], dl); P1[r] = fsub_s(P1[r], dl); } } \
    _Pragma("unroll") for (int r = 0; r < 16; ++r) P0[r] = __builtin_amdgcn_exp2f(P0[r]); } while (0)
#define RESC() do { if (resc) { asm volatile("s_waitcnt lgkmcnt(0)" ::: "memory"); \
      _Pragma("unroll") for (int d_ = 0; d_ < 2; ++d_) _Pragma("unroll") for (int r = 0; r < 16; ++r) o[d_][r] *= wsf[crow(r, hi)]; } } while (0)
    f32x16 pA0, pA1, pB0, pB1;
    int sl_prev = 0, sl_cur = 0, sl_next = SLOTB;
#define ROT() do { sl_prev = sl_cur; sl_cur = sl_next; sl_next = (sl_next == (NSLOT - 1) * SLOTB) ? 0 : sl_next + SLOTB; } while (0)
    DMA_K(2, 2 * SLOTB);
    if (qb > 0) { WAIT_BAR(0); } else { WAIT_BAR(3); }
    qkt(pA0, pA1, Kbase, qr, cini, r32, hi); asm volatile("s_nop 15\n\ts_nop 7" : "+v"(pA0), "+v"(pA1)); cmask(pA0, pA1, 0, qrel, hi);
    START(pA0, pA1);
    _Pragma("unroll") for (int r = 0; r < 16; ++r) pA1[r] = __builtin_amdgcn_exp2f(pA1[r]);
    WAIT_BAR(0);
    DMA_K(3, 0); DMA_V(1, SLOTB);
    ROT();
    kload8(kf, kp0 + sl_cur);
    WAIT_BAR(2);
    s16x4 vlo[8], vhi[8]; u32x4 pw0, pw1, pw2, pw3;
#define PKW(P, B) cvtpk_s(P[B], P[B + 1])
#define PAF(k) __builtin_bit_cast(bf16x8, pw##k)
#define VFR(i) (bf16x8){vlo[i][0], vlo[i][1], vlo[i][2], vlo[i][3], vhi[i][0], vhi[i][1], vhi[i][2], vhi[i][3]}
#define PIN(x) asm volatile("" : "+v"(x))
#define MX3(a, b, c) __builtin_fmaxf(__builtin_fmaxf((a), (b)), (c))
#define GAPA(MF, A0, A1, A2, A3, W0, W1, PW) do { MF; sacc += A0; sacc += A1; sacc += A2; sacc += A3; PIN(sacc); W0; W1; PIN(PW); SBAR(); } while (0)
#define EX(v) __builtin_amdgcn_exp2f(v)
#define GAPB(MF, X, B) do { MF; X[B] = EX(X[B]); X[B + 1] = EX(X[B + 1]); X[B + 2] = EX(X[B + 2]); X[B + 3] = EX(X[B + 3]); PIN(X); SBAR(); } while (0)
#define VRD(i) do { vlo[i] = vtr(vp_ + (((i) >> 2) * 4096 + ((i) & 3) * 1024)); vhi[i] = vtr(vp_ + (((i) >> 2) * 4096 + ((i) & 3) * 1024 + 512)); } while (0)
#define KRD(G, j) do { if (G) { kload2(kf, kp0 + sl_next, j); SBAR(); } } while (0)
#define STEP(C0, C1, P0, P1, t, GK, GV, GL, JB) do { SETC(t, JB); SBAR(); \
    const lds_cptr vp_ = vp0 + sl_prev; \
    VRD(0); SBAR(); float sacc = (P0[0] + P0[1]); \
    GAPA(C0 = __builtin_amdgcn_mfma_f32_32x32x16_bf16(kf[0], qr[0], cini, 0, 0, 0), P0[2], P0[3], P0[4], P0[5],     pw0[0] = PKW(P0, 0), pw0[1] = PKW(P0, 2), pw0); \
    VRD(4); SBAR(); GAPA(C1 = __builtin_amdgcn_mfma_f32_32x32x16_bf16(kf[1], qr[0], cini, 0, 0, 0), P0[6], P0[7], P0[8], P0[9],     pw0[2] = PKW(P0, 4), pw0[3] = PKW(P0, 6), pw0); \
    VRD(1); SBAR(); GAPA(C0 = __builtin_amdgcn_mfma_f32_32x32x16_bf16(kf[2], qr[1], C0, 0, 0, 0),   P0[10], P0[11], P0[12], P0[13], pw1[0] = PKW(P0, 8), pw1[1] = PKW(P0, 10), pw1); \
    VRD(5); SBAR(); GAPA(C1 = __builtin_amdgcn_mfma_f32_32x32x16_bf16(kf[3], qr[1], C1, 0, 0, 0),   P0[14], P0[15], P1[0], P1[1],   pw1[2] = PKW(P0, 12), pw1[3] = PKW(P0, 14), pw1); \
    VRD(2); SBAR(); GAPA(C0 = __builtin_amdgcn_mfma_f32_32x32x16_bf16(kf[4], qr[2], C0, 0, 0, 0),   P1[2], P1[3], P1[4], P1[5],     pw2[0] = PKW(P1, 0), pw2[1] = PKW(P1, 2), pw2); \
    VRD(6); SBAR(); GAPA(C1 = __builtin_amdgcn_mfma_f32_32x32x16_bf16(kf[5], qr[2], C1, 0, 0, 0),   P1[6], P1[7], P1[8], P1[9],     pw2[2] = PKW(P1, 4), pw2[3] = PKW(P1, 6), pw2); \
    VRD(3); SBAR(); GAPA(C0 = __builtin_amdgcn_mfma_f32_32x32x16_bf16(kf[6], qr[3], C0, 0, 0, 0),   P1[10], P1[11], P1[12], P1[13], pw3[0] = PKW(P1, 8), pw3[1] = PKW(P1, 10), pw3); \
    VRD(7); SBAR(); GAPA(C1 = __builtin_amdgcn_mfma_f32_32x32x16_bf16(kf[7], qr[3], C1, 0, 0, 0),   P1[14], P1[15], 0.f, 0.f,       pw3[2] = PKW(P1, 12), pw3[3] = PKW(P1, 14), pw3); \
    l_reg += sacc; \
    if (GK) { DMA_K((t) + 3, sl_cur); } if (GV) { DMA_V((t) + 1, sl_next); } \
    if (JB >= 0) cmask(C0, C1, JB, qrel, hi); \
    { float a = MX3(C0[0], C0[1], C1[0]), b_ = MX3(C0[2], C0[3], C1[1]); a = MX3(a, C1[2], C1[3]); \
      _Pragma("unroll") for (int r = 4; r < 16; r += 4) { a = MX3(a, C0[r], C0[r + 1]); b_ = MX3(b_, C0[r + 2], C0[r + 3]); a = MX3(a, C1[r], C1[r + 1]); b_ = MX3(b_, C1[r + 2], C1[r + 3]); } \
      float rm = __builtin_fmaxf(a, b_); { auto rr = __builtin_amdgcn_permlane32_swap(__float_as_uint(rm), __float_as_uint(rm), false, false); rm = __builtin_fmaxf(__uint_as_float(rr[0]), __uint_as_float(rr[1])); } \
      resc = false; \
      if (__builtin_expect(__any(rm > (float)THRL), 0)) { const float dl = __builtin_fmaxf(rm, 0.f); mhat += dl; \
        _Pragma("unroll") for (int r = 0; r < 16; ++r) { C0[r] -= dl; C1[r] -= dl; } \
        const float f = __builtin_amdgcn_exp2f(-dl); l_reg *= f; if (hi == 0) wsf[r32] = f; resc = true; } } \
    SBAR(); \
    GAPB(o[0] = __builtin_amdgcn_mfma_f32_32x32x16_bf16(PAF(0), VFR(0), o[0], 0, 0, 0), C0, 0); \
    GAPB(o[1] = __builtin_amdgcn_mfma_f32_32x32x16_bf16(PAF(0), VFR(4), o[1], 0, 0, 0), C0, 4); \
    KRD(GL, 0); GAPB(o[0] = __builtin_amdgcn_mfma_f32_32x32x16_bf16(PAF(1), VFR(1), o[0], 0, 0, 0), C0, 8); \
    KRD(GL, 1); GAPB(o[1] = __builtin_amdgcn_mfma_f32_32x32x16_bf16(PAF(1), VFR(5), o[1], 0, 0, 0), C0, 12); \
    KRD(GL, 2); GAPB(o[0] = __builtin_amdgcn_mfma_f32_32x32x16_bf16(PAF(2), VFR(2), o[0], 0, 0, 0), C1, 0); \
    KRD(GL, 3); GAPB(o[1] = __builtin_amdgcn_mfma_f32_32x32x16_bf16(PAF(2), VFR(6), o[1], 0, 0, 0), C1, 4); \
    GAPB(o[0] = __builtin_amdgcn_mfma_f32_32x32x16_bf16(PAF(3), VFR(3), o[0], 0, 0, 0), C1, 8); \
    GAPB(o[1] = __builtin_amdgcn_mfma_f32_32x32x16_bf16(PAF(3), VFR(7), o[1], 0, 0, 0), C1, 12); \
    } while (0)
#define ENDW(tt) do { if ((tt) + 3 < NT) { WAIT_BAR(2); } else if ((tt) + 2 < NT) { WAIT_BAR(1); } else { WAIT_BAR(0); } } while (0)
    STEP(pB0, pB1, pA0, pA1, 1, (4 < NT), true, true, 1);   ENDW(1); RESC(); ROT();
    STEP(pA0, pA1, pB0, pB1, 2, (5 < NT), true, true, 2);   ENDW(2); RESC(); ROT();
    STEP(pB0, pB1, pA0, pA1, 3, (6 < NT), (4 < NT), (4 < NT), 3);   ENDW(3); RESC(); ROT();
    for (int t = 4; t < NT; t += 2) {
        STEP(pA0, pA1, pB0, pB1, t, (t + 3 < NT), true, true, -1);                       ENDW(t);     RESC(); ROT();
        STEP(pB0, pB1, pA0, pA1, t + 1, (t + 4 < NT), (t + 2 < NT), (t + 2 < NT), -1);   ENDW(t + 1); RESC(); ROT();
    }
    { float sacc = pB0[0] + pB0[1]; _Pragma("unroll") for (int r = 2; r < 16; ++r) sacc += pB0[r]; _Pragma("unroll") for (int r = 0; r < 16; ++r) sacc += pB1[r]; l_reg += sacc;
      pw0 = (u32x4){PKW(pB0, 0), PKW(pB0, 2), PKW(pB0, 4), PKW(pB0, 6)}; pw1 = (u32x4){PKW(pB0, 8), PKW(pB0, 10), PKW(pB0, 12), PKW(pB0, 14)}; pw2 = (u32x4){PKW(pB1, 0), PKW(pB1, 2), PKW(pB1, 4), PKW(pB1, 6)}; pw3 = (u32x4){PKW(pB1, 8), PKW(pB1, 10), PKW(pB1, 12), PKW(pB1, 14)};
      SBAR(); pv(o, (int)(unsigned long)vp0 + sl_prev, PAF(0), PAF(1), PAF(2), PAF(3)); }
#undef PKW
#undef PAF
#undef VFR
#undef PIN
#undef MX3
#undef GAPA
#undef GAPB
#undef EX
#undef VRD
#undef KRD
#undef STEP
#undef ENDW
    { auto rr = __builtin_amdgcn_permlane32_swap(__float_as_uint(l_reg), __float_as_uint(l_reg), false, false); l_reg = __uint_as_float(rr[0]) + __uint_as_float(rr[1]); }
    if (hi == 0) wsf[32 + r32] = l_reg; asm volatile("s_waitcnt lgkmcnt(0)" ::: "memory");
    float rli[16];
#pragma unroll
    for (int r = 0; r < 16; ++r) rli[r] = __builtin_amdgcn_rcpf(wsf[32 + crow(r, hi)]);
    bf16_t* Ow = Og + (rowbase + q0 + wid * QBLK) * DMO + h * HD;
    { bf16_t* stg = (bf16_t*)(shm + LDS_OST) + wid * 2048;
#pragma unroll
      for (int r = 0; r < 16; ++r) { const int orow = crow(r, hi);
#pragma unroll
        for (int d0 = 0; d0 < 2; ++d0) stg[orow * 64 + d0 * 32 + r32] = (bf16_t)f2bf(o[d0][r] * rli[r]); }
      asm volatile("s_waitcnt lgkmcnt(0)" ::: "memory");
#pragma unroll
      for (int i = 0; i < 4; ++i) { const int row = i * 8 + (lane >> 3), ch = lane & 7; const u32x4 v = *(const u32x4*)(stg + row * 64 + ch * 8); *(u32x4*)(Ow + (long)row * DMO + ch * 8) = v; } }
    asm volatile("s_waitcnt lgkmcnt(0)\n\ts_barrier" ::: "memory");
#undef DMA_K
#undef DMA_V
#undef TMAP
#undef SETC
#undef START
#undef RESC
#undef ROT
}
#undef SBAR
#undef WAIT_BAR
}

namespace hgrn {
constexpr int RS = 144;
constexpr int R_FQV = 0, FQV_SLOT = 32768;
constexpr int L_Q = 98304, L_K = L_Q + 9216, L_KT = L_K + 9216, L_VT = L_KT + 9216, L_ST = L_VT + 9216, L_SEG = L_ST + 9216, L_DEND = L_SEG + 2048, L_SSQ = L_DEND + 256, L_BYTES = L_SSQ + 512;
__device__ __forceinline__ int crow(int r, int hi) { return (r & 3) + 8 * (r >> 2) + 4 * hi; }
__device__ __forceinline__ void glds16(const void* gsrc, unsigned lds_dst) { unsigned keep;
    asm volatile("s_mov_b32 %0, m0\n\ts_mov_b32 m0, %2\n\ts_nop 0\n\tglobal_load_lds_dwordx4 %1, off\n\ts_mov_b32 m0, %0" : "=&s"(keep) : "v"(gsrc), "s"(lds_dst) : "memory"); }
#define HG_BAR() do { asm volatile("s_waitcnt lgkmcnt(0)" ::: "memory"); __builtin_amdgcn_s_barrier(); asm volatile("" ::: "memory"); } while (0)
__device__ __forceinline__ void hgrn_unit(int b, int h, const bf16_t* __restrict__ proj, bf16_t* __restrict__ mix, const float* __restrict__ lb_logits, const float* __restrict__ norm_g, LAS unsigned char* lds) {
    int tid_ = threadIdx.x; asm volatile("" : "+v"(tid_));
    const int tid = tid_, lane = tid & 63, r32 = lane & 31, hi = lane >> 5; const int w = __builtin_amdgcn_readfirstlane(tid >> 6);
    const float lbk = fast_rcp(1.0f + fast_exp2((lb_logits[512 + h * 64 + lane] - lb_logits[h * 64 + lane]) * LOG2E));
    const int vr = (w >> 1) & 1, tc = w & 1;
    float ng[16];
#pragma unroll
    for (int r = 0; r < 16; ++r) ng[r] = norm_g[h * 64 + 32 * vr + crow(r, hi)];
    f32x16 S = f32x16{};
    for (int i = tid; i < 64 * RS / 4; i += 512) ((LAS unsigned*)(lds + L_ST))[i] = 0u;
    const size_t hoff = (size_t)(b * 8 + h) * (SEQ * 64) + (size_t)w * 512 + lane * 8;
    const bf16_t* gQ = proj + 3 * SEC_ELEMS + hoff; const bf16_t* gF = proj + 4 * SEC_ELEMS + hoff; const bf16_t* gV = proj + 5 * SEC_ELEMS + hoff; const bf16_t* gG = proj + 6 * SEC_ELEMS + hoff;
    const unsigned lds0 = (unsigned)(uintptr_t)(unsigned char*)lds;
#define DMA_FQV(c_) do { const int cc_ = (c_) < 63 ? (c_) : 63; const unsigned d_ = (unsigned)__builtin_amdgcn_readfirstlane(lds0 + R_FQV + (unsigned)(((c_) % 3) * FQV_SLOT) + (unsigned)w * 1024u); \
        glds16(gF + (size_t)cc_ * 4096, d_); glds16(gQ + (size_t)cc_ * 4096, d_ + 8192u); glds16(gV + (size_t)cc_ * 4096, d_ + 16384u); } while (0)
#define DMA_G(c_) do { const int cc_ = (c_) < 63 ? (c_) : 63; glds16(gG + (size_t)cc_ * 4096, (unsigned)__builtin_amdgcn_readfirstlane(lds0 + R_FQV + (unsigned)(((c_) % 3) * FQV_SLOT) + 24576u + (unsigned)w * 1024u)); } while (0)
    DMA_FQV(0); DMA_G(0); DMA_FQV(1); DMA_G(1);
    for (int c = 0; c < 64; ++c) {
        const size_t row0 = (size_t)b * SEQ + (size_t)c * 64;
        DMA_FQV(c + 2);
        asm volatile("s_waitcnt vmcnt(8)" ::: "memory");
        const LAS unsigned char* raw = lds + R_FQV + (c % 3) * FQV_SLOT + (8 * w) * 128 + lane * 2;
        float p[8], kk[8];
        { float run = 0.f;
#pragma unroll
          for (int i = 0; i < 8; ++i) { const float x = bf2f(*(const LAS unsigned short*)(raw + i * 128)); const float sg = fast_rcp(1.0f + fast_exp2(-x * LOG2E)); const float f = lbk + (1.0f - lbk) * sg;
              run += __builtin_amdgcn_logf(f); p[i] = run; kk[i] = 1.0f - f; } }
        ((LAS float*)(lds + L_SEG))[w * 64 + lane] = p[7];
        HG_BAR();
        DMA_G(c + 2);
        { float off = 0.f;
#pragma unroll
          for (int j = 0; j < 7; ++j) { const float sv = ((LAS float*)(lds + L_SEG))[j * 64 + lane]; off += (j < w) ? sv : 0.f; }
          unsigned kq[4], vq[4];
#pragma unroll
          for (int i = 0; i < 8; i += 2) { const float b0 = off + p[i], b1 = off + p[i + 1];
              const unsigned short q0r = *(const LAS unsigned short*)(raw + 8192 + i * 128), q1r = *(const LAS unsigned short*)(raw + 8192 + (i + 1) * 128);
              const unsigned short v0r = *(const LAS unsigned short*)(raw + 16384 + i * 128), v1r = *(const LAS unsigned short*)(raw + 16384 + (i + 1) * 128);
              const float q0 = bf2f(q0r) * fast_exp2(b0), q1 = bf2f(q1r) * fast_exp2(b1), k0 = kk[i] * fast_exp2(-b0), k1 = kk[i + 1] * fast_exp2(-b1);
              const unsigned qq = cvtpk(q0, q1), kw = cvtpk(k0, k1); kq[i >> 1] = kw; vq[i >> 1] = (unsigned)v0r | ((unsigned)v1r << 16);
              *(LAS unsigned short*)(lds + L_Q + (8 * w + i) * RS + lane * 2) = (unsigned short)(qq & 0xffffu);
              *(LAS unsigned short*)(lds + L_Q + (8 * w + i + 1) * RS + lane * 2) = (unsigned short)(qq >> 16);
              *(LAS unsigned short*)(lds + L_K + (8 * w + i) * RS + lane * 2) = (unsigned short)(kw & 0xffffu);
              *(LAS unsigned short*)(lds + L_K + (8 * w + i + 1) * RS + lane * 2) = (unsigned short)(kw >> 16); }
          *(LAS u32x4*)(lds + L_KT + lane * RS + 16 * w) = (u32x4){kq[0], kq[1], kq[2], kq[3]};
          *(LAS u32x4*)(lds + L_VT + lane * RS + 16 * w) = (u32x4){vq[0], vq[1], vq[2], vq[3]};
          if (w == 7) ((LAS float*)(lds + L_DEND))[lane] = fast_exp2(off + p[7]); }
        asm volatile("s_waitcnt vmcnt(8)" ::: "memory");
        HG_BAR();
        f32x16 OT = f32x16{};
        if (w < 4) {
            bf16x8 bq[4];
#pragma unroll
            for (int ks = 0; ks < 4; ++ks) bq[ks] = *(const LAS bf16x8*)(lds + L_Q + (32 * tc + r32) * RS + (16 * ks + 8 * hi) * 2);
#pragma unroll
            for (int sr = 0; sr < 2; ++sr) if (sr <= tc) {
                f32x16 at = f32x16{};
#pragma unroll
                for (int ks = 0; ks < 4; ++ks) { const bf16x8 a = *(const LAS bf16x8*)(lds + L_K + (32 * sr + r32) * RS + (16 * ks + 8 * hi) * 2); at = __builtin_amdgcn_mfma_f32_32x32x16_bf16(a, bq[ks], at, 0, 0, 0); }
                if (sr == tc) {
#pragma unroll
                    for (int r = 0; r < 16; ++r) at[r] = (crow(r, hi) <= r32) ? at[r] : 0.f; }
#pragma unroll
                for (int st = 0; st < 2; ++st) {
                    u32x4 bw; bw.x = cvtpk(at[8 * st + 0], at[8 * st + 1]); bw.y = cvtpk(at[8 * st + 2], at[8 * st + 3]); bw.z = cvtpk(at[8 * st + 4], at[8 * st + 5]); bw.w = cvtpk(at[8 * st + 6], at[8 * st + 7]);
                    const u32x2 lo = *(const LAS u32x2*)(lds + L_VT + (32 * vr + r32) * RS + (32 * sr + 16 * st + 4 * hi) * 2);
                    const u32x2 hh = *(const LAS u32x2*)(lds + L_VT + (32 * vr + r32) * RS + (32 * sr + 16 * st + 8 + 4 * hi) * 2);
                    const u32x4 aw = (u32x4){lo.x, lo.y, hh.x, hh.y};
                    OT = __builtin_amdgcn_mfma_f32_32x32x16_bf16(__builtin_bit_cast(bf16x8, aw), __builtin_bit_cast(bf16x8, bw), OT, 0, 0, 0); }
            }
#pragma unroll
            for (int ks = 0; ks < 4; ++ks) { const bf16x8 a = *(const LAS bf16x8*)(lds + L_ST + (32 * vr + r32) * RS + (16 * ks + 8 * hi) * 2); OT = __builtin_amdgcn_mfma_f32_32x32x16_bf16(a, bq[ks], OT, 0, 0, 0); }
            float sq = 0.f;
#pragma unroll
            for (int r = 0; r < 16; ++r) sq += OT[r] * OT[r];
            sq += __shfl_xor(sq, 32);
            if (hi == 0) ((LAS float*)(lds + L_SSQ))[vr * 64 + 32 * tc + r32] = sq;
        } else {
#pragma unroll
            for (int st = 0; st < 4; ++st) { const bf16x8 a = *(const LAS bf16x8*)(lds + L_KT + (32 * vr + r32) * RS + (16 * st + 8 * hi) * 2);
                const bf16x8 bv = *(const LAS bf16x8*)(lds + L_VT + (32 * tc + r32) * RS + (16 * st + 8 * hi) * 2);
                S = __builtin_amdgcn_mfma_f32_32x32x16_bf16(a, bv, S, 0, 0, 0); }
#pragma unroll
            for (int r = 0; r < 16; ++r) S[r] *= ((LAS float*)(lds + L_DEND))[32 * vr + crow(r, hi)];
        }
        HG_BAR();
        if (w < 4) {
            const int t = 32 * tc + r32;
            const float tot = ((LAS float*)(lds + L_SSQ))[t] + ((LAS float*)(lds + L_SSQ))[64 + t];
            const float rstd = __builtin_amdgcn_rsqf(tot * (1.0f / 64.0f) + EPS);
            const LAS unsigned char* gp = lds + R_FQV + (c % 3) * FQV_SLOT + 24576 + t * 128 + (32 * vr + 4 * hi) * 2;
            bf16_t* op = mix + (row0 + t) * D + 512 + h * 64 + 32 * vr + 4 * hi;
#pragma unroll
            for (int g = 0; g < 4; ++g) { const u32x2 gg = *(const LAS u32x2*)(gp + 16 * g);
                const float y0 = OT[4 * g + 0] * rstd * ng[4 * g + 0] * bflo(gg.x), y1 = OT[4 * g + 1] * rstd * ng[4 * g + 1] * bfhi(gg.x),
                            y2 = OT[4 * g + 2] * rstd * ng[4 * g + 2] * bflo(gg.y), y3 = OT[4 * g + 3] * rstd * ng[4 * g + 3] * bfhi(gg.y);
                *(u32x2*)(op + 8 * g) = (u32x2){cvtpk(y0, y1), cvtpk(y2, y3)}; }
        } else {
#pragma unroll
            for (int g = 0; g < 4; ++g) *(LAS u32x2*)(lds + L_ST + (32 * tc + r32) * RS + (32 * vr + 8 * g + 4 * hi) * 2) = (u32x2){cvtpk(S[4 * g + 0], S[4 * g + 1]), cvtpk(S[4 * g + 2], S[4 * g + 3])};
        }
    }
    asm volatile("s_waitcnt vmcnt(0)" ::: "memory");
    HG_BAR();
#undef DMA_FQV
#undef DMA_G
}
#undef HG_BAR
}

constexpr int NWAVES = 8;
constexpr int LDS_BYTES = 163840;
constexpr int TAIL = 161792;
constexpr int TL_TE = TAIL, TL_TS = TAIL + 576, TL_HIST = TAIL + 768, TL_BASE = TAIL + 896, TL_MISC = TAIL + 1024, TL_CNT = TAIL + 1280;
typedef GAS unsigned gu32;

struct Args { const float* in[20]; float* out; unsigned char* ws; int ph_lo, ph_hi; };

struct Frame {
    LAS unsigned char* lds; volatile LAS unsigned* MISC; unsigned* ctl;
    int tid, lane, wave, G, vcu;
};

struct P0Item { const float* W; bf16_t* WT; const float* gain; int N, K, k0, n0, mode; };
__device__ __forceinline__ bool p0_decode(const Args& a, int it, P0Item& I) {
    unsigned char* ws = a.ws;
    constexpr int I_IN = 16 * 56, I_SQ = 16 * 16, I_KV = 16 * 32, I_W1 = 16 * 32, I_W2 = 16 * 16;
    constexpr int NITEMS = I_IN + 2 * I_SQ + I_KV + NEXP * (I_W1 + I_W2);
    if (it >= NITEMS) return false;
    int r = it; I.gain = nullptr; I.mode = 0; I.K = D;
    if (r < I_IN) { I.W = a.in[3]; I.WT = (bf16_t*)(ws + WS_WIN); I.N = INC; }
    else if ((r -= I_IN) < I_SQ) { I.W = a.in[6]; I.WT = (bf16_t*)(ws + WS_WOUT); I.N = D; }
    else if ((r -= I_SQ) < I_KV) { I.W = a.in[10]; I.WT = (bf16_t*)(ws + WS_WKV); I.N = 2 * D; }
    else if ((r -= I_KV) < I_SQ) { I.W = a.in[11]; I.WT = (bf16_t*)(ws + WS_WO); I.N = D; }
    else if ((r -= I_SQ) < NEXP * I_W1) { const int e = r / I_W1; r -= e * I_W1; I.W = a.in[15] + (size_t)e * D * 2048; I.WT = (bf16_t*)(ws + WS_W1 + (size_t)e * 2048 * D); I.N = 2048; I.gain = a.in[12]; I.mode = 3; }
    else { r -= NEXP * I_W1; const int e = r / I_W2; r -= e * I_W2; I.W = a.in[17] + (size_t)e * D * D; I.WT = (bf16_t*)(ws + WS_W2 + (size_t)e * D * D); I.N = D; I.mode = 2; }
    const int nblk = I.N / 64; I.k0 = 64 * (r / nblk); I.n0 = 64 * (r % nblk); return true;
}
__device__ __forceinline__ void p0_load(const P0Item& I, f32x4 (&v)[16], int lane) {
    const float* p = I.W + (size_t)(I.k0 + (lane >> 4)) * I.N + I.n0 + 4 * (lane & 15);
#pragma unroll
    for (int j = 0; j < 16; ++j) v[j] = __builtin_nontemporal_load((const f32x4*)(p + (size_t)(4 * j) * I.N));
}
__device__ __forceinline__ void p0_store(const P0Item& I, const f32x4 (&v)[16], LAS unsigned char* tl, int lane) {
    const int kr = lane >> 4, nq = lane & 15;
#pragma unroll
    for (int j = 0; j < 16; ++j) { const int k = 4 * j + kr; const float g = I.gain ? I.gain[I.k0 + k] : 1.0f;
        *(LAS u32x2*)(tl + k * 128 + (((nq >> 1) ^ ((k >> 3) & 7)) * 16) + (nq & 1) * 8) = (u32x2){pk2(v[j].x * g, v[j].y * g), pk2(v[j].z * g, v[j].w * g)}; }
    LDS_WAIT(); asm volatile("" ::: "memory");
    const int c = lane & 7;
#pragma unroll
    for (int i = 0; i < 8; ++i) { const int n = (lane >> 3) + 8 * i; const LAS unsigned char* sp = tl + (8 * c) * 128 + ((i ^ c) * 16) + (n & 7) * 2;
        unsigned short e[8];
#pragma unroll
        for (int q = 0; q < 8; ++q) e[q] = *(const LAS unsigned short*)(sp + q * 128);
        int row = I.n0 + n; if (I.mode & 1) { const int jj = row >> 1, bj = row & 1; row = (jj >> 7) * 256 + bj * 128 + (jj & 127); }
        if (I.mode & 2) *(u32x2*)((unsigned char*)I.WT + (size_t)row * I.K + I.k0 + 8 * c) = (u32x2){pk4_fp8(bf2f(e[0]) * WSCALE8, bf2f(e[1]) * WSCALE8, bf2f(e[2]) * WSCALE8, bf2f(e[3]) * WSCALE8), pk4_fp8(bf2f(e[4]) * WSCALE8, bf2f(e[5]) * WSCALE8, bf2f(e[6]) * WSCALE8, bf2f(e[7]) * WSCALE8)};
        else *(u32x4*)(I.WT + (size_t)row * I.K + I.k0 + 8 * c) = (u32x4){(unsigned)e[0] | ((unsigned)e[1] << 16), (unsigned)e[2] | ((unsigned)e[3] << 16), (unsigned)e[4] | ((unsigned)e[5] << 16), (unsigned)e[6] | ((unsigned)e[7] << 16)}; }
    LDS_WAIT(); asm volatile("" ::: "memory");
}
__device__ __forceinline__ void rms_rows2_to_bf16(const float* __restrict__ x0, const float* __restrict__ x1, const float* __restrict__ g, bf16_t* __restrict__ o0, bf16_t* __restrict__ o1, int lane) {
    const f32x4* xa = (const f32x4*)x0 + lane; const f32x4* xb = (const f32x4*)x1 + lane; const f32x4* gr = (const f32x4*)g + lane;
    f32x4 va[4], vb[4]; float sa = 0.f, sb = 0.f;
#pragma unroll
    for (int j = 0; j < 4; ++j) { va[j] = xa[64 * j]; vb[j] = xb[64 * j]; }
#pragma unroll
    for (int j = 0; j < 4; ++j) { sa += (va[j].x * va[j].x + va[j].y * va[j].y) + (va[j].z * va[j].z + va[j].w * va[j].w); sb += (vb[j].x * vb[j].x + vb[j].y * vb[j].y) + (vb[j].z * vb[j].z + vb[j].w * vb[j].w); }
    const float ra = 1.0f / sqrtf(wave_sum(sa) * (1.0f / D) + EPS), rb = 1.0f / sqrtf(wave_sum(sb) * (1.0f / D) + EPS);
    unsigned long long* pa = (unsigned long long*)o0 + lane; unsigned long long* pb = (unsigned long long*)o1 + lane;
#pragma unroll
    for (int j = 0; j < 4; ++j) { const f32x4 gg = gr[64 * j];
        pa[64 * j] = (unsigned long long)pk2(va[j].x * ra * gg.x, va[j].y * ra * gg.y) | ((unsigned long long)pk2(va[j].z * ra * gg.z, va[j].w * ra * gg.w) << 32);
        pb[64 * j] = (unsigned long long)pk2(vb[j].x * rb * gg.x, vb[j].y * rb * gg.y) | ((unsigned long long)pk2(vb[j].z * rb * gg.z, vb[j].w * rb * gg.w) << 32); }
}

__device__ __forceinline__ void p0_prologue(Frame& F, const Args& a) {
    unsigned char* ws = a.ws;
    LAS unsigned char* tl = F.lds + F.wave * 8192;
    const int gw = F.vcu * NWAVES + F.wave, NGW = F.G * NWAVES;
    for (int m = 2 * gw; m < T; m += 2 * NGW) rms_rows2_to_bf16(a.in[0] + (size_t)m * D, a.in[0] + (size_t)(m + 1) * D, a.in[2], (bf16_t*)(ws + WS_XN) + (size_t)m * D, (bf16_t*)(ws + WS_XN) + (size_t)(m + 1) * D, F.lane);
    for (int m = 2 * gw; m < MROWS; m += 2 * NGW) rms_rows2_to_bf16(a.in[1] + (size_t)m * D, a.in[1] + (size_t)(m + 1) * D, a.in[8], (bf16_t*)(ws + WS_MN) + (size_t)m * D, (bf16_t*)(ws + WS_MN) + (size_t)(m + 1) * D, F.lane);
    for (int i = gw * 64 + F.lane; i < D * D / 4; i += NGW * 64) { const f32x4 w = ((const f32x4*)a.in[9])[i]; const float g = a.in[7][i >> 8];
        ((u32x2*)(ws + WS_WQ))[i] = (u32x2){pk2(w.x * g, w.y * g), pk2(w.z * g, w.w * g)}; }
    for (int i = gw * 64 + F.lane; i < NEXP * D; i += NGW * 64) { const int e = i >> 10, k = i & 1023; const float w = a.in[12][k] * a.in[13][k * NEXP + e];
        const unsigned hi = f2bf(w); ((bf16_t*)(ws + WS_WRT))[i] = (bf16_t)hi; ((bf16_t*)(ws + WS_WRT))[NEXP * D + i] = (bf16_t)f2bf(w - bf2f((unsigned short)hi)); }
    P0Item IA, IB; f32x4 va[16], vb[16];
    int it = gw; bool ha = p0_decode(a, it, IA); if (ha) p0_load(IA, va, F.lane);
    while (ha) {
        const bool hb = p0_decode(a, it + NGW, IB); if (hb) p0_load(IB, vb, F.lane);
        p0_store(IA, va, tl, F.lane);
        if (!hb) break;
        it += 2 * NGW; ha = p0_decode(a, it, IA); if (ha) p0_load(IA, va, F.lane);
        p0_store(IB, vb, tl, F.lane);
    }
}

__device__ __forceinline__ unsigned xcc_id() { return (unsigned)__builtin_amdgcn_s_getreg((3 << 11) | 20) & 0xFu; }
constexpr int QITEMS = 16 + 128;
__device__ __forceinline__ void p2_mixer(Frame& F, const Args& a, int rep) {
    unsigned char* ws = a.ws;
    const bf16_t* proj = (const bf16_t*)(ws + WS_PROJ); bf16_t* mix = (bf16_t*)(ws + WS_MIX);
    const unsigned x0 = xcc_id() & 7u;
    int par = 0;
#ifdef MK_P2_REPMODE
    if (rep && MK_P2_REPMODE == 4) return;
#endif
#ifdef MK_P2_HALF
    if (rep && (blockIdx.x & 8)) return;
#endif
    for (;;) {
        if (F.tid == 0) { int code = -1;
            for (int j = 0; j < 8; ++j) { const unsigned xq = (x0 + j) & 7u; const unsigned i = __hip_atomic_fetch_add(F.ctl + CW_QUEUE + 1024 * rep + 64 * xq, 1u, RLX_AGENT);
                if (i < (unsigned)QITEMS) { code = (int)(xq * 256u + i); break; } }
            F.MISC[par] = (unsigned)code; }
        LDS_WAIT(); __builtin_amdgcn_s_barrier(); asm volatile("" ::: "memory");
        const int code = __builtin_amdgcn_readfirstlane((int)F.MISC[par]); par ^= 1;
        if (code < 0) break;
        const int xq = code >> 8, i = code & 255;
#ifdef MK_P2_REPMODE
        if (rep && ((MK_P2_REPMODE == 1 && i >= 8) || (MK_P2_REPMODE == 2 && i < 16) || MK_P2_REPMODE == 3)) continue;
#endif
#ifndef NO_HGRN
        if (i < 8) { hgrn::hgrn_unit(xq, i, proj, mix, a.in[4], a.in[5], F.lds); }
        else
#endif
        if (i < 16) {
            pg8::KvOrder S{(const char*)(ws + WS_MN), (const char*)(ws + WS_WKV), xq * 8 + (i - 8)};
            pg8::EpiBf16 E{(bf16_t*)(ws + WS_MEMK), D, (bf16_t*)(ws + WS_MEMVT), D};
            pg8::gemm_phase<pg8::EpiBf16, pg8::KvOrder, false, false>(F.lds, D, D, D / 64, S, E);
        } else
#ifndef NO_MOBA
        { const int j = i - 16, g = j >> 5, jj = j & 31, hh = 2 * g + (jj & 1), qb = 15 - (jj >> 1);
            moba::attn_unit<8>(xq, hh, qb, proj, proj + SEC_ELEMS, proj + 2 * SEC_ELEMS, mix, (const float*)(ws + WS_KBAR), (char*)(unsigned char*)F.lds); }
#else
        {}
#endif
    }
}

__device__ __forceinline__ void p7_router(Frame& F, const Args& a, int rep) {
    unsigned char* ws = a.ws;
    constexpr int WRS = 2064;
    LAS unsigned char* WH = F.lds; LAS unsigned char* WL = F.lds + 32 * WRS;
    LAS int* hist = (LAS int*)(F.lds + TL_HIST); LAS int* basel = (LAS int*)(F.lds + TL_BASE);
    { const u32x4* src = (const u32x4*)(ws + WS_WRT);
      for (int i = F.tid; i < 2 * NEXP * D / 8; i += 512) { const int m = i >> 12, r = (i >> 7) & 31, c = i & 127; *(LAS u32x4*)(F.lds + m * 32 * WRS + r * WRS + c * 16) = src[i]; } }
    const float* h2f = (const float*)(ws + WS_H2F); const float* ss2 = (const float*)(ws + WS_SS2);
    int* toke = (int*)(ws + (rep ? WS_DUMMY + 1 * MiB : WS_TOKE)); int* tokr = (int*)(ws + (rep ? WS_DUMMY + 1 * MiB + 512 * 1024 : WS_TOKR)); float* tokg = (float*)(ws + (rep ? WS_DUMMY + 2 * MiB : WS_TOKG)); int* list = (int*)(ws + (rep ? WS_DUMMY + 4 * MiB : WS_LIST)); float* glist = (float*)(ws + (rep ? WS_DUMMY + 8 * MiB : WS_GLIST)); float* sslist = (float*)(ws + (rep ? WS_DUMMY + 12 * MiB : WS_SSLIST));
    unsigned* cntw = F.ctl + (rep ? CW_CNT + 2048 * rep : CW_CNT);
    const int lane = F.lane, r16 = lane & 15, g4 = lane >> 4;
    const float br0 = a.in[14][r16], br1 = a.in[14][16 + r16];
    for (int tb = blockIdx.x; tb < T / 128; tb += F.G) {
        if (F.tid < 32) hist[F.tid] = 0;
        LDS_WAIT(); __builtin_amdgcn_s_barrier(); asm volatile("" ::: "memory");
        const int t0 = tb * 128 + F.wave * 16;
        const float* xr = h2f + (size_t)(t0 + r16) * D + 8 * g4;
        f32x4 acc0 = (f32x4){0.f, 0.f, 0.f, 0.f}, acc1 = acc0;
        f32x4 xa = *(const f32x4*)(xr), xb = *(const f32x4*)(xr + 4);
#pragma unroll 4
        for (int ks = 0; ks < 32; ++ks) {
            const f32x4 ca = xa, cb = xb;
            if (ks + 1 < 32) { xa = *(const f32x4*)(xr + 32 * (ks + 1)); xb = *(const f32x4*)(xr + 32 * (ks + 1) + 4); }
            const unsigned h0 = cvtpk(ca.x, ca.y), h1 = cvtpk(ca.z, ca.w), h2 = cvtpk(cb.x, cb.y), h3 = cvtpk(cb.z, cb.w);
            const unsigned l0 = cvtpk(ca.x - bflo(h0), ca.y - bfhi(h0)), l1 = cvtpk(ca.z - bflo(h1), ca.w - bfhi(h1)), l2 = cvtpk(cb.x - bflo(h2), cb.y - bfhi(h2)), l3 = cvtpk(cb.z - bflo(h3), cb.w - bfhi(h3));
            const bf16x8 ah = __builtin_bit_cast(bf16x8, (u32x4){h0, h1, h2, h3}), al = __builtin_bit_cast(bf16x8, (u32x4){l0, l1, l2, l3});
            const int bo = r16 * WRS + (32 * ks + 8 * g4) * 2;
            const bf16x8 bh0 = *(const LAS bf16x8*)(WH + bo), bh1 = *(const LAS bf16x8*)(WH + 16 * WRS + bo), bl0 = *(const LAS bf16x8*)(WL + bo), bl1 = *(const LAS bf16x8*)(WL + 16 * WRS + bo);
            acc0 = __builtin_amdgcn_mfma_f32_16x16x32_bf16(ah, bh0, acc0, 0, 0, 0); acc1 = __builtin_amdgcn_mfma_f32_16x16x32_bf16(ah, bh1, acc1, 0, 0, 0);
            acc0 = __builtin_amdgcn_mfma_f32_16x16x32_bf16(ah, bl0, acc0, 0, 0, 0); acc1 = __builtin_amdgcn_mfma_f32_16x16x32_bf16(ah, bl1, acc1, 0, 0, 0);
            acc0 = __builtin_amdgcn_mfma_f32_16x16x32_bf16(al, bh0, acc0, 0, 0, 0); acc1 = __builtin_amdgcn_mfma_f32_16x16x32_bf16(al, bh1, acc1, 0, 0, 0);
        }
        int my_e = 0; float my_g = 0.f;
#pragma unroll
        for (int j = 0; j < 4; ++j) {
            const float rs = __builtin_amdgcn_rsqf(ss2[t0 + 4 * g4 + j] * (1.0f / D) + EPS);
            float a0 = acc0[j] * rs + br0, a1 = acc1[j] * rs + br1; float tv[4]; int te_[4];
#pragma unroll
            for (int k = 0; k < 4; ++k) { float m = fmaxf(a0, a1);
#pragma unroll
                for (int o = 1; o < 16; o <<= 1) m = fmaxf(m, __shfl_xor(m, o));
                int e = (a0 == m) ? r16 : ((a1 == m) ? 16 + r16 : 99);
#pragma unroll
                for (int o = 1; o < 16; o <<= 1) e = min(e, __shfl_xor(e, o));
                tv[k] = m; te_[k] = e; if (e == r16) a0 = -INFINITY; if (e == 16 + r16) a1 = -INFINITY; }
            const float d1 = fast_exp2((tv[1] - tv[0]) * LOG2E), d2 = fast_exp2((tv[2] - tv[0]) * LOG2E), d3 = fast_exp2((tv[3] - tv[0]) * LOG2E);
            const float inv = 1.0f / (1.0f + d1 + d2 + d3);
            if ((r16 >> 2) == j) { const int k = lane & 3; my_e = k == 0 ? te_[0] : (k == 1 ? te_[1] : (k == 2 ? te_[2] : te_[3])); my_g = (k == 0 ? 1.0f : (k == 1 ? d1 : (k == 2 ? d2 : d3))) * inv; }
        }
        const int rl = __hip_atomic_fetch_add(hist + my_e, 1, __ATOMIC_RELAXED, __HIP_MEMORY_SCOPE_WORKGROUP);
        LDS_WAIT(); __builtin_amdgcn_s_barrier(); asm volatile("" ::: "memory");
        if (F.tid < 32) basel[F.tid] = (int)__hip_atomic_fetch_add(cntw + F.tid, (unsigned)hist[F.tid], RLX_AGENT);
        LDS_WAIT(); VM_WAIT(); __builtin_amdgcn_s_barrier(); asm volatile("" ::: "memory");
        { const int t = t0 + 4 * g4 + (r16 >> 2), k = lane & 3; const int rank = basel[my_e] + rl;
          toke[t * 4 + k] = my_e; tokr[t * 4 + k] = rank; tokg[t * 4 + k] = my_g; list[(size_t)my_e * T + rank] = t; glist[(size_t)my_e * T + rank] = my_g; sslist[(size_t)my_e * T + rank] = ss2[t]; }
        LDS_WAIT(); __builtin_amdgcn_s_barrier(); asm volatile("" ::: "memory");
    }
}

__device__ __forceinline__ int build_tables(Frame& F) {
    LAS int* ts = (LAS int*)(F.lds + TL_TS); LAS unsigned char* te = (LAS unsigned char*)(F.lds + TL_TE);
    if (F.tid < NEXP) ((LAS int*)(F.lds + TL_CNT))[F.tid] = (int)__hip_atomic_load(F.ctl + CW_CNT + F.tid, RLX_AGENT);
    LDS_WAIT(); __builtin_amdgcn_s_barrier(); asm volatile("" ::: "memory");
    if (F.tid == 0) { int run = 0;
        for (int e = 0; e < NEXP; ++e) { ts[e] = run; run += (((LAS int*)(F.lds + TL_CNT))[e] + 255) >> 8; }
        ts[NEXP] = run; }
    LDS_WAIT(); __builtin_amdgcn_s_barrier(); asm volatile("" ::: "memory");
    const int nt = ts[NEXP];
    for (int g = F.tid; g < nt; g += 512) { int e = 0;
        for (int j = 1; j < NEXP; ++j) e += (ts[j] <= g) ? 1 : 0;
        te[g] = (unsigned char)e; }
    LDS_WAIT(); __builtin_amdgcn_s_barrier(); asm volatile("" ::: "memory");
    return __builtin_amdgcn_readfirstlane(nt);
}

__device__ __forceinline__ void p10_combine(Frame& F, const Args& a) {
    unsigned char* ws = a.ws;
    LAS int* ts = (LAS int*)(F.lds + TL_TS);
    const float* h2f = (const float*)(ws + WS_H2F); const unsigned char* Y = (const unsigned char*)(ws + WS_Y);
    const int* toke = (const int*)(ws + WS_TOKE); const int* tokr = (const int*)(ws + WS_TOKR);
    const float* gf = a.in[19];
    const int gw = F.vcu * NWAVES + F.wave, NGW = F.G * NWAVES, lane = F.lane;
    for (int t0 = 2 * gw; t0 < T; t0 += 2 * NGW) {
        float o[2][16]; u32x2 y[2][4][2];
#pragma unroll
        for (int q = 0; q < 2; ++q) { const int t = t0 + q;
#pragma unroll
            for (int k = 0; k < 4; ++k) { const int e = toke[t * 4 + k], r = tokr[t * 4 + k]; const unsigned char* yr = Y + ((size_t)ts[e] * 256 + r) * D;
                y[q][k][0] = *(const u32x2*)(yr + 8 * lane); y[q][k][1] = *(const u32x2*)(yr + 512 + 8 * lane); }
            const f32x4 a0 = *(const f32x4*)(h2f + (size_t)t * D + 8 * lane), a1 = *(const f32x4*)(h2f + (size_t)t * D + 8 * lane + 4), a2 = *(const f32x4*)(h2f + (size_t)t * D + 512 + 8 * lane), a3 = *(const f32x4*)(h2f + (size_t)t * D + 512 + 8 * lane + 4);
            o[q][0] = a0.x; o[q][1] = a0.y; o[q][2] = a0.z; o[q][3] = a0.w; o[q][4] = a1.x; o[q][5] = a1.y; o[q][6] = a1.z; o[q][7] = a1.w; o[q][8] = a2.x; o[q][9] = a2.y; o[q][10] = a2.z; o[q][11] = a2.w; o[q][12] = a3.x; o[q][13] = a3.y; o[q][14] = a3.z; o[q][15] = a3.w; }
#pragma unroll
        for (int q = 0; q < 2; ++q) {
#pragma unroll
            for (int k = 0; k < 4; ++k)
#pragma unroll
                for (int hf = 0; hf < 2; ++hf) { const u32x2 w = y[q][k][hf];
                    const f32x2 c0 = __builtin_amdgcn_cvt_pk_f32_fp8((int)w.x, false), c1 = __builtin_amdgcn_cvt_pk_f32_fp8((int)w.x, true), c2 = __builtin_amdgcn_cvt_pk_f32_fp8((int)w.y, false), c3 = __builtin_amdgcn_cvt_pk_f32_fp8((int)w.y, true);
                    o[q][8 * hf + 0] += pg8::YSCALE_INV * c0.x; o[q][8 * hf + 1] += pg8::YSCALE_INV * c0.y; o[q][8 * hf + 2] += pg8::YSCALE_INV * c1.x; o[q][8 * hf + 3] += pg8::YSCALE_INV * c1.y;
                    o[q][8 * hf + 4] += pg8::YSCALE_INV * c2.x; o[q][8 * hf + 5] += pg8::YSCALE_INV * c2.y; o[q][8 * hf + 6] += pg8::YSCALE_INV * c3.x; o[q][8 * hf + 7] += pg8::YSCALE_INV * c3.y; }
            float s = 0.f;
#pragma unroll
            for (int j = 0; j < 16; ++j) s += o[q][j] * o[q][j];
            const float rstd = 1.0f / sqrtf(wave_sum(s) * (1.0f / D) + EPS);
            float* op = a.out + (size_t)(t0 + q) * D;
#pragma unroll
            for (int v = 0; v < 4; ++v) { const int col = (v >> 1) * 512 + 8 * lane + (v & 1) * 4; const f32x4 g4 = *(const f32x4*)(gf + col);
                *(f32x4*)(op + col) = (f32x4){o[q][4 * v] * rstd * g4.x, o[q][4 * v + 1] * rstd * g4.y, o[q][4 * v + 2] * rstd * g4.z, o[q][4 * v + 3] * rstd * g4.w}; }
        }
    }
}

#define XB_TMO      128
#define XB_XCNT(j)  (256  + 64 * (j))
#define XB_XSUB(j)  (1280 + 64 * (j))
#define XB_XGEN(j)  (2304 + 64 * (j))
#define XB_TOP      3328
#define XB_TOPGEN   3392
#define XCD_BAR_WORDS 3456
#define XB_SPIN_CAP (1u << 22)
__device__ __forceinline__ unsigned xb_ld(unsigned* p)              { return __hip_atomic_load(p, __ATOMIC_RELAXED, __HIP_MEMORY_SCOPE_AGENT); }
__device__ __forceinline__ unsigned xb_add(unsigned* p, unsigned v) { return __hip_atomic_fetch_add(p, v, __ATOMIC_RELAXED, __HIP_MEMORY_SCOPE_AGENT); }
#define XB_SPIN(cond, bar) do { unsigned _sp = 0; while (cond) { __builtin_amdgcn_s_sleep(1); \
    if ((++_sp & 255u) == 0u) { if (xb_ld(&(bar)[XB_TMO])) break; if (_sp > XB_SPIN_CAP) { atomicAdd(&(bar)[XB_TMO], 1u); break; } } } } while (0)
struct XcdBarrier { unsigned* bar; unsigned x; volatile LAS unsigned* st; };
__device__ __forceinline__ XcdBarrier xcd_barrier_post(unsigned* bar, volatile LAS unsigned* st) {
    XcdBarrier b; b.bar = bar; b.x = (unsigned)__builtin_amdgcn_s_getreg((3 << 11) | 20) & 0xFu; b.st = st;
    if (threadIdx.x == 0) (void)xb_add(&bar[XB_XCNT(b.x)], 1u);
    return b;
}
__device__ __forceinline__ void xcd_barrier_complete(unsigned* bar, unsigned x, unsigned& nloc, unsigned& nx) {
    const unsigned G = gridDim.x * gridDim.y * gridDim.z;
    unsigned sum, cnt, mine, sp = 0u;
    for (;;) {
        sum = 0u; cnt = 0u; mine = 0u;
#pragma unroll
        for (unsigned j = 0; j < 16; ++j) { const unsigned c = xb_ld(&bar[XB_XCNT(j)]); sum += c; cnt += (c > 0u) ? 1u : 0u; mine = (j == x) ? c : mine; }
        if (sum == G) break;
        __builtin_amdgcn_s_sleep(1);
        if ((++sp & 255u) == 0u) { if (xb_ld(&bar[XB_TMO])) break; if (sp > XB_SPIN_CAP) { atomicAdd(&bar[XB_TMO], 1u); break; } }
    }
    nloc = mine > 0u ? mine : 1u; nx = cnt > 0u ? cnt : 1u;
}
__device__ __forceinline__ void xcd_barrier(const XcdBarrier& b) {
    asm volatile("s_waitcnt vmcnt(0)" ::: "memory");
    __syncthreads();
    if (threadIdx.x == 0) {
        unsigned* bar = b.bar;
        __builtin_amdgcn_s_waitcnt(0);
        unsigned nloc = b.st[0], nx = b.st[1];
        if (nloc == 0u) { xcd_barrier_complete(bar, b.x, nloc, nx); b.st[0] = nloc; b.st[1] = nx; }
        const unsigned old = xb_add(&bar[XB_XSUB(b.x)], 1u);
        const unsigned gen = old / nloc;
        if (old + 1u == (gen + 1u) * nloc) {
            __builtin_amdgcn_fence(__ATOMIC_RELEASE, "agent");
            asm volatile("s_waitcnt vmcnt(0)" ::: "memory");
            const unsigned og = xb_add(&bar[XB_TOP], 1u);
            const unsigned tg = og / nx;
            if (og + 1u == (tg + 1u) * nx) xb_add(&bar[XB_TOPGEN], 1u);
            else XB_SPIN(xb_ld(&bar[XB_TOPGEN]) == tg, bar);
            __builtin_amdgcn_fence(__ATOMIC_ACQUIRE, "agent");
            xb_add(&bar[XB_XGEN(b.x)], 1u);
            asm volatile("s_waitcnt vmcnt(0)" ::: "memory");
        } else {
            XB_SPIN(xb_ld(&bar[XB_XGEN(b.x)]) == gen, bar);
            __builtin_amdgcn_fence(__ATOMIC_ACQUIRE, "agent");
            asm volatile("s_waitcnt vmcnt(0)" ::: "memory");
        }
    }
    __syncthreads();
}
#ifndef MK_CG_ONLY
#define MK_CG_ONLY 0
#endif
__device__ __forceinline__ void grid_barrier(Frame& F, const XcdBarrier& xb_) { if (MK_CG_ONLY) cg::this_grid().sync(); else xcd_barrier(xb_); }
#ifndef MK_PHASE_MASK
#define MK_PHASE_MASK 0x7ff
#endif
#ifndef MK_REP_PHASE
#define MK_REP_PHASE -1
#endif
#ifndef MK_REP_N
#define MK_REP_N 0
#endif
__device__ __forceinline__ void ph0(Frame& F, const Args& args, int rep) { p0_prologue(F, args); }
__device__ __forceinline__ void ph1(Frame& F, const Args& args, int rep) {
    unsigned char* ws = args.ws; const int cid = (int)blockIdx.x;
    { pg8::DenseOrder S{(const char*)(ws + WS_XN), (const char*)(ws + WS_WIN), D, D, T / 256, INC / 256, F.G, cid};
      pg8::EpiProj E{(bf16_t*)(ws + WS_PROJ), rep ? (float*)(ws + WS_DUMMY) : (float*)(ws + WS_KBAR)};
      pg8::gemm_phase<pg8::EpiProj, pg8::DenseOrder, false, true>(F.lds, D, D, D / 64, S, E); }
}
__device__ __forceinline__ void ph2(Frame& F, const Args& args, int rep) { p2_mixer(F, args, rep); }
constexpr size_t WS_MB = WS_PROJ, WS_NB = WS_PROJ + 16 * MiB, WS_H1Q = WS_PROJ + 32 * MiB, WS_PB = WS_QX;
constexpr size_t WS_UNUSED_XA = 0;
constexpr int LDS_XTAB = 131072;
__device__ __forceinline__ void ph3(Frame& F, const Args& args, int rep) {
    unsigned char* ws = args.ws; const int cid = (int)blockIdx.x;
    pg8::P3Order S{pg8::XmnOrder{(const char*)(ws + WS_MEMK), (const char*)(ws + WS_MEMVT), (const char*)(ws + WS_WQ), (const char*)(ws + WS_WO), F.G, cid},
                   pg8::DenseOrder{(const char*)(ws + WS_MIX), (const char*)(ws + WS_WOUT), D, D, T / 256, D / 256, F.G, cid}};
    pg8::EpiP3 E{pg8::EpiFp8{(unsigned char*)(ws + WS_MB), D, (unsigned char*)(ws + WS_NB), D, XSCALE8},
                 pg8::EpiRes<true, false>{(const void*)args.in[0], (bf16_t*)(ws + WS_H1B), nullptr, rep ? (float*)(ws + WS_DUMMY + 512 * 1024) : (float*)(ws + WS_SS1), 1.0f, (unsigned char*)(ws + WS_H1Q)}};
    pg8::gemm_phase<pg8::EpiP3, pg8::P3Order, false, true>(F.lds, D, D, D / 64, S, E);
}
__device__ __forceinline__ void ph4(Frame& F, const Args& args, int rep) {
    unsigned char* ws = args.ws; const int cid = (int)blockIdx.x;
    pg8::XbOrder S{(const char*)(ws + WS_H1Q), (const char*)(ws + WS_MB), F.G, cid, (size_t)D};
    pg8::EpiSoftmaxS E{(unsigned char*)(ws + WS_PB), (const float*)(ws + WS_SS1), F.lds + LDS_XTAB, XSCALE8_INV};
    pg8::gemm_phase<pg8::EpiSoftmaxS, pg8::XbOrder, false, true, true>(F.lds, D / 2, D / 2, D / 128, S, E);
}
__device__ __forceinline__ void ph5(Frame& F, const Args& args, int rep) {}
__device__ __forceinline__ void ph6(Frame& F, const Args& args, int rep) {
    unsigned char* ws = args.ws; const int cid = (int)blockIdx.x;
    pg8::XbOrder S{(const char*)(ws + WS_PB), (const char*)(ws + WS_NB), F.G, cid, (size_t)D};
    pg8::EpiRes<false, true, true> E{(const void*)(ws + WS_H1B), (bf16_t*)(ws + WS_H2B), (float*)(ws + WS_H2F), rep ? (float*)(ws + WS_DUMMY + 512 * 1024) : (float*)(ws + WS_SS2), PSCALE8_INV * XSCALE8_INV, nullptr};
    pg8::gemm_phase<pg8::EpiRes<false, true, true>, pg8::XbOrder, false, true, true>(F.lds, D / 2, D / 2, D / 128, S, E);
}
__device__ __forceinline__ void ph7(Frame& F, const Args& args, int rep) { p7_router(F, args, rep); }
__device__ __forceinline__ void ph8(Frame& F, const Args& args, int rep) {
    unsigned char* ws = args.ws; const int cid = (int)blockIdx.x;
    const int ntl = build_tables(F);
    pg8::MoeOrder S{(const char*)(ws + WS_H2B), (const char*)(ws + WS_W1), (const int*)(ws + WS_LIST), (const LAS int*)(F.lds + TL_CNT), (const LAS unsigned char*)(F.lds + TL_TE), (const LAS int*)(F.lds + TL_TS),
                    ntl, 8, F.G, cid, (size_t)2048 * D, 1, (size_t)256 * D, (size_t)256 * D};
    pg8::EpiW1 E{(bf16_t*)(ws + WS_HMID), (const float*)(ws + WS_SSLIST), args.in[16], (const int*)(ws + WS_LIST)};
    pg8::gemm_phase<pg8::EpiW1, pg8::MoeOrder, true, true, true>(F.lds, D / 2, D / 2, D / 128, S, E);
}
__device__ __forceinline__ void ph9(Frame& F, const Args& args, int rep) {
    unsigned char* ws = args.ws; const int cid = (int)blockIdx.x;
    const int ntl = build_tables(F);
    pg8::MoeOrder S{(const char*)(ws + WS_HMID), (const char*)(ws + WS_W2), (const int*)(ws + WS_LIST), (const LAS int*)(F.lds + TL_CNT), (const LAS unsigned char*)(F.lds + TL_TE), (const LAS int*)(F.lds + TL_TS),
                    ntl, 4, F.G, cid, (size_t)D * D, 0, (size_t)256 * D, (size_t)256 * D};
    pg8::EpiW2 E{(unsigned char*)(ws + WS_Y), args.in[18], (const int*)(ws + WS_LIST), (const float*)(ws + WS_GLIST)};
    pg8::gemm_phase<pg8::EpiW2, pg8::MoeOrder, false, true, true>(F.lds, D / 2, D / 2, D / 128, S, E);
}
__device__ __forceinline__ void ph10(Frame& F, const Args& args, int rep) { (void)build_tables(F); p10_combine(F, args); }

constexpr int N_PHASES = 11;
__global__ void __launch_bounds__(NWAVES * 64, 2) hymba_fwd(Args args) {
    extern __shared__ __attribute__((aligned(16))) unsigned char lds_raw[];
    Frame F;
    F.lds = (LAS unsigned char*)lds_raw;
    F.MISC = (volatile LAS unsigned*)(F.lds + TL_MISC);
    F.tid = threadIdx.x; F.lane = F.tid & 63; F.wave = __builtin_amdgcn_readfirstlane(F.tid >> 6);
    F.G = gridDim.x; { const int bx = blockIdx.x; F.vcu = (F.G % 8 == 0) ? (bx % 8) * (F.G / 8) + bx / 8 : bx; }
    F.ctl = (unsigned*)(args.ws + WS_CTL);
    const int lo = args.ph_lo, hi = args.ph_hi;
    for (int u = F.tid; u < 64; u += NWAVES * 64) ((LAS unsigned*)(F.lds + TL_MISC))[u] = 0u;
    __syncthreads();
    const XcdBarrier xbar = xcd_barrier_post(F.ctl + CW_BAR, F.MISC + 8);
#define RUN(k, fn) do { if (((MK_PHASE_MASK >> (k)) & 1) && lo <= (k) && (k) < hi) { fn(F, args, 0); \
        if (MK_REP_PHASE == (k) && MK_REP_N >= 1) { grid_barrier(F, xbar); fn(F, args, 1); } \
        if (MK_REP_PHASE == (k) && MK_REP_N >= 2) { grid_barrier(F, xbar); fn(F, args, 2); } \
        if ((k) + 1 < hi) { grid_barrier(F, xbar); } } } while (0)
    if (args.ph_lo < 0) cg::this_grid().sync();
    RUN(0, ph0); RUN(1, ph1); RUN(2, ph2); RUN(3, ph3); RUN(4, ph4);   RUN(6, ph6); RUN(7, ph7); RUN(8, ph8); RUN(9, ph9); RUN(10, ph10);
#undef RUN
}

extern "C" void kernel_launch(void* const* d_in, const int* in_sizes, int n_in, void* d_out, int out_size, void* d_ws, size_t ws_size, hipStream_t stream) {
    static int grid = 0;
    if (grid == 0) {
        if (n_in != 20 || in_sizes[0] != T * D || out_size != T * D || ws_size < WS_END) {
            fprintf(stderr, "kernel_launch: shape/workspace mismatch (n_in %d, in0 %d, out %d, ws %zu, need %zu)\n", n_in, n_in > 0 ? in_sizes[0] : -1, out_size, ws_size, (size_t)WS_END); grid = -1; return; }
        int dev = 0, cus = 0, per_cu = 0;
        if (hipGetDevice(&dev) != hipSuccess || hipDeviceGetAttribute(&cus, hipDeviceAttributeMultiprocessorCount, dev) != hipSuccess) { grid = -1; return; }
        if (hipFuncSetAttribute((const void*)hymba_fwd, hipFuncAttributeMaxDynamicSharedMemorySize, LDS_BYTES) != hipSuccess) { fprintf(stderr, "kernel_launch: hipFuncSetAttribute failed\n"); grid = -1; return; }
        if (hipOccupancyMaxActiveBlocksPerMultiprocessor(&per_cu, (const void*)hymba_fwd, NWAVES * 64, LDS_BYTES) != hipSuccess || per_cu < 1) { fprintf(stderr, "kernel_launch: occupancy query says %d\n", per_cu); }
        (void)hipGetLastError();
        grid = cus;
        if (grid != 256) fprintf(stderr, "kernel_launch: %d CUs; this kernel is built for 256\n", grid);
    }
    if (grid < 0) return;
    (void)hipMemsetAsync((char*)d_ws + WS_CTL, 0, CTL_ZERO_BYTES, stream);
    Args a{};
    for (int i = 0; i < 20; ++i) a.in[i] = (const float*)d_in[i];
    a.out = (float*)d_out; a.ws = (unsigned char*)d_ws;
#if MK_N_LAUNCHES == 1
    a.ph_lo = 0; a.ph_hi = MK_LAST_PHASE + 1;
    void* kargs[] = {&a};
    hipError_t e = hipLaunchCooperativeKernel((const void*)hymba_fwd, dim3(grid), dim3(NWAVES * 64), kargs, LDS_BYTES, stream);
    if (e != hipSuccess) fprintf(stderr, "kernel_launch: cooperative launch failed: %s\n", hipGetErrorString(e));
#else
    for (int p = 0; p <= MK_LAST_PHASE; ++p) { a.ph_lo = p; a.ph_hi = p + 1; hipLaunchKernelGGL(hymba_fwd, dim3(grid), dim3(NWAVES * 64), LDS_BYTES, stream, a); }
#endif
}
```

```cpp
#include <hip/hip_runtime.h>
#include <hip/hip_cooperative_groups.h>
#include <cstdio>
#include <cstdint>
namespace cg = cooperative_groups;

#ifndef MK_N_LAUNCHES
#define MK_N_LAUNCHES 1
#endif
#ifndef MK_LAST_PHASE
#define MK_LAST_PHASE 10
#endif

#define LAS __attribute__((address_space(3)))
#define GAS __attribute__((address_space(1)))
typedef unsigned short bf16_t;
typedef short bf16x8 __attribute__((ext_vector_type(8)));
typedef short s16x4 __attribute__((ext_vector_type(4)));
typedef float f32x4 __attribute__((ext_vector_type(4)));
typedef float f32x2 __attribute__((ext_vector_type(2)));
typedef float f32x16 __attribute__((ext_vector_type(16)));
typedef unsigned u32x4 __attribute__((ext_vector_type(4)));
typedef unsigned u32x2 __attribute__((ext_vector_type(2)));
typedef int v8i32_t __attribute__((ext_vector_type(8)));

constexpr int BATCH = 8, SEQ = 4096, T = BATCH * SEQ, D = 1024, INC = 3584, NMEM = 256, MROWS = BATCH * NMEM;
constexpr int NEXP = 32, TOPK = 4, MT_MAX = T * TOPK / 256 + NEXP, MPAD = MT_MAX * 256;
constexpr float EPS = 1e-6f;
constexpr float LOG2E = 1.4426950408889634f;
constexpr float C2Q = 0.125f * LOG2E;
constexpr float C2X = 0.0625f * LOG2E;
constexpr int C_MQ = 0, C_MK = 512, C_MV = 1024, C_GQ = 1536, C_GF = 2048, C_GI = 2560, C_GG = 3072;

constexpr size_t MiB = 1u << 20;
constexpr size_t WS_CTL = 0, CTL_ZERO_BYTES = 2 * MiB;
constexpr size_t WS_KBAR = 1 * MiB;
constexpr size_t WS_SS1 = 1 * MiB + 256 * 1024;
constexpr size_t WS_SS2 = 1 * MiB + 384 * 1024;
constexpr size_t WS_TOKE = 2 * MiB, WS_TOKR = 2 * MiB + 512 * 1024, WS_TOKG = 3 * MiB;
constexpr size_t WS_WRT = 3 * MiB + 512 * 1024;
constexpr size_t WS_LIST = 4 * MiB;
constexpr size_t WS_GLIST = 8 * MiB;
constexpr size_t WS_SSLIST = 12 * MiB;
constexpr size_t WS_WIN = 16 * MiB, WS_WOUT = 23 * MiB, WS_WQ = 25 * MiB, WS_WKV = 27 * MiB, WS_WO = 31 * MiB;
constexpr size_t WS_MN = 33 * MiB, WS_MEMK = 37 * MiB, WS_MEMVT = 41 * MiB;
constexpr size_t WS_W1 = 48 * MiB, WS_W2 = 176 * MiB;
constexpr size_t WS_PROJ = 240 * MiB;
constexpr size_t SEC_ELEMS = (size_t)16 * 1024 * 1024;
constexpr size_t WS_XN = 464 * MiB;
constexpr size_t WS_OX = 464 * MiB;
constexpr size_t WS_MIX = 528 * MiB;
constexpr size_t WS_H1B = 592 * MiB;
constexpr size_t WS_QX = 656 * MiB;
constexpr size_t WS_PWS = 720 * MiB;
constexpr size_t WS_HMID = 240 * MiB;
constexpr size_t WS_Y = 512 * MiB;
constexpr size_t WS_H2F = 784 * MiB;
constexpr size_t WS_H2B = 912 * MiB;
constexpr size_t WS_DUMMY = 976 * MiB;
constexpr size_t WS_END = 992 * MiB;
static_assert(WS_HMID + (size_t)MPAD * D * 2 <= WS_Y && WS_Y + (size_t)MPAD * D * 2 <= WS_H2F, "ws map");
constexpr int CW_TMO = 0;
constexpr int CW_CNT = 64;
constexpr int CW_QUEUE = 128;
constexpr int CW_BAR = 4096;

__device__ __forceinline__ unsigned f2bf(float f) { unsigned u = __builtin_bit_cast(unsigned, f); return (u + 0x7fffu + ((u >> 16) & 1u)) >> 16; }
__device__ __forceinline__ unsigned pk2(float lo, float hi) { return f2bf(lo) | (f2bf(hi) << 16); }
__device__ __forceinline__ float bf2f(unsigned short h) { return __builtin_bit_cast(float, (unsigned)h << 16); }
__device__ __forceinline__ float bflo(unsigned w) { return __builtin_bit_cast(float, w << 16); }
__device__ __forceinline__ float bfhi(unsigned w) { return __builtin_bit_cast(float, w & 0xffff0000u); }
typedef float f32x2_t __attribute__((ext_vector_type(2))); typedef __bf16 bf16x2_t __attribute__((ext_vector_type(2)));
__device__ __forceinline__ unsigned cvtpk(float lo, float hi) { f32x2_t v = {lo, hi}; bf16x2_t b = __builtin_convertvector(v, bf16x2_t); return __builtin_bit_cast(unsigned, b); }
__device__ __forceinline__ float wave_sum(float v) {
#pragma unroll
    for (int o = 1; o < 64; o <<= 1) v += __shfl_xor(v, o);
    return v;
}
__device__ __forceinline__ float fast_exp2(float x) { return __builtin_amdgcn_exp2f(x); }
__device__ __forceinline__ float fast_rcp(float x) { return __builtin_amdgcn_rcpf(x); }
__device__ __forceinline__ float silu_f(float x) { return x * fast_rcp(1.0f + fast_exp2(-x * LOG2E)); }
__device__ __forceinline__ unsigned pk4_fp8(float a, float b, float c, float d) { int w = 0; w = __builtin_amdgcn_cvt_pk_fp8_f32(a, b, w, false); w = __builtin_amdgcn_cvt_pk_fp8_f32(c, d, w, true); return (unsigned)w; }
constexpr float XSCALE8 = 4.0f, XSCALE8_INV = 0.25f, PSCALE8 = 256.0f, PSCALE8_INV = 1.0f / 256.0f;
constexpr float WSCALE8 = 32.0f, WSCALE8_INV = 1.0f / 32.0f;
#define LDS_WAIT() asm volatile("s_waitcnt lgkmcnt(0)" ::: "memory")
#define VM_WAIT() asm volatile("s_waitcnt vmcnt(0)" ::: "memory")
#define RLX_AGENT __ATOMIC_RELAXED, __HIP_MEMORY_SCOPE_AGENT

namespace pg8 {
constexpr int BM = 256, BK = 64, HALF = 128, HTB = HALF * BK * 2, STAGE_BYTES = 8 * HTB;
__device__ __forceinline__ unsigned gload32_hidden(const void* sbase, unsigned voff) { unsigned v; asm volatile("global_load_dword %0, %1, %2" : "=v"(v) : "v"(voff), "s"(sbase) : "memory"); return v; }
__device__ __forceinline__ f32x4 gload128_hidden(const void* sbase, unsigned voff) { f32x4 v; asm volatile("global_load_dwordx4 %0, %1, %2" : "=v"(v) : "v"(voff), "s"(sbase) : "memory"); return v; }
__device__ __forceinline__ void glds16s(const char* sbase, unsigned voff, unsigned lds_dst) { unsigned keep;
    asm volatile("s_mov_b32 %0, m0\n\ts_mov_b32 m0, %3\n\ts_nop 0\n\tglobal_load_lds_dwordx4 %1, %2\n\ts_mov_b32 m0, %0" : "=&s"(keep) : "v"(voff), "s"(sbase), "s"(lds_dst) : "memory"); }
__host__ __device__ __forceinline__ int lds_byte(int r, int c) { const int st = (r >> 4) * 2 + (c >> 5), rr = r & 15, cc = c & 31, ob = rr * 64 + cc * 2; return st * 1024 + (ob ^ (((ob >> 9) & 1) << 5)); }
__host__ __device__ __forceinline__ void stage_rc(int b, int& R, int& C) { const int st = b / 1024, sb = b % 1024, swz = sb ^ (((sb >> 9) & 1) << 5); R = (st >> 1) * 16 + swz / 64; C = (st & 1) * 32 + (swz % 64) / 2; }
__host__ __device__ __forceinline__ int perm32(int rho) { const int n = rho >> 4, i = rho & 15; return 8 * (i >> 2) + 4 * n + (i & 3); }

struct Unit { const char* A; const char* B; const int* rows; int pm, pn, aux, nrows, ntu; };

template <class Epi, class Sched, bool GATHER, bool ALIGN_EPI, bool FP8 = false>
__device__ __forceinline__ void gemm_phase(LAS unsigned char* lds, const int lda, const int ldb, const int nt_in, const Sched& S, const Epi& E) {
    int nt = nt_in; asm volatile("" : "+s"(nt));
    int tid_ = threadIdx.x; asm volatile("" : "+v"(tid_));
    const int tid = tid_, wid = __builtin_amdgcn_readfirstlane(tid >> 6), lane = tid & 63, wr = wid >> 2, wc = wid & 3, fr = lane & 15, fq = lane >> 4;
    unsigned offB0; { int R, C; stage_rc(tid * 16, R, C); const int Rb = Epi::PERM ? ((R & ~31) + perm32(R & 31)) : R; offB0 = (unsigned)(Rb * ldb + C) * 2u; }
    const size_t pstepB = (size_t)64 * ldb * 2;
    const size_t kstep = (size_t)(BK * 2);
    const size_t hstepB = (size_t)HALF * ldb * 2;
    const unsigned ldsb = (unsigned)__builtin_amdgcn_readfirstlane((int)((unsigned)(uintptr_t)(unsigned char*)lds + (unsigned)wid * 1024u));
    const int aoff = lds_byte(wr * 64 + fr, FP8 ? fq * 16 : fq * 8), boff = lds_byte(wc * 32 + fr, FP8 ? fq * 16 : fq * 8);
#define PG8_SA(b, h) (((b) * 2 + (h)) * HTB)
#define PG8_SB(b, h) ((4 + (b) * 2 + (h)) * HTB)
#define PG8_STGB(bufoff, gbase) do { glds16s((const char*)(gbase), offB0, ldsb + (unsigned)(bufoff)); glds16s((const char*)(gbase) + pstepB, offB0, ldsb + (unsigned)(bufoff) + 8192u); } while (0)
#define PG8_LD16(p_) (*(const LAS u32x4*)(p_))
#define PG8_CAT(x, y) __builtin_bit_cast(v8i32_t, __builtin_shufflevector(x, y, 0, 1, 2, 3, 4, 5, 6, 7))
    unsigned aA0 = (unsigned)(aoff + PG8_SA(0, 0)), aA1 = (unsigned)(aoff + PG8_SA(1, 0)), bB0 = (unsigned)(boff + PG8_SB(0, 0)), bB1 = (unsigned)(boff + PG8_SB(1, 0));
    asm volatile("" : "+v"(aA0), "+v"(aA1), "+v"(bB0), "+v"(bB1));
    int scl8 = 0x7f7f7f7f; asm volatile("" : "+v"(scl8));
#define PG8_LDA(dst, b, h) do { const LAS unsigned char* ap_ = lds + ((b) ? aA1 : aA0) + (h) * HTB; _Pragma("unroll") for (int m = 0; m < 4; ++m) { \
        if constexpr (FP8) { dst##8[m] = PG8_CAT(PG8_LD16(ap_ + m * 2048), PG8_LD16(ap_ + m * 2048 + 16)); } \
        else { _Pragma("unroll") for (int k = 0; k < 2; ++k) dst[m][k] = *(const LAS bf16x8*)(ap_ + m * 2048 + k * 1024); } } } while (0)
#define PG8_LDB(dst, b, h) do { const LAS unsigned char* bp_ = lds + ((b) ? bB1 : bB0) + (h) * HTB; _Pragma("unroll") for (int n = 0; n < 2; ++n) { \
        if constexpr (FP8) { dst##8[n] = PG8_CAT(PG8_LD16(bp_ + n * 2048), PG8_LD16(bp_ + n * 2048 + 16)); } \
        else { _Pragma("unroll") for (int k = 0; k < 2; ++k) dst[n][k] = *(const LAS bf16x8*)(bp_ + n * 2048 + k * 1024); } } } while (0)
#define PG8_MMA(ai, bj, At, Bt) do { __builtin_amdgcn_s_setprio(1); _Pragma("unroll") for (int m = 0; m < 4; ++m) _Pragma("unroll") for (int n = 0; n < 2; ++n) { \
        if constexpr (FP8) asm volatile("v_mfma_scale_f32_16x16x128_f8f6f4 %0, %1, %2, %0, %3, %3 op_sel_hi:[0,0,0]" : "+v"(acc[ai][bj][m][n]) : "v"(Bt##8[n]), "v"(At##8[m]), "v"(scl8));   \
        else { _Pragma("unroll") for (int k = 0; k < 2; ++k) acc[ai][bj][m][n] = __builtin_amdgcn_mfma_f32_16x16x32_bf16(Bt[n][k], At[m][k], acc[ai][bj][m][n], 0, 0, 0); } } \
        __builtin_amdgcn_s_setprio(0); } while (0)
#define PG8_WAIT_V(n) asm volatile("s_waitcnt vmcnt(" #n ")" ::: "memory")
#define PG8_WAIT_L(n) asm volatile("s_waitcnt lgkmcnt(" #n ")" ::: "memory")
#define PG8_BAR __builtin_amdgcn_s_barrier()
#define PG8_SCHED __builtin_amdgcn_sched_barrier(0)
    unsigned voffA0, c2, pkc[2], pkn[2], praw[4];
    { int R, C; stage_rc(tid * 16, R, C); voffA0 = (unsigned)(R * lda + C) * 2u; c2 = (unsigned)C * 2u; }
    const size_t hstepA = (size_t)HALF * lda * 2, pstepA = (size_t)64 * lda * 2;
    const unsigned lda2 = (unsigned)lda * 2u;
#define PG8_PKROWS(dst, u) do { if (GATHER) { _Pragma("unroll") for (int i_ = 0; i_ < 2; ++i_) { int R_, C_; stage_rc(tid * 16 + i_ * 8192, R_, C_); \
        const int nr_ = (u).nrows - 1; const int r0_ = R_ < nr_ ? R_ : nr_, r1_ = (R_ + HALF) < nr_ ? (R_ + HALF) : nr_; \
        dst[i_] = (unsigned)(u).rows[r0_] | ((unsigned)(u).rows[r1_] << 16); } } } while (0)
#define PG8_RAWROWS(u) do { if (GATHER) { _Pragma("unroll") for (int i_ = 0; i_ < 2; ++i_) { int R_, C_; stage_rc(tid * 16 + i_ * 8192, R_, C_); \
        const int nr_ = (u).nrows - 1; const int r0_ = R_ < nr_ ? R_ : nr_, r1_ = (R_ + HALF) < nr_ ? (R_ + HALF) : nr_; \
        praw[2 * i_] = gload32_hidden((u).rows, (unsigned)r0_ * 4u); praw[2 * i_ + 1] = gload32_hidden((u).rows, (unsigned)r1_ * 4u); } } } while (0)
#define PG8_PACKRAW(dst) do { unsigned a0_ = praw[0], a1_ = praw[1], a2_ = praw[2], a3_ = praw[3]; asm volatile("" : "+v"(a0_), "+v"(a1_), "+v"(a2_), "+v"(a3_)); \
        dst[0] = a0_ | (a1_ << 16); dst[1] = a2_ | (a3_ << 16); } while (0)
#define PG8_STGA(bufoff, gbase, h, NX) do { \
        if (GATHER) { const unsigned p0_ = (NX) ? pkn[0] : pkc[0], p1_ = (NX) ? pkn[1] : pkc[1]; \
            const unsigned o0_ = ((h) ? (p0_ >> 16) : (p0_ & 0xffffu)) * lda2 + c2, o1_ = ((h) ? (p1_ >> 16) : (p1_ & 0xffffu)) * lda2 + c2; \
            glds16s((const char*)(gbase), o0_, ldsb + (unsigned)(bufoff)); glds16s((const char*)(gbase), o1_, ldsb + (unsigned)(bufoff) + 8192u); } \
        else { const char* gb_ = (const char*)(gbase) + ((h) ? hstepA : (size_t)0); glds16s(gb_, voffA0, ldsb + (unsigned)(bufoff)); glds16s(gb_ + pstepA, voffA0, ldsb + (unsigned)(bufoff) + 8192u); } } while (0)
    Unit cur, nxt; int ui = 0;
    if (!S.next(0, cur)) return;
    f32x4 acc[2][2][4][2];
#pragma unroll
    for (int a = 0; a < 2; ++a)
#pragma unroll
        for (int b = 0; b < 2; ++b)
#pragma unroll
            for (int m = 0; m < 4; ++m)
#pragma unroll
                for (int n = 0; n < 2; ++n) acc[a][b][m][n] = (f32x4){0.f, 0.f, 0.f, 0.f};
    bf16x8 At[4][2], B0[2][2], B1[2][2]; v8i32_t At8[4], B08[2], B18[2];
    pkc[0] = pkc[1] = pkn[0] = pkn[1] = 0u; praw[0] = praw[1] = praw[2] = praw[3] = 0u;
    PG8_PKROWS(pkc, cur);
    const char* cA = cur.A; const char* cB = cur.B;
    PG8_STGB(PG8_SB(0, 0), cB); PG8_STGB(PG8_SB(0, 1), cB + hstepB); PG8_STGA(PG8_SA(0, 0), cA, 0, false); PG8_STGA(PG8_SA(0, 1), cA, 1, false);
    if (wr == 1) PG8_BAR;
    PG8_WAIT_V(2); PG8_BAR;
    PG8_STGB(PG8_SB(1, 0), cB + kstep); PG8_STGA(PG8_SA(1, 0), cA + kstep, 0, false); PG8_STGB(PG8_SB(1, 1), cB + hstepB + kstep);
    PG8_WAIT_V(6); PG8_BAR;
    for (;;) {
        const bool has_next = S.next(ui + 1, nxt);
        if (GATHER) { if (has_next) { PG8_RAWROWS(nxt); } }
        const char* nA = has_next ? nxt.A : cA; const char* nB = has_next ? nxt.B : cB;
        typename Epi::Pre pre; { int t_p = threadIdx.x; asm volatile("" : "+v"(t_p)); E.prefetch(cur, wr, wc, t_p & 15, (t_p >> 4) & 3, pre); }
        const int ntc = cur.ntu ? cur.ntu : nt;
        for (int t = 0; t < ntc; t += 2) {
            const bool last = (t == ntc - 2);
            if (GATHER) { pkn[0] = pkc[0]; pkn[1] = pkc[1]; if (last && has_next) { PG8_PACKRAW(pkn); } }
            const char* a1 = cA + (size_t)(t + 1) * kstep;
            const char* a2 = last ? nA : cA + (size_t)(t + 2) * kstep; const char* b2 = last ? nB : cB + (size_t)(t + 2) * kstep;
            const char* a3 = a2 + kstep; const char* b3 = b2 + kstep;
            PG8_LDB(B0, 0, 0); PG8_LDB(B1, 0, 1); PG8_SCHED; PG8_LDA(At, 0, 0); PG8_STGA(PG8_SA(1, 1), a1, 1, false);
            PG8_WAIT_V(8); PG8_WAIT_L(0); PG8_BAR; PG8_MMA(0, 0, At, B0); PG8_MMA(0, 1, At, B1); PG8_BAR; PG8_SCHED;
            PG8_LDA(At, 0, 1); PG8_STGB(PG8_SB(0, 0), b2); PG8_STGB(PG8_SB(0, 1), b2 + hstepB); PG8_STGA(PG8_SA(0, 0), a2, 0, last);
            PG8_WAIT_V(8); PG8_WAIT_L(0); PG8_BAR; PG8_MMA(1, 0, At, B0); PG8_MMA(1, 1, At, B1); PG8_BAR; PG8_SCHED;
            PG8_LDB(B0, 1, 0); PG8_LDB(B1, 1, 1); PG8_SCHED; PG8_LDA(At, 1, 0); PG8_STGA(PG8_SA(0, 1), a2, 1, last);
            PG8_WAIT_V(8); PG8_WAIT_L(0); PG8_BAR; PG8_MMA(0, 0, At, B0); PG8_MMA(0, 1, At, B1); PG8_BAR; PG8_SCHED;
            PG8_LDA(At, 1, 1); PG8_STGB(PG8_SB(1, 0), b3); PG8_STGB(PG8_SB(1, 1), b3 + hstepB); PG8_STGA(PG8_SA(1, 0), a3, 0, last);
            PG8_WAIT_V(8); PG8_WAIT_L(0); PG8_BAR; PG8_MMA(1, 0, At, B0); PG8_MMA(1, 1, At, B1); PG8_BAR; PG8_SCHED;
        }
        if constexpr (ALIGN_EPI) { if (wr == 0) PG8_BAR; }
        if constexpr (FP8) asm volatile("s_nop 15\n\ts_nop 15" ::: "memory");
        if constexpr (!Epi::AFTER_DRAIN) { int t_e = threadIdx.x; asm volatile("" : "+v"(t_e)); const int fr_e = t_e & 15, fq_e = (t_e >> 4) & 3; E(acc, cur, wr, wc, fr_e, fq_e, pre); }
        if (!has_next) break;
#pragma unroll
        for (int a = 0; a < 2; ++a)
#pragma unroll
            for (int b = 0; b < 2; ++b)
#pragma unroll
                for (int m = 0; m < 4; ++m)
#pragma unroll
                    for (int n = 0; n < 2; ++n) acc[a][b][m][n] = (f32x4){0.f, 0.f, 0.f, 0.f};
        cur = nxt; cA = nA; cB = nB; ++ui;
        if (GATHER) { PG8_PACKRAW(pkc); }
        if constexpr (ALIGN_EPI) { if (wr == 1) PG8_BAR; }
    }
    PG8_WAIT_V(0);
    if constexpr (!ALIGN_EPI) { if (wr == 0) PG8_BAR; }
    PG8_BAR;
    if constexpr (Epi::AFTER_DRAIN) { int t_e = threadIdx.x; asm volatile("" : "+v"(t_e)); const int fr_e = t_e & 15, fq_e = (t_e >> 4) & 3; E.fused(acc, cur, wr, wc, fr_e, fq_e, lds, wid, t_e & 63); }
#undef PG8_SA
#undef PG8_SB
#undef PG8_STGB
#undef PG8_LDA
#undef PG8_LDB
#undef PG8_MMA
#undef PG8_CAT
#undef PG8_LD16
#undef PG8_WAIT_V
#undef PG8_WAIT_L
#undef PG8_SCHED
#undef PG8_PKROWS
#undef PG8_RAWROWS
#undef PG8_PACKRAW
#undef PG8_STGA
}
}

namespace pg8 {
constexpr int NXCD = 8, WGM = 8;
__device__ __forceinline__ void tile_order(int L, int nM, int nN, int& pm, int& pn) {
    const int nwg = nM * nN; int wgid = L;
    { const int q = nwg / NXCD, r = nwg % NXCD, xcd = wgid % NXCD, off = wgid / NXCD; wgid = (xcd < r ? xcd * (q + 1) : r * (q + 1) + (xcd - r) * q) + off; }
    const int nig = WGM * nN, gid = wgid / nig, fm = gid * WGM, gsz = (nM - fm) < WGM ? (nM - fm) : WGM;
    pm = fm + ((wgid % nig) % gsz); pn = (wgid % nig) / gsz;
}
struct DenseOrder {
    const char* A; const char* B; int lda, ldb, nM, nN, G, c;
    __device__ __forceinline__ bool next(int i, Unit& u) const {
        const long L = (long)i * G + c; if (L >= (long)nM * nN) return false;
        int pm, pn; tile_order((int)L, nM, nN, pm, pn);
        u.pm = pm; u.pn = pn; u.aux = 0; u.rows = nullptr; u.nrows = 256; u.ntu = 0;
        u.A = A + (size_t)pm * 256 * lda * 2; u.B = B + (size_t)pn * 256 * ldb * 2; return true;
    }
};
struct KvOrder {
    const char* MN; const char* W; int L0;
    __device__ __forceinline__ bool next(int i, Unit& u) const {
        const int L = L0; if (i > 0 || L >= 64) return false;
        u.rows = nullptr; u.nrows = 256; u.ntu = 0; u.pm = L >> 3; const int ct = L & 7; u.aux = ct >> 2; u.pn = ct & 3;
        u.A = MN + (size_t)u.pm * 256 * D * 2; u.B = W + (size_t)ct * 256 * D * 2; return true;
    }
};
struct XmnOrder {
    const char* MK; const char* MV; const char* WQN; const char* WOT; int G, c;
    __device__ __forceinline__ bool next(int i, Unit& u) const {
        const int L = c + i * G; if (L >= 256) return false;
        u.rows = nullptr; u.nrows = 256; u.ntu = 0;
        if (L < 128) { const int b = L >> 4, h = (L >> 2) & 3, kt = L & 3; u.aux = 0; u.pm = b * 4 + h; u.pn = kt;
            u.A = MK + ((size_t)(b * 256) * D + h * 256) * 2; u.B = WQN + ((size_t)(kt * 256) * D + h * 256) * 2; }
        else { const int l = L - 128, b = l >> 4, nt = (l >> 2) & 3, h = l & 3; u.aux = 1; u.pm = b * 4 + nt; u.pn = h;
            u.A = WOT + ((size_t)(nt * 256) * D + h * 256) * 2; u.B = MV + ((size_t)(b * 256) * D + h * 256) * 2; }
        return true;
    }
};
struct P3Order {
    XmnOrder X; DenseOrder Dn;
    __device__ __forceinline__ bool next(int i, Unit& u) const {
        if (i == 0 && X.c < 256) { X.next(0, u); u.ntu = 4; return true; }
        const bool ok = Dn.next(X.c < 256 ? i - 1 : i, u); u.aux = 2; return ok;
    }
};
struct XbOrder {
    const char* A; const char* Bb; int G, c; size_t rb;
    __device__ __forceinline__ bool next(int i, Unit& u) const {
        const long L = (long)i * G + c; if (L >= 512) return false;
        int pm, pn; tile_order((int)L, T / 256, 4, pm, pn);
        u.pm = pm; u.pn = pn; u.aux = 0; u.rows = nullptr; u.nrows = 256; u.ntu = 0;
        u.A = A + (size_t)pm * 256 * rb; u.B = Bb + (size_t)(pm >> 4) * D * rb + (size_t)pn * 256 * rb; return true;
    }
};
struct MoeOrder {
    const char* A; const char* W; const int* list; const LAS int* cnt; const LAS unsigned char* te; const LAS int* ts;
    int ntiles, nN, G, c; size_t wstride; int gather; size_t atile, btile;
    __device__ __forceinline__ bool next(int i, Unit& u) const {
        const long L = (long)i * G + c; if (L >= (long)ntiles * nN) return false;
        int pm, pn; tile_order((int)L, ntiles, nN, pm, pn);
        const int e = __builtin_amdgcn_readfirstlane((int)te[pm]);
        const int lt = pm - __builtin_amdgcn_readfirstlane(ts[e]);
        const int n = __builtin_amdgcn_readfirstlane(cnt[e]) - lt * 256;
        u.pm = pm; u.pn = pn; u.aux = e; u.nrows = n < 256 ? n : 256; u.ntu = 0;
        u.rows = list + (size_t)e * T + lt * 256;
        u.A = gather ? A : A + (size_t)pm * atile;
        u.B = W + (size_t)e * wstride + (size_t)pn * btile; return true;
    }
};

struct EpiProj {
    static constexpr bool PERM = true, AFTER_DRAIN = false; struct Pre {}; __device__ __forceinline__ void prefetch(const Unit&, int, int, int, int, Pre&) const {}
    bf16_t* O; float* kbar;
    __device__ __forceinline__ void operator()(const f32x4 (&acc)[2][2][4][2], const Unit& u, int wr, int wc, int fr, int fq, const Pre&) const {
        const int pn = u.pn, sec = pn >> 1, b = u.pm >> 4, t0 = (u.pm & 15) * 256 + wr * 64 + fr;
        const int mode = (pn < 2) ? 1 : ((pn == 6 || pn == 7 || pn >= 12) ? 2 : 0);
        bf16_t* sb = O + (size_t)sec * SEC_ELEMS;
#pragma unroll
        for (int bj = 0; bj < 2; ++bj) {
            const int c = bj * HALF + wc * 32 + 8 * fq, head = (pn & 1) * 4 + (c >> 6), d0 = c & 63;
            bf16_t* hb = sb + (size_t)(b * 8 + head) * (SEQ * 64);
#pragma unroll
            for (int ai = 0; ai < 2; ++ai)
#pragma unroll
                for (int m = 0; m < 4; ++m) { const int t = t0 + ai * HALF + m * 16;
                    f32x4 v0 = acc[ai][bj][m][0], v1 = acc[ai][bj][m][1];
                    if (mode == 1) { v0 = v0 * C2Q; v1 = v1 * C2Q; }
                    else if (mode == 2) {
#pragma unroll
                        for (int e = 0; e < 4; ++e) { v0[e] = silu_f(v0[e]); v1[e] = silu_f(v1[e]); } }
                    u32x4 w; w.x = cvtpk(v0[0], v0[1]); w.y = cvtpk(v0[2], v0[3]); w.z = cvtpk(v1[0], v1[1]); w.w = cvtpk(v1[2], v1[3]);
                    size_t off;
                    if (sec == 1) off = (size_t)(t >> 6) * 4096 + (d0 >> 3) * 512 + (t & 63) * 8;
                    else if (sec == 2) off = (size_t)(t >> 6) * 4096 + (d0 >> 5) * 2048 + (t & 63) * 32 + (d0 & 31);
                    else off = (size_t)t * 64 + d0;
                    *(u32x4*)(hb + off) = w; } }
        if (pn == 2 || pn == 3) {
#pragma unroll
            for (int bj = 0; bj < 2; ++bj)
#pragma unroll
                for (int n = 0; n < 2; ++n)
#pragma unroll
                    for (int e = 0; e < 4; ++e) { float s = 0.f;
#pragma unroll
                        for (int ai = 0; ai < 2; ++ai)
#pragma unroll
                            for (int m = 0; m < 4; ++m) s += acc[ai][bj][m][n][e];
                        s += __shfl_xor(s, 1); s += __shfl_xor(s, 2); s += __shfl_xor(s, 4); s += __shfl_xor(s, 8);
                        if (fr == 0) { const int c = bj * HALF + wc * 32 + 8 * fq + 4 * n + e, head = (pn - 2) * 4 + (c >> 6), d = c & 63;
                            atomicAdd(kbar + ((size_t)u.pm * 8 + head) * 64 + d, s); } }
        }
    }
};
struct EpiBf16 {
    static constexpr bool PERM = true, AFTER_DRAIN = false; struct Pre {}; __device__ __forceinline__ void prefetch(const Unit&, int, int, int, int, Pre&) const {}
    bf16_t* O0; int ldc0; bf16_t* O1; int ldc1;
    __device__ __forceinline__ void operator()(const f32x4 (&acc)[2][2][4][2], const Unit& u, int wr, int wc, int fr, int fq, const Pre&) const {
        bf16_t* O = u.aux ? O1 : O0; const int ldc = u.aux ? ldc1 : ldc0;
        const int row0 = u.pm * BM + wr * 64 + fr, col0 = u.pn * BM + wc * 32 + 8 * fq;
#pragma unroll
        for (int ai = 0; ai < 2; ++ai)
#pragma unroll
            for (int m = 0; m < 4; ++m) { bf16_t* rowp = O + (size_t)(row0 + ai * HALF + m * 16) * ldc + col0;
#pragma unroll
                for (int bj = 0; bj < 2; ++bj) { const f32x4 v0 = acc[ai][bj][m][0], v1 = acc[ai][bj][m][1];
                    u32x4 w; w.x = cvtpk(v0[0], v0[1]); w.y = cvtpk(v0[2], v0[3]); w.z = cvtpk(v1[0], v1[1]); w.w = cvtpk(v1[2], v1[3]);
                    *(u32x4*)(rowp + bj * HALF) = w; } }
    }
};
struct EpiFp8 {
    static constexpr bool PERM = true, AFTER_DRAIN = false; struct Pre {}; __device__ __forceinline__ void prefetch(const Unit&, int, int, int, int, Pre&) const {}
    unsigned char* O0; int ldc0; unsigned char* O1; int ldc1; float scale;
    __device__ __forceinline__ void operator()(const f32x4 (&acc)[2][2][4][2], const Unit& u, int wr, int wc, int fr, int fq, const Pre&) const {
        unsigned char* O = u.aux ? O1 : O0; const int ldc = u.aux ? ldc1 : ldc0;
        const int row0 = u.pm * BM + wr * 64 + fr, col0 = u.pn * BM + wc * 32 + 8 * fq;
#pragma unroll
        for (int ai = 0; ai < 2; ++ai)
#pragma unroll
            for (int m = 0; m < 4; ++m) { unsigned char* rowp = O + (size_t)(row0 + ai * HALF + m * 16) * ldc + col0;
#pragma unroll
                for (int bj = 0; bj < 2; ++bj) { const f32x4 v0 = acc[ai][bj][m][0] * scale, v1 = acc[ai][bj][m][1] * scale;
                    *(u32x2*)(rowp + bj * HALF) = (u32x2){pk4_fp8(v0[0], v0[1], v0[2], v0[3]), pk4_fp8(v1[0], v1[1], v1[2], v1[3])}; } }
    }
};
template <bool BASE_F32, bool WRITE_F32, bool OUT_FP8 = false> struct EpiRes {
    static constexpr bool PERM = true, AFTER_DRAIN = false; struct Pre {}; __device__ __forceinline__ void prefetch(const Unit&, int, int, int, int, Pre&) const {}
    const void* base; bf16_t* Ob; float* Of; float* ss; float asc; unsigned char* Oq;
    __device__ __forceinline__ void operator()(const f32x4 (&acc)[2][2][4][2], const Unit& u, int wr, int wc, int fr, int fq, const Pre&) const {
        const int row0 = u.pm * BM + wr * 64 + fr, col0 = u.pn * BM + wc * 32 + 8 * fq;
#pragma unroll
        for (int ai = 0; ai < 2; ++ai)
#pragma unroll
            for (int m = 0; m < 4; ++m) { const int row = row0 + ai * HALF + m * 16; const size_t off = (size_t)row * D + col0; float sq = 0.f;
#pragma unroll
                for (int bj = 0; bj < 2; ++bj) { f32x4 b0, b1;
                    if (BASE_F32) { b0 = *(const f32x4*)((const float*)base + off + bj * HALF); b1 = *(const f32x4*)((const float*)base + off + bj * HALF + 4); }
                    else { const u32x4 w = *(const u32x4*)((const bf16_t*)base + off + bj * HALF);
                        b0 = (f32x4){bflo(w.x), bfhi(w.x), bflo(w.y), bfhi(w.y)}; b1 = (f32x4){bflo(w.z), bfhi(w.z), bflo(w.w), bfhi(w.w)}; }
                    const f32x4 v0 = acc[ai][bj][m][0] * asc + b0, v1 = acc[ai][bj][m][1] * asc + b1;
                    sq += (v0[0] * v0[0] + v0[1] * v0[1]) + (v0[2] * v0[2] + v0[3] * v0[3]) + (v1[0] * v1[0] + v1[1] * v1[1]) + (v1[2] * v1[2] + v1[3] * v1[3]);
                    if (OUT_FP8) { *(u32x2*)((unsigned char*)Ob + off + bj * HALF) = (u32x2){pk4_fp8(v0[0], v0[1], v0[2], v0[3]), pk4_fp8(v1[0], v1[1], v1[2], v1[3])}; }
                    else { u32x4 w; w.x = cvtpk(v0[0], v0[1]); w.y = cvtpk(v0[2], v0[3]); w.z = cvtpk(v1[0], v1[1]); w.w = cvtpk(v1[2], v1[3]);
                    *(u32x4*)(Ob + off + bj * HALF) = w; }
                    if (Oq) *(u32x2*)(Oq + off + bj * HALF) = (u32x2){pk4_fp8(v0[0], v0[1], v0[2], v0[3]), pk4_fp8(v1[0], v1[1], v1[2], v1[3])};
                    if (WRITE_F32) { *(f32x4*)(Of + off + bj * HALF) = v0; *(f32x4*)(Of + off + bj * HALF + 4) = v1; } }
                sq += __shfl_xor(sq, 16); sq += __shfl_xor(sq, 32);
                if (fq == 0) atomicAdd(ss + row, sq); }
    }
};
struct EpiP3 {
    static constexpr bool PERM = true, AFTER_DRAIN = false; struct Pre {}; __device__ __forceinline__ void prefetch(const Unit&, int, int, int, int, Pre&) const {}
    EpiFp8 a; EpiRes<true, false> b;
    __device__ __forceinline__ void operator()(const f32x4 (&acc)[2][2][4][2], const Unit& u, int wr, int wc, int fr, int fq, const Pre&) const {
        if (u.aux < 2) a(acc, u, wr, wc, fr, fq, EpiFp8::Pre{}); else b(acc, u, wr, wc, fr, fq, EpiRes<true, false>::Pre{});
    }
};
struct EpiQ {
    static constexpr bool PERM = true, AFTER_DRAIN = false; struct Pre {}; __device__ __forceinline__ void prefetch(const Unit&, int, int, int, int, Pre&) const {}
    bf16_t* O; const float* ss;
    __device__ __forceinline__ void operator()(const f32x4 (&acc)[2][2][4][2], const Unit& u, int wr, int wc, int fr, int fq, const Pre&) const {
        const int row0 = u.pm * BM + wr * 64 + fr, col0 = u.pn * BM + wc * 32 + 8 * fq;
#pragma unroll
        for (int ai = 0; ai < 2; ++ai)
#pragma unroll
            for (int m = 0; m < 4; ++m) { const int row = row0 + ai * HALF + m * 16; const float sc = C2X * __builtin_amdgcn_rsqf(ss[row] * (1.0f / D) + EPS);
                bf16_t* rowp = O + (size_t)row * D + col0;
#pragma unroll
                for (int bj = 0; bj < 2; ++bj) { const f32x4 v0 = acc[ai][bj][m][0] * sc, v1 = acc[ai][bj][m][1] * sc;
                    u32x4 w; w.x = cvtpk(v0[0], v0[1]); w.y = cvtpk(v0[2], v0[3]); w.z = cvtpk(v1[0], v1[1]); w.w = cvtpk(v1[2], v1[3]);
                    *(u32x4*)(rowp + bj * HALF) = w; } }
    }
};
struct EpiSoftmaxS {
    static constexpr bool PERM = true, AFTER_DRAIN = false; struct Pre {}; __device__ __forceinline__ void prefetch(const Unit&, int, int, int, int, Pre&) const {}
    unsigned char* P; const float* ss; LAS unsigned char* tb; float qs;
    __device__ __forceinline__ void operator()(f32x4 (&acc)[2][2][4][2], const Unit& u, int wr, int wc, int fr, int fq, const Pre&) const {
        LAS float* MX = (LAS float*)tb;
        LAS float* SM = (LAS float*)(tb + 4096);
#pragma unroll
        for (int ai = 0; ai < 2; ++ai)
#pragma unroll
            for (int m = 0; m < 4; ++m) { const int r = ai * HALF + wr * 64 + m * 16 + fr; const float sc = qs * C2X * __builtin_amdgcn_rsqf(ss[u.pm * BM + r] * (1.0f / D) + EPS); float mx = -3.0e38f;
#pragma unroll
                for (int bj = 0; bj < 2; ++bj)
#pragma unroll
                    for (int n = 0; n < 2; ++n) { f32x4 x = acc[ai][bj][m][n] * sc; acc[ai][bj][m][n] = x; mx = fmaxf(mx, fmaxf(fmaxf(x[0], x[1]), fmaxf(x[2], x[3]))); }
                mx = fmaxf(mx, __shfl_xor(mx, 16)); mx = fmaxf(mx, __shfl_xor(mx, 32));
                if (fq == 0) MX[r * 4 + wc] = mx; }
        LDS_WAIT(); __builtin_amdgcn_s_barrier(); asm volatile("" ::: "memory");
#pragma unroll
        for (int ai = 0; ai < 2; ++ai)
#pragma unroll
            for (int m = 0; m < 4; ++m) { const int r = ai * HALF + wr * 64 + m * 16 + fr; const f32x4 q = *(const LAS f32x4*)(MX + r * 4);
                const float mx = fmaxf(fmaxf(q[0], q[1]), fmaxf(q[2], q[3])); float sm = 0.f;
#pragma unroll
                for (int bj = 0; bj < 2; ++bj)
#pragma unroll
                    for (int n = 0; n < 2; ++n) { f32x4 x = acc[ai][bj][m][n];
#pragma unroll
                        for (int e = 0; e < 4; ++e) { x[e] = fast_exp2(x[e] - mx); sm += x[e]; }
                        acc[ai][bj][m][n] = x; }
                sm += __shfl_xor(sm, 16); sm += __shfl_xor(sm, 32);
                if (fq == 0) SM[r * 4 + wc] = sm; }
        LDS_WAIT(); __builtin_amdgcn_s_barrier(); asm volatile("" ::: "memory");
        const int col0 = u.pn * BM + wc * 32 + 8 * fq;
#pragma unroll
        for (int ai = 0; ai < 2; ++ai)
#pragma unroll
            for (int m = 0; m < 4; ++m) { const int r = ai * HALF + wr * 64 + m * 16 + fr; const f32x4 q = *(const LAS f32x4*)(SM + r * 4);
                const float inv = PSCALE8 * fast_rcp((q[0] + q[1]) + (q[2] + q[3]));
#pragma unroll
                for (int bj = 0; bj < 2; ++bj) { const f32x4 v0 = acc[ai][bj][m][0] * inv, v1 = acc[ai][bj][m][1] * inv;
                    *(u32x2*)(P + ((size_t)u.pm * BM + r) * D + bj * HALF + col0) = (u32x2){pk4_fp8(v0[0], v0[1], v0[2], v0[3]), pk4_fp8(v1[0], v1[1], v1[2], v1[3])}; } }
        LDS_WAIT(); __builtin_amdgcn_s_barrier(); asm volatile("" ::: "memory");
    }
};
struct EpiW1 {
    static constexpr bool PERM = true, AFTER_DRAIN = false;
    struct Pre { float sc[8]; f32x4 bq[4]; };
    bf16_t* O; const float* ssl; const float* b1; const int* list0;
    __device__ __forceinline__ void prefetch(const Unit& u, int wr, int wc, int fr, int fq, Pre& p) const {
        const float* sp = ssl + (u.rows - list0);
        { const float* bb = b1 + (size_t)u.aux * 2048 + 2 * (u.pn * 128); const unsigned bo = (unsigned)(2 * (wc * 32 + 8 * fq)) * 4u;
#pragma unroll
          for (int q = 0; q < 4; ++q) p.bq[q] = gload128_hidden(bb, bo + 16u * q); }
#pragma unroll
        for (int ai = 0; ai < 2; ++ai)
#pragma unroll
            for (int m = 0; m < 4; ++m) { const int r = ai * HALF + wr * 64 + m * 16 + fr; const int rr = r < u.nrows ? r : u.nrows - 1; p.sc[ai * 4 + m] = __uint_as_float(gload32_hidden(sp, (unsigned)rr * 4u)); }
    }
    __device__ __forceinline__ void operator()(const f32x4 (&acc)[2][2][4][2], const Unit& u, int wr, int wc, int fr, int fq, const Pre& pre) const {
        const int c0 = wc * 32 + 8 * fq;
        f32x4 bq0 = pre.bq[0], bq1 = pre.bq[1], bq2 = pre.bq[2], bq3 = pre.bq[3]; asm volatile("" : "+v"(bq0), "+v"(bq1), "+v"(bq2), "+v"(bq3));
        const float bg[8] = {bq0[0], bq0[2], bq1[0], bq1[2], bq2[0], bq2[2], bq3[0], bq3[2]};
        const float bl[8] = {bq0[1], bq0[3], bq1[1], bq1[3], bq2[1], bq2[3], bq3[1], bq3[3]};
#pragma unroll
        for (int ai = 0; ai < 2; ++ai)
#pragma unroll
            for (int m = 0; m < 4; ++m) { const int r = ai * HALF + wr * 64 + m * 16 + fr;
                float ssv = pre.sc[ai * 4 + m]; asm volatile("" : "+v"(ssv));
                const float sc = WSCALE8_INV * __builtin_amdgcn_rsqf(ssv * (1.0f / D) + EPS); float a[8];
#pragma unroll
                for (int j = 0; j < 8; ++j) { const float g = acc[ai][0][m][j >> 2][j & 3] * sc + bg[j], l = acc[ai][1][m][j >> 2][j & 3] * sc + bl[j];
                    const float glu = fminf(g, 7.0f), lin = fminf(fmaxf(l, -7.0f), 7.0f);
                    a[j] = glu * fast_rcp(1.0f + fast_exp2(-1.702f * LOG2E * glu)) * (lin + 1.0f); }
                *(u32x2*)((unsigned char*)O + ((size_t)u.pm * BM + r) * D + u.pn * 128 + c0) = (u32x2){pk4_fp8(a[0], a[1], a[2], a[3]), pk4_fp8(a[4], a[5], a[6], a[7])}; }
    }
};
constexpr float YSCALE = 16.0f, YSCALE_INV = 1.0f / 16.0f;
struct EpiW2 {
    static constexpr bool PERM = true, AFTER_DRAIN = false;
    struct Pre { float g[8]; f32x4 bv[4]; };
    unsigned char* O; const float* b2; const int* list0; const float* gl0;
    __device__ __forceinline__ void prefetch(const Unit& u, int wr, int wc, int fr, int fq, Pre& p) const {
        const float* gp = gl0 + (u.rows - list0);
        { const float* bb = b2 + (size_t)u.aux * D + u.pn * BM; const unsigned bo = (unsigned)(wc * 32 + 8 * fq) * 4u;
#pragma unroll
          for (int q = 0; q < 4; ++q) p.bv[q] = gload128_hidden(bb, bo + (unsigned)((q >> 1) * HALF * 4 + (q & 1) * 16)); }
#pragma unroll
        for (int ai = 0; ai < 2; ++ai)
#pragma unroll
            for (int m = 0; m < 4; ++m) { const int r = ai * HALF + wr * 64 + m * 16 + fr; const int rr = r < u.nrows ? r : u.nrows - 1; p.g[ai * 4 + m] = __uint_as_float(gload32_hidden(gp, (unsigned)rr * 4u)); }
    }
    __device__ __forceinline__ void operator()(const f32x4 (&acc)[2][2][4][2], const Unit& u, int wr, int wc, int fr, int fq, const Pre& pre) const {
        const int row0 = u.pm * BM + wr * 64 + fr, col0 = u.pn * BM + wc * 32 + 8 * fq;
        f32x4 bv[2][2]; bv[0][0] = pre.bv[0]; bv[0][1] = pre.bv[1]; bv[1][0] = pre.bv[2]; bv[1][1] = pre.bv[3]; asm volatile("" : "+v"(bv[0][0]), "+v"(bv[0][1]), "+v"(bv[1][0]), "+v"(bv[1][1]));
#pragma unroll
        for (int ai = 0; ai < 2; ++ai)
#pragma unroll
            for (int m = 0; m < 4; ++m) { unsigned char* rowp = O + (size_t)(row0 + ai * HALF + m * 16) * D + col0; float gv = pre.g[ai * 4 + m]; asm volatile("" : "+v"(gv)); const float g = YSCALE * gv;
#pragma unroll
                for (int bj = 0; bj < 2; ++bj) { const f32x4 v0 = (acc[ai][bj][m][0] * WSCALE8_INV + bv[bj][0]) * g, v1 = (acc[ai][bj][m][1] * WSCALE8_INV + bv[bj][1]) * g;
                    *(u32x2*)(rowp + bj * HALF) = (u32x2){pk4_fp8(v0[0], v0[1], v0[2], v0[3]), pk4_fp8(v1[0], v1[1], v1[2], v1[3])}; } }
    }
};
}

namespace moba {
using bf16x8 = ::bf16x8; using s16x4 = ::s16x4; using f32x16 = ::f32x16; using u32x4 = ::u32x4;
constexpr int DMQ = INC, DMO = D, HD = 64;
constexpr int NW = 8, QBLK = 32, QB = 256, KVBLK = 64;
__device__ __forceinline__ int crow(int r, int hi) { return (r & 3) + 8 * (r >> 2) + 4 * hi; }
#define SBAR() __builtin_amdgcn_sched_barrier(0)
__device__ __forceinline__ void cmask(f32x16& p0, f32x16& p1, int jb, int qrel, int hi) {
    const float NEG = -INFINITY; int kb = 64 * jb + 4 * hi;
#pragma unroll
    for (int r = 0; r < 16; ++r) { int kv = kb + (r & 3) + 8 * (r >> 2); if (kv > qrel) p0[r] = NEG; if (kv + 32 > qrel) p1[r] = NEG; }
}
constexpr int NSLOT = 3, SLOTB = 8192;
constexpr int LDS_K = 0, LDS_V = NSLOT * SLOTB, LDS_WS = 2 * NSLOT * SLOTB, LDS_OST = LDS_WS + NW * 64 * 4, LDS_KB = LDS_OST + NW * 4096, LDS_BYTES = LDS_KB + 16 * 64 * 4;
__device__ __forceinline__ void glds16(const void* gsrc, unsigned lds_dst) { unsigned keep;
    asm volatile("s_mov_b32 %0, m0\n\ts_mov_b32 m0, %2\n\ts_nop 0\n\tglobal_load_lds_dwordx4 %1, off\n\ts_mov_b32 m0, %0" : "=&s"(keep) : "v"(gsrc), "s"(lds_dst) : "memory"); }
__device__ __forceinline__ float max3f(float a, float b, float c) { float r; asm("v_max3_f32 %0, %1, %2, %3" : "=v"(r) : "v"(a), "v"(b), "v"(c)); return r; }
__device__ __forceinline__ float max2f(float a, float b) { float r; asm("v_max_f32_e32 %0, %1, %2" : "=v"(r) : "v"(a), "v"(b)); return r; }
__device__ __forceinline__ float fadd_s(float a, float b) { float r; asm("v_add_f32_e32 %0, %1, %2" : "=v"(r) : "v"(a), "v"(b)); return r; }
__device__ __forceinline__ float fsub_s(float a, float b) { float r; asm("v_sub_f32_e32 %0, %1, %2" : "=v"(r) : "v"(a), "v"(b)); return r; }
__device__ __forceinline__ unsigned cvtpk_s(float lo, float hi) { return ::cvtpk(lo, hi); }
#define WAIT_BAR(N) asm volatile("s_waitcnt vmcnt(" #N ") lgkmcnt(0)\n\ts_barrier" ::: "memory")
__device__ __forceinline__ void qkt(f32x16& p0, f32x16& p1, const char* Kslot, const bf16x8* qr, const f32x16& negm, int r32, int hi) {
    const char* kb = Kslot + hi * 1024 + r32 * 16;
#pragma unroll
    for (int d0 = 0; d0 < 4; ++d0) {
        const bf16x8 b0 = *reinterpret_cast<const bf16x8*>(kb + d0 * 2048);
        const bf16x8 b1 = *reinterpret_cast<const bf16x8*>(kb + d0 * 2048 + 512);
        if (d0 == 0) { p0 = __builtin_amdgcn_mfma_f32_32x32x16_bf16(b0, qr[0], negm, 0, 0, 0); p1 = __builtin_amdgcn_mfma_f32_32x32x16_bf16(b1, qr[0], negm, 0, 0, 0); }
        else { p0 = __builtin_amdgcn_mfma_f32_32x32x16_bf16(b0, qr[d0], p0, 0, 0, 0); p1 = __builtin_amdgcn_mfma_f32_32x32x16_bf16(b1, qr[d0], p1, 0, 0, 0); } }
}
typedef __attribute__((address_space(3))) const char* lds_cptr;
typedef short v4i16_t __attribute__((ext_vector_type(4)));
__device__ __forceinline__ void kload8(bf16x8* kf, lds_cptr kp) {
    kf[0] = *(const __attribute__((address_space(3))) bf16x8*)(kp);        kf[1] = *(const __attribute__((address_space(3))) bf16x8*)(kp + 512);
    kf[2] = *(const __attribute__((address_space(3))) bf16x8*)(kp + 2048); kf[3] = *(const __attribute__((address_space(3))) bf16x8*)(kp + 2560);
    kf[4] = *(const __attribute__((address_space(3))) bf16x8*)(kp + 4096); kf[5] = *(const __attribute__((address_space(3))) bf16x8*)(kp + 4608);
    kf[6] = *(const __attribute__((address_space(3))) bf16x8*)(kp + 6144); kf[7] = *(const __attribute__((address_space(3))) bf16x8*)(kp + 6656);
}
__device__ __forceinline__ void kload2(bf16x8* kf, lds_cptr kp, int j) { kf[2 * j] = *(const __attribute__((address_space(3))) bf16x8*)(kp + j * 2048); kf[2 * j + 1] = *(const __attribute__((address_space(3))) bf16x8*)(kp + j * 2048 + 512); }
__device__ __forceinline__ s16x4 vtr(lds_cptr p) { return __builtin_bit_cast(s16x4, __builtin_amdgcn_ds_read_tr16_b64_v4i16((__attribute__((address_space(3))) v4i16_t*)p)); }
__device__ __forceinline__ float rowmax(const f32x16& p0, const f32x16& p1) {
    float a = max3f(p0[0], p0[1], p1[0]), b = max3f(p0[2], p0[3], p1[1]); a = max3f(a, p1[2], p1[3]);
#pragma unroll
    for (int r = 4; r < 16; r += 4) { a = max3f(a, p0[r], p0[r + 1]); b = max3f(b, p0[r + 2], p0[r + 3]); a = max3f(a, p1[r], p1[r + 1]); b = max3f(b, p1[r + 2], p1[r + 3]); }
    const float m = max2f(a, b);
    auto rr = __builtin_amdgcn_permlane32_swap(__float_as_uint(m), __float_as_uint(m), false, false);
    return max2f(__uint_as_float(rr[0]), __uint_as_float(rr[1]));
}
__device__ __forceinline__ void pv(f32x16* o, int vb, bf16x8 pa0, bf16x8 pa1, bf16x8 pa2, bf16x8 pa3) {
#pragma unroll
    for (int d0 = 0; d0 < 2; ++d0) { s16x4 lo[4], hi[4];
#pragma unroll
        for (int ks = 0; ks < 4; ++ks) {
            asm volatile("ds_read_b64_tr_b16 %0,%1 offset:%c2" : "=&v"(lo[ks]) : "v"(vb), "i"(d0 * 4096 + ks * 1024) : "memory");
            asm volatile("ds_read_b64_tr_b16 %0,%1 offset:%c2" : "=&v"(hi[ks]) : "v"(vb), "i"(d0 * 4096 + ks * 1024 + 512) : "memory"); }
        asm volatile("s_waitcnt lgkmcnt(0)" ::: "memory"); SBAR();
#define PK(k) (bf16x8){lo[k][0], lo[k][1], lo[k][2], lo[k][3], hi[k][0], hi[k][1], hi[k][2], hi[k][3]}
        o[d0] = __builtin_amdgcn_mfma_f32_32x32x16_bf16(pa0, PK(0), o[d0], 0, 0, 0);
        o[d0] = __builtin_amdgcn_mfma_f32_32x32x16_bf16(pa1, PK(1), o[d0], 0, 0, 0);
        o[d0] = __builtin_amdgcn_mfma_f32_32x32x16_bf16(pa2, PK(2), o[d0], 0, 0, 0);
        o[d0] = __builtin_amdgcn_mfma_f32_32x32x16_bf16(pa3, PK(3), o[d0], 0, 0, 0);
#undef PK
    }
}
constexpr float NEGBIG = -1.0e30f;

template <int THRL> __device__ __forceinline__ void attn_unit(int b, int h, int qb, const bf16_t* Qg, const bf16_t* __restrict__ Kg, const bf16_t* __restrict__ Vg, bf16_t* Og, const float* __restrict__ kbar, char* shm) {
    int tid_ = threadIdx.x; asm volatile("" : "+v"(tid_));
    const int tid = tid_, lane = tid & 63, r32 = lane & 31, hi = lane >> 5; const int wid = __builtin_amdgcn_readfirstlane(tid >> 6);
    const long rowbase = (long)b * SEQ; const int q0 = qb * QB;
    const size_t hoff = (size_t)(b * 8 + h) * (SEQ * 64);
    const bf16_t* Qw = Qg + hoff + (size_t)(q0 + wid * QBLK) * 64;
    const bf16_t* Kh = Kg + hoff, *Vh = Vg + hoff;
    const unsigned lds0 = (unsigned)(uintptr_t)shm;
    float* wsf = (float*)(shm + LDS_WS) + wid * 64;
    const bf16_t* ksrc = Kh + wid * 512 + lane * 8;
    const bf16_t* vsrc = Vh + wid * 512 + lane * 8;
    const unsigned kdst = lds0 + LDS_K + wid * 1024, vdst = lds0 + LDS_V + wid * 1024;
    const int NT = 4 * qb + 4, NPAST = 4 * qb;
#define TMAP(t) (((t) < 4) ? (NPAST + (t)) : ((t) - 4))
#define DMA_K(t, slot) glds16(ksrc + (long)TMAP(t) * 4096, (unsigned)__builtin_amdgcn_readfirstlane(kdst + (slot)))
#define DMA_V(t, slot) glds16(vsrc + (long)TMAP(t) * 4096, (unsigned)__builtin_amdgcn_readfirstlane(vdst + (slot)))
    const char* Kbase = shm + LDS_K; bf16x8 kf[8];
    const lds_cptr shm3 = (lds_cptr)shm; const lds_cptr kp0 = shm3 + LDS_K + hi * 1024 + r32 * 16; const lds_cptr vp0 = shm3 + LDS_V + ((lane >> 4) & 1) * 32 + (lane & 3) * 8 + (4 * hi + ((lane & 15) >> 2)) * 64;
    DMA_K(0, 0); DMA_V(0, 0); DMA_K(1, SLOTB);
    bf16x8 qr[4];
#pragma unroll
    for (int d0 = 0; d0 < 4; ++d0) qr[d0] = *reinterpret_cast<const bf16x8*>(&Qw[(long)r32 * 64 + d0 * 16 + hi * 8]);
    unsigned selm = 0u;
    if (qb > 0) {
        float* kbl = (float*)(shm + LDS_KB);
        for (int i = tid; i < qb * 64; i += NW * 64) kbl[i] = kbar[((size_t)(b * 16 + (i >> 6)) * 8 + h) * 64 + (i & 63)];
        asm volatile("s_waitcnt vmcnt(0) lgkmcnt(0)\n\ts_barrier" ::: "memory");
        if (qb <= 3) selm = (1u << qb) - 1u;
        else {
            float qf[32];
#pragma unroll
            for (int d0 = 0; d0 < 4; ++d0)
#pragma unroll
                for (int j = 0; j < 8; ++j) qf[d0 * 8 + j] = bf2f((unsigned short)qr[d0][j]);
            float g[15];
#pragma unroll
            for (int n = 0; n < 15; ++n) { float s = 0.f;
                if (n < qb) {
#pragma unroll
                    for (int d0 = 0; d0 < 4; ++d0) { const f32x4 k0 = *(const f32x4*)(kbl + n * 64 + d0 * 16 + hi * 8), k1 = *(const f32x4*)(kbl + n * 64 + d0 * 16 + hi * 8 + 4);
                        s += qf[d0 * 8 + 0] * k0[0] + qf[d0 * 8 + 1] * k0[1] + qf[d0 * 8 + 2] * k0[2] + qf[d0 * 8 + 3] * k0[3] + qf[d0 * 8 + 4] * k1[0] + qf[d0 * 8 + 5] * k1[1] + qf[d0 * 8 + 6] * k1[2] + qf[d0 * 8 + 7] * k1[3]; }
                    s += __shfl_xor(s, 32);
                } else s = -INFINITY;
                g[n] = s; }
#pragma unroll
            for (int pass = 0; pass < 3; ++pass) { float best = -INFINITY; int bi = 0;
#pragma unroll
                for (int n = 0; n < 15; ++n) if (g[n] > best) { best = g[n]; bi = n; }
                selm |= 1u << bi;
#pragma unroll
                for (int n = 0; n < 15; ++n) if (n == bi) g[n] = -INFINITY; }
        }
    }
    float mhat = 0.f, l_reg = 0.f; f32x16 o[2]; o[0] = f32x16{}; o[1] = f32x16{}; f32x16 cini = f32x16{}; asm volatile("" : "+v"(cini));
    const int qrel = wid * QBLK + r32;
#define SETC(t, JB) do { const float cm_ = ((JB >= 0) || ((selm >> (((t) - 4) >> 2)) & 1u)) ? -mhat : NEGBIG; \
      _Pragma("unroll") for (int r = 0; r < 16; ++r) cini[r] = cm_; asm volatile("" : "+v"(cini)); } while (0)
    bool resc = false;
#define START(P0, P1) do { const float rm = rowmax(P0, P1); resc = false; \
    { const float dl = rm; mhat = fadd_s(mhat, dl); \
      _Pragma("unroll") for (int r = 0; r < 16; ++r) { P0[r] = fsub_s(P0[r], dl); P1[r] = fsub_s(P1[r], dl); } } \
    _Pragma("unroll") for (int r = 0; r < 16; ++r) P0[r] = __builtin_amdgcn_exp2f(P0[r]); } while (0)
#define RESC() do { if (resc) { asm volatile("s_waitcnt lgkmcnt(0)" ::: "memory"); \
      _Pragma("unroll") for (int d_ = 0; d_ < 2; ++d_) _Pragma("unroll") for (int r = 0; r < 16; ++r) o[d_][r] *= wsf[crow(r, hi)]; } } while (0)
    f32x16 pA0, pA1, pB0, pB1;
    int sl_prev = 0, sl_cur = 0, sl_next = SLOTB;
#define ROT() do { sl_prev = sl_cur; sl_cur = sl_next; sl_next = (sl_next == (NSLOT - 1) * SLOTB) ? 0 : sl_next + SLOTB; } while (0)
    DMA_K(2, 2 * SLOTB);
    if (qb > 0) { WAIT_BAR(0); } else { WAIT_BAR(3); }
    qkt(pA0, pA1, Kbase, qr, cini, r32, hi); asm volatile("s_nop 15\n\ts_nop 7" : "+v"(pA0), "+v"(pA1)); cmask(pA0, pA1, 0, qrel, hi);
    START(pA0, pA1);
    _Pragma("unroll") for (int r = 0; r < 16; ++r) pA1[r] = __builtin_amdgcn_exp2f(pA1[r]);
    WAIT_BAR(0);
    DMA_K(3, 0); DMA_V(1, SLOTB);
    ROT();
    kload8(kf, kp0 + sl_cur);
    WAIT_BAR(2);
    s16x4 vlo[8], vhi[8]; u32x4 pw0, pw1, pw2, pw3;
#define PKW(P, B) cvtpk_s(P[B], P[B + 1])
#define PAF(k) __builtin_bit_cast(bf16x8, pw##k)
#define VFR(i) (bf16x8){vlo[i][0], vlo[i][1], vlo[i][2], vlo[i][3], vhi[i][0], vhi[i][1], vhi[i][2], vhi[i][3]}
#define PIN(x) asm volatile("" : "+v"(x))
#define MX3(a, b, c) __builtin_fmaxf(__builtin_fmaxf((a), (b)), (c))
#define GAPA(MF, A0, A1, A2, A3, W0, W1, PW) do { MF; sacc += A0; sacc += A1; sacc += A2; sacc += A3; PIN(sacc); W0; W1; PIN(PW); SBAR(); } while (0)
#define EX(v) __builtin_amdgcn_exp2f(v)
#define GAPB(MF, X, B) do { MF; X[B] = EX(X[B]); X[B + 1] = EX(X[B + 1]); X[B + 2] = EX(X[B + 2]); X[B + 3] = EX(X[B + 3]); PIN(X); SBAR(); } while (0)
#define VRD(i) do { vlo[i] = vtr(vp_ + (((i) >> 2) * 4096 + ((i) & 3) * 1024)); vhi[i] = vtr(vp_ + (((i) >> 2) * 4096 + ((i) & 3) * 1024 + 512)); } while (0)
#define KRD(G, j) do { if (G) { kload2(kf, kp0 + sl_next, j); SBAR(); } } while (0)
#define STEP(C0, C1, P0, P1, t, GK, GV, GL, JB) do { SETC(t, JB); SBAR(); \
    const lds_cptr vp_ = vp0 + sl_prev; \
    VRD(0); SBAR(); float sacc = (P0[0] + P0[1]); \
    GAPA(C0 = __builtin_amdgcn_mfma_f32_32x32x16_bf16(kf[0], qr[0], cini, 0, 0, 0), P0[2], P0[3], P0[4], P0[5],     pw0[0] = PKW(P0, 0), pw0[1] = PKW(P0, 2), pw0); \
    VRD(4); SBAR(); GAPA(C1 = __builtin_amdgcn_mfma_f32_32x32x16_bf16(kf[1], qr[0], cini, 0, 0, 0), P0[6], P0[7], P0[8], P0[9],     pw0[2] = PKW(P0, 4), pw0[3] = PKW(P0, 6), pw0); \
    VRD(1); SBAR(); GAPA(C0 = __builtin_amdgcn_mfma_f32_32x32x16_bf16(kf[2], qr[1], C0, 0, 0, 0),   P0[10], P0[11], P0[12], P0[13], pw1[0] = PKW(P0, 8), pw1[1] = PKW(P0, 10), pw1); \
    VRD(5); SBAR(); GAPA(C1 = __builtin_amdgcn_mfma_f32_32x32x16_bf16(kf[3], qr[1], C1, 0, 0, 0),   P0[14], P0[15], P1[0], P1[1],   pw1[2] = PKW(P0, 12), pw1[3] = PKW(P0, 14), pw1); \
    VRD(2); SBAR(); GAPA(C0 = __builtin_amdgcn_mfma_f32_32x32x16_bf16(kf[4], qr[2], C0, 0, 0, 0),   P1[2], P1[3], P1[4], P1[5],     pw2[0] = PKW(P1, 0), pw2[1] = PKW(P1, 2), pw2); \
    VRD(6); SBAR(); GAPA(C1 = __builtin_amdgcn_mfma_f32_32x32x16_bf16(kf[5], qr[2], C1, 0, 0, 0),   P1[6], P1[7], P1[8], P1[9],     pw2[2] = PKW(P1, 4), pw2[3] = PKW(P1, 6), pw2); \
    VRD(3); SBAR(); GAPA(C0 = __builtin_amdgcn_mfma_f32_32x32x16_bf16(kf[6], qr[3], C0, 0, 0, 0),   P1[10], P1[11], P1[12], P1[13], pw3[0] = PKW(P1, 8), pw3[1] = PKW(P1, 10), pw3); \
    VRD(7); SBAR(); GAPA(C1 = __builtin_amdgcn_mfma_f32_32x32x16_bf16(kf[7], qr[3], C1, 0, 0, 0),   P1[14], P1[15], 0.f, 0.f,       pw3[2] = PKW(P1, 12), pw3[3] = PKW(P1, 14), pw3); \
    l_reg += sacc; \
    if (GK) { DMA_K((t) + 3, sl_cur); } if (GV) { DMA_V((t) + 1, sl_next); } \
    if (JB >= 0) cmask(C0, C1, JB, qrel, hi); \
    { float a = MX3(C0[0], C0[1], C1[0]), b_ = MX3(C0[2], C0[3], C1[1]); a = MX3(a, C1[2], C1[3]); \
      _Pragma("unroll") for (int r = 4; r < 16; r += 4) { a = MX3(a, C0[r], C0[r + 1]); b_ = MX3(b_, C0[r + 2], C0[r + 3]); a = MX3(a, C1[r], C1[r + 1]); b_ = MX3(b_, C1[r + 2], C1[r + 3]); } \
      float rm = __builtin_fmaxf(a, b_); { auto rr = __builtin_amdgcn_permlane32_swap(__float_as_uint(rm), __float_as_uint(rm), false, false); rm = __builtin_fmaxf(__uint_as_float(rr[0]), __uint_as_float(rr[1])); } \
      resc = false; \
      if (__builtin_expect(__any(rm > (float)THRL), 0)) { const float dl = __builtin_fmaxf(rm, 0.f); mhat += dl; \
        _Pragma("unroll") for (int r = 0; r < 16; ++r) { C0[r] -= dl; C1[r] -= dl; } \
        const float f = __builtin_amdgcn_exp2f(-dl); l_reg *= f; if (hi == 0) wsf[r32] = f; resc = true; } } \
    SBAR(); \
    GAPB(o[0] = __builtin_amdgcn_mfma_f32_32x32x16_bf16(PAF(0), VFR(0), o[0], 0, 0, 0), C0, 0); \
    GAPB(o[1] = __builtin_amdgcn_mfma_f32_32x32x16_bf16(PAF(0), VFR(4), o[1], 0, 0, 0), C0, 4); \
    KRD(GL, 0); GAPB(o[0] = __builtin_amdgcn_mfma_f32_32x32x16_bf16(PAF(1), VFR(1), o[0], 0, 0, 0), C0, 8); \
    KRD(GL, 1); GAPB(o[1] = __builtin_amdgcn_mfma_f32_32x32x16_bf16(PAF(1), VFR(5), o[1], 0, 0, 0), C0, 12); \
    KRD(GL, 2); GAPB(o[0] = __builtin_amdgcn_mfma_f32_32x32x16_bf16(PAF(2), VFR(2), o[0], 0, 0, 0), C1, 0); \
    KRD(GL, 3); GAPB(o[1] = __builtin_amdgcn_mfma_f32_32x32x16_bf16(PAF(2), VFR(6), o[1], 0, 0, 0), C1, 4); \
    GAPB(o[0] = __builtin_amdgcn_mfma_f32_32x32x16_bf16(PAF(3), VFR(3), o[0], 0, 0, 0), C1, 8); \
    GAPB(o[1] = __builtin_amdgcn_mfma_f32_32x32x16_bf16(PAF(3), VFR(7), o[1], 0, 0, 0), C1, 12); \
    } while (0)
#define ENDW(tt) do { if ((tt) + 3 < NT) { WAIT_BAR(2); } else if ((tt) + 2 < NT) { WAIT_BAR(1); } else { WAIT_BAR(0); } } while (0)
    STEP(pB0, pB1, pA0, pA1, 1, (4 < NT), true, true, 1);   ENDW(1); RESC(); ROT();
    STEP(pA0, pA1, pB0, pB1, 2, (5 < NT), true, true, 2);   ENDW(2); RESC(); ROT();
    STEP(pB0, pB1, pA0, pA1, 3, (6 < NT), (4 < NT), (4 < NT), 3);   ENDW(3); RESC(); ROT();
    int t = 4;
    for (; t + 4 < NT; t += 2) {
        STEP(pA0, pA1, pB0, pB1, t, true, true, true, -1);       WAIT_BAR(2); RESC(); ROT();
        STEP(pB0, pB1, pA0, pA1, t + 1, true, true, true, -1);   WAIT_BAR(2); RESC(); ROT();
    }
    for (; t < NT; t += 2) {
        STEP(pA0, pA1, pB0, pB1, t, (t + 3 < NT), true, true, -1);                       ENDW(t);     RESC(); ROT();
        STEP(pB0, pB1, pA0, pA1, t + 1, (t + 4 < NT), (t + 2 < NT), (t + 2 < NT), -1);   ENDW(t + 1); RESC(); ROT();
    }
    { float sacc = pB0[0] + pB0[1]; _Pragma("unroll") for (int r = 2; r < 16; ++r) sacc += pB0[r]; _Pragma("unroll") for (int r = 0; r < 16; ++r) sacc += pB1[r]; l_reg += sacc;
      pw0 = (u32x4){PKW(pB0, 0), PKW(pB0, 2), PKW(pB0, 4), PKW(pB0, 6)}; pw1 = (u32x4){PKW(pB0, 8), PKW(pB0, 10), PKW(pB0, 12), PKW(pB0, 14)}; pw2 = (u32x4){PKW(pB1, 0), PKW(pB1, 2), PKW(pB1, 4), PKW(pB1, 6)}; pw3 = (u32x4){PKW(pB1, 8), PKW(pB1, 10), PKW(pB1, 12), PKW(pB1, 14)};
      SBAR(); pv(o, (int)(unsigned long)vp0 + sl_prev, PAF(0), PAF(1), PAF(2), PAF(3)); }
#undef PKW
#undef PAF
#undef VFR
#undef PIN
#undef MX3
#undef GAPA
#undef GAPB
#undef EX
#undef VRD
#undef KRD
#undef STEP
#undef ENDW
    { auto rr = __builtin_amdgcn_permlane32_swap(__float_as_uint(l_reg), __float_as_uint(l_reg), false, false); l_reg = __uint_as_float(rr[0]) + __uint_as_float(rr[1]); }
    if (hi == 0) wsf[32 + r32] = l_reg; asm volatile("s_waitcnt lgkmcnt(0)" ::: "memory");
    float rli[16];
#pragma unroll
    for (int r = 0; r < 16; ++r) rli[r] = __builtin_amdgcn_rcpf(wsf[32 + crow(r, hi)]);
    bf16_t* Ow = Og + (rowbase + q0 + wid * QBLK) * DMO + h * HD;
    { bf16_t* stg = (bf16_t*)(shm + LDS_OST) + wid * 2048;
#pragma unroll
      for (int r = 0; r < 16; ++r) { const int orow = crow(r, hi);
#pragma unroll
        for (int d0 = 0; d0 < 2; ++d0) stg[orow * 64 + d0 * 32 + r32] = (bf16_t)f2bf(o[d0][r] * rli[r]); }
      asm volatile("s_waitcnt lgkmcnt(0)" ::: "memory");
#pragma unroll
      for (int i = 0; i < 4; ++i) { const int row = i * 8 + (lane >> 3), ch = lane & 7; const u32x4 v = *(const u32x4*)(stg + row * 64 + ch * 8); *(u32x4*)(Ow + (long)row * DMO + ch * 8) = v; } }
    asm volatile("s_waitcnt lgkmcnt(0)\n\ts_barrier" ::: "memory");
#undef DMA_K
#undef DMA_V
#undef TMAP
#undef SETC
#undef START
#undef RESC
#undef ROT
}
#undef SBAR
#undef WAIT_BAR
}

namespace hgrn {
constexpr int RS = 144;
constexpr int R_FQV = 0, FQV_SLOT = 32768;
constexpr int L_Q = 98304, L_K = L_Q + 9216, L_KT = L_K + 9216, L_VT = L_KT + 9216, L_ST = L_VT + 9216, L_SEG = L_ST + 9216, L_DEND = L_SEG + 2048, L_SSQ = L_DEND + 256, L_BYTES = L_SSQ + 512;
__device__ __forceinline__ int crow(int r, int hi) { return (r & 3) + 8 * (r >> 2) + 4 * hi; }
__device__ __forceinline__ void glds16(const void* gsrc, unsigned lds_dst) { unsigned keep;
    asm volatile("s_mov_b32 %0, m0\n\ts_mov_b32 m0, %2\n\ts_nop 0\n\tglobal_load_lds_dwordx4 %1, off\n\ts_mov_b32 m0, %0" : "=&s"(keep) : "v"(gsrc), "s"(lds_dst) : "memory"); }
#define HG_BAR() do { asm volatile("s_waitcnt lgkmcnt(0)" ::: "memory"); __builtin_amdgcn_s_barrier(); asm volatile("" ::: "memory"); } while (0)
#ifndef HG_ABL
#define HG_ABL 0
#endif
__device__ __forceinline__ void hgrn_unit(int b, int h, const bf16_t* __restrict__ proj, bf16_t* __restrict__ mix, const float* __restrict__ lb_logits, const float* __restrict__ norm_g, LAS unsigned char* lds, const int abl = 0) {
    int tid_ = threadIdx.x; asm volatile("" : "+v"(tid_));
    const int tid = tid_, lane = tid & 63, r32 = lane & 31, hi = lane >> 5; const int w = __builtin_amdgcn_readfirstlane(tid >> 6);
    const float lbk = fast_rcp(1.0f + fast_exp2((lb_logits[512 + h * 64 + lane] - lb_logits[h * 64 + lane]) * LOG2E));
    const int vr = (w >> 1) & 1, tc = w & 1;
    float ng[16];
#pragma unroll
    for (int r = 0; r < 16; ++r) ng[r] = norm_g[h * 64 + 32 * vr + crow(r, hi)];
    f32x16 S = f32x16{};
    for (int i = tid; i < 64 * RS / 4; i += 512) ((LAS unsigned*)(lds + L_ST))[i] = 0u;
    const size_t hoff = (size_t)(b * 8 + h) * (SEQ * 64) + (size_t)w * 512 + lane * 8;
    const bf16_t* gQ = proj + 3 * SEC_ELEMS + hoff; const bf16_t* gF = proj + 4 * SEC_ELEMS + hoff; const bf16_t* gV = proj + 5 * SEC_ELEMS + hoff; const bf16_t* gG = proj + 6 * SEC_ELEMS + hoff;
    const unsigned lds0 = (unsigned)(uintptr_t)(unsigned char*)lds;
#define DMA_FQV(c_) do { const int cc_ = (c_) < 63 ? (c_) : 63; const unsigned d_ = (unsigned)__builtin_amdgcn_readfirstlane(lds0 + R_FQV + (unsigned)(((c_) % 3) * FQV_SLOT) + (unsigned)w * 1024u); \
        glds16(gF + (size_t)cc_ * 4096, d_); glds16(gQ + (size_t)cc_ * 4096, d_ + 8192u); glds16(gV + (size_t)cc_ * 4096, d_ + 16384u); } while (0)
#define DMA_G(c_) do { const int cc_ = (c_) < 63 ? (c_) : 63; glds16(gG + (size_t)cc_ * 4096, (unsigned)__builtin_amdgcn_readfirstlane(lds0 + R_FQV + (unsigned)(((c_) % 3) * FQV_SLOT) + 24576u + (unsigned)w * 1024u)); } while (0)
    DMA_FQV(0); DMA_G(0); DMA_FQV(1); DMA_G(1); DMA_FQV(2);
    for (int c = 0; c < 64; ++c) {
        const size_t row0 = (size_t)b * SEQ + (size_t)c * 64;
        if (abl & 8) {} else if (w < 4 && c >= 3) asm volatile("s_waitcnt vmcnt(20)" ::: "memory");
        else asm volatile("s_waitcnt vmcnt(8)" ::: "memory");
        const LAS unsigned char* raw = lds + R_FQV + (c % 3) * FQV_SLOT + (8 * w) * 128 + lane * 2;
        float p[8], kk[8];
        { float run = 0.f;
#pragma unroll
          for (int i = 0; i < 8; ++i) { const float x = bf2f(*(const LAS unsigned short*)(raw + i * 128)); float f, lg;
              if (abl & 2) { f = 0.5f + 0.001f * x; lg = -1.0f + 0.001f * x; } else { const float sg = fast_rcp(1.0f + fast_exp2(-x * LOG2E)); f = lbk + (1.0f - lbk) * sg; lg = __builtin_amdgcn_logf(f); }
              run += lg; p[i] = run; kk[i] = 1.0f - f; } }
        ((LAS float*)(lds + L_SEG))[w * 64 + lane] = p[7];
        HG_BAR();
        if (!(abl & 8)) DMA_G(c + 2);
        { float off = 0.f;
#pragma unroll
          for (int j = 0; j < 7; ++j) { const float sv = ((LAS float*)(lds + L_SEG))[j * 64 + lane]; off += (j < w) ? sv : 0.f; }
          unsigned kq[4], vq[4];
#pragma unroll
          for (int i = 0; i < 8; i += 2) { const float b0 = off + p[i], b1 = off + p[i + 1];
              const unsigned short q0r = *(const LAS unsigned short*)(raw + 8192 + i * 128), q1r = *(const LAS unsigned short*)(raw + 8192 + (i + 1) * 128);
              const unsigned short v0r = *(const LAS unsigned short*)(raw + 16384 + i * 128), v1r = *(const LAS unsigned short*)(raw + 16384 + (i + 1) * 128);
              const float q0 = bf2f(q0r) * fast_exp2(b0), q1 = bf2f(q1r) * fast_exp2(b1), k0 = kk[i] * fast_exp2(-b0), k1 = kk[i + 1] * fast_exp2(-b1);
              const unsigned qq = cvtpk(q0, q1), kw = cvtpk(k0, k1); kq[i >> 1] = kw; vq[i >> 1] = (unsigned)v0r | ((unsigned)v1r << 16);
              if (abl & 4) continue;
              *(LAS unsigned short*)(lds + L_Q + (8 * w + i) * RS + lane * 2) = (unsigned short)(qq & 0xffffu);
              *(LAS unsigned short*)(lds + L_Q + (8 * w + i + 1) * RS + lane * 2) = (unsigned short)(qq >> 16);
              *(LAS unsigned short*)(lds + L_K + (8 * w + i) * RS + lane * 2) = (unsigned short)(kw & 0xffffu);
              *(LAS unsigned short*)(lds + L_K + (8 * w + i + 1) * RS + lane * 2) = (unsigned short)(kw >> 16); }
          *(LAS u32x4*)(lds + L_KT + lane * RS + 16 * w) = (u32x4){kq[0], kq[1], kq[2], kq[3]};
          *(LAS u32x4*)(lds + L_VT + lane * RS + 16 * w) = (u32x4){vq[0], vq[1], vq[2], vq[3]};
          if (w == 7) ((LAS float*)(lds + L_DEND))[lane] = fast_exp2(off + p[7]); }
        if (!(abl & 8)) DMA_FQV(c + 3);
        if (abl & 8) {} else if (w < 4 && c >= 2) asm volatile("s_waitcnt vmcnt(19)" ::: "memory");
        else asm volatile("s_waitcnt vmcnt(11)" ::: "memory");
        HG_BAR();
        f32x16 OT = f32x16{};
        if (abl & 1) { OT[0] = (float)c; } else
        if (w < 4) {
            bf16x8 bq[4];
#pragma unroll
            for (int ks = 0; ks < 4; ++ks) bq[ks] = *(const LAS bf16x8*)(lds + L_Q + (32 * tc + r32) * RS + (16 * ks + 8 * hi) * 2);
#pragma unroll
            for (int sr = 0; sr < 2; ++sr) if (sr <= tc) {
                f32x16 at = f32x16{};
#pragma unroll
                for (int ks = 0; ks < 4; ++ks) { const bf16x8 a = *(const LAS bf16x8*)(lds + L_K + (32 * sr + r32) * RS + (16 * ks + 8 * hi) * 2); at = __builtin_amdgcn_mfma_f32_32x32x16_bf16(a, bq[ks], at, 0, 0, 0); }
                if (sr == tc) {
#pragma unroll
                    for (int r = 0; r < 16; ++r) at[r] = (crow(r, hi) <= r32) ? at[r] : 0.f; }
#pragma unroll
                for (int st = 0; st < 2; ++st) {
                    u32x4 bw; bw.x = cvtpk(at[8 * st + 0], at[8 * st + 1]); bw.y = cvtpk(at[8 * st + 2], at[8 * st + 3]); bw.z = cvtpk(at[8 * st + 4], at[8 * st + 5]); bw.w = cvtpk(at[8 * st + 6], at[8 * st + 7]);
                    const u32x2 lo = *(const LAS u32x2*)(lds + L_VT + (32 * vr + r32) * RS + (32 * sr + 16 * st + 4 * hi) * 2);
                    const u32x2 hh = *(const LAS u32x2*)(lds + L_VT + (32 * vr + r32) * RS + (32 * sr + 16 * st + 8 + 4 * hi) * 2);
                    const u32x4 aw = (u32x4){lo.x, lo.y, hh.x, hh.y};
                    OT = __builtin_amdgcn_mfma_f32_32x32x16_bf16(__builtin_bit_cast(bf16x8, aw), __builtin_bit_cast(bf16x8, bw), OT, 0, 0, 0); }
            }
#pragma unroll
            for (int ks = 0; ks < 4; ++ks) { const bf16x8 a = *(const LAS bf16x8*)(lds + L_ST + (32 * vr + r32) * RS + (16 * ks + 8 * hi) * 2); OT = __builtin_amdgcn_mfma_f32_32x32x16_bf16(a, bq[ks], OT, 0, 0, 0); }
            float sq = 0.f;
#pragma unroll
            for (int r = 0; r < 16; ++r) sq += OT[r] * OT[r];
            sq += __shfl_xor(sq, 32);
            if (hi == 0) ((LAS float*)(lds + L_SSQ))[vr * 64 + 32 * tc + r32] = sq;
        } else {
#pragma unroll
            for (int st = 0; st < 4; ++st) { const bf16x8 a = *(const LAS bf16x8*)(lds + L_KT + (32 * vr + r32) * RS + (16 * st + 8 * hi) * 2);
                const bf16x8 bv = *(const LAS bf16x8*)(lds + L_VT + (32 * tc + r32) * RS + (16 * st + 8 * hi) * 2);
                S = __builtin_amdgcn_mfma_f32_32x32x16_bf16(a, bv, S, 0, 0, 0); }
#pragma unroll
            for (int r = 0; r < 16; ++r) S[r] *= ((LAS float*)(lds + L_DEND))[32 * vr + crow(r, hi)];
        }
        HG_BAR();
        if (w < 4) {
            const int t = 32 * tc + r32;
            const float tot = ((LAS float*)(lds + L_SSQ))[t] + ((LAS float*)(lds + L_SSQ))[64 + t];
            const float rstd = __builtin_amdgcn_rsqf(tot * (1.0f / 64.0f) + EPS);
            const LAS unsigned char* gp = lds + R_FQV + (c % 3) * FQV_SLOT + 24576 + t * 128 + (32 * vr + 4 * hi) * 2;
            bf16_t* op = mix + (row0 + t) * D + 512 + h * 64 + 32 * vr + 4 * hi;
#pragma unroll
            for (int g = 0; g < 4; ++g) { const u32x2 gg = *(const LAS u32x2*)(gp + 16 * g);
                const float y0 = OT[4 * g + 0] * rstd * ng[4 * g + 0] * bflo(gg.x), y1 = OT[4 * g + 1] * rstd * ng[4 * g + 1] * bfhi(gg.x),
                            y2 = OT[4 * g + 2] * rstd * ng[4 * g + 2] * bflo(gg.y), y3 = OT[4 * g + 3] * rstd * ng[4 * g + 3] * bfhi(gg.y);
                const u32x2 yv = (u32x2){cvtpk(y0, y1), cvtpk(y2, y3)}; if (!(abl & 16)) asm volatile("global_store_dwordx2 %0, %1, off" :: "v"(op + 8 * g), "v"(yv) : "memory"); }
        } else {
#pragma unroll
            for (int g = 0; g < 4; ++g) *(LAS u32x2*)(lds + L_ST + (32 * tc + r32) * RS + (32 * vr + 8 * g + 4 * hi) * 2) = (u32x2){cvtpk(S[4 * g + 0], S[4 * g + 1]), cvtpk(S[4 * g + 2], S[4 * g + 3])};
        }
    }
    asm volatile("s_waitcnt vmcnt(0)" ::: "memory");
    HG_BAR();
#undef DMA_FQV
#undef DMA_G
}
#undef HG_BAR
}

constexpr int NWAVES = 8;
constexpr int LDS_BYTES = 163840;
constexpr int TAIL = 161792;
constexpr int TL_TE = TAIL, TL_TS = TAIL + 576, TL_HIST = TAIL + 768, TL_BASE = TAIL + 896, TL_MISC = TAIL + 1024, TL_CNT = TAIL + 1280;
typedef GAS unsigned gu32;

struct Args { const float* in[20]; float* out; unsigned char* ws; int ph_lo, ph_hi; };

struct Frame {
    LAS unsigned char* lds; volatile LAS unsigned* MISC; unsigned* ctl;
    int tid, lane, wave, G, vcu;
};

struct P0Item { const float* W; bf16_t* WT; const float* gain; int N, K, k0, n0, mode; };
__device__ __forceinline__ bool p0_decode(const Args& a, int it, P0Item& I) {
    unsigned char* ws = a.ws;
    constexpr int I_IN = 16 * 56, I_SQ = 16 * 16, I_KV = 16 * 32, I_W1 = 16 * 32, I_W2 = 16 * 16;
    constexpr int NITEMS = I_IN + 2 * I_SQ + I_KV + NEXP * (I_W1 + I_W2);
    if (it >= NITEMS) return false;
    int r = it; I.gain = nullptr; I.mode = 0; I.K = D;
    if (r < I_IN) { I.W = a.in[3]; I.WT = (bf16_t*)(ws + WS_WIN); I.N = INC; }
    else if ((r -= I_IN) < I_SQ) { I.W = a.in[6]; I.WT = (bf16_t*)(ws + WS_WOUT); I.N = D; }
    else if ((r -= I_SQ) < I_KV) { I.W = a.in[10]; I.WT = (bf16_t*)(ws + WS_WKV); I.N = 2 * D; }
    else if ((r -= I_KV) < I_SQ) { I.W = a.in[11]; I.WT = (bf16_t*)(ws + WS_WO); I.N = D; }
    else if ((r -= I_SQ) < NEXP * I_W1) { const int e = r / I_W1; r -= e * I_W1; I.W = a.in[15] + (size_t)e * D * 2048; I.WT = (bf16_t*)(ws + WS_W1 + (size_t)e * 2048 * D); I.N = 2048; I.gain = a.in[12]; I.mode = 3; }
    else { r -= NEXP * I_W1; const int e = r / I_W2; r -= e * I_W2; I.W = a.in[17] + (size_t)e * D * D; I.WT = (bf16_t*)(ws + WS_W2 + (size_t)e * D * D); I.N = D; I.mode = 2; }
    const int nblk = I.N / 64; I.k0 = 64 * (r / nblk); I.n0 = 64 * (r % nblk); return true;
}
__device__ __forceinline__ void p0_load(const P0Item& I, f32x4 (&v)[16], int lane) {
    const float* p = I.W + (size_t)(I.k0 + (lane >> 4)) * I.N + I.n0 + 4 * (lane & 15);
#pragma unroll
    for (int j = 0; j < 16; ++j) v[j] = __builtin_nontemporal_load((const f32x4*)(p + (size_t)(4 * j) * I.N));
}
__device__ __forceinline__ void p0_store(const P0Item& I, const f32x4 (&v)[16], LAS unsigned char* tl, int lane) {
    const int kr = lane >> 4, nq = lane & 15;
#pragma unroll
    for (int j = 0; j < 16; ++j) { const int k = 4 * j + kr; const float g = I.gain ? I.gain[I.k0 + k] : 1.0f;
        *(LAS u32x2*)(tl + k * 128 + (((nq >> 1) ^ ((k >> 3) & 7)) * 16) + (nq & 1) * 8) = (u32x2){pk2(v[j].x * g, v[j].y * g), pk2(v[j].z * g, v[j].w * g)}; }
    LDS_WAIT(); asm volatile("" ::: "memory");
    const int c = lane & 7;
#pragma unroll
    for (int i = 0; i < 8; ++i) { const int n = (lane >> 3) + 8 * i; const LAS unsigned char* sp = tl + (8 * c) * 128 + ((i ^ c) * 16) + (n & 7) * 2;
        unsigned short e[8];
#pragma unroll
        for (int q = 0; q < 8; ++q) e[q] = *(const LAS unsigned short*)(sp + q * 128);
        int row = I.n0 + n; if (I.mode & 1) { const int jj = row >> 1, bj = row & 1; row = (jj >> 7) * 256 + bj * 128 + (jj & 127); }
        if (I.mode & 2) *(u32x2*)((unsigned char*)I.WT + (size_t)row * I.K + I.k0 + 8 * c) = (u32x2){pk4_fp8(bf2f(e[0]) * WSCALE8, bf2f(e[1]) * WSCALE8, bf2f(e[2]) * WSCALE8, bf2f(e[3]) * WSCALE8), pk4_fp8(bf2f(e[4]) * WSCALE8, bf2f(e[5]) * WSCALE8, bf2f(e[6]) * WSCALE8, bf2f(e[7]) * WSCALE8)};
        else *(u32x4*)(I.WT + (size_t)row * I.K + I.k0 + 8 * c) = (u32x4){(unsigned)e[0] | ((unsigned)e[1] << 16), (unsigned)e[2] | ((unsigned)e[3] << 16), (unsigned)e[4] | ((unsigned)e[5] << 16), (unsigned)e[6] | ((unsigned)e[7] << 16)}; }
    LDS_WAIT(); asm volatile("" ::: "memory");
}
__device__ __forceinline__ void rms_rows2_to_bf16(const float* __restrict__ x0, const float* __restrict__ x1, const float* __restrict__ g, bf16_t* __restrict__ o0, bf16_t* __restrict__ o1, int lane) {
    const f32x4* xa = (const f32x4*)x0 + lane; const f32x4* xb = (const f32x4*)x1 + lane; const f32x4* gr = (const f32x4*)g + lane;
    f32x4 va[4], vb[4]; float sa = 0.f, sb = 0.f;
#pragma unroll
    for (int j = 0; j < 4; ++j) { va[j] = xa[64 * j]; vb[j] = xb[64 * j]; }
#pragma unroll
    for (int j = 0; j < 4; ++j) { sa += (va[j].x * va[j].x + va[j].y * va[j].y) + (va[j].z * va[j].z + va[j].w * va[j].w); sb += (vb[j].x * vb[j].x + vb[j].y * vb[j].y) + (vb[j].z * vb[j].z + vb[j].w * vb[j].w); }
    const float ra = 1.0f / sqrtf(wave_sum(sa) * (1.0f / D) + EPS), rb = 1.0f / sqrtf(wave_sum(sb) * (1.0f / D) + EPS);
    unsigned long long* pa = (unsigned long long*)o0 + lane; unsigned long long* pb = (unsigned long long*)o1 + lane;
#pragma unroll
    for (int j = 0; j < 4; ++j) { const f32x4 gg = gr[64 * j];
        pa[64 * j] = (unsigned long long)pk2(va[j].x * ra * gg.x, va[j].y * ra * gg.y) | ((unsigned long long)pk2(va[j].z * ra * gg.z, va[j].w * ra * gg.w) << 32);
        pb[64 * j] = (unsigned long long)pk2(vb[j].x * rb * gg.x, vb[j].y * rb * gg.y) | ((unsigned long long)pk2(vb[j].z * rb * gg.z, vb[j].w * rb * gg.w) << 32); }
}

__device__ __forceinline__ void p0_prologue(Frame& F, const Args& a) {
    unsigned char* ws = a.ws;
    LAS unsigned char* tl = F.lds + F.wave * 8192;
    const int gw = F.vcu * NWAVES + F.wave, NGW = F.G * NWAVES;
    for (int m = 2 * gw; m < T; m += 2 * NGW) rms_rows2_to_bf16(a.in[0] + (size_t)m * D, a.in[0] + (size_t)(m + 1) * D, a.in[2], (bf16_t*)(ws + WS_XN) + (size_t)m * D, (bf16_t*)(ws + WS_XN) + (size_t)(m + 1) * D, F.lane);
    for (int m = 2 * gw; m < MROWS; m += 2 * NGW) rms_rows2_to_bf16(a.in[1] + (size_t)m * D, a.in[1] + (size_t)(m + 1) * D, a.in[8], (bf16_t*)(ws + WS_MN) + (size_t)m * D, (bf16_t*)(ws + WS_MN) + (size_t)(m + 1) * D, F.lane);
    for (int i = gw * 64 + F.lane; i < D * D / 4; i += NGW * 64) { const f32x4 w = ((const f32x4*)a.in[9])[i]; const float g = a.in[7][i >> 8];
        ((u32x2*)(ws + WS_WQ))[i] = (u32x2){pk2(w.x * g, w.y * g), pk2(w.z * g, w.w * g)}; }
    for (int i = gw * 64 + F.lane; i < NEXP * D; i += NGW * 64) { const int e = i >> 10, k = i & 1023; const float w = a.in[12][k] * a.in[13][k * NEXP + e];
        const unsigned hi = f2bf(w); ((bf16_t*)(ws + WS_WRT))[i] = (bf16_t)hi; ((bf16_t*)(ws + WS_WRT))[NEXP * D + i] = (bf16_t)f2bf(w - bf2f((unsigned short)hi)); }
    P0Item IA, IB; f32x4 va[16], vb[16];
    int it = gw; bool ha = p0_decode(a, it, IA); if (ha) p0_load(IA, va, F.lane);
    while (ha) {
        const bool hb = p0_decode(a, it + NGW, IB); if (hb) p0_load(IB, vb, F.lane);
        p0_store(IA, va, tl, F.lane);
        if (!hb) break;
        it += 2 * NGW; ha = p0_decode(a, it, IA); if (ha) p0_load(IA, va, F.lane);
        p0_store(IB, vb, tl, F.lane);
    }
}

__device__ __forceinline__ unsigned xcc_id() { return (unsigned)__builtin_amdgcn_s_getreg((3 << 11) | 20) & 0xFu; }
constexpr int QITEMS = 16 + 128;
__device__ __forceinline__ void p2_mixer(Frame& F, const Args& a, int rep) {
    unsigned char* ws = a.ws;
    const bf16_t* proj = (const bf16_t*)(ws + WS_PROJ); bf16_t* mix = (bf16_t*)(ws + WS_MIX);
    const unsigned x0 = xcc_id() & 7u;
    int par = 0;
#ifdef MK_P2_REPMODE
    if (rep && MK_P2_REPMODE == 4) return;
#endif
#ifdef MK_P2_HALF
    if (rep && (blockIdx.x & 8)) return;
#endif
    for (;;) {
        if (F.tid == 0) { int code = -1;
            for (int j = 0; j < 8; ++j) { const unsigned xq = (x0 + j) & 7u; const unsigned i = __hip_atomic_fetch_add(F.ctl + CW_QUEUE + 1024 * rep + 64 * xq, 1u, RLX_AGENT);
                if (i < (unsigned)QITEMS) { code = (int)(xq * 256u + i); break; } }
            F.MISC[par] = (unsigned)code; }
        LDS_WAIT(); __builtin_amdgcn_s_barrier(); asm volatile("" ::: "memory");
        const int code = __builtin_amdgcn_readfirstlane((int)F.MISC[par]); par ^= 1;
        if (code < 0) break;
        const int xq = code >> 8, i = code & 255;
#ifdef MK_P2_REPMODE
        if (rep && ((MK_P2_REPMODE == 1 && i >= 8) || (MK_P2_REPMODE == 2 && i < 16) || MK_P2_REPMODE == 3)) continue;
#endif
#ifndef NO_HGRN
        if (i < 8) { hgrn::hgrn_unit(xq, i, proj, rep ? (bf16_t*)(ws + WS_H2F) : mix, a.in[4], a.in[5], F.lds, rep ? HG_ABL : 0); }
        else
#endif
        if (i < 16) {
            pg8::KvOrder S{(const char*)(ws + WS_MN), (const char*)(ws + WS_WKV), xq * 8 + (i - 8)};
            pg8::EpiBf16 E{(bf16_t*)(ws + WS_MEMK), D, (bf16_t*)(ws + WS_MEMVT), D};
            pg8::gemm_phase<pg8::EpiBf16, pg8::KvOrder, false, false>(F.lds, D, D, D / 64, S, E);
        } else
#ifndef NO_MOBA
        { const int j = i - 16, g = j >> 5, jj = j & 31, hh = 2 * g + (jj & 1), qb = 15 - (jj >> 1);
            moba::attn_unit<8>(xq, hh, qb, proj, proj + SEC_ELEMS, proj + 2 * SEC_ELEMS, mix, (const float*)(ws + WS_KBAR), (char*)(unsigned char*)F.lds); }
#else
        {}
#endif
    }
}

__device__ __forceinline__ void p7_router(Frame& F, const Args& a, int rep) {
    unsigned char* ws = a.ws;
    constexpr int WRS = 2064;
    LAS unsigned char* WH = F.lds; LAS unsigned char* WL = F.lds + 32 * WRS;
    LAS int* hist = (LAS int*)(F.lds + TL_HIST); LAS int* basel = (LAS int*)(F.lds + TL_BASE);
    { const u32x4* src = (const u32x4*)(ws + WS_WRT);
      for (int i = F.tid; i < 2 * NEXP * D / 8; i += 512) { const int m = i >> 12, r = (i >> 7) & 31, c = i & 127; *(LAS u32x4*)(F.lds + m * 32 * WRS + r * WRS + c * 16) = src[i]; } }
    const float* h2f = (const float*)(ws + WS_H2F); const float* ss2 = (const float*)(ws + WS_SS2);
    int* toke = (int*)(ws + (rep ? WS_DUMMY + 1 * MiB : WS_TOKE)); int* tokr = (int*)(ws + (rep ? WS_DUMMY + 1 * MiB + 512 * 1024 : WS_TOKR)); float* tokg = (float*)(ws + (rep ? WS_DUMMY + 2 * MiB : WS_TOKG)); int* list = (int*)(ws + (rep ? WS_DUMMY + 4 * MiB : WS_LIST)); float* glist = (float*)(ws + (rep ? WS_DUMMY + 8 * MiB : WS_GLIST)); float* sslist = (float*)(ws + (rep ? WS_DUMMY + 12 * MiB : WS_SSLIST));
    unsigned* cntw = F.ctl + (rep ? CW_CNT + 2048 * rep : CW_CNT);
    const int lane = F.lane, r16 = lane & 15, g4 = lane >> 4;
    const float br0 = a.in[14][r16], br1 = a.in[14][16 + r16];
    for (int tb = blockIdx.x; tb < T / 128; tb += F.G) {
        if (F.tid < 32) hist[F.tid] = 0;
        LDS_WAIT(); __builtin_amdgcn_s_barrier(); asm volatile("" ::: "memory");
        const int t0 = tb * 128 + F.wave * 16;
        const float* xr = h2f + (size_t)(t0 + r16) * D + 8 * g4;
        f32x4 acc0 = (f32x4){0.f, 0.f, 0.f, 0.f}, acc1 = acc0;
        f32x4 xa = *(const f32x4*)(xr), xb = *(const f32x4*)(xr + 4);
#pragma unroll 4
        for (int ks = 0; ks < 32; ++ks) {
            const f32x4 ca = xa, cb = xb;
            if (ks + 1 < 32) { xa = *(const f32x4*)(xr + 32 * (ks + 1)); xb = *(const f32x4*)(xr + 32 * (ks + 1) + 4); }
            const unsigned h0 = cvtpk(ca.x, ca.y), h1 = cvtpk(ca.z, ca.w), h2 = cvtpk(cb.x, cb.y), h3 = cvtpk(cb.z, cb.w);
            const unsigned l0 = cvtpk(ca.x - bflo(h0), ca.y - bfhi(h0)), l1 = cvtpk(ca.z - bflo(h1), ca.w - bfhi(h1)), l2 = cvtpk(cb.x - bflo(h2), cb.y - bfhi(h2)), l3 = cvtpk(cb.z - bflo(h3), cb.w - bfhi(h3));
            const bf16x8 ah = __builtin_bit_cast(bf16x8, (u32x4){h0, h1, h2, h3}), al = __builtin_bit_cast(bf16x8, (u32x4){l0, l1, l2, l3});
            const int bo = r16 * WRS + (32 * ks + 8 * g4) * 2;
            const bf16x8 bh0 = *(const LAS bf16x8*)(WH + bo), bh1 = *(const LAS bf16x8*)(WH + 16 * WRS + bo), bl0 = *(const LAS bf16x8*)(WL + bo), bl1 = *(const LAS bf16x8*)(WL + 16 * WRS + bo);
            acc0 = __builtin_amdgcn_mfma_f32_16x16x32_bf16(ah, bh0, acc0, 0, 0, 0); acc1 = __builtin_amdgcn_mfma_f32_16x16x32_bf16(ah, bh1, acc1, 0, 0, 0);
            acc0 = __builtin_amdgcn_mfma_f32_16x16x32_bf16(ah, bl0, acc0, 0, 0, 0); acc1 = __builtin_amdgcn_mfma_f32_16x16x32_bf16(ah, bl1, acc1, 0, 0, 0);
            acc0 = __builtin_amdgcn_mfma_f32_16x16x32_bf16(al, bh0, acc0, 0, 0, 0); acc1 = __builtin_amdgcn_mfma_f32_16x16x32_bf16(al, bh1, acc1, 0, 0, 0);
        }
        int my_e = 0; float my_g = 0.f;
#pragma unroll
        for (int j = 0; j < 4; ++j) {
            const float rs = __builtin_amdgcn_rsqf(ss2[t0 + 4 * g4 + j] * (1.0f / D) + EPS);
            float a0 = acc0[j] * rs + br0, a1 = acc1[j] * rs + br1; float tv[4]; int te_[4];
#pragma unroll
            for (int k = 0; k < 4; ++k) { float m = fmaxf(a0, a1);
#pragma unroll
                for (int o = 1; o < 16; o <<= 1) m = fmaxf(m, __shfl_xor(m, o));
                int e = (a0 == m) ? r16 : ((a1 == m) ? 16 + r16 : 99);
#pragma unroll
                for (int o = 1; o < 16; o <<= 1) e = min(e, __shfl_xor(e, o));
                tv[k] = m; te_[k] = e; if (e == r16) a0 = -INFINITY; if (e == 16 + r16) a1 = -INFINITY; }
            const float d1 = fast_exp2((tv[1] - tv[0]) * LOG2E), d2 = fast_exp2((tv[2] - tv[0]) * LOG2E), d3 = fast_exp2((tv[3] - tv[0]) * LOG2E);
            const float inv = 1.0f / (1.0f + d1 + d2 + d3);
            if ((r16 >> 2) == j) { const int k = lane & 3; my_e = k == 0 ? te_[0] : (k == 1 ? te_[1] : (k == 2 ? te_[2] : te_[3])); my_g = (k == 0 ? 1.0f : (k == 1 ? d1 : (k == 2 ? d2 : d3))) * inv; }
        }
        const int rl = __hip_atomic_fetch_add(hist + my_e, 1, __ATOMIC_RELAXED, __HIP_MEMORY_SCOPE_WORKGROUP);
        LDS_WAIT(); __builtin_amdgcn_s_barrier(); asm volatile("" ::: "memory");
        if (F.tid < 32) basel[F.tid] = (int)__hip_atomic_fetch_add(cntw + F.tid, (unsigned)hist[F.tid], RLX_AGENT);
        LDS_WAIT(); VM_WAIT(); __builtin_amdgcn_s_barrier(); asm volatile("" ::: "memory");
        { const int t = t0 + 4 * g4 + (r16 >> 2), k = lane & 3; const int rank = basel[my_e] + rl;
          toke[t * 4 + k] = my_e; tokr[t * 4 + k] = rank; tokg[t * 4 + k] = my_g; list[(size_t)my_e * T + rank] = t; glist[(size_t)my_e * T + rank] = my_g; sslist[(size_t)my_e * T + rank] = ss2[t]; }
        LDS_WAIT(); __builtin_amdgcn_s_barrier(); asm volatile("" ::: "memory");
    }
}

__device__ __forceinline__ int build_tables(Frame& F) {
    LAS int* ts = (LAS int*)(F.lds + TL_TS); LAS unsigned char* te = (LAS unsigned char*)(F.lds + TL_TE);
    if (F.tid < NEXP) ((LAS int*)(F.lds + TL_CNT))[F.tid] = (int)__hip_atomic_load(F.ctl + CW_CNT + F.tid, RLX_AGENT);
    LDS_WAIT(); __builtin_amdgcn_s_barrier(); asm volatile("" ::: "memory");
    if (F.tid == 0) { int run = 0;
        for (int e = 0; e < NEXP; ++e) { ts[e] = run; run += (((LAS int*)(F.lds + TL_CNT))[e] + 255) >> 8; }
        ts[NEXP] = run; }
    LDS_WAIT(); __builtin_amdgcn_s_barrier(); asm volatile("" ::: "memory");
    const int nt = ts[NEXP];
    for (int g = F.tid; g < nt; g += 512) { int e = 0;
        for (int j = 1; j < NEXP; ++j) e += (ts[j] <= g) ? 1 : 0;
        te[g] = (unsigned char)e; }
    LDS_WAIT(); __builtin_amdgcn_s_barrier(); asm volatile("" ::: "memory");
    return __builtin_amdgcn_readfirstlane(nt);
}

__device__ __forceinline__ void p10_combine(Frame& F, const Args& a) {
    unsigned char* ws = a.ws;
    LAS int* ts = (LAS int*)(F.lds + TL_TS);
    const float* h2f = (const float*)(ws + WS_H2F); const unsigned char* Y = (const unsigned char*)(ws + WS_Y);
    const int* toke = (const int*)(ws + WS_TOKE); const int* tokr = (const int*)(ws + WS_TOKR);
    const float* gf = a.in[19];
    const int gw = F.vcu * NWAVES + F.wave, NGW = F.G * NWAVES, lane = F.lane;
    for (int t0 = 2 * gw; t0 < T; t0 += 2 * NGW) {
        float o[2][16]; u32x2 y[2][4][2];
#pragma unroll
        for (int q = 0; q < 2; ++q) { const int t = t0 + q;
#pragma unroll
            for (int k = 0; k < 4; ++k) { const int e = toke[t * 4 + k], r = tokr[t * 4 + k]; const unsigned char* yr = Y + ((size_t)ts[e] * 256 + r) * D;
                y[q][k][0] = *(const u32x2*)(yr + 8 * lane); y[q][k][1] = *(const u32x2*)(yr + 512 + 8 * lane); }
            const f32x4 a0 = *(const f32x4*)(h2f + (size_t)t * D + 8 * lane), a1 = *(const f32x4*)(h2f + (size_t)t * D + 8 * lane + 4), a2 = *(const f32x4*)(h2f + (size_t)t * D + 512 + 8 * lane), a3 = *(const f32x4*)(h2f + (size_t)t * D + 512 + 8 * lane + 4);
            o[q][0] = a0.x; o[q][1] = a0.y; o[q][2] = a0.z; o[q][3] = a0.w; o[q][4] = a1.x; o[q][5] = a1.y; o[q][6] = a1.z; o[q][7] = a1.w; o[q][8] = a2.x; o[q][9] = a2.y; o[q][10] = a2.z; o[q][11] = a2.w; o[q][12] = a3.x; o[q][13] = a3.y; o[q][14] = a3.z; o[q][15] = a3.w; }
#pragma unroll
        for (int q = 0; q < 2; ++q) {
#pragma unroll
            for (int k = 0; k < 4; ++k)
#pragma unroll
                for (int hf = 0; hf < 2; ++hf) { const u32x2 w = y[q][k][hf];
                    const f32x2 c0 = __builtin_amdgcn_cvt_pk_f32_fp8((int)w.x, false), c1 = __builtin_amdgcn_cvt_pk_f32_fp8((int)w.x, true), c2 = __builtin_amdgcn_cvt_pk_f32_fp8((int)w.y, false), c3 = __builtin_amdgcn_cvt_pk_f32_fp8((int)w.y, true);
                    o[q][8 * hf + 0] += pg8::YSCALE_INV * c0.x; o[q][8 * hf + 1] += pg8::YSCALE_INV * c0.y; o[q][8 * hf + 2] += pg8::YSCALE_INV * c1.x; o[q][8 * hf + 3] += pg8::YSCALE_INV * c1.y;
                    o[q][8 * hf + 4] += pg8::YSCALE_INV * c2.x; o[q][8 * hf + 5] += pg8::YSCALE_INV * c2.y; o[q][8 * hf + 6] += pg8::YSCALE_INV * c3.x; o[q][8 * hf + 7] += pg8::YSCALE_INV * c3.y; }
            float s = 0.f;
#pragma unroll
            for (int j = 0; j < 16; ++j) s += o[q][j] * o[q][j];
            const float rstd = 1.0f / sqrtf(wave_sum(s) * (1.0f / D) + EPS);
            float* op = a.out + (size_t)(t0 + q) * D;
#pragma unroll
            for (int v = 0; v < 4; ++v) { const int col = (v >> 1) * 512 + 8 * lane + (v & 1) * 4; const f32x4 g4 = *(const f32x4*)(gf + col);
                *(f32x4*)(op + col) = (f32x4){o[q][4 * v] * rstd * g4.x, o[q][4 * v + 1] * rstd * g4.y, o[q][4 * v + 2] * rstd * g4.z, o[q][4 * v + 3] * rstd * g4.w}; }
        }
    }
}

#define XB_TMO      128
#define XB_XCNT(j)  (256  + 64 * (j))
#define XB_XSUB(j)  (1280 + 64 * (j))
#define XB_XGEN(j)  (2304 + 64 * (j))
#define XB_TOP      3328
#define XB_TOPGEN   3392
#define XCD_BAR_WORDS 3456
#define XB_SPIN_CAP (1u << 22)
__device__ __forceinline__ unsigned xb_ld(unsigned* p)              { return __hip_atomic_load(p, __ATOMIC_RELAXED, __HIP_MEMORY_SCOPE_AGENT); }
__device__ __forceinline__ unsigned xb_add(unsigned* p, unsigned v) { return __hip_atomic_fetch_add(p, v, __ATOMIC_RELAXED, __HIP_MEMORY_SCOPE_AGENT); }
#define XB_SPIN(cond, bar) do { unsigned _sp = 0; while (cond) { __builtin_amdgcn_s_sleep(1); \
    if ((++_sp & 255u) == 0u) { if (xb_ld(&(bar)[XB_TMO])) break; if (_sp > XB_SPIN_CAP) { atomicAdd(&(bar)[XB_TMO], 1u); break; } } } } while (0)
struct XcdBarrier { unsigned* bar; unsigned x; volatile LAS unsigned* st; };
__device__ __forceinline__ XcdBarrier xcd_barrier_post(unsigned* bar, volatile LAS unsigned* st) {
    XcdBarrier b; b.bar = bar; b.x = (unsigned)__builtin_amdgcn_s_getreg((3 << 11) | 20) & 0xFu; b.st = st;
    if (threadIdx.x == 0) (void)xb_add(&bar[XB_XCNT(b.x)], 1u);
    return b;
}
__device__ __forceinline__ void xcd_barrier_complete(unsigned* bar, unsigned x, unsigned& nloc, unsigned& nx) {
    const unsigned G = gridDim.x * gridDim.y * gridDim.z;
    unsigned sum, cnt, mine, sp = 0u;
    for (;;) {
        sum = 0u; cnt = 0u; mine = 0u;
#pragma unroll
        for (unsigned j = 0; j < 16; ++j) { const unsigned c = xb_ld(&bar[XB_XCNT(j)]); sum += c; cnt += (c > 0u) ? 1u : 0u; mine = (j == x) ? c : mine; }
        if (sum == G) break;
        __builtin_amdgcn_s_sleep(1);
        if ((++sp & 255u) == 0u) { if (xb_ld(&bar[XB_TMO])) break; if (sp > XB_SPIN_CAP) { atomicAdd(&bar[XB_TMO], 1u); break; } }
    }
    nloc = mine > 0u ? mine : 1u; nx = cnt > 0u ? cnt : 1u;
}
__device__ __forceinline__ void xcd_barrier(const XcdBarrier& b) {
    asm volatile("s_waitcnt vmcnt(0)" ::: "memory");
    __syncthreads();
    if (threadIdx.x == 0) {
        unsigned* bar = b.bar;
        __builtin_amdgcn_s_waitcnt(0);
        unsigned nloc = b.st[0], nx = b.st[1];
        if (nloc == 0u) { xcd_barrier_complete(bar, b.x, nloc, nx); b.st[0] = nloc; b.st[1] = nx; }
        const unsigned old = xb_add(&bar[XB_XSUB(b.x)], 1u);
        const unsigned gen = old / nloc;
        if (old + 1u == (gen + 1u) * nloc) {
            __builtin_amdgcn_fence(__ATOMIC_RELEASE, "agent");
            asm volatile("s_waitcnt vmcnt(0)" ::: "memory");
            const unsigned og = xb_add(&bar[XB_TOP], 1u);
            const unsigned tg = og / nx;
            if (og + 1u == (tg + 1u) * nx) xb_add(&bar[XB_TOPGEN], 1u);
            else XB_SPIN(xb_ld(&bar[XB_TOPGEN]) == tg, bar);
            __builtin_amdgcn_fence(__ATOMIC_ACQUIRE, "agent");
            xb_add(&bar[XB_XGEN(b.x)], 1u);
            asm volatile("s_waitcnt vmcnt(0)" ::: "memory");
        } else {
            XB_SPIN(xb_ld(&bar[XB_XGEN(b.x)]) == gen, bar);
            __builtin_amdgcn_fence(__ATOMIC_ACQUIRE, "agent");
            asm volatile("s_waitcnt vmcnt(0)" ::: "memory");
        }
    }
    __syncthreads();
}
#ifndef MK_CG_ONLY
#define MK_CG_ONLY 0
#endif
__device__ __forceinline__ void grid_barrier(Frame& F, const XcdBarrier& xb_) { if (MK_CG_ONLY) cg::this_grid().sync(); else xcd_barrier(xb_); }
#ifndef MK_PHASE_MASK
#define MK_PHASE_MASK 0x7ff
#endif
#ifndef MK_REP_PHASE
#define MK_REP_PHASE -1
#endif
#ifndef MK_REP_N
#define MK_REP_N 0
#endif
__device__ __forceinline__ void ph0(Frame& F, const Args& args, int rep) { p0_prologue(F, args); }
__device__ __forceinline__ void ph1(Frame& F, const Args& args, int rep) {
    unsigned char* ws = args.ws; const int cid = (int)blockIdx.x;
    { pg8::DenseOrder S{(const char*)(ws + WS_XN), (const char*)(ws + WS_WIN), D, D, T / 256, INC / 256, F.G, cid};
      pg8::EpiProj E{(bf16_t*)(ws + WS_PROJ), rep ? (float*)(ws + WS_DUMMY) : (float*)(ws + WS_KBAR)};
      pg8::gemm_phase<pg8::EpiProj, pg8::DenseOrder, false, true>(F.lds, D, D, D / 64, S, E); }
}
__device__ __forceinline__ void ph2(Frame& F, const Args& args, int rep) { p2_mixer(F, args, rep); }
constexpr size_t WS_MB = WS_PROJ, WS_NB = WS_PROJ + 16 * MiB, WS_H1Q = WS_PROJ + 32 * MiB, WS_PB = WS_QX;
constexpr size_t WS_UNUSED_XA = 0;
constexpr int LDS_XTAB = 131072;
__device__ __forceinline__ void ph3(Frame& F, const Args& args, int rep) {
    unsigned char* ws = args.ws; const int cid = (int)blockIdx.x;
    pg8::P3Order S{pg8::XmnOrder{(const char*)(ws + WS_MEMK), (const char*)(ws + WS_MEMVT), (const char*)(ws + WS_WQ), (const char*)(ws + WS_WO), F.G, cid},
                   pg8::DenseOrder{(const char*)(ws + WS_MIX), (const char*)(ws + WS_WOUT), D, D, T / 256, D / 256, F.G, cid}};
    pg8::EpiP3 E{pg8::EpiFp8{(unsigned char*)(ws + WS_MB), D, (unsigned char*)(ws + WS_NB), D, XSCALE8},
                 pg8::EpiRes<true, false>{(const void*)args.in[0], (bf16_t*)(ws + WS_H1B), nullptr, rep ? (float*)(ws + WS_DUMMY + 512 * 1024) : (float*)(ws + WS_SS1), 1.0f, (unsigned char*)(ws + WS_H1Q)}};
    pg8::gemm_phase<pg8::EpiP3, pg8::P3Order, false, true>(F.lds, D, D, D / 64, S, E);
}
__device__ __forceinline__ void ph4(Frame& F, const Args& args, int rep) {
    unsigned char* ws = args.ws; const int cid = (int)blockIdx.x;
    pg8::XbOrder S{(const char*)(ws + WS_H1Q), (const char*)(ws + WS_MB), F.G, cid, (size_t)D};
    pg8::EpiSoftmaxS E{(unsigned char*)(ws + WS_PB), (const float*)(ws + WS_SS1), F.lds + LDS_XTAB, XSCALE8_INV};
    pg8::gemm_phase<pg8::EpiSoftmaxS, pg8::XbOrder, false, true, true>(F.lds, D / 2, D / 2, D / 128, S, E);
}
__device__ __forceinline__ void ph5(Frame& F, const Args& args, int rep) {}
__device__ __forceinline__ void ph6(Frame& F, const Args& args, int rep) {
    unsigned char* ws = args.ws; const int cid = (int)blockIdx.x;
    pg8::XbOrder S{(const char*)(ws + WS_PB), (const char*)(ws + WS_NB), F.G, cid, (size_t)D};
    pg8::EpiRes<false, true, true> E{(const void*)(ws + WS_H1B), (bf16_t*)(ws + WS_H2B), (float*)(ws + WS_H2F), rep ? (float*)(ws + WS_DUMMY + 512 * 1024) : (float*)(ws + WS_SS2), PSCALE8_INV * XSCALE8_INV, nullptr};
    pg8::gemm_phase<pg8::EpiRes<false, true, true>, pg8::XbOrder, false, true, true>(F.lds, D / 2, D / 2, D / 128, S, E);
}
__device__ __forceinline__ void ph7(Frame& F, const Args& args, int rep) { p7_router(F, args, rep); }
__device__ __forceinline__ void ph8(Frame& F, const Args& args, int rep) {
    unsigned char* ws = args.ws; const int cid = (int)blockIdx.x;
    const int ntl = build_tables(F);
    pg8::MoeOrder S{(const char*)(ws + WS_H2B), (const char*)(ws + WS_W1), (const int*)(ws + WS_LIST), (const LAS int*)(F.lds + TL_CNT), (const LAS unsigned char*)(F.lds + TL_TE), (const LAS int*)(F.lds + TL_TS),
                    ntl, 8, F.G, cid, (size_t)2048 * D, 1, (size_t)256 * D, (size_t)256 * D};
    pg8::EpiW1 E{(bf16_t*)(ws + WS_HMID), (const float*)(ws + WS_SSLIST), args.in[16], (const int*)(ws + WS_LIST)};
    pg8::gemm_phase<pg8::EpiW1, pg8::MoeOrder, true, true, true>(F.lds, D / 2, D / 2, D / 128, S, E);
}
__device__ __forceinline__ void ph9(Frame& F, const Args& args, int rep) {
    unsigned char* ws = args.ws; const int cid = (int)blockIdx.x;
    const int ntl = build_tables(F);
    pg8::MoeOrder S{(const char*)(ws + WS_HMID), (const char*)(ws + WS_W2), (const int*)(ws + WS_LIST), (const LAS int*)(F.lds + TL_CNT), (const LAS unsigned char*)(F.lds + TL_TE), (const LAS int*)(F.lds + TL_TS),
                    ntl, 4, F.G, cid, (size_t)D * D, 0, (size_t)256 * D, (size_t)256 * D};
    pg8::EpiW2 E{(unsigned char*)(ws + WS_Y), args.in[18], (const int*)(ws + WS_LIST), (const float*)(ws + WS_GLIST)};
    pg8::gemm_phase<pg8::EpiW2, pg8::MoeOrder, false, true, true>(F.lds, D / 2, D / 2, D / 128, S, E);
}
__device__ __forceinline__ void ph10(Frame& F, const Args& args, int rep) { (void)build_tables(F); p10_combine(F, args); }

constexpr int N_PHASES = 11;
__global__ void __launch_bounds__(NWAVES * 64, 2) hymba_fwd(Args args) {
    extern __shared__ __attribute__((aligned(16))) unsigned char lds_raw[];
    Frame F;
    F.lds = (LAS unsigned char*)lds_raw;
    F.MISC = (volatile LAS unsigned*)(F.lds + TL_MISC);
    F.tid = threadIdx.x; F.lane = F.tid & 63; F.wave = __builtin_amdgcn_readfirstlane(F.tid >> 6);
    F.G = gridDim.x; { const int bx = blockIdx.x; F.vcu = (F.G % 8 == 0) ? (bx % 8) * (F.G / 8) + bx / 8 : bx; }
    F.ctl = (unsigned*)(args.ws + WS_CTL);
    const int lo = args.ph_lo, hi = args.ph_hi;
    for (int u = F.tid; u < 64; u += NWAVES * 64) ((LAS unsigned*)(F.lds + TL_MISC))[u] = 0u;
    __syncthreads();
    const XcdBarrier xbar = xcd_barrier_post(F.ctl + CW_BAR, F.MISC + 8);
#define RUN(k, fn) do { if (((MK_PHASE_MASK >> (k)) & 1) && lo <= (k) && (k) < hi) { fn(F, args, 0); \
        if (MK_REP_PHASE == (k) && MK_REP_N >= 1) { grid_barrier(F, xbar); fn(F, args, 1); } \
        if (MK_REP_PHASE == (k) && MK_REP_N >= 2) { grid_barrier(F, xbar); fn(F, args, 2); } \
        if ((k) + 1 < hi) { grid_barrier(F, xbar); } } } while (0)
    if (args.ph_lo < 0) cg::this_grid().sync();
    RUN(0, ph0); RUN(1, ph1); RUN(2, ph2); RUN(3, ph3); RUN(4, ph4);   RUN(6, ph6); RUN(7, ph7); RUN(8, ph8); RUN(9, ph9); RUN(10, ph10);
#undef RUN
}

extern "C" void kernel_launch(void* const* d_in, const int* in_sizes, int n_in, void* d_out, int out_size, void* d_ws, size_t ws_size, hipStream_t stream) {
    static int grid = 0;
    if (grid == 0) {
        if (n_in != 20 || in_sizes[0] != T * D || out_size != T * D || ws_size < WS_END) {
            fprintf(stderr, "kernel_launch: shape/workspace mismatch (n_in %d, in0 %d, out %d, ws %zu, need %zu)\n", n_in, n_in > 0 ? in_sizes[0] : -1, out_size, ws_size, (size_t)WS_END); grid = -1; return; }
        int dev = 0, cus = 0, per_cu = 0;
        if (hipGetDevice(&dev) != hipSuccess || hipDeviceGetAttribute(&cus, hipDeviceAttributeMultiprocessorCount, dev) != hipSuccess) { grid = -1; return; }
        if (hipFuncSetAttribute((const void*)hymba_fwd, hipFuncAttributeMaxDynamicSharedMemorySize, LDS_BYTES) != hipSuccess) { fprintf(stderr, "kernel_launch: hipFuncSetAttribute failed\n"); grid = -1; return; }
        if (hipOccupancyMaxActiveBlocksPerMultiprocessor(&per_cu, (const void*)hymba_fwd, NWAVES * 64, LDS_BYTES) != hipSuccess || per_cu < 1) { fprintf(stderr, "kernel_launch: occupancy query says %d\n", per_cu); }
        (void)hipGetLastError();
        grid = cus;
        if (grid != 256) fprintf(stderr, "kernel_launch: %d CUs; this kernel is built for 256\n", grid);
    }
    if (grid < 0) return;
    (void)hipMemsetAsync((char*)d_ws + WS_CTL, 0, CTL_ZERO_BYTES, stream);
    Args a{};
    for (int i = 0; i < 20; ++i) a.in[i] = (const float*)d_in[i];
    a.out = (float*)d_out; a.ws = (unsigned char*)d_ws;
#if MK_N_LAUNCHES == 1
    a.ph_lo = 0; a.ph_hi = MK_LAST_PHASE + 1;
    void* kargs[] = {&a};
    hipError_t e = hipLaunchCooperativeKernel((const void*)hymba_fwd, dim3(grid), dim3(NWAVES * 64), kargs, LDS_BYTES, stream);
    if (e != hipSuccess) fprintf(stderr, "kernel_launch: cooperative launch failed: %s\n", hipGetErrorString(e));
#else
    for (int p = 0; p <= MK_LAST_PHASE; ++p) { a.ph_lo = p; a.ph_hi = p + 1; hipLaunchKernelGGL(hymba_fwd, dim3(grid), dim3(NWAVES * 64), LDS_BYTES, stream, a); }
#endif
}
```

```cpp
#include <hip/hip_runtime.h>
#include <hip/hip_cooperative_groups.h>
#include <cstdio>
#include <cstdint>
namespace cg = cooperative_groups;

#ifndef MK_N_LAUNCHES
#define MK_N_LAUNCHES 1
#endif
#ifndef MK_LAST_PHASE
#define MK_LAST_PHASE 10
#endif

#define LAS __attribute__((address_space(3)))
#define GAS __attribute__((address_space(1)))
typedef unsigned short bf16_t;
typedef short bf16x8 __attribute__((ext_vector_type(8)));
typedef short s16x4 __attribute__((ext_vector_type(4)));
typedef float f32x4 __attribute__((ext_vector_type(4)));
typedef float f32x2 __attribute__((ext_vector_type(2)));
typedef float f32x16 __attribute__((ext_vector_type(16)));
typedef unsigned u32x4 __attribute__((ext_vector_type(4)));
typedef unsigned u32x2 __attribute__((ext_vector_type(2)));
typedef int v8i32_t __attribute__((ext_vector_type(8)));

constexpr int BATCH = 8, SEQ = 4096, T = BATCH * SEQ, D = 1024, INC = 3584, NMEM = 256, MROWS = BATCH * NMEM;
constexpr int NEXP = 32, TOPK = 4, MT_MAX = T * TOPK / 256 + NEXP, MPAD = MT_MAX * 256;
constexpr float EPS = 1e-6f;
constexpr float LOG2E = 1.4426950408889634f;
constexpr float C2Q = 0.125f * LOG2E;
constexpr float C2X = 0.0625f * LOG2E;
constexpr int C_MQ = 0, C_MK = 512, C_MV = 1024, C_GQ = 1536, C_GF = 2048, C_GI = 2560, C_GG = 3072;

constexpr size_t MiB = 1u << 20;
constexpr size_t WS_CTL = 0, CTL_ZERO_BYTES = 2 * MiB;
constexpr size_t WS_KBAR = 1 * MiB;
constexpr size_t WS_SS1 = 1 * MiB + 256 * 1024;
constexpr size_t WS_SS2 = 1 * MiB + 384 * 1024;
constexpr size_t WS_TOKE = 2 * MiB, WS_TOKR = 2 * MiB + 512 * 1024, WS_TOKG = 3 * MiB;
constexpr size_t WS_WRT = 3 * MiB + 512 * 1024;
constexpr size_t WS_LIST = 4 * MiB;
constexpr size_t WS_GLIST = 8 * MiB;
constexpr size_t WS_SSLIST = 12 * MiB;
constexpr size_t WS_WIN = 16 * MiB, WS_WOUT = 23 * MiB, WS_WQ = 25 * MiB, WS_WKV = 27 * MiB, WS_WO = 31 * MiB;
constexpr size_t WS_MN = 33 * MiB, WS_MEMK = 37 * MiB, WS_MEMVT = 41 * MiB;
constexpr size_t WS_W1 = 48 * MiB, WS_W2 = 176 * MiB;
constexpr size_t WS_PROJ = 240 * MiB;
constexpr size_t SEC_ELEMS = (size_t)16 * 1024 * 1024;
constexpr size_t WS_XN = 464 * MiB;
constexpr size_t WS_OX = 464 * MiB;
constexpr size_t WS_MIX = 528 * MiB;
constexpr size_t WS_H1B = 592 * MiB;
constexpr size_t WS_QX = 656 * MiB;
constexpr size_t WS_PWS = 720 * MiB;
constexpr size_t WS_HMID = 240 * MiB;
constexpr size_t WS_Y = 512 * MiB;
constexpr size_t WS_H2F = 784 * MiB;
constexpr size_t WS_H2B = 912 * MiB;
constexpr size_t WS_DUMMY = 976 * MiB;
constexpr size_t WS_END = 992 * MiB;
static_assert(WS_HMID + (size_t)MPAD * D * 2 <= WS_Y && WS_Y + (size_t)MPAD * D * 2 <= WS_H2F, "ws map");
constexpr int CW_TMO = 0;
constexpr int CW_CNT = 64;
constexpr int CW_QUEUE = 128;
constexpr int CW_BAR = 4096;

__device__ __forceinline__ unsigned f2bf(float f) { unsigned u = __builtin_bit_cast(unsigned, f); return (u + 0x7fffu + ((u >> 16) & 1u)) >> 16; }
__device__ __forceinline__ unsigned pk2(float lo, float hi) { return f2bf(lo) | (f2bf(hi) << 16); }
__device__ __forceinline__ float bf2f(unsigned short h) { return __builtin_bit_cast(float, (unsigned)h << 16); }
__device__ __forceinline__ float bflo(unsigned w) { return __builtin_bit_cast(float, w << 16); }
__device__ __forceinline__ float bfhi(unsigned w) { return __builtin_bit_cast(float, w & 0xffff0000u); }
typedef float f32x2_t __attribute__((ext_vector_type(2))); typedef __bf16 bf16x2_t __attribute__((ext_vector_type(2)));
__device__ __forceinline__ unsigned cvtpk(float lo, float hi) { f32x2_t v = {lo, hi}; bf16x2_t b = __builtin_convertvector(v, bf16x2_t); return __builtin_bit_cast(unsigned, b); }
__device__ __forceinline__ float wave_sum(float v) {
#pragma unroll
    for (int o = 1; o < 64; o <<= 1) v += __shfl_xor(v, o);
    return v;
}
__device__ __forceinline__ float fast_exp2(float x) { return __builtin_amdgcn_exp2f(x); }
__device__ __forceinline__ float fast_rcp(float x) { return __builtin_amdgcn_rcpf(x); }
__device__ __forceinline__ float silu_f(float x) { return x * fast_rcp(1.0f + fast_exp2(-x * LOG2E)); }
__device__ __forceinline__ unsigned pk4_fp8(float a, float b, float c, float d) { int w = 0; w = __builtin_amdgcn_cvt_pk_fp8_f32(a, b, w, false); w = __builtin_amdgcn_cvt_pk_fp8_f32(c, d, w, true); return (unsigned)w; }
constexpr float XSCALE8 = 4.0f, XSCALE8_INV = 0.25f, PSCALE8 = 256.0f, PSCALE8_INV = 1.0f / 256.0f;
constexpr float WSCALE8 = 32.0f, WSCALE8_INV = 1.0f / 32.0f;
#define LDS_WAIT() asm volatile("s_waitcnt lgkmcnt(0)" ::: "memory")
#define VM_WAIT() asm volatile("s_waitcnt vmcnt(0)" ::: "memory")
#define RLX_AGENT __ATOMIC_RELAXED, __HIP_MEMORY_SCOPE_AGENT

namespace pg8 {
constexpr int BM = 256, BK = 64, HALF = 128, HTB = HALF * BK * 2, STAGE_BYTES = 8 * HTB;
__device__ __forceinline__ unsigned gload32_hidden(const void* sbase, unsigned voff) { unsigned v; asm volatile("global_load_dword %0, %1, %2" : "=v"(v) : "v"(voff), "s"(sbase) : "memory"); return v; }
__device__ __forceinline__ f32x4 gload128_hidden(const void* sbase, unsigned voff) { f32x4 v; asm volatile("global_load_dwordx4 %0, %1, %2" : "=v"(v) : "v"(voff), "s"(sbase) : "memory"); return v; }
__device__ __forceinline__ void glds16s(const char* sbase, unsigned voff, unsigned lds_dst) { unsigned keep;
    asm volatile("s_mov_b32 %0, m0\n\ts_mov_b32 m0, %3\n\ts_nop 0\n\tglobal_load_lds_dwordx4 %1, %2\n\ts_mov_b32 m0, %0" : "=&s"(keep) : "v"(voff), "s"(sbase), "s"(lds_dst) : "memory"); }
__host__ __device__ __forceinline__ int lds_byte(int r, int c) { const int st = (r >> 4) * 2 + (c >> 5), rr = r & 15, cc = c & 31, ob = rr * 64 + cc * 2; return st * 1024 + (ob ^ (((ob >> 9) & 1) << 5)); }
__host__ __device__ __forceinline__ void stage_rc(int b, int& R, int& C) { const int st = b / 1024, sb = b % 1024, swz = sb ^ (((sb >> 9) & 1) << 5); R = (st >> 1) * 16 + swz / 64; C = (st & 1) * 32 + (swz % 64) / 2; }
__host__ __device__ __forceinline__ int perm32(int rho) { const int n = rho >> 4, i = rho & 15; return 8 * (i >> 2) + 4 * n + (i & 3); }

struct Unit { const char* A; const char* B; const int* rows; int pm, pn, aux, nrows, ntu; };

template <class Epi, class Sched, bool GATHER, bool ALIGN_EPI, bool FP8 = false>
__device__ __forceinline__ void gemm_phase(LAS unsigned char* lds, const int lda, const int ldb, const int nt_in, const Sched& S, const Epi& E) {
    int nt = nt_in; asm volatile("" : "+s"(nt));
    int tid_ = threadIdx.x; asm volatile("" : "+v"(tid_));
    const int tid = tid_, wid = __builtin_amdgcn_readfirstlane(tid >> 6), lane = tid & 63, wr = wid >> 2, wc = wid & 3, fr = lane & 15, fq = lane >> 4;
    unsigned offB0; { int R, C; stage_rc(tid * 16, R, C); const int Rb = Epi::PERM ? ((R & ~31) + perm32(R & 31)) : R; offB0 = (unsigned)(Rb * ldb + C) * 2u; }
    const size_t pstepB = (size_t)64 * ldb * 2;
    const size_t kstep = (size_t)(BK * 2);
    const size_t hstepB = (size_t)HALF * ldb * 2;
    const unsigned ldsb = (unsigned)__builtin_amdgcn_readfirstlane((int)((unsigned)(uintptr_t)(unsigned char*)lds + (unsigned)wid * 1024u));
    const int aoff = lds_byte(wr * 64 + fr, FP8 ? fq * 16 : fq * 8), boff = lds_byte(wc * 32 + fr, FP8 ? fq * 16 : fq * 8);
#define PG8_SA(b, h) (((b) * 2 + (h)) * HTB)
#define PG8_SB(b, h) ((4 + (b) * 2 + (h)) * HTB)
#define PG8_STGB(bufoff, gbase) do { glds16s((const char*)(gbase), offB0, ldsb + (unsigned)(bufoff)); glds16s((const char*)(gbase) + pstepB, offB0, ldsb + (unsigned)(bufoff) + 8192u); } while (0)
#define PG8_LD16(p_) (*(const LAS u32x4*)(p_))
#define PG8_CAT(x, y) __builtin_bit_cast(v8i32_t, __builtin_shufflevector(x, y, 0, 1, 2, 3, 4, 5, 6, 7))
    unsigned aA0 = (unsigned)(aoff + PG8_SA(0, 0)), aA1 = (unsigned)(aoff + PG8_SA(1, 0)), bB0 = (unsigned)(boff + PG8_SB(0, 0)), bB1 = (unsigned)(boff + PG8_SB(1, 0));
    asm volatile("" : "+v"(aA0), "+v"(aA1), "+v"(bB0), "+v"(bB1));
    int scl8 = 0x7f7f7f7f; asm volatile("" : "+v"(scl8));
#define PG8_LDA(dst, b, h) do { const LAS unsigned char* ap_ = lds + ((b) ? aA1 : aA0) + (h) * HTB; _Pragma("unroll") for (int m = 0; m < 4; ++m) { \
        if constexpr (FP8) { dst##8[m] = PG8_CAT(PG8_LD16(ap_ + m * 2048), PG8_LD16(ap_ + m * 2048 + 16)); } \
        else { _Pragma("unroll") for (int k = 0; k < 2; ++k) dst[m][k] = *(const LAS bf16x8*)(ap_ + m * 2048 + k * 1024); } } } while (0)
#define PG8_LDB(dst, b, h) do { const LAS unsigned char* bp_ = lds + ((b) ? bB1 : bB0) + (h) * HTB; _Pragma("unroll") for (int n = 0; n < 2; ++n) { \
        if constexpr (FP8) { dst##8[n] = PG8_CAT(PG8_LD16(bp_ + n * 2048), PG8_LD16(bp_ + n * 2048 + 16)); } \
        else { _Pragma("unroll") for (int k = 0; k < 2; ++k) dst[n][k] = *(const LAS bf16x8*)(bp_ + n * 2048 + k * 1024); } } } while (0)
#define PG8_MMA(ai, bj, At, Bt) do { __builtin_amdgcn_s_setprio(1); _Pragma("unroll") for (int m = 0; m < 4; ++m) _Pragma("unroll") for (int n = 0; n < 2; ++n) { \
        if constexpr (FP8) asm volatile("v_mfma_scale_f32_16x16x128_f8f6f4 %0, %1, %2, %0, %3, %3 op_sel_hi:[0,0,0]" : "+v"(acc[ai][bj][m][n]) : "v"(Bt##8[n]), "v"(At##8[m]), "v"(scl8));   \
        else { _Pragma("unroll") for (int k = 0; k < 2; ++k) acc[ai][bj][m][n] = __builtin_amdgcn_mfma_f32_16x16x32_bf16(Bt[n][k], At[m][k], acc[ai][bj][m][n], 0, 0, 0); } } \
        __builtin_amdgcn_s_setprio(0); } while (0)
#define PG8_WAIT_V(n) asm volatile("s_waitcnt vmcnt(" #n ")" ::: "memory")
#define PG8_WAIT_L(n) asm volatile("s_waitcnt lgkmcnt(" #n ")" ::: "memory")
#define PG8_BAR __builtin_amdgcn_s_barrier()
#define PG8_SCHED __builtin_amdgcn_sched_barrier(0)
    unsigned voffA0, c2, pkc[2], pkn[2], praw[4];
    { int R, C; stage_rc(tid * 16, R, C); voffA0 = (unsigned)(R * lda + C) * 2u; c2 = (unsigned)C * 2u; }
    const size_t hstepA = (size_t)HALF * lda * 2, pstepA = (size_t)64 * lda * 2;
    const unsigned lda2 = (unsigned)lda * 2u;
#define PG8_PKROWS(dst, u) do { if (GATHER) { _Pragma("unroll") for (int i_ = 0; i_ < 2; ++i_) { int R_, C_; stage_rc(tid * 16 + i_ * 8192, R_, C_); \
        const int nr_ = (u).nrows - 1; const int r0_ = R_ < nr_ ? R_ : nr_, r1_ = (R_ + HALF) < nr_ ? (R_ + HALF) : nr_; \
        dst[i_] = (unsigned)(u).rows[r0_] | ((unsigned)(u).rows[r1_] << 16); } } } while (0)
#define PG8_RAWROWS(u) do { if (GATHER) { _Pragma("unroll") for (int i_ = 0; i_ < 2; ++i_) { int R_, C_; stage_rc(tid * 16 + i_ * 8192, R_, C_); \
        const int nr_ = (u).nrows - 1; const int r0_ = R_ < nr_ ? R_ : nr_, r1_ = (R_ + HALF) < nr_ ? (R_ + HALF) : nr_; \
        praw[2 * i_] = gload32_hidden((u).rows, (unsigned)r0_ * 4u); praw[2 * i_ + 1] = gload32_hidden((u).rows, (unsigned)r1_ * 4u); } } } while (0)
#define PG8_PACKRAW(dst) do { unsigned a0_ = praw[0], a1_ = praw[1], a2_ = praw[2], a3_ = praw[3]; asm volatile("" : "+v"(a0_), "+v"(a1_), "+v"(a2_), "+v"(a3_)); \
        dst[0] = a0_ | (a1_ << 16); dst[1] = a2_ | (a3_ << 16); } while (0)
#define PG8_STGA(bufoff, gbase, h, NX) do { \
        if (GATHER) { const unsigned p0_ = (NX) ? pkn[0] : pkc[0], p1_ = (NX) ? pkn[1] : pkc[1]; \
            const unsigned o0_ = ((h) ? (p0_ >> 16) : (p0_ & 0xffffu)) * lda2 + c2, o1_ = ((h) ? (p1_ >> 16) : (p1_ & 0xffffu)) * lda2 + c2; \
            glds16s((const char*)(gbase), o0_, ldsb + (unsigned)(bufoff)); glds16s((const char*)(gbase), o1_, ldsb + (unsigned)(bufoff) + 8192u); } \
        else { const char* gb_ = (const char*)(gbase) + ((h) ? hstepA : (size_t)0); glds16s(gb_, voffA0, ldsb + (unsigned)(bufoff)); glds16s(gb_ + pstepA, voffA0, ldsb + (unsigned)(bufoff) + 8192u); } } while (0)
    Unit cur, nxt; int ui = 0;
    if (!S.next(0, cur)) return;
    f32x4 acc[2][2][4][2];
#pragma unroll
    for (int a = 0; a < 2; ++a)
#pragma unroll
        for (int b = 0; b < 2; ++b)
#pragma unroll
            for (int m = 0; m < 4; ++m)
#pragma unroll
                for (int n = 0; n < 2; ++n) acc[a][b][m][n] = (f32x4){0.f, 0.f, 0.f, 0.f};
    bf16x8 At[4][2], B0[2][2], B1[2][2]; v8i32_t At8[4], B08[2], B18[2];
    pkc[0] = pkc[1] = pkn[0] = pkn[1] = 0u; praw[0] = praw[1] = praw[2] = praw[3] = 0u;
    PG8_PKROWS(pkc, cur);
    const char* cA = cur.A; const char* cB = cur.B;
    PG8_STGB(PG8_SB(0, 0), cB); PG8_STGB(PG8_SB(0, 1), cB + hstepB); PG8_STGA(PG8_SA(0, 0), cA, 0, false); PG8_STGA(PG8_SA(0, 1), cA, 1, false);
    if (wr == 1) PG8_BAR;
    PG8_WAIT_V(2); PG8_BAR;
    PG8_STGB(PG8_SB(1, 0), cB + kstep); PG8_STGA(PG8_SA(1, 0), cA + kstep, 0, false); PG8_STGB(PG8_SB(1, 1), cB + hstepB + kstep);
    PG8_WAIT_V(6); PG8_BAR;
    for (;;) {
        const bool has_next = S.next(ui + 1, nxt);
        if (GATHER) { if (has_next) { PG8_RAWROWS(nxt); } }
        const char* nA = has_next ? nxt.A : cA; const char* nB = has_next ? nxt.B : cB;
        typename Epi::Pre pre; { int t_p = threadIdx.x; asm volatile("" : "+v"(t_p)); E.prefetch(cur, wr, wc, t_p & 15, (t_p >> 4) & 3, pre); }
        const int ntc = cur.ntu ? cur.ntu : nt;
        for (int t = 0; t < ntc; t += 2) {
            const bool last = (t == ntc - 2);
            if (GATHER) { pkn[0] = pkc[0]; pkn[1] = pkc[1]; if (last && has_next) { PG8_PACKRAW(pkn); } }
            const char* a1 = cA + (size_t)(t + 1) * kstep;
            const char* a2 = last ? nA : cA + (size_t)(t + 2) * kstep; const char* b2 = last ? nB : cB + (size_t)(t + 2) * kstep;
            const char* a3 = a2 + kstep; const char* b3 = b2 + kstep;
            PG8_LDB(B0, 0, 0); PG8_LDB(B1, 0, 1); PG8_SCHED; PG8_LDA(At, 0, 0); PG8_STGA(PG8_SA(1, 1), a1, 1, false);
            PG8_WAIT_V(8); PG8_WAIT_L(0); PG8_BAR; PG8_MMA(0, 0, At, B0); PG8_MMA(0, 1, At, B1); PG8_BAR; PG8_SCHED;
            PG8_LDA(At, 0, 1); PG8_STGB(PG8_SB(0, 0), b2); PG8_STGB(PG8_SB(0, 1), b2 + hstepB); PG8_STGA(PG8_SA(0, 0), a2, 0, last);
            PG8_WAIT_V(8); PG8_WAIT_L(0); PG8_BAR; PG8_MMA(1, 0, At, B0); PG8_MMA(1, 1, At, B1); PG8_BAR; PG8_SCHED;
            PG8_LDB(B0, 1, 0); PG8_LDB(B1, 1, 1); PG8_SCHED; PG8_LDA(At, 1, 0); PG8_STGA(PG8_SA(0, 1), a2, 1, last);
            PG8_WAIT_V(8); PG8_WAIT_L(0); PG8_BAR; PG8_MMA(0, 0, At, B0); PG8_MMA(0, 1, At, B1); PG8_BAR; PG8_SCHED;
            PG8_LDA(At, 1, 1); PG8_STGB(PG8_SB(1, 0), b3); PG8_STGB(PG8_SB(1, 1), b3 + hstepB); PG8_STGA(PG8_SA(1, 0), a3, 0, last);
            PG8_WAIT_V(8); PG8_WAIT_L(0); PG8_BAR; PG8_MMA(1, 0, At, B0); PG8_MMA(1, 1, At, B1); PG8_BAR; PG8_SCHED;
        }
        if constexpr (ALIGN_EPI) { if (wr == 0) PG8_BAR; }
        if constexpr (FP8) asm volatile("s_nop 15\n\ts_nop 15" ::: "memory");
        if constexpr (!Epi::AFTER_DRAIN) { int t_e = threadIdx.x; asm volatile("" : "+v"(t_e)); const int fr_e = t_e & 15, fq_e = (t_e >> 4) & 3; E(acc, cur, wr, wc, fr_e, fq_e, pre); }
        if (!has_next) break;
#pragma unroll
        for (int a = 0; a < 2; ++a)
#pragma unroll
            for (int b = 0; b < 2; ++b)
#pragma unroll
                for (int m = 0; m < 4; ++m)
#pragma unroll
                    for (int n = 0; n < 2; ++n) acc[a][b][m][n] = (f32x4){0.f, 0.f, 0.f, 0.f};
        cur = nxt; cA = nA; cB = nB; ++ui;
        if (GATHER) { PG8_PACKRAW(pkc); }
        if constexpr (ALIGN_EPI) { if (wr == 1) PG8_BAR; }
    }
    PG8_WAIT_V(0);
    if constexpr (!ALIGN_EPI) { if (wr == 0) PG8_BAR; }
    PG8_BAR;
    if constexpr (Epi::AFTER_DRAIN) { int t_e = threadIdx.x; asm volatile("" : "+v"(t_e)); const int fr_e = t_e & 15, fq_e = (t_e >> 4) & 3; E.fused(acc, cur, wr, wc, fr_e, fq_e, lds, wid, t_e & 63); }
#undef PG8_SA
#undef PG8_SB
#undef PG8_STGB
#undef PG8_LDA
#undef PG8_LDB
#undef PG8_MMA
#undef PG8_CAT
#undef PG8_LD16
#undef PG8_WAIT_V
#undef PG8_WAIT_L
#undef PG8_SCHED
#undef PG8_PKROWS
#undef PG8_RAWROWS
#undef PG8_PACKRAW
#undef PG8_STGA
}
}

namespace pg8 {
constexpr int NXCD = 8, WGM = 8;
__device__ __forceinline__ void tile_order(int L, int nM, int nN, int& pm, int& pn) {
    const int nwg = nM * nN; int wgid = L;
    { const int q = nwg / NXCD, r = nwg % NXCD, xcd = wgid % NXCD, off = wgid / NXCD; wgid = (xcd < r ? xcd * (q + 1) : r * (q + 1) + (xcd - r) * q) + off; }
    const int nig = WGM * nN, gid = wgid / nig, fm = gid * WGM, gsz = (nM - fm) < WGM ? (nM - fm) : WGM;
    pm = fm + ((wgid % nig) % gsz); pn = (wgid % nig) / gsz;
}
struct DenseOrder {
    const char* A; const char* B; int lda, ldb, nM, nN, G, c;
    __device__ __forceinline__ bool next(int i, Unit& u) const {
        const long L = (long)i * G + c; if (L >= (long)nM * nN) return false;
        int pm, pn; tile_order((int)L, nM, nN, pm, pn);
        u.pm = pm; u.pn = pn; u.aux = 0; u.rows = nullptr; u.nrows = 256; u.ntu = 0;
        u.A = A + (size_t)pm * 256 * lda * 2; u.B = B + (size_t)pn * 256 * ldb * 2; return true;
    }
};
struct KvOrder {
    const char* MN; const char* W; int L0;
    __device__ __forceinline__ bool next(int i, Unit& u) const {
        const int L = L0; if (i > 0 || L >= 64) return false;
        u.rows = nullptr; u.nrows = 256; u.ntu = 0; u.pm = L >> 3; const int ct = L & 7; u.aux = ct >> 2; u.pn = ct & 3;
        u.A = MN + (size_t)u.pm * 256 * D * 2; u.B = W + (size_t)ct * 256 * D * 2; return true;
    }
};
struct XmnOrder {
    const char* MK; const char* MV; const char* WQN; const char* WOT; int G, c;
    __device__ __forceinline__ bool next(int i, Unit& u) const {
        const int L = c + i * G; if (L >= 256) return false;
        u.rows = nullptr; u.nrows = 256; u.ntu = 0;
        if (L < 128) { const int b = L >> 4, h = (L >> 2) & 3, kt = L & 3; u.aux = 0; u.pm = b * 4 + h; u.pn = kt;
            u.A = MK + ((size_t)(b * 256) * D + h * 256) * 2; u.B = WQN + ((size_t)(kt * 256) * D + h * 256) * 2; }
        else { const int l = L - 128, b = l >> 4, nt = (l >> 2) & 3, h = l & 3; u.aux = 1; u.pm = b * 4 + nt; u.pn = h;
            u.A = WOT + ((size_t)(nt * 256) * D + h * 256) * 2; u.B = MV + ((size_t)(b * 256) * D + h * 256) * 2; }
        return true;
    }
};
struct P3Order {
    XmnOrder X; DenseOrder Dn;
    __device__ __forceinline__ bool next(int i, Unit& u) const {
        if (i == 0 && X.c < 256) { X.next(0, u); u.ntu = 4; return true; }
        const bool ok = Dn.next(X.c < 256 ? i - 1 : i, u); u.aux = 2; return ok;
    }
};
struct XbOrder {
    const char* A; const char* Bb; int G, c; size_t rb;
    __device__ __forceinline__ bool next(int i, Unit& u) const {
        const long L = (long)i * G + c; if (L >= 512) return false;
        int pm, pn; tile_order((int)L, T / 256, 4, pm, pn);
        u.pm = pm; u.pn = pn; u.aux = 0; u.rows = nullptr; u.nrows = 256; u.ntu = 0;
        u.A = A + (size_t)pm * 256 * rb; u.B = Bb + (size_t)(pm >> 4) * D * rb + (size_t)pn * 256 * rb; return true;
    }
};
struct MoeOrder {
    const char* A; const char* W; const int* list; const LAS int* cnt; const LAS unsigned char* te; const LAS int* ts;
    int ntiles, nN, G, c; size_t wstride; int gather; size_t atile, btile;
    __device__ __forceinline__ bool next(int i, Unit& u) const {
        const long L = (long)i * G + c; if (L >= (long)ntiles * nN) return false;
        int pm, pn; tile_order((int)L, ntiles, nN, pm, pn);
        const int e = __builtin_amdgcn_readfirstlane((int)te[pm]);
        const int lt = pm - __builtin_amdgcn_readfirstlane(ts[e]);
        const int n = __builtin_amdgcn_readfirstlane(cnt[e]) - lt * 256;
        u.pm = pm; u.pn = pn; u.aux = e; u.nrows = n < 256 ? n : 256; u.ntu = 0;
        u.rows = list + (size_t)e * T + lt * 256;
        u.A = gather ? A : A + (size_t)pm * atile;
        u.B = W + (size_t)e * wstride + (size_t)pn * btile; return true;
    }
};

struct EpiProj {
    static constexpr bool PERM = true, AFTER_DRAIN = false; struct Pre {}; __device__ __forceinline__ void prefetch(const Unit&, int, int, int, int, Pre&) const {}
    bf16_t* O; float* kbar;
    __device__ __forceinline__ void operator()(const f32x4 (&acc)[2][2][4][2], const Unit& u, int wr, int wc, int fr, int fq, const Pre&) const {
        const int pn = u.pn, sec = pn >> 1, b = u.pm >> 4, t0 = (u.pm & 15) * 256 + wr * 64 + fr;
        const int mode = (pn < 2) ? 1 : ((pn == 6 || pn == 7 || pn >= 12) ? 2 : 0);
        bf16_t* sb = O + (size_t)sec * SEC_ELEMS;
#pragma unroll
        for (int bj = 0; bj < 2; ++bj) {
            const int c = bj * HALF + wc * 32 + 8 * fq, head = (pn & 1) * 4 + (c >> 6), d0 = c & 63;
            bf16_t* hb = sb + (size_t)(b * 8 + head) * (SEQ * 64);
#pragma unroll
            for (int ai = 0; ai < 2; ++ai)
#pragma unroll
                for (int m = 0; m < 4; ++m) { const int t = t0 + ai * HALF + m * 16;
                    f32x4 v0 = acc[ai][bj][m][0], v1 = acc[ai][bj][m][1];
                    if (mode == 1) { v0 = v0 * C2Q; v1 = v1 * C2Q; }
                    else if (mode == 2) {
#pragma unroll
                        for (int e = 0; e < 4; ++e) { v0[e] = silu_f(v0[e]); v1[e] = silu_f(v1[e]); } }
                    u32x4 w; w.x = cvtpk(v0[0], v0[1]); w.y = cvtpk(v0[2], v0[3]); w.z = cvtpk(v1[0], v1[1]); w.w = cvtpk(v1[2], v1[3]);
                    size_t off;
                    if (sec == 1) off = (size_t)(t >> 6) * 4096 + (d0 >> 3) * 512 + (t & 63) * 8;
                    else if (sec == 2) off = (size_t)(t >> 6) * 4096 + (d0 >> 5) * 2048 + (t & 63) * 32 + (d0 & 31);
                    else off = (size_t)t * 64 + d0;
                    *(u32x4*)(hb + off) = w; } }
        if (pn == 2 || pn == 3) {
#pragma unroll
            for (int bj = 0; bj < 2; ++bj)
#pragma unroll
                for (int n = 0; n < 2; ++n)
#pragma unroll
                    for (int e = 0; e < 4; ++e) { float s = 0.f;
#pragma unroll
                        for (int ai = 0; ai < 2; ++ai)
#pragma unroll
                            for (int m = 0; m < 4; ++m) s += acc[ai][bj][m][n][e];
                        s += __shfl_xor(s, 1); s += __shfl_xor(s, 2); s += __shfl_xor(s, 4); s += __shfl_xor(s, 8);
                        if (fr == 0) { const int c = bj * HALF + wc * 32 + 8 * fq + 4 * n + e, head = (pn - 2) * 4 + (c >> 6), d = c & 63;
                            atomicAdd(kbar + ((size_t)u.pm * 8 + head) * 64 + d, s); } }
        }
    }
};
struct EpiBf16 {
    static constexpr bool PERM = true, AFTER_DRAIN = false; struct Pre {}; __device__ __forceinline__ void prefetch(const Unit&, int, int, int, int, Pre&) const {}
    bf16_t* O0; int ldc0; bf16_t* O1; int ldc1;
    __device__ __forceinline__ void operator()(const f32x4 (&acc)[2][2][4][2], const Unit& u, int wr, int wc, int fr, int fq, const Pre&) const {
        bf16_t* O = u.aux ? O1 : O0; const int ldc = u.aux ? ldc1 : ldc0;
        const int row0 = u.pm * BM + wr * 64 + fr, col0 = u.pn * BM + wc * 32 + 8 * fq;
#pragma unroll
        for (int ai = 0; ai < 2; ++ai)
#pragma unroll
            for (int m = 0; m < 4; ++m) { bf16_t* rowp = O + (size_t)(row0 + ai * HALF + m * 16) * ldc + col0;
#pragma unroll
                for (int bj = 0; bj < 2; ++bj) { const f32x4 v0 = acc[ai][bj][m][0], v1 = acc[ai][bj][m][1];
                    u32x4 w; w.x = cvtpk(v0[0], v0[1]); w.y = cvtpk(v0[2], v0[3]); w.z = cvtpk(v1[0], v1[1]); w.w = cvtpk(v1[2], v1[3]);
                    *(u32x4*)(rowp + bj * HALF) = w; } }
    }
};
struct EpiFp8 {
    static constexpr bool PERM = true, AFTER_DRAIN = false; struct Pre {}; __device__ __forceinline__ void prefetch(const Unit&, int, int, int, int, Pre&) const {}
    unsigned char* O0; int ldc0; unsigned char* O1; int ldc1; float scale;
    __device__ __forceinline__ void operator()(const f32x4 (&acc)[2][2][4][2], const Unit& u, int wr, int wc, int fr, int fq, const Pre&) const {
        unsigned char* O = u.aux ? O1 : O0; const int ldc = u.aux ? ldc1 : ldc0;
        const int row0 = u.pm * BM + wr * 64 + fr, col0 = u.pn * BM + wc * 32 + 8 * fq;
#pragma unroll
        for (int ai = 0; ai < 2; ++ai)
#pragma unroll
            for (int m = 0; m < 4; ++m) { unsigned char* rowp = O + (size_t)(row0 + ai * HALF + m * 16) * ldc + col0;
#pragma unroll
                for (int bj = 0; bj < 2; ++bj) { const f32x4 v0 = acc[ai][bj][m][0] * scale, v1 = acc[ai][bj][m][1] * scale;
                    *(u32x2*)(rowp + bj * HALF) = (u32x2){pk4_fp8(v0[0], v0[1], v0[2], v0[3]), pk4_fp8(v1[0], v1[1], v1[2], v1[3])}; } }
    }
};
template <bool BASE_F32, bool WRITE_F32, bool OUT_FP8 = false> struct EpiRes {
    static constexpr bool PERM = true, AFTER_DRAIN = false; struct Pre {}; __device__ __forceinline__ void prefetch(const Unit&, int, int, int, int, Pre&) const {}
    const void* base; bf16_t* Ob; float* Of; float* ss; float asc; unsigned char* Oq;
    __device__ __forceinline__ void operator()(const f32x4 (&acc)[2][2][4][2], const Unit& u, int wr, int wc, int fr, int fq, const Pre&) const {
        const int row0 = u.pm * BM + wr * 64 + fr, col0 = u.pn * BM + wc * 32 + 8 * fq;
#pragma unroll
        for (int ai = 0; ai < 2; ++ai)
#pragma unroll
            for (int m = 0; m < 4; ++m) { const int row = row0 + ai * HALF + m * 16; const size_t off = (size_t)row * D + col0; float sq = 0.f;
#pragma unroll
                for (int bj = 0; bj < 2; ++bj) { f32x4 b0, b1;
                    if (BASE_F32) { b0 = *(const f32x4*)((const float*)base + off + bj * HALF); b1 = *(const f32x4*)((const float*)base + off + bj * HALF + 4); }
                    else { const u32x4 w = *(const u32x4*)((const bf16_t*)base + off + bj * HALF);
                        b0 = (f32x4){bflo(w.x), bfhi(w.x), bflo(w.y), bfhi(w.y)}; b1 = (f32x4){bflo(w.z), bfhi(w.z), bflo(w.w), bfhi(w.w)}; }
                    const f32x4 v0 = acc[ai][bj][m][0] * asc + b0, v1 = acc[ai][bj][m][1] * asc + b1;
                    sq += (v0[0] * v0[0] + v0[1] * v0[1]) + (v0[2] * v0[2] + v0[3] * v0[3]) + (v1[0] * v1[0] + v1[1] * v1[1]) + (v1[2] * v1[2] + v1[3] * v1[3]);
                    if (OUT_FP8) { *(u32x2*)((unsigned char*)Ob + off + bj * HALF) = (u32x2){pk4_fp8(v0[0], v0[1], v0[2], v0[3]), pk4_fp8(v1[0], v1[1], v1[2], v1[3])}; }
                    else { u32x4 w; w.x = cvtpk(v0[0], v0[1]); w.y = cvtpk(v0[2], v0[3]); w.z = cvtpk(v1[0], v1[1]); w.w = cvtpk(v1[2], v1[3]);
                    *(u32x4*)(Ob + off + bj * HALF) = w; }
                    if (Oq) *(u32x2*)(Oq + off + bj * HALF) = (u32x2){pk4_fp8(v0[0], v0[1], v0[2], v0[3]), pk4_fp8(v1[0], v1[1], v1[2], v1[3])};
                    if (WRITE_F32) { *(f32x4*)(Of + off + bj * HALF) = v0; *(f32x4*)(Of + off + bj * HALF + 4) = v1; } }
                sq += __shfl_xor(sq, 16); sq += __shfl_xor(sq, 32);
                if (fq == 0) atomicAdd(ss + row, sq); }
    }
};
struct EpiP3 {
    static constexpr bool PERM = true, AFTER_DRAIN = false; struct Pre {}; __device__ __forceinline__ void prefetch(const Unit&, int, int, int, int, Pre&) const {}
    EpiFp8 a; EpiRes<true, false> b;
    __device__ __forceinline__ void operator()(const f32x4 (&acc)[2][2][4][2], const Unit& u, int wr, int wc, int fr, int fq, const Pre&) const {
        if (u.aux < 2) a(acc, u, wr, wc, fr, fq, EpiFp8::Pre{}); else b(acc, u, wr, wc, fr, fq, EpiRes<true, false>::Pre{});
    }
};
struct EpiQ {
    static constexpr bool PERM = true, AFTER_DRAIN = false; struct Pre {}; __device__ __forceinline__ void prefetch(const Unit&, int, int, int, int, Pre&) const {}
    bf16_t* O; const float* ss;
    __device__ __forceinline__ void operator()(const f32x4 (&acc)[2][2][4][2], const Unit& u, int wr, int wc, int fr, int fq, const Pre&) const {
        const int row0 = u.pm * BM + wr * 64 + fr, col0 = u.pn * BM + wc * 32 + 8 * fq;
#pragma unroll
        for (int ai = 0; ai < 2; ++ai)
#pragma unroll
            for (int m = 0; m < 4; ++m) { const int row = row0 + ai * HALF + m * 16; const float sc = C2X * __builtin_amdgcn_rsqf(ss[row] * (1.0f / D) + EPS);
                bf16_t* rowp = O + (size_t)row * D + col0;
#pragma unroll
                for (int bj = 0; bj < 2; ++bj) { const f32x4 v0 = acc[ai][bj][m][0] * sc, v1 = acc[ai][bj][m][1] * sc;
                    u32x4 w; w.x = cvtpk(v0[0], v0[1]); w.y = cvtpk(v0[2], v0[3]); w.z = cvtpk(v1[0], v1[1]); w.w = cvtpk(v1[2], v1[3]);
                    *(u32x4*)(rowp + bj * HALF) = w; } }
    }
};
struct EpiSoftmaxS {
    static constexpr bool PERM = true, AFTER_DRAIN = false; struct Pre {}; __device__ __forceinline__ void prefetch(const Unit&, int, int, int, int, Pre&) const {}
    unsigned char* P; const float* ss; LAS unsigned char* tb; float qs;
    __device__ __forceinline__ void operator()(f32x4 (&acc)[2][2][4][2], const Unit& u, int wr, int wc, int fr, int fq, const Pre&) const {
        LAS float* MX = (LAS float*)tb;
        LAS float* SM = (LAS float*)(tb + 4096);
#pragma unroll
        for (int ai = 0; ai < 2; ++ai)
#pragma unroll
            for (int m = 0; m < 4; ++m) { const int r = ai * HALF + wr * 64 + m * 16 + fr; const float sc = qs * C2X * __builtin_amdgcn_rsqf(ss[u.pm * BM + r] * (1.0f / D) + EPS); float mx = -3.0e38f;
#pragma unroll
                for (int bj = 0; bj < 2; ++bj)
#pragma unroll
                    for (int n = 0; n < 2; ++n) { f32x4 x = acc[ai][bj][m][n] * sc; acc[ai][bj][m][n] = x; mx = fmaxf(mx, fmaxf(fmaxf(x[0], x[1]), fmaxf(x[2], x[3]))); }
                mx = fmaxf(mx, __shfl_xor(mx, 16)); mx = fmaxf(mx, __shfl_xor(mx, 32));
                if (fq == 0) MX[r * 4 + wc] = mx; }
        LDS_WAIT(); __builtin_amdgcn_s_barrier(); asm volatile("" ::: "memory");
#pragma unroll
        for (int ai = 0; ai < 2; ++ai)
#pragma unroll
            for (int m = 0; m < 4; ++m) { const int r = ai * HALF + wr * 64 + m * 16 + fr; const f32x4 q = *(const LAS f32x4*)(MX + r * 4);
                const float mx = fmaxf(fmaxf(q[0], q[1]), fmaxf(q[2], q[3])); float sm = 0.f;
#pragma unroll
                for (int bj = 0; bj < 2; ++bj)
#pragma unroll
                    for (int n = 0; n < 2; ++n) { f32x4 x = acc[ai][bj][m][n];
#pragma unroll
                        for (int e = 0; e < 4; ++e) { x[e] = fast_exp2(x[e] - mx); sm += x[e]; }
                        acc[ai][bj][m][n] = x; }
                sm += __shfl_xor(sm, 16); sm += __shfl_xor(sm, 32);
                if (fq == 0) SM[r * 4 + wc] = sm; }
        LDS_WAIT(); __builtin_amdgcn_s_barrier(); asm volatile("" ::: "memory");
        const int col0 = u.pn * BM + wc * 32 + 8 * fq;
#pragma unroll
        for (int ai = 0; ai < 2; ++ai)
#pragma unroll
            for (int m = 0; m < 4; ++m) { const int r = ai * HALF + wr * 64 + m * 16 + fr; const f32x4 q = *(const LAS f32x4*)(SM + r * 4);
                const float inv = PSCALE8 * fast_rcp((q[0] + q[1]) + (q[2] + q[3]));
#pragma unroll
                for (int bj = 0; bj < 2; ++bj) { const f32x4 v0 = acc[ai][bj][m][0] * inv, v1 = acc[ai][bj][m][1] * inv;
                    *(u32x2*)(P + ((size_t)u.pm * BM + r) * D + bj * HALF + col0) = (u32x2){pk4_fp8(v0[0], v0[1], v0[2], v0[3]), pk4_fp8(v1[0], v1[1], v1[2], v1[3])}; } }
        LDS_WAIT(); __builtin_amdgcn_s_barrier(); asm volatile("" ::: "memory");
    }
};
struct EpiW1 {
    static constexpr bool PERM = true, AFTER_DRAIN = false;
    struct Pre { float sc[8]; f32x4 bq[4]; };
    bf16_t* O; const float* ssl; const float* b1; const int* list0;
    __device__ __forceinline__ void prefetch(const Unit& u, int wr, int wc, int fr, int fq, Pre& p) const {
        const float* sp = ssl + (u.rows - list0);
        { const float* bb = b1 + (size_t)u.aux * 2048 + 2 * (u.pn * 128); const unsigned bo = (unsigned)(2 * (wc * 32 + 8 * fq)) * 4u;
#pragma unroll
          for (int q = 0; q < 4; ++q) p.bq[q] = gload128_hidden(bb, bo + 16u * q); }
#pragma unroll
        for (int ai = 0; ai < 2; ++ai)
#pragma unroll
            for (int m = 0; m < 4; ++m) { const int r = ai * HALF + wr * 64 + m * 16 + fr; const int rr = r < u.nrows ? r : u.nrows - 1; p.sc[ai * 4 + m] = __uint_as_float(gload32_hidden(sp, (unsigned)rr * 4u)); }
    }
    __device__ __forceinline__ void operator()(const f32x4 (&acc)[2][2][4][2], const Unit& u, int wr, int wc, int fr, int fq, const Pre& pre) const {
        const int c0 = wc * 32 + 8 * fq;
        f32x4 bq0 = pre.bq[0], bq1 = pre.bq[1], bq2 = pre.bq[2], bq3 = pre.bq[3]; asm volatile("" : "+v"(bq0), "+v"(bq1), "+v"(bq2), "+v"(bq3));
        const float bg[8] = {bq0[0], bq0[2], bq1[0], bq1[2], bq2[0], bq2[2], bq3[0], bq3[2]};
        const float bl[8] = {bq0[1], bq0[3], bq1[1], bq1[3], bq2[1], bq2[3], bq3[1], bq3[3]};
#pragma unroll
        for (int ai = 0; ai < 2; ++ai)
#pragma unroll
            for (int m = 0; m < 4; ++m) { const int r = ai * HALF + wr * 64 + m * 16 + fr;
                float ssv = pre.sc[ai * 4 + m]; asm volatile("" : "+v"(ssv));
                const float sc = WSCALE8_INV * __builtin_amdgcn_rsqf(ssv * (1.0f / D) + EPS); float a[8];
#pragma unroll
                for (int j = 0; j < 8; ++j) { const float g = acc[ai][0][m][j >> 2][j & 3] * sc + bg[j], l = acc[ai][1][m][j >> 2][j & 3] * sc + bl[j];
                    const float glu = fminf(g, 7.0f), lin = fminf(fmaxf(l, -7.0f), 7.0f);
                    a[j] = glu * fast_rcp(1.0f + fast_exp2(-1.702f * LOG2E * glu)) * (lin + 1.0f); }
                *(u32x2*)((unsigned char*)O + ((size_t)u.pm * BM + r) * D + u.pn * 128 + c0) = (u32x2){pk4_fp8(a[0], a[1], a[2], a[3]), pk4_fp8(a[4], a[5], a[6], a[7])}; }
    }
};
constexpr float YSCALE = 16.0f, YSCALE_INV = 1.0f / 16.0f;
struct EpiW2 {
    static constexpr bool PERM = true, AFTER_DRAIN = false;
    struct Pre { float g[8]; f32x4 bv[4]; };
    unsigned char* O; const float* b2; const int* list0; const float* gl0;
    __device__ __forceinline__ void prefetch(const Unit& u, int wr, int wc, int fr, int fq, Pre& p) const {
        const float* gp = gl0 + (u.rows - list0);
        { const float* bb = b2 + (size_t)u.aux * D + u.pn * BM; const unsigned bo = (unsigned)(wc * 32 + 8 * fq) * 4u;
#pragma unroll
          for (int q = 0; q < 4; ++q) p.bv[q] = gload128_hidden(bb, bo + (unsigned)((q >> 1) * HALF * 4 + (q & 1) * 16)); }
#pragma unroll
        for (int ai = 0; ai < 2; ++ai)
#pragma unroll
            for (int m = 0; m < 4; ++m) { const int r = ai * HALF + wr * 64 + m * 16 + fr; const int rr = r < u.nrows ? r : u.nrows - 1; p.g[ai * 4 + m] = __uint_as_float(gload32_hidden(gp, (unsigned)rr * 4u)); }
    }
    __device__ __forceinline__ void operator()(const f32x4 (&acc)[2][2][4][2], const Unit& u, int wr, int wc, int fr, int fq, const Pre& pre) const {
        const int row0 = u.pm * BM + wr * 64 + fr, col0 = u.pn * BM + wc * 32 + 8 * fq;
        f32x4 bv[2][2]; bv[0][0] = pre.bv[0]; bv[0][1] = pre.bv[1]; bv[1][0] = pre.bv[2]; bv[1][1] = pre.bv[3]; asm volatile("" : "+v"(bv[0][0]), "+v"(bv[0][1]), "+v"(bv[1][0]), "+v"(bv[1][1]));
#pragma unroll
        for (int ai = 0; ai < 2; ++ai)
#pragma unroll
            for (int m = 0; m < 4; ++m) { unsigned char* rowp = O + (size_t)(row0 + ai * HALF + m * 16) * D + col0; float gv = pre.g[ai * 4 + m]; asm volatile("" : "+v"(gv)); const float g = YSCALE * gv;
#pragma unroll
                for (int bj = 0; bj < 2; ++bj) { const f32x4 v0 = (acc[ai][bj][m][0] * WSCALE8_INV + bv[bj][0]) * g, v1 = (acc[ai][bj][m][1] * WSCALE8_INV + bv[bj][1]) * g;
                    *(u32x2*)(rowp + bj * HALF) = (u32x2){pk4_fp8(v0[0], v0[1], v0[2], v0[3]), pk4_fp8(v1[0], v1[1], v1[2], v1[3])}; } }
    }
};
}

namespace moba {
using bf16x8 = ::bf16x8; using s16x4 = ::s16x4; using f32x16 = ::f32x16; using u32x4 = ::u32x4;
constexpr int DMQ = INC, DMO = D, HD = 64;
constexpr int NW = 8, QBLK = 32, QB = 256, KVBLK = 64;
__device__ __forceinline__ int crow(int r, int hi) { return (r & 3) + 8 * (r >> 2) + 4 * hi; }
#define SBAR() __builtin_amdgcn_sched_barrier(0)
__device__ __forceinline__ void cmask(f32x16& p0, f32x16& p1, int jb, int qrel, int hi) {
    const float NEG = -INFINITY; int kb = 64 * jb + 4 * hi;
#pragma unroll
    for (int r = 0; r < 16; ++r) { int kv = kb + (r & 3) + 8 * (r >> 2); if (kv > qrel) p0[r] = NEG; if (kv + 32 > qrel) p1[r] = NEG; }
}
constexpr int NSLOT = 3, SLOTB = 8192;
constexpr int LDS_K = 0, LDS_V = NSLOT * SLOTB, LDS_WS = 2 * NSLOT * SLOTB, LDS_OST = LDS_WS + NW * 64 * 4, LDS_KB = LDS_OST + NW * 4096, LDS_BYTES = LDS_KB + 16 * 64 * 4;
__device__ __forceinline__ void glds16(const void* gsrc, unsigned lds_dst) { unsigned keep;
    asm volatile("s_mov_b32 %0, m0\n\ts_mov_b32 m0, %2\n\ts_nop 0\n\tglobal_load_lds_dwordx4 %1, off\n\ts_mov_b32 m0, %0" : "=&s"(keep) : "v"(gsrc), "s"(lds_dst) : "memory"); }
__device__ __forceinline__ float max3f(float a, float b, float c) { float r; asm("v_max3_f32 %0, %1, %2, %3" : "=v"(r) : "v"(a), "v"(b), "v"(c)); return r; }
__device__ __forceinline__ float max2f(float a, float b) { float r; asm("v_max_f32_e32 %0, %1, %2" : "=v"(r) : "v"(a), "v"(b)); return r; }
__device__ __forceinline__ float fadd_s(float a, float b) { float r; asm("v_add_f32_e32 %0, %1, %2" : "=v"(r) : "v"(a), "v"(b)); return r; }
__device__ __forceinline__ float fsub_s(float a, float b) { float r; asm("v_sub_f32_e32 %0, %1, %2" : "=v"(r) : "v"(a), "v"(b)); return r; }
__device__ __forceinline__ unsigned cvtpk_s(float lo, float hi) { return ::cvtpk(lo, hi); }
#define WAIT_BAR(N) asm volatile("s_waitcnt vmcnt(" #N ") lgkmcnt(0)\n\ts_barrier" ::: "memory")
__device__ __forceinline__ void qkt(f32x16& p0, f32x16& p1, const char* Kslot, const bf16x8* qr, const f32x16& negm, int r32, int hi) {
    const char* kb = Kslot + hi * 1024 + r32 * 16;
#pragma unroll
    for (int d0 = 0; d0 < 4; ++d0) {
        const bf16x8 b0 = *reinterpret_cast<const bf16x8*>(kb + d0 * 2048);
        const bf16x8 b1 = *reinterpret_cast<const bf16x8*>(kb + d0 * 2048 + 512);
        if (d0 == 0) { p0 = __builtin_amdgcn_mfma_f32_32x32x16_bf16(b0, qr[0], negm, 0, 0, 0); p1 = __builtin_amdgcn_mfma_f32_32x32x16_bf16(b1, qr[0], negm, 0, 0, 0); }
        else { p0 = __builtin_amdgcn_mfma_f32_32x32x16_bf16(b0, qr[d0], p0, 0, 0, 0); p1 = __builtin_amdgcn_mfma_f32_32x32x16_bf16(b1, qr[d0], p1, 0, 0, 0); } }
}
typedef __attribute__((address_space(3))) const char* lds_cptr;
typedef short v4i16_t __attribute__((ext_vector_type(4)));
__device__ __forceinline__ void kload8(bf16x8* kf, lds_cptr kp) {
    kf[0] = *(const __attribute__((address_space(3))) bf16x8*)(kp);        kf[1] = *(const __attribute__((address_space(3))) bf16x8*)(kp + 512);
    kf[2] = *(const __attribute__((address_space(3))) bf16x8*)(kp + 2048); kf[3] = *(const __attribute__((address_space(3))) bf16x8*)(kp + 2560);
    kf[4] = *(const __attribute__((address_space(3))) bf16x8*)(kp + 4096); kf[5] = *(const __attribute__((address_space(3))) bf16x8*)(kp + 4608);
    kf[6] = *(const __attribute__((address_space(3))) bf16x8*)(kp + 6144); kf[7] = *(const __attribute__((address_space(3))) bf16x8*)(kp + 6656);
}
__device__ __forceinline__ void kload2(bf16x8* kf, lds_cptr kp, int j) { kf[2 * j] = *(const __attribute__((address_space(3))) bf16x8*)(kp + j * 2048); kf[2 * j + 1] = *(const __attribute__((address_space(3))) bf16x8*)(kp + j * 2048 + 512); }
__device__ __forceinline__ s16x4 vtr(lds_cptr p) { return __builtin_bit_cast(s16x4, __builtin_amdgcn_ds_read_tr16_b64_v4i16((__attribute__((address_space(3))) v4i16_t*)p)); }
__device__ __forceinline__ float rowmax(const f32x16& p0, const f32x16& p1) {
    float a = max3f(p0[0], p0[1], p1[0]), b = max3f(p0[2], p0[3], p1[1]); a = max3f(a, p1[2], p1[3]);
#pragma unroll
    for (int r = 4; r < 16; r += 4) { a = max3f(a, p0[r], p0[r + 1]); b = max3f(b, p0[r + 2], p0[r + 3]); a = max3f(a, p1[r], p1[r + 1]); b = max3f(b, p1[r + 2], p1[r + 3]); }
    const float m = max2f(a, b);
    auto rr = __builtin_amdgcn_permlane32_swap(__float_as_uint(m), __float_as_uint(m), false, false);
    return max2f(__uint_as_float(rr[0]), __uint_as_float(rr[1]));
}
__device__ __forceinline__ void pv(f32x16* o, int vb, bf16x8 pa0, bf16x8 pa1, bf16x8 pa2, bf16x8 pa3) {
#pragma unroll
    for (int d0 = 0; d0 < 2; ++d0) { s16x4 lo[4], hi[4];
#pragma unroll
        for (int ks = 0; ks < 4; ++ks) {
            asm volatile("ds_read_b64_tr_b16 %0,%1 offset:%c2" : "=&v"(lo[ks]) : "v"(vb), "i"(d0 * 4096 + ks * 1024) : "memory");
            asm volatile("ds_read_b64_tr_b16 %0,%1 offset:%c2" : "=&v"(hi[ks]) : "v"(vb), "i"(d0 * 4096 + ks * 1024 + 512) : "memory"); }
        asm volatile("s_waitcnt lgkmcnt(0)" ::: "memory"); SBAR();
#define PK(k) (bf16x8){lo[k][0], lo[k][1], lo[k][2], lo[k][3], hi[k][0], hi[k][1], hi[k][2], hi[k][3]}
        o[d0] = __builtin_amdgcn_mfma_f32_32x32x16_bf16(pa0, PK(0), o[d0], 0, 0, 0);
        o[d0] = __builtin_amdgcn_mfma_f32_32x32x16_bf16(pa1, PK(1), o[d0], 0, 0, 0);
        o[d0] = __builtin_amdgcn_mfma_f32_32x32x16_bf16(pa2, PK(2), o[d0], 0, 0, 0);
        o[d0] = __builtin_amdgcn_mfma_f32_32x32x16_bf16(pa3, PK(3), o[d0], 0, 0, 0);
#undef PK
    }
}
constexpr float NEGBIG = -1.0e30f;

template <int THRL> __device__ __forceinline__ void attn_unit(int b, int h, int qb, const bf16_t* Qg, const bf16_t* __restrict__ Kg, const bf16_t* __restrict__ Vg, bf16_t* Og, const float* __restrict__ kbar, char* shm) {
    int tid_ = threadIdx.x; asm volatile("" : "+v"(tid_));
    const int tid = tid_, lane = tid & 63, r32 = lane & 31, hi = lane >> 5; const int wid = __builtin_amdgcn_readfirstlane(tid >> 6);
    const long rowbase = (long)b * SEQ; const int q0 = qb * QB;
    const size_t hoff = (size_t)(b * 8 + h) * (SEQ * 64);
    const bf16_t* Qw = Qg + hoff + (size_t)(q0 + wid * QBLK) * 64;
    const bf16_t* Kh = Kg + hoff, *Vh = Vg + hoff;
    const unsigned lds0 = (unsigned)(uintptr_t)shm;
    float* wsf = (float*)(shm + LDS_WS) + wid * 64;
    const bf16_t* ksrc = Kh + wid * 512 + lane * 8;
    const bf16_t* vsrc = Vh + wid * 512 + lane * 8;
    const unsigned kdst = lds0 + LDS_K + wid * 1024, vdst = lds0 + LDS_V + wid * 1024;
    const int NT = 4 * qb + 4, NPAST = 4 * qb;
#define TMAP(t) (((t) < 4) ? (NPAST + (t)) : ((t) - 4))
#define DMA_K(t, slot) glds16(ksrc + (long)TMAP(t) * 4096, (unsigned)__builtin_amdgcn_readfirstlane(kdst + (slot)))
#define DMA_V(t, slot) glds16(vsrc + (long)TMAP(t) * 4096, (unsigned)__builtin_amdgcn_readfirstlane(vdst + (slot)))
    const char* Kbase = shm + LDS_K; bf16x8 kf[8];
    const lds_cptr shm3 = (lds_cptr)shm; const lds_cptr kp0 = shm3 + LDS_K + hi * 1024 + r32 * 16; const lds_cptr vp0 = shm3 + LDS_V + ((lane >> 4) & 1) * 32 + (lane & 3) * 8 + (4 * hi + ((lane & 15) >> 2)) * 64;
    DMA_K(0, 0); DMA_V(0, 0); DMA_K(1, SLOTB);
    bf16x8 qr[4];
#pragma unroll
    for (int d0 = 0; d0 < 4; ++d0) qr[d0] = *reinterpret_cast<const bf16x8*>(&Qw[(long)r32 * 64 + d0 * 16 + hi * 8]);
    unsigned selm = 0u;
    if (qb > 0) {
        float* kbl = (float*)(shm + LDS_KB);
        for (int i = tid; i < qb * 64; i += NW * 64) kbl[i] = kbar[((size_t)(b * 16 + (i >> 6)) * 8 + h) * 64 + (i & 63)];
        asm volatile("s_waitcnt vmcnt(0) lgkmcnt(0)\n\ts_barrier" ::: "memory");
        if (qb <= 3) selm = (1u << qb) - 1u;
        else {
            float qf[32];
#pragma unroll
            for (int d0 = 0; d0 < 4; ++d0)
#pragma unroll
                for (int j = 0; j < 8; ++j) qf[d0 * 8 + j] = bf2f((unsigned short)qr[d0][j]);
            float g[15];
#pragma unroll
            for (int n = 0; n < 15; ++n) { float s = 0.f;
                if (n < qb) {
#pragma unroll
                    for (int d0 = 0; d0 < 4; ++d0) { const f32x4 k0 = *(const f32x4*)(kbl + n * 64 + d0 * 16 + hi * 8), k1 = *(const f32x4*)(kbl + n * 64 + d0 * 16 + hi * 8 + 4);
                        s += qf[d0 * 8 + 0] * k0[0] + qf[d0 * 8 + 1] * k0[1] + qf[d0 * 8 + 2] * k0[2] + qf[d0 * 8 + 3] * k0[3] + qf[d0 * 8 + 4] * k1[0] + qf[d0 * 8 + 5] * k1[1] + qf[d0 * 8 + 6] * k1[2] + qf[d0 * 8 + 7] * k1[3]; }
                    s += __shfl_xor(s, 32);
                } else s = -INFINITY;
                g[n] = s; }
#pragma unroll
            for (int pass = 0; pass < 3; ++pass) { float best = -INFINITY; int bi = 0;
#pragma unroll
                for (int n = 0; n < 15; ++n) if (g[n] > best) { best = g[n]; bi = n; }
                selm |= 1u << bi;
#pragma unroll
                for (int n = 0; n < 15; ++n) if (n == bi) g[n] = -INFINITY; }
        }
    }
    float mhat = 0.f, l_reg = 0.f; f32x16 o[2]; o[0] = f32x16{}; o[1] = f32x16{}; f32x16 cini = f32x16{}; asm volatile("" : "+v"(cini));
    const int qrel = wid * QBLK + r32;
#define SETC(t, JB) do { const float cm_ = ((JB >= 0) || ((selm >> (((t) - 4) >> 2)) & 1u)) ? -mhat : NEGBIG; \
      _Pragma("unroll") for (int r = 0; r < 16; ++r) cini[r] = cm_; asm volatile("" : "+v"(cini)); } while (0)
    bool resc = false;
#define START(P0, P1) do { const float rm = rowmax(P0, P1); resc = false; \
    { const float dl = rm; mhat = fadd_s(mhat, dl); \
      _Pragma("unroll") for (int r = 0; r < 16; ++r) { P0[r] = fsub_s(P0[r], dl); P1[r] = fsub_s(P1[r], dl); } } \
    _Pragma("unroll") for (int r = 0; r < 16; ++r) P0[r] = __builtin_amdgcn_exp2f(P0[r]); } while (0)
#define RESC() do { if (resc) { asm volatile("s_waitcnt lgkmcnt(0)" ::: "memory"); \
      _Pragma("unroll") for (int d_ = 0; d_ < 2; ++d_) _Pragma("unroll") for (int r = 0; r < 16; ++r) o[d_][r] *= wsf[crow(r, hi)]; } } while (0)
    f32x16 pA0, pA1, pB0, pB1;
    int sl_prev = 0, sl_cur = 0, sl_next = SLOTB;
#define ROT() do { sl_prev = sl_cur; sl_cur = sl_next; sl_next = (sl_next == (NSLOT - 1) * SLOTB) ? 0 : sl_next + SLOTB; } while (0)
    DMA_K(2, 2 * SLOTB);
    if (qb > 0) { WAIT_BAR(0); } else { WAIT_BAR(3); }
    qkt(pA0, pA1, Kbase, qr, cini, r32, hi); asm volatile("s_nop 15\n\ts_nop 7" : "+v"(pA0), "+v"(pA1)); cmask(pA0, pA1, 0, qrel, hi);
    START(pA0, pA1);
    _Pragma("unroll") for (int r = 0; r < 16; ++r) pA1[r] = __builtin_amdgcn_exp2f(pA1[r]);
    WAIT_BAR(0);
    DMA_K(3, 0); DMA_V(1, SLOTB);
    ROT();
    kload8(kf, kp0 + sl_cur);
    WAIT_BAR(2);
    s16x4 vlo[8], vhi[8]; u32x4 pw0, pw1, pw2, pw3;
#define PKW(P, B) cvtpk_s(P[B], P[B + 1])
#define PAF(k) __builtin_bit_cast(bf16x8, pw##k)
#define VFR(i) (bf16x8){vlo[i][0], vlo[i][1], vlo[i][2], vlo[i][3], vhi[i][0], vhi[i][1], vhi[i][2], vhi[i][3]}
#define PIN(x) asm volatile("" : "+v"(x))
#define MX3(a, b, c) __builtin_fmaxf(__builtin_fmaxf((a), (b)), (c))
#define GAPA(MF, A0, A1, A2, A3, W0, W1, PW) do { MF; sacc += A0; sacc += A1; sacc += A2; sacc += A3; PIN(sacc); W0; W1; PIN(PW); SBAR(); } while (0)
#define EX(v) __builtin_amdgcn_exp2f(v)
#define GAPB(MF, X, B) do { MF; X[B] = EX(X[B]); X[B + 1] = EX(X[B + 1]); X[B + 2] = EX(X[B + 2]); X[B + 3] = EX(X[B + 3]); PIN(X); SBAR(); } while (0)
#define VRD(i) do { vlo[i] = vtr(vp_ + (((i) >> 2) * 4096 + ((i) & 3) * 1024)); vhi[i] = vtr(vp_ + (((i) >> 2) * 4096 + ((i) & 3) * 1024 + 512)); } while (0)
#define KRD(G, j) do { if (G) { kload2(kf, kp0 + sl_next, j); SBAR(); } } while (0)
#define STEP(C0, C1, P0, P1, t, GK, GV, GL, JB) do { SETC(t, JB); SBAR(); \
    const lds_cptr vp_ = vp0 + sl_prev; \
    VRD(0); SBAR(); float sacc = (P0[0] + P0[1]); \
    GAPA(C0 = __builtin_amdgcn_mfma_f32_32x32x16_bf16(kf[0], qr[0], cini, 0, 0, 0), P0[2], P0[3], P0[4], P0[5],     pw0[0] = PKW(P0, 0), pw0[1] = PKW(P0, 2), pw0); \
    VRD(4); SBAR(); GAPA(C1 = __builtin_amdgcn_mfma_f32_32x32x16_bf16(kf[1], qr[0], cini, 0, 0, 0), P0[6], P0[7], P0[8], P0[9],     pw0[2] = PKW(P0, 4), pw0[3] = PKW(P0, 6), pw0); \
    VRD(1); SBAR(); GAPA(C0 = __builtin_amdgcn_mfma_f32_32x32x16_bf16(kf[2], qr[1], C0, 0, 0, 0),   P0[10], P0[11], P0[12], P0[13], pw1[0] = PKW(P0, 8), pw1[1] = PKW(P0, 10), pw1); \
    VRD(5); SBAR(); GAPA(C1 = __builtin_amdgcn_mfma_f32_32x32x16_bf16(kf[3], qr[1], C1, 0, 0, 0),   P0[14], P0[15], P1[0], P1[1],   pw1[2] = PKW(P0, 12), pw1[3] = PKW(P0, 14), pw1); \
    VRD(2); SBAR(); GAPA(C0 = __builtin_amdgcn_mfma_f32_32x32x16_bf16(kf[4], qr[2], C0, 0, 0, 0),   P1[2], P1[3], P1[4], P1[5],     pw2[0] = PKW(P1, 0), pw2[1] = PKW(P1, 2), pw2); \
    VRD(6); SBAR(); GAPA(C1 = __builtin_amdgcn_mfma_f32_32x32x16_bf16(kf[5], qr[2], C1, 0, 0, 0),   P1[6], P1[7], P1[8], P1[9],     pw2[2] = PKW(P1, 4), pw2[3] = PKW(P1, 6), pw2); \
    VRD(3); SBAR(); GAPA(C0 = __builtin_amdgcn_mfma_f32_32x32x16_bf16(kf[6], qr[3], C0, 0, 0, 0),   P1[10], P1[11], P1[12], P1[13], pw3[0] = PKW(P1, 8), pw3[1] = PKW(P1, 10), pw3); \
    VRD(7); SBAR(); GAPA(C1 = __builtin_amdgcn_mfma_f32_32x32x16_bf16(kf[7], qr[3], C1, 0, 0, 0),   P1[14], P1[15], 0.f, 0.f,       pw3[2] = PKW(P1, 12), pw3[3] = PKW(P1, 14), pw3); \
    l_reg += sacc; \
    if (GK) { DMA_K((t) + 3, sl_cur); } if (GV) { DMA_V((t) + 1, sl_next); } \
    if (JB >= 0) cmask(C0, C1, JB, qrel, hi); \
    { float a = MX3(C0[0], C0[1], C1[0]), b_ = MX3(C0[2], C0[3], C1[1]); a = MX3(a, C1[2], C1[3]); \
      _Pragma("unroll") for (int r = 4; r < 16; r += 4) { a = MX3(a, C0[r], C0[r + 1]); b_ = MX3(b_, C0[r + 2], C0[r + 3]); a = MX3(a, C1[r], C1[r + 1]); b_ = MX3(b_, C1[r + 2], C1[r + 3]); } \
      float rm = __builtin_fmaxf(a, b_); { auto rr = __builtin_amdgcn_permlane32_swap(__float_as_uint(rm), __float_as_uint(rm), false, false); rm = __builtin_fmaxf(__uint_as_float(rr[0]), __uint_as_float(rr[1])); } \
      resc = false; \
      if (__builtin_expect(__any(rm > (float)THRL), 0)) { const float dl = __builtin_fmaxf(rm, 0.f); mhat += dl; \
        _Pragma("unroll") for (int r = 0; r < 16; ++r) { C0[r] -= dl; C1[r] -= dl; } \
        const float f = __builtin_amdgcn_exp2f(-dl); l_reg *= f; if (hi == 0) wsf[r32] = f; resc = true; } } \
    SBAR(); \
    GAPB(o[0] = __builtin_amdgcn_mfma_f32_32x32x16_bf16(PAF(0), VFR(0), o[0], 0, 0, 0), C0, 0); \
    GAPB(o[1] = __builtin_amdgcn_mfma_f32_32x32x16_bf16(PAF(0), VFR(4), o[1], 0, 0, 0), C0, 4); \
    KRD(GL, 0); GAPB(o[0] = __builtin_amdgcn_mfma_f32_32x32x16_bf16(PAF(1), VFR(1), o[0], 0, 0, 0), C0, 8); \
    KRD(GL, 1); GAPB(o[1] = __builtin_amdgcn_mfma_f32_32x32x16_bf16(PAF(1), VFR(5), o[1], 0, 0, 0), C0, 12); \
    KRD(GL, 2); GAPB(o[0] = __builtin_amdgcn_mfma_f32_32x32x16_bf16(PAF(2), VFR(2), o[0], 0, 0, 0), C1, 0); \
    KRD(GL, 3); GAPB(o[1] = __builtin_amdgcn_mfma_f32_32x32x16_bf16(PAF(2), VFR(6), o[1], 0, 0, 0), C1, 4); \
    GAPB(o[0] = __builtin_amdgcn_mfma_f32_32x32x16_bf16(PAF(3), VFR(3), o[0], 0, 0, 0), C1, 8); \
    GAPB(o[1] = __builtin_amdgcn_mfma_f32_32x32x16_bf16(PAF(3), VFR(7), o[1], 0, 0, 0), C1, 12); \
    } while (0)
#define ENDW(tt) do { if ((tt) + 3 < NT) { WAIT_BAR(2); } else if ((tt) + 2 < NT) { WAIT_BAR(1); } else { WAIT_BAR(0); } } while (0)
    STEP(pB0, pB1, pA0, pA1, 1, (4 < NT), true, true, 1);   ENDW(1); RESC(); ROT();
    STEP(pA0, pA1, pB0, pB1, 2, (5 < NT), true, true, 2);   ENDW(2); RESC(); ROT();
    STEP(pB0, pB1, pA0, pA1, 3, (6 < NT), (4 < NT), (4 < NT), 3);   ENDW(3); RESC(); ROT();
    int t = 4;
    for (; t + 4 < NT; t += 2) {
        STEP(pA0, pA1, pB0, pB1, t, true, true, true, -1);       WAIT_BAR(2); RESC(); ROT();
        STEP(pB0, pB1, pA0, pA1, t + 1, true, true, true, -1);   WAIT_BAR(2); RESC(); ROT();
    }
    for (; t < NT; t += 2) {
        STEP(pA0, pA1, pB0, pB1, t, (t + 3 < NT), true, true, -1);                       ENDW(t);     RESC(); ROT();
        STEP(pB0, pB1, pA0, pA1, t + 1, (t + 4 < NT), (t + 2 < NT), (t + 2 < NT), -1);   ENDW(t + 1); RESC(); ROT();
    }
    { float sacc = pB0[0] + pB0[1]; _Pragma("unroll") for (int r = 2; r < 16; ++r) sacc += pB0[r]; _Pragma("unroll") for (int r = 0; r < 16; ++r) sacc += pB1[r]; l_reg += sacc;
      pw0 = (u32x4){PKW(pB0, 0), PKW(pB0, 2), PKW(pB0, 4), PKW(pB0, 6)}; pw1 = (u32x4){PKW(pB0, 8), PKW(pB0, 10), PKW(pB0, 12), PKW(pB0, 14)}; pw2 = (u32x4){PKW(pB1, 0), PKW(pB1, 2), PKW(pB1, 4), PKW(pB1, 6)}; pw3 = (u32x4){PKW(pB1, 8), PKW(pB1, 10), PKW(pB1, 12), PKW(pB1, 14)};
      SBAR(); pv(o, (int)(unsigned long)vp0 + sl_prev, PAF(0), PAF(1), PAF(2), PAF(3)); }
#undef PKW
#undef PAF
#undef VFR
#undef PIN
#undef MX3
#undef GAPA
#undef GAPB
#undef EX
#undef VRD
#undef KRD
#undef STEP
#undef ENDW
    { auto rr = __builtin_amdgcn_permlane32_swap(__float_as_uint(l_reg), __float_as_uint(l_reg), false, false); l_reg = __uint_as_float(rr[0]) + __uint_as_float(rr[1]); }
    if (hi == 0) wsf[32 + r32] = l_reg; asm volatile("s_waitcnt lgkmcnt(0)" ::: "memory");
    float rli[16];
#pragma unroll
    for (int r = 0; r < 16; ++r) rli[r] = __builtin_amdgcn_rcpf(wsf[32 + crow(r, hi)]);
    bf16_t* Ow = Og + (rowbase + q0 + wid * QBLK) * DMO + h * HD;
    { bf16_t* stg = (bf16_t*)(shm + LDS_OST) + wid * 2048;
#pragma unroll
      for (int r = 0; r < 16; ++r) { const int orow = crow(r, hi);
#pragma unroll
        for (int d0 = 0; d0 < 2; ++d0) stg[orow * 64 + d0 * 32 + r32] = (bf16_t)f2bf(o[d0][r] * rli[r]); }
      asm volatile("s_waitcnt lgkmcnt(0)" ::: "memory");
#pragma unroll
      for (int i = 0; i < 4; ++i) { const int row = i * 8 + (lane >> 3), ch = lane & 7; const u32x4 v = *(const u32x4*)(stg + row * 64 + ch * 8); *(u32x4*)(Ow + (long)row * DMO + ch * 8) = v; } }
    asm volatile("s_waitcnt lgkmcnt(0)\n\ts_barrier" ::: "memory");
#undef DMA_K
#undef DMA_V
#undef TMAP
#undef SETC
#undef START
#undef RESC
#undef ROT
}
#undef SBAR
#undef WAIT_BAR
}

namespace hgrn {
constexpr int RS = 144;
constexpr int R_FQV = 0, FQV_SLOT = 32768;
constexpr int L_Q = 98304, L_K = L_Q + 9216, L_KT = L_K + 9216, L_VT = L_KT + 9216, L_ST = L_VT + 9216, L_SEG = L_ST + 9216, L_DEND = L_SEG + 2048, L_SSQ = L_DEND + 256, L_BYTES = L_SSQ + 512;
__device__ __forceinline__ int crow(int r, int hi) { return (r & 3) + 8 * (r >> 2) + 4 * hi; }
__device__ __forceinline__ void glds16(const void* gsrc, unsigned lds_dst) { unsigned keep;
    asm volatile("s_mov_b32 %0, m0\n\ts_mov_b32 m0, %2\n\ts_nop 0\n\tglobal_load_lds_dwordx4 %1, off\n\ts_mov_b32 m0, %0" : "=&s"(keep) : "v"(gsrc), "s"(lds_dst) : "memory"); }
#define HG_BAR() do { asm volatile("s_waitcnt lgkmcnt(0)" ::: "memory"); __builtin_amdgcn_s_barrier(); asm volatile("" ::: "memory"); } while (0)
#ifndef HG_ABL
#define HG_ABL 0
#endif
__device__ __forceinline__ void hgrn_unit(int b, int h, const bf16_t* __restrict__ proj, bf16_t* __restrict__ mix, const float* __restrict__ lb_logits, const float* __restrict__ norm_g, LAS unsigned char* lds, const int abl = 0) {
    int tid_ = threadIdx.x; asm volatile("" : "+v"(tid_));
    const int tid = tid_, lane = tid & 63, r32 = lane & 31, hi = lane >> 5; const int w = __builtin_amdgcn_readfirstlane(tid >> 6);
    const float lbk = fast_rcp(1.0f + fast_exp2((lb_logits[512 + h * 64 + lane] - lb_logits[h * 64 + lane]) * LOG2E));
    const int vr = (w >> 1) & 1, tc = w & 1;
    float ng[16];
#pragma unroll
    for (int r = 0; r < 16; ++r) ng[r] = norm_g[h * 64 + 32 * vr + crow(r, hi)];
    f32x16 S = f32x16{};
    for (int i = tid; i < 64 * RS / 4; i += 512) ((LAS unsigned*)(lds + L_ST))[i] = 0u;
    const size_t hoff = (size_t)(b * 8 + h) * (SEQ * 64) + (size_t)w * 512 + lane * 8;
    const bf16_t* gQ = proj + 3 * SEC_ELEMS + hoff; const bf16_t* gF = proj + 4 * SEC_ELEMS + hoff; const bf16_t* gV = proj + 5 * SEC_ELEMS + hoff; const bf16_t* gG = proj + 6 * SEC_ELEMS + hoff;
    const unsigned lds0 = (unsigned)(uintptr_t)(unsigned char*)lds;
#define DMA_FQV(c_) do { const int cc_ = (c_) < 63 ? (c_) : 63; const unsigned d_ = (unsigned)__builtin_amdgcn_readfirstlane(lds0 + R_FQV + (unsigned)(((c_) % 3) * FQV_SLOT) + (unsigned)w * 1024u); \
        glds16(gF + (size_t)cc_ * 4096, d_); glds16(gQ + (size_t)cc_ * 4096, d_ + 8192u); glds16(gV + (size_t)cc_ * 4096, d_ + 16384u); } while (0)
#define DMA_G(c_) do { const int cc_ = (c_) < 63 ? (c_) : 63; glds16(gG + (size_t)cc_ * 4096, (unsigned)__builtin_amdgcn_readfirstlane(lds0 + R_FQV + (unsigned)(((c_) % 3) * FQV_SLOT) + 24576u + (unsigned)w * 1024u)); } while (0)
    DMA_FQV(0); DMA_G(0); DMA_FQV(1); DMA_G(1); DMA_FQV(2);
    for (int c = 0; c < 64; ++c) {
        const size_t row0 = (size_t)b * SEQ + (size_t)c * 64;
        if (abl & 8) {} else if (w < 4 && c >= 3) asm volatile("s_waitcnt vmcnt(20)" ::: "memory");
        else asm volatile("s_waitcnt vmcnt(8)" ::: "memory");
        const LAS unsigned char* raw = lds + R_FQV + (c % 3) * FQV_SLOT + (8 * w) * 128 + lane * 2;
        float p[8], kk[8];
        { float run = 0.f;
#pragma unroll
          for (int i = 0; i < 8; ++i) { const float x = bf2f(*(const LAS unsigned short*)(raw + i * 128)); float f, lg;
              if (abl & 2) { f = 0.5f + 0.001f * x; lg = -1.0f + 0.001f * x; } else { const float sg = fast_rcp(1.0f + fast_exp2(-x * LOG2E)); f = lbk + (1.0f - lbk) * sg; lg = __builtin_amdgcn_logf(f); }
              run += lg; p[i] = run; kk[i] = 1.0f - f; } }
        ((LAS float*)(lds + L_SEG))[w * 64 + lane] = p[7];
        HG_BAR();
        if (!(abl & 8)) DMA_G(c + 2);
        { float off = 0.f;
#pragma unroll
          for (int j = 0; j < 7; ++j) { const float sv = ((LAS float*)(lds + L_SEG))[j * 64 + lane]; off += (j < w) ? sv : 0.f; }
          unsigned kq[4], vq[4];
#pragma unroll
          for (int i = 0; i < 8; i += 2) { const float b0 = off + p[i], b1 = off + p[i + 1];
              const unsigned short q0r = *(const LAS unsigned short*)(raw + 8192 + i * 128), q1r = *(const LAS unsigned short*)(raw + 8192 + (i + 1) * 128);
              const unsigned short v0r = *(const LAS unsigned short*)(raw + 16384 + i * 128), v1r = *(const LAS unsigned short*)(raw + 16384 + (i + 1) * 128);
              const float q0 = bf2f(q0r) * fast_exp2(b0), q1 = bf2f(q1r) * fast_exp2(b1), k0 = kk[i] * fast_exp2(-b0), k1 = kk[i + 1] * fast_exp2(-b1);
              const unsigned qq = cvtpk(q0, q1), kw = cvtpk(k0, k1); kq[i >> 1] = kw; vq[i >> 1] = (unsigned)v0r | ((unsigned)v1r << 16);
              if (abl & 4) continue;
              *(LAS unsigned short*)(lds + L_Q + (8 * w + i) * RS + lane * 2) = (unsigned short)(qq & 0xffffu);
              *(LAS unsigned short*)(lds + L_Q + (8 * w + i + 1) * RS + lane * 2) = (unsigned short)(qq >> 16);
              *(LAS unsigned short*)(lds + L_K + (8 * w + i) * RS + lane * 2) = (unsigned short)(kw & 0xffffu);
              *(LAS unsigned short*)(lds + L_K + (8 * w + i + 1) * RS + lane * 2) = (unsigned short)(kw >> 16); }
          *(LAS u32x4*)(lds + L_KT + lane * RS + 16 * w) = (u32x4){kq[0], kq[1], kq[2], kq[3]};
          *(LAS u32x4*)(lds + L_VT + lane * RS + 16 * w) = (u32x4){vq[0], vq[1], vq[2], vq[3]};
          if (w == 7) ((LAS float*)(lds + L_DEND))[lane] = fast_exp2(off + p[7]); }
        if (!(abl & 8)) DMA_FQV(c + 3);
        if (abl & 8) {} else if (w < 4 && c >= 2) asm volatile("s_waitcnt vmcnt(19)" ::: "memory");
        else asm volatile("s_waitcnt vmcnt(11)" ::: "memory");
        HG_BAR();
        f32x16 OT = f32x16{};
        if (abl & 1) { OT[0] = (float)c; } else
        if (w < 4) {
            bf16x8 bq[4];
#pragma unroll
            for (int ks = 0; ks < 4; ++ks) bq[ks] = *(const LAS bf16x8*)(lds + L_Q + (32 * tc + r32) * RS + (16 * ks + 8 * hi) * 2);
#pragma unroll
            for (int sr = 0; sr < 2; ++sr) if (sr <= tc) {
                f32x16 at = f32x16{};
#pragma unroll
                for (int ks = 0; ks < 4; ++ks) { const bf16x8 a = *(const LAS bf16x8*)(lds + L_K + (32 * sr + r32) * RS + (16 * ks + 8 * hi) * 2); at = __builtin_amdgcn_mfma_f32_32x32x16_bf16(a, bq[ks], at, 0, 0, 0); }
                if (sr == tc) {
#pragma unroll
                    for (int r = 0; r < 16; ++r) at[r] = (crow(r, hi) <= r32) ? at[r] : 0.f; }
#pragma unroll
                for (int st = 0; st < 2; ++st) {
                    u32x4 bw; bw.x = cvtpk(at[8 * st + 0], at[8 * st + 1]); bw.y = cvtpk(at[8 * st + 2], at[8 * st + 3]); bw.z = cvtpk(at[8 * st + 4], at[8 * st + 5]); bw.w = cvtpk(at[8 * st + 6], at[8 * st + 7]);
                    const u32x2 lo = *(const LAS u32x2*)(lds + L_VT + (32 * vr + r32) * RS + (32 * sr + 16 * st + 4 * hi) * 2);
                    const u32x2 hh = *(const LAS u32x2*)(lds + L_VT + (32 * vr + r32) * RS + (32 * sr + 16 * st + 8 + 4 * hi) * 2);
                    const u32x4 aw = (u32x4){lo.x, lo.y, hh.x, hh.y};
                    OT = __builtin_amdgcn_mfma_f32_32x32x16_bf16(__builtin_bit_cast(bf16x8, aw), __builtin_bit_cast(bf16x8, bw), OT, 0, 0, 0); }
            }
#pragma unroll
            for (int ks = 0; ks < 4; ++ks) { const bf16x8 a = *(const LAS bf16x8*)(lds + L_ST + (32 * vr + r32) * RS + (16 * ks + 8 * hi) * 2); OT = __builtin_amdgcn_mfma_f32_32x32x16_bf16(a, bq[ks], OT, 0, 0, 0); }
            float sq = 0.f;
#pragma unroll
            for (int r = 0; r < 16; ++r) sq += OT[r] * OT[r];
            sq += __shfl_xor(sq, 32);
            if (hi == 0) ((LAS float*)(lds + L_SSQ))[vr * 64 + 32 * tc + r32] = sq;
        } else {
#pragma unroll
            for (int st = 0; st < 4; ++st) { const bf16x8 a = *(const LAS bf16x8*)(lds + L_KT + (32 * vr + r32) * RS + (16 * st + 8 * hi) * 2);
                const bf16x8 bv = *(const LAS bf16x8*)(lds + L_VT + (32 * tc + r32) * RS + (16 * st + 8 * hi) * 2);
                S = __builtin_amdgcn_mfma_f32_32x32x16_bf16(a, bv, S, 0, 0, 0); }
#pragma unroll
            for (int r = 0; r < 16; ++r) S[r] *= ((LAS float*)(lds + L_DEND))[32 * vr + crow(r, hi)];
        }
        HG_BAR();
        if (w < 4) {
            const int t = 32 * tc + r32;
            const float tot = ((LAS float*)(lds + L_SSQ))[t] + ((LAS float*)(lds + L_SSQ))[64 + t];
            const float rstd = __builtin_amdgcn_rsqf(tot * (1.0f / 64.0f) + EPS);
            const LAS unsigned char* gp = lds + R_FQV + (c % 3) * FQV_SLOT + 24576 + t * 128 + (32 * vr + 4 * hi) * 2;
            bf16_t* op = mix + (row0 + t) * D + 512 + h * 64 + 32 * vr + 4 * hi;
#pragma unroll
            for (int g = 0; g < 4; ++g) { const u32x2 gg = *(const LAS u32x2*)(gp + 16 * g);
                const float y0 = OT[4 * g + 0] * rstd * ng[4 * g + 0] * bflo(gg.x), y1 = OT[4 * g + 1] * rstd * ng[4 * g + 1] * bfhi(gg.x),
                            y2 = OT[4 * g + 2] * rstd * ng[4 * g + 2] * bflo(gg.y), y3 = OT[4 * g + 3] * rstd * ng[4 * g + 3] * bfhi(gg.y);
                const u32x2 yv = (u32x2){cvtpk(y0, y1), cvtpk(y2, y3)}; if (!(abl & 16)) asm volatile("global_store_dwordx2 %0, %1, off" :: "v"(op + 8 * g), "v"(yv) : "memory"); }
        } else {
#pragma unroll
            for (int g = 0; g < 4; ++g) *(LAS u32x2*)(lds + L_ST + (32 * tc + r32) * RS + (32 * vr + 8 * g + 4 * hi) * 2) = (u32x2){cvtpk(S[4 * g + 0], S[4 * g + 1]), cvtpk(S[4 * g + 2], S[4 * g + 3])};
        }
    }
    asm volatile("s_waitcnt vmcnt(0)" ::: "memory");
    HG_BAR();
#undef DMA_FQV
#undef DMA_G
}
#undef HG_BAR
}

constexpr int NWAVES = 8;
constexpr int LDS_BYTES = 163840;
constexpr int TAIL = 161792;
constexpr int TL_TE = TAIL, TL_TS = TAIL + 576, TL_HIST = TAIL + 768, TL_BASE = TAIL + 896, TL_MISC = TAIL + 1024, TL_CNT = TAIL + 1280;
typedef GAS unsigned gu32;

struct Args { const float* in[20]; float* out; unsigned char* ws; int ph_lo, ph_hi; };

struct Frame {
    LAS unsigned char* lds; volatile LAS unsigned* MISC; unsigned* ctl;
    int tid, lane, wave, G, vcu;
};

struct P0Item { const float* W; bf16_t* WT; const float* gain; int N, K, k0, n0, mode; };
constexpr int P0_I_IN = 16 * 56, P0_I_SQ = 16 * 16, P0_I_KV = 16 * 32, P0_I_W1 = 16 * 32, P0_I_W2 = 16 * 16;
constexpr int P0_NA = P0_I_IN + P0_I_KV, P0_NB = 2 * P0_I_SQ + NEXP * (P0_I_W1 + P0_I_W2);
template <int SET> __device__ __forceinline__ bool p0_decode(const Args& a, int it, P0Item& I) {
    unsigned char* ws = a.ws;
    if (it >= (SET == 0 ? P0_NA : P0_NB)) return false;
    int r = it; I.gain = nullptr; I.mode = 0; I.K = D;
    if (SET == 0) {
        if (r < P0_I_IN) { I.W = a.in[3]; I.WT = (bf16_t*)(ws + WS_WIN); I.N = INC; }
        else { r -= P0_I_IN; I.W = a.in[10]; I.WT = (bf16_t*)(ws + WS_WKV); I.N = 2 * D; }
    } else {
        if (r < P0_I_SQ) { I.W = a.in[6]; I.WT = (bf16_t*)(ws + WS_WOUT); I.N = D; }
        else if ((r -= P0_I_SQ) < P0_I_SQ) { I.W = a.in[11]; I.WT = (bf16_t*)(ws + WS_WO); I.N = D; }
        else if ((r -= P0_I_SQ) < NEXP * P0_I_W1) { const int e = r / P0_I_W1; r -= e * P0_I_W1; I.W = a.in[15] + (size_t)e * D * 2048; I.WT = (bf16_t*)(ws + WS_W1 + (size_t)e * 2048 * D); I.N = 2048; I.gain = a.in[12]; I.mode = 3; }
        else { r -= NEXP * P0_I_W1; const int e = r / P0_I_W2; r -= e * P0_I_W2; I.W = a.in[17] + (size_t)e * D * D; I.WT = (bf16_t*)(ws + WS_W2 + (size_t)e * D * D); I.N = D; I.mode = 2; }
    }
    const int nblk = I.N / 64; I.k0 = 64 * (r / nblk); I.n0 = 64 * (r % nblk); return true;
}
template <int SET> __device__ __forceinline__ void p0_run(const Args& a, int first, int stride, int count, LAS unsigned char* tl, int lane);
__device__ __forceinline__ void p0_load(const P0Item& I, f32x4 (&v)[16], int lane) {
    const float* p = I.W + (size_t)(I.k0 + (lane >> 4)) * I.N + I.n0 + 4 * (lane & 15);
#pragma unroll
    for (int j = 0; j < 16; ++j) v[j] = __builtin_nontemporal_load((const f32x4*)(p + (size_t)(4 * j) * I.N));
}
__device__ __forceinline__ void p0_store(const P0Item& I, const f32x4 (&v)[16], LAS unsigned char* tl, int lane) {
    const int kr = lane >> 4, nq = lane & 15;
#pragma unroll
    for (int j = 0; j < 16; ++j) { const int k = 4 * j + kr; const float g = I.gain ? I.gain[I.k0 + k] : 1.0f;
        *(LAS u32x2*)(tl + k * 128 + (((nq >> 1) ^ ((k >> 3) & 7)) * 16) + (nq & 1) * 8) = (u32x2){pk2(v[j].x * g, v[j].y * g), pk2(v[j].z * g, v[j].w * g)}; }
    LDS_WAIT(); asm volatile("" ::: "memory");
    const int c = lane & 7;
#pragma unroll
    for (int i = 0; i < 8; ++i) { const int n = (lane >> 3) + 8 * i; const LAS unsigned char* sp = tl + (8 * c) * 128 + ((i ^ c) * 16) + (n & 7) * 2;
        unsigned short e[8];
#pragma unroll
        for (int q = 0; q < 8; ++q) e[q] = *(const LAS unsigned short*)(sp + q * 128);
        int row = I.n0 + n; if (I.mode & 1) { const int jj = row >> 1, bj = row & 1; row = (jj >> 7) * 256 + bj * 128 + (jj & 127); }
        if (I.mode & 2) *(u32x2*)((unsigned char*)I.WT + (size_t)row * I.K + I.k0 + 8 * c) = (u32x2){pk4_fp8(bf2f(e[0]) * WSCALE8, bf2f(e[1]) * WSCALE8, bf2f(e[2]) * WSCALE8, bf2f(e[3]) * WSCALE8), pk4_fp8(bf2f(e[4]) * WSCALE8, bf2f(e[5]) * WSCALE8, bf2f(e[6]) * WSCALE8, bf2f(e[7]) * WSCALE8)};
        else *(u32x4*)(I.WT + (size_t)row * I.K + I.k0 + 8 * c) = (u32x4){(unsigned)e[0] | ((unsigned)e[1] << 16), (unsigned)e[2] | ((unsigned)e[3] << 16), (unsigned)e[4] | ((unsigned)e[5] << 16), (unsigned)e[6] | ((unsigned)e[7] << 16)}; }
    LDS_WAIT(); asm volatile("" ::: "memory");
}
__device__ __forceinline__ void rms_rows2_to_bf16(const float* __restrict__ x0, const float* __restrict__ x1, const float* __restrict__ g, bf16_t* __restrict__ o0, bf16_t* __restrict__ o1, int lane) {
    const f32x4* xa = (const f32x4*)x0 + lane; const f32x4* xb = (const f32x4*)x1 + lane; const f32x4* gr = (const f32x4*)g + lane;
    f32x4 va[4], vb[4]; float sa = 0.f, sb = 0.f;
#pragma unroll
    for (int j = 0; j < 4; ++j) { va[j] = xa[64 * j]; vb[j] = xb[64 * j]; }
#pragma unroll
    for (int j = 0; j < 4; ++j) { sa += (va[j].x * va[j].x + va[j].y * va[j].y) + (va[j].z * va[j].z + va[j].w * va[j].w); sb += (vb[j].x * vb[j].x + vb[j].y * vb[j].y) + (vb[j].z * vb[j].z + vb[j].w * vb[j].w); }
    const float ra = 1.0f / sqrtf(wave_sum(sa) * (1.0f / D) + EPS), rb = 1.0f / sqrtf(wave_sum(sb) * (1.0f / D) + EPS);
    unsigned long long* pa = (unsigned long long*)o0 + lane; unsigned long long* pb = (unsigned long long*)o1 + lane;
#pragma unroll
    for (int j = 0; j < 4; ++j) { const f32x4 gg = gr[64 * j];
        pa[64 * j] = (unsigned long long)pk2(va[j].x * ra * gg.x, va[j].y * ra * gg.y) | ((unsigned long long)pk2(va[j].z * ra * gg.z, va[j].w * ra * gg.w) << 32);
        pb[64 * j] = (unsigned long long)pk2(vb[j].x * rb * gg.x, vb[j].y * rb * gg.y) | ((unsigned long long)pk2(vb[j].z * rb * gg.z, vb[j].w * rb * gg.w) << 32); }
}

__device__ __forceinline__ void p0_prologue(Frame& F, const Args& a) {
    unsigned char* ws = a.ws;
    LAS unsigned char* tl = F.lds + F.wave * 8192;
    const int gw = F.vcu * NWAVES + F.wave, NGW = F.G * NWAVES;
    for (int m = 2 * gw; m < T; m += 2 * NGW) rms_rows2_to_bf16(a.in[0] + (size_t)m * D, a.in[0] + (size_t)(m + 1) * D, a.in[2], (bf16_t*)(ws + WS_XN) + (size_t)m * D, (bf16_t*)(ws + WS_XN) + (size_t)(m + 1) * D, F.lane);
    for (int m = 2 * gw; m < MROWS; m += 2 * NGW) rms_rows2_to_bf16(a.in[1] + (size_t)m * D, a.in[1] + (size_t)(m + 1) * D, a.in[8], (bf16_t*)(ws + WS_MN) + (size_t)m * D, (bf16_t*)(ws + WS_MN) + (size_t)(m + 1) * D, F.lane);
    for (int i = gw * 64 + F.lane; i < D * D / 4; i += NGW * 64) { const f32x4 w = ((const f32x4*)a.in[9])[i]; const float g = a.in[7][i >> 8];
        ((u32x2*)(ws + WS_WQ))[i] = (u32x2){pk2(w.x * g, w.y * g), pk2(w.z * g, w.w * g)}; }
    for (int i = gw * 64 + F.lane; i < NEXP * D; i += NGW * 64) { const int e = i >> 10, k = i & 1023; const float w = a.in[12][k] * a.in[13][k * NEXP + e];
        const unsigned hi = f2bf(w); ((bf16_t*)(ws + WS_WRT))[i] = (bf16_t)hi; ((bf16_t*)(ws + WS_WRT))[NEXP * D + i] = (bf16_t)f2bf(w - bf2f((unsigned short)hi)); }
    p0_run<0>(a, gw, NGW, (P0_NA - gw + NGW - 1) / NGW, tl, F.lane);
}
template <int SET> __device__ __forceinline__ void p0_run(const Args& a, int first, int stride, int count, LAS unsigned char* tl, int lane_in) {
    int lane = lane_in; asm volatile("" : "+v"(lane));
    P0Item IA, IB; f32x4 va[16], vb[16];
    int it = first, left = count; bool ha = left > 0 && p0_decode<SET>(a, it, IA); if (ha) p0_load(IA, va, lane);
    while (ha) {
        const bool hb = left > 1 && p0_decode<SET>(a, it + stride, IB); if (hb) p0_load(IB, vb, lane);
        p0_store(IA, va, tl, lane);
        if (!hb) break;
        it += 2 * stride; left -= 2; ha = left > 0 && p0_decode<SET>(a, it, IA); if (ha) p0_load(IA, va, lane);
        p0_store(IB, vb, tl, lane);
    }
}

__device__ __forceinline__ unsigned xcc_id() { return (unsigned)__builtin_amdgcn_s_getreg((3 << 11) | 20) & 0xFu; }
constexpr int QITEMS = 16 + 177;
constexpr int CONV_PER_Q = 49, CONV_TILES = 64;
static_assert(8 * CONV_PER_Q * CONV_TILES == P0_NB, "conversion items cover SET 1 exactly");
__device__ __forceinline__ void p2_mixer(Frame& F, const Args& a, int rep) {
    unsigned char* ws = a.ws;
    const bf16_t* proj = (const bf16_t*)(ws + WS_PROJ); bf16_t* mix = (bf16_t*)(ws + WS_MIX);
    const unsigned x0 = xcc_id() & 7u;
    int par = 0;
#ifdef MK_P2_REPMODE
    if (rep && MK_P2_REPMODE == 4) return;
#endif
#ifdef MK_P2_HALF
    if (rep && (blockIdx.x & 8)) return;
#endif
    for (;;) {
        if (F.tid == 0) { int code = -1;
            for (int j = 0; j < 8; ++j) { const unsigned xq = (x0 + j) & 7u; const unsigned i = __hip_atomic_fetch_add(F.ctl + CW_QUEUE + 1024 * rep + 64 * xq, 1u, RLX_AGENT);
                if (i < (unsigned)QITEMS) { code = (int)(xq * 256u + i); break; } }
            F.MISC[par] = (unsigned)code; }
        LDS_WAIT(); __builtin_amdgcn_s_barrier(); asm volatile("" ::: "memory");
        const int code = __builtin_amdgcn_readfirstlane((int)F.MISC[par]); par ^= 1;
        if (code < 0) break;
        const int xq = code >> 8, i = code & 255;
#ifdef MK_P2_REPMODE
        if (rep && ((MK_P2_REPMODE == 1 && i >= 8) || (MK_P2_REPMODE == 2 && i < 16) || MK_P2_REPMODE == 3)) continue;
        if (rep && MK_P2_REPMODE == 5) { const int jq_ = i - 16; const bool isconv = i >= 16 && ((jq_ < 168 && (jq_ & 3) == 3) || jq_ >= 170); if (!isconv) continue; }
#endif
#ifndef NO_HGRN
        if (i < 8) { hgrn::hgrn_unit(xq, i, proj, rep ? (bf16_t*)(ws + WS_H2F) : mix, a.in[4], a.in[5], F.lds, rep ? HG_ABL : 0); }
        else
#endif
        if (i < 16) {
            pg8::KvOrder S{(const char*)(ws + WS_MN), (const char*)(ws + WS_WKV), xq * 8 + (i - 8)};
            pg8::EpiBf16 E{(bf16_t*)(ws + WS_MEMK), D, (bf16_t*)(ws + WS_MEMVT), D};
            pg8::gemm_phase<pg8::EpiBf16, pg8::KvOrder, false, false>(F.lds, D, D, D / 64, S, E);
        } else
        {
        const int jq = i - 16; int mi = -1, cv = -1;
        if (jq < 168) { const int g_ = jq >> 2, r_ = jq & 3; if (r_ < 3) mi = 3 * g_ + r_; else cv = g_; } else if (jq < 170) mi = 126 + (jq - 168); else cv = 42 + (jq - 170);
        if (cv >= 0) {
            const int J = xq * CONV_PER_Q + cv;
            p0_run<1>(a, J * CONV_TILES + F.wave * 8, 1, 8, F.lds + F.wave * 8192, F.lane);
            LDS_WAIT(); VM_WAIT(); __builtin_amdgcn_s_barrier(); asm volatile("" ::: "memory");
        } else
#ifndef NO_MOBA
        { const int j = mi, g = j >> 5, jj = j & 31, hh = 2 * g + (jj & 1), qb = 15 - (jj >> 1);
            moba::attn_unit<8>(xq, hh, qb, proj, proj + SEC_ELEMS, proj + 2 * SEC_ELEMS, mix, (const float*)(ws + WS_KBAR), (char*)(unsigned char*)F.lds); }
#else
        {}
#endif
        }
    }
}

__device__ __forceinline__ void p7_router(Frame& F, const Args& a, int rep) {
    unsigned char* ws = a.ws;
    constexpr int WRS = 2064;
    LAS unsigned char* WH = F.lds; LAS unsigned char* WL = F.lds + 32 * WRS;
    LAS int* hist = (LAS int*)(F.lds + TL_HIST); LAS int* basel = (LAS int*)(F.lds + TL_BASE);
    { const u32x4* src = (const u32x4*)(ws + WS_WRT);
      for (int i = F.tid; i < 2 * NEXP * D / 8; i += 512) { const int m = i >> 12, r = (i >> 7) & 31, c = i & 127; *(LAS u32x4*)(F.lds + m * 32 * WRS + r * WRS + c * 16) = src[i]; } }
    const float* h2f = (const float*)(ws + WS_H2F); const float* ss2 = (const float*)(ws + WS_SS2);
    int* toke = (int*)(ws + (rep ? WS_DUMMY + 1 * MiB : WS_TOKE)); int* tokr = (int*)(ws + (rep ? WS_DUMMY + 1 * MiB + 512 * 1024 : WS_TOKR)); float* tokg = (float*)(ws + (rep ? WS_DUMMY + 2 * MiB : WS_TOKG)); int* list = (int*)(ws + (rep ? WS_DUMMY + 4 * MiB : WS_LIST)); float* glist = (float*)(ws + (rep ? WS_DUMMY + 8 * MiB : WS_GLIST)); float* sslist = (float*)(ws + (rep ? WS_DUMMY + 12 * MiB : WS_SSLIST));
    unsigned* cntw = F.ctl + (rep ? CW_CNT + 2048 * rep : CW_CNT);
    const int lane = F.lane, r16 = lane & 15, g4 = lane >> 4;
    const float br0 = a.in[14][r16], br1 = a.in[14][16 + r16];
    for (int tb = blockIdx.x; tb < T / 128; tb += F.G) {
        if (F.tid < 32) hist[F.tid] = 0;
        LDS_WAIT(); __builtin_amdgcn_s_barrier(); asm volatile("" ::: "memory");
        const int t0 = tb * 128 + F.wave * 16;
        const float* xr = h2f + (size_t)(t0 + r16) * D + 8 * g4;
        f32x4 acc0 = (f32x4){0.f, 0.f, 0.f, 0.f}, acc1 = acc0;
        f32x4 xa = *(const f32x4*)(xr), xb = *(const f32x4*)(xr + 4);
#pragma unroll 4
        for (int ks = 0; ks < 32; ++ks) {
            const f32x4 ca = xa, cb = xb;
            if (ks + 1 < 32) { xa = *(const f32x4*)(xr + 32 * (ks + 1)); xb = *(const f32x4*)(xr + 32 * (ks + 1) + 4); }
            const unsigned h0 = cvtpk(ca.x, ca.y), h1 = cvtpk(ca.z, ca.w), h2 = cvtpk(cb.x, cb.y), h3 = cvtpk(cb.z, cb.w);
            const unsigned l0 = cvtpk(ca.x - bflo(h0), ca.y - bfhi(h0)), l1 = cvtpk(ca.z - bflo(h1), ca.w - bfhi(h1)), l2 = cvtpk(cb.x - bflo(h2), cb.y - bfhi(h2)), l3 = cvtpk(cb.z - bflo(h3), cb.w - bfhi(h3));
            const bf16x8 ah = __builtin_bit_cast(bf16x8, (u32x4){h0, h1, h2, h3}), al = __builtin_bit_cast(bf16x8, (u32x4){l0, l1, l2, l3});
            const int bo = r16 * WRS + (32 * ks + 8 * g4) * 2;
            const bf16x8 bh0 = *(const LAS bf16x8*)(WH + bo), bh1 = *(const LAS bf16x8*)(WH + 16 * WRS + bo), bl0 = *(const LAS bf16x8*)(WL + bo), bl1 = *(const LAS bf16x8*)(WL + 16 * WRS + bo);
            acc0 = __builtin_amdgcn_mfma_f32_16x16x32_bf16(ah, bh0, acc0, 0, 0, 0); acc1 = __builtin_amdgcn_mfma_f32_16x16x32_bf16(ah, bh1, acc1, 0, 0, 0);
            acc0 = __builtin_amdgcn_mfma_f32_16x16x32_bf16(ah, bl0, acc0, 0, 0, 0); acc1 = __builtin_amdgcn_mfma_f32_16x16x32_bf16(ah, bl1, acc1, 0, 0, 0);
            acc0 = __builtin_amdgcn_mfma_f32_16x16x32_bf16(al, bh0, acc0, 0, 0, 0); acc1 = __builtin_amdgcn_mfma_f32_16x16x32_bf16(al, bh1, acc1, 0, 0, 0);
        }
        int my_e = 0; float my_g = 0.f;
#pragma unroll
        for (int j = 0; j < 4; ++j) {
            const float rs = __builtin_amdgcn_rsqf(ss2[t0 + 4 * g4 + j] * (1.0f / D) + EPS);
            float a0 = acc0[j] * rs + br0, a1 = acc1[j] * rs + br1; float tv[4]; int te_[4];
#pragma unroll
            for (int k = 0; k < 4; ++k) { float m = fmaxf(a0, a1);
#pragma unroll
                for (int o = 1; o < 16; o <<= 1) m = fmaxf(m, __shfl_xor(m, o));
                int e = (a0 == m) ? r16 : ((a1 == m) ? 16 + r16 : 99);
#pragma unroll
                for (int o = 1; o < 16; o <<= 1) e = min(e, __shfl_xor(e, o));
                tv[k] = m; te_[k] = e; if (e == r16) a0 = -INFINITY; if (e == 16 + r16) a1 = -INFINITY; }
            const float d1 = fast_exp2((tv[1] - tv[0]) * LOG2E), d2 = fast_exp2((tv[2] - tv[0]) * LOG2E), d3 = fast_exp2((tv[3] - tv[0]) * LOG2E);
            const float inv = 1.0f / (1.0f + d1 + d2 + d3);
            if ((r16 >> 2) == j) { const int k = lane & 3; my_e = k == 0 ? te_[0] : (k == 1 ? te_[1] : (k == 2 ? te_[2] : te_[3])); my_g = (k == 0 ? 1.0f : (k == 1 ? d1 : (k == 2 ? d2 : d3))) * inv; }
        }
        const int rl = __hip_atomic_fetch_add(hist + my_e, 1, __ATOMIC_RELAXED, __HIP_MEMORY_SCOPE_WORKGROUP);
        LDS_WAIT(); __builtin_amdgcn_s_barrier(); asm volatile("" ::: "memory");
        if (F.tid < 32) basel[F.tid] = (int)__hip_atomic_fetch_add(cntw + F.tid, (unsigned)hist[F.tid], RLX_AGENT);
        LDS_WAIT(); VM_WAIT(); __builtin_amdgcn_s_barrier(); asm volatile("" ::: "memory");
        { const int t = t0 + 4 * g4 + (r16 >> 2), k = lane & 3; const int rank = basel[my_e] + rl;
          toke[t * 4 + k] = my_e; tokr[t * 4 + k] = rank; tokg[t * 4 + k] = my_g; list[(size_t)my_e * T + rank] = t; glist[(size_t)my_e * T + rank] = my_g; sslist[(size_t)my_e * T + rank] = ss2[t]; }
        LDS_WAIT(); __builtin_amdgcn_s_barrier(); asm volatile("" ::: "memory");
    }
}

__device__ __forceinline__ int build_tables(Frame& F) {
    LAS int* ts = (LAS int*)(F.lds + TL_TS); LAS unsigned char* te = (LAS unsigned char*)(F.lds + TL_TE);
    if (F.tid < NEXP) ((LAS int*)(F.lds + TL_CNT))[F.tid] = (int)__hip_atomic_load(F.ctl + CW_CNT + F.tid, RLX_AGENT);
    LDS_WAIT(); __builtin_amdgcn_s_barrier(); asm volatile("" ::: "memory");
    if (F.tid == 0) { int run = 0;
        for (int e = 0; e < NEXP; ++e) { ts[e] = run; run += (((LAS int*)(F.lds + TL_CNT))[e] + 255) >> 8; }
        ts[NEXP] = run; }
    LDS_WAIT(); __builtin_amdgcn_s_barrier(); asm volatile("" ::: "memory");
    const int nt = ts[NEXP];
    for (int g = F.tid; g < nt; g += 512) { int e = 0;
        for (int j = 1; j < NEXP; ++j) e += (ts[j] <= g) ? 1 : 0;
        te[g] = (unsigned char)e; }
    LDS_WAIT(); __builtin_amdgcn_s_barrier(); asm volatile("" ::: "memory");
    return __builtin_amdgcn_readfirstlane(nt);
}

__device__ __forceinline__ void p10_combine(Frame& F, const Args& a) {
    unsigned char* ws = a.ws;
    LAS int* ts = (LAS int*)(F.lds + TL_TS);
    const float* h2f = (const float*)(ws + WS_H2F); const unsigned char* Y = (const unsigned char*)(ws + WS_Y);
    const int* toke = (const int*)(ws + WS_TOKE); const int* tokr = (const int*)(ws + WS_TOKR);
    const float* gf = a.in[19];
    const int gw = F.vcu * NWAVES + F.wave, NGW = F.G * NWAVES, lane = F.lane;
    for (int t0 = 2 * gw; t0 < T; t0 += 2 * NGW) {
        float o[2][16]; u32x2 y[2][4][2];
#pragma unroll
        for (int q = 0; q < 2; ++q) { const int t = t0 + q;
#pragma unroll
            for (int k = 0; k < 4; ++k) { const int e = toke[t * 4 + k], r = tokr[t * 4 + k]; const unsigned char* yr = Y + ((size_t)ts[e] * 256 + r) * D;
                y[q][k][0] = *(const u32x2*)(yr + 8 * lane); y[q][k][1] = *(const u32x2*)(yr + 512 + 8 * lane); }
            const f32x4 a0 = *(const f32x4*)(h2f + (size_t)t * D + 8 * lane), a1 = *(const f32x4*)(h2f + (size_t)t * D + 8 * lane + 4), a2 = *(const f32x4*)(h2f + (size_t)t * D + 512 + 8 * lane), a3 = *(const f32x4*)(h2f + (size_t)t * D + 512 + 8 * lane + 4);
            o[q][0] = a0.x; o[q][1] = a0.y; o[q][2] = a0.z; o[q][3] = a0.w; o[q][4] = a1.x; o[q][5] = a1.y; o[q][6] = a1.z; o[q][7] = a1.w; o[q][8] = a2.x; o[q][9] = a2.y; o[q][10] = a2.z; o[q][11] = a2.w; o[q][12] = a3.x; o[q][13] = a3.y; o[q][14] = a3.z; o[q][15] = a3.w; }
#pragma unroll
        for (int q = 0; q < 2; ++q) {
#pragma unroll
            for (int k = 0; k < 4; ++k)
#pragma unroll
                for (int hf = 0; hf < 2; ++hf) { const u32x2 w = y[q][k][hf];
                    const f32x2 c0 = __builtin_amdgcn_cvt_pk_f32_fp8((int)w.x, false), c1 = __builtin_amdgcn_cvt_pk_f32_fp8((int)w.x, true), c2 = __builtin_amdgcn_cvt_pk_f32_fp8((int)w.y, false), c3 = __builtin_amdgcn_cvt_pk_f32_fp8((int)w.y, true);
                    o[q][8 * hf + 0] += pg8::YSCALE_INV * c0.x; o[q][8 * hf + 1] += pg8::YSCALE_INV * c0.y; o[q][8 * hf + 2] += pg8::YSCALE_INV * c1.x; o[q][8 * hf + 3] += pg8::YSCALE_INV * c1.y;
                    o[q][8 * hf + 4] += pg8::YSCALE_INV * c2.x; o[q][8 * hf + 5] += pg8::YSCALE_INV * c2.y; o[q][8 * hf + 6] += pg8::YSCALE_INV * c3.x; o[q][8 * hf + 7] += pg8::YSCALE_INV * c3.y; }
            float s = 0.f;
#pragma unroll
            for (int j = 0; j < 16; ++j) s += o[q][j] * o[q][j];
            const float rstd = 1.0f / sqrtf(wave_sum(s) * (1.0f / D) + EPS);
            float* op = a.out + (size_t)(t0 + q) * D;
#pragma unroll
            for (int v = 0; v < 4; ++v) { const int col = (v >> 1) * 512 + 8 * lane + (v & 1) * 4; const f32x4 g4 = *(const f32x4*)(gf + col);
                *(f32x4*)(op + col) = (f32x4){o[q][4 * v] * rstd * g4.x, o[q][4 * v + 1] * rstd * g4.y, o[q][4 * v + 2] * rstd * g4.z, o[q][4 * v + 3] * rstd * g4.w}; }
        }
    }
}

#define XB_TMO      128
#define XB_XCNT(j)  (256  + 64 * (j))
#define XB_XSUB(j)  (1280 + 64 * (j))
#define XB_XGEN(j)  (2304 + 64 * (j))
#define XB_TOP      3328
#define XB_TOPGEN   3392
#define XCD_BAR_WORDS 3456
#define XB_SPIN_CAP (1u << 22)
__device__ __forceinline__ unsigned xb_ld(unsigned* p)              { return __hip_atomic_load(p, __ATOMIC_RELAXED, __HIP_MEMORY_SCOPE_AGENT); }
__device__ __forceinline__ unsigned xb_add(unsigned* p, unsigned v) { return __hip_atomic_fetch_add(p, v, __ATOMIC_RELAXED, __HIP_MEMORY_SCOPE_AGENT); }
#define XB_SPIN(cond, bar) do { unsigned _sp = 0; while (cond) { __builtin_amdgcn_s_sleep(1); \
    if ((++_sp & 255u) == 0u) { if (xb_ld(&(bar)[XB_TMO])) break; if (_sp > XB_SPIN_CAP) { atomicAdd(&(bar)[XB_TMO], 1u); break; } } } } while (0)
struct XcdBarrier { unsigned* bar; unsigned x; volatile LAS unsigned* st; };
__device__ __forceinline__ XcdBarrier xcd_barrier_post(unsigned* bar, volatile LAS unsigned* st) {
    XcdBarrier b; b.bar = bar; b.x = (unsigned)__builtin_amdgcn_s_getreg((3 << 11) | 20) & 0xFu; b.st = st;
    if (threadIdx.x == 0) (void)xb_add(&bar[XB_XCNT(b.x)], 1u);
    return b;
}
__device__ __forceinline__ void xcd_barrier_complete(unsigned* bar, unsigned x, unsigned& nloc, unsigned& nx) {
    const unsigned G = gridDim.x * gridDim.y * gridDim.z;
    unsigned sum, cnt, mine, sp = 0u;
    for (;;) {
        sum = 0u; cnt = 0u; mine = 0u;
#pragma unroll
        for (unsigned j = 0; j < 16; ++j) { const unsigned c = xb_ld(&bar[XB_XCNT(j)]); sum += c; cnt += (c > 0u) ? 1u : 0u; mine = (j == x) ? c : mine; }
        if (sum == G) break;
        __builtin_amdgcn_s_sleep(1);
        if ((++sp & 255u) == 0u) { if (xb_ld(&bar[XB_TMO])) break; if (sp > XB_SPIN_CAP) { atomicAdd(&bar[XB_TMO], 1u); break; } }
    }
    nloc = mine > 0u ? mine : 1u; nx = cnt > 0u ? cnt : 1u;
}
__device__ __forceinline__ void xcd_barrier(const XcdBarrier& b) {
    asm volatile("s_waitcnt vmcnt(0)" ::: "memory");
    __syncthreads();
    if (threadIdx.x == 0) {
        unsigned* bar = b.bar;
        __builtin_amdgcn_s_waitcnt(0);
        unsigned nloc = b.st[0], nx = b.st[1];
        if (nloc == 0u) { xcd_barrier_complete(bar, b.x, nloc, nx); b.st[0] = nloc; b.st[1] = nx; }
        const unsigned old = xb_add(&bar[XB_XSUB(b.x)], 1u);
        const unsigned gen = old / nloc;
        if (old + 1u == (gen + 1u) * nloc) {
            __builtin_amdgcn_fence(__ATOMIC_RELEASE, "agent");
            asm volatile("s_waitcnt vmcnt(0)" ::: "memory");
            const unsigned og = xb_add(&bar[XB_TOP], 1u);
            const unsigned tg = og / nx;
            if (og + 1u == (tg + 1u) * nx) xb_add(&bar[XB_TOPGEN], 1u);
            else XB_SPIN(xb_ld(&bar[XB_TOPGEN]) == tg, bar);
            __builtin_amdgcn_fence(__ATOMIC_ACQUIRE, "agent");
            xb_add(&bar[XB_XGEN(b.x)], 1u);
            asm volatile("s_waitcnt vmcnt(0)" ::: "memory");
        } else {
            XB_SPIN(xb_ld(&bar[XB_XGEN(b.x)]) == gen, bar);
            __builtin_amdgcn_fence(__ATOMIC_ACQUIRE, "agent");
            asm volatile("s_waitcnt vmcnt(0)" ::: "memory");
        }
    }
    __syncthreads();
}
#ifndef MK_CG_ONLY
#define MK_CG_ONLY 0
#endif
__device__ __forceinline__ void grid_barrier(Frame& F, const XcdBarrier& xb_) { if (MK_CG_ONLY) cg::this_grid().sync(); else xcd_barrier(xb_); }
#ifndef MK_PHASE_MASK
#define MK_PHASE_MASK 0x7ff
#endif
#ifndef MK_REP_PHASE
#define MK_REP_PHASE -1
#endif
#ifndef MK_REP_N
#define MK_REP_N 0
#endif
__device__ __forceinline__ void ph0(Frame& F, const Args& args, int rep) { p0_prologue(F, args); }
__device__ __forceinline__ void ph1(Frame& F, const Args& args, int rep) {
    unsigned char* ws = args.ws; const int cid = (int)blockIdx.x;
    { pg8::DenseOrder S{(const char*)(ws + WS_XN), (const char*)(ws + WS_WIN), D, D, T / 256, INC / 256, F.G, cid};
      pg8::EpiProj E{(bf16_t*)(ws + WS_PROJ), rep ? (float*)(ws + WS_DUMMY) : (float*)(ws + WS_KBAR)};
      pg8::gemm_phase<pg8::EpiProj, pg8::DenseOrder, false, true>(F.lds, D, D, D / 64, S, E); }
}
__device__ __forceinline__ void ph2(Frame& F, const Args& args, int rep) { p2_mixer(F, args, rep); }
constexpr size_t WS_MB = WS_PROJ, WS_NB = WS_PROJ + 16 * MiB, WS_H1Q = WS_PROJ + 32 * MiB, WS_PB = WS_QX;
constexpr size_t WS_UNUSED_XA = 0;
constexpr int LDS_XTAB = 131072;
__device__ __forceinline__ void ph3(Frame& F, const Args& args, int rep) {
    unsigned char* ws = args.ws; const int cid = (int)blockIdx.x;
    pg8::P3Order S{pg8::XmnOrder{(const char*)(ws + WS_MEMK), (const char*)(ws + WS_MEMVT), (const char*)(ws + WS_WQ), (const char*)(ws + WS_WO), F.G, cid},
                   pg8::DenseOrder{(const char*)(ws + WS_MIX), (const char*)(ws + WS_WOUT), D, D, T / 256, D / 256, F.G, cid}};
    pg8::EpiP3 E{pg8::EpiFp8{(unsigned char*)(ws + WS_MB), D, (unsigned char*)(ws + WS_NB), D, XSCALE8},
                 pg8::EpiRes<true, false>{(const void*)args.in[0], (bf16_t*)(ws + WS_H1B), nullptr, rep ? (float*)(ws + WS_DUMMY + 512 * 1024) : (float*)(ws + WS_SS1), 1.0f, (unsigned char*)(ws + WS_H1Q)}};
    pg8::gemm_phase<pg8::EpiP3, pg8::P3Order, false, true>(F.lds, D, D, D / 64, S, E);
}
__device__ __forceinline__ void ph4(Frame& F, const Args& args, int rep) {
    unsigned char* ws = args.ws; const int cid = (int)blockIdx.x;
    pg8::XbOrder S{(const char*)(ws + WS_H1Q), (const char*)(ws + WS_MB), F.G, cid, (size_t)D};
    pg8::EpiSoftmaxS E{(unsigned char*)(ws + WS_PB), (const float*)(ws + WS_SS1), F.lds + LDS_XTAB, XSCALE8_INV};
    pg8::gemm_phase<pg8::EpiSoftmaxS, pg8::XbOrder, false, true, true>(F.lds, D / 2, D / 2, D / 128, S, E);
}
__device__ __forceinline__ void ph5(Frame& F, const Args& args, int rep) {}
__device__ __forceinline__ void ph6(Frame& F, const Args& args, int rep) {
    unsigned char* ws = args.ws; const int cid = (int)blockIdx.x;
    pg8::XbOrder S{(const char*)(ws + WS_PB), (const char*)(ws + WS_NB), F.G, cid, (size_t)D};
    pg8::EpiRes<false, true, true> E{(const void*)(ws + WS_H1B), (bf16_t*)(ws + WS_H2B), (float*)(ws + WS_H2F), rep ? (float*)(ws + WS_DUMMY + 512 * 1024) : (float*)(ws + WS_SS2), PSCALE8_INV * XSCALE8_INV, nullptr};
    pg8::gemm_phase<pg8::EpiRes<false, true, true>, pg8::XbOrder, false, true, true>(F.lds, D / 2, D / 2, D / 128, S, E);
}
__device__ __forceinline__ void ph7(Frame& F, const Args& args, int rep) { p7_router(F, args, rep); }
__device__ __forceinline__ void ph8(Frame& F, const Args& args, int rep) {
    unsigned char* ws = args.ws; const int cid = (int)blockIdx.x;
    const int ntl = build_tables(F);
    pg8::MoeOrder S{(const char*)(ws + WS_H2B), (const char*)(ws + WS_W1), (const int*)(ws + WS_LIST), (const LAS int*)(F.lds + TL_CNT), (const LAS unsigned char*)(F.lds + TL_TE), (const LAS int*)(F.lds + TL_TS),
                    ntl, 8, F.G, cid, (size_t)2048 * D, 1, (size_t)256 * D, (size_t)256 * D};
    pg8::EpiW1 E{(bf16_t*)(ws + WS_HMID), (const float*)(ws + WS_SSLIST), args.in[16], (const int*)(ws + WS_LIST)};
    pg8::gemm_phase<pg8::EpiW1, pg8::MoeOrder, true, true, true>(F.lds, D / 2, D / 2, D / 128, S, E);
}
__device__ __forceinline__ void ph9(Frame& F, const Args& args, int rep) {
    unsigned char* ws = args.ws; const int cid = (int)blockIdx.x;
    const int ntl = build_tables(F);
    pg8::MoeOrder S{(const char*)(ws + WS_HMID), (const char*)(ws + WS_W2), (const int*)(ws + WS_LIST), (const LAS int*)(F.lds + TL_CNT), (const LAS unsigned char*)(F.lds + TL_TE), (const LAS int*)(F.lds + TL_TS),
                    ntl, 4, F.G, cid, (size_t)D * D, 0, (size_t)256 * D, (size_t)256 * D};
    pg8::EpiW2 E{(unsigned char*)(ws + WS_Y), args.in[18], (const int*)(ws + WS_LIST), (const float*)(ws + WS_GLIST)};
    pg8::gemm_phase<pg8::EpiW2, pg8::MoeOrder, false, true, true>(F.lds, D / 2, D / 2, D / 128, S, E);
}
__device__ __forceinline__ void ph10(Frame& F, const Args& args, int rep) { (void)build_tables(F); p10_combine(F, args); }

constexpr int N_PHASES = 11;
__global__ void __launch_bounds__(NWAVES * 64, 2) hymba_fwd(Args args) {
    extern __shared__ __attribute__((aligned(16))) unsigned char lds_raw[];
    Frame F;
    F.lds = (LAS unsigned char*)lds_raw;
    F.MISC = (volatile LAS unsigned*)(F.lds + TL_MISC);
    F.tid = threadIdx.x; F.lane = F.tid & 63; F.wave = __builtin_amdgcn_readfirstlane(F.tid >> 6);
    F.G = gridDim.x; { const int bx = blockIdx.x; F.vcu = (F.G % 8 == 0) ? (bx % 8) * (F.G / 8) + bx / 8 : bx; }
    F.ctl = (unsigned*)(args.ws + WS_CTL);
    const int lo = args.ph_lo, hi = args.ph_hi;
    for (int u = F.tid; u < 64; u += NWAVES * 64) ((LAS unsigned*)(F.lds + TL_MISC))[u] = 0u;
    __syncthreads();
    const XcdBarrier xbar = xcd_barrier_post(F.ctl + CW_BAR, F.MISC + 8);
#define RUN(k, fn) do { if (((MK_PHASE_MASK >> (k)) & 1) && lo <= (k) && (k) < hi) { fn(F, args, 0); \
        if (MK_REP_PHASE == (k) && MK_REP_N >= 1) { grid_barrier(F, xbar); fn(F, args, 1); } \
        if (MK_REP_PHASE == (k) && MK_REP_N >= 2) { grid_barrier(F, xbar); fn(F, args, 2); } \
        if ((k) + 1 < hi) { grid_barrier(F, xbar); } } } while (0)
    if (args.ph_lo < 0) cg::this_grid().sync();
    RUN(0, ph0); RUN(1, ph1); RUN(2, ph2); RUN(3, ph3); RUN(4, ph4);   RUN(6, ph6); RUN(7, ph7); RUN(8, ph8); RUN(9, ph9); RUN(10, ph10);
#undef RUN
}

extern "C" void kernel_launch(void* const* d_in, const int* in_sizes, int n_in, void* d_out, int out_size, void* d_ws, size_t ws_size, hipStream_t stream) {
    static int grid = 0;
    if (grid == 0) {
        if (n_in != 20 || in_sizes[0] != T * D || out_size != T * D || ws_size < WS_END) {
            fprintf(stderr, "kernel_launch: shape/workspace mismatch (n_in %d, in0 %d, out %d, ws %zu, need %zu)\n", n_in, n_in > 0 ? in_sizes[0] : -1, out_size, ws_size, (size_t)WS_END); grid = -1; return; }
        int dev = 0, cus = 0, per_cu = 0;
        if (hipGetDevice(&dev) != hipSuccess || hipDeviceGetAttribute(&cus, hipDeviceAttributeMultiprocessorCount, dev) != hipSuccess) { grid = -1; return; }
        if (hipFuncSetAttribute((const void*)hymba_fwd, hipFuncAttributeMaxDynamicSharedMemorySize, LDS_BYTES) != hipSuccess) { fprintf(stderr, "kernel_launch: hipFuncSetAttribute failed\n"); grid = -1; return; }
        if (hipOccupancyMaxActiveBlocksPerMultiprocessor(&per_cu, (const void*)hymba_fwd, NWAVES * 64, LDS_BYTES) != hipSuccess || per_cu < 1) { fprintf(stderr, "kernel_launch: occupancy query says %d\n", per_cu); }
        (void)hipGetLastError();
        grid = cus;
        if (grid != 256) fprintf(stderr, "kernel_launch: %d CUs; this kernel is built for 256\n", grid);
    }
    if (grid < 0) return;
    (void)hipMemsetAsync((char*)d_ws + WS_CTL, 0, CTL_ZERO_BYTES, stream);
    Args a{};
    for (int i = 0; i < 20; ++i) a.in[i] = (const float*)d_in[i];
    a.out = (float*)d_out; a.ws = (unsigned char*)d_ws;
#if MK_N_LAUNCHES == 1
    a.ph_lo = 0; a.ph_hi = MK_LAST_PHASE + 1;
    void* kargs[] = {&a};
    hipError_t e = hipLaunchCooperativeKernel((const void*)hymba_fwd, dim3(grid), dim3(NWAVES * 64), kargs, LDS_BYTES, stream);
    if (e != hipSuccess) fprintf(stderr, "kernel_launch: cooperative launch failed: %s\n", hipGetErrorString(e));
#else
    for (int p = 0; p <= MK_LAST_PHASE; ++p) { a.ph_lo = p; a.ph_hi = p + 1; hipLaunchKernelGGL(hymba_fwd, dim3(grid), dim3(NWAVES * 64), LDS_BYTES, stream, a); }
#endif
}
```

```cpp
#include <hip/hip_runtime.h>
#include <hip/hip_cooperative_groups.h>
#include <cstdio>
#include <cstdint>
namespace cg = cooperative_groups;

#ifndef MK_N_LAUNCHES
#define MK_N_LAUNCHES 1
#endif
#ifndef MK_LAST_PHASE
#define MK_LAST_PHASE 10
#endif

#define LAS __attribute__((address_space(3)))
#define GAS __attribute__((address_space(1)))
typedef unsigned short bf16_t;
typedef short bf16x8 __attribute__((ext_vector_type(8)));
typedef short s16x4 __attribute__((ext_vector_type(4)));
typedef float f32x4 __attribute__((ext_vector_type(4)));
typedef float f32x2 __attribute__((ext_vector_type(2)));
typedef float f32x16 __attribute__((ext_vector_type(16)));
typedef unsigned u32x4 __attribute__((ext_vector_type(4)));
typedef unsigned u32x2 __attribute__((ext_vector_type(2)));
typedef int v8i32_t __attribute__((ext_vector_type(8)));

constexpr int BATCH = 8, SEQ = 4096, T = BATCH * SEQ, D = 1024, INC = 3584, NMEM = 256, MROWS = BATCH * NMEM;
constexpr int NEXP = 32, TOPK = 4, MT_MAX = T * TOPK / 256 + NEXP, MPAD = MT_MAX * 256;
constexpr float EPS = 1e-6f;
constexpr float LOG2E = 1.4426950408889634f;
constexpr float C2Q = 0.125f * LOG2E;
constexpr float C2X = 0.0625f * LOG2E;
constexpr int C_MQ = 0, C_MK = 512, C_MV = 1024, C_GQ = 1536, C_GF = 2048, C_GI = 2560, C_GG = 3072;

constexpr size_t MiB = 1u << 20;
constexpr size_t WS_CTL = 0, CTL_ZERO_BYTES = 2 * MiB;
constexpr size_t WS_KBAR = 1 * MiB;
constexpr size_t WS_SS1 = 1 * MiB + 256 * 1024;
constexpr size_t WS_SS2 = 1 * MiB + 384 * 1024;
constexpr size_t WS_TOKE = 2 * MiB, WS_TOKR = 2 * MiB + 512 * 1024, WS_TOKG = 3 * MiB;
constexpr size_t WS_WRT = 3 * MiB + 512 * 1024;
constexpr size_t WS_LIST = 4 * MiB;
constexpr size_t WS_GLIST = 8 * MiB;
constexpr size_t WS_SSLIST = 12 * MiB;
constexpr size_t WS_WIN8 = 14 * MiB;
constexpr size_t WS_WIN = 16 * MiB, WS_WOUT = 23 * MiB, WS_WQ = 25 * MiB, WS_WKV = 27 * MiB, WS_WO = 31 * MiB;
constexpr size_t WS_MN = 33 * MiB, WS_MEMK = 37 * MiB, WS_MEMVT = 41 * MiB;
constexpr size_t WS_W1 = 48 * MiB, WS_W2 = 176 * MiB;
constexpr size_t WS_PROJ = 240 * MiB;
constexpr size_t SEC_ELEMS = (size_t)16 * 1024 * 1024;
constexpr size_t WS_XN = 464 * MiB;
constexpr size_t WS_OX = 464 * MiB;
constexpr size_t WS_XN8 = 528 * MiB;
constexpr size_t WS_MIX = 528 * MiB;
constexpr size_t WS_H1B = 592 * MiB;
constexpr size_t WS_QX = 656 * MiB;
constexpr size_t WS_PWS = 720 * MiB;
constexpr size_t WS_HMID = 240 * MiB;
constexpr size_t WS_Y = 512 * MiB;
constexpr size_t WS_H2F = 784 * MiB;
constexpr size_t WS_H2B = 912 * MiB;
constexpr size_t WS_DUMMY = 976 * MiB;
constexpr size_t WS_END = 992 * MiB;
static_assert(WS_HMID + (size_t)MPAD * D * 2 <= WS_Y && WS_Y + (size_t)MPAD * D * 2 <= WS_H2F, "ws map");
constexpr int CW_TMO = 0;
constexpr int CW_CNT = 64;
constexpr int CW_QUEUE = 128;
constexpr int CW_BAR = 4096;

__device__ __forceinline__ unsigned f2bf(float f) { unsigned u = __builtin_bit_cast(unsigned, f); return (u + 0x7fffu + ((u >> 16) & 1u)) >> 16; }
__device__ __forceinline__ unsigned pk2(float lo, float hi) { return f2bf(lo) | (f2bf(hi) << 16); }
__device__ __forceinline__ float bf2f(unsigned short h) { return __builtin_bit_cast(float, (unsigned)h << 16); }
__device__ __forceinline__ float bflo(unsigned w) { return __builtin_bit_cast(float, w << 16); }
__device__ __forceinline__ float bfhi(unsigned w) { return __builtin_bit_cast(float, w & 0xffff0000u); }
typedef float f32x2_t __attribute__((ext_vector_type(2))); typedef __bf16 bf16x2_t __attribute__((ext_vector_type(2)));
__device__ __forceinline__ unsigned cvtpk(float lo, float hi) { f32x2_t v = {lo, hi}; bf16x2_t b = __builtin_convertvector(v, bf16x2_t); return __builtin_bit_cast(unsigned, b); }
__device__ __forceinline__ float wave_sum(float v) {
#pragma unroll
    for (int o = 1; o < 64; o <<= 1) v += __shfl_xor(v, o);
    return v;
}
__device__ __forceinline__ float fast_exp2(float x) { return __builtin_amdgcn_exp2f(x); }
__device__ __forceinline__ float fast_rcp(float x) { return __builtin_amdgcn_rcpf(x); }
__device__ __forceinline__ float silu_f(float x) { return x * fast_rcp(1.0f + fast_exp2(-x * LOG2E)); }
__device__ __forceinline__ unsigned pk4_fp8(float a, float b, float c, float d) { int w = 0; w = __builtin_amdgcn_cvt_pk_fp8_f32(a, b, w, false); w = __builtin_amdgcn_cvt_pk_fp8_f32(c, d, w, true); return (unsigned)w; }
constexpr float XSCALE8 = 4.0f, XSCALE8_INV = 0.25f, PSCALE8 = 256.0f, PSCALE8_INV = 1.0f / 256.0f;
constexpr float WSCALE8 = 32.0f, WSCALE8_INV = 1.0f / 32.0f;
#define LDS_WAIT() asm volatile("s_waitcnt lgkmcnt(0)" ::: "memory")
#define VM_WAIT() asm volatile("s_waitcnt vmcnt(0)" ::: "memory")
#define RLX_AGENT __ATOMIC_RELAXED, __HIP_MEMORY_SCOPE_AGENT

namespace pg8 {
constexpr int BM = 256, BK = 64, HALF = 128, HTB = HALF * BK * 2, STAGE_BYTES = 8 * HTB;
__device__ __forceinline__ unsigned gload32_hidden(const void* sbase, unsigned voff) { unsigned v; asm volatile("global_load_dword %0, %1, %2" : "=v"(v) : "v"(voff), "s"(sbase) : "memory"); return v; }
__device__ __forceinline__ f32x4 gload128_hidden(const void* sbase, unsigned voff) { f32x4 v; asm volatile("global_load_dwordx4 %0, %1, %2" : "=v"(v) : "v"(voff), "s"(sbase) : "memory"); return v; }
__device__ __forceinline__ f32x4 gload128_hidden_nt(const void* sbase, unsigned voff) { f32x4 v; asm volatile("global_load_dwordx4 %0, %1, %2 nt" : "=v"(v) : "v"(voff), "s"(sbase) : "memory"); return v; }
__device__ __forceinline__ void glds16s(const char* sbase, unsigned voff, unsigned lds_dst) { unsigned keep;
    asm volatile("s_mov_b32 %0, m0\n\ts_mov_b32 m0, %3\n\ts_nop 0\n\tglobal_load_lds_dwordx4 %1, %2\n\ts_mov_b32 m0, %0" : "=&s"(keep) : "v"(voff), "s"(sbase), "s"(lds_dst) : "memory"); }
__host__ __device__ __forceinline__ int lds_byte(int r, int c) { const int st = (r >> 4) * 2 + (c >> 5), rr = r & 15, cc = c & 31, ob = rr * 64 + cc * 2; return st * 1024 + (ob ^ (((ob >> 9) & 1) << 5)); }
__host__ __device__ __forceinline__ void stage_rc(int b, int& R, int& C) { const int st = b / 1024, sb = b % 1024, swz = sb ^ (((sb >> 9) & 1) << 5); R = (st >> 1) * 16 + swz / 64; C = (st & 1) * 32 + (swz % 64) / 2; }
__host__ __device__ __forceinline__ int perm32(int rho) { const int n = rho >> 4, i = rho & 15; return 8 * (i >> 2) + 4 * n + (i & 3); }

struct Unit { const char* A; const char* B; const int* rows; int pm, pn, aux, nrows, ntu; };

template <class Epi, class Sched, bool GATHER, bool ALIGN_EPI, bool FP8 = false>
__device__ __forceinline__ void gemm_phase(LAS unsigned char* lds, const int lda, const int ldb, const int nt_in, const Sched& S, const Epi& E) {
    int nt = nt_in; asm volatile("" : "+s"(nt));
    int tid_ = threadIdx.x; asm volatile("" : "+v"(tid_));
    const int tid = tid_, wid = __builtin_amdgcn_readfirstlane(tid >> 6), lane = tid & 63, wr = wid >> 2, wc = wid & 3, fr = lane & 15, fq = lane >> 4;
    unsigned offB0; { int R, C; stage_rc(tid * 16, R, C); const int Rb = Epi::PERM ? ((R & ~31) + perm32(R & 31)) : R; offB0 = (unsigned)(Rb * ldb + C) * 2u; }
    const size_t pstepB = (size_t)64 * ldb * 2;
    const size_t kstep = (size_t)(BK * 2);
    const size_t hstepB = (size_t)HALF * ldb * 2;
    const unsigned ldsb = (unsigned)__builtin_amdgcn_readfirstlane((int)((unsigned)(uintptr_t)(unsigned char*)lds + (unsigned)wid * 1024u));
    const int aoff = lds_byte(wr * 64 + fr, FP8 ? fq * 16 : fq * 8), boff = lds_byte(wc * 32 + fr, FP8 ? fq * 16 : fq * 8);
#define PG8_SA(b, h) (((b) * 2 + (h)) * HTB)
#define PG8_SB(b, h) ((4 + (b) * 2 + (h)) * HTB)
#define PG8_STGB(bufoff, gbase) do { glds16s((const char*)(gbase), offB0, ldsb + (unsigned)(bufoff)); glds16s((const char*)(gbase) + pstepB, offB0, ldsb + (unsigned)(bufoff) + 8192u); } while (0)
#define PG8_LD16(p_) (*(const LAS u32x4*)(p_))
#define PG8_CAT(x, y) __builtin_bit_cast(v8i32_t, __builtin_shufflevector(x, y, 0, 1, 2, 3, 4, 5, 6, 7))
    unsigned aA0 = (unsigned)(aoff + PG8_SA(0, 0)), aA1 = (unsigned)(aoff + PG8_SA(1, 0)), bB0 = (unsigned)(boff + PG8_SB(0, 0)), bB1 = (unsigned)(boff + PG8_SB(1, 0));
    asm volatile("" : "+v"(aA0), "+v"(aA1), "+v"(bB0), "+v"(bB1));
    int scl8 = 0x7f7f7f7f; asm volatile("" : "+v"(scl8));
#define PG8_LDA(dst, b, h) do { const LAS unsigned char* ap_ = lds + ((b) ? aA1 : aA0) + (h) * HTB; _Pragma("unroll") for (int m = 0; m < 4; ++m) { \
        if constexpr (FP8) { dst##8[m] = PG8_CAT(PG8_LD16(ap_ + m * 2048), PG8_LD16(ap_ + m * 2048 + 16)); } \
        else { _Pragma("unroll") for (int k = 0; k < 2; ++k) dst[m][k] = *(const LAS bf16x8*)(ap_ + m * 2048 + k * 1024); } } } while (0)
#define PG8_LDB(dst, b, h) do { const LAS unsigned char* bp_ = lds + ((b) ? bB1 : bB0) + (h) * HTB; _Pragma("unroll") for (int n = 0; n < 2; ++n) { \
        if constexpr (FP8) { dst##8[n] = PG8_CAT(PG8_LD16(bp_ + n * 2048), PG8_LD16(bp_ + n * 2048 + 16)); } \
        else { _Pragma("unroll") for (int k = 0; k < 2; ++k) dst[n][k] = *(const LAS bf16x8*)(bp_ + n * 2048 + k * 1024); } } } while (0)
#define PG8_MMA(ai, bj, At, Bt) do { __builtin_amdgcn_s_setprio(1); _Pragma("unroll") for (int m = 0; m < 4; ++m) _Pragma("unroll") for (int n = 0; n < 2; ++n) { \
        if constexpr (FP8) asm volatile("v_mfma_scale_f32_16x16x128_f8f6f4 %0, %1, %2, %0, %3, %3 op_sel_hi:[0,0,0]" : "+v"(acc[ai][bj][m][n]) : "v"(Bt##8[n]), "v"(At##8[m]), "v"(scl8));   \
        else { _Pragma("unroll") for (int k = 0; k < 2; ++k) acc[ai][bj][m][n] = __builtin_amdgcn_mfma_f32_16x16x32_bf16(Bt[n][k], At[m][k], acc[ai][bj][m][n], 0, 0, 0); } } \
        __builtin_amdgcn_s_setprio(0); } while (0)
#define PG8_WAIT_V(n) asm volatile("s_waitcnt vmcnt(" #n ")" ::: "memory")
#define PG8_WAIT_L(n) asm volatile("s_waitcnt lgkmcnt(" #n ")" ::: "memory")
#define PG8_BAR __builtin_amdgcn_s_barrier()
#define PG8_SCHED __builtin_amdgcn_sched_barrier(0)
    unsigned voffA0, c2, pkc[2], pkn[2], praw[4];
    { int R, C; stage_rc(tid * 16, R, C); voffA0 = (unsigned)(R * lda + C) * 2u; c2 = (unsigned)C * 2u; }
    const size_t hstepA = (size_t)HALF * lda * 2, pstepA = (size_t)64 * lda * 2;
    const unsigned lda2 = (unsigned)lda * 2u;
#define PG8_PKROWS(dst, u) do { if (GATHER) { _Pragma("unroll") for (int i_ = 0; i_ < 2; ++i_) { int R_, C_; stage_rc(tid * 16 + i_ * 8192, R_, C_); \
        const int nr_ = (u).nrows - 1; const int r0_ = R_ < nr_ ? R_ : nr_, r1_ = (R_ + HALF) < nr_ ? (R_ + HALF) : nr_; \
        dst[i_] = (unsigned)(u).rows[r0_] | ((unsigned)(u).rows[r1_] << 16); } } } while (0)
#define PG8_RAWROWS(u) do { if (GATHER) { _Pragma("unroll") for (int i_ = 0; i_ < 2; ++i_) { int R_, C_; stage_rc(tid * 16 + i_ * 8192, R_, C_); \
        const int nr_ = (u).nrows - 1; const int r0_ = R_ < nr_ ? R_ : nr_, r1_ = (R_ + HALF) < nr_ ? (R_ + HALF) : nr_; \
        praw[2 * i_] = gload32_hidden((u).rows, (unsigned)r0_ * 4u); praw[2 * i_ + 1] = gload32_hidden((u).rows, (unsigned)r1_ * 4u); } } } while (0)
#define PG8_PACKRAW(dst) do { unsigned a0_ = praw[0], a1_ = praw[1], a2_ = praw[2], a3_ = praw[3]; asm volatile("" : "+v"(a0_), "+v"(a1_), "+v"(a2_), "+v"(a3_)); \
        dst[0] = a0_ | (a1_ << 16); dst[1] = a2_ | (a3_ << 16); } while (0)
#define PG8_STGA(bufoff, gbase, h, NX) do { \
        if (GATHER) { const unsigned p0_ = (NX) ? pkn[0] : pkc[0], p1_ = (NX) ? pkn[1] : pkc[1]; \
            const unsigned o0_ = ((h) ? (p0_ >> 16) : (p0_ & 0xffffu)) * lda2 + c2, o1_ = ((h) ? (p1_ >> 16) : (p1_ & 0xffffu)) * lda2 + c2; \
            glds16s((const char*)(gbase), o0_, ldsb + (unsigned)(bufoff)); glds16s((const char*)(gbase), o1_, ldsb + (unsigned)(bufoff) + 8192u); } \
        else { const char* gb_ = (const char*)(gbase) + ((h) ? hstepA : (size_t)0); glds16s(gb_, voffA0, ldsb + (unsigned)(bufoff)); glds16s(gb_ + pstepA, voffA0, ldsb + (unsigned)(bufoff) + 8192u); } } while (0)
    Unit cur, nxt; int ui = 0;
    if (!S.next(0, cur)) return;
    f32x4 acc[2][2][4][2];
#pragma unroll
    for (int a = 0; a < 2; ++a)
#pragma unroll
        for (int b = 0; b < 2; ++b)
#pragma unroll
            for (int m = 0; m < 4; ++m)
#pragma unroll
                for (int n = 0; n < 2; ++n) acc[a][b][m][n] = (f32x4){0.f, 0.f, 0.f, 0.f};
    bf16x8 At[4][2], B0[2][2], B1[2][2]; v8i32_t At8[4], B08[2], B18[2];
    pkc[0] = pkc[1] = pkn[0] = pkn[1] = 0u; praw[0] = praw[1] = praw[2] = praw[3] = 0u;
    PG8_PKROWS(pkc, cur);
    const char* cA = cur.A; const char* cB = cur.B;
    PG8_STGB(PG8_SB(0, 0), cB); PG8_STGB(PG8_SB(0, 1), cB + hstepB); PG8_STGA(PG8_SA(0, 0), cA, 0, false); PG8_STGA(PG8_SA(0, 1), cA, 1, false);
    if (wr == 1) PG8_BAR;
    PG8_WAIT_V(2); PG8_BAR;
    PG8_STGB(PG8_SB(1, 0), cB + kstep); PG8_STGA(PG8_SA(1, 0), cA + kstep, 0, false); PG8_STGB(PG8_SB(1, 1), cB + hstepB + kstep);
    PG8_WAIT_V(6); PG8_BAR;
    for (;;) {
        const bool has_next = S.next(ui + 1, nxt);
        if (GATHER) { if (has_next) { PG8_RAWROWS(nxt); } }
        const char* nA = has_next ? nxt.A : cA; const char* nB = has_next ? nxt.B : cB;
        typename Epi::Pre pre; { int t_p = threadIdx.x; asm volatile("" : "+v"(t_p)); E.prefetch(cur, wr, wc, t_p & 15, (t_p >> 4) & 3, pre); }
        const int ntc = cur.ntu ? cur.ntu : nt;
        for (int t = 0; t < ntc; t += 2) {
            const bool last = (t == ntc - 2);
            if (GATHER) { pkn[0] = pkc[0]; pkn[1] = pkc[1]; if (last && has_next) { PG8_PACKRAW(pkn); } }
            const char* a1 = cA + (size_t)(t + 1) * kstep;
            const char* a2 = last ? nA : cA + (size_t)(t + 2) * kstep; const char* b2 = last ? nB : cB + (size_t)(t + 2) * kstep;
            const char* a3 = a2 + kstep; const char* b3 = b2 + kstep;
            PG8_LDB(B0, 0, 0); PG8_LDB(B1, 0, 1); PG8_SCHED; PG8_LDA(At, 0, 0); PG8_STGA(PG8_SA(1, 1), a1, 1, false);
            PG8_WAIT_V(8); PG8_WAIT_L(0); PG8_BAR; PG8_MMA(0, 0, At, B0); PG8_MMA(0, 1, At, B1); PG8_BAR; PG8_SCHED;
            PG8_LDA(At, 0, 1); PG8_STGB(PG8_SB(0, 0), b2); PG8_STGB(PG8_SB(0, 1), b2 + hstepB); PG8_STGA(PG8_SA(0, 0), a2, 0, last);
            PG8_WAIT_V(8); PG8_WAIT_L(0); PG8_BAR; PG8_MMA(1, 0, At, B0); PG8_MMA(1, 1, At, B1); PG8_BAR; PG8_SCHED;
            PG8_LDB(B0, 1, 0); PG8_LDB(B1, 1, 1); PG8_SCHED; PG8_LDA(At, 1, 0); PG8_STGA(PG8_SA(0, 1), a2, 1, last);
            PG8_WAIT_V(8); PG8_WAIT_L(0); PG8_BAR; PG8_MMA(0, 0, At, B0); PG8_MMA(0, 1, At, B1); PG8_BAR; PG8_SCHED;
            PG8_LDA(At, 1, 1); PG8_STGB(PG8_SB(1, 0), b3); PG8_STGB(PG8_SB(1, 1), b3 + hstepB); PG8_STGA(PG8_SA(1, 0), a3, 0, last);
            PG8_WAIT_V(8); PG8_WAIT_L(0); PG8_BAR; PG8_MMA(1, 0, At, B0); PG8_MMA(1, 1, At, B1); PG8_BAR; PG8_SCHED;
        }
        if constexpr (ALIGN_EPI) { if (wr == 0) PG8_BAR; }
        if constexpr (FP8) asm volatile("s_nop 15\n\ts_nop 15" ::: "memory");
        if constexpr (!Epi::AFTER_DRAIN) { int t_e = threadIdx.x; asm volatile("" : "+v"(t_e)); const int fr_e = t_e & 15, fq_e = (t_e >> 4) & 3; E(acc, cur, wr, wc, fr_e, fq_e, pre); }
        if (!has_next) break;
#pragma unroll
        for (int a = 0; a < 2; ++a)
#pragma unroll
            for (int b = 0; b < 2; ++b)
#pragma unroll
                for (int m = 0; m < 4; ++m)
#pragma unroll
                    for (int n = 0; n < 2; ++n) acc[a][b][m][n] = (f32x4){0.f, 0.f, 0.f, 0.f};
        cur = nxt; cA = nA; cB = nB; ++ui;
        if (GATHER) { PG8_PACKRAW(pkc); }
        if constexpr (ALIGN_EPI) { if (wr == 1) PG8_BAR; }
    }
    PG8_WAIT_V(0);
    if constexpr (!ALIGN_EPI) { if (wr == 0) PG8_BAR; }
    PG8_BAR;
    if constexpr (Epi::AFTER_DRAIN) { int t_e = threadIdx.x; asm volatile("" : "+v"(t_e)); const int fr_e = t_e & 15, fq_e = (t_e >> 4) & 3; E.fused(acc, cur, wr, wc, fr_e, fq_e, lds, wid, t_e & 63); }
#undef PG8_SA
#undef PG8_SB
#undef PG8_STGB
#undef PG8_LDA
#undef PG8_LDB
#undef PG8_MMA
#undef PG8_CAT
#undef PG8_LD16
#undef PG8_WAIT_V
#undef PG8_WAIT_L
#undef PG8_SCHED
#undef PG8_PKROWS
#undef PG8_RAWROWS
#undef PG8_PACKRAW
#undef PG8_STGA
}
}

namespace pg8 {
constexpr int NXCD = 8, WGM = 8;
__device__ __forceinline__ void tile_order(int L, int nM, int nN, int& pm, int& pn) {
    const int nwg = nM * nN; int wgid = L;
    { const int q = nwg / NXCD, r = nwg % NXCD, xcd = wgid % NXCD, off = wgid / NXCD; wgid = (xcd < r ? xcd * (q + 1) : r * (q + 1) + (xcd - r) * q) + off; }
    const int nig = WGM * nN, gid = wgid / nig, fm = gid * WGM, gsz = (nM - fm) < WGM ? (nM - fm) : WGM;
    pm = fm + ((wgid % nig) % gsz); pn = (wgid % nig) / gsz;
}
struct DenseOrder {
    const char* A; const char* B; int lda, ldb, nM, nN, G, c, pn0;
    __device__ __forceinline__ bool next(int i, Unit& u) const {
        const long L = (long)i * G + c; if (L >= (long)nM * nN) return false;
        int pm, pn; tile_order((int)L, nM, nN, pm, pn);
        u.pm = pm; u.pn = pn + pn0; u.aux = 0; u.rows = nullptr; u.nrows = 256; u.ntu = 0;
        u.A = A + (size_t)pm * 256 * lda * 2; u.B = B + (size_t)pn * 256 * ldb * 2; return true;
    }
};
struct KvOrder {
    const char* MN; const char* W; int L0;
    __device__ __forceinline__ bool next(int i, Unit& u) const {
        const int L = L0; if (i > 0 || L >= 64) return false;
        u.rows = nullptr; u.nrows = 256; u.ntu = 0; u.pm = L >> 3; const int ct = L & 7; u.aux = ct >> 2; u.pn = ct & 3;
        u.A = MN + (size_t)u.pm * 256 * D * 2; u.B = W + (size_t)ct * 256 * D * 2; return true;
    }
};
struct XmnOrder {
    const char* MK; const char* MV; const char* WQN; const char* WOT; int G, c;
    __device__ __forceinline__ bool next(int i, Unit& u) const {
        const int L = c + i * G; if (L >= 256) return false;
        u.rows = nullptr; u.nrows = 256; u.ntu = 0;
        if (L < 128) { const int b = L >> 4, h = (L >> 2) & 3, kt = L & 3; u.aux = 0; u.pm = b * 4 + h; u.pn = kt;
            u.A = MK + ((size_t)(b * 256) * D + h * 256) * 2; u.B = WQN + ((size_t)(kt * 256) * D + h * 256) * 2; }
        else { const int l = L - 128, b = l >> 4, nt = (l >> 2) & 3, h = l & 3; u.aux = 1; u.pm = b * 4 + nt; u.pn = h;
            u.A = WOT + ((size_t)(nt * 256) * D + h * 256) * 2; u.B = MV + ((size_t)(b * 256) * D + h * 256) * 2; }
        return true;
    }
};
struct P3Order {
    XmnOrder X; DenseOrder Dn;
    __device__ __forceinline__ bool next(int i, Unit& u) const {
        if (i == 0 && X.c < 256) { X.next(0, u); u.ntu = 4; return true; }
        const bool ok = Dn.next(X.c < 256 ? i - 1 : i, u); u.aux = 2; return ok;
    }
};
struct XbOrder {
    const char* A; const char* Bb; int G, c; size_t rb;
    __device__ __forceinline__ bool next(int i, Unit& u) const {
        const long L = (long)i * G + c; if (L >= 512) return false;
        int pm, pn; tile_order((int)L, T / 256, 4, pm, pn);
        u.pm = pm; u.pn = pn; u.aux = 0; u.rows = nullptr; u.nrows = 256; u.ntu = 0;
        u.A = A + (size_t)pm * 256 * rb; u.B = Bb + (size_t)(pm >> 4) * D * rb + (size_t)pn * 256 * rb; return true;
    }
};
struct MoeOrder {
    const char* A; const char* W; const int* list; const LAS int* cnt; const LAS unsigned char* te; const LAS int* ts;
    int ntiles, nN, G, c; size_t wstride; int gather; size_t atile, btile;
    __device__ __forceinline__ bool next(int i, Unit& u) const {
        const long L = (long)i * G + c; if (L >= (long)ntiles * nN) return false;
        int pm, pn; tile_order((int)L, ntiles, nN, pm, pn);
        const int e = __builtin_amdgcn_readfirstlane((int)te[pm]);
        const int lt = pm - __builtin_amdgcn_readfirstlane(ts[e]);
        const int n = __builtin_amdgcn_readfirstlane(cnt[e]) - lt * 256;
        u.pm = pm; u.pn = pn; u.aux = e; u.nrows = n < 256 ? n : 256; u.ntu = 0;
        u.rows = list + (size_t)e * T + lt * 256;
        u.A = gather ? A : A + (size_t)pm * atile;
        u.B = W + (size_t)e * wstride + (size_t)pn * btile; return true;
    }
};

struct EpiProj {
    static constexpr bool PERM = true, AFTER_DRAIN = false; struct Pre {}; __device__ __forceinline__ void prefetch(const Unit&, int, int, int, int, Pre&) const {}
    bf16_t* O; float* kbar; float asc;
    __device__ __forceinline__ void operator()(const f32x4 (&acc)[2][2][4][2], const Unit& u, int wr, int wc, int fr, int fq, const Pre&) const {
        const int pn = u.pn, sec = pn >> 1, b = u.pm >> 4, t0 = (u.pm & 15) * 256 + wr * 64 + fr;
        const int mode = (pn < 2) ? 1 : ((pn == 6 || pn == 7 || pn >= 12) ? 2 : 0);
        bf16_t* sb = O + (size_t)sec * SEC_ELEMS;
#pragma unroll
        for (int bj = 0; bj < 2; ++bj) {
            const int c = bj * HALF + wc * 32 + 8 * fq, head = (pn & 1) * 4 + (c >> 6), d0 = c & 63;
            bf16_t* hb = sb + (size_t)(b * 8 + head) * (SEQ * 64);
#pragma unroll
            for (int ai = 0; ai < 2; ++ai)
#pragma unroll
                for (int m = 0; m < 4; ++m) { const int t = t0 + ai * HALF + m * 16;
                    f32x4 v0 = acc[ai][bj][m][0] * asc, v1 = acc[ai][bj][m][1] * asc;
                    if (mode == 1) { v0 = v0 * C2Q; v1 = v1 * C2Q; }
                    else if (mode == 2) {
#pragma unroll
                        for (int e = 0; e < 4; ++e) { v0[e] = silu_f(v0[e]); v1[e] = silu_f(v1[e]); } }
                    u32x4 w; w.x = cvtpk(v0[0], v0[1]); w.y = cvtpk(v0[2], v0[3]); w.z = cvtpk(v1[0], v1[1]); w.w = cvtpk(v1[2], v1[3]);
                    size_t off;
                    if (sec == 1) off = (size_t)(t >> 6) * 4096 + (d0 >> 3) * 512 + (t & 63) * 8;
                    else if (sec == 2) off = (size_t)(t >> 6) * 4096 + (d0 >> 5) * 2048 + (t & 63) * 32 + (d0 & 31);
                    else off = (size_t)t * 64 + d0;
                    *(u32x4*)(hb + off) = w; } }
        if (pn == 2 || pn == 3) {
#pragma unroll
            for (int bj = 0; bj < 2; ++bj)
#pragma unroll
                for (int n = 0; n < 2; ++n)
#pragma unroll
                    for (int e = 0; e < 4; ++e) { float s = 0.f;
#pragma unroll
                        for (int ai = 0; ai < 2; ++ai)
#pragma unroll
                            for (int m = 0; m < 4; ++m) s += acc[ai][bj][m][n][e];
                        s += __shfl_xor(s, 1); s += __shfl_xor(s, 2); s += __shfl_xor(s, 4); s += __shfl_xor(s, 8); s *= asc;
                        if (fr == 0) { const int c = bj * HALF + wc * 32 + 8 * fq + 4 * n + e, head = (pn - 2) * 4 + (c >> 6), d = c & 63;
                            atomicAdd(kbar + ((size_t)u.pm * 8 + head) * 64 + d, s); } }
        }
    }
};
struct EpiBf16 {
    static constexpr bool PERM = true, AFTER_DRAIN = false; struct Pre {}; __device__ __forceinline__ void prefetch(const Unit&, int, int, int, int, Pre&) const {}
    bf16_t* O0; int ldc0; bf16_t* O1; int ldc1;
    __device__ __forceinline__ void operator()(const f32x4 (&acc)[2][2][4][2], const Unit& u, int wr, int wc, int fr, int fq, const Pre&) const {
        bf16_t* O = u.aux ? O1 : O0; const int ldc = u.aux ? ldc1 : ldc0;
        const int row0 = u.pm * BM + wr * 64 + fr, col0 = u.pn * BM + wc * 32 + 8 * fq;
#pragma unroll
        for (int ai = 0; ai < 2; ++ai)
#pragma unroll
            for (int m = 0; m < 4; ++m) { bf16_t* rowp = O + (size_t)(row0 + ai * HALF + m * 16) * ldc + col0;
#pragma unroll
                for (int bj = 0; bj < 2; ++bj) { const f32x4 v0 = acc[ai][bj][m][0], v1 = acc[ai][bj][m][1];
                    u32x4 w; w.x = cvtpk(v0[0], v0[1]); w.y = cvtpk(v0[2], v0[3]); w.z = cvtpk(v1[0], v1[1]); w.w = cvtpk(v1[2], v1[3]);
                    *(u32x4*)(rowp + bj * HALF) = w; } }
    }
};
struct EpiFp8 {
    static constexpr bool PERM = true, AFTER_DRAIN = false; struct Pre {}; __device__ __forceinline__ void prefetch(const Unit&, int, int, int, int, Pre&) const {}
    unsigned char* O0; int ldc0; unsigned char* O1; int ldc1; float scale;
    __device__ __forceinline__ void operator()(const f32x4 (&acc)[2][2][4][2], const Unit& u, int wr, int wc, int fr, int fq, const Pre&) const {
        unsigned char* O = u.aux ? O1 : O0; const int ldc = u.aux ? ldc1 : ldc0;
        const int row0 = u.pm * BM + wr * 64 + fr, col0 = u.pn * BM + wc * 32 + 8 * fq;
#pragma unroll
        for (int ai = 0; ai < 2; ++ai)
#pragma unroll
            for (int m = 0; m < 4; ++m) { unsigned char* rowp = O + (size_t)(row0 + ai * HALF + m * 16) * ldc + col0;
#pragma unroll
                for (int bj = 0; bj < 2; ++bj) { const f32x4 v0 = acc[ai][bj][m][0] * scale, v1 = acc[ai][bj][m][1] * scale;
                    *(u32x2*)(rowp + bj * HALF) = (u32x2){pk4_fp8(v0[0], v0[1], v0[2], v0[3]), pk4_fp8(v1[0], v1[1], v1[2], v1[3])}; } }
    }
};
template <bool BASE_F32, bool WRITE_F32, bool OUT_FP8 = false> struct EpiRes {
    static constexpr bool PERM = true, AFTER_DRAIN = false; struct Pre {}; __device__ __forceinline__ void prefetch(const Unit&, int, int, int, int, Pre&) const {}
    const void* base; bf16_t* Ob; float* Of; float* ss; float asc; unsigned char* Oq;
    __device__ __forceinline__ void operator()(const f32x4 (&acc)[2][2][4][2], const Unit& u, int wr, int wc, int fr, int fq, const Pre&) const {
        const int row0 = u.pm * BM + wr * 64 + fr, col0 = u.pn * BM + wc * 32 + 8 * fq;
#pragma unroll
        for (int ai = 0; ai < 2; ++ai)
#pragma unroll
            for (int m = 0; m < 4; ++m) { const int row = row0 + ai * HALF + m * 16; const size_t off = (size_t)row * D + col0; float sq = 0.f;
#pragma unroll
                for (int bj = 0; bj < 2; ++bj) { f32x4 b0, b1;
                    if (BASE_F32) { b0 = *(const f32x4*)((const float*)base + off + bj * HALF); b1 = *(const f32x4*)((const float*)base + off + bj * HALF + 4); }
                    else { const u32x4 w = *(const u32x4*)((const bf16_t*)base + off + bj * HALF);
                        b0 = (f32x4){bflo(w.x), bfhi(w.x), bflo(w.y), bfhi(w.y)}; b1 = (f32x4){bflo(w.z), bfhi(w.z), bflo(w.w), bfhi(w.w)}; }
                    const f32x4 v0 = acc[ai][bj][m][0] * asc + b0, v1 = acc[ai][bj][m][1] * asc + b1;
                    sq += (v0[0] * v0[0] + v0[1] * v0[1]) + (v0[2] * v0[2] + v0[3] * v0[3]) + (v1[0] * v1[0] + v1[1] * v1[1]) + (v1[2] * v1[2] + v1[3] * v1[3]);
                    if (OUT_FP8) { *(u32x2*)((unsigned char*)Ob + off + bj * HALF) = (u32x2){pk4_fp8(v0[0], v0[1], v0[2], v0[3]), pk4_fp8(v1[0], v1[1], v1[2], v1[3])}; }
                    else { u32x4 w; w.x = cvtpk(v0[0], v0[1]); w.y = cvtpk(v0[2], v0[3]); w.z = cvtpk(v1[0], v1[1]); w.w = cvtpk(v1[2], v1[3]);
                    *(u32x4*)(Ob + off + bj * HALF) = w; }
                    if (Oq) *(u32x2*)(Oq + off + bj * HALF) = (u32x2){pk4_fp8(v0[0], v0[1], v0[2], v0[3]), pk4_fp8(v1[0], v1[1], v1[2], v1[3])};
                    if (WRITE_F32) { *(f32x4*)(Of + off + bj * HALF) = v0; *(f32x4*)(Of + off + bj * HALF + 4) = v1; } }
                sq += __shfl_xor(sq, 16); sq += __shfl_xor(sq, 32);
                if (fq == 0) atomicAdd(ss + row, sq); }
    }
};
struct EpiP3 {
    static constexpr bool PERM = true, AFTER_DRAIN = false; struct Pre {}; __device__ __forceinline__ void prefetch(const Unit&, int, int, int, int, Pre&) const {}
    EpiFp8 a; EpiRes<true, false> b;
    __device__ __forceinline__ void operator()(const f32x4 (&acc)[2][2][4][2], const Unit& u, int wr, int wc, int fr, int fq, const Pre&) const {
        if (u.aux < 2) a(acc, u, wr, wc, fr, fq, EpiFp8::Pre{}); else b(acc, u, wr, wc, fr, fq, EpiRes<true, false>::Pre{});
    }
};
struct EpiQ {
    static constexpr bool PERM = true, AFTER_DRAIN = false; struct Pre {}; __device__ __forceinline__ void prefetch(const Unit&, int, int, int, int, Pre&) const {}
    bf16_t* O; const float* ss;
    __device__ __forceinline__ void operator()(const f32x4 (&acc)[2][2][4][2], const Unit& u, int wr, int wc, int fr, int fq, const Pre&) const {
        const int row0 = u.pm * BM + wr * 64 + fr, col0 = u.pn * BM + wc * 32 + 8 * fq;
#pragma unroll
        for (int ai = 0; ai < 2; ++ai)
#pragma unroll
            for (int m = 0; m < 4; ++m) { const int row = row0 + ai * HALF + m * 16; const float sc = C2X * __builtin_amdgcn_rsqf(ss[row] * (1.0f / D) + EPS);
                bf16_t* rowp = O + (size_t)row * D + col0;
#pragma unroll
                for (int bj = 0; bj < 2; ++bj) { const f32x4 v0 = acc[ai][bj][m][0] * sc, v1 = acc[ai][bj][m][1] * sc;
                    u32x4 w; w.x = cvtpk(v0[0], v0[1]); w.y = cvtpk(v0[2], v0[3]); w.z = cvtpk(v1[0], v1[1]); w.w = cvtpk(v1[2], v1[3]);
                    *(u32x4*)(rowp + bj * HALF) = w; } }
    }
};
struct EpiSoftmaxS {
    static constexpr bool PERM = true, AFTER_DRAIN = false; struct Pre {}; __device__ __forceinline__ void prefetch(const Unit&, int, int, int, int, Pre&) const {}
    unsigned char* P; const float* ss; LAS unsigned char* tb; float qs;
    __device__ __forceinline__ void operator()(f32x4 (&acc)[2][2][4][2], const Unit& u, int wr, int wc, int fr, int fq, const Pre&) const {
        LAS float* MX = (LAS float*)tb;
        LAS float* SM = (LAS float*)(tb + 4096);
#pragma unroll
        for (int ai = 0; ai < 2; ++ai)
#pragma unroll
            for (int m = 0; m < 4; ++m) { const int r = ai * HALF + wr * 64 + m * 16 + fr; const float sc = qs * C2X * __builtin_amdgcn_rsqf(ss[u.pm * BM + r] * (1.0f / D) + EPS); float mx = -3.0e38f;
#pragma unroll
                for (int bj = 0; bj < 2; ++bj)
#pragma unroll
                    for (int n = 0; n < 2; ++n) { f32x4 x = acc[ai][bj][m][n] * sc; acc[ai][bj][m][n] = x; mx = fmaxf(mx, fmaxf(fmaxf(x[0], x[1]), fmaxf(x[2], x[3]))); }
                mx = fmaxf(mx, __shfl_xor(mx, 16)); mx = fmaxf(mx, __shfl_xor(mx, 32));
                if (fq == 0) MX[r * 4 + wc] = mx; }
        LDS_WAIT(); __builtin_amdgcn_s_barrier(); asm volatile("" ::: "memory");
#pragma unroll
        for (int ai = 0; ai < 2; ++ai)
#pragma unroll
            for (int m = 0; m < 4; ++m) { const int r = ai * HALF + wr * 64 + m * 16 + fr; const f32x4 q = *(const LAS f32x4*)(MX + r * 4);
                const float mx = fmaxf(fmaxf(q[0], q[1]), fmaxf(q[2], q[3])); float sm = 0.f;
#pragma unroll
                for (int bj = 0; bj < 2; ++bj)
#pragma unroll
                    for (int n = 0; n < 2; ++n) { f32x4 x = acc[ai][bj][m][n];
#pragma unroll
                        for (int e = 0; e < 4; ++e) { x[e] = fast_exp2(x[e] - mx); sm += x[e]; }
                        acc[ai][bj][m][n] = x; }
                sm += __shfl_xor(sm, 16); sm += __shfl_xor(sm, 32);
                if (fq == 0) SM[r * 4 + wc] = sm; }
        LDS_WAIT(); __builtin_amdgcn_s_barrier(); asm volatile("" ::: "memory");
        const int col0 = u.pn * BM + wc * 32 + 8 * fq;
#pragma unroll
        for (int ai = 0; ai < 2; ++ai)
#pragma unroll
            for (int m = 0; m < 4; ++m) { const int r = ai * HALF + wr * 64 + m * 16 + fr; const f32x4 q = *(const LAS f32x4*)(SM + r * 4);
                const float inv = PSCALE8 * fast_rcp((q[0] + q[1]) + (q[2] + q[3]));
#pragma unroll
                for (int bj = 0; bj < 2; ++bj) { const f32x4 v0 = acc[ai][bj][m][0] * inv, v1 = acc[ai][bj][m][1] * inv;
                    *(u32x2*)(P + ((size_t)u.pm * BM + r) * D + bj * HALF + col0) = (u32x2){pk4_fp8(v0[0], v0[1], v0[2], v0[3]), pk4_fp8(v1[0], v1[1], v1[2], v1[3])}; } }
        LDS_WAIT(); __builtin_amdgcn_s_barrier(); asm volatile("" ::: "memory");
    }
};
struct EpiW1 {
    static constexpr bool PERM = true, AFTER_DRAIN = false;
    struct Pre { float sc[8]; f32x4 bq[4]; };
    bf16_t* O; const float* ssl; const float* b1; const int* list0;
    __device__ __forceinline__ void prefetch(const Unit& u, int wr, int wc, int fr, int fq, Pre& p) const {
        const float* sp = ssl + (u.rows - list0);
        { const float* bb = b1 + (size_t)u.aux * 2048 + 2 * (u.pn * 128); const unsigned bo = (unsigned)(2 * (wc * 32 + 8 * fq)) * 4u;
#pragma unroll
          for (int q = 0; q < 4; ++q) p.bq[q] = gload128_hidden(bb, bo + 16u * q); }
#pragma unroll
        for (int ai = 0; ai < 2; ++ai)
#pragma unroll
            for (int m = 0; m < 4; ++m) { const int r = ai * HALF + wr * 64 + m * 16 + fr; const int rr = r < u.nrows ? r : u.nrows - 1; p.sc[ai * 4 + m] = __uint_as_float(gload32_hidden(sp, (unsigned)rr * 4u)); }
    }
    __device__ __forceinline__ void operator()(const f32x4 (&acc)[2][2][4][2], const Unit& u, int wr, int wc, int fr, int fq, const Pre& pre) const {
        const int c0 = wc * 32 + 8 * fq;
        f32x4 bq0 = pre.bq[0], bq1 = pre.bq[1], bq2 = pre.bq[2], bq3 = pre.bq[3]; asm volatile("" : "+v"(bq0), "+v"(bq1), "+v"(bq2), "+v"(bq3));
        const float bg[8] = {bq0[0], bq0[2], bq1[0], bq1[2], bq2[0], bq2[2], bq3[0], bq3[2]};
        const float bl[8] = {bq0[1], bq0[3], bq1[1], bq1[3], bq2[1], bq2[3], bq3[1], bq3[3]};
#pragma unroll
        for (int ai = 0; ai < 2; ++ai)
#pragma unroll
            for (int m = 0; m < 4; ++m) { const int r = ai * HALF + wr * 64 + m * 16 + fr;
                float ssv = pre.sc[ai * 4 + m]; asm volatile("" : "+v"(ssv));
                const float sc = WSCALE8_INV * __builtin_amdgcn_rsqf(ssv * (1.0f / D) + EPS); float a[8];
#pragma unroll
                for (int j = 0; j < 8; ++j) { const float g = acc[ai][0][m][j >> 2][j & 3] * sc + bg[j], l = acc[ai][1][m][j >> 2][j & 3] * sc + bl[j];
                    const float glu = fminf(g, 7.0f), lin = fminf(fmaxf(l, -7.0f), 7.0f);
                    a[j] = glu * fast_rcp(1.0f + fast_exp2(-1.702f * LOG2E * glu)) * (lin + 1.0f); }
                *(u32x2*)((unsigned char*)O + ((size_t)u.pm * BM + r) * D + u.pn * 128 + c0) = (u32x2){pk4_fp8(a[0], a[1], a[2], a[3]), pk4_fp8(a[4], a[5], a[6], a[7])}; }
    }
};
constexpr float YSCALE = 16.0f, YSCALE_INV = 1.0f / 16.0f;
struct EpiW2 {
    static constexpr bool PERM = true, AFTER_DRAIN = false;
    struct Pre { float g[8]; f32x4 bv[4]; };
    unsigned char* O; const float* b2; const int* list0; const float* gl0;
    __device__ __forceinline__ void prefetch(const Unit& u, int wr, int wc, int fr, int fq, Pre& p) const {
        const float* gp = gl0 + (u.rows - list0);
        { const float* bb = b2 + (size_t)u.aux * D + u.pn * BM; const unsigned bo = (unsigned)(wc * 32 + 8 * fq) * 4u;
#pragma unroll
          for (int q = 0; q < 4; ++q) p.bv[q] = gload128_hidden(bb, bo + (unsigned)((q >> 1) * HALF * 4 + (q & 1) * 16)); }
#pragma unroll
        for (int ai = 0; ai < 2; ++ai)
#pragma unroll
            for (int m = 0; m < 4; ++m) { const int r = ai * HALF + wr * 64 + m * 16 + fr; const int rr = r < u.nrows ? r : u.nrows - 1; p.g[ai * 4 + m] = __uint_as_float(gload32_hidden(gp, (unsigned)rr * 4u)); }
    }
    __device__ __forceinline__ void operator()(const f32x4 (&acc)[2][2][4][2], const Unit& u, int wr, int wc, int fr, int fq, const Pre& pre) const {
        const int row0 = u.pm * BM + wr * 64 + fr, col0 = u.pn * BM + wc * 32 + 8 * fq;
        f32x4 bv[2][2]; bv[0][0] = pre.bv[0]; bv[0][1] = pre.bv[1]; bv[1][0] = pre.bv[2]; bv[1][1] = pre.bv[3]; asm volatile("" : "+v"(bv[0][0]), "+v"(bv[0][1]), "+v"(bv[1][0]), "+v"(bv[1][1]));
#pragma unroll
        for (int ai = 0; ai < 2; ++ai)
#pragma unroll
            for (int m = 0; m < 4; ++m) { unsigned char* rowp = O + (size_t)(row0 + ai * HALF + m * 16) * D + col0; float gv = pre.g[ai * 4 + m]; asm volatile("" : "+v"(gv)); const float g = YSCALE * gv;
#pragma unroll
                for (int bj = 0; bj < 2; ++bj) { const f32x4 v0 = (acc[ai][bj][m][0] * WSCALE8_INV + bv[bj][0]) * g, v1 = (acc[ai][bj][m][1] * WSCALE8_INV + bv[bj][1]) * g;
                    *(u32x2*)(rowp + bj * HALF) = (u32x2){pk4_fp8(v0[0], v0[1], v0[2], v0[3]), pk4_fp8(v1[0], v1[1], v1[2], v1[3])}; } }
    }
};
}

namespace moba {
using bf16x8 = ::bf16x8; using s16x4 = ::s16x4; using f32x16 = ::f32x16; using u32x4 = ::u32x4;
constexpr int DMQ = INC, DMO = D, HD = 64;
constexpr int NW = 8, QBLK = 32, QB = 256, KVBLK = 64;
__device__ __forceinline__ int crow(int r, int hi) { return (r & 3) + 8 * (r >> 2) + 4 * hi; }
#define SBAR() __builtin_amdgcn_sched_barrier(0)
__device__ __forceinline__ void cmask(f32x16& p0, f32x16& p1, int jb, int qrel, int hi) {
    const float NEG = -INFINITY; int kb = 64 * jb + 4 * hi;
#pragma unroll
    for (int r = 0; r < 16; ++r) { int kv = kb + (r & 3) + 8 * (r >> 2); if (kv > qrel) p0[r] = NEG; if (kv + 32 > qrel) p1[r] = NEG; }
}
constexpr int NSLOT = 3, SLOTB = 8192;
constexpr int LDS_K = 0, LDS_V = NSLOT * SLOTB, LDS_WS = 2 * NSLOT * SLOTB, LDS_OST = LDS_WS + NW * 64 * 4, LDS_KB = LDS_OST + NW * 4096, LDS_BYTES = LDS_KB + 16 * 64 * 4;
__device__ __forceinline__ void glds16(const void* gsrc, unsigned lds_dst) { unsigned keep;
    asm volatile("s_mov_b32 %0, m0\n\ts_mov_b32 m0, %2\n\ts_nop 0\n\tglobal_load_lds_dwordx4 %1, off\n\ts_mov_b32 m0, %0" : "=&s"(keep) : "v"(gsrc), "s"(lds_dst) : "memory"); }
__device__ __forceinline__ float max3f(float a, float b, float c) { float r; asm("v_max3_f32 %0, %1, %2, %3" : "=v"(r) : "v"(a), "v"(b), "v"(c)); return r; }
__device__ __forceinline__ float max2f(float a, float b) { float r; asm("v_max_f32_e32 %0, %1, %2" : "=v"(r) : "v"(a), "v"(b)); return r; }
__device__ __forceinline__ float fadd_s(float a, float b) { float r; asm("v_add_f32_e32 %0, %1, %2" : "=v"(r) : "v"(a), "v"(b)); return r; }
__device__ __forceinline__ float fsub_s(float a, float b) { float r; asm("v_sub_f32_e32 %0, %1, %2" : "=v"(r) : "v"(a), "v"(b)); return r; }
__device__ __forceinline__ unsigned cvtpk_s(float lo, float hi) { return ::cvtpk(lo, hi); }
#define WAIT_BAR(N) asm volatile("s_waitcnt vmcnt(" #N ") lgkmcnt(0)\n\ts_barrier" ::: "memory")
__device__ __forceinline__ void qkt(f32x16& p0, f32x16& p1, const char* Kslot, const bf16x8* qr, const f32x16& negm, int r32, int hi) {
    const char* kb = Kslot + hi * 1024 + r32 * 16;
#pragma unroll
    for (int d0 = 0; d0 < 4; ++d0) {
        const bf16x8 b0 = *reinterpret_cast<const bf16x8*>(kb + d0 * 2048);
        const bf16x8 b1 = *reinterpret_cast<const bf16x8*>(kb + d0 * 2048 + 512);
        if (d0 == 0) { p0 = __builtin_amdgcn_mfma_f32_32x32x16_bf16(b0, qr[0], negm, 0, 0, 0); p1 = __builtin_amdgcn_mfma_f32_32x32x16_bf16(b1, qr[0], negm, 0, 0, 0); }
        else { p0 = __builtin_amdgcn_mfma_f32_32x32x16_bf16(b0, qr[d0], p0, 0, 0, 0); p1 = __builtin_amdgcn_mfma_f32_32x32x16_bf16(b1, qr[d0], p1, 0, 0, 0); } }
}
typedef __attribute__((address_space(3))) const char* lds_cptr;
typedef short v4i16_t __attribute__((ext_vector_type(4)));
__device__ __forceinline__ void kload8(bf16x8* kf, lds_cptr kp) {
    kf[0] = *(const __attribute__((address_space(3))) bf16x8*)(kp);        kf[1] = *(const __attribute__((address_space(3))) bf16x8*)(kp + 512);
    kf[2] = *(const __attribute__((address_space(3))) bf16x8*)(kp + 2048); kf[3] = *(const __attribute__((address_space(3))) bf16x8*)(kp + 2560);
    kf[4] = *(const __attribute__((address_space(3))) bf16x8*)(kp + 4096); kf[5] = *(const __attribute__((address_space(3))) bf16x8*)(kp + 4608);
    kf[6] = *(const __attribute__((address_space(3))) bf16x8*)(kp + 6144); kf[7] = *(const __attribute__((address_space(3))) bf16x8*)(kp + 6656);
}
__device__ __forceinline__ void kload2(bf16x8* kf, lds_cptr kp, int j) { kf[2 * j] = *(const __attribute__((address_space(3))) bf16x8*)(kp + j * 2048); kf[2 * j + 1] = *(const __attribute__((address_space(3))) bf16x8*)(kp + j * 2048 + 512); }
__device__ __forceinline__ s16x4 vtr(lds_cptr p) { return __builtin_bit_cast(s16x4, __builtin_amdgcn_ds_read_tr16_b64_v4i16((__attribute__((address_space(3))) v4i16_t*)p)); }
__device__ __forceinline__ float rowmax(const f32x16& p0, const f32x16& p1) {
    float a = max3f(p0[0], p0[1], p1[0]), b = max3f(p0[2], p0[3], p1[1]); a = max3f(a, p1[2], p1[3]);
#pragma unroll
    for (int r = 4; r < 16; r += 4) { a = max3f(a, p0[r], p0[r + 1]); b = max3f(b, p0[r + 2], p0[r + 3]); a = max3f(a, p1[r], p1[r + 1]); b = max3f(b, p1[r + 2], p1[r + 3]); }
    const float m = max2f(a, b);
    auto rr = __builtin_amdgcn_permlane32_swap(__float_as_uint(m), __float_as_uint(m), false, false);
    return max2f(__uint_as_float(rr[0]), __uint_as_float(rr[1]));
}
__device__ __forceinline__ void pv(f32x16* o, int vb, bf16x8 pa0, bf16x8 pa1, bf16x8 pa2, bf16x8 pa3) {
#pragma unroll
    for (int d0 = 0; d0 < 2; ++d0) { s16x4 lo[4], hi[4];
#pragma unroll
        for (int ks = 0; ks < 4; ++ks) {
            asm volatile("ds_read_b64_tr_b16 %0,%1 offset:%c2" : "=&v"(lo[ks]) : "v"(vb), "i"(d0 * 4096 + ks * 1024) : "memory");
            asm volatile("ds_read_b64_tr_b16 %0,%1 offset:%c2" : "=&v"(hi[ks]) : "v"(vb), "i"(d0 * 4096 + ks * 1024 + 512) : "memory"); }
        asm volatile("s_waitcnt lgkmcnt(0)" ::: "memory"); SBAR();
#define PK(k) (bf16x8){lo[k][0], lo[k][1], lo[k][2], lo[k][3], hi[k][0], hi[k][1], hi[k][2], hi[k][3]}
        o[d0] = __builtin_amdgcn_mfma_f32_32x32x16_bf16(pa0, PK(0), o[d0], 0, 0, 0);
        o[d0] = __builtin_amdgcn_mfma_f32_32x32x16_bf16(pa1, PK(1), o[d0], 0, 0, 0);
        o[d0] = __builtin_amdgcn_mfma_f32_32x32x16_bf16(pa2, PK(2), o[d0], 0, 0, 0);
        o[d0] = __builtin_amdgcn_mfma_f32_32x32x16_bf16(pa3, PK(3), o[d0], 0, 0, 0);
#undef PK
    }
}
constexpr float NEGBIG = -1.0e30f;

template <int THRL> __device__ __forceinline__ void attn_unit(int b, int h, int qb, const bf16_t* Qg, const bf16_t* __restrict__ Kg, const bf16_t* __restrict__ Vg, bf16_t* Og, const float* __restrict__ kbar, char* shm) {
    int tid_ = threadIdx.x; asm volatile("" : "+v"(tid_));
    const int tid = tid_, lane = tid & 63, r32 = lane & 31, hi = lane >> 5; const int wid = __builtin_amdgcn_readfirstlane(tid >> 6);
    const long rowbase = (long)b * SEQ; const int q0 = qb * QB;
    const size_t hoff = (size_t)(b * 8 + h) * (SEQ * 64);
    const bf16_t* Qw = Qg + hoff + (size_t)(q0 + wid * QBLK) * 64;
    const bf16_t* Kh = Kg + hoff, *Vh = Vg + hoff;
    const unsigned lds0 = (unsigned)(uintptr_t)shm;
    float* wsf = (float*)(shm + LDS_WS) + wid * 64;
    const bf16_t* ksrc = Kh + wid * 512 + lane * 8;
    const bf16_t* vsrc = Vh + wid * 512 + lane * 8;
    const unsigned kdst = lds0 + LDS_K + wid * 1024, vdst = lds0 + LDS_V + wid * 1024;
    const int NT = 4 * qb + 4, NPAST = 4 * qb;
#define TMAP(t) (((t) < 4) ? (NPAST + (t)) : ((t) - 4))
#define DMA_K(t, slot) glds16(ksrc + (long)TMAP(t) * 4096, (unsigned)__builtin_amdgcn_readfirstlane(kdst + (slot)))
#define DMA_V(t, slot) glds16(vsrc + (long)TMAP(t) * 4096, (unsigned)__builtin_amdgcn_readfirstlane(vdst + (slot)))
    const char* Kbase = shm + LDS_K; bf16x8 kf[8];
    const lds_cptr shm3 = (lds_cptr)shm; const lds_cptr kp0 = shm3 + LDS_K + hi * 1024 + r32 * 16; const lds_cptr vp0 = shm3 + LDS_V + ((lane >> 4) & 1) * 32 + (lane & 3) * 8 + (4 * hi + ((lane & 15) >> 2)) * 64;
    DMA_K(0, 0); DMA_V(0, 0); DMA_K(1, SLOTB);
    bf16x8 qr[4];
#pragma unroll
    for (int d0 = 0; d0 < 4; ++d0) qr[d0] = *reinterpret_cast<const bf16x8*>(&Qw[(long)r32 * 64 + d0 * 16 + hi * 8]);
    unsigned selm = 0u;
    if (qb > 0) {
        float* kbl = (float*)(shm + LDS_KB);
        for (int i = tid; i < qb * 64; i += NW * 64) kbl[i] = kbar[((size_t)(b * 16 + (i >> 6)) * 8 + h) * 64 + (i & 63)];
        asm volatile("s_waitcnt vmcnt(0) lgkmcnt(0)\n\ts_barrier" ::: "memory");
        if (qb <= 3) selm = (1u << qb) - 1u;
        else {
            float qf[32];
#pragma unroll
            for (int d0 = 0; d0 < 4; ++d0)
#pragma unroll
                for (int j = 0; j < 8; ++j) qf[d0 * 8 + j] = bf2f((unsigned short)qr[d0][j]);
            float g[15];
#pragma unroll
            for (int n = 0; n < 15; ++n) { float s = 0.f;
                if (n < qb) {
#pragma unroll
                    for (int d0 = 0; d0 < 4; ++d0) { const f32x4 k0 = *(const f32x4*)(kbl + n * 64 + d0 * 16 + hi * 8), k1 = *(const f32x4*)(kbl + n * 64 + d0 * 16 + hi * 8 + 4);
                        s += qf[d0 * 8 + 0] * k0[0] + qf[d0 * 8 + 1] * k0[1] + qf[d0 * 8 + 2] * k0[2] + qf[d0 * 8 + 3] * k0[3] + qf[d0 * 8 + 4] * k1[0] + qf[d0 * 8 + 5] * k1[1] + qf[d0 * 8 + 6] * k1[2] + qf[d0 * 8 + 7] * k1[3]; }
                    s += __shfl_xor(s, 32);
                } else s = -INFINITY;
                g[n] = s; }
#pragma unroll
            for (int pass = 0; pass < 3; ++pass) { float best = -INFINITY; int bi = 0;
#pragma unroll
                for (int n = 0; n < 15; ++n) if (g[n] > best) { best = g[n]; bi = n; }
                selm |= 1u << bi;
#pragma unroll
                for (int n = 0; n < 15; ++n) if (n == bi) g[n] = -INFINITY; }
        }
    }
    float mhat = 0.f, l_reg = 0.f; f32x16 o[2]; o[0] = f32x16{}; o[1] = f32x16{}; f32x16 cini = f32x16{}; asm volatile("" : "+v"(cini));
    const int qrel = wid * QBLK + r32;
#define SETC(t, JB) do { const float cm_ = ((JB >= 0) || ((selm >> (((t) - 4) >> 2)) & 1u)) ? -mhat : NEGBIG; \
      _Pragma("unroll") for (int r = 0; r < 16; ++r) cini[r] = cm_; asm volatile("" : "+v"(cini)); } while (0)
    bool resc = false;
#define START(P0, P1) do { const float rm = rowmax(P0, P1); resc = false; \
    { const float dl = rm; mhat = fadd_s(mhat, dl); \
      _Pragma("unroll") for (int r = 0; r < 16; ++r) { P0[r] = fsub_s(P0[r], dl); P1[r] = fsub_s(P1[r], dl); } } \
    _Pragma("unroll") for (int r = 0; r < 16; ++r) P0[r] = __builtin_amdgcn_exp2f(P0[r]); } while (0)
#define RESC() do { if (resc) { asm volatile("s_waitcnt lgkmcnt(0)" ::: "memory"); \
      _Pragma("unroll") for (int d_ = 0; d_ < 2; ++d_) _Pragma("unroll") for (int r = 0; r < 16; ++r) o[d_][r] *= wsf[crow(r, hi)]; } } while (0)
    f32x16 pA0, pA1, pB0, pB1;
    int sl_prev = 0, sl_cur = 0, sl_next = SLOTB;
#define ROT() do { sl_prev = sl_cur; sl_cur = sl_next; sl_next = (sl_next == (NSLOT - 1) * SLOTB) ? 0 : sl_next + SLOTB; } while (0)
    DMA_K(2, 2 * SLOTB);
    if (qb > 0) { WAIT_BAR(0); } else { WAIT_BAR(3); }
    qkt(pA0, pA1, Kbase, qr, cini, r32, hi); asm volatile("s_nop 15\n\ts_nop 7" : "+v"(pA0), "+v"(pA1)); cmask(pA0, pA1, 0, qrel, hi);
    START(pA0, pA1);
    _Pragma("unroll") for (int r = 0; r < 16; ++r) pA1[r] = __builtin_amdgcn_exp2f(pA1[r]);
    WAIT_BAR(0);
    DMA_K(3, 0); DMA_V(1, SLOTB);
    ROT();
    kload8(kf, kp0 + sl_cur);
    WAIT_BAR(2);
    s16x4 vlo[8], vhi[8]; u32x4 pw0, pw1, pw2, pw3;
#define PKW(P, B) cvtpk_s(P[B], P[B + 1])
#define PAF(k) __builtin_bit_cast(bf16x8, pw##k)
#define VFR(i) (bf16x8){vlo[i][0], vlo[i][1], vlo[i][2], vlo[i][3], vhi[i][0], vhi[i][1], vhi[i][2], vhi[i][3]}
#define PIN(x) asm volatile("" : "+v"(x))
#define MX3(a, b, c) __builtin_fmaxf(__builtin_fmaxf((a), (b)), (c))
#define GAPA(MF, A0, A1, A2, A3, W0, W1, PW) do { MF; sacc += A0; sacc += A1; sacc += A2; sacc += A3; PIN(sacc); W0; W1; PIN(PW); SBAR(); } while (0)
#define EX(v) __builtin_amdgcn_exp2f(v)
#define GAPB(MF, X, B) do { MF; X[B] = EX(X[B]); X[B + 1] = EX(X[B + 1]); X[B + 2] = EX(X[B + 2]); X[B + 3] = EX(X[B + 3]); PIN(X); SBAR(); } while (0)
#define VRD(i) do { vlo[i] = vtr(vp_ + (((i) >> 2) * 4096 + ((i) & 3) * 1024)); vhi[i] = vtr(vp_ + (((i) >> 2) * 4096 + ((i) & 3) * 1024 + 512)); } while (0)
#define KRD(G, j) do { if (G) { kload2(kf, kp0 + sl_next, j); SBAR(); } } while (0)
#define STEP(C0, C1, P0, P1, t, GK, GV, GL, JB) do { SETC(t, JB); SBAR(); \
    const lds_cptr vp_ = vp0 + sl_prev; \
    VRD(0); SBAR(); float sacc = (P0[0] + P0[1]); \
    GAPA(C0 = __builtin_amdgcn_mfma_f32_32x32x16_bf16(kf[0], qr[0], cini, 0, 0, 0), P0[2], P0[3], P0[4], P0[5],     pw0[0] = PKW(P0, 0), pw0[1] = PKW(P0, 2), pw0); \
    VRD(4); SBAR(); GAPA(C1 = __builtin_amdgcn_mfma_f32_32x32x16_bf16(kf[1], qr[0], cini, 0, 0, 0), P0[6], P0[7], P0[8], P0[9],     pw0[2] = PKW(P0, 4), pw0[3] = PKW(P0, 6), pw0); \
    VRD(1); SBAR(); GAPA(C0 = __builtin_amdgcn_mfma_f32_32x32x16_bf16(kf[2], qr[1], C0, 0, 0, 0),   P0[10], P0[11], P0[12], P0[13], pw1[0] = PKW(P0, 8), pw1[1] = PKW(P0, 10), pw1); \
    VRD(5); SBAR(); GAPA(C1 = __builtin_amdgcn_mfma_f32_32x32x16_bf16(kf[3], qr[1], C1, 0, 0, 0),   P0[14], P0[15], P1[0], P1[1],   pw1[2] = PKW(P0, 12), pw1[3] = PKW(P0, 14), pw1); \
    VRD(2); SBAR(); GAPA(C0 = __builtin_amdgcn_mfma_f32_32x32x16_bf16(kf[4], qr[2], C0, 0, 0, 0),   P1[2], P1[3], P1[4], P1[5],     pw2[0] = PKW(P1, 0), pw2[1] = PKW(P1, 2), pw2); \
    VRD(6); SBAR(); GAPA(C1 = __builtin_amdgcn_mfma_f32_32x32x16_bf16(kf[5], qr[2], C1, 0, 0, 0),   P1[6], P1[7], P1[8], P1[9],     pw2[2] = PKW(P1, 4), pw2[3] = PKW(P1, 6), pw2); \
    VRD(3); SBAR(); GAPA(C0 = __builtin_amdgcn_mfma_f32_32x32x16_bf16(kf[6], qr[3], C0, 0, 0, 0),   P1[10], P1[11], P1[12], P1[13], pw3[0] = PKW(P1, 8), pw3[1] = PKW(P1, 10), pw3); \
    VRD(7); SBAR(); GAPA(C1 = __builtin_amdgcn_mfma_f32_32x32x16_bf16(kf[7], qr[3], C1, 0, 0, 0),   P1[14], P1[15], 0.f, 0.f,       pw3[2] = PKW(P1, 12), pw3[3] = PKW(P1, 14), pw3); \
    l_reg += sacc; \
    if (GK) { DMA_K((t) + 3, sl_cur); } if (GV) { DMA_V((t) + 1, sl_next); } \
    if (JB >= 0) cmask(C0, C1, JB, qrel, hi); \
    { float a = MX3(C0[0], C0[1], C1[0]), b_ = MX3(C0[2], C0[3], C1[1]); a = MX3(a, C1[2], C1[3]); \
      _Pragma("unroll") for (int r = 4; r < 16; r += 4) { a = MX3(a, C0[r], C0[r + 1]); b_ = MX3(b_, C0[r + 2], C0[r + 3]); a = MX3(a, C1[r], C1[r + 1]); b_ = MX3(b_, C1[r + 2], C1[r + 3]); } \
      float rm = __builtin_fmaxf(a, b_); { auto rr = __builtin_amdgcn_permlane32_swap(__float_as_uint(rm), __float_as_uint(rm), false, false); rm = __builtin_fmaxf(__uint_as_float(rr[0]), __uint_as_float(rr[1])); } \
      resc = false; \
      if (__builtin_expect(__any(rm > (float)THRL), 0)) { const float dl = __builtin_fmaxf(rm, 0.f); mhat += dl; \
        _Pragma("unroll") for (int r = 0; r < 16; ++r) { C0[r] -= dl; C1[r] -= dl; } \
        const float f = __builtin_amdgcn_exp2f(-dl); l_reg *= f; if (hi == 0) wsf[r32] = f; resc = true; } } \
    SBAR(); \
    GAPB(o[0] = __builtin_amdgcn_mfma_f32_32x32x16_bf16(PAF(0), VFR(0), o[0], 0, 0, 0), C0, 0); \
    GAPB(o[1] = __builtin_amdgcn_mfma_f32_32x32x16_bf16(PAF(0), VFR(4), o[1], 0, 0, 0), C0, 4); \
    KRD(GL, 0); GAPB(o[0] = __builtin_amdgcn_mfma_f32_32x32x16_bf16(PAF(1), VFR(1), o[0], 0, 0, 0), C0, 8); \
    KRD(GL, 1); GAPB(o[1] = __builtin_amdgcn_mfma_f32_32x32x16_bf16(PAF(1), VFR(5), o[1], 0, 0, 0), C0, 12); \
    KRD(GL, 2); GAPB(o[0] = __builtin_amdgcn_mfma_f32_32x32x16_bf16(PAF(2), VFR(2), o[0], 0, 0, 0), C1, 0); \
    KRD(GL, 3); GAPB(o[1] = __builtin_amdgcn_mfma_f32_32x32x16_bf16(PAF(2), VFR(6), o[1], 0, 0, 0), C1, 4); \
    GAPB(o[0] = __builtin_amdgcn_mfma_f32_32x32x16_bf16(PAF(3), VFR(3), o[0], 0, 0, 0), C1, 8); \
    GAPB(o[1] = __builtin_amdgcn_mfma_f32_32x32x16_bf16(PAF(3), VFR(7), o[1], 0, 0, 0), C1, 12); \
    } while (0)
#define ENDW(tt) do { if ((tt) + 3 < NT) { WAIT_BAR(2); } else if ((tt) + 2 < NT) { WAIT_BAR(1); } else { WAIT_BAR(0); } } while (0)
    STEP(pB0, pB1, pA0, pA1, 1, (4 < NT), true, true, 1);   ENDW(1); RESC(); ROT();
    STEP(pA0, pA1, pB0, pB1, 2, (5 < NT), true, true, 2);   ENDW(2); RESC(); ROT();
    STEP(pB0, pB1, pA0, pA1, 3, (6 < NT), (4 < NT), (4 < NT), 3);   ENDW(3); RESC(); ROT();
    int t = 4;
    for (; t + 4 < NT; t += 2) {
        STEP(pA0, pA1, pB0, pB1, t, true, true, true, -1);       WAIT_BAR(2); RESC(); ROT();
        STEP(pB0, pB1, pA0, pA1, t + 1, true, true, true, -1);   WAIT_BAR(2); RESC(); ROT();
    }
    for (; t < NT; t += 2) {
        STEP(pA0, pA1, pB0, pB1, t, (t + 3 < NT), true, true, -1);                       ENDW(t);     RESC(); ROT();
        STEP(pB0, pB1, pA0, pA1, t + 1, (t + 4 < NT), (t + 2 < NT), (t + 2 < NT), -1);   ENDW(t + 1); RESC(); ROT();
    }
    { float sacc = pB0[0] + pB0[1]; _Pragma("unroll") for (int r = 2; r < 16; ++r) sacc += pB0[r]; _Pragma("unroll") for (int r = 0; r < 16; ++r) sacc += pB1[r]; l_reg += sacc;
      pw0 = (u32x4){PKW(pB0, 0), PKW(pB0, 2), PKW(pB0, 4), PKW(pB0, 6)}; pw1 = (u32x4){PKW(pB0, 8), PKW(pB0, 10), PKW(pB0, 12), PKW(pB0, 14)}; pw2 = (u32x4){PKW(pB1, 0), PKW(pB1, 2), PKW(pB1, 4), PKW(pB1, 6)}; pw3 = (u32x4){PKW(pB1, 8), PKW(pB1, 10), PKW(pB1, 12), PKW(pB1, 14)};
      SBAR(); pv(o, (int)(unsigned long)vp0 + sl_prev, PAF(0), PAF(1), PAF(2), PAF(3)); }
#undef PKW
#undef PAF
#undef VFR
#undef PIN
#undef MX3
#undef GAPA
#undef GAPB
#undef EX
#undef VRD
#undef KRD
#undef STEP
#undef ENDW
    { auto rr = __builtin_amdgcn_permlane32_swap(__float_as_uint(l_reg), __float_as_uint(l_reg), false, false); l_reg = __uint_as_float(rr[0]) + __uint_as_float(rr[1]); }
    if (hi == 0) wsf[32 + r32] = l_reg; asm volatile("s_waitcnt lgkmcnt(0)" ::: "memory");
    float rli[16];
#pragma unroll
    for (int r = 0; r < 16; ++r) rli[r] = __builtin_amdgcn_rcpf(wsf[32 + crow(r, hi)]);
    bf16_t* Ow = Og + (rowbase + q0 + wid * QBLK) * DMO + h * HD;
    { bf16_t* stg = (bf16_t*)(shm + LDS_OST) + wid * 2048;
#pragma unroll
      for (int r = 0; r < 16; ++r) { const int orow = crow(r, hi);
#pragma unroll
        for (int d0 = 0; d0 < 2; ++d0) stg[orow * 64 + d0 * 32 + r32] = (bf16_t)f2bf(o[d0][r] * rli[r]); }
      asm volatile("s_waitcnt lgkmcnt(0)" ::: "memory");
#pragma unroll
      for (int i = 0; i < 4; ++i) { const int row = i * 8 + (lane >> 3), ch = lane & 7; const u32x4 v = *(const u32x4*)(stg + row * 64 + ch * 8); *(u32x4*)(Ow + (long)row * DMO + ch * 8) = v; } }
    asm volatile("s_waitcnt lgkmcnt(0)\n\ts_barrier" ::: "memory");
#undef DMA_K
#undef DMA_V
#undef TMAP
#undef SETC
#undef START
#undef RESC
#undef ROT
}
#undef SBAR
#undef WAIT_BAR
}

namespace hgrn {
constexpr int RS = 144;
constexpr int R_FQV = 0, FQV_SLOT = 32768;
constexpr int L_Q = 98304, L_K = L_Q + 9216, L_KT = L_K + 9216, L_VT = L_KT + 9216, L_ST = L_VT + 9216, L_SEG = L_ST + 9216, L_DEND = L_SEG + 2048, L_SSQ = L_DEND + 256, L_BYTES = L_SSQ + 512;
__device__ __forceinline__ int crow(int r, int hi) { return (r & 3) + 8 * (r >> 2) + 4 * hi; }
__device__ __forceinline__ void glds16(const void* gsrc, unsigned lds_dst) { unsigned keep;
    asm volatile("s_mov_b32 %0, m0\n\ts_mov_b32 m0, %2\n\ts_nop 0\n\tglobal_load_lds_dwordx4 %1, off\n\ts_mov_b32 m0, %0" : "=&s"(keep) : "v"(gsrc), "s"(lds_dst) : "memory"); }
#define HG_BAR() do { asm volatile("s_waitcnt lgkmcnt(0)" ::: "memory"); __builtin_amdgcn_s_barrier(); asm volatile("" ::: "memory"); } while (0)
#ifndef HG_ABL
#define HG_ABL 0
#endif
__device__ __forceinline__ void hgrn_unit(int b, int h, const bf16_t* __restrict__ proj, bf16_t* __restrict__ mix, const float* __restrict__ lb_logits, const float* __restrict__ norm_g, LAS unsigned char* lds, const int abl = 0) {
    int tid_ = threadIdx.x; asm volatile("" : "+v"(tid_));
    const int tid = tid_, lane = tid & 63, r32 = lane & 31, hi = lane >> 5; const int w = __builtin_amdgcn_readfirstlane(tid >> 6);
    const float lbk = fast_rcp(1.0f + fast_exp2((lb_logits[512 + h * 64 + lane] - lb_logits[h * 64 + lane]) * LOG2E));
    const int vr = (w >> 1) & 1, tc = w & 1;
    float ng[16];
#pragma unroll
    for (int r = 0; r < 16; ++r) ng[r] = norm_g[h * 64 + 32 * vr + crow(r, hi)];
    f32x16 S = f32x16{};
    for (int i = tid; i < 64 * RS / 4; i += 512) ((LAS unsigned*)(lds + L_ST))[i] = 0u;
    const size_t hoff = (size_t)(b * 8 + h) * (SEQ * 64) + (size_t)w * 512 + lane * 8;
    const bf16_t* gQ = proj + 3 * SEC_ELEMS + hoff; const bf16_t* gF = proj + 4 * SEC_ELEMS + hoff; const bf16_t* gV = proj + 5 * SEC_ELEMS + hoff; const bf16_t* gG = proj + 6 * SEC_ELEMS + hoff;
    const unsigned lds0 = (unsigned)(uintptr_t)(unsigned char*)lds;
#define DMA_FQV(c_) do { const int cc_ = (c_) < 63 ? (c_) : 63; const unsigned d_ = (unsigned)__builtin_amdgcn_readfirstlane(lds0 + R_FQV + (unsigned)(((c_) % 3) * FQV_SLOT) + (unsigned)w * 1024u); \
        glds16(gF + (size_t)cc_ * 4096, d_); glds16(gQ + (size_t)cc_ * 4096, d_ + 8192u); glds16(gV + (size_t)cc_ * 4096, d_ + 16384u); } while (0)
#define DMA_G(c_) do { const int cc_ = (c_) < 63 ? (c_) : 63; glds16(gG + (size_t)cc_ * 4096, (unsigned)__builtin_amdgcn_readfirstlane(lds0 + R_FQV + (unsigned)(((c_) % 3) * FQV_SLOT) + 24576u + (unsigned)w * 1024u)); } while (0)
    DMA_FQV(0); DMA_G(0); DMA_FQV(1); DMA_G(1); DMA_FQV(2);
    for (int c = 0; c < 64; ++c) {
        const size_t row0 = (size_t)b * SEQ + (size_t)c * 64;
        if (abl & 8) {} else if (w < 4 && c >= 3) asm volatile("s_waitcnt vmcnt(20)" ::: "memory");
        else asm volatile("s_waitcnt vmcnt(8)" ::: "memory");
        const LAS unsigned char* raw = lds + R_FQV + (c % 3) * FQV_SLOT + (8 * w) * 128 + lane * 2;
        float p[8], kk[8];
        { float run = 0.f;
#pragma unroll
          for (int i = 0; i < 8; ++i) { const float x = bf2f(*(const LAS unsigned short*)(raw + i * 128)); float f, lg;
              if (abl & 2) { f = 0.5f + 0.001f * x; lg = -1.0f + 0.001f * x; } else { const float sg = fast_rcp(1.0f + fast_exp2(-x * LOG2E)); f = lbk + (1.0f - lbk) * sg; lg = __builtin_amdgcn_logf(f); }
              run += lg; p[i] = run; kk[i] = 1.0f - f; } }
        ((LAS float*)(lds + L_SEG))[w * 64 + lane] = p[7];
        HG_BAR();
        if (!(abl & 8)) DMA_G(c + 2);
        { float off = 0.f;
#pragma unroll
          for (int j = 0; j < 7; ++j) { const float sv = ((LAS float*)(lds + L_SEG))[j * 64 + lane]; off += (j < w) ? sv : 0.f; }
          unsigned kq[4], vq[4];
#pragma unroll
          for (int i = 0; i < 8; i += 2) { const float b0 = off + p[i], b1 = off + p[i + 1];
              const unsigned short q0r = *(const LAS unsigned short*)(raw + 8192 + i * 128), q1r = *(const LAS unsigned short*)(raw + 8192 + (i + 1) * 128);
              const unsigned short v0r = *(const LAS unsigned short*)(raw + 16384 + i * 128), v1r = *(const LAS unsigned short*)(raw + 16384 + (i + 1) * 128);
              const float q0 = bf2f(q0r) * fast_exp2(b0), q1 = bf2f(q1r) * fast_exp2(b1), k0 = kk[i] * fast_exp2(-b0), k1 = kk[i + 1] * fast_exp2(-b1);
              const unsigned qq = cvtpk(q0, q1), kw = cvtpk(k0, k1); kq[i >> 1] = kw; vq[i >> 1] = (unsigned)v0r | ((unsigned)v1r << 16);
              if (abl & 4) continue;
              *(LAS unsigned short*)(lds + L_Q + (8 * w + i) * RS + lane * 2) = (unsigned short)(qq & 0xffffu);
              *(LAS unsigned short*)(lds + L_Q + (8 * w + i + 1) * RS + lane * 2) = (unsigned short)(qq >> 16);
              *(LAS unsigned short*)(lds + L_K + (8 * w + i) * RS + lane * 2) = (unsigned short)(kw & 0xffffu);
              *(LAS unsigned short*)(lds + L_K + (8 * w + i + 1) * RS + lane * 2) = (unsigned short)(kw >> 16); }
          *(LAS u32x4*)(lds + L_KT + lane * RS + 16 * w) = (u32x4){kq[0], kq[1], kq[2], kq[3]};
          *(LAS u32x4*)(lds + L_VT + lane * RS + 16 * w) = (u32x4){vq[0], vq[1], vq[2], vq[3]};
          if (w == 7) ((LAS float*)(lds + L_DEND))[lane] = fast_exp2(off + p[7]); }
        if (!(abl & 8)) DMA_FQV(c + 3);
        if (abl & 8) {} else if (w < 4 && c >= 2) asm volatile("s_waitcnt vmcnt(19)" ::: "memory");
        else asm volatile("s_waitcnt vmcnt(11)" ::: "memory");
        HG_BAR();
        f32x16 OT = f32x16{};
        if (abl & 1) { OT[0] = (float)c; } else
        if (w < 4) {
            bf16x8 bq[4];
#pragma unroll
            for (int ks = 0; ks < 4; ++ks) bq[ks] = *(const LAS bf16x8*)(lds + L_Q + (32 * tc + r32) * RS + (16 * ks + 8 * hi) * 2);
#pragma unroll
            for (int sr = 0; sr < 2; ++sr) if (sr <= tc) {
                f32x16 at = f32x16{};
#pragma unroll
                for (int ks = 0; ks < 4; ++ks) { const bf16x8 a = *(const LAS bf16x8*)(lds + L_K + (32 * sr + r32) * RS + (16 * ks + 8 * hi) * 2); at = __builtin_amdgcn_mfma_f32_32x32x16_bf16(a, bq[ks], at, 0, 0, 0); }
                if (sr == tc) {
#pragma unroll
                    for (int r = 0; r < 16; ++r) at[r] = (crow(r, hi) <= r32) ? at[r] : 0.f; }
#pragma unroll
                for (int st = 0; st < 2; ++st) {
                    u32x4 bw; bw.x = cvtpk(at[8 * st + 0], at[8 * st + 1]); bw.y = cvtpk(at[8 * st + 2], at[8 * st + 3]); bw.z = cvtpk(at[8 * st + 4], at[8 * st + 5]); bw.w = cvtpk(at[8 * st + 6], at[8 * st + 7]);
                    const u32x2 lo = *(const LAS u32x2*)(lds + L_VT + (32 * vr + r32) * RS + (32 * sr + 16 * st + 4 * hi) * 2);
                    const u32x2 hh = *(const LAS u32x2*)(lds + L_VT + (32 * vr + r32) * RS + (32 * sr + 16 * st + 8 + 4 * hi) * 2);
                    const u32x4 aw = (u32x4){lo.x, lo.y, hh.x, hh.y};
                    OT = __builtin_amdgcn_mfma_f32_32x32x16_bf16(__builtin_bit_cast(bf16x8, aw), __builtin_bit_cast(bf16x8, bw), OT, 0, 0, 0); }
            }
#pragma unroll
            for (int ks = 0; ks < 4; ++ks) { const bf16x8 a = *(const LAS bf16x8*)(lds + L_ST + (32 * vr + r32) * RS + (16 * ks + 8 * hi) * 2); OT = __builtin_amdgcn_mfma_f32_32x32x16_bf16(a, bq[ks], OT, 0, 0, 0); }
            float sq = 0.f;
#pragma unroll
            for (int r = 0; r < 16; ++r) sq += OT[r] * OT[r];
            sq += __shfl_xor(sq, 32);
            if (hi == 0) ((LAS float*)(lds + L_SSQ))[vr * 64 + 32 * tc + r32] = sq;
        } else {
#pragma unroll
            for (int st = 0; st < 4; ++st) { const bf16x8 a = *(const LAS bf16x8*)(lds + L_KT + (32 * vr + r32) * RS + (16 * st + 8 * hi) * 2);
                const bf16x8 bv = *(const LAS bf16x8*)(lds + L_VT + (32 * tc + r32) * RS + (16 * st + 8 * hi) * 2);
                S = __builtin_amdgcn_mfma_f32_32x32x16_bf16(a, bv, S, 0, 0, 0); }
#pragma unroll
            for (int r = 0; r < 16; ++r) S[r] *= ((LAS float*)(lds + L_DEND))[32 * vr + crow(r, hi)];
        }
        HG_BAR();
        if (w < 4) {
            const int t = 32 * tc + r32;
            const float tot = ((LAS float*)(lds + L_SSQ))[t] + ((LAS float*)(lds + L_SSQ))[64 + t];
            const float rstd = __builtin_amdgcn_rsqf(tot * (1.0f / 64.0f) + EPS);
            const LAS unsigned char* gp = lds + R_FQV + (c % 3) * FQV_SLOT + 24576 + t * 128 + (32 * vr + 4 * hi) * 2;
            bf16_t* op = mix + (row0 + t) * D + 512 + h * 64 + 32 * vr + 4 * hi;
#pragma unroll
            for (int g = 0; g < 4; ++g) { const u32x2 gg = *(const LAS u32x2*)(gp + 16 * g);
                const float y0 = OT[4 * g + 0] * rstd * ng[4 * g + 0] * bflo(gg.x), y1 = OT[4 * g + 1] * rstd * ng[4 * g + 1] * bfhi(gg.x),
                            y2 = OT[4 * g + 2] * rstd * ng[4 * g + 2] * bflo(gg.y), y3 = OT[4 * g + 3] * rstd * ng[4 * g + 3] * bfhi(gg.y);
                const u32x2 yv = (u32x2){cvtpk(y0, y1), cvtpk(y2, y3)}; if (!(abl & 16)) asm volatile("global_store_dwordx2 %0, %1, off" :: "v"(op + 8 * g), "v"(yv) : "memory"); }
        } else {
#pragma unroll
            for (int g = 0; g < 4; ++g) *(LAS u32x2*)(lds + L_ST + (32 * tc + r32) * RS + (32 * vr + 8 * g + 4 * hi) * 2) = (u32x2){cvtpk(S[4 * g + 0], S[4 * g + 1]), cvtpk(S[4 * g + 2], S[4 * g + 3])};
        }
    }
    asm volatile("s_waitcnt vmcnt(0)" ::: "memory");
    HG_BAR();
#undef DMA_FQV
#undef DMA_G
}
#undef HG_BAR
}

constexpr int NWAVES = 8;
constexpr int LDS_BYTES = 163840;
constexpr int TAIL = 161792;
constexpr int TL_TE = TAIL, TL_TS = TAIL + 576, TL_HIST = TAIL + 768, TL_BASE = TAIL + 896, TL_MISC = TAIL + 1024, TL_CNT = TAIL + 1280;
typedef GAS unsigned gu32;

struct Args { const float* in[20]; float* out; unsigned char* ws; int ph_lo, ph_hi; };

struct Frame {
    LAS unsigned char* lds; volatile LAS unsigned* MISC; unsigned* ctl;
    int tid, lane, wave, G, vcu;
};

struct P0Item { const float* W; bf16_t* WT; const float* gain; int N, K, k0, n0, mode; };
constexpr int P0_I_IN = 16 * 56, P0_I_SQ = 16 * 16, P0_I_KV = 16 * 32, P0_I_W1 = 16 * 32, P0_I_W2 = 16 * 16;
constexpr int P0_I_IN8 = 16 * 24;
constexpr int P0_NA = P0_I_IN + P0_I_KV + P0_I_IN8, P0_NB = 2 * P0_I_SQ + NEXP * (P0_I_W1 + P0_I_W2);
template <int SET> __device__ __forceinline__ bool p0_decode(const Args& a, int it, P0Item& I) {
    unsigned char* ws = a.ws;
    if (it >= (SET == 0 ? P0_NA : P0_NB)) return false;
    int r = it; I.gain = nullptr; I.mode = 0; I.K = D;
    if (SET == 0) {
        if (r < P0_I_IN) { I.W = a.in[3]; I.WT = (bf16_t*)(ws + WS_WIN); I.N = INC; }
        else if ((r -= P0_I_IN) < P0_I_KV) { I.W = a.in[10]; I.WT = (bf16_t*)(ws + WS_WKV); I.N = 2 * D; }
        else { r -= P0_I_KV; I.W = a.in[3]; I.WT = (bf16_t*)(ws + WS_WIN8); I.N = INC; I.mode = 2; const int nblk8 = 24; I.k0 = 64 * (r / nblk8); I.n0 = 64 * (r % nblk8); return true; }
    } else {
        if (r < P0_I_SQ) { I.W = a.in[6]; I.WT = (bf16_t*)(ws + WS_WOUT); I.N = D; }
        else if ((r -= P0_I_SQ) < P0_I_SQ) { I.W = a.in[11]; I.WT = (bf16_t*)(ws + WS_WO); I.N = D; }
        else if ((r -= P0_I_SQ) < NEXP * P0_I_W1) { const int e = r / P0_I_W1; r -= e * P0_I_W1; I.W = a.in[15] + (size_t)e * D * 2048; I.WT = (bf16_t*)(ws + WS_W1 + (size_t)e * 2048 * D); I.N = 2048; I.gain = a.in[12]; I.mode = 3; }
        else { r -= NEXP * P0_I_W1; const int e = r / P0_I_W2; r -= e * P0_I_W2; I.W = a.in[17] + (size_t)e * D * D; I.WT = (bf16_t*)(ws + WS_W2 + (size_t)e * D * D); I.N = D; I.mode = 2; }
    }
    const int nblk = I.N / 64; I.k0 = 64 * (r / nblk); I.n0 = 64 * (r % nblk); return true;
}
template <int SET> __device__ __forceinline__ void p0_run(const Args& a, int first, int stride, int count, LAS unsigned char* tl, int lane);
__device__ __forceinline__ void p0_load(const P0Item& I, f32x4 (&v)[16], f32x4 (&g)[4], int lane) {
    const float* base = I.W + (size_t)I.k0 * I.N + I.n0;
    const unsigned vo = (unsigned)((lane >> 4) * I.N + 4 * (lane & 15)) * 4u, rs = (unsigned)(4 * I.N) * 4u;
#pragma unroll
    for (int j = 0; j < 16; ++j) v[j] = pg8::gload128_hidden_nt(base, vo + rs * (unsigned)j);
    const float* gb = I.gain ? I.gain + I.k0 : base; const unsigned go = (unsigned)(lane >> 4) * 4u;
#pragma unroll
    for (int q = 0; q < 4; ++q) { g[q][0] = __uint_as_float(pg8::gload32_hidden(gb, go + (unsigned)(16 * q) * 4u)); g[q][1] = __uint_as_float(pg8::gload32_hidden(gb, go + (unsigned)(16 * q + 4) * 4u));
                                  g[q][2] = __uint_as_float(pg8::gload32_hidden(gb, go + (unsigned)(16 * q + 8) * 4u)); g[q][3] = __uint_as_float(pg8::gload32_hidden(gb, go + (unsigned)(16 * q + 12) * 4u)); }
}
constexpr int P0_LOADS = 32;
__device__ __forceinline__ void p0_store(const P0Item& I, const f32x4 (&v)[16], const f32x4 (&gq)[4], LAS unsigned char* tl, int lane) {
    const int kr = lane >> 4, nq = lane & 15;
#pragma unroll
    for (int j = 0; j < 16; ++j) { const int k = 4 * j + kr; const float g = I.gain ? gq[j >> 2][j & 3] : 1.0f;
        *(LAS u32x2*)(tl + k * 128 + (((nq >> 1) ^ ((k >> 3) & 7)) * 16) + (nq & 1) * 8) = (u32x2){pk2(v[j].x * g, v[j].y * g), pk2(v[j].z * g, v[j].w * g)}; }
    LDS_WAIT(); asm volatile("" ::: "memory");
    const int c = lane & 7;
#pragma unroll
    for (int i = 0; i < 8; ++i) { const int n = (lane >> 3) + 8 * i; const LAS unsigned char* sp = tl + (8 * c) * 128 + ((i ^ c) * 16) + (n & 7) * 2;
        unsigned short e[8];
#pragma unroll
        for (int q = 0; q < 8; ++q) e[q] = *(const LAS unsigned short*)(sp + q * 128);
        int row = I.n0 + n; if (I.mode & 1) { const int jj = row >> 1, bj = row & 1; row = (jj >> 7) * 256 + bj * 128 + (jj & 127); }
        if (I.mode & 2) *(u32x2*)((unsigned char*)I.WT + (size_t)row * I.K + I.k0 + 8 * c) = (u32x2){pk4_fp8(bf2f(e[0]) * WSCALE8, bf2f(e[1]) * WSCALE8, bf2f(e[2]) * WSCALE8, bf2f(e[3]) * WSCALE8), pk4_fp8(bf2f(e[4]) * WSCALE8, bf2f(e[5]) * WSCALE8, bf2f(e[6]) * WSCALE8, bf2f(e[7]) * WSCALE8)};
        else *(u32x4*)(I.WT + (size_t)row * I.K + I.k0 + 8 * c) = (u32x4){(unsigned)e[0] | ((unsigned)e[1] << 16), (unsigned)e[2] | ((unsigned)e[3] << 16), (unsigned)e[4] | ((unsigned)e[5] << 16), (unsigned)e[6] | ((unsigned)e[7] << 16)}; }
    LDS_WAIT(); asm volatile("" ::: "memory");
}
__device__ __forceinline__ void rms_rows2_to_bf16(const float* __restrict__ x0, const float* __restrict__ x1, const float* __restrict__ g, bf16_t* __restrict__ o0, bf16_t* __restrict__ o1, int lane, unsigned char* q0 = nullptr, unsigned char* q1 = nullptr) {
    const f32x4* xa = (const f32x4*)x0 + lane; const f32x4* xb = (const f32x4*)x1 + lane; const f32x4* gr = (const f32x4*)g + lane;
    f32x4 va[4], vb[4]; float sa = 0.f, sb = 0.f;
#pragma unroll
    for (int j = 0; j < 4; ++j) { va[j] = xa[64 * j]; vb[j] = xb[64 * j]; }
#pragma unroll
    for (int j = 0; j < 4; ++j) { sa += (va[j].x * va[j].x + va[j].y * va[j].y) + (va[j].z * va[j].z + va[j].w * va[j].w); sb += (vb[j].x * vb[j].x + vb[j].y * vb[j].y) + (vb[j].z * vb[j].z + vb[j].w * vb[j].w); }
    const float ra = 1.0f / sqrtf(wave_sum(sa) * (1.0f / D) + EPS), rb = 1.0f / sqrtf(wave_sum(sb) * (1.0f / D) + EPS);
    unsigned long long* pa = (unsigned long long*)o0 + lane; unsigned long long* pb = (unsigned long long*)o1 + lane;
#pragma unroll
    for (int j = 0; j < 4; ++j) { const f32x4 gg = gr[64 * j];
        if (q0) { ((unsigned*)q0)[lane + 64 * j] = pk4_fp8(va[j].x * ra * gg.x, va[j].y * ra * gg.y, va[j].z * ra * gg.z, va[j].w * ra * gg.w);
                  ((unsigned*)q1)[lane + 64 * j] = pk4_fp8(vb[j].x * rb * gg.x, vb[j].y * rb * gg.y, vb[j].z * rb * gg.z, vb[j].w * rb * gg.w); }
        pa[64 * j] = (unsigned long long)pk2(va[j].x * ra * gg.x, va[j].y * ra * gg.y) | ((unsigned long long)pk2(va[j].z * ra * gg.z, va[j].w * ra * gg.w) << 32);
        pb[64 * j] = (unsigned long long)pk2(vb[j].x * rb * gg.x, vb[j].y * rb * gg.y) | ((unsigned long long)pk2(vb[j].z * rb * gg.z, vb[j].w * rb * gg.w) << 32); }
}

__device__ __forceinline__ void p0_prologue(Frame& F, const Args& a) {
    unsigned char* ws = a.ws;
    LAS unsigned char* tl = F.lds + F.wave * 8192;
    const int gw = F.vcu * NWAVES + F.wave, NGW = F.G * NWAVES;
    for (int m = 2 * gw; m < T; m += 2 * NGW) rms_rows2_to_bf16(a.in[0] + (size_t)m * D, a.in[0] + (size_t)(m + 1) * D, a.in[2], (bf16_t*)(ws + WS_XN) + (size_t)m * D, (bf16_t*)(ws + WS_XN) + (size_t)(m + 1) * D, F.lane, ws + WS_XN8 + (size_t)m * D, ws + WS_XN8 + (size_t)(m + 1) * D);
    for (int m = 2 * gw; m < MROWS; m += 2 * NGW) rms_rows2_to_bf16(a.in[1] + (size_t)m * D, a.in[1] + (size_t)(m + 1) * D, a.in[8], (bf16_t*)(ws + WS_MN) + (size_t)m * D, (bf16_t*)(ws + WS_MN) + (size_t)(m + 1) * D, F.lane);
    for (int i = gw * 64 + F.lane; i < D * D / 4; i += NGW * 64) { const f32x4 w = ((const f32x4*)a.in[9])[i]; const float g = a.in[7][i >> 8];
        ((u32x2*)(ws + WS_WQ))[i] = (u32x2){pk2(w.x * g, w.y * g), pk2(w.z * g, w.w * g)}; }
    for (int i = gw * 64 + F.lane; i < NEXP * D; i += NGW * 64) { const int e = i >> 10, k = i & 1023; const float w = a.in[12][k] * a.in[13][k * NEXP + e];
        const unsigned hi = f2bf(w); ((bf16_t*)(ws + WS_WRT))[i] = (bf16_t)hi; ((bf16_t*)(ws + WS_WRT))[NEXP * D + i] = (bf16_t)f2bf(w - bf2f((unsigned short)hi)); }
    p0_run<0>(a, gw, NGW, (P0_NA - gw + NGW - 1) / NGW, tl, F.lane);
}
#define P0_PIN(vv, gg) do { _Pragma("unroll") for (int j_ = 0; j_ < 16; ++j_) asm volatile("" : "+v"(vv[j_])); _Pragma("unroll") for (int q_ = 0; q_ < 4; ++q_) asm volatile("" : "+v"(gg[q_])); } while (0)
template <int SET> __device__ __forceinline__ void p0_run(const Args& a, int first, int stride, int count, LAS unsigned char* tl, int lane_in) {
    int lane = lane_in; asm volatile("" : "+v"(lane));
    P0Item IA, IB; f32x4 va[16], vb[16], ga[4], gb[4];
    int it = first, left = count; bool ha = left > 0 && p0_decode<SET>(a, it, IA); if (ha) p0_load(IA, va, ga, lane);
    while (ha) {
        const bool hb = left > 1 && p0_decode<SET>(a, it + stride, IB); if (hb) p0_load(IB, vb, gb, lane);
        if (hb) asm volatile("s_waitcnt vmcnt(32)" ::: "memory"); else asm volatile("s_waitcnt vmcnt(0)" ::: "memory");
        P0_PIN(va, ga);
        p0_store(IA, va, ga, tl, lane);
        if (!hb) break;
        it += 2 * stride; left -= 2; ha = left > 0 && p0_decode<SET>(a, it, IA); if (ha) p0_load(IA, va, ga, lane);
        if (ha) asm volatile("s_waitcnt vmcnt(32)" ::: "memory"); else asm volatile("s_waitcnt vmcnt(0)" ::: "memory");
        P0_PIN(vb, gb);
        p0_store(IB, vb, gb, tl, lane);
    }
}
#undef P0_PIN

__device__ __forceinline__ unsigned xcc_id() { return (unsigned)__builtin_amdgcn_s_getreg((3 << 11) | 20) & 0xFu; }
constexpr int QITEMS = 16 + 177;
constexpr int CONV_PER_Q = 49, CONV_TILES = 64;
static_assert(8 * CONV_PER_Q * CONV_TILES == P0_NB, "conversion items cover SET 1 exactly");
__device__ __forceinline__ void p2_mixer(Frame& F, const Args& a, int rep) {
    unsigned char* ws = a.ws;
    const bf16_t* proj = (const bf16_t*)(ws + WS_PROJ); bf16_t* mix = (bf16_t*)(ws + WS_MIX);
    const unsigned x0 = xcc_id() & 7u;
    int par = 0;
#ifdef MK_P2_REPMODE
    if (rep && MK_P2_REPMODE == 4) return;
#endif
#ifdef MK_P2_HALF
    if (rep && (blockIdx.x & 8)) return;
#endif
    for (;;) {
        if (F.tid == 0) { int code = -1;
            for (int j = 0; j < 8; ++j) { const unsigned xq = (x0 + j) & 7u; const unsigned i = __hip_atomic_fetch_add(F.ctl + CW_QUEUE + 1024 * rep + 64 * xq, 1u, RLX_AGENT);
                if (i < (unsigned)QITEMS) { code = (int)(xq * 256u + i); break; } }
            F.MISC[par] = (unsigned)code; }
        LDS_WAIT(); __builtin_amdgcn_s_barrier(); asm volatile("" ::: "memory");
        const int code = __builtin_amdgcn_readfirstlane((int)F.MISC[par]); par ^= 1;
        if (code < 0) break;
        const int xq = code >> 8, i = code & 255;
#ifdef MK_P2_REPMODE
        if (rep && ((MK_P2_REPMODE == 1 && i >= 8) || (MK_P2_REPMODE == 2 && i < 16) || MK_P2_REPMODE == 3)) continue;
        if (rep && MK_P2_REPMODE == 5) { const int jq_ = i - 16; const bool isconv = i >= 16 && jq_ < 2 * CONV_PER_Q && (jq_ & 1); if (!isconv) continue; }
#endif
#ifndef NO_HGRN
        if (i < 8) { hgrn::hgrn_unit(xq, i, proj, rep ? (bf16_t*)(ws + WS_H2F) : mix, a.in[4], a.in[5], F.lds, rep ? HG_ABL : 0); }
        else
#endif
        if (i < 16) {
            pg8::KvOrder S{(const char*)(ws + WS_MN), (const char*)(ws + WS_WKV), xq * 8 + (i - 8)};
            pg8::EpiBf16 E{(bf16_t*)(ws + WS_MEMK), D, (bf16_t*)(ws + WS_MEMVT), D};
            pg8::gemm_phase<pg8::EpiBf16, pg8::KvOrder, false, false>(F.lds, D, D, D / 64, S, E);
        } else
        {
        const int jq = i - 16; int mi = -1, cv = -1;
        if (jq < 2 * CONV_PER_Q) { if (jq & 1) cv = jq >> 1; else mi = jq >> 1; } else mi = jq - CONV_PER_Q;
        if (cv >= 0) {
            const int J = xq * CONV_PER_Q + cv;
            p0_run<1>(a, J * CONV_TILES + F.wave * 8, 1, 8, F.lds + F.wave * 8192, F.lane);
            LDS_WAIT(); VM_WAIT(); __builtin_amdgcn_s_barrier(); asm volatile("" ::: "memory");
        } else
#ifndef NO_MOBA
        { const int j = mi, g = j >> 5, jj = j & 31, hh = 2 * g + (jj & 1), qb = 15 - (jj >> 1);
            moba::attn_unit<8>(xq, hh, qb, proj, proj + SEC_ELEMS, proj + 2 * SEC_ELEMS, mix, (const float*)(ws + WS_KBAR), (char*)(unsigned char*)F.lds); }
#else
        {}
#endif
        }
    }
}

__device__ __forceinline__ void p7_router(Frame& F, const Args& a, int rep) {
    unsigned char* ws = a.ws;
    constexpr int WRS = 2064;
    LAS unsigned char* WH = F.lds; LAS unsigned char* WL = F.lds + 32 * WRS;
    LAS int* hist = (LAS int*)(F.lds + TL_HIST); LAS int* basel = (LAS int*)(F.lds + TL_BASE);
    { const u32x4* src = (const u32x4*)(ws + WS_WRT);
      for (int i = F.tid; i < 2 * NEXP * D / 8; i += 512) { const int m = i >> 12, r = (i >> 7) & 31, c = i & 127; *(LAS u32x4*)(F.lds + m * 32 * WRS + r * WRS + c * 16) = src[i]; } }
    const float* h2f = (const float*)(ws + WS_H2F); const float* ss2 = (const float*)(ws + WS_SS2);
    int* toke = (int*)(ws + (rep ? WS_DUMMY + 1 * MiB : WS_TOKE)); int* tokr = (int*)(ws + (rep ? WS_DUMMY + 1 * MiB + 512 * 1024 : WS_TOKR)); float* tokg = (float*)(ws + (rep ? WS_DUMMY + 2 * MiB : WS_TOKG)); int* list = (int*)(ws + (rep ? WS_DUMMY + 4 * MiB : WS_LIST)); float* glist = (float*)(ws + (rep ? WS_DUMMY + 8 * MiB : WS_GLIST)); float* sslist = (float*)(ws + (rep ? WS_DUMMY + 12 * MiB : WS_SSLIST));
    unsigned* cntw = F.ctl + (rep ? CW_CNT + 2048 * rep : CW_CNT);
    const int lane = F.lane, r16 = lane & 15, g4 = lane >> 4;
    const float br0 = a.in[14][r16], br1 = a.in[14][16 + r16];
    for (int tb = blockIdx.x; tb < T / 128; tb += F.G) {
        if (F.tid < 32) hist[F.tid] = 0;
        LDS_WAIT(); __builtin_amdgcn_s_barrier(); asm volatile("" ::: "memory");
        const int t0 = tb * 128 + F.wave * 16;
        const float* xr = h2f + (size_t)(t0 + r16) * D + 8 * g4;
        f32x4 acc0 = (f32x4){0.f, 0.f, 0.f, 0.f}, acc1 = acc0;
        f32x4 xa = *(const f32x4*)(xr), xb = *(const f32x4*)(xr + 4);
#pragma unroll 4
        for (int ks = 0; ks < 32; ++ks) {
            const f32x4 ca = xa, cb = xb;
            if (ks + 1 < 32) { xa = *(const f32x4*)(xr + 32 * (ks + 1)); xb = *(const f32x4*)(xr + 32 * (ks + 1) + 4); }
            const unsigned h0 = cvtpk(ca.x, ca.y), h1 = cvtpk(ca.z, ca.w), h2 = cvtpk(cb.x, cb.y), h3 = cvtpk(cb.z, cb.w);
            const unsigned l0 = cvtpk(ca.x - bflo(h0), ca.y - bfhi(h0)), l1 = cvtpk(ca.z - bflo(h1), ca.w - bfhi(h1)), l2 = cvtpk(cb.x - bflo(h2), cb.y - bfhi(h2)), l3 = cvtpk(cb.z - bflo(h3), cb.w - bfhi(h3));
            const bf16x8 ah = __builtin_bit_cast(bf16x8, (u32x4){h0, h1, h2, h3}), al = __builtin_bit_cast(bf16x8, (u32x4){l0, l1, l2, l3});
            const int bo = r16 * WRS + (32 * ks + 8 * g4) * 2;
            const bf16x8 bh0 = *(const LAS bf16x8*)(WH + bo), bh1 = *(const LAS bf16x8*)(WH + 16 * WRS + bo), bl0 = *(const LAS bf16x8*)(WL + bo), bl1 = *(const LAS bf16x8*)(WL + 16 * WRS + bo);
            acc0 = __builtin_amdgcn_mfma_f32_16x16x32_bf16(ah, bh0, acc0, 0, 0, 0); acc1 = __builtin_amdgcn_mfma_f32_16x16x32_bf16(ah, bh1, acc1, 0, 0, 0);
            acc0 = __builtin_amdgcn_mfma_f32_16x16x32_bf16(ah, bl0, acc0, 0, 0, 0); acc1 = __builtin_amdgcn_mfma_f32_16x16x32_bf16(ah, bl1, acc1, 0, 0, 0);
            acc0 = __builtin_amdgcn_mfma_f32_16x16x32_bf16(al, bh0, acc0, 0, 0, 0); acc1 = __builtin_amdgcn_mfma_f32_16x16x32_bf16(al, bh1, acc1, 0, 0, 0);
        }
        int my_e = 0; float my_g = 0.f;
#pragma unroll
        for (int j = 0; j < 4; ++j) {
            const float rs = __builtin_amdgcn_rsqf(ss2[t0 + 4 * g4 + j] * (1.0f / D) + EPS);
            float a0 = acc0[j] * rs + br0, a1 = acc1[j] * rs + br1; float tv[4]; int te_[4];
#pragma unroll
            for (int k = 0; k < 4; ++k) { float m = fmaxf(a0, a1);
#pragma unroll
                for (int o = 1; o < 16; o <<= 1) m = fmaxf(m, __shfl_xor(m, o));
                int e = (a0 == m) ? r16 : ((a1 == m) ? 16 + r16 : 99);
#pragma unroll
                for (int o = 1; o < 16; o <<= 1) e = min(e, __shfl_xor(e, o));
                tv[k] = m; te_[k] = e; if (e == r16) a0 = -INFINITY; if (e == 16 + r16) a1 = -INFINITY; }
            const float d1 = fast_exp2((tv[1] - tv[0]) * LOG2E), d2 = fast_exp2((tv[2] - tv[0]) * LOG2E), d3 = fast_exp2((tv[3] - tv[0]) * LOG2E);
            const float inv = 1.0f / (1.0f + d1 + d2 + d3);
            if ((r16 >> 2) == j) { const int k = lane & 3; my_e = k == 0 ? te_[0] : (k == 1 ? te_[1] : (k == 2 ? te_[2] : te_[3])); my_g = (k == 0 ? 1.0f : (k == 1 ? d1 : (k == 2 ? d2 : d3))) * inv; }
        }
        const int rl = __hip_atomic_fetch_add(hist + my_e, 1, __ATOMIC_RELAXED, __HIP_MEMORY_SCOPE_WORKGROUP);
        LDS_WAIT(); __builtin_amdgcn_s_barrier(); asm volatile("" ::: "memory");
        if (F.tid < 32) basel[F.tid] = (int)__hip_atomic_fetch_add(cntw + F.tid, (unsigned)hist[F.tid], RLX_AGENT);
        LDS_WAIT(); VM_WAIT(); __builtin_amdgcn_s_barrier(); asm volatile("" ::: "memory");
        { const int t = t0 + 4 * g4 + (r16 >> 2), k = lane & 3; const int rank = basel[my_e] + rl;
          toke[t * 4 + k] = my_e; tokr[t * 4 + k] = rank; tokg[t * 4 + k] = my_g; list[(size_t)my_e * T + rank] = t; glist[(size_t)my_e * T + rank] = my_g; sslist[(size_t)my_e * T + rank] = ss2[t]; }
        LDS_WAIT(); __builtin_amdgcn_s_barrier(); asm volatile("" ::: "memory");
    }
}

__device__ __forceinline__ int build_tables(Frame& F) {
    LAS int* ts = (LAS int*)(F.lds + TL_TS); LAS unsigned char* te = (LAS unsigned char*)(F.lds + TL_TE);
    if (F.tid < NEXP) ((LAS int*)(F.lds + TL_CNT))[F.tid] = (int)__hip_atomic_load(F.ctl + CW_CNT + F.tid, RLX_AGENT);
    LDS_WAIT(); __builtin_amdgcn_s_barrier(); asm volatile("" ::: "memory");
    if (F.tid == 0) { int run = 0;
        for (int e = 0; e < NEXP; ++e) { ts[e] = run; run += (((LAS int*)(F.lds + TL_CNT))[e] + 255) >> 8; }
        ts[NEXP] = run; }
    LDS_WAIT(); __builtin_amdgcn_s_barrier(); asm volatile("" ::: "memory");
    const int nt = ts[NEXP];
    for (int g = F.tid; g < nt; g += 512) { int e = 0;
        for (int j = 1; j < NEXP; ++j) e += (ts[j] <= g) ? 1 : 0;
        te[g] = (unsigned char)e; }
    LDS_WAIT(); __builtin_amdgcn_s_barrier(); asm volatile("" ::: "memory");
    return __builtin_amdgcn_readfirstlane(nt);
}

__device__ __forceinline__ void p10_combine(Frame& F, const Args& a) {
    unsigned char* ws = a.ws;
    LAS int* ts = (LAS int*)(F.lds + TL_TS);
    const float* h2f = (const float*)(ws + WS_H2F); const unsigned char* Y = (const unsigned char*)(ws + WS_Y);
    const int* toke = (const int*)(ws + WS_TOKE); const int* tokr = (const int*)(ws + WS_TOKR);
    const float* gf = a.in[19];
    const int gw = F.vcu * NWAVES + F.wave, NGW = F.G * NWAVES, lane = F.lane;
    for (int t0 = 2 * gw; t0 < T; t0 += 2 * NGW) {
        float o[2][16]; u32x2 y[2][4][2];
#pragma unroll
        for (int q = 0; q < 2; ++q) { const int t = t0 + q;
#pragma unroll
            for (int k = 0; k < 4; ++k) { const int e = toke[t * 4 + k], r = tokr[t * 4 + k]; const unsigned char* yr = Y + ((size_t)ts[e] * 256 + r) * D;
                y[q][k][0] = *(const u32x2*)(yr + 8 * lane); y[q][k][1] = *(const u32x2*)(yr + 512 + 8 * lane); }
            const f32x4 a0 = *(const f32x4*)(h2f + (size_t)t * D + 8 * lane), a1 = *(const f32x4*)(h2f + (size_t)t * D + 8 * lane + 4), a2 = *(const f32x4*)(h2f + (size_t)t * D + 512 + 8 * lane), a3 = *(const f32x4*)(h2f + (size_t)t * D + 512 + 8 * lane + 4);
            o[q][0] = a0.x; o[q][1] = a0.y; o[q][2] = a0.z; o[q][3] = a0.w; o[q][4] = a1.x; o[q][5] = a1.y; o[q][6] = a1.z; o[q][7] = a1.w; o[q][8] = a2.x; o[q][9] = a2.y; o[q][10] = a2.z; o[q][11] = a2.w; o[q][12] = a3.x; o[q][13] = a3.y; o[q][14] = a3.z; o[q][15] = a3.w; }
#pragma unroll
        for (int q = 0; q < 2; ++q) {
#pragma unroll
            for (int k = 0; k < 4; ++k)
#pragma unroll
                for (int hf = 0; hf < 2; ++hf) { const u32x2 w = y[q][k][hf];
                    const f32x2 c0 = __builtin_amdgcn_cvt_pk_f32_fp8((int)w.x, false), c1 = __builtin_amdgcn_cvt_pk_f32_fp8((int)w.x, true), c2 = __builtin_amdgcn_cvt_pk_f32_fp8((int)w.y, false), c3 = __builtin_amdgcn_cvt_pk_f32_fp8((int)w.y, true);
                    o[q][8 * hf + 0] += pg8::YSCALE_INV * c0.x; o[q][8 * hf + 1] += pg8::YSCALE_INV * c0.y; o[q][8 * hf + 2] += pg8::YSCALE_INV * c1.x; o[q][8 * hf + 3] += pg8::YSCALE_INV * c1.y;
                    o[q][8 * hf + 4] += pg8::YSCALE_INV * c2.x; o[q][8 * hf + 5] += pg8::YSCALE_INV * c2.y; o[q][8 * hf + 6] += pg8::YSCALE_INV * c3.x; o[q][8 * hf + 7] += pg8::YSCALE_INV * c3.y; }
            float s = 0.f;
#pragma unroll
            for (int j = 0; j < 16; ++j) s += o[q][j] * o[q][j];
            const float rstd = 1.0f / sqrtf(wave_sum(s) * (1.0f / D) + EPS);
            float* op = a.out + (size_t)(t0 + q) * D;
#pragma unroll
            for (int v = 0; v < 4; ++v) { const int col = (v >> 1) * 512 + 8 * lane + (v & 1) * 4; const f32x4 g4 = *(const f32x4*)(gf + col);
                *(f32x4*)(op + col) = (f32x4){o[q][4 * v] * rstd * g4.x, o[q][4 * v + 1] * rstd * g4.y, o[q][4 * v + 2] * rstd * g4.z, o[q][4 * v + 3] * rstd * g4.w}; }
        }
    }
}

#define XB_TMO      128
#define XB_XCNT(j)  (256  + 64 * (j))
#define XB_XSUB(j)  (1280 + 64 * (j))
#define XB_XGEN(j)  (2304 + 64 * (j))
#define XB_TOP      3328
#define XB_TOPGEN   3392
#define XCD_BAR_WORDS 3456
#define XB_SPIN_CAP (1u << 22)
__device__ __forceinline__ unsigned xb_ld(unsigned* p)              { return __hip_atomic_load(p, __ATOMIC_RELAXED, __HIP_MEMORY_SCOPE_AGENT); }
__device__ __forceinline__ unsigned xb_add(unsigned* p, unsigned v) { return __hip_atomic_fetch_add(p, v, __ATOMIC_RELAXED, __HIP_MEMORY_SCOPE_AGENT); }
#define XB_SPIN(cond, bar) do { unsigned _sp = 0; while (cond) { __builtin_amdgcn_s_sleep(1); \
    if ((++_sp & 255u) == 0u) { if (xb_ld(&(bar)[XB_TMO])) break; if (_sp > XB_SPIN_CAP) { atomicAdd(&(bar)[XB_TMO], 1u); break; } } } } while (0)
struct XcdBarrier { unsigned* bar; unsigned x; volatile LAS unsigned* st; };
__device__ __forceinline__ XcdBarrier xcd_barrier_post(unsigned* bar, volatile LAS unsigned* st) {
    XcdBarrier b; b.bar = bar; b.x = (unsigned)__builtin_amdgcn_s_getreg((3 << 11) | 20) & 0xFu; b.st = st;
    if (threadIdx.x == 0) (void)xb_add(&bar[XB_XCNT(b.x)], 1u);
    return b;
}
__device__ __forceinline__ void xcd_barrier_complete(unsigned* bar, unsigned x, unsigned& nloc, unsigned& nx) {
    const unsigned G = gridDim.x * gridDim.y * gridDim.z;
    unsigned sum, cnt, mine, sp = 0u;
    for (;;) {
        sum = 0u; cnt = 0u; mine = 0u;
#pragma unroll
        for (unsigned j = 0; j < 16; ++j) { const unsigned c = xb_ld(&bar[XB_XCNT(j)]); sum += c; cnt += (c > 0u) ? 1u : 0u; mine = (j == x) ? c : mine; }
        if (sum == G) break;
        __builtin_amdgcn_s_sleep(1);
        if ((++sp & 255u) == 0u) { if (xb_ld(&bar[XB_TMO])) break; if (sp > XB_SPIN_CAP) { atomicAdd(&bar[XB_TMO], 1u); break; } }
    }
    nloc = mine > 0u ? mine : 1u; nx = cnt > 0u ? cnt : 1u;
}
__device__ __forceinline__ void xcd_barrier(const XcdBarrier& b) {
    asm volatile("s_waitcnt vmcnt(0)" ::: "memory");
    __syncthreads();
    if (threadIdx.x == 0) {
        unsigned* bar = b.bar;
        __builtin_amdgcn_s_waitcnt(0);
        unsigned nloc = b.st[0], nx = b.st[1];
        if (nloc == 0u) { xcd_barrier_complete(bar, b.x, nloc, nx); b.st[0] = nloc; b.st[1] = nx; }
        const unsigned old = xb_add(&bar[XB_XSUB(b.x)], 1u);
        const unsigned gen = old / nloc;
        if (old + 1u == (gen + 1u) * nloc) {
            __builtin_amdgcn_fence(__ATOMIC_RELEASE, "agent");
            asm volatile("s_waitcnt vmcnt(0)" ::: "memory");
            const unsigned og = xb_add(&bar[XB_TOP], 1u);
            const unsigned tg = og / nx;
            if (og + 1u == (tg + 1u) * nx) xb_add(&bar[XB_TOPGEN], 1u);
            else XB_SPIN(xb_ld(&bar[XB_TOPGEN]) == tg, bar);
            __builtin_amdgcn_fence(__ATOMIC_ACQUIRE, "agent");
            xb_add(&bar[XB_XGEN(b.x)], 1u);
            asm volatile("s_waitcnt vmcnt(0)" ::: "memory");
        } else {
            XB_SPIN(xb_ld(&bar[XB_XGEN(b.x)]) == gen, bar);
            __builtin_amdgcn_fence(__ATOMIC_ACQUIRE, "agent");
            asm volatile("s_waitcnt vmcnt(0)" ::: "memory");
        }
    }
    __syncthreads();
}
#ifndef MK_CG_ONLY
#define MK_CG_ONLY 0
#endif
__device__ __forceinline__ void grid_barrier(Frame& F, const XcdBarrier& xb_) { if (MK_CG_ONLY) cg::this_grid().sync(); else xcd_barrier(xb_); }
#ifndef MK_PHASE_MASK
#define MK_PHASE_MASK 0x7ff
#endif
#ifndef MK_REP_PHASE
#define MK_REP_PHASE -1
#endif
#ifndef MK_REP_N
#define MK_REP_N 0
#endif
__device__ __forceinline__ void ph0(Frame& F, const Args& args, int rep) { p0_prologue(F, args); }
__device__ __forceinline__ void ph1(Frame& F, const Args& args, int rep) {
    unsigned char* ws = args.ws; const int cid = (int)blockIdx.x;
    { pg8::DenseOrder S{(const char*)(ws + WS_XN8), (const char*)(ws + WS_WIN8), D / 2, D / 2, T / 256, 6, F.G, cid, 0};
      pg8::EpiProj E{(bf16_t*)(ws + WS_PROJ), rep ? (float*)(ws + WS_DUMMY) : (float*)(ws + WS_KBAR), WSCALE8_INV};
      pg8::gemm_phase<pg8::EpiProj, pg8::DenseOrder, false, true, true>(F.lds, D / 2, D / 2, D / 128, S, E); }
    { pg8::DenseOrder S{(const char*)(ws + WS_XN), (const char*)(ws + WS_WIN + (size_t)1536 * D * 2), D, D, T / 256, 8, F.G, cid, 6};
      pg8::EpiProj E{(bf16_t*)(ws + WS_PROJ), rep ? (float*)(ws + WS_DUMMY) : (float*)(ws + WS_KBAR), 1.0f};
      pg8::gemm_phase<pg8::EpiProj, pg8::DenseOrder, false, true>(F.lds, D, D, D / 64, S, E); }
}
__device__ __forceinline__ void ph2(Frame& F, const Args& args, int rep) { p2_mixer(F, args, rep); }
constexpr size_t WS_MB = WS_PROJ, WS_NB = WS_PROJ + 16 * MiB, WS_H1Q = WS_PROJ + 32 * MiB, WS_PB = WS_QX;
constexpr size_t WS_UNUSED_XA = 0;
constexpr int LDS_XTAB = 131072;
__device__ __forceinline__ void ph3(Frame& F, const Args& args, int rep) {
    unsigned char* ws = args.ws; const int cid = (int)blockIdx.x;
    pg8::P3Order S{pg8::XmnOrder{(const char*)(ws + WS_MEMK), (const char*)(ws + WS_MEMVT), (const char*)(ws + WS_WQ), (const char*)(ws + WS_WO), F.G, cid},
                   pg8::DenseOrder{(const char*)(ws + WS_MIX), (const char*)(ws + WS_WOUT), D, D, T / 256, D / 256, F.G, cid, 0}};
    pg8::EpiP3 E{pg8::EpiFp8{(unsigned char*)(ws + WS_MB), D, (unsigned char*)(ws + WS_NB), D, XSCALE8},
                 pg8::EpiRes<true, false>{(const void*)args.in[0], (bf16_t*)(ws + WS_H1B), nullptr, rep ? (float*)(ws + WS_DUMMY + 512 * 1024) : (float*)(ws + WS_SS1), 1.0f, (unsigned char*)(ws + WS_H1Q)}};
    pg8::gemm_phase<pg8::EpiP3, pg8::P3Order, false, true>(F.lds, D, D, D / 64, S, E);
}
__device__ __forceinline__ void ph4(Frame& F, const Args& args, int rep) {
    unsigned char* ws = args.ws; const int cid = (int)blockIdx.x;
    pg8::XbOrder S{(const char*)(ws + WS_H1Q), (const char*)(ws + WS_MB), F.G, cid, (size_t)D};
    pg8::EpiSoftmaxS E{(unsigned char*)(ws + WS_PB), (const float*)(ws + WS_SS1), F.lds + LDS_XTAB, XSCALE8_INV};
    pg8::gemm_phase<pg8::EpiSoftmaxS, pg8::XbOrder, false, true, true>(F.lds, D / 2, D / 2, D / 128, S, E);
}
__device__ __forceinline__ void ph5(Frame& F, const Args& args, int rep) {}
__device__ __forceinline__ void ph6(Frame& F, const Args& args, int rep) {
    unsigned char* ws = args.ws; const int cid = (int)blockIdx.x;
    pg8::XbOrder S{(const char*)(ws + WS_PB), (const char*)(ws + WS_NB), F.G, cid, (size_t)D};
    pg8::EpiRes<false, true, true> E{(const void*)(ws + WS_H1B), (bf16_t*)(ws + WS_H2B), (float*)(ws + WS_H2F), rep ? (float*)(ws + WS_DUMMY + 512 * 1024) : (float*)(ws + WS_SS2), PSCALE8_INV * XSCALE8_INV, nullptr};
    pg8::gemm_phase<pg8::EpiRes<false, true, true>, pg8::XbOrder, false, true, true>(F.lds, D / 2, D / 2, D / 128, S, E);
}
__device__ __forceinline__ void ph7(Frame& F, const Args& args, int rep) { p7_router(F, args, rep); }
__device__ __forceinline__ void ph8(Frame& F, const Args& args, int rep) {
    unsigned char* ws = args.ws; const int cid = (int)blockIdx.x;
    const int ntl = build_tables(F);
    pg8::MoeOrder S{(const char*)(ws + WS_H2B), (const char*)(ws + WS_W1), (const int*)(ws + WS_LIST), (const LAS int*)(F.lds + TL_CNT), (const LAS unsigned char*)(F.lds + TL_TE), (const LAS int*)(F.lds + TL_TS),
                    ntl, 8, F.G, cid, (size_t)2048 * D, 1, (size_t)256 * D, (size_t)256 * D};
    pg8::EpiW1 E{(bf16_t*)(ws + WS_HMID), (const float*)(ws + WS_SSLIST), args.in[16], (const int*)(ws + WS_LIST)};
    pg8::gemm_phase<pg8::EpiW1, pg8::MoeOrder, true, true, true>(F.lds, D / 2, D / 2, D / 128, S, E);
}
__device__ __forceinline__ void ph9(Frame& F, const Args& args, int rep) {
    unsigned char* ws = args.ws; const int cid = (int)blockIdx.x;
    const int ntl = build_tables(F);
    pg8::MoeOrder S{(const char*)(ws + WS_HMID), (const char*)(ws + WS_W2), (const int*)(ws + WS_LIST), (const LAS int*)(F.lds + TL_CNT), (const LAS unsigned char*)(F.lds + TL_TE), (const LAS int*)(F.lds + TL_TS),
                    ntl, 4, F.G, cid, (size_t)D * D, 0, (size_t)256 * D, (size_t)256 * D};
    pg8::EpiW2 E{(unsigned char*)(ws + WS_Y), args.in[18], (const int*)(ws + WS_LIST), (const float*)(ws + WS_GLIST)};
    pg8::gemm_phase<pg8::EpiW2, pg8::MoeOrder, false, true, true>(F.lds, D / 2, D / 2, D / 128, S, E);
}
__device__ __forceinline__ void ph10(Frame& F, const Args& args, int rep) { (void)build_tables(F); p10_combine(F, args); }

constexpr int N_PHASES = 11;
__global__ void __launch_bounds__(NWAVES * 64, 2) hymba_fwd(Args args) {
    extern __shared__ __attribute__((aligned(16))) unsigned char lds_raw[];
    Frame F;
    F.lds = (LAS unsigned char*)lds_raw;
    F.MISC = (volatile LAS unsigned*)(F.lds + TL_MISC);
    F.tid = threadIdx.x; F.lane = F.tid & 63; F.wave = __builtin_amdgcn_readfirstlane(F.tid >> 6);
    F.G = gridDim.x; { const int bx = blockIdx.x; F.vcu = (F.G % 8 == 0) ? (bx % 8) * (F.G / 8) + bx / 8 : bx; }
    F.ctl = (unsigned*)(args.ws + WS_CTL);
    const int lo = args.ph_lo, hi = args.ph_hi;
    for (int u = F.tid; u < 64; u += NWAVES * 64) ((LAS unsigned*)(F.lds + TL_MISC))[u] = 0u;
    __syncthreads();
    const XcdBarrier xbar = xcd_barrier_post(F.ctl + CW_BAR, F.MISC + 8);
#define RUN(k, fn) do { if (((MK_PHASE_MASK >> (k)) & 1) && lo <= (k) && (k) < hi) { fn(F, args, 0); \
        if (MK_REP_PHASE == (k) && MK_REP_N >= 1) { grid_barrier(F, xbar); fn(F, args, 1); } \
        if (MK_REP_PHASE == (k) && MK_REP_N >= 2) { grid_barrier(F, xbar); fn(F, args, 2); } \
        if ((k) + 1 < hi) { grid_barrier(F, xbar); } } } while (0)
    if (args.ph_lo < 0) cg::this_grid().sync();
    RUN(0, ph0); RUN(1, ph1); RUN(2, ph2); RUN(3, ph3); RUN(4, ph4);   RUN(6, ph6); RUN(7, ph7); RUN(8, ph8); RUN(9, ph9); RUN(10, ph10);
#undef RUN
}

extern "C" void kernel_launch(void* const* d_in, const int* in_sizes, int n_in, void* d_out, int out_size, void* d_ws, size_t ws_size, hipStream_t stream) {
    static int grid = 0;
    if (grid == 0) {
        if (n_in != 20 || in_sizes[0] != T * D || out_size != T * D || ws_size < WS_END) {
            fprintf(stderr, "kernel_launch: shape/workspace mismatch (n_in %d, in0 %d, out %d, ws %zu, need %zu)\n", n_in, n_in > 0 ? in_sizes[0] : -1, out_size, ws_size, (size_t)WS_END); grid = -1; return; }
        int dev = 0, cus = 0, per_cu = 0;
        if (hipGetDevice(&dev) != hipSuccess || hipDeviceGetAttribute(&cus, hipDeviceAttributeMultiprocessorCount, dev) != hipSuccess) { grid = -1; return; }
        if (hipFuncSetAttribute((const void*)hymba_fwd, hipFuncAttributeMaxDynamicSharedMemorySize, LDS_BYTES) != hipSuccess) { fprintf(stderr, "kernel_launch: hipFuncSetAttribute failed\n"); grid = -1; return; }
        if (hipOccupancyMaxActiveBlocksPerMultiprocessor(&per_cu, (const void*)hymba_fwd, NWAVES * 64, LDS_BYTES) != hipSuccess || per_cu < 1) { fprintf(stderr, "kernel_launch: occupancy query says %d\n", per_cu); }
        (void)hipGetLastError();
        grid = cus;
        if (grid != 256) fprintf(stderr, "kernel_launch: %d CUs; this kernel is built for 256\n", grid);
    }
    if (grid < 0) return;
    (void)hipMemsetAsync((char*)d_ws + WS_CTL, 0, CTL_ZERO_BYTES, stream);
    Args a{};
    for (int i = 0; i < 20; ++i) a.in[i] = (const float*)d_in[i];
    a.out = (float*)d_out; a.ws = (unsigned char*)d_ws;
#if MK_N_LAUNCHES == 1
    a.ph_lo = 0; a.ph_hi = MK_LAST_PHASE + 1;
    void* kargs[] = {&a};
    hipError_t e = hipLaunchCooperativeKernel((const void*)hymba_fwd, dim3(grid), dim3(NWAVES * 64), kargs, LDS_BYTES, stream);
    if (e != hipSuccess) fprintf(stderr, "kernel_launch: cooperative launch failed: %s\n", hipGetErrorString(e));
#else
    for (int p = 0; p <= MK_LAST_PHASE; ++p) { a.ph_lo = p; a.ph_hi = p + 1; hipLaunchKernelGGL(hymba_fwd, dim3(grid), dim3(NWAVES * 64), LDS_BYTES, stream, a); }
#endif
}
```

```cpp
#include <hip/hip_runtime.h>
#include <hip/hip_cooperative_groups.h>
#include <cstdio>
#include <cstdint>
namespace cg = cooperative_groups;

#ifndef MK_N_LAUNCHES
#define MK_N_LAUNCHES 1
#endif
#ifndef MK_LAST_PHASE
#define MK_LAST_PHASE 10
#endif

#define LAS __attribute__((address_space(3)))
#define GAS __attribute__((address_space(1)))
typedef unsigned short bf16_t;
typedef short bf16x8 __attribute__((ext_vector_type(8)));
typedef short s16x4 __attribute__((ext_vector_type(4)));
typedef float f32x4 __attribute__((ext_vector_type(4)));
typedef float f32x2 __attribute__((ext_vector_type(2)));
typedef float f32x16 __attribute__((ext_vector_type(16)));
typedef unsigned u32x4 __attribute__((ext_vector_type(4)));
typedef unsigned u32x2 __attribute__((ext_vector_type(2)));
typedef int v8i32_t __attribute__((ext_vector_type(8)));

constexpr int BATCH = 8, SEQ = 4096, T = BATCH * SEQ, D = 1024, INC = 3584, NMEM = 256, MROWS = BATCH * NMEM;
constexpr int NEXP = 32, TOPK = 4, MT_MAX = T * TOPK / 256 + NEXP, MPAD = MT_MAX * 256;
constexpr float EPS = 1e-6f;
constexpr float LOG2E = 1.4426950408889634f;
constexpr float C2Q = 0.125f * LOG2E;
constexpr float C2X = 0.0625f * LOG2E;
constexpr int C_MQ = 0, C_MK = 512, C_MV = 1024, C_GQ = 1536, C_GF = 2048, C_GI = 2560, C_GG = 3072;

constexpr size_t MiB = 1u << 20;
constexpr size_t WS_CTL = 0, CTL_ZERO_BYTES = 2 * MiB;
constexpr size_t WS_KBAR = 1 * MiB;
constexpr size_t WS_SS1 = 1 * MiB + 256 * 1024;
constexpr size_t WS_SS2 = 1 * MiB + 384 * 1024;
constexpr size_t WS_TOKE = 2 * MiB, WS_TOKR = 2 * MiB + 512 * 1024, WS_TOKG = 3 * MiB;
constexpr size_t WS_WRT = 3 * MiB + 512 * 1024;
constexpr size_t WS_LIST = 4 * MiB;
constexpr size_t WS_GLIST = 8 * MiB;
constexpr size_t WS_SSLIST = 12 * MiB;
constexpr size_t WS_WIN8 = 14 * MiB;
constexpr size_t WS_WIN = 16 * MiB, WS_WOUT = 23 * MiB, WS_WQ = 25 * MiB, WS_WKV = 27 * MiB, WS_WO = 31 * MiB;
constexpr size_t WS_MN = 33 * MiB, WS_MEMK = 37 * MiB, WS_MEMVT = 41 * MiB;
constexpr size_t WS_W1 = 48 * MiB, WS_W2 = 176 * MiB;
constexpr size_t WS_PROJ = 240 * MiB;
constexpr size_t SEC_ELEMS = (size_t)16 * 1024 * 1024;
constexpr size_t WS_XN = 464 * MiB;
constexpr size_t WS_OX = 464 * MiB;
constexpr size_t WS_XN8 = 528 * MiB;
constexpr size_t WS_MIX = 528 * MiB;
constexpr size_t WS_H1B = 592 * MiB;
constexpr size_t WS_QX = 656 * MiB;
constexpr size_t WS_PWS = 720 * MiB;
constexpr size_t WS_HMID = 240 * MiB;
constexpr size_t WS_Y = 512 * MiB;
constexpr size_t WS_H2F = 784 * MiB;
constexpr size_t WS_H2B = 912 * MiB;
constexpr size_t WS_DUMMY = 976 * MiB;
constexpr size_t WS_END = 992 * MiB;
static_assert(WS_HMID + (size_t)MPAD * D * 2 <= WS_Y && WS_Y + (size_t)MPAD * D * 2 <= WS_H2F, "ws map");
constexpr int CW_TMO = 0;
constexpr int CW_CNT = 64;
constexpr int CW_QUEUE = 128;
constexpr int CW_BAR = 4096;

__device__ __forceinline__ unsigned f2bf(float f) { unsigned u = __builtin_bit_cast(unsigned, f); return (u + 0x7fffu + ((u >> 16) & 1u)) >> 16; }
__device__ __forceinline__ unsigned pk2(float lo, float hi) { return f2bf(lo) | (f2bf(hi) << 16); }
__device__ __forceinline__ float bf2f(unsigned short h) { return __builtin_bit_cast(float, (unsigned)h << 16); }
__device__ __forceinline__ float bflo(unsigned w) { return __builtin_bit_cast(float, w << 16); }
__device__ __forceinline__ float bfhi(unsigned w) { return __builtin_bit_cast(float, w & 0xffff0000u); }
typedef float f32x2_t __attribute__((ext_vector_type(2))); typedef __bf16 bf16x2_t __attribute__((ext_vector_type(2)));
__device__ __forceinline__ unsigned cvtpk(float lo, float hi) { f32x2_t v = {lo, hi}; bf16x2_t b = __builtin_convertvector(v, bf16x2_t); return __builtin_bit_cast(unsigned, b); }
__device__ __forceinline__ float wave_sum(float v) {
#pragma unroll
    for (int o = 1; o < 64; o <<= 1) v += __shfl_xor(v, o);
    return v;
}
__device__ __forceinline__ float fast_exp2(float x) { return __builtin_amdgcn_exp2f(x); }
__device__ __forceinline__ float fast_rcp(float x) { return __builtin_amdgcn_rcpf(x); }
__device__ __forceinline__ float silu_f(float x) { return x * fast_rcp(1.0f + fast_exp2(-x * LOG2E)); }
__device__ __forceinline__ unsigned pk4_fp8(float a, float b, float c, float d) { int w = 0; w = __builtin_amdgcn_cvt_pk_fp8_f32(a, b, w, false); w = __builtin_amdgcn_cvt_pk_fp8_f32(c, d, w, true); return (unsigned)w; }
constexpr float XSCALE8 = 4.0f, XSCALE8_INV = 0.25f, PSCALE8 = 256.0f, PSCALE8_INV = 1.0f / 256.0f;
constexpr float WSCALE8 = 32.0f, WSCALE8_INV = 1.0f / 32.0f;
#define LDS_WAIT() asm volatile("s_waitcnt lgkmcnt(0)" ::: "memory")
#define VM_WAIT() asm volatile("s_waitcnt vmcnt(0)" ::: "memory")
#define RLX_AGENT __ATOMIC_RELAXED, __HIP_MEMORY_SCOPE_AGENT

namespace pg8 {
constexpr int BM = 256, BK = 64, HALF = 128, HTB = HALF * BK * 2, STAGE_BYTES = 8 * HTB;
__device__ __forceinline__ unsigned gload32_hidden(const void* sbase, unsigned voff) { unsigned v; asm volatile("global_load_dword %0, %1, %2" : "=v"(v) : "v"(voff), "s"(sbase) : "memory"); return v; }
__device__ __forceinline__ f32x4 gload128_hidden(const void* sbase, unsigned voff) { f32x4 v; asm volatile("global_load_dwordx4 %0, %1, %2" : "=v"(v) : "v"(voff), "s"(sbase) : "memory"); return v; }
__device__ __forceinline__ f32x4 gload128_hidden_nt(const void* sbase, unsigned voff) { f32x4 v; asm volatile("global_load_dwordx4 %0, %1, %2 nt" : "=v"(v) : "v"(voff), "s"(sbase) : "memory"); return v; }
__device__ __forceinline__ void glds16s(const char* sbase, unsigned voff, unsigned lds_dst) { unsigned keep;
    asm volatile("s_mov_b32 %0, m0\n\ts_mov_b32 m0, %3\n\ts_nop 0\n\tglobal_load_lds_dwordx4 %1, %2\n\ts_mov_b32 m0, %0" : "=&s"(keep) : "v"(voff), "s"(sbase), "s"(lds_dst) : "memory"); }
__host__ __device__ __forceinline__ int lds_byte(int r, int c) { const int st = (r >> 4) * 2 + (c >> 5), rr = r & 15, cc = c & 31, ob = rr * 64 + cc * 2; return st * 1024 + (ob ^ (((ob >> 9) & 1) << 5)); }
__host__ __device__ __forceinline__ void stage_rc(int b, int& R, int& C) { const int st = b / 1024, sb = b % 1024, swz = sb ^ (((sb >> 9) & 1) << 5); R = (st >> 1) * 16 + swz / 64; C = (st & 1) * 32 + (swz % 64) / 2; }
__host__ __device__ __forceinline__ int perm32(int rho) { const int n = rho >> 4, i = rho & 15; return 8 * (i >> 2) + 4 * n + (i & 3); }

struct Unit { const char* A; const char* B; const int* rows; int pm, pn, aux, nrows, ntu; };

template <class Epi, class Sched, bool GATHER, bool ALIGN_EPI, bool FP8 = false>
__device__ __forceinline__ void gemm_phase(LAS unsigned char* lds, const int lda, const int ldb, const int nt_in, const Sched& S, const Epi& E) {
    int nt = nt_in; asm volatile("" : "+s"(nt));
    int tid_ = threadIdx.x; asm volatile("" : "+v"(tid_));
    const int tid = tid_, wid = __builtin_amdgcn_readfirstlane(tid >> 6), lane = tid & 63, wr = wid >> 2, wc = wid & 3, fr = lane & 15, fq = lane >> 4;
    unsigned offB0; { int R, C; stage_rc(tid * 16, R, C); const int Rb = Epi::PERM ? ((R & ~31) + perm32(R & 31)) : R; offB0 = (unsigned)(Rb * ldb + C) * 2u; }
    const size_t pstepB = (size_t)64 * ldb * 2;
    const size_t kstep = (size_t)(BK * 2);
    const size_t hstepB = (size_t)HALF * ldb * 2;
    const unsigned ldsb = (unsigned)__builtin_amdgcn_readfirstlane((int)((unsigned)(uintptr_t)(unsigned char*)lds + (unsigned)wid * 1024u));
    const int aoff = lds_byte(wr * 64 + fr, FP8 ? fq * 16 : fq * 8), boff = lds_byte(wc * 32 + fr, FP8 ? fq * 16 : fq * 8);
#define PG8_SA(b, h) (((b) * 2 + (h)) * HTB)
#define PG8_SB(b, h) ((4 + (b) * 2 + (h)) * HTB)
#define PG8_STGB(bufoff, gbase) do { glds16s((const char*)(gbase), offB0, ldsb + (unsigned)(bufoff)); glds16s((const char*)(gbase) + pstepB, offB0, ldsb + (unsigned)(bufoff) + 8192u); } while (0)
#define PG8_LD16(p_) (*(const LAS u32x4*)(p_))
#define PG8_CAT(x, y) __builtin_bit_cast(v8i32_t, __builtin_shufflevector(x, y, 0, 1, 2, 3, 4, 5, 6, 7))
    unsigned aA0 = (unsigned)(aoff + PG8_SA(0, 0)), aA1 = (unsigned)(aoff + PG8_SA(1, 0)), bB0 = (unsigned)(boff + PG8_SB(0, 0)), bB1 = (unsigned)(boff + PG8_SB(1, 0));
    asm volatile("" : "+v"(aA0), "+v"(aA1), "+v"(bB0), "+v"(bB1));
    int scl8 = 0x7f7f7f7f; asm volatile("" : "+v"(scl8));
#define PG8_LDA(dst, b, h) do { const LAS unsigned char* ap_ = lds + ((b) ? aA1 : aA0) + (h) * HTB; _Pragma("unroll") for (int m = 0; m < 4; ++m) { \
        if constexpr (FP8) { dst##8[m] = PG8_CAT(PG8_LD16(ap_ + m * 2048), PG8_LD16(ap_ + m * 2048 + 16)); } \
        else { _Pragma("unroll") for (int k = 0; k < 2; ++k) dst[m][k] = *(const LAS bf16x8*)(ap_ + m * 2048 + k * 1024); } } } while (0)
#define PG8_LDB(dst, b, h) do { const LAS unsigned char* bp_ = lds + ((b) ? bB1 : bB0) + (h) * HTB; _Pragma("unroll") for (int n = 0; n < 2; ++n) { \
        if constexpr (FP8) { dst##8[n] = PG8_CAT(PG8_LD16(bp_ + n * 2048), PG8_LD16(bp_ + n * 2048 + 16)); } \
        else { _Pragma("unroll") for (int k = 0; k < 2; ++k) dst[n][k] = *(const LAS bf16x8*)(bp_ + n * 2048 + k * 1024); } } } while (0)
#define PG8_MMA(ai, bj, At, Bt) do { __builtin_amdgcn_s_setprio(1); _Pragma("unroll") for (int m = 0; m < 4; ++m) _Pragma("unroll") for (int n = 0; n < 2; ++n) { \
        if constexpr (FP8) asm volatile("v_mfma_scale_f32_16x16x128_f8f6f4 %0, %1, %2, %0, %3, %3 op_sel_hi:[0,0,0]" : "+v"(acc[ai][bj][m][n]) : "v"(Bt##8[n]), "v"(At##8[m]), "v"(scl8));   \
        else { _Pragma("unroll") for (int k = 0; k < 2; ++k) acc[ai][bj][m][n] = __builtin_amdgcn_mfma_f32_16x16x32_bf16(Bt[n][k], At[m][k], acc[ai][bj][m][n], 0, 0, 0); } } \
        __builtin_amdgcn_s_setprio(0); } while (0)
#define PG8_WAIT_V(n) asm volatile("s_waitcnt vmcnt(" #n ")" ::: "memory")
#define PG8_WAIT_L(n) asm volatile("s_waitcnt lgkmcnt(" #n ")" ::: "memory")
#define PG8_BAR __builtin_amdgcn_s_barrier()
#define PG8_SCHED __builtin_amdgcn_sched_barrier(0)
    unsigned voffA0, c2, pkc[2], pkn[2], praw[4];
    { int R, C; stage_rc(tid * 16, R, C); voffA0 = (unsigned)(R * lda + C) * 2u; c2 = (unsigned)C * 2u; }
    const size_t hstepA = (size_t)HALF * lda * 2, pstepA = (size_t)64 * lda * 2;
    const unsigned lda2 = (unsigned)lda * 2u;
#define PG8_PKROWS(dst, u) do { if (GATHER) { _Pragma("unroll") for (int i_ = 0; i_ < 2; ++i_) { int R_, C_; stage_rc(tid * 16 + i_ * 8192, R_, C_); \
        const int nr_ = (u).nrows - 1; const int r0_ = R_ < nr_ ? R_ : nr_, r1_ = (R_ + HALF) < nr_ ? (R_ + HALF) : nr_; \
        dst[i_] = (unsigned)(u).rows[r0_] | ((unsigned)(u).rows[r1_] << 16); } } } while (0)
#define PG8_RAWROWS(u) do { if (GATHER) { _Pragma("unroll") for (int i_ = 0; i_ < 2; ++i_) { int R_, C_; stage_rc(tid * 16 + i_ * 8192, R_, C_); \
        const int nr_ = (u).nrows - 1; const int r0_ = R_ < nr_ ? R_ : nr_, r1_ = (R_ + HALF) < nr_ ? (R_ + HALF) : nr_; \
        praw[2 * i_] = gload32_hidden((u).rows, (unsigned)r0_ * 4u); praw[2 * i_ + 1] = gload32_hidden((u).rows, (unsigned)r1_ * 4u); } } } while (0)
#define PG8_PACKRAW(dst) do { unsigned a0_ = praw[0], a1_ = praw[1], a2_ = praw[2], a3_ = praw[3]; asm volatile("" : "+v"(a0_), "+v"(a1_), "+v"(a2_), "+v"(a3_)); \
        dst[0] = a0_ | (a1_ << 16); dst[1] = a2_ | (a3_ << 16); } while (0)
#define PG8_STGA(bufoff, gbase, h, NX) do { \
        if (GATHER) { const unsigned p0_ = (NX) ? pkn[0] : pkc[0], p1_ = (NX) ? pkn[1] : pkc[1]; \
            const unsigned o0_ = ((h) ? (p0_ >> 16) : (p0_ & 0xffffu)) * lda2 + c2, o1_ = ((h) ? (p1_ >> 16) : (p1_ & 0xffffu)) * lda2 + c2; \
            glds16s((const char*)(gbase), o0_, ldsb + (unsigned)(bufoff)); glds16s((const char*)(gbase), o1_, ldsb + (unsigned)(bufoff) + 8192u); } \
        else { const char* gb_ = (const char*)(gbase) + ((h) ? hstepA : (size_t)0); glds16s(gb_, voffA0, ldsb + (unsigned)(bufoff)); glds16s(gb_ + pstepA, voffA0, ldsb + (unsigned)(bufoff) + 8192u); } } while (0)
    Unit cur, nxt; int ui = 0;
    if (!S.next(0, cur)) return;
    f32x4 acc[2][2][4][2];
#pragma unroll
    for (int a = 0; a < 2; ++a)
#pragma unroll
        for (int b = 0; b < 2; ++b)
#pragma unroll
            for (int m = 0; m < 4; ++m)
#pragma unroll
                for (int n = 0; n < 2; ++n) acc[a][b][m][n] = (f32x4){0.f, 0.f, 0.f, 0.f};
    bf16x8 At[4][2], B0[2][2], B1[2][2]; v8i32_t At8[4], B08[2], B18[2];
    pkc[0] = pkc[1] = pkn[0] = pkn[1] = 0u; praw[0] = praw[1] = praw[2] = praw[3] = 0u;
    PG8_PKROWS(pkc, cur);
    const char* cA = cur.A; const char* cB = cur.B;
    PG8_STGB(PG8_SB(0, 0), cB); PG8_STGB(PG8_SB(0, 1), cB + hstepB); PG8_STGA(PG8_SA(0, 0), cA, 0, false); PG8_STGA(PG8_SA(0, 1), cA, 1, false);
    if (wr == 1) PG8_BAR;
    PG8_WAIT_V(2); PG8_BAR;
    PG8_STGB(PG8_SB(1, 0), cB + kstep); PG8_STGA(PG8_SA(1, 0), cA + kstep, 0, false); PG8_STGB(PG8_SB(1, 1), cB + hstepB + kstep);
    PG8_WAIT_V(6); PG8_BAR;
    for (;;) {
        const bool has_next = S.next(ui + 1, nxt);
        if (GATHER) { if (has_next) { PG8_RAWROWS(nxt); } }
        const char* nA = has_next ? nxt.A : cA; const char* nB = has_next ? nxt.B : cB;
        typename Epi::Pre pre; { int t_p = threadIdx.x; asm volatile("" : "+v"(t_p)); E.prefetch(cur, wr, wc, t_p & 15, (t_p >> 4) & 3, pre); }
        const int ntc = cur.ntu ? cur.ntu : nt;
        for (int t = 0; t < ntc; t += 2) {
            const bool last = (t == ntc - 2);
            if (GATHER) { pkn[0] = pkc[0]; pkn[1] = pkc[1]; if (last && has_next) { PG8_PACKRAW(pkn); } }
            const char* a1 = cA + (size_t)(t + 1) * kstep;
            const char* a2 = last ? nA : cA + (size_t)(t + 2) * kstep; const char* b2 = last ? nB : cB + (size_t)(t + 2) * kstep;
            const char* a3 = a2 + kstep; const char* b3 = b2 + kstep;
            PG8_LDB(B0, 0, 0); PG8_LDB(B1, 0, 1); PG8_SCHED; PG8_LDA(At, 0, 0); PG8_STGA(PG8_SA(1, 1), a1, 1, false);
            PG8_WAIT_V(8); PG8_WAIT_L(0); PG8_BAR; PG8_MMA(0, 0, At, B0); PG8_MMA(0, 1, At, B1); PG8_BAR; PG8_SCHED;
            PG8_LDA(At, 0, 1); PG8_STGB(PG8_SB(0, 0), b2); PG8_STGB(PG8_SB(0, 1), b2 + hstepB); PG8_STGA(PG8_SA(0, 0), a2, 0, last);
            PG8_WAIT_V(8); PG8_WAIT_L(0); PG8_BAR; PG8_MMA(1, 0, At, B0); PG8_MMA(1, 1, At, B1); PG8_BAR; PG8_SCHED;
            PG8_LDB(B0, 1, 0); PG8_LDB(B1, 1, 1); PG8_SCHED; PG8_LDA(At, 1, 0); PG8_STGA(PG8_SA(0, 1), a2, 1, last);
            PG8_WAIT_V(8); PG8_WAIT_L(0); PG8_BAR; PG8_MMA(0, 0, At, B0); PG8_MMA(0, 1, At, B1); PG8_BAR; PG8_SCHED;
            PG8_LDA(At, 1, 1); PG8_STGB(PG8_SB(1, 0), b3); PG8_STGB(PG8_SB(1, 1), b3 + hstepB); PG8_STGA(PG8_SA(1, 0), a3, 0, last);
            PG8_WAIT_V(8); PG8_WAIT_L(0); PG8_BAR; PG8_MMA(1, 0, At, B0); PG8_MMA(1, 1, At, B1); PG8_BAR; PG8_SCHED;
        }
        if constexpr (ALIGN_EPI) { if (wr == 0) PG8_BAR; }
        if constexpr (FP8) asm volatile("s_nop 15\n\ts_nop 15" ::: "memory");
        if constexpr (!Epi::AFTER_DRAIN) { int t_e = threadIdx.x; asm volatile("" : "+v"(t_e)); const int fr_e = t_e & 15, fq_e = (t_e >> 4) & 3; E(acc, cur, wr, wc, fr_e, fq_e, pre); }
        if (!has_next) break;
#pragma unroll
        for (int a = 0; a < 2; ++a)
#pragma unroll
            for (int b = 0; b < 2; ++b)
#pragma unroll
                for (int m = 0; m < 4; ++m)
#pragma unroll
                    for (int n = 0; n < 2; ++n) acc[a][b][m][n] = (f32x4){0.f, 0.f, 0.f, 0.f};
        cur = nxt; cA = nA; cB = nB; ++ui;
        if (GATHER) { PG8_PACKRAW(pkc); }
        if constexpr (ALIGN_EPI) { if (wr == 1) PG8_BAR; }
    }
    PG8_WAIT_V(0);
    if constexpr (!ALIGN_EPI) { if (wr == 0) PG8_BAR; }
    PG8_BAR;
    if constexpr (Epi::AFTER_DRAIN) { int t_e = threadIdx.x; asm volatile("" : "+v"(t_e)); const int fr_e = t_e & 15, fq_e = (t_e >> 4) & 3; E.fused(acc, cur, wr, wc, fr_e, fq_e, lds, wid, t_e & 63); }
#undef PG8_SA
#undef PG8_SB
#undef PG8_STGB
#undef PG8_LDA
#undef PG8_LDB
#undef PG8_MMA
#undef PG8_CAT
#undef PG8_LD16
#undef PG8_WAIT_V
#undef PG8_WAIT_L
#undef PG8_SCHED
#undef PG8_PKROWS
#undef PG8_RAWROWS
#undef PG8_PACKRAW
#undef PG8_STGA
}
}

namespace pg8 {
constexpr int NXCD = 8, WGM = 8;
__device__ __forceinline__ void tile_order(int L, int nM, int nN, int& pm, int& pn) {
    const int nwg = nM * nN; int wgid = L;
    { const int q = nwg / NXCD, r = nwg % NXCD, xcd = wgid % NXCD, off = wgid / NXCD; wgid = (xcd < r ? xcd * (q + 1) : r * (q + 1) + (xcd - r) * q) + off; }
    const int nig = WGM * nN, gid = wgid / nig, fm = gid * WGM, gsz = (nM - fm) < WGM ? (nM - fm) : WGM;
    pm = fm + ((wgid % nig) % gsz); pn = (wgid % nig) / gsz;
}
struct DenseOrder {
    const char* A; const char* B; int lda, ldb, nM, nN, G, c, pn0;
    __device__ __forceinline__ bool next(int i, Unit& u) const {
        const long L = (long)i * G + c; if (L >= (long)nM * nN) return false;
        int pm, pn; tile_order((int)L, nM, nN, pm, pn);
        u.pm = pm; u.pn = pn + pn0; u.aux = 0; u.rows = nullptr; u.nrows = 256; u.ntu = 0;
        u.A = A + (size_t)pm * 256 * lda * 2; u.B = B + (size_t)pn * 256 * ldb * 2; return true;
    }
};
struct KvOrder {
    const char* MN; const char* W; int L0;
    __device__ __forceinline__ bool next(int i, Unit& u) const {
        const int L = L0; if (i > 0 || L >= 64) return false;
        u.rows = nullptr; u.nrows = 256; u.ntu = 0; u.pm = L >> 3; const int ct = L & 7; u.aux = ct >> 2; u.pn = ct & 3;
        u.A = MN + (size_t)u.pm * 256 * D * 2; u.B = W + (size_t)ct * 256 * D * 2; return true;
    }
};
struct XmnOrder {
    const char* MK; const char* MV; const char* WQN; const char* WOT; int G, c;
    __device__ __forceinline__ bool next(int i, Unit& u) const {
        const int L = c + i * G; if (L >= 256) return false;
        u.rows = nullptr; u.nrows = 256; u.ntu = 0;
        if (L < 128) { const int b = L >> 4, h = (L >> 2) & 3, kt = L & 3; u.aux = 0; u.pm = b * 4 + h; u.pn = kt;
            u.A = MK + ((size_t)(b * 256) * D + h * 256) * 2; u.B = WQN + ((size_t)(kt * 256) * D + h * 256) * 2; }
        else { const int l = L - 128, b = l >> 4, nt = (l >> 2) & 3, h = l & 3; u.aux = 1; u.pm = b * 4 + nt; u.pn = h;
            u.A = WOT + ((size_t)(nt * 256) * D + h * 256) * 2; u.B = MV + ((size_t)(b * 256) * D + h * 256) * 2; }
        return true;
    }
};
struct P3Order {
    XmnOrder X; DenseOrder Dn;
    __device__ __forceinline__ bool next(int i, Unit& u) const {
        if (i == 0 && X.c < 256) { X.next(0, u); u.ntu = 4; return true; }
        const bool ok = Dn.next(X.c < 256 ? i - 1 : i, u); u.aux = 2; return ok;
    }
};
struct XbOrder {
    const char* A; const char* Bb; int G, c; size_t rb;
    __device__ __forceinline__ bool next(int i, Unit& u) const {
        const long L = (long)i * G + c; if (L >= 512) return false;
        int pm, pn; tile_order((int)L, T / 256, 4, pm, pn);
        u.pm = pm; u.pn = pn; u.aux = 0; u.rows = nullptr; u.nrows = 256; u.ntu = 0;
        u.A = A + (size_t)pm * 256 * rb; u.B = Bb + (size_t)(pm >> 4) * D * rb + (size_t)pn * 256 * rb; return true;
    }
};
struct MoeOrder {
    const char* A; const char* W; const int* list; const LAS int* cnt; const LAS unsigned char* te; const LAS int* ts;
    int ntiles, nN, G, c; size_t wstride; int gather; size_t atile, btile;
    __device__ __forceinline__ bool next(int i, Unit& u) const {
        const long L = (long)i * G + c; if (L >= (long)ntiles * nN) return false;
        int pm, pn; tile_order((int)L, ntiles, nN, pm, pn);
        const int e = __builtin_amdgcn_readfirstlane((int)te[pm]);
        const int lt = pm - __builtin_amdgcn_readfirstlane(ts[e]);
        const int n = __builtin_amdgcn_readfirstlane(cnt[e]) - lt * 256;
        u.pm = pm; u.pn = pn; u.aux = e; u.nrows = n < 256 ? n : 256; u.ntu = 0;
        u.rows = list + (size_t)e * T + lt * 256;
        u.A = gather ? A : A + (size_t)pm * atile;
        u.B = W + (size_t)e * wstride + (size_t)pn * btile; return true;
    }
};

struct EpiProj {
    static constexpr bool PERM = true, AFTER_DRAIN = false; struct Pre {}; __device__ __forceinline__ void prefetch(const Unit&, int, int, int, int, Pre&) const {}
    bf16_t* O; float* kbar; float asc;
    __device__ __forceinline__ void operator()(const f32x4 (&acc)[2][2][4][2], const Unit& u, int wr, int wc, int fr, int fq, const Pre&) const {
        const int pn = u.pn, sec = pn >> 1, b = u.pm >> 4, t0 = (u.pm & 15) * 256 + wr * 64 + fr;
        const int mode = (pn < 2) ? 1 : ((pn == 6 || pn == 7 || pn >= 12) ? 2 : 0);
        bf16_t* sb = O + (size_t)sec * SEC_ELEMS;
#pragma unroll
        for (int bj = 0; bj < 2; ++bj) {
            const int c = bj * HALF + wc * 32 + 8 * fq, head = (pn & 1) * 4 + (c >> 6), d0 = c & 63;
            bf16_t* hb = sb + (size_t)(b * 8 + head) * (SEQ * 64);
#pragma unroll
            for (int ai = 0; ai < 2; ++ai)
#pragma unroll
                for (int m = 0; m < 4; ++m) { const int t = t0 + ai * HALF + m * 16;
                    f32x4 v0 = acc[ai][bj][m][0] * asc, v1 = acc[ai][bj][m][1] * asc;
                    if (mode == 1) { v0 = v0 * C2Q; v1 = v1 * C2Q; }
                    else if (mode == 2) {
#pragma unroll
                        for (int e = 0; e < 4; ++e) { v0[e] = silu_f(v0[e]); v1[e] = silu_f(v1[e]); } }
                    u32x4 w; w.x = cvtpk(v0[0], v0[1]); w.y = cvtpk(v0[2], v0[3]); w.z = cvtpk(v1[0], v1[1]); w.w = cvtpk(v1[2], v1[3]);
                    size_t off;
                    if (sec == 1) off = (size_t)(t >> 6) * 4096 + (d0 >> 3) * 512 + (t & 63) * 8;
                    else if (sec == 2) off = (size_t)(t >> 6) * 4096 + (d0 >> 5) * 2048 + (t & 63) * 32 + (d0 & 31);
                    else off = (size_t)t * 64 + d0;
                    *(u32x4*)(hb + off) = w; } }
        if (pn == 2 || pn == 3) {
#pragma unroll
            for (int bj = 0; bj < 2; ++bj)
#pragma unroll
                for (int n = 0; n < 2; ++n)
#pragma unroll
                    for (int e = 0; e < 4; ++e) { float s = 0.f;
#pragma unroll
                        for (int ai = 0; ai < 2; ++ai)
#pragma unroll
                            for (int m = 0; m < 4; ++m) s += acc[ai][bj][m][n][e];
                        s += __shfl_xor(s, 1); s += __shfl_xor(s, 2); s += __shfl_xor(s, 4); s += __shfl_xor(s, 8); s *= asc;
                        if (fr == 0) { const int c = bj * HALF + wc * 32 + 8 * fq + 4 * n + e, head = (pn - 2) * 4 + (c >> 6), d = c & 63;
                            atomicAdd(kbar + ((size_t)u.pm * 8 + head) * 64 + d, s); } }
        }
    }
};
struct EpiBf16 {
    static constexpr bool PERM = true, AFTER_DRAIN = false; struct Pre {}; __device__ __forceinline__ void prefetch(const Unit&, int, int, int, int, Pre&) const {}
    bf16_t* O0; int ldc0; bf16_t* O1; int ldc1;
    __device__ __forceinline__ void operator()(const f32x4 (&acc)[2][2][4][2], const Unit& u, int wr, int wc, int fr, int fq, const Pre&) const {
        bf16_t* O = u.aux ? O1 : O0; const int ldc = u.aux ? ldc1 : ldc0;
        const int row0 = u.pm * BM + wr * 64 + fr, col0 = u.pn * BM + wc * 32 + 8 * fq;
#pragma unroll
        for (int ai = 0; ai < 2; ++ai)
#pragma unroll
            for (int m = 0; m < 4; ++m) { bf16_t* rowp = O + (size_t)(row0 + ai * HALF + m * 16) * ldc + col0;
#pragma unroll
                for (int bj = 0; bj < 2; ++bj) { const f32x4 v0 = acc[ai][bj][m][0], v1 = acc[ai][bj][m][1];
                    u32x4 w; w.x = cvtpk(v0[0], v0[1]); w.y = cvtpk(v0[2], v0[3]); w.z = cvtpk(v1[0], v1[1]); w.w = cvtpk(v1[2], v1[3]);
                    *(u32x4*)(rowp + bj * HALF) = w; } }
    }
};
struct EpiFp8 {
    static constexpr bool PERM = true, AFTER_DRAIN = false; struct Pre {}; __device__ __forceinline__ void prefetch(const Unit&, int, int, int, int, Pre&) const {}
    unsigned char* O0; int ldc0; unsigned char* O1; int ldc1; float scale;
    __device__ __forceinline__ void operator()(const f32x4 (&acc)[2][2][4][2], const Unit& u, int wr, int wc, int fr, int fq, const Pre&) const {
        unsigned char* O = u.aux ? O1 : O0; const int ldc = u.aux ? ldc1 : ldc0;
        const int row0 = u.pm * BM + wr * 64 + fr, col0 = u.pn * BM + wc * 32 + 8 * fq;
#pragma unroll
        for (int ai = 0; ai < 2; ++ai)
#pragma unroll
            for (int m = 0; m < 4; ++m) { unsigned char* rowp = O + (size_t)(row0 + ai * HALF + m * 16) * ldc + col0;
#pragma unroll
                for (int bj = 0; bj < 2; ++bj) { const f32x4 v0 = acc[ai][bj][m][0] * scale, v1 = acc[ai][bj][m][1] * scale;
                    *(u32x2*)(rowp + bj * HALF) = (u32x2){pk4_fp8(v0[0], v0[1], v0[2], v0[3]), pk4_fp8(v1[0], v1[1], v1[2], v1[3])}; } }
    }
};
template <bool BASE_F32, bool WRITE_F32, bool OUT_FP8 = false> struct EpiRes {
    static constexpr bool PERM = true, AFTER_DRAIN = false; struct Pre {}; __device__ __forceinline__ void prefetch(const Unit&, int, int, int, int, Pre&) const {}
    const void* base; bf16_t* Ob; float* Of; float* ss; float asc; unsigned char* Oq;
    static constexpr int LPG = BASE_F32 ? 4 : 2;
    __device__ __forceinline__ void issue(f32x4 (&b)[4], unsigned voff) const {
        if (BASE_F32) { b[0] = gload128_hidden(base, voff); b[1] = gload128_hidden(base, voff + 16u); b[2] = gload128_hidden(base, voff + HALF * 4u); b[3] = gload128_hidden(base, voff + HALF * 4u + 16u); }
        else { b[0] = gload128_hidden(base, voff); b[1] = gload128_hidden(base, voff + HALF * 2u); }
    }
    __device__ __forceinline__ void operator()(const f32x4 (&acc)[2][2][4][2], const Unit& u, int wr, int wc, int fr, int fq, const Pre&) const {
        const int row0 = u.pm * BM + wr * 64 + fr, col0 = u.pn * BM + wc * 32 + 8 * fq;
        const unsigned esz = BASE_F32 ? 4u : 2u;
        f32x4 lb[8][4];
#define ER_VOFF(g_) ((unsigned)((row0 + ((g_) >> 2) * HALF + ((g_) & 3) * 16) * D + col0) * esz)
#pragma unroll
        for (int g = 0; g < 4; ++g) issue(lb[g], ER_VOFF(g));
#pragma unroll
        for (int g = 0; g < 8; ++g) { const int ai = g >> 2, m = g & 3; const int row = row0 + ai * HALF + m * 16; const size_t off = (size_t)row * D + col0; float sq = 0.f;
            { constexpr int dummy = 0; (void)dummy; const int newer = (7 - g < 3 ? 7 - g : 3) * LPG;
              if (newer == 12) asm volatile("s_waitcnt vmcnt(12)" ::: "memory"); else if (newer == 8) asm volatile("s_waitcnt vmcnt(8)" ::: "memory"); else if (newer == 6) asm volatile("s_waitcnt vmcnt(6)" ::: "memory");
              else if (newer == 4) asm volatile("s_waitcnt vmcnt(4)" ::: "memory"); else if (newer == 2) asm volatile("s_waitcnt vmcnt(2)" ::: "memory"); else asm volatile("s_waitcnt vmcnt(0)" ::: "memory"); }
#pragma unroll
            for (int q = 0; q < LPG; ++q) asm volatile("" : "+v"(lb[g][q]));
#pragma unroll
            for (int bj = 0; bj < 2; ++bj) { f32x4 b0, b1;
                if (BASE_F32) { b0 = lb[g][2 * bj]; b1 = lb[g][2 * bj + 1]; }
                else { const u32x4 w = __builtin_bit_cast(u32x4, lb[g][bj]);
                    b0 = (f32x4){bflo(w.x), bfhi(w.x), bflo(w.y), bfhi(w.y)}; b1 = (f32x4){bflo(w.z), bfhi(w.z), bflo(w.w), bfhi(w.w)}; }
                const f32x4 v0 = acc[ai][bj][m][0] * asc + b0, v1 = acc[ai][bj][m][1] * asc + b1;
                sq += (v0[0] * v0[0] + v0[1] * v0[1]) + (v0[2] * v0[2] + v0[3] * v0[3]) + (v1[0] * v1[0] + v1[1] * v1[1]) + (v1[2] * v1[2] + v1[3] * v1[3]);
                if (OUT_FP8) { *(u32x2*)((unsigned char*)Ob + off + bj * HALF) = (u32x2){pk4_fp8(v0[0], v0[1], v0[2], v0[3]), pk4_fp8(v1[0], v1[1], v1[2], v1[3])}; }
                else { u32x4 w; w.x = cvtpk(v0[0], v0[1]); w.y = cvtpk(v0[2], v0[3]); w.z = cvtpk(v1[0], v1[1]); w.w = cvtpk(v1[2], v1[3]);
                *(u32x4*)(Ob + off + bj * HALF) = w; }
                if (Oq) *(u32x2*)(Oq + off + bj * HALF) = (u32x2){pk4_fp8(v0[0], v0[1], v0[2], v0[3]), pk4_fp8(v1[0], v1[1], v1[2], v1[3])};
                if (WRITE_F32) { *(f32x4*)(Of + off + bj * HALF) = v0; *(f32x4*)(Of + off + bj * HALF + 4) = v1; } }
            sq += __shfl_xor(sq, 16); sq += __shfl_xor(sq, 32);
            if (fq == 0) atomicAdd(ss + row, sq);
            if (g + 4 < 8) issue(lb[g + 4], ER_VOFF(g + 4)); }
#undef ER_VOFF
    }
};
struct EpiP3 {
    static constexpr bool PERM = true, AFTER_DRAIN = false; struct Pre {}; __device__ __forceinline__ void prefetch(const Unit&, int, int, int, int, Pre&) const {}
    EpiFp8 a; EpiRes<true, false> b;
    __device__ __forceinline__ void operator()(const f32x4 (&acc)[2][2][4][2], const Unit& u, int wr, int wc, int fr, int fq, const Pre&) const {
        if (u.aux < 2) a(acc, u, wr, wc, fr, fq, EpiFp8::Pre{}); else b(acc, u, wr, wc, fr, fq, EpiRes<true, false>::Pre{});
    }
};
struct EpiQ {
    static constexpr bool PERM = true, AFTER_DRAIN = false; struct Pre {}; __device__ __forceinline__ void prefetch(const Unit&, int, int, int, int, Pre&) const {}
    bf16_t* O; const float* ss;
    __device__ __forceinline__ void operator()(const f32x4 (&acc)[2][2][4][2], const Unit& u, int wr, int wc, int fr, int fq, const Pre&) const {
        const int row0 = u.pm * BM + wr * 64 + fr, col0 = u.pn * BM + wc * 32 + 8 * fq;
#pragma unroll
        for (int ai = 0; ai < 2; ++ai)
#pragma unroll
            for (int m = 0; m < 4; ++m) { const int row = row0 + ai * HALF + m * 16; const float sc = C2X * __builtin_amdgcn_rsqf(ss[row] * (1.0f / D) + EPS);
                bf16_t* rowp = O + (size_t)row * D + col0;
#pragma unroll
                for (int bj = 0; bj < 2; ++bj) { const f32x4 v0 = acc[ai][bj][m][0] * sc, v1 = acc[ai][bj][m][1] * sc;
                    u32x4 w; w.x = cvtpk(v0[0], v0[1]); w.y = cvtpk(v0[2], v0[3]); w.z = cvtpk(v1[0], v1[1]); w.w = cvtpk(v1[2], v1[3]);
                    *(u32x4*)(rowp + bj * HALF) = w; } }
    }
};
struct EpiSoftmaxS {
    static constexpr bool PERM = true, AFTER_DRAIN = false; struct Pre {}; __device__ __forceinline__ void prefetch(const Unit&, int, int, int, int, Pre&) const {}
    unsigned char* P; const float* ss; LAS unsigned char* tb; float qs;
    __device__ __forceinline__ void operator()(f32x4 (&acc)[2][2][4][2], const Unit& u, int wr, int wc, int fr, int fq, const Pre&) const {
        LAS float* MX = (LAS float*)tb;
        LAS float* SM = (LAS float*)(tb + 4096);
#pragma unroll
        for (int ai = 0; ai < 2; ++ai)
#pragma unroll
            for (int m = 0; m < 4; ++m) { const int r = ai * HALF + wr * 64 + m * 16 + fr; const float sc = qs * C2X * __builtin_amdgcn_rsqf(ss[u.pm * BM + r] * (1.0f / D) + EPS); float mx = -3.0e38f;
#pragma unroll
                for (int bj = 0; bj < 2; ++bj)
#pragma unroll
                    for (int n = 0; n < 2; ++n) { f32x4 x = acc[ai][bj][m][n] * sc; acc[ai][bj][m][n] = x; mx = fmaxf(mx, fmaxf(fmaxf(x[0], x[1]), fmaxf(x[2], x[3]))); }
                mx = fmaxf(mx, __shfl_xor(mx, 16)); mx = fmaxf(mx, __shfl_xor(mx, 32));
                if (fq == 0) MX[r * 4 + wc] = mx; }
        LDS_WAIT(); __builtin_amdgcn_s_barrier(); asm volatile("" ::: "memory");
#pragma unroll
        for (int ai = 0; ai < 2; ++ai)
#pragma unroll
            for (int m = 0; m < 4; ++m) { const int r = ai * HALF + wr * 64 + m * 16 + fr; const f32x4 q = *(const LAS f32x4*)(MX + r * 4);
                const float mx = fmaxf(fmaxf(q[0], q[1]), fmaxf(q[2], q[3])); float sm = 0.f;
#pragma unroll
                for (int bj = 0; bj < 2; ++bj)
#pragma unroll
                    for (int n = 0; n < 2; ++n) { f32x4 x = acc[ai][bj][m][n];
#pragma unroll
                        for (int e = 0; e < 4; ++e) { x[e] = fast_exp2(x[e] - mx); sm += x[e]; }
                        acc[ai][bj][m][n] = x; }
                sm += __shfl_xor(sm, 16); sm += __shfl_xor(sm, 32);
                if (fq == 0) SM[r * 4 + wc] = sm; }
        LDS_WAIT(); __builtin_amdgcn_s_barrier(); asm volatile("" ::: "memory");
        const int col0 = u.pn * BM + wc * 32 + 8 * fq;
#pragma unroll
        for (int ai = 0; ai < 2; ++ai)
#pragma unroll
            for (int m = 0; m < 4; ++m) { const int r = ai * HALF + wr * 64 + m * 16 + fr; const f32x4 q = *(const LAS f32x4*)(SM + r * 4);
                const float inv = PSCALE8 * fast_rcp((q[0] + q[1]) + (q[2] + q[3]));
#pragma unroll
                for (int bj = 0; bj < 2; ++bj) { const f32x4 v0 = acc[ai][bj][m][0] * inv, v1 = acc[ai][bj][m][1] * inv;
                    *(u32x2*)(P + ((size_t)u.pm * BM + r) * D + bj * HALF + col0) = (u32x2){pk4_fp8(v0[0], v0[1], v0[2], v0[3]), pk4_fp8(v1[0], v1[1], v1[2], v1[3])}; } }
        LDS_WAIT(); __builtin_amdgcn_s_barrier(); asm volatile("" ::: "memory");
    }
};
struct EpiW1 {
    static constexpr bool PERM = true, AFTER_DRAIN = false;
    struct Pre { float sc[8]; f32x4 bq[4]; };
    bf16_t* O; const float* ssl; const float* b1; const int* list0;
    __device__ __forceinline__ void prefetch(const Unit& u, int wr, int wc, int fr, int fq, Pre& p) const {
        const float* sp = ssl + (u.rows - list0);
        { const float* bb = b1 + (size_t)u.aux * 2048 + 2 * (u.pn * 128); const unsigned bo = (unsigned)(2 * (wc * 32 + 8 * fq)) * 4u;
#pragma unroll
          for (int q = 0; q < 4; ++q) p.bq[q] = gload128_hidden(bb, bo + 16u * q); }
#pragma unroll
        for (int ai = 0; ai < 2; ++ai)
#pragma unroll
            for (int m = 0; m < 4; ++m) { const int r = ai * HALF + wr * 64 + m * 16 + fr; const int rr = r < u.nrows ? r : u.nrows - 1; p.sc[ai * 4 + m] = __uint_as_float(gload32_hidden(sp, (unsigned)rr * 4u)); }
    }
    __device__ __forceinline__ void operator()(const f32x4 (&acc)[2][2][4][2], const Unit& u, int wr, int wc, int fr, int fq, const Pre& pre) const {
        const int c0 = wc * 32 + 8 * fq;
        f32x4 bq0 = pre.bq[0], bq1 = pre.bq[1], bq2 = pre.bq[2], bq3 = pre.bq[3]; asm volatile("" : "+v"(bq0), "+v"(bq1), "+v"(bq2), "+v"(bq3));
        const float bg[8] = {bq0[0], bq0[2], bq1[0], bq1[2], bq2[0], bq2[2], bq3[0], bq3[2]};
        const float bl[8] = {bq0[1], bq0[3], bq1[1], bq1[3], bq2[1], bq2[3], bq3[1], bq3[3]};
#pragma unroll
        for (int ai = 0; ai < 2; ++ai)
#pragma unroll
            for (int m = 0; m < 4; ++m) { const int r = ai * HALF + wr * 64 + m * 16 + fr;
                float ssv = pre.sc[ai * 4 + m]; asm volatile("" : "+v"(ssv));
                const float sc = WSCALE8_INV * __builtin_amdgcn_rsqf(ssv * (1.0f / D) + EPS); float a[8];
#pragma unroll
                for (int j = 0; j < 8; ++j) { const float g = acc[ai][0][m][j >> 2][j & 3] * sc + bg[j], l = acc[ai][1][m][j >> 2][j & 3] * sc + bl[j];
                    const float glu = fminf(g, 7.0f), lin = fminf(fmaxf(l, -7.0f), 7.0f);
                    a[j] = glu * fast_rcp(1.0f + fast_exp2(-1.702f * LOG2E * glu)) * (lin + 1.0f); }
                *(u32x2*)((unsigned char*)O + ((size_t)u.pm * BM + r) * D + u.pn * 128 + c0) = (u32x2){pk4_fp8(a[0], a[1], a[2], a[3]), pk4_fp8(a[4], a[5], a[6], a[7])}; }
    }
};
constexpr float YSCALE = 16.0f, YSCALE_INV = 1.0f / 16.0f;
struct EpiW2 {
    static constexpr bool PERM = true, AFTER_DRAIN = false;
    struct Pre { float g[8]; f32x4 bv[4]; };
    unsigned char* O; const float* b2; const int* list0; const float* gl0;
    __device__ __forceinline__ void prefetch(const Unit& u, int wr, int wc, int fr, int fq, Pre& p) const {
        const float* gp = gl0 + (u.rows - list0);
        { const float* bb = b2 + (size_t)u.aux * D + u.pn * BM; const unsigned bo = (unsigned)(wc * 32 + 8 * fq) * 4u;
#pragma unroll
          for (int q = 0; q < 4; ++q) p.bv[q] = gload128_hidden(bb, bo + (unsigned)((q >> 1) * HALF * 4 + (q & 1) * 16)); }
#pragma unroll
        for (int ai = 0; ai < 2; ++ai)
#pragma unroll
            for (int m = 0; m < 4; ++m) { const int r = ai * HALF + wr * 64 + m * 16 + fr; const int rr = r < u.nrows ? r : u.nrows - 1; p.g[ai * 4 + m] = __uint_as_float(gload32_hidden(gp, (unsigned)rr * 4u)); }
    }
    __device__ __forceinline__ void operator()(const f32x4 (&acc)[2][2][4][2], const Unit& u, int wr, int wc, int fr, int fq, const Pre& pre) const {
        const int row0 = u.pm * BM + wr * 64 + fr, col0 = u.pn * BM + wc * 32 + 8 * fq;
        f32x4 bv[2][2]; bv[0][0] = pre.bv[0]; bv[0][1] = pre.bv[1]; bv[1][0] = pre.bv[2]; bv[1][1] = pre.bv[3]; asm volatile("" : "+v"(bv[0][0]), "+v"(bv[0][1]), "+v"(bv[1][0]), "+v"(bv[1][1]));
#pragma unroll
        for (int ai = 0; ai < 2; ++ai)
#pragma unroll
            for (int m = 0; m < 4; ++m) { unsigned char* rowp = O + (size_t)(row0 + ai * HALF + m * 16) * D + col0; float gv = pre.g[ai * 4 + m]; asm volatile("" : "+v"(gv)); const float g = YSCALE * gv;
#pragma unroll
                for (int bj = 0; bj < 2; ++bj) { const f32x4 v0 = (acc[ai][bj][m][0] * WSCALE8_INV + bv[bj][0]) * g, v1 = (acc[ai][bj][m][1] * WSCALE8_INV + bv[bj][1]) * g;
                    *(u32x2*)(rowp + bj * HALF) = (u32x2){pk4_fp8(v0[0], v0[1], v0[2], v0[3]), pk4_fp8(v1[0], v1[1], v1[2], v1[3])}; } }
    }
};
}

namespace moba {
using bf16x8 = ::bf16x8; using s16x4 = ::s16x4; using f32x16 = ::f32x16; using u32x4 = ::u32x4;
constexpr int DMQ = INC, DMO = D, HD = 64;
constexpr int NW = 8, QBLK = 32, QB = 256, KVBLK = 64;
__device__ __forceinline__ int crow(int r, int hi) { return (r & 3) + 8 * (r >> 2) + 4 * hi; }
#define SBAR() __builtin_amdgcn_sched_barrier(0)
__device__ __forceinline__ void cmask(f32x16& p0, f32x16& p1, int jb, int qrel, int hi) {
    const float NEG = -INFINITY; int kb = 64 * jb + 4 * hi;
#pragma unroll
    for (int r = 0; r < 16; ++r) { int kv = kb + (r & 3) + 8 * (r >> 2); if (kv > qrel) p0[r] = NEG; if (kv + 32 > qrel) p1[r] = NEG; }
}
constexpr int NSLOT = 3, SLOTB = 8192;
constexpr int LDS_K = 0, LDS_V = NSLOT * SLOTB, LDS_WS = 2 * NSLOT * SLOTB, LDS_OST = LDS_WS + NW * 64 * 4, LDS_KB = LDS_OST + NW * 4096, LDS_BYTES = LDS_KB + 16 * 64 * 4;
__device__ __forceinline__ void glds16(const void* gsrc, unsigned lds_dst) { unsigned keep;
    asm volatile("s_mov_b32 %0, m0\n\ts_mov_b32 m0, %2\n\ts_nop 0\n\tglobal_load_lds_dwordx4 %1, off\n\ts_mov_b32 m0, %0" : "=&s"(keep) : "v"(gsrc), "s"(lds_dst) : "memory"); }
__device__ __forceinline__ float max3f(float a, float b, float c) { float r; asm("v_max3_f32 %0, %1, %2, %3" : "=v"(r) : "v"(a), "v"(b), "v"(c)); return r; }
__device__ __forceinline__ float max2f(float a, float b) { float r; asm("v_max_f32_e32 %0, %1, %2" : "=v"(r) : "v"(a), "v"(b)); return r; }
__device__ __forceinline__ float fadd_s(float a, float b) { float r; asm("v_add_f32_e32 %0, %1, %2" : "=v"(r) : "v"(a), "v"(b)); return r; }
__device__ __forceinline__ float fsub_s(float a, float b) { float r; asm("v_sub_f32_e32 %0, %1, %2" : "=v"(r) : "v"(a), "v"(b)); return r; }
__device__ __forceinline__ unsigned cvtpk_s(float lo, float hi) { return ::cvtpk(lo, hi); }
#define WAIT_BAR(N) asm volatile("s_waitcnt vmcnt(" #N ") lgkmcnt(0)\n\ts_barrier" ::: "memory")
__device__ __forceinline__ void qkt(f32x16& p0, f32x16& p1, const char* Kslot, const bf16x8* qr, const f32x16& negm, int r32, int hi) {
    const char* kb = Kslot + hi * 1024 + r32 * 16;
#pragma unroll
    for (int d0 = 0; d0 < 4; ++d0) {
        const bf16x8 b0 = *reinterpret_cast<const bf16x8*>(kb + d0 * 2048);
        const bf16x8 b1 = *reinterpret_cast<const bf16x8*>(kb + d0 * 2048 + 512);
        if (d0 == 0) { p0 = __builtin_amdgcn_mfma_f32_32x32x16_bf16(b0, qr[0], negm, 0, 0, 0); p1 = __builtin_amdgcn_mfma_f32_32x32x16_bf16(b1, qr[0], negm, 0, 0, 0); }
        else { p0 = __builtin_amdgcn_mfma_f32_32x32x16_bf16(b0, qr[d0], p0, 0, 0, 0); p1 = __builtin_amdgcn_mfma_f32_32x32x16_bf16(b1, qr[d0], p1, 0, 0, 0); } }
}
typedef __attribute__((address_space(3))) const char* lds_cptr;
typedef short v4i16_t __attribute__((ext_vector_type(4)));
__device__ __forceinline__ void kload8(bf16x8* kf, lds_cptr kp) {
    kf[0] = *(const __attribute__((address_space(3))) bf16x8*)(kp);        kf[1] = *(const __attribute__((address_space(3))) bf16x8*)(kp + 512);
    kf[2] = *(const __attribute__((address_space(3))) bf16x8*)(kp + 2048); kf[3] = *(const __attribute__((address_space(3))) bf16x8*)(kp + 2560);
    kf[4] = *(const __attribute__((address_space(3))) bf16x8*)(kp + 4096); kf[5] = *(const __attribute__((address_space(3))) bf16x8*)(kp + 4608);
    kf[6] = *(const __attribute__((address_space(3))) bf16x8*)(kp + 6144); kf[7] = *(const __attribute__((address_space(3))) bf16x8*)(kp + 6656);
}
__device__ __forceinline__ void kload2(bf16x8* kf, lds_cptr kp, int j) { kf[2 * j] = *(const __attribute__((address_space(3))) bf16x8*)(kp + j * 2048); kf[2 * j + 1] = *(const __attribute__((address_space(3))) bf16x8*)(kp + j * 2048 + 512); }
__device__ __forceinline__ s16x4 vtr(lds_cptr p) { return __builtin_bit_cast(s16x4, __builtin_amdgcn_ds_read_tr16_b64_v4i16((__attribute__((address_space(3))) v4i16_t*)p)); }
__device__ __forceinline__ float rowmax(const f32x16& p0, const f32x16& p1) {
    float a = max3f(p0[0], p0[1], p1[0]), b = max3f(p0[2], p0[3], p1[1]); a = max3f(a, p1[2], p1[3]);
#pragma unroll
    for (int r = 4; r < 16; r += 4) { a = max3f(a, p0[r], p0[r + 1]); b = max3f(b, p0[r + 2], p0[r + 3]); a = max3f(a, p1[r], p1[r + 1]); b = max3f(b, p1[r + 2], p1[r + 3]); }
    const float m = max2f(a, b);
    auto rr = __builtin_amdgcn_permlane32_swap(__float_as_uint(m), __float_as_uint(m), false, false);
    return max2f(__uint_as_float(rr[0]), __uint_as_float(rr[1]));
}
__device__ __forceinline__ void pv(f32x16* o, int vb, bf16x8 pa0, bf16x8 pa1, bf16x8 pa2, bf16x8 pa3) {
#pragma unroll
    for (int d0 = 0; d0 < 2; ++d0) { s16x4 lo[4], hi[4];
#pragma unroll
        for (int ks = 0; ks < 4; ++ks) {
            asm volatile("ds_read_b64_tr_b16 %0,%1 offset:%c2" : "=&v"(lo[ks]) : "v"(vb), "i"(d0 * 4096 + ks * 1024) : "memory");
            asm volatile("ds_read_b64_tr_b16 %0,%1 offset:%c2" : "=&v"(hi[ks]) : "v"(vb), "i"(d0 * 4096 + ks * 1024 + 512) : "memory"); }
        asm volatile("s_waitcnt lgkmcnt(0)" ::: "memory"); SBAR();
#define PK(k) (bf16x8){lo[k][0], lo[k][1], lo[k][2], lo[k][3], hi[k][0], hi[k][1], hi[k][2], hi[k][3]}
        o[d0] = __builtin_amdgcn_mfma_f32_32x32x16_bf16(pa0, PK(0), o[d0], 0, 0, 0);
        o[d0] = __builtin_amdgcn_mfma_f32_32x32x16_bf16(pa1, PK(1), o[d0], 0, 0, 0);
        o[d0] = __builtin_amdgcn_mfma_f32_32x32x16_bf16(pa2, PK(2), o[d0], 0, 0, 0);
        o[d0] = __builtin_amdgcn_mfma_f32_32x32x16_bf16(pa3, PK(3), o[d0], 0, 0, 0);
#undef PK
    }
}
constexpr float NEGBIG = -1.0e30f;

template <int THRL> __device__ __forceinline__ void attn_unit(int b, int h, int qb, const bf16_t* Qg, const bf16_t* __restrict__ Kg, const bf16_t* __restrict__ Vg, bf16_t* Og, const float* __restrict__ kbar, char* shm) {
    int tid_ = threadIdx.x; asm volatile("" : "+v"(tid_));
    const int tid = tid_, lane = tid & 63, r32 = lane & 31, hi = lane >> 5; const int wid = __builtin_amdgcn_readfirstlane(tid >> 6);
    const long rowbase = (long)b * SEQ; const int q0 = qb * QB;
    const size_t hoff = (size_t)(b * 8 + h) * (SEQ * 64);
    const bf16_t* Qw = Qg + hoff + (size_t)(q0 + wid * QBLK) * 64;
    const bf16_t* Kh = Kg + hoff, *Vh = Vg + hoff;
    const unsigned lds0 = (unsigned)(uintptr_t)shm;
    float* wsf = (float*)(shm + LDS_WS) + wid * 64;
    const bf16_t* ksrc = Kh + wid * 512 + lane * 8;
    const bf16_t* vsrc = Vh + wid * 512 + lane * 8;
    const unsigned kdst = lds0 + LDS_K + wid * 1024, vdst = lds0 + LDS_V + wid * 1024;
    const int NT = 4 * qb + 4, NPAST = 4 * qb;
#define TMAP(t) (((t) < 4) ? (NPAST + (t)) : ((t) - 4))
#define DMA_K(t, slot) glds16(ksrc + (long)TMAP(t) * 4096, (unsigned)__builtin_amdgcn_readfirstlane(kdst + (slot)))
#define DMA_V(t, slot) glds16(vsrc + (long)TMAP(t) * 4096, (unsigned)__builtin_amdgcn_readfirstlane(vdst + (slot)))
    const char* Kbase = shm + LDS_K; bf16x8 kf[8];
    const lds_cptr shm3 = (lds_cptr)shm; const lds_cptr kp0 = shm3 + LDS_K + hi * 1024 + r32 * 16; const lds_cptr vp0 = shm3 + LDS_V + ((lane >> 4) & 1) * 32 + (lane & 3) * 8 + (4 * hi + ((lane & 15) >> 2)) * 64;
    DMA_K(0, 0); DMA_V(0, 0); DMA_K(1, SLOTB);
    bf16x8 qr[4];
#pragma unroll
    for (int d0 = 0; d0 < 4; ++d0) qr[d0] = *reinterpret_cast<const bf16x8*>(&Qw[(long)r32 * 64 + d0 * 16 + hi * 8]);
    unsigned selm = 0u;
    if (qb > 0) {
        float* kbl = (float*)(shm + LDS_KB);
        for (int i = tid; i < qb * 64; i += NW * 64) kbl[i] = kbar[((size_t)(b * 16 + (i >> 6)) * 8 + h) * 64 + (i & 63)];
        asm volatile("s_waitcnt vmcnt(0) lgkmcnt(0)\n\ts_barrier" ::: "memory");
        if (qb <= 3) selm = (1u << qb) - 1u;
        else {
            float qf[32];
#pragma unroll
            for (int d0 = 0; d0 < 4; ++d0)
#pragma unroll
                for (int j = 0; j < 8; ++j) qf[d0 * 8 + j] = bf2f((unsigned short)qr[d0][j]);
            float g[15];
#pragma unroll
            for (int n = 0; n < 15; ++n) { float s = 0.f;
                if (n < qb) {
#pragma unroll
                    for (int d0 = 0; d0 < 4; ++d0) { const f32x4 k0 = *(const f32x4*)(kbl + n * 64 + d0 * 16 + hi * 8), k1 = *(const f32x4*)(kbl + n * 64 + d0 * 16 + hi * 8 + 4);
                        s += qf[d0 * 8 + 0] * k0[0] + qf[d0 * 8 + 1] * k0[1] + qf[d0 * 8 + 2] * k0[2] + qf[d0 * 8 + 3] * k0[3] + qf[d0 * 8 + 4] * k1[0] + qf[d0 * 8 + 5] * k1[1] + qf[d0 * 8 + 6] * k1[2] + qf[d0 * 8 + 7] * k1[3]; }
                    s += __shfl_xor(s, 32);
                } else s = -INFINITY;
                g[n] = s; }
#pragma unroll
            for (int pass = 0; pass < 3; ++pass) { float best = -INFINITY; int bi = 0;
#pragma unroll
                for (int n = 0; n < 15; ++n) if (g[n] > best) { best = g[n]; bi = n; }
                selm |= 1u << bi;
#pragma unroll
                for (int n = 0; n < 15; ++n) if (n == bi) g[n] = -INFINITY; }
        }
    }
    float mhat = 0.f, l_reg = 0.f; f32x16 o[2]; o[0] = f32x16{}; o[1] = f32x16{}; f32x16 cini = f32x16{}; asm volatile("" : "+v"(cini));
    const int qrel = wid * QBLK + r32;
#define SETC(t, JB) do { const float cm_ = ((JB >= 0) || ((selm >> (((t) - 4) >> 2)) & 1u)) ? -mhat : NEGBIG; \
      _Pragma("unroll") for (int r = 0; r < 16; ++r) cini[r] = cm_; asm volatile("" : "+v"(cini)); } while (0)
    bool resc = false;
#define START(P0, P1) do { const float rm = rowmax(P0, P1); resc = false; \
    { const float dl = rm; mhat = fadd_s(mhat, dl); \
      _Pragma("unroll") for (int r = 0; r < 16; ++r) { P0[r] = fsub_s(P0[r], dl); P1[r] = fsub_s(P1[r], dl); } } \
    _Pragma("unroll") for (int r = 0; r < 16; ++r) P0[r] = __builtin_amdgcn_exp2f(P0[r]); } while (0)
#define RESC() do { if (resc) { asm volatile("s_waitcnt lgkmcnt(0)" ::: "memory"); \
      _Pragma("unroll") for (int d_ = 0; d_ < 2; ++d_) _Pragma("unroll") for (int r = 0; r < 16; ++r) o[d_][r] *= wsf[crow(r, hi)]; } } while (0)
    f32x16 pA0, pA1, pB0, pB1;
    int sl_prev = 0, sl_cur = 0, sl_next = SLOTB;
#define ROT() do { sl_prev = sl_cur; sl_cur = sl_next; sl_next = (sl_next == (NSLOT - 1) * SLOTB) ? 0 : sl_next + SLOTB; } while (0)
    DMA_K(2, 2 * SLOTB);
    if (qb > 0) { WAIT_BAR(0); } else { WAIT_BAR(3); }
    qkt(pA0, pA1, Kbase, qr, cini, r32, hi); asm volatile("s_nop 15\n\ts_nop 7" : "+v"(pA0), "+v"(pA1)); cmask(pA0, pA1, 0, qrel, hi);
    START(pA0, pA1);
    _Pragma("unroll") for (int r = 0; r < 16; ++r) pA1[r] = __builtin_amdgcn_exp2f(pA1[r]);
    WAIT_BAR(0);
    DMA_K(3, 0); DMA_V(1, SLOTB);
    ROT();
    kload8(kf, kp0 + sl_cur);
    WAIT_BAR(2);
    s16x4 vlo[8], vhi[8]; u32x4 pw0, pw1, pw2, pw3;
#define PKW(P, B) cvtpk_s(P[B], P[B + 1])
#define PAF(k) __builtin_bit_cast(bf16x8, pw##k)
#define VFR(i) (bf16x8){vlo[i][0], vlo[i][1], vlo[i][2], vlo[i][3], vhi[i][0], vhi[i][1], vhi[i][2], vhi[i][3]}
#define PIN(x) asm volatile("" : "+v"(x))
#define MX3(a, b, c) __builtin_fmaxf(__builtin_fmaxf((a), (b)), (c))
#define GAPA(MF, A0, A1, A2, A3, W0, W1, PW) do { MF; sacc += A0; sacc += A1; sacc += A2; sacc += A3; PIN(sacc); W0; W1; PIN(PW); SBAR(); } while (0)
#define EX(v) __builtin_amdgcn_exp2f(v)
#define GAPB(MF, X, B) do { MF; X[B] = EX(X[B]); X[B + 1] = EX(X[B + 1]); X[B + 2] = EX(X[B + 2]); X[B + 3] = EX(X[B + 3]); PIN(X); SBAR(); } while (0)
#define VRD(i) do { vlo[i] = vtr(vp_ + (((i) >> 2) * 4096 + ((i) & 3) * 1024)); vhi[i] = vtr(vp_ + (((i) >> 2) * 4096 + ((i) & 3) * 1024 + 512)); } while (0)
#define KRD(G, j) do { if (G) { kload2(kf, kp0 + sl_next, j); SBAR(); } } while (0)
#define STEP(C0, C1, P0, P1, t, GK, GV, GL, JB) do { SETC(t, JB); SBAR(); \
    const lds_cptr vp_ = vp0 + sl_prev; \
    VRD(0); SBAR(); float sacc = (P0[0] + P0[1]); \
    GAPA(C0 = __builtin_amdgcn_mfma_f32_32x32x16_bf16(kf[0], qr[0], cini, 0, 0, 0), P0[2], P0[3], P0[4], P0[5],     pw0[0] = PKW(P0, 0), pw0[1] = PKW(P0, 2), pw0); \
    VRD(4); SBAR(); GAPA(C1 = __builtin_amdgcn_mfma_f32_32x32x16_bf16(kf[1], qr[0], cini, 0, 0, 0), P0[6], P0[7], P0[8], P0[9],     pw0[2] = PKW(P0, 4), pw0[3] = PKW(P0, 6), pw0); \
    VRD(1); SBAR(); GAPA(C0 = __builtin_amdgcn_mfma_f32_32x32x16_bf16(kf[2], qr[1], C0, 0, 0, 0),   P0[10], P0[11], P0[12], P0[13], pw1[0] = PKW(P0, 8), pw1[1] = PKW(P0, 10), pw1); \
    VRD(5); SBAR(); GAPA(C1 = __builtin_amdgcn_mfma_f32_32x32x16_bf16(kf[3], qr[1], C1, 0, 0, 0),   P0[14], P0[15], P1[0], P1[1],   pw1[2] = PKW(P0, 12), pw1[3] = PKW(P0, 14), pw1); \
    VRD(2); SBAR(); GAPA(C0 = __builtin_amdgcn_mfma_f32_32x32x16_bf16(kf[4], qr[2], C0, 0, 0, 0),   P1[2], P1[3], P1[4], P1[5],     pw2[0] = PKW(P1, 0), pw2[1] = PKW(P1, 2), pw2); \
    VRD(6); SBAR(); GAPA(C1 = __builtin_amdgcn_mfma_f32_32x32x16_bf16(kf[5], qr[2], C1, 0, 0, 0),   P1[6], P1[7], P1[8], P1[9],     pw2[2] = PKW(P1, 4), pw2[3] = PKW(P1, 6), pw2); \
    VRD(3); SBAR(); GAPA(C0 = __builtin_amdgcn_mfma_f32_32x32x16_bf16(kf[6], qr[3], C0, 0, 0, 0),   P1[10], P1[11], P1[12], P1[13], pw3[0] = PKW(P1, 8), pw3[1] = PKW(P1, 10), pw3); \
    VRD(7); SBAR(); GAPA(C1 = __builtin_amdgcn_mfma_f32_32x32x16_bf16(kf[7], qr[3], C1, 0, 0, 0),   P1[14], P1[15], 0.f, 0.f,       pw3[2] = PKW(P1, 12), pw3[3] = PKW(P1, 14), pw3); \
    l_reg += sacc; \
    if (GK) { DMA_K((t) + 3, sl_cur); } if (GV) { DMA_V((t) + 1, sl_next); } \
    if (JB >= 0) cmask(C0, C1, JB, qrel, hi); \
    { float a = MX3(C0[0], C0[1], C1[0]), b_ = MX3(C0[2], C0[3], C1[1]); a = MX3(a, C1[2], C1[3]); \
      _Pragma("unroll") for (int r = 4; r < 16; r += 4) { a = MX3(a, C0[r], C0[r + 1]); b_ = MX3(b_, C0[r + 2], C0[r + 3]); a = MX3(a, C1[r], C1[r + 1]); b_ = MX3(b_, C1[r + 2], C1[r + 3]); } \
      float rm = __builtin_fmaxf(a, b_); { auto rr = __builtin_amdgcn_permlane32_swap(__float_as_uint(rm), __float_as_uint(rm), false, false); rm = __builtin_fmaxf(__uint_as_float(rr[0]), __uint_as_float(rr[1])); } \
      resc = false; \
      if (__builtin_expect(__any(rm > (float)THRL), 0)) { const float dl = __builtin_fmaxf(rm, 0.f); mhat += dl; \
        _Pragma("unroll") for (int r = 0; r < 16; ++r) { C0[r] -= dl; C1[r] -= dl; } \
        const float f = __builtin_amdgcn_exp2f(-dl); l_reg *= f; if (hi == 0) wsf[r32] = f; resc = true; } } \
    SBAR(); \
    GAPB(o[0] = __builtin_amdgcn_mfma_f32_32x32x16_bf16(PAF(0), VFR(0), o[0], 0, 0, 0), C0, 0); \
    GAPB(o[1] = __builtin_amdgcn_mfma_f32_32x32x16_bf16(PAF(0), VFR(4), o[1], 0, 0, 0), C0, 4); \
    KRD(GL, 0); GAPB(o[0] = __builtin_amdgcn_mfma_f32_32x32x16_bf16(PAF(1), VFR(1), o[0], 0, 0, 0), C0, 8); \
    KRD(GL, 1); GAPB(o[1] = __builtin_amdgcn_mfma_f32_32x32x16_bf16(PAF(1), VFR(5), o[1], 0, 0, 0), C0, 12); \
    KRD(GL, 2); GAPB(o[0] = __builtin_amdgcn_mfma_f32_32x32x16_bf16(PAF(2), VFR(2), o[0], 0, 0, 0), C1, 0); \
    KRD(GL, 3); GAPB(o[1] = __builtin_amdgcn_mfma_f32_32x32x16_bf16(PAF(2), VFR(6), o[1], 0, 0, 0), C1, 4); \
    GAPB(o[0] = __builtin_amdgcn_mfma_f32_32x32x16_bf16(PAF(3), VFR(3), o[0], 0, 0, 0), C1, 8); \
    GAPB(o[1] = __builtin_amdgcn_mfma_f32_32x32x16_bf16(PAF(3), VFR(7), o[1], 0, 0, 0), C1, 12); \
    } while (0)
#define ENDW(tt) do { if ((tt) + 3 < NT) { WAIT_BAR(2); } else if ((tt) + 2 < NT) { WAIT_BAR(1); } else { WAIT_BAR(0); } } while (0)
    STEP(pB0, pB1, pA0, pA1, 1, (4 < NT), true, true, 1);   ENDW(1); RESC(); ROT();
    STEP(pA0, pA1, pB0, pB1, 2, (5 < NT), true, true, 2);   ENDW(2); RESC(); ROT();
    STEP(pB0, pB1, pA0, pA1, 3, (6 < NT), (4 < NT), (4 < NT), 3);   ENDW(3); RESC(); ROT();
    int t = 4;
    for (; t + 4 < NT; t += 2) {
        STEP(pA0, pA1, pB0, pB1, t, true, true, true, -1);       WAIT_BAR(2); RESC(); ROT();
        STEP(pB0, pB1, pA0, pA1, t + 1, true, true, true, -1);   WAIT_BAR(2); RESC(); ROT();
    }
    for (; t < NT; t += 2) {
        STEP(pA0, pA1, pB0, pB1, t, (t + 3 < NT), true, true, -1);                       ENDW(t);     RESC(); ROT();
        STEP(pB0, pB1, pA0, pA1, t + 1, (t + 4 < NT), (t + 2 < NT), (t + 2 < NT), -1);   ENDW(t + 1); RESC(); ROT();
    }
    { float sacc = pB0[0] + pB0[1]; _Pragma("unroll") for (int r = 2; r < 16; ++r) sacc += pB0[r]; _Pragma("unroll") for (int r = 0; r < 16; ++r) sacc += pB1[r]; l_reg += sacc;
      pw0 = (u32x4){PKW(pB0, 0), PKW(pB0, 2), PKW(pB0, 4), PKW(pB0, 6)}; pw1 = (u32x4){PKW(pB0, 8), PKW(pB0, 10), PKW(pB0, 12), PKW(pB0, 14)}; pw2 = (u32x4){PKW(pB1, 0), PKW(pB1, 2), PKW(pB1, 4), PKW(pB1, 6)}; pw3 = (u32x4){PKW(pB1, 8), PKW(pB1, 10), PKW(pB1, 12), PKW(pB1, 14)};
      SBAR(); pv(o, (int)(unsigned long)vp0 + sl_prev, PAF(0), PAF(1), PAF(2), PAF(3)); }
#undef PKW
#undef PAF
#undef VFR
#undef PIN
#undef MX3
#undef GAPA
#undef GAPB
#undef EX
#undef VRD
#undef KRD
#undef STEP
#undef ENDW
    { auto rr = __builtin_amdgcn_permlane32_swap(__float_as_uint(l_reg), __float_as_uint(l_reg), false, false); l_reg = __uint_as_float(rr[0]) + __uint_as_float(rr[1]); }
    if (hi == 0) wsf[32 + r32] = l_reg; asm volatile("s_waitcnt lgkmcnt(0)" ::: "memory");
    float rli[16];
#pragma unroll
    for (int r = 0; r < 16; ++r) rli[r] = __builtin_amdgcn_rcpf(wsf[32 + crow(r, hi)]);
    bf16_t* Ow = Og + (rowbase + q0 + wid * QBLK) * DMO + h * HD;
    { bf16_t* stg = (bf16_t*)(shm + LDS_OST) + wid * 2048;
#pragma unroll
      for (int r = 0; r < 16; ++r) { const int orow = crow(r, hi);
#pragma unroll
        for (int d0 = 0; d0 < 2; ++d0) stg[orow * 64 + d0 * 32 + r32] = (bf16_t)f2bf(o[d0][r] * rli[r]); }
      asm volatile("s_waitcnt lgkmcnt(0)" ::: "memory");
#pragma unroll
      for (int i = 0; i < 4; ++i) { const int row = i * 8 + (lane >> 3), ch = lane & 7; const u32x4 v = *(const u32x4*)(stg + row * 64 + ch * 8); *(u32x4*)(Ow + (long)row * DMO + ch * 8) = v; } }
    asm volatile("s_waitcnt lgkmcnt(0)\n\ts_barrier" ::: "memory");
#undef DMA_K
#undef DMA_V
#undef TMAP
#undef SETC
#undef START
#undef RESC
#undef ROT
}
#undef SBAR
#undef WAIT_BAR
}

namespace hgrn {
constexpr int RS = 144;
constexpr int R_FQV = 0, FQV_SLOT = 32768;
constexpr int L_Q = 98304, L_K = L_Q + 9216, L_KT = L_K + 9216, L_VT = L_KT + 9216, L_ST = L_VT + 9216, L_SEG = L_ST + 9216, L_DEND = L_SEG + 2048, L_SSQ = L_DEND + 256, L_BYTES = L_SSQ + 512;
__device__ __forceinline__ int crow(int r, int hi) { return (r & 3) + 8 * (r >> 2) + 4 * hi; }
__device__ __forceinline__ void glds16(const void* gsrc, unsigned lds_dst) { unsigned keep;
    asm volatile("s_mov_b32 %0, m0\n\ts_mov_b32 m0, %2\n\ts_nop 0\n\tglobal_load_lds_dwordx4 %1, off\n\ts_mov_b32 m0, %0" : "=&s"(keep) : "v"(gsrc), "s"(lds_dst) : "memory"); }
#define HG_BAR() do { asm volatile("s_waitcnt lgkmcnt(0)" ::: "memory"); __builtin_amdgcn_s_barrier(); asm volatile("" ::: "memory"); } while (0)
#ifndef HG_ABL
#define HG_ABL 0
#endif
__device__ __forceinline__ void hgrn_unit(int b, int h, const bf16_t* __restrict__ proj, bf16_t* __restrict__ mix, const float* __restrict__ lb_logits, const float* __restrict__ norm_g, LAS unsigned char* lds, const int abl = 0) {
    int tid_ = threadIdx.x; asm volatile("" : "+v"(tid_));
    const int tid = tid_, lane = tid & 63, r32 = lane & 31, hi = lane >> 5; const int w = __builtin_amdgcn_readfirstlane(tid >> 6);
    const float lbk = fast_rcp(1.0f + fast_exp2((lb_logits[512 + h * 64 + lane] - lb_logits[h * 64 + lane]) * LOG2E));
    const int vr = (w >> 1) & 1, tc = w & 1;
    float ng[16];
#pragma unroll
    for (int r = 0; r < 16; ++r) ng[r] = norm_g[h * 64 + 32 * vr + crow(r, hi)];
    f32x16 S = f32x16{};
    for (int i = tid; i < 64 * RS / 4; i += 512) ((LAS unsigned*)(lds + L_ST))[i] = 0u;
    const size_t hoff = (size_t)(b * 8 + h) * (SEQ * 64) + (size_t)w * 512 + lane * 8;
    const bf16_t* gQ = proj + 3 * SEC_ELEMS + hoff; const bf16_t* gF = proj + 4 * SEC_ELEMS + hoff; const bf16_t* gV = proj + 5 * SEC_ELEMS + hoff; const bf16_t* gG = proj + 6 * SEC_ELEMS + hoff;
    const unsigned lds0 = (unsigned)(uintptr_t)(unsigned char*)lds;
#define DMA_FQV(c_) do { const int cc_ = (c_) < 63 ? (c_) : 63; const unsigned d_ = (unsigned)__builtin_amdgcn_readfirstlane(lds0 + R_FQV + (unsigned)(((c_) % 3) * FQV_SLOT) + (unsigned)w * 1024u); \
        glds16(gF + (size_t)cc_ * 4096, d_); glds16(gQ + (size_t)cc_ * 4096, d_ + 8192u); glds16(gV + (size_t)cc_ * 4096, d_ + 16384u); } while (0)
#define DMA_G(c_) do { const int cc_ = (c_) < 63 ? (c_) : 63; glds16(gG + (size_t)cc_ * 4096, (unsigned)__builtin_amdgcn_readfirstlane(lds0 + R_FQV + (unsigned)(((c_) % 3) * FQV_SLOT) + 24576u + (unsigned)w * 1024u)); } while (0)
    DMA_FQV(0); DMA_G(0); DMA_FQV(1); DMA_G(1); DMA_FQV(2);
    for (int c = 0; c < 64; ++c) {
        const size_t row0 = (size_t)b * SEQ + (size_t)c * 64;
        if (abl & 8) {} else if (w < 4 && c >= 3) asm volatile("s_waitcnt vmcnt(20)" ::: "memory");
        else asm volatile("s_waitcnt vmcnt(8)" ::: "memory");
        const LAS unsigned char* raw = lds + R_FQV + (c % 3) * FQV_SLOT + (8 * w) * 128 + lane * 2;
        float p[8], kk[8];
        { float run = 0.f;
#pragma unroll
          for (int i = 0; i < 8; ++i) { const float x = bf2f(*(const LAS unsigned short*)(raw + i * 128)); float f, lg;
              if (abl & 2) { f = 0.5f + 0.001f * x; lg = -1.0f + 0.001f * x; } else { const float sg = fast_rcp(1.0f + fast_exp2(-x * LOG2E)); f = lbk + (1.0f - lbk) * sg; lg = __builtin_amdgcn_logf(f); }
              run += lg; p[i] = run; kk[i] = 1.0f - f; } }
        ((LAS float*)(lds + L_SEG))[w * 64 + lane] = p[7];
        HG_BAR();
        if (!(abl & 8)) DMA_G(c + 2);
        { float off = 0.f;
#pragma unroll
          for (int j = 0; j < 7; ++j) { const float sv = ((LAS float*)(lds + L_SEG))[j * 64 + lane]; off += (j < w) ? sv : 0.f; }
          unsigned kq[4], vq[4];
#pragma unroll
          for (int i = 0; i < 8; i += 2) { const float b0 = off + p[i], b1 = off + p[i + 1];
              const unsigned short q0r = *(const LAS unsigned short*)(raw + 8192 + i * 128), q1r = *(const LAS unsigned short*)(raw + 8192 + (i + 1) * 128);
              const unsigned short v0r = *(const LAS unsigned short*)(raw + 16384 + i * 128), v1r = *(const LAS unsigned short*)(raw + 16384 + (i + 1) * 128);
              const float q0 = bf2f(q0r) * fast_exp2(b0), q1 = bf2f(q1r) * fast_exp2(b1), k0 = kk[i] * fast_exp2(-b0), k1 = kk[i + 1] * fast_exp2(-b1);
              const unsigned qq = cvtpk(q0, q1), kw = cvtpk(k0, k1); kq[i >> 1] = kw; vq[i >> 1] = (unsigned)v0r | ((unsigned)v1r << 16);
              if (abl & 4) continue;
              *(LAS unsigned short*)(lds + L_Q + (8 * w + i) * RS + lane * 2) = (unsigned short)(qq & 0xffffu);
              *(LAS unsigned short*)(lds + L_Q + (8 * w + i + 1) * RS + lane * 2) = (unsigned short)(qq >> 16);
              *(LAS unsigned short*)(lds + L_K + (8 * w + i) * RS + lane * 2) = (unsigned short)(kw & 0xffffu);
              *(LAS unsigned short*)(lds + L_K + (8 * w + i + 1) * RS + lane * 2) = (unsigned short)(kw >> 16); }
          *(LAS u32x4*)(lds + L_KT + lane * RS + 16 * w) = (u32x4){kq[0], kq[1], kq[2], kq[3]};
          *(LAS u32x4*)(lds + L_VT + lane * RS + 16 * w) = (u32x4){vq[0], vq[1], vq[2], vq[3]};
          if (w == 7) ((LAS float*)(lds + L_DEND))[lane] = fast_exp2(off + p[7]); }
        if (!(abl & 8)) DMA_FQV(c + 3);
        if (abl & 8) {} else if (w < 4 && c >= 2) asm volatile("s_waitcnt vmcnt(19)" ::: "memory");
        else asm volatile("s_waitcnt vmcnt(11)" ::: "memory");
        HG_BAR();
        f32x16 OT = f32x16{};
        if (abl & 1) { OT[0] = (float)c; } else
        if (w < 4) {
            bf16x8 bq[4];
#pragma unroll
            for (int ks = 0; ks < 4; ++ks) bq[ks] = *(const LAS bf16x8*)(lds + L_Q + (32 * tc + r32) * RS + (16 * ks + 8 * hi) * 2);
#pragma unroll
            for (int sr = 0; sr < 2; ++sr) if (sr <= tc) {
                f32x16 at = f32x16{};
#pragma unroll
                for (int ks = 0; ks < 4; ++ks) { const bf16x8 a = *(const LAS bf16x8*)(lds + L_K + (32 * sr + r32) * RS + (16 * ks + 8 * hi) * 2); at = __builtin_amdgcn_mfma_f32_32x32x16_bf16(a, bq[ks], at, 0, 0, 0); }
                if (sr == tc) {
#pragma unroll
                    for (int r = 0; r < 16; ++r) at[r] = (crow(r, hi) <= r32) ? at[r] : 0.f; }
#pragma unroll
                for (int st = 0; st < 2; ++st) {
                    u32x4 bw; bw.x = cvtpk(at[8 * st + 0], at[8 * st + 1]); bw.y = cvtpk(at[8 * st + 2], at[8 * st + 3]); bw.z = cvtpk(at[8 * st + 4], at[8 * st + 5]); bw.w = cvtpk(at[8 * st + 6], at[8 * st + 7]);
                    const u32x2 lo = *(const LAS u32x2*)(lds + L_VT + (32 * vr + r32) * RS + (32 * sr + 16 * st + 4 * hi) * 2);
                    const u32x2 hh = *(const LAS u32x2*)(lds + L_VT + (32 * vr + r32) * RS + (32 * sr + 16 * st + 8 + 4 * hi) * 2);
                    const u32x4 aw = (u32x4){lo.x, lo.y, hh.x, hh.y};
                    OT = __builtin_amdgcn_mfma_f32_32x32x16_bf16(__builtin_bit_cast(bf16x8, aw), __builtin_bit_cast(bf16x8, bw), OT, 0, 0, 0); }
            }
#pragma unroll
            for (int ks = 0; ks < 4; ++ks) { const bf16x8 a = *(const LAS bf16x8*)(lds + L_ST + (32 * vr + r32) * RS + (16 * ks + 8 * hi) * 2); OT = __builtin_amdgcn_mfma_f32_32x32x16_bf16(a, bq[ks], OT, 0, 0, 0); }
            float sq = 0.f;
#pragma unroll
            for (int r = 0; r < 16; ++r) sq += OT[r] * OT[r];
            sq += __shfl_xor(sq, 32);
            if (hi == 0) ((LAS float*)(lds + L_SSQ))[vr * 64 + 32 * tc + r32] = sq;
        } else {
#pragma unroll
            for (int st = 0; st < 4; ++st) { const bf16x8 a = *(const LAS bf16x8*)(lds + L_KT + (32 * vr + r32) * RS + (16 * st + 8 * hi) * 2);
                const bf16x8 bv = *(const LAS bf16x8*)(lds + L_VT + (32 * tc + r32) * RS + (16 * st + 8 * hi) * 2);
                S = __builtin_amdgcn_mfma_f32_32x32x16_bf16(a, bv, S, 0, 0, 0); }
#pragma unroll
            for (int r = 0; r < 16; ++r) S[r] *= ((LAS float*)(lds + L_DEND))[32 * vr + crow(r, hi)];
        }
        HG_BAR();
        if (w < 4) {
            const int t = 32 * tc + r32;
            const float tot = ((LAS float*)(lds + L_SSQ))[t] + ((LAS float*)(lds + L_SSQ))[64 + t];
            const float rstd = __builtin_amdgcn_rsqf(tot * (1.0f / 64.0f) + EPS);
            const LAS unsigned char* gp = lds + R_FQV + (c % 3) * FQV_SLOT + 24576 + t * 128 + (32 * vr + 4 * hi) * 2;
            bf16_t* op = mix + (row0 + t) * D + 512 + h * 64 + 32 * vr + 4 * hi;
#pragma unroll
            for (int g = 0; g < 4; ++g) { const u32x2 gg = *(const LAS u32x2*)(gp + 16 * g);
                const float y0 = OT[4 * g + 0] * rstd * ng[4 * g + 0] * bflo(gg.x), y1 = OT[4 * g + 1] * rstd * ng[4 * g + 1] * bfhi(gg.x),
                            y2 = OT[4 * g + 2] * rstd * ng[4 * g + 2] * bflo(gg.y), y3 = OT[4 * g + 3] * rstd * ng[4 * g + 3] * bfhi(gg.y);
                const u32x2 yv = (u32x2){cvtpk(y0, y1), cvtpk(y2, y3)}; if (!(abl & 16)) asm volatile("global_store_dwordx2 %0, %1, off" :: "v"(op + 8 * g), "v"(yv) : "memory"); }
        } else {
#pragma unroll
            for (int g = 0; g < 4; ++g) *(LAS u32x2*)(lds + L_ST + (32 * tc + r32) * RS + (32 * vr + 8 * g + 4 * hi) * 2) = (u32x2){cvtpk(S[4 * g + 0], S[4 * g + 1]), cvtpk(S[4 * g + 2], S[4 * g + 3])};
        }
    }
    asm volatile("s_waitcnt vmcnt(0)" ::: "memory");
    HG_BAR();
#undef DMA_FQV
#undef DMA_G
}
#undef HG_BAR
}

constexpr int NWAVES = 8;
constexpr int LDS_BYTES = 163840;
constexpr int TAIL = 161792;
constexpr int TL_TE = TAIL, TL_TS = TAIL + 576, TL_HIST = TAIL + 768, TL_BASE = TAIL + 896, TL_MISC = TAIL + 1024, TL_CNT = TAIL + 1280;
typedef GAS unsigned gu32;

struct Args { const float* in[20]; float* out; unsigned char* ws; int ph_lo, ph_hi; };

struct Frame {
    LAS unsigned char* lds; volatile LAS unsigned* MISC; unsigned* ctl;
    int tid, lane, wave, G, vcu;
};

struct P0Item { const float* W; bf16_t* WT; const float* gain; int N, K, k0, n0, mode; };
constexpr int P0_I_IN = 16 * 56, P0_I_SQ = 16 * 16, P0_I_KV = 16 * 32, P0_I_W1 = 16 * 32, P0_I_W2 = 16 * 16;
constexpr int P0_I_IN8 = 16 * 24;
constexpr int P0_NA = P0_I_IN + P0_I_KV + P0_I_IN8, P0_NB = 2 * P0_I_SQ + NEXP * (P0_I_W1 + P0_I_W2);
template <int SET> __device__ __forceinline__ bool p0_decode(const Args& a, int it, P0Item& I) {
    unsigned char* ws = a.ws;
    if (it >= (SET == 0 ? P0_NA : P0_NB)) return false;
    int r = it; I.gain = nullptr; I.mode = 0; I.K = D;
    if (SET == 0) {
        if (r < P0_I_IN) { I.W = a.in[3]; I.WT = (bf16_t*)(ws + WS_WIN); I.N = INC; }
        else if ((r -= P0_I_IN) < P0_I_KV) { I.W = a.in[10]; I.WT = (bf16_t*)(ws + WS_WKV); I.N = 2 * D; }
        else { r -= P0_I_KV; I.W = a.in[3]; I.WT = (bf16_t*)(ws + WS_WIN8); I.N = INC; I.mode = 2; const int nblk8 = 24; I.k0 = 64 * (r / nblk8); I.n0 = 64 * (r % nblk8); return true; }
    } else {
        if (r < P0_I_SQ) { I.W = a.in[6]; I.WT = (bf16_t*)(ws + WS_WOUT); I.N = D; }
        else if ((r -= P0_I_SQ) < P0_I_SQ) { I.W = a.in[11]; I.WT = (bf16_t*)(ws + WS_WO); I.N = D; }
        else if ((r -= P0_I_SQ) < NEXP * P0_I_W1) { const int e = r / P0_I_W1; r -= e * P0_I_W1; I.W = a.in[15] + (size_t)e * D * 2048; I.WT = (bf16_t*)(ws + WS_W1 + (size_t)e * 2048 * D); I.N = 2048; I.gain = a.in[12]; I.mode = 3; }
        else { r -= NEXP * P0_I_W1; const int e = r / P0_I_W2; r -= e * P0_I_W2; I.W = a.in[17] + (size_t)e * D * D; I.WT = (bf16_t*)(ws + WS_W2 + (size_t)e * D * D); I.N = D; I.mode = 2; }
    }
    const int nblk = I.N / 64; I.k0 = 64 * (r / nblk); I.n0 = 64 * (r % nblk); return true;
}
template <int SET> __device__ __forceinline__ void p0_run(const Args& a, int first, int stride, int count, LAS unsigned char* tl, int lane);
__device__ __forceinline__ void p0_load(const P0Item& I, f32x4 (&v)[16], f32x4 (&g)[4], int lane) {
    const float* base = I.W + (size_t)I.k0 * I.N + I.n0;
    const unsigned vo = (unsigned)((lane >> 4) * I.N + 4 * (lane & 15)) * 4u, rs = (unsigned)(4 * I.N) * 4u;
#pragma unroll
    for (int j = 0; j < 16; ++j) v[j] = pg8::gload128_hidden_nt(base, vo + rs * (unsigned)j);
    const float* gb = I.gain ? I.gain + I.k0 : base; const unsigned go = (unsigned)(lane >> 4) * 4u;
#pragma unroll
    for (int q = 0; q < 4; ++q) { g[q][0] = __uint_as_float(pg8::gload32_hidden(gb, go + (unsigned)(16 * q) * 4u)); g[q][1] = __uint_as_float(pg8::gload32_hidden(gb, go + (unsigned)(16 * q + 4) * 4u));
                                  g[q][2] = __uint_as_float(pg8::gload32_hidden(gb, go + (unsigned)(16 * q + 8) * 4u)); g[q][3] = __uint_as_float(pg8::gload32_hidden(gb, go + (unsigned)(16 * q + 12) * 4u)); }
}
constexpr int P0_LOADS = 32;
__device__ __forceinline__ void p0_store(const P0Item& I, const f32x4 (&v)[16], const f32x4 (&gq)[4], LAS unsigned char* tl, int lane) {
    const int kr = lane >> 4, nq = lane & 15;
#pragma unroll
    for (int j = 0; j < 16; ++j) { const int k = 4 * j + kr; const float g = I.gain ? gq[j >> 2][j & 3] : 1.0f;
        *(LAS u32x2*)(tl + k * 128 + (((nq >> 1) ^ ((k >> 3) & 7)) * 16) + (nq & 1) * 8) = (u32x2){pk2(v[j].x * g, v[j].y * g), pk2(v[j].z * g, v[j].w * g)}; }
    LDS_WAIT(); asm volatile("" ::: "memory");
    const int c = lane & 7;
#pragma unroll
    for (int i = 0; i < 8; ++i) { const int n = (lane >> 3) + 8 * i; const LAS unsigned char* sp = tl + (8 * c) * 128 + ((i ^ c) * 16) + (n & 7) * 2;
        unsigned short e[8];
#pragma unroll
        for (int q = 0; q < 8; ++q) e[q] = *(const LAS unsigned short*)(sp + q * 128);
        int row = I.n0 + n; if (I.mode & 1) { const int jj = row >> 1, bj = row & 1; row = (jj >> 7) * 256 + bj * 128 + (jj & 127); }
        if (I.mode & 2) *(u32x2*)((unsigned char*)I.WT + (size_t)row * I.K + I.k0 + 8 * c) = (u32x2){pk4_fp8(bf2f(e[0]) * WSCALE8, bf2f(e[1]) * WSCALE8, bf2f(e[2]) * WSCALE8, bf2f(e[3]) * WSCALE8), pk4_fp8(bf2f(e[4]) * WSCALE8, bf2f(e[5]) * WSCALE8, bf2f(e[6]) * WSCALE8, bf2f(e[7]) * WSCALE8)};
        else *(u32x4*)(I.WT + (size_t)row * I.K + I.k0 + 8 * c) = (u32x4){(unsigned)e[0] | ((unsigned)e[1] << 16), (unsigned)e[2] | ((unsigned)e[3] << 16), (unsigned)e[4] | ((unsigned)e[5] << 16), (unsigned)e[6] | ((unsigned)e[7] << 16)}; }
    LDS_WAIT(); asm volatile("" ::: "memory");
}
__device__ __forceinline__ void rms_rows2_to_bf16(const float* __restrict__ x0, const float* __restrict__ x1, const float* __restrict__ g, bf16_t* __restrict__ o0, bf16_t* __restrict__ o1, int lane, unsigned char* q0 = nullptr, unsigned char* q1 = nullptr) {
    const f32x4* xa = (const f32x4*)x0 + lane; const f32x4* xb = (const f32x4*)x1 + lane; const f32x4* gr = (const f32x4*)g + lane;
    f32x4 va[4], vb[4]; float sa = 0.f, sb = 0.f;
#pragma unroll
    for (int j = 0; j < 4; ++j) { va[j] = xa[64 * j]; vb[j] = xb[64 * j]; }
#pragma unroll
    for (int j = 0; j < 4; ++j) { sa += (va[j].x * va[j].x + va[j].y * va[j].y) + (va[j].z * va[j].z + va[j].w * va[j].w); sb += (vb[j].x * vb[j].x + vb[j].y * vb[j].y) + (vb[j].z * vb[j].z + vb[j].w * vb[j].w); }
    const float ra = 1.0f / sqrtf(wave_sum(sa) * (1.0f / D) + EPS), rb = 1.0f / sqrtf(wave_sum(sb) * (1.0f / D) + EPS);
    unsigned long long* pa = (unsigned long long*)o0 + lane; unsigned long long* pb = (unsigned long long*)o1 + lane;
#pragma unroll
    for (int j = 0; j < 4; ++j) { const f32x4 gg = gr[64 * j];
        if (q0) { ((unsigned*)q0)[lane + 64 * j] = pk4_fp8(va[j].x * ra * gg.x, va[j].y * ra * gg.y, va[j].z * ra * gg.z, va[j].w * ra * gg.w);
                  ((unsigned*)q1)[lane + 64 * j] = pk4_fp8(vb[j].x * rb * gg.x, vb[j].y * rb * gg.y, vb[j].z * rb * gg.z, vb[j].w * rb * gg.w); }
        pa[64 * j] = (unsigned long long)pk2(va[j].x * ra * gg.x, va[j].y * ra * gg.y) | ((unsigned long long)pk2(va[j].z * ra * gg.z, va[j].w * ra * gg.w) << 32);
        pb[64 * j] = (unsigned long long)pk2(vb[j].x * rb * gg.x, vb[j].y * rb * gg.y) | ((unsigned long long)pk2(vb[j].z * rb * gg.z, vb[j].w * rb * gg.w) << 32); }
}

__device__ __forceinline__ void p0_prologue(Frame& F, const Args& a) {
    unsigned char* ws = a.ws;
    LAS unsigned char* tl = F.lds + F.wave * 8192;
    const int gw = F.vcu * NWAVES + F.wave, NGW = F.G * NWAVES;
    for (int m = 2 * gw; m < T; m += 2 * NGW) rms_rows2_to_bf16(a.in[0] + (size_t)m * D, a.in[0] + (size_t)(m + 1) * D, a.in[2], (bf16_t*)(ws + WS_XN) + (size_t)m * D, (bf16_t*)(ws + WS_XN) + (size_t)(m + 1) * D, F.lane, ws + WS_XN8 + (size_t)m * D, ws + WS_XN8 + (size_t)(m + 1) * D);
    for (int m = 2 * gw; m < MROWS; m += 2 * NGW) rms_rows2_to_bf16(a.in[1] + (size_t)m * D, a.in[1] + (size_t)(m + 1) * D, a.in[8], (bf16_t*)(ws + WS_MN) + (size_t)m * D, (bf16_t*)(ws + WS_MN) + (size_t)(m + 1) * D, F.lane);
    for (int i = gw * 64 + F.lane; i < D * D / 4; i += NGW * 64) { const f32x4 w = ((const f32x4*)a.in[9])[i]; const float g = a.in[7][i >> 8];
        ((u32x2*)(ws + WS_WQ))[i] = (u32x2){pk2(w.x * g, w.y * g), pk2(w.z * g, w.w * g)}; }
    for (int i = gw * 64 + F.lane; i < NEXP * D; i += NGW * 64) { const int e = i >> 10, k = i & 1023; const float w = a.in[12][k] * a.in[13][k * NEXP + e];
        const unsigned hi = f2bf(w); ((bf16_t*)(ws + WS_WRT))[i] = (bf16_t)hi; ((bf16_t*)(ws + WS_WRT))[NEXP * D + i] = (bf16_t)f2bf(w - bf2f((unsigned short)hi)); }
    p0_run<0>(a, gw, NGW, (P0_NA - gw + NGW - 1) / NGW, tl, F.lane);
}
#define P0_PIN(vv, gg) do { _Pragma("unroll") for (int j_ = 0; j_ < 16; ++j_) asm volatile("" : "+v"(vv[j_])); _Pragma("unroll") for (int q_ = 0; q_ < 4; ++q_) asm volatile("" : "+v"(gg[q_])); } while (0)
template <int SET> __device__ __forceinline__ void p0_run(const Args& a, int first, int stride, int count, LAS unsigned char* tl, int lane_in) {
    int lane = lane_in; asm volatile("" : "+v"(lane));
    P0Item IA, IB; f32x4 va[16], vb[16], ga[4], gb[4];
    int it = first, left = count; bool ha = left > 0 && p0_decode<SET>(a, it, IA); if (ha) p0_load(IA, va, ga, lane);
    while (ha) {
        const bool hb = left > 1 && p0_decode<SET>(a, it + stride, IB); if (hb) p0_load(IB, vb, gb, lane);
        if (hb) asm volatile("s_waitcnt vmcnt(32)" ::: "memory"); else asm volatile("s_waitcnt vmcnt(0)" ::: "memory");
        P0_PIN(va, ga);
        p0_store(IA, va, ga, tl, lane);
        if (!hb) break;
        it += 2 * stride; left -= 2; ha = left > 0 && p0_decode<SET>(a, it, IA); if (ha) p0_load(IA, va, ga, lane);
        if (ha) asm volatile("s_waitcnt vmcnt(32)" ::: "memory"); else asm volatile("s_waitcnt vmcnt(0)" ::: "memory");
        P0_PIN(vb, gb);
        p0_store(IB, vb, gb, tl, lane);
    }
}
#undef P0_PIN

__device__ __forceinline__ unsigned xcc_id() { return (unsigned)__builtin_amdgcn_s_getreg((3 << 11) | 20) & 0xFu; }
constexpr int QITEMS = 16 + 177;
constexpr int CONV_PER_Q = 49, CONV_TILES = 64;
static_assert(8 * CONV_PER_Q * CONV_TILES == P0_NB, "conversion items cover SET 1 exactly");
__device__ __forceinline__ void p2_mixer(Frame& F, const Args& a, int rep) {
    unsigned char* ws = a.ws;
    const bf16_t* proj = (const bf16_t*)(ws + WS_PROJ); bf16_t* mix = (bf16_t*)(ws + WS_MIX);
    const unsigned x0 = xcc_id() & 7u;
    int par = 0;
#ifdef MK_P2_REPMODE
    if (rep && MK_P2_REPMODE == 4) return;
#endif
#ifdef MK_P2_HALF
    if (rep && (blockIdx.x & 8)) return;
#endif
    for (;;) {
        if (F.tid == 0) { int code = -1;
            for (int j = 0; j < 8; ++j) { const unsigned xq = (x0 + j) & 7u; const unsigned i = __hip_atomic_fetch_add(F.ctl + CW_QUEUE + 1024 * rep + 64 * xq, 1u, RLX_AGENT);
                if (i < (unsigned)QITEMS) { code = (int)(xq * 256u + i); break; } }
            F.MISC[par] = (unsigned)code; }
        LDS_WAIT(); __builtin_amdgcn_s_barrier(); asm volatile("" ::: "memory");
        const int code = __builtin_amdgcn_readfirstlane((int)F.MISC[par]); par ^= 1;
        if (code < 0) break;
        const int xq = code >> 8, i = code & 255;
#ifdef MK_P2_REPMODE
        if (rep && ((MK_P2_REPMODE == 1 && i >= 8) || (MK_P2_REPMODE == 2 && i < 16) || MK_P2_REPMODE == 3)) continue;
        if (rep && MK_P2_REPMODE == 5) { const int jq_ = i - 16; const bool isconv = i >= 16 && jq_ < 2 * CONV_PER_Q && (jq_ & 1); if (!isconv) continue; }
#endif
#ifndef NO_HGRN
        if (i < 8) { hgrn::hgrn_unit(xq, i, proj, rep ? (bf16_t*)(ws + WS_H2F) : mix, a.in[4], a.in[5], F.lds, rep ? HG_ABL : 0); }
        else
#endif
        if (i < 16) {
            pg8::KvOrder S{(const char*)(ws + WS_MN), (const char*)(ws + WS_WKV), xq * 8 + (i - 8)};
            pg8::EpiBf16 E{(bf16_t*)(ws + WS_MEMK), D, (bf16_t*)(ws + WS_MEMVT), D};
            pg8::gemm_phase<pg8::EpiBf16, pg8::KvOrder, false, false>(F.lds, D, D, D / 64, S, E);
        } else
        {
        const int jq = i - 16; int mi = -1, cv = -1;
        if (jq < 2 * CONV_PER_Q) { if (jq & 1) cv = jq >> 1; else mi = jq >> 1; } else mi = jq - CONV_PER_Q;
        if (cv >= 0) {
            const int J = xq * CONV_PER_Q + cv;
            p0_run<1>(a, J * CONV_TILES + F.wave * 8, 1, 8, F.lds + F.wave * 8192, F.lane);
            LDS_WAIT(); VM_WAIT(); __builtin_amdgcn_s_barrier(); asm volatile("" ::: "memory");
        } else
#ifndef NO_MOBA
        { const int j = mi, g = j >> 5, jj = j & 31, hh = 2 * g + (jj & 1), qb = 15 - (jj >> 1);
            moba::attn_unit<8>(xq, hh, qb, proj, proj + SEC_ELEMS, proj + 2 * SEC_ELEMS, mix, (const float*)(ws + WS_KBAR), (char*)(unsigned char*)F.lds); }
#else
        {}
#endif
        }
    }
}

__device__ __forceinline__ void p7_router(Frame& F, const Args& a, int rep) {
    unsigned char* ws = a.ws;
    constexpr int WRS = 2064;
    LAS unsigned char* WH = F.lds; LAS unsigned char* WL = F.lds + 32 * WRS;
    LAS int* hist = (LAS int*)(F.lds + TL_HIST); LAS int* basel = (LAS int*)(F.lds + TL_BASE);
    { const u32x4* src = (const u32x4*)(ws + WS_WRT);
      for (int i = F.tid; i < 2 * NEXP * D / 8; i += 512) { const int m = i >> 12, r = (i >> 7) & 31, c = i & 127; *(LAS u32x4*)(F.lds + m * 32 * WRS + r * WRS + c * 16) = src[i]; } }
    const float* h2f = (const float*)(ws + WS_H2F); const float* ss2 = (const float*)(ws + WS_SS2);
    int* toke = (int*)(ws + (rep ? WS_DUMMY + 1 * MiB : WS_TOKE)); int* tokr = (int*)(ws + (rep ? WS_DUMMY + 1 * MiB + 512 * 1024 : WS_TOKR)); float* tokg = (float*)(ws + (rep ? WS_DUMMY + 2 * MiB : WS_TOKG)); int* list = (int*)(ws + (rep ? WS_DUMMY + 4 * MiB : WS_LIST)); float* glist = (float*)(ws + (rep ? WS_DUMMY + 8 * MiB : WS_GLIST)); float* sslist = (float*)(ws + (rep ? WS_DUMMY + 12 * MiB : WS_SSLIST));
    unsigned* cntw = F.ctl + (rep ? CW_CNT + 2048 * rep : CW_CNT);
    const int lane = F.lane, r16 = lane & 15, g4 = lane >> 4;
    const float br0 = a.in[14][r16], br1 = a.in[14][16 + r16];
    for (int tb = blockIdx.x; tb < T / 128; tb += F.G) {
        if (F.tid < 32) hist[F.tid] = 0;
        LDS_WAIT(); __builtin_amdgcn_s_barrier(); asm volatile("" ::: "memory");
        const int t0 = tb * 128 + F.wave * 16;
        const float* xr = h2f + (size_t)(t0 + r16) * D + 8 * g4;
        f32x4 acc0 = (f32x4){0.f, 0.f, 0.f, 0.f}, acc1 = acc0;
        f32x4 xa = *(const f32x4*)(xr), xb = *(const f32x4*)(xr + 4);
#pragma unroll 4
        for (int ks = 0; ks < 32; ++ks) {
            const f32x4 ca = xa, cb = xb;
            if (ks + 1 < 32) { xa = *(const f32x4*)(xr + 32 * (ks + 1)); xb = *(const f32x4*)(xr + 32 * (ks + 1) + 4); }
            const unsigned h0 = cvtpk(ca.x, ca.y), h1 = cvtpk(ca.z, ca.w), h2 = cvtpk(cb.x, cb.y), h3 = cvtpk(cb.z, cb.w);
            const unsigned l0 = cvtpk(ca.x - bflo(h0), ca.y - bfhi(h0)), l1 = cvtpk(ca.z - bflo(h1), ca.w - bfhi(h1)), l2 = cvtpk(cb.x - bflo(h2), cb.y - bfhi(h2)), l3 = cvtpk(cb.z - bflo(h3), cb.w - bfhi(h3));
            const bf16x8 ah = __builtin_bit_cast(bf16x8, (u32x4){h0, h1, h2, h3}), al = __builtin_bit_cast(bf16x8, (u32x4){l0, l1, l2, l3});
            const int bo = r16 * WRS + (32 * ks + 8 * g4) * 2;
            const bf16x8 bh0 = *(const LAS bf16x8*)(WH + bo), bh1 = *(const LAS bf16x8*)(WH + 16 * WRS + bo), bl0 = *(const LAS bf16x8*)(WL + bo), bl1 = *(const LAS bf16x8*)(WL + 16 * WRS + bo);
            acc0 = __builtin_amdgcn_mfma_f32_16x16x32_bf16(ah, bh0, acc0, 0, 0, 0); acc1 = __builtin_amdgcn_mfma_f32_16x16x32_bf16(ah, bh1, acc1, 0, 0, 0);
            acc0 = __builtin_amdgcn_mfma_f32_16x16x32_bf16(ah, bl0, acc0, 0, 0, 0); acc1 = __builtin_amdgcn_mfma_f32_16x16x32_bf16(ah, bl1, acc1, 0, 0, 0);
            acc0 = __builtin_amdgcn_mfma_f32_16x16x32_bf16(al, bh0, acc0, 0, 0, 0); acc1 = __builtin_amdgcn_mfma_f32_16x16x32_bf16(al, bh1, acc1, 0, 0, 0);
        }
        int my_e = 0; float my_g = 0.f;
#pragma unroll
        for (int j = 0; j < 4; ++j) {
            const float rs = __builtin_amdgcn_rsqf(ss2[t0 + 4 * g4 + j] * (1.0f / D) + EPS);
            float a0 = acc0[j] * rs + br0, a1 = acc1[j] * rs + br1; float tv[4]; int te_[4];
#pragma unroll
            for (int k = 0; k < 4; ++k) { float m = fmaxf(a0, a1);
#pragma unroll
                for (int o = 1; o < 16; o <<= 1) m = fmaxf(m, __shfl_xor(m, o));
                int e = (a0 == m) ? r16 : ((a1 == m) ? 16 + r16 : 99);
#pragma unroll
                for (int o = 1; o < 16; o <<= 1) e = min(e, __shfl_xor(e, o));
                tv[k] = m; te_[k] = e; if (e == r16) a0 = -INFINITY; if (e == 16 + r16) a1 = -INFINITY; }
            const float d1 = fast_exp2((tv[1] - tv[0]) * LOG2E), d2 = fast_exp2((tv[2] - tv[0]) * LOG2E), d3 = fast_exp2((tv[3] - tv[0]) * LOG2E);
            const float inv = 1.0f / (1.0f + d1 + d2 + d3);
            if ((r16 >> 2) == j) { const int k = lane & 3; my_e = k == 0 ? te_[0] : (k == 1 ? te_[1] : (k == 2 ? te_[2] : te_[3])); my_g = (k == 0 ? 1.0f : (k == 1 ? d1 : (k == 2 ? d2 : d3))) * inv; }
        }
        const int rl = __hip_atomic_fetch_add(hist + my_e, 1, __ATOMIC_RELAXED, __HIP_MEMORY_SCOPE_WORKGROUP);
        LDS_WAIT(); __builtin_amdgcn_s_barrier(); asm volatile("" ::: "memory");
        if (F.tid < 32) basel[F.tid] = (int)__hip_atomic_fetch_add(cntw + F.tid, (unsigned)hist[F.tid], RLX_AGENT);
        LDS_WAIT(); VM_WAIT(); __builtin_amdgcn_s_barrier(); asm volatile("" ::: "memory");
        { const int t = t0 + 4 * g4 + (r16 >> 2), k = lane & 3; const int rank = basel[my_e] + rl;
          toke[t * 4 + k] = my_e; tokr[t * 4 + k] = rank; tokg[t * 4 + k] = my_g; list[(size_t)my_e * T + rank] = t; glist[(size_t)my_e * T + rank] = my_g; sslist[(size_t)my_e * T + rank] = ss2[t]; }
        LDS_WAIT(); __builtin_amdgcn_s_barrier(); asm volatile("" ::: "memory");
    }
}

__device__ __forceinline__ int build_tables(Frame& F) {
    LAS int* ts = (LAS int*)(F.lds + TL_TS); LAS unsigned char* te = (LAS unsigned char*)(F.lds + TL_TE);
    if (F.tid < NEXP) ((LAS int*)(F.lds + TL_CNT))[F.tid] = (int)__hip_atomic_load(F.ctl + CW_CNT + F.tid, RLX_AGENT);
    LDS_WAIT(); __builtin_amdgcn_s_barrier(); asm volatile("" ::: "memory");
    if (F.tid == 0) { int run = 0;
        for (int e = 0; e < NEXP; ++e) { ts[e] = run; run += (((LAS int*)(F.lds + TL_CNT))[e] + 255) >> 8; }
        ts[NEXP] = run; }
    LDS_WAIT(); __builtin_amdgcn_s_barrier(); asm volatile("" ::: "memory");
    const int nt = ts[NEXP];
    for (int g = F.tid; g < nt; g += 512) { int e = 0;
        for (int j = 1; j < NEXP; ++j) e += (ts[j] <= g) ? 1 : 0;
        te[g] = (unsigned char)e; }
    LDS_WAIT(); __builtin_amdgcn_s_barrier(); asm volatile("" ::: "memory");
    return __builtin_amdgcn_readfirstlane(nt);
}

__device__ __forceinline__ void p10_combine(Frame& F, const Args& a) {
    unsigned char* ws = a.ws;
    LAS int* ts = (LAS int*)(F.lds + TL_TS);
    const float* h2f = (const float*)(ws + WS_H2F); const unsigned char* Y = (const unsigned char*)(ws + WS_Y);
    const int* toke = (const int*)(ws + WS_TOKE); const int* tokr = (const int*)(ws + WS_TOKR);
    const float* gf = a.in[19];
    const int gw = F.vcu * NWAVES + F.wave, NGW = F.G * NWAVES, lane = F.lane;
    for (int t0 = 2 * gw; t0 < T; t0 += 2 * NGW) {
        float o[2][16]; u32x2 y[2][4][2];
#pragma unroll
        for (int q = 0; q < 2; ++q) { const int t = t0 + q;
#pragma unroll
            for (int k = 0; k < 4; ++k) { const int e = toke[t * 4 + k], r = tokr[t * 4 + k]; const unsigned char* yr = Y + ((size_t)ts[e] * 256 + r) * D;
                y[q][k][0] = *(const u32x2*)(yr + 8 * lane); y[q][k][1] = *(const u32x2*)(yr + 512 + 8 * lane); }
            const f32x4 a0 = *(const f32x4*)(h2f + (size_t)t * D + 8 * lane), a1 = *(const f32x4*)(h2f + (size_t)t * D + 8 * lane + 4), a2 = *(const f32x4*)(h2f + (size_t)t * D + 512 + 8 * lane), a3 = *(const f32x4*)(h2f + (size_t)t * D + 512 + 8 * lane + 4);
            o[q][0] = a0.x; o[q][1] = a0.y; o[q][2] = a0.z; o[q][3] = a0.w; o[q][4] = a1.x; o[q][5] = a1.y; o[q][6] = a1.z; o[q][7] = a1.w; o[q][8] = a2.x; o[q][9] = a2.y; o[q][10] = a2.z; o[q][11] = a2.w; o[q][12] = a3.x; o[q][13] = a3.y; o[q][14] = a3.z; o[q][15] = a3.w; }
#pragma unroll
        for (int q = 0; q < 2; ++q) {
#pragma unroll
            for (int k = 0; k < 4; ++k)
#pragma unroll
                for (int hf = 0; hf < 2; ++hf) { const u32x2 w = y[q][k][hf];
                    const f32x2 c0 = __builtin_amdgcn_cvt_pk_f32_fp8((int)w.x, false), c1 = __builtin_amdgcn_cvt_pk_f32_fp8((int)w.x, true), c2 = __builtin_amdgcn_cvt_pk_f32_fp8((int)w.y, false), c3 = __builtin_amdgcn_cvt_pk_f32_fp8((int)w.y, true);
                    o[q][8 * hf + 0] += pg8::YSCALE_INV * c0.x; o[q][8 * hf + 1] += pg8::YSCALE_INV * c0.y; o[q][8 * hf + 2] += pg8::YSCALE_INV * c1.x; o[q][8 * hf + 3] += pg8::YSCALE_INV * c1.y;
                    o[q][8 * hf + 4] += pg8::YSCALE_INV * c2.x; o[q][8 * hf + 5] += pg8::YSCALE_INV * c2.y; o[q][8 * hf + 6] += pg8::YSCALE_INV * c3.x; o[q][8 * hf + 7] += pg8::YSCALE_INV * c3.y; }
            float s = 0.f;
#pragma unroll
            for (int j = 0; j < 16; ++j) s += o[q][j] * o[q][j];
            const float rstd = 1.0f / sqrtf(wave_sum(s) * (1.0f / D) + EPS);
            float* op = a.out + (size_t)(t0 + q) * D;
#pragma unroll
            for (int v = 0; v < 4; ++v) { const int col = (v >> 1) * 512 + 8 * lane + (v & 1) * 4; const f32x4 g4 = *(const f32x4*)(gf + col);
                *(f32x4*)(op + col) = (f32x4){o[q][4 * v] * rstd * g4.x, o[q][4 * v + 1] * rstd * g4.y, o[q][4 * v + 2] * rstd * g4.z, o[q][4 * v + 3] * rstd * g4.w}; }
        }
    }
}

#define XB_TMO      128
#define XB_XCNT(j)  (256  + 64 * (j))
#define XB_XSUB(j)  (1280 + 64 * (j))
#define XB_XGEN(j)  (2304 + 64 * (j))
#define XB_TOP      3328
#define XB_TOPGEN   3392
#define XCD_BAR_WORDS 3456
#define XB_SPIN_CAP (1u << 22)
__device__ __forceinline__ unsigned xb_ld(unsigned* p)              { return __hip_atomic_load(p, __ATOMIC_RELAXED, __HIP_MEMORY_SCOPE_AGENT); }
__device__ __forceinline__ unsigned xb_add(unsigned* p, unsigned v) { return __hip_atomic_fetch_add(p, v, __ATOMIC_RELAXED, __HIP_MEMORY_SCOPE_AGENT); }
#define XB_SPIN(cond, bar) do { unsigned _sp = 0; while (cond) { __builtin_amdgcn_s_sleep(1); \
    if ((++_sp & 255u) == 0u) { if (xb_ld(&(bar)[XB_TMO])) break; if (_sp > XB_SPIN_CAP) { atomicAdd(&(bar)[XB_TMO], 1u); break; } } } } while (0)
struct XcdBarrier { unsigned* bar; unsigned x; volatile LAS unsigned* st; };
__device__ __forceinline__ XcdBarrier xcd_barrier_post(unsigned* bar, volatile LAS unsigned* st) {
    XcdBarrier b; b.bar = bar; b.x = (unsigned)__builtin_amdgcn_s_getreg((3 << 11) | 20) & 0xFu; b.st = st;
    if (threadIdx.x == 0) (void)xb_add(&bar[XB_XCNT(b.x)], 1u);
    return b;
}
__device__ __forceinline__ void xcd_barrier_complete(unsigned* bar, unsigned x, unsigned& nloc, unsigned& nx) {
    const unsigned G = gridDim.x * gridDim.y * gridDim.z;
    unsigned sum, cnt, mine, sp = 0u;
    for (;;) {
        sum = 0u; cnt = 0u; mine = 0u;
#pragma unroll
        for (unsigned j = 0; j < 16; ++j) { const unsigned c = xb_ld(&bar[XB_XCNT(j)]); sum += c; cnt += (c > 0u) ? 1u : 0u; mine = (j == x) ? c : mine; }
        if (sum == G) break;
        __builtin_amdgcn_s_sleep(1);
        if ((++sp & 255u) == 0u) { if (xb_ld(&bar[XB_TMO])) break; if (sp > XB_SPIN_CAP) { atomicAdd(&bar[XB_TMO], 1u); break; } }
    }
    nloc = mine > 0u ? mine : 1u; nx = cnt > 0u ? cnt : 1u;
}
__device__ __forceinline__ void xcd_barrier(const XcdBarrier& b) {
    asm volatile("s_waitcnt vmcnt(0)" ::: "memory");
    __syncthreads();
    if (threadIdx.x == 0) {
        unsigned* bar = b.bar;
        __builtin_amdgcn_s_waitcnt(0);
        unsigned nloc = b.st[0], nx = b.st[1];
        if (nloc == 0u) { xcd_barrier_complete(bar, b.x, nloc, nx); b.st[0] = nloc; b.st[1] = nx; }
        const unsigned old = xb_add(&bar[XB_XSUB(b.x)], 1u);
        const unsigned gen = old / nloc;
        if (old + 1u == (gen + 1u) * nloc) {
            __builtin_amdgcn_fence(__ATOMIC_RELEASE, "agent");
            asm volatile("s_waitcnt vmcnt(0)" ::: "memory");
            const unsigned og = xb_add(&bar[XB_TOP], 1u);
            const unsigned tg = og / nx;
            if (og + 1u == (tg + 1u) * nx) xb_add(&bar[XB_TOPGEN], 1u);
            else XB_SPIN(xb_ld(&bar[XB_TOPGEN]) == tg, bar);
            __builtin_amdgcn_fence(__ATOMIC_ACQUIRE, "agent");
            xb_add(&bar[XB_XGEN(b.x)], 1u);
            asm volatile("s_waitcnt vmcnt(0)" ::: "memory");
        } else {
            XB_SPIN(xb_ld(&bar[XB_XGEN(b.x)]) == gen, bar);
            __builtin_amdgcn_fence(__ATOMIC_ACQUIRE, "agent");
            asm volatile("s_waitcnt vmcnt(0)" ::: "memory");
        }
    }
    __syncthreads();
}
#ifndef MK_CG_ONLY
#define MK_CG_ONLY 0
#endif
__device__ __forceinline__ void grid_barrier(Frame& F, const XcdBarrier& xb_) { if (MK_CG_ONLY) cg::this_grid().sync(); else xcd_barrier(xb_); }
#ifndef MK_PHASE_MASK
#define MK_PHASE_MASK 0x7ff
#endif
#ifndef MK_REP_PHASE
#define MK_REP_PHASE -1
#endif
#ifndef MK_REP_N
#define MK_REP_N 0
#endif
__device__ __forceinline__ void ph0(Frame& F, const Args& args, int rep) { p0_prologue(F, args); }
__device__ __forceinline__ void ph1(Frame& F, const Args& args, int rep) {
    unsigned char* ws = args.ws; const int cid = (int)blockIdx.x;
    { pg8::DenseOrder S{(const char*)(ws + WS_XN8), (const char*)(ws + WS_WIN8), D / 2, D / 2, T / 256, 6, F.G, cid, 0};
      pg8::EpiProj E{(bf16_t*)(ws + WS_PROJ), rep ? (float*)(ws + WS_DUMMY) : (float*)(ws + WS_KBAR), WSCALE8_INV};
      pg8::gemm_phase<pg8::EpiProj, pg8::DenseOrder, false, true, true>(F.lds, D / 2, D / 2, D / 128, S, E); }
    { pg8::DenseOrder S{(const char*)(ws + WS_XN), (const char*)(ws + WS_WIN + (size_t)1536 * D * 2), D, D, T / 256, 8, F.G, cid, 6};
      pg8::EpiProj E{(bf16_t*)(ws + WS_PROJ), rep ? (float*)(ws + WS_DUMMY) : (float*)(ws + WS_KBAR), 1.0f};
      pg8::gemm_phase<pg8::EpiProj, pg8::DenseOrder, false, true>(F.lds, D, D, D / 64, S, E); }
}
__device__ __forceinline__ void ph2(Frame& F, const Args& args, int rep) { p2_mixer(F, args, rep); }
constexpr size_t WS_MB = WS_PROJ, WS_NB = WS_PROJ + 16 * MiB, WS_H1Q = WS_PROJ + 32 * MiB, WS_PB = WS_QX;
constexpr size_t WS_UNUSED_XA = 0;
constexpr int LDS_XTAB = 131072;
__device__ __forceinline__ void ph3(Frame& F, const Args& args, int rep) {
    unsigned char* ws = args.ws; const int cid = (int)blockIdx.x;
    pg8::P3Order S{pg8::XmnOrder{(const char*)(ws + WS_MEMK), (const char*)(ws + WS_MEMVT), (const char*)(ws + WS_WQ), (const char*)(ws + WS_WO), F.G, cid},
                   pg8::DenseOrder{(const char*)(ws + WS_MIX), (const char*)(ws + WS_WOUT), D, D, T / 256, D / 256, F.G, cid, 0}};
    pg8::EpiP3 E{pg8::EpiFp8{(unsigned char*)(ws + WS_MB), D, (unsigned char*)(ws + WS_NB), D, XSCALE8},
                 pg8::EpiRes<true, false>{(const void*)args.in[0], (bf16_t*)(ws + WS_H1B), nullptr, rep ? (float*)(ws + WS_DUMMY + 512 * 1024) : (float*)(ws + WS_SS1), 1.0f, (unsigned char*)(ws + WS_H1Q)}};
    pg8::gemm_phase<pg8::EpiP3, pg8::P3Order, false, true>(F.lds, D, D, D / 64, S, E);
}
__device__ __forceinline__ void ph4(Frame& F, const Args& args, int rep) {
    unsigned char* ws = args.ws; const int cid = (int)blockIdx.x;
    pg8::XbOrder S{(const char*)(ws + WS_H1Q), (const char*)(ws + WS_MB), F.G, cid, (size_t)D};
    pg8::EpiSoftmaxS E{(unsigned char*)(ws + WS_PB), (const float*)(ws + WS_SS1), F.lds + LDS_XTAB, XSCALE8_INV};
    pg8::gemm_phase<pg8::EpiSoftmaxS, pg8::XbOrder, false, true, true>(F.lds, D / 2, D / 2, D / 128, S, E);
}
__device__ __forceinline__ void ph5(Frame& F, const Args& args, int rep) {}
__device__ __forceinline__ void ph6(Frame& F, const Args& args, int rep) {
    unsigned char* ws = args.ws; const int cid = (int)blockIdx.x;
    pg8::XbOrder S{(const char*)(ws + WS_PB), (const char*)(ws + WS_NB), F.G, cid, (size_t)D};
    pg8::EpiRes<false, true, true> E{(const void*)(ws + WS_H1B), (bf16_t*)(ws + WS_H2B), (float*)(ws + WS_H2F), rep ? (float*)(ws + WS_DUMMY + 512 * 1024) : (float*)(ws + WS_SS2), PSCALE8_INV * XSCALE8_INV, nullptr};
    pg8::gemm_phase<pg8::EpiRes<false, true, true>, pg8::XbOrder, false, true, true>(F.lds, D / 2, D / 2, D / 128, S, E);
}
__device__ __forceinline__ void ph7(Frame& F, const Args& args, int rep) { p7_router(F, args, rep); }
__device__ __forceinline__ void ph8(Frame& F, const Args& args, int rep) {
    unsigned char* ws = args.ws; const int cid = (int)blockIdx.x;
    const int ntl = build_tables(F);
    pg8::MoeOrder S{(const char*)(ws + WS_H2B), (const char*)(ws + WS_W1), (const int*)(ws + WS_LIST), (const LAS int*)(F.lds + TL_CNT), (const LAS unsigned char*)(F.lds + TL_TE), (const LAS int*)(F.lds + TL_TS),
                    ntl, 8, F.G, cid, (size_t)2048 * D, 1, (size_t)256 * D, (size_t)256 * D};
    pg8::EpiW1 E{(bf16_t*)(ws + WS_HMID), (const float*)(ws + WS_SSLIST), args.in[16], (const int*)(ws + WS_LIST)};
    pg8::gemm_phase<pg8::EpiW1, pg8::MoeOrder, true, true, true>(F.lds, D / 2, D / 2, D / 128, S, E);
}
__device__ __forceinline__ void ph9(Frame& F, const Args& args, int rep) {
    unsigned char* ws = args.ws; const int cid = (int)blockIdx.x;
    const int ntl = build_tables(F);
    pg8::MoeOrder S{(const char*)(ws + WS_HMID), (const char*)(ws + WS_W2), (const int*)(ws + WS_LIST), (const LAS int*)(F.lds + TL_CNT), (const LAS unsigned char*)(F.lds + TL_TE), (const LAS int*)(F.lds + TL_TS),
                    ntl, 4, F.G, cid, (size_t)D * D, 0, (size_t)256 * D, (size_t)256 * D};
    pg8::EpiW2 E{(unsigned char*)(ws + WS_Y), args.in[18], (const int*)(ws + WS_LIST), (const float*)(ws + WS_GLIST)};
    pg8::gemm_phase<pg8::EpiW2, pg8::MoeOrder, false, true, true>(F.lds, D / 2, D / 2, D / 128, S, E);
}
__device__ __forceinline__ void ph10(Frame& F, const Args& args, int rep) { (void)build_tables(F); p10_combine(F, args); }

constexpr int N_PHASES = 11;
__global__ void __launch_bounds__(NWAVES * 64, 2) hymba_fwd(Args args) {
    extern __shared__ __attribute__((aligned(16))) unsigned char lds_raw[];
    Frame F;
    F.lds = (LAS unsigned char*)lds_raw;
    F.MISC = (volatile LAS unsigned*)(F.lds + TL_MISC);
    F.tid = threadIdx.x; F.lane = F.tid & 63; F.wave = __builtin_amdgcn_readfirstlane(F.tid >> 6);
    F.G = gridDim.x; { const int bx = blockIdx.x; F.vcu = (F.G % 8 == 0) ? (bx % 8) * (F.G / 8) + bx / 8 : bx; }
    F.ctl = (unsigned*)(args.ws + WS_CTL);
    const int lo = args.ph_lo, hi = args.ph_hi;
    for (int u = F.tid; u < 64; u += NWAVES * 64) ((LAS unsigned*)(F.lds + TL_MISC))[u] = 0u;
    __syncthreads();
    const XcdBarrier xbar = xcd_barrier_post(F.ctl + CW_BAR, F.MISC + 8);
#define RUN(k, fn) do { if (((MK_PHASE_MASK >> (k)) & 1) && lo <= (k) && (k) < hi) { fn(F, args, 0); \
        if (MK_REP_PHASE == (k) && MK_REP_N >= 1) { grid_barrier(F, xbar); fn(F, args, 1); } \
        if (MK_REP_PHASE == (k) && MK_REP_N >= 2) { grid_barrier(F, xbar); fn(F, args, 2); } \
        if ((k) + 1 < hi) { grid_barrier(F, xbar); } } } while (0)
    if (args.ph_lo < 0) cg::this_grid().sync();
    RUN(0, ph0); RUN(1, ph1); RUN(2, ph2); RUN(3, ph3); RUN(4, ph4);   RUN(6, ph6); RUN(7, ph7); RUN(8, ph8); RUN(9, ph9); RUN(10, ph10);
#undef RUN
}

extern "C" void kernel_launch(void* const* d_in, const int* in_sizes, int n_in, void* d_out, int out_size, void* d_ws, size_t ws_size, hipStream_t stream) {
    static int grid = 0;
    if (grid == 0) {
        if (n_in != 20 || in_sizes[0] != T * D || out_size != T * D || ws_size < WS_END) {
            fprintf(stderr, "kernel_launch: shape/workspace mismatch (n_in %d, in0 %d, out %d, ws %zu, need %zu)\n", n_in, n_in > 0 ? in_sizes[0] : -1, out_size, ws_size, (size_t)WS_END); grid = -1; return; }
        int dev = 0, cus = 0, per_cu = 0;
        if (hipGetDevice(&dev) != hipSuccess || hipDeviceGetAttribute(&cus, hipDeviceAttributeMultiprocessorCount, dev) != hipSuccess) { grid = -1; return; }
        if (hipFuncSetAttribute((const void*)hymba_fwd, hipFuncAttributeMaxDynamicSharedMemorySize, LDS_BYTES) != hipSuccess) { fprintf(stderr, "kernel_launch: hipFuncSetAttribute failed\n"); grid = -1; return; }
        if (hipOccupancyMaxActiveBlocksPerMultiprocessor(&per_cu, (const void*)hymba_fwd, NWAVES * 64, LDS_BYTES) != hipSuccess || per_cu < 1) { fprintf(stderr, "kernel_launch: occupancy query says %d\n", per_cu); }
        (void)hipGetLastError();
        grid = cus;
        if (grid != 256) fprintf(stderr, "kernel_launch: %d CUs; this kernel is built for 256\n", grid);
    }
    if (grid < 0) return;
    (void)hipMemsetAsync((char*)d_ws + WS_CTL, 0, CTL_ZERO_BYTES, stream);
    Args a{};
    for (int i = 0; i < 20; ++i) a.in[i] = (const float*)d_in[i];
    a.out = (float*)d_out; a.ws = (unsigned char*)d_ws;
#if MK_N_LAUNCHES == 1
    a.ph_lo = 0; a.ph_hi = MK_LAST_PHASE + 1;
    void* kargs[] = {&a};
    hipError_t e = hipLaunchCooperativeKernel((const void*)hymba_fwd, dim3(grid), dim3(NWAVES * 64), kargs, LDS_BYTES, stream);
    if (e != hipSuccess) fprintf(stderr, "kernel_launch: cooperative launch failed: %s\n", hipGetErrorString(e));
#else
    for (int p = 0; p <= MK_LAST_PHASE; ++p) { a.ph_lo = p; a.ph_hi = p + 1; hipLaunchKernelGGL(hymba_fwd, dim3(grid), dim3(NWAVES * 64), LDS_BYTES, stream, a); }
#endif
}
```

```cpp
#include <hip/hip_runtime.h>
#include <hip/hip_cooperative_groups.h>
#include <cstdio>
#include <cstdint>
namespace cg = cooperative_groups;

#ifndef MK_N_LAUNCHES
#define MK_N_LAUNCHES 1
#endif
#ifndef MK_LAST_PHASE
#define MK_LAST_PHASE 10
#endif

#define LAS __attribute__((address_space(3)))
#define GAS __attribute__((address_space(1)))
typedef unsigned short bf16_t;
typedef short bf16x8 __attribute__((ext_vector_type(8)));
typedef short s16x4 __attribute__((ext_vector_type(4)));
typedef float f32x4 __attribute__((ext_vector_type(4)));
typedef float f32x2 __attribute__((ext_vector_type(2)));
typedef float f32x16 __attribute__((ext_vector_type(16)));
typedef unsigned u32x4 __attribute__((ext_vector_type(4)));
typedef unsigned u32x2 __attribute__((ext_vector_type(2)));
typedef int v8i32_t __attribute__((ext_vector_type(8)));

constexpr int BATCH = 8, SEQ = 4096, T = BATCH * SEQ, D = 1024, INC = 3584, NMEM = 256, MROWS = BATCH * NMEM;
constexpr int NEXP = 32, TOPK = 4, MT_MAX = T * TOPK / 256 + NEXP, MPAD = MT_MAX * 256;
constexpr float EPS = 1e-6f;
constexpr float LOG2E = 1.4426950408889634f;
constexpr float C2Q = 0.125f * LOG2E;
constexpr float C2X = 0.0625f * LOG2E;
constexpr int C_MQ = 0, C_MK = 512, C_MV = 1024, C_GQ = 1536, C_GF = 2048, C_GI = 2560, C_GG = 3072;

constexpr size_t MiB = 1u << 20;
constexpr size_t WS_CTL = 0, CTL_ZERO_BYTES = 2 * MiB;
constexpr size_t WS_KBAR = 1 * MiB;
constexpr size_t WS_SS1 = 1 * MiB + 256 * 1024;
constexpr size_t WS_SS2 = 1 * MiB + 384 * 1024;
constexpr size_t WS_TOKE = 2 * MiB, WS_TOKR = 2 * MiB + 512 * 1024, WS_TOKG = 3 * MiB;
constexpr size_t WS_WRT = 3 * MiB + 512 * 1024;
constexpr size_t WS_LIST = 4 * MiB;
constexpr size_t WS_GLIST = 8 * MiB;
constexpr size_t WS_SSLIST = 12 * MiB;
constexpr size_t WS_WIN8 = 14 * MiB;
constexpr size_t WS_WIN = 16 * MiB, WS_WOUT = 23 * MiB, WS_WQ = 25 * MiB, WS_WKV = 27 * MiB, WS_WO = 31 * MiB;
constexpr size_t WS_MN = 33 * MiB, WS_MEMK = 37 * MiB, WS_MEMVT = 41 * MiB;
constexpr size_t WS_W1 = 48 * MiB, WS_W2 = 176 * MiB;
constexpr size_t WS_PROJ = 240 * MiB;
constexpr size_t SEC_ELEMS = (size_t)16 * 1024 * 1024;
constexpr size_t WS_XN = 464 * MiB;
constexpr size_t WS_OX = 464 * MiB;
constexpr size_t WS_XN8 = 528 * MiB;
constexpr size_t WS_MIX = 528 * MiB;
constexpr size_t WS_H1B = 592 * MiB;
constexpr size_t WS_QX = 656 * MiB;
constexpr size_t WS_PWS = 720 * MiB;
constexpr size_t WS_HMID = 240 * MiB;
constexpr size_t WS_Y = 512 * MiB;
constexpr size_t WS_H2F = 784 * MiB;
constexpr size_t WS_H2B = 912 * MiB;
constexpr size_t WS_DUMMY = 976 * MiB;
constexpr size_t WS_END = 992 * MiB;
static_assert(WS_HMID + (size_t)MPAD * D * 2 <= WS_Y && WS_Y + (size_t)MPAD * D * 2 <= WS_H2F, "ws map");
constexpr int CW_TMO = 0;
constexpr int CW_CNT = 64;
constexpr int CW_QUEUE = 128;
constexpr int CW_BAR = 4096;

__device__ __forceinline__ unsigned f2bf(float f) { unsigned u = __builtin_bit_cast(unsigned, f); return (u + 0x7fffu + ((u >> 16) & 1u)) >> 16; }
__device__ __forceinline__ unsigned pk2(float lo, float hi) { return f2bf(lo) | (f2bf(hi) << 16); }
__device__ __forceinline__ float bf2f(unsigned short h) { return __builtin_bit_cast(float, (unsigned)h << 16); }
__device__ __forceinline__ float bflo(unsigned w) { return __builtin_bit_cast(float, w << 16); }
__device__ __forceinline__ float bfhi(unsigned w) { return __builtin_bit_cast(float, w & 0xffff0000u); }
typedef float f32x2_t __attribute__((ext_vector_type(2))); typedef __bf16 bf16x2_t __attribute__((ext_vector_type(2)));
__device__ __forceinline__ unsigned cvtpk(float lo, float hi) { f32x2_t v = {lo, hi}; bf16x2_t b = __builtin_convertvector(v, bf16x2_t); return __builtin_bit_cast(unsigned, b); }
__device__ __forceinline__ float wave_sum(float v) {
#pragma unroll
    for (int o = 1; o < 64; o <<= 1) v += __shfl_xor(v, o);
    return v;
}
__device__ __forceinline__ float fast_exp2(float x) { return __builtin_amdgcn_exp2f(x); }
__device__ __forceinline__ float fast_rcp(float x) { return __builtin_amdgcn_rcpf(x); }
__device__ __forceinline__ float silu_f(float x) { return x * fast_rcp(1.0f + fast_exp2(-x * LOG2E)); }
__device__ __forceinline__ unsigned pk4_fp8(float a, float b, float c, float d) { int w = 0; w = __builtin_amdgcn_cvt_pk_fp8_f32(a, b, w, false); w = __builtin_amdgcn_cvt_pk_fp8_f32(c, d, w, true); return (unsigned)w; }
constexpr float XSCALE8 = 4.0f, XSCALE8_INV = 0.25f, PSCALE8 = 256.0f, PSCALE8_INV = 1.0f / 256.0f;
constexpr float WSCALE8 = 32.0f, WSCALE8_INV = 1.0f / 32.0f;
#define LDS_WAIT() asm volatile("s_waitcnt lgkmcnt(0)" ::: "memory")
#define VM_WAIT() asm volatile("s_waitcnt vmcnt(0)" ::: "memory")
#define RLX_AGENT __ATOMIC_RELAXED, __HIP_MEMORY_SCOPE_AGENT

namespace pg8 {
constexpr int BM = 256, BK = 64, HALF = 128, HTB = HALF * BK * 2, STAGE_BYTES = 8 * HTB;
__device__ __forceinline__ unsigned gload32_hidden(const void* sbase, unsigned voff) { unsigned v; asm volatile("global_load_dword %0, %1, %2" : "=v"(v) : "v"(voff), "s"(sbase) : "memory"); return v; }
__device__ __forceinline__ f32x4 gload128_hidden(const void* sbase, unsigned voff) { f32x4 v; asm volatile("global_load_dwordx4 %0, %1, %2" : "=v"(v) : "v"(voff), "s"(sbase) : "memory"); return v; }
__device__ __forceinline__ f32x4 gload128_hidden_nt(const void* sbase, unsigned voff) { f32x4 v; asm volatile("global_load_dwordx4 %0, %1, %2 nt" : "=v"(v) : "v"(voff), "s"(sbase) : "memory"); return v; }
__device__ __forceinline__ void glds16s(const char* sbase, unsigned voff, unsigned lds_dst) { unsigned keep;
    asm volatile("s_mov_b32 %0, m0\n\ts_mov_b32 m0, %3\n\ts_nop 0\n\tglobal_load_lds_dwordx4 %1, %2\n\ts_mov_b32 m0, %0" : "=&s"(keep) : "v"(voff), "s"(sbase), "s"(lds_dst) : "memory"); }
__host__ __device__ __forceinline__ int lds_byte(int r, int c) { const int st = (r >> 4) * 2 + (c >> 5), rr = r & 15, cc = c & 31, ob = rr * 64 + cc * 2; return st * 1024 + (ob ^ (((ob >> 9) & 1) << 5)); }
__host__ __device__ __forceinline__ void stage_rc(int b, int& R, int& C) { const int st = b / 1024, sb = b % 1024, swz = sb ^ (((sb >> 9) & 1) << 5); R = (st >> 1) * 16 + swz / 64; C = (st & 1) * 32 + (swz % 64) / 2; }
__host__ __device__ __forceinline__ int perm32(int rho) { const int n = rho >> 4, i = rho & 15; return 8 * (i >> 2) + 4 * n + (i & 3); }

struct Unit { const char* A; const char* B; const int* rows; int pm, pn, aux, nrows, ntu; };

template <class Epi, class Sched, bool GATHER, bool ALIGN_EPI, bool FP8 = false>
__device__ __forceinline__ void gemm_phase(LAS unsigned char* lds, const int lda, const int ldb, const int nt_in, const Sched& S, const Epi& E) {
    int nt = nt_in; asm volatile("" : "+s"(nt));
    int tid_ = threadIdx.x; asm volatile("" : "+v"(tid_));
    const int tid = tid_, wid = __builtin_amdgcn_readfirstlane(tid >> 6), lane = tid & 63, wr = wid >> 2, wc = wid & 3, fr = lane & 15, fq = lane >> 4;
    unsigned offB0; { int R, C; stage_rc(tid * 16, R, C); const int Rb = Epi::PERM ? ((R & ~31) + perm32(R & 31)) : R; offB0 = (unsigned)(Rb * ldb + C) * 2u; }
    const size_t pstepB = (size_t)64 * ldb * 2;
    const size_t kstep = (size_t)(BK * 2);
    const size_t hstepB = (size_t)HALF * ldb * 2;
    const unsigned ldsb = (unsigned)__builtin_amdgcn_readfirstlane((int)((unsigned)(uintptr_t)(unsigned char*)lds + (unsigned)wid * 1024u));
    const int aoff = lds_byte(wr * 64 + fr, FP8 ? fq * 16 : fq * 8), boff = lds_byte(wc * 32 + fr, FP8 ? fq * 16 : fq * 8);
#define PG8_SA(b, h) (((b) * 2 + (h)) * HTB)
#define PG8_SB(b, h) ((4 + (b) * 2 + (h)) * HTB)
#define PG8_STGB(bufoff, gbase) do { glds16s((const char*)(gbase), offB0, ldsb + (unsigned)(bufoff)); glds16s((const char*)(gbase) + pstepB, offB0, ldsb + (unsigned)(bufoff) + 8192u); } while (0)
#define PG8_LD16(p_) (*(const LAS u32x4*)(p_))
#define PG8_CAT(x, y) __builtin_bit_cast(v8i32_t, __builtin_shufflevector(x, y, 0, 1, 2, 3, 4, 5, 6, 7))
    unsigned aA0 = (unsigned)(aoff + PG8_SA(0, 0)), aA1 = (unsigned)(aoff + PG8_SA(1, 0)), bB0 = (unsigned)(boff + PG8_SB(0, 0)), bB1 = (unsigned)(boff + PG8_SB(1, 0));
    asm volatile("" : "+v"(aA0), "+v"(aA1), "+v"(bB0), "+v"(bB1));
    int scl8 = 0x7f7f7f7f; asm volatile("" : "+v"(scl8));
#define PG8_LDA(dst, b, h) do { const LAS unsigned char* ap_ = lds + ((b) ? aA1 : aA0) + (h) * HTB; _Pragma("unroll") for (int m = 0; m < 4; ++m) { \
        if constexpr (FP8) { dst##8[m] = PG8_CAT(PG8_LD16(ap_ + m * 2048), PG8_LD16(ap_ + m * 2048 + 16)); } \
        else { _Pragma("unroll") for (int k = 0; k < 2; ++k) dst[m][k] = *(const LAS bf16x8*)(ap_ + m * 2048 + k * 1024); } } } while (0)
#define PG8_LDB(dst, b, h) do { const LAS unsigned char* bp_ = lds + ((b) ? bB1 : bB0) + (h) * HTB; _Pragma("unroll") for (int n = 0; n < 2; ++n) { \
        if constexpr (FP8) { dst##8[n] = PG8_CAT(PG8_LD16(bp_ + n * 2048), PG8_LD16(bp_ + n * 2048 + 16)); } \
        else { _Pragma("unroll") for (int k = 0; k < 2; ++k) dst[n][k] = *(const LAS bf16x8*)(bp_ + n * 2048 + k * 1024); } } } while (0)
#define PG8_MMA(ai, bj, At, Bt) do { __builtin_amdgcn_s_setprio(1); _Pragma("unroll") for (int m = 0; m < 4; ++m) _Pragma("unroll") for (int n = 0; n < 2; ++n) { \
        if constexpr (FP8) asm volatile("v_mfma_scale_f32_16x16x128_f8f6f4 %0, %1, %2, %0, %3, %3 op_sel_hi:[0,0,0]" : "+v"(acc[ai][bj][m][n]) : "v"(Bt##8[n]), "v"(At##8[m]), "v"(scl8));   \
        else { _Pragma("unroll") for (int k = 0; k < 2; ++k) acc[ai][bj][m][n] = __builtin_amdgcn_mfma_f32_16x16x32_bf16(Bt[n][k], At[m][k], acc[ai][bj][m][n], 0, 0, 0); } } \
        __builtin_amdgcn_s_setprio(0); } while (0)
#define PG8_WAIT_V(n) asm volatile("s_waitcnt vmcnt(" #n ")" ::: "memory")
#define PG8_WAIT_L(n) asm volatile("s_waitcnt lgkmcnt(" #n ")" ::: "memory")
#define PG8_BAR __builtin_amdgcn_s_barrier()
#define PG8_SCHED __builtin_amdgcn_sched_barrier(0)
    unsigned voffA0, c2, pkc[2], pkn[2], praw[4];
    { int R, C; stage_rc(tid * 16, R, C); voffA0 = (unsigned)(R * lda + C) * 2u; c2 = (unsigned)C * 2u; }
    const size_t hstepA = (size_t)HALF * lda * 2, pstepA = (size_t)64 * lda * 2;
    const unsigned lda2 = (unsigned)lda * 2u;
#define PG8_PKROWS(dst, u) do { if (GATHER) { _Pragma("unroll") for (int i_ = 0; i_ < 2; ++i_) { int R_, C_; stage_rc(tid * 16 + i_ * 8192, R_, C_); \
        const int nr_ = (u).nrows - 1; const int r0_ = R_ < nr_ ? R_ : nr_, r1_ = (R_ + HALF) < nr_ ? (R_ + HALF) : nr_; \
        dst[i_] = (unsigned)(u).rows[r0_] | ((unsigned)(u).rows[r1_] << 16); } } } while (0)
#define PG8_RAWROWS(u) do { if (GATHER) { _Pragma("unroll") for (int i_ = 0; i_ < 2; ++i_) { int R_, C_; stage_rc(tid * 16 + i_ * 8192, R_, C_); \
        const int nr_ = (u).nrows - 1; const int r0_ = R_ < nr_ ? R_ : nr_, r1_ = (R_ + HALF) < nr_ ? (R_ + HALF) : nr_; \
        praw[2 * i_] = gload32_hidden((u).rows, (unsigned)r0_ * 4u); praw[2 * i_ + 1] = gload32_hidden((u).rows, (unsigned)r1_ * 4u); } } } while (0)
#define PG8_PACKRAW(dst) do { unsigned a0_ = praw[0], a1_ = praw[1], a2_ = praw[2], a3_ = praw[3]; asm volatile("" : "+v"(a0_), "+v"(a1_), "+v"(a2_), "+v"(a3_)); \
        dst[0] = a0_ | (a1_ << 16); dst[1] = a2_ | (a3_ << 16); } while (0)
#define PG8_STGA(bufoff, gbase, h, NX) do { \
        if (GATHER) { const unsigned p0_ = (NX) ? pkn[0] : pkc[0], p1_ = (NX) ? pkn[1] : pkc[1]; \
            const unsigned o0_ = ((h) ? (p0_ >> 16) : (p0_ & 0xffffu)) * lda2 + c2, o1_ = ((h) ? (p1_ >> 16) : (p1_ & 0xffffu)) * lda2 + c2; \
            glds16s((const char*)(gbase), o0_, ldsb + (unsigned)(bufoff)); glds16s((const char*)(gbase), o1_, ldsb + (unsigned)(bufoff) + 8192u); } \
        else { const char* gb_ = (const char*)(gbase) + ((h) ? hstepA : (size_t)0); glds16s(gb_, voffA0, ldsb + (unsigned)(bufoff)); glds16s(gb_ + pstepA, voffA0, ldsb + (unsigned)(bufoff) + 8192u); } } while (0)
    Unit cur, nxt; int ui = 0;
    if (!S.next(0, cur)) return;
    f32x4 acc[2][2][4][2];
#pragma unroll
    for (int a = 0; a < 2; ++a)
#pragma unroll
        for (int b = 0; b < 2; ++b)
#pragma unroll
            for (int m = 0; m < 4; ++m)
#pragma unroll
                for (int n = 0; n < 2; ++n) acc[a][b][m][n] = (f32x4){0.f, 0.f, 0.f, 0.f};
    bf16x8 At[4][2], B0[2][2], B1[2][2]; v8i32_t At8[4], B08[2], B18[2];
    pkc[0] = pkc[1] = pkn[0] = pkn[1] = 0u; praw[0] = praw[1] = praw[2] = praw[3] = 0u;
    PG8_PKROWS(pkc, cur);
    const char* cA = cur.A; const char* cB = cur.B;
    PG8_STGB(PG8_SB(0, 0), cB); PG8_STGB(PG8_SB(0, 1), cB + hstepB); PG8_STGA(PG8_SA(0, 0), cA, 0, false); PG8_STGA(PG8_SA(0, 1), cA, 1, false);
    if (wr == 1) PG8_BAR;
    PG8_WAIT_V(2); PG8_BAR;
    PG8_STGB(PG8_SB(1, 0), cB + kstep); PG8_STGA(PG8_SA(1, 0), cA + kstep, 0, false); PG8_STGB(PG8_SB(1, 1), cB + hstepB + kstep);
    PG8_WAIT_V(6); PG8_BAR;
    for (;;) {
        const bool has_next = S.next(ui + 1, nxt);
        if (GATHER) { if (has_next) { PG8_RAWROWS(nxt); } }
        const char* nA = has_next ? nxt.A : cA; const char* nB = has_next ? nxt.B : cB;
        typename Epi::Pre pre; { int t_p = threadIdx.x; asm volatile("" : "+v"(t_p)); E.prefetch(cur, wr, wc, t_p & 15, (t_p >> 4) & 3, pre); }
        const int ntc = cur.ntu ? cur.ntu : nt;
        for (int t = 0; t < ntc; t += 2) {
            const bool last = (t == ntc - 2);
            if (GATHER) { pkn[0] = pkc[0]; pkn[1] = pkc[1]; if (last && has_next) { PG8_PACKRAW(pkn); } }
            const char* a1 = cA + (size_t)(t + 1) * kstep;
            const char* a2 = last ? nA : cA + (size_t)(t + 2) * kstep; const char* b2 = last ? nB : cB + (size_t)(t + 2) * kstep;
            const char* a3 = a2 + kstep; const char* b3 = b2 + kstep;
            PG8_LDB(B0, 0, 0); PG8_LDB(B1, 0, 1); PG8_SCHED; PG8_LDA(At, 0, 0); PG8_STGA(PG8_SA(1, 1), a1, 1, false);
            PG8_WAIT_V(8); PG8_WAIT_L(0); PG8_BAR; PG8_MMA(0, 0, At, B0); PG8_MMA(0, 1, At, B1); PG8_BAR; PG8_SCHED;
            PG8_LDA(At, 0, 1); PG8_STGB(PG8_SB(0, 0), b2); PG8_STGB(PG8_SB(0, 1), b2 + hstepB); PG8_STGA(PG8_SA(0, 0), a2, 0, last);
            PG8_WAIT_V(8); PG8_WAIT_L(0); PG8_BAR; PG8_MMA(1, 0, At, B0); PG8_MMA(1, 1, At, B1); PG8_BAR; PG8_SCHED;
            PG8_LDB(B0, 1, 0); PG8_LDB(B1, 1, 1); PG8_SCHED; PG8_LDA(At, 1, 0); PG8_STGA(PG8_SA(0, 1), a2, 1, last);
            PG8_WAIT_V(8); PG8_WAIT_L(0); PG8_BAR; PG8_MMA(0, 0, At, B0); PG8_MMA(0, 1, At, B1); PG8_BAR; PG8_SCHED;
            PG8_LDA(At, 1, 1); PG8_STGB(PG8_SB(1, 0), b3); PG8_STGB(PG8_SB(1, 1), b3 + hstepB); PG8_STGA(PG8_SA(1, 0), a3, 0, last);
            PG8_WAIT_V(8); PG8_WAIT_L(0); PG8_BAR; PG8_MMA(1, 0, At, B0); PG8_MMA(1, 1, At, B1); PG8_BAR; PG8_SCHED;
        }
        if constexpr (ALIGN_EPI) { if (wr == 0) PG8_BAR; }
        if constexpr (FP8) asm volatile("s_nop 15\n\ts_nop 15" ::: "memory");
        if constexpr (!Epi::AFTER_DRAIN) { int t_e = threadIdx.x; asm volatile("" : "+v"(t_e)); const int fr_e = t_e & 15, fq_e = (t_e >> 4) & 3; E(acc, cur, wr, wc, fr_e, fq_e, pre); }
        if (!has_next) break;
#pragma unroll
        for (int a = 0; a < 2; ++a)
#pragma unroll
            for (int b = 0; b < 2; ++b)
#pragma unroll
                for (int m = 0; m < 4; ++m)
#pragma unroll
                    for (int n = 0; n < 2; ++n) acc[a][b][m][n] = (f32x4){0.f, 0.f, 0.f, 0.f};
        cur = nxt; cA = nA; cB = nB; ++ui;
        if (GATHER) { PG8_PACKRAW(pkc); }
        if constexpr (ALIGN_EPI) { if (wr == 1) PG8_BAR; }
    }
    PG8_WAIT_V(0);
    if constexpr (!ALIGN_EPI) { if (wr == 0) PG8_BAR; }
    PG8_BAR;
    if constexpr (Epi::AFTER_DRAIN) { int t_e = threadIdx.x; asm volatile("" : "+v"(t_e)); const int fr_e = t_e & 15, fq_e = (t_e >> 4) & 3; E.fused(acc, cur, wr, wc, fr_e, fq_e, lds, wid, t_e & 63); }
#undef PG8_SA
#undef PG8_SB
#undef PG8_STGB
#undef PG8_LDA
#undef PG8_LDB
#undef PG8_MMA
#undef PG8_CAT
#undef PG8_LD16
#undef PG8_WAIT_V
#undef PG8_WAIT_L
#undef PG8_SCHED
#undef PG8_PKROWS
#undef PG8_RAWROWS
#undef PG8_PACKRAW
#undef PG8_STGA
}
}

namespace pg8 {
constexpr int NXCD = 8, WGM = 8;
__device__ __forceinline__ void tile_order(int L, int nM, int nN, int& pm, int& pn) {
    const int nwg = nM * nN; int wgid = L;
    { const int q = nwg / NXCD, r = nwg % NXCD, xcd = wgid % NXCD, off = wgid / NXCD; wgid = (xcd < r ? xcd * (q + 1) : r * (q + 1) + (xcd - r) * q) + off; }
    const int nig = WGM * nN, gid = wgid / nig, fm = gid * WGM, gsz = (nM - fm) < WGM ? (nM - fm) : WGM;
    pm = fm + ((wgid % nig) % gsz); pn = (wgid % nig) / gsz;
}
struct DenseOrder {
    const char* A; const char* B; int lda, ldb, nM, nN, G, c, pn0;
    __device__ __forceinline__ bool next(int i, Unit& u) const {
        const long L = (long)i * G + c; if (L >= (long)nM * nN) return false;
        int pm, pn; tile_order((int)L, nM, nN, pm, pn);
        u.pm = pm; u.pn = pn + pn0; u.aux = 0; u.rows = nullptr; u.nrows = 256; u.ntu = 0;
        u.A = A + (size_t)pm * 256 * lda * 2; u.B = B + (size_t)pn * 256 * ldb * 2; return true;
    }
};
struct KvOrder {
    const char* MN; const char* W; int L0;
    __device__ __forceinline__ bool next(int i, Unit& u) const {
        const int L = L0; if (i > 0 || L >= 64) return false;
        u.rows = nullptr; u.nrows = 256; u.ntu = 0; u.pm = L >> 3; const int ct = L & 7; u.aux = ct >> 2; u.pn = ct & 3;
        u.A = MN + (size_t)u.pm * 256 * D * 2; u.B = W + (size_t)ct * 256 * D * 2; return true;
    }
};
struct XmnOrder {
    const char* MK; const char* MV; const char* WQN; const char* WOT; int G, c;
    __device__ __forceinline__ bool next(int i, Unit& u) const {
        const int L = c + i * G; if (L >= 256) return false;
        u.rows = nullptr; u.nrows = 256; u.ntu = 0;
        if (L < 128) { const int b = L >> 4, h = (L >> 2) & 3, kt = L & 3; u.aux = 0; u.pm = b * 4 + h; u.pn = kt;
            u.A = MK + ((size_t)(b * 256) * D + h * 256) * 2; u.B = WQN + ((size_t)(kt * 256) * D + h * 256) * 2; }
        else { const int l = L - 128, b = l >> 4, nt = (l >> 2) & 3, h = l & 3; u.aux = 1; u.pm = b * 4 + nt; u.pn = h;
            u.A = WOT + ((size_t)(nt * 256) * D + h * 256) * 2; u.B = MV + ((size_t)(b * 256) * D + h * 256) * 2; }
        return true;
    }
};
struct P3Order {
    XmnOrder X; DenseOrder Dn;
    __device__ __forceinline__ bool next(int i, Unit& u) const {
        if (i == 0 && X.c < 256) { X.next(0, u); u.ntu = 4; return true; }
        const bool ok = Dn.next(X.c < 256 ? i - 1 : i, u); u.aux = 2; return ok;
    }
};
struct XbOrder {
    const char* A; const char* Bb; int G, c; size_t rb;
    __device__ __forceinline__ bool next(int i, Unit& u) const {
        const long L = (long)i * G + c; if (L >= 512) return false;
        int pm, pn; tile_order((int)L, T / 256, 4, pm, pn);
        u.pm = pm; u.pn = pn; u.aux = 0; u.rows = nullptr; u.nrows = 256; u.ntu = 0;
        u.A = A + (size_t)pm * 256 * rb; u.B = Bb + (size_t)(pm >> 4) * D * rb + (size_t)pn * 256 * rb; return true;
    }
};
struct MoeOrder {
    const char* A; const char* W; const int* list; const LAS int* cnt; const LAS unsigned char* te; const LAS int* ts;
    int ntiles, nN, G, c; size_t wstride; int gather; size_t atile, btile;
    __device__ __forceinline__ bool next(int i, Unit& u) const {
        const long L = (long)i * G + c; if (L >= (long)ntiles * nN) return false;
        int pm, pn; tile_order((int)L, ntiles, nN, pm, pn);
        const int e = __builtin_amdgcn_readfirstlane((int)te[pm]);
        const int lt = pm - __builtin_amdgcn_readfirstlane(ts[e]);
        const int n = __builtin_amdgcn_readfirstlane(cnt[e]) - lt * 256;
        u.pm = pm; u.pn = pn; u.aux = e; u.nrows = n < 256 ? n : 256; u.ntu = 0;
        u.rows = list + (size_t)e * T + lt * 256;
        u.A = gather ? A : A + (size_t)pm * atile;
        u.B = W + (size_t)e * wstride + (size_t)pn * btile; return true;
    }
};

struct EpiProj {
    static constexpr bool PERM = true, AFTER_DRAIN = false; struct Pre {}; __device__ __forceinline__ void prefetch(const Unit&, int, int, int, int, Pre&) const {}
    bf16_t* O; float* kbar; float asc;
    __device__ __forceinline__ void operator()(const f32x4 (&acc)[2][2][4][2], const Unit& u, int wr, int wc, int fr, int fq, const Pre&) const {
        const int pn = u.pn, sec = pn >> 1, b = u.pm >> 4, t0 = (u.pm & 15) * 256 + wr * 64 + fr;
        const int mode = (pn < 2) ? 1 : ((pn == 6 || pn == 7 || pn >= 12) ? 2 : 0);
        bf16_t* sb = O + (size_t)sec * SEC_ELEMS;
#pragma unroll
        for (int bj = 0; bj < 2; ++bj) {
            const int c = bj * HALF + wc * 32 + 8 * fq, head = (pn & 1) * 4 + (c >> 6), d0 = c & 63;
            bf16_t* hb = sb + (size_t)(b * 8 + head) * (SEQ * 64);
#pragma unroll
            for (int ai = 0; ai < 2; ++ai)
#pragma unroll
                for (int m = 0; m < 4; ++m) { const int t = t0 + ai * HALF + m * 16;
                    f32x4 v0 = acc[ai][bj][m][0] * asc, v1 = acc[ai][bj][m][1] * asc;
                    if (mode == 1) { v0 = v0 * C2Q; v1 = v1 * C2Q; }
                    else if (mode == 2) {
#pragma unroll
                        for (int e = 0; e < 4; ++e) { v0[e] = silu_f(v0[e]); v1[e] = silu_f(v1[e]); } }
                    u32x4 w; w.x = cvtpk(v0[0], v0[1]); w.y = cvtpk(v0[2], v0[3]); w.z = cvtpk(v1[0], v1[1]); w.w = cvtpk(v1[2], v1[3]);
                    size_t off;
                    if (sec == 1) off = (size_t)(t >> 6) * 4096 + (d0 >> 3) * 512 + (t & 63) * 8;
                    else if (sec == 2) off = (size_t)(t >> 6) * 4096 + (d0 >> 5) * 2048 + (t & 63) * 32 + (d0 & 31);
                    else off = (size_t)t * 64 + d0;
                    *(u32x4*)(hb + off) = w; } }
        if (pn == 2 || pn == 3) {
#pragma unroll
            for (int bj = 0; bj < 2; ++bj)
#pragma unroll
                for (int n = 0; n < 2; ++n)
#pragma unroll
                    for (int e = 0; e < 4; ++e) { float s = 0.f;
#pragma unroll
                        for (int ai = 0; ai < 2; ++ai)
#pragma unroll
                            for (int m = 0; m < 4; ++m) s += acc[ai][bj][m][n][e];
                        s += __shfl_xor(s, 1); s += __shfl_xor(s, 2); s += __shfl_xor(s, 4); s += __shfl_xor(s, 8); s *= asc;
                        if (fr == 0) { const int c = bj * HALF + wc * 32 + 8 * fq + 4 * n + e, head = (pn - 2) * 4 + (c >> 6), d = c & 63;
                            atomicAdd(kbar + ((size_t)u.pm * 8 + head) * 64 + d, s); } }
        }
    }
};
struct EpiBf16 {
    static constexpr bool PERM = true, AFTER_DRAIN = false; struct Pre {}; __device__ __forceinline__ void prefetch(const Unit&, int, int, int, int, Pre&) const {}
    bf16_t* O0; int ldc0; bf16_t* O1; int ldc1;
    __device__ __forceinline__ void operator()(const f32x4 (&acc)[2][2][4][2], const Unit& u, int wr, int wc, int fr, int fq, const Pre&) const {
        bf16_t* O = u.aux ? O1 : O0; const int ldc = u.aux ? ldc1 : ldc0;
        const int row0 = u.pm * BM + wr * 64 + fr, col0 = u.pn * BM + wc * 32 + 8 * fq;
#pragma unroll
        for (int ai = 0; ai < 2; ++ai)
#pragma unroll
            for (int m = 0; m < 4; ++m) { bf16_t* rowp = O + (size_t)(row0 + ai * HALF + m * 16) * ldc + col0;
#pragma unroll
                for (int bj = 0; bj < 2; ++bj) { const f32x4 v0 = acc[ai][bj][m][0], v1 = acc[ai][bj][m][1];
                    u32x4 w; w.x = cvtpk(v0[0], v0[1]); w.y = cvtpk(v0[2], v0[3]); w.z = cvtpk(v1[0], v1[1]); w.w = cvtpk(v1[2], v1[3]);
                    *(u32x4*)(rowp + bj * HALF) = w; } }
    }
};
struct EpiFp8 {
    static constexpr bool PERM = true, AFTER_DRAIN = false; struct Pre {}; __device__ __forceinline__ void prefetch(const Unit&, int, int, int, int, Pre&) const {}
    unsigned char* O0; int ldc0; unsigned char* O1; int ldc1; float scale;
    __device__ __forceinline__ void operator()(const f32x4 (&acc)[2][2][4][2], const Unit& u, int wr, int wc, int fr, int fq, const Pre&) const {
        unsigned char* O = u.aux ? O1 : O0; const int ldc = u.aux ? ldc1 : ldc0;
        const int row0 = u.pm * BM + wr * 64 + fr, col0 = u.pn * BM + wc * 32 + 8 * fq;
#pragma unroll
        for (int ai = 0; ai < 2; ++ai)
#pragma unroll
            for (int m = 0; m < 4; ++m) { unsigned char* rowp = O + (size_t)(row0 + ai * HALF + m * 16) * ldc + col0;
#pragma unroll
                for (int bj = 0; bj < 2; ++bj) { const f32x4 v0 = acc[ai][bj][m][0] * scale, v1 = acc[ai][bj][m][1] * scale;
                    *(u32x2*)(rowp + bj * HALF) = (u32x2){pk4_fp8(v0[0], v0[1], v0[2], v0[3]), pk4_fp8(v1[0], v1[1], v1[2], v1[3])}; } }
    }
};
template <bool BASE_F32, int WRITE_F32, bool OUT_FP8 = false> struct EpiRes {
    static constexpr bool PERM = true, AFTER_DRAIN = false; struct Pre {}; __device__ __forceinline__ void prefetch(const Unit&, int, int, int, int, Pre&) const {}
    const void* base; bf16_t* Ob; float* Of; float* ss; float asc; unsigned char* Oq;
    static constexpr int LPG = BASE_F32 ? 4 : 2;
    __device__ __forceinline__ void issue(f32x4 (&b)[4], unsigned voff) const {
        if (BASE_F32) { b[0] = gload128_hidden(base, voff); b[1] = gload128_hidden(base, voff + 16u); b[2] = gload128_hidden(base, voff + HALF * 4u); b[3] = gload128_hidden(base, voff + HALF * 4u + 16u); }
        else { b[0] = gload128_hidden(base, voff); b[1] = gload128_hidden(base, voff + HALF * 2u); }
    }
    __device__ __forceinline__ void operator()(const f32x4 (&acc)[2][2][4][2], const Unit& u, int wr, int wc, int fr, int fq, const Pre&) const {
        const int row0 = u.pm * BM + wr * 64 + fr, col0 = u.pn * BM + wc * 32 + 8 * fq;
        const unsigned esz = BASE_F32 ? 4u : 2u;
        f32x4 lb[8][4];
#define ER_VOFF(g_) ((unsigned)((row0 + ((g_) >> 2) * HALF + ((g_) & 3) * 16) * D + col0) * esz)
#pragma unroll
        for (int g = 0; g < 4; ++g) issue(lb[g], ER_VOFF(g));
#pragma unroll
        for (int g = 0; g < 8; ++g) { const int ai = g >> 2, m = g & 3; const int row = row0 + ai * HALF + m * 16; const size_t off = (size_t)row * D + col0; float sq = 0.f;
            { constexpr int dummy = 0; (void)dummy; const int newer = (7 - g < 3 ? 7 - g : 3) * LPG;
              if (newer == 12) asm volatile("s_waitcnt vmcnt(12)" ::: "memory"); else if (newer == 8) asm volatile("s_waitcnt vmcnt(8)" ::: "memory"); else if (newer == 6) asm volatile("s_waitcnt vmcnt(6)" ::: "memory");
              else if (newer == 4) asm volatile("s_waitcnt vmcnt(4)" ::: "memory"); else if (newer == 2) asm volatile("s_waitcnt vmcnt(2)" ::: "memory"); else asm volatile("s_waitcnt vmcnt(0)" ::: "memory"); }
#pragma unroll
            for (int q = 0; q < LPG; ++q) asm volatile("" : "+v"(lb[g][q]));
#pragma unroll
            for (int bj = 0; bj < 2; ++bj) { f32x4 b0, b1;
                if (BASE_F32) { b0 = lb[g][2 * bj]; b1 = lb[g][2 * bj + 1]; }
                else { const u32x4 w = __builtin_bit_cast(u32x4, lb[g][bj]);
                    b0 = (f32x4){bflo(w.x), bfhi(w.x), bflo(w.y), bfhi(w.y)}; b1 = (f32x4){bflo(w.z), bfhi(w.z), bflo(w.w), bfhi(w.w)}; }
                const f32x4 v0 = acc[ai][bj][m][0] * asc + b0, v1 = acc[ai][bj][m][1] * asc + b1;
                sq += (v0[0] * v0[0] + v0[1] * v0[1]) + (v0[2] * v0[2] + v0[3] * v0[3]) + (v1[0] * v1[0] + v1[1] * v1[1]) + (v1[2] * v1[2] + v1[3] * v1[3]);
                if (OUT_FP8) { *(u32x2*)((unsigned char*)Ob + off + bj * HALF) = (u32x2){pk4_fp8(v0[0], v0[1], v0[2], v0[3]), pk4_fp8(v1[0], v1[1], v1[2], v1[3])}; }
                else { u32x4 w; w.x = cvtpk(v0[0], v0[1]); w.y = cvtpk(v0[2], v0[3]); w.z = cvtpk(v1[0], v1[1]); w.w = cvtpk(v1[2], v1[3]);
                *(u32x4*)(Ob + off + bj * HALF) = w; }
                if (Oq) *(u32x2*)(Oq + off + bj * HALF) = (u32x2){pk4_fp8(v0[0], v0[1], v0[2], v0[3]), pk4_fp8(v1[0], v1[1], v1[2], v1[3])};
                if (WRITE_F32 == 1) { *(f32x4*)(Of + off + bj * HALF) = v0; *(f32x4*)(Of + off + bj * HALF + 4) = v1; }
                if (WRITE_F32 == 2) { u32x4 w; w.x = cvtpk(v0[0], v0[1]); w.y = cvtpk(v0[2], v0[3]); w.z = cvtpk(v1[0], v1[1]); w.w = cvtpk(v1[2], v1[3]);
                    *(u32x4*)((bf16_t*)Of + off + bj * HALF) = w;
                    *(u32x2*)((unsigned char*)Of + (size_t)T * D * 2 + off + bj * HALF) = (u32x2){
                        pk4_fp8((v0[0] - bflo(w.x)) * 1024.f, (v0[1] - bfhi(w.x)) * 1024.f, (v0[2] - bflo(w.y)) * 1024.f, (v0[3] - bfhi(w.y)) * 1024.f),
                        pk4_fp8((v1[0] - bflo(w.z)) * 1024.f, (v1[1] - bfhi(w.z)) * 1024.f, (v1[2] - bflo(w.w)) * 1024.f, (v1[3] - bfhi(w.w)) * 1024.f)}; } }
            sq += __shfl_xor(sq, 16); sq += __shfl_xor(sq, 32);
            if (fq == 0) atomicAdd(ss + row, sq);
            if (g + 4 < 8) issue(lb[g + 4], ER_VOFF(g + 4)); }
#undef ER_VOFF
    }
};
struct EpiP3 {
    static constexpr bool PERM = true, AFTER_DRAIN = false; struct Pre {}; __device__ __forceinline__ void prefetch(const Unit&, int, int, int, int, Pre&) const {}
    EpiFp8 a; EpiRes<true, 0> b;
    __device__ __forceinline__ void operator()(const f32x4 (&acc)[2][2][4][2], const Unit& u, int wr, int wc, int fr, int fq, const Pre&) const {
        if (u.aux < 2) a(acc, u, wr, wc, fr, fq, EpiFp8::Pre{}); else b(acc, u, wr, wc, fr, fq, EpiRes<true, 0>::Pre{});
    }
};
struct EpiQ {
    static constexpr bool PERM = true, AFTER_DRAIN = false; struct Pre {}; __device__ __forceinline__ void prefetch(const Unit&, int, int, int, int, Pre&) const {}
    bf16_t* O; const float* ss;
    __device__ __forceinline__ void operator()(const f32x4 (&acc)[2][2][4][2], const Unit& u, int wr, int wc, int fr, int fq, const Pre&) const {
        const int row0 = u.pm * BM + wr * 64 + fr, col0 = u.pn * BM + wc * 32 + 8 * fq;
#pragma unroll
        for (int ai = 0; ai < 2; ++ai)
#pragma unroll
            for (int m = 0; m < 4; ++m) { const int row = row0 + ai * HALF + m * 16; const float sc = C2X * __builtin_amdgcn_rsqf(ss[row] * (1.0f / D) + EPS);
                bf16_t* rowp = O + (size_t)row * D + col0;
#pragma unroll
                for (int bj = 0; bj < 2; ++bj) { const f32x4 v0 = acc[ai][bj][m][0] * sc, v1 = acc[ai][bj][m][1] * sc;
                    u32x4 w; w.x = cvtpk(v0[0], v0[1]); w.y = cvtpk(v0[2], v0[3]); w.z = cvtpk(v1[0], v1[1]); w.w = cvtpk(v1[2], v1[3]);
                    *(u32x4*)(rowp + bj * HALF) = w; } }
    }
};
struct EpiSoftmaxS {
    static constexpr bool PERM = true, AFTER_DRAIN = false; struct Pre {}; __device__ __forceinline__ void prefetch(const Unit&, int, int, int, int, Pre&) const {}
    unsigned char* P; const float* ss; LAS unsigned char* tb; float qs;
    __device__ __forceinline__ void operator()(f32x4 (&acc)[2][2][4][2], const Unit& u, int wr, int wc, int fr, int fq, const Pre&) const {
        LAS float* MX = (LAS float*)tb;
        LAS float* SM = (LAS float*)(tb + 4096);
#pragma unroll
        for (int ai = 0; ai < 2; ++ai)
#pragma unroll
            for (int m = 0; m < 4; ++m) { const int r = ai * HALF + wr * 64 + m * 16 + fr; const float sc = qs * C2X * __builtin_amdgcn_rsqf(ss[u.pm * BM + r] * (1.0f / D) + EPS); float mx = -3.0e38f;
#pragma unroll
                for (int bj = 0; bj < 2; ++bj)
#pragma unroll
                    for (int n = 0; n < 2; ++n) { f32x4 x = acc[ai][bj][m][n] * sc; acc[ai][bj][m][n] = x; mx = fmaxf(mx, fmaxf(fmaxf(x[0], x[1]), fmaxf(x[2], x[3]))); }
                mx = fmaxf(mx, __shfl_xor(mx, 16)); mx = fmaxf(mx, __shfl_xor(mx, 32));
                if (fq == 0) MX[r * 4 + wc] = mx; }
        LDS_WAIT(); __builtin_amdgcn_s_barrier(); asm volatile("" ::: "memory");
#pragma unroll
        for (int ai = 0; ai < 2; ++ai)
#pragma unroll
            for (int m = 0; m < 4; ++m) { const int r = ai * HALF + wr * 64 + m * 16 + fr; const f32x4 q = *(const LAS f32x4*)(MX + r * 4);
                const float mx = fmaxf(fmaxf(q[0], q[1]), fmaxf(q[2], q[3])); float sm = 0.f;
#pragma unroll
                for (int bj = 0; bj < 2; ++bj)
#pragma unroll
                    for (int n = 0; n < 2; ++n) { f32x4 x = acc[ai][bj][m][n];
#pragma unroll
                        for (int e = 0; e < 4; ++e) { x[e] = fast_exp2(x[e] - mx); sm += x[e]; }
                        acc[ai][bj][m][n] = x; }
                sm += __shfl_xor(sm, 16); sm += __shfl_xor(sm, 32);
                if (fq == 0) SM[r * 4 + wc] = sm; }
        LDS_WAIT(); __builtin_amdgcn_s_barrier(); asm volatile("" ::: "memory");
        const int col0 = u.pn * BM + wc * 32 + 8 * fq;
#pragma unroll
        for (int ai = 0; ai < 2; ++ai)
#pragma unroll
            for (int m = 0; m < 4; ++m) { const int r = ai * HALF + wr * 64 + m * 16 + fr; const f32x4 q = *(const LAS f32x4*)(SM + r * 4);
                const float inv = PSCALE8 * fast_rcp((q[0] + q[1]) + (q[2] + q[3]));
#pragma unroll
                for (int bj = 0; bj < 2; ++bj) { const f32x4 v0 = acc[ai][bj][m][0] * inv, v1 = acc[ai][bj][m][1] * inv;
                    *(u32x2*)(P + ((size_t)u.pm * BM + r) * D + bj * HALF + col0) = (u32x2){pk4_fp8(v0[0], v0[1], v0[2], v0[3]), pk4_fp8(v1[0], v1[1], v1[2], v1[3])}; } }
        LDS_WAIT(); __builtin_amdgcn_s_barrier(); asm volatile("" ::: "memory");
    }
};
struct EpiW1 {
    static constexpr bool PERM = true, AFTER_DRAIN = false;
    struct Pre { float sc[8]; f32x4 bq[4]; };
    bf16_t* O; const float* ssl; const float* b1; const int* list0;
    __device__ __forceinline__ void prefetch(const Unit& u, int wr, int wc, int fr, int fq, Pre& p) const {
        const float* sp = ssl + (u.rows - list0);
        { const float* bb = b1 + (size_t)u.aux * 2048 + 2 * (u.pn * 128); const unsigned bo = (unsigned)(2 * (wc * 32 + 8 * fq)) * 4u;
#pragma unroll
          for (int q = 0; q < 4; ++q) p.bq[q] = gload128_hidden(bb, bo + 16u * q); }
#pragma unroll
        for (int ai = 0; ai < 2; ++ai)
#pragma unroll
            for (int m = 0; m < 4; ++m) { const int r = ai * HALF + wr * 64 + m * 16 + fr; const int rr = r < u.nrows ? r : u.nrows - 1; p.sc[ai * 4 + m] = __uint_as_float(gload32_hidden(sp, (unsigned)rr * 4u)); }
    }
    __device__ __forceinline__ void operator()(const f32x4 (&acc)[2][2][4][2], const Unit& u, int wr, int wc, int fr, int fq, const Pre& pre) const {
        const int c0 = wc * 32 + 8 * fq;
        f32x4 bq0 = pre.bq[0], bq1 = pre.bq[1], bq2 = pre.bq[2], bq3 = pre.bq[3]; asm volatile("" : "+v"(bq0), "+v"(bq1), "+v"(bq2), "+v"(bq3));
        const float bg[8] = {bq0[0], bq0[2], bq1[0], bq1[2], bq2[0], bq2[2], bq3[0], bq3[2]};
        const float bl[8] = {bq0[1], bq0[3], bq1[1], bq1[3], bq2[1], bq2[3], bq3[1], bq3[3]};
#pragma unroll
        for (int ai = 0; ai < 2; ++ai)
#pragma unroll
            for (int m = 0; m < 4; ++m) { const int r = ai * HALF + wr * 64 + m * 16 + fr;
                float ssv = pre.sc[ai * 4 + m]; asm volatile("" : "+v"(ssv));
                const float sc = WSCALE8_INV * __builtin_amdgcn_rsqf(ssv * (1.0f / D) + EPS); float a[8];
#pragma unroll
                for (int j = 0; j < 8; ++j) { const float g = acc[ai][0][m][j >> 2][j & 3] * sc + bg[j], l = acc[ai][1][m][j >> 2][j & 3] * sc + bl[j];
                    const float glu = fminf(g, 7.0f), lin = fminf(fmaxf(l, -7.0f), 7.0f);
                    a[j] = glu * fast_rcp(1.0f + fast_exp2(-1.702f * LOG2E * glu)) * (lin + 1.0f); }
                *(u32x2*)((unsigned char*)O + ((size_t)u.pm * BM + r) * D + u.pn * 128 + c0) = (u32x2){pk4_fp8(a[0], a[1], a[2], a[3]), pk4_fp8(a[4], a[5], a[6], a[7])}; }
    }
};
constexpr float YSCALE = 16.0f, YSCALE_INV = 1.0f / 16.0f;
struct EpiW2 {
    static constexpr bool PERM = true, AFTER_DRAIN = false;
    struct Pre { float g[8]; f32x4 bv[4]; };
    unsigned char* O; const float* b2; const int* list0; const float* gl0;
    __device__ __forceinline__ void prefetch(const Unit& u, int wr, int wc, int fr, int fq, Pre& p) const {
        const float* gp = gl0 + (u.rows - list0);
        { const float* bb = b2 + (size_t)u.aux * D + u.pn * BM; const unsigned bo = (unsigned)(wc * 32 + 8 * fq) * 4u;
#pragma unroll
          for (int q = 0; q < 4; ++q) p.bv[q] = gload128_hidden(bb, bo + (unsigned)((q >> 1) * HALF * 4 + (q & 1) * 16)); }
#pragma unroll
        for (int ai = 0; ai < 2; ++ai)
#pragma unroll
            for (int m = 0; m < 4; ++m) { const int r = ai * HALF + wr * 64 + m * 16 + fr; const int rr = r < u.nrows ? r : u.nrows - 1; p.g[ai * 4 + m] = __uint_as_float(gload32_hidden(gp, (unsigned)rr * 4u)); }
    }
    __device__ __forceinline__ void operator()(const f32x4 (&acc)[2][2][4][2], const Unit& u, int wr, int wc, int fr, int fq, const Pre& pre) const {
        const int row0 = u.pm * BM + wr * 64 + fr, col0 = u.pn * BM + wc * 32 + 8 * fq;
        f32x4 bv[2][2]; bv[0][0] = pre.bv[0]; bv[0][1] = pre.bv[1]; bv[1][0] = pre.bv[2]; bv[1][1] = pre.bv[3]; asm volatile("" : "+v"(bv[0][0]), "+v"(bv[0][1]), "+v"(bv[1][0]), "+v"(bv[1][1]));
#pragma unroll
        for (int ai = 0; ai < 2; ++ai)
#pragma unroll
            for (int m = 0; m < 4; ++m) { unsigned char* rowp = O + (size_t)(row0 + ai * HALF + m * 16) * D + col0; float gv = pre.g[ai * 4 + m]; asm volatile("" : "+v"(gv)); const float g = YSCALE * gv;
#pragma unroll
                for (int bj = 0; bj < 2; ++bj) { const f32x4 v0 = (acc[ai][bj][m][0] * WSCALE8_INV + bv[bj][0]) * g, v1 = (acc[ai][bj][m][1] * WSCALE8_INV + bv[bj][1]) * g;
                    *(u32x2*)(rowp + bj * HALF) = (u32x2){pk4_fp8(v0[0], v0[1], v0[2], v0[3]), pk4_fp8(v1[0], v1[1], v1[2], v1[3])}; } }
    }
};
}

namespace moba {
using bf16x8 = ::bf16x8; using s16x4 = ::s16x4; using f32x16 = ::f32x16; using u32x4 = ::u32x4;
constexpr int DMQ = INC, DMO = D, HD = 64;
constexpr int NW = 8, QBLK = 32, QB = 256, KVBLK = 64;
__device__ __forceinline__ int crow(int r, int hi) { return (r & 3) + 8 * (r >> 2) + 4 * hi; }
#define SBAR() __builtin_amdgcn_sched_barrier(0)
__device__ __forceinline__ void cmask(f32x16& p0, f32x16& p1, int jb, int qrel, int hi) {
    const float NEG = -INFINITY; int kb = 64 * jb + 4 * hi;
#pragma unroll
    for (int r = 0; r < 16; ++r) { int kv = kb + (r & 3) + 8 * (r >> 2); if (kv > qrel) p0[r] = NEG; if (kv + 32 > qrel) p1[r] = NEG; }
}
constexpr int NSLOT = 3, SLOTB = 8192;
constexpr int LDS_K = 0, LDS_V = NSLOT * SLOTB, LDS_WS = 2 * NSLOT * SLOTB, LDS_OST = LDS_WS + NW * 64 * 4, LDS_KB = LDS_OST + NW * 4096, LDS_BYTES = LDS_KB + 16 * 64 * 4;
__device__ __forceinline__ void glds16(const void* gsrc, unsigned lds_dst) { unsigned keep;
    asm volatile("s_mov_b32 %0, m0\n\ts_mov_b32 m0, %2\n\ts_nop 0\n\tglobal_load_lds_dwordx4 %1, off\n\ts_mov_b32 m0, %0" : "=&s"(keep) : "v"(gsrc), "s"(lds_dst) : "memory"); }
__device__ __forceinline__ float max3f(float a, float b, float c) { float r; asm("v_max3_f32 %0, %1, %2, %3" : "=v"(r) : "v"(a), "v"(b), "v"(c)); return r; }
__device__ __forceinline__ float max2f(float a, float b) { float r; asm("v_max_f32_e32 %0, %1, %2" : "=v"(r) : "v"(a), "v"(b)); return r; }
__device__ __forceinline__ float fadd_s(float a, float b) { float r; asm("v_add_f32_e32 %0, %1, %2" : "=v"(r) : "v"(a), "v"(b)); return r; }
__device__ __forceinline__ float fsub_s(float a, float b) { float r; asm("v_sub_f32_e32 %0, %1, %2" : "=v"(r) : "v"(a), "v"(b)); return r; }
__device__ __forceinline__ unsigned cvtpk_s(float lo, float hi) { return ::cvtpk(lo, hi); }
#define WAIT_BAR(N) asm volatile("s_waitcnt vmcnt(" #N ") lgkmcnt(0)\n\ts_barrier" ::: "memory")
__device__ __forceinline__ void qkt(f32x16& p0, f32x16& p1, const char* Kslot, const bf16x8* qr, const f32x16& negm, int r32, int hi) {
    const char* kb = Kslot + hi * 1024 + r32 * 16;
#pragma unroll
    for (int d0 = 0; d0 < 4; ++d0) {
        const bf16x8 b0 = *reinterpret_cast<const bf16x8*>(kb + d0 * 2048);
        const bf16x8 b1 = *reinterpret_cast<const bf16x8*>(kb + d0 * 2048 + 512);
        if (d0 == 0) { p0 = __builtin_amdgcn_mfma_f32_32x32x16_bf16(b0, qr[0], negm, 0, 0, 0); p1 = __builtin_amdgcn_mfma_f32_32x32x16_bf16(b1, qr[0], negm, 0, 0, 0); }
        else { p0 = __builtin_amdgcn_mfma_f32_32x32x16_bf16(b0, qr[d0], p0, 0, 0, 0); p1 = __builtin_amdgcn_mfma_f32_32x32x16_bf16(b1, qr[d0], p1, 0, 0, 0); } }
}
typedef __attribute__((address_space(3))) const char* lds_cptr;
typedef short v4i16_t __attribute__((ext_vector_type(4)));
__device__ __forceinline__ void kload8(bf16x8* kf, lds_cptr kp) {
    kf[0] = *(const __attribute__((address_space(3))) bf16x8*)(kp);        kf[1] = *(const __attribute__((address_space(3))) bf16x8*)(kp + 512);
    kf[2] = *(const __attribute__((address_space(3))) bf16x8*)(kp + 2048); kf[3] = *(const __attribute__((address_space(3))) bf16x8*)(kp + 2560);
    kf[4] = *(const __attribute__((address_space(3))) bf16x8*)(kp + 4096); kf[5] = *(const __attribute__((address_space(3))) bf16x8*)(kp + 4608);
    kf[6] = *(const __attribute__((address_space(3))) bf16x8*)(kp + 6144); kf[7] = *(const __attribute__((address_space(3))) bf16x8*)(kp + 6656);
}
__device__ __forceinline__ void kload2(bf16x8* kf, lds_cptr kp, int j) { kf[2 * j] = *(const __attribute__((address_space(3))) bf16x8*)(kp + j * 2048); kf[2 * j + 1] = *(const __attribute__((address_space(3))) bf16x8*)(kp + j * 2048 + 512); }
__device__ __forceinline__ s16x4 vtr(lds_cptr p) { return __builtin_bit_cast(s16x4, __builtin_amdgcn_ds_read_tr16_b64_v4i16((__attribute__((address_space(3))) v4i16_t*)p)); }
__device__ __forceinline__ float rowmax(const f32x16& p0, const f32x16& p1) {
    float a = max3f(p0[0], p0[1], p1[0]), b = max3f(p0[2], p0[3], p1[1]); a = max3f(a, p1[2], p1[3]);
#pragma unroll
    for (int r = 4; r < 16; r += 4) { a = max3f(a, p0[r], p0[r + 1]); b = max3f(b, p0[r + 2], p0[r + 3]); a = max3f(a, p1[r], p1[r + 1]); b = max3f(b, p1[r + 2], p1[r + 3]); }
    const float m = max2f(a, b);
    auto rr = __builtin_amdgcn_permlane32_swap(__float_as_uint(m), __float_as_uint(m), false, false);
    return max2f(__uint_as_float(rr[0]), __uint_as_float(rr[1]));
}
__device__ __forceinline__ void pv(f32x16* o, int vb, bf16x8 pa0, bf16x8 pa1, bf16x8 pa2, bf16x8 pa3) {
#pragma unroll
    for (int d0 = 0; d0 < 2; ++d0) { s16x4 lo[4], hi[4];
#pragma unroll
        for (int ks = 0; ks < 4; ++ks) {
            asm volatile("ds_read_b64_tr_b16 %0,%1 offset:%c2" : "=&v"(lo[ks]) : "v"(vb), "i"(d0 * 4096 + ks * 1024) : "memory");
            asm volatile("ds_read_b64_tr_b16 %0,%1 offset:%c2" : "=&v"(hi[ks]) : "v"(vb), "i"(d0 * 4096 + ks * 1024 + 512) : "memory"); }
        asm volatile("s_waitcnt lgkmcnt(0)" ::: "memory"); SBAR();
#define PK(k) (bf16x8){lo[k][0], lo[k][1], lo[k][2], lo[k][3], hi[k][0], hi[k][1], hi[k][2], hi[k][3]}
        o[d0] = __builtin_amdgcn_mfma_f32_32x32x16_bf16(pa0, PK(0), o[d0], 0, 0, 0);
        o[d0] = __builtin_amdgcn_mfma_f32_32x32x16_bf16(pa1, PK(1), o[d0], 0, 0, 0);
        o[d0] = __builtin_amdgcn_mfma_f32_32x32x16_bf16(pa2, PK(2), o[d0], 0, 0, 0);
        o[d0] = __builtin_amdgcn_mfma_f32_32x32x16_bf16(pa3, PK(3), o[d0], 0, 0, 0);
#undef PK
    }
}
constexpr float NEGBIG = -1.0e30f;

template <int THRL> __device__ __forceinline__ void attn_unit(int b, int h, int qb, const bf16_t* Qg, const bf16_t* __restrict__ Kg, const bf16_t* __restrict__ Vg, bf16_t* Og, const float* __restrict__ kbar, char* shm) {
    int tid_ = threadIdx.x; asm volatile("" : "+v"(tid_));
    const int tid = tid_, lane = tid & 63, r32 = lane & 31, hi = lane >> 5; const int wid = __builtin_amdgcn_readfirstlane(tid >> 6);
    const long rowbase = (long)b * SEQ; const int q0 = qb * QB;
    const size_t hoff = (size_t)(b * 8 + h) * (SEQ * 64);
    const bf16_t* Qw = Qg + hoff + (size_t)(q0 + wid * QBLK) * 64;
    const bf16_t* Kh = Kg + hoff, *Vh = Vg + hoff;
    const unsigned lds0 = (unsigned)(uintptr_t)shm;
    float* wsf = (float*)(shm + LDS_WS) + wid * 64;
    const bf16_t* ksrc = Kh + wid * 512 + lane * 8;
    const bf16_t* vsrc = Vh + wid * 512 + lane * 8;
    const unsigned kdst = lds0 + LDS_K + wid * 1024, vdst = lds0 + LDS_V + wid * 1024;
    const int NT = 4 * qb + 4, NPAST = 4 * qb;
#define TMAP(t) (((t) < 4) ? (NPAST + (t)) : ((t) - 4))
#define DMA_K(t, slot) glds16(ksrc + (long)TMAP(t) * 4096, (unsigned)__builtin_amdgcn_readfirstlane(kdst + (slot)))
#define DMA_V(t, slot) glds16(vsrc + (long)TMAP(t) * 4096, (unsigned)__builtin_amdgcn_readfirstlane(vdst + (slot)))
    const char* Kbase = shm + LDS_K; bf16x8 kf[8];
    const lds_cptr shm3 = (lds_cptr)shm; const lds_cptr kp0 = shm3 + LDS_K + hi * 1024 + r32 * 16; const lds_cptr vp0 = shm3 + LDS_V + ((lane >> 4) & 1) * 32 + (lane & 3) * 8 + (4 * hi + ((lane & 15) >> 2)) * 64;
    DMA_K(0, 0); DMA_V(0, 0); DMA_K(1, SLOTB);
    bf16x8 qr[4];
#pragma unroll
    for (int d0 = 0; d0 < 4; ++d0) qr[d0] = *reinterpret_cast<const bf16x8*>(&Qw[(long)r32 * 64 + d0 * 16 + hi * 8]);
    unsigned selm = 0u;
    if (qb > 0) {
        float* kbl = (float*)(shm + LDS_KB);
        for (int i = tid; i < qb * 64; i += NW * 64) kbl[i] = kbar[((size_t)(b * 16 + (i >> 6)) * 8 + h) * 64 + (i & 63)];
        asm volatile("s_waitcnt vmcnt(0) lgkmcnt(0)\n\ts_barrier" ::: "memory");
        if (qb <= 3) selm = (1u << qb) - 1u;
        else {
            float qf[32];
#pragma unroll
            for (int d0 = 0; d0 < 4; ++d0)
#pragma unroll
                for (int j = 0; j < 8; ++j) qf[d0 * 8 + j] = bf2f((unsigned short)qr[d0][j]);
            float g[15];
#pragma unroll
            for (int n = 0; n < 15; ++n) { float s = 0.f;
                if (n < qb) {
#pragma unroll
                    for (int d0 = 0; d0 < 4; ++d0) { const f32x4 k0 = *(const f32x4*)(kbl + n * 64 + d0 * 16 + hi * 8), k1 = *(const f32x4*)(kbl + n * 64 + d0 * 16 + hi * 8 + 4);
                        s += qf[d0 * 8 + 0] * k0[0] + qf[d0 * 8 + 1] * k0[1] + qf[d0 * 8 + 2] * k0[2] + qf[d0 * 8 + 3] * k0[3] + qf[d0 * 8 + 4] * k1[0] + qf[d0 * 8 + 5] * k1[1] + qf[d0 * 8 + 6] * k1[2] + qf[d0 * 8 + 7] * k1[3]; }
                    s += __shfl_xor(s, 32);
                } else s = -INFINITY;
                g[n] = s; }
#pragma unroll
            for (int pass = 0; pass < 3; ++pass) { float best = -INFINITY; int bi = 0;
#pragma unroll
                for (int n = 0; n < 15; ++n) if (g[n] > best) { best = g[n]; bi = n; }
                selm |= 1u << bi;
#pragma unroll
                for (int n = 0; n < 15; ++n) if (n == bi) g[n] = -INFINITY; }
        }
    }
    float mhat = 0.f, l_reg = 0.f; f32x16 o[2]; o[0] = f32x16{}; o[1] = f32x16{}; f32x16 cini = f32x16{}; asm volatile("" : "+v"(cini));
    const int qrel = wid * QBLK + r32;
#define SETC(t, JB) do { const float cm_ = ((JB >= 0) || ((selm >> (((t) - 4) >> 2)) & 1u)) ? -mhat : NEGBIG; \
      _Pragma("unroll") for (int r = 0; r < 16; ++r) cini[r] = cm_; asm volatile("" : "+v"(cini)); } while (0)
    bool resc = false;
#define START(P0, P1) do { const float rm = rowmax(P0, P1); resc = false; \
    { const float dl = rm; mhat = fadd_s(mhat, dl); \
      _Pragma("unroll") for (int r = 0; r < 16; ++r) { P0[r] = fsub_s(P0[r], dl); P1[r] = fsub_s(P1[r], dl); } } \
    _Pragma("unroll") for (int r = 0; r < 16; ++r) P0[r] = __builtin_amdgcn_exp2f(P0[r]); } while (0)
#define RESC() do { if (resc) { asm volatile("s_waitcnt lgkmcnt(0)" ::: "memory"); \
      _Pragma("unroll") for (int d_ = 0; d_ < 2; ++d_) _Pragma("unroll") for (int r = 0; r < 16; ++r) o[d_][r] *= wsf[crow(r, hi)]; } } while (0)
    f32x16 pA0, pA1, pB0, pB1;
    int sl_prev = 0, sl_cur = 0, sl_next = SLOTB;
#define ROT() do { sl_prev = sl_cur; sl_cur = sl_next; sl_next = (sl_next == (NSLOT - 1) * SLOTB) ? 0 : sl_next + SLOTB; } while (0)
    DMA_K(2, 2 * SLOTB);
    if (qb > 0) { WAIT_BAR(0); } else { WAIT_BAR(3); }
    qkt(pA0, pA1, Kbase, qr, cini, r32, hi); asm volatile("s_nop 15\n\ts_nop 7" : "+v"(pA0), "+v"(pA1)); cmask(pA0, pA1, 0, qrel, hi);
    START(pA0, pA1);
    _Pragma("unroll") for (int r = 0; r < 16; ++r) pA1[r] = __builtin_amdgcn_exp2f(pA1[r]);
    WAIT_BAR(0);
    DMA_K(3, 0); DMA_V(1, SLOTB);
    ROT();
    kload8(kf, kp0 + sl_cur);
    WAIT_BAR(2);
    s16x4 vlo[8], vhi[8]; u32x4 pw0, pw1, pw2, pw3;
#define PKW(P, B) cvtpk_s(P[B], P[B + 1])
#define PAF(k) __builtin_bit_cast(bf16x8, pw##k)
#define VFR(i) (bf16x8){vlo[i][0], vlo[i][1], vlo[i][2], vlo[i][3], vhi[i][0], vhi[i][1], vhi[i][2], vhi[i][3]}
#define PIN(x) asm volatile("" : "+v"(x))
#define MX3(a, b, c) __builtin_fmaxf(__builtin_fmaxf((a), (b)), (c))
#define GAPA(MF, A0, A1, A2, A3, W0, W1, PW) do { MF; sacc += A0; sacc += A1; sacc += A2; sacc += A3; PIN(sacc); W0; W1; PIN(PW); SBAR(); } while (0)
#define EX(v) __builtin_amdgcn_exp2f(v)
#define GAPB(MF, X, B) do { MF; X[B] = EX(X[B]); X[B + 1] = EX(X[B + 1]); X[B + 2] = EX(X[B + 2]); X[B + 3] = EX(X[B + 3]); PIN(X); SBAR(); } while (0)
#define VRD(i) do { vlo[i] = vtr(vp_ + (((i) >> 2) * 4096 + ((i) & 3) * 1024)); vhi[i] = vtr(vp_ + (((i) >> 2) * 4096 + ((i) & 3) * 1024 + 512)); } while (0)
#define KRD(G, j) do { if (G) { kload2(kf, kp0 + sl_next, j); SBAR(); } } while (0)
#define STEP(C0, C1, P0, P1, t, GK, GV, GL, JB) do { SETC(t, JB); SBAR(); \
    const lds_cptr vp_ = vp0 + sl_prev; \
    VRD(0); SBAR(); float sacc = (P0[0] + P0[1]); \
    GAPA(C0 = __builtin_amdgcn_mfma_f32_32x32x16_bf16(kf[0], qr[0], cini, 0, 0, 0), P0[2], P0[3], P0[4], P0[5],     pw0[0] = PKW(P0, 0), pw0[1] = PKW(P0, 2), pw0); \
    VRD(4); SBAR(); GAPA(C1 = __builtin_amdgcn_mfma_f32_32x32x16_bf16(kf[1], qr[0], cini, 0, 0, 0), P0[6], P0[7], P0[8], P0[9],     pw0[2] = PKW(P0, 4), pw0[3] = PKW(P0, 6), pw0); \
    VRD(1); SBAR(); GAPA(C0 = __builtin_amdgcn_mfma_f32_32x32x16_bf16(kf[2], qr[1], C0, 0, 0, 0),   P0[10], P0[11], P0[12], P0[13], pw1[0] = PKW(P0, 8), pw1[1] = PKW(P0, 10), pw1); \
    VRD(5); SBAR(); GAPA(C1 = __builtin_amdgcn_mfma_f32_32x32x16_bf16(kf[3], qr[1], C1, 0, 0, 0),   P0[14], P0[15], P1[0], P1[1],   pw1[2] = PKW(P0, 12), pw1[3] = PKW(P0, 14), pw1); \
    VRD(2); SBAR(); GAPA(C0 = __builtin_amdgcn_mfma_f32_32x32x16_bf16(kf[4], qr[2], C0, 0, 0, 0),   P1[2], P1[3], P1[4], P1[5],     pw2[0] = PKW(P1, 0), pw2[1] = PKW(P1, 2), pw2); \
    VRD(6); SBAR(); GAPA(C1 = __builtin_amdgcn_mfma_f32_32x32x16_bf16(kf[5], qr[2], C1, 0, 0, 0),   P1[6], P1[7], P1[8], P1[9],     pw2[2] = PKW(P1, 4), pw2[3] = PKW(P1, 6), pw2); \
    VRD(3); SBAR(); GAPA(C0 = __builtin_amdgcn_mfma_f32_32x32x16_bf16(kf[6], qr[3], C0, 0, 0, 0),   P1[10], P1[11], P1[12], P1[13], pw3[0] = PKW(P1, 8), pw3[1] = PKW(P1, 10), pw3); \
    VRD(7); SBAR(); GAPA(C1 = __builtin_amdgcn_mfma_f32_32x32x16_bf16(kf[7], qr[3], C1, 0, 0, 0),   P1[14], P1[15], 0.f, 0.f,       pw3[2] = PKW(P1, 12), pw3[3] = PKW(P1, 14), pw3); \
    l_reg += sacc; \
    if (GK) { DMA_K((t) + 3, sl_cur); } if (GV) { DMA_V((t) + 1, sl_next); } \
    if (JB >= 0) cmask(C0, C1, JB, qrel, hi); \
    { float a = MX3(C0[0], C0[1], C1[0]), b_ = MX3(C0[2], C0[3], C1[1]); a = MX3(a, C1[2], C1[3]); \
      _Pragma("unroll") for (int r = 4; r < 16; r += 4) { a = MX3(a, C0[r], C0[r + 1]); b_ = MX3(b_, C0[r + 2], C0[r + 3]); a = MX3(a, C1[r], C1[r + 1]); b_ = MX3(b_, C1[r + 2], C1[r + 3]); } \
      float rm = __builtin_fmaxf(a, b_); { auto rr = __builtin_amdgcn_permlane32_swap(__float_as_uint(rm), __float_as_uint(rm), false, false); rm = __builtin_fmaxf(__uint_as_float(rr[0]), __uint_as_float(rr[1])); } \
      resc = false; \
      if (__builtin_expect(__any(rm > (float)THRL), 0)) { const float dl = __builtin_fmaxf(rm, 0.f); mhat += dl; \
        _Pragma("unroll") for (int r = 0; r < 16; ++r) { C0[r] -= dl; C1[r] -= dl; } \
        const float f = __builtin_amdgcn_exp2f(-dl); l_reg *= f; if (hi == 0) wsf[r32] = f; resc = true; } } \
    SBAR(); \
    GAPB(o[0] = __builtin_amdgcn_mfma_f32_32x32x16_bf16(PAF(0), VFR(0), o[0], 0, 0, 0), C0, 0); \
    GAPB(o[1] = __builtin_amdgcn_mfma_f32_32x32x16_bf16(PAF(0), VFR(4), o[1], 0, 0, 0), C0, 4); \
    KRD(GL, 0); GAPB(o[0] = __builtin_amdgcn_mfma_f32_32x32x16_bf16(PAF(1), VFR(1), o[0], 0, 0, 0), C0, 8); \
    KRD(GL, 1); GAPB(o[1] = __builtin_amdgcn_mfma_f32_32x32x16_bf16(PAF(1), VFR(5), o[1], 0, 0, 0), C0, 12); \
    KRD(GL, 2); GAPB(o[0] = __builtin_amdgcn_mfma_f32_32x32x16_bf16(PAF(2), VFR(2), o[0], 0, 0, 0), C1, 0); \
    KRD(GL, 3); GAPB(o[1] = __builtin_amdgcn_mfma_f32_32x32x16_bf16(PAF(2), VFR(6), o[1], 0, 0, 0), C1, 4); \
    GAPB(o[0] = __builtin_amdgcn_mfma_f32_32x32x16_bf16(PAF(3), VFR(3), o[0], 0, 0, 0), C1, 8); \
    GAPB(o[1] = __builtin_amdgcn_mfma_f32_32x32x16_bf16(PAF(3), VFR(7), o[1], 0, 0, 0), C1, 12); \
    } while (0)
#define ENDW(tt) do { if ((tt) + 3 < NT) { WAIT_BAR(2); } else if ((tt) + 2 < NT) { WAIT_BAR(1); } else { WAIT_BAR(0); } } while (0)
    STEP(pB0, pB1, pA0, pA1, 1, (4 < NT), true, true, 1);   ENDW(1); RESC(); ROT();
    STEP(pA0, pA1, pB0, pB1, 2, (5 < NT), true, true, 2);   ENDW(2); RESC(); ROT();
    STEP(pB0, pB1, pA0, pA1, 3, (6 < NT), (4 < NT), (4 < NT), 3);   ENDW(3); RESC(); ROT();
    int t = 4;
    for (; t + 4 < NT; t += 2) {
        STEP(pA0, pA1, pB0, pB1, t, true, true, true, -1);       WAIT_BAR(2); RESC(); ROT();
        STEP(pB0, pB1, pA0, pA1, t + 1, true, true, true, -1);   WAIT_BAR(2); RESC(); ROT();
    }
    for (; t < NT; t += 2) {
        STEP(pA0, pA1, pB0, pB1, t, (t + 3 < NT), true, true, -1);                       ENDW(t);     RESC(); ROT();
        STEP(pB0, pB1, pA0, pA1, t + 1, (t + 4 < NT), (t + 2 < NT), (t + 2 < NT), -1);   ENDW(t + 1); RESC(); ROT();
    }
    { float sacc = pB0[0] + pB0[1]; _Pragma("unroll") for (int r = 2; r < 16; ++r) sacc += pB0[r]; _Pragma("unroll") for (int r = 0; r < 16; ++r) sacc += pB1[r]; l_reg += sacc;
      pw0 = (u32x4){PKW(pB0, 0), PKW(pB0, 2), PKW(pB0, 4), PKW(pB0, 6)}; pw1 = (u32x4){PKW(pB0, 8), PKW(pB0, 10), PKW(pB0, 12), PKW(pB0, 14)}; pw2 = (u32x4){PKW(pB1, 0), PKW(pB1, 2), PKW(pB1, 4), PKW(pB1, 6)}; pw3 = (u32x4){PKW(pB1, 8), PKW(pB1, 10), PKW(pB1, 12), PKW(pB1, 14)};
      SBAR(); pv(o, (int)(unsigned long)vp0 + sl_prev, PAF(0), PAF(1), PAF(2), PAF(3)); }
#undef PKW
#undef PAF
#undef VFR
#undef PIN
#undef MX3
#undef GAPA
#undef GAPB
#undef EX
#undef VRD
#undef KRD
#undef STEP
#undef ENDW
    { auto rr = __builtin_amdgcn_permlane32_swap(__float_as_uint(l_reg), __float_as_uint(l_reg), false, false); l_reg = __uint_as_float(rr[0]) + __uint_as_float(rr[1]); }
    if (hi == 0) wsf[32 + r32] = l_reg; asm volatile("s_waitcnt lgkmcnt(0)" ::: "memory");
    float rli[16];
#pragma unroll
    for (int r = 0; r < 16; ++r) rli[r] = __builtin_amdgcn_rcpf(wsf[32 + crow(r, hi)]);
    bf16_t* Ow = Og + (rowbase + q0 + wid * QBLK) * DMO + h * HD;
    { bf16_t* stg = (bf16_t*)(shm + LDS_OST) + wid * 2048;
#pragma unroll
      for (int r = 0; r < 16; ++r) { const int orow = crow(r, hi);
#pragma unroll
        for (int d0 = 0; d0 < 2; ++d0) stg[orow * 64 + d0 * 32 + r32] = (bf16_t)f2bf(o[d0][r] * rli[r]); }
      asm volatile("s_waitcnt lgkmcnt(0)" ::: "memory");
#pragma unroll
      for (int i = 0; i < 4; ++i) { const int row = i * 8 + (lane >> 3), ch = lane & 7; const u32x4 v = *(const u32x4*)(stg + row * 64 + ch * 8); *(u32x4*)(Ow + (long)row * DMO + ch * 8) = v; } }
    asm volatile("s_waitcnt lgkmcnt(0)\n\ts_barrier" ::: "memory");
#undef DMA_K
#undef DMA_V
#undef TMAP
#undef SETC
#undef START
#undef RESC
#undef ROT
}
#undef SBAR
#undef WAIT_BAR
}

namespace hgrn {
constexpr int RS = 144;
constexpr int R_FQV = 0, FQV_SLOT = 32768;
constexpr int L_Q = 98304, L_K = L_Q + 9216, L_KT = L_K + 9216, L_VT = L_KT + 9216, L_ST = L_VT + 9216, L_SEG = L_ST + 9216, L_DEND = L_SEG + 2048, L_SSQ = L_DEND + 256, L_BYTES = L_SSQ + 512;
__device__ __forceinline__ int crow(int r, int hi) { return (r & 3) + 8 * (r >> 2) + 4 * hi; }
__device__ __forceinline__ void glds16(const void* gsrc, unsigned lds_dst) { unsigned keep;
    asm volatile("s_mov_b32 %0, m0\n\ts_mov_b32 m0, %2\n\ts_nop 0\n\tglobal_load_lds_dwordx4 %1, off\n\ts_mov_b32 m0, %0" : "=&s"(keep) : "v"(gsrc), "s"(lds_dst) : "memory"); }
#define HG_BAR() do { asm volatile("s_waitcnt lgkmcnt(0)" ::: "memory"); __builtin_amdgcn_s_barrier(); asm volatile("" ::: "memory"); } while (0)
#ifndef HG_ABL
#define HG_ABL 0
#endif
__device__ __forceinline__ void hgrn_unit(int b, int h, const bf16_t* __restrict__ proj, bf16_t* __restrict__ mix, const float* __restrict__ lb_logits, const float* __restrict__ norm_g, LAS unsigned char* lds, const int abl = 0) {
    int tid_ = threadIdx.x; asm volatile("" : "+v"(tid_));
    const int tid = tid_, lane = tid & 63, r32 = lane & 31, hi = lane >> 5; const int w = __builtin_amdgcn_readfirstlane(tid >> 6);
    const float lbk = fast_rcp(1.0f + fast_exp2((lb_logits[512 + h * 64 + lane] - lb_logits[h * 64 + lane]) * LOG2E));
    const int vr = (w >> 1) & 1, tc = w & 1;
    float ng[16];
#pragma unroll
    for (int r = 0; r < 16; ++r) ng[r] = norm_g[h * 64 + 32 * vr + crow(r, hi)];
    f32x16 S = f32x16{};
    for (int i = tid; i < 64 * RS / 4; i += 512) ((LAS unsigned*)(lds + L_ST))[i] = 0u;
    const size_t hoff = (size_t)(b * 8 + h) * (SEQ * 64) + (size_t)w * 512 + lane * 8;
    const bf16_t* gQ = proj + 3 * SEC_ELEMS + hoff; const bf16_t* gF = proj + 4 * SEC_ELEMS + hoff; const bf16_t* gV = proj + 5 * SEC_ELEMS + hoff; const bf16_t* gG = proj + 6 * SEC_ELEMS + hoff;
    const unsigned lds0 = (unsigned)(uintptr_t)(unsigned char*)lds;
#define DMA_FQV(c_) do { const int cc_ = (c_) < 63 ? (c_) : 63; const unsigned d_ = (unsigned)__builtin_amdgcn_readfirstlane(lds0 + R_FQV + (unsigned)(((c_) % 3) * FQV_SLOT) + (unsigned)w * 1024u); \
        glds16(gF + (size_t)cc_ * 4096, d_); glds16(gQ + (size_t)cc_ * 4096, d_ + 8192u); glds16(gV + (size_t)cc_ * 4096, d_ + 16384u); } while (0)
#define DMA_G(c_) do { const int cc_ = (c_) < 63 ? (c_) : 63; glds16(gG + (size_t)cc_ * 4096, (unsigned)__builtin_amdgcn_readfirstlane(lds0 + R_FQV + (unsigned)(((c_) % 3) * FQV_SLOT) + 24576u + (unsigned)w * 1024u)); } while (0)
    DMA_FQV(0); DMA_G(0); DMA_FQV(1); DMA_G(1); DMA_FQV(2);
    for (int c = 0; c < 64; ++c) {
        const size_t row0 = (size_t)b * SEQ + (size_t)c * 64;
        if (abl & 8) {} else if (w < 4 && c >= 3) asm volatile("s_waitcnt vmcnt(20)" ::: "memory");
        else asm volatile("s_waitcnt vmcnt(8)" ::: "memory");
        const LAS unsigned char* raw = lds + R_FQV + (c % 3) * FQV_SLOT + (8 * w) * 128 + lane * 2;
        float p[8], kk[8];
        { float run = 0.f;
#pragma unroll
          for (int i = 0; i < 8; ++i) { const float x = bf2f(*(const LAS unsigned short*)(raw + i * 128)); float f, lg;
              if (abl & 2) { f = 0.5f + 0.001f * x; lg = -1.0f + 0.001f * x; } else { const float sg = fast_rcp(1.0f + fast_exp2(-x * LOG2E)); f = lbk + (1.0f - lbk) * sg; lg = __builtin_amdgcn_logf(f); }
              run += lg; p[i] = run; kk[i] = 1.0f - f; } }
        ((LAS float*)(lds + L_SEG))[w * 64 + lane] = p[7];
        HG_BAR();
        if (!(abl & 8)) DMA_G(c + 2);
        { float off = 0.f;
#pragma unroll
          for (int j = 0; j < 7; ++j) { const float sv = ((LAS float*)(lds + L_SEG))[j * 64 + lane]; off += (j < w) ? sv : 0.f; }
          unsigned kq[4], vq[4];
#pragma unroll
          for (int i = 0; i < 8; i += 2) { const float b0 = off + p[i], b1 = off + p[i + 1];
              const unsigned short q0r = *(const LAS unsigned short*)(raw + 8192 + i * 128), q1r = *(const LAS unsigned short*)(raw + 8192 + (i + 1) * 128);
              const unsigned short v0r = *(const LAS unsigned short*)(raw + 16384 + i * 128), v1r = *(const LAS unsigned short*)(raw + 16384 + (i + 1) * 128);
              const float q0 = bf2f(q0r) * fast_exp2(b0), q1 = bf2f(q1r) * fast_exp2(b1), k0 = kk[i] * fast_exp2(-b0), k1 = kk[i + 1] * fast_exp2(-b1);
              const unsigned qq = cvtpk(q0, q1), kw = cvtpk(k0, k1); kq[i >> 1] = kw; vq[i >> 1] = (unsigned)v0r | ((unsigned)v1r << 16);
              if (abl & 4) continue;
              *(LAS unsigned short*)(lds + L_Q + (8 * w + i) * RS + lane * 2) = (unsigned short)(qq & 0xffffu);
              *(LAS unsigned short*)(lds + L_Q + (8 * w + i + 1) * RS + lane * 2) = (unsigned short)(qq >> 16);
              *(LAS unsigned short*)(lds + L_K + (8 * w + i) * RS + lane * 2) = (unsigned short)(kw & 0xffffu);
              *(LAS unsigned short*)(lds + L_K + (8 * w + i + 1) * RS + lane * 2) = (unsigned short)(kw >> 16); }
          *(LAS u32x4*)(lds + L_KT + lane * RS + 16 * w) = (u32x4){kq[0], kq[1], kq[2], kq[3]};
          *(LAS u32x4*)(lds + L_VT + lane * RS + 16 * w) = (u32x4){vq[0], vq[1], vq[2], vq[3]};
          if (w == 7) ((LAS float*)(lds + L_DEND))[lane] = fast_exp2(off + p[7]); }
        if (!(abl & 8)) DMA_FQV(c + 3);
        if (abl & 8) {} else if (w < 4 && c >= 2) asm volatile("s_waitcnt vmcnt(19)" ::: "memory");
        else asm volatile("s_waitcnt vmcnt(11)" ::: "memory");
        HG_BAR();
        f32x16 OT = f32x16{};
        if (abl & 1) { OT[0] = (float)c; } else
        if (w < 4) {
            bf16x8 bq[4];
#pragma unroll
            for (int ks = 0; ks < 4; ++ks) bq[ks] = *(const LAS bf16x8*)(lds + L_Q + (32 * tc + r32) * RS + (16 * ks + 8 * hi) * 2);
#pragma unroll
            for (int sr = 0; sr < 2; ++sr) if (sr <= tc) {
                f32x16 at = f32x16{};
#pragma unroll
                for (int ks = 0; ks < 4; ++ks) { const bf16x8 a = *(const LAS bf16x8*)(lds + L_K + (32 * sr + r32) * RS + (16 * ks + 8 * hi) * 2); at = __builtin_amdgcn_mfma_f32_32x32x16_bf16(a, bq[ks], at, 0, 0, 0); }
                if (sr == tc) {
#pragma unroll
                    for (int r = 0; r < 16; ++r) at[r] = (crow(r, hi) <= r32) ? at[r] : 0.f; }
#pragma unroll
                for (int st = 0; st < 2; ++st) {
                    u32x4 bw; bw.x = cvtpk(at[8 * st + 0], at[8 * st + 1]); bw.y = cvtpk(at[8 * st + 2], at[8 * st + 3]); bw.z = cvtpk(at[8 * st + 4], at[8 * st + 5]); bw.w = cvtpk(at[8 * st + 6], at[8 * st + 7]);
                    const u32x2 lo = *(const LAS u32x2*)(lds + L_VT + (32 * vr + r32) * RS + (32 * sr + 16 * st + 4 * hi) * 2);
                    const u32x2 hh = *(const LAS u32x2*)(lds + L_VT + (32 * vr + r32) * RS + (32 * sr + 16 * st + 8 + 4 * hi) * 2);
                    const u32x4 aw = (u32x4){lo.x, lo.y, hh.x, hh.y};
                    OT = __builtin_amdgcn_mfma_f32_32x32x16_bf16(__builtin_bit_cast(bf16x8, aw), __builtin_bit_cast(bf16x8, bw), OT, 0, 0, 0); }
            }
#pragma unroll
            for (int ks = 0; ks < 4; ++ks) { const bf16x8 a = *(const LAS bf16x8*)(lds + L_ST + (32 * vr + r32) * RS + (16 * ks + 8 * hi) * 2); OT = __builtin_amdgcn_mfma_f32_32x32x16_bf16(a, bq[ks], OT, 0, 0, 0); }
            float sq = 0.f;
#pragma unroll
            for (int r = 0; r < 16; ++r) sq += OT[r] * OT[r];
            sq += __shfl_xor(sq, 32);
            if (hi == 0) ((LAS float*)(lds + L_SSQ))[vr * 64 + 32 * tc + r32] = sq;
        } else {
#pragma unroll
            for (int st = 0; st < 4; ++st) { const bf16x8 a = *(const LAS bf16x8*)(lds + L_KT + (32 * vr + r32) * RS + (16 * st + 8 * hi) * 2);
                const bf16x8 bv = *(const LAS bf16x8*)(lds + L_VT + (32 * tc + r32) * RS + (16 * st + 8 * hi) * 2);
                S = __builtin_amdgcn_mfma_f32_32x32x16_bf16(a, bv, S, 0, 0, 0); }
#pragma unroll
            for (int r = 0; r < 16; ++r) S[r] *= ((LAS float*)(lds + L_DEND))[32 * vr + crow(r, hi)];
        }
        HG_BAR();
        if (w < 4) {
            const int t = 32 * tc + r32;
            const float tot = ((LAS float*)(lds + L_SSQ))[t] + ((LAS float*)(lds + L_SSQ))[64 + t];
            const float rstd = __builtin_amdgcn_rsqf(tot * (1.0f / 64.0f) + EPS);
            const LAS unsigned char* gp = lds + R_FQV + (c % 3) * FQV_SLOT + 24576 + t * 128 + (32 * vr + 4 * hi) * 2;
            bf16_t* op = mix + (row0 + t) * D + 512 + h * 64 + 32 * vr + 4 * hi;
#pragma unroll
            for (int g = 0; g < 4; ++g) { const u32x2 gg = *(const LAS u32x2*)(gp + 16 * g);
                const float y0 = OT[4 * g + 0] * rstd * ng[4 * g + 0] * bflo(gg.x), y1 = OT[4 * g + 1] * rstd * ng[4 * g + 1] * bfhi(gg.x),
                            y2 = OT[4 * g + 2] * rstd * ng[4 * g + 2] * bflo(gg.y), y3 = OT[4 * g + 3] * rstd * ng[4 * g + 3] * bfhi(gg.y);
                const u32x2 yv = (u32x2){cvtpk(y0, y1), cvtpk(y2, y3)}; if (!(abl & 16)) asm volatile("global_store_dwordx2 %0, %1, off" :: "v"(op + 8 * g), "v"(yv) : "memory"); }
        } else {
#pragma unroll
            for (int g = 0; g < 4; ++g) *(LAS u32x2*)(lds + L_ST + (32 * tc + r32) * RS + (32 * vr + 8 * g + 4 * hi) * 2) = (u32x2){cvtpk(S[4 * g + 0], S[4 * g + 1]), cvtpk(S[4 * g + 2], S[4 * g + 3])};
        }
    }
    asm volatile("s_waitcnt vmcnt(0)" ::: "memory");
    HG_BAR();
#undef DMA_FQV
#undef DMA_G
}
#undef HG_BAR
}

constexpr int NWAVES = 8;
constexpr int LDS_BYTES = 163840;
constexpr int TAIL = 161792;
constexpr int TL_TE = TAIL, TL_TS = TAIL + 576, TL_HIST = TAIL + 768, TL_BASE = TAIL + 896, TL_MISC = TAIL + 1024, TL_CNT = TAIL + 1280;
typedef GAS unsigned gu32;

struct Args { const float* in[20]; float* out; unsigned char* ws; int ph_lo, ph_hi; };

struct Frame {
    LAS unsigned char* lds; volatile LAS unsigned* MISC; unsigned* ctl;
    int tid, lane, wave, G, vcu;
};

struct P0Item { const float* W; bf16_t* WT; const float* gain; int N, K, k0, n0, mode; };
constexpr int P0_I_IN = 16 * 56, P0_I_SQ = 16 * 16, P0_I_KV = 16 * 32, P0_I_W1 = 16 * 32, P0_I_W2 = 16 * 16;
constexpr int P0_I_IN8 = 16 * 24;
constexpr int P0_NA = P0_I_IN + P0_I_KV + P0_I_IN8, P0_NB = 2 * P0_I_SQ + NEXP * (P0_I_W1 + P0_I_W2);
template <int SET> __device__ __forceinline__ bool p0_decode(const Args& a, int it, P0Item& I) {
    unsigned char* ws = a.ws;
    if (it >= (SET == 0 ? P0_NA : P0_NB)) return false;
    int r = it; I.gain = nullptr; I.mode = 0; I.K = D;
    if (SET == 0) {
        if (r < P0_I_IN) { I.W = a.in[3]; I.WT = (bf16_t*)(ws + WS_WIN); I.N = INC; }
        else if ((r -= P0_I_IN) < P0_I_KV) { I.W = a.in[10]; I.WT = (bf16_t*)(ws + WS_WKV); I.N = 2 * D; }
        else { r -= P0_I_KV; I.W = a.in[3]; I.WT = (bf16_t*)(ws + WS_WIN8); I.N = INC; I.mode = 2; const int nblk8 = 24; I.k0 = 64 * (r / nblk8); I.n0 = 64 * (r % nblk8); return true; }
    } else {
        if (r < P0_I_SQ) { I.W = a.in[6]; I.WT = (bf16_t*)(ws + WS_WOUT); I.N = D; }
        else if ((r -= P0_I_SQ) < P0_I_SQ) { I.W = a.in[11]; I.WT = (bf16_t*)(ws + WS_WO); I.N = D; }
        else if ((r -= P0_I_SQ) < NEXP * P0_I_W1) { const int e = r / P0_I_W1; r -= e * P0_I_W1; I.W = a.in[15] + (size_t)e * D * 2048; I.WT = (bf16_t*)(ws + WS_W1 + (size_t)e * 2048 * D); I.N = 2048; I.gain = a.in[12]; I.mode = 3; }
        else { r -= NEXP * P0_I_W1; const int e = r / P0_I_W2; r -= e * P0_I_W2; I.W = a.in[17] + (size_t)e * D * D; I.WT = (bf16_t*)(ws + WS_W2 + (size_t)e * D * D); I.N = D; I.mode = 2; }
    }
    const int nblk = I.N / 64; I.k0 = 64 * (r / nblk); I.n0 = 64 * (r % nblk); return true;
}
template <int SET> __device__ __forceinline__ void p0_run(const Args& a, int first, int stride, int count, LAS unsigned char* tl, int lane);
__device__ __forceinline__ void p0_load(const P0Item& I, f32x4 (&v)[16], f32x4 (&g)[4], int lane) {
    const float* base = I.W + (size_t)I.k0 * I.N + I.n0;
    const unsigned vo = (unsigned)((lane >> 4) * I.N + 4 * (lane & 15)) * 4u, rs = (unsigned)(4 * I.N) * 4u;
#pragma unroll
    for (int j = 0; j < 16; ++j) v[j] = pg8::gload128_hidden_nt(base, vo + rs * (unsigned)j);
    const float* gb = I.gain ? I.gain + I.k0 : base; const unsigned go = (unsigned)(lane >> 4) * 4u;
#pragma unroll
    for (int q = 0; q < 4; ++q) { g[q][0] = __uint_as_float(pg8::gload32_hidden(gb, go + (unsigned)(16 * q) * 4u)); g[q][1] = __uint_as_float(pg8::gload32_hidden(gb, go + (unsigned)(16 * q + 4) * 4u));
                                  g[q][2] = __uint_as_float(pg8::gload32_hidden(gb, go + (unsigned)(16 * q + 8) * 4u)); g[q][3] = __uint_as_float(pg8::gload32_hidden(gb, go + (unsigned)(16 * q + 12) * 4u)); }
}
constexpr int P0_LOADS = 32;
__device__ __forceinline__ void p0_store(const P0Item& I, const f32x4 (&v)[16], const f32x4 (&gq)[4], LAS unsigned char* tl, int lane) {
    const int kr = lane >> 4, nq = lane & 15;
#pragma unroll
    for (int j = 0; j < 16; ++j) { const int k = 4 * j + kr; const float g = I.gain ? gq[j >> 2][j & 3] : 1.0f;
        *(LAS u32x2*)(tl + k * 128 + (((nq >> 1) ^ ((k >> 3) & 7)) * 16) + (nq & 1) * 8) = (u32x2){pk2(v[j].x * g, v[j].y * g), pk2(v[j].z * g, v[j].w * g)}; }
    LDS_WAIT(); asm volatile("" ::: "memory");
    const int c = lane & 7;
#pragma unroll
    for (int i = 0; i < 8; ++i) { const int n = (lane >> 3) + 8 * i; const LAS unsigned char* sp = tl + (8 * c) * 128 + ((i ^ c) * 16) + (n & 7) * 2;
        unsigned short e[8];
#pragma unroll
        for (int q = 0; q < 8; ++q) e[q] = *(const LAS unsigned short*)(sp + q * 128);
        int row = I.n0 + n; if (I.mode & 1) { const int jj = row >> 1, bj = row & 1; row = (jj >> 7) * 256 + bj * 128 + (jj & 127); }
        if (I.mode & 2) *(u32x2*)((unsigned char*)I.WT + (size_t)row * I.K + I.k0 + 8 * c) = (u32x2){pk4_fp8(bf2f(e[0]) * WSCALE8, bf2f(e[1]) * WSCALE8, bf2f(e[2]) * WSCALE8, bf2f(e[3]) * WSCALE8), pk4_fp8(bf2f(e[4]) * WSCALE8, bf2f(e[5]) * WSCALE8, bf2f(e[6]) * WSCALE8, bf2f(e[7]) * WSCALE8)};
        else *(u32x4*)(I.WT + (size_t)row * I.K + I.k0 + 8 * c) = (u32x4){(unsigned)e[0] | ((unsigned)e[1] << 16), (unsigned)e[2] | ((unsigned)e[3] << 16), (unsigned)e[4] | ((unsigned)e[5] << 16), (unsigned)e[6] | ((unsigned)e[7] << 16)}; }
    LDS_WAIT(); asm volatile("" ::: "memory");
}
__device__ __forceinline__ void rms_rows2_to_bf16(const float* __restrict__ x0, const float* __restrict__ x1, const float* __restrict__ g, bf16_t* __restrict__ o0, bf16_t* __restrict__ o1, int lane, unsigned char* q0 = nullptr, unsigned char* q1 = nullptr) {
    const f32x4* xa = (const f32x4*)x0 + lane; const f32x4* xb = (const f32x4*)x1 + lane; const f32x4* gr = (const f32x4*)g + lane;
    f32x4 va[4], vb[4]; float sa = 0.f, sb = 0.f;
#pragma unroll
    for (int j = 0; j < 4; ++j) { va[j] = xa[64 * j]; vb[j] = xb[64 * j]; }
#pragma unroll
    for (int j = 0; j < 4; ++j) { sa += (va[j].x * va[j].x + va[j].y * va[j].y) + (va[j].z * va[j].z + va[j].w * va[j].w); sb += (vb[j].x * vb[j].x + vb[j].y * vb[j].y) + (vb[j].z * vb[j].z + vb[j].w * vb[j].w); }
    const float ra = 1.0f / sqrtf(wave_sum(sa) * (1.0f / D) + EPS), rb = 1.0f / sqrtf(wave_sum(sb) * (1.0f / D) + EPS);
    unsigned long long* pa = (unsigned long long*)o0 + lane; unsigned long long* pb = (unsigned long long*)o1 + lane;
#pragma unroll
    for (int j = 0; j < 4; ++j) { const f32x4 gg = gr[64 * j];
        if (q0) { ((unsigned*)q0)[lane + 64 * j] = pk4_fp8(va[j].x * ra * gg.x, va[j].y * ra * gg.y, va[j].z * ra * gg.z, va[j].w * ra * gg.w);
                  ((unsigned*)q1)[lane + 64 * j] = pk4_fp8(vb[j].x * rb * gg.x, vb[j].y * rb * gg.y, vb[j].z * rb * gg.z, vb[j].w * rb * gg.w); }
        pa[64 * j] = (unsigned long long)pk2(va[j].x * ra * gg.x, va[j].y * ra * gg.y) | ((unsigned long long)pk2(va[j].z * ra * gg.z, va[j].w * ra * gg.w) << 32);
        pb[64 * j] = (unsigned long long)pk2(vb[j].x * rb * gg.x, vb[j].y * rb * gg.y) | ((unsigned long long)pk2(vb[j].z * rb * gg.z, vb[j].w * rb * gg.w) << 32); }
}

__device__ __forceinline__ void p0_prologue(Frame& F, const Args& a) {
    unsigned char* ws = a.ws;
    LAS unsigned char* tl = F.lds + F.wave * 8192;
    const int gw = F.vcu * NWAVES + F.wave, NGW = F.G * NWAVES;
    for (int m = 2 * gw; m < T; m += 2 * NGW) rms_rows2_to_bf16(a.in[0] + (size_t)m * D, a.in[0] + (size_t)(m + 1) * D, a.in[2], (bf16_t*)(ws + WS_XN) + (size_t)m * D, (bf16_t*)(ws + WS_XN) + (size_t)(m + 1) * D, F.lane, ws + WS_XN8 + (size_t)m * D, ws + WS_XN8 + (size_t)(m + 1) * D);
    for (int m = 2 * gw; m < MROWS; m += 2 * NGW) rms_rows2_to_bf16(a.in[1] + (size_t)m * D, a.in[1] + (size_t)(m + 1) * D, a.in[8], (bf16_t*)(ws + WS_MN) + (size_t)m * D, (bf16_t*)(ws + WS_MN) + (size_t)(m + 1) * D, F.lane);
    for (int i = gw * 64 + F.lane; i < D * D / 4; i += NGW * 64) { const f32x4 w = ((const f32x4*)a.in[9])[i]; const float g = a.in[7][i >> 8];
        ((u32x2*)(ws + WS_WQ))[i] = (u32x2){pk2(w.x * g, w.y * g), pk2(w.z * g, w.w * g)}; }
    for (int i = gw * 64 + F.lane; i < NEXP * D; i += NGW * 64) { const int e = i >> 10, k = i & 1023; const float w = a.in[12][k] * a.in[13][k * NEXP + e];
        const unsigned hi = f2bf(w); ((bf16_t*)(ws + WS_WRT))[i] = (bf16_t)hi; ((bf16_t*)(ws + WS_WRT))[NEXP * D + i] = (bf16_t)f2bf(w - bf2f((unsigned short)hi)); }
    p0_run<0>(a, gw, NGW, (P0_NA - gw + NGW - 1) / NGW, tl, F.lane);
}
#define P0_PIN(vv, gg) do { _Pragma("unroll") for (int j_ = 0; j_ < 16; ++j_) asm volatile("" : "+v"(vv[j_])); _Pragma("unroll") for (int q_ = 0; q_ < 4; ++q_) asm volatile("" : "+v"(gg[q_])); } while (0)
template <int SET> __device__ __forceinline__ void p0_run(const Args& a, int first, int stride, int count, LAS unsigned char* tl, int lane_in) {
    int lane = lane_in; asm volatile("" : "+v"(lane));
    P0Item IA, IB; f32x4 va[16], vb[16], ga[4], gb[4];
    int it = first, left = count; bool ha = left > 0 && p0_decode<SET>(a, it, IA); if (ha) p0_load(IA, va, ga, lane);
    while (ha) {
        const bool hb = left > 1 && p0_decode<SET>(a, it + stride, IB); if (hb) p0_load(IB, vb, gb, lane);
        if (hb) asm volatile("s_waitcnt vmcnt(32)" ::: "memory"); else asm volatile("s_waitcnt vmcnt(0)" ::: "memory");
        P0_PIN(va, ga);
        p0_store(IA, va, ga, tl, lane);
        if (!hb) break;
        it += 2 * stride; left -= 2; ha = left > 0 && p0_decode<SET>(a, it, IA); if (ha) p0_load(IA, va, ga, lane);
        if (ha) asm volatile("s_waitcnt vmcnt(32)" ::: "memory"); else asm volatile("s_waitcnt vmcnt(0)" ::: "memory");
        P0_PIN(vb, gb);
        p0_store(IB, vb, gb, tl, lane);
    }
}
#undef P0_PIN

__device__ __forceinline__ unsigned xcc_id() { return (unsigned)__builtin_amdgcn_s_getreg((3 << 11) | 20) & 0xFu; }
constexpr int QITEMS = 16 + 177;
constexpr int CONV_PER_Q = 49, CONV_TILES = 64;
static_assert(8 * CONV_PER_Q * CONV_TILES == P0_NB, "conversion items cover SET 1 exactly");
__device__ __forceinline__ void p2_mixer(Frame& F, const Args& a, int rep) {
    unsigned char* ws = a.ws;
    const bf16_t* proj = (const bf16_t*)(ws + WS_PROJ); bf16_t* mix = (bf16_t*)(ws + WS_MIX);
    const unsigned x0 = xcc_id() & 7u;
    int par = 0;
#ifdef MK_P2_REPMODE
    if (rep && MK_P2_REPMODE == 4) return;
#endif
#ifdef MK_P2_HALF
    if (rep && (blockIdx.x & 8)) return;
#endif
    for (;;) {
        if (F.tid == 0) { int code = -1;
            for (int j = 0; j < 8; ++j) { const unsigned xq = (x0 + j) & 7u; const unsigned i = __hip_atomic_fetch_add(F.ctl + CW_QUEUE + 1024 * rep + 64 * xq, 1u, RLX_AGENT);
                if (i < (unsigned)QITEMS) { code = (int)(xq * 256u + i); break; } }
            F.MISC[par] = (unsigned)code; }
        LDS_WAIT(); __builtin_amdgcn_s_barrier(); asm volatile("" ::: "memory");
        const int code = __builtin_amdgcn_readfirstlane((int)F.MISC[par]); par ^= 1;
        if (code < 0) break;
        const int xq = code >> 8, i = code & 255;
#ifdef MK_P2_REPMODE
        if (rep && ((MK_P2_REPMODE == 1 && i >= 8) || (MK_P2_REPMODE == 2 && i < 16) || MK_P2_REPMODE == 3)) continue;
        if (rep && MK_P2_REPMODE == 5) { const int jq_ = i - 16; const bool isconv = i >= 16 && jq_ < 2 * CONV_PER_Q && (jq_ & 1); if (!isconv) continue; }
#endif
#ifndef NO_HGRN
        if (i < 8) { hgrn::hgrn_unit(xq, i, proj, rep ? (bf16_t*)(ws + WS_H2F) : mix, a.in[4], a.in[5], F.lds, rep ? HG_ABL : 0); }
        else
#endif
        if (i < 16) {
            pg8::KvOrder S{(const char*)(ws + WS_MN), (const char*)(ws + WS_WKV), xq * 8 + (i - 8)};
            pg8::EpiBf16 E{(bf16_t*)(ws + WS_MEMK), D, (bf16_t*)(ws + WS_MEMVT), D};
            pg8::gemm_phase<pg8::EpiBf16, pg8::KvOrder, false, false>(F.lds, D, D, D / 64, S, E);
        } else
        {
        const int jq = i - 16; int mi = -1, cv = -1;
        if (jq < 2 * CONV_PER_Q) { if (jq & 1) cv = jq >> 1; else mi = jq >> 1; } else mi = jq - CONV_PER_Q;
        if (cv >= 0) {
            const int J = xq * CONV_PER_Q + cv;
            p0_run<1>(a, J * CONV_TILES + F.wave * 8, 1, 8, F.lds + F.wave * 8192, F.lane);
            LDS_WAIT(); VM_WAIT(); __builtin_amdgcn_s_barrier(); asm volatile("" ::: "memory");
        } else
#ifndef NO_MOBA
        { const int j = mi, g = j >> 5, jj = j & 31, hh = 2 * g + (jj & 1), qb = 15 - (jj >> 1);
            moba::attn_unit<8>(xq, hh, qb, proj, proj + SEC_ELEMS, proj + 2 * SEC_ELEMS, mix, (const float*)(ws + WS_KBAR), (char*)(unsigned char*)F.lds); }
#else
        {}
#endif
        }
    }
}

__device__ __forceinline__ void p7_router(Frame& F, const Args& a, int rep) {
    unsigned char* ws = a.ws;
    constexpr int WRS = 2064;
    LAS unsigned char* WH = F.lds; LAS unsigned char* WL = F.lds + 32 * WRS;
    LAS int* hist = (LAS int*)(F.lds + TL_HIST); LAS int* basel = (LAS int*)(F.lds + TL_BASE);
    { const u32x4* src = (const u32x4*)(ws + WS_WRT);
      for (int i = F.tid; i < 2 * NEXP * D / 8; i += 512) { const int m = i >> 12, r = (i >> 7) & 31, c = i & 127; *(LAS u32x4*)(F.lds + m * 32 * WRS + r * WRS + c * 16) = src[i]; } }
    const bf16_t* h2h = (const bf16_t*)(ws + WS_H2F); const unsigned char* h2l = ws + WS_H2F + (size_t)T * D * 2; const float* ss2 = (const float*)(ws + WS_SS2);
    int* toke = (int*)(ws + (rep ? WS_DUMMY + 1 * MiB : WS_TOKE)); int* tokr = (int*)(ws + (rep ? WS_DUMMY + 1 * MiB + 512 * 1024 : WS_TOKR)); float* tokg = (float*)(ws + (rep ? WS_DUMMY + 2 * MiB : WS_TOKG)); int* list = (int*)(ws + (rep ? WS_DUMMY + 4 * MiB : WS_LIST)); float* glist = (float*)(ws + (rep ? WS_DUMMY + 8 * MiB : WS_GLIST)); float* sslist = (float*)(ws + (rep ? WS_DUMMY + 12 * MiB : WS_SSLIST));
    unsigned* cntw = F.ctl + (rep ? CW_CNT + 2048 * rep : CW_CNT);
    const int lane = F.lane, r16 = lane & 15, g4 = lane >> 4;
    const float br0 = a.in[14][r16], br1 = a.in[14][16 + r16];
    for (int tb = blockIdx.x; tb < T / 128; tb += F.G) {
        if (F.tid < 32) hist[F.tid] = 0;
        LDS_WAIT(); __builtin_amdgcn_s_barrier(); asm volatile("" ::: "memory");
        const int t0 = tb * 128 + F.wave * 16;
        const bf16_t* xr = h2h + (size_t)(t0 + r16) * D + 8 * g4; const unsigned char* xl = h2l + (size_t)(t0 + r16) * D + 8 * g4;
        f32x4 acc0 = (f32x4){0.f, 0.f, 0.f, 0.f}, acc1 = acc0;
        u32x4 xa = *(const u32x4*)(xr); u32x2 xb = *(const u32x2*)(xl);
#pragma unroll 4
        for (int ks = 0; ks < 32; ++ks) {
            const u32x4 ca = xa; const u32x2 cb = xb;
            if (ks + 1 < 32) { xa = *(const u32x4*)(xr + 32 * (ks + 1)); xb = *(const u32x2*)(xl + 32 * (ks + 1)); }
            constexpr float LS = 1.0f / 1024.0f;
            const f32x2 c0 = __builtin_amdgcn_cvt_pk_f32_fp8((int)cb.x, false), c1 = __builtin_amdgcn_cvt_pk_f32_fp8((int)cb.x, true), c2 = __builtin_amdgcn_cvt_pk_f32_fp8((int)cb.y, false), c3 = __builtin_amdgcn_cvt_pk_f32_fp8((int)cb.y, true);
            const unsigned l0 = cvtpk(c0.x * LS, c0.y * LS), l1 = cvtpk(c1.x * LS, c1.y * LS), l2 = cvtpk(c2.x * LS, c2.y * LS), l3 = cvtpk(c3.x * LS, c3.y * LS);
            const bf16x8 ah = __builtin_bit_cast(bf16x8, ca), al = __builtin_bit_cast(bf16x8, (u32x4){l0, l1, l2, l3});
            const int bo = r16 * WRS + (32 * ks + 8 * g4) * 2;
            const bf16x8 bh0 = *(const LAS bf16x8*)(WH + bo), bh1 = *(const LAS bf16x8*)(WH + 16 * WRS + bo), bl0 = *(const LAS bf16x8*)(WL + bo), bl1 = *(const LAS bf16x8*)(WL + 16 * WRS + bo);
            acc0 = __builtin_amdgcn_mfma_f32_16x16x32_bf16(ah, bh0, acc0, 0, 0, 0); acc1 = __builtin_amdgcn_mfma_f32_16x16x32_bf16(ah, bh1, acc1, 0, 0, 0);
            acc0 = __builtin_amdgcn_mfma_f32_16x16x32_bf16(ah, bl0, acc0, 0, 0, 0); acc1 = __builtin_amdgcn_mfma_f32_16x16x32_bf16(ah, bl1, acc1, 0, 0, 0);
            acc0 = __builtin_amdgcn_mfma_f32_16x16x32_bf16(al, bh0, acc0, 0, 0, 0); acc1 = __builtin_amdgcn_mfma_f32_16x16x32_bf16(al, bh1, acc1, 0, 0, 0);
        }
        int my_e = 0; float my_g = 0.f;
#pragma unroll
        for (int j = 0; j < 4; ++j) {
            const float rs = __builtin_amdgcn_rsqf(ss2[t0 + 4 * g4 + j] * (1.0f / D) + EPS);
            float a0 = acc0[j] * rs + br0, a1 = acc1[j] * rs + br1; float tv[4]; int te_[4];
#pragma unroll
            for (int k = 0; k < 4; ++k) { float m = fmaxf(a0, a1);
#pragma unroll
                for (int o = 1; o < 16; o <<= 1) m = fmaxf(m, __shfl_xor(m, o));
                int e = (a0 == m) ? r16 : ((a1 == m) ? 16 + r16 : 99);
#pragma unroll
                for (int o = 1; o < 16; o <<= 1) e = min(e, __shfl_xor(e, o));
                tv[k] = m; te_[k] = e; if (e == r16) a0 = -INFINITY; if (e == 16 + r16) a1 = -INFINITY; }
            const float d1 = fast_exp2((tv[1] - tv[0]) * LOG2E), d2 = fast_exp2((tv[2] - tv[0]) * LOG2E), d3 = fast_exp2((tv[3] - tv[0]) * LOG2E);
            const float inv = 1.0f / (1.0f + d1 + d2 + d3);
            if ((r16 >> 2) == j) { const int k = lane & 3; my_e = k == 0 ? te_[0] : (k == 1 ? te_[1] : (k == 2 ? te_[2] : te_[3])); my_g = (k == 0 ? 1.0f : (k == 1 ? d1 : (k == 2 ? d2 : d3))) * inv; }
        }
        const int rl = __hip_atomic_fetch_add(hist + my_e, 1, __ATOMIC_RELAXED, __HIP_MEMORY_SCOPE_WORKGROUP);
        LDS_WAIT(); __builtin_amdgcn_s_barrier(); asm volatile("" ::: "memory");
        if (F.tid < 32) basel[F.tid] = (int)__hip_atomic_fetch_add(cntw + F.tid, (unsigned)hist[F.tid], RLX_AGENT);
        LDS_WAIT(); VM_WAIT(); __builtin_amdgcn_s_barrier(); asm volatile("" ::: "memory");
        { const int t = t0 + 4 * g4 + (r16 >> 2), k = lane & 3; const int rank = basel[my_e] + rl;
          toke[t * 4 + k] = my_e; tokr[t * 4 + k] = rank; tokg[t * 4 + k] = my_g; list[(size_t)my_e * T + rank] = t; glist[(size_t)my_e * T + rank] = my_g; sslist[(size_t)my_e * T + rank] = ss2[t]; }
        LDS_WAIT(); __builtin_amdgcn_s_barrier(); asm volatile("" ::: "memory");
    }
}

__device__ __forceinline__ int build_tables(Frame& F) {
    LAS int* ts = (LAS int*)(F.lds + TL_TS); LAS unsigned char* te = (LAS unsigned char*)(F.lds + TL_TE);
    if (F.tid < NEXP) ((LAS int*)(F.lds + TL_CNT))[F.tid] = (int)__hip_atomic_load(F.ctl + CW_CNT + F.tid, RLX_AGENT);
    LDS_WAIT(); __builtin_amdgcn_s_barrier(); asm volatile("" ::: "memory");
    if (F.tid == 0) { int run = 0;
        for (int e = 0; e < NEXP; ++e) { ts[e] = run; run += (((LAS int*)(F.lds + TL_CNT))[e] + 255) >> 8; }
        ts[NEXP] = run; }
    LDS_WAIT(); __builtin_amdgcn_s_barrier(); asm volatile("" ::: "memory");
    const int nt = ts[NEXP];
    for (int g = F.tid; g < nt; g += 512) { int e = 0;
        for (int j = 1; j < NEXP; ++j) e += (ts[j] <= g) ? 1 : 0;
        te[g] = (unsigned char)e; }
    LDS_WAIT(); __builtin_amdgcn_s_barrier(); asm volatile("" ::: "memory");
    return __builtin_amdgcn_readfirstlane(nt);
}

__device__ __forceinline__ void p10_combine(Frame& F, const Args& a) {
    unsigned char* ws = a.ws;
    LAS int* ts = (LAS int*)(F.lds + TL_TS);
    const bf16_t* h2h = (const bf16_t*)(ws + WS_H2F); const unsigned char* Y = (const unsigned char*)(ws + WS_Y);
    const int* toke = (const int*)(ws + WS_TOKE); const int* tokr = (const int*)(ws + WS_TOKR);
    const float* gf = a.in[19];
    const int gw = F.vcu * NWAVES + F.wave, NGW = F.G * NWAVES, lane = F.lane;
    for (int t0 = 2 * gw; t0 < T; t0 += 2 * NGW) {
        float o[2][16]; u32x2 y[2][4][2];
#pragma unroll
        for (int q = 0; q < 2; ++q) { const int t = t0 + q;
#pragma unroll
            for (int k = 0; k < 4; ++k) { const int e = toke[t * 4 + k], r = tokr[t * 4 + k]; const unsigned char* yr = Y + ((size_t)ts[e] * 256 + r) * D;
                y[q][k][0] = *(const u32x2*)(yr + 8 * lane); y[q][k][1] = *(const u32x2*)(yr + 512 + 8 * lane); }
            const u32x4 a0 = *(const u32x4*)(h2h + (size_t)t * D + 8 * lane), a2 = *(const u32x4*)(h2h + (size_t)t * D + 512 + 8 * lane);
            o[q][0] = bflo(a0.x); o[q][1] = bfhi(a0.x); o[q][2] = bflo(a0.y); o[q][3] = bfhi(a0.y); o[q][4] = bflo(a0.z); o[q][5] = bfhi(a0.z); o[q][6] = bflo(a0.w); o[q][7] = bfhi(a0.w);
            o[q][8] = bflo(a2.x); o[q][9] = bfhi(a2.x); o[q][10] = bflo(a2.y); o[q][11] = bfhi(a2.y); o[q][12] = bflo(a2.z); o[q][13] = bfhi(a2.z); o[q][14] = bflo(a2.w); o[q][15] = bfhi(a2.w); }
#pragma unroll
        for (int q = 0; q < 2; ++q) {
#pragma unroll
            for (int k = 0; k < 4; ++k)
#pragma unroll
                for (int hf = 0; hf < 2; ++hf) { const u32x2 w = y[q][k][hf];
                    const f32x2 c0 = __builtin_amdgcn_cvt_pk_f32_fp8((int)w.x, false), c1 = __builtin_amdgcn_cvt_pk_f32_fp8((int)w.x, true), c2 = __builtin_amdgcn_cvt_pk_f32_fp8((int)w.y, false), c3 = __builtin_amdgcn_cvt_pk_f32_fp8((int)w.y, true);
                    o[q][8 * hf + 0] += pg8::YSCALE_INV * c0.x; o[q][8 * hf + 1] += pg8::YSCALE_INV * c0.y; o[q][8 * hf + 2] += pg8::YSCALE_INV * c1.x; o[q][8 * hf + 3] += pg8::YSCALE_INV * c1.y;
                    o[q][8 * hf + 4] += pg8::YSCALE_INV * c2.x; o[q][8 * hf + 5] += pg8::YSCALE_INV * c2.y; o[q][8 * hf + 6] += pg8::YSCALE_INV * c3.x; o[q][8 * hf + 7] += pg8::YSCALE_INV * c3.y; }
            float s = 0.f;
#pragma unroll
            for (int j = 0; j < 16; ++j) s += o[q][j] * o[q][j];
            const float rstd = 1.0f / sqrtf(wave_sum(s) * (1.0f / D) + EPS);
            float* op = a.out + (size_t)(t0 + q) * D;
#pragma unroll
            for (int v = 0; v < 4; ++v) { const int col = (v >> 1) * 512 + 8 * lane + (v & 1) * 4; const f32x4 g4 = *(const f32x4*)(gf + col);
                *(f32x4*)(op + col) = (f32x4){o[q][4 * v] * rstd * g4.x, o[q][4 * v + 1] * rstd * g4.y, o[q][4 * v + 2] * rstd * g4.z, o[q][4 * v + 3] * rstd * g4.w}; }
        }
    }
}

#define XB_TMO      128
#define XB_XCNT(j)  (256  + 64 * (j))
#define XB_XSUB(j)  (1280 + 64 * (j))
#define XB_XGEN(j)  (2304 + 64 * (j))
#define XB_TOP      3328
#define XB_TOPGEN   3392
#define XCD_BAR_WORDS 3456
#define XB_SPIN_CAP (1u << 22)
__device__ __forceinline__ unsigned xb_ld(unsigned* p)              { return __hip_atomic_load(p, __ATOMIC_RELAXED, __HIP_MEMORY_SCOPE_AGENT); }
__device__ __forceinline__ unsigned xb_add(unsigned* p, unsigned v) { return __hip_atomic_fetch_add(p, v, __ATOMIC_RELAXED, __HIP_MEMORY_SCOPE_AGENT); }
#define XB_SPIN(cond, bar) do { unsigned _sp = 0; while (cond) { __builtin_amdgcn_s_sleep(1); \
    if ((++_sp & 255u) == 0u) { if (xb_ld(&(bar)[XB_TMO])) break; if (_sp > XB_SPIN_CAP) { atomicAdd(&(bar)[XB_TMO], 1u); break; } } } } while (0)
struct XcdBarrier { unsigned* bar; unsigned x; volatile LAS unsigned* st; };
__device__ __forceinline__ XcdBarrier xcd_barrier_post(unsigned* bar, volatile LAS unsigned* st) {
    XcdBarrier b; b.bar = bar; b.x = (unsigned)__builtin_amdgcn_s_getreg((3 << 11) | 20) & 0xFu; b.st = st;
    if (threadIdx.x == 0) (void)xb_add(&bar[XB_XCNT(b.x)], 1u);
    return b;
}
__device__ __forceinline__ void xcd_barrier_complete(unsigned* bar, unsigned x, unsigned& nloc, unsigned& nx) {
    const unsigned G = gridDim.x * gridDim.y * gridDim.z;
    unsigned sum, cnt, mine, sp = 0u;
    for (;;) {
        sum = 0u; cnt = 0u; mine = 0u;
#pragma unroll
        for (unsigned j = 0; j < 16; ++j) { const unsigned c = xb_ld(&bar[XB_XCNT(j)]); sum += c; cnt += (c > 0u) ? 1u : 0u; mine = (j == x) ? c : mine; }
        if (sum == G) break;
        __builtin_amdgcn_s_sleep(1);
        if ((++sp & 255u) == 0u) { if (xb_ld(&bar[XB_TMO])) break; if (sp > XB_SPIN_CAP) { atomicAdd(&bar[XB_TMO], 1u); break; } }
    }
    nloc = mine > 0u ? mine : 1u; nx = cnt > 0u ? cnt : 1u;
}
__device__ __forceinline__ void xcd_barrier(const XcdBarrier& b) {
    asm volatile("s_waitcnt vmcnt(0)" ::: "memory");
    __syncthreads();
    if (threadIdx.x == 0) {
        unsigned* bar = b.bar;
        __builtin_amdgcn_s_waitcnt(0);
        unsigned nloc = b.st[0], nx = b.st[1];
        if (nloc == 0u) { xcd_barrier_complete(bar, b.x, nloc, nx); b.st[0] = nloc; b.st[1] = nx; }
        const unsigned old = xb_add(&bar[XB_XSUB(b.x)], 1u);
        const unsigned gen = old / nloc;
        if (old + 1u == (gen + 1u) * nloc) {
            __builtin_amdgcn_fence(__ATOMIC_RELEASE, "agent");
            asm volatile("s_waitcnt vmcnt(0)" ::: "memory");
            const unsigned og = xb_add(&bar[XB_TOP], 1u);
            const unsigned tg = og / nx;
            if (og + 1u == (tg + 1u) * nx) xb_add(&bar[XB_TOPGEN], 1u);
            else XB_SPIN(xb_ld(&bar[XB_TOPGEN]) == tg, bar);
            __builtin_amdgcn_fence(__ATOMIC_ACQUIRE, "agent");
            xb_add(&bar[XB_XGEN(b.x)], 1u);
            asm volatile("s_waitcnt vmcnt(0)" ::: "memory");
        } else {
            XB_SPIN(xb_ld(&bar[XB_XGEN(b.x)]) == gen, bar);
            __builtin_amdgcn_fence(__ATOMIC_ACQUIRE, "agent");
            asm volatile("s_waitcnt vmcnt(0)" ::: "memory");
        }
    }
    __syncthreads();
}
#ifndef MK_CG_ONLY
#define MK_CG_ONLY 0
#endif
__device__ __forceinline__ void grid_barrier(Frame& F, const XcdBarrier& xb_) { if (MK_CG_ONLY) cg::this_grid().sync(); else xcd_barrier(xb_); }
#ifndef MK_PHASE_MASK
#define MK_PHASE_MASK 0x7ff
#endif
#ifndef MK_REP_PHASE
#define MK_REP_PHASE -1
#endif
#ifndef MK_REP_N
#define MK_REP_N 0
#endif
__device__ __forceinline__ void ph0(Frame& F, const Args& args, int rep) { p0_prologue(F, args); }
__device__ __forceinline__ void ph1(Frame& F, const Args& args, int rep) {
    unsigned char* ws = args.ws; const int cid = (int)blockIdx.x;
    { pg8::DenseOrder S{(const char*)(ws + WS_XN8), (const char*)(ws + WS_WIN8), D / 2, D / 2, T / 256, 6, F.G, cid, 0};
      pg8::EpiProj E{(bf16_t*)(ws + WS_PROJ), rep ? (float*)(ws + WS_DUMMY) : (float*)(ws + WS_KBAR), WSCALE8_INV};
      pg8::gemm_phase<pg8::EpiProj, pg8::DenseOrder, false, true, true>(F.lds, D / 2, D / 2, D / 128, S, E); }
    { pg8::DenseOrder S{(const char*)(ws + WS_XN), (const char*)(ws + WS_WIN + (size_t)1536 * D * 2), D, D, T / 256, 8, F.G, cid, 6};
      pg8::EpiProj E{(bf16_t*)(ws + WS_PROJ), rep ? (float*)(ws + WS_DUMMY) : (float*)(ws + WS_KBAR), 1.0f};
      pg8::gemm_phase<pg8::EpiProj, pg8::DenseOrder, false, true>(F.lds, D, D, D / 64, S, E); }
}
__device__ __forceinline__ void ph2(Frame& F, const Args& args, int rep) { p2_mixer(F, args, rep); }
constexpr size_t WS_MB = WS_PROJ, WS_NB = WS_PROJ + 16 * MiB, WS_H1Q = WS_PROJ + 32 * MiB, WS_PB = WS_QX;
constexpr size_t WS_UNUSED_XA = 0;
constexpr int LDS_XTAB = 131072;
__device__ __forceinline__ void ph3(Frame& F, const Args& args, int rep) {
    unsigned char* ws = args.ws; const int cid = (int)blockIdx.x;
    pg8::P3Order S{pg8::XmnOrder{(const char*)(ws + WS_MEMK), (const char*)(ws + WS_MEMVT), (const char*)(ws + WS_WQ), (const char*)(ws + WS_WO), F.G, cid},
                   pg8::DenseOrder{(const char*)(ws + WS_MIX), (const char*)(ws + WS_WOUT), D, D, T / 256, D / 256, F.G, cid, 0}};
    pg8::EpiP3 E{pg8::EpiFp8{(unsigned char*)(ws + WS_MB), D, (unsigned char*)(ws + WS_NB), D, XSCALE8},
                 pg8::EpiRes<true, 0>{(const void*)args.in[0], (bf16_t*)(ws + WS_H1B), nullptr, rep ? (float*)(ws + WS_DUMMY + 512 * 1024) : (float*)(ws + WS_SS1), 1.0f, (unsigned char*)(ws + WS_H1Q)}};
    pg8::gemm_phase<pg8::EpiP3, pg8::P3Order, false, true>(F.lds, D, D, D / 64, S, E);
}
__device__ __forceinline__ void ph4(Frame& F, const Args& args, int rep) {
    unsigned char* ws = args.ws; const int cid = (int)blockIdx.x;
    pg8::XbOrder S{(const char*)(ws + WS_H1Q), (const char*)(ws + WS_MB), F.G, cid, (size_t)D};
    pg8::EpiSoftmaxS E{(unsigned char*)(ws + WS_PB), (const float*)(ws + WS_SS1), F.lds + LDS_XTAB, XSCALE8_INV};
    pg8::gemm_phase<pg8::EpiSoftmaxS, pg8::XbOrder, false, true, true>(F.lds, D / 2, D / 2, D / 128, S, E);
}
__device__ __forceinline__ void ph5(Frame& F, const Args& args, int rep) {}
__device__ __forceinline__ void ph6(Frame& F, const Args& args, int rep) {
    unsigned char* ws = args.ws; const int cid = (int)blockIdx.x;
    pg8::XbOrder S{(const char*)(ws + WS_PB), (const char*)(ws + WS_NB), F.G, cid, (size_t)D};
    pg8::EpiRes<false, 2, true> E{(const void*)(ws + WS_H1B), (bf16_t*)(ws + WS_H2B), (float*)(ws + WS_H2F), rep ? (float*)(ws + WS_DUMMY + 512 * 1024) : (float*)(ws + WS_SS2), PSCALE8_INV * XSCALE8_INV, nullptr};
    pg8::gemm_phase<pg8::EpiRes<false, 2, true>, pg8::XbOrder, false, true, true>(F.lds, D / 2, D / 2, D / 128, S, E);
}
__device__ __forceinline__ void ph7(Frame& F, const Args& args, int rep) { p7_router(F, args, rep); }
__device__ __forceinline__ void ph8(Frame& F, const Args& args, int rep) {
    unsigned char* ws = args.ws; const int cid = (int)blockIdx.x;
    const int ntl = build_tables(F);
    pg8::MoeOrder S{(const char*)(ws + WS_H2B), (const char*)(ws + WS_W1), (const int*)(ws + WS_LIST), (const LAS int*)(F.lds + TL_CNT), (const LAS unsigned char*)(F.lds + TL_TE), (const LAS int*)(F.lds + TL_TS),
                    ntl, 8, F.G, cid, (size_t)2048 * D, 1, (size_t)256 * D, (size_t)256 * D};
    pg8::EpiW1 E{(bf16_t*)(ws + WS_HMID), (const float*)(ws + WS_SSLIST), args.in[16], (const int*)(ws + WS_LIST)};
    pg8::gemm_phase<pg8::EpiW1, pg8::MoeOrder, true, true, true>(F.lds, D / 2, D / 2, D / 128, S, E);
}
__device__ __forceinline__ void ph9(Frame& F, const Args& args, int rep) {
    unsigned char* ws = args.ws; const int cid = (int)blockIdx.x;
    const int ntl = build_tables(F);
    pg8::MoeOrder S{(const char*)(ws + WS_HMID), (const char*)(ws + WS_W2), (const int*)(ws + WS_LIST), (const LAS int*)(F.lds + TL_CNT), (const LAS unsigned char*)(F.lds + TL_TE), (const LAS int*)(F.lds + TL_TS),
                    ntl, 4, F.G, cid, (size_t)D * D, 0, (size_t)256 * D, (size_t)256 * D};
    pg8::EpiW2 E{(unsigned char*)(ws + WS_Y), args.in[18], (const int*)(ws + WS_LIST), (const float*)(ws + WS_GLIST)};
    pg8::gemm_phase<pg8::EpiW2, pg8::MoeOrder, false, true, true>(F.lds, D / 2, D / 2, D / 128, S, E);
}
__device__ __forceinline__ void ph10(Frame& F, const Args& args, int rep) { (void)build_tables(F); p10_combine(F, args); }

constexpr int N_PHASES = 11;
__global__ void __launch_bounds__(NWAVES * 64, 2) hymba_fwd(Args args) {
    extern __shared__ __attribute__((aligned(16))) unsigned char lds_raw[];
    Frame F;
    F.lds = (LAS unsigned char*)lds_raw;
    F.MISC = (volatile LAS unsigned*)(F.lds + TL_MISC);
    F.tid = threadIdx.x; F.lane = F.tid & 63; F.wave = __builtin_amdgcn_readfirstlane(F.tid >> 6);
    F.G = gridDim.x; { const int bx = blockIdx.x; F.vcu = (F.G % 8 == 0) ? (bx % 8) * (F.G / 8) + bx / 8 : bx; }
    F.ctl = (unsigned*)(args.ws + WS_CTL);
    const int lo = args.ph_lo, hi = args.ph_hi;
    for (int u = F.tid; u < 64; u += NWAVES * 64) ((LAS unsigned*)(F.lds + TL_MISC))[u] = 0u;
    __syncthreads();
    const XcdBarrier xbar = xcd_barrier_post(F.ctl + CW_BAR, F.MISC + 8);
#define RUN(k, fn) do { if (((MK_PHASE_MASK >> (k)) & 1) && lo <= (k) && (k) < hi) { fn(F, args, 0); \
        if (MK_REP_PHASE == (k) && MK_REP_N >= 1) { grid_barrier(F, xbar); fn(F, args, 1); } \
        if (MK_REP_PHASE == (k) && MK_REP_N >= 2) { grid_barrier(F, xbar); fn(F, args, 2); } \
        if ((k) + 1 < hi) { grid_barrier(F, xbar); } } } while (0)
    if (args.ph_lo < 0) cg::this_grid().sync();
    RUN(0, ph0); RUN(1, ph1); RUN(2, ph2); RUN(3, ph3); RUN(4, ph4);   RUN(6, ph6); RUN(7, ph7); RUN(8, ph8); RUN(9, ph9); RUN(10, ph10);
#undef RUN
}

extern "C" void kernel_launch(void* const* d_in, const int* in_sizes, int n_in, void* d_out, int out_size, void* d_ws, size_t ws_size, hipStream_t stream) {
    static int grid = 0;
    if (grid == 0) {
        if (n_in != 20 || in_sizes[0] != T * D || out_size != T * D || ws_size < WS_END) {
            fprintf(stderr, "kernel_launch: shape/workspace mismatch (n_in %d, in0 %d, out %d, ws %zu, need %zu)\n", n_in, n_in > 0 ? in_sizes[0] : -1, out_size, ws_size, (size_t)WS_END); grid = -1; return; }
        int dev = 0, cus = 0, per_cu = 0;
        if (hipGetDevice(&dev) != hipSuccess || hipDeviceGetAttribute(&cus, hipDeviceAttributeMultiprocessorCount, dev) != hipSuccess) { grid = -1; return; }
        if (hipFuncSetAttribute((const void*)hymba_fwd, hipFuncAttributeMaxDynamicSharedMemorySize, LDS_BYTES) != hipSuccess) { fprintf(stderr, "kernel_launch: hipFuncSetAttribute failed\n"); grid = -1; return; }
        if (hipOccupancyMaxActiveBlocksPerMultiprocessor(&per_cu, (const void*)hymba_fwd, NWAVES * 64, LDS_BYTES) != hipSuccess || per_cu < 1) { fprintf(stderr, "kernel_launch: occupancy query says %d\n", per_cu); }
        (void)hipGetLastError();
        grid = cus;
        if (grid != 256) fprintf(stderr, "kernel_launch: %d CUs; this kernel is built for 256\n", grid);
    }
    if (grid < 0) return;
    (void)hipMemsetAsync((char*)d_ws + WS_CTL, 0, CTL_ZERO_BYTES, stream);
    Args a{};
    for (int i = 0; i < 20; ++i) a.in[i] = (const float*)d_in[i];
    a.out = (float*)d_out; a.ws = (unsigned char*)d_ws;
#if MK_N_LAUNCHES == 1
    a.ph_lo = 0; a.ph_hi = MK_LAST_PHASE + 1;
    void* kargs[] = {&a};
    hipError_t e = hipLaunchCooperativeKernel((const void*)hymba_fwd, dim3(grid), dim3(NWAVES * 64), kargs, LDS_BYTES, stream);
    if (e != hipSuccess) fprintf(stderr, "kernel_launch: cooperative launch failed: %s\n", hipGetErrorString(e));
#else
    for (int p = 0; p <= MK_LAST_PHASE; ++p) { a.ph_lo = p; a.ph_hi = p + 1; hipLaunchKernelGGL(hymba_fwd, dim3(grid), dim3(NWAVES * 64), LDS_BYTES, stream, a); }
#endif
}
```

```cpp
#include <hip/hip_runtime.h>
#include <hip/hip_cooperative_groups.h>
#include <cstdio>
#include <cstdint>
namespace cg = cooperative_groups;

#ifndef MK_N_LAUNCHES
#define MK_N_LAUNCHES 1
#endif
#ifndef MK_LAST_PHASE
#define MK_LAST_PHASE 10
#endif

#define LAS __attribute__((address_space(3)))
#define GAS __attribute__((address_space(1)))
typedef unsigned short bf16_t;
typedef short bf16x8 __attribute__((ext_vector_type(8)));
typedef short s16x4 __attribute__((ext_vector_type(4)));
typedef float f32x4 __attribute__((ext_vector_type(4)));
typedef float f32x2 __attribute__((ext_vector_type(2)));
typedef float f32x16 __attribute__((ext_vector_type(16)));
typedef unsigned u32x4 __attribute__((ext_vector_type(4)));
typedef unsigned u32x2 __attribute__((ext_vector_type(2)));
typedef int v8i32_t __attribute__((ext_vector_type(8)));

constexpr int BATCH = 8, SEQ = 4096, T = BATCH * SEQ, D = 1024, INC = 3584, NMEM = 256, MROWS = BATCH * NMEM;
constexpr int NEXP = 32, TOPK = 4, MT_MAX = T * TOPK / 256 + NEXP, MPAD = MT_MAX * 256;
constexpr float EPS = 1e-6f;
constexpr float LOG2E = 1.4426950408889634f;
constexpr float C2Q = 0.125f * LOG2E;
constexpr float C2X = 0.0625f * LOG2E;
constexpr int C_MQ = 0, C_MK = 512, C_MV = 1024, C_GQ = 1536, C_GF = 2048, C_GI = 2560, C_GG = 3072;

constexpr size_t MiB = 1u << 20;
constexpr size_t WS_CTL = 0, CTL_ZERO_BYTES = 2 * MiB;
constexpr size_t WS_KBAR = 1 * MiB;
constexpr size_t WS_SS1 = 1 * MiB + 256 * 1024;
constexpr size_t WS_SS2 = 1 * MiB + 384 * 1024;
constexpr size_t WS_RS0 = 1 * MiB + 512 * 1024;
constexpr size_t WS_TOKE = 2 * MiB, WS_TOKR = 2 * MiB + 512 * 1024, WS_TOKG = 3 * MiB;
constexpr size_t WS_WRT = 3 * MiB + 512 * 1024;
constexpr size_t WS_LIST = 4 * MiB;
constexpr size_t WS_GLIST = 8 * MiB;
constexpr size_t WS_SSLIST = 12 * MiB;
constexpr size_t WS_WIN8 = 14 * MiB;
constexpr size_t WS_WIN = 16 * MiB, WS_WOUT = 23 * MiB, WS_WQ = 25 * MiB, WS_WKV = 27 * MiB, WS_WO = 31 * MiB;
constexpr size_t WS_MN = 33 * MiB, WS_MEMK = 37 * MiB, WS_MEMVT = 41 * MiB;
constexpr size_t WS_W1 = 48 * MiB, WS_W2 = 176 * MiB;
constexpr size_t WS_PROJ = 240 * MiB;
constexpr size_t SEC_ELEMS = (size_t)16 * 1024 * 1024;
constexpr size_t WS_XN = 464 * MiB;
constexpr size_t WS_OX = 464 * MiB;
constexpr size_t WS_XN8 = 528 * MiB;
constexpr size_t WS_MIX = 528 * MiB;
constexpr size_t WS_H1B = 592 * MiB;
constexpr size_t WS_QX = 656 * MiB;
constexpr size_t WS_PWS = 720 * MiB;
constexpr size_t WS_HMID = 240 * MiB;
constexpr size_t WS_Y = 512 * MiB;
constexpr size_t WS_H2F = 784 * MiB;
constexpr size_t WS_H2B = 912 * MiB;
constexpr size_t WS_DUMMY = 976 * MiB;
constexpr size_t WS_END = 992 * MiB;
static_assert(WS_HMID + (size_t)MPAD * D * 2 <= WS_Y && WS_Y + (size_t)MPAD * D * 2 <= WS_H2F, "ws map");
constexpr int CW_TMO = 0;
constexpr int CW_CNT = 64;
constexpr int CW_QUEUE = 128;
constexpr int CW_BAR = 4096;

__device__ __forceinline__ unsigned f2bf(float f) { unsigned u = __builtin_bit_cast(unsigned, f); return (u + 0x7fffu + ((u >> 16) & 1u)) >> 16; }
__device__ __forceinline__ unsigned pk2(float lo, float hi) { return f2bf(lo) | (f2bf(hi) << 16); }
__device__ __forceinline__ float bf2f(unsigned short h) { return __builtin_bit_cast(float, (unsigned)h << 16); }
__device__ __forceinline__ float bflo(unsigned w) { return __builtin_bit_cast(float, w << 16); }
__device__ __forceinline__ float bfhi(unsigned w) { return __builtin_bit_cast(float, w & 0xffff0000u); }
typedef float f32x2_t __attribute__((ext_vector_type(2))); typedef __bf16 bf16x2_t __attribute__((ext_vector_type(2)));
__device__ __forceinline__ unsigned cvtpk(float lo, float hi) { f32x2_t v = {lo, hi}; bf16x2_t b = __builtin_convertvector(v, bf16x2_t); return __builtin_bit_cast(unsigned, b); }
__device__ __forceinline__ float wave_sum(float v) {
#pragma unroll
    for (int o = 1; o < 64; o <<= 1) v += __shfl_xor(v, o);
    return v;
}
__device__ __forceinline__ float fast_exp2(float x) { return __builtin_amdgcn_exp2f(x); }
__device__ __forceinline__ float fast_rcp(float x) { return __builtin_amdgcn_rcpf(x); }
__device__ __forceinline__ float silu_f(float x) { return x * fast_rcp(1.0f + fast_exp2(-x * LOG2E)); }
__device__ __forceinline__ unsigned pk4_fp8(float a, float b, float c, float d) { int w = 0; w = __builtin_amdgcn_cvt_pk_fp8_f32(a, b, w, false); w = __builtin_amdgcn_cvt_pk_fp8_f32(c, d, w, true); return (unsigned)w; }
constexpr float XSCALE8 = 4.0f, XSCALE8_INV = 0.25f, PSCALE8 = 256.0f, PSCALE8_INV = 1.0f / 256.0f;
constexpr float WSCALE8 = 32.0f, WSCALE8_INV = 1.0f / 32.0f;
#define LDS_WAIT() asm volatile("s_waitcnt lgkmcnt(0)" ::: "memory")
#define VM_WAIT() asm volatile("s_waitcnt vmcnt(0)" ::: "memory")
#define RLX_AGENT __ATOMIC_RELAXED, __HIP_MEMORY_SCOPE_AGENT

namespace pg8 {
constexpr int BM = 256, BK = 64, HALF = 128, HTB = HALF * BK * 2, STAGE_BYTES = 8 * HTB;
__device__ __forceinline__ unsigned gload32_hidden(const void* sbase, unsigned voff) { unsigned v; asm volatile("global_load_dword %0, %1, %2" : "=v"(v) : "v"(voff), "s"(sbase) : "memory"); return v; }
__device__ __forceinline__ f32x4 gload128_hidden(const void* sbase, unsigned voff) { f32x4 v; asm volatile("global_load_dwordx4 %0, %1, %2" : "=v"(v) : "v"(voff), "s"(sbase) : "memory"); return v; }
__device__ __forceinline__ f32x4 gload128_hidden_nt(const void* sbase, unsigned voff) { f32x4 v; asm volatile("global_load_dwordx4 %0, %1, %2 nt" : "=v"(v) : "v"(voff), "s"(sbase) : "memory"); return v; }
__device__ __forceinline__ void glds16s(const char* sbase, unsigned voff, unsigned lds_dst) { unsigned keep;
    asm volatile("s_mov_b32 %0, m0\n\ts_mov_b32 m0, %3\n\ts_nop 0\n\tglobal_load_lds_dwordx4 %1, %2\n\ts_mov_b32 m0, %0" : "=&s"(keep) : "v"(voff), "s"(sbase), "s"(lds_dst) : "memory"); }
__host__ __device__ __forceinline__ int lds_byte(int r, int c) { const int st = (r >> 4) * 2 + (c >> 5), rr = r & 15, cc = c & 31, ob = rr * 64 + cc * 2; return st * 1024 + (ob ^ (((ob >> 9) & 1) << 5)); }
__host__ __device__ __forceinline__ void stage_rc(int b, int& R, int& C) { const int st = b / 1024, sb = b % 1024, swz = sb ^ (((sb >> 9) & 1) << 5); R = (st >> 1) * 16 + swz / 64; C = (st & 1) * 32 + (swz % 64) / 2; }
__host__ __device__ __forceinline__ int perm32(int rho) { const int n = rho >> 4, i = rho & 15; return 8 * (i >> 2) + 4 * n + (i & 3); }

struct Unit { const char* A; const char* B; const int* rows; int pm, pn, aux, nrows, ntu; };

template <class Epi, class Sched, bool GATHER, bool ALIGN_EPI, bool FP8 = false>
__device__ __forceinline__ void gemm_phase(LAS unsigned char* lds, const int lda, const int ldb, const int nt_in, const Sched& S, const Epi& E) {
    int nt = nt_in; asm volatile("" : "+s"(nt));
    int tid_ = threadIdx.x; asm volatile("" : "+v"(tid_));
    const int tid = tid_, wid = __builtin_amdgcn_readfirstlane(tid >> 6), lane = tid & 63, wr = wid >> 2, wc = wid & 3, fr = lane & 15, fq = lane >> 4;
    unsigned offB0; { int R, C; stage_rc(tid * 16, R, C); const int Rb = Epi::PERM ? ((R & ~31) + perm32(R & 31)) : R; offB0 = (unsigned)(Rb * ldb + C) * 2u; }
    const size_t pstepB = (size_t)64 * ldb * 2;
    const size_t kstep = (size_t)(BK * 2);
    const size_t hstepB = (size_t)HALF * ldb * 2;
    const unsigned ldsb = (unsigned)__builtin_amdgcn_readfirstlane((int)((unsigned)(uintptr_t)(unsigned char*)lds + (unsigned)wid * 1024u));
    const int aoff = lds_byte(wr * 64 + fr, FP8 ? fq * 16 : fq * 8), boff = lds_byte(wc * 32 + fr, FP8 ? fq * 16 : fq * 8);
#define PG8_SA(b, h) (((b) * 2 + (h)) * HTB)
#define PG8_SB(b, h) ((4 + (b) * 2 + (h)) * HTB)
#define PG8_STGB(bufoff, gbase) do { glds16s((const char*)(gbase), offB0, ldsb + (unsigned)(bufoff)); glds16s((const char*)(gbase) + pstepB, offB0, ldsb + (unsigned)(bufoff) + 8192u); } while (0)
#define PG8_LD16(p_) (*(const LAS u32x4*)(p_))
#define PG8_CAT(x, y) __builtin_bit_cast(v8i32_t, __builtin_shufflevector(x, y, 0, 1, 2, 3, 4, 5, 6, 7))
    unsigned aA0 = (unsigned)(aoff + PG8_SA(0, 0)), aA1 = (unsigned)(aoff + PG8_SA(1, 0)), bB0 = (unsigned)(boff + PG8_SB(0, 0)), bB1 = (unsigned)(boff + PG8_SB(1, 0));
    asm volatile("" : "+v"(aA0), "+v"(aA1), "+v"(bB0), "+v"(bB1));
    int scl8 = 0x7f7f7f7f; asm volatile("" : "+v"(scl8));
#define PG8_LDA(dst, b, h) do { const LAS unsigned char* ap_ = lds + ((b) ? aA1 : aA0) + (h) * HTB; _Pragma("unroll") for (int m = 0; m < 4; ++m) { \
        if constexpr (FP8) { dst##8[m] = PG8_CAT(PG8_LD16(ap_ + m * 2048), PG8_LD16(ap_ + m * 2048 + 16)); } \
        else { _Pragma("unroll") for (int k = 0; k < 2; ++k) dst[m][k] = *(const LAS bf16x8*)(ap_ + m * 2048 + k * 1024); } } } while (0)
#define PG8_LDB(dst, b, h) do { const LAS unsigned char* bp_ = lds + ((b) ? bB1 : bB0) + (h) * HTB; _Pragma("unroll") for (int n = 0; n < 2; ++n) { \
        if constexpr (FP8) { dst##8[n] = PG8_CAT(PG8_LD16(bp_ + n * 2048), PG8_LD16(bp_ + n * 2048 + 16)); } \
        else { _Pragma("unroll") for (int k = 0; k < 2; ++k) dst[n][k] = *(const LAS bf16x8*)(bp_ + n * 2048 + k * 1024); } } } while (0)
#define PG8_MMA(ai, bj, At, Bt) do { __builtin_amdgcn_s_setprio(1); _Pragma("unroll") for (int m = 0; m < 4; ++m) _Pragma("unroll") for (int n = 0; n < 2; ++n) { \
        if constexpr (FP8) asm volatile("v_mfma_scale_f32_16x16x128_f8f6f4 %0, %1, %2, %0, %3, %3 op_sel_hi:[0,0,0]" : "+v"(acc[ai][bj][m][n]) : "v"(Bt##8[n]), "v"(At##8[m]), "v"(scl8));   \
        else { _Pragma("unroll") for (int k = 0; k < 2; ++k) acc[ai][bj][m][n] = __builtin_amdgcn_mfma_f32_16x16x32_bf16(Bt[n][k], At[m][k], acc[ai][bj][m][n], 0, 0, 0); } } \
        __builtin_amdgcn_s_setprio(0); } while (0)
#define PG8_WAIT_V(n) asm volatile("s_waitcnt vmcnt(" #n ")" ::: "memory")
#define PG8_WAIT_L(n) asm volatile("s_waitcnt lgkmcnt(" #n ")" ::: "memory")
#define PG8_BAR __builtin_amdgcn_s_barrier()
#define PG8_SCHED __builtin_amdgcn_sched_barrier(0)
    unsigned voffA0, c2, pkc[2], pkn[2], praw[4];
    { int R, C; stage_rc(tid * 16, R, C); voffA0 = (unsigned)(R * lda + C) * 2u; c2 = (unsigned)C * 2u; }
    const size_t hstepA = (size_t)HALF * lda * 2, pstepA = (size_t)64 * lda * 2;
    const unsigned lda2 = (unsigned)lda * 2u;
#define PG8_PKROWS(dst, u) do { if (GATHER) { _Pragma("unroll") for (int i_ = 0; i_ < 2; ++i_) { int R_, C_; stage_rc(tid * 16 + i_ * 8192, R_, C_); \
        const int nr_ = (u).nrows - 1; const int r0_ = R_ < nr_ ? R_ : nr_, r1_ = (R_ + HALF) < nr_ ? (R_ + HALF) : nr_; \
        dst[i_] = (unsigned)(u).rows[r0_] | ((unsigned)(u).rows[r1_] << 16); } } } while (0)
#define PG8_RAWROWS(u) do { if (GATHER) { _Pragma("unroll") for (int i_ = 0; i_ < 2; ++i_) { int R_, C_; stage_rc(tid * 16 + i_ * 8192, R_, C_); \
        const int nr_ = (u).nrows - 1; const int r0_ = R_ < nr_ ? R_ : nr_, r1_ = (R_ + HALF) < nr_ ? (R_ + HALF) : nr_; \
        praw[2 * i_] = gload32_hidden((u).rows, (unsigned)r0_ * 4u); praw[2 * i_ + 1] = gload32_hidden((u).rows, (unsigned)r1_ * 4u); } } } while (0)
#define PG8_PACKRAW(dst) do { unsigned a0_ = praw[0], a1_ = praw[1], a2_ = praw[2], a3_ = praw[3]; asm volatile("" : "+v"(a0_), "+v"(a1_), "+v"(a2_), "+v"(a3_)); \
        dst[0] = a0_ | (a1_ << 16); dst[1] = a2_ | (a3_ << 16); } while (0)
#define PG8_STGA(bufoff, gbase, h, NX) do { \
        if (GATHER) { const unsigned p0_ = (NX) ? pkn[0] : pkc[0], p1_ = (NX) ? pkn[1] : pkc[1]; \
            const unsigned o0_ = ((h) ? (p0_ >> 16) : (p0_ & 0xffffu)) * lda2 + c2, o1_ = ((h) ? (p1_ >> 16) : (p1_ & 0xffffu)) * lda2 + c2; \
            glds16s((const char*)(gbase), o0_, ldsb + (unsigned)(bufoff)); glds16s((const char*)(gbase), o1_, ldsb + (unsigned)(bufoff) + 8192u); } \
        else { const char* gb_ = (const char*)(gbase) + ((h) ? hstepA : (size_t)0); glds16s(gb_, voffA0, ldsb + (unsigned)(bufoff)); glds16s(gb_ + pstepA, voffA0, ldsb + (unsigned)(bufoff) + 8192u); } } while (0)
    Unit cur, nxt; int ui = 0;
    if (!S.next(0, cur)) return;
    f32x4 acc[2][2][4][2];
#pragma unroll
    for (int a = 0; a < 2; ++a)
#pragma unroll
        for (int b = 0; b < 2; ++b)
#pragma unroll
            for (int m = 0; m < 4; ++m)
#pragma unroll
                for (int n = 0; n < 2; ++n) acc[a][b][m][n] = (f32x4){0.f, 0.f, 0.f, 0.f};
    bf16x8 At[4][2], B0[2][2], B1[2][2]; v8i32_t At8[4], B08[2], B18[2];
    pkc[0] = pkc[1] = pkn[0] = pkn[1] = 0u; praw[0] = praw[1] = praw[2] = praw[3] = 0u;
    PG8_PKROWS(pkc, cur);
    const char* cA = cur.A; const char* cB = cur.B;
    PG8_STGB(PG8_SB(0, 0), cB); PG8_STGB(PG8_SB(0, 1), cB + hstepB); PG8_STGA(PG8_SA(0, 0), cA, 0, false); PG8_STGA(PG8_SA(0, 1), cA, 1, false);
    if (wr == 1) PG8_BAR;
    PG8_WAIT_V(2); PG8_BAR;
    PG8_STGB(PG8_SB(1, 0), cB + kstep); PG8_STGA(PG8_SA(1, 0), cA + kstep, 0, false); PG8_STGB(PG8_SB(1, 1), cB + hstepB + kstep);
    PG8_WAIT_V(6); PG8_BAR;
    for (;;) {
        const bool has_next = S.next(ui + 1, nxt);
        if (GATHER) { if (has_next) { PG8_RAWROWS(nxt); } }
        const char* nA = has_next ? nxt.A : cA; const char* nB = has_next ? nxt.B : cB;
        typename Epi::Pre pre; { int t_p = threadIdx.x; asm volatile("" : "+v"(t_p)); E.prefetch(cur, wr, wc, t_p & 15, (t_p >> 4) & 3, pre); }
        const int ntc = cur.ntu ? cur.ntu : nt;
        for (int t = 0; t < ntc; t += 2) {
            const bool last = (t == ntc - 2);
            if (GATHER) { pkn[0] = pkc[0]; pkn[1] = pkc[1]; if (last && has_next) { PG8_PACKRAW(pkn); } }
            const char* a1 = cA + (size_t)(t + 1) * kstep;
            const char* a2 = last ? nA : cA + (size_t)(t + 2) * kstep; const char* b2 = last ? nB : cB + (size_t)(t + 2) * kstep;
            const char* a3 = a2 + kstep; const char* b3 = b2 + kstep;
            PG8_LDB(B0, 0, 0); PG8_LDB(B1, 0, 1); PG8_SCHED; PG8_LDA(At, 0, 0); PG8_STGA(PG8_SA(1, 1), a1, 1, false);
            PG8_WAIT_V(8); PG8_WAIT_L(0); PG8_BAR; PG8_MMA(0, 0, At, B0); PG8_MMA(0, 1, At, B1); PG8_BAR; PG8_SCHED;
            PG8_LDA(At, 0, 1); PG8_STGB(PG8_SB(0, 0), b2); PG8_STGB(PG8_SB(0, 1), b2 + hstepB); PG8_STGA(PG8_SA(0, 0), a2, 0, last);
            PG8_WAIT_V(8); PG8_WAIT_L(0); PG8_BAR; PG8_MMA(1, 0, At, B0); PG8_MMA(1, 1, At, B1); PG8_BAR; PG8_SCHED;
            PG8_LDB(B0, 1, 0); PG8_LDB(B1, 1, 1); PG8_SCHED; PG8_LDA(At, 1, 0); PG8_STGA(PG8_SA(0, 1), a2, 1, last);
            PG8_WAIT_V(8); PG8_WAIT_L(0); PG8_BAR; PG8_MMA(0, 0, At, B0); PG8_MMA(0, 1, At, B1); PG8_BAR; PG8_SCHED;
            PG8_LDA(At, 1, 1); PG8_STGB(PG8_SB(1, 0), b3); PG8_STGB(PG8_SB(1, 1), b3 + hstepB); PG8_STGA(PG8_SA(1, 0), a3, 0, last);
            PG8_WAIT_V(8); PG8_WAIT_L(0); PG8_BAR; PG8_MMA(1, 0, At, B0); PG8_MMA(1, 1, At, B1); PG8_BAR; PG8_SCHED;
        }
        if constexpr (ALIGN_EPI) { if (wr == 0) PG8_BAR; }
        if constexpr (FP8) asm volatile("s_nop 15\n\ts_nop 15" ::: "memory");
        if constexpr (!Epi::AFTER_DRAIN) { int t_e = threadIdx.x; asm volatile("" : "+v"(t_e)); const int fr_e = t_e & 15, fq_e = (t_e >> 4) & 3; E(acc, cur, wr, wc, fr_e, fq_e, pre); }
        if (!has_next) break;
#pragma unroll
        for (int a = 0; a < 2; ++a)
#pragma unroll
            for (int b = 0; b < 2; ++b)
#pragma unroll
                for (int m = 0; m < 4; ++m)
#pragma unroll
                    for (int n = 0; n < 2; ++n) acc[a][b][m][n] = (f32x4){0.f, 0.f, 0.f, 0.f};
        cur = nxt; cA = nA; cB = nB; ++ui;
        if (GATHER) { PG8_PACKRAW(pkc); }
        if constexpr (ALIGN_EPI) { if (wr == 1) PG8_BAR; }
    }
    PG8_WAIT_V(0);
    if constexpr (!ALIGN_EPI) { if (wr == 0) PG8_BAR; }
    PG8_BAR;
    if constexpr (Epi::AFTER_DRAIN) { int t_e = threadIdx.x; asm volatile("" : "+v"(t_e)); const int fr_e = t_e & 15, fq_e = (t_e >> 4) & 3; E.fused(acc, cur, wr, wc, fr_e, fq_e, lds, wid, t_e & 63); }
#undef PG8_SA
#undef PG8_SB
#undef PG8_STGB
#undef PG8_LDA
#undef PG8_LDB
#undef PG8_MMA
#undef PG8_CAT
#undef PG8_LD16
#undef PG8_WAIT_V
#undef PG8_WAIT_L
#undef PG8_SCHED
#undef PG8_PKROWS
#undef PG8_RAWROWS
#undef PG8_PACKRAW
#undef PG8_STGA
}
}

namespace pg8 {
constexpr int NXCD = 8, WGM = 8;
__device__ __forceinline__ void tile_order(int L, int nM, int nN, int& pm, int& pn) {
    const int nwg = nM * nN; int wgid = L;
    { const int q = nwg / NXCD, r = nwg % NXCD, xcd = wgid % NXCD, off = wgid / NXCD; wgid = (xcd < r ? xcd * (q + 1) : r * (q + 1) + (xcd - r) * q) + off; }
    const int nig = WGM * nN, gid = wgid / nig, fm = gid * WGM, gsz = (nM - fm) < WGM ? (nM - fm) : WGM;
    pm = fm + ((wgid % nig) % gsz); pn = (wgid % nig) / gsz;
}
struct DenseOrder {
    const char* A; const char* B; int lda, ldb, nM, nN, G, c, pn0;
    __device__ __forceinline__ bool next(int i, Unit& u) const {
        const long L = (long)i * G + c; if (L >= (long)nM * nN) return false;
        int pm, pn; tile_order((int)L, nM, nN, pm, pn);
        u.pm = pm; u.pn = pn + pn0; u.aux = 0; u.rows = nullptr; u.nrows = 256; u.ntu = 0;
        u.A = A + (size_t)pm * 256 * lda * 2; u.B = B + (size_t)pn * 256 * ldb * 2; return true;
    }
};
struct KvOrder {
    const char* MN; const char* W; int L0;
    __device__ __forceinline__ bool next(int i, Unit& u) const {
        const int L = L0; if (i > 0 || L >= 64) return false;
        u.rows = nullptr; u.nrows = 256; u.ntu = 0; u.pm = L >> 3; const int ct = L & 7; u.aux = ct >> 2; u.pn = ct & 3;
        u.A = MN + (size_t)u.pm * 256 * D * 2; u.B = W + (size_t)ct * 256 * D * 2; return true;
    }
};
struct XmnOrder {
    const char* MK; const char* MV; const char* WQN; const char* WOT; int G, c;
    __device__ __forceinline__ bool next(int i, Unit& u) const {
        const int L = c + i * G; if (L >= 256) return false;
        u.rows = nullptr; u.nrows = 256; u.ntu = 0;
        if (L < 128) { const int b = L >> 4, h = (L >> 2) & 3, kt = L & 3; u.aux = 0; u.pm = b * 4 + h; u.pn = kt;
            u.A = MK + ((size_t)(b * 256) * D + h * 256) * 2; u.B = WQN + ((size_t)(kt * 256) * D + h * 256) * 2; }
        else { const int l = L - 128, b = l >> 4, nt = (l >> 2) & 3, h = l & 3; u.aux = 1; u.pm = b * 4 + nt; u.pn = h;
            u.A = WOT + ((size_t)(nt * 256) * D + h * 256) * 2; u.B = MV + ((size_t)(b * 256) * D + h * 256) * 2; }
        return true;
    }
};
struct P3Order {
    XmnOrder X; DenseOrder Dn;
    __device__ __forceinline__ bool next(int i, Unit& u) const {
        if (i == 0 && X.c < 256) { X.next(0, u); u.ntu = 4; return true; }
        const bool ok = Dn.next(X.c < 256 ? i - 1 : i, u); u.aux = 2; return ok;
    }
};
struct XbOrder {
    const char* A; const char* Bb; int G, c; size_t rb;
    __device__ __forceinline__ bool next(int i, Unit& u) const {
        const long L = (long)i * G + c; if (L >= 512) return false;
        int pm, pn; tile_order((int)L, T / 256, 4, pm, pn);
        u.pm = pm; u.pn = pn; u.aux = 0; u.rows = nullptr; u.nrows = 256; u.ntu = 0;
        u.A = A + (size_t)pm * 256 * rb; u.B = Bb + (size_t)(pm >> 4) * D * rb + (size_t)pn * 256 * rb; return true;
    }
};
struct MoeOrder {
    const char* A; const char* W; const int* list; const LAS int* cnt; const LAS unsigned char* te; const LAS int* ts;
    int ntiles, nN, G, c; size_t wstride; int gather; size_t atile, btile;
    __device__ __forceinline__ bool next(int i, Unit& u) const {
        const long L = (long)i * G + c; if (L >= (long)ntiles * nN) return false;
        int pm, pn; tile_order((int)L, ntiles, nN, pm, pn);
        const int e = __builtin_amdgcn_readfirstlane((int)te[pm]);
        const int lt = pm - __builtin_amdgcn_readfirstlane(ts[e]);
        const int n = __builtin_amdgcn_readfirstlane(cnt[e]) - lt * 256;
        u.pm = pm; u.pn = pn; u.aux = e; u.nrows = n < 256 ? n : 256; u.ntu = 0;
        u.rows = list + (size_t)e * T + lt * 256;
        u.A = gather ? A : A + (size_t)pm * atile;
        u.B = W + (size_t)e * wstride + (size_t)pn * btile; return true;
    }
};

struct EpiProj {
    static constexpr bool PERM = true, AFTER_DRAIN = false; struct Pre {}; __device__ __forceinline__ void prefetch(const Unit&, int, int, int, int, Pre&) const {}
    bf16_t* O; float* kbar; float asc;
    __device__ __forceinline__ void operator()(const f32x4 (&acc)[2][2][4][2], const Unit& u, int wr, int wc, int fr, int fq, const Pre&) const {
        const int pn = u.pn, sec = pn >> 1, b = u.pm >> 4, t0 = (u.pm & 15) * 256 + wr * 64 + fr;
        const int mode = (pn < 2) ? 1 : ((pn == 6 || pn == 7 || pn >= 12) ? 2 : 0);
        bf16_t* sb = O + (size_t)sec * SEC_ELEMS;
#pragma unroll
        for (int bj = 0; bj < 2; ++bj) {
            const int c = bj * HALF + wc * 32 + 8 * fq, head = (pn & 1) * 4 + (c >> 6), d0 = c & 63;
            bf16_t* hb = sb + (size_t)(b * 8 + head) * (SEQ * 64);
#pragma unroll
            for (int ai = 0; ai < 2; ++ai)
#pragma unroll
                for (int m = 0; m < 4; ++m) { const int t = t0 + ai * HALF + m * 16;
                    f32x4 v0 = acc[ai][bj][m][0] * asc, v1 = acc[ai][bj][m][1] * asc;
                    if (mode == 1) { v0 = v0 * C2Q; v1 = v1 * C2Q; }
                    else if (mode == 2) {
#pragma unroll
                        for (int e = 0; e < 4; ++e) { v0[e] = silu_f(v0[e]); v1[e] = silu_f(v1[e]); } }
                    u32x4 w; w.x = cvtpk(v0[0], v0[1]); w.y = cvtpk(v0[2], v0[3]); w.z = cvtpk(v1[0], v1[1]); w.w = cvtpk(v1[2], v1[3]);
                    size_t off;
                    if (sec == 1) off = (size_t)(t >> 6) * 4096 + (d0 >> 3) * 512 + (t & 63) * 8;
                    else if (sec == 2) off = (size_t)(t >> 6) * 4096 + (d0 >> 5) * 2048 + (t & 63) * 32 + (d0 & 31);
                    else off = (size_t)t * 64 + d0;
                    *(u32x4*)(hb + off) = w; } }
        if (pn == 2 || pn == 3) {
#pragma unroll
            for (int bj = 0; bj < 2; ++bj)
#pragma unroll
                for (int n = 0; n < 2; ++n)
#pragma unroll
                    for (int e = 0; e < 4; ++e) { float s = 0.f;
#pragma unroll
                        for (int ai = 0; ai < 2; ++ai)
#pragma unroll
                            for (int m = 0; m < 4; ++m) s += acc[ai][bj][m][n][e];
                        s += __shfl_xor(s, 1); s += __shfl_xor(s, 2); s += __shfl_xor(s, 4); s += __shfl_xor(s, 8); s *= asc;
                        if (fr == 0) { const int c = bj * HALF + wc * 32 + 8 * fq + 4 * n + e, head = (pn - 2) * 4 + (c >> 6), d = c & 63;
                            atomicAdd(kbar + ((size_t)u.pm * 8 + head) * 64 + d, s); } }
        }
    }
};
struct EpiBf16 {
    static constexpr bool PERM = true, AFTER_DRAIN = false; struct Pre {}; __device__ __forceinline__ void prefetch(const Unit&, int, int, int, int, Pre&) const {}
    bf16_t* O0; int ldc0; bf16_t* O1; int ldc1;
    __device__ __forceinline__ void operator()(const f32x4 (&acc)[2][2][4][2], const Unit& u, int wr, int wc, int fr, int fq, const Pre&) const {
        bf16_t* O = u.aux ? O1 : O0; const int ldc = u.aux ? ldc1 : ldc0;
        const int row0 = u.pm * BM + wr * 64 + fr, col0 = u.pn * BM + wc * 32 + 8 * fq;
#pragma unroll
        for (int ai = 0; ai < 2; ++ai)
#pragma unroll
            for (int m = 0; m < 4; ++m) { bf16_t* rowp = O + (size_t)(row0 + ai * HALF + m * 16) * ldc + col0;
#pragma unroll
                for (int bj = 0; bj < 2; ++bj) { const f32x4 v0 = acc[ai][bj][m][0], v1 = acc[ai][bj][m][1];
                    u32x4 w; w.x = cvtpk(v0[0], v0[1]); w.y = cvtpk(v0[2], v0[3]); w.z = cvtpk(v1[0], v1[1]); w.w = cvtpk(v1[2], v1[3]);
                    *(u32x4*)(rowp + bj * HALF) = w; } }
    }
};
struct EpiFp8 {
    static constexpr bool PERM = true, AFTER_DRAIN = false; struct Pre {}; __device__ __forceinline__ void prefetch(const Unit&, int, int, int, int, Pre&) const {}
    unsigned char* O0; int ldc0; unsigned char* O1; int ldc1; float scale;
    __device__ __forceinline__ void operator()(const f32x4 (&acc)[2][2][4][2], const Unit& u, int wr, int wc, int fr, int fq, const Pre&) const {
        unsigned char* O = u.aux ? O1 : O0; const int ldc = u.aux ? ldc1 : ldc0;
        const int row0 = u.pm * BM + wr * 64 + fr, col0 = u.pn * BM + wc * 32 + 8 * fq;
#pragma unroll
        for (int ai = 0; ai < 2; ++ai)
#pragma unroll
            for (int m = 0; m < 4; ++m) { unsigned char* rowp = O + (size_t)(row0 + ai * HALF + m * 16) * ldc + col0;
#pragma unroll
                for (int bj = 0; bj < 2; ++bj) { const f32x4 v0 = acc[ai][bj][m][0] * scale, v1 = acc[ai][bj][m][1] * scale;
                    *(u32x2*)(rowp + bj * HALF) = (u32x2){pk4_fp8(v0[0], v0[1], v0[2], v0[3]), pk4_fp8(v1[0], v1[1], v1[2], v1[3])}; } }
    }
};
template <bool BASE_F32, int WRITE_F32, bool OUT_FP8 = false, bool BASE_RS = false> struct EpiRes {
    static constexpr bool PERM = true, AFTER_DRAIN = false; struct Pre {}; __device__ __forceinline__ void prefetch(const Unit&, int, int, int, int, Pre&) const {}
    const void* base; bf16_t* Ob; float* Of; float* ss; float asc; unsigned char* Oq; const float* brs = nullptr;
    static constexpr int LPG = BASE_F32 ? 4 : 2;
    __device__ __forceinline__ void issue(f32x4 (&b)[4], unsigned voff) const {
        if (BASE_F32) { b[0] = gload128_hidden(base, voff); b[1] = gload128_hidden(base, voff + 16u); b[2] = gload128_hidden(base, voff + HALF * 4u); b[3] = gload128_hidden(base, voff + HALF * 4u + 16u); }
        else { b[0] = gload128_hidden(base, voff); b[1] = gload128_hidden(base, voff + HALF * 2u); }
    }
    __device__ __forceinline__ void operator()(const f32x4 (&acc)[2][2][4][2], const Unit& u, int wr, int wc, int fr, int fq, const Pre&) const {
        const int row0 = u.pm * BM + wr * 64 + fr, col0 = u.pn * BM + wc * 32 + 8 * fq;
        const unsigned esz = BASE_F32 ? 4u : 2u;
        f32x4 lb[8][4];
#define ER_VOFF(g_) ((unsigned)((row0 + ((g_) >> 2) * HALF + ((g_) & 3) * 16) * D + col0) * esz)
        float rsv[8];
        if (BASE_RS) {
#pragma unroll
            for (int g = 0; g < 8; ++g) rsv[g] = __uint_as_float(gload32_hidden(brs, (unsigned)(row0 + (g >> 2) * HALF + (g & 3) * 16) * 4u)); }
#pragma unroll
        for (int g = 0; g < 4; ++g) issue(lb[g], ER_VOFF(g));
#pragma unroll
        for (int g = 0; g < 8; ++g) { const int ai = g >> 2, m = g & 3; const int row = row0 + ai * HALF + m * 16; const size_t off = (size_t)row * D + col0; float sq = 0.f;
            { constexpr int dummy = 0; (void)dummy; const int newer = (7 - g < 3 ? 7 - g : 3) * LPG;
              if (newer == 12) asm volatile("s_waitcnt vmcnt(12)" ::: "memory"); else if (newer == 8) asm volatile("s_waitcnt vmcnt(8)" ::: "memory"); else if (newer == 6) asm volatile("s_waitcnt vmcnt(6)" ::: "memory");
              else if (newer == 4) asm volatile("s_waitcnt vmcnt(4)" ::: "memory"); else if (newer == 2) asm volatile("s_waitcnt vmcnt(2)" ::: "memory"); else asm volatile("s_waitcnt vmcnt(0)" ::: "memory"); }
#pragma unroll
            for (int q = 0; q < LPG; ++q) asm volatile("" : "+v"(lb[g][q]));
            if (BASE_RS && g == 0) {
#pragma unroll
                for (int q = 0; q < 8; ++q) asm volatile("" : "+v"(rsv[q])); }
#pragma unroll
            for (int bj = 0; bj < 2; ++bj) { f32x4 b0, b1;
                if (BASE_F32) { b0 = lb[g][2 * bj]; b1 = lb[g][2 * bj + 1]; }
                else { const u32x4 w = __builtin_bit_cast(u32x4, lb[g][bj]);
                    b0 = (f32x4){bflo(w.x), bfhi(w.x), bflo(w.y), bfhi(w.y)}; b1 = (f32x4){bflo(w.z), bfhi(w.z), bflo(w.w), bfhi(w.w)};
                    if (BASE_RS) { b0 = b0 * rsv[g]; b1 = b1 * rsv[g]; } }
                const f32x4 v0 = acc[ai][bj][m][0] * asc + b0, v1 = acc[ai][bj][m][1] * asc + b1;
                sq += (v0[0] * v0[0] + v0[1] * v0[1]) + (v0[2] * v0[2] + v0[3] * v0[3]) + (v1[0] * v1[0] + v1[1] * v1[1]) + (v1[2] * v1[2] + v1[3] * v1[3]);
                if (OUT_FP8) { *(u32x2*)((unsigned char*)Ob + off + bj * HALF) = (u32x2){pk4_fp8(v0[0], v0[1], v0[2], v0[3]), pk4_fp8(v1[0], v1[1], v1[2], v1[3])}; }
                else { u32x4 w; w.x = cvtpk(v0[0], v0[1]); w.y = cvtpk(v0[2], v0[3]); w.z = cvtpk(v1[0], v1[1]); w.w = cvtpk(v1[2], v1[3]);
                *(u32x4*)(Ob + off + bj * HALF) = w; }
                if (Oq) *(u32x2*)(Oq + off + bj * HALF) = (u32x2){pk4_fp8(v0[0], v0[1], v0[2], v0[3]), pk4_fp8(v1[0], v1[1], v1[2], v1[3])};
                if (WRITE_F32 == 1) { *(f32x4*)(Of + off + bj * HALF) = v0; *(f32x4*)(Of + off + bj * HALF + 4) = v1; }
                if (WRITE_F32 == 2) { u32x4 w; w.x = cvtpk(v0[0], v0[1]); w.y = cvtpk(v0[2], v0[3]); w.z = cvtpk(v1[0], v1[1]); w.w = cvtpk(v1[2], v1[3]);
                    *(u32x4*)((bf16_t*)Of + off + bj * HALF) = w;
                    *(u32x2*)((unsigned char*)Of + (size_t)T * D * 2 + off + bj * HALF) = (u32x2){
                        pk4_fp8((v0[0] - bflo(w.x)) * 1024.f, (v0[1] - bfhi(w.x)) * 1024.f, (v0[2] - bflo(w.y)) * 1024.f, (v0[3] - bfhi(w.y)) * 1024.f),
                        pk4_fp8((v1[0] - bflo(w.z)) * 1024.f, (v1[1] - bfhi(w.z)) * 1024.f, (v1[2] - bflo(w.w)) * 1024.f, (v1[3] - bfhi(w.w)) * 1024.f)}; } }
            sq += __shfl_xor(sq, 16); sq += __shfl_xor(sq, 32);
            if (fq == 0) atomicAdd(ss + row, sq);
            if (g + 4 < 8) issue(lb[g + 4], ER_VOFF(g + 4)); }
#undef ER_VOFF
    }
};
struct EpiP3 {
    static constexpr bool PERM = true, AFTER_DRAIN = false; struct Pre {}; __device__ __forceinline__ void prefetch(const Unit&, int, int, int, int, Pre&) const {}
    EpiFp8 a; EpiRes<false, 0, false, true> b;
    __device__ __forceinline__ void operator()(const f32x4 (&acc)[2][2][4][2], const Unit& u, int wr, int wc, int fr, int fq, const Pre&) const {
        if (u.aux < 2) a(acc, u, wr, wc, fr, fq, EpiFp8::Pre{}); else b(acc, u, wr, wc, fr, fq, EpiRes<false, 0, false, true>::Pre{});
    }
};
struct EpiQ {
    static constexpr bool PERM = true, AFTER_DRAIN = false; struct Pre {}; __device__ __forceinline__ void prefetch(const Unit&, int, int, int, int, Pre&) const {}
    bf16_t* O; const float* ss;
    __device__ __forceinline__ void operator()(const f32x4 (&acc)[2][2][4][2], const Unit& u, int wr, int wc, int fr, int fq, const Pre&) const {
        const int row0 = u.pm * BM + wr * 64 + fr, col0 = u.pn * BM + wc * 32 + 8 * fq;
#pragma unroll
        for (int ai = 0; ai < 2; ++ai)
#pragma unroll
            for (int m = 0; m < 4; ++m) { const int row = row0 + ai * HALF + m * 16; const float sc = C2X * __builtin_amdgcn_rsqf(ss[row] * (1.0f / D) + EPS);
                bf16_t* rowp = O + (size_t)row * D + col0;
#pragma unroll
                for (int bj = 0; bj < 2; ++bj) { const f32x4 v0 = acc[ai][bj][m][0] * sc, v1 = acc[ai][bj][m][1] * sc;
                    u32x4 w; w.x = cvtpk(v0[0], v0[1]); w.y = cvtpk(v0[2], v0[3]); w.z = cvtpk(v1[0], v1[1]); w.w = cvtpk(v1[2], v1[3]);
                    *(u32x4*)(rowp + bj * HALF) = w; } }
    }
};
struct EpiSoftmaxS {
    static constexpr bool PERM = true, AFTER_DRAIN = false; struct Pre {}; __device__ __forceinline__ void prefetch(const Unit&, int, int, int, int, Pre&) const {}
    unsigned char* P; const float* ss; LAS unsigned char* tb; float qs;
    __device__ __forceinline__ void operator()(f32x4 (&acc)[2][2][4][2], const Unit& u, int wr, int wc, int fr, int fq, const Pre&) const {
        LAS float* MX = (LAS float*)tb;
        LAS float* SM = (LAS float*)(tb + 4096);
#pragma unroll
        for (int ai = 0; ai < 2; ++ai)
#pragma unroll
            for (int m = 0; m < 4; ++m) { const int r = ai * HALF + wr * 64 + m * 16 + fr; const float sc = qs * C2X * __builtin_amdgcn_rsqf(ss[u.pm * BM + r] * (1.0f / D) + EPS); float mx = -3.0e38f;
#pragma unroll
                for (int bj = 0; bj < 2; ++bj)
#pragma unroll
                    for (int n = 0; n < 2; ++n) { f32x4 x = acc[ai][bj][m][n] * sc; acc[ai][bj][m][n] = x; mx = fmaxf(mx, fmaxf(fmaxf(x[0], x[1]), fmaxf(x[2], x[3]))); }
                mx = fmaxf(mx, __shfl_xor(mx, 16)); mx = fmaxf(mx, __shfl_xor(mx, 32));
                if (fq == 0) MX[r * 4 + wc] = mx; }
        LDS_WAIT(); __builtin_amdgcn_s_barrier(); asm volatile("" ::: "memory");
#pragma unroll
        for (int ai = 0; ai < 2; ++ai)
#pragma unroll
            for (int m = 0; m < 4; ++m) { const int r = ai * HALF + wr * 64 + m * 16 + fr; const f32x4 q = *(const LAS f32x4*)(MX + r * 4);
                const float mx = fmaxf(fmaxf(q[0], q[1]), fmaxf(q[2], q[3])); float sm = 0.f;
#pragma unroll
                for (int bj = 0; bj < 2; ++bj)
#pragma unroll
                    for (int n = 0; n < 2; ++n) { f32x4 x = acc[ai][bj][m][n];
#pragma unroll
                        for (int e = 0; e < 4; ++e) { x[e] = fast_exp2(x[e] - mx); sm += x[e]; }
                        acc[ai][bj][m][n] = x; }
                sm += __shfl_xor(sm, 16); sm += __shfl_xor(sm, 32);
                if (fq == 0) SM[r * 4 + wc] = sm; }
        LDS_WAIT(); __builtin_amdgcn_s_barrier(); asm volatile("" ::: "memory");
        const int col0 = u.pn * BM + wc * 32 + 8 * fq;
#pragma unroll
        for (int ai = 0; ai < 2; ++ai)
#pragma unroll
            for (int m = 0; m < 4; ++m) { const int r = ai * HALF + wr * 64 + m * 16 + fr; const f32x4 q = *(const LAS f32x4*)(SM + r * 4);
                const float inv = PSCALE8 * fast_rcp((q[0] + q[1]) + (q[2] + q[3]));
#pragma unroll
                for (int bj = 0; bj < 2; ++bj) { const f32x4 v0 = acc[ai][bj][m][0] * inv, v1 = acc[ai][bj][m][1] * inv;
                    *(u32x2*)(P + ((size_t)u.pm * BM + r) * D + bj * HALF + col0) = (u32x2){pk4_fp8(v0[0], v0[1], v0[2], v0[3]), pk4_fp8(v1[0], v1[1], v1[2], v1[3])}; } }
        LDS_WAIT(); __builtin_amdgcn_s_barrier(); asm volatile("" ::: "memory");
    }
};
struct EpiW1 {
    static constexpr bool PERM = true, AFTER_DRAIN = false;
    struct Pre { float sc[8]; f32x4 bq[4]; };
    bf16_t* O; const float* ssl; const float* b1; const int* list0;
    __device__ __forceinline__ void prefetch(const Unit& u, int wr, int wc, int fr, int fq, Pre& p) const {
        const float* sp = ssl + (u.rows - list0);
        { const float* bb = b1 + (size_t)u.aux * 2048 + 2 * (u.pn * 128); const unsigned bo = (unsigned)(2 * (wc * 32 + 8 * fq)) * 4u;
#pragma unroll
          for (int q = 0; q < 4; ++q) p.bq[q] = gload128_hidden(bb, bo + 16u * q); }
#pragma unroll
        for (int ai = 0; ai < 2; ++ai)
#pragma unroll
            for (int m = 0; m < 4; ++m) { const int r = ai * HALF + wr * 64 + m * 16 + fr; const int rr = r < u.nrows ? r : u.nrows - 1; p.sc[ai * 4 + m] = __uint_as_float(gload32_hidden(sp, (unsigned)rr * 4u)); }
    }
    __device__ __forceinline__ void operator()(const f32x4 (&acc)[2][2][4][2], const Unit& u, int wr, int wc, int fr, int fq, const Pre& pre) const {
        const int c0 = wc * 32 + 8 * fq;
        f32x4 bq0 = pre.bq[0], bq1 = pre.bq[1], bq2 = pre.bq[2], bq3 = pre.bq[3]; asm volatile("" : "+v"(bq0), "+v"(bq1), "+v"(bq2), "+v"(bq3));
        const float bg[8] = {bq0[0], bq0[2], bq1[0], bq1[2], bq2[0], bq2[2], bq3[0], bq3[2]};
        const float bl[8] = {bq0[1], bq0[3], bq1[1], bq1[3], bq2[1], bq2[3], bq3[1], bq3[3]};
#pragma unroll
        for (int ai = 0; ai < 2; ++ai)
#pragma unroll
            for (int m = 0; m < 4; ++m) { const int r = ai * HALF + wr * 64 + m * 16 + fr;
                float ssv = pre.sc[ai * 4 + m]; asm volatile("" : "+v"(ssv));
                const float sc = WSCALE8_INV * __builtin_amdgcn_rsqf(ssv * (1.0f / D) + EPS); float a[8];
#pragma unroll
                for (int j = 0; j < 8; ++j) { const float g = acc[ai][0][m][j >> 2][j & 3] * sc + bg[j], l = acc[ai][1][m][j >> 2][j & 3] * sc + bl[j];
                    const float glu = fminf(g, 7.0f), lin = fminf(fmaxf(l, -7.0f), 7.0f);
                    a[j] = glu * fast_rcp(1.0f + fast_exp2(-1.702f * LOG2E * glu)) * (lin + 1.0f); }
                *(u32x2*)((unsigned char*)O + ((size_t)u.pm * BM + r) * D + u.pn * 128 + c0) = (u32x2){pk4_fp8(a[0], a[1], a[2], a[3]), pk4_fp8(a[4], a[5], a[6], a[7])}; }
    }
};
constexpr float YSCALE = 16.0f, YSCALE_INV = 1.0f / 16.0f;
struct EpiW2 {
    static constexpr bool PERM = true, AFTER_DRAIN = false;
    struct Pre { float g[8]; f32x4 bv[4]; };
    unsigned char* O; const float* b2; const int* list0; const float* gl0;
    __device__ __forceinline__ void prefetch(const Unit& u, int wr, int wc, int fr, int fq, Pre& p) const {
        const float* gp = gl0 + (u.rows - list0);
        { const float* bb = b2 + (size_t)u.aux * D + u.pn * BM; const unsigned bo = (unsigned)(wc * 32 + 8 * fq) * 4u;
#pragma unroll
          for (int q = 0; q < 4; ++q) p.bv[q] = gload128_hidden(bb, bo + (unsigned)((q >> 1) * HALF * 4 + (q & 1) * 16)); }
#pragma unroll
        for (int ai = 0; ai < 2; ++ai)
#pragma unroll
            for (int m = 0; m < 4; ++m) { const int r = ai * HALF + wr * 64 + m * 16 + fr; const int rr = r < u.nrows ? r : u.nrows - 1; p.g[ai * 4 + m] = __uint_as_float(gload32_hidden(gp, (unsigned)rr * 4u)); }
    }
    __device__ __forceinline__ void operator()(const f32x4 (&acc)[2][2][4][2], const Unit& u, int wr, int wc, int fr, int fq, const Pre& pre) const {
        const int row0 = u.pm * BM + wr * 64 + fr, col0 = u.pn * BM + wc * 32 + 8 * fq;
        f32x4 bv[2][2]; bv[0][0] = pre.bv[0]; bv[0][1] = pre.bv[1]; bv[1][0] = pre.bv[2]; bv[1][1] = pre.bv[3]; asm volatile("" : "+v"(bv[0][0]), "+v"(bv[0][1]), "+v"(bv[1][0]), "+v"(bv[1][1]));
#pragma unroll
        for (int ai = 0; ai < 2; ++ai)
#pragma unroll
            for (int m = 0; m < 4; ++m) { unsigned char* rowp = O + (size_t)(row0 + ai * HALF + m * 16) * D + col0; float gv = pre.g[ai * 4 + m]; asm volatile("" : "+v"(gv)); const float g = YSCALE * gv;
#pragma unroll
                for (int bj = 0; bj < 2; ++bj) { const f32x4 v0 = (acc[ai][bj][m][0] * WSCALE8_INV + bv[bj][0]) * g, v1 = (acc[ai][bj][m][1] * WSCALE8_INV + bv[bj][1]) * g;
                    *(u32x2*)(rowp + bj * HALF) = (u32x2){pk4_fp8(v0[0], v0[1], v0[2], v0[3]), pk4_fp8(v1[0], v1[1], v1[2], v1[3])}; } }
    }
};
}

namespace moba {
using bf16x8 = ::bf16x8; using s16x4 = ::s16x4; using f32x16 = ::f32x16; using u32x4 = ::u32x4;
constexpr int DMQ = INC, DMO = D, HD = 64;
constexpr int NW = 8, QBLK = 32, QB = 256, KVBLK = 64;
__device__ __forceinline__ int crow(int r, int hi) { return (r & 3) + 8 * (r >> 2) + 4 * hi; }
#define SBAR() __builtin_amdgcn_sched_barrier(0)
__device__ __forceinline__ void cmask(f32x16& p0, f32x16& p1, int jb, int qrel, int hi) {
    const float NEG = -INFINITY; int kb = 64 * jb + 4 * hi;
#pragma unroll
    for (int r = 0; r < 16; ++r) { int kv = kb + (r & 3) + 8 * (r >> 2); if (kv > qrel) p0[r] = NEG; if (kv + 32 > qrel) p1[r] = NEG; }
}
constexpr int NSLOT = 3, SLOTB = 8192;
constexpr int LDS_K = 0, LDS_V = NSLOT * SLOTB, LDS_WS = 2 * NSLOT * SLOTB, LDS_OST = LDS_WS + NW * 64 * 4, LDS_KB = LDS_OST + NW * 4096, LDS_BYTES = LDS_KB + 16 * 64 * 4;
__device__ __forceinline__ void glds16(const void* gsrc, unsigned lds_dst) { unsigned keep;
    asm volatile("s_mov_b32 %0, m0\n\ts_mov_b32 m0, %2\n\ts_nop 0\n\tglobal_load_lds_dwordx4 %1, off\n\ts_mov_b32 m0, %0" : "=&s"(keep) : "v"(gsrc), "s"(lds_dst) : "memory"); }
__device__ __forceinline__ float max3f(float a, float b, float c) { float r; asm("v_max3_f32 %0, %1, %2, %3" : "=v"(r) : "v"(a), "v"(b), "v"(c)); return r; }
__device__ __forceinline__ float max2f(float a, float b) { float r; asm("v_max_f32_e32 %0, %1, %2" : "=v"(r) : "v"(a), "v"(b)); return r; }
__device__ __forceinline__ float fadd_s(float a, float b) { float r; asm("v_add_f32_e32 %0, %1, %2" : "=v"(r) : "v"(a), "v"(b)); return r; }
__device__ __forceinline__ float fsub_s(float a, float b) { float r; asm("v_sub_f32_e32 %0, %1, %2" : "=v"(r) : "v"(a), "v"(b)); return r; }
__device__ __forceinline__ unsigned cvtpk_s(float lo, float hi) { return ::cvtpk(lo, hi); }
#define WAIT_BAR(N) asm volatile("s_waitcnt vmcnt(" #N ") lgkmcnt(0)\n\ts_barrier" ::: "memory")
__device__ __forceinline__ void qkt(f32x16& p0, f32x16& p1, const char* Kslot, const bf16x8* qr, const f32x16& negm, int r32, int hi) {
    const char* kb = Kslot + hi * 1024 + r32 * 16;
#pragma unroll
    for (int d0 = 0; d0 < 4; ++d0) {
        const bf16x8 b0 = *reinterpret_cast<const bf16x8*>(kb + d0 * 2048);
        const bf16x8 b1 = *reinterpret_cast<const bf16x8*>(kb + d0 * 2048 + 512);
        if (d0 == 0) { p0 = __builtin_amdgcn_mfma_f32_32x32x16_bf16(b0, qr[0], negm, 0, 0, 0); p1 = __builtin_amdgcn_mfma_f32_32x32x16_bf16(b1, qr[0], negm, 0, 0, 0); }
        else { p0 = __builtin_amdgcn_mfma_f32_32x32x16_bf16(b0, qr[d0], p0, 0, 0, 0); p1 = __builtin_amdgcn_mfma_f32_32x32x16_bf16(b1, qr[d0], p1, 0, 0, 0); } }
}
typedef __attribute__((address_space(3))) const char* lds_cptr;
typedef short v4i16_t __attribute__((ext_vector_type(4)));
__device__ __forceinline__ void kload8(bf16x8* kf, lds_cptr kp) {
    kf[0] = *(const __attribute__((address_space(3))) bf16x8*)(kp);        kf[1] = *(const __attribute__((address_space(3))) bf16x8*)(kp + 512);
    kf[2] = *(const __attribute__((address_space(3))) bf16x8*)(kp + 2048); kf[3] = *(const __attribute__((address_space(3))) bf16x8*)(kp + 2560);
    kf[4] = *(const __attribute__((address_space(3))) bf16x8*)(kp + 4096); kf[5] = *(const __attribute__((address_space(3))) bf16x8*)(kp + 4608);
    kf[6] = *(const __attribute__((address_space(3))) bf16x8*)(kp + 6144); kf[7] = *(const __attribute__((address_space(3))) bf16x8*)(kp + 6656);
}
__device__ __forceinline__ void kload2(bf16x8* kf, lds_cptr kp, int j) { kf[2 * j] = *(const __attribute__((address_space(3))) bf16x8*)(kp + j * 2048); kf[2 * j + 1] = *(const __attribute__((address_space(3))) bf16x8*)(kp + j * 2048 + 512); }
__device__ __forceinline__ s16x4 vtr(lds_cptr p) { return __builtin_bit_cast(s16x4, __builtin_amdgcn_ds_read_tr16_b64_v4i16((__attribute__((address_space(3))) v4i16_t*)p)); }
__device__ __forceinline__ float rowmax(const f32x16& p0, const f32x16& p1) {
    float a = max3f(p0[0], p0[1], p1[0]), b = max3f(p0[2], p0[3], p1[1]); a = max3f(a, p1[2], p1[3]);
#pragma unroll
    for (int r = 4; r < 16; r += 4) { a = max3f(a, p0[r], p0[r + 1]); b = max3f(b, p0[r + 2], p0[r + 3]); a = max3f(a, p1[r], p1[r + 1]); b = max3f(b, p1[r + 2], p1[r + 3]); }
    const float m = max2f(a, b);
    auto rr = __builtin_amdgcn_permlane32_swap(__float_as_uint(m), __float_as_uint(m), false, false);
    return max2f(__uint_as_float(rr[0]), __uint_as_float(rr[1]));
}
__device__ __forceinline__ void pv(f32x16* o, int vb, bf16x8 pa0, bf16x8 pa1, bf16x8 pa2, bf16x8 pa3) {
#pragma unroll
    for (int d0 = 0; d0 < 2; ++d0) { s16x4 lo[4], hi[4];
#pragma unroll
        for (int ks = 0; ks < 4; ++ks) {
            asm volatile("ds_read_b64_tr_b16 %0,%1 offset:%c2" : "=&v"(lo[ks]) : "v"(vb), "i"(d0 * 4096 + ks * 1024) : "memory");
            asm volatile("ds_read_b64_tr_b16 %0,%1 offset:%c2" : "=&v"(hi[ks]) : "v"(vb), "i"(d0 * 4096 + ks * 1024 + 512) : "memory"); }
        asm volatile("s_waitcnt lgkmcnt(0)" ::: "memory"); SBAR();
#define PK(k) (bf16x8){lo[k][0], lo[k][1], lo[k][2], lo[k][3], hi[k][0], hi[k][1], hi[k][2], hi[k][3]}
        o[d0] = __builtin_amdgcn_mfma_f32_32x32x16_bf16(pa0, PK(0), o[d0], 0, 0, 0);
        o[d0] = __builtin_amdgcn_mfma_f32_32x32x16_bf16(pa1, PK(1), o[d0], 0, 0, 0);
        o[d0] = __builtin_amdgcn_mfma_f32_32x32x16_bf16(pa2, PK(2), o[d0], 0, 0, 0);
        o[d0] = __builtin_amdgcn_mfma_f32_32x32x16_bf16(pa3, PK(3), o[d0], 0, 0, 0);
#undef PK
    }
}
constexpr float NEGBIG = -1.0e30f;

template <int THRL> __device__ __forceinline__ void attn_unit(int b, int h, int qb, const bf16_t* Qg, const bf16_t* __restrict__ Kg, const bf16_t* __restrict__ Vg, bf16_t* Og, const float* __restrict__ kbar, char* shm) {
    int tid_ = threadIdx.x; asm volatile("" : "+v"(tid_));
    const int tid = tid_, lane = tid & 63, r32 = lane & 31, hi = lane >> 5; const int wid = __builtin_amdgcn_readfirstlane(tid >> 6);
    const long rowbase = (long)b * SEQ; const int q0 = qb * QB;
    const size_t hoff = (size_t)(b * 8 + h) * (SEQ * 64);
    const bf16_t* Qw = Qg + hoff + (size_t)(q0 + wid * QBLK) * 64;
    const bf16_t* Kh = Kg + hoff, *Vh = Vg + hoff;
    const unsigned lds0 = (unsigned)(uintptr_t)shm;
    float* wsf = (float*)(shm + LDS_WS) + wid * 64;
    const bf16_t* ksrc = Kh + wid * 512 + lane * 8;
    const bf16_t* vsrc = Vh + wid * 512 + lane * 8;
    const unsigned kdst = lds0 + LDS_K + wid * 1024, vdst = lds0 + LDS_V + wid * 1024;
    const int NT = 4 * qb + 4, NPAST = 4 * qb;
#define TMAP(t) (((t) < 4) ? (NPAST + (t)) : ((t) - 4))
#define DMA_K(t, slot) glds16(ksrc + (long)TMAP(t) * 4096, (unsigned)__builtin_amdgcn_readfirstlane(kdst + (slot)))
#define DMA_V(t, slot) glds16(vsrc + (long)TMAP(t) * 4096, (unsigned)__builtin_amdgcn_readfirstlane(vdst + (slot)))
    const char* Kbase = shm + LDS_K; bf16x8 kf[8];
    const lds_cptr shm3 = (lds_cptr)shm; const lds_cptr kp0 = shm3 + LDS_K + hi * 1024 + r32 * 16; const lds_cptr vp0 = shm3 + LDS_V + ((lane >> 4) & 1) * 32 + (lane & 3) * 8 + (4 * hi + ((lane & 15) >> 2)) * 64;
    DMA_K(0, 0); DMA_V(0, 0); DMA_K(1, SLOTB);
    bf16x8 qr[4];
#pragma unroll
    for (int d0 = 0; d0 < 4; ++d0) qr[d0] = *reinterpret_cast<const bf16x8*>(&Qw[(long)r32 * 64 + d0 * 16 + hi * 8]);
    unsigned selm = 0u;
    if (qb > 0) {
        float* kbl = (float*)(shm + LDS_KB);
        for (int i = tid; i < qb * 64; i += NW * 64) kbl[i] = kbar[((size_t)(b * 16 + (i >> 6)) * 8 + h) * 64 + (i & 63)];
        asm volatile("s_waitcnt vmcnt(0) lgkmcnt(0)\n\ts_barrier" ::: "memory");
        if (qb <= 3) selm = (1u << qb) - 1u;
        else {
            float qf[32];
#pragma unroll
            for (int d0 = 0; d0 < 4; ++d0)
#pragma unroll
                for (int j = 0; j < 8; ++j) qf[d0 * 8 + j] = bf2f((unsigned short)qr[d0][j]);
            float g[15];
#pragma unroll
            for (int n = 0; n < 15; ++n) { float s = 0.f;
                if (n < qb) {
#pragma unroll
                    for (int d0 = 0; d0 < 4; ++d0) { const f32x4 k0 = *(const f32x4*)(kbl + n * 64 + d0 * 16 + hi * 8), k1 = *(const f32x4*)(kbl + n * 64 + d0 * 16 + hi * 8 + 4);
                        s += qf[d0 * 8 + 0] * k0[0] + qf[d0 * 8 + 1] * k0[1] + qf[d0 * 8 + 2] * k0[2] + qf[d0 * 8 + 3] * k0[3] + qf[d0 * 8 + 4] * k1[0] + qf[d0 * 8 + 5] * k1[1] + qf[d0 * 8 + 6] * k1[2] + qf[d0 * 8 + 7] * k1[3]; }
                    s += __shfl_xor(s, 32);
                } else s = -INFINITY;
                g[n] = s; }
#pragma unroll
            for (int pass = 0; pass < 3; ++pass) { float best = -INFINITY; int bi = 0;
#pragma unroll
                for (int n = 0; n < 15; ++n) if (g[n] > best) { best = g[n]; bi = n; }
                selm |= 1u << bi;
#pragma unroll
                for (int n = 0; n < 15; ++n) if (n == bi) g[n] = -INFINITY; }
        }
    }
    float mhat = 0.f, l_reg = 0.f; f32x16 o[2]; o[0] = f32x16{}; o[1] = f32x16{}; f32x16 cini = f32x16{}; asm volatile("" : "+v"(cini));
    const int qrel = wid * QBLK + r32;
#define SETC(t, JB) do { const float cm_ = ((JB >= 0) || ((selm >> (((t) - 4) >> 2)) & 1u)) ? -mhat : NEGBIG; \
      _Pragma("unroll") for (int r = 0; r < 16; ++r) cini[r] = cm_; asm volatile("" : "+v"(cini)); } while (0)
    bool resc = false;
#define START(P0, P1) do { const float rm = rowmax(P0, P1); resc = false; \
    { const float dl = rm; mhat = fadd_s(mhat, dl); \
      _Pragma("unroll") for (int r = 0; r < 16; ++r) { P0[r] = fsub_s(P0[r], dl); P1[r] = fsub_s(P1[r], dl); } } \
    _Pragma("unroll") for (int r = 0; r < 16; ++r) P0[r] = __builtin_amdgcn_exp2f(P0[r]); } while (0)
#define RESC() do { if (resc) { asm volatile("s_waitcnt lgkmcnt(0)" ::: "memory"); \
      _Pragma("unroll") for (int d_ = 0; d_ < 2; ++d_) _Pragma("unroll") for (int r = 0; r < 16; ++r) o[d_][r] *= wsf[crow(r, hi)]; } } while (0)
    f32x16 pA0, pA1, pB0, pB1;
    int sl_prev = 0, sl_cur = 0, sl_next = SLOTB;
#define ROT() do { sl_prev = sl_cur; sl_cur = sl_next; sl_next = (sl_next == (NSLOT - 1) * SLOTB) ? 0 : sl_next + SLOTB; } while (0)
    DMA_K(2, 2 * SLOTB);
    if (qb > 0) { WAIT_BAR(0); } else { WAIT_BAR(3); }
    qkt(pA0, pA1, Kbase, qr, cini, r32, hi); asm volatile("s_nop 15\n\ts_nop 7" : "+v"(pA0), "+v"(pA1)); cmask(pA0, pA1, 0, qrel, hi);
    START(pA0, pA1);
    _Pragma("unroll") for (int r = 0; r < 16; ++r) pA1[r] = __builtin_amdgcn_exp2f(pA1[r]);
    WAIT_BAR(0);
    DMA_K(3, 0); DMA_V(1, SLOTB);
    ROT();
    kload8(kf, kp0 + sl_cur);
    WAIT_BAR(2);
    s16x4 vlo[8], vhi[8]; u32x4 pw0, pw1, pw2, pw3;
#define PKW(P, B) cvtpk_s(P[B], P[B + 1])
#define PAF(k) __builtin_bit_cast(bf16x8, pw##k)
#define VFR(i) (bf16x8){vlo[i][0], vlo[i][1], vlo[i][2], vlo[i][3], vhi[i][0], vhi[i][1], vhi[i][2], vhi[i][3]}
#define PIN(x) asm volatile("" : "+v"(x))
#define MX3(a, b, c) __builtin_fmaxf(__builtin_fmaxf((a), (b)), (c))
#define GAPA(MF, A0, A1, A2, A3, W0, W1, PW) do { MF; sacc += A0; sacc += A1; sacc += A2; sacc += A3; PIN(sacc); W0; W1; PIN(PW); SBAR(); } while (0)
#define EX(v) __builtin_amdgcn_exp2f(v)
#define GAPB(MF, X, B) do { MF; X[B] = EX(X[B]); X[B + 1] = EX(X[B + 1]); X[B + 2] = EX(X[B + 2]); X[B + 3] = EX(X[B + 3]); PIN(X); SBAR(); } while (0)
#define VRD(i) do { vlo[i] = vtr(vp_ + (((i) >> 2) * 4096 + ((i) & 3) * 1024)); vhi[i] = vtr(vp_ + (((i) >> 2) * 4096 + ((i) & 3) * 1024 + 512)); } while (0)
#define KRD(G, j) do { if (G) { kload2(kf, kp0 + sl_next, j); SBAR(); } } while (0)
#define STEP(C0, C1, P0, P1, t, GK, GV, GL, JB) do { SETC(t, JB); SBAR(); \
    const lds_cptr vp_ = vp0 + sl_prev; \
    VRD(0); SBAR(); float sacc = (P0[0] + P0[1]); \
    GAPA(C0 = __builtin_amdgcn_mfma_f32_32x32x16_bf16(kf[0], qr[0], cini, 0, 0, 0), P0[2], P0[3], P0[4], P0[5],     pw0[0] = PKW(P0, 0), pw0[1] = PKW(P0, 2), pw0); \
    VRD(4); SBAR(); GAPA(C1 = __builtin_amdgcn_mfma_f32_32x32x16_bf16(kf[1], qr[0], cini, 0, 0, 0), P0[6], P0[7], P0[8], P0[9],     pw0[2] = PKW(P0, 4), pw0[3] = PKW(P0, 6), pw0); \
    VRD(1); SBAR(); GAPA(C0 = __builtin_amdgcn_mfma_f32_32x32x16_bf16(kf[2], qr[1], C0, 0, 0, 0),   P0[10], P0[11], P0[12], P0[13], pw1[0] = PKW(P0, 8), pw1[1] = PKW(P0, 10), pw1); \
    VRD(5); SBAR(); GAPA(C1 = __builtin_amdgcn_mfma_f32_32x32x16_bf16(kf[3], qr[1], C1, 0, 0, 0),   P0[14], P0[15], P1[0], P1[1],   pw1[2] = PKW(P0, 12), pw1[3] = PKW(P0, 14), pw1); \
    VRD(2); SBAR(); GAPA(C0 = __builtin_amdgcn_mfma_f32_32x32x16_bf16(kf[4], qr[2], C0, 0, 0, 0),   P1[2], P1[3], P1[4], P1[5],     pw2[0] = PKW(P1, 0), pw2[1] = PKW(P1, 2), pw2); \
    VRD(6); SBAR(); GAPA(C1 = __builtin_amdgcn_mfma_f32_32x32x16_bf16(kf[5], qr[2], C1, 0, 0, 0),   P1[6], P1[7], P1[8], P1[9],     pw2[2] = PKW(P1, 4), pw2[3] = PKW(P1, 6), pw2); \
    VRD(3); SBAR(); GAPA(C0 = __builtin_amdgcn_mfma_f32_32x32x16_bf16(kf[6], qr[3], C0, 0, 0, 0),   P1[10], P1[11], P1[12], P1[13], pw3[0] = PKW(P1, 8), pw3[1] = PKW(P1, 10), pw3); \
    VRD(7); SBAR(); GAPA(C1 = __builtin_amdgcn_mfma_f32_32x32x16_bf16(kf[7], qr[3], C1, 0, 0, 0),   P1[14], P1[15], 0.f, 0.f,       pw3[2] = PKW(P1, 12), pw3[3] = PKW(P1, 14), pw3); \
    l_reg += sacc; \
    if (GK) { DMA_K((t) + 3, sl_cur); } if (GV) { DMA_V((t) + 1, sl_next); } \
    if (JB >= 0) cmask(C0, C1, JB, qrel, hi); \
    { float a = MX3(C0[0], C0[1], C1[0]), b_ = MX3(C0[2], C0[3], C1[1]); a = MX3(a, C1[2], C1[3]); \
      _Pragma("unroll") for (int r = 4; r < 16; r += 4) { a = MX3(a, C0[r], C0[r + 1]); b_ = MX3(b_, C0[r + 2], C0[r + 3]); a = MX3(a, C1[r], C1[r + 1]); b_ = MX3(b_, C1[r + 2], C1[r + 3]); } \
      float rm = __builtin_fmaxf(a, b_); { auto rr = __builtin_amdgcn_permlane32_swap(__float_as_uint(rm), __float_as_uint(rm), false, false); rm = __builtin_fmaxf(__uint_as_float(rr[0]), __uint_as_float(rr[1])); } \
      resc = false; \
      if (__builtin_expect(__any(rm > (float)THRL), 0)) { const float dl = __builtin_fmaxf(rm, 0.f); mhat += dl; \
        _Pragma("unroll") for (int r = 0; r < 16; ++r) { C0[r] -= dl; C1[r] -= dl; } \
        const float f = __builtin_amdgcn_exp2f(-dl); l_reg *= f; if (hi == 0) wsf[r32] = f; resc = true; } } \
    SBAR(); \
    GAPB(o[0] = __builtin_amdgcn_mfma_f32_32x32x16_bf16(PAF(0), VFR(0), o[0], 0, 0, 0), C0, 0); \
    GAPB(o[1] = __builtin_amdgcn_mfma_f32_32x32x16_bf16(PAF(0), VFR(4), o[1], 0, 0, 0), C0, 4); \
    KRD(GL, 0); GAPB(o[0] = __builtin_amdgcn_mfma_f32_32x32x16_bf16(PAF(1), VFR(1), o[0], 0, 0, 0), C0, 8); \
    KRD(GL, 1); GAPB(o[1] = __builtin_amdgcn_mfma_f32_32x32x16_bf16(PAF(1), VFR(5), o[1], 0, 0, 0), C0, 12); \
    KRD(GL, 2); GAPB(o[0] = __builtin_amdgcn_mfma_f32_32x32x16_bf16(PAF(2), VFR(2), o[0], 0, 0, 0), C1, 0); \
    KRD(GL, 3); GAPB(o[1] = __builtin_amdgcn_mfma_f32_32x32x16_bf16(PAF(2), VFR(6), o[1], 0, 0, 0), C1, 4); \
    GAPB(o[0] = __builtin_amdgcn_mfma_f32_32x32x16_bf16(PAF(3), VFR(3), o[0], 0, 0, 0), C1, 8); \
    GAPB(o[1] = __builtin_amdgcn_mfma_f32_32x32x16_bf16(PAF(3), VFR(7), o[1], 0, 0, 0), C1, 12); \
    } while (0)
#define ENDW(tt) do { if ((tt) + 3 < NT) { WAIT_BAR(2); } else if ((tt) + 2 < NT) { WAIT_BAR(1); } else { WAIT_BAR(0); } } while (0)
    STEP(pB0, pB1, pA0, pA1, 1, (4 < NT), true, true, 1);   ENDW(1); RESC(); ROT();
    STEP(pA0, pA1, pB0, pB1, 2, (5 < NT), true, true, 2);   ENDW(2); RESC(); ROT();
    STEP(pB0, pB1, pA0, pA1, 3, (6 < NT), (4 < NT), (4 < NT), 3);   ENDW(3); RESC(); ROT();
    int t = 4;
    for (; t + 4 < NT; t += 2) {
        STEP(pA0, pA1, pB0, pB1, t, true, true, true, -1);       WAIT_BAR(2); RESC(); ROT();
        STEP(pB0, pB1, pA0, pA1, t + 1, true, true, true, -1);   WAIT_BAR(2); RESC(); ROT();
    }
    for (; t < NT; t += 2) {
        STEP(pA0, pA1, pB0, pB1, t, (t + 3 < NT), true, true, -1);                       ENDW(t);     RESC(); ROT();
        STEP(pB0, pB1, pA0, pA1, t + 1, (t + 4 < NT), (t + 2 < NT), (t + 2 < NT), -1);   ENDW(t + 1); RESC(); ROT();
    }
    { float sacc = pB0[0] + pB0[1]; _Pragma("unroll") for (int r = 2; r < 16; ++r) sacc += pB0[r]; _Pragma("unroll") for (int r = 0; r < 16; ++r) sacc += pB1[r]; l_reg += sacc;
      pw0 = (u32x4){PKW(pB0, 0), PKW(pB0, 2), PKW(pB0, 4), PKW(pB0, 6)}; pw1 = (u32x4){PKW(pB0, 8), PKW(pB0, 10), PKW(pB0, 12), PKW(pB0, 14)}; pw2 = (u32x4){PKW(pB1, 0), PKW(pB1, 2), PKW(pB1, 4), PKW(pB1, 6)}; pw3 = (u32x4){PKW(pB1, 8), PKW(pB1, 10), PKW(pB1, 12), PKW(pB1, 14)};
      SBAR(); pv(o, (int)(unsigned long)vp0 + sl_prev, PAF(0), PAF(1), PAF(2), PAF(3)); }
#undef PKW
#undef PAF
#undef VFR
#undef PIN
#undef MX3
#undef GAPA
#undef GAPB
#undef EX
#undef VRD
#undef KRD
#undef STEP
#undef ENDW
    { auto rr = __builtin_amdgcn_permlane32_swap(__float_as_uint(l_reg), __float_as_uint(l_reg), false, false); l_reg = __uint_as_float(rr[0]) + __uint_as_float(rr[1]); }
    if (hi == 0) wsf[32 + r32] = l_reg; asm volatile("s_waitcnt lgkmcnt(0)" ::: "memory");
    float rli[16];
#pragma unroll
    for (int r = 0; r < 16; ++r) rli[r] = __builtin_amdgcn_rcpf(wsf[32 + crow(r, hi)]);
    bf16_t* Ow = Og + (rowbase + q0 + wid * QBLK) * DMO + h * HD;
    { bf16_t* stg = (bf16_t*)(shm + LDS_OST) + wid * 2048;
#pragma unroll
      for (int r = 0; r < 16; ++r) { const int orow = crow(r, hi);
#pragma unroll
        for (int d0 = 0; d0 < 2; ++d0) stg[orow * 64 + d0 * 32 + r32] = (bf16_t)f2bf(o[d0][r] * rli[r]); }
      asm volatile("s_waitcnt lgkmcnt(0)" ::: "memory");
#pragma unroll
      for (int i = 0; i < 4; ++i) { const int row = i * 8 + (lane >> 3), ch = lane & 7; const u32x4 v = *(const u32x4*)(stg + row * 64 + ch * 8); *(u32x4*)(Ow + (long)row * DMO + ch * 8) = v; } }
    asm volatile("s_waitcnt lgkmcnt(0)\n\ts_barrier" ::: "memory");
#undef DMA_K
#undef DMA_V
#undef TMAP
#undef SETC
#undef START
#undef RESC
#undef ROT
}
#undef SBAR
#undef WAIT_BAR
}

namespace hgrn {
constexpr int RS = 144;
constexpr int R_FQV = 0, FQV_SLOT = 32768;
constexpr int L_Q = 98304, L_K = L_Q + 9216, L_KT = L_K + 9216, L_VT = L_KT + 9216, L_ST = L_VT + 9216, L_SEG = L_ST + 9216, L_DEND = L_SEG + 2048, L_SSQ = L_DEND + 256, L_BYTES = L_SSQ + 512;
__device__ __forceinline__ int crow(int r, int hi) { return (r & 3) + 8 * (r >> 2) + 4 * hi; }
__device__ __forceinline__ void glds16(const void* gsrc, unsigned lds_dst) { unsigned keep;
    asm volatile("s_mov_b32 %0, m0\n\ts_mov_b32 m0, %2\n\ts_nop 0\n\tglobal_load_lds_dwordx4 %1, off\n\ts_mov_b32 m0, %0" : "=&s"(keep) : "v"(gsrc), "s"(lds_dst) : "memory"); }
#define HG_BAR() do { asm volatile("s_waitcnt lgkmcnt(0)" ::: "memory"); __builtin_amdgcn_s_barrier(); asm volatile("" ::: "memory"); } while (0)
#ifndef HG_ABL
#define HG_ABL 0
#endif
__device__ __forceinline__ void hgrn_unit(int b, int h, const bf16_t* __restrict__ proj, bf16_t* __restrict__ mix, const float* __restrict__ lb_logits, const float* __restrict__ norm_g, LAS unsigned char* lds, const int abl = 0) {
    int tid_ = threadIdx.x; asm volatile("" : "+v"(tid_));
    const int tid = tid_, lane = tid & 63, r32 = lane & 31, hi = lane >> 5; const int w = __builtin_amdgcn_readfirstlane(tid >> 6);
    const float lbk = fast_rcp(1.0f + fast_exp2((lb_logits[512 + h * 64 + lane] - lb_logits[h * 64 + lane]) * LOG2E));
    const int vr = (w >> 1) & 1, tc = w & 1;
    float ng[16];
#pragma unroll
    for (int r = 0; r < 16; ++r) ng[r] = norm_g[h * 64 + 32 * vr + crow(r, hi)];
    f32x16 S = f32x16{};
    for (int i = tid; i < 64 * RS / 4; i += 512) ((LAS unsigned*)(lds + L_ST))[i] = 0u;
    const size_t hoff = (size_t)(b * 8 + h) * (SEQ * 64) + (size_t)w * 512 + lane * 8;
    const bf16_t* gQ = proj + 3 * SEC_ELEMS + hoff; const bf16_t* gF = proj + 4 * SEC_ELEMS + hoff; const bf16_t* gV = proj + 5 * SEC_ELEMS + hoff; const bf16_t* gG = proj + 6 * SEC_ELEMS + hoff;
    const unsigned lds0 = (unsigned)(uintptr_t)(unsigned char*)lds;
#define DMA_FQV(c_) do { const int cc_ = (c_) < 63 ? (c_) : 63; const unsigned d_ = (unsigned)__builtin_amdgcn_readfirstlane(lds0 + R_FQV + (unsigned)(((c_) % 3) * FQV_SLOT) + (unsigned)w * 1024u); \
        glds16(gF + (size_t)cc_ * 4096, d_); glds16(gQ + (size_t)cc_ * 4096, d_ + 8192u); glds16(gV + (size_t)cc_ * 4096, d_ + 16384u); } while (0)
#define DMA_G(c_) do { const int cc_ = (c_) < 63 ? (c_) : 63; glds16(gG + (size_t)cc_ * 4096, (unsigned)__builtin_amdgcn_readfirstlane(lds0 + R_FQV + (unsigned)(((c_) % 3) * FQV_SLOT) + 24576u + (unsigned)w * 1024u)); } while (0)
    DMA_FQV(0); DMA_G(0); DMA_FQV(1); DMA_G(1); DMA_FQV(2);
    for (int c = 0; c < 64; ++c) {
        const size_t row0 = (size_t)b * SEQ + (size_t)c * 64;
        if (abl & 8) {} else if (w < 4 && c >= 3) asm volatile("s_waitcnt vmcnt(20)" ::: "memory");
        else asm volatile("s_waitcnt vmcnt(8)" ::: "memory");
        const LAS unsigned char* raw = lds + R_FQV + (c % 3) * FQV_SLOT + (8 * w) * 128 + lane * 2;
        float p[8], kk[8];
        { float run = 0.f;
#pragma unroll
          for (int i = 0; i < 8; ++i) { const float x = bf2f(*(const LAS unsigned short*)(raw + i * 128)); float f, lg;
              if (abl & 2) { f = 0.5f + 0.001f * x; lg = -1.0f + 0.001f * x; } else { const float sg = fast_rcp(1.0f + fast_exp2(-x * LOG2E)); f = lbk + (1.0f - lbk) * sg; lg = __builtin_amdgcn_logf(f); }
              run += lg; p[i] = run; kk[i] = 1.0f - f; } }
        ((LAS float*)(lds + L_SEG))[w * 64 + lane] = p[7];
        HG_BAR();
        if (!(abl & 8)) DMA_G(c + 2);
        { float off = 0.f;
#pragma unroll
          for (int j = 0; j < 7; ++j) { const float sv = ((LAS float*)(lds + L_SEG))[j * 64 + lane]; off += (j < w) ? sv : 0.f; }
          unsigned kq[4], vq[4];
#pragma unroll
          for (int i = 0; i < 8; i += 2) { const float b0 = off + p[i], b1 = off + p[i + 1];
              const unsigned short q0r = *(const LAS unsigned short*)(raw + 8192 + i * 128), q1r = *(const LAS unsigned short*)(raw + 8192 + (i + 1) * 128);
              const unsigned short v0r = *(const LAS unsigned short*)(raw + 16384 + i * 128), v1r = *(const LAS unsigned short*)(raw + 16384 + (i + 1) * 128);
              const float q0 = bf2f(q0r) * fast_exp2(b0), q1 = bf2f(q1r) * fast_exp2(b1), k0 = kk[i] * fast_exp2(-b0), k1 = kk[i + 1] * fast_exp2(-b1);
              const unsigned qq = cvtpk(q0, q1), kw = cvtpk(k0, k1); kq[i >> 1] = kw; vq[i >> 1] = (unsigned)v0r | ((unsigned)v1r << 16);
              if (abl & 4) continue;
              *(LAS unsigned short*)(lds + L_Q + (8 * w + i) * RS + lane * 2) = (unsigned short)(qq & 0xffffu);
              *(LAS unsigned short*)(lds + L_Q + (8 * w + i + 1) * RS + lane * 2) = (unsigned short)(qq >> 16);
              *(LAS unsigned short*)(lds + L_K + (8 * w + i) * RS + lane * 2) = (unsigned short)(kw & 0xffffu);
              *(LAS unsigned short*)(lds + L_K + (8 * w + i + 1) * RS + lane * 2) = (unsigned short)(kw >> 16); }
          *(LAS u32x4*)(lds + L_KT + lane * RS + 16 * w) = (u32x4){kq[0], kq[1], kq[2], kq[3]};
          *(LAS u32x4*)(lds + L_VT + lane * RS + 16 * w) = (u32x4){vq[0], vq[1], vq[2], vq[3]};
          if (w == 7) ((LAS float*)(lds + L_DEND))[lane] = fast_exp2(off + p[7]); }
        if (!(abl & 8)) DMA_FQV(c + 3);
        if (abl & 8) {} else if (w < 4 && c >= 2) asm volatile("s_waitcnt vmcnt(19)" ::: "memory");
        else asm volatile("s_waitcnt vmcnt(11)" ::: "memory");
        HG_BAR();
        f32x16 OT = f32x16{};
        if (abl & 1) { OT[0] = (float)c; } else
        if (w < 4) {
            bf16x8 bq[4];
#pragma unroll
            for (int ks = 0; ks < 4; ++ks) bq[ks] = *(const LAS bf16x8*)(lds + L_Q + (32 * tc + r32) * RS + (16 * ks + 8 * hi) * 2);
#pragma unroll
            for (int sr = 0; sr < 2; ++sr) if (sr <= tc) {
                f32x16 at = f32x16{};
#pragma unroll
                for (int ks = 0; ks < 4; ++ks) { const bf16x8 a = *(const LAS bf16x8*)(lds + L_K + (32 * sr + r32) * RS + (16 * ks + 8 * hi) * 2); at = __builtin_amdgcn_mfma_f32_32x32x16_bf16(a, bq[ks], at, 0, 0, 0); }
                if (sr == tc) {
#pragma unroll
                    for (int r = 0; r < 16; ++r) at[r] = (crow(r, hi) <= r32) ? at[r] : 0.f; }
#pragma unroll
                for (int st = 0; st < 2; ++st) {
                    u32x4 bw; bw.x = cvtpk(at[8 * st + 0], at[8 * st + 1]); bw.y = cvtpk(at[8 * st + 2], at[8 * st + 3]); bw.z = cvtpk(at[8 * st + 4], at[8 * st + 5]); bw.w = cvtpk(at[8 * st + 6], at[8 * st + 7]);
                    const u32x2 lo = *(const LAS u32x2*)(lds + L_VT + (32 * vr + r32) * RS + (32 * sr + 16 * st + 4 * hi) * 2);
                    const u32x2 hh = *(const LAS u32x2*)(lds + L_VT + (32 * vr + r32) * RS + (32 * sr + 16 * st + 8 + 4 * hi) * 2);
                    const u32x4 aw = (u32x4){lo.x, lo.y, hh.x, hh.y};
                    OT = __builtin_amdgcn_mfma_f32_32x32x16_bf16(__builtin_bit_cast(bf16x8, aw), __builtin_bit_cast(bf16x8, bw), OT, 0, 0, 0); }
            }
#pragma unroll
            for (int ks = 0; ks < 4; ++ks) { const bf16x8 a = *(const LAS bf16x8*)(lds + L_ST + (32 * vr + r32) * RS + (16 * ks + 8 * hi) * 2); OT = __builtin_amdgcn_mfma_f32_32x32x16_bf16(a, bq[ks], OT, 0, 0, 0); }
            float sq = 0.f;
#pragma unroll
            for (int r = 0; r < 16; ++r) sq += OT[r] * OT[r];
            sq += __shfl_xor(sq, 32);
            if (hi == 0) ((LAS float*)(lds + L_SSQ))[vr * 64 + 32 * tc + r32] = sq;
        } else {
#pragma unroll
            for (int st = 0; st < 4; ++st) { const bf16x8 a = *(const LAS bf16x8*)(lds + L_KT + (32 * vr + r32) * RS + (16 * st + 8 * hi) * 2);
                const bf16x8 bv = *(const LAS bf16x8*)(lds + L_VT + (32 * tc + r32) * RS + (16 * st + 8 * hi) * 2);
                S = __builtin_amdgcn_mfma_f32_32x32x16_bf16(a, bv, S, 0, 0, 0); }
#pragma unroll
            for (int r = 0; r < 16; ++r) S[r] *= ((LAS float*)(lds + L_DEND))[32 * vr + crow(r, hi)];
        }
        HG_BAR();
        if (w < 4) {
            const int t = 32 * tc + r32;
            const float tot = ((LAS float*)(lds + L_SSQ))[t] + ((LAS float*)(lds + L_SSQ))[64 + t];
            const float rstd = __builtin_amdgcn_rsqf(tot * (1.0f / 64.0f) + EPS);
            const LAS unsigned char* gp = lds + R_FQV + (c % 3) * FQV_SLOT + 24576 + t * 128 + (32 * vr + 4 * hi) * 2;
            bf16_t* op = mix + (row0 + t) * D + 512 + h * 64 + 32 * vr + 4 * hi;
#pragma unroll
            for (int g = 0; g < 4; ++g) { const u32x2 gg = *(const LAS u32x2*)(gp + 16 * g);
                const float y0 = OT[4 * g + 0] * rstd * ng[4 * g + 0] * bflo(gg.x), y1 = OT[4 * g + 1] * rstd * ng[4 * g + 1] * bfhi(gg.x),
                            y2 = OT[4 * g + 2] * rstd * ng[4 * g + 2] * bflo(gg.y), y3 = OT[4 * g + 3] * rstd * ng[4 * g + 3] * bfhi(gg.y);
                const u32x2 yv = (u32x2){cvtpk(y0, y1), cvtpk(y2, y3)}; if (!(abl & 16)) asm volatile("global_store_dwordx2 %0, %1, off" :: "v"(op + 8 * g), "v"(yv) : "memory"); }
        } else {
#pragma unroll
            for (int g = 0; g < 4; ++g) *(LAS u32x2*)(lds + L_ST + (32 * tc + r32) * RS + (32 * vr + 8 * g + 4 * hi) * 2) = (u32x2){cvtpk(S[4 * g + 0], S[4 * g + 1]), cvtpk(S[4 * g + 2], S[4 * g + 3])};
        }
    }
    asm volatile("s_waitcnt vmcnt(0)" ::: "memory");
    HG_BAR();
#undef DMA_FQV
#undef DMA_G
}
#undef HG_BAR
}

constexpr int NWAVES = 8;
constexpr int LDS_BYTES = 163840;
constexpr int TAIL = 161792;
constexpr int TL_TE = TAIL, TL_TS = TAIL + 576, TL_HIST = TAIL + 768, TL_BASE = TAIL + 896, TL_MISC = TAIL + 1024, TL_CNT = TAIL + 1280;
typedef GAS unsigned gu32;

struct Args { const float* in[20]; float* out; unsigned char* ws; int ph_lo, ph_hi; };

struct Frame {
    LAS unsigned char* lds; volatile LAS unsigned* MISC; unsigned* ctl;
    int tid, lane, wave, G, vcu;
};

struct P0Item { const float* W; bf16_t* WT; const float* gain; int N, K, k0, n0, mode; };
constexpr int P0_I_IN = 16 * 56, P0_I_SQ = 16 * 16, P0_I_KV = 16 * 32, P0_I_W1 = 16 * 32, P0_I_W2 = 16 * 16;
constexpr int P0_I_IN8 = 16 * 24;
constexpr int P0_NA = P0_I_IN + P0_I_KV + P0_I_IN8, P0_NB = 2 * P0_I_SQ + NEXP * (P0_I_W1 + P0_I_W2);
template <int SET> __device__ __forceinline__ bool p0_decode(const Args& a, int it, P0Item& I) {
    unsigned char* ws = a.ws;
    if (it >= (SET == 0 ? P0_NA : P0_NB)) return false;
    int r = it; I.gain = nullptr; I.mode = 0; I.K = D;
    if (SET == 0) {
        if (r < P0_I_IN) { I.W = a.in[3]; I.WT = (bf16_t*)(ws + WS_WIN); I.N = INC; I.gain = a.in[2]; }
        else if ((r -= P0_I_IN) < P0_I_KV) { I.W = a.in[10]; I.WT = (bf16_t*)(ws + WS_WKV); I.N = 2 * D; }
        else { r -= P0_I_KV; I.W = a.in[3]; I.WT = (bf16_t*)(ws + WS_WIN8); I.N = INC; I.mode = 2; I.gain = a.in[2]; const int nblk8 = 24; I.k0 = 64 * (r / nblk8); I.n0 = 64 * (r % nblk8); return true; }
    } else {
        if (r < P0_I_SQ) { I.W = a.in[6]; I.WT = (bf16_t*)(ws + WS_WOUT); I.N = D; }
        else if ((r -= P0_I_SQ) < P0_I_SQ) { I.W = a.in[11]; I.WT = (bf16_t*)(ws + WS_WO); I.N = D; }
        else if ((r -= P0_I_SQ) < NEXP * P0_I_W1) { const int e = r / P0_I_W1; r -= e * P0_I_W1; I.W = a.in[15] + (size_t)e * D * 2048; I.WT = (bf16_t*)(ws + WS_W1 + (size_t)e * 2048 * D); I.N = 2048; I.gain = a.in[12]; I.mode = 3; }
        else { r -= NEXP * P0_I_W1; const int e = r / P0_I_W2; r -= e * P0_I_W2; I.W = a.in[17] + (size_t)e * D * D; I.WT = (bf16_t*)(ws + WS_W2 + (size_t)e * D * D); I.N = D; I.mode = 2; }
    }
    const int nblk = I.N / 64; I.k0 = 64 * (r / nblk); I.n0 = 64 * (r % nblk); return true;
}
template <int SET> __device__ __forceinline__ void p0_run(const Args& a, int first, int stride, int count, LAS unsigned char* tl, int lane);
__device__ __forceinline__ void p0_load(const P0Item& I, f32x4 (&v)[16], f32x4 (&g)[4], int lane) {
    const float* base = I.W + (size_t)I.k0 * I.N + I.n0;
    const unsigned vo = (unsigned)((lane >> 4) * I.N + 4 * (lane & 15)) * 4u, rs = (unsigned)(4 * I.N) * 4u;
#pragma unroll
    for (int j = 0; j < 16; ++j) v[j] = pg8::gload128_hidden_nt(base, vo + rs * (unsigned)j);
    const float* gb = I.gain ? I.gain + I.k0 : base; const unsigned go = (unsigned)(lane >> 4) * 4u;
#pragma unroll
    for (int q = 0; q < 4; ++q) { g[q][0] = __uint_as_float(pg8::gload32_hidden(gb, go + (unsigned)(16 * q) * 4u)); g[q][1] = __uint_as_float(pg8::gload32_hidden(gb, go + (unsigned)(16 * q + 4) * 4u));
                                  g[q][2] = __uint_as_float(pg8::gload32_hidden(gb, go + (unsigned)(16 * q + 8) * 4u)); g[q][3] = __uint_as_float(pg8::gload32_hidden(gb, go + (unsigned)(16 * q + 12) * 4u)); }
}
constexpr int P0_LOADS = 32;
__device__ __forceinline__ void p0_store(const P0Item& I, const f32x4 (&v)[16], const f32x4 (&gq)[4], LAS unsigned char* tl, int lane) {
    const int kr = lane >> 4, nq = lane & 15;
#pragma unroll
    for (int j = 0; j < 16; ++j) { const int k = 4 * j + kr; const float g = I.gain ? gq[j >> 2][j & 3] : 1.0f;
        *(LAS u32x2*)(tl + k * 128 + (((nq >> 1) ^ ((k >> 3) & 7)) * 16) + (nq & 1) * 8) = (u32x2){pk2(v[j].x * g, v[j].y * g), pk2(v[j].z * g, v[j].w * g)}; }
    LDS_WAIT(); asm volatile("" ::: "memory");
    const int c = lane & 7;
#pragma unroll
    for (int i = 0; i < 8; ++i) { const int n = (lane >> 3) + 8 * i; const LAS unsigned char* sp = tl + (8 * c) * 128 + ((i ^ c) * 16) + (n & 7) * 2;
        unsigned short e[8];
#pragma unroll
        for (int q = 0; q < 8; ++q) e[q] = *(const LAS unsigned short*)(sp + q * 128);
        int row = I.n0 + n; if (I.mode & 1) { const int jj = row >> 1, bj = row & 1; row = (jj >> 7) * 256 + bj * 128 + (jj & 127); }
        if (I.mode & 2) *(u32x2*)((unsigned char*)I.WT + (size_t)row * I.K + I.k0 + 8 * c) = (u32x2){pk4_fp8(bf2f(e[0]) * WSCALE8, bf2f(e[1]) * WSCALE8, bf2f(e[2]) * WSCALE8, bf2f(e[3]) * WSCALE8), pk4_fp8(bf2f(e[4]) * WSCALE8, bf2f(e[5]) * WSCALE8, bf2f(e[6]) * WSCALE8, bf2f(e[7]) * WSCALE8)};
        else *(u32x4*)(I.WT + (size_t)row * I.K + I.k0 + 8 * c) = (u32x4){(unsigned)e[0] | ((unsigned)e[1] << 16), (unsigned)e[2] | ((unsigned)e[3] << 16), (unsigned)e[4] | ((unsigned)e[5] << 16), (unsigned)e[6] | ((unsigned)e[7] << 16)}; }
    LDS_WAIT(); asm volatile("" ::: "memory");
}
template <bool GAIN> __device__ __forceinline__ void rms_rows2_to_bf16(const float* __restrict__ x0, const float* __restrict__ x1, const float* __restrict__ g, bf16_t* __restrict__ o0, bf16_t* __restrict__ o1, int lane, unsigned char* q0 = nullptr, unsigned char* q1 = nullptr, float* irs = nullptr) {
    const f32x4* xa = (const f32x4*)x0 + lane; const f32x4* xb = (const f32x4*)x1 + lane; const f32x4* gr = (const f32x4*)g + lane;
    f32x4 va[4], vb[4]; float sa = 0.f, sb = 0.f;
#pragma unroll
    for (int j = 0; j < 4; ++j) { va[j] = xa[64 * j]; vb[j] = xb[64 * j]; }
#pragma unroll
    for (int j = 0; j < 4; ++j) { sa += (va[j].x * va[j].x + va[j].y * va[j].y) + (va[j].z * va[j].z + va[j].w * va[j].w); sb += (vb[j].x * vb[j].x + vb[j].y * vb[j].y) + (vb[j].z * vb[j].z + vb[j].w * vb[j].w); }
    const float qa = sqrtf(wave_sum(sa) * (1.0f / D) + EPS), qb = sqrtf(wave_sum(sb) * (1.0f / D) + EPS); const float ra = 1.0f / qa, rb = 1.0f / qb;
    if (irs && lane == 0) { irs[0] = qa; irs[1] = qb; }
    unsigned long long* pa = (unsigned long long*)o0 + lane; unsigned long long* pb = (unsigned long long*)o1 + lane;
#pragma unroll
    for (int j = 0; j < 4; ++j) { const f32x4 gg = GAIN ? gr[64 * j] : (f32x4){1.f, 1.f, 1.f, 1.f};
        if (q0) { ((unsigned*)q0)[lane + 64 * j] = pk4_fp8(va[j].x * ra * gg.x, va[j].y * ra * gg.y, va[j].z * ra * gg.z, va[j].w * ra * gg.w);
                  ((unsigned*)q1)[lane + 64 * j] = pk4_fp8(vb[j].x * rb * gg.x, vb[j].y * rb * gg.y, vb[j].z * rb * gg.z, vb[j].w * rb * gg.w); }
        pa[64 * j] = (unsigned long long)pk2(va[j].x * ra * gg.x, va[j].y * ra * gg.y) | ((unsigned long long)pk2(va[j].z * ra * gg.z, va[j].w * ra * gg.w) << 32);
        pb[64 * j] = (unsigned long long)pk2(vb[j].x * rb * gg.x, vb[j].y * rb * gg.y) | ((unsigned long long)pk2(vb[j].z * rb * gg.z, vb[j].w * rb * gg.w) << 32); }
}

__device__ __forceinline__ void p0_prologue(Frame& F, const Args& a) {
    unsigned char* ws = a.ws;
    LAS unsigned char* tl = F.lds + F.wave * 8192;
    const int gw = F.vcu * NWAVES + F.wave, NGW = F.G * NWAVES;
    for (int m = 2 * gw; m < T; m += 2 * NGW) rms_rows2_to_bf16<false>(a.in[0] + (size_t)m * D, a.in[0] + (size_t)(m + 1) * D, a.in[2], (bf16_t*)(ws + WS_XN) + (size_t)m * D, (bf16_t*)(ws + WS_XN) + (size_t)(m + 1) * D, F.lane, ws + WS_XN8 + (size_t)m * D, ws + WS_XN8 + (size_t)(m + 1) * D, (float*)(ws + WS_RS0) + m);
    for (int m = 2 * gw; m < MROWS; m += 2 * NGW) rms_rows2_to_bf16<true>(a.in[1] + (size_t)m * D, a.in[1] + (size_t)(m + 1) * D, a.in[8], (bf16_t*)(ws + WS_MN) + (size_t)m * D, (bf16_t*)(ws + WS_MN) + (size_t)(m + 1) * D, F.lane);
    for (int i = gw * 64 + F.lane; i < D * D / 4; i += NGW * 64) { const f32x4 w = ((const f32x4*)a.in[9])[i]; const float g = a.in[7][i >> 8];
        ((u32x2*)(ws + WS_WQ))[i] = (u32x2){pk2(w.x * g, w.y * g), pk2(w.z * g, w.w * g)}; }
    for (int i = gw * 64 + F.lane; i < NEXP * D; i += NGW * 64) { const int e = i >> 10, k = i & 1023; const float w = a.in[12][k] * a.in[13][k * NEXP + e];
        const unsigned hi = f2bf(w); ((bf16_t*)(ws + WS_WRT))[i] = (bf16_t)hi; ((bf16_t*)(ws + WS_WRT))[NEXP * D + i] = (bf16_t)f2bf(w - bf2f((unsigned short)hi)); }
    p0_run<0>(a, gw, NGW, (P0_NA - gw + NGW - 1) / NGW, tl, F.lane);
}
#define P0_PIN(vv, gg) do { _Pragma("unroll") for (int j_ = 0; j_ < 16; ++j_) asm volatile("" : "+v"(vv[j_])); _Pragma("unroll") for (int q_ = 0; q_ < 4; ++q_) asm volatile("" : "+v"(gg[q_])); } while (0)
template <int SET> __device__ __forceinline__ void p0_run(const Args& a, int first, int stride, int count, LAS unsigned char* tl, int lane_in) {
    int lane = lane_in; asm volatile("" : "+v"(lane));
    P0Item IA, IB; f32x4 va[16], vb[16], ga[4], gb[4];
    int it = first, left = count; bool ha = left > 0 && p0_decode<SET>(a, it, IA); if (ha) p0_load(IA, va, ga, lane);
    while (ha) {
        const bool hb = left > 1 && p0_decode<SET>(a, it + stride, IB); if (hb) p0_load(IB, vb, gb, lane);
        if (hb) asm volatile("s_waitcnt vmcnt(32)" ::: "memory"); else asm volatile("s_waitcnt vmcnt(0)" ::: "memory");
        P0_PIN(va, ga);
        p0_store(IA, va, ga, tl, lane);
        if (!hb) break;
        it += 2 * stride; left -= 2; ha = left > 0 && p0_decode<SET>(a, it, IA); if (ha) p0_load(IA, va, ga, lane);
        if (ha) asm volatile("s_waitcnt vmcnt(32)" ::: "memory"); else asm volatile("s_waitcnt vmcnt(0)" ::: "memory");
        P0_PIN(vb, gb);
        p0_store(IB, vb, gb, tl, lane);
    }
}
#undef P0_PIN

__device__ __forceinline__ unsigned xcc_id() { return (unsigned)__builtin_amdgcn_s_getreg((3 << 11) | 20) & 0xFu; }
constexpr int QITEMS = 16 + 177;
constexpr int CONV_PER_Q = 49, CONV_TILES = 64;
static_assert(8 * CONV_PER_Q * CONV_TILES == P0_NB, "conversion items cover SET 1 exactly");
__device__ __forceinline__ void p2_mixer(Frame& F, const Args& a, int rep) {
    unsigned char* ws = a.ws;
    const bf16_t* proj = (const bf16_t*)(ws + WS_PROJ); bf16_t* mix = (bf16_t*)(ws + WS_MIX);
    const unsigned x0 = xcc_id() & 7u;
    int par = 0;
#ifdef MK_P2_REPMODE
    if (rep && MK_P2_REPMODE == 4) return;
#endif
#ifdef MK_P2_HALF
    if (rep && (blockIdx.x & 8)) return;
#endif
    for (;;) {
        if (F.tid == 0) { int code = -1;
            for (int j = 0; j < 8; ++j) { const unsigned xq = (x0 + j) & 7u; const unsigned i = __hip_atomic_fetch_add(F.ctl + CW_QUEUE + 1024 * rep + 64 * xq, 1u, RLX_AGENT);
                if (i < (unsigned)QITEMS) { code = (int)(xq * 256u + i); break; } }
            F.MISC[par] = (unsigned)code; }
        LDS_WAIT(); __builtin_amdgcn_s_barrier(); asm volatile("" ::: "memory");
        const int code = __builtin_amdgcn_readfirstlane((int)F.MISC[par]); par ^= 1;
        if (code < 0) break;
        const int xq = code >> 8, i = code & 255;
#ifdef MK_P2_REPMODE
        if (rep && ((MK_P2_REPMODE == 1 && i >= 8) || (MK_P2_REPMODE == 2 && i < 16) || MK_P2_REPMODE == 3)) continue;
        if (rep && MK_P2_REPMODE == 5) { const int jq_ = i - 16; const bool isconv = i >= 16 && jq_ < 2 * CONV_PER_Q && (jq_ & 1); if (!isconv) continue; }
#endif
#ifndef NO_HGRN
        if (i < 8) { hgrn::hgrn_unit(xq, i, proj, rep ? (bf16_t*)(ws + WS_H2F) : mix, a.in[4], a.in[5], F.lds, rep ? HG_ABL : 0); }
        else
#endif
        if (i < 16) {
            pg8::KvOrder S{(const char*)(ws + WS_MN), (const char*)(ws + WS_WKV), xq * 8 + (i - 8)};
            pg8::EpiBf16 E{(bf16_t*)(ws + WS_MEMK), D, (bf16_t*)(ws + WS_MEMVT), D};
            pg8::gemm_phase<pg8::EpiBf16, pg8::KvOrder, false, false>(F.lds, D, D, D / 64, S, E);
        } else
        {
        const int jq = i - 16; int mi = -1, cv = -1;
        if (jq < 2 * CONV_PER_Q) { if (jq & 1) cv = jq >> 1; else mi = jq >> 1; } else mi = jq - CONV_PER_Q;
        if (cv >= 0) {
            const int J = xq * CONV_PER_Q + cv;
            p0_run<1>(a, J * CONV_TILES + F.wave * 8, 1, 8, F.lds + F.wave * 8192, F.lane);
            LDS_WAIT(); VM_WAIT(); __builtin_amdgcn_s_barrier(); asm volatile("" ::: "memory");
        } else
#ifndef NO_MOBA
        { const int j = mi, g = j >> 5, jj = j & 31, hh = 2 * g + (jj & 1), qb = 15 - (jj >> 1);
            moba::attn_unit<8>(xq, hh, qb, proj, proj + SEC_ELEMS, proj + 2 * SEC_ELEMS, mix, (const float*)(ws + WS_KBAR), (char*)(unsigned char*)F.lds); }
#else
        {}
#endif
        }
    }
}

__device__ __forceinline__ void p7_router(Frame& F, const Args& a, int rep) {
    unsigned char* ws = a.ws;
    constexpr int WRS = 2064;
    LAS unsigned char* WH = F.lds; LAS unsigned char* WL = F.lds + 32 * WRS;
    LAS int* hist = (LAS int*)(F.lds + TL_HIST); LAS int* basel = (LAS int*)(F.lds + TL_BASE);
    { const u32x4* src = (const u32x4*)(ws + WS_WRT);
      for (int i = F.tid; i < 2 * NEXP * D / 8; i += 512) { const int m = i >> 12, r = (i >> 7) & 31, c = i & 127; *(LAS u32x4*)(F.lds + m * 32 * WRS + r * WRS + c * 16) = src[i]; } }
    const bf16_t* h2h = (const bf16_t*)(ws + WS_H2F); const unsigned char* h2l = ws + WS_H2F + (size_t)T * D * 2; const float* ss2 = (const float*)(ws + WS_SS2);
    int* toke = (int*)(ws + (rep ? WS_DUMMY + 1 * MiB : WS_TOKE)); int* tokr = (int*)(ws + (rep ? WS_DUMMY + 1 * MiB + 512 * 1024 : WS_TOKR)); float* tokg = (float*)(ws + (rep ? WS_DUMMY + 2 * MiB : WS_TOKG)); int* list = (int*)(ws + (rep ? WS_DUMMY + 4 * MiB : WS_LIST)); float* glist = (float*)(ws + (rep ? WS_DUMMY + 8 * MiB : WS_GLIST)); float* sslist = (float*)(ws + (rep ? WS_DUMMY + 12 * MiB : WS_SSLIST));
    unsigned* cntw = F.ctl + (rep ? CW_CNT + 2048 * rep : CW_CNT);
    const int lane = F.lane, r16 = lane & 15, g4 = lane >> 4;
    const float br0 = a.in[14][r16], br1 = a.in[14][16 + r16];
    for (int tb = blockIdx.x; tb < T / 128; tb += F.G) {
        if (F.tid < 32) hist[F.tid] = 0;
        LDS_WAIT(); __builtin_amdgcn_s_barrier(); asm volatile("" ::: "memory");
        const int t0 = tb * 128 + F.wave * 16;
        const bf16_t* xr = h2h + (size_t)(t0 + r16) * D + 8 * g4; const unsigned char* xl = h2l + (size_t)(t0 + r16) * D + 8 * g4;
        f32x4 acc0 = (f32x4){0.f, 0.f, 0.f, 0.f}, acc1 = acc0;
        u32x4 xa = *(const u32x4*)(xr); u32x2 xb = *(const u32x2*)(xl);
#pragma unroll 4
        for (int ks = 0; ks < 32; ++ks) {
            const u32x4 ca = xa; const u32x2 cb = xb;
            if (ks + 1 < 32) { xa = *(const u32x4*)(xr + 32 * (ks + 1)); xb = *(const u32x2*)(xl + 32 * (ks + 1)); }
            constexpr float LS = 1.0f / 1024.0f;
            const f32x2 c0 = __builtin_amdgcn_cvt_pk_f32_fp8((int)cb.x, false), c1 = __builtin_amdgcn_cvt_pk_f32_fp8((int)cb.x, true), c2 = __builtin_amdgcn_cvt_pk_f32_fp8((int)cb.y, false), c3 = __builtin_amdgcn_cvt_pk_f32_fp8((int)cb.y, true);
            const unsigned l0 = cvtpk(c0.x * LS, c0.y * LS), l1 = cvtpk(c1.x * LS, c1.y * LS), l2 = cvtpk(c2.x * LS, c2.y * LS), l3 = cvtpk(c3.x * LS, c3.y * LS);
            const bf16x8 ah = __builtin_bit_cast(bf16x8, ca), al = __builtin_bit_cast(bf16x8, (u32x4){l0, l1, l2, l3});
            const int bo = r16 * WRS + (32 * ks + 8 * g4) * 2;
            const bf16x8 bh0 = *(const LAS bf16x8*)(WH + bo), bh1 = *(const LAS bf16x8*)(WH + 16 * WRS + bo), bl0 = *(const LAS bf16x8*)(WL + bo), bl1 = *(const LAS bf16x8*)(WL + 16 * WRS + bo);
            acc0 = __builtin_amdgcn_mfma_f32_16x16x32_bf16(ah, bh0, acc0, 0, 0, 0); acc1 = __builtin_amdgcn_mfma_f32_16x16x32_bf16(ah, bh1, acc1, 0, 0, 0);
            acc0 = __builtin_amdgcn_mfma_f32_16x16x32_bf16(ah, bl0, acc0, 0, 0, 0); acc1 = __builtin_amdgcn_mfma_f32_16x16x32_bf16(ah, bl1, acc1, 0, 0, 0);
            acc0 = __builtin_amdgcn_mfma_f32_16x16x32_bf16(al, bh0, acc0, 0, 0, 0); acc1 = __builtin_amdgcn_mfma_f32_16x16x32_bf16(al, bh1, acc1, 0, 0, 0);
        }
        int my_e = 0; float my_g = 0.f;
#pragma unroll
        for (int j = 0; j < 4; ++j) {
            const float rs = __builtin_amdgcn_rsqf(ss2[t0 + 4 * g4 + j] * (1.0f / D) + EPS);
            float a0 = acc0[j] * rs + br0, a1 = acc1[j] * rs + br1; float tv[4]; int te_[4];
#pragma unroll
            for (int k = 0; k < 4; ++k) { float m = fmaxf(a0, a1);
#pragma unroll
                for (int o = 1; o < 16; o <<= 1) m = fmaxf(m, __shfl_xor(m, o));
                int e = (a0 == m) ? r16 : ((a1 == m) ? 16 + r16 : 99);
#pragma unroll
                for (int o = 1; o < 16; o <<= 1) e = min(e, __shfl_xor(e, o));
                tv[k] = m; te_[k] = e; if (e == r16) a0 = -INFINITY; if (e == 16 + r16) a1 = -INFINITY; }
            const float d1 = fast_exp2((tv[1] - tv[0]) * LOG2E), d2 = fast_exp2((tv[2] - tv[0]) * LOG2E), d3 = fast_exp2((tv[3] - tv[0]) * LOG2E);
            const float inv = 1.0f / (1.0f + d1 + d2 + d3);
            if ((r16 >> 2) == j) { const int k = lane & 3; my_e = k == 0 ? te_[0] : (k == 1 ? te_[1] : (k == 2 ? te_[2] : te_[3])); my_g = (k == 0 ? 1.0f : (k == 1 ? d1 : (k == 2 ? d2 : d3))) * inv; }
        }
        const int rl = __hip_atomic_fetch_add(hist + my_e, 1, __ATOMIC_RELAXED, __HIP_MEMORY_SCOPE_WORKGROUP);
        LDS_WAIT(); __builtin_amdgcn_s_barrier(); asm volatile("" ::: "memory");
        if (F.tid < 32) basel[F.tid] = (int)__hip_atomic_fetch_add(cntw + F.tid, (unsigned)hist[F.tid], RLX_AGENT);
        LDS_WAIT(); VM_WAIT(); __builtin_amdgcn_s_barrier(); asm volatile("" ::: "memory");
        { const int t = t0 + 4 * g4 + (r16 >> 2), k = lane & 3; const int rank = basel[my_e] + rl;
          toke[t * 4 + k] = my_e; tokr[t * 4 + k] = rank; tokg[t * 4 + k] = my_g; list[(size_t)my_e * T + rank] = t; glist[(size_t)my_e * T + rank] = my_g; sslist[(size_t)my_e * T + rank] = ss2[t]; }
        LDS_WAIT(); __builtin_amdgcn_s_barrier(); asm volatile("" ::: "memory");
    }
}

__device__ __forceinline__ int build_tables(Frame& F) {
    LAS int* ts = (LAS int*)(F.lds + TL_TS); LAS unsigned char* te = (LAS unsigned char*)(F.lds + TL_TE);
    if (F.tid < NEXP) ((LAS int*)(F.lds + TL_CNT))[F.tid] = (int)__hip_atomic_load(F.ctl + CW_CNT + F.tid, RLX_AGENT);
    LDS_WAIT(); __builtin_amdgcn_s_barrier(); asm volatile("" ::: "memory");
    if (F.tid == 0) { int run = 0;
        for (int e = 0; e < NEXP; ++e) { ts[e] = run; run += (((LAS int*)(F.lds + TL_CNT))[e] + 255) >> 8; }
        ts[NEXP] = run; }
    LDS_WAIT(); __builtin_amdgcn_s_barrier(); asm volatile("" ::: "memory");
    const int nt = ts[NEXP];
    for (int g = F.tid; g < nt; g += 512) { int e = 0;
        for (int j = 1; j < NEXP; ++j) e += (ts[j] <= g) ? 1 : 0;
        te[g] = (unsigned char)e; }
    LDS_WAIT(); __builtin_amdgcn_s_barrier(); asm volatile("" ::: "memory");
    return __builtin_amdgcn_readfirstlane(nt);
}

__device__ __forceinline__ void p10_combine(Frame& F, const Args& a) {
    unsigned char* ws = a.ws;
    LAS int* ts = (LAS int*)(F.lds + TL_TS);
    const bf16_t* h2h = (const bf16_t*)(ws + WS_H2F); const unsigned char* Y = (const unsigned char*)(ws + WS_Y);
    const int* toke = (const int*)(ws + WS_TOKE); const int* tokr = (const int*)(ws + WS_TOKR);
    const float* gf = a.in[19];
    const int gw = F.vcu * NWAVES + F.wave, NGW = F.G * NWAVES, lane = F.lane;
    for (int t0 = 2 * gw; t0 < T; t0 += 2 * NGW) {
        float o[2][16]; u32x2 y[2][4][2];
#pragma unroll
        for (int q = 0; q < 2; ++q) { const int t = t0 + q;
#pragma unroll
            for (int k = 0; k < 4; ++k) { const int e = toke[t * 4 + k], r = tokr[t * 4 + k]; const unsigned char* yr = Y + ((size_t)ts[e] * 256 + r) * D;
                y[q][k][0] = *(const u32x2*)(yr + 8 * lane); y[q][k][1] = *(const u32x2*)(yr + 512 + 8 * lane); }
            const u32x4 a0 = *(const u32x4*)(h2h + (size_t)t * D + 8 * lane), a2 = *(const u32x4*)(h2h + (size_t)t * D + 512 + 8 * lane);
            o[q][0] = bflo(a0.x); o[q][1] = bfhi(a0.x); o[q][2] = bflo(a0.y); o[q][3] = bfhi(a0.y); o[q][4] = bflo(a0.z); o[q][5] = bfhi(a0.z); o[q][6] = bflo(a0.w); o[q][7] = bfhi(a0.w);
            o[q][8] = bflo(a2.x); o[q][9] = bfhi(a2.x); o[q][10] = bflo(a2.y); o[q][11] = bfhi(a2.y); o[q][12] = bflo(a2.z); o[q][13] = bfhi(a2.z); o[q][14] = bflo(a2.w); o[q][15] = bfhi(a2.w); }
#pragma unroll
        for (int q = 0; q < 2; ++q) {
#pragma unroll
            for (int k = 0; k < 4; ++k)
#pragma unroll
                for (int hf = 0; hf < 2; ++hf) { const u32x2 w = y[q][k][hf];
                    const f32x2 c0 = __builtin_amdgcn_cvt_pk_f32_fp8((int)w.x, false), c1 = __builtin_amdgcn_cvt_pk_f32_fp8((int)w.x, true), c2 = __builtin_amdgcn_cvt_pk_f32_fp8((int)w.y, false), c3 = __builtin_amdgcn_cvt_pk_f32_fp8((int)w.y, true);
                    o[q][8 * hf + 0] += pg8::YSCALE_INV * c0.x; o[q][8 * hf + 1] += pg8::YSCALE_INV * c0.y; o[q][8 * hf + 2] += pg8::YSCALE_INV * c1.x; o[q][8 * hf + 3] += pg8::YSCALE_INV * c1.y;
                    o[q][8 * hf + 4] += pg8::YSCALE_INV * c2.x; o[q][8 * hf + 5] += pg8::YSCALE_INV * c2.y; o[q][8 * hf + 6] += pg8::YSCALE_INV * c3.x; o[q][8 * hf + 7] += pg8::YSCALE_INV * c3.y; }
            float s = 0.f;
#pragma unroll
            for (int j = 0; j < 16; ++j) s += o[q][j] * o[q][j];
            const float rstd = 1.0f / sqrtf(wave_sum(s) * (1.0f / D) + EPS);
            float* op = a.out + (size_t)(t0 + q) * D;
#pragma unroll
            for (int v = 0; v < 4; ++v) { const int col = (v >> 1) * 512 + 8 * lane + (v & 1) * 4; const f32x4 g4 = *(const f32x4*)(gf + col);
                *(f32x4*)(op + col) = (f32x4){o[q][4 * v] * rstd * g4.x, o[q][4 * v + 1] * rstd * g4.y, o[q][4 * v + 2] * rstd * g4.z, o[q][4 * v + 3] * rstd * g4.w}; }
        }
    }
}

#define XB_TMO      128
#define XB_XCNT(j)  (256  + 64 * (j))
#define XB_XSUB(j)  (1280 + 64 * (j))
#define XB_XGEN(j)  (2304 + 64 * (j))
#define XB_TOP      3328
#define XB_TOPGEN   3392
#define XCD_BAR_WORDS 3456
#define XB_SPIN_CAP (1u << 22)
__device__ __forceinline__ unsigned xb_ld(unsigned* p)              { return __hip_atomic_load(p, __ATOMIC_RELAXED, __HIP_MEMORY_SCOPE_AGENT); }
__device__ __forceinline__ unsigned xb_add(unsigned* p, unsigned v) { return __hip_atomic_fetch_add(p, v, __ATOMIC_RELAXED, __HIP_MEMORY_SCOPE_AGENT); }
#define XB_SPIN(cond, bar) do { unsigned _sp = 0; while (cond) { __builtin_amdgcn_s_sleep(1); \
    if ((++_sp & 255u) == 0u) { if (xb_ld(&(bar)[XB_TMO])) break; if (_sp > XB_SPIN_CAP) { atomicAdd(&(bar)[XB_TMO], 1u); break; } } } } while (0)
struct XcdBarrier { unsigned* bar; unsigned x; volatile LAS unsigned* st; };
__device__ __forceinline__ XcdBarrier xcd_barrier_post(unsigned* bar, volatile LAS unsigned* st) {
    XcdBarrier b; b.bar = bar; b.x = (unsigned)__builtin_amdgcn_s_getreg((3 << 11) | 20) & 0xFu; b.st = st;
    if (threadIdx.x == 0) (void)xb_add(&bar[XB_XCNT(b.x)], 1u);
    return b;
}
__device__ __forceinline__ void xcd_barrier_complete(unsigned* bar, unsigned x, unsigned& nloc, unsigned& nx) {
    const unsigned G = gridDim.x * gridDim.y * gridDim.z;
    unsigned sum, cnt, mine, sp = 0u;
    for (;;) {
        sum = 0u; cnt = 0u; mine = 0u;
#pragma unroll
        for (unsigned j = 0; j < 16; ++j) { const unsigned c = xb_ld(&bar[XB_XCNT(j)]); sum += c; cnt += (c > 0u) ? 1u : 0u; mine = (j == x) ? c : mine; }
        if (sum == G) break;
        __builtin_amdgcn_s_sleep(1);
        if ((++sp & 255u) == 0u) { if (xb_ld(&bar[XB_TMO])) break; if (sp > XB_SPIN_CAP) { atomicAdd(&bar[XB_TMO], 1u); break; } }
    }
    nloc = mine > 0u ? mine : 1u; nx = cnt > 0u ? cnt : 1u;
}
__device__ __forceinline__ void xcd_barrier(const XcdBarrier& b) {
    asm volatile("s_waitcnt vmcnt(0)" ::: "memory");
    __syncthreads();
    if (threadIdx.x == 0) {
        unsigned* bar = b.bar;
        __builtin_amdgcn_s_waitcnt(0);
        unsigned nloc = b.st[0], nx = b.st[1];
        if (nloc == 0u) { xcd_barrier_complete(bar, b.x, nloc, nx); b.st[0] = nloc; b.st[1] = nx; }
        const unsigned old = xb_add(&bar[XB_XSUB(b.x)], 1u);
        const unsigned gen = old / nloc;
        if (old + 1u == (gen + 1u) * nloc) {
            __builtin_amdgcn_fence(__ATOMIC_RELEASE, "agent");
            asm volatile("s_waitcnt vmcnt(0)" ::: "memory");
            const unsigned og = xb_add(&bar[XB_TOP], 1u);
            const unsigned tg = og / nx;
            if (og + 1u == (tg + 1u) * nx) xb_add(&bar[XB_TOPGEN], 1u);
            else XB_SPIN(xb_ld(&bar[XB_TOPGEN]) == tg, bar);
            __builtin_amdgcn_fence(__ATOMIC_ACQUIRE, "agent");
            xb_add(&bar[XB_XGEN(b.x)], 1u);
            asm volatile("s_waitcnt vmcnt(0)" ::: "memory");
        } else {
            XB_SPIN(xb_ld(&bar[XB_XGEN(b.x)]) == gen, bar);
            __builtin_amdgcn_fence(__ATOMIC_ACQUIRE, "agent");
            asm volatile("s_waitcnt vmcnt(0)" ::: "memory");
        }
    }
    __syncthreads();
}
#ifndef MK_CG_ONLY
#define MK_CG_ONLY 0
#endif
__device__ __forceinline__ void grid_barrier(Frame& F, const XcdBarrier& xb_) { if (MK_CG_ONLY) cg::this_grid().sync(); else xcd_barrier(xb_); }
#ifndef MK_PHASE_MASK
#define MK_PHASE_MASK 0x7ff
#endif
#ifndef MK_REP_PHASE
#define MK_REP_PHASE -1
#endif
#ifndef MK_REP_N
#define MK_REP_N 0
#endif
__device__ __forceinline__ void ph0(Frame& F, const Args& args, int rep) { p0_prologue(F, args); }
__device__ __forceinline__ void ph1(Frame& F, const Args& args, int rep) {
    unsigned char* ws = args.ws; const int cid = (int)blockIdx.x;
    { pg8::DenseOrder S{(const char*)(ws + WS_XN8), (const char*)(ws + WS_WIN8), D / 2, D / 2, T / 256, 6, F.G, cid, 0};
      pg8::EpiProj E{(bf16_t*)(ws + WS_PROJ), rep ? (float*)(ws + WS_DUMMY) : (float*)(ws + WS_KBAR), WSCALE8_INV};
      pg8::gemm_phase<pg8::EpiProj, pg8::DenseOrder, false, true, true>(F.lds, D / 2, D / 2, D / 128, S, E); }
    { pg8::DenseOrder S{(const char*)(ws + WS_XN), (const char*)(ws + WS_WIN + (size_t)1536 * D * 2), D, D, T / 256, 8, F.G, cid, 6};
      pg8::EpiProj E{(bf16_t*)(ws + WS_PROJ), rep ? (float*)(ws + WS_DUMMY) : (float*)(ws + WS_KBAR), 1.0f};
      pg8::gemm_phase<pg8::EpiProj, pg8::DenseOrder, false, true>(F.lds, D, D, D / 64, S, E); }
}
__device__ __forceinline__ void ph2(Frame& F, const Args& args, int rep) { p2_mixer(F, args, rep); }
constexpr size_t WS_MB = WS_PROJ, WS_NB = WS_PROJ + 16 * MiB, WS_H1Q = WS_PROJ + 32 * MiB, WS_PB = WS_QX;
constexpr size_t WS_UNUSED_XA = 0;
constexpr int LDS_XTAB = 131072;
__device__ __forceinline__ void ph3(Frame& F, const Args& args, int rep) {
    unsigned char* ws = args.ws; const int cid = (int)blockIdx.x;
    pg8::P3Order S{pg8::XmnOrder{(const char*)(ws + WS_MEMK), (const char*)(ws + WS_MEMVT), (const char*)(ws + WS_WQ), (const char*)(ws + WS_WO), F.G, cid},
                   pg8::DenseOrder{(const char*)(ws + WS_MIX), (const char*)(ws + WS_WOUT), D, D, T / 256, D / 256, F.G, cid, 0}};
    pg8::EpiP3 E{pg8::EpiFp8{(unsigned char*)(ws + WS_MB), D, (unsigned char*)(ws + WS_NB), D, XSCALE8},
                 pg8::EpiRes<false, 0, false, true>{(const void*)(ws + WS_XN), (bf16_t*)(ws + WS_H1B), nullptr, rep ? (float*)(ws + WS_DUMMY + 512 * 1024) : (float*)(ws + WS_SS1), 1.0f, (unsigned char*)(ws + WS_H1Q), (const float*)(ws + WS_RS0)}};
    pg8::gemm_phase<pg8::EpiP3, pg8::P3Order, false, true>(F.lds, D, D, D / 64, S, E);
}
__device__ __forceinline__ void ph4(Frame& F, const Args& args, int rep) {
    unsigned char* ws = args.ws; const int cid = (int)blockIdx.x;
    pg8::XbOrder S{(const char*)(ws + WS_H1Q), (const char*)(ws + WS_MB), F.G, cid, (size_t)D};
    pg8::EpiSoftmaxS E{(unsigned char*)(ws + WS_PB), (const float*)(ws + WS_SS1), F.lds + LDS_XTAB, XSCALE8_INV};
    pg8::gemm_phase<pg8::EpiSoftmaxS, pg8::XbOrder, false, true, true>(F.lds, D / 2, D / 2, D / 128, S, E);
}
__device__ __forceinline__ void ph5(Frame& F, const Args& args, int rep) {}
__device__ __forceinline__ void ph6(Frame& F, const Args& args, int rep) {
    unsigned char* ws = args.ws; const int cid = (int)blockIdx.x;
    pg8::XbOrder S{(const char*)(ws + WS_PB), (const char*)(ws + WS_NB), F.G, cid, (size_t)D};
    pg8::EpiRes<false, 2, true> E{(const void*)(ws + WS_H1B), (bf16_t*)(ws + WS_H2B), (float*)(ws + WS_H2F), rep ? (float*)(ws + WS_DUMMY + 512 * 1024) : (float*)(ws + WS_SS2), PSCALE8_INV * XSCALE8_INV, nullptr};
    pg8::gemm_phase<pg8::EpiRes<false, 2, true>, pg8::XbOrder, false, true, true>(F.lds, D / 2, D / 2, D / 128, S, E);
}
__device__ __forceinline__ void ph7(Frame& F, const Args& args, int rep) { p7_router(F, args, rep); }
__device__ __forceinline__ void ph8(Frame& F, const Args& args, int rep) {
    unsigned char* ws = args.ws; const int cid = (int)blockIdx.x;
    const int ntl = build_tables(F);
    pg8::MoeOrder S{(const char*)(ws + WS_H2B), (const char*)(ws + WS_W1), (const int*)(ws + WS_LIST), (const LAS int*)(F.lds + TL_CNT), (const LAS unsigned char*)(F.lds + TL_TE), (const LAS int*)(F.lds + TL_TS),
                    ntl, 8, F.G, cid, (size_t)2048 * D, 1, (size_t)256 * D, (size_t)256 * D};
    pg8::EpiW1 E{(bf16_t*)(ws + WS_HMID), (const float*)(ws + WS_SSLIST), args.in[16], (const int*)(ws + WS_LIST)};
    pg8::gemm_phase<pg8::EpiW1, pg8::MoeOrder, true, true, true>(F.lds, D / 2, D / 2, D / 128, S, E);
}
__device__ __forceinline__ void ph9(Frame& F, const Args& args, int rep) {
    unsigned char* ws = args.ws; const int cid = (int)blockIdx.x;
    const int ntl = build_tables(F);
    pg8::MoeOrder S{(const char*)(ws + WS_HMID), (const char*)(ws + WS_W2), (const int*)(ws + WS_LIST), (const LAS int*)(F.lds + TL_CNT), (const LAS unsigned char*)(F.lds + TL_TE), (const LAS int*)(F.lds + TL_TS),
                    ntl, 4, F.G, cid, (size_t)D * D, 0, (size_t)256 * D, (size_t)256 * D};
    pg8::EpiW2 E{(unsigned char*)(ws + WS_Y), args.in[18], (const int*)(ws + WS_LIST), (const float*)(ws + WS_GLIST)};
    pg8::gemm_phase<pg8::EpiW2, pg8::MoeOrder, false, true, true>(F.lds, D / 2, D / 2, D / 128, S, E);
}
__device__ __forceinline__ void ph10(Frame& F, const Args& args, int rep) { (void)build_tables(F); p10_combine(F, args); }

constexpr int N_PHASES = 11;
__global__ void __launch_bounds__(NWAVES * 64, 2) hymba_fwd(Args args) {
    extern __shared__ __attribute__((aligned(16))) unsigned char lds_raw[];
    Frame F;
    F.lds = (LAS unsigned char*)lds_raw;
    F.MISC = (volatile LAS unsigned*)(F.lds + TL_MISC);
    F.tid = threadIdx.x; F.lane = F.tid & 63; F.wave = __builtin_amdgcn_readfirstlane(F.tid >> 6);
    F.G = gridDim.x; { const int bx = blockIdx.x; F.vcu = (F.G % 8 == 0) ? (bx % 8) * (F.G / 8) + bx / 8 : bx; }
    F.ctl = (unsigned*)(args.ws + WS_CTL);
    const int lo = args.ph_lo, hi = args.ph_hi;
    for (int u = F.tid; u < 64; u += NWAVES * 64) ((LAS unsigned*)(F.lds + TL_MISC))[u] = 0u;
    __syncthreads();
    const XcdBarrier xbar = xcd_barrier_post(F.ctl + CW_BAR, F.MISC + 8);
#define RUN(k, fn) do { if (((MK_PHASE_MASK >> (k)) & 1) && lo <= (k) && (k) < hi) { fn(F, args, 0); \
        if (MK_REP_PHASE == (k) && MK_REP_N >= 1) { grid_barrier(F, xbar); fn(F, args, 1); } \
        if (MK_REP_PHASE == (k) && MK_REP_N >= 2) { grid_barrier(F, xbar); fn(F, args, 2); } \
        if ((k) + 1 < hi) { grid_barrier(F, xbar); } } } while (0)
    if (args.ph_lo < 0) cg::this_grid().sync();
    RUN(0, ph0); RUN(1, ph1); RUN(2, ph2); RUN(3, ph3); RUN(4, ph4);   RUN(6, ph6); RUN(7, ph7); RUN(8, ph8); RUN(9, ph9); RUN(10, ph10);
#undef RUN
}

extern "C" void kernel_launch(void* const* d_in, const int* in_sizes, int n_in, void* d_out, int out_size, void* d_ws, size_t ws_size, hipStream_t stream) {
    static int grid = 0;
    if (grid == 0) {
        if (n_in != 20 || in_sizes[0] != T * D || out_size != T * D || ws_size < WS_END) {
            fprintf(stderr, "kernel_launch: shape/workspace mismatch (n_in %d, in0 %d, out %d, ws %zu, need %zu)\n", n_in, n_in > 0 ? in_sizes[0] : -1, out_size, ws_size, (size_t)WS_END); grid = -1; return; }
        int dev = 0, cus = 0, per_cu = 0;
        if (hipGetDevice(&dev) != hipSuccess || hipDeviceGetAttribute(&cus, hipDeviceAttributeMultiprocessorCount, dev) != hipSuccess) { grid = -1; return; }
        if (hipFuncSetAttribute((const void*)hymba_fwd, hipFuncAttributeMaxDynamicSharedMemorySize, LDS_BYTES) != hipSuccess) { fprintf(stderr, "kernel_launch: hipFuncSetAttribute failed\n"); grid = -1; return; }
        if (hipOccupancyMaxActiveBlocksPerMultiprocessor(&per_cu, (const void*)hymba_fwd, NWAVES * 64, LDS_BYTES) != hipSuccess || per_cu < 1) { fprintf(stderr, "kernel_launch: occupancy query says %d\n", per_cu); }
        (void)hipGetLastError();
        grid = cus;
        if (grid != 256) fprintf(stderr, "kernel_launch: %d CUs; this kernel is built for 256\n", grid);
    }
    if (grid < 0) return;
    (void)hipMemsetAsync((char*)d_ws + WS_CTL, 0, CTL_ZERO_BYTES, stream);
    Args a{};
    for (int i = 0; i < 20; ++i) a.in[i] = (const float*)d_in[i];
    a.out = (float*)d_out; a.ws = (unsigned char*)d_ws;
#if MK_N_LAUNCHES == 1
    a.ph_lo = 0; a.ph_hi = MK_LAST_PHASE + 1;
    void* kargs[] = {&a};
    hipError_t e = hipLaunchCooperativeKernel((const void*)hymba_fwd, dim3(grid), dim3(NWAVES * 64), kargs, LDS_BYTES, stream);
    if (e != hipSuccess) fprintf(stderr, "kernel_launch: cooperative launch failed: %s\n", hipGetErrorString(e));
#else
    for (int p = 0; p <= MK_LAST_PHASE; ++p) { a.ph_lo = p; a.ph_hi = p + 1; hipLaunchKernelGGL(hymba_fwd, dim3(grid), dim3(NWAVES * 64), LDS_BYTES, stream, a); }
#endif
}
```

```cpp
#include <hip/hip_runtime.h>
#include <hip/hip_cooperative_groups.h>
#include <cstdio>
#include <cstdint>
namespace cg = cooperative_groups;

#ifndef MK_N_LAUNCHES
#define MK_N_LAUNCHES 1
#endif
#ifndef MK_LAST_PHASE
#define MK_LAST_PHASE 10
#endif

#define LAS __attribute__((address_space(3)))
#define GAS __attribute__((address_space(1)))
typedef unsigned short bf16_t;
typedef short bf16x8 __attribute__((ext_vector_type(8)));
typedef short s16x4 __attribute__((ext_vector_type(4)));
typedef float f32x4 __attribute__((ext_vector_type(4)));
typedef float f32x2 __attribute__((ext_vector_type(2)));
typedef float f32x16 __attribute__((ext_vector_type(16)));
typedef unsigned u32x4 __attribute__((ext_vector_type(4)));
typedef unsigned u32x2 __attribute__((ext_vector_type(2)));
typedef int v8i32_t __attribute__((ext_vector_type(8)));

constexpr int BATCH = 8, SEQ = 4096, T = BATCH * SEQ, D = 1024, INC = 3584, NMEM = 256, MROWS = BATCH * NMEM;
constexpr int NEXP = 32, TOPK = 4, MT_MAX = T * TOPK / 256 + NEXP, MPAD = MT_MAX * 256;
constexpr float EPS = 1e-6f;
constexpr float LOG2E = 1.4426950408889634f;
constexpr float C2Q = 0.125f * LOG2E;
constexpr float C2X = 0.0625f * LOG2E;
constexpr int C_MQ = 0, C_MK = 512, C_MV = 1024, C_GQ = 1536, C_GF = 2048, C_GI = 2560, C_GG = 3072;

constexpr size_t MiB = 1u << 20;
constexpr size_t WS_CTL = 0, CTL_ZERO_BYTES = 2 * MiB;
constexpr size_t WS_KBAR = 1 * MiB;
constexpr size_t WS_SS1 = 1 * MiB + 256 * 1024;
constexpr size_t WS_SS2 = 1 * MiB + 384 * 1024;
constexpr size_t WS_RS0 = 1 * MiB + 512 * 1024;
constexpr size_t WS_TOKE = 2 * MiB, WS_TOKR = 2 * MiB + 512 * 1024, WS_TOKG = 3 * MiB;
constexpr size_t WS_WRT = 3 * MiB + 512 * 1024;
constexpr size_t WS_LIST = 4 * MiB;
constexpr size_t WS_GLIST = 8 * MiB;
constexpr size_t WS_SSLIST = 12 * MiB;
constexpr size_t WS_WIN8 = 14 * MiB;
constexpr size_t WS_WIN = 16 * MiB, WS_WOUT = 23 * MiB, WS_WQ = 25 * MiB, WS_WKV = 27 * MiB, WS_WO = 31 * MiB;
constexpr size_t WS_MN = 33 * MiB, WS_MEMK = 37 * MiB, WS_MEMVT = 41 * MiB;
constexpr size_t WS_W1 = 48 * MiB, WS_W2 = 176 * MiB;
constexpr size_t WS_PROJ = 240 * MiB;
constexpr size_t SEC_ELEMS = (size_t)16 * 1024 * 1024;
constexpr size_t WS_XN = 464 * MiB;
constexpr size_t WS_OX = 464 * MiB;
constexpr size_t WS_XN8 = 528 * MiB;
constexpr size_t WS_MIX = 528 * MiB;
constexpr size_t WS_H1B = 592 * MiB;
constexpr size_t WS_QX = 656 * MiB;
constexpr size_t WS_PWS = 720 * MiB;
constexpr size_t WS_HMID = 240 * MiB;
constexpr size_t WS_Y = 512 * MiB;
constexpr size_t WS_H2F = 784 * MiB;
constexpr size_t WS_H2B = 912 * MiB;
constexpr size_t WS_DUMMY = 976 * MiB;
constexpr size_t WS_END = 992 * MiB;
static_assert(WS_HMID + (size_t)MPAD * D * 2 <= WS_Y && WS_Y + (size_t)MPAD * D * 2 <= WS_H2F, "ws map");
constexpr int CW_TMO = 0;
constexpr int CW_CNT = 64;
constexpr int CW_QUEUE = 128;
constexpr int CW_BAR = 4096;

__device__ __forceinline__ unsigned f2bf(float f) { unsigned u = __builtin_bit_cast(unsigned, f); return (u + 0x7fffu + ((u >> 16) & 1u)) >> 16; }
__device__ __forceinline__ unsigned pk2(float lo, float hi) { return f2bf(lo) | (f2bf(hi) << 16); }
__device__ __forceinline__ float bf2f(unsigned short h) { return __builtin_bit_cast(float, (unsigned)h << 16); }
__device__ __forceinline__ float bflo(unsigned w) { return __builtin_bit_cast(float, w << 16); }
__device__ __forceinline__ float bfhi(unsigned w) { return __builtin_bit_cast(float, w & 0xffff0000u); }
typedef float f32x2_t __attribute__((ext_vector_type(2))); typedef __bf16 bf16x2_t __attribute__((ext_vector_type(2)));
__device__ __forceinline__ unsigned cvtpk(float lo, float hi) { f32x2_t v = {lo, hi}; bf16x2_t b = __builtin_convertvector(v, bf16x2_t); return __builtin_bit_cast(unsigned, b); }
__device__ __forceinline__ float wave_sum(float v) {
#pragma unroll
    for (int o = 1; o < 64; o <<= 1) v += __shfl_xor(v, o);
    return v;
}
__device__ __forceinline__ float fast_exp2(float x) { return __builtin_amdgcn_exp2f(x); }
__device__ __forceinline__ float fast_rcp(float x) { return __builtin_amdgcn_rcpf(x); }
__device__ __forceinline__ float silu_f(float x) { return x * fast_rcp(1.0f + fast_exp2(-x * LOG2E)); }
__device__ __forceinline__ unsigned pk4_fp8(float a, float b, float c, float d) { int w = 0; w = __builtin_amdgcn_cvt_pk_fp8_f32(a, b, w, false); w = __builtin_amdgcn_cvt_pk_fp8_f32(c, d, w, true); return (unsigned)w; }
constexpr float XSCALE8 = 4.0f, XSCALE8_INV = 0.25f, PSCALE8 = 256.0f, PSCALE8_INV = 1.0f / 256.0f;
constexpr float WSCALE8 = 32.0f, WSCALE8_INV = 1.0f / 32.0f;
#define LDS_WAIT() asm volatile("s_waitcnt lgkmcnt(0)" ::: "memory")
#define VM_WAIT() asm volatile("s_waitcnt vmcnt(0)" ::: "memory")
#define RLX_AGENT __ATOMIC_RELAXED, __HIP_MEMORY_SCOPE_AGENT

namespace pg8 {
constexpr int BM = 256, BK = 64, HALF = 128, HTB = HALF * BK * 2, STAGE_BYTES = 8 * HTB;
__device__ __forceinline__ unsigned gload32_hidden(const void* sbase, unsigned voff) { unsigned v; asm volatile("global_load_dword %0, %1, %2" : "=v"(v) : "v"(voff), "s"(sbase) : "memory"); return v; }
__device__ __forceinline__ f32x4 gload128_hidden(const void* sbase, unsigned voff) { f32x4 v; asm volatile("global_load_dwordx4 %0, %1, %2" : "=v"(v) : "v"(voff), "s"(sbase) : "memory"); return v; }
__device__ __forceinline__ f32x4 gload128_hidden_nt(const void* sbase, unsigned voff) { f32x4 v; asm volatile("global_load_dwordx4 %0, %1, %2 nt" : "=v"(v) : "v"(voff), "s"(sbase) : "memory"); return v; }
__device__ __forceinline__ void glds16s(const char* sbase, unsigned voff, unsigned lds_dst) { unsigned keep;
    asm volatile("s_mov_b32 %0, m0\n\ts_mov_b32 m0, %3\n\ts_nop 0\n\tglobal_load_lds_dwordx4 %1, %2\n\ts_mov_b32 m0, %0" : "=&s"(keep) : "v"(voff), "s"(sbase), "s"(lds_dst) : "memory"); }
__host__ __device__ __forceinline__ int lds_byte(int r, int c) { const int st = (r >> 4) * 2 + (c >> 5), rr = r & 15, cc = c & 31, ob = rr * 64 + cc * 2; return st * 1024 + (ob ^ (((ob >> 9) & 1) << 5)); }
__host__ __device__ __forceinline__ void stage_rc(int b, int& R, int& C) { const int st = b / 1024, sb = b % 1024, swz = sb ^ (((sb >> 9) & 1) << 5); R = (st >> 1) * 16 + swz / 64; C = (st & 1) * 32 + (swz % 64) / 2; }
__host__ __device__ __forceinline__ int perm32(int rho) { const int n = rho >> 4, i = rho & 15; return 8 * (i >> 2) + 4 * n + (i & 3); }

struct Unit { const char* A; const char* B; const int* rows; int pm, pn, aux, nrows, ntu; };

template <class Epi, class Sched, bool GATHER, bool ALIGN_EPI, bool FP8 = false>
__device__ __forceinline__ void gemm_phase(LAS unsigned char* lds, const int lda, const int ldb, const int nt_in, const Sched& S, const Epi& E) {
    int nt = nt_in; asm volatile("" : "+s"(nt));
    int tid_ = threadIdx.x; asm volatile("" : "+v"(tid_));
    const int tid = tid_, wid = __builtin_amdgcn_readfirstlane(tid >> 6), lane = tid & 63, wr = wid >> 2, wc = wid & 3, fr = lane & 15, fq = lane >> 4;
    unsigned offB0; { int R, C; stage_rc(tid * 16, R, C); const int Rb = Epi::PERM ? ((R & ~31) + perm32(R & 31)) : R; offB0 = (unsigned)(Rb * ldb + C) * 2u; }
    const size_t pstepB = (size_t)64 * ldb * 2;
    const size_t kstep = (size_t)(BK * 2);
    const size_t hstepB = (size_t)HALF * ldb * 2;
    const unsigned ldsb = (unsigned)__builtin_amdgcn_readfirstlane((int)((unsigned)(uintptr_t)(unsigned char*)lds + (unsigned)wid * 1024u));
    const int aoff = lds_byte(wr * 64 + fr, FP8 ? fq * 16 : fq * 8), boff = lds_byte(wc * 32 + fr, FP8 ? fq * 16 : fq * 8);
#define PG8_SA(b, h) (((b) * 2 + (h)) * HTB)
#define PG8_SB(b, h) ((4 + (b) * 2 + (h)) * HTB)
#define PG8_STGB(bufoff, gbase) do { glds16s((const char*)(gbase), offB0, ldsb + (unsigned)(bufoff)); glds16s((const char*)(gbase) + pstepB, offB0, ldsb + (unsigned)(bufoff) + 8192u); } while (0)
#define PG8_LD16(p_) (*(const LAS u32x4*)(p_))
#define PG8_CAT(x, y) __builtin_bit_cast(v8i32_t, __builtin_shufflevector(x, y, 0, 1, 2, 3, 4, 5, 6, 7))
    unsigned aA0 = (unsigned)(aoff + PG8_SA(0, 0)), aA1 = (unsigned)(aoff + PG8_SA(1, 0)), bB0 = (unsigned)(boff + PG8_SB(0, 0)), bB1 = (unsigned)(boff + PG8_SB(1, 0));
    asm volatile("" : "+v"(aA0), "+v"(aA1), "+v"(bB0), "+v"(bB1));
    int scl8 = 0x7f7f7f7f; asm volatile("" : "+v"(scl8));
#define PG8_LDA(dst, b, h) do { const LAS unsigned char* ap_ = lds + ((b) ? aA1 : aA0) + (h) * HTB; _Pragma("unroll") for (int m = 0; m < 4; ++m) { \
        if constexpr (FP8) { dst##8[m] = PG8_CAT(PG8_LD16(ap_ + m * 2048), PG8_LD16(ap_ + m * 2048 + 16)); } \
        else { _Pragma("unroll") for (int k = 0; k < 2; ++k) dst[m][k] = *(const LAS bf16x8*)(ap_ + m * 2048 + k * 1024); } } } while (0)
#define PG8_LDB(dst, b, h) do { const LAS unsigned char* bp_ = lds + ((b) ? bB1 : bB0) + (h) * HTB; _Pragma("unroll") for (int n = 0; n < 2; ++n) { \
        if constexpr (FP8) { dst##8[n] = PG8_CAT(PG8_LD16(bp_ + n * 2048), PG8_LD16(bp_ + n * 2048 + 16)); } \
        else { _Pragma("unroll") for (int k = 0; k < 2; ++k) dst[n][k] = *(const LAS bf16x8*)(bp_ + n * 2048 + k * 1024); } } } while (0)
#define PG8_MMA(ai, bj, At, Bt) do { __builtin_amdgcn_s_setprio(1); _Pragma("unroll") for (int m = 0; m < 4; ++m) _Pragma("unroll") for (int n = 0; n < 2; ++n) { \
        if constexpr (FP8) asm volatile("v_mfma_scale_f32_16x16x128_f8f6f4 %0, %1, %2, %0, %3, %3 op_sel_hi:[0,0,0]" : "+v"(acc[ai][bj][m][n]) : "v"(Bt##8[n]), "v"(At##8[m]), "v"(scl8));   \
        else { _Pragma("unroll") for (int k = 0; k < 2; ++k) acc[ai][bj][m][n] = __builtin_amdgcn_mfma_f32_16x16x32_bf16(Bt[n][k], At[m][k], acc[ai][bj][m][n], 0, 0, 0); } } \
        __builtin_amdgcn_s_setprio(0); } while (0)
#define PG8_WAIT_V(n) asm volatile("s_waitcnt vmcnt(" #n ")" ::: "memory")
#define PG8_WAIT_L(n) asm volatile("s_waitcnt lgkmcnt(" #n ")" ::: "memory")
#define PG8_BAR __builtin_amdgcn_s_barrier()
#define PG8_SCHED __builtin_amdgcn_sched_barrier(0)
    unsigned voffA0, c2, pkc[2], pkn[2], praw[4];
    { int R, C; stage_rc(tid * 16, R, C); voffA0 = (unsigned)(R * lda + C) * 2u; c2 = (unsigned)C * 2u; }
    const size_t hstepA = (size_t)HALF * lda * 2, pstepA = (size_t)64 * lda * 2;
    const unsigned lda2 = (unsigned)lda * 2u;
#define PG8_PKROWS(dst, u) do { if (GATHER) { _Pragma("unroll") for (int i_ = 0; i_ < 2; ++i_) { int R_, C_; stage_rc(tid * 16 + i_ * 8192, R_, C_); \
        const int nr_ = (u).nrows - 1; const int r0_ = R_ < nr_ ? R_ : nr_, r1_ = (R_ + HALF) < nr_ ? (R_ + HALF) : nr_; \
        dst[i_] = (unsigned)(u).rows[r0_] | ((unsigned)(u).rows[r1_] << 16); } } } while (0)
#define PG8_RAWROWS(u) do { if (GATHER) { _Pragma("unroll") for (int i_ = 0; i_ < 2; ++i_) { int R_, C_; stage_rc(tid * 16 + i_ * 8192, R_, C_); \
        const int nr_ = (u).nrows - 1; const int r0_ = R_ < nr_ ? R_ : nr_, r1_ = (R_ + HALF) < nr_ ? (R_ + HALF) : nr_; \
        praw[2 * i_] = gload32_hidden((u).rows, (unsigned)r0_ * 4u); praw[2 * i_ + 1] = gload32_hidden((u).rows, (unsigned)r1_ * 4u); } } } while (0)
#define PG8_PACKRAW(dst) do { unsigned a0_ = praw[0], a1_ = praw[1], a2_ = praw[2], a3_ = praw[3]; asm volatile("" : "+v"(a0_), "+v"(a1_), "+v"(a2_), "+v"(a3_)); \
        dst[0] = a0_ | (a1_ << 16); dst[1] = a2_ | (a3_ << 16); } while (0)
#define PG8_STGA(bufoff, gbase, h, NX) do { \
        if (GATHER) { const unsigned p0_ = (NX) ? pkn[0] : pkc[0], p1_ = (NX) ? pkn[1] : pkc[1]; \
            const unsigned o0_ = ((h) ? (p0_ >> 16) : (p0_ & 0xffffu)) * lda2 + c2, o1_ = ((h) ? (p1_ >> 16) : (p1_ & 0xffffu)) * lda2 + c2; \
            glds16s((const char*)(gbase), o0_, ldsb + (unsigned)(bufoff)); glds16s((const char*)(gbase), o1_, ldsb + (unsigned)(bufoff) + 8192u); } \
        else { const char* gb_ = (const char*)(gbase) + ((h) ? hstepA : (size_t)0); glds16s(gb_, voffA0, ldsb + (unsigned)(bufoff)); glds16s(gb_ + pstepA, voffA0, ldsb + (unsigned)(bufoff) + 8192u); } } while (0)
    Unit cur, nxt; int ui = 0;
    if (!S.next(0, cur)) return;
    f32x4 acc[2][2][4][2];
#pragma unroll
    for (int a = 0; a < 2; ++a)
#pragma unroll
        for (int b = 0; b < 2; ++b)
#pragma unroll
            for (int m = 0; m < 4; ++m)
#pragma unroll
                for (int n = 0; n < 2; ++n) acc[a][b][m][n] = (f32x4){0.f, 0.f, 0.f, 0.f};
    bf16x8 At[4][2], B0[2][2], B1[2][2]; v8i32_t At8[4], B08[2], B18[2];
    pkc[0] = pkc[1] = pkn[0] = pkn[1] = 0u; praw[0] = praw[1] = praw[2] = praw[3] = 0u;
    PG8_PKROWS(pkc, cur);
    const char* cA = cur.A; const char* cB = cur.B;
    PG8_STGB(PG8_SB(0, 0), cB); PG8_STGB(PG8_SB(0, 1), cB + hstepB); PG8_STGA(PG8_SA(0, 0), cA, 0, false); PG8_STGA(PG8_SA(0, 1), cA, 1, false);
    if (wr == 1) PG8_BAR;
    PG8_WAIT_V(2); PG8_BAR;
    PG8_STGB(PG8_SB(1, 0), cB + kstep); PG8_STGA(PG8_SA(1, 0), cA + kstep, 0, false); PG8_STGB(PG8_SB(1, 1), cB + hstepB + kstep);
    PG8_WAIT_V(6); PG8_BAR;
    for (;;) {
        const bool has_next = S.next(ui + 1, nxt);
        if (GATHER) { if (has_next) { PG8_RAWROWS(nxt); } }
        const char* nA = has_next ? nxt.A : cA; const char* nB = has_next ? nxt.B : cB;
        typename Epi::Pre pre; { int t_p = threadIdx.x; asm volatile("" : "+v"(t_p)); E.prefetch(cur, wr, wc, t_p & 15, (t_p >> 4) & 3, pre); }
        const int ntc = cur.ntu ? cur.ntu : nt;
        for (int t = 0; t < ntc; t += 2) {
            const bool last = (t == ntc - 2);
            if (GATHER) { pkn[0] = pkc[0]; pkn[1] = pkc[1]; if (last && has_next) { PG8_PACKRAW(pkn); } }
            const char* a1 = cA + (size_t)(t + 1) * kstep;
            const char* a2 = last ? nA : cA + (size_t)(t + 2) * kstep; const char* b2 = last ? nB : cB + (size_t)(t + 2) * kstep;
            const char* a3 = a2 + kstep; const char* b3 = b2 + kstep;
            PG8_LDB(B0, 0, 0); PG8_LDB(B1, 0, 1); PG8_SCHED; PG8_LDA(At, 0, 0); PG8_STGA(PG8_SA(1, 1), a1, 1, false);
            PG8_WAIT_V(8); PG8_WAIT_L(0); PG8_BAR; PG8_MMA(0, 0, At, B0); PG8_MMA(0, 1, At, B1); PG8_BAR; PG8_SCHED;
            PG8_LDA(At, 0, 1); PG8_STGB(PG8_SB(0, 0), b2); PG8_STGB(PG8_SB(0, 1), b2 + hstepB); PG8_STGA(PG8_SA(0, 0), a2, 0, last);
            PG8_WAIT_V(8); PG8_WAIT_L(0); PG8_BAR; PG8_MMA(1, 0, At, B0); PG8_MMA(1, 1, At, B1); PG8_BAR; PG8_SCHED;
            PG8_LDB(B0, 1, 0); PG8_LDB(B1, 1, 1); PG8_SCHED; PG8_LDA(At, 1, 0); PG8_STGA(PG8_SA(0, 1), a2, 1, last);
            PG8_WAIT_V(8); PG8_WAIT_L(0); PG8_BAR; PG8_MMA(0, 0, At, B0); PG8_MMA(0, 1, At, B1); PG8_BAR; PG8_SCHED;
            PG8_LDA(At, 1, 1); PG8_STGB(PG8_SB(1, 0), b3); PG8_STGB(PG8_SB(1, 1), b3 + hstepB); PG8_STGA(PG8_SA(1, 0), a3, 0, last);
            PG8_WAIT_V(8); PG8_WAIT_L(0); PG8_BAR; PG8_MMA(1, 0, At, B0); PG8_MMA(1, 1, At, B1); PG8_BAR; PG8_SCHED;
        }
        if constexpr (ALIGN_EPI) { if (wr == 0) PG8_BAR; }
        if constexpr (FP8) asm volatile("s_nop 15\n\ts_nop 15" ::: "memory");
        if constexpr (!Epi::AFTER_DRAIN) { int t_e = threadIdx.x; asm volatile("" : "+v"(t_e)); const int fr_e = t_e & 15, fq_e = (t_e >> 4) & 3; E(acc, cur, wr, wc, fr_e, fq_e, pre); }
        if (!has_next) break;
#pragma unroll
        for (int a = 0; a < 2; ++a)
#pragma unroll
            for (int b = 0; b < 2; ++b)
#pragma unroll
                for (int m = 0; m < 4; ++m)
#pragma unroll
                    for (int n = 0; n < 2; ++n) acc[a][b][m][n] = (f32x4){0.f, 0.f, 0.f, 0.f};
        cur = nxt; cA = nA; cB = nB; ++ui;
        if (GATHER) { PG8_PACKRAW(pkc); }
        if constexpr (ALIGN_EPI) { if (wr == 1) PG8_BAR; }
    }
    PG8_WAIT_V(0);
    if constexpr (!ALIGN_EPI) { if (wr == 0) PG8_BAR; }
    PG8_BAR;
    if constexpr (Epi::AFTER_DRAIN) { int t_e = threadIdx.x; asm volatile("" : "+v"(t_e)); const int fr_e = t_e & 15, fq_e = (t_e >> 4) & 3; E.fused(acc, cur, wr, wc, fr_e, fq_e, lds, wid, t_e & 63); }
#undef PG8_SA
#undef PG8_SB
#undef PG8_STGB
#undef PG8_LDA
#undef PG8_LDB
#undef PG8_MMA
#undef PG8_CAT
#undef PG8_LD16
#undef PG8_WAIT_V
#undef PG8_WAIT_L
#undef PG8_SCHED
#undef PG8_PKROWS
#undef PG8_RAWROWS
#undef PG8_PACKRAW
#undef PG8_STGA
}
}

namespace pg8 {
constexpr int NXCD = 8, WGM = 8;
__device__ __forceinline__ void tile_order(int L, int nM, int nN, int& pm, int& pn) {
    const int nwg = nM * nN; int wgid = L;
    { const int q = nwg / NXCD, r = nwg % NXCD, xcd = wgid % NXCD, off = wgid / NXCD; wgid = (xcd < r ? xcd * (q + 1) : r * (q + 1) + (xcd - r) * q) + off; }
    const int nig = WGM * nN, gid = wgid / nig, fm = gid * WGM, gsz = (nM - fm) < WGM ? (nM - fm) : WGM;
    pm = fm + ((wgid % nig) % gsz); pn = (wgid % nig) / gsz;
}
struct DenseOrder {
    const char* A; const char* B; int lda, ldb, nM, nN, G, c, pn0;
    __device__ __forceinline__ bool next(int i, Unit& u) const {
        const long L = (long)i * G + c; if (L >= (long)nM * nN) return false;
        int pm, pn; tile_order((int)L, nM, nN, pm, pn);
        u.pm = pm; u.pn = pn + pn0; u.aux = 0; u.rows = nullptr; u.nrows = 256; u.ntu = 0;
        u.A = A + (size_t)pm * 256 * lda * 2; u.B = B + (size_t)pn * 256 * ldb * 2; return true;
    }
};
struct KvOrder {
    const char* MN; const char* W; int L0;
    __device__ __forceinline__ bool next(int i, Unit& u) const {
        const int L = L0; if (i > 0 || L >= 64) return false;
        u.rows = nullptr; u.nrows = 256; u.ntu = 0; u.pm = L >> 3; const int ct = L & 7; u.aux = ct >> 2; u.pn = ct & 3;
        u.A = MN + (size_t)u.pm * 256 * D * 2; u.B = W + (size_t)ct * 256 * D * 2; return true;
    }
};
struct XmnOrder {
    const char* MK; const char* MV; const char* WQN; const char* WOT; int G, c;
    __device__ __forceinline__ bool next(int i, Unit& u) const {
        const int L = c + i * G; if (L >= 256) return false;
        u.rows = nullptr; u.nrows = 256; u.ntu = 0;
        if (L < 128) { const int b = L >> 4, h = (L >> 2) & 3, kt = L & 3; u.aux = 0; u.pm = b * 4 + h; u.pn = kt;
            u.A = MK + ((size_t)(b * 256) * D + h * 256) * 2; u.B = WQN + ((size_t)(kt * 256) * D + h * 256) * 2; }
        else { const int l = L - 128, b = l >> 4, nt = (l >> 2) & 3, h = l & 3; u.aux = 1; u.pm = b * 4 + nt; u.pn = h;
            u.A = WOT + ((size_t)(nt * 256) * D + h * 256) * 2; u.B = MV + ((size_t)(b * 256) * D + h * 256) * 2; }
        return true;
    }
};
struct P3Order {
    XmnOrder X; DenseOrder Dn;
    __device__ __forceinline__ bool next(int i, Unit& u) const {
        if (i == 0 && X.c < 256) { X.next(0, u); u.ntu = 4; return true; }
        const bool ok = Dn.next(X.c < 256 ? i - 1 : i, u); u.aux = 2; return ok;
    }
};
struct XbOrder {
    const char* A; const char* Bb; int G, c; size_t rb;
    __device__ __forceinline__ bool next(int i, Unit& u) const {
        const long L = (long)i * G + c; if (L >= 512) return false;
        int pm, pn; tile_order((int)L, T / 256, 4, pm, pn);
        u.pm = pm; u.pn = pn; u.aux = 0; u.rows = nullptr; u.nrows = 256; u.ntu = 0;
        u.A = A + (size_t)pm * 256 * rb; u.B = Bb + (size_t)(pm >> 4) * D * rb + (size_t)pn * 256 * rb; return true;
    }
};
struct MoeOrder {
    const char* A; const char* W; const int* list; const LAS int* cnt; const LAS unsigned char* te; const LAS int* ts;
    int ntiles, nN, G, c; size_t wstride; int gather; size_t atile, btile;
    __device__ __forceinline__ bool next(int i, Unit& u) const {
        const long L = (long)i * G + c; if (L >= (long)ntiles * nN) return false;
        int pm, pn; tile_order((int)L, ntiles, nN, pm, pn);
        const int e = __builtin_amdgcn_readfirstlane((int)te[pm]);
        const int lt = pm - __builtin_amdgcn_readfirstlane(ts[e]);
        const int n = __builtin_amdgcn_readfirstlane(cnt[e]) - lt * 256;
        u.pm = pm; u.pn = pn; u.aux = e; u.nrows = n < 256 ? n : 256; u.ntu = 0;
        u.rows = list + (size_t)e * T + lt * 256;
        u.A = gather ? A : A + (size_t)pm * atile;
        u.B = W + (size_t)e * wstride + (size_t)pn * btile; return true;
    }
};

struct EpiProj {
    static constexpr bool PERM = true, AFTER_DRAIN = false; struct Pre {}; __device__ __forceinline__ void prefetch(const Unit&, int, int, int, int, Pre&) const {}
    bf16_t* O; float* kbar; float asc;
    __device__ __forceinline__ void operator()(const f32x4 (&acc)[2][2][4][2], const Unit& u, int wr, int wc, int fr, int fq, const Pre&) const {
        const int pn = u.pn, sec = pn >> 1, b = u.pm >> 4, t0 = (u.pm & 15) * 256 + wr * 64 + fr;
        const int mode = (pn < 2) ? 1 : ((pn == 6 || pn == 7 || pn >= 12) ? 2 : 0);
        bf16_t* sb = O + (size_t)sec * SEC_ELEMS;
#pragma unroll
        for (int bj = 0; bj < 2; ++bj) {
            const int c = bj * HALF + wc * 32 + 8 * fq, head = (pn & 1) * 4 + (c >> 6), d0 = c & 63;
            bf16_t* hb = sb + (size_t)(b * 8 + head) * (SEQ * 64);
#pragma unroll
            for (int ai = 0; ai < 2; ++ai)
#pragma unroll
                for (int m = 0; m < 4; ++m) { const int t = t0 + ai * HALF + m * 16;
                    f32x4 v0 = acc[ai][bj][m][0] * asc, v1 = acc[ai][bj][m][1] * asc;
                    if (mode == 1) { v0 = v0 * C2Q; v1 = v1 * C2Q; }
                    else if (mode == 2) {
#pragma unroll
                        for (int e = 0; e < 4; ++e) { v0[e] = silu_f(v0[e]); v1[e] = silu_f(v1[e]); } }
                    u32x4 w; w.x = cvtpk(v0[0], v0[1]); w.y = cvtpk(v0[2], v0[3]); w.z = cvtpk(v1[0], v1[1]); w.w = cvtpk(v1[2], v1[3]);
                    size_t off;
                    if (sec == 1) off = (size_t)(t >> 6) * 4096 + (d0 >> 3) * 512 + (t & 63) * 8;
                    else if (sec == 2) off = (size_t)(t >> 6) * 4096 + (d0 >> 5) * 2048 + (t & 63) * 32 + (d0 & 31);
                    else off = (size_t)t * 64 + d0;
                    *(u32x4*)(hb + off) = w; } }
        if (pn == 2 || pn == 3) {
#pragma unroll
            for (int bj = 0; bj < 2; ++bj)
#pragma unroll
                for (int n = 0; n < 2; ++n)
#pragma unroll
                    for (int e = 0; e < 4; ++e) { float s = 0.f;
#pragma unroll
                        for (int ai = 0; ai < 2; ++ai)
#pragma unroll
                            for (int m = 0; m < 4; ++m) s += acc[ai][bj][m][n][e];
                        s += __shfl_xor(s, 1); s += __shfl_xor(s, 2); s += __shfl_xor(s, 4); s += __shfl_xor(s, 8); s *= asc;
                        if (fr == 0) { const int c = bj * HALF + wc * 32 + 8 * fq + 4 * n + e, head = (pn - 2) * 4 + (c >> 6), d = c & 63;
                            atomicAdd(kbar + ((size_t)u.pm * 8 + head) * 64 + d, s); } }
        }
    }
};
struct EpiBf16 {
    static constexpr bool PERM = true, AFTER_DRAIN = false; struct Pre {}; __device__ __forceinline__ void prefetch(const Unit&, int, int, int, int, Pre&) const {}
    bf16_t* O0; int ldc0; bf16_t* O1; int ldc1;
    __device__ __forceinline__ void operator()(const f32x4 (&acc)[2][2][4][2], const Unit& u, int wr, int wc, int fr, int fq, const Pre&) const {
        bf16_t* O = u.aux ? O1 : O0; const int ldc = u.aux ? ldc1 : ldc0;
        const int row0 = u.pm * BM + wr * 64 + fr, col0 = u.pn * BM + wc * 32 + 8 * fq;
#pragma unroll
        for (int ai = 0; ai < 2; ++ai)
#pragma unroll
            for (int m = 0; m < 4; ++m) { bf16_t* rowp = O + (size_t)(row0 + ai * HALF + m * 16) * ldc + col0;
#pragma unroll
                for (int bj = 0; bj < 2; ++bj) { const f32x4 v0 = acc[ai][bj][m][0], v1 = acc[ai][bj][m][1];
                    u32x4 w; w.x = cvtpk(v0[0], v0[1]); w.y = cvtpk(v0[2], v0[3]); w.z = cvtpk(v1[0], v1[1]); w.w = cvtpk(v1[2], v1[3]);
                    *(u32x4*)(rowp + bj * HALF) = w; } }
    }
};
struct EpiFp8 {
    static constexpr bool PERM = true, AFTER_DRAIN = false; struct Pre {}; __device__ __forceinline__ void prefetch(const Unit&, int, int, int, int, Pre&) const {}
    unsigned char* O0; int ldc0; unsigned char* O1; int ldc1; float scale;
    __device__ __forceinline__ void operator()(const f32x4 (&acc)[2][2][4][2], const Unit& u, int wr, int wc, int fr, int fq, const Pre&) const {
        unsigned char* O = u.aux ? O1 : O0; const int ldc = u.aux ? ldc1 : ldc0;
        const int row0 = u.pm * BM + wr * 64 + fr, col0 = u.pn * BM + wc * 32 + 8 * fq;
#pragma unroll
        for (int ai = 0; ai < 2; ++ai)
#pragma unroll
            for (int m = 0; m < 4; ++m) { unsigned char* rowp = O + (size_t)(row0 + ai * HALF + m * 16) * ldc + col0;
#pragma unroll
                for (int bj = 0; bj < 2; ++bj) { const f32x4 v0 = acc[ai][bj][m][0] * scale, v1 = acc[ai][bj][m][1] * scale;
                    *(u32x2*)(rowp + bj * HALF) = (u32x2){pk4_fp8(v0[0], v0[1], v0[2], v0[3]), pk4_fp8(v1[0], v1[1], v1[2], v1[3])}; } }
    }
};
template <bool BASE_F32, int WRITE_F32, bool OUT_FP8 = false, bool BASE_RS = false> struct EpiRes {
    static constexpr bool PERM = true, AFTER_DRAIN = false; struct Pre {}; __device__ __forceinline__ void prefetch(const Unit&, int, int, int, int, Pre&) const {}
    const void* base; bf16_t* Ob; float* Of; float* ss; float asc; unsigned char* Oq; const float* brs = nullptr;
    static constexpr int LPG = BASE_F32 ? 4 : 2;
    __device__ __forceinline__ void issue(f32x4 (&b)[4], unsigned voff) const {
        if (BASE_F32) { b[0] = gload128_hidden(base, voff); b[1] = gload128_hidden(base, voff + 16u); b[2] = gload128_hidden(base, voff + HALF * 4u); b[3] = gload128_hidden(base, voff + HALF * 4u + 16u); }
        else { b[0] = gload128_hidden(base, voff); b[1] = gload128_hidden(base, voff + HALF * 2u); }
    }
    __device__ __forceinline__ void operator()(const f32x4 (&acc)[2][2][4][2], const Unit& u, int wr, int wc, int fr, int fq, const Pre&) const {
        const int row0 = u.pm * BM + wr * 64 + fr, col0 = u.pn * BM + wc * 32 + 8 * fq;
        const unsigned esz = BASE_F32 ? 4u : 2u;
        f32x4 lb[8][4];
#define ER_VOFF(g_) ((unsigned)((row0 + ((g_) >> 2) * HALF + ((g_) & 3) * 16) * D + col0) * esz)
        float rsv[8];
        if (BASE_RS) {
#pragma unroll
            for (int g = 0; g < 8; ++g) rsv[g] = __uint_as_float(gload32_hidden(brs, (unsigned)(row0 + (g >> 2) * HALF + (g & 3) * 16) * 4u)); }
#pragma unroll
        for (int g = 0; g < 4; ++g) issue(lb[g], ER_VOFF(g));
#pragma unroll
        for (int g = 0; g < 8; ++g) { const int ai = g >> 2, m = g & 3; const int row = row0 + ai * HALF + m * 16; const size_t off = (size_t)row * D + col0; float sq = 0.f;
            { constexpr int dummy = 0; (void)dummy; const int newer = (7 - g < 3 ? 7 - g : 3) * LPG;
              if (newer == 12) asm volatile("s_waitcnt vmcnt(12)" ::: "memory"); else if (newer == 8) asm volatile("s_waitcnt vmcnt(8)" ::: "memory"); else if (newer == 6) asm volatile("s_waitcnt vmcnt(6)" ::: "memory");
              else if (newer == 4) asm volatile("s_waitcnt vmcnt(4)" ::: "memory"); else if (newer == 2) asm volatile("s_waitcnt vmcnt(2)" ::: "memory"); else asm volatile("s_waitcnt vmcnt(0)" ::: "memory"); }
#pragma unroll
            for (int q = 0; q < LPG; ++q) asm volatile("" : "+v"(lb[g][q]));
            if (BASE_RS && g == 0) {
#pragma unroll
                for (int q = 0; q < 8; ++q) asm volatile("" : "+v"(rsv[q])); }
#pragma unroll
            for (int bj = 0; bj < 2; ++bj) { f32x4 b0, b1;
                if (BASE_F32) { b0 = lb[g][2 * bj]; b1 = lb[g][2 * bj + 1]; }
                else { const u32x4 w = __builtin_bit_cast(u32x4, lb[g][bj]);
                    b0 = (f32x4){bflo(w.x), bfhi(w.x), bflo(w.y), bfhi(w.y)}; b1 = (f32x4){bflo(w.z), bfhi(w.z), bflo(w.w), bfhi(w.w)};
                    if (BASE_RS) { b0 = b0 * rsv[g]; b1 = b1 * rsv[g]; } }
                const f32x4 v0 = acc[ai][bj][m][0] * asc + b0, v1 = acc[ai][bj][m][1] * asc + b1;
                sq += (v0[0] * v0[0] + v0[1] * v0[1]) + (v0[2] * v0[2] + v0[3] * v0[3]) + (v1[0] * v1[0] + v1[1] * v1[1]) + (v1[2] * v1[2] + v1[3] * v1[3]);
                if (OUT_FP8) { *(u32x2*)((unsigned char*)Ob + off + bj * HALF) = (u32x2){pk4_fp8(v0[0], v0[1], v0[2], v0[3]), pk4_fp8(v1[0], v1[1], v1[2], v1[3])}; }
                else { u32x4 w; w.x = cvtpk(v0[0], v0[1]); w.y = cvtpk(v0[2], v0[3]); w.z = cvtpk(v1[0], v1[1]); w.w = cvtpk(v1[2], v1[3]);
                *(u32x4*)(Ob + off + bj * HALF) = w; }
                if (Oq) *(u32x2*)(Oq + off + bj * HALF) = (u32x2){pk4_fp8(v0[0], v0[1], v0[2], v0[3]), pk4_fp8(v1[0], v1[1], v1[2], v1[3])};
                if (WRITE_F32 == 1) { *(f32x4*)(Of + off + bj * HALF) = v0; *(f32x4*)(Of + off + bj * HALF + 4) = v1; }
                if (WRITE_F32 == 2) { u32x4 w; w.x = cvtpk(v0[0], v0[1]); w.y = cvtpk(v0[2], v0[3]); w.z = cvtpk(v1[0], v1[1]); w.w = cvtpk(v1[2], v1[3]);
                    *(u32x4*)((bf16_t*)Of + off + bj * HALF) = w;
                    *(u32x2*)((unsigned char*)Of + (size_t)T * D * 2 + off + bj * HALF) = (u32x2){
                        pk4_fp8((v0[0] - bflo(w.x)) * 1024.f, (v0[1] - bfhi(w.x)) * 1024.f, (v0[2] - bflo(w.y)) * 1024.f, (v0[3] - bfhi(w.y)) * 1024.f),
                        pk4_fp8((v1[0] - bflo(w.z)) * 1024.f, (v1[1] - bfhi(w.z)) * 1024.f, (v1[2] - bflo(w.w)) * 1024.f, (v1[3] - bfhi(w.w)) * 1024.f)}; } }
            sq += __shfl_xor(sq, 16); sq += __shfl_xor(sq, 32);
            if (fq == 0) atomicAdd(ss + row, sq);
            if (g + 4 < 8) issue(lb[g + 4], ER_VOFF(g + 4)); }
#undef ER_VOFF
    }
};
struct EpiP3 {
    static constexpr bool PERM = true, AFTER_DRAIN = false; struct Pre {}; __device__ __forceinline__ void prefetch(const Unit&, int, int, int, int, Pre&) const {}
    EpiFp8 a; EpiRes<false, 0, false, true> b;
    __device__ __forceinline__ void operator()(const f32x4 (&acc)[2][2][4][2], const Unit& u, int wr, int wc, int fr, int fq, const Pre&) const {
        if (u.aux < 2) a(acc, u, wr, wc, fr, fq, EpiFp8::Pre{}); else b(acc, u, wr, wc, fr, fq, EpiRes<false, 0, false, true>::Pre{});
    }
};
struct EpiQ {
    static constexpr bool PERM = true, AFTER_DRAIN = false; struct Pre {}; __device__ __forceinline__ void prefetch(const Unit&, int, int, int, int, Pre&) const {}
    bf16_t* O; const float* ss;
    __device__ __forceinline__ void operator()(const f32x4 (&acc)[2][2][4][2], const Unit& u, int wr, int wc, int fr, int fq, const Pre&) const {
        const int row0 = u.pm * BM + wr * 64 + fr, col0 = u.pn * BM + wc * 32 + 8 * fq;
#pragma unroll
        for (int ai = 0; ai < 2; ++ai)
#pragma unroll
            for (int m = 0; m < 4; ++m) { const int row = row0 + ai * HALF + m * 16; const float sc = C2X * __builtin_amdgcn_rsqf(ss[row] * (1.0f / D) + EPS);
                bf16_t* rowp = O + (size_t)row * D + col0;
#pragma unroll
                for (int bj = 0; bj < 2; ++bj) { const f32x4 v0 = acc[ai][bj][m][0] * sc, v1 = acc[ai][bj][m][1] * sc;
                    u32x4 w; w.x = cvtpk(v0[0], v0[1]); w.y = cvtpk(v0[2], v0[3]); w.z = cvtpk(v1[0], v1[1]); w.w = cvtpk(v1[2], v1[3]);
                    *(u32x4*)(rowp + bj * HALF) = w; } }
    }
};
struct EpiSoftmaxS {
    static constexpr bool PERM = true, AFTER_DRAIN = false; struct Pre {}; __device__ __forceinline__ void prefetch(const Unit&, int, int, int, int, Pre&) const {}
    unsigned char* P; const float* ss; LAS unsigned char* tb; float qs;
    __device__ __forceinline__ void operator()(f32x4 (&acc)[2][2][4][2], const Unit& u, int wr, int wc, int fr, int fq, const Pre&) const {
        LAS float* MX = (LAS float*)tb;
        LAS float* SM = (LAS float*)(tb + 4096);
#pragma unroll
        for (int ai = 0; ai < 2; ++ai)
#pragma unroll
            for (int m = 0; m < 4; ++m) { const int r = ai * HALF + wr * 64 + m * 16 + fr; const float sc = qs * C2X * __builtin_amdgcn_rsqf(ss[u.pm * BM + r] * (1.0f / D) + EPS); float mx = -3.0e38f;
#pragma unroll
                for (int bj = 0; bj < 2; ++bj)
#pragma unroll
                    for (int n = 0; n < 2; ++n) { f32x4 x = acc[ai][bj][m][n] * sc; acc[ai][bj][m][n] = x; mx = fmaxf(mx, fmaxf(fmaxf(x[0], x[1]), fmaxf(x[2], x[3]))); }
                mx = fmaxf(mx, __shfl_xor(mx, 16)); mx = fmaxf(mx, __shfl_xor(mx, 32));
                if (fq == 0) MX[r * 4 + wc] = mx; }
        LDS_WAIT(); __builtin_amdgcn_s_barrier(); asm volatile("" ::: "memory");
#pragma unroll
        for (int ai = 0; ai < 2; ++ai)
#pragma unroll
            for (int m = 0; m < 4; ++m) { const int r = ai * HALF + wr * 64 + m * 16 + fr; const f32x4 q = *(const LAS f32x4*)(MX + r * 4);
                const float mx = fmaxf(fmaxf(q[0], q[1]), fmaxf(q[2], q[3])); float sm = 0.f;
#pragma unroll
                for (int bj = 0; bj < 2; ++bj)
#pragma unroll
                    for (int n = 0; n < 2; ++n) { f32x4 x = acc[ai][bj][m][n];
#pragma unroll
                        for (int e = 0; e < 4; ++e) { x[e] = fast_exp2(x[e] - mx); sm += x[e]; }
                        acc[ai][bj][m][n] = x; }
                sm += __shfl_xor(sm, 16); sm += __shfl_xor(sm, 32);
                if (fq == 0) SM[r * 4 + wc] = sm; }
        LDS_WAIT(); __builtin_amdgcn_s_barrier(); asm volatile("" ::: "memory");
        const int col0 = u.pn * BM + wc * 32 + 8 * fq;
#pragma unroll
        for (int ai = 0; ai < 2; ++ai)
#pragma unroll
            for (int m = 0; m < 4; ++m) { const int r = ai * HALF + wr * 64 + m * 16 + fr; const f32x4 q = *(const LAS f32x4*)(SM + r * 4);
                const float inv = PSCALE8 * fast_rcp((q[0] + q[1]) + (q[2] + q[3]));
#pragma unroll
                for (int bj = 0; bj < 2; ++bj) { const f32x4 v0 = acc[ai][bj][m][0] * inv, v1 = acc[ai][bj][m][1] * inv;
                    *(u32x2*)(P + ((size_t)u.pm * BM + r) * D + bj * HALF + col0) = (u32x2){pk4_fp8(v0[0], v0[1], v0[2], v0[3]), pk4_fp8(v1[0], v1[1], v1[2], v1[3])}; } }
        LDS_WAIT(); __builtin_amdgcn_s_barrier(); asm volatile("" ::: "memory");
    }
};
struct EpiW1 {
    static constexpr bool PERM = true, AFTER_DRAIN = false;
    struct Pre { float sc[8]; f32x4 bq[4]; };
    bf16_t* O; const float* ssl; const float* b1; const int* list0;
    __device__ __forceinline__ void prefetch(const Unit& u, int wr, int wc, int fr, int fq, Pre& p) const {
        const float* sp = ssl + (u.rows - list0);
        { const float* bb = b1 + (size_t)u.aux * 2048 + 2 * (u.pn * 128); const unsigned bo = (unsigned)(2 * (wc * 32 + 8 * fq)) * 4u;
#pragma unroll
          for (int q = 0; q < 4; ++q) p.bq[q] = gload128_hidden(bb, bo + 16u * q); }
#pragma unroll
        for (int ai = 0; ai < 2; ++ai)
#pragma unroll
            for (int m = 0; m < 4; ++m) { const int r = ai * HALF + wr * 64 + m * 16 + fr; const int rr = r < u.nrows ? r : u.nrows - 1; p.sc[ai * 4 + m] = __uint_as_float(gload32_hidden(sp, (unsigned)rr * 4u)); }
    }
    __device__ __forceinline__ void operator()(const f32x4 (&acc)[2][2][4][2], const Unit& u, int wr, int wc, int fr, int fq, const Pre& pre) const {
        const int c0 = wc * 32 + 8 * fq;
        f32x4 bq0 = pre.bq[0], bq1 = pre.bq[1], bq2 = pre.bq[2], bq3 = pre.bq[3]; asm volatile("" : "+v"(bq0), "+v"(bq1), "+v"(bq2), "+v"(bq3));
        constexpr float CG = -1.702f * LOG2E, ICG = 1.0f / CG;
        f32x2 bg2[4] = {(f32x2){bq0[0], bq0[2]} * CG, (f32x2){bq1[0], bq1[2]} * CG, (f32x2){bq2[0], bq2[2]} * CG, (f32x2){bq3[0], bq3[2]} * CG};
        f32x2 bl2[4] = {((f32x2){bq0[1], bq0[3]} + 1.0f) * ICG, ((f32x2){bq1[1], bq1[3]} + 1.0f) * ICG, ((f32x2){bq2[1], bq2[3]} + 1.0f) * ICG, ((f32x2){bq3[1], bq3[3]} + 1.0f) * ICG};
#pragma unroll
        for (int j = 0; j < 4; ++j) asm volatile("" : "+v"(bg2[j]), "+v"(bl2[j]));
#pragma unroll
        for (int ai = 0; ai < 2; ++ai)
#pragma unroll
            for (int m = 0; m < 4; ++m) { const int r = ai * HALF + wr * 64 + m * 16 + fr;
                float ssv = pre.sc[ai * 4 + m]; asm volatile("" : "+v"(ssv));
                const float sc = WSCALE8_INV * __builtin_amdgcn_rsqf(ssv * (1.0f / D) + EPS); const float scg = sc * CG, scl = sc * ICG; f32x2 a[4];
#pragma unroll
                for (int j = 0; j < 4; ++j) { const f32x2 ag = (f32x2){acc[ai][0][m][j >> 1][2 * (j & 1)], acc[ai][0][m][j >> 1][2 * (j & 1) + 1]}, al = (f32x2){acc[ai][1][m][j >> 1][2 * (j & 1)], acc[ai][1][m][j >> 1][2 * (j & 1) + 1]};
                    f32x2 w = ag * scg + bg2[j]; w = (f32x2){fmaxf(w.x, 7.0f * CG), fmaxf(w.y, 7.0f * CG)};
                    f32x2 d = (f32x2){fast_exp2(w.x), fast_exp2(w.y)} + 1.0f; d = (f32x2){fast_rcp(d.x), fast_rcp(d.y)};
                    f32x2 l = al * scl + bl2[j]; l = (f32x2){__builtin_amdgcn_fmed3f(l.x, 8.0f * ICG, -6.0f * ICG), __builtin_amdgcn_fmed3f(l.y, 8.0f * ICG, -6.0f * ICG)};
                    a[j] = (w * d) * l; }
                *(u32x2*)((unsigned char*)O + ((size_t)u.pm * BM + r) * D + u.pn * 128 + c0) = (u32x2){pk4_fp8(a[0].x, a[0].y, a[1].x, a[1].y), pk4_fp8(a[2].x, a[2].y, a[3].x, a[3].y)}; }
    }
};
constexpr float YSCALE = 16.0f, YSCALE_INV = 1.0f / 16.0f;
struct EpiW2 {
    static constexpr bool PERM = true, AFTER_DRAIN = false;
    struct Pre { float g[8]; f32x4 bv[4]; };
    unsigned char* O; const float* b2; const int* list0; const float* gl0;
    __device__ __forceinline__ void prefetch(const Unit& u, int wr, int wc, int fr, int fq, Pre& p) const {
        const float* gp = gl0 + (u.rows - list0);
        { const float* bb = b2 + (size_t)u.aux * D + u.pn * BM; const unsigned bo = (unsigned)(wc * 32 + 8 * fq) * 4u;
#pragma unroll
          for (int q = 0; q < 4; ++q) p.bv[q] = gload128_hidden(bb, bo + (unsigned)((q >> 1) * HALF * 4 + (q & 1) * 16)); }
#pragma unroll
        for (int ai = 0; ai < 2; ++ai)
#pragma unroll
            for (int m = 0; m < 4; ++m) { const int r = ai * HALF + wr * 64 + m * 16 + fr; const int rr = r < u.nrows ? r : u.nrows - 1; p.g[ai * 4 + m] = __uint_as_float(gload32_hidden(gp, (unsigned)rr * 4u)); }
    }
    __device__ __forceinline__ void operator()(const f32x4 (&acc)[2][2][4][2], const Unit& u, int wr, int wc, int fr, int fq, const Pre& pre) const {
        const int row0 = u.pm * BM + wr * 64 + fr, col0 = u.pn * BM + wc * 32 + 8 * fq;
        f32x4 bv[2][2]; bv[0][0] = pre.bv[0]; bv[0][1] = pre.bv[1]; bv[1][0] = pre.bv[2]; bv[1][1] = pre.bv[3]; asm volatile("" : "+v"(bv[0][0]), "+v"(bv[0][1]), "+v"(bv[1][0]), "+v"(bv[1][1]));
#pragma unroll
        for (int ai = 0; ai < 2; ++ai)
#pragma unroll
            for (int m = 0; m < 4; ++m) { unsigned char* rowp = O + (size_t)(row0 + ai * HALF + m * 16) * D + col0; float gv = pre.g[ai * 4 + m]; asm volatile("" : "+v"(gv)); const float g = YSCALE * gv;
#pragma unroll
                for (int bj = 0; bj < 2; ++bj) { const f32x4 v0 = (acc[ai][bj][m][0] * WSCALE8_INV + bv[bj][0]) * g, v1 = (acc[ai][bj][m][1] * WSCALE8_INV + bv[bj][1]) * g;
                    *(u32x2*)(rowp + bj * HALF) = (u32x2){pk4_fp8(v0[0], v0[1], v0[2], v0[3]), pk4_fp8(v1[0], v1[1], v1[2], v1[3])}; } }
    }
};
}

namespace moba {
using bf16x8 = ::bf16x8; using s16x4 = ::s16x4; using f32x16 = ::f32x16; using u32x4 = ::u32x4;
constexpr int DMQ = INC, DMO = D, HD = 64;
constexpr int NW = 8, QBLK = 32, QB = 256, KVBLK = 64;
__device__ __forceinline__ int crow(int r, int hi) { return (r & 3) + 8 * (r >> 2) + 4 * hi; }
#define SBAR() __builtin_amdgcn_sched_barrier(0)
__device__ __forceinline__ void cmask(f32x16& p0, f32x16& p1, int jb, int qrel, int hi) {
    const float NEG = -INFINITY; int kb = 64 * jb + 4 * hi;
#pragma unroll
    for (int r = 0; r < 16; ++r) { int kv = kb + (r & 3) + 8 * (r >> 2); if (kv > qrel) p0[r] = NEG; if (kv + 32 > qrel) p1[r] = NEG; }
}
constexpr int NSLOT = 3, SLOTB = 8192;
constexpr int LDS_K = 0, LDS_V = NSLOT * SLOTB, LDS_WS = 2 * NSLOT * SLOTB, LDS_OST = LDS_WS + NW * 64 * 4, LDS_KB = LDS_OST + NW * 4096, LDS_BYTES = LDS_KB + 16 * 64 * 4;
__device__ __forceinline__ void glds16(const void* gsrc, unsigned lds_dst) { unsigned keep;
    asm volatile("s_mov_b32 %0, m0\n\ts_mov_b32 m0, %2\n\ts_nop 0\n\tglobal_load_lds_dwordx4 %1, off\n\ts_mov_b32 m0, %0" : "=&s"(keep) : "v"(gsrc), "s"(lds_dst) : "memory"); }
__device__ __forceinline__ float max3f(float a, float b, float c) { float r; asm("v_max3_f32 %0, %1, %2, %3" : "=v"(r) : "v"(a), "v"(b), "v"(c)); return r; }
__device__ __forceinline__ float max2f(float a, float b) { float r; asm("v_max_f32_e32 %0, %1, %2" : "=v"(r) : "v"(a), "v"(b)); return r; }
__device__ __forceinline__ float fadd_s(float a, float b) { float r; asm("v_add_f32_e32 %0, %1, %2" : "=v"(r) : "v"(a), "v"(b)); return r; }
__device__ __forceinline__ float fsub_s(float a, float b) { float r; asm("v_sub_f32_e32 %0, %1, %2" : "=v"(r) : "v"(a), "v"(b)); return r; }
__device__ __forceinline__ unsigned cvtpk_s(float lo, float hi) { return ::cvtpk(lo, hi); }
#define WAIT_BAR(N) asm volatile("s_waitcnt vmcnt(" #N ") lgkmcnt(0)\n\ts_barrier" ::: "memory")
__device__ __forceinline__ void qkt(f32x16& p0, f32x16& p1, const char* Kslot, const bf16x8* qr, const f32x16& negm, int r32, int hi) {
    const char* kb = Kslot + hi * 1024 + r32 * 16;
#pragma unroll
    for (int d0 = 0; d0 < 4; ++d0) {
        const bf16x8 b0 = *reinterpret_cast<const bf16x8*>(kb + d0 * 2048);
        const bf16x8 b1 = *reinterpret_cast<const bf16x8*>(kb + d0 * 2048 + 512);
        if (d0 == 0) { p0 = __builtin_amdgcn_mfma_f32_32x32x16_bf16(b0, qr[0], negm, 0, 0, 0); p1 = __builtin_amdgcn_mfma_f32_32x32x16_bf16(b1, qr[0], negm, 0, 0, 0); }
        else { p0 = __builtin_amdgcn_mfma_f32_32x32x16_bf16(b0, qr[d0], p0, 0, 0, 0); p1 = __builtin_amdgcn_mfma_f32_32x32x16_bf16(b1, qr[d0], p1, 0, 0, 0); } }
}
typedef __attribute__((address_space(3))) const char* lds_cptr;
typedef short v4i16_t __attribute__((ext_vector_type(4)));
__device__ __forceinline__ void kload8(bf16x8* kf, lds_cptr kp) {
    kf[0] = *(const __attribute__((address_space(3))) bf16x8*)(kp);        kf[1] = *(const __attribute__((address_space(3))) bf16x8*)(kp + 512);
    kf[2] = *(const __attribute__((address_space(3))) bf16x8*)(kp + 2048); kf[3] = *(const __attribute__((address_space(3))) bf16x8*)(kp + 2560);
    kf[4] = *(const __attribute__((address_space(3))) bf16x8*)(kp + 4096); kf[5] = *(const __attribute__((address_space(3))) bf16x8*)(kp + 4608);
    kf[6] = *(const __attribute__((address_space(3))) bf16x8*)(kp + 6144); kf[7] = *(const __attribute__((address_space(3))) bf16x8*)(kp + 6656);
}
__device__ __forceinline__ void kload2(bf16x8* kf, lds_cptr kp, int j) { kf[2 * j] = *(const __attribute__((address_space(3))) bf16x8*)(kp + j * 2048); kf[2 * j + 1] = *(const __attribute__((address_space(3))) bf16x8*)(kp + j * 2048 + 512); }
__device__ __forceinline__ s16x4 vtr(lds_cptr p) { return __builtin_bit_cast(s16x4, __builtin_amdgcn_ds_read_tr16_b64_v4i16((__attribute__((address_space(3))) v4i16_t*)p)); }
__device__ __forceinline__ float rowmax(const f32x16& p0, const f32x16& p1) {
    float a = max3f(p0[0], p0[1], p1[0]), b = max3f(p0[2], p0[3], p1[1]); a = max3f(a, p1[2], p1[3]);
#pragma unroll
    for (int r = 4; r < 16; r += 4) { a = max3f(a, p0[r], p0[r + 1]); b = max3f(b, p0[r + 2], p0[r + 3]); a = max3f(a, p1[r], p1[r + 1]); b = max3f(b, p1[r + 2], p1[r + 3]); }
    const float m = max2f(a, b);
    auto rr = __builtin_amdgcn_permlane32_swap(__float_as_uint(m), __float_as_uint(m), false, false);
    return max2f(__uint_as_float(rr[0]), __uint_as_float(rr[1]));
}
__device__ __forceinline__ void pv(f32x16* o, int vb, bf16x8 pa0, bf16x8 pa1, bf16x8 pa2, bf16x8 pa3) {
#pragma unroll
    for (int d0 = 0; d0 < 2; ++d0) { s16x4 lo[4], hi[4];
#pragma unroll
        for (int ks = 0; ks < 4; ++ks) {
            asm volatile("ds_read_b64_tr_b16 %0,%1 offset:%c2" : "=&v"(lo[ks]) : "v"(vb), "i"(d0 * 4096 + ks * 1024) : "memory");
            asm volatile("ds_read_b64_tr_b16 %0,%1 offset:%c2" : "=&v"(hi[ks]) : "v"(vb), "i"(d0 * 4096 + ks * 1024 + 512) : "memory"); }
        asm volatile("s_waitcnt lgkmcnt(0)" ::: "memory"); SBAR();
#define PK(k) (bf16x8){lo[k][0], lo[k][1], lo[k][2], lo[k][3], hi[k][0], hi[k][1], hi[k][2], hi[k][3]}
        o[d0] = __builtin_amdgcn_mfma_f32_32x32x16_bf16(pa0, PK(0), o[d0], 0, 0, 0);
        o[d0] = __builtin_amdgcn_mfma_f32_32x32x16_bf16(pa1, PK(1), o[d0], 0, 0, 0);
        o[d0] = __builtin_amdgcn_mfma_f32_32x32x16_bf16(pa2, PK(2), o[d0], 0, 0, 0);
        o[d0] = __builtin_amdgcn_mfma_f32_32x32x16_bf16(pa3, PK(3), o[d0], 0, 0, 0);
#undef PK
    }
}
constexpr float NEGBIG = -1.0e30f;

template <int THRL> __device__ __forceinline__ void attn_unit(int b, int h, int qb, const bf16_t* Qg, const bf16_t* __restrict__ Kg, const bf16_t* __restrict__ Vg, bf16_t* Og, const float* __restrict__ kbar, char* shm) {
    int tid_ = threadIdx.x; asm volatile("" : "+v"(tid_));
    const int tid = tid_, lane = tid & 63, r32 = lane & 31, hi = lane >> 5; const int wid = __builtin_amdgcn_readfirstlane(tid >> 6);
    const long rowbase = (long)b * SEQ; const int q0 = qb * QB;
    const size_t hoff = (size_t)(b * 8 + h) * (SEQ * 64);
    const bf16_t* Qw = Qg + hoff + (size_t)(q0 + wid * QBLK) * 64;
    const bf16_t* Kh = Kg + hoff, *Vh = Vg + hoff;
    const unsigned lds0 = (unsigned)(uintptr_t)shm;
    float* wsf = (float*)(shm + LDS_WS) + wid * 64;
    const bf16_t* ksrc = Kh + wid * 512 + lane * 8;
    const bf16_t* vsrc = Vh + wid * 512 + lane * 8;
    const unsigned kdst = lds0 + LDS_K + wid * 1024, vdst = lds0 + LDS_V + wid * 1024;
    const int NT = 4 * qb + 4, NPAST = 4 * qb;
#define TMAP(t) (((t) < 4) ? (NPAST + (t)) : ((t) - 4))
#define DMA_K(t, slot) glds16(ksrc + (long)TMAP(t) * 4096, (unsigned)__builtin_amdgcn_readfirstlane(kdst + (slot)))
#define DMA_V(t, slot) glds16(vsrc + (long)TMAP(t) * 4096, (unsigned)__builtin_amdgcn_readfirstlane(vdst + (slot)))
    const char* Kbase = shm + LDS_K; bf16x8 kf[8];
    const lds_cptr shm3 = (lds_cptr)shm; const lds_cptr kp0 = shm3 + LDS_K + hi * 1024 + r32 * 16; const lds_cptr vp0 = shm3 + LDS_V + ((lane >> 4) & 1) * 32 + (lane & 3) * 8 + (4 * hi + ((lane & 15) >> 2)) * 64;
    DMA_K(0, 0); DMA_V(0, 0); DMA_K(1, SLOTB);
    bf16x8 qr[4];
#pragma unroll
    for (int d0 = 0; d0 < 4; ++d0) qr[d0] = *reinterpret_cast<const bf16x8*>(&Qw[(long)r32 * 64 + d0 * 16 + hi * 8]);
    unsigned selm = 0u;
    if (qb > 0) {
        float* kbl = (float*)(shm + LDS_KB);
        for (int i = tid; i < qb * 64; i += NW * 64) kbl[i] = kbar[((size_t)(b * 16 + (i >> 6)) * 8 + h) * 64 + (i & 63)];
        asm volatile("s_waitcnt vmcnt(0) lgkmcnt(0)\n\ts_barrier" ::: "memory");
        if (qb <= 3) selm = (1u << qb) - 1u;
        else {
            float qf[32];
#pragma unroll
            for (int d0 = 0; d0 < 4; ++d0)
#pragma unroll
                for (int j = 0; j < 8; ++j) qf[d0 * 8 + j] = bf2f((unsigned short)qr[d0][j]);
            float g[15];
#pragma unroll
            for (int n = 0; n < 15; ++n) { float s = 0.f;
                if (n < qb) {
#pragma unroll
                    for (int d0 = 0; d0 < 4; ++d0) { const f32x4 k0 = *(const f32x4*)(kbl + n * 64 + d0 * 16 + hi * 8), k1 = *(const f32x4*)(kbl + n * 64 + d0 * 16 + hi * 8 + 4);
                        s += qf[d0 * 8 + 0] * k0[0] + qf[d0 * 8 + 1] * k0[1] + qf[d0 * 8 + 2] * k0[2] + qf[d0 * 8 + 3] * k0[3] + qf[d0 * 8 + 4] * k1[0] + qf[d0 * 8 + 5] * k1[1] + qf[d0 * 8 + 6] * k1[2] + qf[d0 * 8 + 7] * k1[3]; }
                    s += __shfl_xor(s, 32);
                } else s = -INFINITY;
                g[n] = s; }
#pragma unroll
            for (int pass = 0; pass < 3; ++pass) { float best = -INFINITY; int bi = 0;
#pragma unroll
                for (int n = 0; n < 15; ++n) if (g[n] > best) { best = g[n]; bi = n; }
                selm |= 1u << bi;
#pragma unroll
                for (int n = 0; n < 15; ++n) if (n == bi) g[n] = -INFINITY; }
        }
    }
    float mhat = 0.f, l_reg = 0.f; f32x16 o[2]; o[0] = f32x16{}; o[1] = f32x16{}; f32x16 cini = f32x16{}; asm volatile("" : "+v"(cini));
    const int qrel = wid * QBLK + r32;
#define SETC(t, JB) do { const float cm_ = ((JB >= 0) || ((selm >> (((t) - 4) >> 2)) & 1u)) ? -mhat : NEGBIG; \
      _Pragma("unroll") for (int r = 0; r < 16; ++r) cini[r] = cm_; asm volatile("" : "+v"(cini)); } while (0)
    bool resc = false;
#define START(P0, P1) do { const float rm = rowmax(P0, P1); resc = false; \
    { const float dl = rm; mhat = fadd_s(mhat, dl); \
      _Pragma("unroll") for (int r = 0; r < 16; ++r) { P0[r] = fsub_s(P0[r], dl); P1[r] = fsub_s(P1[r], dl); } } \
    _Pragma("unroll") for (int r = 0; r < 16; ++r) P0[r] = __builtin_amdgcn_exp2f(P0[r]); } while (0)
#define RESC() do { if (resc) { asm volatile("s_waitcnt lgkmcnt(0)" ::: "memory"); \
      _Pragma("unroll") for (int d_ = 0; d_ < 2; ++d_) _Pragma("unroll") for (int r = 0; r < 16; ++r) o[d_][r] *= wsf[crow(r, hi)]; } } while (0)
    f32x16 pA0, pA1, pB0, pB1;
    int sl_prev = 0, sl_cur = 0, sl_next = SLOTB;
#define ROT() do { sl_prev = sl_cur; sl_cur = sl_next; sl_next = (sl_next == (NSLOT - 1) * SLOTB) ? 0 : sl_next + SLOTB; } while (0)
    DMA_K(2, 2 * SLOTB);
    if (qb > 0) { WAIT_BAR(0); } else { WAIT_BAR(3); }
    qkt(pA0, pA1, Kbase, qr, cini, r32, hi); asm volatile("s_nop 15\n\ts_nop 7" : "+v"(pA0), "+v"(pA1)); cmask(pA0, pA1, 0, qrel, hi);
    START(pA0, pA1);
    _Pragma("unroll") for (int r = 0; r < 16; ++r) pA1[r] = __builtin_amdgcn_exp2f(pA1[r]);
    WAIT_BAR(0);
    DMA_K(3, 0); DMA_V(1, SLOTB);
    ROT();
    kload8(kf, kp0 + sl_cur);
    WAIT_BAR(2);
    s16x4 vlo[8], vhi[8]; u32x4 pw0, pw1, pw2, pw3;
#define PKW(P, B) cvtpk_s(P[B], P[B + 1])
#define PAF(k) __builtin_bit_cast(bf16x8, pw##k)
#define VFR(i) (bf16x8){vlo[i][0], vlo[i][1], vlo[i][2], vlo[i][3], vhi[i][0], vhi[i][1], vhi[i][2], vhi[i][3]}
#define PIN(x) asm volatile("" : "+v"(x))
#define MX3(a, b, c) __builtin_fmaxf(__builtin_fmaxf((a), (b)), (c))
#define GAPA(MF, A0, A1, A2, A3, W0, W1, PW) do { MF; sacc += A0; sacc += A1; sacc += A2; sacc += A3; PIN(sacc); W0; W1; PIN(PW); SBAR(); } while (0)
#define EX(v) __builtin_amdgcn_exp2f(v)
#define GAPB(MF, X, B) do { MF; X[B] = EX(X[B]); X[B + 1] = EX(X[B + 1]); X[B + 2] = EX(X[B + 2]); X[B + 3] = EX(X[B + 3]); PIN(X); SBAR(); } while (0)
#define VRD(i) do { vlo[i] = vtr(vp_ + (((i) >> 2) * 4096 + ((i) & 3) * 1024)); vhi[i] = vtr(vp_ + (((i) >> 2) * 4096 + ((i) & 3) * 1024 + 512)); } while (0)
#define KRD(G, j) do { if (G) { kload2(kf, kp0 + sl_next, j); SBAR(); } } while (0)
#define STEP(C0, C1, P0, P1, t, GK, GV, GL, JB) do { SETC(t, JB); SBAR(); \
    const lds_cptr vp_ = vp0 + sl_prev; \
    VRD(0); SBAR(); float sacc = (P0[0] + P0[1]); \
    GAPA(C0 = __builtin_amdgcn_mfma_f32_32x32x16_bf16(kf[0], qr[0], cini, 0, 0, 0), P0[2], P0[3], P0[4], P0[5],     pw0[0] = PKW(P0, 0), pw0[1] = PKW(P0, 2), pw0); \
    VRD(4); SBAR(); GAPA(C1 = __builtin_amdgcn_mfma_f32_32x32x16_bf16(kf[1], qr[0], cini, 0, 0, 0), P0[6], P0[7], P0[8], P0[9],     pw0[2] = PKW(P0, 4), pw0[3] = PKW(P0, 6), pw0); \
    VRD(1); SBAR(); GAPA(C0 = __builtin_amdgcn_mfma_f32_32x32x16_bf16(kf[2], qr[1], C0, 0, 0, 0),   P0[10], P0[11], P0[12], P0[13], pw1[0] = PKW(P0, 8), pw1[1] = PKW(P0, 10), pw1); \
    VRD(5); SBAR(); GAPA(C1 = __builtin_amdgcn_mfma_f32_32x32x16_bf16(kf[3], qr[1], C1, 0, 0, 0),   P0[14], P0[15], P1[0], P1[1],   pw1[2] = PKW(P0, 12), pw1[3] = PKW(P0, 14), pw1); \
    VRD(2); SBAR(); GAPA(C0 = __builtin_amdgcn_mfma_f32_32x32x16_bf16(kf[4], qr[2], C0, 0, 0, 0),   P1[2], P1[3], P1[4], P1[5],     pw2[0] = PKW(P1, 0), pw2[1] = PKW(P1, 2), pw2); \
    VRD(6); SBAR(); GAPA(C1 = __builtin_amdgcn_mfma_f32_32x32x16_bf16(kf[5], qr[2], C1, 0, 0, 0),   P1[6], P1[7], P1[8], P1[9],     pw2[2] = PKW(P1, 4), pw2[3] = PKW(P1, 6), pw2); \
    VRD(3); SBAR(); GAPA(C0 = __builtin_amdgcn_mfma_f32_32x32x16_bf16(kf[6], qr[3], C0, 0, 0, 0),   P1[10], P1[11], P1[12], P1[13], pw3[0] = PKW(P1, 8), pw3[1] = PKW(P1, 10), pw3); \
    VRD(7); SBAR(); GAPA(C1 = __builtin_amdgcn_mfma_f32_32x32x16_bf16(kf[7], qr[3], C1, 0, 0, 0),   P1[14], P1[15], 0.f, 0.f,       pw3[2] = PKW(P1, 12), pw3[3] = PKW(P1, 14), pw3); \
    l_reg += sacc; \
    if (GK) { DMA_K((t) + 3, sl_cur); } if (GV) { DMA_V((t) + 1, sl_next); } \
    if (JB >= 0) cmask(C0, C1, JB, qrel, hi); \
    { float a = MX3(C0[0], C0[1], C1[0]), b_ = MX3(C0[2], C0[3], C1[1]); a = MX3(a, C1[2], C1[3]); \
      _Pragma("unroll") for (int r = 4; r < 16; r += 4) { a = MX3(a, C0[r], C0[r + 1]); b_ = MX3(b_, C0[r + 2], C0[r + 3]); a = MX3(a, C1[r], C1[r + 1]); b_ = MX3(b_, C1[r + 2], C1[r + 3]); } \
      float rm = __builtin_fmaxf(a, b_); { auto rr = __builtin_amdgcn_permlane32_swap(__float_as_uint(rm), __float_as_uint(rm), false, false); rm = __builtin_fmaxf(__uint_as_float(rr[0]), __uint_as_float(rr[1])); } \
      resc = false; \
      if (__builtin_expect(__any(rm > (float)THRL), 0)) { const float dl = __builtin_fmaxf(rm, 0.f); mhat += dl; \
        _Pragma("unroll") for (int r = 0; r < 16; ++r) { C0[r] -= dl; C1[r] -= dl; } \
        const float f = __builtin_amdgcn_exp2f(-dl); l_reg *= f; if (hi == 0) wsf[r32] = f; resc = true; } } \
    SBAR(); \
    GAPB(o[0] = __builtin_amdgcn_mfma_f32_32x32x16_bf16(PAF(0), VFR(0), o[0], 0, 0, 0), C0, 0); \
    GAPB(o[1] = __builtin_amdgcn_mfma_f32_32x32x16_bf16(PAF(0), VFR(4), o[1], 0, 0, 0), C0, 4); \
    KRD(GL, 0); GAPB(o[0] = __builtin_amdgcn_mfma_f32_32x32x16_bf16(PAF(1), VFR(1), o[0], 0, 0, 0), C0, 8); \
    KRD(GL, 1); GAPB(o[1] = __builtin_amdgcn_mfma_f32_32x32x16_bf16(PAF(1), VFR(5), o[1], 0, 0, 0), C0, 12); \
    KRD(GL, 2); GAPB(o[0] = __builtin_amdgcn_mfma_f32_32x32x16_bf16(PAF(2), VFR(2), o[0], 0, 0, 0), C1, 0); \
    KRD(GL, 3); GAPB(o[1] = __builtin_amdgcn_mfma_f32_32x32x16_bf16(PAF(2), VFR(6), o[1], 0, 0, 0), C1, 4); \
    GAPB(o[0] = __builtin_amdgcn_mfma_f32_32x32x16_bf16(PAF(3), VFR(3), o[0], 0, 0, 0), C1, 8); \
    GAPB(o[1] = __builtin_amdgcn_mfma_f32_32x32x16_bf16(PAF(3), VFR(7), o[1], 0, 0, 0), C1, 12); \
    } while (0)
#define ENDW(tt) do { if ((tt) + 3 < NT) { WAIT_BAR(2); } else if ((tt) + 2 < NT) { WAIT_BAR(1); } else { WAIT_BAR(0); } } while (0)
    STEP(pB0, pB1, pA0, pA1, 1, (4 < NT), true, true, 1);   ENDW(1); RESC(); ROT();
    STEP(pA0, pA1, pB0, pB1, 2, (5 < NT), true, true, 2);   ENDW(2); RESC(); ROT();
    STEP(pB0, pB1, pA0, pA1, 3, (6 < NT), (4 < NT), (4 < NT), 3);   ENDW(3); RESC(); ROT();
    int t = 4;
    for (; t + 4 < NT; t += 2) {
        STEP(pA0, pA1, pB0, pB1, t, true, true, true, -1);       WAIT_BAR(2); RESC(); ROT();
        STEP(pB0, pB1, pA0, pA1, t + 1, true, true, true, -1);   WAIT_BAR(2); RESC(); ROT();
    }
    for (; t < NT; t += 2) {
        STEP(pA0, pA1, pB0, pB1, t, (t + 3 < NT), true, true, -1);                       ENDW(t);     RESC(); ROT();
        STEP(pB0, pB1, pA0, pA1, t + 1, (t + 4 < NT), (t + 2 < NT), (t + 2 < NT), -1);   ENDW(t + 1); RESC(); ROT();
    }
    { float sacc = pB0[0] + pB0[1]; _Pragma("unroll") for (int r = 2; r < 16; ++r) sacc += pB0[r]; _Pragma("unroll") for (int r = 0; r < 16; ++r) sacc += pB1[r]; l_reg += sacc;
      pw0 = (u32x4){PKW(pB0, 0), PKW(pB0, 2), PKW(pB0, 4), PKW(pB0, 6)}; pw1 = (u32x4){PKW(pB0, 8), PKW(pB0, 10), PKW(pB0, 12), PKW(pB0, 14)}; pw2 = (u32x4){PKW(pB1, 0), PKW(pB1, 2), PKW(pB1, 4), PKW(pB1, 6)}; pw3 = (u32x4){PKW(pB1, 8), PKW(pB1, 10), PKW(pB1, 12), PKW(pB1, 14)};
      SBAR(); pv(o, (int)(unsigned long)vp0 + sl_prev, PAF(0), PAF(1), PAF(2), PAF(3)); }
#undef PKW
#undef PAF
#undef VFR
#undef PIN
#undef MX3
#undef GAPA
#undef GAPB
#undef EX
#undef VRD
#undef KRD
#undef STEP
#undef ENDW
    { auto rr = __builtin_amdgcn_permlane32_swap(__float_as_uint(l_reg), __float_as_uint(l_reg), false, false); l_reg = __uint_as_float(rr[0]) + __uint_as_float(rr[1]); }
    if (hi == 0) wsf[32 + r32] = l_reg; asm volatile("s_waitcnt lgkmcnt(0)" ::: "memory");
    float rli[16];
#pragma unroll
    for (int r = 0; r < 16; ++r) rli[r] = __builtin_amdgcn_rcpf(wsf[32 + crow(r, hi)]);
    bf16_t* Ow = Og + (rowbase + q0 + wid * QBLK) * DMO + h * HD;
    { bf16_t* stg = (bf16_t*)(shm + LDS_OST) + wid * 2048;
#pragma unroll
      for (int r = 0; r < 16; ++r) { const int orow = crow(r, hi);
#pragma unroll
        for (int d0 = 0; d0 < 2; ++d0) stg[orow * 64 + d0 * 32 + r32] = (bf16_t)f2bf(o[d0][r] * rli[r]); }
      asm volatile("s_waitcnt lgkmcnt(0)" ::: "memory");
#pragma unroll
      for (int i = 0; i < 4; ++i) { const int row = i * 8 + (lane >> 3), ch = lane & 7; const u32x4 v = *(const u32x4*)(stg + row * 64 + ch * 8); *(u32x4*)(Ow + (long)row * DMO + ch * 8) = v; } }
    asm volatile("s_waitcnt lgkmcnt(0)\n\ts_barrier" ::: "memory");
#undef DMA_K
#undef DMA_V
#undef TMAP
#undef SETC
#undef START
#undef RESC
#undef ROT
}
#undef SBAR
#undef WAIT_BAR
}

namespace hgrn {
constexpr int RS = 144;
constexpr int R_FQV = 0, FQV_SLOT = 32768;
constexpr int L_Q = 98304, L_K = L_Q + 9216, L_KT = L_K + 9216, L_VT = L_KT + 9216, L_ST = L_VT + 9216, L_SEG = L_ST + 9216, L_DEND = L_SEG + 2048, L_SSQ = L_DEND + 256, L_BYTES = L_SSQ + 512;
__device__ __forceinline__ int crow(int r, int hi) { return (r & 3) + 8 * (r >> 2) + 4 * hi; }
__device__ __forceinline__ void glds16(const void* gsrc, unsigned lds_dst) { unsigned keep;
    asm volatile("s_mov_b32 %0, m0\n\ts_mov_b32 m0, %2\n\ts_nop 0\n\tglobal_load_lds_dwordx4 %1, off\n\ts_mov_b32 m0, %0" : "=&s"(keep) : "v"(gsrc), "s"(lds_dst) : "memory"); }
#define HG_BAR() do { asm volatile("s_waitcnt lgkmcnt(0)" ::: "memory"); __builtin_amdgcn_s_barrier(); asm volatile("" ::: "memory"); } while (0)
#ifndef HG_ABL
#define HG_ABL 0
#endif
__device__ __forceinline__ void hgrn_unit(int b, int h, const bf16_t* __restrict__ proj, bf16_t* __restrict__ mix, const float* __restrict__ lb_logits, const float* __restrict__ norm_g, LAS unsigned char* lds, const int abl = 0) {
    int tid_ = threadIdx.x; asm volatile("" : "+v"(tid_));
    const int tid = tid_, lane = tid & 63, r32 = lane & 31, hi = lane >> 5; const int w = __builtin_amdgcn_readfirstlane(tid >> 6);
    const float lbk = fast_rcp(1.0f + fast_exp2((lb_logits[512 + h * 64 + lane] - lb_logits[h * 64 + lane]) * LOG2E));
    const int vr = (w >> 1) & 1, tc = w & 1;
    float ng[16];
#pragma unroll
    for (int r = 0; r < 16; ++r) ng[r] = norm_g[h * 64 + 32 * vr + crow(r, hi)];
    f32x16 S = f32x16{};
    for (int i = tid; i < 64 * RS / 4; i += 512) ((LAS unsigned*)(lds + L_ST))[i] = 0u;
    const size_t hoff = (size_t)(b * 8 + h) * (SEQ * 64) + (size_t)w * 512 + lane * 8;
    const bf16_t* gQ = proj + 3 * SEC_ELEMS + hoff; const bf16_t* gF = proj + 4 * SEC_ELEMS + hoff; const bf16_t* gV = proj + 5 * SEC_ELEMS + hoff; const bf16_t* gG = proj + 6 * SEC_ELEMS + hoff;
    const unsigned lds0 = (unsigned)(uintptr_t)(unsigned char*)lds;
#define DMA_FQV(c_) do { const int cc_ = (c_) < 63 ? (c_) : 63; const unsigned d_ = (unsigned)__builtin_amdgcn_readfirstlane(lds0 + R_FQV + (unsigned)(((c_) % 3) * FQV_SLOT) + (unsigned)w * 1024u); \
        glds16(gF + (size_t)cc_ * 4096, d_); glds16(gQ + (size_t)cc_ * 4096, d_ + 8192u); glds16(gV + (size_t)cc_ * 4096, d_ + 16384u); } while (0)
#define DMA_G(c_) do { const int cc_ = (c_) < 63 ? (c_) : 63; glds16(gG + (size_t)cc_ * 4096, (unsigned)__builtin_amdgcn_readfirstlane(lds0 + R_FQV + (unsigned)(((c_) % 3) * FQV_SLOT) + 24576u + (unsigned)w * 1024u)); } while (0)
    DMA_FQV(0); DMA_G(0); DMA_FQV(1); DMA_G(1); DMA_FQV(2);
    for (int c = 0; c < 64; ++c) {
        const size_t row0 = (size_t)b * SEQ + (size_t)c * 64;
        if (abl & 8) {} else if (w < 4 && c >= 3) asm volatile("s_waitcnt vmcnt(20)" ::: "memory");
        else asm volatile("s_waitcnt vmcnt(8)" ::: "memory");
        const LAS unsigned char* raw = lds + R_FQV + (c % 3) * FQV_SLOT + (8 * w) * 128 + lane * 2;
        float p[8], kk[8];
        { float run = 0.f;
#pragma unroll
          for (int i = 0; i < 8; ++i) { const float x = bf2f(*(const LAS unsigned short*)(raw + i * 128)); float f, lg;
              if (abl & 2) { f = 0.5f + 0.001f * x; lg = -1.0f + 0.001f * x; } else { const float sg = fast_rcp(1.0f + fast_exp2(-x * LOG2E)); f = lbk + (1.0f - lbk) * sg; lg = __builtin_amdgcn_logf(f); }
              run += lg; p[i] = run; kk[i] = 1.0f - f; } }
        ((LAS float*)(lds + L_SEG))[w * 64 + lane] = p[7];
        HG_BAR();
        if (!(abl & 8)) DMA_G(c + 2);
        { float off = 0.f;
#pragma unroll
          for (int j = 0; j < 7; ++j) { const float sv = ((LAS float*)(lds + L_SEG))[j * 64 + lane]; off += (j < w) ? sv : 0.f; }
          unsigned kq[4], vq[4];
#pragma unroll
          for (int i = 0; i < 8; i += 2) { const float b0 = off + p[i], b1 = off + p[i + 1];
              const unsigned short q0r = *(const LAS unsigned short*)(raw + 8192 + i * 128), q1r = *(const LAS unsigned short*)(raw + 8192 + (i + 1) * 128);
              const unsigned short v0r = *(const LAS unsigned short*)(raw + 16384 + i * 128), v1r = *(const LAS unsigned short*)(raw + 16384 + (i + 1) * 128);
              const float q0 = bf2f(q0r) * fast_exp2(b0), q1 = bf2f(q1r) * fast_exp2(b1), k0 = kk[i] * fast_exp2(-b0), k1 = kk[i + 1] * fast_exp2(-b1);
              const unsigned qq = cvtpk(q0, q1), kw = cvtpk(k0, k1); kq[i >> 1] = kw; vq[i >> 1] = (unsigned)v0r | ((unsigned)v1r << 16);
              if (abl & 4) continue;
              *(LAS unsigned short*)(lds + L_Q + (8 * w + i) * RS + lane * 2) = (unsigned short)(qq & 0xffffu);
              *(LAS unsigned short*)(lds + L_Q + (8 * w + i + 1) * RS + lane * 2) = (unsigned short)(qq >> 16);
              *(LAS unsigned short*)(lds + L_K + (8 * w + i) * RS + lane * 2) = (unsigned short)(kw & 0xffffu);
              *(LAS unsigned short*)(lds + L_K + (8 * w + i + 1) * RS + lane * 2) = (unsigned short)(kw >> 16); }
          *(LAS u32x4*)(lds + L_KT + lane * RS + 16 * w) = (u32x4){kq[0], kq[1], kq[2], kq[3]};
          *(LAS u32x4*)(lds + L_VT + lane * RS + 16 * w) = (u32x4){vq[0], vq[1], vq[2], vq[3]};
          if (w == 7) ((LAS float*)(lds + L_DEND))[lane] = fast_exp2(off + p[7]); }
        if (!(abl & 8)) DMA_FQV(c + 3);
        if (abl & 8) {} else if (w < 4 && c >= 2) asm volatile("s_waitcnt vmcnt(19)" ::: "memory");
        else asm volatile("s_waitcnt vmcnt(11)" ::: "memory");
        HG_BAR();
        f32x16 OT = f32x16{};
        if (abl & 1) { OT[0] = (float)c; } else
        if (w < 4) {
            bf16x8 bq[4];
#pragma unroll
            for (int ks = 0; ks < 4; ++ks) bq[ks] = *(const LAS bf16x8*)(lds + L_Q + (32 * tc + r32) * RS + (16 * ks + 8 * hi) * 2);
#pragma unroll
            for (int sr = 0; sr < 2; ++sr) if (sr <= tc) {
                f32x16 at = f32x16{};
#pragma unroll
                for (int ks = 0; ks < 4; ++ks) { const bf16x8 a = *(const LAS bf16x8*)(lds + L_K + (32 * sr + r32) * RS + (16 * ks + 8 * hi) * 2); at = __builtin_amdgcn_mfma_f32_32x32x16_bf16(a, bq[ks], at, 0, 0, 0); }
                if (sr == tc) {
#pragma unroll
                    for (int r = 0; r < 16; ++r) at[r] = (crow(r, hi) <= r32) ? at[r] : 0.f; }
#pragma unroll
                for (int st = 0; st < 2; ++st) {
                    u32x4 bw; bw.x = cvtpk(at[8 * st + 0], at[8 * st + 1]); bw.y = cvtpk(at[8 * st + 2], at[8 * st + 3]); bw.z = cvtpk(at[8 * st + 4], at[8 * st + 5]); bw.w = cvtpk(at[8 * st + 6], at[8 * st + 7]);
                    const u32x2 lo = *(const LAS u32x2*)(lds + L_VT + (32 * vr + r32) * RS + (32 * sr + 16 * st + 4 * hi) * 2);
                    const u32x2 hh = *(const LAS u32x2*)(lds + L_VT + (32 * vr + r32) * RS + (32 * sr + 16 * st + 8 + 4 * hi) * 2);
                    const u32x4 aw = (u32x4){lo.x, lo.y, hh.x, hh.y};
                    OT = __builtin_amdgcn_mfma_f32_32x32x16_bf16(__builtin_bit_cast(bf16x8, aw), __builtin_bit_cast(bf16x8, bw), OT, 0, 0, 0); }
            }
#pragma unroll
            for (int ks = 0; ks < 4; ++ks) { const bf16x8 a = *(const LAS bf16x8*)(lds + L_ST + (32 * vr + r32) * RS + (16 * ks + 8 * hi) * 2); OT = __builtin_amdgcn_mfma_f32_32x32x16_bf16(a, bq[ks], OT, 0, 0, 0); }
            float sq = 0.f;
#pragma unroll
            for (int r = 0; r < 16; ++r) sq += OT[r] * OT[r];
            sq += __shfl_xor(sq, 32);
            if (hi == 0) ((LAS float*)(lds + L_SSQ))[vr * 64 + 32 * tc + r32] = sq;
        } else {
#pragma unroll
            for (int st = 0; st < 4; ++st) { const bf16x8 a = *(const LAS bf16x8*)(lds + L_KT + (32 * vr + r32) * RS + (16 * st + 8 * hi) * 2);
                const bf16x8 bv = *(const LAS bf16x8*)(lds + L_VT + (32 * tc + r32) * RS + (16 * st + 8 * hi) * 2);
                S = __builtin_amdgcn_mfma_f32_32x32x16_bf16(a, bv, S, 0, 0, 0); }
#pragma unroll
            for (int r = 0; r < 16; ++r) S[r] *= ((LAS float*)(lds + L_DEND))[32 * vr + crow(r, hi)];
        }
        HG_BAR();
        if (w < 4) {
            const int t = 32 * tc + r32;
            const float tot = ((LAS float*)(lds + L_SSQ))[t] + ((LAS float*)(lds + L_SSQ))[64 + t];
            const float rstd = __builtin_amdgcn_rsqf(tot * (1.0f / 64.0f) + EPS);
            const LAS unsigned char* gp = lds + R_FQV + (c % 3) * FQV_SLOT + 24576 + t * 128 + (32 * vr + 4 * hi) * 2;
            bf16_t* op = mix + (row0 + t) * D + 512 + h * 64 + 32 * vr + 4 * hi;
#pragma unroll
            for (int g = 0; g < 4; ++g) { const u32x2 gg = *(const LAS u32x2*)(gp + 16 * g);
                const float y0 = OT[4 * g + 0] * rstd * ng[4 * g + 0] * bflo(gg.x), y1 = OT[4 * g + 1] * rstd * ng[4 * g + 1] * bfhi(gg.x),
                            y2 = OT[4 * g + 2] * rstd * ng[4 * g + 2] * bflo(gg.y), y3 = OT[4 * g + 3] * rstd * ng[4 * g + 3] * bfhi(gg.y);
                const u32x2 yv = (u32x2){cvtpk(y0, y1), cvtpk(y2, y3)}; if (!(abl & 16)) asm volatile("global_store_dwordx2 %0, %1, off" :: "v"(op + 8 * g), "v"(yv) : "memory"); }
        } else {
#pragma unroll
            for (int g = 0; g < 4; ++g) *(LAS u32x2*)(lds + L_ST + (32 * tc + r32) * RS + (32 * vr + 8 * g + 4 * hi) * 2) = (u32x2){cvtpk(S[4 * g + 0], S[4 * g + 1]), cvtpk(S[4 * g + 2], S[4 * g + 3])};
        }
    }
    asm volatile("s_waitcnt vmcnt(0)" ::: "memory");
    HG_BAR();
#undef DMA_FQV
#undef DMA_G
}
#undef HG_BAR
}

constexpr int NWAVES = 8;
constexpr int LDS_BYTES = 163840;
constexpr int TAIL = 161792;
constexpr int TL_TE = TAIL, TL_TS = TAIL + 576, TL_HIST = TAIL + 768, TL_BASE = TAIL + 896, TL_MISC = TAIL + 1024, TL_CNT = TAIL + 1280;
typedef GAS unsigned gu32;

struct Args { const float* in[20]; float* out; unsigned char* ws; int ph_lo, ph_hi; };

struct Frame {
    LAS unsigned char* lds; volatile LAS unsigned* MISC; unsigned* ctl;
    int tid, lane, wave, G, vcu;
};

struct P0Item { const float* W; bf16_t* WT; const float* gain; int N, K, k0, n0, mode; };
constexpr int P0_I_IN = 16 * 56, P0_I_SQ = 16 * 16, P0_I_KV = 16 * 32, P0_I_W1 = 16 * 32, P0_I_W2 = 16 * 16;
constexpr int P0_I_IN8 = 16 * 24;
constexpr int P0_NA = P0_I_IN + P0_I_KV + P0_I_IN8, P0_NB = 2 * P0_I_SQ + NEXP * (P0_I_W1 + P0_I_W2);
template <int SET> __device__ __forceinline__ bool p0_decode(const Args& a, int it, P0Item& I) {
    unsigned char* ws = a.ws;
    if (it >= (SET == 0 ? P0_NA : P0_NB)) return false;
    int r = it; I.gain = nullptr; I.mode = 0; I.K = D;
    if (SET == 0) {
        if (r < P0_I_IN) { I.W = a.in[3]; I.WT = (bf16_t*)(ws + WS_WIN); I.N = INC; I.gain = a.in[2]; }
        else if ((r -= P0_I_IN) < P0_I_KV) { I.W = a.in[10]; I.WT = (bf16_t*)(ws + WS_WKV); I.N = 2 * D; }
        else { r -= P0_I_KV; I.W = a.in[3]; I.WT = (bf16_t*)(ws + WS_WIN8); I.N = INC; I.mode = 2; I.gain = a.in[2]; const int nblk8 = 24; I.k0 = 64 * (r / nblk8); I.n0 = 64 * (r % nblk8); return true; }
    } else {
        if (r < P0_I_SQ) { I.W = a.in[6]; I.WT = (bf16_t*)(ws + WS_WOUT); I.N = D; }
        else if ((r -= P0_I_SQ) < P0_I_SQ) { I.W = a.in[11]; I.WT = (bf16_t*)(ws + WS_WO); I.N = D; }
        else if ((r -= P0_I_SQ) < NEXP * P0_I_W1) { const int e = r / P0_I_W1; r -= e * P0_I_W1; I.W = a.in[15] + (size_t)e * D * 2048; I.WT = (bf16_t*)(ws + WS_W1 + (size_t)e * 2048 * D); I.N = 2048; I.gain = a.in[12]; I.mode = 3; }
        else { r -= NEXP * P0_I_W1; const int e = r / P0_I_W2; r -= e * P0_I_W2; I.W = a.in[17] + (size_t)e * D * D; I.WT = (bf16_t*)(ws + WS_W2 + (size_t)e * D * D); I.N = D; I.mode = 2; }
    }
    const int nblk = I.N / 64; I.k0 = 64 * (r / nblk); I.n0 = 64 * (r % nblk); return true;
}
template <int SET> __device__ __forceinline__ void p0_run(const Args& a, int first, int stride, int count, LAS unsigned char* tl, int lane);
__device__ __forceinline__ void p0_load(const P0Item& I, f32x4 (&v)[16], f32x4 (&g)[4], int lane) {
    const float* base = I.W + (size_t)I.k0 * I.N + I.n0;
    const unsigned vo = (unsigned)((lane >> 4) * I.N + 4 * (lane & 15)) * 4u, rs = (unsigned)(4 * I.N) * 4u;
#pragma unroll
    for (int j = 0; j < 16; ++j) v[j] = pg8::gload128_hidden_nt(base, vo + rs * (unsigned)j);
    const float* gb = I.gain ? I.gain + I.k0 : base; const unsigned go = (unsigned)(lane >> 4) * 4u;
#pragma unroll
    for (int q = 0; q < 4; ++q) { g[q][0] = __uint_as_float(pg8::gload32_hidden(gb, go + (unsigned)(16 * q) * 4u)); g[q][1] = __uint_as_float(pg8::gload32_hidden(gb, go + (unsigned)(16 * q + 4) * 4u));
                                  g[q][2] = __uint_as_float(pg8::gload32_hidden(gb, go + (unsigned)(16 * q + 8) * 4u)); g[q][3] = __uint_as_float(pg8::gload32_hidden(gb, go + (unsigned)(16 * q + 12) * 4u)); }
}
constexpr int P0_LOADS = 32;
__device__ __forceinline__ void p0_store(const P0Item& I, const f32x4 (&v)[16], const f32x4 (&gq)[4], LAS unsigned char* tl, int lane) {
    const int kr = lane >> 4, nq = lane & 15;
#pragma unroll
    for (int j = 0; j < 16; ++j) { const int k = 4 * j + kr; const float g = I.gain ? gq[j >> 2][j & 3] : 1.0f;
        *(LAS u32x2*)(tl + k * 128 + (((nq >> 1) ^ ((k >> 3) & 7)) * 16) + (nq & 1) * 8) = (u32x2){pk2(v[j].x * g, v[j].y * g), pk2(v[j].z * g, v[j].w * g)}; }
    LDS_WAIT(); asm volatile("" ::: "memory");
    const int c = lane & 7;
#pragma unroll
    for (int i = 0; i < 8; ++i) { const int n = (lane >> 3) + 8 * i; const LAS unsigned char* sp = tl + (8 * c) * 128 + ((i ^ c) * 16) + (n & 7) * 2;
        unsigned short e[8];
#pragma unroll
        for (int q = 0; q < 8; ++q) e[q] = *(const LAS unsigned short*)(sp + q * 128);
        int row = I.n0 + n; if (I.mode & 1) { const int jj = row >> 1, bj = row & 1; row = (jj >> 7) * 256 + bj * 128 + (jj & 127); }
        if (I.mode & 2) *(u32x2*)((unsigned char*)I.WT + (size_t)row * I.K + I.k0 + 8 * c) = (u32x2){pk4_fp8(bf2f(e[0]) * WSCALE8, bf2f(e[1]) * WSCALE8, bf2f(e[2]) * WSCALE8, bf2f(e[3]) * WSCALE8), pk4_fp8(bf2f(e[4]) * WSCALE8, bf2f(e[5]) * WSCALE8, bf2f(e[6]) * WSCALE8, bf2f(e[7]) * WSCALE8)};
        else *(u32x4*)(I.WT + (size_t)row * I.K + I.k0 + 8 * c) = (u32x4){(unsigned)e[0] | ((unsigned)e[1] << 16), (unsigned)e[2] | ((unsigned)e[3] << 16), (unsigned)e[4] | ((unsigned)e[5] << 16), (unsigned)e[6] | ((unsigned)e[7] << 16)}; }
    LDS_WAIT(); asm volatile("" ::: "memory");
}
template <bool GAIN> __device__ __forceinline__ void rms_rows2_to_bf16(const float* __restrict__ x0, const float* __restrict__ x1, const float* __restrict__ g, bf16_t* __restrict__ o0, bf16_t* __restrict__ o1, int lane, unsigned char* q0 = nullptr, unsigned char* q1 = nullptr, float* irs = nullptr) {
    const f32x4* xa = (const f32x4*)x0 + lane; const f32x4* xb = (const f32x4*)x1 + lane; const f32x4* gr = (const f32x4*)g + lane;
    f32x4 va[4], vb[4]; float sa = 0.f, sb = 0.f;
#pragma unroll
    for (int j = 0; j < 4; ++j) { va[j] = xa[64 * j]; vb[j] = xb[64 * j]; }
#pragma unroll
    for (int j = 0; j < 4; ++j) { sa += (va[j].x * va[j].x + va[j].y * va[j].y) + (va[j].z * va[j].z + va[j].w * va[j].w); sb += (vb[j].x * vb[j].x + vb[j].y * vb[j].y) + (vb[j].z * vb[j].z + vb[j].w * vb[j].w); }
    const float qa = sqrtf(wave_sum(sa) * (1.0f / D) + EPS), qb = sqrtf(wave_sum(sb) * (1.0f / D) + EPS); const float ra = 1.0f / qa, rb = 1.0f / qb;
    if (irs && lane == 0) { irs[0] = qa; irs[1] = qb; }
    unsigned long long* pa = (unsigned long long*)o0 + lane; unsigned long long* pb = (unsigned long long*)o1 + lane;
#pragma unroll
    for (int j = 0; j < 4; ++j) { const f32x4 gg = GAIN ? gr[64 * j] : (f32x4){1.f, 1.f, 1.f, 1.f};
        if (q0) { ((unsigned*)q0)[lane + 64 * j] = pk4_fp8(va[j].x * ra * gg.x, va[j].y * ra * gg.y, va[j].z * ra * gg.z, va[j].w * ra * gg.w);
                  ((unsigned*)q1)[lane + 64 * j] = pk4_fp8(vb[j].x * rb * gg.x, vb[j].y * rb * gg.y, vb[j].z * rb * gg.z, vb[j].w * rb * gg.w); }
        pa[64 * j] = (unsigned long long)pk2(va[j].x * ra * gg.x, va[j].y * ra * gg.y) | ((unsigned long long)pk2(va[j].z * ra * gg.z, va[j].w * ra * gg.w) << 32);
        pb[64 * j] = (unsigned long long)pk2(vb[j].x * rb * gg.x, vb[j].y * rb * gg.y) | ((unsigned long long)pk2(vb[j].z * rb * gg.z, vb[j].w * rb * gg.w) << 32); }
}

__device__ __forceinline__ void p0_prologue(Frame& F, const Args& a) {
    unsigned char* ws = a.ws;
    LAS unsigned char* tl = F.lds + F.wave * 8192;
    const int gw = F.vcu * NWAVES + F.wave, NGW = F.G * NWAVES;
    for (int m = 2 * gw; m < T; m += 2 * NGW) rms_rows2_to_bf16<false>(a.in[0] + (size_t)m * D, a.in[0] + (size_t)(m + 1) * D, a.in[2], (bf16_t*)(ws + WS_XN) + (size_t)m * D, (bf16_t*)(ws + WS_XN) + (size_t)(m + 1) * D, F.lane, ws + WS_XN8 + (size_t)m * D, ws + WS_XN8 + (size_t)(m + 1) * D, (float*)(ws + WS_RS0) + m);
    for (int m = 2 * gw; m < MROWS; m += 2 * NGW) rms_rows2_to_bf16<true>(a.in[1] + (size_t)m * D, a.in[1] + (size_t)(m + 1) * D, a.in[8], (bf16_t*)(ws + WS_MN) + (size_t)m * D, (bf16_t*)(ws + WS_MN) + (size_t)(m + 1) * D, F.lane);
    for (int i = gw * 64 + F.lane; i < D * D / 4; i += NGW * 64) { const f32x4 w = ((const f32x4*)a.in[9])[i]; const float g = a.in[7][i >> 8];
        ((u32x2*)(ws + WS_WQ))[i] = (u32x2){pk2(w.x * g, w.y * g), pk2(w.z * g, w.w * g)}; }
    for (int i = gw * 64 + F.lane; i < NEXP * D; i += NGW * 64) { const int e = i >> 10, k = i & 1023; const float w = a.in[12][k] * a.in[13][k * NEXP + e];
        const unsigned hi = f2bf(w); ((bf16_t*)(ws + WS_WRT))[i] = (bf16_t)hi; ((bf16_t*)(ws + WS_WRT))[NEXP * D + i] = (bf16_t)f2bf(w - bf2f((unsigned short)hi)); }
    p0_run<0>(a, gw, NGW, (P0_NA - gw + NGW - 1) / NGW, tl, F.lane);
}
#define P0_PIN(vv, gg) do { _Pragma("unroll") for (int j_ = 0; j_ < 16; ++j_) asm volatile("" : "+v"(vv[j_])); _Pragma("unroll") for (int q_ = 0; q_ < 4; ++q_) asm volatile("" : "+v"(gg[q_])); } while (0)
template <int SET> __device__ __forceinline__ void p0_run(const Args& a, int first, int stride, int count, LAS unsigned char* tl, int lane_in) {
    int lane = lane_in; asm volatile("" : "+v"(lane));
    P0Item IA, IB; f32x4 va[16], vb[16], ga[4], gb[4];
    int it = first, left = count; bool ha = left > 0 && p0_decode<SET>(a, it, IA); if (ha) p0_load(IA, va, ga, lane);
    while (ha) {
        const bool hb = left > 1 && p0_decode<SET>(a, it + stride, IB); if (hb) p0_load(IB, vb, gb, lane);
        if (hb) asm volatile("s_waitcnt vmcnt(32)" ::: "memory"); else asm volatile("s_waitcnt vmcnt(0)" ::: "memory");
        P0_PIN(va, ga);
        p0_store(IA, va, ga, tl, lane);
        if (!hb) break;
        it += 2 * stride; left -= 2; ha = left > 0 && p0_decode<SET>(a, it, IA); if (ha) p0_load(IA, va, ga, lane);
        if (ha) asm volatile("s_waitcnt vmcnt(32)" ::: "memory"); else asm volatile("s_waitcnt vmcnt(0)" ::: "memory");
        P0_PIN(vb, gb);
        p0_store(IB, vb, gb, tl, lane);
    }
}
#undef P0_PIN

__device__ __forceinline__ unsigned xcc_id() { return (unsigned)__builtin_amdgcn_s_getreg((3 << 11) | 20) & 0xFu; }
constexpr int QITEMS = 16 + 177;
constexpr int CONV_PER_Q = 49, CONV_TILES = 64;
static_assert(8 * CONV_PER_Q * CONV_TILES == P0_NB, "conversion items cover SET 1 exactly");
__device__ __forceinline__ void p2_mixer(Frame& F, const Args& a, int rep) {
    unsigned char* ws = a.ws;
    const bf16_t* proj = (const bf16_t*)(ws + WS_PROJ); bf16_t* mix = (bf16_t*)(ws + WS_MIX);
    const unsigned x0 = xcc_id() & 7u;
    int par = 0;
#ifdef MK_P2_REPMODE
    if (rep && MK_P2_REPMODE == 4) return;
#endif
#ifdef MK_P2_HALF
    if (rep && (blockIdx.x & 8)) return;
#endif
    for (;;) {
        if (F.tid == 0) { int code = -1;
            for (int j = 0; j < 8; ++j) { const unsigned xq = (x0 + j) & 7u; const unsigned i = __hip_atomic_fetch_add(F.ctl + CW_QUEUE + 1024 * rep + 64 * xq, 1u, RLX_AGENT);
                if (i < (unsigned)QITEMS) { code = (int)(xq * 256u + i); break; } }
            F.MISC[par] = (unsigned)code; }
        LDS_WAIT(); __builtin_amdgcn_s_barrier(); asm volatile("" ::: "memory");
        const int code = __builtin_amdgcn_readfirstlane((int)F.MISC[par]); par ^= 1;
        if (code < 0) break;
        const int xq = code >> 8, i = code & 255;
#ifdef MK_P2_REPMODE
        if (rep && ((MK_P2_REPMODE == 1 && i >= 8) || (MK_P2_REPMODE == 2 && i < 16) || MK_P2_REPMODE == 3)) continue;
        if (rep && MK_P2_REPMODE == 5) { const int jq_ = i - 16; const bool isconv = i >= 16 && jq_ < 2 * CONV_PER_Q && (jq_ & 1); if (!isconv) continue; }
#endif
#ifndef NO_HGRN
        if (i < 8) { hgrn::hgrn_unit(xq, i, proj, rep ? (bf16_t*)(ws + WS_H2F) : mix, a.in[4], a.in[5], F.lds, rep ? HG_ABL : 0); }
        else
#endif
        if (i < 16) {
            pg8::KvOrder S{(const char*)(ws + WS_MN), (const char*)(ws + WS_WKV), xq * 8 + (i - 8)};
            pg8::EpiBf16 E{(bf16_t*)(ws + WS_MEMK), D, (bf16_t*)(ws + WS_MEMVT), D};
            pg8::gemm_phase<pg8::EpiBf16, pg8::KvOrder, false, false>(F.lds, D, D, D / 64, S, E);
        } else
        {
        const int jq = i - 16; int mi = -1, cv = -1;
        if (jq < 2 * CONV_PER_Q) { if (jq & 1) cv = jq >> 1; else mi = jq >> 1; } else mi = jq - CONV_PER_Q;
        if (cv >= 0) {
            const int J = xq * CONV_PER_Q + cv;
            p0_run<1>(a, J * CONV_TILES + F.wave * 8, 1, 8, F.lds + F.wave * 8192, F.lane);
            LDS_WAIT(); VM_WAIT(); __builtin_amdgcn_s_barrier(); asm volatile("" ::: "memory");
        } else
#ifndef NO_MOBA
        { const int j = mi, g = j >> 5, jj = j & 31, hh = 2 * g + (jj & 1), qb = 15 - (jj >> 1);
            moba::attn_unit<8>(xq, hh, qb, proj, proj + SEC_ELEMS, proj + 2 * SEC_ELEMS, mix, (const float*)(ws + WS_KBAR), (char*)(unsigned char*)F.lds); }
#else
        {}
#endif
        }
    }
}

__device__ __forceinline__ void p7_router(Frame& F, const Args& a, int rep) {
    unsigned char* ws = a.ws;
    constexpr int WRS = 2064;
    LAS unsigned char* WH = F.lds; LAS unsigned char* WL = F.lds + 32 * WRS;
    LAS int* hist = (LAS int*)(F.lds + TL_HIST); LAS int* basel = (LAS int*)(F.lds + TL_BASE);
    { const u32x4* src = (const u32x4*)(ws + WS_WRT);
      for (int i = F.tid; i < 2 * NEXP * D / 8; i += 512) { const int m = i >> 12, r = (i >> 7) & 31, c = i & 127; *(LAS u32x4*)(F.lds + m * 32 * WRS + r * WRS + c * 16) = src[i]; } }
    const bf16_t* h2h = (const bf16_t*)(ws + WS_H2F); const unsigned char* h2l = ws + WS_H2F + (size_t)T * D * 2; const float* ss2 = (const float*)(ws + WS_SS2);
    int* toke = (int*)(ws + (rep ? WS_DUMMY + 1 * MiB : WS_TOKE)); int* tokr = (int*)(ws + (rep ? WS_DUMMY + 1 * MiB + 512 * 1024 : WS_TOKR)); float* tokg = (float*)(ws + (rep ? WS_DUMMY + 2 * MiB : WS_TOKG)); int* list = (int*)(ws + (rep ? WS_DUMMY + 4 * MiB : WS_LIST)); float* glist = (float*)(ws + (rep ? WS_DUMMY + 8 * MiB : WS_GLIST)); float* sslist = (float*)(ws + (rep ? WS_DUMMY + 12 * MiB : WS_SSLIST));
    unsigned* cntw = F.ctl + (rep ? CW_CNT + 2048 * rep : CW_CNT);
    const int lane = F.lane, r16 = lane & 15, g4 = lane >> 4;
    const float br0 = a.in[14][r16], br1 = a.in[14][16 + r16];
    for (int tb = blockIdx.x; tb < T / 128; tb += F.G) {
        if (F.tid < 32) hist[F.tid] = 0;
        LDS_WAIT(); __builtin_amdgcn_s_barrier(); asm volatile("" ::: "memory");
        const int t0 = tb * 128 + F.wave * 16;
        const bf16_t* xr = h2h + (size_t)(t0 + r16) * D + 8 * g4; const unsigned char* xl = h2l + (size_t)(t0 + r16) * D + 8 * g4;
        f32x4 acc0 = (f32x4){0.f, 0.f, 0.f, 0.f}, acc1 = acc0;
        u32x4 xa = *(const u32x4*)(xr); u32x2 xb = *(const u32x2*)(xl);
#pragma unroll 4
        for (int ks = 0; ks < 32; ++ks) {
            const u32x4 ca = xa; const u32x2 cb = xb;
            if (ks + 1 < 32) { xa = *(const u32x4*)(xr + 32 * (ks + 1)); xb = *(const u32x2*)(xl + 32 * (ks + 1)); }
            constexpr float LS = 1.0f / 1024.0f;
            const f32x2 c0 = __builtin_amdgcn_cvt_pk_f32_fp8((int)cb.x, false), c1 = __builtin_amdgcn_cvt_pk_f32_fp8((int)cb.x, true), c2 = __builtin_amdgcn_cvt_pk_f32_fp8((int)cb.y, false), c3 = __builtin_amdgcn_cvt_pk_f32_fp8((int)cb.y, true);
            const unsigned l0 = cvtpk(c0.x * LS, c0.y * LS), l1 = cvtpk(c1.x * LS, c1.y * LS), l2 = cvtpk(c2.x * LS, c2.y * LS), l3 = cvtpk(c3.x * LS, c3.y * LS);
            const bf16x8 ah = __builtin_bit_cast(bf16x8, ca), al = __builtin_bit_cast(bf16x8, (u32x4){l0, l1, l2, l3});
            const int bo = r16 * WRS + (32 * ks + 8 * g4) * 2;
            const bf16x8 bh0 = *(const LAS bf16x8*)(WH + bo), bh1 = *(const LAS bf16x8*)(WH + 16 * WRS + bo), bl0 = *(const LAS bf16x8*)(WL + bo), bl1 = *(const LAS bf16x8*)(WL + 16 * WRS + bo);
            acc0 = __builtin_amdgcn_mfma_f32_16x16x32_bf16(ah, bh0, acc0, 0, 0, 0); acc1 = __builtin_amdgcn_mfma_f32_16x16x32_bf16(ah, bh1, acc1, 0, 0, 0);
            acc0 = __builtin_amdgcn_mfma_f32_16x16x32_bf16(ah, bl0, acc0, 0, 0, 0); acc1 = __builtin_amdgcn_mfma_f32_16x16x32_bf16(ah, bl1, acc1, 0, 0, 0);
            acc0 = __builtin_amdgcn_mfma_f32_16x16x32_bf16(al, bh0, acc0, 0, 0, 0); acc1 = __builtin_amdgcn_mfma_f32_16x16x32_bf16(al, bh1, acc1, 0, 0, 0);
        }
        int my_e = 0; float my_g = 0.f;
#pragma unroll
        for (int j = 0; j < 4; ++j) {
            const float rs = __builtin_amdgcn_rsqf(ss2[t0 + 4 * g4 + j] * (1.0f / D) + EPS);
            float a0 = acc0[j] * rs + br0, a1 = acc1[j] * rs + br1; float tv[4]; int te_[4];
#pragma unroll
            for (int k = 0; k < 4; ++k) { float m = fmaxf(a0, a1);
#pragma unroll
                for (int o = 1; o < 16; o <<= 1) m = fmaxf(m, __shfl_xor(m, o));
                int e = (a0 == m) ? r16 : ((a1 == m) ? 16 + r16 : 99);
#pragma unroll
                for (int o = 1; o < 16; o <<= 1) e = min(e, __shfl_xor(e, o));
                tv[k] = m; te_[k] = e; if (e == r16) a0 = -INFINITY; if (e == 16 + r16) a1 = -INFINITY; }
            const float d1 = fast_exp2((tv[1] - tv[0]) * LOG2E), d2 = fast_exp2((tv[2] - tv[0]) * LOG2E), d3 = fast_exp2((tv[3] - tv[0]) * LOG2E);
            const float inv = 1.0f / (1.0f + d1 + d2 + d3);
            if ((r16 >> 2) == j) { const int k = lane & 3; my_e = k == 0 ? te_[0] : (k == 1 ? te_[1] : (k == 2 ? te_[2] : te_[3])); my_g = (k == 0 ? 1.0f : (k == 1 ? d1 : (k == 2 ? d2 : d3))) * inv; }
        }
        const int rl = __hip_atomic_fetch_add(hist + my_e, 1, __ATOMIC_RELAXED, __HIP_MEMORY_SCOPE_WORKGROUP);
        LDS_WAIT(); __builtin_amdgcn_s_barrier(); asm volatile("" ::: "memory");
        if (F.tid < 32) basel[F.tid] = (int)__hip_atomic_fetch_add(cntw + F.tid, (unsigned)hist[F.tid], RLX_AGENT);
        LDS_WAIT(); VM_WAIT(); __builtin_amdgcn_s_barrier(); asm volatile("" ::: "memory");
        { const int t = t0 + 4 * g4 + (r16 >> 2), k = lane & 3; const int rank = basel[my_e] + rl;
          toke[t * 4 + k] = my_e; tokr[t * 4 + k] = rank; tokg[t * 4 + k] = my_g; list[(size_t)my_e * T + rank] = t; glist[(size_t)my_e * T + rank] = my_g; sslist[(size_t)my_e * T + rank] = ss2[t]; }
        LDS_WAIT(); __builtin_amdgcn_s_barrier(); asm volatile("" ::: "memory");
    }
}

__device__ __forceinline__ int build_tables(Frame& F) {
    LAS int* ts = (LAS int*)(F.lds + TL_TS); LAS unsigned char* te = (LAS unsigned char*)(F.lds + TL_TE);
    if (F.tid < NEXP) ((LAS int*)(F.lds + TL_CNT))[F.tid] = (int)__hip_atomic_load(F.ctl + CW_CNT + F.tid, RLX_AGENT);
    LDS_WAIT(); __builtin_amdgcn_s_barrier(); asm volatile("" ::: "memory");
    if (F.tid == 0) { int run = 0;
        for (int e = 0; e < NEXP; ++e) { ts[e] = run; run += (((LAS int*)(F.lds + TL_CNT))[e] + 255) >> 8; }
        ts[NEXP] = run; }
    LDS_WAIT(); __builtin_amdgcn_s_barrier(); asm volatile("" ::: "memory");
    const int nt = ts[NEXP];
    for (int g = F.tid; g < nt; g += 512) { int e = 0;
        for (int j = 1; j < NEXP; ++j) e += (ts[j] <= g) ? 1 : 0;
        te[g] = (unsigned char)e; }
    LDS_WAIT(); __builtin_amdgcn_s_barrier(); asm volatile("" ::: "memory");
    return __builtin_amdgcn_readfirstlane(nt);
}

__device__ __forceinline__ void p10_combine(Frame& F, const Args& a) {
    unsigned char* ws = a.ws;
    LAS int* ts = (LAS int*)(F.lds + TL_TS);
    const bf16_t* h2h = (const bf16_t*)(ws + WS_H2F); const unsigned char* Y = (const unsigned char*)(ws + WS_Y);
    const int* toke = (const int*)(ws + WS_TOKE); const int* tokr = (const int*)(ws + WS_TOKR);
    const float* gf = a.in[19];
    const int gw = F.vcu * NWAVES + F.wave, NGW = F.G * NWAVES, lane = F.lane;
    for (int t0 = 2 * gw; t0 < T; t0 += 2 * NGW) {
        float o[2][16]; u32x2 y[2][4][2];
#pragma unroll
        for (int q = 0; q < 2; ++q) { const int t = t0 + q;
#pragma unroll
            for (int k = 0; k < 4; ++k) { const int e = toke[t * 4 + k], r = tokr[t * 4 + k]; const unsigned char* yr = Y + ((size_t)ts[e] * 256 + r) * D;
                y[q][k][0] = *(const u32x2*)(yr + 8 * lane); y[q][k][1] = *(const u32x2*)(yr + 512 + 8 * lane); }
            const u32x4 a0 = *(const u32x4*)(h2h + (size_t)t * D + 8 * lane), a2 = *(const u32x4*)(h2h + (size_t)t * D + 512 + 8 * lane);
            o[q][0] = bflo(a0.x); o[q][1] = bfhi(a0.x); o[q][2] = bflo(a0.y); o[q][3] = bfhi(a0.y); o[q][4] = bflo(a0.z); o[q][5] = bfhi(a0.z); o[q][6] = bflo(a0.w); o[q][7] = bfhi(a0.w);
            o[q][8] = bflo(a2.x); o[q][9] = bfhi(a2.x); o[q][10] = bflo(a2.y); o[q][11] = bfhi(a2.y); o[q][12] = bflo(a2.z); o[q][13] = bfhi(a2.z); o[q][14] = bflo(a2.w); o[q][15] = bfhi(a2.w); }
#pragma unroll
        for (int q = 0; q < 2; ++q) {
#pragma unroll
            for (int k = 0; k < 4; ++k)
#pragma unroll
                for (int hf = 0; hf < 2; ++hf) { const u32x2 w = y[q][k][hf];
                    const f32x2 c0 = __builtin_amdgcn_cvt_pk_f32_fp8((int)w.x, false), c1 = __builtin_amdgcn_cvt_pk_f32_fp8((int)w.x, true), c2 = __builtin_amdgcn_cvt_pk_f32_fp8((int)w.y, false), c3 = __builtin_amdgcn_cvt_pk_f32_fp8((int)w.y, true);
                    o[q][8 * hf + 0] += pg8::YSCALE_INV * c0.x; o[q][8 * hf + 1] += pg8::YSCALE_INV * c0.y; o[q][8 * hf + 2] += pg8::YSCALE_INV * c1.x; o[q][8 * hf + 3] += pg8::YSCALE_INV * c1.y;
                    o[q][8 * hf + 4] += pg8::YSCALE_INV * c2.x; o[q][8 * hf + 5] += pg8::YSCALE_INV * c2.y; o[q][8 * hf + 6] += pg8::YSCALE_INV * c3.x; o[q][8 * hf + 7] += pg8::YSCALE_INV * c3.y; }
            float s = 0.f;
#pragma unroll
            for (int j = 0; j < 16; ++j) s += o[q][j] * o[q][j];
            const float rstd = 1.0f / sqrtf(wave_sum(s) * (1.0f / D) + EPS);
            float* op = a.out + (size_t)(t0 + q) * D;
#pragma unroll
            for (int v = 0; v < 4; ++v) { const int col = (v >> 1) * 512 + 8 * lane + (v & 1) * 4; const f32x4 g4 = *(const f32x4*)(gf + col);
                *(f32x4*)(op + col) = (f32x4){o[q][4 * v] * rstd * g4.x, o[q][4 * v + 1] * rstd * g4.y, o[q][4 * v + 2] * rstd * g4.z, o[q][4 * v + 3] * rstd * g4.w}; }
        }
    }
}

#define XB_TMO      128
#define XB_XCNT(j)  (256  + 64 * (j))
#define XB_XSUB(j)  (1280 + 64 * (j))
#define XB_XGEN(j)  (2304 + 64 * (j))
#define XB_TOP      3328
#define XB_TOPGEN   3392
#define XCD_BAR_WORDS 3456
#define XB_SPIN_CAP (1u << 22)
__device__ __forceinline__ unsigned xb_ld(unsigned* p)              { return __hip_atomic_load(p, __ATOMIC_RELAXED, __HIP_MEMORY_SCOPE_AGENT); }
__device__ __forceinline__ unsigned xb_add(unsigned* p, unsigned v) { return __hip_atomic_fetch_add(p, v, __ATOMIC_RELAXED, __HIP_MEMORY_SCOPE_AGENT); }
#define XB_SPIN(cond, bar) do { unsigned _sp = 0; while (cond) { __builtin_amdgcn_s_sleep(1); \
    if ((++_sp & 255u) == 0u) { if (xb_ld(&(bar)[XB_TMO])) break; if (_sp > XB_SPIN_CAP) { atomicAdd(&(bar)[XB_TMO], 1u); break; } } } } while (0)
struct XcdBarrier { unsigned* bar; unsigned x; volatile LAS unsigned* st; };
__device__ __forceinline__ XcdBarrier xcd_barrier_post(unsigned* bar, volatile LAS unsigned* st) {
    XcdBarrier b; b.bar = bar; b.x = (unsigned)__builtin_amdgcn_s_getreg((3 << 11) | 20) & 0xFu; b.st = st;
    if (threadIdx.x == 0) (void)xb_add(&bar[XB_XCNT(b.x)], 1u);
    return b;
}
__device__ __forceinline__ void xcd_barrier_complete(unsigned* bar, unsigned x, unsigned& nloc, unsigned& nx) {
    const unsigned G = gridDim.x * gridDim.y * gridDim.z;
    unsigned sum, cnt, mine, sp = 0u;
    for (;;) {
        sum = 0u; cnt = 0u; mine = 0u;
#pragma unroll
        for (unsigned j = 0; j < 16; ++j) { const unsigned c = xb_ld(&bar[XB_XCNT(j)]); sum += c; cnt += (c > 0u) ? 1u : 0u; mine = (j == x) ? c : mine; }
        if (sum == G) break;
        __builtin_amdgcn_s_sleep(1);
        if ((++sp & 255u) == 0u) { if (xb_ld(&bar[XB_TMO])) break; if (sp > XB_SPIN_CAP) { atomicAdd(&bar[XB_TMO], 1u); break; } }
    }
    nloc = mine > 0u ? mine : 1u; nx = cnt > 0u ? cnt : 1u;
}
__device__ __forceinline__ void xcd_barrier(const XcdBarrier& b) {
    asm volatile("s_waitcnt vmcnt(0)" ::: "memory");
    __syncthreads();
    if (threadIdx.x == 0) {
        unsigned* bar = b.bar;
        __builtin_amdgcn_s_waitcnt(0);
        unsigned nloc = b.st[0], nx = b.st[1];
        if (nloc == 0u) { xcd_barrier_complete(bar, b.x, nloc, nx); b.st[0] = nloc; b.st[1] = nx; }
        const unsigned old = xb_add(&bar[XB_XSUB(b.x)], 1u);
        const unsigned gen = old / nloc;
        if (old + 1u == (gen + 1u) * nloc) {
            __builtin_amdgcn_fence(__ATOMIC_RELEASE, "agent");
            asm volatile("s_waitcnt vmcnt(0)" ::: "memory");
            const unsigned og = xb_add(&bar[XB_TOP], 1u);
            const unsigned tg = og / nx;
            if (og + 1u == (tg + 1u) * nx) xb_add(&bar[XB_TOPGEN], 1u);
            else XB_SPIN(xb_ld(&bar[XB_TOPGEN]) == tg, bar);
            __builtin_amdgcn_fence(__ATOMIC_ACQUIRE, "agent");
            xb_add(&bar[XB_XGEN(b.x)], 1u);
            asm volatile("s_waitcnt vmcnt(0)" ::: "memory");
        } else {
            XB_SPIN(xb_ld(&bar[XB_XGEN(b.x)]) == gen, bar);
            __builtin_amdgcn_fence(__ATOMIC_ACQUIRE, "agent");
            asm volatile("s_waitcnt vmcnt(0)" ::: "memory");
        }
    }
    __syncthreads();
}
#ifndef MK_CG_ONLY
#define MK_CG_ONLY 0
#endif
__device__ __forceinline__ void grid_barrier(Frame& F, const XcdBarrier& xb_) { if (MK_CG_ONLY) cg::this_grid().sync(); else xcd_barrier(xb_); }
#ifndef MK_PHASE_MASK
#define MK_PHASE_MASK 0x7ff
#endif
#ifndef MK_REP_PHASE
#define MK_REP_PHASE -1
#endif
#ifndef MK_REP_N
#define MK_REP_N 0
#endif
__device__ __forceinline__ void ph0(Frame& F, const Args& args, int rep) { p0_prologue(F, args); }
__device__ __forceinline__ void ph1(Frame& F, const Args& args, int rep) {
    unsigned char* ws = args.ws; const int cid = (int)blockIdx.x;
    { pg8::DenseOrder S{(const char*)(ws + WS_XN8), (const char*)(ws + WS_WIN8), D / 2, D / 2, T / 256, 6, F.G, cid, 0};
      pg8::EpiProj E{(bf16_t*)(ws + WS_PROJ), rep ? (float*)(ws + WS_DUMMY) : (float*)(ws + WS_KBAR), WSCALE8_INV};
      pg8::gemm_phase<pg8::EpiProj, pg8::DenseOrder, false, true, true>(F.lds, D / 2, D / 2, D / 128, S, E); }
    { pg8::DenseOrder S{(const char*)(ws + WS_XN), (const char*)(ws + WS_WIN + (size_t)1536 * D * 2), D, D, T / 256, 8, F.G, cid, 6};
      pg8::EpiProj E{(bf16_t*)(ws + WS_PROJ), rep ? (float*)(ws + WS_DUMMY) : (float*)(ws + WS_KBAR), 1.0f};
      pg8::gemm_phase<pg8::EpiProj, pg8::DenseOrder, false, true>(F.lds, D, D, D / 64, S, E); }
}
__device__ __forceinline__ void ph2(Frame& F, const Args& args, int rep) { p2_mixer(F, args, rep); }
constexpr size_t WS_MB = WS_PROJ, WS_NB = WS_PROJ + 16 * MiB, WS_H1Q = WS_PROJ + 32 * MiB, WS_PB = WS_QX;
constexpr size_t WS_UNUSED_XA = 0;
constexpr int LDS_XTAB = 131072;
__device__ __forceinline__ void ph3(Frame& F, const Args& args, int rep) {
    unsigned char* ws = args.ws; const int cid = (int)blockIdx.x;
    pg8::P3Order S{pg8::XmnOrder{(const char*)(ws + WS_MEMK), (const char*)(ws + WS_MEMVT), (const char*)(ws + WS_WQ), (const char*)(ws + WS_WO), F.G, cid},
                   pg8::DenseOrder{(const char*)(ws + WS_MIX), (const char*)(ws + WS_WOUT), D, D, T / 256, D / 256, F.G, cid, 0}};
    pg8::EpiP3 E{pg8::EpiFp8{(unsigned char*)(ws + WS_MB), D, (unsigned char*)(ws + WS_NB), D, XSCALE8},
                 pg8::EpiRes<false, 0, false, true>{(const void*)(ws + WS_XN), (bf16_t*)(ws + WS_H1B), nullptr, rep ? (float*)(ws + WS_DUMMY + 512 * 1024) : (float*)(ws + WS_SS1), 1.0f, (unsigned char*)(ws + WS_H1Q), (const float*)(ws + WS_RS0)}};
    pg8::gemm_phase<pg8::EpiP3, pg8::P3Order, false, true>(F.lds, D, D, D / 64, S, E);
}
__device__ __forceinline__ void ph4(Frame& F, const Args& args, int rep) {
    unsigned char* ws = args.ws; const int cid = (int)blockIdx.x;
    pg8::XbOrder S{(const char*)(ws + WS_H1Q), (const char*)(ws + WS_MB), F.G, cid, (size_t)D};
    pg8::EpiSoftmaxS E{(unsigned char*)(ws + WS_PB), (const float*)(ws + WS_SS1), F.lds + LDS_XTAB, XSCALE8_INV};
    pg8::gemm_phase<pg8::EpiSoftmaxS, pg8::XbOrder, false, true, true>(F.lds, D / 2, D / 2, D / 128, S, E);
}
__device__ __forceinline__ void ph5(Frame& F, const Args& args, int rep) {}
__device__ __forceinline__ void ph6(Frame& F, const Args& args, int rep) {
    unsigned char* ws = args.ws; const int cid = (int)blockIdx.x;
    pg8::XbOrder S{(const char*)(ws + WS_PB), (const char*)(ws + WS_NB), F.G, cid, (size_t)D};
    pg8::EpiRes<false, 2, true> E{(const void*)(ws + WS_H1B), (bf16_t*)(ws + WS_H2B), (float*)(ws + WS_H2F), rep ? (float*)(ws + WS_DUMMY + 512 * 1024) : (float*)(ws + WS_SS2), PSCALE8_INV * XSCALE8_INV, nullptr};
    pg8::gemm_phase<pg8::EpiRes<false, 2, true>, pg8::XbOrder, false, true, true>(F.lds, D / 2, D / 2, D / 128, S, E);
}
__device__ __forceinline__ void ph7(Frame& F, const Args& args, int rep) { p7_router(F, args, rep); }
__device__ __forceinline__ void ph8(Frame& F, const Args& args, int rep) {
    unsigned char* ws = args.ws; const int cid = (int)blockIdx.x;
    const int ntl = build_tables(F);
    pg8::MoeOrder S{(const char*)(ws + WS_H2B), (const char*)(ws + WS_W1), (const int*)(ws + WS_LIST), (const LAS int*)(F.lds + TL_CNT), (const LAS unsigned char*)(F.lds + TL_TE), (const LAS int*)(F.lds + TL_TS),
                    ntl, 8, F.G, cid, (size_t)2048 * D, 1, (size_t)256 * D, (size_t)256 * D};
    pg8::EpiW1 E{(bf16_t*)(ws + WS_HMID), (const float*)(ws + WS_SSLIST), args.in[16], (const int*)(ws + WS_LIST)};
    pg8::gemm_phase<pg8::EpiW1, pg8::MoeOrder, true, true, true>(F.lds, D / 2, D / 2, D / 128, S, E);
}
__device__ __forceinline__ void ph9(Frame& F, const Args& args, int rep) {
    unsigned char* ws = args.ws; const int cid = (int)blockIdx.x;
    const int ntl = build_tables(F);
    pg8::MoeOrder S{(const char*)(ws + WS_HMID), (const char*)(ws + WS_W2), (const int*)(ws + WS_LIST), (const LAS int*)(F.lds + TL_CNT), (const LAS unsigned char*)(F.lds + TL_TE), (const LAS int*)(F.lds + TL_TS),
                    ntl, 4, F.G, cid, (size_t)D * D, 0, (size_t)256 * D, (size_t)256 * D};
    pg8::EpiW2 E{(unsigned char*)(ws + WS_Y), args.in[18], (const int*)(ws + WS_LIST), (const float*)(ws + WS_GLIST)};
    pg8::gemm_phase<pg8::EpiW2, pg8::MoeOrder, false, true, true>(F.lds, D / 2, D / 2, D / 128, S, E);
}
__device__ __forceinline__ void ph10(Frame& F, const Args& args, int rep) { (void)build_tables(F); p10_combine(F, args); }

constexpr int N_PHASES = 11;
__global__ void __launch_bounds__(NWAVES * 64, 2) hymba_fwd(Args args) {
    extern __shared__ __attribute__((aligned(16))) unsigned char lds_raw[];
    Frame F;
    F.lds = (LAS unsigned char*)lds_raw;
    F.MISC = (volatile LAS unsigned*)(F.lds + TL_MISC);
    F.tid = threadIdx.x; F.lane = F.tid & 63; F.wave = __builtin_amdgcn_readfirstlane(F.tid >> 6);
    F.G = gridDim.x; { const int bx = blockIdx.x; F.vcu = (F.G % 8 == 0) ? (bx % 8) * (F.G / 8) + bx / 8 : bx; }
    F.ctl = (unsigned*)(args.ws + WS_CTL);
    const int lo = args.ph_lo, hi = args.ph_hi;
    for (int u = F.tid; u < 64; u += NWAVES * 64) ((LAS unsigned*)(F.lds + TL_MISC))[u] = 0u;
    __syncthreads();
    const XcdBarrier xbar = xcd_barrier_post(F.ctl + CW_BAR, F.MISC + 8);
#define RUN(k, fn) do { if (((MK_PHASE_MASK >> (k)) & 1) && lo <= (k) && (k) < hi) { fn(F, args, 0); \
        if (MK_REP_PHASE == (k) && MK_REP_N >= 1) { grid_barrier(F, xbar); fn(F, args, 1); } \
        if (MK_REP_PHASE == (k) && MK_REP_N >= 2) { grid_barrier(F, xbar); fn(F, args, 2); } \
        if ((k) + 1 < hi) { grid_barrier(F, xbar); } } } while (0)
    if (args.ph_lo < 0) cg::this_grid().sync();
    RUN(0, ph0); RUN(1, ph1); RUN(2, ph2); RUN(3, ph3); RUN(4, ph4);   RUN(6, ph6); RUN(7, ph7); RUN(8, ph8); RUN(9, ph9); RUN(10, ph10);
#undef RUN
}

extern "C" void kernel_launch(void* const* d_in, const int* in_sizes, int n_in, void* d_out, int out_size, void* d_ws, size_t ws_size, hipStream_t stream) {
    static int grid = 0;
    if (grid == 0) {
        if (n_in != 20 || in_sizes[0] != T * D || out_size != T * D || ws_size < WS_END) {
            fprintf(stderr, "kernel_launch: shape/workspace mismatch (n_in %d, in0 %d, out %d, ws %zu, need %zu)\n", n_in, n_in > 0 ? in_sizes[0] : -1, out_size, ws_size, (size_t)WS_END); grid = -1; return; }
        int dev = 0, cus = 0, per_cu = 0;
        if (hipGetDevice(&dev) != hipSuccess || hipDeviceGetAttribute(&cus, hipDeviceAttributeMultiprocessorCount, dev) != hipSuccess) { grid = -1; return; }
        if (hipFuncSetAttribute((const void*)hymba_fwd, hipFuncAttributeMaxDynamicSharedMemorySize, LDS_BYTES) != hipSuccess) { fprintf(stderr, "kernel_launch: hipFuncSetAttribute failed\n"); grid = -1; return; }
        if (hipOccupancyMaxActiveBlocksPerMultiprocessor(&per_cu, (const void*)hymba_fwd, NWAVES * 64, LDS_BYTES) != hipSuccess || per_cu < 1) { fprintf(stderr, "kernel_launch: occupancy query says %d\n", per_cu); }
        (void)hipGetLastError();
        grid = cus;
        if (grid != 256) fprintf(stderr, "kernel_launch: %d CUs; this kernel is built for 256\n", grid);
    }
    if (grid < 0) return;
    (void)hipMemsetAsync((char*)d_ws + WS_CTL, 0, CTL_ZERO_BYTES, stream);
    Args a{};
    for (int i = 0; i < 20; ++i) a.in[i] = (const float*)d_in[i];
    a.out = (float*)d_out; a.ws = (unsigned char*)d_ws;
#if MK_N_LAUNCHES == 1
    a.ph_lo = 0; a.ph_hi = MK_LAST_PHASE + 1;
    void* kargs[] = {&a};
    hipError_t e = hipLaunchCooperativeKernel((const void*)hymba_fwd, dim3(grid), dim3(NWAVES * 64), kargs, LDS_BYTES, stream);
    if (e != hipSuccess) fprintf(stderr, "kernel_launch: cooperative launch failed: %s\n", hipGetErrorString(e));
#else
    for (int p = 0; p <= MK_LAST_PHASE; ++p) { a.ph_lo = p; a.ph_hi = p + 1; hipLaunchKernelGGL(hymba_fwd, dim3(grid), dim3(NWAVES * 64), LDS_BYTES, stream, a); }
#endif
}
```

```cpp
#include <hip/hip_runtime.h>
#include <hip/hip_cooperative_groups.h>
#include <cstdio>
#include <cstdint>
namespace cg = cooperative_groups;

#ifndef MK_N_LAUNCHES
#define MK_N_LAUNCHES 1
#endif
#ifndef MK_LAST_PHASE
#define MK_LAST_PHASE 10
#endif

#define LAS __attribute__((address_space(3)))
#define GAS __attribute__((address_space(1)))
typedef unsigned short bf16_t;
typedef short bf16x8 __attribute__((ext_vector_type(8)));
typedef short s16x4 __attribute__((ext_vector_type(4)));
typedef float f32x4 __attribute__((ext_vector_type(4)));
typedef float f32x2 __attribute__((ext_vector_type(2)));
typedef float f32x16 __attribute__((ext_vector_type(16)));
typedef unsigned u32x4 __attribute__((ext_vector_type(4)));
typedef unsigned u32x2 __attribute__((ext_vector_type(2)));
typedef int v8i32_t __attribute__((ext_vector_type(8)));

constexpr int BATCH = 8, SEQ = 4096, T = BATCH * SEQ, D = 1024, INC = 3584, NMEM = 256, MROWS = BATCH * NMEM;
constexpr int NEXP = 32, TOPK = 4, MT_MAX = T * TOPK / 256 + NEXP, MPAD = MT_MAX * 256;
constexpr float EPS = 1e-6f;
constexpr float LOG2E = 1.4426950408889634f;
constexpr float C2Q = 0.125f * LOG2E;
constexpr float C2X = 0.0625f * LOG2E;
constexpr int C_MQ = 0, C_MK = 512, C_MV = 1024, C_GQ = 1536, C_GF = 2048, C_GI = 2560, C_GG = 3072;

constexpr size_t MiB = 1u << 20;
constexpr size_t WS_CTL = 0, CTL_ZERO_BYTES = 2 * MiB;
constexpr size_t WS_KBAR = 1 * MiB;
constexpr size_t WS_SS1 = 1 * MiB + 256 * 1024;
constexpr size_t WS_SS2 = 1 * MiB + 384 * 1024;
constexpr size_t WS_RS0 = 1 * MiB + 512 * 1024;
constexpr size_t WS_TOKE = 2 * MiB, WS_TOKR = 2 * MiB + 512 * 1024, WS_TOKG = 3 * MiB;
constexpr size_t WS_WRT = 3 * MiB + 512 * 1024;
constexpr size_t WS_LIST = 4 * MiB;
constexpr size_t WS_GLIST = 8 * MiB;
constexpr size_t WS_DLIST = 16 * MiB;
constexpr size_t WS_SSLIST = 12 * MiB;
constexpr size_t WS_WIN8 = 14 * MiB;
constexpr size_t WS_WIN = 16 * MiB, WS_WOUT = 23 * MiB, WS_WQ = 25 * MiB, WS_WKV = 27 * MiB, WS_WO = 31 * MiB;
constexpr size_t WS_MN = 33 * MiB, WS_MEMK = 37 * MiB, WS_MEMVT = 41 * MiB;
constexpr size_t WS_W1 = 48 * MiB, WS_W2 = 176 * MiB;
constexpr size_t WS_PROJ = 240 * MiB;
constexpr size_t SEC_ELEMS = (size_t)16 * 1024 * 1024;
constexpr size_t WS_XN = 464 * MiB;
constexpr size_t WS_OX = 464 * MiB;
constexpr size_t WS_XN8 = 528 * MiB;
constexpr size_t WS_MIX = 528 * MiB;
constexpr size_t WS_H1B = 592 * MiB;
constexpr size_t WS_QX = 656 * MiB;
constexpr size_t WS_PWS = 720 * MiB;
constexpr size_t WS_HMID = 240 * MiB;
constexpr size_t WS_Y = 512 * MiB;
constexpr size_t WS_H2F = 784 * MiB;
constexpr size_t WS_H2B = 912 * MiB;
constexpr size_t WS_DUMMY = 976 * MiB;
constexpr size_t WS_END = 992 * MiB;
static_assert(WS_HMID + (size_t)MPAD * D * 2 <= WS_Y && WS_Y + (size_t)MPAD * D * 2 <= WS_H2F, "ws map");
constexpr int CW_TMO = 0;
constexpr int CW_CNT = 64;
constexpr int CW_QUEUE = 128;
constexpr int CW_BAR = 4096;

__device__ __forceinline__ unsigned f2bf(float f) { unsigned u = __builtin_bit_cast(unsigned, f); return (u + 0x7fffu + ((u >> 16) & 1u)) >> 16; }
__device__ __forceinline__ unsigned pk2(float lo, float hi) { return f2bf(lo) | (f2bf(hi) << 16); }
__device__ __forceinline__ float bf2f(unsigned short h) { return __builtin_bit_cast(float, (unsigned)h << 16); }
__device__ __forceinline__ float bflo(unsigned w) { return __builtin_bit_cast(float, w << 16); }
__device__ __forceinline__ float bfhi(unsigned w) { return __builtin_bit_cast(float, w & 0xffff0000u); }
typedef float f32x2_t __attribute__((ext_vector_type(2))); typedef __bf16 bf16x2_t __attribute__((ext_vector_type(2)));
__device__ __forceinline__ unsigned cvtpk(float lo, float hi) { f32x2_t v = {lo, hi}; bf16x2_t b = __builtin_convertvector(v, bf16x2_t); return __builtin_bit_cast(unsigned, b); }
template <int CTRL> __device__ __forceinline__ float dpp_f(float v) { return __int_as_float(__builtin_amdgcn_update_dpp(__float_as_int(v), __float_as_int(v), CTRL, 0xF, 0xF, true)); }
template <int CTRL> __device__ __forceinline__ int dpp_i(int v) { return __builtin_amdgcn_update_dpp(v, v, CTRL, 0xF, 0xF, true); }
__device__ __forceinline__ float row16_sum(float v) { v += dpp_f<0xB1>(v); v += dpp_f<0x4E>(v); v += dpp_f<0x141>(v); v += dpp_f<0x140>(v); return v; }
__device__ __forceinline__ float row16_max(float v) { v = fmaxf(v, dpp_f<0xB1>(v)); v = fmaxf(v, dpp_f<0x4E>(v)); v = fmaxf(v, dpp_f<0x141>(v)); v = fmaxf(v, dpp_f<0x140>(v)); return v; }
__device__ __forceinline__ int row16_min(int v) { v = min(v, dpp_i<0xB1>(v)); v = min(v, dpp_i<0x4E>(v)); v = min(v, dpp_i<0x141>(v)); v = min(v, dpp_i<0x140>(v)); return v; }
__device__ __forceinline__ float half32_sum(float v) { const auto u = __builtin_amdgcn_permlane32_swap(__float_as_uint(v), __float_as_uint(v), false, false); return __uint_as_float(u[0]) + __uint_as_float(u[1]); }
__device__ __forceinline__ float xrow_sum(float v) { const auto r = __builtin_amdgcn_permlane16_swap(__float_as_uint(v), __float_as_uint(v), false, false); return half32_sum(__uint_as_float(r[0]) + __uint_as_float(r[1])); }
__device__ __forceinline__ float xrow_max(float v) { const auto r = __builtin_amdgcn_permlane16_swap(__float_as_uint(v), __float_as_uint(v), false, false); const float t = fmaxf(__uint_as_float(r[0]), __uint_as_float(r[1]));
    const auto u = __builtin_amdgcn_permlane32_swap(__float_as_uint(t), __float_as_uint(t), false, false); return fmaxf(__uint_as_float(u[0]), __uint_as_float(u[1])); }
__device__ __forceinline__ float wave_sum(float v) { return xrow_sum(row16_sum(v)); }
__device__ __forceinline__ float fast_exp2(float x) { return __builtin_amdgcn_exp2f(x); }
__device__ __forceinline__ float fast_rcp(float x) { return __builtin_amdgcn_rcpf(x); }
__device__ __forceinline__ float silu_f(float x) { return x * fast_rcp(1.0f + fast_exp2(-x * LOG2E)); }
__device__ __forceinline__ unsigned pk4_fp8(float a, float b, float c, float d) { int w = 0; w = __builtin_amdgcn_cvt_pk_fp8_f32(a, b, w, false); w = __builtin_amdgcn_cvt_pk_fp8_f32(c, d, w, true); return (unsigned)w; }
constexpr float XSCALE8 = 4.0f, XSCALE8_INV = 0.25f, PSCALE8 = 256.0f, PSCALE8_INV = 1.0f / 256.0f;
__device__ __forceinline__ f32x4 dec4_fp8(unsigned w) { const f32x2 a = __builtin_amdgcn_cvt_pk_f32_fp8((int)w, false), b = __builtin_amdgcn_cvt_pk_f32_fp8((int)w, true); return (f32x4){a.x, a.y, b.x, b.y}; }
constexpr float MIXS8 = 8.0f, MIXS8_INV = 1.0f / 8.0f;
constexpr float WSCALE8 = 32.0f, WSCALE8_INV = 1.0f / 32.0f;
#define LDS_WAIT() asm volatile("s_waitcnt lgkmcnt(0)" ::: "memory")
#define VM_WAIT() asm volatile("s_waitcnt vmcnt(0)" ::: "memory")
#define RLX_AGENT __ATOMIC_RELAXED, __HIP_MEMORY_SCOPE_AGENT

namespace pg8 {
constexpr int BM = 256, BK = 64, HALF = 128, HTB = HALF * BK * 2, STAGE_BYTES = 8 * HTB;
__device__ __forceinline__ unsigned gload32_hidden(const void* sbase, unsigned voff) { unsigned v; asm volatile("global_load_dword %0, %1, %2" : "=v"(v) : "v"(voff), "s"(sbase) : "memory"); return v; }
__device__ __forceinline__ u32x2 gload64_hidden(const void* sbase, unsigned voff) { u32x2 v; asm volatile("global_load_dwordx2 %0, %1, %2" : "=v"(v) : "v"(voff), "s"(sbase) : "memory"); return v; }
__device__ __forceinline__ f32x4 gload128_hidden(const void* sbase, unsigned voff) { f32x4 v; asm volatile("global_load_dwordx4 %0, %1, %2" : "=v"(v) : "v"(voff), "s"(sbase) : "memory"); return v; }
__device__ __forceinline__ f32x4 gload128_hidden_nt(const void* sbase, unsigned voff) { f32x4 v; asm volatile("global_load_dwordx4 %0, %1, %2 nt" : "=v"(v) : "v"(voff), "s"(sbase) : "memory"); return v; }
__device__ __forceinline__ void glds16s(const char* sbase, unsigned voff, unsigned lds_dst) {
    asm volatile("s_mov_b32 m0, %2\n\ts_nop 0\n\tglobal_load_lds_dwordx4 %0, %1" :: "v"(voff), "s"(sbase), "s"(lds_dst) : "memory", "m0"); }
__host__ __device__ __forceinline__ int lds_byte(int r, int c) { const int st = (r >> 4) * 2 + (c >> 5), rr = r & 15, cc = c & 31, ob = rr * 64 + cc * 2; return st * 1024 + (ob ^ (((ob >> 9) & 1) << 5)); }
__host__ __device__ __forceinline__ void stage_rc(int b, int& R, int& C) { const int st = b / 1024, sb = b % 1024, swz = sb ^ (((sb >> 9) & 1) << 5); R = (st >> 1) * 16 + swz / 64; C = (st & 1) * 32 + (swz % 64) / 2; }
__host__ __device__ __forceinline__ int perm32(int rho) { const int n = rho >> 4, i = rho & 15; return 8 * (i >> 2) + 4 * n + (i & 3); }

struct Unit { const char* A; const char* B; const int* rows; int pm, pn, aux, nrows, ntu; };

template <class Epi, class Sched, bool GATHER, bool ALIGN_EPI, bool FP8 = false>
__device__ __forceinline__ void gemm_phase(LAS unsigned char* lds, const int lda, const int ldb, const int nt_in, const Sched S, const Epi E) {
    int nt = nt_in; asm volatile("" : "+s"(nt));
    int tid_ = threadIdx.x; asm volatile("" : "+v"(tid_));
    const int tid = tid_, wid = __builtin_amdgcn_readfirstlane(tid >> 6), lane = tid & 63, wr = wid >> 2, wc = wid & 3, fr = lane & 15, fq = lane >> 4;
    unsigned offB0; { int R, C; stage_rc(tid * 16, R, C); const int Rb = Epi::PERM ? ((R & ~31) + perm32(R & 31)) : R; offB0 = (unsigned)(Rb * ldb + C) * 2u; }
    const size_t pstepB = (size_t)64 * ldb * 2;
    const size_t kstep = (size_t)(BK * 2);
    const size_t hstepB = (size_t)HALF * ldb * 2;
    const unsigned ldsb = (unsigned)__builtin_amdgcn_readfirstlane((int)((unsigned)(uintptr_t)(unsigned char*)lds + (unsigned)wid * 1024u));
    const int aoff = lds_byte(wr * 64 + fr, FP8 ? fq * 16 : fq * 8), boff = lds_byte(wc * 32 + fr, FP8 ? fq * 16 : fq * 8);
#define PG8_SA(b, h) (((b) * 2 + (h)) * HTB)
#define PG8_SB(b, h) ((4 + (b) * 2 + (h)) * HTB)
#define PG8_STGB(bufoff, gbase) do { glds16s((const char*)(gbase), offB0, ldsb + (unsigned)(bufoff)); glds16s((const char*)(gbase) + pstepB, offB0, ldsb + (unsigned)(bufoff) + 8192u); } while (0)
#define PG8_LD16(p_) (*(const LAS u32x4*)(p_))
#define PG8_CAT(x, y) __builtin_bit_cast(v8i32_t, __builtin_shufflevector(x, y, 0, 1, 2, 3, 4, 5, 6, 7))
    unsigned aA0 = (unsigned)(aoff + PG8_SA(0, 0)), aA1 = (unsigned)(aoff + PG8_SA(1, 0)), bB0 = (unsigned)(boff + PG8_SB(0, 0)), bB1 = (unsigned)(boff + PG8_SB(1, 0));
    asm volatile("" : "+v"(aA0), "+v"(aA1), "+v"(bB0), "+v"(bB1));
    int scl8 = 0x7f7f7f7f; asm volatile("" : "+v"(scl8));
#define PG8_LDA(dst, b, h) do { const LAS unsigned char* ap_ = lds + ((b) ? aA1 : aA0) + (h) * HTB; _Pragma("unroll") for (int m = 0; m < 4; ++m) { \
        if constexpr (FP8) { dst##8[m] = PG8_CAT(PG8_LD16(ap_ + m * 2048), PG8_LD16(ap_ + m * 2048 + 16)); } \
        else { _Pragma("unroll") for (int k = 0; k < 2; ++k) dst[m][k] = *(const LAS bf16x8*)(ap_ + m * 2048 + k * 1024); } } } while (0)
#define PG8_LDB(dst, b, h) do { const LAS unsigned char* bp_ = lds + ((b) ? bB1 : bB0) + (h) * HTB; _Pragma("unroll") for (int n = 0; n < 2; ++n) { \
        if constexpr (FP8) { dst##8[n] = PG8_CAT(PG8_LD16(bp_ + n * 2048), PG8_LD16(bp_ + n * 2048 + 16)); } \
        else { _Pragma("unroll") for (int k = 0; k < 2; ++k) dst[n][k] = *(const LAS bf16x8*)(bp_ + n * 2048 + k * 1024); } } } while (0)
#define PG8_MMA(ai, bj, At, Bt) do { __builtin_amdgcn_s_setprio(1); _Pragma("unroll") for (int m = 0; m < 4; ++m) _Pragma("unroll") for (int n = 0; n < 2; ++n) { \
        if constexpr (FP8) asm volatile("v_mfma_scale_f32_16x16x128_f8f6f4 %0, %1, %2, %0, %3, %3 op_sel_hi:[0,0,0]" : "+v"(acc[ai][bj][m][n]) : "v"(Bt##8[n]), "v"(At##8[m]), "v"(scl8));   \
        else { _Pragma("unroll") for (int k = 0; k < 2; ++k) acc[ai][bj][m][n] = __builtin_amdgcn_mfma_f32_16x16x32_bf16(Bt[n][k], At[m][k], acc[ai][bj][m][n], 0, 0, 0); } } \
        __builtin_amdgcn_s_setprio(0); } while (0)
#define PG8_MMAZ(ai, bj, At, Bt) do { __builtin_amdgcn_s_setprio(1); _Pragma("unroll") for (int m = 0; m < 4; ++m) _Pragma("unroll") for (int n = 0; n < 2; ++n) { \
        if constexpr (FP8) asm volatile("v_mfma_scale_f32_16x16x128_f8f6f4 %0, %1, %2, 0, %3, %3 op_sel_hi:[0,0,0]" : "=&v"(acc[ai][bj][m][n]) : "v"(Bt##8[n]), "v"(At##8[m]), "v"(scl8)); \
        else { acc[ai][bj][m][n] = __builtin_amdgcn_mfma_f32_16x16x32_bf16(Bt[n][0], At[m][0], (f32x4){0.f, 0.f, 0.f, 0.f}, 0, 0, 0); acc[ai][bj][m][n] = __builtin_amdgcn_mfma_f32_16x16x32_bf16(Bt[n][1], At[m][1], acc[ai][bj][m][n], 0, 0, 0); } } \
        __builtin_amdgcn_s_setprio(0); } while (0)
#define PG8_WAIT_V(n) asm volatile("s_waitcnt vmcnt(" #n ")" ::: "memory")
#define PG8_WAIT_L(n) asm volatile("s_waitcnt lgkmcnt(" #n ")" ::: "memory")
#define PG8_BAR __builtin_amdgcn_s_barrier()
#define PG8_SCHED __builtin_amdgcn_sched_barrier(0)
    unsigned voffA0, c2, pkc[2], pkn[2], praw[4];
    { int R, C; stage_rc(tid * 16, R, C); voffA0 = (unsigned)(R * lda + C) * 2u; c2 = (unsigned)C * 2u; }
    const size_t hstepA = (size_t)HALF * lda * 2, pstepA = (size_t)64 * lda * 2;
    const unsigned lda2 = (unsigned)lda * 2u;
#define PG8_PKROWS(dst, u) do { if (GATHER) { _Pragma("unroll") for (int i_ = 0; i_ < 2; ++i_) { int R_, C_; stage_rc(tid * 16 + i_ * 8192, R_, C_); \
        const int nr_ = (u).nrows - 1; const int r0_ = R_ < nr_ ? R_ : nr_, r1_ = (R_ + HALF) < nr_ ? (R_ + HALF) : nr_; \
        dst[i_] = (unsigned)(u).rows[r0_] | ((unsigned)(u).rows[r1_] << 16); } } } while (0)
#define PG8_RAWROWS(u) do { if (GATHER) { _Pragma("unroll") for (int i_ = 0; i_ < 2; ++i_) { int R_, C_; stage_rc(tid * 16 + i_ * 8192, R_, C_); \
        const int nr_ = (u).nrows - 1; const int r0_ = R_ < nr_ ? R_ : nr_, r1_ = (R_ + HALF) < nr_ ? (R_ + HALF) : nr_; \
        praw[2 * i_] = gload32_hidden((u).rows, (unsigned)r0_ * 4u); praw[2 * i_ + 1] = gload32_hidden((u).rows, (unsigned)r1_ * 4u); } } } while (0)
#define PG8_PACKRAW(dst) do { unsigned a0_ = praw[0], a1_ = praw[1], a2_ = praw[2], a3_ = praw[3]; asm volatile("" : "+v"(a0_), "+v"(a1_), "+v"(a2_), "+v"(a3_)); \
        dst[0] = a0_ | (a1_ << 16); dst[1] = a2_ | (a3_ << 16); } while (0)
#define PG8_STGA(bufoff, gbase, h, NX) do { \
        if (GATHER) { const unsigned p0_ = (NX) ? pkn[0] : pkc[0], p1_ = (NX) ? pkn[1] : pkc[1]; \
            const unsigned o0_ = ((h) ? (p0_ >> 16) : (p0_ & 0xffffu)) * lda2 + c2, o1_ = ((h) ? (p1_ >> 16) : (p1_ & 0xffffu)) * lda2 + c2; \
            glds16s((const char*)(gbase), o0_, ldsb + (unsigned)(bufoff)); glds16s((const char*)(gbase), o1_, ldsb + (unsigned)(bufoff) + 8192u); } \
        else { const char* gb_ = (const char*)(gbase) + ((h) ? hstepA : (size_t)0); glds16s(gb_, voffA0, ldsb + (unsigned)(bufoff)); glds16s(gb_ + pstepA, voffA0, ldsb + (unsigned)(bufoff) + 8192u); } } while (0)
    Unit cur, nxt; int ui = 0;
    if (!S.next(0, cur)) return;
    f32x4 acc[2][2][4][2];
#pragma unroll
    for (int a = 0; a < 2; ++a)
#pragma unroll
        for (int b = 0; b < 2; ++b)
#pragma unroll
            for (int m = 0; m < 4; ++m)
#pragma unroll
                for (int n = 0; n < 2; ++n) acc[a][b][m][n] = (f32x4){0.f, 0.f, 0.f, 0.f};
    bf16x8 At[4][2], B0[2][2], B1[2][2]; v8i32_t At8[4], B08[2], B18[2];
    pkc[0] = pkc[1] = pkn[0] = pkn[1] = 0u; praw[0] = praw[1] = praw[2] = praw[3] = 0u;
    PG8_PKROWS(pkc, cur);
    const char* cA = cur.A; const char* cB = cur.B;
    PG8_STGB(PG8_SB(0, 0), cB); PG8_STGB(PG8_SB(0, 1), cB + hstepB); PG8_STGA(PG8_SA(0, 0), cA, 0, false); PG8_STGA(PG8_SA(0, 1), cA, 1, false);
    if (wr == 1) PG8_BAR;
    PG8_WAIT_V(2); PG8_BAR;
    PG8_STGB(PG8_SB(1, 0), cB + kstep); PG8_STGB(PG8_SB(1, 1), cB + hstepB + kstep);
    PG8_WAIT_V(4); PG8_BAR;
    for (;;) {
        const bool has_next = S.next(ui + 1, nxt);
        if (GATHER) { if (has_next) { PG8_RAWROWS(nxt); } }
        const char* nA = has_next ? nxt.A : cA; const char* nB = has_next ? nxt.B : cB;
        typename Epi::Pre pre; { int t_p = threadIdx.x; asm volatile("" : "+v"(t_p)); E.prefetch(cur, wr, wc, t_p & 15, (t_p >> 4) & 3, pre); }
        const int ntc = cur.ntu ? cur.ntu : nt;
        for (int t = 0; t < ntc; t += 2) {
            const bool last = (t == ntc - 2);
            if (GATHER) { pkn[0] = pkc[0]; pkn[1] = pkc[1]; if (last && has_next) { PG8_PACKRAW(pkn); } }
            const char* a1 = cA + (size_t)(t + 1) * kstep;
            const char* a2 = last ? nA : cA + (size_t)(t + 2) * kstep; const char* b2 = last ? nB : cB + (size_t)(t + 2) * kstep;
            const char* a3 = a2 + kstep; const char* b3 = b2 + kstep;
            PG8_LDB(B0, 0, 0); PG8_LDB(B1, 0, 1); PG8_SCHED; PG8_LDA(At, 0, 0); PG8_STGA(PG8_SA(1, 0), a1, 0, false); PG8_STGA(PG8_SA(1, 1), a1, 1, false);
            PG8_WAIT_V(8); PG8_WAIT_L(0); PG8_BAR; if (t == 0) { PG8_MMAZ(0, 0, At, B0); PG8_MMAZ(0, 1, At, B1); } else { PG8_MMA(0, 0, At, B0); PG8_MMA(0, 1, At, B1); } PG8_BAR; PG8_SCHED;
            PG8_LDA(At, 0, 1); PG8_STGB(PG8_SB(0, 0), b2); PG8_STGB(PG8_SB(0, 1), b2 + hstepB);
            PG8_WAIT_V(6); PG8_WAIT_L(0); PG8_BAR; if (t == 0) { PG8_MMAZ(1, 0, At, B0); PG8_MMAZ(1, 1, At, B1); } else { PG8_MMA(1, 0, At, B0); PG8_MMA(1, 1, At, B1); } PG8_BAR; PG8_SCHED;
            PG8_LDB(B0, 1, 0); PG8_LDB(B1, 1, 1); PG8_SCHED; PG8_LDA(At, 1, 0); PG8_STGA(PG8_SA(0, 0), a2, 0, last); PG8_STGA(PG8_SA(0, 1), a2, 1, last);
            PG8_WAIT_V(8); PG8_WAIT_L(0); PG8_BAR; PG8_MMA(0, 0, At, B0); PG8_MMA(0, 1, At, B1); PG8_BAR; PG8_SCHED;
            PG8_LDA(At, 1, 1); PG8_STGB(PG8_SB(1, 0), b3); PG8_STGB(PG8_SB(1, 1), b3 + hstepB);
            PG8_WAIT_V(6); PG8_WAIT_L(0); PG8_BAR; PG8_MMA(1, 0, At, B0); PG8_MMA(1, 1, At, B1); PG8_BAR; PG8_SCHED;
        }
        if constexpr (ALIGN_EPI) { if (wr == 0) PG8_BAR; }
        if constexpr (FP8) asm volatile("s_nop 15\n\ts_nop 15" ::: "memory");
        if constexpr (!Epi::AFTER_DRAIN) { int t_e = threadIdx.x; asm volatile("" : "+v"(t_e)); const int fr_e = t_e & 15, fq_e = (t_e >> 4) & 3; E(acc, cur, wr, wc, fr_e, fq_e, pre); }
        if (!has_next) break;
        cur = nxt; cA = nA; cB = nB; ++ui;
        if (GATHER) { PG8_PACKRAW(pkc); }
        if constexpr (ALIGN_EPI) { if (wr == 1) PG8_BAR; }
    }
    PG8_WAIT_V(0);
    if constexpr (!ALIGN_EPI) { if (wr == 0) PG8_BAR; }
    PG8_BAR;
    if constexpr (Epi::AFTER_DRAIN) { int t_e = threadIdx.x; asm volatile("" : "+v"(t_e)); const int fr_e = t_e & 15, fq_e = (t_e >> 4) & 3; E.fused(acc, cur, wr, wc, fr_e, fq_e, lds, wid, t_e & 63); }
#undef PG8_SA
#undef PG8_SB
#undef PG8_STGB
#undef PG8_LDA
#undef PG8_LDB
#undef PG8_MMA
#undef PG8_MMAZ
#undef PG8_CAT
#undef PG8_LD16
#undef PG8_WAIT_V
#undef PG8_WAIT_L
#undef PG8_SCHED
#undef PG8_PKROWS
#undef PG8_RAWROWS
#undef PG8_PACKRAW
#undef PG8_STGA
}
}

namespace pg8 {
constexpr int NXCD = 8, WGM = 8;
__device__ __forceinline__ void tile_order(int L, int nM, int nN, int& pm, int& pn) {
    const int nwg = nM * nN; int wgid = L;
    { const int q = nwg / NXCD, r = nwg % NXCD, xcd = wgid % NXCD, off = wgid / NXCD; wgid = (xcd < r ? xcd * (q + 1) : r * (q + 1) + (xcd - r) * q) + off; }
    const int nig = WGM * nN, gid = wgid / nig, fm = gid * WGM, gsz = (nM - fm) < WGM ? (nM - fm) : WGM;
    pm = fm + ((wgid % nig) % gsz); pn = (wgid % nig) / gsz;
}
struct DenseOrder {
    const char* A; const char* B; int lda, ldb, nM, nN, G, c, pn0;
    __device__ __forceinline__ bool next(int i, Unit& u) const {
        const long L = (long)i * G + c; if (L >= (long)nM * nN) return false;
        int pm, pn; tile_order((int)L, nM, nN, pm, pn);
        u.pm = pm; u.pn = pn + pn0; u.aux = 0; u.rows = nullptr; u.nrows = 256; u.ntu = 0;
        u.A = A + (size_t)pm * 256 * lda * 2; u.B = B + (size_t)pn * 256 * ldb * 2; return true;
    }
};
struct KvOrder {
    const char* MN; const char* W; int L0;
    __device__ __forceinline__ bool next(int i, Unit& u) const {
        const int L = L0; if (i > 0 || L >= 64) return false;
        u.rows = nullptr; u.nrows = 256; u.ntu = 0; u.pm = L >> 3; const int ct = L & 7; u.aux = ct >> 2; u.pn = ct & 3;
        u.A = MN + (size_t)u.pm * 256 * D * 2; u.B = W + (size_t)ct * 256 * D * 2; return true;
    }
};
struct XmnOrder {
    const char* MK; const char* MV; const char* WQN; const char* WOT; int G, c;
    __device__ __forceinline__ bool next(int i, Unit& u) const {
        const int L = c + i * G; if (L >= 256) return false;
        u.rows = nullptr; u.nrows = 256; u.ntu = 0;
        if (L < 128) { const int b = L >> 4, h = (L >> 2) & 3, kt = L & 3; u.aux = 0; u.pm = b * 4 + h; u.pn = kt;
            u.A = MK + ((size_t)(b * 256) * D + h * 256) * 2; u.B = WQN + ((size_t)(kt * 256) * D + h * 256) * 2; }
        else { const int l = L - 128, b = l >> 4, nt = (l >> 2) & 3, h = l & 3; u.aux = 1; u.pm = b * 4 + nt; u.pn = h;
            u.A = WOT + ((size_t)(nt * 256) * D + h * 256) * 2; u.B = MV + ((size_t)(b * 256) * D + h * 256) * 2; }
        return true;
    }
};
struct P3Order {
    XmnOrder X; DenseOrder Dn;
    __device__ __forceinline__ bool next(int i, Unit& u) const {
        if (i == 0 && X.c < 256) { X.next(0, u); u.ntu = 4; return true; }
        const bool ok = Dn.next(X.c < 256 ? i - 1 : i, u); u.aux = 2; return ok;
    }
};
struct XbOrder {
    const char* A; const char* Bb; int G, c; size_t rb;
    __device__ __forceinline__ bool next(int i, Unit& u) const {
        const long L = (long)i * G + c; if (L >= 512) return false;
        int pm, pn; tile_order((int)L, T / 256, 4, pm, pn);
        u.pm = pm; u.pn = pn; u.aux = 0; u.rows = nullptr; u.nrows = 256; u.ntu = 0;
        u.A = A + (size_t)pm * 256 * rb; u.B = Bb + (size_t)(pm >> 4) * D * rb + (size_t)pn * 256 * rb; return true;
    }
};
struct MoeOrder {
    const char* A; const char* W; const int* list; const LAS int* cnt; const LAS unsigned char* te; const LAS int* ts;
    int ntiles, nN, G, c; size_t wstride; int gather; size_t atile, btile;
    __device__ __forceinline__ bool next(int i, Unit& u) const {
        const long L = (long)i * G + c; if (L >= (long)ntiles * nN) return false;
        int pm, pn; tile_order((int)L, ntiles, nN, pm, pn);
        const int e = __builtin_amdgcn_readfirstlane((int)te[pm]);
        const int lt = pm - __builtin_amdgcn_readfirstlane(ts[e]);
        const int n = __builtin_amdgcn_readfirstlane(cnt[e]) - lt * 256;
        u.pm = pm; u.pn = pn; u.aux = e; u.nrows = n < 256 ? n : 256; u.ntu = 0;
        u.rows = list + (size_t)e * T + lt * 256;
        u.A = gather ? A : A + (size_t)pm * atile;
        u.B = W + (size_t)e * wstride + (size_t)pn * btile; return true;
    }
};

struct EpiProj {
    static constexpr bool PERM = true, AFTER_DRAIN = false; struct Pre {}; __device__ __forceinline__ void prefetch(const Unit&, int, int, int, int, Pre&) const {}
    bf16_t* O; float* kbar; float asc;
    __device__ __forceinline__ void operator()(const f32x4 (&acc)[2][2][4][2], const Unit& u, int wr, int wc, int fr, int fq, const Pre&) const {
        const int pn = u.pn, sec = pn >> 1, b = u.pm >> 4, t0 = (u.pm & 15) * 256 + wr * 64 + fr;
        const int mode = (pn < 2) ? 1 : ((pn == 6 || pn == 7 || pn >= 12) ? 2 : 0);
        const float sc1 = (mode == 1) ? asc * C2Q : asc;
        bf16_t* sb = O + (size_t)sec * SEC_ELEMS;
#pragma unroll
        for (int bj = 0; bj < 2; ++bj) {
            const int c = bj * HALF + wc * 32 + 8 * fq, head = (pn & 1) * 4 + (c >> 6), d0 = c & 63;
            bf16_t* hb = sb + (size_t)(b * 8 + head) * (SEQ * 64);
#pragma unroll
            for (int ai = 0; ai < 2; ++ai)
#pragma unroll
                for (int m = 0; m < 4; ++m) { const int t = t0 + ai * HALF + m * 16;
                    f32x4 v0 = acc[ai][bj][m][0], v1 = acc[ai][bj][m][1];
                    if (sc1 != 1.0f) { v0 = v0 * sc1; v1 = v1 * sc1; }
                    if (mode == 2) {
#pragma unroll
                        for (int e = 0; e < 4; ++e) { v0[e] = silu_f(v0[e]); v1[e] = silu_f(v1[e]); } }
                    u32x4 w; w.x = cvtpk(v0[0], v0[1]); w.y = cvtpk(v0[2], v0[3]); w.z = cvtpk(v1[0], v1[1]); w.w = cvtpk(v1[2], v1[3]);
                    size_t off;
                    if (sec == 1) off = (size_t)(t >> 6) * 4096 + (d0 >> 3) * 512 + (t & 63) * 8;
                    else if (sec == 2) off = (size_t)(t >> 6) * 4096 + (d0 >> 5) * 2048 + (t & 63) * 32 + (d0 & 31);
                    else off = (size_t)t * 64 + d0;
                    *(u32x4*)(hb + off) = w; } }
        if (pn == 2 || pn == 3) {
#pragma unroll
            for (int bj = 0; bj < 2; ++bj)
#pragma unroll
                for (int n = 0; n < 2; ++n)
#pragma unroll
                    for (int e = 0; e < 4; ++e) { float s = 0.f;
#pragma unroll
                        for (int ai = 0; ai < 2; ++ai)
#pragma unroll
                            for (int m = 0; m < 4; ++m) s += acc[ai][bj][m][n][e];
                        s = row16_sum(s) * asc;
                        if (fr == 0) { const int c = bj * HALF + wc * 32 + 8 * fq + 4 * n + e, head = (pn - 2) * 4 + (c >> 6), d = c & 63;
                            atomicAdd(kbar + ((size_t)u.pm * 8 + head) * 64 + d, s); } }
        }
    }
};
struct EpiBf16 {
    static constexpr bool PERM = true, AFTER_DRAIN = false; struct Pre {}; __device__ __forceinline__ void prefetch(const Unit&, int, int, int, int, Pre&) const {}
    bf16_t* O0; int ldc0; bf16_t* O1; int ldc1;
    __device__ __forceinline__ void operator()(const f32x4 (&acc)[2][2][4][2], const Unit& u, int wr, int wc, int fr, int fq, const Pre&) const {
        bf16_t* O = u.aux ? O1 : O0; const int ldc = u.aux ? ldc1 : ldc0;
        const int row0 = u.pm * BM + wr * 64 + fr, col0 = u.pn * BM + wc * 32 + 8 * fq;
#pragma unroll
        for (int ai = 0; ai < 2; ++ai)
#pragma unroll
            for (int m = 0; m < 4; ++m) { bf16_t* rowp = O + (size_t)(row0 + ai * HALF + m * 16) * ldc + col0;
#pragma unroll
                for (int bj = 0; bj < 2; ++bj) { const f32x4 v0 = acc[ai][bj][m][0], v1 = acc[ai][bj][m][1];
                    u32x4 w; w.x = cvtpk(v0[0], v0[1]); w.y = cvtpk(v0[2], v0[3]); w.z = cvtpk(v1[0], v1[1]); w.w = cvtpk(v1[2], v1[3]);
                    *(u32x4*)(rowp + bj * HALF) = w; } }
    }
};
struct EpiFp8 {
    static constexpr bool PERM = true, AFTER_DRAIN = false; struct Pre {}; __device__ __forceinline__ void prefetch(const Unit&, int, int, int, int, Pre&) const {}
    unsigned char* O0; int ldc0; unsigned char* O1; int ldc1; float scale;
    __device__ __forceinline__ void operator()(const f32x4 (&acc)[2][2][4][2], const Unit& u, int wr, int wc, int fr, int fq, const Pre&) const {
        unsigned char* O = u.aux ? O1 : O0; const int ldc = u.aux ? ldc1 : ldc0;
        const int row0 = u.pm * BM + wr * 64 + fr; unsigned sv[2][2];
#pragma unroll
        for (int ai = 0; ai < 2; ++ai)
#pragma unroll
            for (int m = 0; m < 4; ++m) {
#pragma unroll
                for (int bj = 0; bj < 2; ++bj) { const f32x4 v0 = acc[ai][bj][m][0] * scale, v1 = acc[ai][bj][m][1] * scale;
                    const unsigned ca = pk4_fp8(v0[0], v0[1], v0[2], v0[3]), cb = pk4_fp8(v1[0], v1[1], v1[2], v1[3]);
                    if (!(m & 1)) { sv[bj][0] = ca; sv[bj][1] = cb; }
                    else { const auto s0 = __builtin_amdgcn_permlane16_swap(sv[bj][0], ca, false, false), s1 = __builtin_amdgcn_permlane16_swap(sv[bj][1], cb, false, false);
                        *(u32x4*)(O + (size_t)(row0 + ai * HALF + (m - 1 + (fq & 1)) * 16) * ldc + u.pn * BM + wc * 32 + 16 * (fq >> 1) + bj * HALF) = (u32x4){s0[0], s1[0], s0[1], s1[1]}; } } }
    }
};
constexpr float PL1 = 16.0f, PL1_INV = 1.0f / 16.0f, PL2 = 256.0f, PL2_INV = 1.0f / 256.0f;
template <int BASE, int OUT, bool BASE_RS = false> struct EpiRes {
    static constexpr bool PERM = true, AFTER_DRAIN = false; struct Pre {}; __device__ __forceinline__ void prefetch(const Unit&, int, int, int, int, Pre&) const {}
    const void* base; bf16_t* Ob; float* Of; float* ss; unsigned char* Oq; const float* brs; const void* base2; float asc;
    static constexpr int LPG = BASE == 1 ? 2 : 4;
    __device__ __forceinline__ void issue(f32x4 (&b)[4], unsigned voff) const {
        if (BASE == 0) { b[0] = gload128_hidden(base, voff); b[1] = gload128_hidden(base, voff + 16u); b[2] = gload128_hidden(base, voff + HALF * 4u); b[3] = gload128_hidden(base, voff + HALF * 4u + 16u); }
        else if (BASE == 1) { b[0] = gload128_hidden(base, voff); b[1] = gload128_hidden(base, voff + HALF * 2u); }
    }
    __device__ __forceinline__ void issue8(u32x2 (&b)[4], unsigned voff) const {
        b[0] = gload64_hidden(base, voff); b[1] = gload64_hidden(base2, voff); b[2] = gload64_hidden(base, voff + HALF); b[3] = gload64_hidden(base2, voff + HALF);
    }
    __device__ __forceinline__ void operator()(const f32x4 (&acc)[2][2][4][2], const Unit& u, int wr, int wc, int fr, int fq, const Pre&) const {
        const int row0 = u.pm * BM + wr * 64 + fr, col0 = u.pn * BM + wc * 32 + 8 * fq;
        const unsigned esz = BASE == 0 ? 4u : (BASE == 1 ? 2u : 1u);
        f32x4 lb[8][4]; u32x2 l8[8][4]; unsigned sv[3][2][2];
#define ER_VOFF(g_) ((unsigned)((row0 + ((g_) >> 2) * HALF + ((g_) & 3) * 16) * D + col0) * esz)
        float rsv[8];
        if (BASE_RS) {
#pragma unroll
            for (int g = 0; g < 8; ++g) rsv[g] = __uint_as_float(gload32_hidden(brs, (unsigned)(row0 + (g >> 2) * HALF + (g & 3) * 16) * 4u)); }
#pragma unroll
        for (int g = 0; g < 4; ++g) { if (BASE == 2) issue8(l8[g], ER_VOFF(g)); else issue(lb[g], ER_VOFF(g)); }
#pragma unroll
        for (int g = 0; g < 8; ++g) { const int ai = g >> 2, m = g & 3; const int row = row0 + ai * HALF + m * 16; const size_t off = (size_t)row * D + col0; float sq = 0.f;
            { const int newer = (7 - g < 3 ? 7 - g : 3) * LPG;
              if (newer == 12) asm volatile("s_waitcnt vmcnt(12)" ::: "memory"); else if (newer == 8) asm volatile("s_waitcnt vmcnt(8)" ::: "memory"); else if (newer == 6) asm volatile("s_waitcnt vmcnt(6)" ::: "memory");
              else if (newer == 4) asm volatile("s_waitcnt vmcnt(4)" ::: "memory"); else if (newer == 2) asm volatile("s_waitcnt vmcnt(2)" ::: "memory"); else asm volatile("s_waitcnt vmcnt(0)" ::: "memory"); }
#pragma unroll
            for (int q = 0; q < LPG; ++q) { if (BASE == 2) asm volatile("" : "+v"(l8[g][q])); else asm volatile("" : "+v"(lb[g][q])); }
            if (BASE_RS && g == 0) {
#pragma unroll
                for (int q = 0; q < 8; ++q) asm volatile("" : "+v"(rsv[q])); }
#pragma unroll
            for (int bj = 0; bj < 2; ++bj) { f32x4 b0, b1;
                if (BASE == 0) { b0 = lb[g][2 * bj]; b1 = lb[g][2 * bj + 1]; }
                else if (BASE == 1) { const u32x4 w = __builtin_bit_cast(u32x4, lb[g][bj]);
                    b0 = (f32x4){bflo(w.x), bfhi(w.x), bflo(w.y), bfhi(w.y)}; b1 = (f32x4){bflo(w.z), bfhi(w.z), bflo(w.w), bfhi(w.w)};
                    if (BASE_RS) { b0 = b0 * rsv[g]; b1 = b1 * rsv[g]; } }
                else { const u32x2 wq = l8[g][2 * bj], wr_ = l8[g][2 * bj + 1];
                    b0 = dec4_fp8(wq.x) + dec4_fp8(wr_.x) * PL1_INV; b1 = dec4_fp8(wq.y) + dec4_fp8(wr_.y) * PL1_INV; }
                const f32x4 v0 = acc[ai][bj][m][0] * asc + b0, v1 = acc[ai][bj][m][1] * asc + b1;
                sq += (v0[0] * v0[0] + v0[1] * v0[1]) + (v0[2] * v0[2] + v0[3] * v0[3]) + (v1[0] * v1[0] + v1[1] * v1[1]) + (v1[2] * v1[2] + v1[3] * v1[3]);
                if (OUT == 1) { u32x4 w; w.x = cvtpk(v0[0], v0[1]); w.y = cvtpk(v0[2], v0[3]); w.z = cvtpk(v1[0], v1[1]); w.w = cvtpk(v1[2], v1[3]);
                    *(u32x4*)(Ob + off + bj * HALF) = w;
                    if (Oq) *(u32x2*)(Oq + off + bj * HALF) = (u32x2){pk4_fp8(v0[0], v0[1], v0[2], v0[3]), pk4_fp8(v1[0], v1[1], v1[2], v1[3])}; }
                else { unsigned cur[3][2];
                    cur[0][0] = pk4_fp8(v0[0], v0[1], v0[2], v0[3]); cur[0][1] = pk4_fp8(v1[0], v1[1], v1[2], v1[3]);
                    const f32x4 e0 = (v0 - dec4_fp8(cur[0][0])) * PL1, e1 = (v1 - dec4_fp8(cur[0][1])) * PL1;
                    cur[1][0] = pk4_fp8(e0[0], e0[1], e0[2], e0[3]); cur[1][1] = pk4_fp8(e1[0], e1[1], e1[2], e1[3]);
                    if (OUT == 3) { const f32x4 f0 = (e0 - dec4_fp8(cur[1][0])) * (PL2 * PL1_INV), f1 = (e1 - dec4_fp8(cur[1][1])) * (PL2 * PL1_INV);
                        cur[2][0] = pk4_fp8(f0[0], f0[1], f0[2], f0[3]); cur[2][1] = pk4_fp8(f1[0], f1[1], f1[2], f1[3]); }
                    if (!(m & 1)) {
#pragma unroll
                        for (int pl = 0; pl < OUT; ++pl) { sv[pl][bj][0] = cur[pl][0]; sv[pl][bj][1] = cur[pl][1]; } }
                    else { const size_t offw = (size_t)(row0 + ai * HALF + (m - 1 + (fq & 1)) * 16) * D + u.pn * BM + wc * 32 + 16 * (fq >> 1) + bj * HALF;
#pragma unroll
                        for (int pl = 0; pl < OUT; ++pl) { unsigned char* pp = pl == 0 ? (OUT == 2 ? Oq : (unsigned char*)Ob) : (pl == 1 ? (OUT == 2 ? (unsigned char*)Ob : (unsigned char*)Of) : (unsigned char*)Of + (size_t)T * D);
                            const auto s0 = __builtin_amdgcn_permlane16_swap(sv[pl][bj][0], cur[pl][0], false, false), s1 = __builtin_amdgcn_permlane16_swap(sv[pl][bj][1], cur[pl][1], false, false);
                            *(u32x4*)(pp + offw) = (u32x4){s0[0], s1[0], s0[1], s1[1]}; } } } }
            sq = xrow_sum(sq);
            if (fq == 0) atomicAdd(ss + row, sq);
            if (g + 4 < 8) { if (BASE == 2) issue8(l8[g + 4], ER_VOFF(g + 4)); else issue(lb[g + 4], ER_VOFF(g + 4)); } }
#undef ER_VOFF
    }
};
struct EpiQ {
    static constexpr bool PERM = true, AFTER_DRAIN = false; struct Pre {}; __device__ __forceinline__ void prefetch(const Unit&, int, int, int, int, Pre&) const {}
    bf16_t* O; const float* ss;
    __device__ __forceinline__ void operator()(const f32x4 (&acc)[2][2][4][2], const Unit& u, int wr, int wc, int fr, int fq, const Pre&) const {
        const int row0 = u.pm * BM + wr * 64 + fr, col0 = u.pn * BM + wc * 32 + 8 * fq;
#pragma unroll
        for (int ai = 0; ai < 2; ++ai)
#pragma unroll
            for (int m = 0; m < 4; ++m) { const int row = row0 + ai * HALF + m * 16; const float sc = C2X * __builtin_amdgcn_rsqf(ss[row] * (1.0f / D) + EPS);
                bf16_t* rowp = O + (size_t)row * D + col0;
#pragma unroll
                for (int bj = 0; bj < 2; ++bj) { const f32x4 v0 = acc[ai][bj][m][0] * sc, v1 = acc[ai][bj][m][1] * sc;
                    u32x4 w; w.x = cvtpk(v0[0], v0[1]); w.y = cvtpk(v0[2], v0[3]); w.z = cvtpk(v1[0], v1[1]); w.w = cvtpk(v1[2], v1[3]);
                    *(u32x4*)(rowp + bj * HALF) = w; } }
    }
};
struct EpiSoftmaxS {
    static constexpr bool PERM = true, AFTER_DRAIN = false; struct Pre {}; __device__ __forceinline__ void prefetch(const Unit&, int, int, int, int, Pre&) const {}
    unsigned char* P; const float* ss; LAS unsigned char* tb; float qs;
    __device__ __forceinline__ void operator()(f32x4 (&acc)[2][2][4][2], const Unit& u, int wr, int wc, int fr, int fq, const Pre&) const {
        LAS float* MX = (LAS float*)tb;
        LAS float* SM = (LAS float*)(tb + 4096);
#pragma unroll
        for (int ai = 0; ai < 2; ++ai)
#pragma unroll
            for (int m = 0; m < 4; ++m) { const int r = ai * HALF + wr * 64 + m * 16 + fr; const float sc = qs * C2X * __builtin_amdgcn_rsqf(ss[u.pm * BM + r] * (1.0f / D) + EPS); float mx = -3.0e38f;
#pragma unroll
                for (int bj = 0; bj < 2; ++bj)
#pragma unroll
                    for (int n = 0; n < 2; ++n) { f32x4 x = acc[ai][bj][m][n] * sc; acc[ai][bj][m][n] = x; mx = fmaxf(mx, fmaxf(fmaxf(x[0], x[1]), fmaxf(x[2], x[3]))); }
                mx = xrow_max(mx);
                if (fq == 0) MX[r * 4 + wc] = mx; }
        LDS_WAIT(); __builtin_amdgcn_s_barrier(); asm volatile("" ::: "memory");
#pragma unroll
        for (int ai = 0; ai < 2; ++ai)
#pragma unroll
            for (int m = 0; m < 4; ++m) { const int r = ai * HALF + wr * 64 + m * 16 + fr; const f32x4 q = *(const LAS f32x4*)(MX + r * 4);
                const float mx = fmaxf(fmaxf(q[0], q[1]), fmaxf(q[2], q[3])); float sm = 0.f;
#pragma unroll
                for (int bj = 0; bj < 2; ++bj)
#pragma unroll
                    for (int n = 0; n < 2; ++n) { f32x4 x = acc[ai][bj][m][n];
#pragma unroll
                        for (int e = 0; e < 4; ++e) { x[e] = fast_exp2(x[e] - mx); sm += x[e]; }
                        acc[ai][bj][m][n] = x; }
                sm = xrow_sum(sm);
                if (fq == 0) SM[r * 4 + wc] = sm; }
        LDS_WAIT(); __builtin_amdgcn_s_barrier(); asm volatile("" ::: "memory");
        const int colw = u.pn * BM + wc * 32 + 16 * (fq >> 1);
        unsigned sv[2][2];
#pragma unroll
        for (int ai = 0; ai < 2; ++ai)
#pragma unroll
            for (int m = 0; m < 4; ++m) { const int r = ai * HALF + wr * 64 + m * 16 + fr; const f32x4 q = *(const LAS f32x4*)(SM + r * 4);
                const float inv = PSCALE8 * fast_rcp((q[0] + q[1]) + (q[2] + q[3]));
#pragma unroll
                for (int bj = 0; bj < 2; ++bj) { const f32x4 v0 = acc[ai][bj][m][0] * inv, v1 = acc[ai][bj][m][1] * inv;
                    const unsigned ca = pk4_fp8(v0[0], v0[1], v0[2], v0[3]), cb = pk4_fp8(v1[0], v1[1], v1[2], v1[3]);
                    if (!(m & 1)) { sv[bj][0] = ca; sv[bj][1] = cb; }
                    else { const auto s0 = __builtin_amdgcn_permlane16_swap(sv[bj][0], ca, false, false), s1 = __builtin_amdgcn_permlane16_swap(sv[bj][1], cb, false, false);
                        const int rw = ai * HALF + wr * 64 + (m - 1 + (fq & 1)) * 16 + fr;
                        *(u32x4*)(P + ((size_t)u.pm * BM + rw) * D + bj * HALF + colw) = (u32x4){s0[0], s1[0], s0[1], s1[1]}; } } }
        LDS_WAIT(); __builtin_amdgcn_s_barrier(); asm volatile("" ::: "memory");
    }
};
struct EpiW1 {
    static constexpr bool PERM = true, AFTER_DRAIN = false;
    struct Pre { float sc[8]; f32x4 bq[4]; };
    bf16_t* O; const float* ssl; const float* b1; const int* list0;
    __device__ __forceinline__ void prefetch(const Unit& u, int wr, int wc, int fr, int fq, Pre& p) const {
        const float* sp = ssl + (u.rows - list0);
        { const float* bb = b1 + (size_t)u.aux * 2048 + 2 * (u.pn * 128); const unsigned bo = (unsigned)(2 * (wc * 32 + 8 * fq)) * 4u;
#pragma unroll
          for (int q = 0; q < 4; ++q) p.bq[q] = gload128_hidden(bb, bo + 16u * q); }
#pragma unroll
        for (int ai = 0; ai < 2; ++ai)
#pragma unroll
            for (int m = 0; m < 4; ++m) { const int r = ai * HALF + wr * 64 + m * 16 + fr; const int rr = r < u.nrows ? r : u.nrows - 1; p.sc[ai * 4 + m] = __uint_as_float(gload32_hidden(sp, (unsigned)rr * 4u)); }
    }
    __device__ __forceinline__ void operator()(const f32x4 (&acc)[2][2][4][2], const Unit& u, int wr, int wc, int fr, int fq, const Pre& pre) const {
        const int c0 = wc * 32 + 8 * fq;
        f32x4 bq0 = pre.bq[0], bq1 = pre.bq[1], bq2 = pre.bq[2], bq3 = pre.bq[3]; asm volatile("" : "+v"(bq0), "+v"(bq1), "+v"(bq2), "+v"(bq3));
        constexpr float CG = -1.702f * LOG2E, ICG = 1.0f / CG;
        f32x2 bg2[4] = {(f32x2){bq0[0], bq0[2]} * CG, (f32x2){bq1[0], bq1[2]} * CG, (f32x2){bq2[0], bq2[2]} * CG, (f32x2){bq3[0], bq3[2]} * CG};
        f32x2 bl2[4] = {((f32x2){bq0[1], bq0[3]} + 1.0f) * ICG, ((f32x2){bq1[1], bq1[3]} + 1.0f) * ICG, ((f32x2){bq2[1], bq2[3]} + 1.0f) * ICG, ((f32x2){bq3[1], bq3[3]} + 1.0f) * ICG};
#pragma unroll
        for (int j = 0; j < 4; ++j) asm volatile("" : "+v"(bg2[j]), "+v"(bl2[j]));
        unsigned pa = 0u, pb = 0u;
#pragma unroll
        for (int ai = 0; ai < 2; ++ai)
#pragma unroll
            for (int m = 0; m < 4; ++m) {
                float ssv = pre.sc[ai * 4 + m]; asm volatile("" : "+v"(ssv));
                const float sc = WSCALE8_INV * __builtin_amdgcn_rsqf(ssv * (1.0f / D) + EPS); const float scg = sc * CG, scl = sc * ICG; f32x2 a[4];
#pragma unroll
                for (int j = 0; j < 4; ++j) { const f32x2 ag = (f32x2){acc[ai][0][m][j >> 1][2 * (j & 1)], acc[ai][0][m][j >> 1][2 * (j & 1) + 1]}, al = (f32x2){acc[ai][1][m][j >> 1][2 * (j & 1)], acc[ai][1][m][j >> 1][2 * (j & 1) + 1]};
                    f32x2 w = ag * scg + bg2[j]; w = (f32x2){fmaxf(w.x, 7.0f * CG), fmaxf(w.y, 7.0f * CG)};
                    f32x2 d = (f32x2){fast_exp2(w.x), fast_exp2(w.y)} + 1.0f; d = (f32x2){fast_rcp(d.x), fast_rcp(d.y)};
                    f32x2 l = al * scl + bl2[j]; l = (f32x2){__builtin_amdgcn_fmed3f(l.x, 8.0f * ICG, -6.0f * ICG), __builtin_amdgcn_fmed3f(l.y, 8.0f * ICG, -6.0f * ICG)};
                    a[j] = (w * d) * l; }
                const unsigned wa = pk4_fp8(a[0].x, a[0].y, a[1].x, a[1].y), wb = pk4_fp8(a[2].x, a[2].y, a[3].x, a[3].y);
                if (m & 1) {
                    const auto sa = __builtin_amdgcn_permlane16_swap(pa, wa, false, false), sb = __builtin_amdgcn_permlane16_swap(pb, wb, false, false);
                    const int r = ai * HALF + wr * 64 + (m - 1 + (fq & 1)) * 16 + fr;
                    *(u32x4*)((unsigned char*)O + ((size_t)u.pm * BM + r) * D + u.pn * 128 + wc * 32 + 16 * (fq >> 1)) = (u32x4){sa[0], sb[0], sa[1], sb[1]}; }
                else { pa = wa; pb = wb; } }
    }
};
constexpr float YSCALE = 16.0f, YSCALE_INV = 1.0f / 16.0f;
struct EpiW2 {
    static constexpr bool PERM = true, AFTER_DRAIN = false;
    struct Pre { float g[8]; f32x4 bv[4]; unsigned d[8]; };
    unsigned char* O; const float* b2; const int* list0; const float* gl0; const int* dl0;
    __device__ __forceinline__ void prefetch(const Unit& u, int wr, int wc, int fr, int fq, Pre& p) const {
        const float* gp = gl0 + (u.rows - list0);
        { const float* bb = b2 + (size_t)u.aux * D + u.pn * BM; const unsigned bo = (unsigned)(wc * 32 + 8 * fq) * 4u;
#pragma unroll
          for (int q = 0; q < 4; ++q) p.bv[q] = gload128_hidden(bb, bo + (unsigned)((q >> 1) * HALF * 4 + (q & 1) * 16)); }
#pragma unroll
        for (int ai = 0; ai < 2; ++ai)
#pragma unroll
            for (int m = 0; m < 4; ++m) { const int r = ai * HALF + wr * 64 + m * 16 + fr; const int rr = r < u.nrows ? r : u.nrows - 1; p.g[ai * 4 + m] = __uint_as_float(gload32_hidden(gp, (unsigned)rr * 4u)); p.d[ai * 4 + m] = gload32_hidden(dl0 + (u.rows - list0), (unsigned)rr * 4u); }
    }
    __device__ __forceinline__ void operator()(const f32x4 (&acc)[2][2][4][2], const Unit& u, int wr, int wc, int fr, int fq, const Pre& pre) const {
            f32x4 bv[2][2]; bv[0][0] = pre.bv[0]; bv[0][1] = pre.bv[1]; bv[1][0] = pre.bv[2]; bv[1][1] = pre.bv[3]; asm volatile("" : "+v"(bv[0][0]), "+v"(bv[0][1]), "+v"(bv[1][0]), "+v"(bv[1][1]));
        const int colw = u.pn * BM + wc * 32 + 16 * (fq >> 1);
#pragma unroll
        for (int ai = 0; ai < 2; ++ai)
#pragma unroll
            for (int mp = 0; mp < 2; ++mp) { unsigned qa[2][2], qb[2][2];
#pragma unroll
                for (int mm = 0; mm < 2; ++mm) { const int m = 2 * mp + mm; float gv = pre.g[ai * 4 + m]; asm volatile("" : "+v"(gv)); const float g = YSCALE * gv;
#pragma unroll
                    for (int bj = 0; bj < 2; ++bj) { const f32x4 v0 = (acc[ai][bj][m][0] * WSCALE8_INV + bv[bj][0]) * g, v1 = (acc[ai][bj][m][1] * WSCALE8_INV + bv[bj][1]) * g;
                        qa[mm][bj] = pk4_fp8(v0[0], v0[1], v0[2], v0[3]); qb[mm][bj] = pk4_fp8(v1[0], v1[1], v1[2], v1[3]); } }
                unsigned d0 = pre.d[ai * 4 + 2 * mp], d1 = pre.d[ai * 4 + 2 * mp + 1]; asm volatile("" : "+v"(d0), "+v"(d1));
                const bool live = (ai * HALF + wr * 64 + (2 * mp + (fq & 1)) * 16 + fr) < u.nrows;
                unsigned char* rowp = O + (size_t)((fq & 1) ? d1 : d0) * D + colw;
#pragma unroll
                for (int bj = 0; bj < 2; ++bj) { const auto sa = __builtin_amdgcn_permlane16_swap(qa[0][bj], qa[1][bj], false, false), sb = __builtin_amdgcn_permlane16_swap(qb[0][bj], qb[1][bj], false, false);
                    if (live) *(u32x4*)(rowp + bj * HALF) = (u32x4){sa[0], sb[0], sa[1], sb[1]}; } }
    }
};
}

namespace moba {
using bf16x8 = ::bf16x8; using s16x4 = ::s16x4; using f32x16 = ::f32x16; using u32x4 = ::u32x4;
constexpr int DMQ = INC, DMO = D, HD = 64;
constexpr int NW = 8, QBLK = 32, QB = 256, KVBLK = 64;
__device__ __forceinline__ int crow(int r, int hi) { return (r & 3) + 8 * (r >> 2) + 4 * hi; }
#define SBAR() __builtin_amdgcn_sched_barrier(0)
__device__ __forceinline__ void cmask(f32x16& p0, f32x16& p1, int jb, int qrel, int hi) {
    const float NEG = -INFINITY; int kb = 64 * jb + 4 * hi;
#pragma unroll
    for (int r = 0; r < 16; ++r) { int kv = kb + (r & 3) + 8 * (r >> 2); if (kv > qrel) p0[r] = NEG; if (kv + 32 > qrel) p1[r] = NEG; }
}
constexpr int NSLOT = 3, SLOTB = 8192;
constexpr int LDS_K = 0, LDS_V = NSLOT * SLOTB, LDS_WS = 2 * NSLOT * SLOTB, LDS_OST = LDS_WS + NW * 64 * 4, LDS_KB = LDS_OST + NW * 4096, LDS_BYTES = LDS_KB + 16 * 64 * 4;
__device__ __forceinline__ void glds16(const void* gsrc, unsigned lds_dst) { unsigned keep;
    asm volatile("s_mov_b32 %0, m0\n\ts_mov_b32 m0, %2\n\ts_nop 0\n\tglobal_load_lds_dwordx4 %1, off\n\ts_mov_b32 m0, %0" : "=&s"(keep) : "v"(gsrc), "s"(lds_dst) : "memory"); }
__device__ __forceinline__ float max3f(float a, float b, float c) { float r; asm("v_max3_f32 %0, %1, %2, %3" : "=v"(r) : "v"(a), "v"(b), "v"(c)); return r; }
__device__ __forceinline__ float max2f(float a, float b) { float r; asm("v_max_f32_e32 %0, %1, %2" : "=v"(r) : "v"(a), "v"(b)); return r; }
__device__ __forceinline__ float fadd_s(float a, float b) { float r; asm("v_add_f32_e32 %0, %1, %2" : "=v"(r) : "v"(a), "v"(b)); return r; }
__device__ __forceinline__ float fsub_s(float a, float b) { float r; asm("v_sub_f32_e32 %0, %1, %2" : "=v"(r) : "v"(a), "v"(b)); return r; }
__device__ __forceinline__ unsigned cvtpk_s(float lo, float hi) { return ::cvtpk(lo, hi); }
#define WAIT_BAR(N) asm volatile("s_waitcnt vmcnt(" #N ") lgkmcnt(0)\n\ts_barrier" ::: "memory")
__device__ __forceinline__ void qkt(f32x16& p0, f32x16& p1, const char* Kslot, const bf16x8* qr, const f32x16& negm, int r32, int hi) {
    const char* kb = Kslot + hi * 1024 + r32 * 16;
#pragma unroll
    for (int d0 = 0; d0 < 4; ++d0) {
        const bf16x8 b0 = *reinterpret_cast<const bf16x8*>(kb + d0 * 2048);
        const bf16x8 b1 = *reinterpret_cast<const bf16x8*>(kb + d0 * 2048 + 512);
        if (d0 == 0) { p0 = __builtin_amdgcn_mfma_f32_32x32x16_bf16(b0, qr[0], negm, 0, 0, 0); p1 = __builtin_amdgcn_mfma_f32_32x32x16_bf16(b1, qr[0], negm, 0, 0, 0); }
        else { p0 = __builtin_amdgcn_mfma_f32_32x32x16_bf16(b0, qr[d0], p0, 0, 0, 0); p1 = __builtin_amdgcn_mfma_f32_32x32x16_bf16(b1, qr[d0], p1, 0, 0, 0); } }
}
typedef __attribute__((address_space(3))) const char* lds_cptr;
typedef short v4i16_t __attribute__((ext_vector_type(4)));
__device__ __forceinline__ void kload8(bf16x8* kf, lds_cptr kp) {
    kf[0] = *(const __attribute__((address_space(3))) bf16x8*)(kp);        kf[1] = *(const __attribute__((address_space(3))) bf16x8*)(kp + 512);
    kf[2] = *(const __attribute__((address_space(3))) bf16x8*)(kp + 2048); kf[3] = *(const __attribute__((address_space(3))) bf16x8*)(kp + 2560);
    kf[4] = *(const __attribute__((address_space(3))) bf16x8*)(kp + 4096); kf[5] = *(const __attribute__((address_space(3))) bf16x8*)(kp + 4608);
    kf[6] = *(const __attribute__((address_space(3))) bf16x8*)(kp + 6144); kf[7] = *(const __attribute__((address_space(3))) bf16x8*)(kp + 6656);
}
__device__ __forceinline__ void kload2(bf16x8* kf, lds_cptr kp, int j) { kf[2 * j] = *(const __attribute__((address_space(3))) bf16x8*)(kp + j * 2048); kf[2 * j + 1] = *(const __attribute__((address_space(3))) bf16x8*)(kp + j * 2048 + 512); }
__device__ __forceinline__ s16x4 vtr(lds_cptr p) { return __builtin_bit_cast(s16x4, __builtin_amdgcn_ds_read_tr16_b64_v4i16((__attribute__((address_space(3))) v4i16_t*)p)); }
__device__ __forceinline__ float rowmax(const f32x16& p0, const f32x16& p1) {
    float a = max3f(p0[0], p0[1], p1[0]), b = max3f(p0[2], p0[3], p1[1]); a = max3f(a, p1[2], p1[3]);
#pragma unroll
    for (int r = 4; r < 16; r += 4) { a = max3f(a, p0[r], p0[r + 1]); b = max3f(b, p0[r + 2], p0[r + 3]); a = max3f(a, p1[r], p1[r + 1]); b = max3f(b, p1[r + 2], p1[r + 3]); }
    const float m = max2f(a, b);
    auto rr = __builtin_amdgcn_permlane32_swap(__float_as_uint(m), __float_as_uint(m), false, false);
    return max2f(__uint_as_float(rr[0]), __uint_as_float(rr[1]));
}
__device__ __forceinline__ void pv(f32x16* o, int vb, bf16x8 pa0, bf16x8 pa1, bf16x8 pa2, bf16x8 pa3) {
#pragma unroll
    for (int d0 = 0; d0 < 2; ++d0) { s16x4 lo[4], hi[4];
#pragma unroll
        for (int ks = 0; ks < 4; ++ks) {
            asm volatile("ds_read_b64_tr_b16 %0,%1 offset:%c2" : "=&v"(lo[ks]) : "v"(vb), "i"(d0 * 4096 + ks * 1024) : "memory");
            asm volatile("ds_read_b64_tr_b16 %0,%1 offset:%c2" : "=&v"(hi[ks]) : "v"(vb), "i"(d0 * 4096 + ks * 1024 + 512) : "memory"); }
        asm volatile("s_waitcnt lgkmcnt(0)" ::: "memory"); SBAR();
#define PK(k) (bf16x8){lo[k][0], lo[k][1], lo[k][2], lo[k][3], hi[k][0], hi[k][1], hi[k][2], hi[k][3]}
        o[d0] = __builtin_amdgcn_mfma_f32_32x32x16_bf16(pa0, PK(0), o[d0], 0, 0, 0);
        o[d0] = __builtin_amdgcn_mfma_f32_32x32x16_bf16(pa1, PK(1), o[d0], 0, 0, 0);
        o[d0] = __builtin_amdgcn_mfma_f32_32x32x16_bf16(pa2, PK(2), o[d0], 0, 0, 0);
        o[d0] = __builtin_amdgcn_mfma_f32_32x32x16_bf16(pa3, PK(3), o[d0], 0, 0, 0);
#undef PK
    }
}
constexpr float NEGBIG = -1.0e30f;

template <int THRL> __device__ __forceinline__ void attn_unit(int b, int h, int qb, const bf16_t* Qg, const bf16_t* __restrict__ Kg, const bf16_t* __restrict__ Vg, bf16_t* Og, const float* __restrict__ kbar, char* shm) {
    int tid_ = threadIdx.x; asm volatile("" : "+v"(tid_));
    const int tid = tid_, lane = tid & 63, r32 = lane & 31, hi = lane >> 5; const int wid = __builtin_amdgcn_readfirstlane(tid >> 6);
    const long rowbase = (long)b * SEQ; const int q0 = qb * QB;
    const size_t hoff = (size_t)(b * 8 + h) * (SEQ * 64);
    const bf16_t* Qw = Qg + hoff + (size_t)(q0 + wid * QBLK) * 64;
    const bf16_t* Kh = Kg + hoff, *Vh = Vg + hoff;
    const unsigned lds0 = (unsigned)(uintptr_t)shm;
    float* wsf = (float*)(shm + LDS_WS) + wid * 64;
    const bf16_t* ksrc = Kh + wid * 512 + lane * 8;
    const bf16_t* vsrc = Vh + wid * 512 + lane * 8;
    const unsigned kdst = lds0 + LDS_K + wid * 1024, vdst = lds0 + LDS_V + wid * 1024;
    const int NT = 4 * qb + 4, NPAST = 4 * qb;
#define TMAP(t) (((t) < 4) ? (NPAST + (t)) : ((t) - 4))
#define DMA_K(t, slot) glds16(ksrc + (long)TMAP(t) * 4096, (unsigned)__builtin_amdgcn_readfirstlane(kdst + (slot)))
#define DMA_V(t, slot) glds16(vsrc + (long)TMAP(t) * 4096, (unsigned)__builtin_amdgcn_readfirstlane(vdst + (slot)))
    const char* Kbase = shm + LDS_K; bf16x8 kf[8];
    const lds_cptr shm3 = (lds_cptr)shm; const lds_cptr kp0 = shm3 + LDS_K + hi * 1024 + r32 * 16; const lds_cptr vp0 = shm3 + LDS_V + ((lane >> 4) & 1) * 32 + (lane & 3) * 8 + (4 * hi + ((lane & 15) >> 2)) * 64;
    DMA_K(0, 0); DMA_V(0, 0); DMA_K(1, SLOTB);
    bf16x8 qr[4];
#pragma unroll
    for (int d0 = 0; d0 < 4; ++d0) qr[d0] = *reinterpret_cast<const bf16x8*>(&Qw[(long)r32 * 64 + d0 * 16 + hi * 8]);
    unsigned selm = 0u;
    if (qb > 0) {
        float* kbl = (float*)(shm + LDS_KB);
        for (int i = tid; i < qb * 64; i += NW * 64) kbl[i] = kbar[((size_t)(b * 16 + (i >> 6)) * 8 + h) * 64 + (i & 63)];
        asm volatile("s_waitcnt vmcnt(0) lgkmcnt(0)\n\ts_barrier" ::: "memory");
        if (qb <= 3) selm = (1u << qb) - 1u;
        else {
            float qf[32];
#pragma unroll
            for (int d0 = 0; d0 < 4; ++d0)
#pragma unroll
                for (int j = 0; j < 8; ++j) qf[d0 * 8 + j] = bf2f((unsigned short)qr[d0][j]);
            float g[15];
#pragma unroll
            for (int n = 0; n < 15; ++n) { float s = 0.f;
                if (n < qb) {
#pragma unroll
                    for (int d0 = 0; d0 < 4; ++d0) { const f32x4 k0 = *(const f32x4*)(kbl + n * 64 + d0 * 16 + hi * 8), k1 = *(const f32x4*)(kbl + n * 64 + d0 * 16 + hi * 8 + 4);
                        s += qf[d0 * 8 + 0] * k0[0] + qf[d0 * 8 + 1] * k0[1] + qf[d0 * 8 + 2] * k0[2] + qf[d0 * 8 + 3] * k0[3] + qf[d0 * 8 + 4] * k1[0] + qf[d0 * 8 + 5] * k1[1] + qf[d0 * 8 + 6] * k1[2] + qf[d0 * 8 + 7] * k1[3]; }
                    s = half32_sum(s);
                } else s = -INFINITY;
                g[n] = s; }
#pragma unroll
            for (int pass = 0; pass < 3; ++pass) { float best = -INFINITY; int bi = 0;
#pragma unroll
                for (int n = 0; n < 15; ++n) if (g[n] > best) { best = g[n]; bi = n; }
                selm |= 1u << bi;
#pragma unroll
                for (int n = 0; n < 15; ++n) if (n == bi) g[n] = -INFINITY; }
        }
    }
    if (wid >= 4) __builtin_amdgcn_s_setprio(1);
    float mhat = 0.f, l_reg = 0.f; f32x16 o[2]; o[0] = f32x16{}; o[1] = f32x16{}; f32x16 cini = f32x16{}; asm volatile("" : "+v"(cini));
    const int qrel = wid * QBLK + r32;
#define SETC(t, JB) do { const float cm_ = ((JB >= 0) || ((selm >> (((t) - 4) >> 2)) & 1u)) ? -mhat : NEGBIG; \
      _Pragma("unroll") for (int r = 0; r < 16; ++r) cini[r] = cm_; asm volatile("" : "+v"(cini)); } while (0)
    bool resc = false;
#define START(P0, P1) do { const float rm = rowmax(P0, P1); resc = false; \
    { const float dl = rm; mhat = fadd_s(mhat, dl); \
      _Pragma("unroll") for (int r = 0; r < 16; ++r) { P0[r] = fsub_s(P0[r], dl); P1[r] = fsub_s(P1[r], dl); } } \
    _Pragma("unroll") for (int r = 0; r < 16; ++r) P0[r] = __builtin_amdgcn_exp2f(P0[r]); } while (0)
#define RESC() do { if (resc) { asm volatile("s_waitcnt lgkmcnt(0)" ::: "memory"); \
      _Pragma("unroll") for (int d_ = 0; d_ < 2; ++d_) _Pragma("unroll") for (int r = 0; r < 16; ++r) o[d_][r] *= wsf[crow(r, hi)]; } } while (0)
    f32x16 pA0, pA1, pB0, pB1;
    int sl_prev = 0, sl_cur = 0, sl_next = SLOTB;
#define ROT() do { sl_prev = sl_cur; sl_cur = sl_next; sl_next = (sl_next == (NSLOT - 1) * SLOTB) ? 0 : sl_next + SLOTB; } while (0)
    DMA_K(2, 2 * SLOTB);
    if (qb > 0) { WAIT_BAR(0); } else { WAIT_BAR(3); }
    qkt(pA0, pA1, Kbase, qr, cini, r32, hi); asm volatile("s_nop 15\n\ts_nop 7" : "+v"(pA0), "+v"(pA1)); cmask(pA0, pA1, 0, qrel, hi);
    START(pA0, pA1);
    _Pragma("unroll") for (int r = 0; r < 16; ++r) pA1[r] = __builtin_amdgcn_exp2f(pA1[r]);
    WAIT_BAR(0);
    DMA_K(3, 0); DMA_V(1, SLOTB);
    ROT();
    kload8(kf, kp0 + sl_cur);
    WAIT_BAR(2);
    s16x4 vlo[8], vhi[8]; u32x4 pw0, pw1, pw2, pw3;
#define PKW(P, B) cvtpk_s(P[B], P[B + 1])
#define PAF(k) __builtin_bit_cast(bf16x8, pw##k)
#define VFR(i) (bf16x8){vlo[i][0], vlo[i][1], vlo[i][2], vlo[i][3], vhi[i][0], vhi[i][1], vhi[i][2], vhi[i][3]}
#define PIN(x) asm volatile("" : "+v"(x))
#define MX3(a, b, c) __builtin_fmaxf(__builtin_fmaxf((a), (b)), (c))
#define GAPA(MF, A0, A1, A2, A3, W0, W1, PW) do { MF; sacc += A0; sacc += A1; sacc += A2; sacc += A3; PIN(sacc); W0; W1; PIN(PW); SBAR(); } while (0)
#define EX(v) __builtin_amdgcn_exp2f(v)
#define GAPB(MF, X, B) do { MF; X[B] = EX(X[B]); X[B + 1] = EX(X[B + 1]); X[B + 2] = EX(X[B + 2]); X[B + 3] = EX(X[B + 3]); PIN(X); SBAR(); } while (0)
#define VRD(i) do { vlo[i] = vtr(vp_ + (((i) >> 2) * 4096 + ((i) & 3) * 1024)); vhi[i] = vtr(vp_ + (((i) >> 2) * 4096 + ((i) & 3) * 1024 + 512)); } while (0)
#define KRD(G, j) do { if (G) { kload2(kf, kp0 + sl_next, j); SBAR(); } } while (0)
#define STEP(C0, C1, P0, P1, t, GK, GV, GL, JB) do { if ((JB) >= 0 || ((((t) - 4) & 3) == 0) || resc) { SETC(t, JB); } SBAR();        \
    const lds_cptr vp_ = vp0 + sl_prev; \
    VRD(0); SBAR(); float sacc = (P0[0] + P0[1]); \
    GAPA(C0 = __builtin_amdgcn_mfma_f32_32x32x16_bf16(kf[0], qr[0], cini, 0, 0, 0), P0[2], P0[3], P0[4], P0[5],     pw0[0] = PKW(P0, 0), pw0[1] = PKW(P0, 2), pw0); \
    VRD(4); SBAR(); GAPA(C1 = __builtin_amdgcn_mfma_f32_32x32x16_bf16(kf[1], qr[0], cini, 0, 0, 0), P0[6], P0[7], P0[8], P0[9],     pw0[2] = PKW(P0, 4), pw0[3] = PKW(P0, 6), pw0); \
    VRD(1); SBAR(); GAPA(C0 = __builtin_amdgcn_mfma_f32_32x32x16_bf16(kf[2], qr[1], C0, 0, 0, 0),   P0[10], P0[11], P0[12], P0[13], pw1[0] = PKW(P0, 8), pw1[1] = PKW(P0, 10), pw1); \
    VRD(5); SBAR(); GAPA(C1 = __builtin_amdgcn_mfma_f32_32x32x16_bf16(kf[3], qr[1], C1, 0, 0, 0),   P0[14], P0[15], P1[0], P1[1],   pw1[2] = PKW(P0, 12), pw1[3] = PKW(P0, 14), pw1); \
    VRD(2); SBAR(); GAPA(C0 = __builtin_amdgcn_mfma_f32_32x32x16_bf16(kf[4], qr[2], C0, 0, 0, 0),   P1[2], P1[3], P1[4], P1[5],     pw2[0] = PKW(P1, 0), pw2[1] = PKW(P1, 2), pw2); \
    VRD(6); SBAR(); GAPA(C1 = __builtin_amdgcn_mfma_f32_32x32x16_bf16(kf[5], qr[2], C1, 0, 0, 0),   P1[6], P1[7], P1[8], P1[9],     pw2[2] = PKW(P1, 4), pw2[3] = PKW(P1, 6), pw2); \
    VRD(3); SBAR(); GAPA(C0 = __builtin_amdgcn_mfma_f32_32x32x16_bf16(kf[6], qr[3], C0, 0, 0, 0),   P1[10], P1[11], P1[12], P1[13], pw3[0] = PKW(P1, 8), pw3[1] = PKW(P1, 10), pw3); \
    VRD(7); SBAR(); GAPA(C1 = __builtin_amdgcn_mfma_f32_32x32x16_bf16(kf[7], qr[3], C1, 0, 0, 0),   P1[14], P1[15], 0.f, 0.f,       pw3[2] = PKW(P1, 12), pw3[3] = PKW(P1, 14), pw3); \
    l_reg += sacc; \
    if (GK) { DMA_K((t) + 3, sl_cur); } if (GV) { DMA_V((t) + 1, sl_next); } \
    if (JB >= 0) cmask(C0, C1, JB, qrel, hi); \
    { float a = MX3(C0[0], C0[1], C1[0]), b_ = MX3(C0[2], C0[3], C1[1]); a = MX3(a, C1[2], C1[3]); \
      _Pragma("unroll") for (int r = 4; r < 16; r += 4) { a = MX3(a, C0[r], C0[r + 1]); b_ = MX3(b_, C0[r + 2], C0[r + 3]); a = MX3(a, C1[r], C1[r + 1]); b_ = MX3(b_, C1[r + 2], C1[r + 3]); } \
      float rm = __builtin_fmaxf(a, b_); { auto rr = __builtin_amdgcn_permlane32_swap(__float_as_uint(rm), __float_as_uint(rm), false, false); rm = __builtin_fmaxf(__uint_as_float(rr[0]), __uint_as_float(rr[1])); } \
      resc = false; \
      if (__builtin_expect(__any(rm > (float)THRL), 0)) { const float dl = __builtin_fmaxf(rm, 0.f); mhat += dl; \
        _Pragma("unroll") for (int r = 0; r < 16; ++r) { C0[r] -= dl; C1[r] -= dl; } \
        const float f = __builtin_amdgcn_exp2f(-dl); l_reg *= f; if (hi == 0) wsf[r32] = f; resc = true; } } \
    SBAR(); \
    GAPB(o[0] = __builtin_amdgcn_mfma_f32_32x32x16_bf16(PAF(0), VFR(0), o[0], 0, 0, 0), C0, 0); \
    GAPB(o[1] = __builtin_amdgcn_mfma_f32_32x32x16_bf16(PAF(0), VFR(4), o[1], 0, 0, 0), C0, 4); \
    KRD(GL, 0); GAPB(o[0] = __builtin_amdgcn_mfma_f32_32x32x16_bf16(PAF(1), VFR(1), o[0], 0, 0, 0), C0, 8); \
    KRD(GL, 1); GAPB(o[1] = __builtin_amdgcn_mfma_f32_32x32x16_bf16(PAF(1), VFR(5), o[1], 0, 0, 0), C0, 12); \
    KRD(GL, 2); GAPB(o[0] = __builtin_amdgcn_mfma_f32_32x32x16_bf16(PAF(2), VFR(2), o[0], 0, 0, 0), C1, 0); \
    KRD(GL, 3); GAPB(o[1] = __builtin_amdgcn_mfma_f32_32x32x16_bf16(PAF(2), VFR(6), o[1], 0, 0, 0), C1, 4); \
    GAPB(o[0] = __builtin_amdgcn_mfma_f32_32x32x16_bf16(PAF(3), VFR(3), o[0], 0, 0, 0), C1, 8); \
    GAPB(o[1] = __builtin_amdgcn_mfma_f32_32x32x16_bf16(PAF(3), VFR(7), o[1], 0, 0, 0), C1, 12); \
    } while (0)
#define ENDW(tt) do { if ((tt) + 3 < NT) { WAIT_BAR(2); } else if ((tt) + 2 < NT) { WAIT_BAR(1); } else { WAIT_BAR(0); } } while (0)
    STEP(pB0, pB1, pA0, pA1, 1, (4 < NT), true, true, 1);   ENDW(1); RESC(); ROT();
    STEP(pA0, pA1, pB0, pB1, 2, (5 < NT), true, true, 2);   ENDW(2); RESC(); ROT();
    STEP(pB0, pB1, pA0, pA1, 3, (6 < NT), (4 < NT), (4 < NT), 3);   ENDW(3); RESC(); ROT();
    int t = 4;
    for (; t + 4 < NT; t += 2) {
        STEP(pA0, pA1, pB0, pB1, t, true, true, true, -1);       WAIT_BAR(2); RESC(); ROT();
        STEP(pB0, pB1, pA0, pA1, t + 1, true, true, true, -1);   WAIT_BAR(2); RESC(); ROT();
    }
    for (; t < NT; t += 2) {
        STEP(pA0, pA1, pB0, pB1, t, (t + 3 < NT), true, true, -1);                       ENDW(t);     RESC(); ROT();
        STEP(pB0, pB1, pA0, pA1, t + 1, (t + 4 < NT), (t + 2 < NT), (t + 2 < NT), -1);   ENDW(t + 1); RESC(); ROT();
    }
    { float sacc = pB0[0] + pB0[1]; _Pragma("unroll") for (int r = 2; r < 16; ++r) sacc += pB0[r]; _Pragma("unroll") for (int r = 0; r < 16; ++r) sacc += pB1[r]; l_reg += sacc;
      pw0 = (u32x4){PKW(pB0, 0), PKW(pB0, 2), PKW(pB0, 4), PKW(pB0, 6)}; pw1 = (u32x4){PKW(pB0, 8), PKW(pB0, 10), PKW(pB0, 12), PKW(pB0, 14)}; pw2 = (u32x4){PKW(pB1, 0), PKW(pB1, 2), PKW(pB1, 4), PKW(pB1, 6)}; pw3 = (u32x4){PKW(pB1, 8), PKW(pB1, 10), PKW(pB1, 12), PKW(pB1, 14)};
      SBAR(); pv(o, (int)(unsigned long)vp0 + sl_prev, PAF(0), PAF(1), PAF(2), PAF(3)); }
#undef PKW
#undef PAF
#undef VFR
#undef PIN
#undef MX3
#undef GAPA
#undef GAPB
#undef EX
#undef VRD
#undef KRD
#undef STEP
#undef ENDW
    { auto rr = __builtin_amdgcn_permlane32_swap(__float_as_uint(l_reg), __float_as_uint(l_reg), false, false); l_reg = __uint_as_float(rr[0]) + __uint_as_float(rr[1]); }
    if (hi == 0) wsf[32 + r32] = l_reg; asm volatile("s_waitcnt lgkmcnt(0)" ::: "memory");
    float rli[16];
#pragma unroll
    for (int r = 0; r < 16; ++r) rli[r] = __builtin_amdgcn_rcpf(wsf[32 + crow(r, hi)]);
    unsigned char* Ow = (unsigned char*)Og + (rowbase + q0 + wid * QBLK) * DMO + h * HD;
    { bf16_t* stg = (bf16_t*)(shm + LDS_OST) + wid * 2048;
#pragma unroll
      for (int r = 0; r < 16; ++r) { const int orow = crow(r, hi);
#pragma unroll
        for (int d0 = 0; d0 < 2; ++d0) stg[orow * 64 + d0 * 32 + r32] = (bf16_t)f2bf(o[d0][r] * rli[r]); }
      asm volatile("s_waitcnt lgkmcnt(0)" ::: "memory");
#pragma unroll
      for (int i = 0; i < 4; ++i) { const int row = i * 8 + (lane >> 3), ch = lane & 7; const u32x4 v = *(const u32x4*)(stg + row * 64 + ch * 8);
          *(u32x2*)(Ow + (long)row * DMO + ch * 8) = (u32x2){pk4_fp8(bflo(v.x) * MIXS8, bfhi(v.x) * MIXS8, bflo(v.y) * MIXS8, bfhi(v.y) * MIXS8), pk4_fp8(bflo(v.z) * MIXS8, bfhi(v.z) * MIXS8, bflo(v.w) * MIXS8, bfhi(v.w) * MIXS8)}; } }
    __builtin_amdgcn_s_setprio(0);
    asm volatile("s_waitcnt lgkmcnt(0)\n\ts_barrier" ::: "memory");
#undef DMA_K
#undef DMA_V
#undef TMAP
#undef SETC
#undef START
#undef RESC
#undef ROT
}
#undef SBAR
#undef WAIT_BAR
}

namespace hgrn {
constexpr int RS = 144;
constexpr int R_FQV = 0, FQV_SLOT = 32768;
constexpr int L_Q = 98304, L_K = L_Q + 9216, L_KT = L_K + 9216, L_VT = L_KT + 9216, L_ST = L_VT + 9216, L_SEG = L_ST + 9216, L_DEND = L_SEG + 2048, L_SSQ = L_DEND + 256, L_BYTES = L_SSQ + 512;
__device__ __forceinline__ int crow(int r, int hi) { return (r & 3) + 8 * (r >> 2) + 4 * hi; }
__device__ __forceinline__ void glds16(const void* gsrc, unsigned lds_dst) { unsigned keep;
    asm volatile("s_mov_b32 %0, m0\n\ts_mov_b32 m0, %2\n\ts_nop 0\n\tglobal_load_lds_dwordx4 %1, off\n\ts_mov_b32 m0, %0" : "=&s"(keep) : "v"(gsrc), "s"(lds_dst) : "memory"); }
#define HG_BAR() do { asm volatile("s_waitcnt lgkmcnt(0)" ::: "memory"); __builtin_amdgcn_s_barrier(); asm volatile("" ::: "memory"); } while (0)
#ifndef HG_ABL
#define HG_ABL 0
#endif
__device__ __forceinline__ void hgrn_unit(int b, int h, const bf16_t* __restrict__ proj, bf16_t* __restrict__ mix, const float* __restrict__ lb_logits, const float* __restrict__ norm_g, LAS unsigned char* lds, const int abl = 0) {
    int tid_ = threadIdx.x; asm volatile("" : "+v"(tid_));
    const int tid = tid_, lane = tid & 63, r32 = lane & 31, hi = lane >> 5; const int w = __builtin_amdgcn_readfirstlane(tid >> 6);
    const float lbk = fast_rcp(1.0f + fast_exp2((lb_logits[512 + h * 64 + lane] - lb_logits[h * 64 + lane]) * LOG2E));
    const int vr = (w >> 1) & 1, tc = w & 1;
    float ng[16];
#pragma unroll
    for (int r = 0; r < 16; ++r) ng[r] = norm_g[h * 64 + 32 * vr + crow(r, hi)];
    f32x16 S = f32x16{};
    for (int i = tid; i < 64 * RS / 4; i += 512) ((LAS unsigned*)(lds + L_ST))[i] = 0u;
    const size_t hoff = (size_t)(b * 8 + h) * (SEQ * 64) + (size_t)w * 512 + lane * 8;
    const bf16_t* gQ = proj + 3 * SEC_ELEMS + hoff; const bf16_t* gF = proj + 4 * SEC_ELEMS + hoff; const bf16_t* gV = proj + 5 * SEC_ELEMS + hoff; const bf16_t* gG = proj + 6 * SEC_ELEMS + hoff;
    const unsigned lds0 = (unsigned)(uintptr_t)(unsigned char*)lds;
#define DMA_FQV(c_) do { const int cc_ = (c_) < 63 ? (c_) : 63; const unsigned d_ = (unsigned)__builtin_amdgcn_readfirstlane(lds0 + R_FQV + (unsigned)(((c_) % 3) * FQV_SLOT) + (unsigned)w * 1024u); \
        glds16(gF + (size_t)cc_ * 4096, d_); glds16(gQ + (size_t)cc_ * 4096, d_ + 8192u); glds16(gV + (size_t)cc_ * 4096, d_ + 16384u); } while (0)
#define DMA_G(c_) do { const int cc_ = (c_) < 63 ? (c_) : 63; glds16(gG + (size_t)cc_ * 4096, (unsigned)__builtin_amdgcn_readfirstlane(lds0 + R_FQV + (unsigned)(((c_) % 3) * FQV_SLOT) + 24576u + (unsigned)w * 1024u)); } while (0)
    DMA_FQV(0); DMA_G(0); DMA_FQV(1); DMA_G(1); DMA_FQV(2);
    for (int c = 0; c < 64; ++c) {
        const size_t row0 = (size_t)b * SEQ + (size_t)c * 64;
        if (abl & 8) {} else if (w < 4 && c >= 3) asm volatile("s_waitcnt vmcnt(20)" ::: "memory");
        else asm volatile("s_waitcnt vmcnt(8)" ::: "memory");
        const LAS unsigned char* raw = lds + R_FQV + (c % 3) * FQV_SLOT + (8 * w) * 128 + lane * 2;
        float p[8], kk[8];
        { float run = 0.f;
#pragma unroll
          for (int i = 0; i < 8; ++i) { const float x = bf2f(*(const LAS unsigned short*)(raw + i * 128)); float f, lg;
              if (abl & 2) { f = 0.5f + 0.001f * x; lg = -1.0f + 0.001f * x; } else { const float sg = fast_rcp(1.0f + fast_exp2(-x * LOG2E)); f = lbk + (1.0f - lbk) * sg; lg = __builtin_amdgcn_logf(f); }
              run += lg; p[i] = run; kk[i] = 1.0f - f; } }
        ((LAS float*)(lds + L_SEG))[w * 64 + lane] = p[7];
        HG_BAR();
        if (!(abl & 8)) DMA_G(c + 2);
        { float off = 0.f;
#pragma unroll
          for (int j = 0; j < 7; ++j) { const float sv = ((LAS float*)(lds + L_SEG))[j * 64 + lane]; off += (j < w) ? sv : 0.f; }
          unsigned kq[4], vq[4];
#pragma unroll
          for (int i = 0; i < 8; i += 2) { const float b0 = off + p[i], b1 = off + p[i + 1];
              const unsigned short q0r = *(const LAS unsigned short*)(raw + 8192 + i * 128), q1r = *(const LAS unsigned short*)(raw + 8192 + (i + 1) * 128);
              const unsigned short v0r = *(const LAS unsigned short*)(raw + 16384 + i * 128), v1r = *(const LAS unsigned short*)(raw + 16384 + (i + 1) * 128);
              const float q0 = bf2f(q0r) * fast_exp2(b0), q1 = bf2f(q1r) * fast_exp2(b1), k0 = kk[i] * fast_exp2(-b0), k1 = kk[i + 1] * fast_exp2(-b1);
              const unsigned qq = cvtpk(q0, q1), kw = cvtpk(k0, k1); kq[i >> 1] = kw; vq[i >> 1] = (unsigned)v0r | ((unsigned)v1r << 16);
              if (abl & 4) continue;
              *(LAS unsigned short*)(lds + L_Q + (8 * w + i) * RS + lane * 2) = (unsigned short)(qq & 0xffffu);
              *(LAS unsigned short*)(lds + L_Q + (8 * w + i + 1) * RS + lane * 2) = (unsigned short)(qq >> 16);
              *(LAS unsigned short*)(lds + L_K + (8 * w + i) * RS + lane * 2) = (unsigned short)(kw & 0xffffu);
              *(LAS unsigned short*)(lds + L_K + (8 * w + i + 1) * RS + lane * 2) = (unsigned short)(kw >> 16); }
          *(LAS u32x4*)(lds + L_KT + lane * RS + 16 * w) = (u32x4){kq[0], kq[1], kq[2], kq[3]};
          *(LAS u32x4*)(lds + L_VT + lane * RS + 16 * w) = (u32x4){vq[0], vq[1], vq[2], vq[3]};
          if (w == 7) ((LAS float*)(lds + L_DEND))[lane] = fast_exp2(off + p[7]); }
        if (!(abl & 8)) DMA_FQV(c + 3);
        if (abl & 8) {} else if (w < 4 && c >= 2) asm volatile("s_waitcnt vmcnt(19)" ::: "memory");
        else asm volatile("s_waitcnt vmcnt(11)" ::: "memory");
        HG_BAR();
        f32x16 OT = f32x16{};
        if (abl & 1) { OT[0] = (float)c; } else
        if (w < 4) {
            bf16x8 bq[4];
#pragma unroll
            for (int ks = 0; ks < 4; ++ks) bq[ks] = *(const LAS bf16x8*)(lds + L_Q + (32 * tc + r32) * RS + (16 * ks + 8 * hi) * 2);
#pragma unroll
            for (int sr = 0; sr < 2; ++sr) if (sr <= tc) {
                f32x16 at = f32x16{};
#pragma unroll
                for (int ks = 0; ks < 4; ++ks) { const bf16x8 a = *(const LAS bf16x8*)(lds + L_K + (32 * sr + r32) * RS + (16 * ks + 8 * hi) * 2); at = __builtin_amdgcn_mfma_f32_32x32x16_bf16(a, bq[ks], at, 0, 0, 0); }
                if (sr == tc) {
#pragma unroll
                    for (int r = 0; r < 16; ++r) at[r] = (crow(r, hi) <= r32) ? at[r] : 0.f; }
#pragma unroll
                for (int st = 0; st < 2; ++st) {
                    u32x4 bw; bw.x = cvtpk(at[8 * st + 0], at[8 * st + 1]); bw.y = cvtpk(at[8 * st + 2], at[8 * st + 3]); bw.z = cvtpk(at[8 * st + 4], at[8 * st + 5]); bw.w = cvtpk(at[8 * st + 6], at[8 * st + 7]);
                    const u32x2 lo = *(const LAS u32x2*)(lds + L_VT + (32 * vr + r32) * RS + (32 * sr + 16 * st + 4 * hi) * 2);
                    const u32x2 hh = *(const LAS u32x2*)(lds + L_VT + (32 * vr + r32) * RS + (32 * sr + 16 * st + 8 + 4 * hi) * 2);
                    const u32x4 aw = (u32x4){lo.x, lo.y, hh.x, hh.y};
                    OT = __builtin_amdgcn_mfma_f32_32x32x16_bf16(__builtin_bit_cast(bf16x8, aw), __builtin_bit_cast(bf16x8, bw), OT, 0, 0, 0); }
            }
#pragma unroll
            for (int ks = 0; ks < 4; ++ks) { const bf16x8 a = *(const LAS bf16x8*)(lds + L_ST + (32 * vr + r32) * RS + (16 * ks + 8 * hi) * 2); OT = __builtin_amdgcn_mfma_f32_32x32x16_bf16(a, bq[ks], OT, 0, 0, 0); }
            float sq = 0.f;
#pragma unroll
            for (int r = 0; r < 16; ++r) sq += OT[r] * OT[r];
            sq = half32_sum(sq);
            if (hi == 0) ((LAS float*)(lds + L_SSQ))[vr * 64 + 32 * tc + r32] = sq;
        } else {
#pragma unroll
            for (int st = 0; st < 4; ++st) { const bf16x8 a = *(const LAS bf16x8*)(lds + L_KT + (32 * vr + r32) * RS + (16 * st + 8 * hi) * 2);
                const bf16x8 bv = *(const LAS bf16x8*)(lds + L_VT + (32 * tc + r32) * RS + (16 * st + 8 * hi) * 2);
                S = __builtin_amdgcn_mfma_f32_32x32x16_bf16(a, bv, S, 0, 0, 0); }
#pragma unroll
            for (int r = 0; r < 16; ++r) S[r] *= ((LAS float*)(lds + L_DEND))[32 * vr + crow(r, hi)];
        }
        HG_BAR();
        if (w < 4) {
            const int t = 32 * tc + r32;
            const float tot = ((LAS float*)(lds + L_SSQ))[t] + ((LAS float*)(lds + L_SSQ))[64 + t];
            const float rstd = __builtin_amdgcn_rsqf(tot * (1.0f / 64.0f) + EPS);
            const LAS unsigned char* gp = lds + R_FQV + (c % 3) * FQV_SLOT + 24576 + t * 128 + (32 * vr + 4 * hi) * 2;
            unsigned char* op = (unsigned char*)mix + (size_t)(row0 + t) * D + 512 + h * 64 + 32 * vr + 4 * hi;
#pragma unroll
            for (int g = 0; g < 4; ++g) { const u32x2 gg = *(const LAS u32x2*)(gp + 16 * g);
                const float y0 = OT[4 * g + 0] * rstd * ng[4 * g + 0] * bflo(gg.x), y1 = OT[4 * g + 1] * rstd * ng[4 * g + 1] * bfhi(gg.x),
                            y2 = OT[4 * g + 2] * rstd * ng[4 * g + 2] * bflo(gg.y), y3 = OT[4 * g + 3] * rstd * ng[4 * g + 3] * bfhi(gg.y);
                const unsigned yv = pk4_fp8(y0 * MIXS8, y1 * MIXS8, y2 * MIXS8, y3 * MIXS8); if (!(abl & 16)) asm volatile("global_store_dword %0, %1, off" :: "v"(op + 8 * g), "v"(yv) : "memory"); }
        } else {
#pragma unroll
            for (int g = 0; g < 4; ++g) *(LAS u32x2*)(lds + L_ST + (32 * tc + r32) * RS + (32 * vr + 8 * g + 4 * hi) * 2) = (u32x2){cvtpk(S[4 * g + 0], S[4 * g + 1]), cvtpk(S[4 * g + 2], S[4 * g + 3])};
        }
    }
    asm volatile("s_waitcnt vmcnt(0)" ::: "memory");
    HG_BAR();
#undef DMA_FQV
#undef DMA_G
}
#undef HG_BAR
}

constexpr int NWAVES = 8;
constexpr int LDS_BYTES = 163840;
constexpr int TAIL = 161792;
constexpr int TL_TE = TAIL, TL_TS = TAIL + 576, TL_HIST = TAIL + 768, TL_BASE = TAIL + 896, TL_MISC = TAIL + 1024, TL_CNT = TAIL + 1280;
typedef GAS unsigned gu32;

struct Args { const float* in[20]; float* out; unsigned char* ws; int ph_lo, ph_hi; };

struct Frame {
    LAS unsigned char* lds; volatile LAS unsigned* MISC; unsigned* ctl;
    int tid, lane, wave, G, vcu;
};

struct P0Item { const float* W; bf16_t* WT; const float* gain; int N, K, k0, n0, mode; };
constexpr int P0_I_IN = 16 * 56, P0_I_SQ = 16 * 16, P0_I_KV = 16 * 32, P0_I_W1 = 16 * 32, P0_I_W2 = 16 * 16;
constexpr int P0_I_IN8 = 16 * 24;
constexpr int P0_NA = P0_I_IN + P0_I_KV + P0_I_IN8, P0_NB = 2 * P0_I_SQ + NEXP * (P0_I_W1 + P0_I_W2);
template <int SET> __device__ __forceinline__ bool p0_decode(const Args& a, int it, P0Item& I) {
    unsigned char* ws = a.ws;
    if (it >= (SET == 0 ? P0_NA : P0_NB)) return false;
    int r = it; I.gain = nullptr; I.mode = 0; I.K = D;
    if (SET == 0) {
        if (r < P0_I_IN) { I.W = a.in[3]; I.WT = (bf16_t*)(ws + WS_WIN); I.N = INC; I.gain = a.in[2]; }
        else if ((r -= P0_I_IN) < P0_I_KV) { I.W = a.in[10]; I.WT = (bf16_t*)(ws + WS_WKV); I.N = 2 * D; }
        else { r -= P0_I_KV; I.W = a.in[3]; I.WT = (bf16_t*)(ws + WS_WIN8); I.N = INC; I.mode = 2; I.gain = a.in[2]; const int nblk8 = 24; I.k0 = 64 * (r / nblk8); I.n0 = 64 * (r % nblk8); return true; }
    } else {
        if (r < P0_I_SQ) { I.W = a.in[6]; I.WT = (bf16_t*)(ws + WS_WOUT); I.N = D; I.mode = 2; }
        else if ((r -= P0_I_SQ) < P0_I_SQ) { I.W = a.in[11]; I.WT = (bf16_t*)(ws + WS_WO); I.N = D; }
        else if ((r -= P0_I_SQ) < NEXP * P0_I_W1) { const int e = r / P0_I_W1; r -= e * P0_I_W1; I.W = a.in[15] + (size_t)e * D * 2048; I.WT = (bf16_t*)(ws + WS_W1 + (size_t)e * 2048 * D); I.N = 2048; I.gain = a.in[12]; I.mode = 3; }
        else { r -= NEXP * P0_I_W1; const int e = r / P0_I_W2; r -= e * P0_I_W2; I.W = a.in[17] + (size_t)e * D * D; I.WT = (bf16_t*)(ws + WS_W2 + (size_t)e * D * D); I.N = D; I.mode = 2; }
    }
    const int nblk = I.N / 64; I.k0 = 64 * (r / nblk); I.n0 = 64 * (r % nblk); return true;
}
template <int SET> __device__ __forceinline__ void p0_run(const Args& a, int first, int stride, int count, LAS unsigned char* tl, int lane);
__device__ __forceinline__ void p0_load(const P0Item& I, f32x4 (&v)[16], f32x4 (&g)[4], int lane) {
    const float* base = I.W + (size_t)I.k0 * I.N + I.n0;
    const unsigned vo = (unsigned)((lane >> 4) * I.N + 4 * (lane & 15)) * 4u, rs = (unsigned)(4 * I.N) * 4u;
#pragma unroll
    for (int j = 0; j < 16; ++j) v[j] = pg8::gload128_hidden_nt(base, vo + rs * (unsigned)j);
    const float* gb = I.gain ? I.gain + I.k0 : base; const unsigned go = (unsigned)(lane >> 4) * 4u;
#pragma unroll
    for (int q = 0; q < 4; ++q) { g[q][0] = __uint_as_float(pg8::gload32_hidden(gb, go + (unsigned)(16 * q) * 4u)); g[q][1] = __uint_as_float(pg8::gload32_hidden(gb, go + (unsigned)(16 * q + 4) * 4u));
                                  g[q][2] = __uint_as_float(pg8::gload32_hidden(gb, go + (unsigned)(16 * q + 8) * 4u)); g[q][3] = __uint_as_float(pg8::gload32_hidden(gb, go + (unsigned)(16 * q + 12) * 4u)); }
}
constexpr int P0_LOADS = 32;
__device__ __forceinline__ void p0_store(const P0Item& I, const f32x4 (&v)[16], const f32x4 (&gq)[4], LAS unsigned char* tl, int lane) {
    const int kr = lane >> 4, nq = lane & 15;
#pragma unroll
    for (int j = 0; j < 16; ++j) { const int k = 4 * j + kr; const float g = I.gain ? gq[j >> 2][j & 3] : 1.0f;
        *(LAS u32x2*)(tl + k * 128 + (((nq >> 1) ^ ((k >> 3) & 7)) * 16) + (nq & 1) * 8) = (u32x2){pk2(v[j].x * g, v[j].y * g), pk2(v[j].z * g, v[j].w * g)}; }
    LDS_WAIT(); asm volatile("" ::: "memory");
    const int c = lane & 7;
#pragma unroll
    for (int i = 0; i < 8; ++i) { const int n = (lane >> 3) + 8 * i; const LAS unsigned char* sp = tl + (8 * c) * 128 + ((i ^ c) * 16) + (n & 7) * 2;
        unsigned short e[8];
#pragma unroll
        for (int q = 0; q < 8; ++q) e[q] = *(const LAS unsigned short*)(sp + q * 128);
        int row = I.n0 + n; if (I.mode & 1) { const int jj = row >> 1, bj = row & 1; row = (jj >> 7) * 256 + bj * 128 + (jj & 127); }
        if (I.mode & 2) *(u32x2*)((unsigned char*)I.WT + (size_t)row * I.K + I.k0 + 8 * c) = (u32x2){pk4_fp8(bf2f(e[0]) * WSCALE8, bf2f(e[1]) * WSCALE8, bf2f(e[2]) * WSCALE8, bf2f(e[3]) * WSCALE8), pk4_fp8(bf2f(e[4]) * WSCALE8, bf2f(e[5]) * WSCALE8, bf2f(e[6]) * WSCALE8, bf2f(e[7]) * WSCALE8)};
        else *(u32x4*)(I.WT + (size_t)row * I.K + I.k0 + 8 * c) = (u32x4){(unsigned)e[0] | ((unsigned)e[1] << 16), (unsigned)e[2] | ((unsigned)e[3] << 16), (unsigned)e[4] | ((unsigned)e[5] << 16), (unsigned)e[6] | ((unsigned)e[7] << 16)}; }
    LDS_WAIT(); asm volatile("" ::: "memory");
}
template <bool GAIN> __device__ __forceinline__ void rms_rows2_to_bf16(const float* __restrict__ x0, const float* __restrict__ x1, const float* __restrict__ g, bf16_t* __restrict__ o0, bf16_t* __restrict__ o1, int lane, unsigned char* q0 = nullptr, unsigned char* q1 = nullptr, float* irs = nullptr) {
    const f32x4* xa = (const f32x4*)x0 + 2 * lane; const f32x4* xb = (const f32x4*)x1 + 2 * lane; const f32x4* gr = (const f32x4*)g + 2 * lane;
    f32x4 va[4], vb[4]; float sa = 0.f, sb = 0.f;
#pragma unroll
    for (int j = 0; j < 4; ++j) { va[j] = __builtin_nontemporal_load(xa + 128 * (j >> 1) + (j & 1)); vb[j] = __builtin_nontemporal_load(xb + 128 * (j >> 1) + (j & 1)); }
#pragma unroll
    for (int j = 0; j < 4; ++j) { sa += (va[j].x * va[j].x + va[j].y * va[j].y) + (va[j].z * va[j].z + va[j].w * va[j].w); sb += (vb[j].x * vb[j].x + vb[j].y * vb[j].y) + (vb[j].z * vb[j].z + vb[j].w * vb[j].w); }
    const float qa = sqrtf(wave_sum(sa) * (1.0f / D) + EPS), qb = sqrtf(wave_sum(sb) * (1.0f / D) + EPS); const float ra = 1.0f / qa, rb = 1.0f / qb;
    if (irs && lane == 0) { irs[0] = qa; irs[1] = qb; }
#pragma unroll
    for (int h = 0; h < 2; ++h) { const f32x4 g0 = GAIN ? gr[128 * h] : (f32x4){1.f, 1.f, 1.f, 1.f}, g1 = GAIN ? gr[128 * h + 1] : (f32x4){1.f, 1.f, 1.f, 1.f};
        const f32x4 a0 = va[2 * h] * ra * g0, a1 = va[2 * h + 1] * ra * g1, b0 = vb[2 * h] * rb * g0, b1 = vb[2 * h + 1] * rb * g1;
        if (q0) { *(u32x2*)(q0 + 512 * h + 8 * lane) = (u32x2){pk4_fp8(a0.x, a0.y, a0.z, a0.w), pk4_fp8(a1.x, a1.y, a1.z, a1.w)};
                  *(u32x2*)(q1 + 512 * h + 8 * lane) = (u32x2){pk4_fp8(b0.x, b0.y, b0.z, b0.w), pk4_fp8(b1.x, b1.y, b1.z, b1.w)}; }
        *(u32x4*)(o0 + 512 * h + 8 * lane) = (u32x4){pk2(a0.x, a0.y), pk2(a0.z, a0.w), pk2(a1.x, a1.y), pk2(a1.z, a1.w)};
        *(u32x4*)(o1 + 512 * h + 8 * lane) = (u32x4){pk2(b0.x, b0.y), pk2(b0.z, b0.w), pk2(b1.x, b1.y), pk2(b1.z, b1.w)}; }
}

__device__ __forceinline__ void p0_prologue(Frame& F, const Args& a) {
    unsigned char* ws = a.ws;
    LAS unsigned char* tl = F.lds + F.wave * 8192;
    const int gw = F.vcu * NWAVES + F.wave, NGW = F.G * NWAVES;
    for (int m = 2 * gw; m < T; m += 2 * NGW) rms_rows2_to_bf16<false>(a.in[0] + (size_t)m * D, a.in[0] + (size_t)(m + 1) * D, a.in[2], (bf16_t*)(ws + WS_XN) + (size_t)m * D, (bf16_t*)(ws + WS_XN) + (size_t)(m + 1) * D, F.lane, ws + WS_XN8 + (size_t)m * D, ws + WS_XN8 + (size_t)(m + 1) * D, (float*)(ws + WS_RS0) + m);
    for (int m = 2 * gw; m < MROWS; m += 2 * NGW) rms_rows2_to_bf16<true>(a.in[1] + (size_t)m * D, a.in[1] + (size_t)(m + 1) * D, a.in[8], (bf16_t*)(ws + WS_MN) + (size_t)m * D, (bf16_t*)(ws + WS_MN) + (size_t)(m + 1) * D, F.lane);
    for (int i = gw * 64 + F.lane; i < D * D / 4; i += NGW * 64) { const f32x4 w = ((const f32x4*)a.in[9])[i]; const float g = a.in[7][i >> 8];
        ((u32x2*)(ws + WS_WQ))[i] = (u32x2){pk2(w.x * g, w.y * g), pk2(w.z * g, w.w * g)}; }
    for (int i = gw * 64 + F.lane; i < NEXP * D; i += NGW * 64) { const int e = i >> 10, k = i & 1023; const float w = a.in[12][k] * a.in[13][k * NEXP + e];
        const unsigned hi = f2bf(w); ((bf16_t*)(ws + WS_WRT))[i] = (bf16_t)hi; ((bf16_t*)(ws + WS_WRT))[NEXP * D + i] = (bf16_t)f2bf(w - bf2f((unsigned short)hi)); }
    p0_run<0>(a, gw, NGW, (P0_NA - gw + NGW - 1) / NGW, tl, F.lane);
}
#define P0_PIN(vv, gg) do { _Pragma("unroll") for (int j_ = 0; j_ < 16; ++j_) asm volatile("" : "+v"(vv[j_])); _Pragma("unroll") for (int q_ = 0; q_ < 4; ++q_) asm volatile("" : "+v"(gg[q_])); } while (0)
template <int SET> __device__ __forceinline__ void p0_run(const Args& a, int first, int stride, int count, LAS unsigned char* tl, int lane_in) {
    int lane = lane_in; asm volatile("" : "+v"(lane));
    P0Item IA, IB; f32x4 va[16], vb[16], ga[4], gb[4];
    int it = first, left = count; bool ha = left > 0 && p0_decode<SET>(a, it, IA); if (ha) p0_load(IA, va, ga, lane);
    while (ha) {
        const bool hb = left > 1 && p0_decode<SET>(a, it + stride, IB); if (hb) p0_load(IB, vb, gb, lane);
        if (hb) asm volatile("s_waitcnt vmcnt(32)" ::: "memory"); else asm volatile("s_waitcnt vmcnt(0)" ::: "memory");
        P0_PIN(va, ga);
        p0_store(IA, va, ga, tl, lane);
        if (!hb) break;
        it += 2 * stride; left -= 2; ha = left > 0 && p0_decode<SET>(a, it, IA); if (ha) p0_load(IA, va, ga, lane);
        if (ha) asm volatile("s_waitcnt vmcnt(32)" ::: "memory"); else asm volatile("s_waitcnt vmcnt(0)" ::: "memory");
        P0_PIN(vb, gb);
        p0_store(IB, vb, gb, tl, lane);
    }
}
#undef P0_PIN

__device__ __forceinline__ unsigned xcc_id() { return (unsigned)__builtin_amdgcn_s_getreg((3 << 11) | 20) & 0xFu; }
constexpr int QITEMS = 16 + 177;
constexpr int CONV_PER_Q = 49, CONV_TILES = 64;
static_assert(8 * CONV_PER_Q * CONV_TILES == P0_NB, "conversion items cover SET 1 exactly");
__device__ __forceinline__ void p2_mixer(Frame& F, const Args& a, int rep) {
    unsigned char* ws = a.ws;
    const bf16_t* proj = (const bf16_t*)(ws + WS_PROJ); bf16_t* mix = (bf16_t*)(ws + WS_MIX);
    const unsigned x0 = xcc_id() & 7u;
    int par = 0;
#ifdef MK_P2_REPMODE
    if (rep && MK_P2_REPMODE == 4) return;
#endif
#ifdef MK_P2_HALF
    if (rep && (blockIdx.x & 8)) return;
#endif
    for (;;) {
        if (F.tid == 0) { int code = -1;
            for (int j = 0; j < 8; ++j) { const unsigned xq = (x0 + j) & 7u; const unsigned i = __hip_atomic_fetch_add(F.ctl + CW_QUEUE + 1024 * rep + 64 * xq, 1u, RLX_AGENT);
                if (i < (unsigned)QITEMS) { code = (int)(xq * 256u + i); break; } }
            F.MISC[par] = (unsigned)code; }
        LDS_WAIT(); __builtin_amdgcn_s_barrier(); asm volatile("" ::: "memory");
        const int code = __builtin_amdgcn_readfirstlane((int)F.MISC[par]); par ^= 1;
        if (code < 0) break;
        const int xq = code >> 8, i = code & 255;
#ifdef MK_P2_REPMODE
        if (rep && ((MK_P2_REPMODE == 1 && i >= 8) || (MK_P2_REPMODE == 2 && i < 16) || MK_P2_REPMODE == 3)) continue;
        if (rep && MK_P2_REPMODE == 5) { const int jq_ = i - 16; const bool isconv = i >= 16 && jq_ < 2 * CONV_PER_Q && (jq_ & 1); if (!isconv) continue; }
#endif
#ifndef NO_HGRN
        if (i < 8) { hgrn::hgrn_unit(xq, i, proj, rep ? (bf16_t*)(ws + WS_H2F) : mix, a.in[4], a.in[5], F.lds, rep ? HG_ABL : 0); }
        else
#endif
        if (i < 16) {
            pg8::KvOrder S{(const char*)(ws + WS_MN), (const char*)(ws + WS_WKV), xq * 8 + (i - 8)};
            pg8::EpiBf16 E{(bf16_t*)(ws + WS_MEMK), D, (bf16_t*)(ws + WS_MEMVT), D};
            pg8::gemm_phase<pg8::EpiBf16, pg8::KvOrder, false, false>(F.lds, D, D, D / 64, S, E);
        } else
        {
        const int jq = i - 16; int mi = -1, cv = -1;
        if (jq < 2 * CONV_PER_Q) { if (jq & 1) cv = jq >> 1; else mi = jq >> 1; } else mi = jq - CONV_PER_Q;
        if (cv >= 0) {
            const int J = xq * CONV_PER_Q + cv;
            p0_run<1>(a, J * CONV_TILES + F.wave * 8, 1, 8, F.lds + F.wave * 8192, F.lane);
            LDS_WAIT(); VM_WAIT(); __builtin_amdgcn_s_barrier(); asm volatile("" ::: "memory");
        } else
#ifndef NO_MOBA
        { const int j = mi, hh = j & 7, qb = 15 - (j >> 3);
            moba::attn_unit<8>(xq, hh, qb, proj, proj + SEC_ELEMS, proj + 2 * SEC_ELEMS, mix, (const float*)(ws + WS_KBAR), (char*)(unsigned char*)F.lds); }
#else
        {}
#endif
        }
    }
}

__device__ __forceinline__ void p7_router(Frame& F, const Args& a, int rep) {
    unsigned char* ws = a.ws;
    constexpr int WRS = 2064;
    LAS unsigned char* WH = F.lds; LAS unsigned char* WL = F.lds + 32 * WRS;
    LAS int* hist = (LAS int*)(F.lds + TL_HIST); LAS int* basel = (LAS int*)(F.lds + TL_BASE);
    { const char* src = (const char*)(ws + WS_WRT); const unsigned lds0 = (unsigned)(uintptr_t)(unsigned char*)F.lds;
#pragma unroll
      for (int k = 0; k < 16; ++k) { const int chunk = F.wave * 16 + k, m = chunk >> 6, r = (chunk >> 1) & 31, hf = chunk & 1;
          pg8::glds16s(src, (unsigned)(chunk * 1024 + F.lane * 16), (unsigned)__builtin_amdgcn_readfirstlane((int)(lds0 + (unsigned)(m * 32 * WRS + r * WRS + hf * 1024)))); }
      asm volatile("s_waitcnt vmcnt(0)" ::: "memory"); }
    const unsigned char* h2q = ws + WS_H2B; const unsigned char* h2r = ws + WS_H2F; const unsigned char* h2s = ws + WS_H2F + (size_t)T * D; const float* ss2 = (const float*)(ws + WS_SS2);
    int* toke = (int*)(ws + (rep ? WS_DUMMY + 1 * MiB : WS_TOKE)); int* tokr = (int*)(ws + (rep ? WS_DUMMY + 1 * MiB + 512 * 1024 : WS_TOKR)); float* tokg = (float*)(ws + (rep ? WS_DUMMY + 2 * MiB : WS_TOKG)); int* list = (int*)(ws + (rep ? WS_DUMMY + 4 * MiB : WS_LIST)); float* glist = (float*)(ws + (rep ? WS_DUMMY + 8 * MiB : WS_GLIST)); float* sslist = (float*)(ws + (rep ? WS_DUMMY + 12 * MiB : WS_SSLIST)); int* dlist = (int*)(ws + (rep ? WS_DUMMY + 4 * MiB : WS_DLIST));
    unsigned* cntw = F.ctl + (rep ? CW_CNT + 2048 * rep : CW_CNT);
    const int lane = F.lane, r16 = lane & 15, g4 = lane >> 4;
    const float br0 = a.in[14][r16], br1 = a.in[14][16 + r16];
    for (int tb = blockIdx.x; tb < T / 128; tb += F.G) {
        if (F.tid < 32) hist[F.tid] = 0;
        LDS_WAIT(); __builtin_amdgcn_s_barrier(); asm volatile("" ::: "memory");
        const int t0 = tb * 128 + F.wave * 16;
        const size_t xo = (size_t)(t0 + r16) * D + 8 * g4;
        f32x4 acc0 = (f32x4){0.f, 0.f, 0.f, 0.f}, acc1 = acc0;
        u32x2 x1[3][4], x2[3][4], x3[3][4];
        const unsigned xo32 = (unsigned)xo;
#define P7_LOADG(g_) do { _Pragma("unroll") for (int j_ = 0; j_ < 4; ++j_) { x1[(g_) % 3][j_] = pg8::gload64_hidden(h2q, xo32 + 32u * (unsigned)(4 * (g_) + j_)); x2[(g_) % 3][j_] = pg8::gload64_hidden(h2r, xo32 + 32u * (unsigned)(4 * (g_) + j_)); x3[(g_) % 3][j_] = pg8::gload64_hidden(h2s, xo32 + 32u * (unsigned)(4 * (g_) + j_)); } } while (0)
        P7_LOADG(0); P7_LOADG(1);
#pragma unroll
        for (int ks = 0; ks < 32; ++ks) {
            if ((ks & 3) == 0) { const int g_ = ks >> 2;
                if (g_ + 2 < 8) { P7_LOADG(g_ + 2); }
                if (g_ + 2 < 8) asm volatile("s_waitcnt vmcnt(24)" ::: "memory"); else if (g_ + 1 < 8) asm volatile("s_waitcnt vmcnt(12)" ::: "memory"); else asm volatile("s_waitcnt vmcnt(0)" ::: "memory");
#pragma unroll
                for (int j_ = 0; j_ < 4; ++j_) asm volatile("" : "+v"(x1[g_ % 3][j_]), "+v"(x2[g_ % 3][j_]), "+v"(x3[g_ % 3][j_])); }
            const u32x2 c1 = x1[(ks >> 2) % 3][ks & 3], c2 = x2[(ks >> 2) % 3][ks & 3], c3 = x3[(ks >> 2) % 3][ks & 3];
#define P7_BF8(w_, sc_) __builtin_bit_cast(bf16x8, (u32x4){cvtpk(dec4_fp8(w_.x)[0] * sc_, dec4_fp8(w_.x)[1] * sc_), cvtpk(dec4_fp8(w_.x)[2] * sc_, dec4_fp8(w_.x)[3] * sc_), cvtpk(dec4_fp8(w_.y)[0] * sc_, dec4_fp8(w_.y)[1] * sc_), cvtpk(dec4_fp8(w_.y)[2] * sc_, dec4_fp8(w_.y)[3] * sc_)})
            const bf16x8 ah = P7_BF8(c1, 1.0f), al = P7_BF8(c2, pg8::PL1_INV), am = P7_BF8(c3, pg8::PL2_INV);
#undef P7_BF8
            const int bo = r16 * WRS + (32 * ks + 8 * g4) * 2;
            const bf16x8 bh0 = *(const LAS bf16x8*)(WH + bo), bh1 = *(const LAS bf16x8*)(WH + 16 * WRS + bo), bl0 = *(const LAS bf16x8*)(WL + bo), bl1 = *(const LAS bf16x8*)(WL + 16 * WRS + bo);
            acc0 = __builtin_amdgcn_mfma_f32_16x16x32_bf16(ah, bh0, acc0, 0, 0, 0); acc1 = __builtin_amdgcn_mfma_f32_16x16x32_bf16(ah, bh1, acc1, 0, 0, 0);
            acc0 = __builtin_amdgcn_mfma_f32_16x16x32_bf16(ah, bl0, acc0, 0, 0, 0); acc1 = __builtin_amdgcn_mfma_f32_16x16x32_bf16(ah, bl1, acc1, 0, 0, 0);
            acc0 = __builtin_amdgcn_mfma_f32_16x16x32_bf16(al, bh0, acc0, 0, 0, 0); acc1 = __builtin_amdgcn_mfma_f32_16x16x32_bf16(al, bh1, acc1, 0, 0, 0);
            acc0 = __builtin_amdgcn_mfma_f32_16x16x32_bf16(am, bh0, acc0, 0, 0, 0); acc1 = __builtin_amdgcn_mfma_f32_16x16x32_bf16(am, bh1, acc1, 0, 0, 0);
        }
#undef P7_LOADG
        int my_e = 0; float my_g = 0.f;
#pragma unroll
        for (int j = 0; j < 4; ++j) {
            const float rs = __builtin_amdgcn_rsqf(ss2[t0 + 4 * g4 + j] * (1.0f / D) + EPS);
            float a0 = acc0[j] * rs + br0, a1 = acc1[j] * rs + br1; float tv[4]; int te_[4];
#pragma unroll
            for (int k = 0; k < 4; ++k) { float m = fmaxf(a0, a1);
                m = row16_max(m);
                int e = (a0 == m) ? r16 : ((a1 == m) ? 16 + r16 : 99);
                e = row16_min(e);
                tv[k] = m; te_[k] = e; if (e == r16) a0 = -INFINITY; if (e == 16 + r16) a1 = -INFINITY; }
            const float d1 = fast_exp2((tv[1] - tv[0]) * LOG2E), d2 = fast_exp2((tv[2] - tv[0]) * LOG2E), d3 = fast_exp2((tv[3] - tv[0]) * LOG2E);
            const float inv = 1.0f / (1.0f + d1 + d2 + d3);
            if ((r16 >> 2) == j) { const int k = lane & 3; my_e = k == 0 ? te_[0] : (k == 1 ? te_[1] : (k == 2 ? te_[2] : te_[3])); my_g = (k == 0 ? 1.0f : (k == 1 ? d1 : (k == 2 ? d2 : d3))) * inv; }
        }
        const int rl = __hip_atomic_fetch_add(hist + my_e, 1, __ATOMIC_RELAXED, __HIP_MEMORY_SCOPE_WORKGROUP);
        LDS_WAIT(); __builtin_amdgcn_s_barrier(); asm volatile("" ::: "memory");
        if (F.tid < 32) basel[F.tid] = (int)__hip_atomic_fetch_add(cntw + F.tid, (unsigned)hist[F.tid], RLX_AGENT);
        LDS_WAIT(); VM_WAIT(); __builtin_amdgcn_s_barrier(); asm volatile("" ::: "memory");
        { const int t = t0 + 4 * g4 + (r16 >> 2), k = lane & 3; const int rank = basel[my_e] + rl;
          list[(size_t)my_e * T + rank] = t; dlist[(size_t)my_e * T + rank] = t * 4 + k; glist[(size_t)my_e * T + rank] = my_g; sslist[(size_t)my_e * T + rank] = ss2[t]; }
        LDS_WAIT(); __builtin_amdgcn_s_barrier(); asm volatile("" ::: "memory");
    }
}

__device__ __forceinline__ int build_tables(Frame& F) {
    LAS int* ts = (LAS int*)(F.lds + TL_TS); LAS unsigned char* te = (LAS unsigned char*)(F.lds + TL_TE);
    if (F.tid < NEXP) ((LAS int*)(F.lds + TL_CNT))[F.tid] = (int)__hip_atomic_load(F.ctl + CW_CNT + F.tid, RLX_AGENT);
    LDS_WAIT(); __builtin_amdgcn_s_barrier(); asm volatile("" ::: "memory");
    if (F.tid == 0) { int run = 0;
        for (int e = 0; e < NEXP; ++e) { ts[e] = run; run += (((LAS int*)(F.lds + TL_CNT))[e] + 255) >> 8; }
        ts[NEXP] = run; }
    LDS_WAIT(); __builtin_amdgcn_s_barrier(); asm volatile("" ::: "memory");
    const int nt = ts[NEXP];
    for (int g = F.tid; g < nt; g += 512) { int e = 0;
        for (int j = 1; j < NEXP; ++j) e += (ts[j] <= g) ? 1 : 0;
        te[g] = (unsigned char)e; }
    LDS_WAIT(); __builtin_amdgcn_s_barrier(); asm volatile("" ::: "memory");
    return __builtin_amdgcn_readfirstlane(nt);
}

typedef int i32x4 __attribute__((ext_vector_type(4)));
struct P10Rows { u32x2 y[2][4][2]; u32x2 hq[2][2], hr[2][2]; };
__device__ __forceinline__ void p10_issue(P10Rows& R, int t0, const unsigned char* Y, const unsigned char* h2q, const unsigned char* h2r, int lane) {
#pragma unroll
    for (int q = 0; q < 2; ++q) { const int t = t0 + q;
#pragma unroll
        for (int k = 0; k < 4; ++k) { const unsigned char* yr = Y + ((size_t)t * 4 + k) * D;
            R.y[q][k][0] = __builtin_nontemporal_load((const u32x2*)(yr + 8 * lane)); R.y[q][k][1] = __builtin_nontemporal_load((const u32x2*)(yr + 512 + 8 * lane)); }
        R.hq[q][0] = __builtin_nontemporal_load((const u32x2*)(h2q + (size_t)t * D + 8 * lane)); R.hr[q][0] = __builtin_nontemporal_load((const u32x2*)(h2r + (size_t)t * D + 8 * lane));
        R.hq[q][1] = __builtin_nontemporal_load((const u32x2*)(h2q + (size_t)t * D + 512 + 8 * lane)); R.hr[q][1] = __builtin_nontemporal_load((const u32x2*)(h2r + (size_t)t * D + 512 + 8 * lane)); }
}
__device__ __forceinline__ void p10_combine(Frame& F, const Args& a) {
    unsigned char* ws = a.ws;
    const unsigned char* h2q = ws + WS_H2B; const unsigned char* h2r = ws + WS_H2F; const unsigned char* Y = (const unsigned char*)(ws + WS_Y);
    const float* gf = a.in[19];
    const int gw = F.vcu * NWAVES + F.wave, NGW = F.G * NWAVES, lane = F.lane, step = 2 * NGW;
    int t0 = 2 * gw; if (t0 >= T) return;
    P10Rows R, Rn;
    p10_issue(R, t0, Y, h2q, h2r, lane);
    for (; t0 < T; t0 += step) {
        const int tn = t0 + step; const bool hn = tn < T;
        if (hn) p10_issue(Rn, tn, Y, h2q, h2r, lane);
        float o[2][16];
#pragma unroll
        for (int q = 0; q < 2; ++q) {
            const f32x4 h0 = dec4_fp8(R.hq[q][0].x) + dec4_fp8(R.hr[q][0].x) * pg8::PL1_INV, h1_ = dec4_fp8(R.hq[q][0].y) + dec4_fp8(R.hr[q][0].y) * pg8::PL1_INV,
                        h2_ = dec4_fp8(R.hq[q][1].x) + dec4_fp8(R.hr[q][1].x) * pg8::PL1_INV, h3 = dec4_fp8(R.hq[q][1].y) + dec4_fp8(R.hr[q][1].y) * pg8::PL1_INV;
#pragma unroll
            for (int j = 0; j < 4; ++j) { o[q][j] = h0[j]; o[q][4 + j] = h1_[j]; o[q][8 + j] = h2_[j]; o[q][12 + j] = h3[j]; }
#pragma unroll
            for (int k = 0; k < 4; ++k)
#pragma unroll
                for (int hf = 0; hf < 2; ++hf) { const u32x2 w = R.y[q][k][hf]; const f32x4 c0 = dec4_fp8(w.x), c1 = dec4_fp8(w.y);
#pragma unroll
                    for (int j = 0; j < 4; ++j) { o[q][8 * hf + j] += pg8::YSCALE_INV * c0[j]; o[q][8 * hf + 4 + j] += pg8::YSCALE_INV * c1[j]; } }
            float s = 0.f;
#pragma unroll
            for (int j = 0; j < 16; ++j) s += o[q][j] * o[q][j];
            const float rstd = 1.0f / sqrtf(wave_sum(s) * (1.0f / D) + EPS);
            float* op = a.out + (size_t)(t0 + q) * D;
#pragma unroll
            for (int v = 0; v < 4; ++v) { const int col = (v >> 1) * 512 + 8 * lane + (v & 1) * 4; const f32x4 g4 = *(const f32x4*)(gf + col);
                *(f32x4*)(op + col) = (f32x4){o[q][4 * v] * rstd * g4.x, o[q][4 * v + 1] * rstd * g4.y, o[q][4 * v + 2] * rstd * g4.z, o[q][4 * v + 3] * rstd * g4.w}; }
        }
        R = Rn;
    }
}

#define XB_TMO      128
#define XB_XCNT(j)  (256  + 64 * (j))
#define XB_XSUB(j)  (1280 + 64 * (j))
#define XB_XGEN(j)  (2304 + 64 * (j))
#define XB_TOP      3328
#define XB_TOPGEN   3392
#define XCD_BAR_WORDS 3456
#define XB_SPIN_CAP (1u << 22)
__device__ __forceinline__ unsigned xb_ld(unsigned* p)              { return __hip_atomic_load(p, __ATOMIC_RELAXED, __HIP_MEMORY_SCOPE_AGENT); }
__device__ __forceinline__ unsigned xb_add(unsigned* p, unsigned v) { return __hip_atomic_fetch_add(p, v, __ATOMIC_RELAXED, __HIP_MEMORY_SCOPE_AGENT); }
#define XB_SPIN(cond, bar) do { unsigned _sp = 0; while (cond) { __builtin_amdgcn_s_sleep(1); \
    if ((++_sp & 255u) == 0u) { if (xb_ld(&(bar)[XB_TMO])) break; if (_sp > XB_SPIN_CAP) { atomicAdd(&(bar)[XB_TMO], 1u); break; } } } } while (0)
struct XcdBarrier { unsigned* bar; unsigned x; volatile LAS unsigned* st; };
__device__ __forceinline__ XcdBarrier xcd_barrier_post(unsigned* bar, volatile LAS unsigned* st) {
    XcdBarrier b; b.bar = bar; b.x = (unsigned)__builtin_amdgcn_s_getreg((3 << 11) | 20) & 0xFu; b.st = st;
    if (threadIdx.x == 0) (void)xb_add(&bar[XB_XCNT(b.x)], 1u);
    return b;
}
__device__ __forceinline__ void xcd_barrier_complete(unsigned* bar, unsigned x, unsigned& nloc, unsigned& nx) {
    const unsigned G = gridDim.x * gridDim.y * gridDim.z;
    unsigned sum, cnt, mine, sp = 0u;
    for (;;) {
        sum = 0u; cnt = 0u; mine = 0u;
#pragma unroll
        for (unsigned j = 0; j < 16; ++j) { const unsigned c = xb_ld(&bar[XB_XCNT(j)]); sum += c; cnt += (c > 0u) ? 1u : 0u; mine = (j == x) ? c : mine; }
        if (sum == G) break;
        __builtin_amdgcn_s_sleep(1);
        if ((++sp & 255u) == 0u) { if (xb_ld(&bar[XB_TMO])) break; if (sp > XB_SPIN_CAP) { atomicAdd(&bar[XB_TMO], 1u); break; } }
    }
    nloc = mine > 0u ? mine : 1u; nx = cnt > 0u ? cnt : 1u;
}
__device__ __forceinline__ void xcd_barrier(const XcdBarrier& b) {
    asm volatile("s_waitcnt vmcnt(0)" ::: "memory");
    __syncthreads();
    if (threadIdx.x == 0) {
        unsigned* bar = b.bar;
        __builtin_amdgcn_s_waitcnt(0);
        unsigned nloc = b.st[0], nx = b.st[1];
        if (nloc == 0u) { xcd_barrier_complete(bar, b.x, nloc, nx); b.st[0] = nloc; b.st[1] = nx; }
        const unsigned old = xb_add(&bar[XB_XSUB(b.x)], 1u);
        const unsigned gen = old / nloc;
        if (old + 1u == (gen + 1u) * nloc) {
            __builtin_amdgcn_fence(__ATOMIC_RELEASE, "agent");
            asm volatile("s_waitcnt vmcnt(0)" ::: "memory");
            const unsigned og = xb_add(&bar[XB_TOP], 1u);
            const unsigned tg = og / nx;
            if (og + 1u == (tg + 1u) * nx) xb_add(&bar[XB_TOPGEN], 1u);
            else XB_SPIN(xb_ld(&bar[XB_TOPGEN]) == tg, bar);
            __builtin_amdgcn_fence(__ATOMIC_ACQUIRE, "agent");
            xb_add(&bar[XB_XGEN(b.x)], 1u);
            asm volatile("s_waitcnt vmcnt(0)" ::: "memory");
        } else {
            XB_SPIN(xb_ld(&bar[XB_XGEN(b.x)]) == gen, bar);
            __builtin_amdgcn_fence(__ATOMIC_ACQUIRE, "agent");
            asm volatile("s_waitcnt vmcnt(0)" ::: "memory");
        }
    }
    __syncthreads();
}
#ifndef MK_CG_ONLY
#define MK_CG_ONLY 0
#endif
__device__ __forceinline__ void grid_barrier(Frame& F, const XcdBarrier& xb_) { if (MK_CG_ONLY) cg::this_grid().sync(); else xcd_barrier(xb_); }
#ifndef MK_PHASE_MASK
#define MK_PHASE_MASK 0x7ff
#endif
#ifndef MK_REP_PHASE
#define MK_REP_PHASE -1
#endif
#ifndef MK_REP_N
#define MK_REP_N 0
#endif
__device__ __forceinline__ void ph0(Frame& F, const Args& args, int rep) { p0_prologue(F, args); }
__device__ __forceinline__ void ph1(Frame& F, const Args& args, int rep) {
    unsigned char* ws = args.ws; const int cid = (int)blockIdx.x;
    { pg8::DenseOrder S{(const char*)(ws + WS_XN8), (const char*)(ws + WS_WIN8), D / 2, D / 2, T / 256, 6, F.G, cid, 0};
      pg8::EpiProj E{(bf16_t*)(ws + WS_PROJ), rep ? (float*)(ws + WS_DUMMY) : (float*)(ws + WS_KBAR), WSCALE8_INV};
      pg8::gemm_phase<pg8::EpiProj, pg8::DenseOrder, false, true, true>(F.lds, D / 2, D / 2, D / 128, S, E); }
    { pg8::DenseOrder S{(const char*)(ws + WS_XN), (const char*)(ws + WS_WIN + (size_t)1536 * D * 2), D, D, T / 256, 8, F.G, cid, 6};
      pg8::EpiProj E{(bf16_t*)(ws + WS_PROJ), rep ? (float*)(ws + WS_DUMMY) : (float*)(ws + WS_KBAR), 1.0f};
      pg8::gemm_phase<pg8::EpiProj, pg8::DenseOrder, false, true>(F.lds, D, D, D / 64, S, E); }
}
__device__ __forceinline__ void ph2(Frame& F, const Args& args, int rep) { p2_mixer(F, args, rep); }
constexpr size_t WS_MB = WS_PROJ, WS_NB = WS_PROJ + 16 * MiB, WS_H1Q = WS_PROJ + 32 * MiB, WS_PB = WS_QX;
constexpr size_t WS_UNUSED_XA = 0;
constexpr int LDS_XTAB = 131072;
__device__ __forceinline__ void ph3(Frame& F, const Args& args, int rep) {
    unsigned char* ws = args.ws; const int cid = (int)blockIdx.x;
    { pg8::DenseOrder S{(const char*)(ws + WS_MIX), (const char*)(ws + WS_WOUT), D / 2, D / 2, T / 256, D / 256, F.G, cid, 0};
      pg8::EpiRes<1, 2, true> E{(const void*)(ws + WS_XN), (bf16_t*)(ws + WS_H1B), nullptr, rep ? (float*)(ws + WS_DUMMY + 512 * 1024) : (float*)(ws + WS_SS1), (unsigned char*)(ws + WS_H1Q), (const float*)(ws + WS_RS0), nullptr, MIXS8_INV * WSCALE8_INV};
      pg8::gemm_phase<pg8::EpiRes<1, 2, true>, pg8::DenseOrder, false, true, true>(F.lds, D / 2, D / 2, D / 128, S, E); }
    { pg8::XmnOrder S{(const char*)(ws + WS_MEMK), (const char*)(ws + WS_MEMVT), (const char*)(ws + WS_WQ), (const char*)(ws + WS_WO), F.G, cid};
      pg8::EpiFp8 E{(unsigned char*)(ws + WS_MB), D, (unsigned char*)(ws + WS_NB), D, XSCALE8};
      pg8::gemm_phase<pg8::EpiFp8, pg8::XmnOrder, false, true>(F.lds, D, D, 4, S, E); }
}
__device__ __forceinline__ void ph4(Frame& F, const Args& args, int rep) {
    unsigned char* ws = args.ws; const int cid = (int)blockIdx.x;
    pg8::XbOrder S{(const char*)(ws + WS_H1Q), (const char*)(ws + WS_MB), F.G, cid, (size_t)D};
    pg8::EpiSoftmaxS E{(unsigned char*)(ws + WS_PB), (const float*)(ws + WS_SS1), F.lds + LDS_XTAB, XSCALE8_INV};
    pg8::gemm_phase<pg8::EpiSoftmaxS, pg8::XbOrder, false, true, true>(F.lds, D / 2, D / 2, D / 128, S, E);
}
__device__ __forceinline__ void ph5(Frame& F, const Args& args, int rep) {}
__device__ __forceinline__ void ph6(Frame& F, const Args& args, int rep) {
    unsigned char* ws = args.ws; const int cid = (int)blockIdx.x;
    pg8::XbOrder S{(const char*)(ws + WS_PB), (const char*)(ws + WS_NB), F.G, cid, (size_t)D};
    pg8::EpiRes<2, 3> E{(const void*)(ws + WS_H1Q), (bf16_t*)(ws + WS_H2B), (float*)(ws + WS_H2F), rep ? (float*)(ws + WS_DUMMY + 512 * 1024) : (float*)(ws + WS_SS2), nullptr, nullptr, (const void*)(ws + WS_H1B), PSCALE8_INV * XSCALE8_INV};
    pg8::gemm_phase<pg8::EpiRes<2, 3>, pg8::XbOrder, false, true, true>(F.lds, D / 2, D / 2, D / 128, S, E);
}
__device__ __forceinline__ void ph7(Frame& F, const Args& args, int rep) { p7_router(F, args, rep); }
__device__ __forceinline__ void ph8(Frame& F, const Args& args, int rep) {
    unsigned char* ws = args.ws; const int cid = (int)blockIdx.x;
    const int ntl = build_tables(F);
    pg8::MoeOrder S{(const char*)(ws + WS_H2B), (const char*)(ws + WS_W1), (const int*)(ws + WS_LIST), (const LAS int*)(F.lds + TL_CNT), (const LAS unsigned char*)(F.lds + TL_TE), (const LAS int*)(F.lds + TL_TS),
                    ntl, 8, F.G, cid, (size_t)2048 * D, 1, (size_t)256 * D, (size_t)256 * D};
    pg8::EpiW1 E{(bf16_t*)(ws + WS_HMID), (const float*)(ws + WS_SSLIST), args.in[16], (const int*)(ws + WS_LIST)};
    pg8::gemm_phase<pg8::EpiW1, pg8::MoeOrder, true, true, true>(F.lds, D / 2, D / 2, D / 128, S, E);
}
__device__ __forceinline__ void ph9(Frame& F, const Args& args, int rep) {
    unsigned char* ws = args.ws; const int cid = (int)blockIdx.x;
    const int ntl = (args.ph_lo <= 8) ? __builtin_amdgcn_readfirstlane(((const LAS int*)(F.lds + TL_TS))[NEXP]) : build_tables(F);
    pg8::MoeOrder S{(const char*)(ws + WS_HMID), (const char*)(ws + WS_W2), (const int*)(ws + WS_LIST), (const LAS int*)(F.lds + TL_CNT), (const LAS unsigned char*)(F.lds + TL_TE), (const LAS int*)(F.lds + TL_TS),
                    ntl, 4, F.G, cid, (size_t)D * D, 0, (size_t)256 * D, (size_t)256 * D};
    pg8::EpiW2 E{(unsigned char*)(ws + WS_Y), args.in[18], (const int*)(ws + WS_LIST), (const float*)(ws + WS_GLIST), (const int*)(ws + WS_DLIST)};
    pg8::gemm_phase<pg8::EpiW2, pg8::MoeOrder, false, true, true>(F.lds, D / 2, D / 2, D / 128, S, E);
}
__device__ __forceinline__ void ph10(Frame& F, const Args& args, int rep) { if (args.ph_lo > 8) (void)build_tables(F); p10_combine(F, args); }

constexpr int N_PHASES = 11;
__global__ void __launch_bounds__(NWAVES * 64, 2) hymba_fwd(Args args) {
    extern __shared__ __attribute__((aligned(16))) unsigned char lds_raw[];
    Frame F;
    F.lds = (LAS unsigned char*)lds_raw;
    F.MISC = (volatile LAS unsigned*)(F.lds + TL_MISC);
    F.tid = threadIdx.x; F.lane = F.tid & 63; F.wave = __builtin_amdgcn_readfirstlane(F.tid >> 6);
    F.G = gridDim.x; { const int bx = blockIdx.x; F.vcu = (F.G % 8 == 0) ? (bx % 8) * (F.G / 8) + bx / 8 : bx; }
    F.ctl = (unsigned*)(args.ws + WS_CTL);
    const int lo = args.ph_lo, hi = args.ph_hi;
    for (int u = F.tid; u < 64; u += NWAVES * 64) ((LAS unsigned*)(F.lds + TL_MISC))[u] = 0u;
    __syncthreads();
    const XcdBarrier xbar = xcd_barrier_post(F.ctl + CW_BAR, F.MISC + 8);
#define RUN(k, fn) do { if (((MK_PHASE_MASK >> (k)) & 1) && lo <= (k) && (k) < hi) { fn(F, args, 0); \
        if (MK_REP_PHASE == (k) && MK_REP_N >= 1) { grid_barrier(F, xbar); fn(F, args, 1); } \
        if (MK_REP_PHASE == (k) && MK_REP_N >= 2) { grid_barrier(F, xbar); fn(F, args, 2); } \
        if ((k) + 1 < hi) { grid_barrier(F, xbar); } } } while (0)
    if (args.ph_lo < 0) cg::this_grid().sync();
    RUN(0, ph0); RUN(1, ph1); RUN(2, ph2); RUN(3, ph3); RUN(4, ph4);   RUN(6, ph6); RUN(7, ph7); RUN(8, ph8); RUN(9, ph9); RUN(10, ph10);
#undef RUN
}

extern "C" void kernel_launch(void* const* d_in, const int* in_sizes, int n_in, void* d_out, int out_size, void* d_ws, size_t ws_size, hipStream_t stream) {
    static int grid = 0;
    if (grid == 0) {
        if (n_in != 20 || in_sizes[0] != T * D || out_size != T * D || ws_size < WS_END) {
            fprintf(stderr, "kernel_launch: shape/workspace mismatch (n_in %d, in0 %d, out %d, ws %zu, need %zu)\n", n_in, n_in > 0 ? in_sizes[0] : -1, out_size, ws_size, (size_t)WS_END); grid = -1; return; }
        int dev = 0, cus = 0, per_cu = 0;
        if (hipGetDevice(&dev) != hipSuccess || hipDeviceGetAttribute(&cus, hipDeviceAttributeMultiprocessorCount, dev) != hipSuccess) { grid = -1; return; }
        if (hipFuncSetAttribute((const void*)hymba_fwd, hipFuncAttributeMaxDynamicSharedMemorySize, LDS_BYTES) != hipSuccess) { fprintf(stderr, "kernel_launch: hipFuncSetAttribute failed\n"); grid = -1; return; }
        if (hipOccupancyMaxActiveBlocksPerMultiprocessor(&per_cu, (const void*)hymba_fwd, NWAVES * 64, LDS_BYTES) != hipSuccess || per_cu < 1) { fprintf(stderr, "kernel_launch: occupancy query says %d\n", per_cu); }
        (void)hipGetLastError();
        grid = cus;
        if (grid != 256) fprintf(stderr, "kernel_launch: %d CUs; this kernel is built for 256\n", grid);
    }
    if (grid < 0) return;
    (void)hipMemsetAsync((char*)d_ws + WS_CTL, 0, CTL_ZERO_BYTES, stream);
    Args a{};
    for (int i = 0; i < 20; ++i) a.in[i] = (const float*)d_in[i];
    a.out = (float*)d_out; a.ws = (unsigned char*)d_ws;
#if MK_N_LAUNCHES == 1
    a.ph_lo = 0; a.ph_hi = MK_LAST_PHASE + 1;
    void* kargs[] = {&a};
    hipError_t e = hipLaunchCooperativeKernel((const void*)hymba_fwd, dim3(grid), dim3(NWAVES * 64), kargs, LDS_BYTES, stream);
    if (e != hipSuccess) fprintf(stderr, "kernel_launch: cooperative launch failed: %s\n", hipGetErrorString(e));
#else
    for (int p = 0; p <= MK_LAST_PHASE; ++p) { a.ph_lo = p; a.ph_hi = p + 1; hipLaunchKernelGGL(hymba_fwd, dim3(grid), dim3(NWAVES * 64), LDS_BYTES, stream, a); }
#endif
}
```
